# Optimizing an MI355X kernel written in HIP

```python
import functools
import jax, jax.numpy as jnp
from jax import lax
import numpy as np

D_MODEL = 2048
BATCH = 16
SEQ = 2048
DEPTH = 4

GRID_W = 64
CTX_LEN = 256
N_MIXERS = 3
EPS = 1e-6

F_GROUPS = 4
M_HEADS = 8
M_DQK = D_MODEL // (2 * M_HEADS)
M_DV = D_MODEL // M_HEADS
M_QK = M_HEADS * M_DQK
M_V = M_HEADS * M_DV
M_CHUNK = 64
M_IN = 2 * M_QK + 3 * M_V + 4 * M_HEADS
A_HEADS = 16
A_KV = 4
A_HD = 128
A_GROUP = A_HEADS // A_KV
A_Q = A_HEADS * A_HD
A_KVW = A_KV * A_HD
A_IN = 2 * A_Q + 2 * A_KVW
A_BLOCK = 128
A_ROT_AXIS = A_HD // 2
ROPE_THETA = 10000.0

N_FNET = (DEPTH + 2) // 3
N_MLSTM = (DEPTH + 1) // 3
N_ATTN = DEPTH // 3

kernel_name = 'hybrid_fnet_mlstm_gqa_prefix_dit'


def _rmsnorm(x, g):
    x32 = x.astype(jnp.float32)
    y = x32 * lax.rsqrt(jnp.mean(x32 * x32, axis=-1, keepdims=True) + EPS)
    return (y * g.astype(jnp.float32)).astype(x.dtype)


def _fourier_mix(h):
    B, T, D = h.shape
    hg = h.astype(jnp.float32).reshape(B, T, F_GROUPS, D // F_GROUPS)
    y = jnp.fft.fft2(hg, axes=(1, 3), norm='ortho').real
    return y.reshape(B, T, D).astype(h.dtype)


def _fnet_branch(h, w_gate, w_out):
    return (_fourier_mix(h) * jax.nn.silu(h @ w_gate)) @ w_out


def _mlstm_chunk(carry, xs, emit):
    C, n, m = carry
    q, k, v, ig, lf = xs
    L = lf.shape[-1]
    b = jnp.cumsum(lf, axis=-1)
    b_end = b[..., -1]
    g = b_end[..., None] - b + ig
    m_new = jnp.maximum(b_end + m, jnp.max(g, axis=-1))
    w = jnp.exp(g - m_new[..., None])
    decay = jnp.exp(b_end + m - m_new)
    C_new = decay[..., None, None] * C + jnp.einsum('bhsd,bhse->bhde', k * w[..., None], v)
    n_new = decay[..., None] * n + jnp.einsum('bhs,bhsd->bhd', w, k)
    if not emit:
        return (C_new, n_new, m_new), None
    order = jnp.tril(jnp.ones((L, L), dtype=bool))
    dmat = jnp.where(order, b[..., :, None] - b[..., None, :] + ig[..., None, :], -jnp.inf)
    inter = b + m[..., None]
    m_t = jnp.maximum(inter, jnp.max(dmat, axis=-1))
    s = jnp.einsum('bhtd,bhsd->bhts', q, k) * jnp.exp(dmat - m_t[..., None])
    a = jnp.exp(inter - m_t)
    num = a[..., None] * jnp.einsum('bhtd,bhde->bhte', q, C) + jnp.einsum('bhts,bhse->bhte', s, v)
    den = a * jnp.einsum('bhtd,bhd->bht', q, n) + jnp.sum(s, axis=-1)
    h = num / jnp.maximum(jnp.abs(den), jnp.exp(-m_t))[..., None]
    return (C_new, n_new, m_new), h


def _mlstm_scan(q, k, v, ig, lf, state, emit):
    B, NH, T, _ = q.shape
    nc = T // M_CHUNK

    def to_chunks(a):
        a = a.reshape(a.shape[:2] + (nc, M_CHUNK) + a.shape[3:])
        return jnp.moveaxis(a, 2, 0)

    xs = (to_chunks(q), to_chunks(k), to_chunks(v), to_chunks(ig), to_chunks(lf))
    state, h = lax.scan(functools.partial(_mlstm_chunk, emit=emit), state, xs)
    if emit:
        h = jnp.moveaxis(h, 0, 2).reshape(B, NH, T, M_DV)
    return state, h


def _mlstm_bidir(q, k, v, ig_f, lf_f, ig_b, lf_b, st_f, st_b, emit):
    st_f, h_f = _mlstm_scan(q, k, v, ig_f, lf_f, st_f, emit)
    flip = lambda a: jnp.flip(a, axis=2)
    st_b, h_b = _mlstm_scan(flip(q), flip(k), flip(v), flip(ig_b), flip(lf_b), st_b, emit)
    h = (h_f + flip(h_b)) if emit else None
    return st_f, st_b, h


def _mlstm_branch(h_lat, h_ctx, w_in, b_gate, hn, w_out, ctx_out):
    f32 = jnp.float32
    idx = [M_QK, 2 * M_QK, 2 * M_QK + M_V, 2 * M_QK + 2 * M_V, 2 * M_QK + 2 * M_V + 4 * M_HEADS]

    def project(h):
        B, T, _ = h.shape
        q, k, v, o, g, z = jnp.split(h @ w_in, idx, axis=-1)
        heads = lambda a, d: a.reshape(B, T, M_HEADS, d).transpose(0, 2, 1, 3).astype(f32)
        q = heads(q, M_DQK) * (M_DQK ** -0.5)
        k = heads(k, M_DQK)
        v = heads(v, M_DV)
        g = (g.astype(f32) + b_gate.astype(f32)).reshape(B, T, 4, M_HEADS).transpose(2, 0, 3, 1)
        ig_f, fg_f, ig_b, fg_b = g[0], g[1], g[2], g[3]
        scan_in = (q, k, v, ig_f, jax.nn.log_sigmoid(fg_f), ig_b, jax.nn.log_sigmoid(fg_b))
        return scan_in, o, z

    def finish(h, o, z):
        B, _, T, _ = h.shape
        h = h.transpose(0, 2, 1, 3)
        y = jax.nn.sigmoid(o.astype(f32)).reshape(B, T, M_HEADS, M_DV) * h
        y = _rmsnorm(y, hn.reshape(M_HEADS, M_DV)).reshape(B, T, M_V).astype(z.dtype)
        return (y * jax.nn.silu(z)) @ w_out

    B = h_ctx.shape[0]
    zero = (jnp.zeros((B, M_HEADS, M_DQK, M_DV), f32), jnp.zeros((B, M_HEADS, M_DQK), f32),
            jnp.zeros((B, M_HEADS), f32))
    ctx_in, o_c, z_c = project(h_ctx)
    st_f, st_b, h_c = _mlstm_bidir(*ctx_in, zero, zero, emit=ctx_out)
    lat_in, o_x, z_x = project(h_lat)
    _, _, h_x = _mlstm_bidir(*lat_in, st_f, st_b, emit=True)
    y_lat = finish(h_x, o_x, z_x)
    y_ctx = finish(h_c, o_c, z_c) if ctx_out else None
    return y_lat, y_ctx


def _rope_tables(T):
    rows = T // GRID_W
    r = jnp.repeat(jnp.arange(rows), GRID_W).astype(jnp.float32)
    col = jnp.tile(jnp.arange(GRID_W), rows).astype(jnp.float32)
    freqs = ROPE_THETA ** (-jnp.arange(0, A_ROT_AXIS, 2, dtype=jnp.float32) / A_ROT_AXIS)
    ang = jnp.concatenate([r[:, None] * freqs, col[:, None] * freqs], axis=-1)
    return jnp.cos(ang), jnp.sin(ang)


def _rope(x, cos, sin):
    x32 = x.astype(jnp.float32).reshape(x.shape[:-1] + (A_HD // 2, 2))
    x0, x1 = x32[..., 0], x32[..., 1]
    c = cos[None, :, None, :]
    s = sin[None, :, None, :]
    out = jnp.stack([x0 * c - x1 * s, x0 * s + x1 * c], axis=-1).reshape(x.shape)
    return out.astype(x.dtype)


def _attend(q, k, v):
    B, Tq = q.shape[:2]
    nb = Tq // A_BLOCK
    qb = jnp.moveaxis(q.reshape((B, nb, A_BLOCK) + q.shape[2:]), 1, 0)

    def one(qblk):
        s = jnp.einsum('bqkgd,bskd->bkgqs', qblk, k).astype(jnp.float32) * (A_HD ** -0.5)
        p = jax.nn.softmax(s, axis=-1).astype(v.dtype)
        return jnp.einsum('bkgqs,bskd->bqkgd', p, v)

    o = lax.map(one, qb)
    return jnp.moveaxis(o, 0, 1).reshape(B, Tq, A_Q)


def _attn_branch(h_lat, h_ctx, w_in, qn, kn, w_out, ctx_out):
    def project(h):
        B, T, _ = h.shape
        q, k, v, z = jnp.split(h @ w_in, [A_Q, A_Q + A_KVW, A_Q + 2 * A_KVW], axis=-1)
        q = _rmsnorm(q.reshape(B, T, A_HEADS, A_HD), qn)
        k = _rmsnorm(k.reshape(B, T, A_KV, A_HD), kn)
        v = v.reshape(B, T, A_KV, A_HD)
        return q, k, v, z

    group = lambda q: q.reshape(q.shape[:2] + (A_KV, A_GROUP, A_HD))
    qc, kc, vc, zc = project(h_ctx)
    qx, kx, vx, zx = project(h_lat)
    cos, sin = _rope_tables(h_lat.shape[1])
    qx = _rope(qx, cos, sin)
    kx = _rope(kx, cos, sin)
    k_all = jnp.concatenate([kx, kc], axis=1)
    v_all = jnp.concatenate([vx, vc], axis=1)
    y_lat = (_attend(group(qx), k_all, v_all) * jax.nn.silu(zx)) @ w_out
    y_ctx = ((_attend(group(qc), kc, vc) * jax.nn.silu(zc)) @ w_out) if ctx_out else None
    return y_lat, y_ctx


def setup_inputs(seed: int = 0) -> dict:
    key = jax.random.key(seed)
    ks = jax.random.split(key, 20)
    D = D_MODEL
    nrm = lambda k, shape, s: jax.random.normal(k, shape, jnp.float32) * s
    f_bias = jnp.linspace(3.0, 6.0, M_HEADS, dtype=jnp.float32)
    base = jnp.stack([jnp.zeros_like(f_bias), f_bias, jnp.zeros_like(f_bias), f_bias])
    b_gate = (base[None] + nrm(ks[11], (N_MLSTM, 4, M_HEADS), 0.1)).reshape(N_MLSTM, 4 * M_HEADS)
    return {
        'x': nrm(ks[0], (BATCH, SEQ, D), 1.0),
        'c': nrm(ks[1], (BATCH, D), 1.0),
        'ctx': nrm(ks[2], (BATCH, CTX_LEN, D), 1.0),
        'c_ctx': nrm(ks[3], (D,), 1.0),
        'ada_w': nrm(ks[4], (DEPTH, D, 3 * D), 0.5 * D ** -0.5),
        'ada_b': nrm(ks[5], (DEPTH, 3 * D), 0.01),
        'norm_g': 1.0 + nrm(ks[6], (DEPTH, D), 0.02),
        'fnet_w_gate': nrm(ks[7], (N_FNET, D, D), D ** -0.5),
        'fnet_w_out': nrm(ks[8], (N_FNET, D, D), D ** -0.5),
        'mlstm_w_in': nrm(ks[9], (N_MLSTM, D, M_IN), D ** -0.5),
        'mlstm_b_gate': b_gate,
        'mlstm_hn': 1.0 + nrm(ks[12], (N_MLSTM, M_V), 0.02),
        'mlstm_w_out': nrm(ks[13], (N_MLSTM, M_V, D), M_V ** -0.5),
        'attn_w_in': nrm(ks[14], (N_ATTN, D, A_IN), D ** -0.5),
        'attn_qn': 1.0 + nrm(ks[15], (N_ATTN, A_HD), 0.02),
        'attn_kn': 1.0 + nrm(ks[16], (N_ATTN, A_HD), 0.02),
        'attn_w_out': nrm(ks[17], (N_ATTN, A_Q, D), A_Q ** -0.5),
        'final_g': 1.0 + nrm(ks[18], (D,), 0.02),
    }


def reference(x, c, ctx, c_ctx, ada_w, ada_b, norm_g, fnet_w_gate, fnet_w_out, mlstm_w_in,
              mlstm_b_gate, mlstm_hn, mlstm_w_out, attn_w_in, attn_qn, attn_kn, attn_w_out, final_g):
    sc = jax.nn.silu(c)
    sc_ctx = jax.nn.silu(c_ctx)
    for i in range(DEPTH):
        kind = i % N_MIXERS
        j = i // N_MIXERS
        ctx_out = i != DEPTH - 1
        shift, scale, gate = jnp.split(sc @ ada_w[i] + ada_b[i], 3, axis=-1)
        hx = _rmsnorm(x, norm_g[i]) * (1.0 + scale[:, None]) + shift[:, None]
        hc = None
        if ctx_out or kind != 0:
            shift_c, scale_c, gate_c = jnp.split(sc_ctx @ ada_w[i] + ada_b[i], 3, axis=-1)
            hc = _rmsnorm(ctx, norm_g[i]) * (1.0 + scale_c) + shift_c
        if kind == 0:
            y_x = _fnet_branch(hx, fnet_w_gate[j], fnet_w_out[j])
            y_c = _fnet_branch(hc, fnet_w_gate[j], fnet_w_out[j]) if ctx_out else None
        elif kind == 1:
            y_x, y_c = _mlstm_branch(hx, hc, mlstm_w_in[j], mlstm_b_gate[j], mlstm_hn[j],
                                     mlstm_w_out[j], ctx_out)
        else:
            y_x, y_c = _attn_branch(hx, hc, attn_w_in[j], attn_qn[j], attn_kn[j],
                                    attn_w_out[j], ctx_out)
        x = x + gate[:, None] * y_x
        if ctx_out:
            ctx = ctx + gate_c * y_c
    return _rmsnorm(x, final_g)
```

```cpp
#include <hip/hip_runtime.h>
#include <hip/hip_cooperative_groups.h>
#include <cstdio>
#include <cstdint>
namespace cg = cooperative_groups;

#define LAS __attribute__((address_space(3)))
#define DI __device__ __forceinline__
typedef unsigned short bf16_t;
typedef short bf16x8 __attribute__((ext_vector_type(8)));
typedef short s16x4 __attribute__((ext_vector_type(4)));
typedef float f32x2 __attribute__((ext_vector_type(2)));
typedef float f32x4 __attribute__((ext_vector_type(4)));
typedef float f32x16 __attribute__((ext_vector_type(16)));
typedef unsigned u32x2 __attribute__((ext_vector_type(2)));
typedef unsigned u32x4 __attribute__((ext_vector_type(4)));
typedef __bf16 bf16v2 __attribute__((ext_vector_type(2)));

constexpr int DM = 2048, NB = 16, TL = 2048, TC = 256, TB = TL + TC, NTOK = NB * TB;
constexpr int NWAVES = 8, NTHREADS = 512;
constexpr float EPS = 1e-6f;
constexpr int MOD_LD = 3 * DM;
constexpr int M_WA_ROWS = 6400, M_WB_ROWS = 3072;
constexpr size_t MiB = 1u << 20;
constexpr size_t WS_MOD = 0;
constexpr size_t MOD_BYTES = (size_t)4 * 17 * MOD_LD * 4;
constexpr size_t WS_WFG = 2 * MiB, WS_WFO = 18 * MiB, WS_WMA = 34 * MiB, WS_WMB = 59 * MiB, WS_WMO = 71 * MiB, WS_WAI = 79 * MiB, WS_WAO = 99 * MiB;
constexpr size_t WS_DC = 107 * MiB, WS_DT = 108 * MiB, WS_DT2 = 124 * MiB, WS_CTXS = 125 * MiB, WS_H = 157 * MiB, WS_SCR = 301 * MiB;
constexpr size_t WS_END = 1024 * MiB;
constexpr size_t F_G = 0, F_PQX = 144 * MiB, F_PQC = 400 * MiB;
constexpr size_t M_Q = 0, M_K = 72 * MiB, M_KVT = 144 * MiB, M_G32 = 360 * MiB, M_HF = 365 * MiB, M_HB = 509 * MiB, M_SO = 0, M_SZ = 144 * MiB;
constexpr size_t A_Q = 0, A_K = 144 * MiB, A_V = 180 * MiB, A_SZ = 216 * MiB;
static_assert(WS_SCR + M_HB + 144 * MiB <= WS_END, "ws map");
constexpr int LDS_BYTES = 131072 + 1024;

DI unsigned pk2(float a, float b) { f32x2 v = {a, b}; return __builtin_bit_cast(unsigned, __builtin_convertvector(v, bf16v2)); }
DI float bf_lo(unsigned w) { return __uint_as_float(w << 16); }
DI float bf_hi(unsigned w) { return __uint_as_float(w & 0xffff0000u); }
DI float wave_sum(float v) {
#pragma unroll
    for (int o = 1; o < 64; o <<= 1) v += __shfl_xor(v, o);
    return v;
}
DI int otid(int wv) { int t; asm volatile("v_mbcnt_lo_u32_b32 %0, -1, 0\n\tv_mbcnt_hi_u32_b32 %0, -1, %0" : "=v"(t)); return wv * 64 + t; }
DI float siluf(float x) { return x / (1.f + __expf(-x)); }
DI float sigmf(float x) { return 1.f / (1.f + __expf(-x)); }
DI void st_bf16x8(bf16_t* p, f32x4 a, f32x4 b) { u32x4 w = {pk2(a[0], a[1]), pk2(a[2], a[3]), pk2(b[0], b[1]), pk2(b[2], b[3])}; *(u32x4*)p = w; }
DI void ld_bf16x8(const bf16_t* p, f32x4& a, f32x4& b) { const u32x4 w = *(const u32x4*)p; a = (f32x4){bf_lo(w.x), bf_hi(w.x), bf_lo(w.y), bf_hi(w.y)}; b = (f32x4){bf_lo(w.z), bf_hi(w.z), bf_lo(w.w), bf_hi(w.w)}; }

struct Args { const float* in[18]; float* out; unsigned char* ws; int ph_lo, ph_hi; };

namespace pg8 {
constexpr int BM = 256, BK = 64, HALF = 128, HTB = HALF * BK * 2, NXCD = 8;
DI int lds_byte(int r, int c) { const int st = (r >> 4) * 2 + (c >> 5), rr = r & 15, cc = c & 31, ob = rr * 64 + cc * 2; return st * 1024 + (ob ^ (((ob >> 9) & 1) << 5)); }
DI void stage_rc(int b, int& R, int& C) { const int st = b / 1024, sb = b % 1024, swz = sb ^ (((sb >> 9) & 1) << 5); R = (st >> 1) * 16 + swz / 64; C = (st & 1) * 32 + (swz % 64) / 2; }
DI int perm32(int rho) { const int n = rho >> 4, i = rho & 15; return 8 * (i >> 2) + 4 * n + (i & 3); }
struct Unit { const char* a; const char* b; int i0, i1, i2; };
DI int xcd_remap(int L, int total) { const int q = total / NXCD, r = total % NXCD, xcd = L % NXCD, off = L / NXCD; return (xcd < r ? xcd * (q + 1) : r * (q + 1) + (xcd - r) * q) + off; }

template <class Desc, class Epi>
DI void gemm_phase(LAS unsigned char* lds, const Desc& D, const Epi& E, int wv) {
    const int tid = otid(wv), wid = __builtin_amdgcn_readfirstlane(tid >> 6), lane = tid & 63, wr = wid >> 2, wc = wid & 3, fr = lane & 15, fq = lane >> 4;
    const int G = gridDim.x, c = blockIdx.x, total = D.total;
    const int K = D.K, nt = K / BK;
    unsigned voffA[2], voffB[2];
#pragma unroll
    for (int i = 0; i < 2; ++i) { int R, C; stage_rc(tid * 16 + i * 8192, R, C); const int Rb = (R & ~31) + perm32(R & 31);
        voffA[i] = (unsigned)(R * D.lda + C) * 2u; voffB[i] = (unsigned)(Rb * D.ldb + C) * 2u; }
    const size_t kstep = (size_t)(BK * 2);
    const size_t hstepA = (size_t)HALF * D.lda * 2, hstepB = (size_t)HALF * D.ldb * 2;
    const unsigned ldsw = (unsigned)wid * 1024u;
    const int aoff = lds_byte(wr * 64 + fr, fq * 8), boff = lds_byte(wc * 32 + fr, fq * 8);
#define PG8_SA(b, h) (((b) * 2 + (h)) * HTB)
#define PG8_SB(b, h) ((4 + (b) * 2 + (h)) * HTB)
#define PG8_STAGE(bufoff, gbase, voff) do { _Pragma("unroll") for (int _i = 0; _i < 2; ++_i) \
        __builtin_amdgcn_global_load_lds((const unsigned*)((const char*)(gbase) + (voff)[_i]), (LAS unsigned*)(lds + (bufoff) + ldsw + _i * 8192), 16, 0, 0); } while (0)
#define PG8_LDA(dst, b, h) do { _Pragma("unroll") for (int m = 0; m < 4; ++m) _Pragma("unroll") for (int k = 0; k < 2; ++k) dst[m][k] = *(const LAS bf16x8*)(lds + PG8_SA(b, h) + aoff + m * 2048 + k * 1024); } while (0)
#define PG8_LDB(dst, b, h) do { _Pragma("unroll") for (int n = 0; n < 2; ++n) _Pragma("unroll") for (int k = 0; k < 2; ++k) dst[n][k] = *(const LAS bf16x8*)(lds + PG8_SB(b, h) + boff + n * 2048 + k * 1024); } while (0)
#define PG8_MMA(ai, bj, At, Bt) do { __builtin_amdgcn_s_setprio(1); _Pragma("unroll") for (int m = 0; m < 4; ++m) _Pragma("unroll") for (int n = 0; n < 2; ++n) _Pragma("unroll") for (int k = 0; k < 2; ++k) \
        acc[ai][bj][m][n] = __builtin_amdgcn_mfma_f32_16x16x32_bf16(Bt[n][k], At[m][k], acc[ai][bj][m][n], 0, 0, 0); __builtin_amdgcn_s_setprio(0); } while (0)
#define PG8_WAIT_V(n) asm volatile("s_waitcnt vmcnt(" #n ")" ::: "memory")
#define PG8_WAIT_L(n) asm volatile("s_waitcnt lgkmcnt(" #n ")" ::: "memory")
#define PG8_BAR __builtin_amdgcn_s_barrier()
#define PG8_SCHED __builtin_amdgcn_sched_barrier(0)
    if (c >= total) return;
    Unit cur = D.unit(xcd_remap(c, total)), nxt = cur; int ui = 0;
    f32x4 acc[2][2][4][2];
#pragma unroll
    for (int a = 0; a < 2; ++a)
#pragma unroll
        for (int b = 0; b < 2; ++b)
#pragma unroll
            for (int m = 0; m < 4; ++m)
#pragma unroll
                for (int n = 0; n < 2; ++n) acc[a][b][m][n] = (f32x4){0.f, 0.f, 0.f, 0.f};
    bf16x8 At[4][2], B0[2][2], B1[2][2];
    const char* cA = cur.a; const char* cB = cur.b;
    PG8_STAGE(PG8_SB(0, 0), cB, voffB); PG8_STAGE(PG8_SB(0, 1), cB + hstepB, voffB); PG8_STAGE(PG8_SA(0, 0), cA, voffA); PG8_STAGE(PG8_SA(0, 1), cA + hstepA, voffA);
    if (wr == 1) PG8_BAR;
    PG8_WAIT_V(2); PG8_BAR;
    PG8_STAGE(PG8_SB(1, 0), cB + kstep, voffB); PG8_STAGE(PG8_SA(1, 0), cA + kstep, voffA); PG8_STAGE(PG8_SB(1, 1), cB + hstepB + kstep, voffB);
    PG8_WAIT_V(6); PG8_BAR;
    for (;;) {
        const long Ln = (long)(ui + 1) * G + c;
        const bool has_next = Ln < total;
        if (has_next) nxt = D.unit(xcd_remap((int)Ln, total));
        const char* nA = has_next ? nxt.a : cA; const char* nB = has_next ? nxt.b : cB;
        for (int t = 0; t < nt; t += 2) {
            const bool last = (t == nt - 2);
            const char* a1 = cA + (size_t)(t + 1) * kstep;
            const char* a2 = last ? nA : cA + (size_t)(t + 2) * kstep; const char* b2 = last ? nB : cB + (size_t)(t + 2) * kstep;
            const char* a3 = a2 + kstep; const char* b3 = b2 + kstep;
            PG8_LDB(B0, 0, 0); PG8_LDB(B1, 0, 1); PG8_SCHED; PG8_LDA(At, 0, 0); PG8_STAGE(PG8_SA(1, 1), a1 + hstepA, voffA);
            PG8_WAIT_V(8); PG8_WAIT_L(0); PG8_BAR; PG8_MMA(0, 0, At, B0); PG8_MMA(0, 1, At, B1); PG8_BAR; PG8_SCHED;
            PG8_LDA(At, 0, 1); PG8_STAGE(PG8_SB(0, 0), b2, voffB); PG8_STAGE(PG8_SB(0, 1), b2 + hstepB, voffB); PG8_STAGE(PG8_SA(0, 0), a2, voffA);
            PG8_WAIT_V(8); PG8_WAIT_L(0); PG8_BAR; PG8_MMA(1, 0, At, B0); PG8_MMA(1, 1, At, B1); PG8_BAR; PG8_SCHED;
            PG8_LDB(B0, 1, 0); PG8_LDB(B1, 1, 1); PG8_SCHED; PG8_LDA(At, 1, 0); PG8_STAGE(PG8_SA(0, 1), a2 + hstepA, voffA);
            PG8_WAIT_V(8); PG8_WAIT_L(0); PG8_BAR; PG8_MMA(0, 0, At, B0); PG8_MMA(0, 1, At, B1); PG8_BAR; PG8_SCHED;
            PG8_LDA(At, 1, 1); PG8_STAGE(PG8_SB(1, 0), b3, voffB); PG8_STAGE(PG8_SB(1, 1), b3 + hstepB, voffB); PG8_STAGE(PG8_SA(1, 0), a3, voffA);
            PG8_WAIT_V(8); PG8_WAIT_L(0); PG8_BAR; PG8_MMA(1, 0, At, B0); PG8_MMA(1, 1, At, B1); PG8_BAR; PG8_SCHED;
        }
        if (wr == 0) PG8_BAR;
#pragma unroll
        for (int ai = 0; ai < 2; ++ai)
#pragma unroll
            for (int m = 0; m < 4; ++m)
#pragma unroll
                for (int bj = 0; bj < 2; ++bj)
                    E(cur, ai * HALF + wr * 64 + m * 16 + fr, bj * HALF + wc * 32 + 8 * fq, acc[ai][bj][m][0], acc[ai][bj][m][1]);
        if (!has_next) break;
#pragma unroll
        for (int a = 0; a < 2; ++a)
#pragma unroll
            for (int b = 0; b < 2; ++b)
#pragma unroll
                for (int m = 0; m < 4; ++m)
#pragma unroll
                    for (int n = 0; n < 2; ++n) acc[a][b][m][n] = (f32x4){0.f, 0.f, 0.f, 0.f};
        cur = nxt; cA = nA; cB = nB; ++ui;
        if (wr == 1) PG8_BAR;
    }
    PG8_WAIT_V(0);
    PG8_BAR;
#undef PG8_SA
#undef PG8_SB
#undef PG8_STAGE
#undef PG8_LDA
#undef PG8_LDB
#undef PG8_MMA
#undef PG8_WAIT_V
#undef PG8_WAIT_L
#undef PG8_BAR
#undef PG8_SCHED
}
}

DI void transpose_item(const float* W, int N, int kb, int nb, bf16_t* d0, bf16_t* d1, int K, LAS float* scr, int lane) {
    const int k0 = 64 * kb, n0 = 32 * nb;
#pragma unroll 8
    for (int i = 0; i < 32; ++i) { const int kk = 2 * i + (lane >> 5); scr[kk * 33 + (lane & 31)] = W[(size_t)(k0 + kk) * N + n0 + (lane & 31)]; }
    asm volatile("s_waitcnt lgkmcnt(0)" ::: "memory");
    const int c = lane & 7;
#pragma unroll
    for (int j = 0; j < 4; ++j) { const int n = (lane >> 3) + 8 * j; const LAS float* s = scr + (8 * c) * 33 + n;
        u32x4 o; o.x = pk2(s[0 * 33], s[1 * 33]); o.y = pk2(s[2 * 33], s[3 * 33]); o.z = pk2(s[4 * 33], s[5 * 33]); o.w = pk2(s[6 * 33], s[7 * 33]);
        *(u32x4*)(d0 + (size_t)n * K + k0 + 8 * c) = o;
        if (d1) *(u32x4*)(d1 + (size_t)n * K + k0 + 8 * c) = o; }
    asm volatile("s_waitcnt lgkmcnt(0)" ::: "memory");
}

DI void prep_phase(const Args& A, LAS unsigned char* lds, int wv) {
    const int tid = otid(wv), lane = tid & 63, wave = tid >> 6, G = gridDim.x;
    unsigned char* ws = A.ws;
    {
        LAS float* s_lds = (LAS float*)lds;
        const float* cc = A.in[1]; const float* cctx = A.in[3]; const float* aw = A.in[4]; const float* ab = A.in[5];
        float* mod = (float*)(ws + WS_MOD);
        for (int item = blockIdx.x; item < 768; item += G) {
            const int kc = item % 16, cb = (item / 16) % 12, l = item / 192;
            const int k0 = kc * 128, j = cb * 512 + tid;
            __syncthreads();
            for (int e = tid; e < 17 * 128; e += NTHREADS) { const int r = e / 128, k = e % 128; const float v = r < 16 ? cc[r * DM + k0 + k] : cctx[k0 + k]; s_lds[k * 20 + r] = siluf(v); }
            __syncthreads();
            float acc[17];
#pragma unroll
            for (int r = 0; r < 17; ++r) acc[r] = 0.f;
            const float* wp = aw + ((size_t)l * DM + k0) * MOD_LD + j;
#pragma unroll 4
            for (int k = 0; k < 128; ++k) {
                const float w = wp[(size_t)k * MOD_LD];
                const LAS f32x4* sp = (const LAS f32x4*)(s_lds + k * 20);
                const f32x4 s0 = sp[0], s1 = sp[1], s2 = sp[2], s3 = sp[3]; const float s4 = s_lds[k * 20 + 16];
#pragma unroll
                for (int q = 0; q < 4; ++q) { acc[q] += s0[q] * w; acc[4 + q] += s1[q] * w; acc[8 + q] += s2[q] * w; acc[12 + q] += s3[q] * w; }
                acc[16] += s4 * w;
            }
            const float bias = (kc == 0) ? ab[l * MOD_LD + j] : 0.f;
#pragma unroll
            for (int r = 0; r < 17; ++r) unsafeAtomicAdd(&mod[(size_t)(l * 17 + r) * MOD_LD + j], acc[r] + bias);
        }
        __syncthreads();
    }
    {
        LAS float* scr = (LAS float*)(lds + wave * 16384);
        const int gw = blockIdx.x * NWAVES + wave, NGW = G * NWAVES;
        constexpr int I_SQ = 32 * 64, I_AI = 32 * 160, I_MI = 32 * 257;
        constexpr int NIT = 6 * I_SQ + I_AI + I_MI;
        for (int it = gw; it < NIT; it += NGW) {
            int r = it;
            if (r < 6 * I_SQ) {
                const int w = r / I_SQ; r -= w * I_SQ;
                const float* src; bf16_t* dst;
                if (w < 2)      { src = A.in[7] + (size_t)w * DM * DM;       dst = (bf16_t*)(ws + WS_WFG) + (size_t)w * DM * DM; }
                else if (w < 4) { src = A.in[8] + (size_t)(w - 2) * DM * DM; dst = (bf16_t*)(ws + WS_WFO) + (size_t)(w - 2) * DM * DM; }
                else if (w == 4) { src = A.in[12]; dst = (bf16_t*)(ws + WS_WMO); }
                else             { src = A.in[16]; dst = (bf16_t*)(ws + WS_WAO); }
                const int kb = r / 64, nb = r % 64;
                transpose_item(src, DM, kb, nb, dst + (size_t)(32 * nb) * DM, nullptr, DM, scr, lane);
                continue;
            }
            r -= 6 * I_SQ;
            if (r < I_AI) { const int kb = r / 160, nb = r % 160; transpose_item(A.in[13], 5120, kb, nb, (bf16_t*)(ws + WS_WAI) + (size_t)(32 * nb) * DM, nullptr, DM, scr, lane); continue; }
            r -= I_AI;
            {
                const int kb = r / 257, nb = r % 257, n0 = 32 * nb;
                bf16_t* WA = (bf16_t*)(ws + WS_WMA); bf16_t* WB = (bf16_t*)(ws + WS_WMB);
                bf16_t* d0; bf16_t* d1 = nullptr;
                if (n0 < 1024) d0 = WA + (size_t)n0 * DM;
                else if (n0 < 2048) { d0 = WA + (size_t)n0 * DM; d1 = WB + (size_t)(n0 - 1024) * DM; }
                else if (n0 < 4096) d0 = WB + (size_t)(1024 + n0 - 2048) * DM;
                else if (n0 < 6144) d0 = WA + (size_t)(2304 + n0 - 4096) * DM;
                else if (n0 < 6176) d0 = WA + (size_t)(2048 + n0 - 6144) * DM;
                else d0 = WA + (size_t)(4352 + n0 - 6176) * DM;
                transpose_item(A.in[9], 8224, kb, nb, d0, d1, DM, scr, lane);
            }
        }
    }
    {
        const long gt = (long)blockIdx.x * NTHREADS + tid, NGT = (long)G * NTHREADS;
        constexpr long N_DC = 1024L * 512 / 8, N_DT = 2048L * 4096 / 8, N_DT2 = 256L * 512 / 8;
        for (long it = gt; it < N_DC + N_DT + N_DT2; it += NGT) {
            float v[8]; bf16_t* dst;
            if (it < N_DC) {
                const int m = (int)(it / 64), k0 = (int)(it % 64) * 8; const float sc = 0.044194173824159216f;
#pragma unroll
                for (int j = 0; j < 8; ++j) { const int rr = ((m & 511) * (k0 + j)) & 511; const float ang = (float)rr * (1.f / 256.f); v[j] = (m < 512 ? cospif(ang) : sinpif(ang)) * sc; }
                dst = (bf16_t*)(ws + WS_DC) + (size_t)m * 512 + k0;
            } else if (it < N_DC + N_DT) {
                const long i2 = it - N_DC; const int kk = (int)(i2 / 512), s0 = (int)(i2 % 512) * 8; const float sc = 0.022097086912079608f;
#pragma unroll
                for (int j = 0; j < 8; ++j) { const int s = s0 + j; const int rr = (kk * (s & 2047)) & 2047; const float ang = (float)rr * (1.f / 1024.f); v[j] = (s < 2048 ? cospif(ang) : -sinpif(ang)) * sc; }
                dst = (bf16_t*)(ws + WS_DT) + (size_t)kk * 4096 + s0;
            } else {
                const long i2 = it - N_DC - N_DT; const int kk = (int)(i2 / 64), s0 = (int)(i2 % 64) * 8; const float sc = 0.0625f;
#pragma unroll
                for (int j = 0; j < 8; ++j) { const int s = s0 + j; const int rr = (kk * (s & 255)) & 255; const float ang = (float)rr * (1.f / 128.f); v[j] = (s < 256 ? cospif(ang) : -sinpif(ang)) * sc; }
                dst = (bf16_t*)(ws + WS_DT2) + (size_t)kk * 512 + s0;
            }
            u32x4 o = {pk2(v[0], v[1]), pk2(v[2], v[3]), pk2(v[4], v[5]), pk2(v[6], v[7])};
            *(u32x4*)dst = o;
        }
    }
}

DI const float* xrow_ptr(const Args& A, int layer, int r) {
    const int b = r / TB, t = r % TB;
    if (t < TL) return (layer == 0 ? A.in[0] : (const float*)A.out) + ((size_t)b * TL + t) * DM;
    return (layer == 0 ? A.in[2] : (const float*)(A.ws + WS_CTXS)) + ((size_t)b * TC + (t - TL)) * DM;
}
DI void norm_phase(const Args& A, int layer, bool latonly, int wv) {
    const int tid = otid(wv), lane = tid & 63, wave = tid >> 6, G = gridDim.x;
    const float* ng = A.in[6] + (size_t)layer * DM;
    const float* mod = (const float*)(A.ws + WS_MOD) + (size_t)layer * 17 * MOD_LD;
    bf16_t* H = (bf16_t*)(A.ws + WS_H);
    for (int r = blockIdx.x * NWAVES + wave; r < NTOK; r += G * NWAVES) {
        const int b = r / TB, t = r % TB;
        if (latonly && t >= TL) continue;
        const float* xr = xrow_ptr(A, layer, r);
        const float* mr = mod + (size_t)(t < TL ? b : 16) * MOD_LD;
        f32x4 v[4][2]; float ss = 0.f;
#pragma unroll
        for (int j = 0; j < 4; ++j) { const f32x4* p = (const f32x4*)(xr + 512 * j + 8 * lane); v[j][0] = p[0]; v[j][1] = p[1];
#pragma unroll
            for (int q = 0; q < 4; ++q) ss += v[j][0][q] * v[j][0][q] + v[j][1][q] * v[j][1][q]; }
        const float rs = 1.0f / sqrtf(wave_sum(ss) * (1.f / DM) + EPS);
#pragma unroll
        for (int j = 0; j < 4; ++j) { const int c0 = 512 * j + 8 * lane; f32x4 o[2];
#pragma unroll
            for (int h = 0; h < 2; ++h) { const f32x4 g4 = *(const f32x4*)(ng + c0 + 4 * h), sh = *(const f32x4*)(mr + c0 + 4 * h), sc = *(const f32x4*)(mr + DM + c0 + 4 * h);
                o[h] = (v[j][h] * rs) * g4 * (sc + 1.0f) + sh; }
            st_bf16x8(H + (size_t)r * DM + c0, o[0], o[1]); }
    }
}
DI void final_norm_phase(const Args& A, const float* src_override, int wv) {
    const int tid = otid(wv), lane = tid & 63, wave = tid >> 6, G = gridDim.x;
    const float* fg = A.in[17];
    for (int r = blockIdx.x * NWAVES + wave; r < NB * TL; r += G * NWAVES) {
        const float* xr = (src_override ? src_override : (const float*)A.out) + (size_t)r * DM; float* orow = A.out + (size_t)r * DM;
        f32x4 v[4][2]; float ss = 0.f;
#pragma unroll
        for (int j = 0; j < 4; ++j) { const f32x4* p = (const f32x4*)(xr + 512 * j + 8 * lane); v[j][0] = p[0]; v[j][1] = p[1];
#pragma unroll
            for (int q = 0; q < 4; ++q) ss += v[j][0][q] * v[j][0][q] + v[j][1][q] * v[j][1][q]; }
        const float rs = 1.0f / sqrtf(wave_sum(ss) * (1.f / DM) + EPS);
#pragma unroll
        for (int j = 0; j < 4; ++j) { const int c0 = 512 * j + 8 * lane;
#pragma unroll
            for (int h = 0; h < 2; ++h) { const f32x4 g4 = *(const f32x4*)(fg + c0 + 4 * h); *(f32x4*)(orow + c0 + 4 * h) = (v[j][h] * rs) * g4; } }
    }
}


struct DescPlain {
    const bf16_t* A; const bf16_t* B; int nN; bool latonly; int lda, ldb, K, total;
    DI void init(const bf16_t* A_, const bf16_t* B_, int nN_, bool lat) { A = A_; B = B_; nN = nN_; latonly = lat; lda = DM; ldb = DM; K = DM; total = (lat ? 128 : 144) * nN_; }
    DI pg8::Unit unit(int idx) const {
        const int nMt = latonly ? 128 : 144, nig = 8 * nN, gid = idx / nig, fm = gid * 8, gsz = (nMt - fm) < 8 ? (nMt - fm) : 8;
        const int pmi = fm + (idx % nig) % gsz, pn = (idx % nig) / gsz, pm = latonly ? (pmi / 8) * 9 + (pmi % 8) : pmi;
        pg8::Unit u; u.a = (const char*)(A + (size_t)pm * 256 * DM); u.b = (const char*)(B + (size_t)pn * 256 * DM); u.i0 = pm; u.i1 = pn; u.i2 = 0; return u;
    }
};
struct DescChan {
    const bf16_t* DC; const bf16_t* H; int lda, ldb, K, total;
    DI void init(const bf16_t* DC_, const bf16_t* H_, bool lat) { DC = DC_; H = H_; lda = 512; ldb = DM; K = 512; total = lat ? 2048 : 2304; }
    DI pg8::Unit unit(int idx) const {
        pg8::Unit u; int b, g, mt, nt, toff;
        if (idx < 2048) { mt = idx % 4; nt = (idx / 4) % 8; g = (idx / 32) % 4; b = idx / 128; toff = nt * 256; u.i2 = nt; }
        else { const int j = idx - 2048; mt = j % 4; g = (j / 4) % 4; b = j / 16; toff = TL; u.i2 = 8; }
        u.a = (const char*)(DC + (size_t)mt * 256 * 512); u.b = (const char*)(H + ((size_t)b * TB + toff) * DM + g * 512); u.i0 = b * 4 + g; u.i1 = mt; return u;
    }
};
struct DescT {
    const bf16_t* DT; const bf16_t* PQ; int nMt; int lda, ldb, K, total;
    DI void init(const bf16_t* DT_, const bf16_t* PQ_, int T) { DT = DT_; PQ = PQ_; nMt = T / 256; lda = 2 * T; ldb = 2 * T; K = 2 * T; total = NB * nMt * 8; }
    DI pg8::Unit unit(int idx) const {
        const int mt = idx % nMt, nt = (idx / nMt) % 8, b = idx / (nMt * 8);
        pg8::Unit u; u.a = (const char*)(DT + (size_t)mt * 256 * K); u.b = (const char*)(PQ + ((size_t)b * DM + nt * 256) * K); u.i0 = b; u.i1 = mt; u.i2 = nt; return u;
    }
};

DI void resid_store(const Args& A, int layer, int pm, int row_l, int col, const float* modl, f32x4 v0, f32x4 v1) {
    const int b = pm / 9, tt = pm % 9;
    const float* gp = modl + (size_t)(tt < 8 ? b : 16) * MOD_LD + 2 * DM + col;
    const f32x4 g0 = *(const f32x4*)gp, g1 = *(const f32x4*)(gp + 4);
    const float* src; float* dst;
    if (tt < 8) { const size_t off = ((size_t)b * TL + tt * 256 + row_l) * DM + col; src = (layer == 0 ? A.in[0] : (const float*)A.out) + off; dst = A.out + off; }
    else { const size_t off = ((size_t)b * TC + row_l) * DM + col; src = (layer == 0 ? A.in[2] : (const float*)(A.ws + WS_CTXS)) + off; dst = (float*)(A.ws + WS_CTXS) + off; }
    const f32x4 x0 = *(const f32x4*)src, x1 = *(const f32x4*)(src + 4);
    *(f32x4*)dst = x0 + g0 * v0; *(f32x4*)(dst + 4) = x1 + g1 * v1;
}

DI void fnet_layer(const Args& A, LAS unsigned char* lds, cg::grid_group& grid, int layer, int j, bool latonly, int wv) {
    unsigned char* ws = A.ws;
    const bf16_t* H = (const bf16_t*)(ws + WS_H); bf16_t* U = (bf16_t*)(ws + WS_H);
    bf16_t* Gt = (bf16_t*)(ws + WS_SCR + F_G); bf16_t* PQX = (bf16_t*)(ws + WS_SCR + F_PQX); bf16_t* PQC = (bf16_t*)(ws + WS_SCR + F_PQC);
    norm_phase(A, layer, latonly, wv);
    grid.sync();
    {
        DescPlain D; D.init(H, (const bf16_t*)(ws + WS_WFG) + (size_t)j * DM * DM, 8, latonly);
        auto E = [=](const pg8::Unit& u, int row_l, int col_l, f32x4 v0, f32x4 v1) {
            f32x4 a, b;
#pragma unroll
            for (int q = 0; q < 4; ++q) { a[q] = siluf(v0[q]); b[q] = siluf(v1[q]); }
            st_bf16x8(Gt + ((size_t)u.i0 * 256 + row_l) * DM + u.i1 * 256 + col_l, a, b);
        };
        pg8::gemm_phase(lds, D, E, wv);
    }
    {
        DescChan D; D.init((const bf16_t*)(ws + WS_DC), H, latonly);
        auto E = [=](const pg8::Unit& u, int row_l, int col_l, f32x4 v0, f32x4 v1) {
            const int b = u.i0 >> 2, g = u.i0 & 3, mt = u.i1, half = mt >> 1, ch = g * 512 + (mt & 1) * 256 + row_l;
            bf16_t* dst = (u.i2 < 8) ? PQX + ((size_t)b * DM + ch) * 4096 + half * 2048 + u.i2 * 256 + col_l
                                     : PQC + ((size_t)b * DM + ch) * 512 + half * 256 + col_l;
            st_bf16x8(dst, v0, v1);
        };
        pg8::gemm_phase(lds, D, E, wv);
    }
    grid.sync();
    {
        DescT D; D.init((const bf16_t*)(ws + WS_DT), PQX, TL);
        auto E = [=](const pg8::Unit& u, int row_l, int col_l, f32x4 v0, f32x4 v1) {
            const size_t off = ((size_t)u.i0 * TB + u.i1 * 256 + row_l) * DM + u.i2 * 256 + col_l;
            f32x4 g0, g1; ld_bf16x8(Gt + off, g0, g1);
            st_bf16x8(U + off, v0 * g0, v1 * g1);
        };
        pg8::gemm_phase(lds, D, E, wv);
    }
    if (!latonly) {
        DescT D; D.init((const bf16_t*)(ws + WS_DT2), PQC, TC);
        auto E = [=](const pg8::Unit& u, int row_l, int col_l, f32x4 v0, f32x4 v1) {
            const size_t off = ((size_t)u.i0 * TB + TL + row_l) * DM + u.i2 * 256 + col_l;
            f32x4 g0, g1; ld_bf16x8(Gt + off, g0, g1);
            st_bf16x8(U + off, v0 * g0, v1 * g1);
        };
        pg8::gemm_phase(lds, D, E, wv);
    }
    grid.sync();
    {
        DescPlain D; D.init(U, (const bf16_t*)(ws + WS_WFO) + (size_t)j * DM * DM, 8, latonly);
        const float* modl = (const float*)(ws + WS_MOD) + (size_t)layer * 17 * MOD_LD;
        auto E = [=](const pg8::Unit& u, int row_l, int col_l, f32x4 v0, f32x4 v1) { resid_store(A, layer, u.i0, row_l, u.i1 * 256 + col_l, modl, v0, v1); };
        pg8::gemm_phase(lds, D, E, wv);
    }
    grid.sync();
}


namespace att {
constexpr int D = 128, NW = 8, QBLK = 32, KVBLK = 64;
constexpr float SCALE = 0.088388347648318440f;
constexpr float THR = 8.f;
constexpr int LDQ = 2048, LDK = 512;
constexpr size_t SHM_V = KVBLK * D * 2, SHM_K = KVBLK * D * 2;
typedef float f32x8 __attribute__((ext_vector_type(8)));
#define KSWZ(row, colB) ((row) * 256 + ((colB) ^ (((row) & 7) << 4)))
#define SBAR() __builtin_amdgcn_sched_barrier(0)
DI int crow(int r, int hi) { return (r & 3) + 8 * (r >> 2) + 4 * hi; }
DI unsigned cvtpk(float lo, float hi) { unsigned r; asm volatile("v_cvt_pk_bf16_f32 %0, %1, %2" : "=v"(r) : "v"(lo), "v"(hi)); return r; }
DI void partialSM(f32x16& p0, f32x16& p1, float& m_reg, float& mn, float& alpha) {
  constexpr float C = SCALE * 1.4426950408889634f;
  float pmax = p0[0];
#pragma unroll
  for (int r = 1; r < 16; ++r) pmax = fmaxf(pmax, p0[r]);
#pragma unroll
  for (int r = 0; r < 16; ++r) pmax = fmaxf(pmax, p1[r]);
  { auto rr = __builtin_amdgcn_permlane32_swap(__float_as_uint(pmax), __float_as_uint(pmax), false, false);
    pmax = fmaxf(__uint_as_float(rr[0]), __uint_as_float(rr[1])); }
  if (__builtin_expect(__all(pmax - m_reg <= THR / SCALE), 1)) { mn = m_reg; alpha = 1.f; }
  else { mn = fmaxf(m_reg, pmax); alpha = __builtin_amdgcn_exp2f((m_reg - mn) * C); m_reg = mn; }
  float mnC = -mn * C;
#pragma unroll
  for (int r = 0; r < 16; ++r) p0[r] = fmaf(p0[r], C, mnC);
#pragma unroll
  for (int r = 0; r < 16; ++r) p1[r] = fmaf(p1[r], C, mnC);
#pragma unroll
  for (int r = 0; r < 16; ++r) p0[r] = __builtin_amdgcn_exp2f(p0[r]);
}
DI void finishSM(f32x16& p0, f32x16& p1, float alpha, float& l_reg, bf16x8& pa0, bf16x8& pa1, bf16x8& pa2, bf16x8& pa3) {
#pragma unroll
  for (int r = 0; r < 16; ++r) p1[r] = __builtin_amdgcn_exp2f(p1[r]);
  float ps = 0;
#pragma unroll
  for (int r = 0; r < 16; ++r) ps += p0[r];
#pragma unroll
  for (int r = 0; r < 16; ++r) ps += p1[r];
  { auto rr = __builtin_amdgcn_permlane32_swap(__float_as_uint(ps), __float_as_uint(ps), false, false);
    ps = __uint_as_float(rr[0]) + __uint_as_float(rr[1]); }
  l_reg = l_reg * alpha + ps;
#define PK4(P, BASE, OUT) do { unsigned a0 = cvtpk(P[BASE + 0], P[BASE + 1]), a1 = cvtpk(P[BASE + 2], P[BASE + 3]);   \
    unsigned b0 = cvtpk(P[BASE + 4], P[BASE + 5]), b1 = cvtpk(P[BASE + 6], P[BASE + 7]);                              \
    auto r0 = __builtin_amdgcn_permlane32_swap(a0, b0, false, false); auto r1 = __builtin_amdgcn_permlane32_swap(a1, b1, false, false); \
    u32x4 w = {r0[0], r1[0], r0[1], r1[1]}; OUT = *reinterpret_cast<bf16x8*>(&w); } while (0)
  PK4(p0, 0, pa0); PK4(p0, 8, pa1); PK4(p1, 0, pa2); PK4(p1, 8, pa3);
#undef PK4
}
DI void qkt(f32x16& p0, f32x16& p1, const bf16_t* Ks, const bf16x8* qr, int r32, int hi) {
  p0 = f32x16{}; p1 = f32x16{};
#pragma unroll
  for (int d0 = 0; d0 < 8; ++d0) { int cb = (d0 * 16 + hi * 8) * 2;
    bf16x8 b0 = *reinterpret_cast<const bf16x8*>((const char*)Ks + KSWZ(r32, cb));
    bf16x8 b1 = *reinterpret_cast<const bf16x8*>((const char*)Ks + KSWZ(32 + r32, cb));
    p0 = __builtin_amdgcn_mfma_f32_32x32x16_bf16(b0, qr[d0], p0, 0, 0, 0);
    p1 = __builtin_amdgcn_mfma_f32_32x32x16_bf16(b1, qr[d0], p1, 0, 0, 0); }
}
DI int v_st(int k, int c) { const int kk = (k & ~0xC) | ((k & 4) << 1) | ((k & 8) >> 1); return ((kk >> 3) * 4 + (c >> 5)) * 512 + ((kk & 7) * 32 + (c & 31)) * 2; }
DI int v_rd_base(int lane) { return ((lane & 3) << 3) | (((lane >> 2) & 3) << 6) | (((lane >> 4) & 1) << 5) | (((lane >> 5) & 1) << 8); }
constexpr int v_rd_off(int d0, int ks, int half) { return d0 * 512 + ks * 4096 + half * 2048; }
template <int OFF> DI s16x4 tr_read(int vb) {
  s16x4 r; asm volatile("ds_read_b64_tr_b16 %0, %1 offset:%2" : "=&v"(r) : "v"(vb), "i"(OFF) : "memory"); return r;
}
template <int D0> DI void pv_one(f32x16& od, int vb, bf16x8 pa0, bf16x8 pa1, bf16x8 pa2, bf16x8 pa3) {
  const s16x4 l0 = tr_read<v_rd_off(D0, 0, 0)>(vb), h0 = tr_read<v_rd_off(D0, 0, 1)>(vb), l1 = tr_read<v_rd_off(D0, 1, 0)>(vb), h1 = tr_read<v_rd_off(D0, 1, 1)>(vb);
  const s16x4 l2 = tr_read<v_rd_off(D0, 2, 0)>(vb), h2 = tr_read<v_rd_off(D0, 2, 1)>(vb), l3 = tr_read<v_rd_off(D0, 3, 0)>(vb), h3 = tr_read<v_rd_off(D0, 3, 1)>(vb);
  asm volatile("s_waitcnt lgkmcnt(0)" ::: "memory"); SBAR();
#define PK(L, H) (bf16x8){L[0], L[1], L[2], L[3], H[0], H[1], H[2], H[3]}
  od = __builtin_amdgcn_mfma_f32_32x32x16_bf16(pa0, PK(l0, h0), od, 0, 0, 0);
  od = __builtin_amdgcn_mfma_f32_32x32x16_bf16(pa1, PK(l1, h1), od, 0, 0, 0);
  od = __builtin_amdgcn_mfma_f32_32x32x16_bf16(pa2, PK(l2, h2), od, 0, 0, 0);
  od = __builtin_amdgcn_mfma_f32_32x32x16_bf16(pa3, PK(l3, h3), od, 0, 0, 0);
#undef PK
}
DI void pv_d0(f32x16* o, int vb, bf16x8 pa0, bf16x8 pa1, bf16x8 pa2, bf16x8 pa3) {
  pv_one<0>(o[0], vb, pa0, pa1, pa2, pa3); pv_one<1>(o[1], vb, pa0, pa1, pa2, pa3); pv_one<2>(o[2], vb, pa0, pa1, pa2, pa3); pv_one<3>(o[3], vb, pa0, pa1, pa2, pa3);
}
DI void attn_dense_body(const bf16_t* __restrict__ Qb, const bf16_t* __restrict__ Kh, const bf16_t* __restrict__ Vh, const bf16_t* SZb, bf16_t* Ub, int seq, char* lds, int wv) {
  const int tid = otid(wv), wid = tid >> 6, lane = tid & 63, r32 = lane & 31, hi = lane >> 5;
  bf16_t* V_lds = (bf16_t*)lds; bf16_t* K_lds = (bf16_t*)(lds + 2 * SHM_V);
  float* wsf = (float*)(lds + 2 * SHM_V + 2 * SHM_K) + wid * 64; float* li_l = wsf; float* al_l = wsf + 32;
  float m_reg = -1e30f, l_reg = 0; f32x16 o[4] = {}; bf16x8 qr[8];
  const bf16_t* Qw = Qb + (long)(wid * QBLK + r32) * LDQ + hi * 8;
#pragma unroll
  for (int d0 = 0; d0 < 8; ++d0) qr[d0] = *reinterpret_cast<const bf16x8*>(Qw + d0 * 16);
  const int sr = tid >> 4, sc = (tid & 15) * 8, vst0 = v_st(sr, sc), vst1 = v_st(32 + sr, sc);
  const int vb0 = (int)(uintptr_t)V_lds + v_rd_base(lane);
  struct { bf16x8 vs0, vs1, ks0, ks1; } sr_[2];
#define SLOAD(i, k0) do { sr_[i].vs0 = *reinterpret_cast<const bf16x8*>(&Vh[(long)((k0) + sr) * LDK + sc]); sr_[i].vs1 = *reinterpret_cast<const bf16x8*>(&Vh[(long)((k0) + 32 + sr) * LDK + sc]); \
    sr_[i].ks0 = *reinterpret_cast<const bf16x8*>(&Kh[(long)((k0) + sr) * LDK + sc]); sr_[i].ks1 = *reinterpret_cast<const bf16x8*>(&Kh[(long)((k0) + 32 + sr) * LDK + sc]); } while (0)
#define SWRITE(b, i) do { *(bf16x8*)((char*)V_lds + (b) * SHM_V + vst0) = sr_[i].vs0;          \
    *(bf16x8*)((char*)V_lds + (b) * SHM_V + vst1) = sr_[i].vs1; int kc = sc * 2;               \
    *(bf16x8*)((char*)K_lds + (b) * SHM_K + KSWZ(sr, kc)) = sr_[i].ks0;                       \
    *(bf16x8*)((char*)K_lds + (b) * SHM_K + KSWZ(32 + sr, kc)) = sr_[i].ks1; } while (0)
#define SWAIT() asm volatile("s_waitcnt vmcnt(4)" ::: "memory")
#define RESC(a) do { if (__any((a) < 1.f)) { if (hi == 0) al_l[r32] = (a); asm volatile("s_waitcnt lgkmcnt(0)" ::: "memory"); \
    _Pragma("unroll") for (int d = 0; d < 4; ++d) _Pragma("unroll") for (int r = 0; r < 16; ++r) o[d][r] *= al_l[crow(r, hi)]; } } while (0)
  f32x16 pA0, pA1, pB0, pB1; float mnA, mnB, alA, alB; bf16x8 pa0, pa1, pa2, pa3; const int NT = seq / KVBLK;
  constexpr int SE = 0, SO = 1;
  SLOAD(SE, 0); asm volatile("s_waitcnt vmcnt(0)" ::: "memory"); SWRITE(0, SE); __syncthreads();
  qkt(pA0, pA1, K_lds, qr, r32, hi); partialSM(pA0, pA1, m_reg, mnA, alA);
  SLOAD(SO, KVBLK); if (2 < NT) SLOAD(SE, 2 * KVBLK);
  SWAIT(); SWRITE(1, SO); __syncthreads();
  for (int j = 1; j + 1 < NT; j += 2) {
    SBAR(); qkt(pB0, pB1, (bf16_t*)((char*)K_lds + SHM_K), qr, r32, hi);
    finishSM(pA0, pA1, alA, l_reg, pa0, pa1, pa2, pa3); SBAR();
    SLOAD(SO, (j + 2) * KVBLK); SBAR();
    pv_d0(o, vb0, pa0, pa1, pa2, pa3); partialSM(pB0, pB1, m_reg, mnB, alB);
    __syncthreads(); SWAIT(); SWRITE(0, SE);
    RESC(alB); __syncthreads();
    SBAR(); qkt(pA0, pA1, K_lds, qr, r32, hi);
    finishSM(pB0, pB1, alB, l_reg, pa0, pa1, pa2, pa3); SBAR();
    if (j + 3 < NT) SLOAD(SE, (j + 3) * KVBLK); SBAR();
    pv_d0(o, vb0 + (int)SHM_V, pa0, pa1, pa2, pa3); partialSM(pA0, pA1, m_reg, mnA, alA);
    __syncthreads(); SWAIT(); SWRITE(1, SO);
    RESC(alA); __syncthreads();
  }
  SBAR(); qkt(pB0, pB1, (bf16_t*)((char*)K_lds + SHM_K), qr, r32, hi);
  finishSM(pA0, pA1, alA, l_reg, pa0, pa1, pa2, pa3); SBAR();
  pv_d0(o, vb0, pa0, pa1, pa2, pa3); partialSM(pB0, pB1, m_reg, mnB, alB);
  __syncthreads(); RESC(alB);
  finishSM(pB0, pB1, alB, l_reg, pa0, pa1, pa2, pa3); SBAR();
  pv_d0(o, vb0 + (int)SHM_V, pa0, pa1, pa2, pa3);
  if (hi == 0) li_l[r32] = l_reg; asm volatile("s_waitcnt lgkmcnt(0)" ::: "memory");
  float rli[16];
#pragma unroll
  for (int r = 0; r < 16; ++r) rli[r] = __builtin_amdgcn_rcpf(li_l[crow(r, hi)]);
#pragma unroll
  for (int r = 0; r < 16; ++r) { const long ro = (long)(wid * QBLK + crow(r, hi)) * LDQ + r32;
#pragma unroll
    for (int d0 = 0; d0 < 4; ++d0) Ub[ro + d0 * 32] = (bf16_t)(pk2(o[d0][r] * rli[r], 0.f) & 0xffffu); }
  __syncthreads();
#pragma unroll 2
  for (int i = 0; i < 8; ++i) { const int id = tid + 512 * i; const long off = (long)(id >> 4) * LDQ + (id & 15) * 8;
    f32x4 a0, a1, z0, z1; ld_bf16x8(Ub + off, a0, a1); ld_bf16x8(SZb + off, z0, z1); st_bf16x8(Ub + off, a0 * z0, a1 * z1); }
  __syncthreads();
#undef SLOAD
#undef SWRITE
#undef SWAIT
#undef RESC
}
#undef KSWZ
#undef SBAR
}

DI void qknorm_phase(const Args& A, int wv) {
    const int tid = otid(wv), lane = tid & 63, wave = tid >> 6, G = gridDim.x;
    bf16_t* Q = (bf16_t*)(A.ws + WS_SCR + A_Q); bf16_t* Kb = (bf16_t*)(A.ws + WS_SCR + A_K);
    const float* qn = A.in[14]; const float* kn = A.in[15];
    const int sub = lane >> 4, l16 = lane & 15, e0 = l16 * 8;
    const long NIT = (long)NTOK * 20;
    for (long it = ((long)blockIdx.x * NWAVES + wave) * 4 + sub; it < NIT; it += (long)G * NWAVES * 4) {
        const int row = (int)(it / 20), hj = (int)(it % 20);
        bf16_t* p = (hj < 16) ? Q + (size_t)row * 2048 + hj * 128 + e0 : Kb + (size_t)row * 512 + (hj - 16) * 128 + e0;
        const float* wn = (hj < 16 ? qn : kn) + e0;
        f32x4 a, b; ld_bf16x8(p, a, b);
        float ss = 0.f;
#pragma unroll
        for (int q = 0; q < 4; ++q) ss += a[q] * a[q] + b[q] * b[q];
        ss += __shfl_xor(ss, 1); ss += __shfl_xor(ss, 2); ss += __shfl_xor(ss, 4); ss += __shfl_xor(ss, 8);
        const float rs = 1.0f / sqrtf(ss * (1.f / 128.f) + EPS);
        const f32x4 w0 = *(const f32x4*)wn, w1 = *(const f32x4*)(wn + 4);
        a = a * rs * w0; b = b * rs * w1;
        const int t = row % TB;
        if (t < TL) {
            const float pos = (l16 < 8) ? (float)(t >> 6) : (float)(t & 63);
            float y[8] = {a[0], a[1], a[2], a[3], b[0], b[1], b[2], b[3]};
#pragma unroll
            for (int pp = 0; pp < 4; ++pp) {
                const int fi = (4 * l16 + pp) & 31;
                const float ang = pos * exp2f(-(float)fi * 0.41524101186092029f);
                const float cs = cosf(ang), sn = sinf(ang);
                const float x0 = y[2 * pp], x1 = y[2 * pp + 1];
                y[2 * pp] = x0 * cs - x1 * sn; y[2 * pp + 1] = x0 * sn + x1 * cs;
            }
            a = (f32x4){y[0], y[1], y[2], y[3]}; b = (f32x4){y[4], y[5], y[6], y[7]};
        }
        st_bf16x8(p, a, b);
    }
}

DI void attn_layer(const Args& A, LAS unsigned char* lds, char* lds_gen, cg::grid_group& grid, int layer, int wv) {
    unsigned char* ws = A.ws;
    const bf16_t* H = (const bf16_t*)(ws + WS_H); bf16_t* U = (bf16_t*)(ws + WS_H);
    bf16_t* Q = (bf16_t*)(ws + WS_SCR + A_Q); bf16_t* Kb = (bf16_t*)(ws + WS_SCR + A_K); bf16_t* Vb = (bf16_t*)(ws + WS_SCR + A_V); bf16_t* SZ = (bf16_t*)(ws + WS_SCR + A_SZ);
    norm_phase(A, layer, false, wv);
    grid.sync();
    {
        DescPlain D; D.init(H, (const bf16_t*)(ws + WS_WAI), 20, false);
        auto E = [=](const pg8::Unit& u, int row_l, int col_l, f32x4 v0, f32x4 v1) {
            const size_t row = (size_t)u.i0 * 256 + row_l; const int pn = u.i1;
            if (pn < 8) st_bf16x8(Q + row * 2048 + pn * 256 + col_l, v0, v1);
            else if (pn < 10) st_bf16x8(Kb + row * 512 + (pn - 8) * 256 + col_l, v0, v1);
            else if (pn < 12) st_bf16x8(Vb + row * 512 + (pn - 10) * 256 + col_l, v0, v1);
            else { f32x4 a, b;
#pragma unroll
                for (int q = 0; q < 4; ++q) { a[q] = siluf(v0[q]); b[q] = siluf(v1[q]); }
                st_bf16x8(SZ + row * 2048 + (pn - 12) * 256 + col_l, a, b); }
        };
        pg8::gemm_phase(lds, D, E, wv);
    }
    grid.sync();
    qknorm_phase(A, wv);
    grid.sync();
    {
        const int G = gridDim.x, c = blockIdx.x;
        for (long L = c; L < 2048; L += G) {
            const int u = pg8::xcd_remap((int)L, 2048);
            const int b = u / 128, rem = u % 128, kvh = rem / 32, g = (rem / 8) % 4, qb = rem % 8, h = kvh * 4 + g;
            const size_t qoff = ((size_t)b * TB + qb * 256) * 2048 + h * 128, koff = ((size_t)b * TB) * 512 + kvh * 128;
            att::attn_dense_body(Q + qoff, Kb + koff, Vb + koff, SZ + qoff, U + qoff, TB, lds_gen, wv);
        }
        for (int u = c; u < 256; u += G) {
            const int b = u / 16, h = u % 16, kvh = h / 4;
            const size_t qoff = ((size_t)b * TB + TL) * 2048 + h * 128, koff = ((size_t)b * TB + TL) * 512 + kvh * 128;
            att::attn_dense_body(Q + qoff, Kb + koff, Vb + koff, SZ + qoff, U + qoff, TC, lds_gen, wv);
        }
    }
    grid.sync();
    {
        DescPlain D; D.init(U, (const bf16_t*)(ws + WS_WAO), 8, false);
        const float* modl = (const float*)(ws + WS_MOD) + (size_t)layer * 17 * MOD_LD;
        auto E = [=](const pg8::Unit& u, int row_l, int col_l, f32x4 v0, f32x4 v1) { resid_store(A, layer, u.i0, row_l, u.i1 * 256 + col_l, modl, v0, v1); };
        pg8::gemm_phase(lds, D, E, wv);
    }
    grid.sync();
}


struct DescKVT {
    const bf16_t* WB; const bf16_t* H; int lda, ldb, K, total;
    DI void init(const bf16_t* WB_, const bf16_t* H_) { WB = WB_; H = H_; lda = DM; ldb = DM; K = DM; total = 12 * 144; }
    DI pg8::Unit unit(int idx) const { const int mt = idx % 12, nt = idx / 12; pg8::Unit u; u.a = (const char*)(WB + (size_t)mt * 256 * DM); u.b = (const char*)(H + (size_t)nt * 256 * DM); u.i0 = mt; u.i1 = nt; u.i2 = 0; return u; }
};
namespace ml {
#define MFMA32(a, b, c) __builtin_amdgcn_mfma_f32_32x32x16_bf16((a), (b), (c), 0, 0, 0)
#define LFENCE() asm volatile("s_waitcnt lgkmcnt(0)" ::: "memory")
DI int crow(int reg, int h) { return (reg & 3) + 8 * (reg >> 2) + 4 * h; }
DI bf16x8 ldperm(const bf16_t* p) { const s16x4 lo = *(const s16x4*)p, hi = *(const s16x4*)(p + 8); return __builtin_shufflevector(lo, hi, 0, 1, 2, 3, 4, 5, 6, 7); }
DI bf16x8 pack_step(const f32x16& x, int s) { u32x4 p = {pk2(x[8 * s], x[8 * s + 1]), pk2(x[8 * s + 2], x[8 * s + 3]), pk2(x[8 * s + 4], x[8 * s + 5]), pk2(x[8 * s + 6], x[8 * s + 7])}; return __builtin_bit_cast(bf16x8, p); }
DI float bfs(short h) { return __uint_as_float(((unsigned)(unsigned short)h) << 16); }

DI void scan_phase(const Args& A, LAS unsigned char* lds, int wv) {
    const int tid = otid(wv), lane = tid & 63, wave = tid >> 6, r = lane & 31, hl = lane >> 5;
    LAS float* wl = (LAS float*)(lds + wave * 8192);
    LAS unsigned char* hst = lds + wave * 8192 + 2048;
    LAS float* u_l = wl; LAS float* pm_l = wl + 64; LAS float* a_l = wl + 128; LAS float* fl_l = wl + 192; LAS float* w_l = wl + 256; LAS float* rd_l = wl + 320; LAS float* n_l = wl + 384;
    unsigned char* ws = A.ws;
    const bf16_t* Qg = (const bf16_t*)(ws + WS_SCR + M_Q); const bf16_t* Kg = (const bf16_t*)(ws + WS_SCR + M_K); const bf16_t* KVT = (const bf16_t*)(ws + WS_SCR + M_KVT);
    const float* G32 = (const float*)(ws + WS_SCR + M_G32); const float* bg = A.in[10];
    for (int item = blockIdx.x; item < 256; item += gridDim.x) {
        const int dir = item & 1, h = (item >> 1) & 7, b = item >> 4, e0 = wave * 32;
        const bf16_t* Qu = Qg + (size_t)b * TB * 1024 + h * 128;
        const bf16_t* Ku = Kg + (size_t)b * TB * 1024 + h * 128;
        const bf16_t* KTu = KVT + ((size_t)b * 3072 + h * 128) * TB;
        const bf16_t* VTu = KVT + ((size_t)b * 3072 + 1024 + h * 256 + e0) * TB;
        bf16_t* Hout = (bf16_t*)(ws + WS_SCR + (dir ? M_HB : M_HF)) + (size_t)b * TB * DM + h * 256 + e0;
        const float big = bg[(dir * 2) * 8 + h], bfg = bg[(dir * 2 + 1) * 8 + h];
        f32x16 cacc[4];
#pragma unroll
        for (int d = 0; d < 4; ++d)
#pragma unroll
            for (int i = 0; i < 16; ++i) cacc[d][i] = 0.f;
        float m = 0.f;
        n_l[lane] = 0.f; n_l[64 + lane] = 0.f;
        LFENCE();
        for (int j = 0; j < 36; ++j) {
            const int pos0 = dir == 0 ? (j < 4 ? TL + 64 * j : 64 * (j - 4)) : (j < 4 ? TL + 64 * (3 - j) : 64 * (35 - j));
            int rj = r, h4 = 4 * hl, lj = lane; asm volatile("" : "+v"(rj), "+v"(h4), "+v"(lj));
            LAS float* wh = wl + h4; LAS float* wr = wl + rj; LAS unsigned char* hb = hst + h4 * 64 + rj * 2;
            const bf16_t* q0 = Qu + (size_t)(pos0 + rj) * 1024 + h4; const bf16_t* q1 = q0 + 32 * 1024;
            const bf16_t* k0 = Ku + (size_t)(pos0 + rj) * 1024 + h4; const bf16_t* k1 = k0 + 32 * 1024;
            const bf16_t* KTp = KTu + (size_t)rj * TB + pos0 + h4;
            const bf16_t* VTp = VTu + (size_t)rj * TB + pos0 + h4;
            float decay, m_new;
            {
                const int s = dir ? 63 - lj : lj;
                const float* gp = G32 + (size_t)(b * TB + pos0 + s) * 32;
                const float ig = gp[(dir * 2) * 8 + h] + big, fg = gp[(dir * 2 + 1) * 8 + h] + bfg;
                const float lf = fminf(fg, 0.f) - log1pf(__expf(-fabsf(fg)));
                float bs = lf;
#pragma unroll
                for (int o = 1; o < 64; o <<= 1) { const float t = __shfl_up(bs, o); if (lj >= o) bs += t; }
                const float uu = ig - bs;
                float pmx = uu;
#pragma unroll
                for (int o = 1; o < 64; o <<= 1) { const float t = __shfl_up(pmx, o); if (lj >= o) pmx = fmaxf(pmx, t); }
                pmx = fmaxf(pmx, m);
                const float b_end = __shfl(bs, 63), pm_last = __shfl(pmx, 63);
                LAS float* ws_ = wl + s;
                ws_[0] = uu; ws_[64] = pmx; ws_[128] = __expf(m - pmx); ws_[192] = __expf(-(bs + pmx)); ws_[256] = __expf(uu - pm_last);
                decay = __expf(m - pm_last); m_new = b_end + pm_last;
            }
            LFENCE();
            const int sbase = dir ? 63 - h4 : h4, sgn = dir ? -1 : 1;
#pragma unroll
            for (int tb = 0; tb < 2; ++tb) {
                __builtin_amdgcn_sched_barrier(0);
                const bf16_t* qt = tb ? q1 : q0;
                f32x16 ha;
#pragma unroll
                for (int i = 0; i < 16; ++i) ha[i] = 0.f;
                float qnv = 0.f;
#pragma unroll
                for (int kk = 0; kk < 8; ++kk) {
                    const bf16x8 qa = ldperm(qt + 16 * kk);
                    ha = MFMA32(qa, pack_step(cacc[kk >> 1], kk & 1), ha);
                    const f32x4 n0 = *(const LAS f32x4*)(wh + 384 + 16 * kk), n1 = *(const LAS f32x4*)(wh + 384 + 16 * kk + 8);
#pragma unroll
                    for (int jj = 0; jj < 4; ++jj) qnv += bfs(qa[jj]) * n0[jj] + bfs(qa[4 + jj]) * n1[jj];
                }
                qnv += __shfl_xor(qnv, 32);
#pragma unroll
                for (int i = 0; i < 16; ++i) ha[i] *= wh[128 + 32 * tb + (i & 3) + 8 * (i >> 2)];
                const float pmt = wr[64 + 32 * tb];
                const int tp = dir ? (63 - 32 * tb) - rj : 32 * tb + rj;
                float ds = 0.f;
#pragma unroll
                for (int sb = 0; sb < 2; ++sb) {
                    __builtin_amdgcn_sched_barrier(0);
                    const bf16_t* ks = sb ? k1 : k0;
                    f32x16 st;
#pragma unroll
                    for (int i = 0; i < 16; ++i) st[i] = 0.f;
#pragma unroll
                    for (int kk = 0; kk < 8; ++kk) st = MFMA32(ldperm(ks + 16 * kk), ldperm(qt + 16 * kk), st);
#pragma unroll
                    for (int i = 0; i < 16; ++i) {
                        const int sc = 32 * sb + (i & 3) + 8 * (i >> 2);
                        const int sp = sbase + sgn * sc;
                        st[i] *= __expf((sp <= tp) ? wh[sc] - pmt : -1e30f);
                        ds += st[i];
                    }
                    ha = MFMA32(pack_step(st, 0), ldperm(VTp + 16 * (2 * sb)), ha);
                    ha = MFMA32(pack_step(st, 1), ldperm(VTp + 16 * (2 * sb + 1)), ha);
                }
                ds += __shfl_xor(ds, 32);
                {
                    const float den = wr[128 + 32 * tb] * qnv + ds;
                    const float rd = 1.0f / fmaxf(fabsf(den), wr[192 + 32 * tb]);
                    if (h4 == 0) wr[320 + 32 * tb] = rd;
                }
                LFENCE();
#pragma unroll
                for (int i = 0; i < 16; ++i) { const int tc = 32 * tb + (i & 3) + 8 * (i >> 2);
                    *(LAS unsigned short*)(hb + tc * 64) = (unsigned short)(pk2(ha[i] * wh[320 + tc], 0.f) & 0xffffu); }
            }
            LFENCE();
            {
                bf16_t* hp = Hout + (size_t)(pos0 + lj) * DM;
                const LAS unsigned char* hrow = hst + lj * 64;
#pragma unroll
                for (int q = 0; q < 4; ++q) *(u32x4*)(hp + 8 * q) = *(const LAS u32x4*)(hrow + 16 * q);
            }
            __builtin_amdgcn_sched_barrier(0);
            bf16x8 vf[4];
#pragma unroll
            for (int kk = 0; kk < 4; ++kk) vf[kk] = ldperm(VTp + 16 * kk);
            __builtin_amdgcn_sched_barrier(0);
#pragma unroll
            for (int db = 0; db < 4; ++db) {
                if (db == 2) __builtin_amdgcn_sched_barrier(0);
#pragma unroll
                for (int i = 0; i < 16; ++i) cacc[db][i] *= decay;
                const bf16_t* kt = KTp + (size_t)(32 * db) * TB;
                float nadd = 0.f;
#pragma unroll
                for (int kk = 0; kk < 4; ++kk) {
                    const bf16x8 kv = ldperm(kt + 16 * kk);
                    const f32x4 w0 = *(const LAS f32x4*)(wh + 256 + 16 * kk), w1 = *(const LAS f32x4*)(wh + 256 + 16 * kk + 8);
                    float f[8];
#pragma unroll
                    for (int jj = 0; jj < 4; ++jj) { f[jj] = bfs(kv[jj]) * w0[jj]; f[4 + jj] = bfs(kv[4 + jj]) * w1[jj]; }
#pragma unroll
                    for (int jj = 0; jj < 8; ++jj) nadd += f[jj];
                    u32x4 p = {pk2(f[0], f[1]), pk2(f[2], f[3]), pk2(f[4], f[5]), pk2(f[6], f[7])};
                    cacc[db] = MFMA32(__builtin_bit_cast(bf16x8, p), vf[kk], cacc[db]);
                }
                nadd += __shfl_xor(nadd, 32);
                if (h4 == 0) wr[384 + 32 * db] = decay * wr[384 + 32 * db] + nadd;
            }
            LFENCE();
            m = m_new;
        }
    }
}
#undef MFMA32
#undef LFENCE
}

DI void mlstm_finish_phase(const Args& A, int wv) {
    const int tid = otid(wv), lane = tid & 63, wave = tid >> 6, G = gridDim.x;
    unsigned char* ws = A.ws;
    const bf16_t* HF = (const bf16_t*)(ws + WS_SCR + M_HF); const bf16_t* HB = (const bf16_t*)(ws + WS_SCR + M_HB);
    const bf16_t* SO = (const bf16_t*)(ws + WS_SCR + M_SO); const bf16_t* SZ = (const bf16_t*)(ws + WS_SCR + M_SZ);
    bf16_t* U = (bf16_t*)(ws + WS_H); const float* hn = A.in[11];
    const int sub = lane >> 5, e0 = (lane & 31) * 8;
    const long NIT = (long)NTOK * 8;
    for (long it = ((long)blockIdx.x * NWAVES + wave) * 2 + sub; it < NIT; it += (long)G * NWAVES * 2) {
        const size_t off = (size_t)(it >> 3) * DM + (int)(it & 7) * 256 + e0;
        f32x4 f0, f1, b0, b1, o0, o1, z0, z1;
        ld_bf16x8(HF + off, f0, f1); ld_bf16x8(HB + off, b0, b1); ld_bf16x8(SO + off, o0, o1); ld_bf16x8(SZ + off, z0, z1);
        f32x4 y0 = o0 * (f0 + b0), y1 = o1 * (f1 + b1);
        float ss = 0.f;
#pragma unroll
        for (int q = 0; q < 4; ++q) ss += y0[q] * y0[q] + y1[q] * y1[q];
        ss += __shfl_xor(ss, 1); ss += __shfl_xor(ss, 2); ss += __shfl_xor(ss, 4); ss += __shfl_xor(ss, 8); ss += __shfl_xor(ss, 16);
        const float rs = 1.0f / sqrtf(ss * (1.f / 256.f) + EPS);
        const float* hp = hn + (int)(it & 7) * 256 + e0;
        const f32x4 h0 = *(const f32x4*)hp, h1 = *(const f32x4*)(hp + 4);
        st_bf16x8(U + off, y0 * rs * h0 * z0, y1 * rs * h1 * z1);
    }
}

DI void mlstm_layer(const Args& A, LAS unsigned char* lds, cg::grid_group& grid, int layer, int wv) {
    unsigned char* ws = A.ws;
    const bf16_t* H = (const bf16_t*)(ws + WS_H); bf16_t* U = (bf16_t*)(ws + WS_H);
    bf16_t* Q = (bf16_t*)(ws + WS_SCR + M_Q); bf16_t* Kb = (bf16_t*)(ws + WS_SCR + M_K); bf16_t* KVT = (bf16_t*)(ws + WS_SCR + M_KVT);
    float* G32 = (float*)(ws + WS_SCR + M_G32); bf16_t* SO = (bf16_t*)(ws + WS_SCR + M_SO); bf16_t* SZ = (bf16_t*)(ws + WS_SCR + M_SZ);
    norm_phase(A, layer, false, wv);
    grid.sync();
    {
        DescPlain D; D.init(H, (const bf16_t*)(ws + WS_WMA), 9, false);
        auto E = [=](const pg8::Unit& u, int row_l, int col_l, f32x4 v0, f32x4 v1) {
            const size_t row = (size_t)u.i0 * 256 + row_l; const int pn = u.i1;
            if (pn < 4) st_bf16x8(Q + row * 1024 + pn * 256 + col_l, v0 * 0.088388347648318440f, v1 * 0.088388347648318440f);
            else if (pn < 8) st_bf16x8(Kb + row * 1024 + (pn - 4) * 256 + col_l, v0, v1);
            else if (col_l < 32) { *(f32x4*)(G32 + row * 32 + col_l) = v0; *(f32x4*)(G32 + row * 32 + col_l + 4) = v1; }
        };
        pg8::gemm_phase(lds, D, E, wv);
    }
    {
        DescKVT D; D.init((const bf16_t*)(ws + WS_WMB), H);
        auto E = [=](const pg8::Unit& u, int row_l, int col_l, f32x4 v0, f32x4 v1) {
            const int bb = u.i1 / 9, s0 = (u.i1 % 9) * 256;
            st_bf16x8(KVT + ((size_t)bb * 3072 + u.i0 * 256 + row_l) * TB + s0 + col_l, v0, v1);
        };
        pg8::gemm_phase(lds, D, E, wv);
    }
    grid.sync();
    ml::scan_phase(A, lds, wv);
    grid.sync();
    {
        DescPlain D; D.init(H, (const bf16_t*)(ws + WS_WMA) + (size_t)2304 * DM, 16, false);
        auto E = [=](const pg8::Unit& u, int row_l, int col_l, f32x4 v0, f32x4 v1) {
            const size_t row = (size_t)u.i0 * 256 + row_l; const int pn = u.i1; f32x4 a, b;
            if (pn < 8) {
#pragma unroll
                for (int q = 0; q < 4; ++q) { a[q] = sigmf(v0[q]); b[q] = sigmf(v1[q]); }
                st_bf16x8(SO + row * DM + pn * 256 + col_l, a, b);
            } else {
#pragma unroll
                for (int q = 0; q < 4; ++q) { a[q] = siluf(v0[q]); b[q] = siluf(v1[q]); }
                st_bf16x8(SZ + row * DM + (pn - 8) * 256 + col_l, a, b);
            }
        };
        pg8::gemm_phase(lds, D, E, wv);
    }
    grid.sync();
    mlstm_finish_phase(A, wv);
    grid.sync();
    {
        DescPlain D; D.init(U, (const bf16_t*)(ws + WS_WMO), 8, false);
        const float* modl = (const float*)(ws + WS_MOD) + (size_t)layer * 17 * MOD_LD;
        auto E = [=](const pg8::Unit& u, int row_l, int col_l, f32x4 v0, f32x4 v1) { resid_store(A, layer, u.i0, row_l, u.i1 * 256 + col_l, modl, v0, v1); };
        pg8::gemm_phase(lds, D, E, wv);
    }
    grid.sync();
}

__global__ void __launch_bounds__(NTHREADS, 2) fwd_megakernel(Args A) {
    extern __shared__ __attribute__((aligned(16))) unsigned char lds_raw[];
    LAS unsigned char* lds = (LAS unsigned char*)lds_raw;
    cg::grid_group grid = cg::this_grid();
    const int wv = __builtin_amdgcn_readfirstlane(threadIdx.x >> 6);
    prep_phase(A, lds, wv);
    grid.sync();
    fnet_layer(A, lds, grid, 0, 0, false, wv);
    mlstm_layer(A, lds, grid, 1, wv);
    attn_layer(A, lds, (char*)lds_raw, grid, 2, wv);
    fnet_layer(A, lds, grid, 3, 1, true, wv);
    final_norm_phase(A, nullptr, wv);
}

extern "C" void kernel_launch(void* const* d_in, const int* in_sizes, int n_in, void* d_out, int out_size, void* d_ws, size_t ws_size, hipStream_t stream) {
    static int grid = 0;
    if (grid == 0) {
        if (n_in != 18 || ws_size < WS_END) { fprintf(stderr, "kernel_launch: unexpected n_in %d / ws_size %zu (need %zu)\n", n_in, ws_size, (size_t)WS_END); grid = -1; return; }
        int dev = 0, cus = 0, per_cu = 0;
        hipGetDevice(&dev);
        hipDeviceGetAttribute(&cus, hipDeviceAttributeMultiprocessorCount, dev);
        if (hipFuncSetAttribute((const void*)fwd_megakernel, hipFuncAttributeMaxDynamicSharedMemorySize, LDS_BYTES) != hipSuccess) { fprintf(stderr, "kernel_launch: hipFuncSetAttribute failed\n"); grid = -1; return; }
        if (hipOccupancyMaxActiveBlocksPerMultiprocessor(&per_cu, (const void*)fwd_megakernel, NTHREADS, LDS_BYTES) != hipSuccess || per_cu < 1) { fprintf(stderr, "kernel_launch: occupancy query failed (%d)\n", per_cu); per_cu = 1; }
        (void)hipGetLastError();
        grid = cus * per_cu;
        fprintf(stderr, "kernel_launch: grid %d (cus %d x %d)\n", grid, cus, per_cu);
    }
    if (grid < 0) return;
    hipMemsetAsync((char*)d_ws + WS_MOD, 0, MOD_BYTES, stream);
    Args a{};
    for (int i = 0; i < 18; ++i) a.in[i] = (const float*)d_in[i];
    a.out = (float*)d_out; a.ws = (unsigned char*)d_ws; a.ph_lo = 0; a.ph_hi = 100;
    void* args[] = {&a};
    hipError_t e = hipLaunchCooperativeKernel((const void*)fwd_megakernel, dim3(grid), dim3(NTHREADS), args, LDS_BYTES, stream);
    if (e != hipSuccess) fprintf(stderr, "kernel_launch: cooperative launch failed: %s (grid %d)\n", hipGetErrorString(e), grid);
}
```

```cpp
#include <hip/hip_runtime.h>
#include <hip/hip_cooperative_groups.h>
#include <cstdio>
#include <cstdint>
namespace cg = cooperative_groups;

#define LAS __attribute__((address_space(3)))
#define DI __device__ __forceinline__
typedef unsigned short bf16_t;
typedef short bf16x8 __attribute__((ext_vector_type(8)));
typedef short s16x4 __attribute__((ext_vector_type(4)));
typedef float f32x2 __attribute__((ext_vector_type(2)));
typedef float f32x4 __attribute__((ext_vector_type(4)));
typedef float f32x16 __attribute__((ext_vector_type(16)));
typedef unsigned u32x2 __attribute__((ext_vector_type(2)));
typedef unsigned u32x4 __attribute__((ext_vector_type(4)));
typedef __bf16 bf16v2 __attribute__((ext_vector_type(2)));

constexpr int DM = 2048, NB = 16, TL = 2048, TC = 256, TB = TL + TC, NTOK = NB * TB;
constexpr int NWAVES = 8, NTHREADS = 512;
constexpr float EPS = 1e-6f;
constexpr int MOD_LD = 3 * DM;
constexpr int M_WA_ROWS = 6400, M_WB_ROWS = 3072;
constexpr size_t MiB = 1u << 20;
constexpr size_t WS_MOD = 0;
constexpr size_t MOD_BYTES = (size_t)4 * 17 * MOD_LD * 4;
constexpr size_t WS_WFG = 2 * MiB, WS_WFO = 18 * MiB, WS_WMA = 34 * MiB, WS_WMB = 59 * MiB, WS_WMO = 71 * MiB, WS_WAI = 79 * MiB, WS_WAO = 99 * MiB;
constexpr size_t WS_DC = 107 * MiB, WS_DT = 108 * MiB, WS_DT2 = 124 * MiB, WS_CTXS = 125 * MiB, WS_H = 157 * MiB, WS_SCR = 301 * MiB;
constexpr size_t WS_END = 1024 * MiB;
constexpr size_t F_G = 0, F_PQX = 144 * MiB, F_PQC = 400 * MiB;
constexpr size_t M_Q = 0, M_K = 72 * MiB, M_KVT = 144 * MiB, M_G32 = 360 * MiB, M_HF = 365 * MiB, M_HB = 509 * MiB, M_SO = 0, M_SZ = 144 * MiB;
constexpr size_t A_Q = 0, A_K = 144 * MiB, A_V = 180 * MiB, A_SZ = 216 * MiB;
static_assert(WS_SCR + M_HB + 144 * MiB <= WS_END, "ws map");
constexpr int LDS_BYTES = 147456 + 1024;

DI unsigned pk2(float a, float b) { f32x2 v = {a, b}; return __builtin_bit_cast(unsigned, __builtin_convertvector(v, bf16v2)); }
DI float bf_lo(unsigned w) { return __uint_as_float(w << 16); }
DI float bf_hi(unsigned w) { return __uint_as_float(w & 0xffff0000u); }
DI float wave_sum(float v) {
#pragma unroll
    for (int o = 1; o < 64; o <<= 1) v += __shfl_xor(v, o);
    return v;
}
DI int otid(int wv) { int t; asm volatile("v_mbcnt_lo_u32_b32 %0, -1, 0\n\tv_mbcnt_hi_u32_b32 %0, -1, %0" : "=v"(t)); return wv * 64 + t; }
DI float siluf(float x) { return x / (1.f + __expf(-x)); }
DI float sigmf(float x) { return 1.f / (1.f + __expf(-x)); }
DI void st_bf16x8(bf16_t* p, f32x4 a, f32x4 b) { u32x4 w = {pk2(a[0], a[1]), pk2(a[2], a[3]), pk2(b[0], b[1]), pk2(b[2], b[3])}; *(u32x4*)p = w; }
DI void ld_bf16x8(const bf16_t* p, f32x4& a, f32x4& b) { const u32x4 w = *(const u32x4*)p; a = (f32x4){bf_lo(w.x), bf_hi(w.x), bf_lo(w.y), bf_hi(w.y)}; b = (f32x4){bf_lo(w.z), bf_hi(w.z), bf_lo(w.w), bf_hi(w.w)}; }

struct Args { const float* in[18]; float* out; unsigned char* ws; int ph_lo, ph_hi; };

namespace pg8 {
constexpr int BM = 256, BK = 64, HALF = 128, HTB = HALF * BK * 2, NXCD = 8;
DI int lds_byte(int r, int c) { const int st = (r >> 4) * 2 + (c >> 5), rr = r & 15, cc = c & 31, ob = rr * 64 + cc * 2; return st * 1024 + (ob ^ (((ob >> 9) & 1) << 5)); }
DI void stage_rc(int b, int& R, int& C) { const int st = b / 1024, sb = b % 1024, swz = sb ^ (((sb >> 9) & 1) << 5); R = (st >> 1) * 16 + swz / 64; C = (st & 1) * 32 + (swz % 64) / 2; }
DI int perm32(int rho) { const int n = rho >> 4, i = rho & 15; return 8 * (i >> 2) + 4 * n + (i & 3); }
struct Unit { const char* a; const char* b; int i0, i1, i2; };
DI int xcd_remap(int L, int total) { const int q = total / NXCD, r = total % NXCD, xcd = L % NXCD, off = L / NXCD; return (xcd < r ? xcd * (q + 1) : r * (q + 1) + (xcd - r) * q) + off; }

template <class Desc, class Epi>
DI void gemm_phase(LAS unsigned char* lds, const Desc& D, const Epi& E, int wv) {
    const int tid = otid(wv), wid = __builtin_amdgcn_readfirstlane(tid >> 6), lane = tid & 63, wr = wid >> 2, wc = wid & 3, fr = lane & 15, fq = lane >> 4;
    const int G = gridDim.x, c = blockIdx.x, total = D.total;
    const int K = D.K, nt = K / BK;
    unsigned voffA[2], voffB[2];
#pragma unroll
    for (int i = 0; i < 2; ++i) { int R, C; stage_rc(tid * 16 + i * 8192, R, C); const int Rb = (R & ~31) + perm32(R & 31);
        voffA[i] = (unsigned)(R * D.lda + C) * 2u; voffB[i] = (unsigned)(Rb * D.ldb + C) * 2u; }
    const size_t kstep = (size_t)(BK * 2);
    const size_t hstepA = (size_t)HALF * D.lda * 2, hstepB = (size_t)HALF * D.ldb * 2;
    const unsigned ldsw = (unsigned)wid * 1024u;
    const int aoff = lds_byte(wr * 64 + fr, fq * 8), boff = lds_byte(wc * 32 + fr, fq * 8);
#define PG8_SA(b, h) (((b) * 2 + (h)) * HTB)
#define PG8_SB(b, h) ((4 + (b) * 2 + (h)) * HTB)
#define PG8_STAGE(bufoff, gbase, voff) do { _Pragma("unroll") for (int _i = 0; _i < 2; ++_i) \
        __builtin_amdgcn_global_load_lds((const unsigned*)((const char*)(gbase) + (voff)[_i]), (LAS unsigned*)(lds + (bufoff) + ldsw + _i * 8192), 16, 0, 0); } while (0)
#define PG8_LDA(dst, b, h) do { _Pragma("unroll") for (int m = 0; m < 4; ++m) _Pragma("unroll") for (int k = 0; k < 2; ++k) dst[m][k] = *(const LAS bf16x8*)(lds + PG8_SA(b, h) + aoff + m * 2048 + k * 1024); } while (0)
#define PG8_LDB(dst, b, h) do { _Pragma("unroll") for (int n = 0; n < 2; ++n) _Pragma("unroll") for (int k = 0; k < 2; ++k) dst[n][k] = *(const LAS bf16x8*)(lds + PG8_SB(b, h) + boff + n * 2048 + k * 1024); } while (0)
#define PG8_MMA(ai, bj, At, Bt) do { __builtin_amdgcn_s_setprio(1); _Pragma("unroll") for (int m = 0; m < 4; ++m) _Pragma("unroll") for (int n = 0; n < 2; ++n) _Pragma("unroll") for (int k = 0; k < 2; ++k) \
        acc[ai][bj][m][n] = __builtin_amdgcn_mfma_f32_16x16x32_bf16(Bt[n][k], At[m][k], acc[ai][bj][m][n], 0, 0, 0); __builtin_amdgcn_s_setprio(0); } while (0)
#define PG8_WAIT_V(n) asm volatile("s_waitcnt vmcnt(" #n ")" ::: "memory")
#define PG8_WAIT_L(n) asm volatile("s_waitcnt lgkmcnt(" #n ")" ::: "memory")
#define PG8_BAR __builtin_amdgcn_s_barrier()
#define PG8_SCHED __builtin_amdgcn_sched_barrier(0)
    if (c >= total) return;
    Unit cur = D.unit(xcd_remap(c, total)), nxt = cur; int ui = 0;
    f32x4 acc[2][2][4][2];
#pragma unroll
    for (int a = 0; a < 2; ++a)
#pragma unroll
        for (int b = 0; b < 2; ++b)
#pragma unroll
            for (int m = 0; m < 4; ++m)
#pragma unroll
                for (int n = 0; n < 2; ++n) acc[a][b][m][n] = (f32x4){0.f, 0.f, 0.f, 0.f};
    bf16x8 At[4][2], B0[2][2], B1[2][2];
    const char* cA = cur.a; const char* cB = cur.b;
    PG8_STAGE(PG8_SB(0, 0), cB, voffB); PG8_STAGE(PG8_SB(0, 1), cB + hstepB, voffB); PG8_STAGE(PG8_SA(0, 0), cA, voffA); PG8_STAGE(PG8_SA(0, 1), cA + hstepA, voffA);
    if (wr == 1) PG8_BAR;
    PG8_WAIT_V(2); PG8_BAR;
    PG8_STAGE(PG8_SB(1, 0), cB + kstep, voffB); PG8_STAGE(PG8_SA(1, 0), cA + kstep, voffA); PG8_STAGE(PG8_SB(1, 1), cB + hstepB + kstep, voffB);
    PG8_WAIT_V(6); PG8_BAR;
    for (;;) {
        const long Ln = (long)(ui + 1) * G + c;
        const bool has_next = Ln < total;
        if (has_next) nxt = D.unit(xcd_remap((int)Ln, total));
        const char* nA = has_next ? nxt.a : cA; const char* nB = has_next ? nxt.b : cB;
        for (int t = 0; t < nt; t += 2) {
            const bool last = (t == nt - 2);
            const char* a1 = cA + (size_t)(t + 1) * kstep;
            const char* a2 = last ? nA : cA + (size_t)(t + 2) * kstep; const char* b2 = last ? nB : cB + (size_t)(t + 2) * kstep;
            const char* a3 = a2 + kstep; const char* b3 = b2 + kstep;
            PG8_LDB(B0, 0, 0); PG8_LDB(B1, 0, 1); PG8_SCHED; PG8_LDA(At, 0, 0); PG8_STAGE(PG8_SA(1, 1), a1 + hstepA, voffA);
            PG8_WAIT_V(8); PG8_WAIT_L(0); PG8_BAR; PG8_MMA(0, 0, At, B0); PG8_MMA(0, 1, At, B1); PG8_BAR; PG8_SCHED;
            PG8_LDA(At, 0, 1); PG8_STAGE(PG8_SB(0, 0), b2, voffB); PG8_STAGE(PG8_SB(0, 1), b2 + hstepB, voffB); PG8_STAGE(PG8_SA(0, 0), a2, voffA);
            PG8_WAIT_V(8); PG8_WAIT_L(0); PG8_BAR; PG8_MMA(1, 0, At, B0); PG8_MMA(1, 1, At, B1); PG8_BAR; PG8_SCHED;
            PG8_LDB(B0, 1, 0); PG8_LDB(B1, 1, 1); PG8_SCHED; PG8_LDA(At, 1, 0); PG8_STAGE(PG8_SA(0, 1), a2 + hstepA, voffA);
            PG8_WAIT_V(8); PG8_WAIT_L(0); PG8_BAR; PG8_MMA(0, 0, At, B0); PG8_MMA(0, 1, At, B1); PG8_BAR; PG8_SCHED;
            PG8_LDA(At, 1, 1); PG8_STAGE(PG8_SB(1, 0), b3, voffB); PG8_STAGE(PG8_SB(1, 1), b3 + hstepB, voffB); PG8_STAGE(PG8_SA(1, 0), a3, voffA);
            PG8_WAIT_V(8); PG8_WAIT_L(0); PG8_BAR; PG8_MMA(1, 0, At, B0); PG8_MMA(1, 1, At, B1); PG8_BAR; PG8_SCHED;
        }
        if (wr == 0) PG8_BAR;
#pragma unroll
        for (int ai = 0; ai < 2; ++ai)
#pragma unroll
            for (int m = 0; m < 4; ++m)
#pragma unroll
                for (int bj = 0; bj < 2; ++bj)
                    E(cur, ai * HALF + wr * 64 + m * 16 + fr, bj * HALF + wc * 32 + 8 * fq, acc[ai][bj][m][0], acc[ai][bj][m][1]);
        if (!has_next) break;
#pragma unroll
        for (int a = 0; a < 2; ++a)
#pragma unroll
            for (int b = 0; b < 2; ++b)
#pragma unroll
                for (int m = 0; m < 4; ++m)
#pragma unroll
                    for (int n = 0; n < 2; ++n) acc[a][b][m][n] = (f32x4){0.f, 0.f, 0.f, 0.f};
        cur = nxt; cA = nA; cB = nB; ++ui;
        if (wr == 1) PG8_BAR;
    }
    PG8_WAIT_V(0);
    PG8_BAR;
#undef PG8_SA
#undef PG8_SB
#undef PG8_STAGE
#undef PG8_LDA
#undef PG8_LDB
#undef PG8_MMA
#undef PG8_WAIT_V
#undef PG8_WAIT_L
#undef PG8_BAR
#undef PG8_SCHED
}
}

DI void transpose_item(const float* W, int N, int kb, int nb, bf16_t* d0, bf16_t* d1, int K, LAS float* scr, int lane) {
    const int k0 = 64 * kb, n0 = 32 * nb;
#pragma unroll 8
    for (int i = 0; i < 32; ++i) { const int kk = 2 * i + (lane >> 5); scr[kk * 33 + (lane & 31)] = W[(size_t)(k0 + kk) * N + n0 + (lane & 31)]; }
    asm volatile("s_waitcnt lgkmcnt(0)" ::: "memory");
    const int c = lane & 7;
#pragma unroll
    for (int j = 0; j < 4; ++j) { const int n = (lane >> 3) + 8 * j; const LAS float* s = scr + (8 * c) * 33 + n;
        u32x4 o; o.x = pk2(s[0 * 33], s[1 * 33]); o.y = pk2(s[2 * 33], s[3 * 33]); o.z = pk2(s[4 * 33], s[5 * 33]); o.w = pk2(s[6 * 33], s[7 * 33]);
        *(u32x4*)(d0 + (size_t)n * K + k0 + 8 * c) = o;
        if (d1) *(u32x4*)(d1 + (size_t)n * K + k0 + 8 * c) = o; }
    asm volatile("s_waitcnt lgkmcnt(0)" ::: "memory");
}

DI void prep_phase(const Args& A, LAS unsigned char* lds, int wv) {
    const int tid = otid(wv), lane = tid & 63, wave = tid >> 6, G = gridDim.x;
    unsigned char* ws = A.ws;
    {
        LAS float* s_lds = (LAS float*)lds;
        const float* cc = A.in[1]; const float* cctx = A.in[3]; const float* aw = A.in[4]; const float* ab = A.in[5];
        float* mod = (float*)(ws + WS_MOD);
        for (int item = blockIdx.x; item < 768; item += G) {
            const int kc = item % 16, cb = (item / 16) % 12, l = item / 192;
            const int k0 = kc * 128, j = cb * 512 + tid;
            __syncthreads();
            for (int e = tid; e < 17 * 128; e += NTHREADS) { const int r = e / 128, k = e % 128; const float v = r < 16 ? cc[r * DM + k0 + k] : cctx[k0 + k]; s_lds[k * 20 + r] = siluf(v); }
            __syncthreads();
            float acc[17];
#pragma unroll
            for (int r = 0; r < 17; ++r) acc[r] = 0.f;
            const float* wp = aw + ((size_t)l * DM + k0) * MOD_LD + j;
#pragma unroll 4
            for (int k = 0; k < 128; ++k) {
                const float w = wp[(size_t)k * MOD_LD];
                const LAS f32x4* sp = (const LAS f32x4*)(s_lds + k * 20);
                const f32x4 s0 = sp[0], s1 = sp[1], s2 = sp[2], s3 = sp[3]; const float s4 = s_lds[k * 20 + 16];
#pragma unroll
                for (int q = 0; q < 4; ++q) { acc[q] += s0[q] * w; acc[4 + q] += s1[q] * w; acc[8 + q] += s2[q] * w; acc[12 + q] += s3[q] * w; }
                acc[16] += s4 * w;
            }
            const float bias = (kc == 0) ? ab[l * MOD_LD + j] : 0.f;
#pragma unroll
            for (int r = 0; r < 17; ++r) unsafeAtomicAdd(&mod[(size_t)(l * 17 + r) * MOD_LD + j], acc[r] + bias);
        }
        __syncthreads();
    }
    {
        LAS float* scr = (LAS float*)(lds + wave * 16384);
        const int gw = blockIdx.x * NWAVES + wave, NGW = G * NWAVES;
        constexpr int I_SQ = 32 * 64, I_AI = 32 * 160, I_MI = 32 * 257;
        constexpr int NIT = 6 * I_SQ + I_AI + I_MI;
        for (int it = gw; it < NIT; it += NGW) {
            int r = it;
            if (r < 6 * I_SQ) {
                const int w = r / I_SQ; r -= w * I_SQ;
                const float* src; bf16_t* dst;
                if (w < 2)      { src = A.in[7] + (size_t)w * DM * DM;       dst = (bf16_t*)(ws + WS_WFG) + (size_t)w * DM * DM; }
                else if (w < 4) { src = A.in[8] + (size_t)(w - 2) * DM * DM; dst = (bf16_t*)(ws + WS_WFO) + (size_t)(w - 2) * DM * DM; }
                else if (w == 4) { src = A.in[12]; dst = (bf16_t*)(ws + WS_WMO); }
                else             { src = A.in[16]; dst = (bf16_t*)(ws + WS_WAO); }
                const int kb = r / 64, nb = r % 64;
                transpose_item(src, DM, kb, nb, dst + (size_t)(32 * nb) * DM, nullptr, DM, scr, lane);
                continue;
            }
            r -= 6 * I_SQ;
            if (r < I_AI) { const int kb = r / 160, nb = r % 160; transpose_item(A.in[13], 5120, kb, nb, (bf16_t*)(ws + WS_WAI) + (size_t)(32 * nb) * DM, nullptr, DM, scr, lane); continue; }
            r -= I_AI;
            {
                const int kb = r / 257, nb = r % 257, n0 = 32 * nb;
                bf16_t* WA = (bf16_t*)(ws + WS_WMA); bf16_t* WB = (bf16_t*)(ws + WS_WMB);
                bf16_t* d0; bf16_t* d1 = nullptr;
                if (n0 < 1024) d0 = WA + (size_t)n0 * DM;
                else if (n0 < 2048) { d0 = WA + (size_t)n0 * DM; d1 = WB + (size_t)(n0 - 1024) * DM; }
                else if (n0 < 4096) d0 = WB + (size_t)(1024 + n0 - 2048) * DM;
                else if (n0 < 6144) d0 = WA + (size_t)(2304 + n0 - 4096) * DM;
                else if (n0 < 6176) d0 = WA + (size_t)(2048 + n0 - 6144) * DM;
                else d0 = WA + (size_t)(4352 + n0 - 6176) * DM;
                transpose_item(A.in[9], 8224, kb, nb, d0, d1, DM, scr, lane);
            }
        }
    }
    {
        const long gt = (long)blockIdx.x * NTHREADS + tid, NGT = (long)G * NTHREADS;
        constexpr long N_DC = 1024L * 512 / 8, N_DT = 2048L * 4096 / 8, N_DT2 = 256L * 512 / 8;
        for (long it = gt; it < N_DC + N_DT + N_DT2; it += NGT) {
            float v[8]; bf16_t* dst;
            if (it < N_DC) {
                const int m = (int)(it / 64), k0 = (int)(it % 64) * 8; const float sc = 0.044194173824159216f;
#pragma unroll
                for (int j = 0; j < 8; ++j) { const int rr = ((m & 511) * (k0 + j)) & 511; const float ang = (float)rr * (1.f / 256.f); v[j] = (m < 512 ? cospif(ang) : sinpif(ang)) * sc; }
                dst = (bf16_t*)(ws + WS_DC) + (size_t)m * 512 + k0;
            } else if (it < N_DC + N_DT) {
                const long i2 = it - N_DC; const int kk = (int)(i2 / 512), s0 = (int)(i2 % 512) * 8; const float sc = 0.022097086912079608f;
#pragma unroll
                for (int j = 0; j < 8; ++j) { const int s = s0 + j; const int rr = (kk * (s & 2047)) & 2047; const float ang = (float)rr * (1.f / 1024.f); v[j] = (s < 2048 ? cospif(ang) : -sinpif(ang)) * sc; }
                dst = (bf16_t*)(ws + WS_DT) + (size_t)kk * 4096 + s0;
            } else {
                const long i2 = it - N_DC - N_DT; const int kk = (int)(i2 / 64), s0 = (int)(i2 % 64) * 8; const float sc = 0.0625f;
#pragma unroll
                for (int j = 0; j < 8; ++j) { const int s = s0 + j; const int rr = (kk * (s & 255)) & 255; const float ang = (float)rr * (1.f / 128.f); v[j] = (s < 256 ? cospif(ang) : -sinpif(ang)) * sc; }
                dst = (bf16_t*)(ws + WS_DT2) + (size_t)kk * 512 + s0;
            }
            u32x4 o = {pk2(v[0], v[1]), pk2(v[2], v[3]), pk2(v[4], v[5]), pk2(v[6], v[7])};
            *(u32x4*)dst = o;
        }
    }
}

DI const float* xrow_ptr(const Args& A, int layer, int r) {
    const int b = r / TB, t = r % TB;
    if (t < TL) return (layer == 0 ? A.in[0] : (const float*)A.out) + ((size_t)b * TL + t) * DM;
    return (layer == 0 ? A.in[2] : (const float*)(A.ws + WS_CTXS)) + ((size_t)b * TC + (t - TL)) * DM;
}
DI void norm_phase(const Args& A, int layer, bool latonly, int wv) {
    const int tid = otid(wv), lane = tid & 63, wave = tid >> 6, G = gridDim.x;
    const float* ng = A.in[6] + (size_t)layer * DM;
    const float* mod = (const float*)(A.ws + WS_MOD) + (size_t)layer * 17 * MOD_LD;
    bf16_t* H = (bf16_t*)(A.ws + WS_H);
    for (int r = blockIdx.x * NWAVES + wave; r < NTOK; r += G * NWAVES) {
        const int b = r / TB, t = r % TB;
        if (latonly && t >= TL) continue;
        const float* xr = xrow_ptr(A, layer, r);
        const float* mr = mod + (size_t)(t < TL ? b : 16) * MOD_LD;
        f32x4 v[4][2]; float ss = 0.f;
#pragma unroll
        for (int j = 0; j < 4; ++j) { const f32x4* p = (const f32x4*)(xr + 512 * j + 8 * lane); v[j][0] = p[0]; v[j][1] = p[1];
#pragma unroll
            for (int q = 0; q < 4; ++q) ss += v[j][0][q] * v[j][0][q] + v[j][1][q] * v[j][1][q]; }
        const float rs = 1.0f / sqrtf(wave_sum(ss) * (1.f / DM) + EPS);
#pragma unroll
        for (int j = 0; j < 4; ++j) { const int c0 = 512 * j + 8 * lane; f32x4 o[2];
#pragma unroll
            for (int h = 0; h < 2; ++h) { const f32x4 g4 = *(const f32x4*)(ng + c0 + 4 * h), sh = *(const f32x4*)(mr + c0 + 4 * h), sc = *(const f32x4*)(mr + DM + c0 + 4 * h);
                o[h] = (v[j][h] * rs) * g4 * (sc + 1.0f) + sh; }
            st_bf16x8(H + (size_t)r * DM + c0, o[0], o[1]); }
    }
}
DI void final_norm_phase(const Args& A, const float* src_override, int wv) {
    const int tid = otid(wv), lane = tid & 63, wave = tid >> 6, G = gridDim.x;
    const float* fg = A.in[17];
    for (int r = blockIdx.x * NWAVES + wave; r < NB * TL; r += G * NWAVES) {
        const float* xr = (src_override ? src_override : (const float*)A.out) + (size_t)r * DM; float* orow = A.out + (size_t)r * DM;
        f32x4 v[4][2]; float ss = 0.f;
#pragma unroll
        for (int j = 0; j < 4; ++j) { const f32x4* p = (const f32x4*)(xr + 512 * j + 8 * lane); v[j][0] = p[0]; v[j][1] = p[1];
#pragma unroll
            for (int q = 0; q < 4; ++q) ss += v[j][0][q] * v[j][0][q] + v[j][1][q] * v[j][1][q]; }
        const float rs = 1.0f / sqrtf(wave_sum(ss) * (1.f / DM) + EPS);
#pragma unroll
        for (int j = 0; j < 4; ++j) { const int c0 = 512 * j + 8 * lane;
#pragma unroll
            for (int h = 0; h < 2; ++h) { const f32x4 g4 = *(const f32x4*)(fg + c0 + 4 * h); *(f32x4*)(orow + c0 + 4 * h) = (v[j][h] * rs) * g4; } }
    }
}


struct DescPlain {
    const bf16_t* A; const bf16_t* B; int nN; bool latonly; int lda, ldb, K, total;
    DI void init(const bf16_t* A_, const bf16_t* B_, int nN_, bool lat) { A = A_; B = B_; nN = nN_; latonly = lat; lda = DM; ldb = DM; K = DM; total = (lat ? 128 : 144) * nN_; }
    DI pg8::Unit unit(int idx) const {
        const int nMt = latonly ? 128 : 144, nig = 8 * nN, gid = idx / nig, fm = gid * 8, gsz = (nMt - fm) < 8 ? (nMt - fm) : 8;
        const int pmi = fm + (idx % nig) % gsz, pn = (idx % nig) / gsz, pm = latonly ? (pmi / 8) * 9 + (pmi % 8) : pmi;
        pg8::Unit u; u.a = (const char*)(A + (size_t)pm * 256 * DM); u.b = (const char*)(B + (size_t)pn * 256 * DM); u.i0 = pm; u.i1 = pn; u.i2 = 0; return u;
    }
};
struct DescChan {
    const bf16_t* DC; const bf16_t* H; int lda, ldb, K, total;
    DI void init(const bf16_t* DC_, const bf16_t* H_, bool lat) { DC = DC_; H = H_; lda = 512; ldb = DM; K = 512; total = lat ? 2048 : 2304; }
    DI pg8::Unit unit(int idx) const {
        pg8::Unit u; int b, g, mt, nt, toff;
        if (idx < 2048) { mt = idx % 4; nt = (idx / 4) % 8; g = (idx / 32) % 4; b = idx / 128; toff = nt * 256; u.i2 = nt; }
        else { const int j = idx - 2048; mt = j % 4; g = (j / 4) % 4; b = j / 16; toff = TL; u.i2 = 8; }
        u.a = (const char*)(DC + (size_t)mt * 256 * 512); u.b = (const char*)(H + ((size_t)b * TB + toff) * DM + g * 512); u.i0 = b * 4 + g; u.i1 = mt; return u;
    }
};
struct DescT {
    const bf16_t* DT; const bf16_t* PQ; int nMt; int lda, ldb, K, total;
    DI void init(const bf16_t* DT_, const bf16_t* PQ_, int T) { DT = DT_; PQ = PQ_; nMt = T / 256; lda = 2 * T; ldb = 2 * T; K = 2 * T; total = NB * nMt * 8; }
    DI pg8::Unit unit(int idx) const {
        const int mt = idx % nMt, nt = (idx / nMt) % 8, b = idx / (nMt * 8);
        pg8::Unit u; u.a = (const char*)(DT + (size_t)mt * 256 * K); u.b = (const char*)(PQ + ((size_t)b * DM + nt * 256) * K); u.i0 = b; u.i1 = mt; u.i2 = nt; return u;
    }
};

DI void resid_store(const Args& A, int layer, int pm, int row_l, int col, const float* modl, f32x4 v0, f32x4 v1) {
    const int b = pm / 9, tt = pm % 9;
    const float* gp = modl + (size_t)(tt < 8 ? b : 16) * MOD_LD + 2 * DM + col;
    const f32x4 g0 = *(const f32x4*)gp, g1 = *(const f32x4*)(gp + 4);
    const float* src; float* dst;
    if (tt < 8) { const size_t off = ((size_t)b * TL + tt * 256 + row_l) * DM + col; src = (layer == 0 ? A.in[0] : (const float*)A.out) + off; dst = A.out + off; }
    else { const size_t off = ((size_t)b * TC + row_l) * DM + col; src = (layer == 0 ? A.in[2] : (const float*)(A.ws + WS_CTXS)) + off; dst = (float*)(A.ws + WS_CTXS) + off; }
    const f32x4 x0 = *(const f32x4*)src, x1 = *(const f32x4*)(src + 4);
    *(f32x4*)dst = x0 + g0 * v0; *(f32x4*)(dst + 4) = x1 + g1 * v1;
}

DI void fnet_layer(const Args& A, LAS unsigned char* lds, cg::grid_group& grid, int layer, int j, bool latonly, int wv) {
    unsigned char* ws = A.ws;
    const bf16_t* H = (const bf16_t*)(ws + WS_H); bf16_t* U = (bf16_t*)(ws + WS_H);
    bf16_t* Gt = (bf16_t*)(ws + WS_SCR + F_G); bf16_t* PQX = (bf16_t*)(ws + WS_SCR + F_PQX); bf16_t* PQC = (bf16_t*)(ws + WS_SCR + F_PQC);
    norm_phase(A, layer, latonly, wv);
    grid.sync();
    {
        DescPlain D; D.init(H, (const bf16_t*)(ws + WS_WFG) + (size_t)j * DM * DM, 8, latonly);
        auto E = [=](const pg8::Unit& u, int row_l, int col_l, f32x4 v0, f32x4 v1) {
            f32x4 a, b;
#pragma unroll
            for (int q = 0; q < 4; ++q) { a[q] = siluf(v0[q]); b[q] = siluf(v1[q]); }
            st_bf16x8(Gt + ((size_t)u.i0 * 256 + row_l) * DM + u.i1 * 256 + col_l, a, b);
        };
        pg8::gemm_phase(lds, D, E, wv);
    }
    {
        DescChan D; D.init((const bf16_t*)(ws + WS_DC), H, latonly);
        auto E = [=](const pg8::Unit& u, int row_l, int col_l, f32x4 v0, f32x4 v1) {
            const int b = u.i0 >> 2, g = u.i0 & 3, mt = u.i1, half = mt >> 1, ch = g * 512 + (mt & 1) * 256 + row_l;
            bf16_t* dst = (u.i2 < 8) ? PQX + ((size_t)b * DM + ch) * 4096 + half * 2048 + u.i2 * 256 + col_l
                                     : PQC + ((size_t)b * DM + ch) * 512 + half * 256 + col_l;
            st_bf16x8(dst, v0, v1);
        };
        pg8::gemm_phase(lds, D, E, wv);
    }
    grid.sync();
    {
        DescT D; D.init((const bf16_t*)(ws + WS_DT), PQX, TL);
        auto E = [=](const pg8::Unit& u, int row_l, int col_l, f32x4 v0, f32x4 v1) {
            const size_t off = ((size_t)u.i0 * TB + u.i1 * 256 + row_l) * DM + u.i2 * 256 + col_l;
            f32x4 g0, g1; ld_bf16x8(Gt + off, g0, g1);
            st_bf16x8(U + off, v0 * g0, v1 * g1);
        };
        pg8::gemm_phase(lds, D, E, wv);
    }
    if (!latonly) {
        DescT D; D.init((const bf16_t*)(ws + WS_DT2), PQC, TC);
        auto E = [=](const pg8::Unit& u, int row_l, int col_l, f32x4 v0, f32x4 v1) {
            const size_t off = ((size_t)u.i0 * TB + TL + row_l) * DM + u.i2 * 256 + col_l;
            f32x4 g0, g1; ld_bf16x8(Gt + off, g0, g1);
            st_bf16x8(U + off, v0 * g0, v1 * g1);
        };
        pg8::gemm_phase(lds, D, E, wv);
    }
    grid.sync();
    {
        DescPlain D; D.init(U, (const bf16_t*)(ws + WS_WFO) + (size_t)j * DM * DM, 8, latonly);
        const float* modl = (const float*)(ws + WS_MOD) + (size_t)layer * 17 * MOD_LD;
        auto E = [=](const pg8::Unit& u, int row_l, int col_l, f32x4 v0, f32x4 v1) { resid_store(A, layer, u.i0, row_l, u.i1 * 256 + col_l, modl, v0, v1); };
        pg8::gemm_phase(lds, D, E, wv);
    }
    grid.sync();
}


namespace att {
constexpr int D = 128, NW = 8, QBLK = 32, KVBLK = 64;
constexpr float SCALE = 0.088388347648318440f;
constexpr float THR = 8.f;
constexpr int LDQ = 2048, LDK = 512;
constexpr size_t SHM_V = KVBLK * D * 2, SHM_K = KVBLK * D * 2;
typedef float f32x8 __attribute__((ext_vector_type(8)));
#define KSWZ(row, colB) ((row) * 256 + ((colB) ^ (((row) & 7) << 4)))
#define SBAR() __builtin_amdgcn_sched_barrier(0)
DI int crow(int r, int hi) { return (r & 3) + 8 * (r >> 2) + 4 * hi; }
DI unsigned cvtpk(float lo, float hi) { unsigned r; asm volatile("v_cvt_pk_bf16_f32 %0, %1, %2" : "=v"(r) : "v"(lo), "v"(hi)); return r; }
DI void partialSM(f32x16& p0, f32x16& p1, float& m_reg, float& mn, float& alpha) {
  constexpr float C = SCALE * 1.4426950408889634f;
  float pmax = p0[0];
#pragma unroll
  for (int r = 1; r < 16; ++r) pmax = fmaxf(pmax, p0[r]);
#pragma unroll
  for (int r = 0; r < 16; ++r) pmax = fmaxf(pmax, p1[r]);
  { auto rr = __builtin_amdgcn_permlane32_swap(__float_as_uint(pmax), __float_as_uint(pmax), false, false);
    pmax = fmaxf(__uint_as_float(rr[0]), __uint_as_float(rr[1])); }
  if (__builtin_expect(__all(pmax - m_reg <= THR / SCALE), 1)) { mn = m_reg; alpha = 1.f; }
  else { mn = fmaxf(m_reg, pmax); alpha = __builtin_amdgcn_exp2f((m_reg - mn) * C); m_reg = mn; }
  float mnC = -mn * C;
#pragma unroll
  for (int r = 0; r < 16; ++r) p0[r] = fmaf(p0[r], C, mnC);
#pragma unroll
  for (int r = 0; r < 16; ++r) p1[r] = fmaf(p1[r], C, mnC);
#pragma unroll
  for (int r = 0; r < 16; ++r) p0[r] = __builtin_amdgcn_exp2f(p0[r]);
}
DI void finishSM(f32x16& p0, f32x16& p1, float alpha, float& l_reg, bf16x8& pa0, bf16x8& pa1, bf16x8& pa2, bf16x8& pa3) {
#pragma unroll
  for (int r = 0; r < 16; ++r) p1[r] = __builtin_amdgcn_exp2f(p1[r]);
  float ps = 0;
#pragma unroll
  for (int r = 0; r < 16; ++r) ps += p0[r];
#pragma unroll
  for (int r = 0; r < 16; ++r) ps += p1[r];
  { auto rr = __builtin_amdgcn_permlane32_swap(__float_as_uint(ps), __float_as_uint(ps), false, false);
    ps = __uint_as_float(rr[0]) + __uint_as_float(rr[1]); }
  l_reg = l_reg * alpha + ps;
#define PK4(P, BASE, OUT) do { unsigned a0 = cvtpk(P[BASE + 0], P[BASE + 1]), a1 = cvtpk(P[BASE + 2], P[BASE + 3]);   \
    unsigned b0 = cvtpk(P[BASE + 4], P[BASE + 5]), b1 = cvtpk(P[BASE + 6], P[BASE + 7]);                              \
    auto r0 = __builtin_amdgcn_permlane32_swap(a0, b0, false, false); auto r1 = __builtin_amdgcn_permlane32_swap(a1, b1, false, false); \
    u32x4 w = {r0[0], r1[0], r0[1], r1[1]}; OUT = *reinterpret_cast<bf16x8*>(&w); } while (0)
  PK4(p0, 0, pa0); PK4(p0, 8, pa1); PK4(p1, 0, pa2); PK4(p1, 8, pa3);
#undef PK4
}
DI void qkt(f32x16& p0, f32x16& p1, const bf16_t* Ks, const bf16x8* qr, int r32, int hi) {
  p0 = f32x16{}; p1 = f32x16{};
#pragma unroll
  for (int d0 = 0; d0 < 8; ++d0) { int cb = (d0 * 16 + hi * 8) * 2;
    bf16x8 b0 = *reinterpret_cast<const bf16x8*>((const char*)Ks + KSWZ(r32, cb));
    bf16x8 b1 = *reinterpret_cast<const bf16x8*>((const char*)Ks + KSWZ(32 + r32, cb));
    p0 = __builtin_amdgcn_mfma_f32_32x32x16_bf16(b0, qr[d0], p0, 0, 0, 0);
    p1 = __builtin_amdgcn_mfma_f32_32x32x16_bf16(b1, qr[d0], p1, 0, 0, 0); }
}
DI int v_st(int k, int c) { const int kk = (k & ~0xC) | ((k & 4) << 1) | ((k & 8) >> 1); return ((kk >> 3) * 4 + (c >> 5)) * 512 + ((kk & 7) * 32 + (c & 31)) * 2; }
DI int v_rd_base(int lane) { return ((lane & 3) << 3) | (((lane >> 2) & 3) << 6) | (((lane >> 4) & 1) << 5) | (((lane >> 5) & 1) << 8); }
constexpr int v_rd_off(int d0, int ks, int half) { return d0 * 512 + ks * 4096 + half * 2048; }
template <int OFF> DI s16x4 tr_read(int vb) {
  s16x4 r; asm volatile("ds_read_b64_tr_b16 %0, %1 offset:%2" : "=&v"(r) : "v"(vb), "i"(OFF) : "memory"); return r;
}
template <int D0> DI void pv_one(f32x16& od, int vb, bf16x8 pa0, bf16x8 pa1, bf16x8 pa2, bf16x8 pa3) {
  const s16x4 l0 = tr_read<v_rd_off(D0, 0, 0)>(vb), h0 = tr_read<v_rd_off(D0, 0, 1)>(vb), l1 = tr_read<v_rd_off(D0, 1, 0)>(vb), h1 = tr_read<v_rd_off(D0, 1, 1)>(vb);
  const s16x4 l2 = tr_read<v_rd_off(D0, 2, 0)>(vb), h2 = tr_read<v_rd_off(D0, 2, 1)>(vb), l3 = tr_read<v_rd_off(D0, 3, 0)>(vb), h3 = tr_read<v_rd_off(D0, 3, 1)>(vb);
  asm volatile("s_waitcnt lgkmcnt(0)" ::: "memory"); SBAR();
#define PK(L, H) (bf16x8){L[0], L[1], L[2], L[3], H[0], H[1], H[2], H[3]}
  od = __builtin_amdgcn_mfma_f32_32x32x16_bf16(pa0, PK(l0, h0), od, 0, 0, 0);
  od = __builtin_amdgcn_mfma_f32_32x32x16_bf16(pa1, PK(l1, h1), od, 0, 0, 0);
  od = __builtin_amdgcn_mfma_f32_32x32x16_bf16(pa2, PK(l2, h2), od, 0, 0, 0);
  od = __builtin_amdgcn_mfma_f32_32x32x16_bf16(pa3, PK(l3, h3), od, 0, 0, 0);
#undef PK
}
DI void pv_d0(f32x16* o, int vb, bf16x8 pa0, bf16x8 pa1, bf16x8 pa2, bf16x8 pa3) {
  pv_one<0>(o[0], vb, pa0, pa1, pa2, pa3); pv_one<1>(o[1], vb, pa0, pa1, pa2, pa3); pv_one<2>(o[2], vb, pa0, pa1, pa2, pa3); pv_one<3>(o[3], vb, pa0, pa1, pa2, pa3);
}
DI void attn_dense_body(const bf16_t* __restrict__ Qb, const bf16_t* __restrict__ Kh, const bf16_t* __restrict__ Vh, const bf16_t* SZb, bf16_t* Ub, int seq, char* lds, int wv) {
  const int tid = otid(wv), wid = tid >> 6, lane = tid & 63, r32 = lane & 31, hi = lane >> 5;
  bf16_t* V_lds = (bf16_t*)lds; bf16_t* K_lds = (bf16_t*)(lds + 2 * SHM_V);
  float* wsf = (float*)(lds + 2 * SHM_V + 2 * SHM_K) + wid * 64; float* li_l = wsf; float* al_l = wsf + 32;
  float m_reg = -1e30f, l_reg = 0; f32x16 o[4] = {}; bf16x8 qr[8];
  const bf16_t* Qw = Qb + (long)(wid * QBLK + r32) * LDQ + hi * 8;
#pragma unroll
  for (int d0 = 0; d0 < 8; ++d0) qr[d0] = *reinterpret_cast<const bf16x8*>(Qw + d0 * 16);
  const int sr = tid >> 4, sc = (tid & 15) * 8, vst0 = v_st(sr, sc), vst1 = v_st(32 + sr, sc);
  const int vb0 = (int)(uintptr_t)V_lds + v_rd_base(lane);
  struct { bf16x8 vs0, vs1, ks0, ks1; } sr_[2];
#define SLOAD(i, k0) do { sr_[i].vs0 = *reinterpret_cast<const bf16x8*>(&Vh[(long)((k0) + sr) * LDK + sc]); sr_[i].vs1 = *reinterpret_cast<const bf16x8*>(&Vh[(long)((k0) + 32 + sr) * LDK + sc]); \
    sr_[i].ks0 = *reinterpret_cast<const bf16x8*>(&Kh[(long)((k0) + sr) * LDK + sc]); sr_[i].ks1 = *reinterpret_cast<const bf16x8*>(&Kh[(long)((k0) + 32 + sr) * LDK + sc]); } while (0)
#define SWRITE(b, i) do { *(bf16x8*)((char*)V_lds + (b) * SHM_V + vst0) = sr_[i].vs0;          \
    *(bf16x8*)((char*)V_lds + (b) * SHM_V + vst1) = sr_[i].vs1; int kc = sc * 2;               \
    *(bf16x8*)((char*)K_lds + (b) * SHM_K + KSWZ(sr, kc)) = sr_[i].ks0;                       \
    *(bf16x8*)((char*)K_lds + (b) * SHM_K + KSWZ(32 + sr, kc)) = sr_[i].ks1; } while (0)
#define SWAIT() asm volatile("s_waitcnt vmcnt(4)" ::: "memory")
#define RESC(a) do { if (__any((a) < 1.f)) { if (hi == 0) al_l[r32] = (a); asm volatile("s_waitcnt lgkmcnt(0)" ::: "memory"); \
    _Pragma("unroll") for (int d = 0; d < 4; ++d) _Pragma("unroll") for (int r = 0; r < 16; ++r) o[d][r] *= al_l[crow(r, hi)]; } } while (0)
  f32x16 pA0, pA1, pB0, pB1; float mnA, mnB, alA, alB; bf16x8 pa0, pa1, pa2, pa3; const int NT = seq / KVBLK;
  constexpr int SE = 0, SO = 1;
  SLOAD(SE, 0); asm volatile("s_waitcnt vmcnt(0)" ::: "memory"); SWRITE(0, SE); __syncthreads();
  qkt(pA0, pA1, K_lds, qr, r32, hi); partialSM(pA0, pA1, m_reg, mnA, alA);
  SLOAD(SO, KVBLK); if (2 < NT) SLOAD(SE, 2 * KVBLK);
  SWAIT(); SWRITE(1, SO); __syncthreads();
  for (int j = 1; j + 1 < NT; j += 2) {
    SBAR(); qkt(pB0, pB1, (bf16_t*)((char*)K_lds + SHM_K), qr, r32, hi);
    finishSM(pA0, pA1, alA, l_reg, pa0, pa1, pa2, pa3); SBAR();
    SLOAD(SO, (j + 2) * KVBLK); SBAR();
    pv_d0(o, vb0, pa0, pa1, pa2, pa3); partialSM(pB0, pB1, m_reg, mnB, alB);
    __syncthreads(); SWAIT(); SWRITE(0, SE);
    RESC(alB); __syncthreads();
    SBAR(); qkt(pA0, pA1, K_lds, qr, r32, hi);
    finishSM(pB0, pB1, alB, l_reg, pa0, pa1, pa2, pa3); SBAR();
    if (j + 3 < NT) SLOAD(SE, (j + 3) * KVBLK); SBAR();
    pv_d0(o, vb0 + (int)SHM_V, pa0, pa1, pa2, pa3); partialSM(pA0, pA1, m_reg, mnA, alA);
    __syncthreads(); SWAIT(); SWRITE(1, SO);
    RESC(alA); __syncthreads();
  }
  SBAR(); qkt(pB0, pB1, (bf16_t*)((char*)K_lds + SHM_K), qr, r32, hi);
  finishSM(pA0, pA1, alA, l_reg, pa0, pa1, pa2, pa3); SBAR();
  pv_d0(o, vb0, pa0, pa1, pa2, pa3); partialSM(pB0, pB1, m_reg, mnB, alB);
  __syncthreads(); RESC(alB);
  finishSM(pB0, pB1, alB, l_reg, pa0, pa1, pa2, pa3); SBAR();
  pv_d0(o, vb0 + (int)SHM_V, pa0, pa1, pa2, pa3);
  if (hi == 0) li_l[r32] = l_reg; asm volatile("s_waitcnt lgkmcnt(0)" ::: "memory");
  float rli[16];
#pragma unroll
  for (int r = 0; r < 16; ++r) rli[r] = __builtin_amdgcn_rcpf(li_l[crow(r, hi)]);
#pragma unroll
  for (int r = 0; r < 16; ++r) { const long ro = (long)(wid * QBLK + crow(r, hi)) * LDQ + r32;
#pragma unroll
    for (int d0 = 0; d0 < 4; ++d0) Ub[ro + d0 * 32] = (bf16_t)(pk2(o[d0][r] * rli[r], 0.f) & 0xffffu); }
  __syncthreads();
#pragma unroll 2
  for (int i = 0; i < 8; ++i) { const int id = tid + 512 * i; const long off = (long)(id >> 4) * LDQ + (id & 15) * 8;
    f32x4 a0, a1, z0, z1; ld_bf16x8(Ub + off, a0, a1); ld_bf16x8(SZb + off, z0, z1); st_bf16x8(Ub + off, a0 * z0, a1 * z1); }
  __syncthreads();
#undef SLOAD
#undef SWRITE
#undef SWAIT
#undef RESC
}
#undef KSWZ
#undef SBAR
}

DI void qknorm_phase(const Args& A, int wv) {
    const int tid = otid(wv), lane = tid & 63, wave = tid >> 6, G = gridDim.x;
    bf16_t* Q = (bf16_t*)(A.ws + WS_SCR + A_Q); bf16_t* Kb = (bf16_t*)(A.ws + WS_SCR + A_K);
    const float* qn = A.in[14]; const float* kn = A.in[15];
    const int sub = lane >> 4, l16 = lane & 15, e0 = l16 * 8;
    const long NIT = (long)NTOK * 20;
    for (long it = ((long)blockIdx.x * NWAVES + wave) * 4 + sub; it < NIT; it += (long)G * NWAVES * 4) {
        const int row = (int)(it / 20), hj = (int)(it % 20);
        bf16_t* p = (hj < 16) ? Q + (size_t)row * 2048 + hj * 128 + e0 : Kb + (size_t)row * 512 + (hj - 16) * 128 + e0;
        const float* wn = (hj < 16 ? qn : kn) + e0;
        f32x4 a, b; ld_bf16x8(p, a, b);
        float ss = 0.f;
#pragma unroll
        for (int q = 0; q < 4; ++q) ss += a[q] * a[q] + b[q] * b[q];
        ss += __shfl_xor(ss, 1); ss += __shfl_xor(ss, 2); ss += __shfl_xor(ss, 4); ss += __shfl_xor(ss, 8);
        const float rs = 1.0f / sqrtf(ss * (1.f / 128.f) + EPS);
        const f32x4 w0 = *(const f32x4*)wn, w1 = *(const f32x4*)(wn + 4);
        a = a * rs * w0; b = b * rs * w1;
        const int t = row % TB;
        if (t < TL) {
            const float pos = (l16 < 8) ? (float)(t >> 6) : (float)(t & 63);
            float y[8] = {a[0], a[1], a[2], a[3], b[0], b[1], b[2], b[3]};
#pragma unroll
            for (int pp = 0; pp < 4; ++pp) {
                const int fi = (4 * l16 + pp) & 31;
                const float ang = pos * exp2f(-(float)fi * 0.41524101186092029f);
                const float cs = cosf(ang), sn = sinf(ang);
                const float x0 = y[2 * pp], x1 = y[2 * pp + 1];
                y[2 * pp] = x0 * cs - x1 * sn; y[2 * pp + 1] = x0 * sn + x1 * cs;
            }
            a = (f32x4){y[0], y[1], y[2], y[3]}; b = (f32x4){y[4], y[5], y[6], y[7]};
        }
        st_bf16x8(p, a, b);
    }
}

DI void attn_layer(const Args& A, LAS unsigned char* lds, char* lds_gen, cg::grid_group& grid, int layer, int wv) {
    unsigned char* ws = A.ws;
    const bf16_t* H = (const bf16_t*)(ws + WS_H); bf16_t* U = (bf16_t*)(ws + WS_H);
    bf16_t* Q = (bf16_t*)(ws + WS_SCR + A_Q); bf16_t* Kb = (bf16_t*)(ws + WS_SCR + A_K); bf16_t* Vb = (bf16_t*)(ws + WS_SCR + A_V); bf16_t* SZ = (bf16_t*)(ws + WS_SCR + A_SZ);
    norm_phase(A, layer, false, wv);
    grid.sync();
    {
        DescPlain D; D.init(H, (const bf16_t*)(ws + WS_WAI), 20, false);
        auto E = [=](const pg8::Unit& u, int row_l, int col_l, f32x4 v0, f32x4 v1) {
            const size_t row = (size_t)u.i0 * 256 + row_l; const int pn = u.i1;
            if (pn < 8) st_bf16x8(Q + row * 2048 + pn * 256 + col_l, v0, v1);
            else if (pn < 10) st_bf16x8(Kb + row * 512 + (pn - 8) * 256 + col_l, v0, v1);
            else if (pn < 12) st_bf16x8(Vb + row * 512 + (pn - 10) * 256 + col_l, v0, v1);
            else { f32x4 a, b;
#pragma unroll
                for (int q = 0; q < 4; ++q) { a[q] = siluf(v0[q]); b[q] = siluf(v1[q]); }
                st_bf16x8(SZ + row * 2048 + (pn - 12) * 256 + col_l, a, b); }
        };
        pg8::gemm_phase(lds, D, E, wv);
    }
    grid.sync();
    qknorm_phase(A, wv);
    grid.sync();
    {
        const int G = gridDim.x, c = blockIdx.x;
        for (long L = c; L < 2048; L += G) {
            const int u = pg8::xcd_remap((int)L, 2048);
            const int b = u / 128, rem = u % 128, kvh = rem / 32, g = (rem / 8) % 4, qb = rem % 8, h = kvh * 4 + g;
            const size_t qoff = ((size_t)b * TB + qb * 256) * 2048 + h * 128, koff = ((size_t)b * TB) * 512 + kvh * 128;
            att::attn_dense_body(Q + qoff, Kb + koff, Vb + koff, SZ + qoff, U + qoff, TB, lds_gen, wv);
        }
        for (int u = c; u < 256; u += G) {
            const int b = u / 16, h = u % 16, kvh = h / 4;
            const size_t qoff = ((size_t)b * TB + TL) * 2048 + h * 128, koff = ((size_t)b * TB + TL) * 512 + kvh * 128;
            att::attn_dense_body(Q + qoff, Kb + koff, Vb + koff, SZ + qoff, U + qoff, TC, lds_gen, wv);
        }
    }
    grid.sync();
    {
        DescPlain D; D.init(U, (const bf16_t*)(ws + WS_WAO), 8, false);
        const float* modl = (const float*)(ws + WS_MOD) + (size_t)layer * 17 * MOD_LD;
        auto E = [=](const pg8::Unit& u, int row_l, int col_l, f32x4 v0, f32x4 v1) { resid_store(A, layer, u.i0, row_l, u.i1 * 256 + col_l, modl, v0, v1); };
        pg8::gemm_phase(lds, D, E, wv);
    }
    grid.sync();
}


struct DescKVT {
    const bf16_t* WB; const bf16_t* H; int lda, ldb, K, total;
    DI void init(const bf16_t* WB_, const bf16_t* H_) { WB = WB_; H = H_; lda = DM; ldb = DM; K = DM; total = 12 * 144; }
    DI pg8::Unit unit(int idx) const { const int mt = idx % 12, nt = idx / 12; pg8::Unit u; u.a = (const char*)(WB + (size_t)mt * 256 * DM); u.b = (const char*)(H + (size_t)nt * 256 * DM); u.i0 = mt; u.i1 = nt; u.i2 = 0; return u; }
};
namespace ml {
#define MFMA32(a, b, c) __builtin_amdgcn_mfma_f32_32x32x16_bf16((a), (b), (c), 0, 0, 0)
#define LFENCE() asm volatile("s_waitcnt lgkmcnt(0)" ::: "memory")
DI int crow(int reg, int h) { return (reg & 3) + 8 * (reg >> 2) + 4 * h; }
DI bf16x8 ldperm(const bf16_t* p) { const s16x4 lo = *(const s16x4*)p, hi = *(const s16x4*)(p + 8); return __builtin_shufflevector(lo, hi, 0, 1, 2, 3, 4, 5, 6, 7); }
DI bf16x8 pack_step(const f32x16& x, int s) { u32x4 p = {pk2(x[8 * s], x[8 * s + 1]), pk2(x[8 * s + 2], x[8 * s + 3]), pk2(x[8 * s + 4], x[8 * s + 5]), pk2(x[8 * s + 6], x[8 * s + 7])}; return __builtin_bit_cast(bf16x8, p); }
DI float bfs(short h) { return __uint_as_float(((unsigned)(unsigned short)h) << 16); }

constexpr int SC_Q = 0, SC_K = 16384, SC_KT = 32768, SC_BUF = 49152, SC_WAVE = 2 * SC_BUF, SC_WAVE_BYTES = 6144;
DI bf16x8 ldsfrag(const LAS unsigned char* buf, unsigned o) { const s16x4 lo = *(const LAS s16x4*)(buf + o), hi = *(const LAS s16x4*)(buf + (o ^ 16u)); return __builtin_shufflevector(lo, hi, 0, 1, 2, 3, 4, 5, 6, 7); }
DI void scan_phase(const Args& A, LAS unsigned char* lds, int wv) {
    const int wave = wv;
    LAS float* wl = (LAS float*)(lds + SC_WAVE + wave * SC_WAVE_BYTES);
    LAS unsigned char* hst = lds + SC_WAVE + wave * SC_WAVE_BYTES + 2048;
    unsigned char* ws = A.ws;
    const bf16_t* Qg = (const bf16_t*)(ws + WS_SCR + M_Q); const bf16_t* Kg = (const bf16_t*)(ws + WS_SCR + M_K); const bf16_t* KVT = (const bf16_t*)(ws + WS_SCR + M_KVT);
    const float* G32 = (const float*)(ws + WS_SCR + M_G32); const float* bg = A.in[10];
#define SC_POS0(j) (dir == 0 ? ((j) < 4 ? TL + 64 * (j) : 64 * ((j) - 4)) : ((j) < 4 ? TL + 64 * (3 - (j)) : 64 * (35 - (j))))
#define SC_DMA(bufi, p0) do { const int tj_ = otid(wv); _Pragma("unroll") for (int i_ = 0; i_ < 2; ++i_) { const int sl_ = i_ * 512 + tj_; \
        { const int row_ = sl_ >> 4, c_ = (sl_ & 15) ^ (row_ & 15); const size_t go_ = (size_t)((p0) + row_) * 1024 + c_ * 8; \
          __builtin_amdgcn_global_load_lds((const unsigned*)(Qu + go_), (LAS unsigned*)(lds + (bufi) * SC_BUF + SC_Q + i_ * 8192 + wave * 1024), 16, 0, 0); \
          __builtin_amdgcn_global_load_lds((const unsigned*)(Ku + go_), (LAS unsigned*)(lds + (bufi) * SC_BUF + SC_K + i_ * 8192 + wave * 1024), 16, 0, 0); } \
        { const int d_ = sl_ >> 3, c_ = (sl_ & 7) ^ ((d_ >> 1) & 7); \
          __builtin_amdgcn_global_load_lds((const unsigned*)(KTu + (size_t)d_ * TB + (p0) + c_ * 8), (LAS unsigned*)(lds + (bufi) * SC_BUF + SC_KT + i_ * 8192 + wave * 1024), 16, 0, 0); } } } while (0)
    for (int item = blockIdx.x; item < 256; item += gridDim.x) {
        const int dir = item & 1, h = (item >> 1) & 7, b = item >> 4, e0 = wave * 32;
        const bf16_t* Qu = Qg + (size_t)b * TB * 1024 + h * 128;
        const bf16_t* Ku = Kg + (size_t)b * TB * 1024 + h * 128;
        const bf16_t* KTu = KVT + ((size_t)b * 3072 + h * 128) * TB;
        const bf16_t* VTu = KVT + ((size_t)b * 3072 + 1024 + h * 256 + e0) * TB;
        bf16_t* Hout = (bf16_t*)(ws + WS_SCR + (dir ? M_HB : M_HF)) + (size_t)b * TB * DM + h * 256 + e0;
        const float big = bg[(dir * 2) * 8 + h], bfg = bg[(dir * 2 + 1) * 8 + h];
        f32x16 cacc[4];
#pragma unroll
        for (int d = 0; d < 4; ++d)
#pragma unroll
            for (int i = 0; i < 16; ++i) cacc[d][i] = 0.f;
        float m = 0.f;
        { const int l0 = otid(wv) & 63; wl[384 + l0] = 0.f; wl[448 + l0] = 0.f; }
        LFENCE();
        SC_DMA(0, SC_POS0(0));
        for (int j = 0; j < 36; ++j) {
            const int pos0 = SC_POS0(j);
            const LAS unsigned char* Qb = lds + (j & 1) * SC_BUF + SC_Q; const LAS unsigned char* Kb = lds + (j & 1) * SC_BUF + SC_K; const LAS unsigned char* KTb = lds + (j & 1) * SC_BUF + SC_KT;
            asm volatile("s_waitcnt vmcnt(0)" ::: "memory"); __builtin_amdgcn_s_barrier(); asm volatile("" ::: "memory");
            if (j + 1 < 36) SC_DMA((j + 1) & 1, SC_POS0(j + 1));
            const int lj = otid(wv) & 63, rj = lj & 31, h4 = (lj >> 5) * 4;
            LAS float* wh = wl + h4; LAS float* wr = wl + rj; LAS unsigned char* hb = hst + h4 * 64 + rj * 2;
            const unsigned xr = rj & 15, xd = (rj >> 1) & 7;
            const unsigned qro = (unsigned)rj * 256u + 2u * h4;
            const unsigned kro = (unsigned)rj * 128u + 2u * h4;
            const bf16_t* VTp = VTu + (size_t)rj * TB + pos0 + h4;
            bf16x8 vf[4];
#pragma unroll
            for (int kk = 0; kk < 4; ++kk) vf[kk] = ldperm(VTp + 16 * kk);
            float decay, m_new;
            {
                const int s = dir ? 63 - lj : lj;
                const float* gp = G32 + (size_t)(b * TB + pos0 + s) * 32;
                const float ig = gp[(dir * 2) * 8 + h] + big, fg = gp[(dir * 2 + 1) * 8 + h] + bfg;
                const float lf = fminf(fg, 0.f) - log1pf(__expf(-fabsf(fg)));
                float bs = lf;
#pragma unroll
                for (int o = 1; o < 64; o <<= 1) { const float t = __shfl_up(bs, o); if (lj >= o) bs += t; }
                const float uu = ig - bs;
                float pmx = uu;
#pragma unroll
                for (int o = 1; o < 64; o <<= 1) { const float t = __shfl_up(pmx, o); if (lj >= o) pmx = fmaxf(pmx, t); }
                pmx = fmaxf(pmx, m);
                const float b_end = __shfl(bs, 63), pm_last = __shfl(pmx, 63);
                LAS float* ws_ = wl + s;
                ws_[0] = uu; ws_[64] = pmx; ws_[128] = __expf(m - pmx); ws_[192] = __expf(-(bs + pmx)); ws_[256] = __expf(uu - pm_last);
                decay = __expf(m - pm_last); m_new = b_end + pm_last;
            }
            LFENCE();
            const int sbase = dir ? 63 - h4 : h4, sgn = dir ? -1 : 1;
#pragma unroll
            for (int tb = 0; tb < 2; ++tb) {
                __builtin_amdgcn_sched_barrier(0);
                const unsigned qo = qro + tb * 8192u;
                f32x16 ha;
#pragma unroll
                for (int i = 0; i < 16; ++i) ha[i] = 0.f;
                float qnv = 0.f;
#pragma unroll
                for (int kk = 0; kk < 8; ++kk) {
                    const bf16x8 qa = ldsfrag(Qb, qo + (((2u * kk) ^ xr) << 4));
                    ha = MFMA32(qa, pack_step(cacc[kk >> 1], kk & 1), ha);
                    const f32x4 n0 = *(const LAS f32x4*)(wh + 384 + 16 * kk), n1 = *(const LAS f32x4*)(wh + 384 + 16 * kk + 8);
#pragma unroll
                    for (int jj = 0; jj < 4; ++jj) qnv += bfs(qa[jj]) * n0[jj] + bfs(qa[4 + jj]) * n1[jj];
                }
                qnv += __shfl_xor(qnv, 32);
#pragma unroll
                for (int i = 0; i < 16; ++i) ha[i] *= wh[128 + 32 * tb + (i & 3) + 8 * (i >> 2)];
                const float pmt = wr[64 + 32 * tb];
                const int tp = dir ? (63 - 32 * tb) - rj : 32 * tb + rj;
                float ds = 0.f;
#pragma unroll
                for (int sb = 0; sb < 2; ++sb) {
                    __builtin_amdgcn_sched_barrier(0);
                    const unsigned ko = qro + sb * 8192u;
                    f32x16 st;
#pragma unroll
                    for (int i = 0; i < 16; ++i) st[i] = 0.f;
#pragma unroll
                    for (int kk = 0; kk < 8; ++kk) { const unsigned c = ((2u * kk) ^ xr) << 4; st = MFMA32(ldsfrag(Kb, ko + c), ldsfrag(Qb, qo + c), st); }
#pragma unroll
                    for (int i = 0; i < 16; ++i) {
                        const int sc = 32 * sb + (i & 3) + 8 * (i >> 2);
                        const int sp = sbase + sgn * sc;
                        st[i] *= __expf((sp <= tp) ? wh[sc] - pmt : -1e30f);
                        ds += st[i];
                    }
                    ha = MFMA32(pack_step(st, 0), vf[2 * sb], ha);
                    ha = MFMA32(pack_step(st, 1), vf[2 * sb + 1], ha);
                }
                ds += __shfl_xor(ds, 32);
                {
                    const float den = wr[128 + 32 * tb] * qnv + ds;
                    const float rd = 1.0f / fmaxf(fabsf(den), wr[192 + 32 * tb]);
                    if (h4 == 0) wr[320 + 32 * tb] = rd;
                }
                LFENCE();
#pragma unroll
                for (int i = 0; i < 16; ++i) { const int tc = 32 * tb + (i & 3) + 8 * (i >> 2);
                    *(LAS unsigned short*)(hb + tc * 64) = (unsigned short)(pk2(ha[i] * wh[320 + tc], 0.f) & 0xffffu); }
            }
            LFENCE();
            {
                bf16_t* hp = Hout + (size_t)(pos0 + lj) * DM;
                const LAS unsigned char* hrow = hst + lj * 64;
#pragma unroll
                for (int q = 0; q < 4; ++q) *(u32x4*)(hp + 8 * q) = *(const LAS u32x4*)(hrow + 16 * q);
            }
            __builtin_amdgcn_sched_barrier(0);
#pragma unroll
            for (int db = 0; db < 4; ++db) {
                if (db == 2) __builtin_amdgcn_sched_barrier(0);
#pragma unroll
                for (int i = 0; i < 16; ++i) cacc[db][i] *= decay;
                const unsigned to = kro + db * 4096u;
                float nadd = 0.f;
#pragma unroll
                for (int kk = 0; kk < 4; ++kk) {
                    const bf16x8 kv = ldsfrag(KTb, to + (((2u * kk) ^ xd) << 4));
                    const f32x4 w0 = *(const LAS f32x4*)(wh + 256 + 16 * kk), w1 = *(const LAS f32x4*)(wh + 256 + 16 * kk + 8);
                    float f[8];
#pragma unroll
                    for (int jj = 0; jj < 4; ++jj) { f[jj] = bfs(kv[jj]) * w0[jj]; f[4 + jj] = bfs(kv[4 + jj]) * w1[jj]; }
#pragma unroll
                    for (int jj = 0; jj < 8; ++jj) nadd += f[jj];
                    u32x4 p = {pk2(f[0], f[1]), pk2(f[2], f[3]), pk2(f[4], f[5]), pk2(f[6], f[7])};
                    cacc[db] = MFMA32(__builtin_bit_cast(bf16x8, p), vf[kk], cacc[db]);
                }
                nadd += __shfl_xor(nadd, 32);
                if (h4 == 0) wr[384 + 32 * db] = decay * wr[384 + 32 * db] + nadd;
            }
            LFENCE();
            m = m_new;
        }
        asm volatile("s_waitcnt vmcnt(0)" ::: "memory"); __builtin_amdgcn_s_barrier();
    }
#undef SC_DMA
#undef SC_POS0
}
#undef MFMA32
#undef LFENCE
}

DI void mlstm_finish_phase(const Args& A, int wv) {
    const int tid = otid(wv), lane = tid & 63, wave = tid >> 6, G = gridDim.x;
    unsigned char* ws = A.ws;
    const bf16_t* HF = (const bf16_t*)(ws + WS_SCR + M_HF); const bf16_t* HB = (const bf16_t*)(ws + WS_SCR + M_HB);
    const bf16_t* SO = (const bf16_t*)(ws + WS_SCR + M_SO); const bf16_t* SZ = (const bf16_t*)(ws + WS_SCR + M_SZ);
    bf16_t* U = (bf16_t*)(ws + WS_H); const float* hn = A.in[11];
    const int sub = lane >> 5, e0 = (lane & 31) * 8;
    const long NIT = (long)NTOK * 8;
    for (long it = ((long)blockIdx.x * NWAVES + wave) * 2 + sub; it < NIT; it += (long)G * NWAVES * 2) {
        const size_t off = (size_t)(it >> 3) * DM + (int)(it & 7) * 256 + e0;
        f32x4 f0, f1, b0, b1, o0, o1, z0, z1;
        ld_bf16x8(HF + off, f0, f1); ld_bf16x8(HB + off, b0, b1); ld_bf16x8(SO + off, o0, o1); ld_bf16x8(SZ + off, z0, z1);
        f32x4 y0 = o0 * (f0 + b0), y1 = o1 * (f1 + b1);
        float ss = 0.f;
#pragma unroll
        for (int q = 0; q < 4; ++q) ss += y0[q] * y0[q] + y1[q] * y1[q];
        ss += __shfl_xor(ss, 1); ss += __shfl_xor(ss, 2); ss += __shfl_xor(ss, 4); ss += __shfl_xor(ss, 8); ss += __shfl_xor(ss, 16);
        const float rs = 1.0f / sqrtf(ss * (1.f / 256.f) + EPS);
        const float* hp = hn + (int)(it & 7) * 256 + e0;
        const f32x4 h0 = *(const f32x4*)hp, h1 = *(const f32x4*)(hp + 4);
        st_bf16x8(U + off, y0 * rs * h0 * z0, y1 * rs * h1 * z1);
    }
}

DI void mlstm_layer(const Args& A, LAS unsigned char* lds, cg::grid_group& grid, int layer, int wv) {
    unsigned char* ws = A.ws;
    const bf16_t* H = (const bf16_t*)(ws + WS_H); bf16_t* U = (bf16_t*)(ws + WS_H);
    bf16_t* Q = (bf16_t*)(ws + WS_SCR + M_Q); bf16_t* Kb = (bf16_t*)(ws + WS_SCR + M_K); bf16_t* KVT = (bf16_t*)(ws + WS_SCR + M_KVT);
    float* G32 = (float*)(ws + WS_SCR + M_G32); bf16_t* SO = (bf16_t*)(ws + WS_SCR + M_SO); bf16_t* SZ = (bf16_t*)(ws + WS_SCR + M_SZ);
    norm_phase(A, layer, false, wv);
    grid.sync();
    {
        DescPlain D; D.init(H, (const bf16_t*)(ws + WS_WMA), 9, false);
        auto E = [=](const pg8::Unit& u, int row_l, int col_l, f32x4 v0, f32x4 v1) {
            const size_t row = (size_t)u.i0 * 256 + row_l; const int pn = u.i1;
            if (pn < 4) st_bf16x8(Q + row * 1024 + pn * 256 + col_l, v0 * 0.088388347648318440f, v1 * 0.088388347648318440f);
            else if (pn < 8) st_bf16x8(Kb + row * 1024 + (pn - 4) * 256 + col_l, v0, v1);
            else if (col_l < 32) { *(f32x4*)(G32 + row * 32 + col_l) = v0; *(f32x4*)(G32 + row * 32 + col_l + 4) = v1; }
        };
        pg8::gemm_phase(lds, D, E, wv);
    }
    {
        DescKVT D; D.init((const bf16_t*)(ws + WS_WMB), H);
        auto E = [=](const pg8::Unit& u, int row_l, int col_l, f32x4 v0, f32x4 v1) {
            const int bb = u.i1 / 9, s0 = (u.i1 % 9) * 256;
            st_bf16x8(KVT + ((size_t)bb * 3072 + u.i0 * 256 + row_l) * TB + s0 + col_l, v0, v1);
        };
        pg8::gemm_phase(lds, D, E, wv);
    }
    grid.sync();
    ml::scan_phase(A, lds, wv);
    grid.sync();
    {
        DescPlain D; D.init(H, (const bf16_t*)(ws + WS_WMA) + (size_t)2304 * DM, 16, false);
        auto E = [=](const pg8::Unit& u, int row_l, int col_l, f32x4 v0, f32x4 v1) {
            const size_t row = (size_t)u.i0 * 256 + row_l; const int pn = u.i1; f32x4 a, b;
            if (pn < 8) {
#pragma unroll
                for (int q = 0; q < 4; ++q) { a[q] = sigmf(v0[q]); b[q] = sigmf(v1[q]); }
                st_bf16x8(SO + row * DM + pn * 256 + col_l, a, b);
            } else {
#pragma unroll
                for (int q = 0; q < 4; ++q) { a[q] = siluf(v0[q]); b[q] = siluf(v1[q]); }
                st_bf16x8(SZ + row * DM + (pn - 8) * 256 + col_l, a, b);
            }
        };
        pg8::gemm_phase(lds, D, E, wv);
    }
    grid.sync();
    mlstm_finish_phase(A, wv);
    grid.sync();
    {
        DescPlain D; D.init(U, (const bf16_t*)(ws + WS_WMO), 8, false);
        const float* modl = (const float*)(ws + WS_MOD) + (size_t)layer * 17 * MOD_LD;
        auto E = [=](const pg8::Unit& u, int row_l, int col_l, f32x4 v0, f32x4 v1) { resid_store(A, layer, u.i0, row_l, u.i1 * 256 + col_l, modl, v0, v1); };
        pg8::gemm_phase(lds, D, E, wv);
    }
    grid.sync();
}

__global__ void __launch_bounds__(NTHREADS, 2) fwd_megakernel(Args A) {
    extern __shared__ __attribute__((aligned(16))) unsigned char lds_raw[];
    LAS unsigned char* lds = (LAS unsigned char*)lds_raw;
    cg::grid_group grid = cg::this_grid();
    const int wv = __builtin_amdgcn_readfirstlane(threadIdx.x >> 6);
    prep_phase(A, lds, wv);
    grid.sync();
    fnet_layer(A, lds, grid, 0, 0, false, wv);
    mlstm_layer(A, lds, grid, 1, wv);
    attn_layer(A, lds, (char*)lds_raw, grid, 2, wv);
    fnet_layer(A, lds, grid, 3, 1, true, wv);
    final_norm_phase(A, nullptr, wv);
}

extern "C" void kernel_launch(void* const* d_in, const int* in_sizes, int n_in, void* d_out, int out_size, void* d_ws, size_t ws_size, hipStream_t stream) {
    static int grid = 0;
    if (grid == 0) {
        if (n_in != 18 || ws_size < WS_END) { fprintf(stderr, "kernel_launch: unexpected n_in %d / ws_size %zu (need %zu)\n", n_in, ws_size, (size_t)WS_END); grid = -1; return; }
        int dev = 0, cus = 0, per_cu = 0;
        hipGetDevice(&dev);
        hipDeviceGetAttribute(&cus, hipDeviceAttributeMultiprocessorCount, dev);
        if (hipFuncSetAttribute((const void*)fwd_megakernel, hipFuncAttributeMaxDynamicSharedMemorySize, LDS_BYTES) != hipSuccess) { fprintf(stderr, "kernel_launch: hipFuncSetAttribute failed\n"); grid = -1; return; }
        if (hipOccupancyMaxActiveBlocksPerMultiprocessor(&per_cu, (const void*)fwd_megakernel, NTHREADS, LDS_BYTES) != hipSuccess || per_cu < 1) { fprintf(stderr, "kernel_launch: occupancy query failed (%d)\n", per_cu); per_cu = 1; }
        (void)hipGetLastError();
        grid = cus * per_cu;
        fprintf(stderr, "kernel_launch: grid %d (cus %d x %d)\n", grid, cus, per_cu);
    }
    if (grid < 0) return;
    hipMemsetAsync((char*)d_ws + WS_MOD, 0, MOD_BYTES, stream);
    Args a{};
    for (int i = 0; i < 18; ++i) a.in[i] = (const float*)d_in[i];
    a.out = (float*)d_out; a.ws = (unsigned char*)d_ws; a.ph_lo = 0; a.ph_hi = 100;
    void* args[] = {&a};
    hipError_t e = hipLaunchCooperativeKernel((const void*)fwd_megakernel, dim3(grid), dim3(NTHREADS), args, LDS_BYTES, stream);
    if (e != hipSuccess) fprintf(stderr, "kernel_launch: cooperative launch failed: %s (grid %d)\n", hipGetErrorString(e), grid);
}
```

```cpp
#include <hip/hip_runtime.h>
#include <hip/hip_cooperative_groups.h>
#include <cstdio>
#include <cstdint>
namespace cg = cooperative_groups;

#define LAS __attribute__((address_space(3)))
#define DI __device__ __forceinline__
typedef unsigned short bf16_t;
typedef short bf16x8 __attribute__((ext_vector_type(8)));
typedef short s16x4 __attribute__((ext_vector_type(4)));
typedef float f32x2 __attribute__((ext_vector_type(2)));
typedef float f32x4 __attribute__((ext_vector_type(4)));
typedef float f32x16 __attribute__((ext_vector_type(16)));
typedef unsigned u32x2 __attribute__((ext_vector_type(2)));
typedef unsigned u32x4 __attribute__((ext_vector_type(4)));
typedef __bf16 bf16v2 __attribute__((ext_vector_type(2)));

constexpr int DM = 2048, NB = 16, TL = 2048, TC = 256, TB = TL + TC, NTOK = NB * TB;
constexpr int NWAVES = 8, NTHREADS = 512;
constexpr float EPS = 1e-6f;
constexpr int MOD_LD = 3 * DM;
constexpr int M_WA_ROWS = 6400, M_WB_ROWS = 3072;
constexpr size_t MiB = 1u << 20;
constexpr size_t WS_MOD = 0;
constexpr size_t MOD_BYTES = (size_t)4 * 17 * MOD_LD * 4;
constexpr size_t WS_WFG = 2 * MiB, WS_WFO = 18 * MiB, WS_WMA = 34 * MiB, WS_WMB = 59 * MiB, WS_WMO = 71 * MiB, WS_WAI = 79 * MiB, WS_WAO = 99 * MiB;
constexpr size_t WS_DC = 107 * MiB, WS_DT = 108 * MiB, WS_DT2 = 124 * MiB, WS_CTXS = 125 * MiB, WS_H = 157 * MiB, WS_SCR = 301 * MiB;
constexpr size_t WS_END = 1024 * MiB;
constexpr size_t F_G = 0, F_PQX = 144 * MiB, F_PQC = 400 * MiB, F_A1 = 432 * MiB, F_NYQ = 496 * MiB;
constexpr size_t M_Q = 0, M_K = 72 * MiB, M_KVT = 144 * MiB, M_G32 = 360 * MiB, M_HF = 365 * MiB, M_HB = 509 * MiB, M_SO = 0, M_SZ = 144 * MiB;
constexpr size_t A_Q = 0, A_K = 144 * MiB, A_V = 180 * MiB, A_SZ = 216 * MiB;
static_assert(WS_SCR + M_HB + 144 * MiB <= WS_END, "ws map");
constexpr int LDS_BYTES = 147456 + 1024;

DI unsigned pk2(float a, float b) { f32x2 v = {a, b}; return __builtin_bit_cast(unsigned, __builtin_convertvector(v, bf16v2)); }
DI float bf_lo(unsigned w) { return __uint_as_float(w << 16); }
DI float bf_hi(unsigned w) { return __uint_as_float(w & 0xffff0000u); }
DI float wave_sum(float v) {
#pragma unroll
    for (int o = 1; o < 64; o <<= 1) v += __shfl_xor(v, o);
    return v;
}
DI int otid(int wv) { int t; asm volatile("v_mbcnt_lo_u32_b32 %0, -1, 0\n\tv_mbcnt_hi_u32_b32 %0, -1, %0" : "=v"(t)); return wv * 64 + t; }
DI float siluf(float x) { return x / (1.f + __expf(-x)); }
DI float sigmf(float x) { return 1.f / (1.f + __expf(-x)); }
DI void st_bf16x8(bf16_t* p, f32x4 a, f32x4 b) { u32x4 w = {pk2(a[0], a[1]), pk2(a[2], a[3]), pk2(b[0], b[1]), pk2(b[2], b[3])}; *(u32x4*)p = w; }
DI void ld_bf16x8(const bf16_t* p, f32x4& a, f32x4& b) { const u32x4 w = *(const u32x4*)p; a = (f32x4){bf_lo(w.x), bf_hi(w.x), bf_lo(w.y), bf_hi(w.y)}; b = (f32x4){bf_lo(w.z), bf_hi(w.z), bf_lo(w.w), bf_hi(w.w)}; }

struct Args { const float* in[18]; float* out; unsigned char* ws; int ph_lo, ph_hi; };

namespace pg8 {
constexpr int BM = 256, BK = 64, HALF = 128, HTB = HALF * BK * 2, NXCD = 8;
DI int lds_byte(int r, int c) { const int st = (r >> 4) * 2 + (c >> 5), rr = r & 15, cc = c & 31, ob = rr * 64 + cc * 2; return st * 1024 + (ob ^ (((ob >> 9) & 1) << 5)); }
DI void stage_rc(int b, int& R, int& C) { const int st = b / 1024, sb = b % 1024, swz = sb ^ (((sb >> 9) & 1) << 5); R = (st >> 1) * 16 + swz / 64; C = (st & 1) * 32 + (swz % 64) / 2; }
DI int perm32(int rho) { const int n = rho >> 4, i = rho & 15; return 8 * (i >> 2) + 4 * n + (i & 3); }
struct Unit { const char* a; const char* b; int i0, i1, i2; };
DI int xcd_remap(int L, int total) { const int q = total / NXCD, r = total % NXCD, xcd = L % NXCD, off = L / NXCD; return (xcd < r ? xcd * (q + 1) : r * (q + 1) + (xcd - r) * q) + off; }

template <class Desc, class Epi>
DI void gemm_phase(LAS unsigned char* lds, const Desc& D, const Epi& E, int wv) {
    const int tid = otid(wv), wid = __builtin_amdgcn_readfirstlane(tid >> 6), lane = tid & 63, wr = wid >> 2, wc = wid & 3, fr = lane & 15, fq = lane >> 4;
    const int G = gridDim.x, c = blockIdx.x, total = D.total;
    const int K = D.K, nt = K / BK;
    unsigned voffA[2], voffB[2];
#pragma unroll
    for (int i = 0; i < 2; ++i) { int R, C; stage_rc(tid * 16 + i * 8192, R, C); const int Rb = (R & ~31) + perm32(R & 31);
        voffA[i] = (unsigned)(R * D.lda + C) * 2u; voffB[i] = (unsigned)(Rb * D.ldb + C) * 2u; }
    const size_t kstep = (size_t)(BK * 2);
    const size_t hstepA = (size_t)HALF * D.lda * 2, hstepB = (size_t)HALF * D.ldb * 2;
    const unsigned ldsw = (unsigned)wid * 1024u;
    const int aoff = lds_byte(wr * 64 + fr, fq * 8), boff = lds_byte(wc * 32 + fr, fq * 8);
#define PG8_SA(b, h) (((b) * 2 + (h)) * HTB)
#define PG8_SB(b, h) ((4 + (b) * 2 + (h)) * HTB)
#define PG8_STAGE(bufoff, gbase, voff) do { _Pragma("unroll") for (int _i = 0; _i < 2; ++_i) \
        __builtin_amdgcn_global_load_lds((const unsigned*)((const char*)(gbase) + (voff)[_i]), (LAS unsigned*)(lds + (bufoff) + ldsw + _i * 8192), 16, 0, 0); } while (0)
#define PG8_LDA(dst, b, h) do { _Pragma("unroll") for (int m = 0; m < 4; ++m) _Pragma("unroll") for (int k = 0; k < 2; ++k) dst[m][k] = *(const LAS bf16x8*)(lds + PG8_SA(b, h) + aoff + m * 2048 + k * 1024); } while (0)
#define PG8_LDB(dst, b, h) do { _Pragma("unroll") for (int n = 0; n < 2; ++n) _Pragma("unroll") for (int k = 0; k < 2; ++k) dst[n][k] = *(const LAS bf16x8*)(lds + PG8_SB(b, h) + boff + n * 2048 + k * 1024); } while (0)
#define PG8_MMA(ai, bj, At, Bt) do { __builtin_amdgcn_s_setprio(1); _Pragma("unroll") for (int m = 0; m < 4; ++m) _Pragma("unroll") for (int n = 0; n < 2; ++n) _Pragma("unroll") for (int k = 0; k < 2; ++k) \
        acc[ai][bj][m][n] = __builtin_amdgcn_mfma_f32_16x16x32_bf16(Bt[n][k], At[m][k], acc[ai][bj][m][n], 0, 0, 0); __builtin_amdgcn_s_setprio(0); } while (0)
#define PG8_WAIT_V(n) asm volatile("s_waitcnt vmcnt(" #n ")" ::: "memory")
#define PG8_WAIT_L(n) asm volatile("s_waitcnt lgkmcnt(" #n ")" ::: "memory")
#define PG8_BAR __builtin_amdgcn_s_barrier()
#define PG8_SCHED __builtin_amdgcn_sched_barrier(0)
    if (c >= total) return;
    Unit cur = D.unit(xcd_remap(c, total)), nxt = cur; int ui = 0;
    f32x4 acc[2][2][4][2];
#pragma unroll
    for (int a = 0; a < 2; ++a)
#pragma unroll
        for (int b = 0; b < 2; ++b)
#pragma unroll
            for (int m = 0; m < 4; ++m)
#pragma unroll
                for (int n = 0; n < 2; ++n) acc[a][b][m][n] = (f32x4){0.f, 0.f, 0.f, 0.f};
    bf16x8 At[4][2], B0[2][2], B1[2][2];
    const char* cA = cur.a; const char* cB = cur.b;
    PG8_STAGE(PG8_SB(0, 0), cB, voffB); PG8_STAGE(PG8_SB(0, 1), cB + hstepB, voffB); PG8_STAGE(PG8_SA(0, 0), cA, voffA); PG8_STAGE(PG8_SA(0, 1), cA + hstepA, voffA);
    if (wr == 1) PG8_BAR;
    PG8_WAIT_V(2); PG8_BAR;
    PG8_STAGE(PG8_SB(1, 0), cB + kstep, voffB); PG8_STAGE(PG8_SA(1, 0), cA + kstep, voffA); PG8_STAGE(PG8_SB(1, 1), cB + hstepB + kstep, voffB);
    PG8_WAIT_V(6); PG8_BAR;
    for (;;) {
        const long Ln = (long)(ui + 1) * G + c;
        const bool has_next = Ln < total;
        if (has_next) nxt = D.unit(xcd_remap((int)Ln, total));
        const char* nA = has_next ? nxt.a : cA; const char* nB = has_next ? nxt.b : cB;
        for (int t = 0; t < nt; t += 2) {
            const bool last = (t == nt - 2);
            const char* a1 = cA + (size_t)(t + 1) * kstep;
            const char* a2 = last ? nA : cA + (size_t)(t + 2) * kstep; const char* b2 = last ? nB : cB + (size_t)(t + 2) * kstep;
            const char* a3 = a2 + kstep; const char* b3 = b2 + kstep;
            PG8_LDB(B0, 0, 0); PG8_LDB(B1, 0, 1); PG8_SCHED; PG8_LDA(At, 0, 0); PG8_STAGE(PG8_SA(1, 1), a1 + hstepA, voffA);
            PG8_WAIT_V(8); PG8_WAIT_L(0); PG8_BAR; PG8_MMA(0, 0, At, B0); PG8_MMA(0, 1, At, B1); PG8_BAR; PG8_SCHED;
            PG8_LDA(At, 0, 1); PG8_STAGE(PG8_SB(0, 0), b2, voffB); PG8_STAGE(PG8_SB(0, 1), b2 + hstepB, voffB); PG8_STAGE(PG8_SA(0, 0), a2, voffA);
            PG8_WAIT_V(8); PG8_WAIT_L(0); PG8_BAR; PG8_MMA(1, 0, At, B0); PG8_MMA(1, 1, At, B1); PG8_BAR; PG8_SCHED;
            PG8_LDB(B0, 1, 0); PG8_LDB(B1, 1, 1); PG8_SCHED; PG8_LDA(At, 1, 0); PG8_STAGE(PG8_SA(0, 1), a2 + hstepA, voffA);
            PG8_WAIT_V(8); PG8_WAIT_L(0); PG8_BAR; PG8_MMA(0, 0, At, B0); PG8_MMA(0, 1, At, B1); PG8_BAR; PG8_SCHED;
            PG8_LDA(At, 1, 1); PG8_STAGE(PG8_SB(1, 0), b3, voffB); PG8_STAGE(PG8_SB(1, 1), b3 + hstepB, voffB); PG8_STAGE(PG8_SA(1, 0), a3, voffA);
            PG8_WAIT_V(8); PG8_WAIT_L(0); PG8_BAR; PG8_MMA(1, 0, At, B0); PG8_MMA(1, 1, At, B1); PG8_BAR; PG8_SCHED;
        }
        if (wr == 0) PG8_BAR;
#pragma unroll
        for (int ai = 0; ai < 2; ++ai)
#pragma unroll
            for (int m = 0; m < 4; ++m)
#pragma unroll
                for (int bj = 0; bj < 2; ++bj)
                    E(cur, ai * HALF + wr * 64 + m * 16 + fr, bj * HALF + wc * 32 + 8 * fq, acc[ai][bj][m][0], acc[ai][bj][m][1]);
        if (!has_next) break;
#pragma unroll
        for (int a = 0; a < 2; ++a)
#pragma unroll
            for (int b = 0; b < 2; ++b)
#pragma unroll
                for (int m = 0; m < 4; ++m)
#pragma unroll
                    for (int n = 0; n < 2; ++n) acc[a][b][m][n] = (f32x4){0.f, 0.f, 0.f, 0.f};
        cur = nxt; cA = nA; cB = nB; ++ui;
        if (wr == 1) PG8_BAR;
    }
    PG8_WAIT_V(0);
    PG8_BAR;
#undef PG8_SA
#undef PG8_SB
#undef PG8_STAGE
#undef PG8_LDA
#undef PG8_LDB
#undef PG8_MMA
#undef PG8_WAIT_V
#undef PG8_WAIT_L
#undef PG8_BAR
#undef PG8_SCHED
}
}

DI void transpose_item(const float* W, int N, int kb, int nb, bf16_t* d0, bf16_t* d1, int K, LAS float* scr, int lane) {
    const int k0 = 64 * kb, n0 = 32 * nb;
#pragma unroll 8
    for (int i = 0; i < 32; ++i) { const int kk = 2 * i + (lane >> 5); scr[kk * 33 + (lane & 31)] = W[(size_t)(k0 + kk) * N + n0 + (lane & 31)]; }
    asm volatile("s_waitcnt lgkmcnt(0)" ::: "memory");
    const int c = lane & 7;
#pragma unroll
    for (int j = 0; j < 4; ++j) { const int n = (lane >> 3) + 8 * j; const LAS float* s = scr + (8 * c) * 33 + n;
        u32x4 o; o.x = pk2(s[0 * 33], s[1 * 33]); o.y = pk2(s[2 * 33], s[3 * 33]); o.z = pk2(s[4 * 33], s[5 * 33]); o.w = pk2(s[6 * 33], s[7 * 33]);
        *(u32x4*)(d0 + (size_t)n * K + k0 + 8 * c) = o;
        if (d1) *(u32x4*)(d1 + (size_t)n * K + k0 + 8 * c) = o; }
    asm volatile("s_waitcnt lgkmcnt(0)" ::: "memory");
}

DI void prep_phase(const Args& A, LAS unsigned char* lds, int wv) {
    const int tid = otid(wv), lane = tid & 63, wave = tid >> 6, G = gridDim.x;
    unsigned char* ws = A.ws;
    {
        LAS float* s_lds = (LAS float*)lds;
        const float* cc = A.in[1]; const float* cctx = A.in[3]; const float* aw = A.in[4]; const float* ab = A.in[5];
        float* mod = (float*)(ws + WS_MOD);
        for (int item = blockIdx.x; item < 768; item += G) {
            const int kc = item % 16, cb = (item / 16) % 12, l = item / 192;
            const int k0 = kc * 128, j = cb * 512 + tid;
            __syncthreads();
            for (int e = tid; e < 17 * 128; e += NTHREADS) { const int r = e / 128, k = e % 128; const float v = r < 16 ? cc[r * DM + k0 + k] : cctx[k0 + k]; s_lds[k * 20 + r] = siluf(v); }
            __syncthreads();
            float acc[17];
#pragma unroll
            for (int r = 0; r < 17; ++r) acc[r] = 0.f;
            const float* wp = aw + ((size_t)l * DM + k0) * MOD_LD + j;
#pragma unroll 4
            for (int k = 0; k < 128; ++k) {
                const float w = wp[(size_t)k * MOD_LD];
                const LAS f32x4* sp = (const LAS f32x4*)(s_lds + k * 20);
                const f32x4 s0 = sp[0], s1 = sp[1], s2 = sp[2], s3 = sp[3]; const float s4 = s_lds[k * 20 + 16];
#pragma unroll
                for (int q = 0; q < 4; ++q) { acc[q] += s0[q] * w; acc[4 + q] += s1[q] * w; acc[8 + q] += s2[q] * w; acc[12 + q] += s3[q] * w; }
                acc[16] += s4 * w;
            }
            const float bias = (kc == 0) ? ab[l * MOD_LD + j] : 0.f;
#pragma unroll
            for (int r = 0; r < 17; ++r) unsafeAtomicAdd(&mod[(size_t)(l * 17 + r) * MOD_LD + j], acc[r] + bias);
        }
        __syncthreads();
    }
    {
        LAS float* scr = (LAS float*)(lds + wave * 16384);
        const int gw = blockIdx.x * NWAVES + wave, NGW = G * NWAVES;
        constexpr int I_SQ = 32 * 64, I_AI = 32 * 160, I_MI = 32 * 257;
        constexpr int NIT = 6 * I_SQ + I_AI + I_MI;
        for (int it = gw; it < NIT; it += NGW) {
            int r = it;
            if (r < 6 * I_SQ) {
                const int w = r / I_SQ; r -= w * I_SQ;
                const float* src; bf16_t* dst;
                if (w < 2)      { src = A.in[7] + (size_t)w * DM * DM;       dst = (bf16_t*)(ws + WS_WFG) + (size_t)w * DM * DM; }
                else if (w < 4) { src = A.in[8] + (size_t)(w - 2) * DM * DM; dst = (bf16_t*)(ws + WS_WFO) + (size_t)(w - 2) * DM * DM; }
                else if (w == 4) { src = A.in[12]; dst = (bf16_t*)(ws + WS_WMO); }
                else             { src = A.in[16]; dst = (bf16_t*)(ws + WS_WAO); }
                const int kb = r / 64, nb = r % 64;
                transpose_item(src, DM, kb, nb, dst + (size_t)(32 * nb) * DM, nullptr, DM, scr, lane);
                continue;
            }
            r -= 6 * I_SQ;
            if (r < I_AI) { const int kb = r / 160, nb = r % 160; transpose_item(A.in[13], 5120, kb, nb, (bf16_t*)(ws + WS_WAI) + (size_t)(32 * nb) * DM, nullptr, DM, scr, lane); continue; }
            r -= I_AI;
            {
                const int kb = r / 257, nb = r % 257, n0 = 32 * nb;
                bf16_t* WA = (bf16_t*)(ws + WS_WMA); bf16_t* WB = (bf16_t*)(ws + WS_WMB);
                bf16_t* d0; bf16_t* d1 = nullptr;
                if (n0 < 1024) d0 = WA + (size_t)n0 * DM;
                else if (n0 < 2048) { d0 = WA + (size_t)n0 * DM; d1 = WB + (size_t)(n0 - 1024) * DM; }
                else if (n0 < 4096) d0 = WB + (size_t)(1024 + n0 - 2048) * DM;
                else if (n0 < 6144) d0 = WA + (size_t)(2304 + n0 - 4096) * DM;
                else if (n0 < 6176) d0 = WA + (size_t)(2048 + n0 - 6144) * DM;
                else d0 = WA + (size_t)(4352 + n0 - 6176) * DM;
                transpose_item(A.in[9], 8224, kb, nb, d0, d1, DM, scr, lane);
            }
        }
    }
    {
        const long gt = (long)blockIdx.x * NTHREADS + tid, NGT = (long)G * NTHREADS;
        constexpr long N_DC = 1024L * 512 / 8, N_DT = 2048L * 4096 / 8, N_DT2 = 256L * 512 / 8;
        for (long it = gt; it < N_DC + N_DT + N_DT2; it += NGT) {
            float v[8]; bf16_t* dst;
            if (it < N_DC) {
                const int m = (int)(it / 64), k0 = (int)(it % 64) * 8; const float sc = 0.044194173824159216f;
#pragma unroll
                for (int j = 0; j < 8; ++j) { const int rr = ((m & 511) * (k0 + j)) & 511; const float ang = (float)rr * (1.f / 256.f); v[j] = (m < 512 ? cospif(ang) : sinpif(ang)) * sc; }
                dst = (bf16_t*)(ws + WS_DC) + (size_t)m * 512 + k0;
            } else if (it < N_DC + N_DT) {
                const long i2 = it - N_DC; const int kk = (int)(i2 / 512), s0 = (int)(i2 % 512) * 8; const float sc = 0.022097086912079608f;
#pragma unroll
                for (int j = 0; j < 8; ++j) { const int s = s0 + j; const int rr = (kk * (s & 2047)) & 2047; const float ang = (float)rr * (1.f / 1024.f); v[j] = (s < 2048 ? cospif(ang) : -sinpif(ang)) * sc; }
                dst = (bf16_t*)(ws + WS_DT) + (size_t)kk * 4096 + s0;
            } else {
                const long i2 = it - N_DC - N_DT; const int kk = (int)(i2 / 64), s0 = (int)(i2 % 64) * 8; const float sc = 0.0625f;
#pragma unroll
                for (int j = 0; j < 8; ++j) { const int s = s0 + j; const int rr = (kk * (s & 255)) & 255; const float ang = (float)rr * (1.f / 128.f); v[j] = (s < 256 ? cospif(ang) : -sinpif(ang)) * sc; }
                dst = (bf16_t*)(ws + WS_DT2) + (size_t)kk * 512 + s0;
            }
            u32x4 o = {pk2(v[0], v[1]), pk2(v[2], v[3]), pk2(v[4], v[5]), pk2(v[6], v[7])};
            *(u32x4*)dst = o;
        }
    }
}

DI const float* xrow_ptr(const Args& A, int layer, int r) {
    const int b = r / TB, t = r % TB;
    if (t < TL) return (layer == 0 ? A.in[0] : (const float*)A.out) + ((size_t)b * TL + t) * DM;
    return (layer == 0 ? A.in[2] : (const float*)(A.ws + WS_CTXS)) + ((size_t)b * TC + (t - TL)) * DM;
}
DI void norm_phase(const Args& A, int layer, bool latonly, int wv) {
    const int tid = otid(wv), lane = tid & 63, wave = tid >> 6, G = gridDim.x;
    const float* ng = A.in[6] + (size_t)layer * DM;
    const float* mod = (const float*)(A.ws + WS_MOD) + (size_t)layer * 17 * MOD_LD;
    bf16_t* H = (bf16_t*)(A.ws + WS_H);
    for (int r = blockIdx.x * NWAVES + wave; r < NTOK; r += G * NWAVES) {
        const int b = r / TB, t = r % TB;
        if (latonly && t >= TL) continue;
        const float* xr = xrow_ptr(A, layer, r);
        const float* mr = mod + (size_t)(t < TL ? b : 16) * MOD_LD;
        f32x4 v[4][2]; float ss = 0.f;
#pragma unroll
        for (int j = 0; j < 4; ++j) { const f32x4* p = (const f32x4*)(xr + 512 * j + 8 * lane); v[j][0] = p[0]; v[j][1] = p[1];
#pragma unroll
            for (int q = 0; q < 4; ++q) ss += v[j][0][q] * v[j][0][q] + v[j][1][q] * v[j][1][q]; }
        const float rs = 1.0f / sqrtf(wave_sum(ss) * (1.f / DM) + EPS);
#pragma unroll
        for (int j = 0; j < 4; ++j) { const int c0 = 512 * j + 8 * lane; f32x4 o[2];
#pragma unroll
            for (int h = 0; h < 2; ++h) { const f32x4 g4 = *(const f32x4*)(ng + c0 + 4 * h), sh = *(const f32x4*)(mr + c0 + 4 * h), sc = *(const f32x4*)(mr + DM + c0 + 4 * h);
                o[h] = (v[j][h] * rs) * g4 * (sc + 1.0f) + sh; }
            st_bf16x8(H + (size_t)r * DM + c0, o[0], o[1]); }
    }
}
DI void final_norm_phase(const Args& A, const float* src_override, int wv) {
    const int tid = otid(wv), lane = tid & 63, wave = tid >> 6, G = gridDim.x;
    const float* fg = A.in[17];
    for (int r = blockIdx.x * NWAVES + wave; r < NB * TL; r += G * NWAVES) {
        const float* xr = (src_override ? src_override : (const float*)A.out) + (size_t)r * DM; float* orow = A.out + (size_t)r * DM;
        f32x4 v[4][2]; float ss = 0.f;
#pragma unroll
        for (int j = 0; j < 4; ++j) { const f32x4* p = (const f32x4*)(xr + 512 * j + 8 * lane); v[j][0] = p[0]; v[j][1] = p[1];
#pragma unroll
            for (int q = 0; q < 4; ++q) ss += v[j][0][q] * v[j][0][q] + v[j][1][q] * v[j][1][q]; }
        const float rs = 1.0f / sqrtf(wave_sum(ss) * (1.f / DM) + EPS);
#pragma unroll
        for (int j = 0; j < 4; ++j) { const int c0 = 512 * j + 8 * lane;
#pragma unroll
            for (int h = 0; h < 2; ++h) { const f32x4 g4 = *(const f32x4*)(fg + c0 + 4 * h); *(f32x4*)(orow + c0 + 4 * h) = (v[j][h] * rs) * g4; } }
    }
}


struct DescPlain {
    const bf16_t* A; const bf16_t* B; int nN; bool latonly; int lda, ldb, K, total;
    DI void init(const bf16_t* A_, const bf16_t* B_, int nN_, bool lat) { A = A_; B = B_; nN = nN_; latonly = lat; lda = DM; ldb = DM; K = DM; total = (lat ? 128 : 144) * nN_; }
    DI pg8::Unit unit(int idx) const {
        const int nMt = latonly ? 128 : 144, nig = 8 * nN, gid = idx / nig, fm = gid * 8, gsz = (nMt - fm) < 8 ? (nMt - fm) : 8;
        const int pmi = fm + (idx % nig) % gsz, pn = (idx % nig) / gsz, pm = latonly ? (pmi / 8) * 9 + (pmi % 8) : pmi;
        pg8::Unit u; u.a = (const char*)(A + (size_t)pm * 256 * DM); u.b = (const char*)(B + (size_t)pn * 256 * DM); u.i0 = pm; u.i1 = pn; u.i2 = 0; return u;
    }
};
struct DescChan {
    const bf16_t* DC; const bf16_t* H; int lda, ldb, K, total;
    DI void init(const bf16_t* DC_, const bf16_t* H_, bool lat) { DC = DC_; H = H_; lda = 512; ldb = DM; K = 512; total = lat ? 2048 : 2304; }
    DI pg8::Unit unit(int idx) const {
        pg8::Unit u; int b, g, mt, nt, toff;
        if (idx < 2048) { mt = idx % 4; nt = (idx / 4) % 8; g = (idx / 32) % 4; b = idx / 128; toff = nt * 256; u.i2 = nt; }
        else { const int j = idx - 2048; mt = j % 4; g = (j / 4) % 4; b = j / 16; toff = TL; u.i2 = 8; }
        u.a = (const char*)(DC + (size_t)mt * 256 * 512); u.b = (const char*)(H + ((size_t)b * TB + toff) * DM + g * 512); u.i0 = b * 4 + g; u.i1 = mt; return u;
    }
};
struct DescT {
    const bf16_t* DT; const bf16_t* PQ; int nMt; int lda, ldb, K, total;
    DI void init(const bf16_t* DT_, const bf16_t* PQ_, int ld, int Kd, int coff, int nMt_) { DT = DT_ + coff; PQ = PQ_ + coff; nMt = nMt_; lda = ld; ldb = ld; K = Kd; total = NB * nMt_ * 8; }
    DI pg8::Unit unit(int idx) const {
        const int mt = idx % nMt, nt = (idx / nMt) % 8, b = idx / (nMt * 8);
        pg8::Unit u; u.a = (const char*)(DT + (size_t)mt * 256 * lda); u.b = (const char*)(PQ + ((size_t)b * DM + nt * 256) * ldb); u.i0 = b; u.i1 = mt; u.i2 = nt; return u;
    }
};

DI void resid_store(const Args& A, int layer, int pm, int row_l, int col, const float* modl, f32x4 v0, f32x4 v1) {
    const int b = pm / 9, tt = pm % 9;
    const float* gp = modl + (size_t)(tt < 8 ? b : 16) * MOD_LD + 2 * DM + col;
    const f32x4 g0 = *(const f32x4*)gp, g1 = *(const f32x4*)(gp + 4);
    const float* src; float* dst;
    if (tt < 8) { const size_t off = ((size_t)b * TL + tt * 256 + row_l) * DM + col; src = (layer == 0 ? A.in[0] : (const float*)A.out) + off; dst = A.out + off; }
    else { const size_t off = ((size_t)b * TC + row_l) * DM + col; src = (layer == 0 ? A.in[2] : (const float*)(A.ws + WS_CTXS)) + off; dst = (float*)(A.ws + WS_CTXS) + off; }
    const f32x4 x0 = *(const f32x4*)src, x1 = *(const f32x4*)(src + 4);
    *(f32x4*)dst = x0 + g0 * v0; *(f32x4*)(dst + 4) = x1 + g1 * v1;
}

DI void fnet_layer(const Args& A, LAS unsigned char* lds, cg::grid_group& grid, int layer, int j, bool latonly, int wv) {
    unsigned char* ws = A.ws;
    const bf16_t* H = (const bf16_t*)(ws + WS_H); bf16_t* U = (bf16_t*)(ws + WS_H);
    bf16_t* Gt = (bf16_t*)(ws + WS_SCR + F_G); bf16_t* PQX = (bf16_t*)(ws + WS_SCR + F_PQX); bf16_t* PQC = (bf16_t*)(ws + WS_SCR + F_PQC);
    norm_phase(A, layer, latonly, wv);
    grid.sync();
    {
        DescPlain D; D.init(H, (const bf16_t*)(ws + WS_WFG) + (size_t)j * DM * DM, 8, latonly);
        auto E = [=](const pg8::Unit& u, int row_l, int col_l, f32x4 v0, f32x4 v1) {
            f32x4 a, b;
#pragma unroll
            for (int q = 0; q < 4; ++q) { a[q] = siluf(v0[q]); b[q] = siluf(v1[q]); }
            st_bf16x8(Gt + ((size_t)u.i0 * 256 + row_l) * DM + u.i1 * 256 + col_l, a, b);
        };
        pg8::gemm_phase(lds, D, E, wv);
    }
    {
        DescChan D; D.init((const bf16_t*)(ws + WS_DC), H, latonly);
        auto E = [=](const pg8::Unit& u, int row_l, int col_l, f32x4 v0, f32x4 v1) {
            const int b = u.i0 >> 2, g = u.i0 & 3, mt = u.i1, half = mt >> 1, ch = g * 512 + (mt & 1) * 256 + row_l;
            bf16_t* dst = (u.i2 < 8) ? PQX + ((size_t)b * DM + ch) * 4096 + half * 2048 + u.i2 * 256 + col_l
                                     : PQC + ((size_t)b * DM + ch) * 512 + half * 256 + col_l;
            st_bf16x8(dst, v0, v1);
        };
        pg8::gemm_phase(lds, D, E, wv);
    }
    grid.sync();
    bf16_t* A1 = (bf16_t*)(ws + WS_SCR + F_A1); float* NYQ = (float*)(ws + WS_SCR + F_NYQ);
    {
        const int tid = otid(wv), lane = tid & 63;
        for (int rr = blockIdx.x * NWAVES + wv; rr < NB * DM; rr += gridDim.x * NWAVES) {
            const bf16_t* pr = PQX + (size_t)rr * 4096; float acc = 0.f;
#pragma unroll
            for (int q = 0; q < 4; ++q) { f32x4 a, b; ld_bf16x8(pr + (q * 64 + lane) * 8, a, b); acc += (a[0] - a[1]) + (a[2] - a[3]) + (b[0] - b[1]) + (b[2] - b[3]); }
            acc = wave_sum(acc);
            if (lane == 0) NYQ[rr] = acc * 0.022097086912079608f;
        }
    }
    {
        DescT D; D.init((const bf16_t*)(ws + WS_DT), PQX, 4096, 2048, 0, 4);
        auto E = [=](const pg8::Unit& u, int row_l, int col_l, f32x4 v0, f32x4 v1) {
            st_bf16x8(A1 + ((size_t)u.i0 * 1024 + u.i1 * 256 + row_l) * DM + u.i2 * 256 + col_l, v0, v1);
        };
        pg8::gemm_phase(lds, D, E, wv);
    }
    grid.sync();
    {
        DescT D; D.init((const bf16_t*)(ws + WS_DT), PQX, 4096, 2048, 2048, 4);
        auto E = [=](const pg8::Unit& u, int row_l, int col_l, f32x4 v0, f32x4 v1) {
            const int k = u.i1 * 256 + row_l, col = u.i2 * 256 + col_l;
            f32x4 a0, a1; ld_bf16x8(A1 + ((size_t)u.i0 * 1024 + k) * DM + col, a0, a1);
            const size_t off = ((size_t)u.i0 * TB + k) * DM + col;
            f32x4 g0, g1; ld_bf16x8(Gt + off, g0, g1);
            st_bf16x8(U + off, (a0 + v0) * g0, (a1 + v1) * g1);
            const size_t off2 = ((size_t)u.i0 * TB + (k == 0 ? 1024 : TL - k)) * DM + col;
            ld_bf16x8(Gt + off2, g0, g1);
            if (k == 0) { const float* nq = NYQ + (size_t)u.i0 * DM + col; a0 = *(const f32x4*)nq; a1 = *(const f32x4*)(nq + 4); v0 = (f32x4){0.f, 0.f, 0.f, 0.f}; v1 = v0; }
            st_bf16x8(U + off2, (a0 - v0) * g0, (a1 - v1) * g1);
        };
        pg8::gemm_phase(lds, D, E, wv);
    }
    if (!latonly) {
        DescT D; D.init((const bf16_t*)(ws + WS_DT2), PQC, 512, 512, 0, 1);
        auto E = [=](const pg8::Unit& u, int row_l, int col_l, f32x4 v0, f32x4 v1) {
            const size_t off = ((size_t)u.i0 * TB + TL + row_l) * DM + u.i2 * 256 + col_l;
            f32x4 g0, g1; ld_bf16x8(Gt + off, g0, g1);
            st_bf16x8(U + off, v0 * g0, v1 * g1);
        };
        pg8::gemm_phase(lds, D, E, wv);
    }
    grid.sync();
    {
        DescPlain D; D.init(U, (const bf16_t*)(ws + WS_WFO) + (size_t)j * DM * DM, 8, latonly);
        const float* modl = (const float*)(ws + WS_MOD) + (size_t)layer * 17 * MOD_LD;
        auto E = [=](const pg8::Unit& u, int row_l, int col_l, f32x4 v0, f32x4 v1) { resid_store(A, layer, u.i0, row_l, u.i1 * 256 + col_l, modl, v0, v1); };
        pg8::gemm_phase(lds, D, E, wv);
    }
    grid.sync();
}


namespace att {
constexpr int D = 128, NW = 8, QBLK = 32, KVBLK = 64;
constexpr float SCALE = 0.088388347648318440f;
constexpr float THR = 8.f;
constexpr int LDQ = 2048, LDK = 512;
constexpr size_t SHM_V = KVBLK * D * 2, SHM_K = KVBLK * D * 2;
typedef float f32x8 __attribute__((ext_vector_type(8)));
#define KSWZ(row, colB) ((row) * 256 + ((colB) ^ (((row) & 7) << 4)))
#define SBAR() __builtin_amdgcn_sched_barrier(0)
DI int crow(int r, int hi) { return (r & 3) + 8 * (r >> 2) + 4 * hi; }
DI unsigned cvtpk(float lo, float hi) { unsigned r; asm volatile("v_cvt_pk_bf16_f32 %0, %1, %2" : "=v"(r) : "v"(lo), "v"(hi)); return r; }
DI void partialSM(f32x16& p0, f32x16& p1, float& m_reg, float& mn, float& alpha) {
  constexpr float C = SCALE * 1.4426950408889634f;
  float pmax = p0[0];
#pragma unroll
  for (int r = 1; r < 16; ++r) pmax = fmaxf(pmax, p0[r]);
#pragma unroll
  for (int r = 0; r < 16; ++r) pmax = fmaxf(pmax, p1[r]);
  { auto rr = __builtin_amdgcn_permlane32_swap(__float_as_uint(pmax), __float_as_uint(pmax), false, false);
    pmax = fmaxf(__uint_as_float(rr[0]), __uint_as_float(rr[1])); }
  if (__builtin_expect(__all(pmax - m_reg <= THR / SCALE), 1)) { mn = m_reg; alpha = 1.f; }
  else { mn = fmaxf(m_reg, pmax); alpha = __builtin_amdgcn_exp2f((m_reg - mn) * C); m_reg = mn; }
  float mnC = -mn * C;
#pragma unroll
  for (int r = 0; r < 16; ++r) p0[r] = fmaf(p0[r], C, mnC);
#pragma unroll
  for (int r = 0; r < 16; ++r) p1[r] = fmaf(p1[r], C, mnC);
#pragma unroll
  for (int r = 0; r < 16; ++r) p0[r] = __builtin_amdgcn_exp2f(p0[r]);
}
DI void finishSM(f32x16& p0, f32x16& p1, float alpha, float& l_reg, bf16x8& pa0, bf16x8& pa1, bf16x8& pa2, bf16x8& pa3) {
#pragma unroll
  for (int r = 0; r < 16; ++r) p1[r] = __builtin_amdgcn_exp2f(p1[r]);
  float ps = 0;
#pragma unroll
  for (int r = 0; r < 16; ++r) ps += p0[r];
#pragma unroll
  for (int r = 0; r < 16; ++r) ps += p1[r];
  { auto rr = __builtin_amdgcn_permlane32_swap(__float_as_uint(ps), __float_as_uint(ps), false, false);
    ps = __uint_as_float(rr[0]) + __uint_as_float(rr[1]); }
  l_reg = l_reg * alpha + ps;
#define PK4(P, BASE, OUT) do { unsigned a0 = cvtpk(P[BASE + 0], P[BASE + 1]), a1 = cvtpk(P[BASE + 2], P[BASE + 3]);   \
    unsigned b0 = cvtpk(P[BASE + 4], P[BASE + 5]), b1 = cvtpk(P[BASE + 6], P[BASE + 7]);                              \
    auto r0 = __builtin_amdgcn_permlane32_swap(a0, b0, false, false); auto r1 = __builtin_amdgcn_permlane32_swap(a1, b1, false, false); \
    u32x4 w = {r0[0], r1[0], r0[1], r1[1]}; OUT = *reinterpret_cast<bf16x8*>(&w); } while (0)
  PK4(p0, 0, pa0); PK4(p0, 8, pa1); PK4(p1, 0, pa2); PK4(p1, 8, pa3);
#undef PK4
}
DI void qkt(f32x16& p0, f32x16& p1, const bf16_t* Ks, const bf16x8* qr, int r32, int hi) {
  p0 = f32x16{}; p1 = f32x16{};
#pragma unroll
  for (int d0 = 0; d0 < 8; ++d0) { int cb = (d0 * 16 + hi * 8) * 2;
    bf16x8 b0 = *reinterpret_cast<const bf16x8*>((const char*)Ks + KSWZ(r32, cb));
    bf16x8 b1 = *reinterpret_cast<const bf16x8*>((const char*)Ks + KSWZ(32 + r32, cb));
    p0 = __builtin_amdgcn_mfma_f32_32x32x16_bf16(b0, qr[d0], p0, 0, 0, 0);
    p1 = __builtin_amdgcn_mfma_f32_32x32x16_bf16(b1, qr[d0], p1, 0, 0, 0); }
}
DI int v_st(int k, int c) { const int kk = (k & ~0xC) | ((k & 4) << 1) | ((k & 8) >> 1); return ((kk >> 3) * 4 + (c >> 5)) * 512 + ((kk & 7) * 32 + (c & 31)) * 2; }
DI int v_rd_base(int lane) { return ((lane & 3) << 3) | (((lane >> 2) & 3) << 6) | (((lane >> 4) & 1) << 5) | (((lane >> 5) & 1) << 8); }
constexpr int v_rd_off(int d0, int ks, int half) { return d0 * 512 + ks * 4096 + half * 2048; }
template <int OFF> DI s16x4 tr_read(int vb) {
  s16x4 r; asm volatile("ds_read_b64_tr_b16 %0, %1 offset:%2" : "=&v"(r) : "v"(vb), "i"(OFF) : "memory"); return r;
}
template <int D0> DI void pv_one(f32x16& od, int vb, bf16x8 pa0, bf16x8 pa1, bf16x8 pa2, bf16x8 pa3) {
  const s16x4 l0 = tr_read<v_rd_off(D0, 0, 0)>(vb), h0 = tr_read<v_rd_off(D0, 0, 1)>(vb), l1 = tr_read<v_rd_off(D0, 1, 0)>(vb), h1 = tr_read<v_rd_off(D0, 1, 1)>(vb);
  const s16x4 l2 = tr_read<v_rd_off(D0, 2, 0)>(vb), h2 = tr_read<v_rd_off(D0, 2, 1)>(vb), l3 = tr_read<v_rd_off(D0, 3, 0)>(vb), h3 = tr_read<v_rd_off(D0, 3, 1)>(vb);
  asm volatile("s_waitcnt lgkmcnt(0)" ::: "memory"); SBAR();
#define PK(L, H) (bf16x8){L[0], L[1], L[2], L[3], H[0], H[1], H[2], H[3]}
  od = __builtin_amdgcn_mfma_f32_32x32x16_bf16(pa0, PK(l0, h0), od, 0, 0, 0);
  od = __builtin_amdgcn_mfma_f32_32x32x16_bf16(pa1, PK(l1, h1), od, 0, 0, 0);
  od = __builtin_amdgcn_mfma_f32_32x32x16_bf16(pa2, PK(l2, h2), od, 0, 0, 0);
  od = __builtin_amdgcn_mfma_f32_32x32x16_bf16(pa3, PK(l3, h3), od, 0, 0, 0);
#undef PK
}
DI void pv_d0(f32x16* o, int vb, bf16x8 pa0, bf16x8 pa1, bf16x8 pa2, bf16x8 pa3) {
  pv_one<0>(o[0], vb, pa0, pa1, pa2, pa3); pv_one<1>(o[1], vb, pa0, pa1, pa2, pa3); pv_one<2>(o[2], vb, pa0, pa1, pa2, pa3); pv_one<3>(o[3], vb, pa0, pa1, pa2, pa3);
}
DI void attn_dense_body(const bf16_t* __restrict__ Qb, const bf16_t* __restrict__ Kh, const bf16_t* __restrict__ Vh, const bf16_t* SZb, bf16_t* Ub, int seq, char* lds, int wv) {
  const int tid = otid(wv), wid = tid >> 6, lane = tid & 63, r32 = lane & 31, hi = lane >> 5;
  bf16_t* V_lds = (bf16_t*)lds; bf16_t* K_lds = (bf16_t*)(lds + 2 * SHM_V);
  float* wsf = (float*)(lds + 2 * SHM_V + 2 * SHM_K) + wid * 64; float* li_l = wsf; float* al_l = wsf + 32;
  float m_reg = -1e30f, l_reg = 0; f32x16 o[4] = {}; bf16x8 qr[8];
  const bf16_t* Qw = Qb + (long)(wid * QBLK + r32) * LDQ + hi * 8;
#pragma unroll
  for (int d0 = 0; d0 < 8; ++d0) qr[d0] = *reinterpret_cast<const bf16x8*>(Qw + d0 * 16);
  const int sr = tid >> 4, sc = (tid & 15) * 8, vst0 = v_st(sr, sc), vst1 = v_st(32 + sr, sc);
  const int vb0 = (int)(uintptr_t)V_lds + v_rd_base(lane);
  struct { bf16x8 vs0, vs1, ks0, ks1; } sr_[2];
#define SLOAD(i, k0) do { sr_[i].vs0 = *reinterpret_cast<const bf16x8*>(&Vh[(long)((k0) + sr) * LDK + sc]); sr_[i].vs1 = *reinterpret_cast<const bf16x8*>(&Vh[(long)((k0) + 32 + sr) * LDK + sc]); \
    sr_[i].ks0 = *reinterpret_cast<const bf16x8*>(&Kh[(long)((k0) + sr) * LDK + sc]); sr_[i].ks1 = *reinterpret_cast<const bf16x8*>(&Kh[(long)((k0) + 32 + sr) * LDK + sc]); } while (0)
#define SWRITE(b, i) do { *(bf16x8*)((char*)V_lds + (b) * SHM_V + vst0) = sr_[i].vs0;          \
    *(bf16x8*)((char*)V_lds + (b) * SHM_V + vst1) = sr_[i].vs1; int kc = sc * 2;               \
    *(bf16x8*)((char*)K_lds + (b) * SHM_K + KSWZ(sr, kc)) = sr_[i].ks0;                       \
    *(bf16x8*)((char*)K_lds + (b) * SHM_K + KSWZ(32 + sr, kc)) = sr_[i].ks1; } while (0)
#define SWAIT() asm volatile("s_waitcnt vmcnt(4)" ::: "memory")
#define RESC(a) do { if (__any((a) < 1.f)) { if (hi == 0) al_l[r32] = (a); asm volatile("s_waitcnt lgkmcnt(0)" ::: "memory"); \
    _Pragma("unroll") for (int d = 0; d < 4; ++d) _Pragma("unroll") for (int r = 0; r < 16; ++r) o[d][r] *= al_l[crow(r, hi)]; } } while (0)
  f32x16 pA0, pA1, pB0, pB1; float mnA, mnB, alA, alB; bf16x8 pa0, pa1, pa2, pa3; const int NT = seq / KVBLK;
  constexpr int SE = 0, SO = 1;
  SLOAD(SE, 0); asm volatile("s_waitcnt vmcnt(0)" ::: "memory"); SWRITE(0, SE); __syncthreads();
  qkt(pA0, pA1, K_lds, qr, r32, hi); partialSM(pA0, pA1, m_reg, mnA, alA);
  SLOAD(SO, KVBLK); if (2 < NT) SLOAD(SE, 2 * KVBLK);
  SWAIT(); SWRITE(1, SO); __syncthreads();
  for (int j = 1; j + 1 < NT; j += 2) {
    SBAR(); qkt(pB0, pB1, (bf16_t*)((char*)K_lds + SHM_K), qr, r32, hi);
    finishSM(pA0, pA1, alA, l_reg, pa0, pa1, pa2, pa3); SBAR();
    SLOAD(SO, (j + 2) * KVBLK); SBAR();
    pv_d0(o, vb0, pa0, pa1, pa2, pa3); partialSM(pB0, pB1, m_reg, mnB, alB);
    __syncthreads(); SWAIT(); SWRITE(0, SE);
    RESC(alB); __syncthreads();
    SBAR(); qkt(pA0, pA1, K_lds, qr, r32, hi);
    finishSM(pB0, pB1, alB, l_reg, pa0, pa1, pa2, pa3); SBAR();
    if (j + 3 < NT) SLOAD(SE, (j + 3) * KVBLK); SBAR();
    pv_d0(o, vb0 + (int)SHM_V, pa0, pa1, pa2, pa3); partialSM(pA0, pA1, m_reg, mnA, alA);
    __syncthreads(); SWAIT(); SWRITE(1, SO);
    RESC(alA); __syncthreads();
  }
  SBAR(); qkt(pB0, pB1, (bf16_t*)((char*)K_lds + SHM_K), qr, r32, hi);
  finishSM(pA0, pA1, alA, l_reg, pa0, pa1, pa2, pa3); SBAR();
  pv_d0(o, vb0, pa0, pa1, pa2, pa3); partialSM(pB0, pB1, m_reg, mnB, alB);
  __syncthreads(); RESC(alB);
  finishSM(pB0, pB1, alB, l_reg, pa0, pa1, pa2, pa3); SBAR();
  pv_d0(o, vb0 + (int)SHM_V, pa0, pa1, pa2, pa3);
  if (hi == 0) li_l[r32] = l_reg; asm volatile("s_waitcnt lgkmcnt(0)" ::: "memory");
  float rli[16];
#pragma unroll
  for (int r = 0; r < 16; ++r) rli[r] = __builtin_amdgcn_rcpf(li_l[crow(r, hi)]);
#pragma unroll
  for (int r = 0; r < 16; ++r) { const long ro = (long)(wid * QBLK + crow(r, hi)) * LDQ + r32;
#pragma unroll
    for (int d0 = 0; d0 < 4; ++d0) Ub[ro + d0 * 32] = (bf16_t)(pk2(o[d0][r] * rli[r], 0.f) & 0xffffu); }
  __syncthreads();
#pragma unroll 2
  for (int i = 0; i < 8; ++i) { const int id = tid + 512 * i; const long off = (long)(id >> 4) * LDQ + (id & 15) * 8;
    f32x4 a0, a1, z0, z1; ld_bf16x8(Ub + off, a0, a1); ld_bf16x8(SZb + off, z0, z1); st_bf16x8(Ub + off, a0 * z0, a1 * z1); }
  __syncthreads();
#undef SLOAD
#undef SWRITE
#undef SWAIT
#undef RESC
}
#undef KSWZ
#undef SBAR
}

DI void qknorm_phase(const Args& A, int wv) {
    const int tid = otid(wv), lane = tid & 63, wave = tid >> 6, G = gridDim.x;
    bf16_t* Q = (bf16_t*)(A.ws + WS_SCR + A_Q); bf16_t* Kb = (bf16_t*)(A.ws + WS_SCR + A_K);
    const float* qn = A.in[14]; const float* kn = A.in[15];
    const int sub = lane >> 4, l16 = lane & 15, e0 = l16 * 8;
    const long NIT = (long)NTOK * 20;
    for (long it = ((long)blockIdx.x * NWAVES + wave) * 4 + sub; it < NIT; it += (long)G * NWAVES * 4) {
        const int row = (int)(it / 20), hj = (int)(it % 20);
        bf16_t* p = (hj < 16) ? Q + (size_t)row * 2048 + hj * 128 + e0 : Kb + (size_t)row * 512 + (hj - 16) * 128 + e0;
        const float* wn = (hj < 16 ? qn : kn) + e0;
        f32x4 a, b; ld_bf16x8(p, a, b);
        float ss = 0.f;
#pragma unroll
        for (int q = 0; q < 4; ++q) ss += a[q] * a[q] + b[q] * b[q];
        ss += __shfl_xor(ss, 1); ss += __shfl_xor(ss, 2); ss += __shfl_xor(ss, 4); ss += __shfl_xor(ss, 8);
        const float rs = 1.0f / sqrtf(ss * (1.f / 128.f) + EPS);
        const f32x4 w0 = *(const f32x4*)wn, w1 = *(const f32x4*)(wn + 4);
        a = a * rs * w0; b = b * rs * w1;
        const int t = row % TB;
        if (t < TL) {
            const float pos = (l16 < 8) ? (float)(t >> 6) : (float)(t & 63);
            float y[8] = {a[0], a[1], a[2], a[3], b[0], b[1], b[2], b[3]};
#pragma unroll
            for (int pp = 0; pp < 4; ++pp) {
                const int fi = (4 * l16 + pp) & 31;
                const float ang = pos * exp2f(-(float)fi * 0.41524101186092029f);
                const float cs = cosf(ang), sn = sinf(ang);
                const float x0 = y[2 * pp], x1 = y[2 * pp + 1];
                y[2 * pp] = x0 * cs - x1 * sn; y[2 * pp + 1] = x0 * sn + x1 * cs;
            }
            a = (f32x4){y[0], y[1], y[2], y[3]}; b = (f32x4){y[4], y[5], y[6], y[7]};
        }
        st_bf16x8(p, a, b);
    }
}

DI void attn_layer(const Args& A, LAS unsigned char* lds, char* lds_gen, cg::grid_group& grid, int layer, int wv) {
    unsigned char* ws = A.ws;
    const bf16_t* H = (const bf16_t*)(ws + WS_H); bf16_t* U = (bf16_t*)(ws + WS_H);
    bf16_t* Q = (bf16_t*)(ws + WS_SCR + A_Q); bf16_t* Kb = (bf16_t*)(ws + WS_SCR + A_K); bf16_t* Vb = (bf16_t*)(ws + WS_SCR + A_V); bf16_t* SZ = (bf16_t*)(ws + WS_SCR + A_SZ);
    norm_phase(A, layer, false, wv);
    grid.sync();
    {
        DescPlain D; D.init(H, (const bf16_t*)(ws + WS_WAI), 20, false);
        auto E = [=](const pg8::Unit& u, int row_l, int col_l, f32x4 v0, f32x4 v1) {
            const size_t row = (size_t)u.i0 * 256 + row_l; const int pn = u.i1;
            if (pn < 8) st_bf16x8(Q + row * 2048 + pn * 256 + col_l, v0, v1);
            else if (pn < 10) st_bf16x8(Kb + row * 512 + (pn - 8) * 256 + col_l, v0, v1);
            else if (pn < 12) st_bf16x8(Vb + row * 512 + (pn - 10) * 256 + col_l, v0, v1);
            else { f32x4 a, b;
#pragma unroll
                for (int q = 0; q < 4; ++q) { a[q] = siluf(v0[q]); b[q] = siluf(v1[q]); }
                st_bf16x8(SZ + row * 2048 + (pn - 12) * 256 + col_l, a, b); }
        };
        pg8::gemm_phase(lds, D, E, wv);
    }
    grid.sync();
    qknorm_phase(A, wv);
    grid.sync();
    {
        const int G = gridDim.x, c = blockIdx.x;
        for (long L = c; L < 2048; L += G) {
            const int u = pg8::xcd_remap((int)L, 2048);
            const int b = u / 128, rem = u % 128, kvh = rem / 32, g = (rem / 8) % 4, qb = rem % 8, h = kvh * 4 + g;
            const size_t qoff = ((size_t)b * TB + qb * 256) * 2048 + h * 128, koff = ((size_t)b * TB) * 512 + kvh * 128;
            att::attn_dense_body(Q + qoff, Kb + koff, Vb + koff, SZ + qoff, U + qoff, TB, lds_gen, wv);
        }
        for (int u = c; u < 256; u += G) {
            const int b = u / 16, h = u % 16, kvh = h / 4;
            const size_t qoff = ((size_t)b * TB + TL) * 2048 + h * 128, koff = ((size_t)b * TB + TL) * 512 + kvh * 128;
            att::attn_dense_body(Q + qoff, Kb + koff, Vb + koff, SZ + qoff, U + qoff, TC, lds_gen, wv);
        }
    }
    grid.sync();
    {
        DescPlain D; D.init(U, (const bf16_t*)(ws + WS_WAO), 8, false);
        const float* modl = (const float*)(ws + WS_MOD) + (size_t)layer * 17 * MOD_LD;
        auto E = [=](const pg8::Unit& u, int row_l, int col_l, f32x4 v0, f32x4 v1) { resid_store(A, layer, u.i0, row_l, u.i1 * 256 + col_l, modl, v0, v1); };
        pg8::gemm_phase(lds, D, E, wv);
    }
    grid.sync();
}


struct DescKVT {
    const bf16_t* WB; const bf16_t* H; int lda, ldb, K, total;
    DI void init(const bf16_t* WB_, const bf16_t* H_) { WB = WB_; H = H_; lda = DM; ldb = DM; K = DM; total = 12 * 144; }
    DI pg8::Unit unit(int idx) const { const int mt = idx % 12, nt = idx / 12; pg8::Unit u; u.a = (const char*)(WB + (size_t)mt * 256 * DM); u.b = (const char*)(H + (size_t)nt * 256 * DM); u.i0 = mt; u.i1 = nt; u.i2 = 0; return u; }
};
namespace ml {
#define MFMA32(a, b, c) __builtin_amdgcn_mfma_f32_32x32x16_bf16((a), (b), (c), 0, 0, 0)
#define LFENCE() asm volatile("s_waitcnt lgkmcnt(0)" ::: "memory")
DI int crow(int reg, int h) { return (reg & 3) + 8 * (reg >> 2) + 4 * h; }
DI bf16x8 ldperm(const bf16_t* p) { const s16x4 lo = *(const s16x4*)p, hi = *(const s16x4*)(p + 8); return __builtin_shufflevector(lo, hi, 0, 1, 2, 3, 4, 5, 6, 7); }
DI bf16x8 pack_step(const f32x16& x, int s) { u32x4 p = {pk2(x[8 * s], x[8 * s + 1]), pk2(x[8 * s + 2], x[8 * s + 3]), pk2(x[8 * s + 4], x[8 * s + 5]), pk2(x[8 * s + 6], x[8 * s + 7])}; return __builtin_bit_cast(bf16x8, p); }
DI float bfs(short h) { return __uint_as_float(((unsigned)(unsigned short)h) << 16); }

constexpr int SC_Q = 0, SC_K = 16384, SC_KT = 32768, SC_BUF = 49152, SC_WAVE = 2 * SC_BUF, SC_WAVE_BYTES = 6144;
DI bf16x8 ldsfrag(const LAS unsigned char* buf, unsigned o) { const s16x4 lo = *(const LAS s16x4*)(buf + o), hi = *(const LAS s16x4*)(buf + (o ^ 16u)); return __builtin_shufflevector(lo, hi, 0, 1, 2, 3, 4, 5, 6, 7); }
DI void scan_phase(const Args& A, LAS unsigned char* lds, int wv) {
    const int wave = wv;
    LAS float* wl = (LAS float*)(lds + SC_WAVE + wave * SC_WAVE_BYTES);
    LAS unsigned char* hst = lds + SC_WAVE + wave * SC_WAVE_BYTES + 2048;
    unsigned char* ws = A.ws;
    const bf16_t* Qg = (const bf16_t*)(ws + WS_SCR + M_Q); const bf16_t* Kg = (const bf16_t*)(ws + WS_SCR + M_K); const bf16_t* KVT = (const bf16_t*)(ws + WS_SCR + M_KVT);
    const float* G32 = (const float*)(ws + WS_SCR + M_G32); const float* bg = A.in[10];
#define SC_POS0(j) (dir == 0 ? ((j) < 4 ? TL + 64 * (j) : 64 * ((j) - 4)) : ((j) < 4 ? TL + 64 * (3 - (j)) : 64 * (35 - (j))))
#define SC_DMA(bufi, p0) do { const int tj_ = otid(wv); _Pragma("unroll") for (int i_ = 0; i_ < 2; ++i_) { const int sl_ = i_ * 512 + tj_; \
        { const int row_ = sl_ >> 4, c_ = (sl_ & 15) ^ (row_ & 15); const size_t go_ = (size_t)((p0) + row_) * 1024 + c_ * 8; \
          __builtin_amdgcn_global_load_lds((const unsigned*)(Qu + go_), (LAS unsigned*)(lds + (bufi) * SC_BUF + SC_Q + i_ * 8192 + wave * 1024), 16, 0, 0); \
          __builtin_amdgcn_global_load_lds((const unsigned*)(Ku + go_), (LAS unsigned*)(lds + (bufi) * SC_BUF + SC_K + i_ * 8192 + wave * 1024), 16, 0, 0); } \
        { const int d_ = sl_ >> 3, c_ = (sl_ & 7) ^ ((d_ >> 1) & 7); \
          __builtin_amdgcn_global_load_lds((const unsigned*)(KTu + (size_t)d_ * TB + (p0) + c_ * 8), (LAS unsigned*)(lds + (bufi) * SC_BUF + SC_KT + i_ * 8192 + wave * 1024), 16, 0, 0); } } } while (0)
    for (int item = blockIdx.x; item < 256; item += gridDim.x) {
        const int dir = item & 1, h = (item >> 1) & 7, b = item >> 4, e0 = wave * 32;
        const bf16_t* Qu = Qg + (size_t)b * TB * 1024 + h * 128;
        const bf16_t* Ku = Kg + (size_t)b * TB * 1024 + h * 128;
        const bf16_t* KTu = KVT + ((size_t)b * 3072 + h * 128) * TB;
        const bf16_t* VTu = KVT + ((size_t)b * 3072 + 1024 + h * 256 + e0) * TB;
        bf16_t* Hout = (bf16_t*)(ws + WS_SCR + (dir ? M_HB : M_HF)) + (size_t)b * TB * DM + h * 256 + e0;
        const float big = bg[(dir * 2) * 8 + h], bfg = bg[(dir * 2 + 1) * 8 + h];
        f32x16 cacc[4];
#pragma unroll
        for (int d = 0; d < 4; ++d)
#pragma unroll
            for (int i = 0; i < 16; ++i) cacc[d][i] = 0.f;
        float m = 0.f;
        { const int l0 = otid(wv) & 63; wl[384 + l0] = 0.f; wl[448 + l0] = 0.f; }
        LFENCE();
        SC_DMA(0, SC_POS0(0));
        for (int j = 0; j < 36; ++j) {
            const int pos0 = SC_POS0(j);
            const LAS unsigned char* Qb = lds + (j & 1) * SC_BUF + SC_Q; const LAS unsigned char* Kb = lds + (j & 1) * SC_BUF + SC_K; const LAS unsigned char* KTb = lds + (j & 1) * SC_BUF + SC_KT;
            asm volatile("s_waitcnt vmcnt(0)" ::: "memory"); __builtin_amdgcn_s_barrier(); asm volatile("" ::: "memory");
            if (j + 1 < 36) SC_DMA((j + 1) & 1, SC_POS0(j + 1));
            const int lj = otid(wv) & 63, rj = lj & 31, h4 = (lj >> 5) * 4;
            LAS float* wh = wl + h4; LAS float* wr = wl + rj; LAS unsigned char* hb = hst + h4 * 64 + rj * 2;
            const unsigned xr = rj & 15, xd = (rj >> 1) & 7;
            const unsigned qro = (unsigned)rj * 256u + 2u * h4;
            const unsigned kro = (unsigned)rj * 128u + 2u * h4;
            const bf16_t* VTp = VTu + (size_t)rj * TB + pos0 + h4;
            bf16x8 vf[4];
#pragma unroll
            for (int kk = 0; kk < 4; ++kk) vf[kk] = ldperm(VTp + 16 * kk);
            float decay, m_new;
            {
                const int s = dir ? 63 - lj : lj;
                const float* gp = G32 + (size_t)(b * TB + pos0 + s) * 32;
                const float ig = gp[(dir * 2) * 8 + h] + big, fg = gp[(dir * 2 + 1) * 8 + h] + bfg;
                const float lf = fminf(fg, 0.f) - log1pf(__expf(-fabsf(fg)));
                float bs = lf;
#pragma unroll
                for (int o = 1; o < 64; o <<= 1) { const float t = __shfl_up(bs, o); if (lj >= o) bs += t; }
                const float uu = ig - bs;
                float pmx = uu;
#pragma unroll
                for (int o = 1; o < 64; o <<= 1) { const float t = __shfl_up(pmx, o); if (lj >= o) pmx = fmaxf(pmx, t); }
                pmx = fmaxf(pmx, m);
                const float b_end = __shfl(bs, 63), pm_last = __shfl(pmx, 63);
                LAS float* ws_ = wl + s;
                ws_[0] = uu; ws_[64] = pmx; ws_[128] = __expf(m - pmx); ws_[192] = __expf(-(bs + pmx)); ws_[256] = __expf(uu - pm_last);
                decay = __expf(m - pm_last); m_new = b_end + pm_last;
            }
            LFENCE();
            const int sbase = dir ? 63 - h4 : h4, sgn = dir ? -1 : 1;
#pragma unroll
            for (int tb = 0; tb < 2; ++tb) {
                __builtin_amdgcn_sched_barrier(0);
                const unsigned qo = qro + tb * 8192u;
                f32x16 ha;
#pragma unroll
                for (int i = 0; i < 16; ++i) ha[i] = 0.f;
                float qnv = 0.f;
#pragma unroll
                for (int kk = 0; kk < 8; ++kk) {
                    const bf16x8 qa = ldsfrag(Qb, qo + (((2u * kk) ^ xr) << 4));
                    ha = MFMA32(qa, pack_step(cacc[kk >> 1], kk & 1), ha);
                    const f32x4 n0 = *(const LAS f32x4*)(wh + 384 + 16 * kk), n1 = *(const LAS f32x4*)(wh + 384 + 16 * kk + 8);
#pragma unroll
                    for (int jj = 0; jj < 4; ++jj) qnv += bfs(qa[jj]) * n0[jj] + bfs(qa[4 + jj]) * n1[jj];
                }
                qnv += __shfl_xor(qnv, 32);
#pragma unroll
                for (int i = 0; i < 16; ++i) ha[i] *= wh[128 + 32 * tb + (i & 3) + 8 * (i >> 2)];
                const float pmt = wr[64 + 32 * tb];
                const int tp = dir ? (63 - 32 * tb) - rj : 32 * tb + rj;
                float ds = 0.f;
#pragma unroll
                for (int sb = 0; sb < 2; ++sb) {
                    __builtin_amdgcn_sched_barrier(0);
                    const unsigned ko = qro + sb * 8192u;
                    f32x16 st;
#pragma unroll
                    for (int i = 0; i < 16; ++i) st[i] = 0.f;
#pragma unroll
                    for (int kk = 0; kk < 8; ++kk) { const unsigned c = ((2u * kk) ^ xr) << 4; st = MFMA32(ldsfrag(Kb, ko + c), ldsfrag(Qb, qo + c), st); }
#pragma unroll
                    for (int i = 0; i < 16; ++i) {
                        const int sc = 32 * sb + (i & 3) + 8 * (i >> 2);
                        const int sp = sbase + sgn * sc;
                        st[i] *= __expf((sp <= tp) ? wh[sc] - pmt : -1e30f);
                        ds += st[i];
                    }
                    ha = MFMA32(pack_step(st, 0), vf[2 * sb], ha);
                    ha = MFMA32(pack_step(st, 1), vf[2 * sb + 1], ha);
                }
                ds += __shfl_xor(ds, 32);
                {
                    const float den = wr[128 + 32 * tb] * qnv + ds;
                    const float rd = 1.0f / fmaxf(fabsf(den), wr[192 + 32 * tb]);
                    if (h4 == 0) wr[320 + 32 * tb] = rd;
                }
                LFENCE();
#pragma unroll
                for (int i = 0; i < 16; ++i) { const int tc = 32 * tb + (i & 3) + 8 * (i >> 2);
                    *(LAS unsigned short*)(hb + tc * 64) = (unsigned short)(pk2(ha[i] * wh[320 + tc], 0.f) & 0xffffu); }
            }
            LFENCE();
            {
                bf16_t* hp = Hout + (size_t)(pos0 + lj) * DM;
                const LAS unsigned char* hrow = hst + lj * 64;
#pragma unroll
                for (int q = 0; q < 4; ++q) *(u32x4*)(hp + 8 * q) = *(const LAS u32x4*)(hrow + 16 * q);
            }
            __builtin_amdgcn_sched_barrier(0);
#pragma unroll
            for (int db = 0; db < 4; ++db) {
                if (db == 2) __builtin_amdgcn_sched_barrier(0);
#pragma unroll
                for (int i = 0; i < 16; ++i) cacc[db][i] *= decay;
                const unsigned to = kro + db * 4096u;
                float nadd = 0.f;
#pragma unroll
                for (int kk = 0; kk < 4; ++kk) {
                    const bf16x8 kv = ldsfrag(KTb, to + (((2u * kk) ^ xd) << 4));
                    const f32x4 w0 = *(const LAS f32x4*)(wh + 256 + 16 * kk), w1 = *(const LAS f32x4*)(wh + 256 + 16 * kk + 8);
                    float f[8];
#pragma unroll
                    for (int jj = 0; jj < 4; ++jj) { f[jj] = bfs(kv[jj]) * w0[jj]; f[4 + jj] = bfs(kv[4 + jj]) * w1[jj]; }
#pragma unroll
                    for (int jj = 0; jj < 8; ++jj) nadd += f[jj];
                    u32x4 p = {pk2(f[0], f[1]), pk2(f[2], f[3]), pk2(f[4], f[5]), pk2(f[6], f[7])};
                    cacc[db] = MFMA32(__builtin_bit_cast(bf16x8, p), vf[kk], cacc[db]);
                }
                nadd += __shfl_xor(nadd, 32);
                if (h4 == 0) wr[384 + 32 * db] = decay * wr[384 + 32 * db] + nadd;
            }
            LFENCE();
            m = m_new;
        }
        asm volatile("s_waitcnt vmcnt(0)" ::: "memory"); __builtin_amdgcn_s_barrier();
    }
#undef SC_DMA
#undef SC_POS0
}
#undef MFMA32
#undef LFENCE
}

DI void mlstm_finish_phase(const Args& A, int wv) {
    const int tid = otid(wv), lane = tid & 63, wave = tid >> 6, G = gridDim.x;
    unsigned char* ws = A.ws;
    const bf16_t* HF = (const bf16_t*)(ws + WS_SCR + M_HF); const bf16_t* HB = (const bf16_t*)(ws + WS_SCR + M_HB);
    const bf16_t* SO = (const bf16_t*)(ws + WS_SCR + M_SO); const bf16_t* SZ = (const bf16_t*)(ws + WS_SCR + M_SZ);
    bf16_t* U = (bf16_t*)(ws + WS_H); const float* hn = A.in[11];
    const int sub = lane >> 5, e0 = (lane & 31) * 8;
    const long NIT = (long)NTOK * 8;
    for (long it = ((long)blockIdx.x * NWAVES + wave) * 2 + sub; it < NIT; it += (long)G * NWAVES * 2) {
        const size_t off = (size_t)(it >> 3) * DM + (int)(it & 7) * 256 + e0;
        f32x4 f0, f1, b0, b1, o0, o1, z0, z1;
        ld_bf16x8(HF + off, f0, f1); ld_bf16x8(HB + off, b0, b1); ld_bf16x8(SO + off, o0, o1); ld_bf16x8(SZ + off, z0, z1);
        f32x4 y0 = o0 * (f0 + b0), y1 = o1 * (f1 + b1);
        float ss = 0.f;
#pragma unroll
        for (int q = 0; q < 4; ++q) ss += y0[q] * y0[q] + y1[q] * y1[q];
        ss += __shfl_xor(ss, 1); ss += __shfl_xor(ss, 2); ss += __shfl_xor(ss, 4); ss += __shfl_xor(ss, 8); ss += __shfl_xor(ss, 16);
        const float rs = 1.0f / sqrtf(ss * (1.f / 256.f) + EPS);
        const float* hp = hn + (int)(it & 7) * 256 + e0;
        const f32x4 h0 = *(const f32x4*)hp, h1 = *(const f32x4*)(hp + 4);
        st_bf16x8(U + off, y0 * rs * h0 * z0, y1 * rs * h1 * z1);
    }
}

DI void mlstm_layer(const Args& A, LAS unsigned char* lds, cg::grid_group& grid, int layer, int wv) {
    unsigned char* ws = A.ws;
    const bf16_t* H = (const bf16_t*)(ws + WS_H); bf16_t* U = (bf16_t*)(ws + WS_H);
    bf16_t* Q = (bf16_t*)(ws + WS_SCR + M_Q); bf16_t* Kb = (bf16_t*)(ws + WS_SCR + M_K); bf16_t* KVT = (bf16_t*)(ws + WS_SCR + M_KVT);
    float* G32 = (float*)(ws + WS_SCR + M_G32); bf16_t* SO = (bf16_t*)(ws + WS_SCR + M_SO); bf16_t* SZ = (bf16_t*)(ws + WS_SCR + M_SZ);
    norm_phase(A, layer, false, wv);
    grid.sync();
    {
        DescPlain D; D.init(H, (const bf16_t*)(ws + WS_WMA), 9, false);
        auto E = [=](const pg8::Unit& u, int row_l, int col_l, f32x4 v0, f32x4 v1) {
            const size_t row = (size_t)u.i0 * 256 + row_l; const int pn = u.i1;
            if (pn < 4) st_bf16x8(Q + row * 1024 + pn * 256 + col_l, v0 * 0.088388347648318440f, v1 * 0.088388347648318440f);
            else if (pn < 8) st_bf16x8(Kb + row * 1024 + (pn - 4) * 256 + col_l, v0, v1);
            else if (col_l < 32) { *(f32x4*)(G32 + row * 32 + col_l) = v0; *(f32x4*)(G32 + row * 32 + col_l + 4) = v1; }
        };
        pg8::gemm_phase(lds, D, E, wv);
    }
    {
        DescKVT D; D.init((const bf16_t*)(ws + WS_WMB), H);
        auto E = [=](const pg8::Unit& u, int row_l, int col_l, f32x4 v0, f32x4 v1) {
            const int bb = u.i1 / 9, s0 = (u.i1 % 9) * 256;
            st_bf16x8(KVT + ((size_t)bb * 3072 + u.i0 * 256 + row_l) * TB + s0 + col_l, v0, v1);
        };
        pg8::gemm_phase(lds, D, E, wv);
    }
    grid.sync();
    ml::scan_phase(A, lds, wv);
    grid.sync();
    {
        DescPlain D; D.init(H, (const bf16_t*)(ws + WS_WMA) + (size_t)2304 * DM, 16, false);
        auto E = [=](const pg8::Unit& u, int row_l, int col_l, f32x4 v0, f32x4 v1) {
            const size_t row = (size_t)u.i0 * 256 + row_l; const int pn = u.i1; f32x4 a, b;
            if (pn < 8) {
#pragma unroll
                for (int q = 0; q < 4; ++q) { a[q] = sigmf(v0[q]); b[q] = sigmf(v1[q]); }
                st_bf16x8(SO + row * DM + pn * 256 + col_l, a, b);
            } else {
#pragma unroll
                for (int q = 0; q < 4; ++q) { a[q] = siluf(v0[q]); b[q] = siluf(v1[q]); }
                st_bf16x8(SZ + row * DM + (pn - 8) * 256 + col_l, a, b);
            }
        };
        pg8::gemm_phase(lds, D, E, wv);
    }
    grid.sync();
    mlstm_finish_phase(A, wv);
    grid.sync();
    {
        DescPlain D; D.init(U, (const bf16_t*)(ws + WS_WMO), 8, false);
        const float* modl = (const float*)(ws + WS_MOD) + (size_t)layer * 17 * MOD_LD;
        auto E = [=](const pg8::Unit& u, int row_l, int col_l, f32x4 v0, f32x4 v1) { resid_store(A, layer, u.i0, row_l, u.i1 * 256 + col_l, modl, v0, v1); };
        pg8::gemm_phase(lds, D, E, wv);
    }
    grid.sync();
}

__global__ void __launch_bounds__(NTHREADS, 2) fwd_megakernel(Args A) {
    extern __shared__ __attribute__((aligned(16))) unsigned char lds_raw[];
    LAS unsigned char* lds = (LAS unsigned char*)lds_raw;
    cg::grid_group grid = cg::this_grid();
    const int wv = __builtin_amdgcn_readfirstlane(threadIdx.x >> 6);
    prep_phase(A, lds, wv);
    grid.sync();
    fnet_layer(A, lds, grid, 0, 0, false, wv);
    mlstm_layer(A, lds, grid, 1, wv);
    attn_layer(A, lds, (char*)lds_raw, grid, 2, wv);
    fnet_layer(A, lds, grid, 3, 1, true, wv);
    final_norm_phase(A, nullptr, wv);
}

extern "C" void kernel_launch(void* const* d_in, const int* in_sizes, int n_in, void* d_out, int out_size, void* d_ws, size_t ws_size, hipStream_t stream) {
    static int grid = 0;
    if (grid == 0) {
        if (n_in != 18 || ws_size < WS_END) { fprintf(stderr, "kernel_launch: unexpected n_in %d / ws_size %zu (need %zu)\n", n_in, ws_size, (size_t)WS_END); grid = -1; return; }
        int dev = 0, cus = 0, per_cu = 0;
        hipGetDevice(&dev);
        hipDeviceGetAttribute(&cus, hipDeviceAttributeMultiprocessorCount, dev);
        if (hipFuncSetAttribute((const void*)fwd_megakernel, hipFuncAttributeMaxDynamicSharedMemorySize, LDS_BYTES) != hipSuccess) { fprintf(stderr, "kernel_launch: hipFuncSetAttribute failed\n"); grid = -1; return; }
        if (hipOccupancyMaxActiveBlocksPerMultiprocessor(&per_cu, (const void*)fwd_megakernel, NTHREADS, LDS_BYTES) != hipSuccess || per_cu < 1) { fprintf(stderr, "kernel_launch: occupancy query failed (%d)\n", per_cu); per_cu = 1; }
        (void)hipGetLastError();
        grid = cus * per_cu;
        fprintf(stderr, "kernel_launch: grid %d (cus %d x %d)\n", grid, cus, per_cu);
    }
    if (grid < 0) return;
    hipMemsetAsync((char*)d_ws + WS_MOD, 0, MOD_BYTES, stream);
    Args a{};
    for (int i = 0; i < 18; ++i) a.in[i] = (const float*)d_in[i];
    a.out = (float*)d_out; a.ws = (unsigned char*)d_ws; a.ph_lo = 0; a.ph_hi = 100;
    void* args[] = {&a};
    hipError_t e = hipLaunchCooperativeKernel((const void*)fwd_megakernel, dim3(grid), dim3(NTHREADS), args, LDS_BYTES, stream);
    if (e != hipSuccess) fprintf(stderr, "kernel_launch: cooperative launch failed: %s (grid %d)\n", hipGetErrorString(e), grid);
}
```

```cpp
#include <hip/hip_runtime.h>
#include <hip/hip_cooperative_groups.h>
#include <cstdio>
#include <cstdint>
namespace cg = cooperative_groups;

#define LAS __attribute__((address_space(3)))
#define DI __device__ __forceinline__
typedef unsigned short bf16_t;
typedef short bf16x8 __attribute__((ext_vector_type(8)));
typedef short s16x4 __attribute__((ext_vector_type(4)));
typedef float f32x2 __attribute__((ext_vector_type(2)));
typedef float f32x4 __attribute__((ext_vector_type(4)));
typedef float f32x16 __attribute__((ext_vector_type(16)));
typedef unsigned u32x2 __attribute__((ext_vector_type(2)));
typedef unsigned u32x4 __attribute__((ext_vector_type(4)));
typedef __bf16 bf16v2 __attribute__((ext_vector_type(2)));

constexpr int DM = 2048, NB = 16, TL = 2048, TC = 256, TB = TL + TC, NTOK = NB * TB;
constexpr int NWAVES = 8, NTHREADS = 512;
constexpr float EPS = 1e-6f;
constexpr int MOD_LD = 3 * DM;
constexpr int M_WA_ROWS = 6400, M_WB_ROWS = 3072;
constexpr size_t MiB = 1u << 20;
constexpr size_t WS_MOD = 0;
constexpr size_t MOD_BYTES = (size_t)4 * 17 * MOD_LD * 4;
constexpr size_t WS_BAR = 1792 * 1024, ZERO_BYTES = 2 * MiB;
constexpr size_t WS_WFG = 2 * MiB, WS_WFO = 18 * MiB, WS_WMA = 34 * MiB, WS_WMB = 59 * MiB, WS_WMO = 71 * MiB, WS_WAI = 79 * MiB, WS_WAO = 99 * MiB;
constexpr size_t WS_DC = 107 * MiB, WS_DT = 108 * MiB, WS_DT2 = 124 * MiB, WS_CTXS = 125 * MiB, WS_H = 157 * MiB, WS_SCR = 301 * MiB;
constexpr size_t WS_END = 1024 * MiB;
constexpr size_t F_G = 0, F_PQX = 144 * MiB, F_PQC = 400 * MiB, F_A1 = 432 * MiB, F_NYQ = 496 * MiB;
constexpr size_t M_Q = 0, M_K = 72 * MiB, M_KVT = 144 * MiB, M_G32 = 360 * MiB, M_HF = 365 * MiB, M_HB = 509 * MiB, M_SO = 0, M_SZ = 144 * MiB;
constexpr size_t A_Q = 0, A_K = 144 * MiB, A_V = 180 * MiB, A_SZ = 216 * MiB;
static_assert(WS_SCR + M_HB + 144 * MiB <= WS_END, "ws map");
constexpr int LDS_BYTES = 147456 + 1024;

DI unsigned pk2(float a, float b) { f32x2 v = {a, b}; return __builtin_bit_cast(unsigned, __builtin_convertvector(v, bf16v2)); }
DI float bf_lo(unsigned w) { return __uint_as_float(w << 16); }
DI float bf_hi(unsigned w) { return __uint_as_float(w & 0xffff0000u); }
DI float wave_sum(float v) {
#pragma unroll
    for (int o = 1; o < 64; o <<= 1) v += __shfl_xor(v, o);
    return v;
}
DI int otid(int wv) { int t; asm volatile("v_mbcnt_lo_u32_b32 %0, -1, 0\n\tv_mbcnt_hi_u32_b32 %0, -1, %0" : "=v"(t)); return wv * 64 + t; }
DI float siluf(float x) { return x / (1.f + __expf(-x)); }
DI float sigmf(float x) { return 1.f / (1.f + __expf(-x)); }
DI void st_bf16x8(bf16_t* p, f32x4 a, f32x4 b) { u32x4 w = {pk2(a[0], a[1]), pk2(a[2], a[3]), pk2(b[0], b[1]), pk2(b[2], b[3])}; *(u32x4*)p = w; }
DI void ld_bf16x8(const bf16_t* p, f32x4& a, f32x4& b) { const u32x4 w = *(const u32x4*)p; a = (f32x4){bf_lo(w.x), bf_hi(w.x), bf_lo(w.y), bf_hi(w.y)}; b = (f32x4){bf_lo(w.z), bf_hi(w.z), bf_lo(w.w), bf_hi(w.w)}; }

struct Args { const float* in[18]; float* out; unsigned char* ws; int ph_lo, ph_hi; };

#define XB_TMO      128
#define XB_XCNT(j)  (256  + 64 * (j))
#define XB_XSUB(j)  (1280 + 64 * (j))
#define XB_XGEN(j)  (2304 + 64 * (j))
#define XB_TOP      3328
#define XB_TOPGEN   3392
#define XCD_BAR_WORDS 3456
#define XB_SPIN_CAP (1u << 18)

__device__ __forceinline__ unsigned xb_ld(unsigned* p)              { return __hip_atomic_load(p, __ATOMIC_RELAXED, __HIP_MEMORY_SCOPE_AGENT); }
__device__ __forceinline__ unsigned xb_add(unsigned* p, unsigned v) { return __hip_atomic_fetch_add(p, v, __ATOMIC_RELAXED, __HIP_MEMORY_SCOPE_AGENT); }
__device__ __forceinline__ unsigned xb_xcc_id() { return (unsigned)__builtin_amdgcn_s_getreg((3 << 11) | 20) & 0xFu; }
#define XB_SPIN(cond, bar) do { unsigned _sp = 0; while (cond) { __builtin_amdgcn_s_sleep(1); \
    if ((++_sp & 255u) == 0u) { if (xb_ld(&(bar)[XB_TMO])) break; if (_sp > XB_SPIN_CAP) { atomicAdd(&(bar)[XB_TMO], 1u); break; } } } } while (0)

struct XcdBarrier {
    unsigned* bar; unsigned x;
    volatile LAS unsigned* st;
};

__device__ __forceinline__ XcdBarrier xcd_barrier_post(unsigned* bar, volatile LAS unsigned* st, int wv) {
    XcdBarrier b; b.bar = bar; b.x = xb_xcc_id(); b.st = st;
    if (otid(wv) == 0) (void)xb_add(&bar[XB_XCNT(b.x)], 1u);
    return b;
}
__device__ __forceinline__ void xcd_barrier_complete(unsigned* bar, unsigned x, unsigned& nloc, unsigned& nx) {
    const unsigned G = gridDim.x * gridDim.y * gridDim.z;
    unsigned sum, cnt, mine, sp = 0u;
    for (;;) {
        sum = 0u; cnt = 0u; mine = 0u;
#pragma unroll
        for (unsigned j = 0; j < 16; ++j) { const unsigned c = xb_ld(&bar[XB_XCNT(j)]); sum += c; cnt += (c > 0u) ? 1u : 0u; mine = (j == x) ? c : mine; }
        if (sum == G) break;
        __builtin_amdgcn_s_sleep(1);
        if ((++sp & 255u) == 0u) { if (xb_ld(&bar[XB_TMO])) break; if (sp > XB_SPIN_CAP) { atomicAdd(&bar[XB_TMO], 1u); break; } }
    }
    nloc = mine > 0u ? mine : 1u; nx = cnt > 0u ? cnt : 1u;
}

__device__ __forceinline__ void xcd_barrier(const XcdBarrier& b, int wv) {
    asm volatile("s_waitcnt vmcnt(0)" ::: "memory");
    __syncthreads();
    if (otid(wv) == 0) {
        unsigned* bar = b.bar;
        __builtin_amdgcn_s_waitcnt(0);
        unsigned nloc = b.st[0], nx = b.st[1];
        if (nloc == 0u) { xcd_barrier_complete(bar, b.x, nloc, nx); b.st[0] = nloc; b.st[1] = nx; }
        const unsigned old = xb_add(&bar[XB_XSUB(b.x)], 1u);
        const unsigned gen = old / nloc;
        if (old + 1u == (gen + 1u) * nloc) {
            __builtin_amdgcn_fence(__ATOMIC_RELEASE, "agent");
            asm volatile("s_waitcnt vmcnt(0)" ::: "memory");
            const unsigned og = xb_add(&bar[XB_TOP], 1u);
            const unsigned tg = og / nx;
            if (og + 1u == (tg + 1u) * nx) xb_add(&bar[XB_TOPGEN], 1u);
            else XB_SPIN(xb_ld(&bar[XB_TOPGEN]) == tg, bar);
            __builtin_amdgcn_fence(__ATOMIC_ACQUIRE, "agent");
            xb_add(&bar[XB_XGEN(b.x)], 1u);
            asm volatile("s_waitcnt vmcnt(0)" ::: "memory");
        } else {
            XB_SPIN(xb_ld(&bar[XB_XGEN(b.x)]) == gen, bar);
            __builtin_amdgcn_fence(__ATOMIC_ACQUIRE, "agent");
            asm volatile("s_waitcnt vmcnt(0)" ::: "memory");
        }
    }
    __syncthreads();
}


namespace pg8 {
constexpr int BM = 256, BK = 64, HALF = 128, HTB = HALF * BK * 2, NXCD = 8;
DI int lds_byte(int r, int c) { const int st = (r >> 4) * 2 + (c >> 5), rr = r & 15, cc = c & 31, ob = rr * 64 + cc * 2; return st * 1024 + (ob ^ (((ob >> 9) & 1) << 5)); }
DI void stage_rc(int b, int& R, int& C) { const int st = b / 1024, sb = b % 1024, swz = sb ^ (((sb >> 9) & 1) << 5); R = (st >> 1) * 16 + swz / 64; C = (st & 1) * 32 + (swz % 64) / 2; }
DI int perm32(int rho) { const int n = rho >> 4, i = rho & 15; return 8 * (i >> 2) + 4 * n + (i & 3); }
struct Unit { const char* a; const char* b; int i0, i1, i2; };
DI int xcd_remap(int L, int total) { const int q = total / NXCD, r = total % NXCD, xcd = L % NXCD, off = L / NXCD; return (xcd < r ? xcd * (q + 1) : r * (q + 1) + (xcd - r) * q) + off; }

template <class Desc, class Epi>
DI void gemm_phase(LAS unsigned char* lds, const Desc& D, const Epi& E, int wv) {
    const int tid = otid(wv), wid = __builtin_amdgcn_readfirstlane(tid >> 6), lane = tid & 63, wr = wid >> 2, wc = wid & 3, fr = lane & 15, fq = lane >> 4;
    const int G = gridDim.x, c = blockIdx.x, total = D.total;
    const int K = D.K, nt = K / BK;
    unsigned voffA[2], voffB[2];
#pragma unroll
    for (int i = 0; i < 2; ++i) { int R, C; stage_rc(tid * 16 + i * 8192, R, C); const int Rb = (R & ~31) + perm32(R & 31);
        voffA[i] = (unsigned)(R * D.lda + C) * 2u; voffB[i] = (unsigned)(Rb * D.ldb + C) * 2u; }
    const size_t kstep = (size_t)(BK * 2);
    const size_t hstepA = (size_t)HALF * D.lda * 2, hstepB = (size_t)HALF * D.ldb * 2;
    const unsigned ldsw = (unsigned)wid * 1024u;
    const int aoff = lds_byte(wr * 64 + fr, fq * 8), boff = lds_byte(wc * 32 + fr, fq * 8);
#define PG8_SA(b, h) (((b) * 2 + (h)) * HTB)
#define PG8_SB(b, h) ((4 + (b) * 2 + (h)) * HTB)
#define PG8_STAGE(bufoff, gbase, voff) do { _Pragma("unroll") for (int _i = 0; _i < 2; ++_i) \
        __builtin_amdgcn_global_load_lds((const unsigned*)((const char*)(gbase) + (voff)[_i]), (LAS unsigned*)(lds + (bufoff) + ldsw + _i * 8192), 16, 0, 0); } while (0)
#define PG8_LDA(dst, b, h) do { _Pragma("unroll") for (int m = 0; m < 4; ++m) _Pragma("unroll") for (int k = 0; k < 2; ++k) dst[m][k] = *(const LAS bf16x8*)(lds + PG8_SA(b, h) + aoff + m * 2048 + k * 1024); } while (0)
#define PG8_LDB(dst, b, h) do { _Pragma("unroll") for (int n = 0; n < 2; ++n) _Pragma("unroll") for (int k = 0; k < 2; ++k) dst[n][k] = *(const LAS bf16x8*)(lds + PG8_SB(b, h) + boff + n * 2048 + k * 1024); } while (0)
#define PG8_MMA(ai, bj, At, Bt) do { __builtin_amdgcn_s_setprio(1); _Pragma("unroll") for (int m = 0; m < 4; ++m) _Pragma("unroll") for (int n = 0; n < 2; ++n) _Pragma("unroll") for (int k = 0; k < 2; ++k) \
        acc[ai][bj][m][n] = __builtin_amdgcn_mfma_f32_16x16x32_bf16(Bt[n][k], At[m][k], acc[ai][bj][m][n], 0, 0, 0); __builtin_amdgcn_s_setprio(0); } while (0)
#define PG8_WAIT_V(n) asm volatile("s_waitcnt vmcnt(" #n ")" ::: "memory")
#define PG8_WAIT_L(n) asm volatile("s_waitcnt lgkmcnt(" #n ")" ::: "memory")
#define PG8_BAR __builtin_amdgcn_s_barrier()
#define PG8_SCHED __builtin_amdgcn_sched_barrier(0)
    if (c >= total) return;
    Unit cur = D.unit(xcd_remap(c, total)), nxt = cur; int ui = 0;
    f32x4 acc[2][2][4][2];
#pragma unroll
    for (int a = 0; a < 2; ++a)
#pragma unroll
        for (int b = 0; b < 2; ++b)
#pragma unroll
            for (int m = 0; m < 4; ++m)
#pragma unroll
                for (int n = 0; n < 2; ++n) acc[a][b][m][n] = (f32x4){0.f, 0.f, 0.f, 0.f};
    bf16x8 At[4][2], B0[2][2], B1[2][2];
    const char* cA = cur.a; const char* cB = cur.b;
    PG8_STAGE(PG8_SB(0, 0), cB, voffB); PG8_STAGE(PG8_SB(0, 1), cB + hstepB, voffB); PG8_STAGE(PG8_SA(0, 0), cA, voffA); PG8_STAGE(PG8_SA(0, 1), cA + hstepA, voffA);
    if (wr == 1) PG8_BAR;
    PG8_WAIT_V(2); PG8_BAR;
    PG8_STAGE(PG8_SB(1, 0), cB + kstep, voffB); PG8_STAGE(PG8_SA(1, 0), cA + kstep, voffA); PG8_STAGE(PG8_SB(1, 1), cB + hstepB + kstep, voffB);
    PG8_WAIT_V(6); PG8_BAR;
    for (;;) {
        const long Ln = (long)(ui + 1) * G + c;
        const bool has_next = Ln < total;
        if (has_next) nxt = D.unit(xcd_remap((int)Ln, total));
        const char* nA = has_next ? nxt.a : cA; const char* nB = has_next ? nxt.b : cB;
        for (int t = 0; t < nt; t += 2) {
            const bool last = (t == nt - 2);
            const char* a1 = cA + (size_t)(t + 1) * kstep;
            const char* a2 = last ? nA : cA + (size_t)(t + 2) * kstep; const char* b2 = last ? nB : cB + (size_t)(t + 2) * kstep;
            const char* a3 = a2 + kstep; const char* b3 = b2 + kstep;
            PG8_LDB(B0, 0, 0); PG8_LDB(B1, 0, 1); PG8_SCHED; PG8_LDA(At, 0, 0); PG8_STAGE(PG8_SA(1, 1), a1 + hstepA, voffA);
            PG8_WAIT_V(8); PG8_WAIT_L(0); PG8_BAR; PG8_MMA(0, 0, At, B0); PG8_MMA(0, 1, At, B1); PG8_BAR; PG8_SCHED;
            PG8_LDA(At, 0, 1); PG8_STAGE(PG8_SB(0, 0), b2, voffB); PG8_STAGE(PG8_SB(0, 1), b2 + hstepB, voffB); PG8_STAGE(PG8_SA(0, 0), a2, voffA);
            PG8_WAIT_V(8); PG8_WAIT_L(0); PG8_BAR; PG8_MMA(1, 0, At, B0); PG8_MMA(1, 1, At, B1); PG8_BAR; PG8_SCHED;
            PG8_LDB(B0, 1, 0); PG8_LDB(B1, 1, 1); PG8_SCHED; PG8_LDA(At, 1, 0); PG8_STAGE(PG8_SA(0, 1), a2 + hstepA, voffA);
            PG8_WAIT_V(8); PG8_WAIT_L(0); PG8_BAR; PG8_MMA(0, 0, At, B0); PG8_MMA(0, 1, At, B1); PG8_BAR; PG8_SCHED;
            PG8_LDA(At, 1, 1); PG8_STAGE(PG8_SB(1, 0), b3, voffB); PG8_STAGE(PG8_SB(1, 1), b3 + hstepB, voffB); PG8_STAGE(PG8_SA(1, 0), a3, voffA);
            PG8_WAIT_V(8); PG8_WAIT_L(0); PG8_BAR; PG8_MMA(1, 0, At, B0); PG8_MMA(1, 1, At, B1); PG8_BAR; PG8_SCHED;
        }
        if (wr == 0) PG8_BAR;
#pragma unroll
        for (int ai = 0; ai < 2; ++ai)
#pragma unroll
            for (int m = 0; m < 4; ++m)
#pragma unroll
                for (int bj = 0; bj < 2; ++bj)
                    E(cur, ai * HALF + wr * 64 + m * 16 + fr, bj * HALF + wc * 32 + 8 * fq, acc[ai][bj][m][0], acc[ai][bj][m][1]);
        if (!has_next) break;
#pragma unroll
        for (int a = 0; a < 2; ++a)
#pragma unroll
            for (int b = 0; b < 2; ++b)
#pragma unroll
                for (int m = 0; m < 4; ++m)
#pragma unroll
                    for (int n = 0; n < 2; ++n) acc[a][b][m][n] = (f32x4){0.f, 0.f, 0.f, 0.f};
        cur = nxt; cA = nA; cB = nB; ++ui;
        if (wr == 1) PG8_BAR;
    }
    PG8_WAIT_V(0);
    PG8_BAR;
#undef PG8_SA
#undef PG8_SB
#undef PG8_STAGE
#undef PG8_LDA
#undef PG8_LDB
#undef PG8_MMA
#undef PG8_WAIT_V
#undef PG8_WAIT_L
#undef PG8_BAR
#undef PG8_SCHED
}
}

DI void transpose_item(const float* W, int N, int kb, int nb, bf16_t* d0, bf16_t* d1, int K, LAS float* scr, int lane) {
    const int k0 = 64 * kb, n0 = 32 * nb;
#pragma unroll 8
    for (int i = 0; i < 32; ++i) { const int kk = 2 * i + (lane >> 5); scr[kk * 33 + (lane & 31)] = W[(size_t)(k0 + kk) * N + n0 + (lane & 31)]; }
    asm volatile("s_waitcnt lgkmcnt(0)" ::: "memory");
    const int c = lane & 7;
#pragma unroll
    for (int j = 0; j < 4; ++j) { const int n = (lane >> 3) + 8 * j; const LAS float* s = scr + (8 * c) * 33 + n;
        u32x4 o; o.x = pk2(s[0 * 33], s[1 * 33]); o.y = pk2(s[2 * 33], s[3 * 33]); o.z = pk2(s[4 * 33], s[5 * 33]); o.w = pk2(s[6 * 33], s[7 * 33]);
        *(u32x4*)(d0 + (size_t)n * K + k0 + 8 * c) = o;
        if (d1) *(u32x4*)(d1 + (size_t)n * K + k0 + 8 * c) = o; }
    asm volatile("s_waitcnt lgkmcnt(0)" ::: "memory");
}

DI void prep_phase(const Args& A, LAS unsigned char* lds, int wv) {
    const int tid = otid(wv), lane = tid & 63, wave = tid >> 6, G = gridDim.x;
    unsigned char* ws = A.ws;
    {
        LAS float* s_lds = (LAS float*)lds;
        const float* cc = A.in[1]; const float* cctx = A.in[3]; const float* aw = A.in[4]; const float* ab = A.in[5];
        float* mod = (float*)(ws + WS_MOD);
        for (int item = blockIdx.x; item < 768; item += G) {
            const int kc = item % 16, cb = (item / 16) % 12, l = item / 192;
            const int k0 = kc * 128, j = cb * 512 + tid;
            __syncthreads();
            for (int e = tid; e < 17 * 128; e += NTHREADS) { const int r = e / 128, k = e % 128; const float v = r < 16 ? cc[r * DM + k0 + k] : cctx[k0 + k]; s_lds[k * 20 + r] = siluf(v); }
            __syncthreads();
            float acc[17];
#pragma unroll
            for (int r = 0; r < 17; ++r) acc[r] = 0.f;
            const float* wp = aw + ((size_t)l * DM + k0) * MOD_LD + j;
#pragma unroll 4
            for (int k = 0; k < 128; ++k) {
                const float w = wp[(size_t)k * MOD_LD];
                const LAS f32x4* sp = (const LAS f32x4*)(s_lds + k * 20);
                const f32x4 s0 = sp[0], s1 = sp[1], s2 = sp[2], s3 = sp[3]; const float s4 = s_lds[k * 20 + 16];
#pragma unroll
                for (int q = 0; q < 4; ++q) { acc[q] += s0[q] * w; acc[4 + q] += s1[q] * w; acc[8 + q] += s2[q] * w; acc[12 + q] += s3[q] * w; }
                acc[16] += s4 * w;
            }
            const float bias = (kc == 0) ? ab[l * MOD_LD + j] : 0.f;
#pragma unroll
            for (int r = 0; r < 17; ++r) unsafeAtomicAdd(&mod[(size_t)(l * 17 + r) * MOD_LD + j], acc[r] + bias);
        }
        __syncthreads();
    }
    {
        LAS float* scr = (LAS float*)(lds + wave * 16384);
        const int gw = blockIdx.x * NWAVES + wave, NGW = G * NWAVES;
        constexpr int I_SQ = 32 * 64, I_AI = 32 * 160, I_MI = 32 * 257;
        constexpr int NIT = 6 * I_SQ + I_AI + I_MI;
        for (int it = gw; it < NIT; it += NGW) {
            int r = it;
            if (r < 6 * I_SQ) {
                const int w = r / I_SQ; r -= w * I_SQ;
                const float* src; bf16_t* dst;
                if (w < 2)      { src = A.in[7] + (size_t)w * DM * DM;       dst = (bf16_t*)(ws + WS_WFG) + (size_t)w * DM * DM; }
                else if (w < 4) { src = A.in[8] + (size_t)(w - 2) * DM * DM; dst = (bf16_t*)(ws + WS_WFO) + (size_t)(w - 2) * DM * DM; }
                else if (w == 4) { src = A.in[12]; dst = (bf16_t*)(ws + WS_WMO); }
                else             { src = A.in[16]; dst = (bf16_t*)(ws + WS_WAO); }
                const int kb = r / 64, nb = r % 64;
                transpose_item(src, DM, kb, nb, dst + (size_t)(32 * nb) * DM, nullptr, DM, scr, lane);
                continue;
            }
            r -= 6 * I_SQ;
            if (r < I_AI) { const int kb = r / 160, nb = r % 160; transpose_item(A.in[13], 5120, kb, nb, (bf16_t*)(ws + WS_WAI) + (size_t)(32 * nb) * DM, nullptr, DM, scr, lane); continue; }
            r -= I_AI;
            {
                const int kb = r / 257, nb = r % 257, n0 = 32 * nb;
                bf16_t* WA = (bf16_t*)(ws + WS_WMA); bf16_t* WB = (bf16_t*)(ws + WS_WMB);
                bf16_t* d0; bf16_t* d1 = nullptr;
                if (n0 < 1024) d0 = WA + (size_t)n0 * DM;
                else if (n0 < 2048) { d0 = WA + (size_t)n0 * DM; d1 = WB + (size_t)(n0 - 1024) * DM; }
                else if (n0 < 4096) d0 = WB + (size_t)(1024 + n0 - 2048) * DM;
                else if (n0 < 6144) d0 = WA + (size_t)(2304 + n0 - 4096) * DM;
                else if (n0 < 6176) d0 = WA + (size_t)(2048 + n0 - 6144) * DM;
                else d0 = WA + (size_t)(4352 + n0 - 6176) * DM;
                transpose_item(A.in[9], 8224, kb, nb, d0, d1, DM, scr, lane);
            }
        }
    }
    {
        const long gt = (long)blockIdx.x * NTHREADS + tid, NGT = (long)G * NTHREADS;
        constexpr long N_DC = 1024L * 512 / 8, N_DT = 2048L * 4096 / 8, N_DT2 = 256L * 512 / 8;
        for (long it = gt; it < N_DC + N_DT + N_DT2; it += NGT) {
            float v[8]; bf16_t* dst;
            if (it < N_DC) {
                const int m = (int)(it / 64), k0 = (int)(it % 64) * 8; const float sc = 0.044194173824159216f;
#pragma unroll
                for (int j = 0; j < 8; ++j) { const int rr = ((m & 511) * (k0 + j)) & 511; const float ang = (float)rr * (1.f / 256.f); v[j] = (m < 512 ? cospif(ang) : sinpif(ang)) * sc; }
                dst = (bf16_t*)(ws + WS_DC) + (size_t)m * 512 + k0;
            } else if (it < N_DC + N_DT) {
                const long i2 = it - N_DC; const int kk = (int)(i2 / 512), s0 = (int)(i2 % 512) * 8; const float sc = 0.022097086912079608f;
#pragma unroll
                for (int j = 0; j < 8; ++j) { const int s = s0 + j; const int rr = (kk * (s & 2047)) & 2047; const float ang = (float)rr * (1.f / 1024.f); v[j] = (s < 2048 ? cospif(ang) : -sinpif(ang)) * sc; }
                dst = (bf16_t*)(ws + WS_DT) + (size_t)kk * 4096 + s0;
            } else {
                const long i2 = it - N_DC - N_DT; const int kk = (int)(i2 / 64), s0 = (int)(i2 % 64) * 8; const float sc = 0.0625f;
#pragma unroll
                for (int j = 0; j < 8; ++j) { const int s = s0 + j; const int rr = (kk * (s & 255)) & 255; const float ang = (float)rr * (1.f / 128.f); v[j] = (s < 256 ? cospif(ang) : -sinpif(ang)) * sc; }
                dst = (bf16_t*)(ws + WS_DT2) + (size_t)kk * 512 + s0;
            }
            u32x4 o = {pk2(v[0], v[1]), pk2(v[2], v[3]), pk2(v[4], v[5]), pk2(v[6], v[7])};
            *(u32x4*)dst = o;
        }
    }
}

DI const float* xrow_ptr(const Args& A, int layer, int r) {
    const int b = r / TB, t = r % TB;
    if (t < TL) return (layer == 0 ? A.in[0] : (const float*)A.out) + ((size_t)b * TL + t) * DM;
    return (layer == 0 ? A.in[2] : (const float*)(A.ws + WS_CTXS)) + ((size_t)b * TC + (t - TL)) * DM;
}
DI void norm_phase(const Args& A, int layer, bool latonly, int wv) {
    const int tid = otid(wv), lane = tid & 63, wave = tid >> 6, G = gridDim.x;
    const float* ng = A.in[6] + (size_t)layer * DM;
    const float* mod = (const float*)(A.ws + WS_MOD) + (size_t)layer * 17 * MOD_LD;
    bf16_t* H = (bf16_t*)(A.ws + WS_H);
    for (int r = blockIdx.x * NWAVES + wave; r < NTOK; r += G * NWAVES) {
        const int b = r / TB, t = r % TB;
        if (latonly && t >= TL) continue;
        const float* xr = xrow_ptr(A, layer, r);
        const float* mr = mod + (size_t)(t < TL ? b : 16) * MOD_LD;
        f32x4 v[4][2]; float ss = 0.f;
#pragma unroll
        for (int j = 0; j < 4; ++j) { const f32x4* p = (const f32x4*)(xr + 512 * j + 8 * lane); v[j][0] = p[0]; v[j][1] = p[1];
#pragma unroll
            for (int q = 0; q < 4; ++q) ss += v[j][0][q] * v[j][0][q] + v[j][1][q] * v[j][1][q]; }
        const float rs = 1.0f / sqrtf(wave_sum(ss) * (1.f / DM) + EPS);
#pragma unroll
        for (int j = 0; j < 4; ++j) { const int c0 = 512 * j + 8 * lane; f32x4 o[2];
#pragma unroll
            for (int h = 0; h < 2; ++h) { const f32x4 g4 = *(const f32x4*)(ng + c0 + 4 * h), sh = *(const f32x4*)(mr + c0 + 4 * h), sc = *(const f32x4*)(mr + DM + c0 + 4 * h);
                o[h] = (v[j][h] * rs) * g4 * (sc + 1.0f) + sh; }
            st_bf16x8(H + (size_t)r * DM + c0, o[0], o[1]); }
    }
}
DI void final_norm_phase(const Args& A, const float* src_override, int wv) {
    const int tid = otid(wv), lane = tid & 63, wave = tid >> 6, G = gridDim.x;
    const float* fg = A.in[17];
    for (int r = blockIdx.x * NWAVES + wave; r < NB * TL; r += G * NWAVES) {
        const float* xr = (src_override ? src_override : (const float*)A.out) + (size_t)r * DM; float* orow = A.out + (size_t)r * DM;
        f32x4 v[4][2]; float ss = 0.f;
#pragma unroll
        for (int j = 0; j < 4; ++j) { const f32x4* p = (const f32x4*)(xr + 512 * j + 8 * lane); v[j][0] = p[0]; v[j][1] = p[1];
#pragma unroll
            for (int q = 0; q < 4; ++q) ss += v[j][0][q] * v[j][0][q] + v[j][1][q] * v[j][1][q]; }
        const float rs = 1.0f / sqrtf(wave_sum(ss) * (1.f / DM) + EPS);
#pragma unroll
        for (int j = 0; j < 4; ++j) { const int c0 = 512 * j + 8 * lane;
#pragma unroll
            for (int h = 0; h < 2; ++h) { const f32x4 g4 = *(const f32x4*)(fg + c0 + 4 * h); *(f32x4*)(orow + c0 + 4 * h) = (v[j][h] * rs) * g4; } }
    }
}


struct DescPlain {
    const bf16_t* A; const bf16_t* B; int nN; bool latonly; int lda, ldb, K, total;
    DI void init(const bf16_t* A_, const bf16_t* B_, int nN_, bool lat) { A = A_; B = B_; nN = nN_; latonly = lat; lda = DM; ldb = DM; K = DM; total = (lat ? 128 : 144) * nN_; }
    DI pg8::Unit unit(int idx) const {
        const int nMt = latonly ? 128 : 144, nig = 8 * nN, gid = idx / nig, fm = gid * 8, gsz = (nMt - fm) < 8 ? (nMt - fm) : 8;
        const int pmi = fm + (idx % nig) % gsz, pn = (idx % nig) / gsz, pm = latonly ? (pmi / 8) * 9 + (pmi % 8) : pmi;
        pg8::Unit u; u.a = (const char*)(A + (size_t)pm * 256 * DM); u.b = (const char*)(B + (size_t)pn * 256 * DM); u.i0 = pm; u.i1 = pn; u.i2 = 0; return u;
    }
};
struct DescChan {
    const bf16_t* DC; const bf16_t* H; int lda, ldb, K, total;
    DI void init(const bf16_t* DC_, const bf16_t* H_, bool lat) { DC = DC_; H = H_; lda = 512; ldb = DM; K = 512; total = lat ? 2048 : 2304; }
    DI pg8::Unit unit(int idx) const {
        pg8::Unit u; int b, g, mt, nt, toff;
        if (idx < 2048) { mt = idx % 4; nt = (idx / 4) % 8; g = (idx / 32) % 4; b = idx / 128; toff = nt * 256; u.i2 = nt; }
        else { const int j = idx - 2048; mt = j % 4; g = (j / 4) % 4; b = j / 16; toff = TL; u.i2 = 8; }
        u.a = (const char*)(DC + (size_t)mt * 256 * 512); u.b = (const char*)(H + ((size_t)b * TB + toff) * DM + g * 512); u.i0 = b * 4 + g; u.i1 = mt; return u;
    }
};
struct DescT {
    const bf16_t* DT; const bf16_t* PQ; int nMt; int lda, ldb, K, total;
    DI void init(const bf16_t* DT_, const bf16_t* PQ_, int ld, int Kd, int coff, int nMt_) { DT = DT_ + coff; PQ = PQ_ + coff; nMt = nMt_; lda = ld; ldb = ld; K = Kd; total = NB * nMt_ * 8; }
    DI pg8::Unit unit(int idx) const {
        const int mt = idx % nMt, nt = (idx / nMt) % 8, b = idx / (nMt * 8);
        pg8::Unit u; u.a = (const char*)(DT + (size_t)mt * 256 * lda); u.b = (const char*)(PQ + ((size_t)b * DM + nt * 256) * ldb); u.i0 = b; u.i1 = mt; u.i2 = nt; return u;
    }
};

DI void resid_store(const Args& A, int layer, int pm, int row_l, int col, const float* modl, f32x4 v0, f32x4 v1) {
    const int b = pm / 9, tt = pm % 9;
    const float* gp = modl + (size_t)(tt < 8 ? b : 16) * MOD_LD + 2 * DM + col;
    const f32x4 g0 = *(const f32x4*)gp, g1 = *(const f32x4*)(gp + 4);
    const float* src; float* dst;
    if (tt < 8) { const size_t off = ((size_t)b * TL + tt * 256 + row_l) * DM + col; src = (layer == 0 ? A.in[0] : (const float*)A.out) + off; dst = A.out + off; }
    else { const size_t off = ((size_t)b * TC + row_l) * DM + col; src = (layer == 0 ? A.in[2] : (const float*)(A.ws + WS_CTXS)) + off; dst = (float*)(A.ws + WS_CTXS) + off; }
    const f32x4 x0 = *(const f32x4*)src, x1 = *(const f32x4*)(src + 4);
    *(f32x4*)dst = x0 + g0 * v0; *(f32x4*)(dst + 4) = x1 + g1 * v1;
}

DI void fnet_layer(const Args& A, LAS unsigned char* lds, const XcdBarrier& gbar, int layer, int j, bool latonly, int wv) {
    unsigned char* ws = A.ws;
    const bf16_t* H = (const bf16_t*)(ws + WS_H); bf16_t* U = (bf16_t*)(ws + WS_H);
    bf16_t* Gt = (bf16_t*)(ws + WS_SCR + F_G); bf16_t* PQX = (bf16_t*)(ws + WS_SCR + F_PQX); bf16_t* PQC = (bf16_t*)(ws + WS_SCR + F_PQC);
    norm_phase(A, layer, latonly, wv);
    xcd_barrier(gbar, wv);
    {
        DescPlain D; D.init(H, (const bf16_t*)(ws + WS_WFG) + (size_t)j * DM * DM, 8, latonly);
        auto E = [=](const pg8::Unit& u, int row_l, int col_l, f32x4 v0, f32x4 v1) {
            f32x4 a, b;
#pragma unroll
            for (int q = 0; q < 4; ++q) { a[q] = siluf(v0[q]); b[q] = siluf(v1[q]); }
            st_bf16x8(Gt + ((size_t)u.i0 * 256 + row_l) * DM + u.i1 * 256 + col_l, a, b);
        };
        pg8::gemm_phase(lds, D, E, wv);
    }
    {
        DescChan D; D.init((const bf16_t*)(ws + WS_DC), H, latonly);
        auto E = [=](const pg8::Unit& u, int row_l, int col_l, f32x4 v0, f32x4 v1) {
            const int b = u.i0 >> 2, g = u.i0 & 3, mt = u.i1, half = mt >> 1, ch = g * 512 + (mt & 1) * 256 + row_l;
            bf16_t* dst = (u.i2 < 8) ? PQX + ((size_t)b * DM + ch) * 4096 + half * 2048 + u.i2 * 256 + col_l
                                     : PQC + ((size_t)b * DM + ch) * 512 + half * 256 + col_l;
            st_bf16x8(dst, v0, v1);
        };
        pg8::gemm_phase(lds, D, E, wv);
    }
    xcd_barrier(gbar, wv);
    bf16_t* A1 = (bf16_t*)(ws + WS_SCR + F_A1); float* NYQ = (float*)(ws + WS_SCR + F_NYQ);
    {
        const int tid = otid(wv), lane = tid & 63;
        for (int rr = blockIdx.x * NWAVES + wv; rr < NB * DM; rr += gridDim.x * NWAVES) {
            const bf16_t* pr = PQX + (size_t)rr * 4096; float acc = 0.f;
#pragma unroll
            for (int q = 0; q < 4; ++q) { f32x4 a, b; ld_bf16x8(pr + (q * 64 + lane) * 8, a, b); acc += (a[0] - a[1]) + (a[2] - a[3]) + (b[0] - b[1]) + (b[2] - b[3]); }
            acc = wave_sum(acc);
            if (lane == 0) NYQ[rr] = acc * 0.022097086912079608f;
        }
    }
    {
        DescT D; D.init((const bf16_t*)(ws + WS_DT), PQX, 4096, 2048, 0, 4);
        auto E = [=](const pg8::Unit& u, int row_l, int col_l, f32x4 v0, f32x4 v1) {
            st_bf16x8(A1 + ((size_t)u.i0 * 1024 + u.i1 * 256 + row_l) * DM + u.i2 * 256 + col_l, v0, v1);
        };
        pg8::gemm_phase(lds, D, E, wv);
    }
    xcd_barrier(gbar, wv);
    {
        DescT D; D.init((const bf16_t*)(ws + WS_DT), PQX, 4096, 2048, 2048, 4);
        auto E = [=](const pg8::Unit& u, int row_l, int col_l, f32x4 v0, f32x4 v1) {
            const int k = u.i1 * 256 + row_l, col = u.i2 * 256 + col_l;
            f32x4 a0, a1; ld_bf16x8(A1 + ((size_t)u.i0 * 1024 + k) * DM + col, a0, a1);
            const size_t off = ((size_t)u.i0 * TB + k) * DM + col;
            f32x4 g0, g1; ld_bf16x8(Gt + off, g0, g1);
            st_bf16x8(U + off, (a0 + v0) * g0, (a1 + v1) * g1);
            const size_t off2 = ((size_t)u.i0 * TB + (k == 0 ? 1024 : TL - k)) * DM + col;
            ld_bf16x8(Gt + off2, g0, g1);
            if (k == 0) { const float* nq = NYQ + (size_t)u.i0 * DM + col; a0 = *(const f32x4*)nq; a1 = *(const f32x4*)(nq + 4); v0 = (f32x4){0.f, 0.f, 0.f, 0.f}; v1 = v0; }
            st_bf16x8(U + off2, (a0 - v0) * g0, (a1 - v1) * g1);
        };
        pg8::gemm_phase(lds, D, E, wv);
    }
    if (!latonly) {
        DescT D; D.init((const bf16_t*)(ws + WS_DT2), PQC, 512, 512, 0, 1);
        auto E = [=](const pg8::Unit& u, int row_l, int col_l, f32x4 v0, f32x4 v1) {
            const size_t off = ((size_t)u.i0 * TB + TL + row_l) * DM + u.i2 * 256 + col_l;
            f32x4 g0, g1; ld_bf16x8(Gt + off, g0, g1);
            st_bf16x8(U + off, v0 * g0, v1 * g1);
        };
        pg8::gemm_phase(lds, D, E, wv);
    }
    xcd_barrier(gbar, wv);
    {
        DescPlain D; D.init(U, (const bf16_t*)(ws + WS_WFO) + (size_t)j * DM * DM, 8, latonly);
        const float* modl = (const float*)(ws + WS_MOD) + (size_t)layer * 17 * MOD_LD;
        auto E = [=](const pg8::Unit& u, int row_l, int col_l, f32x4 v0, f32x4 v1) { resid_store(A, layer, u.i0, row_l, u.i1 * 256 + col_l, modl, v0, v1); };
        pg8::gemm_phase(lds, D, E, wv);
    }
    xcd_barrier(gbar, wv);
}


namespace att {
constexpr int D = 128, NW = 8, QBLK = 32, KVBLK = 64;
constexpr float SCALE = 0.088388347648318440f;
constexpr float THR = 8.f;
constexpr int LDQ = 2048, LDK = 512;
constexpr size_t SHM_V = KVBLK * D * 2, SHM_K = KVBLK * D * 2;
typedef float f32x8 __attribute__((ext_vector_type(8)));
#define KSWZ(row, colB) ((row) * 256 + ((colB) ^ (((row) & 7) << 4)))
#define SBAR() __builtin_amdgcn_sched_barrier(0)
DI int crow(int r, int hi) { return (r & 3) + 8 * (r >> 2) + 4 * hi; }
DI unsigned cvtpk(float lo, float hi) { unsigned r; asm volatile("v_cvt_pk_bf16_f32 %0, %1, %2" : "=v"(r) : "v"(lo), "v"(hi)); return r; }
DI void partialSM(f32x16& p0, f32x16& p1, float& m_reg, float& mn, float& alpha) {
  constexpr float C = SCALE * 1.4426950408889634f;
  float pmax = p0[0];
#pragma unroll
  for (int r = 1; r < 16; ++r) pmax = fmaxf(pmax, p0[r]);
#pragma unroll
  for (int r = 0; r < 16; ++r) pmax = fmaxf(pmax, p1[r]);
  { auto rr = __builtin_amdgcn_permlane32_swap(__float_as_uint(pmax), __float_as_uint(pmax), false, false);
    pmax = fmaxf(__uint_as_float(rr[0]), __uint_as_float(rr[1])); }
  if (__builtin_expect(__all(pmax - m_reg <= THR / SCALE), 1)) { mn = m_reg; alpha = 1.f; }
  else { mn = fmaxf(m_reg, pmax); alpha = __builtin_amdgcn_exp2f((m_reg - mn) * C); m_reg = mn; }
  float mnC = -mn * C;
#pragma unroll
  for (int r = 0; r < 16; ++r) p0[r] = fmaf(p0[r], C, mnC);
#pragma unroll
  for (int r = 0; r < 16; ++r) p1[r] = fmaf(p1[r], C, mnC);
#pragma unroll
  for (int r = 0; r < 16; ++r) p0[r] = __builtin_amdgcn_exp2f(p0[r]);
}
DI void finishSM(f32x16& p0, f32x16& p1, float alpha, float& l_reg, bf16x8& pa0, bf16x8& pa1, bf16x8& pa2, bf16x8& pa3) {
#pragma unroll
  for (int r = 0; r < 16; ++r) p1[r] = __builtin_amdgcn_exp2f(p1[r]);
  float ps = 0;
#pragma unroll
  for (int r = 0; r < 16; ++r) ps += p0[r];
#pragma unroll
  for (int r = 0; r < 16; ++r) ps += p1[r];
  { auto rr = __builtin_amdgcn_permlane32_swap(__float_as_uint(ps), __float_as_uint(ps), false, false);
    ps = __uint_as_float(rr[0]) + __uint_as_float(rr[1]); }
  l_reg = l_reg * alpha + ps;
#define PK4(P, BASE, OUT) do { unsigned a0 = cvtpk(P[BASE + 0], P[BASE + 1]), a1 = cvtpk(P[BASE + 2], P[BASE + 3]);   \
    unsigned b0 = cvtpk(P[BASE + 4], P[BASE + 5]), b1 = cvtpk(P[BASE + 6], P[BASE + 7]);                              \
    auto r0 = __builtin_amdgcn_permlane32_swap(a0, b0, false, false); auto r1 = __builtin_amdgcn_permlane32_swap(a1, b1, false, false); \
    u32x4 w = {r0[0], r1[0], r0[1], r1[1]}; OUT = *reinterpret_cast<bf16x8*>(&w); } while (0)
  PK4(p0, 0, pa0); PK4(p0, 8, pa1); PK4(p1, 0, pa2); PK4(p1, 8, pa3);
#undef PK4
}
DI void qkt(f32x16& p0, f32x16& p1, const bf16_t* Ks, const bf16x8* qr, int r32, int hi) {
  p0 = f32x16{}; p1 = f32x16{};
#pragma unroll
  for (int d0 = 0; d0 < 8; ++d0) { int cb = (d0 * 16 + hi * 8) * 2;
    bf16x8 b0 = *reinterpret_cast<const bf16x8*>((const char*)Ks + KSWZ(r32, cb));
    bf16x8 b1 = *reinterpret_cast<const bf16x8*>((const char*)Ks + KSWZ(32 + r32, cb));
    p0 = __builtin_amdgcn_mfma_f32_32x32x16_bf16(b0, qr[d0], p0, 0, 0, 0);
    p1 = __builtin_amdgcn_mfma_f32_32x32x16_bf16(b1, qr[d0], p1, 0, 0, 0); }
}
DI int v_st(int k, int c) { const int kk = (k & ~0xC) | ((k & 4) << 1) | ((k & 8) >> 1); return ((kk >> 3) * 4 + (c >> 5)) * 512 + ((kk & 7) * 32 + (c & 31)) * 2; }
DI int v_rd_base(int lane) { return ((lane & 3) << 3) | (((lane >> 2) & 3) << 6) | (((lane >> 4) & 1) << 5) | (((lane >> 5) & 1) << 8); }
constexpr int v_rd_off(int d0, int ks, int half) { return d0 * 512 + ks * 4096 + half * 2048; }
template <int OFF> DI s16x4 tr_read(int vb) {
  s16x4 r; asm volatile("ds_read_b64_tr_b16 %0, %1 offset:%2" : "=&v"(r) : "v"(vb), "i"(OFF) : "memory"); return r;
}
template <int D0> DI void pv_one(f32x16& od, int vb, bf16x8 pa0, bf16x8 pa1, bf16x8 pa2, bf16x8 pa3) {
  const s16x4 l0 = tr_read<v_rd_off(D0, 0, 0)>(vb), h0 = tr_read<v_rd_off(D0, 0, 1)>(vb), l1 = tr_read<v_rd_off(D0, 1, 0)>(vb), h1 = tr_read<v_rd_off(D0, 1, 1)>(vb);
  const s16x4 l2 = tr_read<v_rd_off(D0, 2, 0)>(vb), h2 = tr_read<v_rd_off(D0, 2, 1)>(vb), l3 = tr_read<v_rd_off(D0, 3, 0)>(vb), h3 = tr_read<v_rd_off(D0, 3, 1)>(vb);
  asm volatile("s_waitcnt lgkmcnt(0)" ::: "memory"); SBAR();
#define PK(L, H) (bf16x8){L[0], L[1], L[2], L[3], H[0], H[1], H[2], H[3]}
  od = __builtin_amdgcn_mfma_f32_32x32x16_bf16(pa0, PK(l0, h0), od, 0, 0, 0);
  od = __builtin_amdgcn_mfma_f32_32x32x16_bf16(pa1, PK(l1, h1), od, 0, 0, 0);
  od = __builtin_amdgcn_mfma_f32_32x32x16_bf16(pa2, PK(l2, h2), od, 0, 0, 0);
  od = __builtin_amdgcn_mfma_f32_32x32x16_bf16(pa3, PK(l3, h3), od, 0, 0, 0);
#undef PK
}
DI void pv_d0(f32x16* o, int vb, bf16x8 pa0, bf16x8 pa1, bf16x8 pa2, bf16x8 pa3) {
  pv_one<0>(o[0], vb, pa0, pa1, pa2, pa3); pv_one<1>(o[1], vb, pa0, pa1, pa2, pa3); pv_one<2>(o[2], vb, pa0, pa1, pa2, pa3); pv_one<3>(o[3], vb, pa0, pa1, pa2, pa3);
}
DI void attn_dense_body(const bf16_t* __restrict__ Qb, const bf16_t* __restrict__ Kh, const bf16_t* __restrict__ Vh, const bf16_t* SZb, bf16_t* Ub, int seq, char* lds, int wv) {
  const int tid = otid(wv), wid = tid >> 6, lane = tid & 63, r32 = lane & 31, hi = lane >> 5;
  bf16_t* V_lds = (bf16_t*)lds; bf16_t* K_lds = (bf16_t*)(lds + 2 * SHM_V);
  float* wsf = (float*)(lds + 2 * SHM_V + 2 * SHM_K) + wid * 64; float* li_l = wsf; float* al_l = wsf + 32;
  float m_reg = -1e30f, l_reg = 0; f32x16 o[4] = {}; bf16x8 qr[8];
  const bf16_t* Qw = Qb + (long)(wid * QBLK + r32) * LDQ + hi * 8;
#pragma unroll
  for (int d0 = 0; d0 < 8; ++d0) qr[d0] = *reinterpret_cast<const bf16x8*>(Qw + d0 * 16);
  const int sr = tid >> 4, sc = (tid & 15) * 8, vst0 = v_st(sr, sc), vst1 = v_st(32 + sr, sc);
  const int vb0 = (int)(uintptr_t)V_lds + v_rd_base(lane);
  struct { bf16x8 vs0, vs1, ks0, ks1; } sr_[2];
#define SLOAD(i, k0) do { sr_[i].vs0 = *reinterpret_cast<const bf16x8*>(&Vh[(long)((k0) + sr) * LDK + sc]); sr_[i].vs1 = *reinterpret_cast<const bf16x8*>(&Vh[(long)((k0) + 32 + sr) * LDK + sc]); \
    sr_[i].ks0 = *reinterpret_cast<const bf16x8*>(&Kh[(long)((k0) + sr) * LDK + sc]); sr_[i].ks1 = *reinterpret_cast<const bf16x8*>(&Kh[(long)((k0) + 32 + sr) * LDK + sc]); } while (0)
#define SWRITE(b, i) do { *(bf16x8*)((char*)V_lds + (b) * SHM_V + vst0) = sr_[i].vs0;          \
    *(bf16x8*)((char*)V_lds + (b) * SHM_V + vst1) = sr_[i].vs1; int kc = sc * 2;               \
    *(bf16x8*)((char*)K_lds + (b) * SHM_K + KSWZ(sr, kc)) = sr_[i].ks0;                       \
    *(bf16x8*)((char*)K_lds + (b) * SHM_K + KSWZ(32 + sr, kc)) = sr_[i].ks1; } while (0)
#define SWAIT() asm volatile("s_waitcnt vmcnt(4)" ::: "memory")
#define RESC(a) do { if (__any((a) < 1.f)) { if (hi == 0) al_l[r32] = (a); asm volatile("s_waitcnt lgkmcnt(0)" ::: "memory"); \
    _Pragma("unroll") for (int d = 0; d < 4; ++d) _Pragma("unroll") for (int r = 0; r < 16; ++r) o[d][r] *= al_l[crow(r, hi)]; } } while (0)
  f32x16 pA0, pA1, pB0, pB1; float mnA, mnB, alA, alB; bf16x8 pa0, pa1, pa2, pa3; const int NT = seq / KVBLK;
  constexpr int SE = 0, SO = 1;
  SLOAD(SE, 0); asm volatile("s_waitcnt vmcnt(0)" ::: "memory"); SWRITE(0, SE); __syncthreads();
  qkt(pA0, pA1, K_lds, qr, r32, hi); partialSM(pA0, pA1, m_reg, mnA, alA);
  SLOAD(SO, KVBLK); if (2 < NT) SLOAD(SE, 2 * KVBLK);
  SWAIT(); SWRITE(1, SO); __syncthreads();
  for (int j = 1; j + 1 < NT; j += 2) {
    SBAR(); qkt(pB0, pB1, (bf16_t*)((char*)K_lds + SHM_K), qr, r32, hi);
    finishSM(pA0, pA1, alA, l_reg, pa0, pa1, pa2, pa3); SBAR();
    SLOAD(SO, (j + 2) * KVBLK); SBAR();
    pv_d0(o, vb0, pa0, pa1, pa2, pa3); partialSM(pB0, pB1, m_reg, mnB, alB);
    __syncthreads(); SWAIT(); SWRITE(0, SE);
    RESC(alB); __syncthreads();
    SBAR(); qkt(pA0, pA1, K_lds, qr, r32, hi);
    finishSM(pB0, pB1, alB, l_reg, pa0, pa1, pa2, pa3); SBAR();
    if (j + 3 < NT) SLOAD(SE, (j + 3) * KVBLK); SBAR();
    pv_d0(o, vb0 + (int)SHM_V, pa0, pa1, pa2, pa3); partialSM(pA0, pA1, m_reg, mnA, alA);
    __syncthreads(); SWAIT(); SWRITE(1, SO);
    RESC(alA); __syncthreads();
  }
  SBAR(); qkt(pB0, pB1, (bf16_t*)((char*)K_lds + SHM_K), qr, r32, hi);
  finishSM(pA0, pA1, alA, l_reg, pa0, pa1, pa2, pa3); SBAR();
  pv_d0(o, vb0, pa0, pa1, pa2, pa3); partialSM(pB0, pB1, m_reg, mnB, alB);
  __syncthreads(); RESC(alB);
  finishSM(pB0, pB1, alB, l_reg, pa0, pa1, pa2, pa3); SBAR();
  pv_d0(o, vb0 + (int)SHM_V, pa0, pa1, pa2, pa3);
  if (hi == 0) li_l[r32] = l_reg; asm volatile("s_waitcnt lgkmcnt(0)" ::: "memory");
  float rli[16];
#pragma unroll
  for (int r = 0; r < 16; ++r) rli[r] = __builtin_amdgcn_rcpf(li_l[crow(r, hi)]);
#pragma unroll
  for (int r = 0; r < 16; ++r) { const long ro = (long)(wid * QBLK + crow(r, hi)) * LDQ + r32;
#pragma unroll
    for (int d0 = 0; d0 < 4; ++d0) Ub[ro + d0 * 32] = (bf16_t)(pk2(o[d0][r] * rli[r], 0.f) & 0xffffu); }
  __syncthreads();
#pragma unroll 2
  for (int i = 0; i < 8; ++i) { const int id = tid + 512 * i; const long off = (long)(id >> 4) * LDQ + (id & 15) * 8;
    f32x4 a0, a1, z0, z1; ld_bf16x8(Ub + off, a0, a1); ld_bf16x8(SZb + off, z0, z1); st_bf16x8(Ub + off, a0 * z0, a1 * z1); }
  __syncthreads();
#undef SLOAD
#undef SWRITE
#undef SWAIT
#undef RESC
}
#undef KSWZ
#undef SBAR
}

DI void qknorm_phase(const Args& A, int wv) {
    const int tid = otid(wv), lane = tid & 63, wave = tid >> 6, G = gridDim.x;
    bf16_t* Q = (bf16_t*)(A.ws + WS_SCR + A_Q); bf16_t* Kb = (bf16_t*)(A.ws + WS_SCR + A_K);
    const float* qn = A.in[14]; const float* kn = A.in[15];
    const int sub = lane >> 4, l16 = lane & 15, e0 = l16 * 8;
    const long NIT = (long)NTOK * 20;
    for (long it = ((long)blockIdx.x * NWAVES + wave) * 4 + sub; it < NIT; it += (long)G * NWAVES * 4) {
        const int row = (int)(it / 20), hj = (int)(it % 20);
        bf16_t* p = (hj < 16) ? Q + (size_t)row * 2048 + hj * 128 + e0 : Kb + (size_t)row * 512 + (hj - 16) * 128 + e0;
        const float* wn = (hj < 16 ? qn : kn) + e0;
        f32x4 a, b; ld_bf16x8(p, a, b);
        float ss = 0.f;
#pragma unroll
        for (int q = 0; q < 4; ++q) ss += a[q] * a[q] + b[q] * b[q];
        ss += __shfl_xor(ss, 1); ss += __shfl_xor(ss, 2); ss += __shfl_xor(ss, 4); ss += __shfl_xor(ss, 8);
        const float rs = 1.0f / sqrtf(ss * (1.f / 128.f) + EPS);
        const f32x4 w0 = *(const f32x4*)wn, w1 = *(const f32x4*)(wn + 4);
        a = a * rs * w0; b = b * rs * w1;
        const int t = row % TB;
        if (t < TL) {
            const float pos = (l16 < 8) ? (float)(t >> 6) : (float)(t & 63);
            float y[8] = {a[0], a[1], a[2], a[3], b[0], b[1], b[2], b[3]};
#pragma unroll
            for (int pp = 0; pp < 4; ++pp) {
                const int fi = (4 * l16 + pp) & 31;
                const float ang = pos * exp2f(-(float)fi * 0.41524101186092029f);
                const float cs = cosf(ang), sn = sinf(ang);
                const float x0 = y[2 * pp], x1 = y[2 * pp + 1];
                y[2 * pp] = x0 * cs - x1 * sn; y[2 * pp + 1] = x0 * sn + x1 * cs;
            }
            a = (f32x4){y[0], y[1], y[2], y[3]}; b = (f32x4){y[4], y[5], y[6], y[7]};
        }
        st_bf16x8(p, a, b);
    }
}

DI void attn_layer(const Args& A, LAS unsigned char* lds, char* lds_gen, const XcdBarrier& gbar, int layer, int wv) {
    unsigned char* ws = A.ws;
    const bf16_t* H = (const bf16_t*)(ws + WS_H); bf16_t* U = (bf16_t*)(ws + WS_H);
    bf16_t* Q = (bf16_t*)(ws + WS_SCR + A_Q); bf16_t* Kb = (bf16_t*)(ws + WS_SCR + A_K); bf16_t* Vb = (bf16_t*)(ws + WS_SCR + A_V); bf16_t* SZ = (bf16_t*)(ws + WS_SCR + A_SZ);
    norm_phase(A, layer, false, wv);
    xcd_barrier(gbar, wv);
    {
        DescPlain D; D.init(H, (const bf16_t*)(ws + WS_WAI), 20, false);
        auto E = [=](const pg8::Unit& u, int row_l, int col_l, f32x4 v0, f32x4 v1) {
            const size_t row = (size_t)u.i0 * 256 + row_l; const int pn = u.i1;
            if (pn < 8) st_bf16x8(Q + row * 2048 + pn * 256 + col_l, v0, v1);
            else if (pn < 10) st_bf16x8(Kb + row * 512 + (pn - 8) * 256 + col_l, v0, v1);
            else if (pn < 12) st_bf16x8(Vb + row * 512 + (pn - 10) * 256 + col_l, v0, v1);
            else { f32x4 a, b;
#pragma unroll
                for (int q = 0; q < 4; ++q) { a[q] = siluf(v0[q]); b[q] = siluf(v1[q]); }
                st_bf16x8(SZ + row * 2048 + (pn - 12) * 256 + col_l, a, b); }
        };
        pg8::gemm_phase(lds, D, E, wv);
    }
    xcd_barrier(gbar, wv);
    qknorm_phase(A, wv);
    xcd_barrier(gbar, wv);
    {
        const int G = gridDim.x, c = blockIdx.x;
        for (long L = c; L < 2048; L += G) {
            const int u = pg8::xcd_remap((int)L, 2048);
            const int b = u / 128, rem = u % 128, kvh = rem / 32, g = (rem / 8) % 4, qb = rem % 8, h = kvh * 4 + g;
            const size_t qoff = ((size_t)b * TB + qb * 256) * 2048 + h * 128, koff = ((size_t)b * TB) * 512 + kvh * 128;
            att::attn_dense_body(Q + qoff, Kb + koff, Vb + koff, SZ + qoff, U + qoff, TB, lds_gen, wv);
        }
        for (int u = c; u < 256; u += G) {
            const int b = u / 16, h = u % 16, kvh = h / 4;
            const size_t qoff = ((size_t)b * TB + TL) * 2048 + h * 128, koff = ((size_t)b * TB + TL) * 512 + kvh * 128;
            att::attn_dense_body(Q + qoff, Kb + koff, Vb + koff, SZ + qoff, U + qoff, TC, lds_gen, wv);
        }
    }
    xcd_barrier(gbar, wv);
    {
        DescPlain D; D.init(U, (const bf16_t*)(ws + WS_WAO), 8, false);
        const float* modl = (const float*)(ws + WS_MOD) + (size_t)layer * 17 * MOD_LD;
        auto E = [=](const pg8::Unit& u, int row_l, int col_l, f32x4 v0, f32x4 v1) { resid_store(A, layer, u.i0, row_l, u.i1 * 256 + col_l, modl, v0, v1); };
        pg8::gemm_phase(lds, D, E, wv);
    }
    xcd_barrier(gbar, wv);
}


struct DescKVT {
    const bf16_t* WB; const bf16_t* H; int lda, ldb, K, total;
    DI void init(const bf16_t* WB_, const bf16_t* H_) { WB = WB_; H = H_; lda = DM; ldb = DM; K = DM; total = 12 * 144; }
    DI pg8::Unit unit(int idx) const { const int mt = idx % 12, nt = idx / 12; pg8::Unit u; u.a = (const char*)(WB + (size_t)mt * 256 * DM); u.b = (const char*)(H + (size_t)nt * 256 * DM); u.i0 = mt; u.i1 = nt; u.i2 = 0; return u; }
};
namespace ml {
#define MFMA32(a, b, c) __builtin_amdgcn_mfma_f32_32x32x16_bf16((a), (b), (c), 0, 0, 0)
#define LFENCE() asm volatile("s_waitcnt lgkmcnt(0)" ::: "memory")
DI int crow(int reg, int h) { return (reg & 3) + 8 * (reg >> 2) + 4 * h; }
DI bf16x8 ldperm(const bf16_t* p) { const s16x4 lo = *(const s16x4*)p, hi = *(const s16x4*)(p + 8); return __builtin_shufflevector(lo, hi, 0, 1, 2, 3, 4, 5, 6, 7); }
DI bf16x8 pack_step(const f32x16& x, int s) { u32x4 p = {pk2(x[8 * s], x[8 * s + 1]), pk2(x[8 * s + 2], x[8 * s + 3]), pk2(x[8 * s + 4], x[8 * s + 5]), pk2(x[8 * s + 6], x[8 * s + 7])}; return __builtin_bit_cast(bf16x8, p); }
DI float bfs(short h) { return __uint_as_float(((unsigned)(unsigned short)h) << 16); }

constexpr int SC_Q = 0, SC_K = 16384, SC_KT = 32768, SC_BUF = 49152, SC_WAVE = 2 * SC_BUF, SC_WAVE_BYTES = 6144;
DI bf16x8 ldsfrag(const LAS unsigned char* buf, unsigned o) { const s16x4 lo = *(const LAS s16x4*)(buf + o), hi = *(const LAS s16x4*)(buf + (o ^ 16u)); return __builtin_shufflevector(lo, hi, 0, 1, 2, 3, 4, 5, 6, 7); }
DI void scan_phase(const Args& A, LAS unsigned char* lds, int wv) {
    const int wave = wv;
    LAS float* wl = (LAS float*)(lds + SC_WAVE + wave * SC_WAVE_BYTES);
    LAS unsigned char* hst = lds + SC_WAVE + wave * SC_WAVE_BYTES + 2048;
    unsigned char* ws = A.ws;
    const bf16_t* Qg = (const bf16_t*)(ws + WS_SCR + M_Q); const bf16_t* Kg = (const bf16_t*)(ws + WS_SCR + M_K); const bf16_t* KVT = (const bf16_t*)(ws + WS_SCR + M_KVT);
    const float* G32 = (const float*)(ws + WS_SCR + M_G32); const float* bg = A.in[10];
#define SC_POS0(j) (dir == 0 ? ((j) < 4 ? TL + 64 * (j) : 64 * ((j) - 4)) : ((j) < 4 ? TL + 64 * (3 - (j)) : 64 * (35 - (j))))
#define SC_DMA(bufi, p0) do { const int tj_ = otid(wv); _Pragma("unroll") for (int i_ = 0; i_ < 2; ++i_) { const int sl_ = i_ * 512 + tj_; \
        { const int row_ = sl_ >> 4, c_ = (sl_ & 15) ^ (row_ & 15); const size_t go_ = (size_t)((p0) + row_) * 1024 + c_ * 8; \
          __builtin_amdgcn_global_load_lds((const unsigned*)(Qu + go_), (LAS unsigned*)(lds + (bufi) * SC_BUF + SC_Q + i_ * 8192 + wave * 1024), 16, 0, 0); \
          __builtin_amdgcn_global_load_lds((const unsigned*)(Ku + go_), (LAS unsigned*)(lds + (bufi) * SC_BUF + SC_K + i_ * 8192 + wave * 1024), 16, 0, 0); } \
        { const int d_ = sl_ >> 3, c_ = (sl_ & 7) ^ ((d_ >> 1) & 7); \
          __builtin_amdgcn_global_load_lds((const unsigned*)(KTu + (size_t)d_ * TB + (p0) + c_ * 8), (LAS unsigned*)(lds + (bufi) * SC_BUF + SC_KT + i_ * 8192 + wave * 1024), 16, 0, 0); } } } while (0)
    for (int item = blockIdx.x; item < 256; item += gridDim.x) {
        const int dir = item & 1, h = (item >> 1) & 7, b = item >> 4, e0 = wave * 32;
        const bf16_t* Qu = Qg + (size_t)b * TB * 1024 + h * 128;
        const bf16_t* Ku = Kg + (size_t)b * TB * 1024 + h * 128;
        const bf16_t* KTu = KVT + ((size_t)b * 3072 + h * 128) * TB;
        const bf16_t* VTu = KVT + ((size_t)b * 3072 + 1024 + h * 256 + e0) * TB;
        bf16_t* Hout = (bf16_t*)(ws + WS_SCR + (dir ? M_HB : M_HF)) + (size_t)b * TB * DM + h * 256 + e0;
        const float big = bg[(dir * 2) * 8 + h], bfg = bg[(dir * 2 + 1) * 8 + h];
        f32x16 cacc[4];
#pragma unroll
        for (int d = 0; d < 4; ++d)
#pragma unroll
            for (int i = 0; i < 16; ++i) cacc[d][i] = 0.f;
        float m = 0.f;
        { const int l0 = otid(wv) & 63; wl[384 + l0] = 0.f; wl[448 + l0] = 0.f; }
        LFENCE();
        SC_DMA(0, SC_POS0(0));
        for (int j = 0; j < 36; ++j) {
            const int pos0 = SC_POS0(j);
            const LAS unsigned char* Qb = lds + (j & 1) * SC_BUF + SC_Q; const LAS unsigned char* Kb = lds + (j & 1) * SC_BUF + SC_K; const LAS unsigned char* KTb = lds + (j & 1) * SC_BUF + SC_KT;
            asm volatile("s_waitcnt vmcnt(0)" ::: "memory"); __builtin_amdgcn_s_barrier(); asm volatile("" ::: "memory");
            if (j + 1 < 36) SC_DMA((j + 1) & 1, SC_POS0(j + 1));
            const int lj = otid(wv) & 63, rj = lj & 31, h4 = (lj >> 5) * 4;
            LAS float* wh = wl + h4; LAS float* wr = wl + rj; LAS unsigned char* hb = hst + h4 * 64 + rj * 2;
            const unsigned xr = rj & 15, xd = (rj >> 1) & 7;
            const unsigned qro = (unsigned)rj * 256u + 2u * h4;
            const unsigned kro = (unsigned)rj * 128u + 2u * h4;
            const bf16_t* VTp = VTu + (size_t)rj * TB + pos0 + h4;
            bf16x8 vf[4];
#pragma unroll
            for (int kk = 0; kk < 4; ++kk) vf[kk] = ldperm(VTp + 16 * kk);
            float decay, m_new;
            {
                const int s = dir ? 63 - lj : lj;
                const float* gp = G32 + (size_t)(b * TB + pos0 + s) * 32;
                const float ig = gp[(dir * 2) * 8 + h] + big, fg = gp[(dir * 2 + 1) * 8 + h] + bfg;
                const float lf = fminf(fg, 0.f) - log1pf(__expf(-fabsf(fg)));
                float bs = lf;
#pragma unroll
                for (int o = 1; o < 64; o <<= 1) { const float t = __shfl_up(bs, o); if (lj >= o) bs += t; }
                const float uu = ig - bs;
                float pmx = uu;
#pragma unroll
                for (int o = 1; o < 64; o <<= 1) { const float t = __shfl_up(pmx, o); if (lj >= o) pmx = fmaxf(pmx, t); }
                pmx = fmaxf(pmx, m);
                const float b_end = __shfl(bs, 63), pm_last = __shfl(pmx, 63);
                LAS float* ws_ = wl + s;
                ws_[0] = uu; ws_[64] = pmx; ws_[128] = __expf(m - pmx); ws_[192] = __expf(-(bs + pmx)); ws_[256] = __expf(uu - pm_last);
                decay = __expf(m - pm_last); m_new = b_end + pm_last;
            }
            LFENCE();
            const int sbase = dir ? 63 - h4 : h4, sgn = dir ? -1 : 1;
#pragma unroll
            for (int tb = 0; tb < 2; ++tb) {
                __builtin_amdgcn_sched_barrier(0);
                const unsigned qo = qro + tb * 8192u;
                f32x16 ha;
#pragma unroll
                for (int i = 0; i < 16; ++i) ha[i] = 0.f;
                float qnv = 0.f;
#pragma unroll
                for (int kk = 0; kk < 8; ++kk) {
                    const bf16x8 qa = ldsfrag(Qb, qo + (((2u * kk) ^ xr) << 4));
                    ha = MFMA32(qa, pack_step(cacc[kk >> 1], kk & 1), ha);
                    const f32x4 n0 = *(const LAS f32x4*)(wh + 384 + 16 * kk), n1 = *(const LAS f32x4*)(wh + 384 + 16 * kk + 8);
#pragma unroll
                    for (int jj = 0; jj < 4; ++jj) qnv += bfs(qa[jj]) * n0[jj] + bfs(qa[4 + jj]) * n1[jj];
                }
                qnv += __shfl_xor(qnv, 32);
#pragma unroll
                for (int i = 0; i < 16; ++i) ha[i] *= wh[128 + 32 * tb + (i & 3) + 8 * (i >> 2)];
                const float pmt = wr[64 + 32 * tb];
                const int tp = dir ? (63 - 32 * tb) - rj : 32 * tb + rj;
                float ds = 0.f;
#pragma unroll
                for (int sb = 0; sb < 2; ++sb) {
                    __builtin_amdgcn_sched_barrier(0);
                    const unsigned ko = qro + sb * 8192u;
                    f32x16 st;
#pragma unroll
                    for (int i = 0; i < 16; ++i) st[i] = 0.f;
#pragma unroll
                    for (int kk = 0; kk < 8; ++kk) { const unsigned c = ((2u * kk) ^ xr) << 4; st = MFMA32(ldsfrag(Kb, ko + c), ldsfrag(Qb, qo + c), st); }
#pragma unroll
                    for (int i = 0; i < 16; ++i) {
                        const int sc = 32 * sb + (i & 3) + 8 * (i >> 2);
                        const int sp = sbase + sgn * sc;
                        st[i] *= __expf((sp <= tp) ? wh[sc] - pmt : -1e30f);
                        ds += st[i];
                    }
                    ha = MFMA32(pack_step(st, 0), vf[2 * sb], ha);
                    ha = MFMA32(pack_step(st, 1), vf[2 * sb + 1], ha);
                }
                ds += __shfl_xor(ds, 32);
                {
                    const float den = wr[128 + 32 * tb] * qnv + ds;
                    const float rd = 1.0f / fmaxf(fabsf(den), wr[192 + 32 * tb]);
                    if (h4 == 0) wr[320 + 32 * tb] = rd;
                }
                LFENCE();
#pragma unroll
                for (int i = 0; i < 16; ++i) { const int tc = 32 * tb + (i & 3) + 8 * (i >> 2);
                    *(LAS unsigned short*)(hb + tc * 64) = (unsigned short)(pk2(ha[i] * wh[320 + tc], 0.f) & 0xffffu); }
            }
            LFENCE();
            {
                bf16_t* hp = Hout + (size_t)(pos0 + lj) * DM;
                const LAS unsigned char* hrow = hst + lj * 64;
#pragma unroll
                for (int q = 0; q < 4; ++q) *(u32x4*)(hp + 8 * q) = *(const LAS u32x4*)(hrow + 16 * q);
            }
            __builtin_amdgcn_sched_barrier(0);
#pragma unroll
            for (int db = 0; db < 4; ++db) {
                if (db == 2) __builtin_amdgcn_sched_barrier(0);
#pragma unroll
                for (int i = 0; i < 16; ++i) cacc[db][i] *= decay;
                const unsigned to = kro + db * 4096u;
                float nadd = 0.f;
#pragma unroll
                for (int kk = 0; kk < 4; ++kk) {
                    const bf16x8 kv = ldsfrag(KTb, to + (((2u * kk) ^ xd) << 4));
                    const f32x4 w0 = *(const LAS f32x4*)(wh + 256 + 16 * kk), w1 = *(const LAS f32x4*)(wh + 256 + 16 * kk + 8);
                    float f[8];
#pragma unroll
                    for (int jj = 0; jj < 4; ++jj) { f[jj] = bfs(kv[jj]) * w0[jj]; f[4 + jj] = bfs(kv[4 + jj]) * w1[jj]; }
#pragma unroll
                    for (int jj = 0; jj < 8; ++jj) nadd += f[jj];
                    u32x4 p = {pk2(f[0], f[1]), pk2(f[2], f[3]), pk2(f[4], f[5]), pk2(f[6], f[7])};
                    cacc[db] = MFMA32(__builtin_bit_cast(bf16x8, p), vf[kk], cacc[db]);
                }
                nadd += __shfl_xor(nadd, 32);
                if (h4 == 0) wr[384 + 32 * db] = decay * wr[384 + 32 * db] + nadd;
            }
            LFENCE();
            m = m_new;
        }
        asm volatile("s_waitcnt vmcnt(0)" ::: "memory"); __builtin_amdgcn_s_barrier();
    }
#undef SC_DMA
#undef SC_POS0
}
#undef MFMA32
#undef LFENCE
}

DI void mlstm_finish_phase(const Args& A, int wv) {
    const int tid = otid(wv), lane = tid & 63, wave = tid >> 6, G = gridDim.x;
    unsigned char* ws = A.ws;
    const bf16_t* HF = (const bf16_t*)(ws + WS_SCR + M_HF); const bf16_t* HB = (const bf16_t*)(ws + WS_SCR + M_HB);
    const bf16_t* SO = (const bf16_t*)(ws + WS_SCR + M_SO); const bf16_t* SZ = (const bf16_t*)(ws + WS_SCR + M_SZ);
    bf16_t* U = (bf16_t*)(ws + WS_H); const float* hn = A.in[11];
    const int sub = lane >> 5, e0 = (lane & 31) * 8;
    const long NIT = (long)NTOK * 8;
    for (long it = ((long)blockIdx.x * NWAVES + wave) * 2 + sub; it < NIT; it += (long)G * NWAVES * 2) {
        const size_t off = (size_t)(it >> 3) * DM + (int)(it & 7) * 256 + e0;
        f32x4 f0, f1, b0, b1, o0, o1, z0, z1;
        ld_bf16x8(HF + off, f0, f1); ld_bf16x8(HB + off, b0, b1); ld_bf16x8(SO + off, o0, o1); ld_bf16x8(SZ + off, z0, z1);
        f32x4 y0 = o0 * (f0 + b0), y1 = o1 * (f1 + b1);
        float ss = 0.f;
#pragma unroll
        for (int q = 0; q < 4; ++q) ss += y0[q] * y0[q] + y1[q] * y1[q];
        ss += __shfl_xor(ss, 1); ss += __shfl_xor(ss, 2); ss += __shfl_xor(ss, 4); ss += __shfl_xor(ss, 8); ss += __shfl_xor(ss, 16);
        const float rs = 1.0f / sqrtf(ss * (1.f / 256.f) + EPS);
        const float* hp = hn + (int)(it & 7) * 256 + e0;
        const f32x4 h0 = *(const f32x4*)hp, h1 = *(const f32x4*)(hp + 4);
        st_bf16x8(U + off, y0 * rs * h0 * z0, y1 * rs * h1 * z1);
    }
}

DI void mlstm_layer(const Args& A, LAS unsigned char* lds, const XcdBarrier& gbar, int layer, int wv) {
    unsigned char* ws = A.ws;
    const bf16_t* H = (const bf16_t*)(ws + WS_H); bf16_t* U = (bf16_t*)(ws + WS_H);
    bf16_t* Q = (bf16_t*)(ws + WS_SCR + M_Q); bf16_t* Kb = (bf16_t*)(ws + WS_SCR + M_K); bf16_t* KVT = (bf16_t*)(ws + WS_SCR + M_KVT);
    float* G32 = (float*)(ws + WS_SCR + M_G32); bf16_t* SO = (bf16_t*)(ws + WS_SCR + M_SO); bf16_t* SZ = (bf16_t*)(ws + WS_SCR + M_SZ);
    norm_phase(A, layer, false, wv);
    xcd_barrier(gbar, wv);
    {
        DescPlain D; D.init(H, (const bf16_t*)(ws + WS_WMA), 9, false);
        auto E = [=](const pg8::Unit& u, int row_l, int col_l, f32x4 v0, f32x4 v1) {
            const size_t row = (size_t)u.i0 * 256 + row_l; const int pn = u.i1;
            if (pn < 4) st_bf16x8(Q + row * 1024 + pn * 256 + col_l, v0 * 0.088388347648318440f, v1 * 0.088388347648318440f);
            else if (pn < 8) st_bf16x8(Kb + row * 1024 + (pn - 4) * 256 + col_l, v0, v1);
            else if (col_l < 32) { *(f32x4*)(G32 + row * 32 + col_l) = v0; *(f32x4*)(G32 + row * 32 + col_l + 4) = v1; }
        };
        pg8::gemm_phase(lds, D, E, wv);
    }
    {
        DescKVT D; D.init((const bf16_t*)(ws + WS_WMB), H);
        auto E = [=](const pg8::Unit& u, int row_l, int col_l, f32x4 v0, f32x4 v1) {
            const int bb = u.i1 / 9, s0 = (u.i1 % 9) * 256;
            st_bf16x8(KVT + ((size_t)bb * 3072 + u.i0 * 256 + row_l) * TB + s0 + col_l, v0, v1);
        };
        pg8::gemm_phase(lds, D, E, wv);
    }
    xcd_barrier(gbar, wv);
    ml::scan_phase(A, lds, wv);
    xcd_barrier(gbar, wv);
    {
        DescPlain D; D.init(H, (const bf16_t*)(ws + WS_WMA) + (size_t)2304 * DM, 16, false);
        auto E = [=](const pg8::Unit& u, int row_l, int col_l, f32x4 v0, f32x4 v1) {
            const size_t row = (size_t)u.i0 * 256 + row_l; const int pn = u.i1; f32x4 a, b;
            if (pn < 8) {
#pragma unroll
                for (int q = 0; q < 4; ++q) { a[q] = sigmf(v0[q]); b[q] = sigmf(v1[q]); }
                st_bf16x8(SO + row * DM + pn * 256 + col_l, a, b);
            } else {
#pragma unroll
                for (int q = 0; q < 4; ++q) { a[q] = siluf(v0[q]); b[q] = siluf(v1[q]); }
                st_bf16x8(SZ + row * DM + (pn - 8) * 256 + col_l, a, b);
            }
        };
        pg8::gemm_phase(lds, D, E, wv);
    }
    xcd_barrier(gbar, wv);
    mlstm_finish_phase(A, wv);
    xcd_barrier(gbar, wv);
    {
        DescPlain D; D.init(U, (const bf16_t*)(ws + WS_WMO), 8, false);
        const float* modl = (const float*)(ws + WS_MOD) + (size_t)layer * 17 * MOD_LD;
        auto E = [=](const pg8::Unit& u, int row_l, int col_l, f32x4 v0, f32x4 v1) { resid_store(A, layer, u.i0, row_l, u.i1 * 256 + col_l, modl, v0, v1); };
        pg8::gemm_phase(lds, D, E, wv);
    }
    xcd_barrier(gbar, wv);
}

__global__ void __launch_bounds__(NTHREADS, 2) fwd_megakernel(Args A) {
    extern __shared__ __attribute__((aligned(16))) unsigned char lds_raw[];
    LAS unsigned char* lds = (LAS unsigned char*)lds_raw;
    cg::grid_group grid = cg::this_grid();
    const int wv = __builtin_amdgcn_readfirstlane(threadIdx.x >> 6);
    volatile LAS unsigned* bst = (volatile LAS unsigned*)(lds + 147456);
    if (otid(wv) < 2) bst[otid(wv)] = 0u;
    __syncthreads();
    const XcdBarrier gbar = xcd_barrier_post((unsigned*)(A.ws + WS_BAR), bst, wv);
    prep_phase(A, lds, wv);
    grid.sync();
    fnet_layer(A, lds, gbar, 0, 0, false, wv);
    mlstm_layer(A, lds, gbar, 1, wv);
    attn_layer(A, lds, (char*)lds_raw, gbar, 2, wv);
    fnet_layer(A, lds, gbar, 3, 1, true, wv);
    final_norm_phase(A, nullptr, wv);
}

extern "C" void kernel_launch(void* const* d_in, const int* in_sizes, int n_in, void* d_out, int out_size, void* d_ws, size_t ws_size, hipStream_t stream) {
    static int grid = 0;
    if (grid == 0) {
        if (n_in != 18 || ws_size < WS_END) { fprintf(stderr, "kernel_launch: unexpected n_in %d / ws_size %zu (need %zu)\n", n_in, ws_size, (size_t)WS_END); grid = -1; return; }
        int dev = 0, cus = 0, per_cu = 0;
        hipGetDevice(&dev);
        hipDeviceGetAttribute(&cus, hipDeviceAttributeMultiprocessorCount, dev);
        if (hipFuncSetAttribute((const void*)fwd_megakernel, hipFuncAttributeMaxDynamicSharedMemorySize, LDS_BYTES) != hipSuccess) { fprintf(stderr, "kernel_launch: hipFuncSetAttribute failed\n"); grid = -1; return; }
        if (hipOccupancyMaxActiveBlocksPerMultiprocessor(&per_cu, (const void*)fwd_megakernel, NTHREADS, LDS_BYTES) != hipSuccess || per_cu < 1) { fprintf(stderr, "kernel_launch: occupancy query failed (%d)\n", per_cu); per_cu = 1; }
        (void)hipGetLastError();
        grid = cus * per_cu;
        fprintf(stderr, "kernel_launch: grid %d (cus %d x %d)\n", grid, cus, per_cu);
    }
    if (grid < 0) return;
    (void)hipMemsetAsync((char*)d_ws + WS_MOD, 0, ZERO_BYTES, stream);
    Args a{};
    for (int i = 0; i < 18; ++i) a.in[i] = (const float*)d_in[i];
    a.out = (float*)d_out; a.ws = (unsigned char*)d_ws; a.ph_lo = 0; a.ph_hi = 100;
    void* args[] = {&a};
    hipError_t e = hipLaunchCooperativeKernel((const void*)fwd_megakernel, dim3(grid), dim3(NTHREADS), args, LDS_BYTES, stream);
    if (e != hipSuccess) fprintf(stderr, "kernel_launch: cooperative launch failed: %s (grid %d)\n", hipGetErrorString(e), grid);
}
```

```cpp
#include <hip/hip_runtime.h>
#include <hip/hip_cooperative_groups.h>
#include <cstdio>
#include <cstdint>
namespace cg = cooperative_groups;

#define LAS __attribute__((address_space(3)))
#define DI __device__ __forceinline__
typedef unsigned short bf16_t;
typedef short bf16x8 __attribute__((ext_vector_type(8)));
typedef short s16x4 __attribute__((ext_vector_type(4)));
typedef float f32x2 __attribute__((ext_vector_type(2)));
typedef float f32x4 __attribute__((ext_vector_type(4)));
typedef float f32x16 __attribute__((ext_vector_type(16)));
typedef unsigned u32x2 __attribute__((ext_vector_type(2)));
typedef unsigned u32x4 __attribute__((ext_vector_type(4)));
typedef __bf16 bf16v2 __attribute__((ext_vector_type(2)));

constexpr int DM = 2048, NB = 16, TL = 2048, TC = 256, TB = TL + TC, NTOK = NB * TB;
constexpr int NWAVES = 8, NTHREADS = 512;
constexpr float EPS = 1e-6f;
constexpr int MOD_LD = 3 * DM;
constexpr int M_WA_ROWS = 6400, M_WB_ROWS = 3072;
constexpr size_t MiB = 1u << 20;
constexpr size_t WS_SCR_ = 301 * MiB;
constexpr size_t WS_MOD = 0;
constexpr size_t MOD_BYTES = (size_t)4 * 17 * MOD_LD * 4;
constexpr size_t WS_BAR = 1792 * 1024, ZERO_BYTES = 2 * MiB;
constexpr size_t WS_MODI = WS_SCR_ + 700 * MiB, MODI_BYTES = (size_t)4 * 17 * MOD_LD * 8;
constexpr float MODI_SCALE = 1073741824.f, MODI_INV = 9.313225746154785e-10f;
constexpr size_t WS_WFG = 2 * MiB, WS_WFO = 18 * MiB, WS_WMA = 34 * MiB, WS_WMB = 59 * MiB, WS_WMO = 71 * MiB, WS_WAI = 79 * MiB, WS_WAO = 99 * MiB;
constexpr size_t WS_DC = 107 * MiB, WS_DT = 108 * MiB, WS_DT2 = 124 * MiB, WS_CTXS = 125 * MiB, WS_H = 157 * MiB, WS_SCR = 301 * MiB;
constexpr size_t WS_END = 1024 * MiB;
constexpr size_t F_G = 0, F_PQX = 144 * MiB, F_PQC = 400 * MiB, F_A1 = 432 * MiB, F_NYQ = 496 * MiB;
constexpr size_t M_Q = 0, M_K = 72 * MiB, M_KVT = 144 * MiB, M_G32 = 360 * MiB, M_HF = 365 * MiB, M_HB = 509 * MiB, M_SO = 0, M_SZ = 144 * MiB;
constexpr size_t A_Q = 0, A_K = 144 * MiB, A_V = 180 * MiB, A_SZ = 216 * MiB;
static_assert(WS_SCR + M_HB + 144 * MiB <= WS_END, "ws map");
constexpr int LDS_BYTES = 147456 + 1024;

DI unsigned pk2(float a, float b) { f32x2 v = {a, b}; return __builtin_bit_cast(unsigned, __builtin_convertvector(v, bf16v2)); }
DI float bf_lo(unsigned w) { return __uint_as_float(w << 16); }
DI float bf_hi(unsigned w) { return __uint_as_float(w & 0xffff0000u); }
DI float wave_sum(float v) {
#pragma unroll
    for (int o = 1; o < 64; o <<= 1) v += __shfl_xor(v, o);
    return v;
}
DI int otid(int wv) { int t; asm volatile("v_mbcnt_lo_u32_b32 %0, -1, 0\n\tv_mbcnt_hi_u32_b32 %0, -1, %0" : "=v"(t)); return wv * 64 + t; }
DI float siluf(float x) { return x / (1.f + __expf(-x)); }
DI float sigmf(float x) { return 1.f / (1.f + __expf(-x)); }
DI void st_bf16x8(bf16_t* p, f32x4 a, f32x4 b) { u32x4 w = {pk2(a[0], a[1]), pk2(a[2], a[3]), pk2(b[0], b[1]), pk2(b[2], b[3])}; *(u32x4*)p = w; }
DI void ld_bf16x8(const bf16_t* p, f32x4& a, f32x4& b) { const u32x4 w = *(const u32x4*)p; a = (f32x4){bf_lo(w.x), bf_hi(w.x), bf_lo(w.y), bf_hi(w.y)}; b = (f32x4){bf_lo(w.z), bf_hi(w.z), bf_lo(w.w), bf_hi(w.w)}; }

DI f32x4 ldmod4(const long long* p) { return (f32x4){(float)p[0] * MODI_INV, (float)p[1] * MODI_INV, (float)p[2] * MODI_INV, (float)p[3] * MODI_INV}; }

struct Args { const float* in[18]; float* out; unsigned char* ws; int ph_lo, ph_hi; };

#define XB_TMO      128
#define XB_XCNT(j)  (256  + 64 * (j))
#define XB_XSUB(j)  (1280 + 64 * (j))
#define XB_XGEN(j)  (2304 + 64 * (j))
#define XB_TOP      3328
#define XB_TOPGEN   3392
#define XCD_BAR_WORDS 3456
#define XB_SPIN_CAP (1u << 18)

__device__ __forceinline__ unsigned xb_ld(unsigned* p)              { return __hip_atomic_load(p, __ATOMIC_RELAXED, __HIP_MEMORY_SCOPE_AGENT); }
__device__ __forceinline__ unsigned xb_add(unsigned* p, unsigned v) { return __hip_atomic_fetch_add(p, v, __ATOMIC_RELAXED, __HIP_MEMORY_SCOPE_AGENT); }
__device__ __forceinline__ unsigned xb_xcc_id() { return (unsigned)__builtin_amdgcn_s_getreg((3 << 11) | 20) & 0xFu; }
#define XB_SPIN(cond, bar) do { unsigned _sp = 0; while (cond) { __builtin_amdgcn_s_sleep(1); \
    if ((++_sp & 255u) == 0u) { if (xb_ld(&(bar)[XB_TMO])) break; if (_sp > XB_SPIN_CAP) { atomicAdd(&(bar)[XB_TMO], 1u); break; } } } } while (0)

struct XcdBarrier {
    unsigned* bar; unsigned x;
    volatile LAS unsigned* st;
};

__device__ __forceinline__ XcdBarrier xcd_barrier_post(unsigned* bar, volatile LAS unsigned* st, int wv) {
    XcdBarrier b; b.bar = bar; b.x = xb_xcc_id(); b.st = st;
    if (otid(wv) == 0) (void)xb_add(&bar[XB_XCNT(b.x)], 1u);
    return b;
}
__device__ __forceinline__ void xcd_barrier_complete(unsigned* bar, unsigned x, unsigned& nloc, unsigned& nx) {
    const unsigned G = gridDim.x * gridDim.y * gridDim.z;
    unsigned sum, cnt, mine, sp = 0u;
    for (;;) {
        sum = 0u; cnt = 0u; mine = 0u;
#pragma unroll
        for (unsigned j = 0; j < 16; ++j) { const unsigned c = xb_ld(&bar[XB_XCNT(j)]); sum += c; cnt += (c > 0u) ? 1u : 0u; mine = (j == x) ? c : mine; }
        if (sum == G) break;
        __builtin_amdgcn_s_sleep(1);
        if ((++sp & 255u) == 0u) { if (xb_ld(&bar[XB_TMO])) break; if (sp > XB_SPIN_CAP) { atomicAdd(&bar[XB_TMO], 1u); break; } }
    }
    nloc = mine > 0u ? mine : 1u; nx = cnt > 0u ? cnt : 1u;
}

__device__ __forceinline__ void xcd_barrier(const XcdBarrier& b, int wv) {
    asm volatile("s_waitcnt vmcnt(0)" ::: "memory");
    __syncthreads();
    if (otid(wv) == 0) {
        unsigned* bar = b.bar;
        __builtin_amdgcn_s_waitcnt(0);
        unsigned nloc = b.st[0], nx = b.st[1];
        if (nloc == 0u) { xcd_barrier_complete(bar, b.x, nloc, nx); b.st[0] = nloc; b.st[1] = nx; }
        const unsigned old = xb_add(&bar[XB_XSUB(b.x)], 1u);
        const unsigned gen = old / nloc;
        if (old + 1u == (gen + 1u) * nloc) {
            __builtin_amdgcn_fence(__ATOMIC_RELEASE, "agent");
            asm volatile("s_waitcnt vmcnt(0)" ::: "memory");
            const unsigned og = xb_add(&bar[XB_TOP], 1u);
            const unsigned tg = og / nx;
            if (og + 1u == (tg + 1u) * nx) xb_add(&bar[XB_TOPGEN], 1u);
            else XB_SPIN(xb_ld(&bar[XB_TOPGEN]) == tg, bar);
            __builtin_amdgcn_fence(__ATOMIC_ACQUIRE, "agent");
            xb_add(&bar[XB_XGEN(b.x)], 1u);
            asm volatile("s_waitcnt vmcnt(0)" ::: "memory");
        } else {
            XB_SPIN(xb_ld(&bar[XB_XGEN(b.x)]) == gen, bar);
            __builtin_amdgcn_fence(__ATOMIC_ACQUIRE, "agent");
            asm volatile("s_waitcnt vmcnt(0)" ::: "memory");
        }
    }
    __syncthreads();
}


namespace pg8 {
constexpr int BM = 256, BK = 64, HALF = 128, HTB = HALF * BK * 2, NXCD = 8;
DI int lds_byte(int r, int c) { const int st = (r >> 4) * 2 + (c >> 5), rr = r & 15, cc = c & 31, ob = rr * 64 + cc * 2; return st * 1024 + (ob ^ (((ob >> 9) & 1) << 5)); }
DI void stage_rc(int b, int& R, int& C) { const int st = b / 1024, sb = b % 1024, swz = sb ^ (((sb >> 9) & 1) << 5); R = (st >> 1) * 16 + swz / 64; C = (st & 1) * 32 + (swz % 64) / 2; }
DI int perm32(int rho) { const int n = rho >> 4, i = rho & 15; return 8 * (i >> 2) + 4 * n + (i & 3); }
struct Unit { const char* a; const char* b; int i0, i1, i2; };
DI int xcd_remap(int L, int total) { const int q = total / NXCD, r = total % NXCD, xcd = L % NXCD, off = L / NXCD; return (xcd < r ? xcd * (q + 1) : r * (q + 1) + (xcd - r) * q) + off; }

template <class Desc, class Epi>
DI void gemm_phase(LAS unsigned char* lds, const Desc& D, const Epi& E, int wv) {
    const int tid = otid(wv), wid = __builtin_amdgcn_readfirstlane(tid >> 6), lane = tid & 63, wr = wid >> 2, wc = wid & 3, fr = lane & 15, fq = lane >> 4;
    const int G = gridDim.x, c = blockIdx.x, total = D.total;
    const int K = D.K, nt = K / BK;
    unsigned voffA[2], voffB[2];
#pragma unroll
    for (int i = 0; i < 2; ++i) { int R, C; stage_rc(tid * 16 + i * 8192, R, C); const int Rb = (R & ~31) + perm32(R & 31);
        voffA[i] = (unsigned)(R * D.lda + C) * 2u; voffB[i] = (unsigned)(Rb * D.ldb + C) * 2u; }
    const size_t kstep = (size_t)(BK * 2);
    const size_t hstepA = (size_t)HALF * D.lda * 2, hstepB = (size_t)HALF * D.ldb * 2;
    const unsigned ldsw = (unsigned)wid * 1024u;
    const int aoff = lds_byte(wr * 64 + fr, fq * 8), boff = lds_byte(wc * 32 + fr, fq * 8);
#define PG8_SA(b, h) (((b) * 2 + (h)) * HTB)
#define PG8_SB(b, h) ((4 + (b) * 2 + (h)) * HTB)
#define PG8_STAGE(bufoff, gbase, voff) do { _Pragma("unroll") for (int _i = 0; _i < 2; ++_i) \
        __builtin_amdgcn_global_load_lds((const unsigned*)((const char*)(gbase) + (voff)[_i]), (LAS unsigned*)(lds + (bufoff) + ldsw + _i * 8192), 16, 0, 0); } while (0)
#define PG8_LDA(dst, b, h) do { _Pragma("unroll") for (int m = 0; m < 4; ++m) _Pragma("unroll") for (int k = 0; k < 2; ++k) dst[m][k] = *(const LAS bf16x8*)(lds + PG8_SA(b, h) + aoff + m * 2048 + k * 1024); } while (0)
#define PG8_LDB(dst, b, h) do { _Pragma("unroll") for (int n = 0; n < 2; ++n) _Pragma("unroll") for (int k = 0; k < 2; ++k) dst[n][k] = *(const LAS bf16x8*)(lds + PG8_SB(b, h) + boff + n * 2048 + k * 1024); } while (0)
#define PG8_MMA(ai, bj, At, Bt) do { __builtin_amdgcn_s_setprio(1); _Pragma("unroll") for (int m = 0; m < 4; ++m) _Pragma("unroll") for (int n = 0; n < 2; ++n) _Pragma("unroll") for (int k = 0; k < 2; ++k) \
        acc[ai][bj][m][n] = __builtin_amdgcn_mfma_f32_16x16x32_bf16(Bt[n][k], At[m][k], acc[ai][bj][m][n], 0, 0, 0); __builtin_amdgcn_s_setprio(0); } while (0)
#define PG8_WAIT_V(n) asm volatile("s_waitcnt vmcnt(" #n ")" ::: "memory")
#define PG8_WAIT_L(n) asm volatile("s_waitcnt lgkmcnt(" #n ")" ::: "memory")
#define PG8_BAR __builtin_amdgcn_s_barrier()
#define PG8_SCHED __builtin_amdgcn_sched_barrier(0)
    if (c >= total) return;
    Unit cur = D.unit(xcd_remap(c, total)), nxt = cur; int ui = 0;
    f32x4 acc[2][2][4][2];
#pragma unroll
    for (int a = 0; a < 2; ++a)
#pragma unroll
        for (int b = 0; b < 2; ++b)
#pragma unroll
            for (int m = 0; m < 4; ++m)
#pragma unroll
                for (int n = 0; n < 2; ++n) acc[a][b][m][n] = (f32x4){0.f, 0.f, 0.f, 0.f};
    bf16x8 At[4][2], B0[2][2], B1[2][2];
    const char* cA = cur.a; const char* cB = cur.b;
    PG8_STAGE(PG8_SB(0, 0), cB, voffB); PG8_STAGE(PG8_SB(0, 1), cB + hstepB, voffB); PG8_STAGE(PG8_SA(0, 0), cA, voffA); PG8_STAGE(PG8_SA(0, 1), cA + hstepA, voffA);
    if (wr == 1) PG8_BAR;
    PG8_WAIT_V(2); PG8_BAR;
    PG8_STAGE(PG8_SB(1, 0), cB + kstep, voffB); PG8_STAGE(PG8_SA(1, 0), cA + kstep, voffA); PG8_STAGE(PG8_SB(1, 1), cB + hstepB + kstep, voffB);
    PG8_WAIT_V(6); PG8_BAR;
    for (;;) {
        const long Ln = (long)(ui + 1) * G + c;
        const bool has_next = Ln < total;
        if (has_next) nxt = D.unit(xcd_remap((int)Ln, total));
        const char* nA = has_next ? nxt.a : cA; const char* nB = has_next ? nxt.b : cB;
        for (int t = 0; t < nt; t += 2) {
            const bool last = (t == nt - 2);
            const char* a1 = cA + (size_t)(t + 1) * kstep;
            const char* a2 = last ? nA : cA + (size_t)(t + 2) * kstep; const char* b2 = last ? nB : cB + (size_t)(t + 2) * kstep;
            const char* a3 = a2 + kstep; const char* b3 = b2 + kstep;
            PG8_LDB(B0, 0, 0); PG8_LDB(B1, 0, 1); PG8_SCHED; PG8_LDA(At, 0, 0); PG8_STAGE(PG8_SA(1, 1), a1 + hstepA, voffA);
            PG8_WAIT_V(8); PG8_WAIT_L(0); PG8_BAR; PG8_MMA(0, 0, At, B0); PG8_MMA(0, 1, At, B1); PG8_BAR; PG8_SCHED;
            PG8_LDA(At, 0, 1); PG8_STAGE(PG8_SB(0, 0), b2, voffB); PG8_STAGE(PG8_SB(0, 1), b2 + hstepB, voffB); PG8_STAGE(PG8_SA(0, 0), a2, voffA);
            PG8_WAIT_V(8); PG8_WAIT_L(0); PG8_BAR; PG8_MMA(1, 0, At, B0); PG8_MMA(1, 1, At, B1); PG8_BAR; PG8_SCHED;
            PG8_LDB(B0, 1, 0); PG8_LDB(B1, 1, 1); PG8_SCHED; PG8_LDA(At, 1, 0); PG8_STAGE(PG8_SA(0, 1), a2 + hstepA, voffA);
            PG8_WAIT_V(8); PG8_WAIT_L(0); PG8_BAR; PG8_MMA(0, 0, At, B0); PG8_MMA(0, 1, At, B1); PG8_BAR; PG8_SCHED;
            PG8_LDA(At, 1, 1); PG8_STAGE(PG8_SB(1, 0), b3, voffB); PG8_STAGE(PG8_SB(1, 1), b3 + hstepB, voffB); PG8_STAGE(PG8_SA(1, 0), a3, voffA);
            PG8_WAIT_V(8); PG8_WAIT_L(0); PG8_BAR; PG8_MMA(1, 0, At, B0); PG8_MMA(1, 1, At, B1); PG8_BAR; PG8_SCHED;
        }
        if (wr == 0) PG8_BAR;
        {
            const int le = otid(wv) & 63, fre = le & 15, fqe = le >> 4;
#pragma unroll
            for (int ai = 0; ai < 2; ++ai)
#pragma unroll
                for (int m = 0; m < 4; ++m)
#pragma unroll
                    for (int bj = 0; bj < 2; ++bj)
                        E(cur, ai * HALF + wr * 64 + m * 16 + fre, bj * HALF + wc * 32 + 8 * fqe, acc[ai][bj][m][0], acc[ai][bj][m][1]);
        }
        if (!has_next) break;
#pragma unroll
        for (int a = 0; a < 2; ++a)
#pragma unroll
            for (int b = 0; b < 2; ++b)
#pragma unroll
                for (int m = 0; m < 4; ++m)
#pragma unroll
                    for (int n = 0; n < 2; ++n) acc[a][b][m][n] = (f32x4){0.f, 0.f, 0.f, 0.f};
        cur = nxt; cA = nA; cB = nB; ++ui;
        if (wr == 1) PG8_BAR;
    }
    PG8_WAIT_V(0);
    PG8_BAR;
#undef PG8_SA
#undef PG8_SB
#undef PG8_STAGE
#undef PG8_LDA
#undef PG8_LDB
#undef PG8_MMA
#undef PG8_WAIT_V
#undef PG8_WAIT_L
#undef PG8_BAR
#undef PG8_SCHED
}
}

DI void transpose_item(const float* W, int N, int kb, int nb, bf16_t* d0, bf16_t* d1, int K, LAS float* scr, int lane) {
    const int k0 = 64 * kb, n0 = 32 * nb;
#pragma unroll 8
    for (int i = 0; i < 32; ++i) { const int kk = 2 * i + (lane >> 5); scr[kk * 33 + (lane & 31)] = W[(size_t)(k0 + kk) * N + n0 + (lane & 31)]; }
    asm volatile("s_waitcnt lgkmcnt(0)" ::: "memory");
    const int c = lane & 7;
#pragma unroll
    for (int j = 0; j < 4; ++j) { const int n = (lane >> 3) + 8 * j; const LAS float* s = scr + (8 * c) * 33 + n;
        u32x4 o; o.x = pk2(s[0 * 33], s[1 * 33]); o.y = pk2(s[2 * 33], s[3 * 33]); o.z = pk2(s[4 * 33], s[5 * 33]); o.w = pk2(s[6 * 33], s[7 * 33]);
        *(u32x4*)(d0 + (size_t)n * K + k0 + 8 * c) = o;
        if (d1) *(u32x4*)(d1 + (size_t)n * K + k0 + 8 * c) = o; }
    asm volatile("s_waitcnt lgkmcnt(0)" ::: "memory");
}

DI void prep_phase(const Args& A, LAS unsigned char* lds, int wv) {
    const int tid = otid(wv), lane = tid & 63, wave = tid >> 6, G = gridDim.x;
    unsigned char* ws = A.ws;
    {
        LAS float* s_lds = (LAS float*)lds;
        const float* cc = A.in[1]; const float* cctx = A.in[3]; const float* aw = A.in[4]; const float* ab = A.in[5];
        long long* modi = (long long*)(ws + WS_MODI);
        for (int item = blockIdx.x; item < 768; item += G) {
            const int kc = item % 16, cb = (item / 16) % 12, l = item / 192;
            const int k0 = kc * 128, j = cb * 512 + tid;
            __syncthreads();
            for (int e = tid; e < 17 * 128; e += NTHREADS) { const int r = e / 128, k = e % 128; const float v = r < 16 ? cc[r * DM + k0 + k] : cctx[k0 + k]; s_lds[k * 20 + r] = siluf(v); }
            __syncthreads();
            float acc[17];
#pragma unroll
            for (int r = 0; r < 17; ++r) acc[r] = 0.f;
            const float* wp = aw + ((size_t)l * DM + k0) * MOD_LD + j;
#pragma unroll 4
            for (int k = 0; k < 128; ++k) {
                const float w = wp[(size_t)k * MOD_LD];
                const LAS f32x4* sp = (const LAS f32x4*)(s_lds + k * 20);
                const f32x4 s0 = sp[0], s1 = sp[1], s2 = sp[2], s3 = sp[3]; const float s4 = s_lds[k * 20 + 16];
#pragma unroll
                for (int q = 0; q < 4; ++q) { acc[q] += s0[q] * w; acc[4 + q] += s1[q] * w; acc[8 + q] += s2[q] * w; acc[12 + q] += s3[q] * w; }
                acc[16] += s4 * w;
            }
            const float bias = (kc == 0) ? ab[l * MOD_LD + j] : 0.f;
#pragma unroll
            for (int r = 0; r < 17; ++r) atomicAdd((unsigned long long*)&modi[(size_t)(l * 17 + r) * MOD_LD + j], (unsigned long long)__float2ll_rn((acc[r] + bias) * MODI_SCALE));
        }
        __syncthreads();
    }
    {
        LAS float* scr = (LAS float*)(lds + wave * 16384);
        const int gw = blockIdx.x * NWAVES + wave, NGW = G * NWAVES;
        constexpr int I_SQ = 32 * 64, I_AI = 32 * 160, I_MI = 32 * 257;
        constexpr int NIT = 6 * I_SQ + I_AI + I_MI;
        for (int it = gw; it < NIT; it += NGW) {
            int r = it;
            if (r < 6 * I_SQ) {
                const int w = r / I_SQ; r -= w * I_SQ;
                const float* src; bf16_t* dst;
                if (w < 2)      { src = A.in[7] + (size_t)w * DM * DM;       dst = (bf16_t*)(ws + WS_WFG) + (size_t)w * DM * DM; }
                else if (w < 4) { src = A.in[8] + (size_t)(w - 2) * DM * DM; dst = (bf16_t*)(ws + WS_WFO) + (size_t)(w - 2) * DM * DM; }
                else if (w == 4) { src = A.in[12]; dst = (bf16_t*)(ws + WS_WMO); }
                else             { src = A.in[16]; dst = (bf16_t*)(ws + WS_WAO); }
                const int kb = r / 64, nb = r % 64;
                transpose_item(src, DM, kb, nb, dst + (size_t)(32 * nb) * DM, nullptr, DM, scr, lane);
                continue;
            }
            r -= 6 * I_SQ;
            if (r < I_AI) { const int kb = r / 160, nb = r % 160; transpose_item(A.in[13], 5120, kb, nb, (bf16_t*)(ws + WS_WAI) + (size_t)(32 * nb) * DM, nullptr, DM, scr, lane); continue; }
            r -= I_AI;
            {
                const int kb = r / 257, nb = r % 257, n0 = 32 * nb;
                bf16_t* WA = (bf16_t*)(ws + WS_WMA); bf16_t* WB = (bf16_t*)(ws + WS_WMB);
                bf16_t* d0; bf16_t* d1 = nullptr;
                if (n0 < 1024) d0 = WA + (size_t)n0 * DM;
                else if (n0 < 2048) { d0 = WA + (size_t)n0 * DM; d1 = WB + (size_t)(n0 - 1024) * DM; }
                else if (n0 < 4096) d0 = WB + (size_t)(1024 + n0 - 2048) * DM;
                else if (n0 < 6144) d0 = WA + (size_t)(2304 + n0 - 4096) * DM;
                else if (n0 < 6176) d0 = WA + (size_t)(2048 + n0 - 6144) * DM;
                else d0 = WA + (size_t)(4352 + n0 - 6176) * DM;
                transpose_item(A.in[9], 8224, kb, nb, d0, d1, DM, scr, lane);
            }
        }
    }
    {
        const long gt = (long)blockIdx.x * NTHREADS + tid, NGT = (long)G * NTHREADS;
        constexpr long N_DC = 1024L * 512 / 8, N_DT = 2048L * 4096 / 8, N_DT2 = 256L * 512 / 8;
        for (long it = gt; it < N_DC + N_DT + N_DT2; it += NGT) {
            float v[8]; bf16_t* dst;
            if (it < N_DC) {
                const int m = (int)(it / 64), k0 = (int)(it % 64) * 8; const float sc = 0.044194173824159216f;
#pragma unroll
                for (int j = 0; j < 8; ++j) { const int rr = ((m & 511) * (k0 + j)) & 511; const float ang = (float)rr * (1.f / 256.f); v[j] = (m < 512 ? cospif(ang) : sinpif(ang)) * sc; }
                dst = (bf16_t*)(ws + WS_DC) + (size_t)m * 512 + k0;
            } else if (it < N_DC + N_DT) {
                const long i2 = it - N_DC; const int kk = (int)(i2 / 512), s0 = (int)(i2 % 512) * 8; const float sc = 0.022097086912079608f;
#pragma unroll
                for (int j = 0; j < 8; ++j) { const int s = s0 + j; const int rr = (kk * (s & 2047)) & 2047; const float ang = (float)rr * (1.f / 1024.f); v[j] = (s < 2048 ? cospif(ang) : -sinpif(ang)) * sc; }
                dst = (bf16_t*)(ws + WS_DT) + (size_t)kk * 4096 + s0;
            } else {
                const long i2 = it - N_DC - N_DT; const int kk = (int)(i2 / 64), s0 = (int)(i2 % 64) * 8; const float sc = 0.0625f;
#pragma unroll
                for (int j = 0; j < 8; ++j) { const int s = s0 + j; const int rr = (kk * (s & 255)) & 255; const float ang = (float)rr * (1.f / 128.f); v[j] = (s < 256 ? cospif(ang) : -sinpif(ang)) * sc; }
                dst = (bf16_t*)(ws + WS_DT2) + (size_t)kk * 512 + s0;
            }
            u32x4 o = {pk2(v[0], v[1]), pk2(v[2], v[3]), pk2(v[4], v[5]), pk2(v[6], v[7])};
            *(u32x4*)dst = o;
        }
    }
}

DI const float* xrow_in(const Args& A, int r) {
    const int b = r / TB, t = r % TB;
    if (t < TL) return A.in[0] + ((size_t)b * TL + t) * DM;
    return A.in[2] + ((size_t)b * TC + (t - TL)) * DM;
}
DI void norm_phase(const Args& A, int layer, bool latonly, int wv) {
    const int tid = otid(wv), lane = tid & 63, wave = tid >> 6, G = gridDim.x;
    const float* ng = A.in[6] + (size_t)layer * DM;
    const float* mod = (const float*)(A.ws + WS_MOD) + (size_t)layer * 17 * MOD_LD;
    bf16_t* H = (bf16_t*)(A.ws + WS_H);
    const bf16_t* XB = (const bf16_t*)A.out;
    for (int r = blockIdx.x * NWAVES + wave; r < NTOK; r += G * NWAVES) {
        const int b = r / TB, t = r % TB;
        if (latonly && t >= TL) continue;
        const float* mr = mod + (size_t)(t < TL ? b : 16) * MOD_LD;
        f32x4 v[4][2]; float ss = 0.f;
        if (layer == 0) {
            const float* xr = xrow_in(A, r);
#pragma unroll
            for (int j = 0; j < 4; ++j) { const f32x4* p = (const f32x4*)(xr + 512 * j + 8 * lane); v[j][0] = p[0]; v[j][1] = p[1]; }
        } else {
#pragma unroll
            for (int j = 0; j < 4; ++j) ld_bf16x8(XB + (size_t)r * DM + 512 * j + 8 * lane, v[j][0], v[j][1]);
        }
#pragma unroll
        for (int j = 0; j < 4; ++j)
#pragma unroll
            for (int q = 0; q < 4; ++q) ss += v[j][0][q] * v[j][0][q] + v[j][1][q] * v[j][1][q];
        const float rs = 1.0f / sqrtf(wave_sum(ss) * (1.f / DM) + EPS);
#pragma unroll
        for (int j = 0; j < 4; ++j) { const int c0 = 512 * j + 8 * lane; f32x4 o[2];
#pragma unroll
            for (int h = 0; h < 2; ++h) { const f32x4 g4 = *(const f32x4*)(ng + c0 + 4 * h), sh = *(const f32x4*)(mr + c0 + 4 * h), sc = *(const f32x4*)(mr + DM + c0 + 4 * h);
                o[h] = (v[j][h] * rs) * g4 * (sc + 1.0f) + sh; }
            st_bf16x8(H + (size_t)r * DM + c0, o[0], o[1]); }
    }
}
DI void final_norm_phase(const Args& A, const float* src_override, int wv) {
    const int tid = otid(wv), lane = tid & 63, wave = tid >> 6, G = gridDim.x;
    const float* fg = A.in[17];
    for (int r = blockIdx.x * NWAVES + wave; r < NB * TL; r += G * NWAVES) {
        const float* xr = (src_override ? src_override : (const float*)A.out) + (size_t)r * DM; float* orow = A.out + (size_t)r * DM;
        f32x4 v[4][2]; float ss = 0.f;
#pragma unroll
        for (int j = 0; j < 4; ++j) { const f32x4* p = (const f32x4*)(xr + 512 * j + 8 * lane); v[j][0] = p[0]; v[j][1] = p[1];
#pragma unroll
            for (int q = 0; q < 4; ++q) ss += v[j][0][q] * v[j][0][q] + v[j][1][q] * v[j][1][q]; }
        const float rs = 1.0f / sqrtf(wave_sum(ss) * (1.f / DM) + EPS);
#pragma unroll
        for (int j = 0; j < 4; ++j) { const int c0 = 512 * j + 8 * lane;
#pragma unroll
            for (int h = 0; h < 2; ++h) { const f32x4 g4 = *(const f32x4*)(fg + c0 + 4 * h); *(f32x4*)(orow + c0 + 4 * h) = (v[j][h] * rs) * g4; } }
    }
}


struct DescPlain {
    const bf16_t* A; const bf16_t* B; int nN; bool latonly; int lda, ldb, K, total;
    DI void init(const bf16_t* A_, const bf16_t* B_, int nN_, bool lat) { A = A_; B = B_; nN = nN_; latonly = lat; lda = DM; ldb = DM; K = DM; total = (lat ? 128 : 144) * nN_; }
    DI pg8::Unit unit(int idx) const {
        const int nMt = latonly ? 128 : 144, nig = 8 * nN, gid = idx / nig, fm = gid * 8, gsz = (nMt - fm) < 8 ? (nMt - fm) : 8;
        const int pmi = fm + (idx % nig) % gsz, pn = (idx % nig) / gsz, pm = latonly ? (pmi / 8) * 9 + (pmi % 8) : pmi;
        pg8::Unit u; u.a = (const char*)(A + (size_t)pm * 256 * DM); u.b = (const char*)(B + (size_t)pn * 256 * DM); u.i0 = pm; u.i1 = pn; u.i2 = 0; return u;
    }
};
struct DescChan {
    const bf16_t* DC; const bf16_t* H; int lda, ldb, K, total;
    DI void init(const bf16_t* DC_, const bf16_t* H_, bool lat) { DC = DC_; H = H_; lda = 512; ldb = DM; K = 512; total = lat ? 2048 : 2304; }
    DI pg8::Unit unit(int idx) const {
        pg8::Unit u; int b, g, mt, nt, toff;
        if (idx < 2048) { mt = idx % 4; nt = (idx / 4) % 8; g = (idx / 32) % 4; b = idx / 128; toff = nt * 256; u.i2 = nt; }
        else { const int j = idx - 2048; mt = j % 4; g = (j / 4) % 4; b = j / 16; toff = TL; u.i2 = 8; }
        u.a = (const char*)(DC + (size_t)mt * 256 * 512); u.b = (const char*)(H + ((size_t)b * TB + toff) * DM + g * 512); u.i0 = b * 4 + g; u.i1 = mt; return u;
    }
};
struct DescT {
    const bf16_t* DT; const bf16_t* PQ; int nMt; int lda, ldb, K, total;
    DI void init(const bf16_t* DT_, const bf16_t* PQ_, int ld, int Kd, int coff, int nMt_) { DT = DT_ + coff; PQ = PQ_ + coff; nMt = nMt_; lda = ld; ldb = ld; K = Kd; total = NB * nMt_ * 8; }
    DI pg8::Unit unit(int idx) const {
        const int mt = idx % nMt, nt = (idx / nMt) % 8, b = idx / (nMt * 8);
        pg8::Unit u; u.a = (const char*)(DT + (size_t)mt * 256 * lda); u.b = (const char*)(PQ + ((size_t)b * DM + nt * 256) * ldb); u.i0 = b; u.i1 = mt; u.i2 = nt; return u;
    }
};

DI void resid_store(const Args& A, int layer, int pm, int row_l, int col, const float* modl, f32x4 v0, f32x4 v1) {
    const int b = pm / 9, tt = pm % 9;
    const float* gp = modl + (size_t)(tt < 8 ? b : 16) * MOD_LD + 2 * DM + col;
    const f32x4 g0 = *(const f32x4*)gp, g1 = *(const f32x4*)(gp + 4);
    bf16_t* XB = (bf16_t*)A.out;
    const size_t roff = ((size_t)pm * 256 + row_l) * DM + col;
    f32x4 x0, x1;
    if (layer == 0) {
        const float* src = (tt < 8) ? A.in[0] + ((size_t)b * TL + tt * 256 + row_l) * DM + col : A.in[2] + ((size_t)b * TC + row_l) * DM + col;
        x0 = *(const f32x4*)src; x1 = *(const f32x4*)(src + 4);
    } else ld_bf16x8(XB + roff, x0, x1);
    x0 = x0 + g0 * v0; x1 = x1 + g1 * v1;
    if (layer == 3) { float* dst = (float*)(A.ws + WS_SCR + F_PQX) + ((size_t)b * TL + tt * 256 + row_l) * DM + col; *(f32x4*)dst = x0; *(f32x4*)(dst + 4) = x1; }
    else st_bf16x8(XB + roff, x0, x1);
}

DI void fnet_layer(const Args& A, LAS unsigned char* lds, const XcdBarrier& gbar, int layer, int j, bool latonly, int wv) {
    unsigned char* ws = A.ws;
    const bf16_t* H = (const bf16_t*)(ws + WS_H); bf16_t* U = (bf16_t*)(ws + WS_H);
    bf16_t* Gt = (bf16_t*)(ws + WS_SCR + F_G); bf16_t* PQX = (bf16_t*)(ws + WS_SCR + F_PQX); bf16_t* PQC = (bf16_t*)(ws + WS_SCR + F_PQC);
    norm_phase(A, layer, latonly, wv);
    xcd_barrier(gbar, wv);
    {
        DescPlain D; D.init(H, (const bf16_t*)(ws + WS_WFG) + (size_t)j * DM * DM, 8, latonly);
        auto E = [=](const pg8::Unit& u, int row_l, int col_l, f32x4 v0, f32x4 v1) {
            f32x4 a, b;
#pragma unroll
            for (int q = 0; q < 4; ++q) { a[q] = siluf(v0[q]); b[q] = siluf(v1[q]); }
            st_bf16x8(Gt + ((size_t)u.i0 * 256 + row_l) * DM + u.i1 * 256 + col_l, a, b);
        };
        pg8::gemm_phase(lds, D, E, wv);
    }
    {
        DescChan D; D.init((const bf16_t*)(ws + WS_DC), H, latonly);
        auto E = [=](const pg8::Unit& u, int row_l, int col_l, f32x4 v0, f32x4 v1) {
            const int b = u.i0 >> 2, g = u.i0 & 3, mt = u.i1, half = mt >> 1, ch = g * 512 + (mt & 1) * 256 + row_l;
            bf16_t* dst = (u.i2 < 8) ? PQX + ((size_t)b * DM + ch) * 4096 + half * 2048 + u.i2 * 256 + col_l
                                     : PQC + ((size_t)b * DM + ch) * 512 + half * 256 + col_l;
            st_bf16x8(dst, v0, v1);
        };
        pg8::gemm_phase(lds, D, E, wv);
    }
    xcd_barrier(gbar, wv);
    bf16_t* A1 = (bf16_t*)(ws + WS_SCR + F_A1); float* NYQ = (float*)(ws + WS_SCR + F_NYQ);
    {
        const int tid = otid(wv), lane = tid & 63;
        for (int rr = blockIdx.x * NWAVES + wv; rr < NB * DM; rr += gridDim.x * NWAVES) {
            const bf16_t* pr = PQX + (size_t)rr * 4096; float acc = 0.f;
#pragma unroll
            for (int q = 0; q < 4; ++q) { f32x4 a, b; ld_bf16x8(pr + (q * 64 + lane) * 8, a, b); acc += (a[0] - a[1]) + (a[2] - a[3]) + (b[0] - b[1]) + (b[2] - b[3]); }
            acc = wave_sum(acc);
            if (lane == 0) NYQ[rr] = acc * 0.022097086912079608f;
        }
    }
    {
        DescT D; D.init((const bf16_t*)(ws + WS_DT), PQX, 4096, 2048, 0, 4);
        auto E = [=](const pg8::Unit& u, int row_l, int col_l, f32x4 v0, f32x4 v1) {
            st_bf16x8(A1 + ((size_t)u.i0 * 1024 + u.i1 * 256 + row_l) * DM + u.i2 * 256 + col_l, v0, v1);
        };
        pg8::gemm_phase(lds, D, E, wv);
    }
    xcd_barrier(gbar, wv);
    {
        DescT D; D.init((const bf16_t*)(ws + WS_DT), PQX, 4096, 2048, 2048, 4);
        auto E = [=](const pg8::Unit& u, int row_l, int col_l, f32x4 v0, f32x4 v1) {
            const int k = u.i1 * 256 + row_l, col = u.i2 * 256 + col_l;
            f32x4 a0, a1; ld_bf16x8(A1 + ((size_t)u.i0 * 1024 + k) * DM + col, a0, a1);
            const size_t off = ((size_t)u.i0 * TB + k) * DM + col;
            f32x4 g0, g1; ld_bf16x8(Gt + off, g0, g1);
            st_bf16x8(U + off, (a0 + v0) * g0, (a1 + v1) * g1);
            const size_t off2 = ((size_t)u.i0 * TB + (k == 0 ? 1024 : TL - k)) * DM + col;
            ld_bf16x8(Gt + off2, g0, g1);
            if (k == 0) { const float* nq = NYQ + (size_t)u.i0 * DM + col; a0 = *(const f32x4*)nq; a1 = *(const f32x4*)(nq + 4); v0 = (f32x4){0.f, 0.f, 0.f, 0.f}; v1 = v0; }
            st_bf16x8(U + off2, (a0 - v0) * g0, (a1 - v1) * g1);
        };
        pg8::gemm_phase(lds, D, E, wv);
    }
    if (!latonly) {
        DescT D; D.init((const bf16_t*)(ws + WS_DT2), PQC, 512, 512, 0, 1);
        auto E = [=](const pg8::Unit& u, int row_l, int col_l, f32x4 v0, f32x4 v1) {
            const size_t off = ((size_t)u.i0 * TB + TL + row_l) * DM + u.i2 * 256 + col_l;
            f32x4 g0, g1; ld_bf16x8(Gt + off, g0, g1);
            st_bf16x8(U + off, v0 * g0, v1 * g1);
        };
        pg8::gemm_phase(lds, D, E, wv);
    }
    xcd_barrier(gbar, wv);
    {
        DescPlain D; D.init(U, (const bf16_t*)(ws + WS_WFO) + (size_t)j * DM * DM, 8, latonly);
        const float* modl = (const float*)(ws + WS_MOD) + (size_t)layer * 17 * MOD_LD;
        auto E = [=](const pg8::Unit& u, int row_l, int col_l, f32x4 v0, f32x4 v1) { resid_store(A, layer, u.i0, row_l, u.i1 * 256 + col_l, modl, v0, v1); };
        pg8::gemm_phase(lds, D, E, wv);
    }
    xcd_barrier(gbar, wv);
}


namespace att {
constexpr int D = 128, NW = 8, QBLK = 32, KVBLK = 64;
constexpr float SCALE = 0.088388347648318440f;
constexpr float THR = 8.f;
constexpr int LDQ = 2048, LDK = 512;
constexpr size_t SHM_V = KVBLK * D * 2, SHM_K = KVBLK * D * 2;
typedef float f32x8 __attribute__((ext_vector_type(8)));
#define KSWZ(row, colB) ((row) * 256 + ((colB) ^ (((row) & 7) << 4)))
#define SBAR() __builtin_amdgcn_sched_barrier(0)
DI int crow(int r, int hi) { return (r & 3) + 8 * (r >> 2) + 4 * hi; }
DI unsigned cvtpk(float lo, float hi) { unsigned r; asm volatile("v_cvt_pk_bf16_f32 %0, %1, %2" : "=v"(r) : "v"(lo), "v"(hi)); return r; }
DI void partialSM(f32x16& p0, f32x16& p1, float& m_reg, float& mn, float& alpha) {
  constexpr float C = SCALE * 1.4426950408889634f;
  float pmax = p0[0];
#pragma unroll
  for (int r = 1; r < 16; ++r) pmax = fmaxf(pmax, p0[r]);
#pragma unroll
  for (int r = 0; r < 16; ++r) pmax = fmaxf(pmax, p1[r]);
  { auto rr = __builtin_amdgcn_permlane32_swap(__float_as_uint(pmax), __float_as_uint(pmax), false, false);
    pmax = fmaxf(__uint_as_float(rr[0]), __uint_as_float(rr[1])); }
  if (__builtin_expect(__all(pmax - m_reg <= THR / SCALE), 1)) { mn = m_reg; alpha = 1.f; }
  else { mn = fmaxf(m_reg, pmax); alpha = __builtin_amdgcn_exp2f((m_reg - mn) * C); m_reg = mn; }
  float mnC = -mn * C;
#pragma unroll
  for (int r = 0; r < 16; ++r) p0[r] = fmaf(p0[r], C, mnC);
#pragma unroll
  for (int r = 0; r < 16; ++r) p1[r] = fmaf(p1[r], C, mnC);
#pragma unroll
  for (int r = 0; r < 16; ++r) p0[r] = __builtin_amdgcn_exp2f(p0[r]);
}
DI void finishSM(f32x16& p0, f32x16& p1, float alpha, float& l_reg, bf16x8& pa0, bf16x8& pa1, bf16x8& pa2, bf16x8& pa3) {
#pragma unroll
  for (int r = 0; r < 16; ++r) p1[r] = __builtin_amdgcn_exp2f(p1[r]);
  float ps = 0;
#pragma unroll
  for (int r = 0; r < 16; ++r) ps += p0[r];
#pragma unroll
  for (int r = 0; r < 16; ++r) ps += p1[r];
  { auto rr = __builtin_amdgcn_permlane32_swap(__float_as_uint(ps), __float_as_uint(ps), false, false);
    ps = __uint_as_float(rr[0]) + __uint_as_float(rr[1]); }
  l_reg = l_reg * alpha + ps;
#define PK4(P, BASE, OUT) do { unsigned a0 = cvtpk(P[BASE + 0], P[BASE + 1]), a1 = cvtpk(P[BASE + 2], P[BASE + 3]);   \
    unsigned b0 = cvtpk(P[BASE + 4], P[BASE + 5]), b1 = cvtpk(P[BASE + 6], P[BASE + 7]);                              \
    auto r0 = __builtin_amdgcn_permlane32_swap(a0, b0, false, false); auto r1 = __builtin_amdgcn_permlane32_swap(a1, b1, false, false); \
    u32x4 w = {r0[0], r1[0], r0[1], r1[1]}; OUT = *reinterpret_cast<bf16x8*>(&w); } while (0)
  PK4(p0, 0, pa0); PK4(p0, 8, pa1); PK4(p1, 0, pa2); PK4(p1, 8, pa3);
#undef PK4
}
DI void qkt(f32x16& p0, f32x16& p1, const bf16_t* Ks, const bf16x8* qr, int r32, int hi) {
  p0 = f32x16{}; p1 = f32x16{};
#pragma unroll
  for (int d0 = 0; d0 < 8; ++d0) { int cb = (d0 * 16 + hi * 8) * 2;
    bf16x8 b0 = *reinterpret_cast<const bf16x8*>((const char*)Ks + KSWZ(r32, cb));
    bf16x8 b1 = *reinterpret_cast<const bf16x8*>((const char*)Ks + KSWZ(32 + r32, cb));
    p0 = __builtin_amdgcn_mfma_f32_32x32x16_bf16(b0, qr[d0], p0, 0, 0, 0);
    p1 = __builtin_amdgcn_mfma_f32_32x32x16_bf16(b1, qr[d0], p1, 0, 0, 0); }
}
DI int v_st(int k, int c) { const int kk = (k & ~0xC) | ((k & 4) << 1) | ((k & 8) >> 1); return ((kk >> 3) * 4 + (c >> 5)) * 512 + ((kk & 7) * 32 + (c & 31)) * 2; }
DI int v_rd_base(int lane) { return ((lane & 3) << 3) | (((lane >> 2) & 3) << 6) | (((lane >> 4) & 1) << 5) | (((lane >> 5) & 1) << 8); }
constexpr int v_rd_off(int d0, int ks, int half) { return d0 * 512 + ks * 4096 + half * 2048; }
template <int OFF> DI s16x4 tr_read(int vb) {
  s16x4 r; asm volatile("ds_read_b64_tr_b16 %0, %1 offset:%2" : "=&v"(r) : "v"(vb), "i"(OFF) : "memory"); return r;
}
template <int D0> DI void pv_one(f32x16& od, int vb, bf16x8 pa0, bf16x8 pa1, bf16x8 pa2, bf16x8 pa3) {
  const s16x4 l0 = tr_read<v_rd_off(D0, 0, 0)>(vb), h0 = tr_read<v_rd_off(D0, 0, 1)>(vb), l1 = tr_read<v_rd_off(D0, 1, 0)>(vb), h1 = tr_read<v_rd_off(D0, 1, 1)>(vb);
  const s16x4 l2 = tr_read<v_rd_off(D0, 2, 0)>(vb), h2 = tr_read<v_rd_off(D0, 2, 1)>(vb), l3 = tr_read<v_rd_off(D0, 3, 0)>(vb), h3 = tr_read<v_rd_off(D0, 3, 1)>(vb);
  asm volatile("s_waitcnt lgkmcnt(0)" ::: "memory"); SBAR();
#define PK(L, H) (bf16x8){L[0], L[1], L[2], L[3], H[0], H[1], H[2], H[3]}
  od = __builtin_amdgcn_mfma_f32_32x32x16_bf16(pa0, PK(l0, h0), od, 0, 0, 0);
  od = __builtin_amdgcn_mfma_f32_32x32x16_bf16(pa1, PK(l1, h1), od, 0, 0, 0);
  od = __builtin_amdgcn_mfma_f32_32x32x16_bf16(pa2, PK(l2, h2), od, 0, 0, 0);
  od = __builtin_amdgcn_mfma_f32_32x32x16_bf16(pa3, PK(l3, h3), od, 0, 0, 0);
#undef PK
}
DI void pv_d0(f32x16* o, int vb, bf16x8 pa0, bf16x8 pa1, bf16x8 pa2, bf16x8 pa3) {
  pv_one<0>(o[0], vb, pa0, pa1, pa2, pa3); pv_one<1>(o[1], vb, pa0, pa1, pa2, pa3); pv_one<2>(o[2], vb, pa0, pa1, pa2, pa3); pv_one<3>(o[3], vb, pa0, pa1, pa2, pa3);
}
DI void attn_dense_body(const bf16_t* __restrict__ Qb, const bf16_t* __restrict__ Kh, const bf16_t* __restrict__ Vh, const bf16_t* SZb, bf16_t* Ub, int seq, char* lds, int wv) {
  const int tid = otid(wv), wid = tid >> 6, lane = tid & 63, r32 = lane & 31, hi = lane >> 5;
  bf16_t* V_lds = (bf16_t*)lds; bf16_t* K_lds = (bf16_t*)(lds + 2 * SHM_V);
  float* wsf = (float*)(lds + 2 * SHM_V + 2 * SHM_K) + wid * 64; float* li_l = wsf; float* al_l = wsf + 32;
  float m_reg = -1e30f, l_reg = 0; f32x16 o[4] = {}; bf16x8 qr[8];
  const bf16_t* Qw = Qb + (long)(wid * QBLK + r32) * LDQ + hi * 8;
#pragma unroll
  for (int d0 = 0; d0 < 8; ++d0) qr[d0] = *reinterpret_cast<const bf16x8*>(Qw + d0 * 16);
  const int sr = tid >> 4, sc = (tid & 15) * 8, vst0 = v_st(sr, sc), vst1 = v_st(32 + sr, sc);
  const int vb0 = (int)(uintptr_t)V_lds + v_rd_base(lane);
  struct { bf16x8 vs0, vs1, ks0, ks1; } sr_[2];
#define SLOAD(i, k0) do { sr_[i].vs0 = *reinterpret_cast<const bf16x8*>(&Vh[(long)((k0) + sr) * LDK + sc]); sr_[i].vs1 = *reinterpret_cast<const bf16x8*>(&Vh[(long)((k0) + 32 + sr) * LDK + sc]); \
    sr_[i].ks0 = *reinterpret_cast<const bf16x8*>(&Kh[(long)((k0) + sr) * LDK + sc]); sr_[i].ks1 = *reinterpret_cast<const bf16x8*>(&Kh[(long)((k0) + 32 + sr) * LDK + sc]); } while (0)
#define SWRITE(b, i) do { *(bf16x8*)((char*)V_lds + (b) * SHM_V + vst0) = sr_[i].vs0;          \
    *(bf16x8*)((char*)V_lds + (b) * SHM_V + vst1) = sr_[i].vs1; int kc = sc * 2;               \
    *(bf16x8*)((char*)K_lds + (b) * SHM_K + KSWZ(sr, kc)) = sr_[i].ks0;                       \
    *(bf16x8*)((char*)K_lds + (b) * SHM_K + KSWZ(32 + sr, kc)) = sr_[i].ks1; } while (0)
#define SWAIT() asm volatile("s_waitcnt vmcnt(4)" ::: "memory")
#define RESC(a) do { if (__any((a) < 1.f)) { if (hi == 0) al_l[r32] = (a); asm volatile("s_waitcnt lgkmcnt(0)" ::: "memory"); \
    _Pragma("unroll") for (int d = 0; d < 4; ++d) _Pragma("unroll") for (int r = 0; r < 16; ++r) o[d][r] *= al_l[crow(r, hi)]; } } while (0)
  f32x16 pA0, pA1, pB0, pB1; float mnA, mnB, alA, alB; bf16x8 pa0, pa1, pa2, pa3; const int NT = seq / KVBLK;
  constexpr int SE = 0, SO = 1;
  SLOAD(SE, 0); asm volatile("s_waitcnt vmcnt(0)" ::: "memory"); SWRITE(0, SE); __syncthreads();
  qkt(pA0, pA1, K_lds, qr, r32, hi); partialSM(pA0, pA1, m_reg, mnA, alA);
  SLOAD(SO, KVBLK); if (2 < NT) SLOAD(SE, 2 * KVBLK);
  SWAIT(); SWRITE(1, SO); __syncthreads();
  for (int j = 1; j + 1 < NT; j += 2) {
    SBAR(); qkt(pB0, pB1, (bf16_t*)((char*)K_lds + SHM_K), qr, r32, hi);
    finishSM(pA0, pA1, alA, l_reg, pa0, pa1, pa2, pa3); SBAR();
    SLOAD(SO, (j + 2) * KVBLK); SBAR();
    pv_d0(o, vb0, pa0, pa1, pa2, pa3); partialSM(pB0, pB1, m_reg, mnB, alB);
    __syncthreads(); SWAIT(); SWRITE(0, SE);
    RESC(alB); __syncthreads();
    SBAR(); qkt(pA0, pA1, K_lds, qr, r32, hi);
    finishSM(pB0, pB1, alB, l_reg, pa0, pa1, pa2, pa3); SBAR();
    if (j + 3 < NT) SLOAD(SE, (j + 3) * KVBLK); SBAR();
    pv_d0(o, vb0 + (int)SHM_V, pa0, pa1, pa2, pa3); partialSM(pA0, pA1, m_reg, mnA, alA);
    __syncthreads(); SWAIT(); SWRITE(1, SO);
    RESC(alA); __syncthreads();
  }
  SBAR(); qkt(pB0, pB1, (bf16_t*)((char*)K_lds + SHM_K), qr, r32, hi);
  finishSM(pA0, pA1, alA, l_reg, pa0, pa1, pa2, pa3); SBAR();
  pv_d0(o, vb0, pa0, pa1, pa2, pa3); partialSM(pB0, pB1, m_reg, mnB, alB);
  __syncthreads(); RESC(alB);
  finishSM(pB0, pB1, alB, l_reg, pa0, pa1, pa2, pa3); SBAR();
  pv_d0(o, vb0 + (int)SHM_V, pa0, pa1, pa2, pa3);
  if (hi == 0) li_l[r32] = l_reg; asm volatile("s_waitcnt lgkmcnt(0)" ::: "memory");
  float rli[16];
#pragma unroll
  for (int r = 0; r < 16; ++r) rli[r] = __builtin_amdgcn_rcpf(li_l[crow(r, hi)]);
#pragma unroll
  for (int r = 0; r < 16; ++r) { const long ro = (long)(wid * QBLK + crow(r, hi)) * LDQ + r32;
#pragma unroll
    for (int d0 = 0; d0 < 4; ++d0) Ub[ro + d0 * 32] = (bf16_t)(pk2(o[d0][r] * rli[r], 0.f) & 0xffffu); }
  __syncthreads();
#pragma unroll 2
  for (int i = 0; i < 8; ++i) { const int id = tid + 512 * i; const long off = (long)(id >> 4) * LDQ + (id & 15) * 8;
    f32x4 a0, a1, z0, z1; ld_bf16x8(Ub + off, a0, a1); ld_bf16x8(SZb + off, z0, z1); st_bf16x8(Ub + off, a0 * z0, a1 * z1); }
  __syncthreads();
#undef SLOAD
#undef SWRITE
#undef SWAIT
#undef RESC
}
#undef KSWZ
#undef SBAR
}

DI void qknorm_phase(const Args& A, int wv) {
    const int tid = otid(wv), lane = tid & 63, wave = tid >> 6, G = gridDim.x;
    bf16_t* Q = (bf16_t*)(A.ws + WS_SCR + A_Q); bf16_t* Kb = (bf16_t*)(A.ws + WS_SCR + A_K);
    const float* qn = A.in[14]; const float* kn = A.in[15];
    const int sub = lane >> 4, l16 = lane & 15, e0 = l16 * 8;
    const long NIT = (long)NTOK * 20;
    for (long it = ((long)blockIdx.x * NWAVES + wave) * 4 + sub; it < NIT; it += (long)G * NWAVES * 4) {
        const int row = (int)(it / 20), hj = (int)(it % 20);
        bf16_t* p = (hj < 16) ? Q + (size_t)row * 2048 + hj * 128 + e0 : Kb + (size_t)row * 512 + (hj - 16) * 128 + e0;
        const float* wn = (hj < 16 ? qn : kn) + e0;
        f32x4 a, b; ld_bf16x8(p, a, b);
        float ss = 0.f;
#pragma unroll
        for (int q = 0; q < 4; ++q) ss += a[q] * a[q] + b[q] * b[q];
        ss += __shfl_xor(ss, 1); ss += __shfl_xor(ss, 2); ss += __shfl_xor(ss, 4); ss += __shfl_xor(ss, 8);
        const float rs = 1.0f / sqrtf(ss * (1.f / 128.f) + EPS);
        const f32x4 w0 = *(const f32x4*)wn, w1 = *(const f32x4*)(wn + 4);
        a = a * rs * w0; b = b * rs * w1;
        const int t = row % TB;
        if (t < TL) {
            const float pos = (l16 < 8) ? (float)(t >> 6) : (float)(t & 63);
            float y[8] = {a[0], a[1], a[2], a[3], b[0], b[1], b[2], b[3]};
#pragma unroll
            for (int pp = 0; pp < 4; ++pp) {
                const int fi = (4 * l16 + pp) & 31;
                const float ang = pos * exp2f(-(float)fi * 0.41524101186092029f);
                const float cs = cosf(ang), sn = sinf(ang);
                const float x0 = y[2 * pp], x1 = y[2 * pp + 1];
                y[2 * pp] = x0 * cs - x1 * sn; y[2 * pp + 1] = x0 * sn + x1 * cs;
            }
            a = (f32x4){y[0], y[1], y[2], y[3]}; b = (f32x4){y[4], y[5], y[6], y[7]};
        }
        st_bf16x8(p, a, b);
    }
}

DI void attn_layer(const Args& A, LAS unsigned char* lds, char* lds_gen, const XcdBarrier& gbar, int layer, int wv) {
    unsigned char* ws = A.ws;
    const bf16_t* H = (const bf16_t*)(ws + WS_H); bf16_t* U = (bf16_t*)(ws + WS_H);
    bf16_t* Q = (bf16_t*)(ws + WS_SCR + A_Q); bf16_t* Kb = (bf16_t*)(ws + WS_SCR + A_K); bf16_t* Vb = (bf16_t*)(ws + WS_SCR + A_V); bf16_t* SZ = (bf16_t*)(ws + WS_SCR + A_SZ);
    norm_phase(A, layer, false, wv);
    xcd_barrier(gbar, wv);
    {
        DescPlain D; D.init(H, (const bf16_t*)(ws + WS_WAI), 20, false);
        auto E = [=](const pg8::Unit& u, int row_l, int col_l, f32x4 v0, f32x4 v1) {
            const size_t row = (size_t)u.i0 * 256 + row_l; const int pn = u.i1;
            if (pn < 8) st_bf16x8(Q + row * 2048 + pn * 256 + col_l, v0, v1);
            else if (pn < 10) st_bf16x8(Kb + row * 512 + (pn - 8) * 256 + col_l, v0, v1);
            else if (pn < 12) st_bf16x8(Vb + row * 512 + (pn - 10) * 256 + col_l, v0, v1);
            else { f32x4 a, b;
#pragma unroll
                for (int q = 0; q < 4; ++q) { a[q] = siluf(v0[q]); b[q] = siluf(v1[q]); }
                st_bf16x8(SZ + row * 2048 + (pn - 12) * 256 + col_l, a, b); }
        };
        pg8::gemm_phase(lds, D, E, wv);
    }
    xcd_barrier(gbar, wv);
    qknorm_phase(A, wv);
    xcd_barrier(gbar, wv);
    {
        const int G = gridDim.x, c = blockIdx.x;
        for (long L = c; L < 2048; L += G) {
            const int u = pg8::xcd_remap((int)L, 2048);
            const int b = u / 128, rem = u % 128, kvh = rem / 32, g = (rem / 8) % 4, qb = rem % 8, h = kvh * 4 + g;
            const size_t qoff = ((size_t)b * TB + qb * 256) * 2048 + h * 128, koff = ((size_t)b * TB) * 512 + kvh * 128;
            att::attn_dense_body(Q + qoff, Kb + koff, Vb + koff, SZ + qoff, U + qoff, TB, lds_gen, wv);
        }
        for (int u = c; u < 256; u += G) {
            const int b = u / 16, h = u % 16, kvh = h / 4;
            const size_t qoff = ((size_t)b * TB + TL) * 2048 + h * 128, koff = ((size_t)b * TB + TL) * 512 + kvh * 128;
            att::attn_dense_body(Q + qoff, Kb + koff, Vb + koff, SZ + qoff, U + qoff, TC, lds_gen, wv);
        }
    }
    xcd_barrier(gbar, wv);
    {
        DescPlain D; D.init(U, (const bf16_t*)(ws + WS_WAO), 8, false);
        const float* modl = (const float*)(ws + WS_MOD) + (size_t)layer * 17 * MOD_LD;
        auto E = [=](const pg8::Unit& u, int row_l, int col_l, f32x4 v0, f32x4 v1) { resid_store(A, layer, u.i0, row_l, u.i1 * 256 + col_l, modl, v0, v1); };
        pg8::gemm_phase(lds, D, E, wv);
    }
    xcd_barrier(gbar, wv);
}


struct DescM1 {
    const bf16_t* H; const bf16_t* WA; const bf16_t* WB; int lda, ldb, K, total;
    DI void init(const bf16_t* H_, const bf16_t* WA_, const bf16_t* WB_) { H = H_; WA = WA_; WB = WB_; lda = DM; ldb = DM; K = DM; total = 144 * 9 + 12 * 144; }
    DI pg8::Unit unit(int idx) const {
        pg8::Unit u;
        if (idx < 1296) { const int nig = 72, gid = idx / nig, pm = gid * 8 + (idx % nig) % 8, pn = (idx % nig) / 8;
            u.a = (const char*)(H + (size_t)pm * 256 * DM); u.b = (const char*)(WA + (size_t)pn * 256 * DM); u.i0 = pm; u.i1 = pn; u.i2 = 0; }
        else { const int j = idx - 1296, mt = j % 12, nt = j / 12;
            u.a = (const char*)(WB + (size_t)mt * 256 * DM); u.b = (const char*)(H + (size_t)nt * 256 * DM); u.i0 = mt; u.i1 = nt; u.i2 = 1; }
        return u;
    }
};
namespace ml {
#define MFMA32(a, b, c) __builtin_amdgcn_mfma_f32_32x32x16_bf16((a), (b), (c), 0, 0, 0)
#define LFENCE() asm volatile("s_waitcnt lgkmcnt(0)" ::: "memory")
DI int crow(int reg, int h) { return (reg & 3) + 8 * (reg >> 2) + 4 * h; }
DI bf16x8 ldperm(const bf16_t* p) { const s16x4 lo = *(const s16x4*)p, hi = *(const s16x4*)(p + 8); return __builtin_shufflevector(lo, hi, 0, 1, 2, 3, 4, 5, 6, 7); }
DI bf16x8 pack_step(const f32x16& x, int s) { u32x4 p = {pk2(x[8 * s], x[8 * s + 1]), pk2(x[8 * s + 2], x[8 * s + 3]), pk2(x[8 * s + 4], x[8 * s + 5]), pk2(x[8 * s + 6], x[8 * s + 7])}; return __builtin_bit_cast(bf16x8, p); }
DI float bfs(short h) { return __uint_as_float(((unsigned)(unsigned short)h) << 16); }

constexpr int SC_Q = 0, SC_K = 16384, SC_KT = 32768, SC_BUF = 49152, SC_WAVE = 2 * SC_BUF, SC_WAVE_BYTES = 6144;
DI bf16x8 ldsfrag(const LAS unsigned char* buf, unsigned o) { const s16x4 lo = *(const LAS s16x4*)(buf + o), hi = *(const LAS s16x4*)(buf + (o ^ 16u)); return __builtin_shufflevector(lo, hi, 0, 1, 2, 3, 4, 5, 6, 7); }
DI void scan_phase(const Args& A, LAS unsigned char* lds, int wv) {
    const int wave = wv;
    LAS float* wl = (LAS float*)(lds + SC_WAVE + wave * SC_WAVE_BYTES);
    LAS unsigned char* hst = lds + SC_WAVE + wave * SC_WAVE_BYTES + 2048;
    unsigned char* ws = A.ws;
    const bf16_t* Qg = (const bf16_t*)(ws + WS_SCR + M_Q); const bf16_t* Kg = (const bf16_t*)(ws + WS_SCR + M_K); const bf16_t* KVT = (const bf16_t*)(ws + WS_SCR + M_KVT);
    const float* G32 = (const float*)(ws + WS_SCR + M_G32); const float* bg = A.in[10];
#define SC_POS0(j) (dir == 0 ? ((j) < 4 ? TL + 64 * (j) : 64 * ((j) - 4)) : ((j) < 4 ? TL + 64 * (3 - (j)) : 64 * (35 - (j))))
#define SC_DMA(bufi, p0) do { const int tj_ = otid(wv); _Pragma("unroll") for (int i_ = 0; i_ < 2; ++i_) { const int sl_ = i_ * 512 + tj_; \
        { const int row_ = sl_ >> 4, c_ = (sl_ & 15) ^ (row_ & 15); const size_t go_ = (size_t)((p0) + row_) * 1024 + c_ * 8; \
          __builtin_amdgcn_global_load_lds((const unsigned*)(Qu + go_), (LAS unsigned*)(lds + (bufi) * SC_BUF + SC_Q + i_ * 8192 + wave * 1024), 16, 0, 0); \
          __builtin_amdgcn_global_load_lds((const unsigned*)(Ku + go_), (LAS unsigned*)(lds + (bufi) * SC_BUF + SC_K + i_ * 8192 + wave * 1024), 16, 0, 0); } \
        { const int d_ = sl_ >> 3, c_ = (sl_ & 7) ^ ((d_ >> 1) & 7); \
          __builtin_amdgcn_global_load_lds((const unsigned*)(KTu + (size_t)d_ * TB + (p0) + c_ * 8), (LAS unsigned*)(lds + (bufi) * SC_BUF + SC_KT + i_ * 8192 + wave * 1024), 16, 0, 0); } } } while (0)
    for (int item = blockIdx.x; item < 256; item += gridDim.x) {
        const int dir = item & 1, h = (item >> 1) & 7, b = item >> 4, e0 = wave * 32;
        const bf16_t* Qu = Qg + (size_t)b * TB * 1024 + h * 128;
        const bf16_t* Ku = Kg + (size_t)b * TB * 1024 + h * 128;
        const bf16_t* KTu = KVT + ((size_t)b * 3072 + h * 128) * TB;
        const bf16_t* VTu = KVT + ((size_t)b * 3072 + 1024 + h * 256 + e0) * TB;
        bf16_t* Hout = (bf16_t*)(ws + WS_SCR + (dir ? M_HB : M_HF)) + (size_t)b * TB * DM + h * 256 + e0;
        const float big = bg[(dir * 2) * 8 + h], bfg = bg[(dir * 2 + 1) * 8 + h];
        f32x16 cacc[4];
#pragma unroll
        for (int d = 0; d < 4; ++d)
#pragma unroll
            for (int i = 0; i < 16; ++i) cacc[d][i] = 0.f;
        float m = 0.f;
        { const int l0 = otid(wv) & 63; wl[384 + l0] = 0.f; wl[448 + l0] = 0.f; }
        LFENCE();
        SC_DMA(0, SC_POS0(0));
        float ig_n, fg_n;
        { const int l0 = otid(wv) & 63; const float* gp = G32 + (size_t)(b * TB + SC_POS0(0) + (dir ? 63 - l0 : l0)) * 32 + (dir * 2) * 8 + h; ig_n = gp[0]; fg_n = gp[8]; }
        for (int j = 0; j < 36; ++j) {
            const int pos0 = SC_POS0(j);
            const LAS unsigned char* Qb = lds + (j & 1) * SC_BUF + SC_Q; const LAS unsigned char* Kb = lds + (j & 1) * SC_BUF + SC_K; const LAS unsigned char* KTb = lds + (j & 1) * SC_BUF + SC_KT;
            asm volatile("s_waitcnt vmcnt(0)" ::: "memory"); __builtin_amdgcn_s_barrier(); asm volatile("" ::: "memory");
            if (j + 1 < 36) SC_DMA((j + 1) & 1, SC_POS0(j + 1));
            const int lj = otid(wv) & 63, rj = lj & 31, h4 = (lj >> 5) * 4;
            LAS float* wh = wl + h4; LAS float* wr = wl + rj; LAS unsigned char* hb = hst + h4 * 64 + rj * 2;
            const unsigned xr = rj & 15, xd = (rj >> 1) & 7;
            const unsigned qro = (unsigned)rj * 256u + 2u * h4;
            const unsigned kro = (unsigned)rj * 128u + 2u * h4;
            const bf16_t* VTp = VTu + (size_t)rj * TB + pos0 + h4;
            bf16x8 vf[4];
#pragma unroll
            for (int kk = 0; kk < 4; ++kk) vf[kk] = ldperm(VTp + 16 * kk);
            float decay, m_new;
            {
                const int s = dir ? 63 - lj : lj;
                const float ig = ig_n + big, fg = fg_n + bfg;
                if (j + 1 < 36) { const float* gp = G32 + (size_t)(b * TB + SC_POS0(j + 1) + s) * 32 + (dir * 2) * 8 + h; ig_n = gp[0]; fg_n = gp[8]; }
                const float lf = fminf(fg, 0.f) - log1pf(__expf(-fabsf(fg)));
                float bs = lf;
#pragma unroll
                for (int o = 1; o < 64; o <<= 1) { const float t = __shfl_up(bs, o); if (lj >= o) bs += t; }
                const float uu = ig - bs;
                float pmx = uu;
#pragma unroll
                for (int o = 1; o < 64; o <<= 1) { const float t = __shfl_up(pmx, o); if (lj >= o) pmx = fmaxf(pmx, t); }
                pmx = fmaxf(pmx, m);
                const float b_end = __shfl(bs, 63), pm_last = __shfl(pmx, 63);
                LAS float* ws_ = wl + s;
                ws_[0] = uu; ws_[64] = pmx; ws_[128] = __expf(m - pmx); ws_[192] = __expf(-(bs + pmx)); ws_[256] = __expf(uu - pm_last);
                decay = __expf(m - pm_last); m_new = b_end + pm_last;
            }
            LFENCE();
            const int sbase = dir ? 63 - h4 : h4, sgn = dir ? -1 : 1;
#pragma unroll
            for (int tb = 0; tb < 2; ++tb) {
                __builtin_amdgcn_sched_barrier(0);
                const unsigned qo = qro + tb * 8192u;
                f32x16 ha;
#pragma unroll
                for (int i = 0; i < 16; ++i) ha[i] = 0.f;
                float qnv = 0.f;
#pragma unroll
                for (int kk = 0; kk < 8; ++kk) {
                    const bf16x8 qa = ldsfrag(Qb, qo + (((2u * kk) ^ xr) << 4));
                    ha = MFMA32(qa, pack_step(cacc[kk >> 1], kk & 1), ha);
                    const f32x4 n0 = *(const LAS f32x4*)(wh + 384 + 16 * kk), n1 = *(const LAS f32x4*)(wh + 384 + 16 * kk + 8);
#pragma unroll
                    for (int jj = 0; jj < 4; ++jj) qnv += bfs(qa[jj]) * n0[jj] + bfs(qa[4 + jj]) * n1[jj];
                }
                qnv += __shfl_xor(qnv, 32);
#pragma unroll
                for (int i = 0; i < 16; ++i) ha[i] *= wh[128 + 32 * tb + (i & 3) + 8 * (i >> 2)];
                const float pmt = wr[64 + 32 * tb];
                const int tp = dir ? (63 - 32 * tb) - rj : 32 * tb + rj;
                float ds = 0.f;
#pragma unroll
                for (int sb = 0; sb < 2; ++sb) {
                    __builtin_amdgcn_sched_barrier(0);
                    if (sb != tb && (dir ? sb < tb : sb > tb)) continue;
                    const unsigned ko = qro + sb * 8192u;
                    f32x16 st;
#pragma unroll
                    for (int i = 0; i < 16; ++i) st[i] = 0.f;
#pragma unroll
                    for (int kk = 0; kk < 8; ++kk) { const unsigned c = ((2u * kk) ^ xr) << 4; st = MFMA32(ldsfrag(Kb, ko + c), ldsfrag(Qb, qo + c), st); }
#pragma unroll
                    for (int i = 0; i < 16; ++i) {
                        const int sc = 32 * sb + (i & 3) + 8 * (i >> 2);
                        const int sp = sbase + sgn * sc;
                        st[i] *= __expf((sp <= tp) ? wh[sc] - pmt : -1e30f);
                        ds += st[i];
                    }
                    ha = MFMA32(pack_step(st, 0), vf[2 * sb], ha);
                    ha = MFMA32(pack_step(st, 1), vf[2 * sb + 1], ha);
                }
                ds += __shfl_xor(ds, 32);
                {
                    const float den = wr[128 + 32 * tb] * qnv + ds;
                    const float rd = 1.0f / fmaxf(fabsf(den), wr[192 + 32 * tb]);
                    if (h4 == 0) wr[320 + 32 * tb] = rd;
                }
                LFENCE();
#pragma unroll
                for (int i = 0; i < 16; ++i) { const int tc = 32 * tb + (i & 3) + 8 * (i >> 2);
                    *(LAS unsigned short*)(hb + tc * 64) = (unsigned short)(pk2(ha[i] * wh[320 + tc], 0.f) & 0xffffu); }
            }
            LFENCE();
            {
                bf16_t* hp = Hout + (size_t)(pos0 + lj) * DM;
                const LAS unsigned char* hrow = hst + lj * 64;
#pragma unroll
                for (int q = 0; q < 4; ++q) *(u32x4*)(hp + 8 * q) = *(const LAS u32x4*)(hrow + 16 * q);
            }
            __builtin_amdgcn_sched_barrier(0);
#pragma unroll
            for (int db = 0; db < 4; ++db) {
                if (db == 2) __builtin_amdgcn_sched_barrier(0);
#pragma unroll
                for (int i = 0; i < 16; ++i) cacc[db][i] *= decay;
                const unsigned to = kro + db * 4096u;
                float nadd = 0.f;
#pragma unroll
                for (int kk = 0; kk < 4; ++kk) {
                    const bf16x8 kv = ldsfrag(KTb, to + (((2u * kk) ^ xd) << 4));
                    const f32x4 w0 = *(const LAS f32x4*)(wh + 256 + 16 * kk), w1 = *(const LAS f32x4*)(wh + 256 + 16 * kk + 8);
                    float f[8];
#pragma unroll
                    for (int jj = 0; jj < 4; ++jj) { f[jj] = bfs(kv[jj]) * w0[jj]; f[4 + jj] = bfs(kv[4 + jj]) * w1[jj]; }
#pragma unroll
                    for (int jj = 0; jj < 8; ++jj) nadd += f[jj];
                    u32x4 p = {pk2(f[0], f[1]), pk2(f[2], f[3]), pk2(f[4], f[5]), pk2(f[6], f[7])};
                    cacc[db] = MFMA32(__builtin_bit_cast(bf16x8, p), vf[kk], cacc[db]);
                }
                nadd += __shfl_xor(nadd, 32);
                if (h4 == 0) wr[384 + 32 * db] = decay * wr[384 + 32 * db] + nadd;
            }
            LFENCE();
            m = m_new;
        }
        asm volatile("s_waitcnt vmcnt(0)" ::: "memory"); __builtin_amdgcn_s_barrier();
    }
#undef SC_DMA
#undef SC_POS0
}
#undef MFMA32
#undef LFENCE
}

DI void mlstm_finish_phase(const Args& A, int wv) {
    const int tid = otid(wv), lane = tid & 63, wave = tid >> 6, G = gridDim.x;
    unsigned char* ws = A.ws;
    const bf16_t* HF = (const bf16_t*)(ws + WS_SCR + M_HF); const bf16_t* HB = (const bf16_t*)(ws + WS_SCR + M_HB);
    const bf16_t* SO = (const bf16_t*)(ws + WS_SCR + M_SO); const bf16_t* SZ = (const bf16_t*)(ws + WS_SCR + M_SZ);
    bf16_t* U = (bf16_t*)(ws + WS_H); const float* hn = A.in[11];
    const int sub = lane >> 5, e0 = (lane & 31) * 8;
    const long NIT = (long)NTOK * 8;
    for (long it = ((long)blockIdx.x * NWAVES + wave) * 2 + sub; it < NIT; it += (long)G * NWAVES * 2) {
        const size_t off = (size_t)(it >> 3) * DM + (int)(it & 7) * 256 + e0;
        f32x4 f0, f1, b0, b1, o0, o1, z0, z1;
        ld_bf16x8(HF + off, f0, f1); ld_bf16x8(HB + off, b0, b1); ld_bf16x8(SO + off, o0, o1); ld_bf16x8(SZ + off, z0, z1);
        f32x4 y0 = o0 * (f0 + b0), y1 = o1 * (f1 + b1);
        float ss = 0.f;
#pragma unroll
        for (int q = 0; q < 4; ++q) ss += y0[q] * y0[q] + y1[q] * y1[q];
        ss += __shfl_xor(ss, 1); ss += __shfl_xor(ss, 2); ss += __shfl_xor(ss, 4); ss += __shfl_xor(ss, 8); ss += __shfl_xor(ss, 16);
        const float rs = 1.0f / sqrtf(ss * (1.f / 256.f) + EPS);
        const float* hp = hn + (int)(it & 7) * 256 + e0;
        const f32x4 h0 = *(const f32x4*)hp, h1 = *(const f32x4*)(hp + 4);
        st_bf16x8(U + off, y0 * rs * h0 * z0, y1 * rs * h1 * z1);
    }
}

DI void mlstm_layer(const Args& A, LAS unsigned char* lds, const XcdBarrier& gbar, int layer, int wv) {
    unsigned char* ws = A.ws;
    const bf16_t* H = (const bf16_t*)(ws + WS_H); bf16_t* U = (bf16_t*)(ws + WS_H);
    bf16_t* Q = (bf16_t*)(ws + WS_SCR + M_Q); bf16_t* Kb = (bf16_t*)(ws + WS_SCR + M_K); bf16_t* KVT = (bf16_t*)(ws + WS_SCR + M_KVT);
    float* G32 = (float*)(ws + WS_SCR + M_G32); bf16_t* SO = (bf16_t*)(ws + WS_SCR + M_SO); bf16_t* SZ = (bf16_t*)(ws + WS_SCR + M_SZ);
    norm_phase(A, layer, false, wv);
    xcd_barrier(gbar, wv);
    {
        DescM1 D; D.init(H, (const bf16_t*)(ws + WS_WMA), (const bf16_t*)(ws + WS_WMB));
        auto E = [=](const pg8::Unit& u, int row_l, int col_l, f32x4 v0, f32x4 v1) {
            if (u.i2 == 0) {
                const size_t row = (size_t)u.i0 * 256 + row_l; const int pn = u.i1;
                if (pn < 4) st_bf16x8(Q + row * 1024 + pn * 256 + col_l, v0 * 0.088388347648318440f, v1 * 0.088388347648318440f);
                else if (pn < 8) st_bf16x8(Kb + row * 1024 + (pn - 4) * 256 + col_l, v0, v1);
                else if (col_l < 32) { *(f32x4*)(G32 + row * 32 + col_l) = v0; *(f32x4*)(G32 + row * 32 + col_l + 4) = v1; }
            } else {
                const int bb = u.i1 / 9, s0 = (u.i1 % 9) * 256;
                st_bf16x8(KVT + ((size_t)bb * 3072 + u.i0 * 256 + row_l) * TB + s0 + col_l, v0, v1);
            }
        };
        pg8::gemm_phase(lds, D, E, wv);
    }
    xcd_barrier(gbar, wv);
    ml::scan_phase(A, lds, wv);
    xcd_barrier(gbar, wv);
    {
        DescPlain D; D.init(H, (const bf16_t*)(ws + WS_WMA) + (size_t)2304 * DM, 16, false);
        auto E = [=](const pg8::Unit& u, int row_l, int col_l, f32x4 v0, f32x4 v1) {
            const size_t row = (size_t)u.i0 * 256 + row_l; const int pn = u.i1; f32x4 a, b;
            if (pn < 8) {
#pragma unroll
                for (int q = 0; q < 4; ++q) { a[q] = sigmf(v0[q]); b[q] = sigmf(v1[q]); }
                st_bf16x8(SO + row * DM + pn * 256 + col_l, a, b);
            } else {
#pragma unroll
                for (int q = 0; q < 4; ++q) { a[q] = siluf(v0[q]); b[q] = siluf(v1[q]); }
                st_bf16x8(SZ + row * DM + (pn - 8) * 256 + col_l, a, b);
            }
        };
        pg8::gemm_phase(lds, D, E, wv);
    }
    xcd_barrier(gbar, wv);
    mlstm_finish_phase(A, wv);
    xcd_barrier(gbar, wv);
    {
        DescPlain D; D.init(U, (const bf16_t*)(ws + WS_WMO), 8, false);
        const float* modl = (const float*)(ws + WS_MOD) + (size_t)layer * 17 * MOD_LD;
        auto E = [=](const pg8::Unit& u, int row_l, int col_l, f32x4 v0, f32x4 v1) { resid_store(A, layer, u.i0, row_l, u.i1 * 256 + col_l, modl, v0, v1); };
        pg8::gemm_phase(lds, D, E, wv);
    }
    xcd_barrier(gbar, wv);
}

__global__ void __launch_bounds__(NTHREADS, 2) fwd_megakernel(Args A) {
    extern __shared__ __attribute__((aligned(16))) unsigned char lds_raw[];
    LAS unsigned char* lds = (LAS unsigned char*)lds_raw;
    cg::grid_group grid = cg::this_grid();
    const int wv = __builtin_amdgcn_readfirstlane(threadIdx.x >> 6);
    volatile LAS unsigned* bst = (volatile LAS unsigned*)(lds + 147456);
    if (otid(wv) < 2) bst[otid(wv)] = 0u;
    __syncthreads();
    const XcdBarrier gbar = xcd_barrier_post((unsigned*)(A.ws + WS_BAR), bst, wv);
    prep_phase(A, lds, wv);
    grid.sync();
    {
        const long long* mi = (const long long*)(A.ws + WS_MODI); float* mf = (float*)(A.ws + WS_MOD);
        for (int i = blockIdx.x * NTHREADS + otid(wv); i < 4 * 17 * MOD_LD; i += gridDim.x * NTHREADS) mf[i] = (float)mi[i] * MODI_INV;
    }
    xcd_barrier(gbar, wv);
    fnet_layer(A, lds, gbar, 0, 0, false, wv);
    mlstm_layer(A, lds, gbar, 1, wv);
    attn_layer(A, lds, (char*)lds_raw, gbar, 2, wv);
    fnet_layer(A, lds, gbar, 3, 1, true, wv);
    final_norm_phase(A, (const float*)(A.ws + WS_SCR + F_PQX), wv);
}

extern "C" void kernel_launch(void* const* d_in, const int* in_sizes, int n_in, void* d_out, int out_size, void* d_ws, size_t ws_size, hipStream_t stream) {
    static int grid = 0;
    if (grid == 0) {
        if (n_in != 18 || ws_size < WS_END) { fprintf(stderr, "kernel_launch: unexpected n_in %d / ws_size %zu (need %zu)\n", n_in, ws_size, (size_t)WS_END); grid = -1; return; }
        int dev = 0, cus = 0, per_cu = 0;
        hipGetDevice(&dev);
        hipDeviceGetAttribute(&cus, hipDeviceAttributeMultiprocessorCount, dev);
        if (hipFuncSetAttribute((const void*)fwd_megakernel, hipFuncAttributeMaxDynamicSharedMemorySize, LDS_BYTES) != hipSuccess) { fprintf(stderr, "kernel_launch: hipFuncSetAttribute failed\n"); grid = -1; return; }
        if (hipOccupancyMaxActiveBlocksPerMultiprocessor(&per_cu, (const void*)fwd_megakernel, NTHREADS, LDS_BYTES) != hipSuccess || per_cu < 1) { fprintf(stderr, "kernel_launch: occupancy query failed (%d)\n", per_cu); per_cu = 1; }
        (void)hipGetLastError();
        grid = cus * per_cu;
        fprintf(stderr, "kernel_launch: grid %d (cus %d x %d)\n", grid, cus, per_cu);
    }
    if (grid < 0) return;
    (void)hipMemsetAsync((char*)d_ws + WS_MOD, 0, ZERO_BYTES, stream);
    (void)hipMemsetAsync((char*)d_ws + WS_MODI, 0, MODI_BYTES, stream);
    Args a{};
    for (int i = 0; i < 18; ++i) a.in[i] = (const float*)d_in[i];
    a.out = (float*)d_out; a.ws = (unsigned char*)d_ws; a.ph_lo = 0; a.ph_hi = 100;
    void* args[] = {&a};
    hipError_t e = hipLaunchCooperativeKernel((const void*)fwd_megakernel, dim3(grid), dim3(NTHREADS), args, LDS_BYTES, stream);
    if (e != hipSuccess) fprintf(stderr, "kernel_launch: cooperative launch failed: %s (grid %d)\n", hipGetErrorString(e), grid);
}
```

```cpp
#include <hip/hip_runtime.h>
#include <hip/hip_cooperative_groups.h>
#include <cstdio>
#include <cstdint>
namespace cg = cooperative_groups;

#define LAS __attribute__((address_space(3)))
#define DI __device__ __forceinline__
typedef unsigned short bf16_t;
typedef short bf16x8 __attribute__((ext_vector_type(8)));
typedef short s16x4 __attribute__((ext_vector_type(4)));
typedef float f32x2 __attribute__((ext_vector_type(2)));
typedef float f32x4 __attribute__((ext_vector_type(4)));
typedef float f32x16 __attribute__((ext_vector_type(16)));
typedef unsigned u32x2 __attribute__((ext_vector_type(2)));
typedef unsigned u32x4 __attribute__((ext_vector_type(4)));
typedef __bf16 bf16v2 __attribute__((ext_vector_type(2)));

constexpr int DM = 2048, NB = 16, TL = 2048, TC = 256, TB = TL + TC, NTOK = NB * TB;
constexpr int NWAVES = 8, NTHREADS = 512;
constexpr float EPS = 1e-6f;
constexpr int MOD_LD = 3 * DM;
constexpr int M_WA_ROWS = 6400, M_WB_ROWS = 3072;
constexpr size_t MiB = 1u << 20;
constexpr size_t WS_SCR_ = 301 * MiB;
constexpr size_t WS_MOD = 0;
constexpr size_t MOD_BYTES = (size_t)4 * 17 * MOD_LD * 4;
constexpr size_t WS_BAR = 1792 * 1024, ZERO_BYTES = 2 * MiB;
constexpr size_t WS_MODI = WS_SCR_ + 700 * MiB, MODI_BYTES = (size_t)4 * 17 * MOD_LD * 8;
constexpr float MODI_SCALE = 1073741824.f, MODI_INV = 9.313225746154785e-10f;
constexpr size_t WS_WFG = 2 * MiB, WS_WFO = 18 * MiB, WS_WMA = 34 * MiB, WS_WMB = 59 * MiB, WS_WMO = 71 * MiB, WS_WAI = 79 * MiB, WS_WAO = 99 * MiB;
constexpr size_t WS_DC = 107 * MiB, WS_DT = 108 * MiB, WS_DT2 = 124 * MiB, WS_CTXS = 125 * MiB, WS_H = 157 * MiB, WS_SCR = 301 * MiB;
constexpr size_t WS_END = 1024 * MiB;
constexpr size_t F_G = 0, F_PQX = 144 * MiB, F_PQC = 400 * MiB, F_A1 = 432 * MiB, F_NYQ = 496 * MiB;
constexpr size_t M_Q = 0, M_K = 72 * MiB, M_KVT = 144 * MiB, M_G32 = 360 * MiB, M_HF = 365 * MiB, M_HB = 509 * MiB, M_SO = 0, M_SZ = 144 * MiB;
constexpr size_t A_Q = 0, A_K = 144 * MiB, A_V = 180 * MiB, A_SZ = 216 * MiB;
static_assert(WS_SCR + M_HB + 144 * MiB <= WS_END, "ws map");
constexpr int LDS_BYTES = 147456 + 1024;

DI unsigned pk2(float a, float b) { f32x2 v = {a, b}; return __builtin_bit_cast(unsigned, __builtin_convertvector(v, bf16v2)); }
DI float bf_lo(unsigned w) { return __uint_as_float(w << 16); }
DI float bf_hi(unsigned w) { return __uint_as_float(w & 0xffff0000u); }
DI float wave_sum(float v) {
#pragma unroll
    for (int o = 1; o < 64; o <<= 1) v += __shfl_xor(v, o);
    return v;
}
DI int otid(int wv) { int t; asm volatile("v_mbcnt_lo_u32_b32 %0, -1, 0\n\tv_mbcnt_hi_u32_b32 %0, -1, %0" : "=v"(t)); return wv * 64 + t; }
DI float siluf(float x) { return x / (1.f + __expf(-x)); }
DI float sigmf(float x) { return 1.f / (1.f + __expf(-x)); }
DI void st_bf16x8(bf16_t* p, f32x4 a, f32x4 b) { u32x4 w = {pk2(a[0], a[1]), pk2(a[2], a[3]), pk2(b[0], b[1]), pk2(b[2], b[3])}; *(u32x4*)p = w; }
DI void ld_bf16x8(const bf16_t* p, f32x4& a, f32x4& b) { const u32x4 w = *(const u32x4*)p; a = (f32x4){bf_lo(w.x), bf_hi(w.x), bf_lo(w.y), bf_hi(w.y)}; b = (f32x4){bf_lo(w.z), bf_hi(w.z), bf_lo(w.w), bf_hi(w.w)}; }

DI f32x4 ldmod4(const long long* p) { return (f32x4){(float)p[0] * MODI_INV, (float)p[1] * MODI_INV, (float)p[2] * MODI_INV, (float)p[3] * MODI_INV}; }

struct Args { const float* in[18]; float* out; unsigned char* ws; int ph_lo, ph_hi; };

#define XB_TMO      128
#define XB_XCNT(j)  (256  + 64 * (j))
#define XB_XSUB(j)  (1280 + 64 * (j))
#define XB_XGEN(j)  (2304 + 64 * (j))
#define XB_TOP      3328
#define XB_TOPGEN   3392
#define XCD_BAR_WORDS 3456
#define XB_SPIN_CAP (1u << 18)

__device__ __forceinline__ unsigned xb_ld(unsigned* p)              { return __hip_atomic_load(p, __ATOMIC_RELAXED, __HIP_MEMORY_SCOPE_AGENT); }
__device__ __forceinline__ unsigned xb_add(unsigned* p, unsigned v) { return __hip_atomic_fetch_add(p, v, __ATOMIC_RELAXED, __HIP_MEMORY_SCOPE_AGENT); }
__device__ __forceinline__ unsigned xb_xcc_id() { return (unsigned)__builtin_amdgcn_s_getreg((3 << 11) | 20) & 0xFu; }
#define XB_SPIN(cond, bar) do { unsigned _sp = 0; while (cond) { __builtin_amdgcn_s_sleep(1); \
    if ((++_sp & 255u) == 0u) { if (xb_ld(&(bar)[XB_TMO])) break; if (_sp > XB_SPIN_CAP) { atomicAdd(&(bar)[XB_TMO], 1u); break; } } } } while (0)

struct XcdBarrier {
    unsigned* bar; unsigned x;
    volatile LAS unsigned* st;
};

__device__ __forceinline__ XcdBarrier xcd_barrier_post(unsigned* bar, volatile LAS unsigned* st, int wv) {
    XcdBarrier b; b.bar = bar; b.x = xb_xcc_id(); b.st = st;
    if (otid(wv) == 0) (void)xb_add(&bar[XB_XCNT(b.x)], 1u);
    return b;
}
__device__ __forceinline__ void xcd_barrier_complete(unsigned* bar, unsigned x, unsigned& nloc, unsigned& nx) {
    const unsigned G = gridDim.x * gridDim.y * gridDim.z;
    unsigned sum, cnt, mine, sp = 0u;
    for (;;) {
        sum = 0u; cnt = 0u; mine = 0u;
#pragma unroll
        for (unsigned j = 0; j < 16; ++j) { const unsigned c = xb_ld(&bar[XB_XCNT(j)]); sum += c; cnt += (c > 0u) ? 1u : 0u; mine = (j == x) ? c : mine; }
        if (sum == G) break;
        __builtin_amdgcn_s_sleep(1);
        if ((++sp & 255u) == 0u) { if (xb_ld(&bar[XB_TMO])) break; if (sp > XB_SPIN_CAP) { atomicAdd(&bar[XB_TMO], 1u); break; } }
    }
    nloc = mine > 0u ? mine : 1u; nx = cnt > 0u ? cnt : 1u;
}

__device__ __forceinline__ void xcd_barrier(const XcdBarrier& b, int wv) {
    asm volatile("s_waitcnt vmcnt(0)" ::: "memory");
    __syncthreads();
    if (otid(wv) == 0) {
        unsigned* bar = b.bar;
        __builtin_amdgcn_s_waitcnt(0);
        unsigned nloc = b.st[0], nx = b.st[1];
        if (nloc == 0u) { xcd_barrier_complete(bar, b.x, nloc, nx); b.st[0] = nloc; b.st[1] = nx; }
        const unsigned old = xb_add(&bar[XB_XSUB(b.x)], 1u);
        const unsigned gen = old / nloc;
        if (old + 1u == (gen + 1u) * nloc) {
            __builtin_amdgcn_fence(__ATOMIC_RELEASE, "agent");
            asm volatile("s_waitcnt vmcnt(0)" ::: "memory");
            const unsigned og = xb_add(&bar[XB_TOP], 1u);
            const unsigned tg = og / nx;
            if (og + 1u == (tg + 1u) * nx) xb_add(&bar[XB_TOPGEN], 1u);
            else XB_SPIN(xb_ld(&bar[XB_TOPGEN]) == tg, bar);
            __builtin_amdgcn_fence(__ATOMIC_ACQUIRE, "agent");
            xb_add(&bar[XB_XGEN(b.x)], 1u);
            asm volatile("s_waitcnt vmcnt(0)" ::: "memory");
        } else {
            XB_SPIN(xb_ld(&bar[XB_XGEN(b.x)]) == gen, bar);
            __builtin_amdgcn_fence(__ATOMIC_ACQUIRE, "agent");
            asm volatile("s_waitcnt vmcnt(0)" ::: "memory");
        }
    }
    __syncthreads();
}


namespace pg8 {
constexpr int BM = 256, BK = 64, HALF = 128, HTB = HALF * BK * 2, NXCD = 8;
DI int lds_byte(int r, int c) { const int st = (r >> 4) * 2 + (c >> 5), rr = r & 15, cc = c & 31, ob = rr * 64 + cc * 2; return st * 1024 + (ob ^ (((ob >> 9) & 1) << 5)); }
DI void stage_rc(int b, int& R, int& C) { const int st = b / 1024, sb = b % 1024, swz = sb ^ (((sb >> 9) & 1) << 5); R = (st >> 1) * 16 + swz / 64; C = (st & 1) * 32 + (swz % 64) / 2; }
DI int perm32(int rho) { const int n = rho >> 4, i = rho & 15; return 8 * (i >> 2) + 4 * n + (i & 3); }
struct Unit { const char* a; const char* b; int i0, i1, i2; };
DI int xcd_remap(int L, int total) { const int q = total / NXCD, r = total % NXCD, xcd = L % NXCD, off = L / NXCD; return (xcd < r ? xcd * (q + 1) : r * (q + 1) + (xcd - r) * q) + off; }

template <class Desc, class Epi>
DI void gemm_phase(LAS unsigned char* lds, const Desc& D, const Epi& E, int wv) {
    const int tid = otid(wv), wid = __builtin_amdgcn_readfirstlane(tid >> 6), lane = tid & 63, wr = wid >> 2, wc = wid & 3, fr = lane & 15, fq = lane >> 4;
    const int G = gridDim.x, c = blockIdx.x, total = D.total;
    const int K = D.K, nt = K / BK;
    unsigned voffA[2], voffB[2];
#pragma unroll
    for (int i = 0; i < 2; ++i) { int R, C; stage_rc(tid * 16 + i * 8192, R, C); const int Rb = (R & ~31) + perm32(R & 31);
        voffA[i] = (unsigned)(R * D.lda + C) * 2u; voffB[i] = (unsigned)(Rb * D.ldb + C) * 2u; }
    const size_t kstep = (size_t)(BK * 2);
    const size_t hstepA = (size_t)HALF * D.lda * 2, hstepB = (size_t)HALF * D.ldb * 2;
    const unsigned ldsw = (unsigned)wid * 1024u;
    const int aoff = lds_byte(wr * 64 + fr, fq * 8), boff = lds_byte(wc * 32 + fr, fq * 8);
#define PG8_SA(b, h) (((b) * 2 + (h)) * HTB)
#define PG8_SB(b, h) ((4 + (b) * 2 + (h)) * HTB)
#define PG8_STAGE(bufoff, gbase, voff) do { _Pragma("unroll") for (int _i = 0; _i < 2; ++_i) \
        __builtin_amdgcn_global_load_lds((const unsigned*)((const char*)(gbase) + (voff)[_i]), (LAS unsigned*)(lds + (bufoff) + ldsw + _i * 8192), 16, 0, 0); } while (0)
#define PG8_LDA(dst, b, h) do { _Pragma("unroll") for (int m = 0; m < 4; ++m) _Pragma("unroll") for (int k = 0; k < 2; ++k) dst[m][k] = *(const LAS bf16x8*)(lds + PG8_SA(b, h) + aoff + m * 2048 + k * 1024); } while (0)
#define PG8_LDB(dst, b, h) do { _Pragma("unroll") for (int n = 0; n < 2; ++n) _Pragma("unroll") for (int k = 0; k < 2; ++k) dst[n][k] = *(const LAS bf16x8*)(lds + PG8_SB(b, h) + boff + n * 2048 + k * 1024); } while (0)
#define PG8_MMA(ai, bj, At, Bt) do { __builtin_amdgcn_s_setprio(1); _Pragma("unroll") for (int m = 0; m < 4; ++m) _Pragma("unroll") for (int n = 0; n < 2; ++n) _Pragma("unroll") for (int k = 0; k < 2; ++k) \
        acc[ai][bj][m][n] = __builtin_amdgcn_mfma_f32_16x16x32_bf16(Bt[n][k], At[m][k], acc[ai][bj][m][n], 0, 0, 0); __builtin_amdgcn_s_setprio(0); } while (0)
#define PG8_WAIT_V(n) asm volatile("s_waitcnt vmcnt(" #n ")" ::: "memory")
#define PG8_WAIT_L(n) asm volatile("s_waitcnt lgkmcnt(" #n ")" ::: "memory")
#define PG8_BAR __builtin_amdgcn_s_barrier()
#define PG8_SCHED __builtin_amdgcn_sched_barrier(0)
    if (c >= total) return;
    Unit cur = D.unit(xcd_remap(c, total)), nxt = cur; int ui = 0;
    f32x4 acc[2][2][4][2];
#pragma unroll
    for (int a = 0; a < 2; ++a)
#pragma unroll
        for (int b = 0; b < 2; ++b)
#pragma unroll
            for (int m = 0; m < 4; ++m)
#pragma unroll
                for (int n = 0; n < 2; ++n) acc[a][b][m][n] = (f32x4){0.f, 0.f, 0.f, 0.f};
    bf16x8 At[4][2], B0[2][2], B1[2][2];
    const char* cA = cur.a; const char* cB = cur.b;
    PG8_STAGE(PG8_SB(0, 0), cB, voffB); PG8_STAGE(PG8_SB(0, 1), cB + hstepB, voffB); PG8_STAGE(PG8_SA(0, 0), cA, voffA); PG8_STAGE(PG8_SA(0, 1), cA + hstepA, voffA);
    if (wr == 1) PG8_BAR;
    PG8_WAIT_V(2); PG8_BAR;
    PG8_STAGE(PG8_SB(1, 0), cB + kstep, voffB); PG8_STAGE(PG8_SA(1, 0), cA + kstep, voffA); PG8_STAGE(PG8_SB(1, 1), cB + hstepB + kstep, voffB);
    PG8_WAIT_V(6); PG8_BAR;
    for (;;) {
        const long Ln = (long)(ui + 1) * G + c;
        const bool has_next = Ln < total;
        if (has_next) nxt = D.unit(xcd_remap((int)Ln, total));
        const char* nA = has_next ? nxt.a : cA; const char* nB = has_next ? nxt.b : cB;
        for (int t = 0; t < nt; t += 2) {
            const bool last = (t == nt - 2);
            const char* a1 = cA + (size_t)(t + 1) * kstep;
            const char* a2 = last ? nA : cA + (size_t)(t + 2) * kstep; const char* b2 = last ? nB : cB + (size_t)(t + 2) * kstep;
            const char* a3 = a2 + kstep; const char* b3 = b2 + kstep;
            PG8_LDB(B0, 0, 0); PG8_LDB(B1, 0, 1); PG8_SCHED; PG8_LDA(At, 0, 0); PG8_STAGE(PG8_SA(1, 1), a1 + hstepA, voffA);
            PG8_WAIT_V(8); PG8_WAIT_L(0); PG8_BAR; PG8_MMA(0, 0, At, B0); PG8_MMA(0, 1, At, B1); PG8_BAR; PG8_SCHED;
            PG8_LDA(At, 0, 1); PG8_STAGE(PG8_SB(0, 0), b2, voffB); PG8_STAGE(PG8_SB(0, 1), b2 + hstepB, voffB); PG8_STAGE(PG8_SA(0, 0), a2, voffA);
            PG8_WAIT_V(8); PG8_WAIT_L(0); PG8_BAR; PG8_MMA(1, 0, At, B0); PG8_MMA(1, 1, At, B1); PG8_BAR; PG8_SCHED;
            PG8_LDB(B0, 1, 0); PG8_LDB(B1, 1, 1); PG8_SCHED; PG8_LDA(At, 1, 0); PG8_STAGE(PG8_SA(0, 1), a2 + hstepA, voffA);
            PG8_WAIT_V(8); PG8_WAIT_L(0); PG8_BAR; PG8_MMA(0, 0, At, B0); PG8_MMA(0, 1, At, B1); PG8_BAR; PG8_SCHED;
            PG8_LDA(At, 1, 1); PG8_STAGE(PG8_SB(1, 0), b3, voffB); PG8_STAGE(PG8_SB(1, 1), b3 + hstepB, voffB); PG8_STAGE(PG8_SA(1, 0), a3, voffA);
            PG8_WAIT_V(8); PG8_WAIT_L(0); PG8_BAR; PG8_MMA(1, 0, At, B0); PG8_MMA(1, 1, At, B1); PG8_BAR; PG8_SCHED;
        }
        if (wr == 0) PG8_BAR;
        {
            const int le = otid(wv) & 63, fre = le & 15, fqe = le >> 4;
#pragma unroll
            for (int ai = 0; ai < 2; ++ai)
#pragma unroll
                for (int m = 0; m < 4; ++m)
#pragma unroll
                    for (int bj = 0; bj < 2; ++bj)
                        E(cur, ai * HALF + wr * 64 + m * 16 + fre, bj * HALF + wc * 32 + 8 * fqe, acc[ai][bj][m][0], acc[ai][bj][m][1]);
        }
        if (!has_next) break;
#pragma unroll
        for (int a = 0; a < 2; ++a)
#pragma unroll
            for (int b = 0; b < 2; ++b)
#pragma unroll
                for (int m = 0; m < 4; ++m)
#pragma unroll
                    for (int n = 0; n < 2; ++n) acc[a][b][m][n] = (f32x4){0.f, 0.f, 0.f, 0.f};
        cur = nxt; cA = nA; cB = nB; ++ui;
        if (wr == 1) PG8_BAR;
    }
    PG8_WAIT_V(0);
    PG8_BAR;
#undef PG8_SA
#undef PG8_SB
#undef PG8_STAGE
#undef PG8_LDA
#undef PG8_LDB
#undef PG8_MMA
#undef PG8_WAIT_V
#undef PG8_WAIT_L
#undef PG8_BAR
#undef PG8_SCHED
}
}

DI void transpose_item(const float* W, int N, int kb, int nb, bf16_t* d0, bf16_t* d1, int K, LAS float* scr, int lane) {
    const int k0 = 64 * kb, n0 = 32 * nb;
#pragma unroll 8
    for (int i = 0; i < 32; ++i) { const int kk = 2 * i + (lane >> 5); scr[kk * 33 + (lane & 31)] = W[(size_t)(k0 + kk) * N + n0 + (lane & 31)]; }
    asm volatile("s_waitcnt lgkmcnt(0)" ::: "memory");
    const int c = lane & 7;
#pragma unroll
    for (int j = 0; j < 4; ++j) { const int n = (lane >> 3) + 8 * j; const LAS float* s = scr + (8 * c) * 33 + n;
        u32x4 o; o.x = pk2(s[0 * 33], s[1 * 33]); o.y = pk2(s[2 * 33], s[3 * 33]); o.z = pk2(s[4 * 33], s[5 * 33]); o.w = pk2(s[6 * 33], s[7 * 33]);
        *(u32x4*)(d0 + (size_t)n * K + k0 + 8 * c) = o;
        if (d1) *(u32x4*)(d1 + (size_t)n * K + k0 + 8 * c) = o; }
    asm volatile("s_waitcnt lgkmcnt(0)" ::: "memory");
}

DI void prep_phase(const Args& A, LAS unsigned char* lds, int wv) {
    const int tid = otid(wv), lane = tid & 63, wave = tid >> 6, G = gridDim.x;
    unsigned char* ws = A.ws;
    {
        LAS float* s_lds = (LAS float*)lds;
        const float* cc = A.in[1]; const float* cctx = A.in[3]; const float* aw = A.in[4]; const float* ab = A.in[5];
        long long* modi = (long long*)(ws + WS_MODI);
        for (int item = blockIdx.x; item < 768; item += G) {
            const int kc = item % 16, cb = (item / 16) % 12, l = item / 192;
            const int k0 = kc * 128, j = cb * 512 + tid;
            __syncthreads();
            for (int e = tid; e < 17 * 128; e += NTHREADS) { const int r = e / 128, k = e % 128; const float v = r < 16 ? cc[r * DM + k0 + k] : cctx[k0 + k]; s_lds[k * 20 + r] = siluf(v); }
            __syncthreads();
            float acc[17];
#pragma unroll
            for (int r = 0; r < 17; ++r) acc[r] = 0.f;
            const float* wp = aw + ((size_t)l * DM + k0) * MOD_LD + j;
#pragma unroll 4
            for (int k = 0; k < 128; ++k) {
                const float w = wp[(size_t)k * MOD_LD];
                const LAS f32x4* sp = (const LAS f32x4*)(s_lds + k * 20);
                const f32x4 s0 = sp[0], s1 = sp[1], s2 = sp[2], s3 = sp[3]; const float s4 = s_lds[k * 20 + 16];
#pragma unroll
                for (int q = 0; q < 4; ++q) { acc[q] += s0[q] * w; acc[4 + q] += s1[q] * w; acc[8 + q] += s2[q] * w; acc[12 + q] += s3[q] * w; }
                acc[16] += s4 * w;
            }
            const float bias = (kc == 0) ? ab[l * MOD_LD + j] : 0.f;
#pragma unroll
            for (int r = 0; r < 17; ++r) atomicAdd((unsigned long long*)&modi[(size_t)(l * 17 + r) * MOD_LD + j], (unsigned long long)__float2ll_rn((acc[r] + bias) * MODI_SCALE));
        }
        __syncthreads();
    }
    {
        LAS float* scr = (LAS float*)(lds + wave * 16384);
        const int gw = blockIdx.x * NWAVES + wave, NGW = G * NWAVES;
        constexpr int I_SQ = 32 * 64, I_AI = 32 * 160, I_MI = 32 * 257;
        constexpr int NIT = 6 * I_SQ + I_AI + I_MI;
        for (int it = gw; it < NIT; it += NGW) {
            int r = it;
            if (r < 6 * I_SQ) {
                const int w = r / I_SQ; r -= w * I_SQ;
                const float* src; bf16_t* dst;
                if (w < 2)      { src = A.in[7] + (size_t)w * DM * DM;       dst = (bf16_t*)(ws + WS_WFG) + (size_t)w * DM * DM; }
                else if (w < 4) { src = A.in[8] + (size_t)(w - 2) * DM * DM; dst = (bf16_t*)(ws + WS_WFO) + (size_t)(w - 2) * DM * DM; }
                else if (w == 4) { src = A.in[12]; dst = (bf16_t*)(ws + WS_WMO); }
                else             { src = A.in[16]; dst = (bf16_t*)(ws + WS_WAO); }
                const int kb = r / 64, nb = r % 64;
                transpose_item(src, DM, kb, nb, dst + (size_t)(32 * nb) * DM, nullptr, DM, scr, lane);
                continue;
            }
            r -= 6 * I_SQ;
            if (r < I_AI) { const int kb = r / 160, nb = r % 160; transpose_item(A.in[13], 5120, kb, nb, (bf16_t*)(ws + WS_WAI) + (size_t)(32 * nb) * DM, nullptr, DM, scr, lane); continue; }
            r -= I_AI;
            {
                const int kb = r / 257, nb = r % 257, n0 = 32 * nb;
                bf16_t* WA = (bf16_t*)(ws + WS_WMA); bf16_t* WB = (bf16_t*)(ws + WS_WMB);
                bf16_t* d0; bf16_t* d1 = nullptr;
                if (n0 < 1024) d0 = WA + (size_t)n0 * DM;
                else if (n0 < 2048) { d0 = WA + (size_t)n0 * DM; d1 = WB + (size_t)(n0 - 1024) * DM; }
                else if (n0 < 4096) d0 = WB + (size_t)(1024 + n0 - 2048) * DM;
                else if (n0 < 6144) d0 = WA + (size_t)(2304 + n0 - 4096) * DM;
                else if (n0 < 6176) d0 = WA + (size_t)(2048 + n0 - 6144) * DM;
                else d0 = WA + (size_t)(4352 + n0 - 6176) * DM;
                transpose_item(A.in[9], 8224, kb, nb, d0, d1, DM, scr, lane);
            }
        }
    }
    {
        const long gt = (long)blockIdx.x * NTHREADS + tid, NGT = (long)G * NTHREADS;
        constexpr long N_DC = 1024L * 512 / 8, N_DT = 2048L * 4096 / 8, N_DT2 = 256L * 512 / 8;
        for (long it = gt; it < N_DC + N_DT + N_DT2; it += NGT) {
            float v[8]; bf16_t* dst;
            if (it < N_DC) {
                const int m = (int)(it / 64), k0 = (int)(it % 64) * 8; const float sc = 0.044194173824159216f;
#pragma unroll
                for (int j = 0; j < 8; ++j) { const int rr = ((m & 511) * (k0 + j)) & 511; const float ang = (float)rr * (1.f / 256.f); v[j] = (m < 512 ? cospif(ang) : sinpif(ang)) * sc; }
                dst = (bf16_t*)(ws + WS_DC) + (size_t)m * 512 + k0;
            } else if (it < N_DC + N_DT) {
                const long i2 = it - N_DC; const int kk = (int)(i2 / 512), s0 = (int)(i2 % 512) * 8; const float sc = 0.022097086912079608f;
#pragma unroll
                for (int j = 0; j < 8; ++j) { const int s = s0 + j; const int rr = (kk * (s & 2047)) & 2047; const float ang = (float)rr * (1.f / 1024.f); v[j] = (s < 2048 ? cospif(ang) : -sinpif(ang)) * sc; }
                dst = (bf16_t*)(ws + WS_DT) + (size_t)kk * 4096 + s0;
            } else {
                const long i2 = it - N_DC - N_DT; const int kk = (int)(i2 / 64), s0 = (int)(i2 % 64) * 8; const float sc = 0.0625f;
#pragma unroll
                for (int j = 0; j < 8; ++j) { const int s = s0 + j; const int rr = (kk * (s & 255)) & 255; const float ang = (float)rr * (1.f / 128.f); v[j] = (s < 256 ? cospif(ang) : -sinpif(ang)) * sc; }
                dst = (bf16_t*)(ws + WS_DT2) + (size_t)kk * 512 + s0;
            }
            u32x4 o = {pk2(v[0], v[1]), pk2(v[2], v[3]), pk2(v[4], v[5]), pk2(v[6], v[7])};
            *(u32x4*)dst = o;
        }
    }
}

DI const float* xrow_in(const Args& A, int r) {
    const int b = r / TB, t = r % TB;
    if (t < TL) return A.in[0] + ((size_t)b * TL + t) * DM;
    return A.in[2] + ((size_t)b * TC + (t - TL)) * DM;
}
DI void norm_phase(const Args& A, int layer, bool latonly, int wv) {
    const int tid = otid(wv), lane = tid & 63, wave = tid >> 6, G = gridDim.x;
    const float* ng = A.in[6] + (size_t)layer * DM;
    const float* mod = (const float*)(A.ws + WS_MOD) + (size_t)layer * 17 * MOD_LD;
    bf16_t* H = (bf16_t*)(A.ws + WS_H);
    const bf16_t* XB = (const bf16_t*)A.out;
    for (int r = blockIdx.x * NWAVES + wave; r < NTOK; r += G * NWAVES) {
        const int b = r / TB, t = r % TB;
        if (latonly && t >= TL) continue;
        const float* mr = mod + (size_t)(t < TL ? b : 16) * MOD_LD;
        f32x4 v[4][2]; float ss = 0.f;
        if (layer == 0) {
            const float* xr = xrow_in(A, r);
#pragma unroll
            for (int j = 0; j < 4; ++j) { const f32x4* p = (const f32x4*)(xr + 512 * j + 8 * lane); v[j][0] = p[0]; v[j][1] = p[1]; }
        } else {
#pragma unroll
            for (int j = 0; j < 4; ++j) ld_bf16x8(XB + (size_t)r * DM + 512 * j + 8 * lane, v[j][0], v[j][1]);
        }
#pragma unroll
        for (int j = 0; j < 4; ++j)
#pragma unroll
            for (int q = 0; q < 4; ++q) ss += v[j][0][q] * v[j][0][q] + v[j][1][q] * v[j][1][q];
        const float rs = 1.0f / sqrtf(wave_sum(ss) * (1.f / DM) + EPS);
#pragma unroll
        for (int j = 0; j < 4; ++j) { const int c0 = 512 * j + 8 * lane; f32x4 o[2];
#pragma unroll
            for (int h = 0; h < 2; ++h) { const f32x4 g4 = *(const f32x4*)(ng + c0 + 4 * h), sh = *(const f32x4*)(mr + c0 + 4 * h), sc = *(const f32x4*)(mr + DM + c0 + 4 * h);
                o[h] = (v[j][h] * rs) * g4 * (sc + 1.0f) + sh; }
            st_bf16x8(H + (size_t)r * DM + c0, o[0], o[1]); }
    }
}
DI void final_norm_phase(const Args& A, const float* src_override, int wv) {
    const int tid = otid(wv), lane = tid & 63, wave = tid >> 6, G = gridDim.x;
    const float* fg = A.in[17];
    for (int r = blockIdx.x * NWAVES + wave; r < NB * TL; r += G * NWAVES) {
        const float* xr = (src_override ? src_override : (const float*)A.out) + (size_t)r * DM; float* orow = A.out + (size_t)r * DM;
        f32x4 v[4][2]; float ss = 0.f;
#pragma unroll
        for (int j = 0; j < 4; ++j) { const f32x4* p = (const f32x4*)(xr + 512 * j + 8 * lane); v[j][0] = p[0]; v[j][1] = p[1];
#pragma unroll
            for (int q = 0; q < 4; ++q) ss += v[j][0][q] * v[j][0][q] + v[j][1][q] * v[j][1][q]; }
        const float rs = 1.0f / sqrtf(wave_sum(ss) * (1.f / DM) + EPS);
#pragma unroll
        for (int j = 0; j < 4; ++j) { const int c0 = 512 * j + 8 * lane;
#pragma unroll
            for (int h = 0; h < 2; ++h) { const f32x4 g4 = *(const f32x4*)(fg + c0 + 4 * h); *(f32x4*)(orow + c0 + 4 * h) = (v[j][h] * rs) * g4; } }
    }
}


struct DescPlain {
    const bf16_t* A; const bf16_t* B; int nN; bool latonly; int lda, ldb, K, total;
    DI void init(const bf16_t* A_, const bf16_t* B_, int nN_, bool lat) { A = A_; B = B_; nN = nN_; latonly = lat; lda = DM; ldb = DM; K = DM; total = (lat ? 128 : 144) * nN_; }
    DI pg8::Unit unit(int idx) const {
        const int nMt = latonly ? 128 : 144, nig = 8 * nN, gid = idx / nig, fm = gid * 8, gsz = (nMt - fm) < 8 ? (nMt - fm) : 8;
        const int pmi = fm + (idx % nig) % gsz, pn = (idx % nig) / gsz, pm = latonly ? (pmi / 8) * 9 + (pmi % 8) : pmi;
        pg8::Unit u; u.a = (const char*)(A + (size_t)pm * 256 * DM); u.b = (const char*)(B + (size_t)pn * 256 * DM); u.i0 = pm; u.i1 = pn; u.i2 = 0; return u;
    }
};
struct DescChan {
    const bf16_t* DC; const bf16_t* H; int lda, ldb, K, total;
    DI void init(const bf16_t* DC_, const bf16_t* H_, bool lat) { DC = DC_; H = H_; lda = 512; ldb = DM; K = 512; total = lat ? 2048 : 2304; }
    DI pg8::Unit unit(int idx) const {
        pg8::Unit u; int b, g, mt, nt, toff;
        if (idx < 2048) { mt = idx % 4; nt = (idx / 4) % 8; g = (idx / 32) % 4; b = idx / 128; toff = nt * 256; u.i2 = nt; }
        else { const int j = idx - 2048; mt = j % 4; g = (j / 4) % 4; b = j / 16; toff = TL; u.i2 = 8; }
        u.a = (const char*)(DC + (size_t)mt * 256 * 512); u.b = (const char*)(H + ((size_t)b * TB + toff) * DM + g * 512); u.i0 = b * 4 + g; u.i1 = mt; return u;
    }
};
struct DescT {
    const bf16_t* DT; const bf16_t* PQ; int nMt; int lda, ldb, K, total;
    DI void init(const bf16_t* DT_, const bf16_t* PQ_, int ld, int Kd, int coff, int nMt_) { DT = DT_ + coff; PQ = PQ_ + coff; nMt = nMt_; lda = ld; ldb = ld; K = Kd; total = NB * nMt_ * 8; }
    DI pg8::Unit unit(int idx) const {
        const int mt = idx % nMt, nt = (idx / nMt) % 8, b = idx / (nMt * 8);
        pg8::Unit u; u.a = (const char*)(DT + (size_t)mt * 256 * lda); u.b = (const char*)(PQ + ((size_t)b * DM + nt * 256) * ldb); u.i0 = b; u.i1 = mt; u.i2 = nt; return u;
    }
};

DI void resid_store(const Args& A, int layer, int pm, int row_l, int col, const float* modl, f32x4 v0, f32x4 v1) {
    const int b = pm / 9, tt = pm % 9;
    const float* gp = modl + (size_t)(tt < 8 ? b : 16) * MOD_LD + 2 * DM + col;
    const f32x4 g0 = *(const f32x4*)gp, g1 = *(const f32x4*)(gp + 4);
    bf16_t* XB = (bf16_t*)A.out;
    const size_t roff = ((size_t)pm * 256 + row_l) * DM + col;
    f32x4 x0, x1;
    if (layer == 0) {
        const float* src = (tt < 8) ? A.in[0] + ((size_t)b * TL + tt * 256 + row_l) * DM + col : A.in[2] + ((size_t)b * TC + row_l) * DM + col;
        x0 = *(const f32x4*)src; x1 = *(const f32x4*)(src + 4);
    } else ld_bf16x8(XB + roff, x0, x1);
    x0 = x0 + g0 * v0; x1 = x1 + g1 * v1;
    if (layer == 3) { float* dst = (float*)(A.ws + WS_SCR + F_PQX) + ((size_t)b * TL + tt * 256 + row_l) * DM + col; *(f32x4*)dst = x0; *(f32x4*)(dst + 4) = x1; }
    else st_bf16x8(XB + roff, x0, x1);
}

DI void fnet_layer(const Args& A, LAS unsigned char* lds, const XcdBarrier& gbar, int layer, int j, bool latonly, int wv) {
    unsigned char* ws = A.ws;
    const bf16_t* H = (const bf16_t*)(ws + WS_H); bf16_t* U = (bf16_t*)(ws + WS_H);
    bf16_t* Gt = (bf16_t*)(ws + WS_SCR + F_G); bf16_t* PQX = (bf16_t*)(ws + WS_SCR + F_PQX); bf16_t* PQC = (bf16_t*)(ws + WS_SCR + F_PQC);
    norm_phase(A, layer, latonly, wv);
    xcd_barrier(gbar, wv);
    {
        DescPlain D; D.init(H, (const bf16_t*)(ws + WS_WFG) + (size_t)j * DM * DM, 8, latonly);
        auto E = [=](const pg8::Unit& u, int row_l, int col_l, f32x4 v0, f32x4 v1) {
            f32x4 a, b;
#pragma unroll
            for (int q = 0; q < 4; ++q) { a[q] = siluf(v0[q]); b[q] = siluf(v1[q]); }
            st_bf16x8(Gt + ((size_t)u.i0 * 256 + row_l) * DM + u.i1 * 256 + col_l, a, b);
        };
        pg8::gemm_phase(lds, D, E, wv);
    }
    {
        DescChan D; D.init((const bf16_t*)(ws + WS_DC), H, latonly);
        auto E = [=](const pg8::Unit& u, int row_l, int col_l, f32x4 v0, f32x4 v1) {
            const int b = u.i0 >> 2, g = u.i0 & 3, mt = u.i1, half = mt >> 1, ch = g * 512 + (mt & 1) * 256 + row_l;
            bf16_t* dst = (u.i2 < 8) ? PQX + ((size_t)b * DM + ch) * 4096 + half * 2048 + u.i2 * 256 + col_l
                                     : PQC + ((size_t)b * DM + ch) * 512 + half * 256 + col_l;
            st_bf16x8(dst, v0, v1);
        };
        pg8::gemm_phase(lds, D, E, wv);
    }
    xcd_barrier(gbar, wv);
    bf16_t* A1 = (bf16_t*)(ws + WS_SCR + F_A1); float* NYQ = (float*)(ws + WS_SCR + F_NYQ);
    {
        const int tid = otid(wv), lane = tid & 63;
        for (int rr = blockIdx.x * NWAVES + wv; rr < NB * DM; rr += gridDim.x * NWAVES) {
            const bf16_t* pr = PQX + (size_t)rr * 4096; float acc = 0.f;
#pragma unroll
            for (int q = 0; q < 4; ++q) { f32x4 a, b; ld_bf16x8(pr + (q * 64 + lane) * 8, a, b); acc += (a[0] - a[1]) + (a[2] - a[3]) + (b[0] - b[1]) + (b[2] - b[3]); }
            acc = wave_sum(acc);
            if (lane == 0) NYQ[rr] = acc * 0.022097086912079608f;
        }
    }
    {
        DescT D; D.init((const bf16_t*)(ws + WS_DT), PQX, 4096, 2048, 0, 4);
        auto E = [=](const pg8::Unit& u, int row_l, int col_l, f32x4 v0, f32x4 v1) {
            st_bf16x8(A1 + ((size_t)u.i0 * 1024 + u.i1 * 256 + row_l) * DM + u.i2 * 256 + col_l, v0, v1);
        };
        pg8::gemm_phase(lds, D, E, wv);
    }
    xcd_barrier(gbar, wv);
    {
        DescT D; D.init((const bf16_t*)(ws + WS_DT), PQX, 4096, 2048, 2048, 4);
        auto E = [=](const pg8::Unit& u, int row_l, int col_l, f32x4 v0, f32x4 v1) {
            const int k = u.i1 * 256 + row_l, col = u.i2 * 256 + col_l;
            f32x4 a0, a1; ld_bf16x8(A1 + ((size_t)u.i0 * 1024 + k) * DM + col, a0, a1);
            const size_t off = ((size_t)u.i0 * TB + k) * DM + col;
            f32x4 g0, g1; ld_bf16x8(Gt + off, g0, g1);
            st_bf16x8(U + off, (a0 + v0) * g0, (a1 + v1) * g1);
            const size_t off2 = ((size_t)u.i0 * TB + (k == 0 ? 1024 : TL - k)) * DM + col;
            ld_bf16x8(Gt + off2, g0, g1);
            if (k == 0) { const float* nq = NYQ + (size_t)u.i0 * DM + col; a0 = *(const f32x4*)nq; a1 = *(const f32x4*)(nq + 4); v0 = (f32x4){0.f, 0.f, 0.f, 0.f}; v1 = v0; }
            st_bf16x8(U + off2, (a0 - v0) * g0, (a1 - v1) * g1);
        };
        pg8::gemm_phase(lds, D, E, wv);
    }
    if (!latonly) {
        DescT D; D.init((const bf16_t*)(ws + WS_DT2), PQC, 512, 512, 0, 1);
        auto E = [=](const pg8::Unit& u, int row_l, int col_l, f32x4 v0, f32x4 v1) {
            const size_t off = ((size_t)u.i0 * TB + TL + row_l) * DM + u.i2 * 256 + col_l;
            f32x4 g0, g1; ld_bf16x8(Gt + off, g0, g1);
            st_bf16x8(U + off, v0 * g0, v1 * g1);
        };
        pg8::gemm_phase(lds, D, E, wv);
    }
    xcd_barrier(gbar, wv);
    {
        DescPlain D; D.init(U, (const bf16_t*)(ws + WS_WFO) + (size_t)j * DM * DM, 8, latonly);
        const float* modl = (const float*)(ws + WS_MOD) + (size_t)layer * 17 * MOD_LD;
        auto E = [=](const pg8::Unit& u, int row_l, int col_l, f32x4 v0, f32x4 v1) { resid_store(A, layer, u.i0, row_l, u.i1 * 256 + col_l, modl, v0, v1); };
        pg8::gemm_phase(lds, D, E, wv);
    }
    xcd_barrier(gbar, wv);
}


namespace att {
constexpr int D = 128, NW = 8, QBLK = 32, KVBLK = 64;
constexpr float SCALE = 0.088388347648318440f;
constexpr float THR = 8.f;
constexpr int LDQ = 2048, LDK = 512;
constexpr size_t SHM_V = KVBLK * D * 2, SHM_K = KVBLK * D * 2;
typedef float f32x8 __attribute__((ext_vector_type(8)));
#define KSWZ(row, colB) ((row) * 256 + ((colB) ^ (((row) & 7) << 4)))
#define SBAR() __builtin_amdgcn_sched_barrier(0)
DI int crow(int r, int hi) { return (r & 3) + 8 * (r >> 2) + 4 * hi; }
DI unsigned cvtpk(float lo, float hi) { unsigned r; asm volatile("v_cvt_pk_bf16_f32 %0, %1, %2" : "=v"(r) : "v"(lo), "v"(hi)); return r; }
DI void partialSM(f32x16& p0, f32x16& p1, float& m_reg, float& mn, float& alpha) {
  constexpr float C = SCALE * 1.4426950408889634f;
  float pmax = p0[0];
#pragma unroll
  for (int r = 1; r < 16; ++r) pmax = fmaxf(pmax, p0[r]);
#pragma unroll
  for (int r = 0; r < 16; ++r) pmax = fmaxf(pmax, p1[r]);
  { auto rr = __builtin_amdgcn_permlane32_swap(__float_as_uint(pmax), __float_as_uint(pmax), false, false);
    pmax = fmaxf(__uint_as_float(rr[0]), __uint_as_float(rr[1])); }
  if (__builtin_expect(__all(pmax - m_reg <= THR / SCALE), 1)) { mn = m_reg; alpha = 1.f; }
  else { mn = fmaxf(m_reg, pmax); alpha = __builtin_amdgcn_exp2f((m_reg - mn) * C); m_reg = mn; }
  float mnC = -mn * C;
#pragma unroll
  for (int r = 0; r < 16; ++r) p0[r] = fmaf(p0[r], C, mnC);
#pragma unroll
  for (int r = 0; r < 16; ++r) p1[r] = fmaf(p1[r], C, mnC);
#pragma unroll
  for (int r = 0; r < 16; ++r) p0[r] = __builtin_amdgcn_exp2f(p0[r]);
}
DI void finishSM(f32x16& p0, f32x16& p1, float alpha, float& l_reg, bf16x8& pa0, bf16x8& pa1, bf16x8& pa2, bf16x8& pa3) {
#pragma unroll
  for (int r = 0; r < 16; ++r) p1[r] = __builtin_amdgcn_exp2f(p1[r]);
  float ps = 0;
#pragma unroll
  for (int r = 0; r < 16; ++r) ps += p0[r];
#pragma unroll
  for (int r = 0; r < 16; ++r) ps += p1[r];
  { auto rr = __builtin_amdgcn_permlane32_swap(__float_as_uint(ps), __float_as_uint(ps), false, false);
    ps = __uint_as_float(rr[0]) + __uint_as_float(rr[1]); }
  l_reg = l_reg * alpha + ps;
#define PK4(P, BASE, OUT) do { unsigned a0 = cvtpk(P[BASE + 0], P[BASE + 1]), a1 = cvtpk(P[BASE + 2], P[BASE + 3]);   \
    unsigned b0 = cvtpk(P[BASE + 4], P[BASE + 5]), b1 = cvtpk(P[BASE + 6], P[BASE + 7]);                              \
    auto r0 = __builtin_amdgcn_permlane32_swap(a0, b0, false, false); auto r1 = __builtin_amdgcn_permlane32_swap(a1, b1, false, false); \
    u32x4 w = {r0[0], r1[0], r0[1], r1[1]}; OUT = *reinterpret_cast<bf16x8*>(&w); } while (0)
  PK4(p0, 0, pa0); PK4(p0, 8, pa1); PK4(p1, 0, pa2); PK4(p1, 8, pa3);
#undef PK4
}
DI void qkt(f32x16& p0, f32x16& p1, const bf16_t* Ks, const bf16x8* qr, int r32, int hi) {
  p0 = f32x16{}; p1 = f32x16{};
#pragma unroll
  for (int d0 = 0; d0 < 8; ++d0) { int cb = (d0 * 16 + hi * 8) * 2;
    bf16x8 b0 = *reinterpret_cast<const bf16x8*>((const char*)Ks + KSWZ(r32, cb));
    bf16x8 b1 = *reinterpret_cast<const bf16x8*>((const char*)Ks + KSWZ(32 + r32, cb));
    p0 = __builtin_amdgcn_mfma_f32_32x32x16_bf16(b0, qr[d0], p0, 0, 0, 0);
    p1 = __builtin_amdgcn_mfma_f32_32x32x16_bf16(b1, qr[d0], p1, 0, 0, 0); }
}
DI int v_st(int k, int c) { const int kk = (k & ~0xC) | ((k & 4) << 1) | ((k & 8) >> 1); return ((kk >> 3) * 4 + (c >> 5)) * 512 + ((kk & 7) * 32 + (c & 31)) * 2; }
DI int v_rd_base(int lane) { return ((lane & 3) << 3) | (((lane >> 2) & 3) << 6) | (((lane >> 4) & 1) << 5) | (((lane >> 5) & 1) << 8); }
constexpr int v_rd_off(int d0, int ks, int half) { return d0 * 512 + ks * 4096 + half * 2048; }
template <int OFF> DI s16x4 tr_read(int vb) {
  s16x4 r; asm volatile("ds_read_b64_tr_b16 %0, %1 offset:%2" : "=&v"(r) : "v"(vb), "i"(OFF) : "memory"); return r;
}
template <int D0> DI void pv_one(f32x16& od, int vb, bf16x8 pa0, bf16x8 pa1, bf16x8 pa2, bf16x8 pa3) {
  const s16x4 l0 = tr_read<v_rd_off(D0, 0, 0)>(vb), h0 = tr_read<v_rd_off(D0, 0, 1)>(vb), l1 = tr_read<v_rd_off(D0, 1, 0)>(vb), h1 = tr_read<v_rd_off(D0, 1, 1)>(vb);
  const s16x4 l2 = tr_read<v_rd_off(D0, 2, 0)>(vb), h2 = tr_read<v_rd_off(D0, 2, 1)>(vb), l3 = tr_read<v_rd_off(D0, 3, 0)>(vb), h3 = tr_read<v_rd_off(D0, 3, 1)>(vb);
  asm volatile("s_waitcnt lgkmcnt(0)" ::: "memory"); SBAR();
#define PK(L, H) (bf16x8){L[0], L[1], L[2], L[3], H[0], H[1], H[2], H[3]}
  od = __builtin_amdgcn_mfma_f32_32x32x16_bf16(pa0, PK(l0, h0), od, 0, 0, 0);
  od = __builtin_amdgcn_mfma_f32_32x32x16_bf16(pa1, PK(l1, h1), od, 0, 0, 0);
  od = __builtin_amdgcn_mfma_f32_32x32x16_bf16(pa2, PK(l2, h2), od, 0, 0, 0);
  od = __builtin_amdgcn_mfma_f32_32x32x16_bf16(pa3, PK(l3, h3), od, 0, 0, 0);
#undef PK
}
DI void pv_d0(f32x16* o, int vb, bf16x8 pa0, bf16x8 pa1, bf16x8 pa2, bf16x8 pa3) {
  pv_one<0>(o[0], vb, pa0, pa1, pa2, pa3); pv_one<1>(o[1], vb, pa0, pa1, pa2, pa3); pv_one<2>(o[2], vb, pa0, pa1, pa2, pa3); pv_one<3>(o[3], vb, pa0, pa1, pa2, pa3);
}
DI void attn_dense_body(const bf16_t* __restrict__ Qb, const bf16_t* __restrict__ Kh, const bf16_t* __restrict__ Vh, const bf16_t* SZb, bf16_t* Ub, int seq, char* lds, int wv) {
  const int tid = otid(wv), wid = tid >> 6, lane = tid & 63, r32 = lane & 31, hi = lane >> 5;
  bf16_t* V_lds = (bf16_t*)lds; bf16_t* K_lds = (bf16_t*)(lds + 2 * SHM_V);
  float* wsf = (float*)(lds + 2 * SHM_V + 2 * SHM_K) + wid * 64; float* li_l = wsf; float* al_l = wsf + 32;
  float m_reg = -1e30f, l_reg = 0; f32x16 o[4] = {}; bf16x8 qr[8];
  const bf16_t* Qw = Qb + (long)(wid * QBLK + r32) * LDQ + hi * 8;
#pragma unroll
  for (int d0 = 0; d0 < 8; ++d0) qr[d0] = *reinterpret_cast<const bf16x8*>(Qw + d0 * 16);
  const int sr = tid >> 4, sc = (tid & 15) * 8, vst0 = v_st(sr, sc), vst1 = v_st(32 + sr, sc);
  const int vb0 = (int)(uintptr_t)V_lds + v_rd_base(lane);
  struct { bf16x8 vs0, vs1, ks0, ks1; } sr_[2];
#define SLOAD(i, k0) do { sr_[i].vs0 = *reinterpret_cast<const bf16x8*>(&Vh[(long)((k0) + sr) * LDK + sc]); sr_[i].vs1 = *reinterpret_cast<const bf16x8*>(&Vh[(long)((k0) + 32 + sr) * LDK + sc]); \
    sr_[i].ks0 = *reinterpret_cast<const bf16x8*>(&Kh[(long)((k0) + sr) * LDK + sc]); sr_[i].ks1 = *reinterpret_cast<const bf16x8*>(&Kh[(long)((k0) + 32 + sr) * LDK + sc]); } while (0)
#define SWRITE(b, i) do { *(bf16x8*)((char*)V_lds + (b) * SHM_V + vst0) = sr_[i].vs0;          \
    *(bf16x8*)((char*)V_lds + (b) * SHM_V + vst1) = sr_[i].vs1; int kc = sc * 2;               \
    *(bf16x8*)((char*)K_lds + (b) * SHM_K + KSWZ(sr, kc)) = sr_[i].ks0;                       \
    *(bf16x8*)((char*)K_lds + (b) * SHM_K + KSWZ(32 + sr, kc)) = sr_[i].ks1; } while (0)
#define SWAIT() asm volatile("s_waitcnt vmcnt(4)" ::: "memory")
#define RESC(a) do { if (__any((a) < 1.f)) { if (hi == 0) al_l[r32] = (a); asm volatile("s_waitcnt lgkmcnt(0)" ::: "memory"); \
    _Pragma("unroll") for (int d = 0; d < 4; ++d) _Pragma("unroll") for (int r = 0; r < 16; ++r) o[d][r] *= al_l[crow(r, hi)]; } } while (0)
  f32x16 pA0, pA1, pB0, pB1; float mnA, mnB, alA, alB; bf16x8 pa0, pa1, pa2, pa3; const int NT = seq / KVBLK;
  constexpr int SE = 0, SO = 1;
  SLOAD(SE, 0); asm volatile("s_waitcnt vmcnt(0)" ::: "memory"); SWRITE(0, SE); __syncthreads();
  qkt(pA0, pA1, K_lds, qr, r32, hi); partialSM(pA0, pA1, m_reg, mnA, alA);
  SLOAD(SO, KVBLK); if (2 < NT) SLOAD(SE, 2 * KVBLK);
  SWAIT(); SWRITE(1, SO); __syncthreads();
  for (int j = 1; j + 1 < NT; j += 2) {
    SBAR(); qkt(pB0, pB1, (bf16_t*)((char*)K_lds + SHM_K), qr, r32, hi);
    finishSM(pA0, pA1, alA, l_reg, pa0, pa1, pa2, pa3); SBAR();
    SLOAD(SO, (j + 2) * KVBLK); SBAR();
    pv_d0(o, vb0, pa0, pa1, pa2, pa3); partialSM(pB0, pB1, m_reg, mnB, alB);
    __syncthreads(); SWAIT(); SWRITE(0, SE);
    RESC(alB); __syncthreads();
    SBAR(); qkt(pA0, pA1, K_lds, qr, r32, hi);
    finishSM(pB0, pB1, alB, l_reg, pa0, pa1, pa2, pa3); SBAR();
    if (j + 3 < NT) SLOAD(SE, (j + 3) * KVBLK); SBAR();
    pv_d0(o, vb0 + (int)SHM_V, pa0, pa1, pa2, pa3); partialSM(pA0, pA1, m_reg, mnA, alA);
    __syncthreads(); SWAIT(); SWRITE(1, SO);
    RESC(alA); __syncthreads();
  }
  SBAR(); qkt(pB0, pB1, (bf16_t*)((char*)K_lds + SHM_K), qr, r32, hi);
  finishSM(pA0, pA1, alA, l_reg, pa0, pa1, pa2, pa3); SBAR();
  pv_d0(o, vb0, pa0, pa1, pa2, pa3); partialSM(pB0, pB1, m_reg, mnB, alB);
  __syncthreads(); RESC(alB);
  finishSM(pB0, pB1, alB, l_reg, pa0, pa1, pa2, pa3); SBAR();
  pv_d0(o, vb0 + (int)SHM_V, pa0, pa1, pa2, pa3);
  u32x4 zq[8];
#pragma unroll
  for (int i = 0; i < 8; ++i) { const int id = tid + 512 * i; zq[i] = *(const u32x4*)(SZb + (long)(id >> 4) * LDQ + (id & 15) * 8); }
  if (hi == 0) li_l[r32] = l_reg; asm volatile("s_waitcnt lgkmcnt(0)" ::: "memory");
  __syncthreads();
  {
    float rli[16];
#pragma unroll
    for (int r = 0; r < 16; ++r) rli[r] = __builtin_amdgcn_rcpf(li_l[crow(r, hi)]);
    char* ost = lds;
#pragma unroll
    for (int r = 0; r < 16; ++r) { char* rowp = ost + (wid * QBLK + crow(r, hi)) * 256 + r32 * 2;
#pragma unroll
      for (int d0 = 0; d0 < 4; ++d0) *(unsigned short*)(rowp + d0 * 64) = (unsigned short)(pk2(o[d0][r] * rli[r], 0.f) & 0xffffu); }
  }
  __syncthreads();
#pragma unroll
  for (int i = 0; i < 8; ++i) { const int id = tid + 512 * i; const int row = id >> 4, ch = id & 15;
    const u32x4 ov = *(const u32x4*)(lds + row * 256 + ch * 16);
    f32x4 a0 = {bf_lo(ov.x), bf_hi(ov.x), bf_lo(ov.y), bf_hi(ov.y)}, a1 = {bf_lo(ov.z), bf_hi(ov.z), bf_lo(ov.w), bf_hi(ov.w)};
    const f32x4 z0 = {bf_lo(zq[i].x), bf_hi(zq[i].x), bf_lo(zq[i].y), bf_hi(zq[i].y)}, z1 = {bf_lo(zq[i].z), bf_hi(zq[i].z), bf_lo(zq[i].w), bf_hi(zq[i].w)};
    st_bf16x8(Ub + (long)row * LDQ + ch * 8, a0 * z0, a1 * z1); }
  __syncthreads();
#undef SLOAD
#undef SWRITE
#undef SWAIT
#undef RESC
}
#undef KSWZ
#undef SBAR
}

DI void qknorm_phase(const Args& A, int wv) {
    const int tid = otid(wv), lane = tid & 63, wave = tid >> 6, G = gridDim.x;
    bf16_t* Q = (bf16_t*)(A.ws + WS_SCR + A_Q); bf16_t* Kb = (bf16_t*)(A.ws + WS_SCR + A_K);
    const float* qn = A.in[14]; const float* kn = A.in[15];
    const int sub = lane >> 4, l16 = lane & 15, e0 = l16 * 8;
    const long NIT = (long)NTOK * 20;
    for (long it = ((long)blockIdx.x * NWAVES + wave) * 4 + sub; it < NIT; it += (long)G * NWAVES * 4) {
        const int row = (int)(it / 20), hj = (int)(it % 20);
        bf16_t* p = (hj < 16) ? Q + (size_t)row * 2048 + hj * 128 + e0 : Kb + (size_t)row * 512 + (hj - 16) * 128 + e0;
        const float* wn = (hj < 16 ? qn : kn) + e0;
        f32x4 a, b; ld_bf16x8(p, a, b);
        float ss = 0.f;
#pragma unroll
        for (int q = 0; q < 4; ++q) ss += a[q] * a[q] + b[q] * b[q];
        ss += __shfl_xor(ss, 1); ss += __shfl_xor(ss, 2); ss += __shfl_xor(ss, 4); ss += __shfl_xor(ss, 8);
        const float rs = 1.0f / sqrtf(ss * (1.f / 128.f) + EPS);
        const f32x4 w0 = *(const f32x4*)wn, w1 = *(const f32x4*)(wn + 4);
        a = a * rs * w0; b = b * rs * w1;
        const int t = row % TB;
        if (t < TL) {
            const float pos = (l16 < 8) ? (float)(t >> 6) : (float)(t & 63);
            float y[8] = {a[0], a[1], a[2], a[3], b[0], b[1], b[2], b[3]};
#pragma unroll
            for (int pp = 0; pp < 4; ++pp) {
                const int fi = (4 * l16 + pp) & 31;
                const float ang = pos * exp2f(-(float)fi * 0.41524101186092029f);
                const float cs = cosf(ang), sn = sinf(ang);
                const float x0 = y[2 * pp], x1 = y[2 * pp + 1];
                y[2 * pp] = x0 * cs - x1 * sn; y[2 * pp + 1] = x0 * sn + x1 * cs;
            }
            a = (f32x4){y[0], y[1], y[2], y[3]}; b = (f32x4){y[4], y[5], y[6], y[7]};
        }
        st_bf16x8(p, a, b);
    }
}

DI void attn_layer(const Args& A, LAS unsigned char* lds, char* lds_gen, const XcdBarrier& gbar, int layer, int wv) {
    unsigned char* ws = A.ws;
    const bf16_t* H = (const bf16_t*)(ws + WS_H); bf16_t* U = (bf16_t*)(ws + WS_H);
    bf16_t* Q = (bf16_t*)(ws + WS_SCR + A_Q); bf16_t* Kb = (bf16_t*)(ws + WS_SCR + A_K); bf16_t* Vb = (bf16_t*)(ws + WS_SCR + A_V); bf16_t* SZ = (bf16_t*)(ws + WS_SCR + A_SZ);
    norm_phase(A, layer, false, wv);
    xcd_barrier(gbar, wv);
    {
        DescPlain D; D.init(H, (const bf16_t*)(ws + WS_WAI), 20, false);
        auto E = [=](const pg8::Unit& u, int row_l, int col_l, f32x4 v0, f32x4 v1) {
            const size_t row = (size_t)u.i0 * 256 + row_l; const int pn = u.i1;
            if (pn < 8) st_bf16x8(Q + row * 2048 + pn * 256 + col_l, v0, v1);
            else if (pn < 10) st_bf16x8(Kb + row * 512 + (pn - 8) * 256 + col_l, v0, v1);
            else if (pn < 12) st_bf16x8(Vb + row * 512 + (pn - 10) * 256 + col_l, v0, v1);
            else { f32x4 a, b;
#pragma unroll
                for (int q = 0; q < 4; ++q) { a[q] = siluf(v0[q]); b[q] = siluf(v1[q]); }
                st_bf16x8(SZ + row * 2048 + (pn - 12) * 256 + col_l, a, b); }
        };
        pg8::gemm_phase(lds, D, E, wv);
    }
    xcd_barrier(gbar, wv);
    qknorm_phase(A, wv);
    xcd_barrier(gbar, wv);
    {
        const int G = gridDim.x, c = blockIdx.x;
        for (long L = c; L < 2048; L += G) {
            const int u = pg8::xcd_remap((int)L, 2048);
            const int b = u / 128, rem = u % 128, kvh = rem / 32, g = (rem / 8) % 4, qb = rem % 8, h = kvh * 4 + g;
            const size_t qoff = ((size_t)b * TB + qb * 256) * 2048 + h * 128, koff = ((size_t)b * TB) * 512 + kvh * 128;
            att::attn_dense_body(Q + qoff, Kb + koff, Vb + koff, SZ + qoff, U + qoff, TB, lds_gen, wv);
        }
        for (int u = c; u < 256; u += G) {
            const int b = u / 16, h = u % 16, kvh = h / 4;
            const size_t qoff = ((size_t)b * TB + TL) * 2048 + h * 128, koff = ((size_t)b * TB + TL) * 512 + kvh * 128;
            att::attn_dense_body(Q + qoff, Kb + koff, Vb + koff, SZ + qoff, U + qoff, TC, lds_gen, wv);
        }
    }
    xcd_barrier(gbar, wv);
    {
        DescPlain D; D.init(U, (const bf16_t*)(ws + WS_WAO), 8, false);
        const float* modl = (const float*)(ws + WS_MOD) + (size_t)layer * 17 * MOD_LD;
        auto E = [=](const pg8::Unit& u, int row_l, int col_l, f32x4 v0, f32x4 v1) { resid_store(A, layer, u.i0, row_l, u.i1 * 256 + col_l, modl, v0, v1); };
        pg8::gemm_phase(lds, D, E, wv);
    }
    xcd_barrier(gbar, wv);
}


struct DescM1 {
    const bf16_t* H; const bf16_t* WA; const bf16_t* WB; int lda, ldb, K, total;
    DI void init(const bf16_t* H_, const bf16_t* WA_, const bf16_t* WB_) { H = H_; WA = WA_; WB = WB_; lda = DM; ldb = DM; K = DM; total = 144 * 9 + 12 * 144; }
    DI pg8::Unit unit(int idx) const {
        pg8::Unit u;
        if (idx < 1296) { const int nig = 72, gid = idx / nig, pm = gid * 8 + (idx % nig) % 8, pn = (idx % nig) / 8;
            u.a = (const char*)(H + (size_t)pm * 256 * DM); u.b = (const char*)(WA + (size_t)pn * 256 * DM); u.i0 = pm; u.i1 = pn; u.i2 = 0; }
        else { const int j = idx - 1296, mt = j % 12, nt = j / 12;
            u.a = (const char*)(WB + (size_t)mt * 256 * DM); u.b = (const char*)(H + (size_t)nt * 256 * DM); u.i0 = mt; u.i1 = nt; u.i2 = 1; }
        return u;
    }
};
namespace ml {
#define MFMA32(a, b, c) __builtin_amdgcn_mfma_f32_32x32x16_bf16((a), (b), (c), 0, 0, 0)
#define LFENCE() asm volatile("s_waitcnt lgkmcnt(0)" ::: "memory")
DI int crow(int reg, int h) { return (reg & 3) + 8 * (reg >> 2) + 4 * h; }
DI bf16x8 ldperm(const bf16_t* p) { const s16x4 lo = *(const s16x4*)p, hi = *(const s16x4*)(p + 8); return __builtin_shufflevector(lo, hi, 0, 1, 2, 3, 4, 5, 6, 7); }
DI bf16x8 pack_step(const f32x16& x, int s) { u32x4 p = {pk2(x[8 * s], x[8 * s + 1]), pk2(x[8 * s + 2], x[8 * s + 3]), pk2(x[8 * s + 4], x[8 * s + 5]), pk2(x[8 * s + 6], x[8 * s + 7])}; return __builtin_bit_cast(bf16x8, p); }
DI float bfs(short h) { return __uint_as_float(((unsigned)(unsigned short)h) << 16); }

constexpr int SC_Q = 0, SC_K = 16384, SC_KT = 32768, SC_BUF = 49152, SC_WAVE = 2 * SC_BUF, SC_WAVE_BYTES = 6144;
DI bf16x8 ldsfrag(const LAS unsigned char* buf, unsigned o) { const s16x4 lo = *(const LAS s16x4*)(buf + o), hi = *(const LAS s16x4*)(buf + (o ^ 16u)); return __builtin_shufflevector(lo, hi, 0, 1, 2, 3, 4, 5, 6, 7); }
DI void scan_phase(const Args& A, LAS unsigned char* lds, int wv) {
    const int wave = wv;
    LAS float* wl = (LAS float*)(lds + SC_WAVE + wave * SC_WAVE_BYTES);
    LAS unsigned char* hst = lds + SC_WAVE + wave * SC_WAVE_BYTES + 2048;
    unsigned char* ws = A.ws;
    const bf16_t* Qg = (const bf16_t*)(ws + WS_SCR + M_Q); const bf16_t* Kg = (const bf16_t*)(ws + WS_SCR + M_K); const bf16_t* KVT = (const bf16_t*)(ws + WS_SCR + M_KVT);
    const float* G32 = (const float*)(ws + WS_SCR + M_G32); const float* bg = A.in[10];
#define SC_POS0(j) (dir == 0 ? ((j) < 4 ? TL + 64 * (j) : 64 * ((j) - 4)) : ((j) < 4 ? TL + 64 * (3 - (j)) : 64 * (35 - (j))))
#define SC_DMA(bufi, p0) do { const int tj_ = otid(wv); _Pragma("unroll") for (int i_ = 0; i_ < 2; ++i_) { const int sl_ = i_ * 512 + tj_; \
        { const int row_ = sl_ >> 4, c_ = (sl_ & 15) ^ (row_ & 15); const size_t go_ = (size_t)((p0) + row_) * 1024 + c_ * 8; \
          __builtin_amdgcn_global_load_lds((const unsigned*)(Qu + go_), (LAS unsigned*)(lds + (bufi) * SC_BUF + SC_Q + i_ * 8192 + wave * 1024), 16, 0, 0); \
          __builtin_amdgcn_global_load_lds((const unsigned*)(Ku + go_), (LAS unsigned*)(lds + (bufi) * SC_BUF + SC_K + i_ * 8192 + wave * 1024), 16, 0, 0); } \
        { const int d_ = sl_ >> 3, c_ = (sl_ & 7) ^ ((d_ >> 1) & 7); \
          __builtin_amdgcn_global_load_lds((const unsigned*)(KTu + (size_t)d_ * TB + (p0) + c_ * 8), (LAS unsigned*)(lds + (bufi) * SC_BUF + SC_KT + i_ * 8192 + wave * 1024), 16, 0, 0); } } } while (0)
    for (int item = blockIdx.x; item < 256; item += gridDim.x) {
        const int dir = item & 1, h = (item >> 1) & 7, b = item >> 4, e0 = wave * 32;
        const bf16_t* Qu = Qg + (size_t)b * TB * 1024 + h * 128;
        const bf16_t* Ku = Kg + (size_t)b * TB * 1024 + h * 128;
        const bf16_t* KTu = KVT + ((size_t)b * 3072 + h * 128) * TB;
        const bf16_t* VTu = KVT + ((size_t)b * 3072 + 1024 + h * 256 + e0) * TB;
        bf16_t* Hout = (bf16_t*)(ws + WS_SCR + (dir ? M_HB : M_HF)) + (size_t)b * TB * DM + h * 256 + e0;
        const float big = bg[(dir * 2) * 8 + h], bfg = bg[(dir * 2 + 1) * 8 + h];
        f32x16 cacc[4];
#pragma unroll
        for (int d = 0; d < 4; ++d)
#pragma unroll
            for (int i = 0; i < 16; ++i) cacc[d][i] = 0.f;
        float m = 0.f;
        { const int l0 = otid(wv) & 63; wl[384 + l0] = 0.f; wl[448 + l0] = 0.f; }
        LFENCE();
        SC_DMA(0, SC_POS0(0));
        float ig_n, fg_n;
        { const int l0 = otid(wv) & 63; const float* gp = G32 + (size_t)(b * TB + SC_POS0(0) + (dir ? 63 - l0 : l0)) * 32 + (dir * 2) * 8 + h; ig_n = gp[0]; fg_n = gp[8]; }
        for (int j = 0; j < 36; ++j) {
            const int pos0 = SC_POS0(j);
            const LAS unsigned char* Qb = lds + (j & 1) * SC_BUF + SC_Q; const LAS unsigned char* Kb = lds + (j & 1) * SC_BUF + SC_K; const LAS unsigned char* KTb = lds + (j & 1) * SC_BUF + SC_KT;
            asm volatile("s_waitcnt vmcnt(0)" ::: "memory"); __builtin_amdgcn_s_barrier(); asm volatile("" ::: "memory");
            if (j + 1 < 36) SC_DMA((j + 1) & 1, SC_POS0(j + 1));
            const int lj = otid(wv) & 63, rj = lj & 31, h4 = (lj >> 5) * 4;
            LAS float* wh = wl + h4; LAS float* wr = wl + rj; LAS unsigned char* hb = hst + h4 * 64 + rj * 2;
            const unsigned xr = rj & 15, xd = (rj >> 1) & 7;
            const unsigned qro = (unsigned)rj * 256u + 2u * h4;
            const unsigned kro = (unsigned)rj * 128u + 2u * h4;
            const bf16_t* VTp = VTu + (size_t)rj * TB + pos0 + h4;
            bf16x8 vf[4];
#pragma unroll
            for (int kk = 0; kk < 4; ++kk) vf[kk] = ldperm(VTp + 16 * kk);
            float decay, m_new;
            {
                const int s = dir ? 63 - lj : lj;
                const float ig = ig_n + big, fg = fg_n + bfg;
                if (j + 1 < 36) { const float* gp = G32 + (size_t)(b * TB + SC_POS0(j + 1) + s) * 32 + (dir * 2) * 8 + h; ig_n = gp[0]; fg_n = gp[8]; }
                const float lf = fminf(fg, 0.f) - log1pf(__expf(-fabsf(fg)));
                float bs = lf;
#pragma unroll
                for (int o = 1; o < 64; o <<= 1) { const float t = __shfl_up(bs, o); if (lj >= o) bs += t; }
                const float uu = ig - bs;
                float pmx = uu;
#pragma unroll
                for (int o = 1; o < 64; o <<= 1) { const float t = __shfl_up(pmx, o); if (lj >= o) pmx = fmaxf(pmx, t); }
                pmx = fmaxf(pmx, m);
                const float b_end = __shfl(bs, 63), pm_last = __shfl(pmx, 63);
                LAS float* ws_ = wl + s;
                ws_[0] = uu * 1.4426950408889634f; ws_[64] = pmx * 1.4426950408889634f; ws_[128] = __expf(m - pmx); ws_[192] = __expf(-(bs + pmx)); ws_[256] = __expf(uu - pm_last);
                decay = __expf(m - pm_last); m_new = b_end + pm_last;
            }
            LFENCE();
            const int sbase = dir ? 63 - h4 : h4, sgn = dir ? -1 : 1;
#pragma unroll
            for (int tb = 0; tb < 2; ++tb) {
                __builtin_amdgcn_sched_barrier(0);
                const unsigned qo = qro + tb * 8192u;
                f32x16 ha;
#pragma unroll
                for (int i = 0; i < 16; ++i) ha[i] = 0.f;
                float qnv = 0.f;
#pragma unroll
                for (int kk = 0; kk < 8; ++kk) {
                    const bf16x8 qa = ldsfrag(Qb, qo + (((2u * kk) ^ xr) << 4));
                    ha = MFMA32(qa, pack_step(cacc[kk >> 1], kk & 1), ha);
                    const f32x4 n0 = *(const LAS f32x4*)(wh + 384 + 16 * kk), n1 = *(const LAS f32x4*)(wh + 384 + 16 * kk + 8);
#pragma unroll
                    for (int jj = 0; jj < 4; ++jj) qnv += bfs(qa[jj]) * n0[jj] + bfs(qa[4 + jj]) * n1[jj];
                }
                qnv += __shfl_xor(qnv, 32);
#pragma unroll
                for (int g = 0; g < 4; ++g) { const f32x4 av = *(const LAS f32x4*)(wh + 128 + 32 * tb + 8 * g);
#pragma unroll
                    for (int q = 0; q < 4; ++q) ha[4 * g + q] *= av[q]; }
                const float pmt = wr[64 + 32 * tb];
                const int tp = dir ? (63 - 32 * tb) - rj : 32 * tb + rj;
                float ds = 0.f;
#pragma unroll
                for (int sb = 0; sb < 2; ++sb) {
                    __builtin_amdgcn_sched_barrier(0);
                    if (sb != tb && (dir ? sb < tb : sb > tb)) continue;
                    const unsigned ko = qro + sb * 8192u;
                    f32x16 st;
#pragma unroll
                    for (int i = 0; i < 16; ++i) st[i] = 0.f;
#pragma unroll
                    for (int kk = 0; kk < 8; ++kk) { const unsigned c = ((2u * kk) ^ xr) << 4; st = MFMA32(ldsfrag(Kb, ko + c), ldsfrag(Qb, qo + c), st); }
#pragma unroll
                    for (int g = 0; g < 4; ++g) { const f32x4 uv = *(const LAS f32x4*)(wh + 32 * sb + 8 * g);
#pragma unroll
                        for (int q = 0; q < 4; ++q) {
                            const int sc = 32 * sb + q + 8 * g;
                            const int sp = sbase + sgn * sc;
                            st[4 * g + q] *= __builtin_amdgcn_exp2f((sp <= tp) ? uv[q] - pmt : -1e30f);
                            ds += st[4 * g + q];
                        } }
                    ha = MFMA32(pack_step(st, 0), vf[2 * sb], ha);
                    ha = MFMA32(pack_step(st, 1), vf[2 * sb + 1], ha);
                }
                ds += __shfl_xor(ds, 32);
                {
                    const float den = wr[128 + 32 * tb] * qnv + ds;
                    const float rd = 1.0f / fmaxf(fabsf(den), wr[192 + 32 * tb]);
                    if (h4 == 0) wr[320 + 32 * tb] = rd;
                }
                LFENCE();
#pragma unroll
                for (int g = 0; g < 4; ++g) { const f32x4 rv = *(const LAS f32x4*)(wh + 320 + 32 * tb + 8 * g);
#pragma unroll
                    for (int q = 0; q < 4; ++q) { const int tc = 32 * tb + q + 8 * g;
                        *(LAS unsigned short*)(hb + tc * 64) = (unsigned short)(pk2(ha[4 * g + q] * rv[q], 0.f) & 0xffffu); } }
            }
            LFENCE();
            {
                bf16_t* hp = Hout + (size_t)(pos0 + lj) * DM;
                const LAS unsigned char* hrow = hst + lj * 64;
#pragma unroll
                for (int q = 0; q < 4; ++q) *(u32x4*)(hp + 8 * q) = *(const LAS u32x4*)(hrow + 16 * q);
            }
            __builtin_amdgcn_sched_barrier(0);
#pragma unroll
            for (int db = 0; db < 4; ++db) {
                if (db == 2) __builtin_amdgcn_sched_barrier(0);
#pragma unroll
                for (int i = 0; i < 16; ++i) cacc[db][i] *= decay;
                const unsigned to = kro + db * 4096u;
                float nadd = 0.f;
#pragma unroll
                for (int kk = 0; kk < 4; ++kk) {
                    const bf16x8 kv = ldsfrag(KTb, to + (((2u * kk) ^ xd) << 4));
                    const f32x4 w0 = *(const LAS f32x4*)(wh + 256 + 16 * kk), w1 = *(const LAS f32x4*)(wh + 256 + 16 * kk + 8);
                    float f[8];
#pragma unroll
                    for (int jj = 0; jj < 4; ++jj) { f[jj] = bfs(kv[jj]) * w0[jj]; f[4 + jj] = bfs(kv[4 + jj]) * w1[jj]; }
#pragma unroll
                    for (int jj = 0; jj < 8; ++jj) nadd += f[jj];
                    u32x4 p = {pk2(f[0], f[1]), pk2(f[2], f[3]), pk2(f[4], f[5]), pk2(f[6], f[7])};
                    cacc[db] = MFMA32(__builtin_bit_cast(bf16x8, p), vf[kk], cacc[db]);
                }
                nadd += __shfl_xor(nadd, 32);
                if (h4 == 0) wr[384 + 32 * db] = decay * wr[384 + 32 * db] + nadd;
            }
            LFENCE();
            m = m_new;
        }
        asm volatile("s_waitcnt vmcnt(0)" ::: "memory"); __builtin_amdgcn_s_barrier();
    }
#undef SC_DMA
#undef SC_POS0
}
#undef MFMA32
#undef LFENCE
}

DI void mlstm_finish_phase(const Args& A, int wv) {
    const int tid = otid(wv), lane = tid & 63, wave = tid >> 6, G = gridDim.x;
    unsigned char* ws = A.ws;
    const bf16_t* HF = (const bf16_t*)(ws + WS_SCR + M_HF); const bf16_t* HB = (const bf16_t*)(ws + WS_SCR + M_HB);
    const bf16_t* SO = (const bf16_t*)(ws + WS_SCR + M_SO); const bf16_t* SZ = (const bf16_t*)(ws + WS_SCR + M_SZ);
    bf16_t* U = (bf16_t*)(ws + WS_H); const float* hn = A.in[11];
    const int sub = lane >> 5, e0 = (lane & 31) * 8;
    const long NIT = (long)NTOK * 8;
    for (long it = ((long)blockIdx.x * NWAVES + wave) * 2 + sub; it < NIT; it += (long)G * NWAVES * 2) {
        const size_t off = (size_t)(it >> 3) * DM + (int)(it & 7) * 256 + e0;
        f32x4 f0, f1, b0, b1, o0, o1, z0, z1;
        ld_bf16x8(HF + off, f0, f1); ld_bf16x8(HB + off, b0, b1); ld_bf16x8(SO + off, o0, o1); ld_bf16x8(SZ + off, z0, z1);
        f32x4 y0 = o0 * (f0 + b0), y1 = o1 * (f1 + b1);
        float ss = 0.f;
#pragma unroll
        for (int q = 0; q < 4; ++q) ss += y0[q] * y0[q] + y1[q] * y1[q];
        ss += __shfl_xor(ss, 1); ss += __shfl_xor(ss, 2); ss += __shfl_xor(ss, 4); ss += __shfl_xor(ss, 8); ss += __shfl_xor(ss, 16);
        const float rs = 1.0f / sqrtf(ss * (1.f / 256.f) + EPS);
        const float* hp = hn + (int)(it & 7) * 256 + e0;
        const f32x4 h0 = *(const f32x4*)hp, h1 = *(const f32x4*)(hp + 4);
        st_bf16x8(U + off, y0 * rs * h0 * z0, y1 * rs * h1 * z1);
    }
}

DI void mlstm_layer(const Args& A, LAS unsigned char* lds, const XcdBarrier& gbar, int layer, int wv) {
    unsigned char* ws = A.ws;
    const bf16_t* H = (const bf16_t*)(ws + WS_H); bf16_t* U = (bf16_t*)(ws + WS_H);
    bf16_t* Q = (bf16_t*)(ws + WS_SCR + M_Q); bf16_t* Kb = (bf16_t*)(ws + WS_SCR + M_K); bf16_t* KVT = (bf16_t*)(ws + WS_SCR + M_KVT);
    float* G32 = (float*)(ws + WS_SCR + M_G32); bf16_t* SO = (bf16_t*)(ws + WS_SCR + M_SO); bf16_t* SZ = (bf16_t*)(ws + WS_SCR + M_SZ);
    norm_phase(A, layer, false, wv);
    xcd_barrier(gbar, wv);
    {
        DescM1 D; D.init(H, (const bf16_t*)(ws + WS_WMA), (const bf16_t*)(ws + WS_WMB));
        auto E = [=](const pg8::Unit& u, int row_l, int col_l, f32x4 v0, f32x4 v1) {
            if (u.i2 == 0) {
                const size_t row = (size_t)u.i0 * 256 + row_l; const int pn = u.i1;
                if (pn < 4) st_bf16x8(Q + row * 1024 + pn * 256 + col_l, v0 * 0.088388347648318440f, v1 * 0.088388347648318440f);
                else if (pn < 8) st_bf16x8(Kb + row * 1024 + (pn - 4) * 256 + col_l, v0, v1);
                else if (col_l < 32) { *(f32x4*)(G32 + row * 32 + col_l) = v0; *(f32x4*)(G32 + row * 32 + col_l + 4) = v1; }
            } else {
                const int bb = u.i1 / 9, s0 = (u.i1 % 9) * 256;
                st_bf16x8(KVT + ((size_t)bb * 3072 + u.i0 * 256 + row_l) * TB + s0 + col_l, v0, v1);
            }
        };
        pg8::gemm_phase(lds, D, E, wv);
    }
    xcd_barrier(gbar, wv);
    ml::scan_phase(A, lds, wv);
    xcd_barrier(gbar, wv);
    {
        DescPlain D; D.init(H, (const bf16_t*)(ws + WS_WMA) + (size_t)2304 * DM, 16, false);
        auto E = [=](const pg8::Unit& u, int row_l, int col_l, f32x4 v0, f32x4 v1) {
            const size_t row = (size_t)u.i0 * 256 + row_l; const int pn = u.i1; f32x4 a, b;
            if (pn < 8) {
#pragma unroll
                for (int q = 0; q < 4; ++q) { a[q] = sigmf(v0[q]); b[q] = sigmf(v1[q]); }
                st_bf16x8(SO + row * DM + pn * 256 + col_l, a, b);
            } else {
#pragma unroll
                for (int q = 0; q < 4; ++q) { a[q] = siluf(v0[q]); b[q] = siluf(v1[q]); }
                st_bf16x8(SZ + row * DM + (pn - 8) * 256 + col_l, a, b);
            }
        };
        pg8::gemm_phase(lds, D, E, wv);
    }
    xcd_barrier(gbar, wv);
    mlstm_finish_phase(A, wv);
    xcd_barrier(gbar, wv);
    {
        DescPlain D; D.init(U, (const bf16_t*)(ws + WS_WMO), 8, false);
        const float* modl = (const float*)(ws + WS_MOD) + (size_t)layer * 17 * MOD_LD;
        auto E = [=](const pg8::Unit& u, int row_l, int col_l, f32x4 v0, f32x4 v1) { resid_store(A, layer, u.i0, row_l, u.i1 * 256 + col_l, modl, v0, v1); };
        pg8::gemm_phase(lds, D, E, wv);
    }
    xcd_barrier(gbar, wv);
}

__global__ void __launch_bounds__(NTHREADS, 2) fwd_megakernel(Args A) {
    extern __shared__ __attribute__((aligned(16))) unsigned char lds_raw[];
    LAS unsigned char* lds = (LAS unsigned char*)lds_raw;
    cg::grid_group grid = cg::this_grid();
    const int wv = __builtin_amdgcn_readfirstlane(threadIdx.x >> 6);
    volatile LAS unsigned* bst = (volatile LAS unsigned*)(lds + 147456);
    if (otid(wv) < 2) bst[otid(wv)] = 0u;
    __syncthreads();
    const XcdBarrier gbar = xcd_barrier_post((unsigned*)(A.ws + WS_BAR), bst, wv);
    prep_phase(A, lds, wv);
    grid.sync();
    {
        const long long* mi = (const long long*)(A.ws + WS_MODI); float* mf = (float*)(A.ws + WS_MOD);
        for (int i = blockIdx.x * NTHREADS + otid(wv); i < 4 * 17 * MOD_LD; i += gridDim.x * NTHREADS) mf[i] = (float)mi[i] * MODI_INV;
    }
    xcd_barrier(gbar, wv);
    fnet_layer(A, lds, gbar, 0, 0, false, wv);
    mlstm_layer(A, lds, gbar, 1, wv);
    attn_layer(A, lds, (char*)lds_raw, gbar, 2, wv);
    fnet_layer(A, lds, gbar, 3, 1, true, wv);
    final_norm_phase(A, (const float*)(A.ws + WS_SCR + F_PQX), wv);
}

extern "C" void kernel_launch(void* const* d_in, const int* in_sizes, int n_in, void* d_out, int out_size, void* d_ws, size_t ws_size, hipStream_t stream) {
    static int grid = 0;
    if (grid == 0) {
        if (n_in != 18 || ws_size < WS_END) { fprintf(stderr, "kernel_launch: unexpected n_in %d / ws_size %zu (need %zu)\n", n_in, ws_size, (size_t)WS_END); grid = -1; return; }
        int dev = 0, cus = 0, per_cu = 0;
        hipGetDevice(&dev);
        hipDeviceGetAttribute(&cus, hipDeviceAttributeMultiprocessorCount, dev);
        if (hipFuncSetAttribute((const void*)fwd_megakernel, hipFuncAttributeMaxDynamicSharedMemorySize, LDS_BYTES) != hipSuccess) { fprintf(stderr, "kernel_launch: hipFuncSetAttribute failed\n"); grid = -1; return; }
        if (hipOccupancyMaxActiveBlocksPerMultiprocessor(&per_cu, (const void*)fwd_megakernel, NTHREADS, LDS_BYTES) != hipSuccess || per_cu < 1) { fprintf(stderr, "kernel_launch: occupancy query failed (%d)\n", per_cu); per_cu = 1; }
        (void)hipGetLastError();
        grid = cus * per_cu;
        fprintf(stderr, "kernel_launch: grid %d (cus %d x %d)\n", grid, cus, per_cu);
    }
    if (grid < 0) return;
    (void)hipMemsetAsync((char*)d_ws + WS_MOD, 0, ZERO_BYTES, stream);
    (void)hipMemsetAsync((char*)d_ws + WS_MODI, 0, MODI_BYTES, stream);
    Args a{};
    for (int i = 0; i < 18; ++i) a.in[i] = (const float*)d_in[i];
    a.out = (float*)d_out; a.ws = (unsigned char*)d_ws; a.ph_lo = 0; a.ph_hi = 100;
    void* args[] = {&a};
    hipError_t e = hipLaunchCooperativeKernel((const void*)fwd_megakernel, dim3(grid), dim3(NTHREADS), args, LDS_BYTES, stream);
    if (e != hipSuccess) fprintf(stderr, "kernel_launch: cooperative launch failed: %s (grid %d)\n", hipGetErrorString(e), grid);
}
```

```cpp
#include <hip/hip_runtime.h>
#include <hip/hip_cooperative_groups.h>
#include <cstdio>
#include <cstdint>
namespace cg = cooperative_groups;

#define LAS __attribute__((address_space(3)))
#define DI __device__ __forceinline__
typedef unsigned short bf16_t;
typedef short bf16x8 __attribute__((ext_vector_type(8)));
typedef short s16x4 __attribute__((ext_vector_type(4)));
typedef float f32x2 __attribute__((ext_vector_type(2)));
typedef float f32x4 __attribute__((ext_vector_type(4)));
typedef float f32x16 __attribute__((ext_vector_type(16)));
typedef unsigned u32x2 __attribute__((ext_vector_type(2)));
typedef unsigned u32x4 __attribute__((ext_vector_type(4)));
typedef __bf16 bf16v2 __attribute__((ext_vector_type(2)));

constexpr int DM = 2048, NB = 16, TL = 2048, TC = 256, TB = TL + TC, NTOK = NB * TB;
constexpr int NWAVES = 8, NTHREADS = 512;
constexpr float EPS = 1e-6f;
constexpr int MOD_LD = 3 * DM;
constexpr int M_WA_ROWS = 6400, M_WB_ROWS = 3072;
constexpr size_t MiB = 1u << 20;
constexpr size_t WS_SCR_ = 301 * MiB;
constexpr size_t WS_MOD = 0;
constexpr size_t MOD_BYTES = (size_t)4 * 17 * MOD_LD * 4;
constexpr size_t WS_BAR = 1792 * 1024, ZERO_BYTES = 2 * MiB;
constexpr size_t WS_MODI = WS_SCR_ + 700 * MiB, MODI_BYTES = (size_t)4 * 17 * MOD_LD * 8;
constexpr float MODI_SCALE = 1073741824.f, MODI_INV = 9.313225746154785e-10f;
constexpr size_t WS_WFG = 2 * MiB, WS_WFO = 18 * MiB, WS_WMA = 34 * MiB, WS_WMB = 59 * MiB, WS_WMO = 71 * MiB, WS_WAI = 79 * MiB, WS_WAO = 99 * MiB;
constexpr size_t WS_DC = 107 * MiB, WS_DT = 108 * MiB, WS_DT2 = 124 * MiB, WS_CTXS = 125 * MiB, WS_H = 157 * MiB, WS_SCR = 301 * MiB;
constexpr size_t WS_END = 1024 * MiB;
constexpr size_t F_G = 0, F_PQX = 144 * MiB, F_PQC = 400 * MiB, F_A1 = 432 * MiB, F_NYQ = 496 * MiB;
constexpr size_t M_Q = 0, M_K = 72 * MiB, M_KVT = 144 * MiB, M_G32 = 360 * MiB, M_HF = 365 * MiB, M_HB = 509 * MiB, M_SO = 0, M_SZ = 144 * MiB;
constexpr size_t A_Q = 0, A_K = 144 * MiB, A_V = 180 * MiB, A_SZ = 216 * MiB;
static_assert(WS_SCR + M_HB + 144 * MiB <= WS_END, "ws map");
constexpr int LDS_BYTES = 147456 + 1024;

DI unsigned pk2(float a, float b) { f32x2 v = {a, b}; return __builtin_bit_cast(unsigned, __builtin_convertvector(v, bf16v2)); }
DI float bf_lo(unsigned w) { return __uint_as_float(w << 16); }
DI float bf_hi(unsigned w) { return __uint_as_float(w & 0xffff0000u); }
DI float wave_sum(float v) {
#pragma unroll
    for (int o = 1; o < 64; o <<= 1) v += __shfl_xor(v, o);
    return v;
}
DI int otid(int wv) { int t; asm volatile("v_mbcnt_lo_u32_b32 %0, -1, 0\n\tv_mbcnt_hi_u32_b32 %0, -1, %0" : "=v"(t)); return wv * 64 + t; }
DI float siluf(float x) { return x / (1.f + __expf(-x)); }
DI float sigmf(float x) { return 1.f / (1.f + __expf(-x)); }
DI void st_bf16x8(bf16_t* p, f32x4 a, f32x4 b) { u32x4 w = {pk2(a[0], a[1]), pk2(a[2], a[3]), pk2(b[0], b[1]), pk2(b[2], b[3])}; *(u32x4*)p = w; }
DI void ld_bf16x8(const bf16_t* p, f32x4& a, f32x4& b) { const u32x4 w = *(const u32x4*)p; a = (f32x4){bf_lo(w.x), bf_hi(w.x), bf_lo(w.y), bf_hi(w.y)}; b = (f32x4){bf_lo(w.z), bf_hi(w.z), bf_lo(w.w), bf_hi(w.w)}; }

DI f32x4 ldmod4(const long long* p) { return (f32x4){(float)p[0] * MODI_INV, (float)p[1] * MODI_INV, (float)p[2] * MODI_INV, (float)p[3] * MODI_INV}; }

struct Args { const float* in[18]; float* out; unsigned char* ws; int ph_lo, ph_hi; };

#define XB_TMO      128
#define XB_XCNT(j)  (256  + 64 * (j))
#define XB_XSUB(j)  (1280 + 64 * (j))
#define XB_XGEN(j)  (2304 + 64 * (j))
#define XB_TOP      3328
#define XB_TOPGEN   3392
#define XCD_BAR_WORDS 3456
#define XB_SPIN_CAP (1u << 18)

__device__ __forceinline__ unsigned xb_ld(unsigned* p)              { return __hip_atomic_load(p, __ATOMIC_RELAXED, __HIP_MEMORY_SCOPE_AGENT); }
__device__ __forceinline__ unsigned xb_add(unsigned* p, unsigned v) { return __hip_atomic_fetch_add(p, v, __ATOMIC_RELAXED, __HIP_MEMORY_SCOPE_AGENT); }
__device__ __forceinline__ unsigned xb_xcc_id() { return (unsigned)__builtin_amdgcn_s_getreg((3 << 11) | 20) & 0xFu; }
#define XB_SPIN(cond, bar) do { unsigned _sp = 0; while (cond) { __builtin_amdgcn_s_sleep(1); \
    if ((++_sp & 255u) == 0u) { if (xb_ld(&(bar)[XB_TMO])) break; if (_sp > XB_SPIN_CAP) { atomicAdd(&(bar)[XB_TMO], 1u); break; } } } } while (0)

struct XcdBarrier {
    unsigned* bar; unsigned x;
    volatile LAS unsigned* st;
};

__device__ __forceinline__ XcdBarrier xcd_barrier_post(unsigned* bar, volatile LAS unsigned* st, int wv) {
    XcdBarrier b; b.bar = bar; b.x = xb_xcc_id(); b.st = st;
    if (otid(wv) == 0) (void)xb_add(&bar[XB_XCNT(b.x)], 1u);
    return b;
}
__device__ __forceinline__ void xcd_barrier_complete(unsigned* bar, unsigned x, unsigned& nloc, unsigned& nx) {
    const unsigned G = gridDim.x * gridDim.y * gridDim.z;
    unsigned sum, cnt, mine, sp = 0u;
    for (;;) {
        sum = 0u; cnt = 0u; mine = 0u;
#pragma unroll
        for (unsigned j = 0; j < 16; ++j) { const unsigned c = xb_ld(&bar[XB_XCNT(j)]); sum += c; cnt += (c > 0u) ? 1u : 0u; mine = (j == x) ? c : mine; }
        if (sum == G) break;
        __builtin_amdgcn_s_sleep(1);
        if ((++sp & 255u) == 0u) { if (xb_ld(&bar[XB_TMO])) break; if (sp > XB_SPIN_CAP) { atomicAdd(&bar[XB_TMO], 1u); break; } }
    }
    nloc = mine > 0u ? mine : 1u; nx = cnt > 0u ? cnt : 1u;
}

__device__ __forceinline__ void xcd_barrier(const XcdBarrier& b, int wv) {
    asm volatile("s_waitcnt vmcnt(0)" ::: "memory");
    __syncthreads();
    if (otid(wv) == 0) {
        unsigned* bar = b.bar;
        __builtin_amdgcn_s_waitcnt(0);
        unsigned nloc = b.st[0], nx = b.st[1];
        if (nloc == 0u) { xcd_barrier_complete(bar, b.x, nloc, nx); b.st[0] = nloc; b.st[1] = nx; }
        const unsigned old = xb_add(&bar[XB_XSUB(b.x)], 1u);
        const unsigned gen = old / nloc;
        if (old + 1u == (gen + 1u) * nloc) {
            __builtin_amdgcn_fence(__ATOMIC_RELEASE, "agent");
            asm volatile("s_waitcnt vmcnt(0)" ::: "memory");
            const unsigned og = xb_add(&bar[XB_TOP], 1u);
            const unsigned tg = og / nx;
            if (og + 1u == (tg + 1u) * nx) xb_add(&bar[XB_TOPGEN], 1u);
            else XB_SPIN(xb_ld(&bar[XB_TOPGEN]) == tg, bar);
            __builtin_amdgcn_fence(__ATOMIC_ACQUIRE, "agent");
            xb_add(&bar[XB_XGEN(b.x)], 1u);
            asm volatile("s_waitcnt vmcnt(0)" ::: "memory");
        } else {
            XB_SPIN(xb_ld(&bar[XB_XGEN(b.x)]) == gen, bar);
            __builtin_amdgcn_fence(__ATOMIC_ACQUIRE, "agent");
            asm volatile("s_waitcnt vmcnt(0)" ::: "memory");
        }
    }
    __syncthreads();
}


namespace pg8 {
constexpr int BM = 256, BK = 64, HALF = 128, HTB = HALF * BK * 2, NXCD = 8;
DI int lds_byte(int r, int c) { const int st = (r >> 4) * 2 + (c >> 5), rr = r & 15, cc = c & 31, ob = rr * 64 + cc * 2; return st * 1024 + (ob ^ (((ob >> 9) & 1) << 5)); }
DI void stage_rc(int b, int& R, int& C) { const int st = b / 1024, sb = b % 1024, swz = sb ^ (((sb >> 9) & 1) << 5); R = (st >> 1) * 16 + swz / 64; C = (st & 1) * 32 + (swz % 64) / 2; }
DI int perm32(int rho) { const int n = rho >> 4, i = rho & 15; return 8 * (i >> 2) + 4 * n + (i & 3); }
struct Unit { const char* a; const char* b; int i0, i1, i2; };
DI int xcd_remap(int L, int total) { const int q = total / NXCD, r = total % NXCD, xcd = L % NXCD, off = L / NXCD; return (xcd < r ? xcd * (q + 1) : r * (q + 1) + (xcd - r) * q) + off; }

template <class Desc, class Epi>
DI void gemm_phase(LAS unsigned char* lds, const Desc& D, const Epi& E, int wv) {
    const int tid = otid(wv), wid = __builtin_amdgcn_readfirstlane(tid >> 6), lane = tid & 63, wr = wid >> 2, wc = wid & 3, fr = lane & 15, fq = lane >> 4;
    const int G = gridDim.x, c = blockIdx.x, total = D.total;
    const int K = D.K, nt = K / BK;
    unsigned voffA[2], voffB[2];
#pragma unroll
    for (int i = 0; i < 2; ++i) { int R, C; stage_rc(tid * 16 + i * 8192, R, C); const int Rb = (R & ~31) + perm32(R & 31);
        voffA[i] = (unsigned)(R * D.lda + C) * 2u; voffB[i] = (unsigned)(Rb * D.ldb + C) * 2u; }
    const size_t kstep = (size_t)(BK * 2);
    const size_t hstepA = (size_t)HALF * D.lda * 2, hstepB = (size_t)HALF * D.ldb * 2;
    const unsigned ldsw = (unsigned)wid * 1024u;
    const int aoff = lds_byte(wr * 64 + fr, fq * 8), boff = lds_byte(wc * 32 + fr, fq * 8);
#define PG8_SA(b, h) (((b) * 2 + (h)) * HTB)
#define PG8_SB(b, h) ((4 + (b) * 2 + (h)) * HTB)
#define PG8_STAGE(bufoff, gbase, voff) do { _Pragma("unroll") for (int _i = 0; _i < 2; ++_i) \
        __builtin_amdgcn_global_load_lds((const unsigned*)((const char*)(gbase) + (voff)[_i]), (LAS unsigned*)(lds + (bufoff) + ldsw + _i * 8192), 16, 0, 0); } while (0)
#define PG8_LDA(dst, b, h) do { _Pragma("unroll") for (int m = 0; m < 4; ++m) _Pragma("unroll") for (int k = 0; k < 2; ++k) dst[m][k] = *(const LAS bf16x8*)(lds + PG8_SA(b, h) + aoff + m * 2048 + k * 1024); } while (0)
#define PG8_LDB(dst, b, h) do { _Pragma("unroll") for (int n = 0; n < 2; ++n) _Pragma("unroll") for (int k = 0; k < 2; ++k) dst[n][k] = *(const LAS bf16x8*)(lds + PG8_SB(b, h) + boff + n * 2048 + k * 1024); } while (0)
#define PG8_MMA(ai, bj, At, Bt) do { __builtin_amdgcn_s_setprio(1); _Pragma("unroll") for (int m = 0; m < 4; ++m) _Pragma("unroll") for (int n = 0; n < 2; ++n) _Pragma("unroll") for (int k = 0; k < 2; ++k) \
        acc[ai][bj][m][n] = __builtin_amdgcn_mfma_f32_16x16x32_bf16(Bt[n][k], At[m][k], acc[ai][bj][m][n], 0, 0, 0); __builtin_amdgcn_s_setprio(0); } while (0)
#define PG8_WAIT_V(n) asm volatile("s_waitcnt vmcnt(" #n ")" ::: "memory")
#define PG8_WAIT_L(n) asm volatile("s_waitcnt lgkmcnt(" #n ")" ::: "memory")
#define PG8_BAR __builtin_amdgcn_s_barrier()
#define PG8_SCHED __builtin_amdgcn_sched_barrier(0)
    if (c >= total) return;
    Unit cur = D.unit(xcd_remap(c, total)), nxt = cur; int ui = 0;
    f32x4 acc[2][2][4][2];
#pragma unroll
    for (int a = 0; a < 2; ++a)
#pragma unroll
        for (int b = 0; b < 2; ++b)
#pragma unroll
            for (int m = 0; m < 4; ++m)
#pragma unroll
                for (int n = 0; n < 2; ++n) acc[a][b][m][n] = (f32x4){0.f, 0.f, 0.f, 0.f};
    bf16x8 At[4][2], B0[2][2], B1[2][2];
    const char* cA = cur.a; const char* cB = cur.b;
    PG8_STAGE(PG8_SB(0, 0), cB, voffB); PG8_STAGE(PG8_SB(0, 1), cB + hstepB, voffB); PG8_STAGE(PG8_SA(0, 0), cA, voffA); PG8_STAGE(PG8_SA(0, 1), cA + hstepA, voffA);
    if (wr == 1) PG8_BAR;
    PG8_WAIT_V(2); PG8_BAR;
    PG8_STAGE(PG8_SB(1, 0), cB + kstep, voffB); PG8_STAGE(PG8_SA(1, 0), cA + kstep, voffA); PG8_STAGE(PG8_SB(1, 1), cB + hstepB + kstep, voffB);
    PG8_WAIT_V(6); PG8_BAR;
    for (;;) {
        const long Ln = (long)(ui + 1) * G + c;
        const bool has_next = Ln < total;
        if (has_next) nxt = D.unit(xcd_remap((int)Ln, total));
        const char* nA = has_next ? nxt.a : cA; const char* nB = has_next ? nxt.b : cB;
        for (int t = 0; t < nt; t += 2) {
            const bool last = (t == nt - 2);
            const char* a1 = cA + (size_t)(t + 1) * kstep;
            const char* a2 = last ? nA : cA + (size_t)(t + 2) * kstep; const char* b2 = last ? nB : cB + (size_t)(t + 2) * kstep;
            const char* a3 = a2 + kstep; const char* b3 = b2 + kstep;
            PG8_LDB(B0, 0, 0); PG8_LDB(B1, 0, 1); PG8_SCHED; PG8_LDA(At, 0, 0); PG8_STAGE(PG8_SA(1, 1), a1 + hstepA, voffA);
            PG8_WAIT_V(8); PG8_WAIT_L(0); PG8_BAR; PG8_MMA(0, 0, At, B0); PG8_MMA(0, 1, At, B1); PG8_BAR; PG8_SCHED;
            PG8_LDA(At, 0, 1); PG8_STAGE(PG8_SB(0, 0), b2, voffB); PG8_STAGE(PG8_SB(0, 1), b2 + hstepB, voffB); PG8_STAGE(PG8_SA(0, 0), a2, voffA);
            PG8_WAIT_V(8); PG8_WAIT_L(0); PG8_BAR; PG8_MMA(1, 0, At, B0); PG8_MMA(1, 1, At, B1); PG8_BAR; PG8_SCHED;
            PG8_LDB(B0, 1, 0); PG8_LDB(B1, 1, 1); PG8_SCHED; PG8_LDA(At, 1, 0); PG8_STAGE(PG8_SA(0, 1), a2 + hstepA, voffA);
            PG8_WAIT_V(8); PG8_WAIT_L(0); PG8_BAR; PG8_MMA(0, 0, At, B0); PG8_MMA(0, 1, At, B1); PG8_BAR; PG8_SCHED;
            PG8_LDA(At, 1, 1); PG8_STAGE(PG8_SB(1, 0), b3, voffB); PG8_STAGE(PG8_SB(1, 1), b3 + hstepB, voffB); PG8_STAGE(PG8_SA(1, 0), a3, voffA);
            PG8_WAIT_V(8); PG8_WAIT_L(0); PG8_BAR; PG8_MMA(1, 0, At, B0); PG8_MMA(1, 1, At, B1); PG8_BAR; PG8_SCHED;
        }
        if (wr == 0) PG8_BAR;
        {
            const int le = otid(wv) & 63, fre = le & 15, fqe = le >> 4;
#pragma unroll
            for (int ai = 0; ai < 2; ++ai)
#pragma unroll
                for (int m = 0; m < 4; ++m)
#pragma unroll
                    for (int bj = 0; bj < 2; ++bj)
                        E(cur, ai * HALF + wr * 64 + m * 16 + fre, bj * HALF + wc * 32 + 8 * fqe, acc[ai][bj][m][0], acc[ai][bj][m][1]);
        }
        if (!has_next) break;
#pragma unroll
        for (int a = 0; a < 2; ++a)
#pragma unroll
            for (int b = 0; b < 2; ++b)
#pragma unroll
                for (int m = 0; m < 4; ++m)
#pragma unroll
                    for (int n = 0; n < 2; ++n) acc[a][b][m][n] = (f32x4){0.f, 0.f, 0.f, 0.f};
        cur = nxt; cA = nA; cB = nB; ++ui;
        if (wr == 1) PG8_BAR;
    }
    PG8_WAIT_V(0);
    PG8_BAR;
#undef PG8_SA
#undef PG8_SB
#undef PG8_STAGE
#undef PG8_LDA
#undef PG8_LDB
#undef PG8_MMA
#undef PG8_WAIT_V
#undef PG8_WAIT_L
#undef PG8_BAR
#undef PG8_SCHED
}
}

DI void transpose_item(const float* W, int N, int kb, int nb, bf16_t* d0, bf16_t* d1, int K, LAS float* scr, int lane) {
    const int k0 = 64 * kb, n0 = 32 * nb;
#pragma unroll 8
    for (int i = 0; i < 32; ++i) { const int kk = 2 * i + (lane >> 5); scr[kk * 33 + (lane & 31)] = W[(size_t)(k0 + kk) * N + n0 + (lane & 31)]; }
    asm volatile("s_waitcnt lgkmcnt(0)" ::: "memory");
    const int c = lane & 7;
#pragma unroll
    for (int j = 0; j < 4; ++j) { const int n = (lane >> 3) + 8 * j; const LAS float* s = scr + (8 * c) * 33 + n;
        u32x4 o; o.x = pk2(s[0 * 33], s[1 * 33]); o.y = pk2(s[2 * 33], s[3 * 33]); o.z = pk2(s[4 * 33], s[5 * 33]); o.w = pk2(s[6 * 33], s[7 * 33]);
        *(u32x4*)(d0 + (size_t)n * K + k0 + 8 * c) = o;
        if (d1) *(u32x4*)(d1 + (size_t)n * K + k0 + 8 * c) = o; }
    asm volatile("s_waitcnt lgkmcnt(0)" ::: "memory");
}

DI void prep_phase(const Args& A, LAS unsigned char* lds, int wv) {
    const int tid = otid(wv), lane = tid & 63, wave = tid >> 6, G = gridDim.x;
    unsigned char* ws = A.ws;
    {
        LAS float* s_lds = (LAS float*)lds;
        const float* cc = A.in[1]; const float* cctx = A.in[3]; const float* aw = A.in[4]; const float* ab = A.in[5];
        long long* modi = (long long*)(ws + WS_MODI);
        for (int item = blockIdx.x; item < 768; item += G) {
            const int kc = item % 16, cb = (item / 16) % 12, l = item / 192;
            const int k0 = kc * 128, j = cb * 512 + tid;
            __syncthreads();
            for (int e = tid; e < 17 * 128; e += NTHREADS) { const int r = e / 128, k = e % 128; const float v = r < 16 ? cc[r * DM + k0 + k] : cctx[k0 + k]; s_lds[k * 20 + r] = siluf(v); }
            __syncthreads();
            float acc[17];
#pragma unroll
            for (int r = 0; r < 17; ++r) acc[r] = 0.f;
            const float* wp = aw + ((size_t)l * DM + k0) * MOD_LD + j;
#pragma unroll 4
            for (int k = 0; k < 128; ++k) {
                const float w = wp[(size_t)k * MOD_LD];
                const LAS f32x4* sp = (const LAS f32x4*)(s_lds + k * 20);
                const f32x4 s0 = sp[0], s1 = sp[1], s2 = sp[2], s3 = sp[3]; const float s4 = s_lds[k * 20 + 16];
#pragma unroll
                for (int q = 0; q < 4; ++q) { acc[q] += s0[q] * w; acc[4 + q] += s1[q] * w; acc[8 + q] += s2[q] * w; acc[12 + q] += s3[q] * w; }
                acc[16] += s4 * w;
            }
            const float bias = (kc == 0) ? ab[l * MOD_LD + j] : 0.f;
#pragma unroll
            for (int r = 0; r < 17; ++r) atomicAdd((unsigned long long*)&modi[(size_t)(l * 17 + r) * MOD_LD + j], (unsigned long long)__float2ll_rn((acc[r] + bias) * MODI_SCALE));
        }
        __syncthreads();
    }
    {
        LAS float* scr = (LAS float*)(lds + wave * 16384);
        const int gw = blockIdx.x * NWAVES + wave, NGW = G * NWAVES;
        constexpr int I_SQ = 32 * 64, I_AI = 32 * 160, I_MI = 32 * 257;
        constexpr int NIT = 6 * I_SQ + I_AI + I_MI;
        for (int it = gw; it < NIT; it += NGW) {
            int r = it;
            if (r < 6 * I_SQ) {
                const int w = r / I_SQ; r -= w * I_SQ;
                const float* src; bf16_t* dst;
                if (w < 2)      { src = A.in[7] + (size_t)w * DM * DM;       dst = (bf16_t*)(ws + WS_WFG) + (size_t)w * DM * DM; }
                else if (w < 4) { src = A.in[8] + (size_t)(w - 2) * DM * DM; dst = (bf16_t*)(ws + WS_WFO) + (size_t)(w - 2) * DM * DM; }
                else if (w == 4) { src = A.in[12]; dst = (bf16_t*)(ws + WS_WMO); }
                else             { src = A.in[16]; dst = (bf16_t*)(ws + WS_WAO); }
                const int kb = r / 64, nb = r % 64;
                transpose_item(src, DM, kb, nb, dst + (size_t)(32 * nb) * DM, nullptr, DM, scr, lane);
                continue;
            }
            r -= 6 * I_SQ;
            if (r < I_AI) { const int kb = r / 160, nb = r % 160; transpose_item(A.in[13], 5120, kb, nb, (bf16_t*)(ws + WS_WAI) + (size_t)(32 * nb) * DM, nullptr, DM, scr, lane); continue; }
            r -= I_AI;
            {
                const int kb = r / 257, nb = r % 257, n0 = 32 * nb;
                bf16_t* WA = (bf16_t*)(ws + WS_WMA); bf16_t* WB = (bf16_t*)(ws + WS_WMB);
                bf16_t* d0; bf16_t* d1 = nullptr;
                if (n0 < 1024) d0 = WA + (size_t)n0 * DM;
                else if (n0 < 2048) { d0 = WA + (size_t)n0 * DM; d1 = WB + (size_t)(n0 - 1024) * DM; }
                else if (n0 < 4096) d0 = WB + (size_t)(1024 + n0 - 2048) * DM;
                else if (n0 < 6144) d0 = WA + (size_t)(2304 + n0 - 4096) * DM;
                else if (n0 < 6176) d0 = WA + (size_t)(2048 + n0 - 6144) * DM;
                else d0 = WA + (size_t)(4352 + n0 - 6176) * DM;
                transpose_item(A.in[9], 8224, kb, nb, d0, d1, DM, scr, lane);
            }
        }
    }
    {
        const long gt = (long)blockIdx.x * NTHREADS + tid, NGT = (long)G * NTHREADS;
        constexpr long N_DC = 1024L * 512 / 8, N_DT = 2048L * 4096 / 8, N_DT2 = 256L * 512 / 8;
        for (long it = gt; it < N_DC + N_DT + N_DT2; it += NGT) {
            float v[8]; bf16_t* dst;
            if (it < N_DC) {
                const int m = (int)(it / 64), k0 = (int)(it % 64) * 8; const float sc = 0.044194173824159216f;
#pragma unroll
                for (int j = 0; j < 8; ++j) { const int rr = ((m & 511) * (k0 + j)) & 511; const float ang = (float)rr * (1.f / 256.f); v[j] = (m < 512 ? cospif(ang) : sinpif(ang)) * sc; }
                dst = (bf16_t*)(ws + WS_DC) + (size_t)m * 512 + k0;
            } else if (it < N_DC + N_DT) {
                const long i2 = it - N_DC; const int kk = (int)(i2 / 512), s0 = (int)(i2 % 512) * 8; const float sc = 0.022097086912079608f;
#pragma unroll
                for (int j = 0; j < 8; ++j) { const int s = s0 + j; const int rr = (kk * (s & 2047)) & 2047; const float ang = (float)rr * (1.f / 1024.f); v[j] = (s < 2048 ? cospif(ang) : -sinpif(ang)) * sc; }
                dst = (bf16_t*)(ws + WS_DT) + (size_t)kk * 4096 + s0;
            } else {
                const long i2 = it - N_DC - N_DT; const int kk = (int)(i2 / 64), s0 = (int)(i2 % 64) * 8; const float sc = 0.0625f;
#pragma unroll
                for (int j = 0; j < 8; ++j) { const int s = s0 + j; const int rr = (kk * (s & 255)) & 255; const float ang = (float)rr * (1.f / 128.f); v[j] = (s < 256 ? cospif(ang) : -sinpif(ang)) * sc; }
                dst = (bf16_t*)(ws + WS_DT2) + (size_t)kk * 512 + s0;
            }
            u32x4 o = {pk2(v[0], v[1]), pk2(v[2], v[3]), pk2(v[4], v[5]), pk2(v[6], v[7])};
            *(u32x4*)dst = o;
        }
    }
}

DI const float* xrow_in(const Args& A, int r) {
    const int b = r / TB, t = r % TB;
    if (t < TL) return A.in[0] + ((size_t)b * TL + t) * DM;
    return A.in[2] + ((size_t)b * TC + (t - TL)) * DM;
}
DI void norm_phase(const Args& A, int layer, bool latonly, int wv) {
    const int tid = otid(wv), lane = tid & 63, wave = tid >> 6, G = gridDim.x;
    const float* ng = A.in[6] + (size_t)layer * DM;
    const float* mod = (const float*)(A.ws + WS_MOD) + (size_t)layer * 17 * MOD_LD;
    bf16_t* H = (bf16_t*)(A.ws + WS_H);
    const bf16_t* XB = (const bf16_t*)A.out;
    for (int r0 = (blockIdx.x * NWAVES + wave) * 2; r0 < NTOK; r0 += G * NWAVES * 2) {
        const int b = r0 / TB, t = r0 % TB;
        if (latonly && t >= TL) continue;
        const float* mr = mod + (size_t)(t < TL ? b : 16) * MOD_LD;
        f32x4 v[2][4][2];
#pragma unroll
        for (int k = 0; k < 2; ++k) {
            const int r = r0 + k;
            if (layer == 0) {
                const float* xr = xrow_in(A, r);
#pragma unroll
                for (int j = 0; j < 4; ++j) { const f32x4* p = (const f32x4*)(xr + 512 * j + 8 * lane); v[k][j][0] = p[0]; v[k][j][1] = p[1]; }
            } else {
#pragma unroll
                for (int j = 0; j < 4; ++j) ld_bf16x8(XB + (size_t)r * DM + 512 * j + 8 * lane, v[k][j][0], v[k][j][1]);
            }
        }
#pragma unroll
        for (int k = 0; k < 2; ++k) {
            const int r = r0 + k; float ss = 0.f;
#pragma unroll
            for (int j = 0; j < 4; ++j)
#pragma unroll
                for (int q = 0; q < 4; ++q) ss += v[k][j][0][q] * v[k][j][0][q] + v[k][j][1][q] * v[k][j][1][q];
            const float rs = 1.0f / sqrtf(wave_sum(ss) * (1.f / DM) + EPS);
#pragma unroll
            for (int j = 0; j < 4; ++j) { const int c0 = 512 * j + 8 * lane; f32x4 o[2];
#pragma unroll
                for (int h = 0; h < 2; ++h) { const f32x4 g4 = *(const f32x4*)(ng + c0 + 4 * h), sh = *(const f32x4*)(mr + c0 + 4 * h), sc = *(const f32x4*)(mr + DM + c0 + 4 * h);
                    o[h] = (v[k][j][h] * rs) * g4 * (sc + 1.0f) + sh; }
                st_bf16x8(H + (size_t)r * DM + c0, o[0], o[1]); }
        }
    }
}
DI void final_norm_phase(const Args& A, const float* src_override, int wv) {
    const int tid = otid(wv), lane = tid & 63, wave = tid >> 6, G = gridDim.x;
    const float* fg = A.in[17];
    for (int r0 = (blockIdx.x * NWAVES + wave) * 2; r0 < NB * TL; r0 += G * NWAVES * 2) {
        f32x4 v[2][4][2];
#pragma unroll
        for (int k = 0; k < 2; ++k) { const float* xr = (src_override ? src_override : (const float*)A.out) + (size_t)(r0 + k) * DM;
#pragma unroll
            for (int j = 0; j < 4; ++j) { const f32x4* p = (const f32x4*)(xr + 512 * j + 8 * lane); v[k][j][0] = p[0]; v[k][j][1] = p[1]; } }
#pragma unroll
        for (int k = 0; k < 2; ++k) { float* orow = A.out + (size_t)(r0 + k) * DM; float ss = 0.f;
#pragma unroll
            for (int j = 0; j < 4; ++j)
#pragma unroll
                for (int q = 0; q < 4; ++q) ss += v[k][j][0][q] * v[k][j][0][q] + v[k][j][1][q] * v[k][j][1][q];
            const float rs = 1.0f / sqrtf(wave_sum(ss) * (1.f / DM) + EPS);
#pragma unroll
            for (int j = 0; j < 4; ++j) { const int c0 = 512 * j + 8 * lane;
#pragma unroll
                for (int h = 0; h < 2; ++h) { const f32x4 g4 = *(const f32x4*)(fg + c0 + 4 * h); *(f32x4*)(orow + c0 + 4 * h) = (v[k][j][h] * rs) * g4; } }
        }
    }
}

struct DescPlain {
    const bf16_t* A; const bf16_t* B; int nN; bool latonly; int lda, ldb, K, total;
    DI void init(const bf16_t* A_, const bf16_t* B_, int nN_, bool lat) { A = A_; B = B_; nN = nN_; latonly = lat; lda = DM; ldb = DM; K = DM; total = (lat ? 128 : 144) * nN_; }
    DI pg8::Unit unit(int idx) const {
        const int nMt = latonly ? 128 : 144, nig = 8 * nN, gid = idx / nig, fm = gid * 8, gsz = (nMt - fm) < 8 ? (nMt - fm) : 8;
        const int pmi = fm + (idx % nig) % gsz, pn = (idx % nig) / gsz, pm = latonly ? (pmi / 8) * 9 + (pmi % 8) : pmi;
        pg8::Unit u; u.a = (const char*)(A + (size_t)pm * 256 * DM); u.b = (const char*)(B + (size_t)pn * 256 * DM); u.i0 = pm; u.i1 = pn; u.i2 = 0; return u;
    }
};
struct DescChan {
    const bf16_t* DC; const bf16_t* H; int lda, ldb, K, total;
    DI void init(const bf16_t* DC_, const bf16_t* H_, bool lat) { DC = DC_; H = H_; lda = 512; ldb = DM; K = 512; total = lat ? 2048 : 2304; }
    DI pg8::Unit unit(int idx) const {
        pg8::Unit u; int b, g, mt, nt, toff;
        if (idx < 2048) { mt = idx % 4; nt = (idx / 4) % 8; g = (idx / 32) % 4; b = idx / 128; toff = nt * 256; u.i2 = nt; }
        else { const int j = idx - 2048; mt = j % 4; g = (j / 4) % 4; b = j / 16; toff = TL; u.i2 = 8; }
        u.a = (const char*)(DC + (size_t)mt * 256 * 512); u.b = (const char*)(H + ((size_t)b * TB + toff) * DM + g * 512); u.i0 = b * 4 + g; u.i1 = mt; return u;
    }
};
struct DescT {
    const bf16_t* DT; const bf16_t* PQ; int nMt; int lda, ldb, K, total;
    DI void init(const bf16_t* DT_, const bf16_t* PQ_, int ld, int Kd, int coff, int nMt_) { DT = DT_ + coff; PQ = PQ_ + coff; nMt = nMt_; lda = ld; ldb = ld; K = Kd; total = NB * nMt_ * 8; }
    DI pg8::Unit unit(int idx) const {
        const int mt = idx % nMt, nt = (idx / nMt) % 8, b = idx / (nMt * 8);
        pg8::Unit u; u.a = (const char*)(DT + (size_t)mt * 256 * lda); u.b = (const char*)(PQ + ((size_t)b * DM + nt * 256) * ldb); u.i0 = b; u.i1 = mt; u.i2 = nt; return u;
    }
};

DI void resid_store(const Args& A, int layer, int pm, int row_l, int col, const float* modl, f32x4 v0, f32x4 v1) {
    const int b = pm / 9, tt = pm % 9;
    const float* gp = modl + (size_t)(tt < 8 ? b : 16) * MOD_LD + 2 * DM + col;
    const f32x4 g0 = *(const f32x4*)gp, g1 = *(const f32x4*)(gp + 4);
    bf16_t* XB = (bf16_t*)A.out;
    const size_t roff = ((size_t)pm * 256 + row_l) * DM + col;
    f32x4 x0, x1;
    if (layer == 0) {
        const float* src = (tt < 8) ? A.in[0] + ((size_t)b * TL + tt * 256 + row_l) * DM + col : A.in[2] + ((size_t)b * TC + row_l) * DM + col;
        x0 = *(const f32x4*)src; x1 = *(const f32x4*)(src + 4);
    } else ld_bf16x8(XB + roff, x0, x1);
    x0 = x0 + g0 * v0; x1 = x1 + g1 * v1;
    if (layer == 3) { float* dst = (float*)(A.ws + WS_SCR + F_PQX) + ((size_t)b * TL + tt * 256 + row_l) * DM + col; *(f32x4*)dst = x0; *(f32x4*)(dst + 4) = x1; }
    else st_bf16x8(XB + roff, x0, x1);
}

DI void fnet_layer(const Args& A, LAS unsigned char* lds, const XcdBarrier& gbar, int layer, int j, bool latonly, int wv) {
    unsigned char* ws = A.ws;
    const bf16_t* H = (const bf16_t*)(ws + WS_H); bf16_t* U = (bf16_t*)(ws + WS_H);
    bf16_t* Gt = (bf16_t*)(ws + WS_SCR + F_G); bf16_t* PQX = (bf16_t*)(ws + WS_SCR + F_PQX); bf16_t* PQC = (bf16_t*)(ws + WS_SCR + F_PQC);
    norm_phase(A, layer, latonly, wv);
    xcd_barrier(gbar, wv);
    {
        DescPlain D; D.init(H, (const bf16_t*)(ws + WS_WFG) + (size_t)j * DM * DM, 8, latonly);
        auto E = [=](const pg8::Unit& u, int row_l, int col_l, f32x4 v0, f32x4 v1) {
            f32x4 a, b;
#pragma unroll
            for (int q = 0; q < 4; ++q) { a[q] = siluf(v0[q]); b[q] = siluf(v1[q]); }
            st_bf16x8(Gt + ((size_t)u.i0 * 256 + row_l) * DM + u.i1 * 256 + col_l, a, b);
        };
        pg8::gemm_phase(lds, D, E, wv);
    }
    {
        DescChan D; D.init((const bf16_t*)(ws + WS_DC), H, latonly);
        auto E = [=](const pg8::Unit& u, int row_l, int col_l, f32x4 v0, f32x4 v1) {
            const int b = u.i0 >> 2, g = u.i0 & 3, mt = u.i1, half = mt >> 1, ch = g * 512 + (mt & 1) * 256 + row_l;
            bf16_t* dst = (u.i2 < 8) ? PQX + ((size_t)b * DM + ch) * 4096 + half * 2048 + u.i2 * 256 + col_l
                                     : PQC + ((size_t)b * DM + ch) * 512 + half * 256 + col_l;
            st_bf16x8(dst, v0, v1);
        };
        pg8::gemm_phase(lds, D, E, wv);
    }
    xcd_barrier(gbar, wv);
    bf16_t* A1 = (bf16_t*)(ws + WS_SCR + F_A1); float* NYQ = (float*)(ws + WS_SCR + F_NYQ);
    {
        const int tid = otid(wv), lane = tid & 63;
        for (int rr = blockIdx.x * NWAVES + wv; rr < NB * DM; rr += gridDim.x * NWAVES) {
            const bf16_t* pr = PQX + (size_t)rr * 4096; float acc = 0.f;
#pragma unroll
            for (int q = 0; q < 4; ++q) { f32x4 a, b; ld_bf16x8(pr + (q * 64 + lane) * 8, a, b); acc += (a[0] - a[1]) + (a[2] - a[3]) + (b[0] - b[1]) + (b[2] - b[3]); }
            acc = wave_sum(acc);
            if (lane == 0) NYQ[rr] = acc * 0.022097086912079608f;
        }
    }
    {
        DescT D; D.init((const bf16_t*)(ws + WS_DT), PQX, 4096, 2048, 0, 4);
        auto E = [=](const pg8::Unit& u, int row_l, int col_l, f32x4 v0, f32x4 v1) {
            st_bf16x8(A1 + ((size_t)u.i0 * 1024 + u.i1 * 256 + row_l) * DM + u.i2 * 256 + col_l, v0, v1);
        };
        pg8::gemm_phase(lds, D, E, wv);
    }
    xcd_barrier(gbar, wv);
    {
        DescT D; D.init((const bf16_t*)(ws + WS_DT), PQX, 4096, 2048, 2048, 4);
        auto E = [=](const pg8::Unit& u, int row_l, int col_l, f32x4 v0, f32x4 v1) {
            const int k = u.i1 * 256 + row_l, col = u.i2 * 256 + col_l;
            f32x4 a0, a1; ld_bf16x8(A1 + ((size_t)u.i0 * 1024 + k) * DM + col, a0, a1);
            const size_t off = ((size_t)u.i0 * TB + k) * DM + col;
            f32x4 g0, g1; ld_bf16x8(Gt + off, g0, g1);
            st_bf16x8(U + off, (a0 + v0) * g0, (a1 + v1) * g1);
            const size_t off2 = ((size_t)u.i0 * TB + (k == 0 ? 1024 : TL - k)) * DM + col;
            ld_bf16x8(Gt + off2, g0, g1);
            if (k == 0) { const float* nq = NYQ + (size_t)u.i0 * DM + col; a0 = *(const f32x4*)nq; a1 = *(const f32x4*)(nq + 4); v0 = (f32x4){0.f, 0.f, 0.f, 0.f}; v1 = v0; }
            st_bf16x8(U + off2, (a0 - v0) * g0, (a1 - v1) * g1);
        };
        pg8::gemm_phase(lds, D, E, wv);
    }
    if (!latonly) {
        DescT D; D.init((const bf16_t*)(ws + WS_DT2), PQC, 512, 512, 0, 1);
        auto E = [=](const pg8::Unit& u, int row_l, int col_l, f32x4 v0, f32x4 v1) {
            const size_t off = ((size_t)u.i0 * TB + TL + row_l) * DM + u.i2 * 256 + col_l;
            f32x4 g0, g1; ld_bf16x8(Gt + off, g0, g1);
            st_bf16x8(U + off, v0 * g0, v1 * g1);
        };
        pg8::gemm_phase(lds, D, E, wv);
    }
    xcd_barrier(gbar, wv);
    {
        DescPlain D; D.init(U, (const bf16_t*)(ws + WS_WFO) + (size_t)j * DM * DM, 8, latonly);
        const float* modl = (const float*)(ws + WS_MOD) + (size_t)layer * 17 * MOD_LD;
        auto E = [=](const pg8::Unit& u, int row_l, int col_l, f32x4 v0, f32x4 v1) { resid_store(A, layer, u.i0, row_l, u.i1 * 256 + col_l, modl, v0, v1); };
        pg8::gemm_phase(lds, D, E, wv);
    }
    xcd_barrier(gbar, wv);
}


namespace att {
constexpr int D = 128, NW = 8, QBLK = 32, KVBLK = 64;
constexpr float SCALE = 0.088388347648318440f;
constexpr float THR = 8.f;
constexpr int LDQ = 2048, LDK = 512;
constexpr size_t SHM_V = KVBLK * D * 2, SHM_K = KVBLK * D * 2;
typedef float f32x8 __attribute__((ext_vector_type(8)));
#define KSWZ(row, colB) ((row) * 256 + ((colB) ^ (((row) & 7) << 4)))
#define SBAR() __builtin_amdgcn_sched_barrier(0)
DI int crow(int r, int hi) { return (r & 3) + 8 * (r >> 2) + 4 * hi; }
DI unsigned cvtpk(float lo, float hi) { unsigned r; asm volatile("v_cvt_pk_bf16_f32 %0, %1, %2" : "=v"(r) : "v"(lo), "v"(hi)); return r; }
DI void partialSM(f32x16& p0, f32x16& p1, float& m_reg, float& mn, float& alpha) {
  constexpr float C = SCALE * 1.4426950408889634f;
  float pmax = p0[0];
#pragma unroll
  for (int r = 1; r < 16; ++r) pmax = fmaxf(pmax, p0[r]);
#pragma unroll
  for (int r = 0; r < 16; ++r) pmax = fmaxf(pmax, p1[r]);
  { auto rr = __builtin_amdgcn_permlane32_swap(__float_as_uint(pmax), __float_as_uint(pmax), false, false);
    pmax = fmaxf(__uint_as_float(rr[0]), __uint_as_float(rr[1])); }
  if (__builtin_expect(__all(pmax - m_reg <= THR / SCALE), 1)) { mn = m_reg; alpha = 1.f; }
  else { mn = fmaxf(m_reg, pmax); alpha = __builtin_amdgcn_exp2f((m_reg - mn) * C); m_reg = mn; }
  float mnC = -mn * C;
#pragma unroll
  for (int r = 0; r < 16; ++r) p0[r] = fmaf(p0[r], C, mnC);
#pragma unroll
  for (int r = 0; r < 16; ++r) p1[r] = fmaf(p1[r], C, mnC);
#pragma unroll
  for (int r = 0; r < 16; ++r) p0[r] = __builtin_amdgcn_exp2f(p0[r]);
}
DI void finishSM(f32x16& p0, f32x16& p1, float alpha, float& l_reg, bf16x8& pa0, bf16x8& pa1, bf16x8& pa2, bf16x8& pa3) {
#pragma unroll
  for (int r = 0; r < 16; ++r) p1[r] = __builtin_amdgcn_exp2f(p1[r]);
  float ps = 0;
#pragma unroll
  for (int r = 0; r < 16; ++r) ps += p0[r];
#pragma unroll
  for (int r = 0; r < 16; ++r) ps += p1[r];
  { auto rr = __builtin_amdgcn_permlane32_swap(__float_as_uint(ps), __float_as_uint(ps), false, false);
    ps = __uint_as_float(rr[0]) + __uint_as_float(rr[1]); }
  l_reg = l_reg * alpha + ps;
#define PK4(P, BASE, OUT) do { unsigned a0 = cvtpk(P[BASE + 0], P[BASE + 1]), a1 = cvtpk(P[BASE + 2], P[BASE + 3]);   \
    unsigned b0 = cvtpk(P[BASE + 4], P[BASE + 5]), b1 = cvtpk(P[BASE + 6], P[BASE + 7]);                              \
    auto r0 = __builtin_amdgcn_permlane32_swap(a0, b0, false, false); auto r1 = __builtin_amdgcn_permlane32_swap(a1, b1, false, false); \
    u32x4 w = {r0[0], r1[0], r0[1], r1[1]}; OUT = *reinterpret_cast<bf16x8*>(&w); } while (0)
  PK4(p0, 0, pa0); PK4(p0, 8, pa1); PK4(p1, 0, pa2); PK4(p1, 8, pa3);
#undef PK4
}
DI void qkt(f32x16& p0, f32x16& p1, const bf16_t* Ks, const bf16x8* qr, int r32, int hi) {
  p0 = f32x16{}; p1 = f32x16{};
#pragma unroll
  for (int d0 = 0; d0 < 8; ++d0) { int cb = (d0 * 16 + hi * 8) * 2;
    bf16x8 b0 = *reinterpret_cast<const bf16x8*>((const char*)Ks + KSWZ(r32, cb));
    bf16x8 b1 = *reinterpret_cast<const bf16x8*>((const char*)Ks + KSWZ(32 + r32, cb));
    p0 = __builtin_amdgcn_mfma_f32_32x32x16_bf16(b0, qr[d0], p0, 0, 0, 0);
    p1 = __builtin_amdgcn_mfma_f32_32x32x16_bf16(b1, qr[d0], p1, 0, 0, 0); }
}
DI int v_st(int k, int c) { const int kk = (k & ~0xC) | ((k & 4) << 1) | ((k & 8) >> 1); return ((kk >> 3) * 4 + (c >> 5)) * 512 + ((kk & 7) * 32 + (c & 31)) * 2; }
DI int v_rd_base(int lane) { return ((lane & 3) << 3) | (((lane >> 2) & 3) << 6) | (((lane >> 4) & 1) << 5) | (((lane >> 5) & 1) << 8); }
constexpr int v_rd_off(int d0, int ks, int half) { return d0 * 512 + ks * 4096 + half * 2048; }
template <int OFF> DI s16x4 tr_read(int vb) {
  s16x4 r; asm volatile("ds_read_b64_tr_b16 %0, %1 offset:%2" : "=&v"(r) : "v"(vb), "i"(OFF) : "memory"); return r;
}
template <int D0> DI void pv_one(f32x16& od, int vb, bf16x8 pa0, bf16x8 pa1, bf16x8 pa2, bf16x8 pa3) {
  const s16x4 l0 = tr_read<v_rd_off(D0, 0, 0)>(vb), h0 = tr_read<v_rd_off(D0, 0, 1)>(vb), l1 = tr_read<v_rd_off(D0, 1, 0)>(vb), h1 = tr_read<v_rd_off(D0, 1, 1)>(vb);
  const s16x4 l2 = tr_read<v_rd_off(D0, 2, 0)>(vb), h2 = tr_read<v_rd_off(D0, 2, 1)>(vb), l3 = tr_read<v_rd_off(D0, 3, 0)>(vb), h3 = tr_read<v_rd_off(D0, 3, 1)>(vb);
  asm volatile("s_waitcnt lgkmcnt(0)" ::: "memory"); SBAR();
#define PK(L, H) (bf16x8){L[0], L[1], L[2], L[3], H[0], H[1], H[2], H[3]}
  od = __builtin_amdgcn_mfma_f32_32x32x16_bf16(pa0, PK(l0, h0), od, 0, 0, 0);
  od = __builtin_amdgcn_mfma_f32_32x32x16_bf16(pa1, PK(l1, h1), od, 0, 0, 0);
  od = __builtin_amdgcn_mfma_f32_32x32x16_bf16(pa2, PK(l2, h2), od, 0, 0, 0);
  od = __builtin_amdgcn_mfma_f32_32x32x16_bf16(pa3, PK(l3, h3), od, 0, 0, 0);
#undef PK
}
DI void pv_d0(f32x16* o, int vb, bf16x8 pa0, bf16x8 pa1, bf16x8 pa2, bf16x8 pa3) {
  pv_one<0>(o[0], vb, pa0, pa1, pa2, pa3); pv_one<1>(o[1], vb, pa0, pa1, pa2, pa3); pv_one<2>(o[2], vb, pa0, pa1, pa2, pa3); pv_one<3>(o[3], vb, pa0, pa1, pa2, pa3);
}
DI void attn_dense_body(const bf16_t* __restrict__ Qb, const bf16_t* __restrict__ Kh, const bf16_t* __restrict__ Vh, const bf16_t* SZb, bf16_t* Ub, int seq, char* lds, int wv) {
  const int tid = otid(wv), wid = tid >> 6, lane = tid & 63, r32 = lane & 31, hi = lane >> 5;
  bf16_t* V_lds = (bf16_t*)lds; bf16_t* K_lds = (bf16_t*)(lds + 2 * SHM_V);
  float* wsf = (float*)(lds + 2 * SHM_V + 2 * SHM_K) + wid * 64; float* li_l = wsf; float* al_l = wsf + 32;
  float m_reg = -1e30f, l_reg = 0; f32x16 o[4] = {}; bf16x8 qr[8];
  const bf16_t* Qw = Qb + (long)(wid * QBLK + r32) * LDQ + hi * 8;
#pragma unroll
  for (int d0 = 0; d0 < 8; ++d0) qr[d0] = *reinterpret_cast<const bf16x8*>(Qw + d0 * 16);
  const int sr = tid >> 4, sc = (tid & 15) * 8, vst0 = v_st(sr, sc), vst1 = v_st(32 + sr, sc);
  const int vb0 = (int)(uintptr_t)V_lds + v_rd_base(lane);
  struct { bf16x8 vs0, vs1, ks0, ks1; } sr_[2];
#define SLOAD(i, k0) do { sr_[i].vs0 = *reinterpret_cast<const bf16x8*>(&Vh[(long)((k0) + sr) * LDK + sc]); sr_[i].vs1 = *reinterpret_cast<const bf16x8*>(&Vh[(long)((k0) + 32 + sr) * LDK + sc]); \
    sr_[i].ks0 = *reinterpret_cast<const bf16x8*>(&Kh[(long)((k0) + sr) * LDK + sc]); sr_[i].ks1 = *reinterpret_cast<const bf16x8*>(&Kh[(long)((k0) + 32 + sr) * LDK + sc]); } while (0)
#define SWRITE(b, i) do { *(bf16x8*)((char*)V_lds + (b) * SHM_V + vst0) = sr_[i].vs0;          \
    *(bf16x8*)((char*)V_lds + (b) * SHM_V + vst1) = sr_[i].vs1; int kc = sc * 2;               \
    *(bf16x8*)((char*)K_lds + (b) * SHM_K + KSWZ(sr, kc)) = sr_[i].ks0;                       \
    *(bf16x8*)((char*)K_lds + (b) * SHM_K + KSWZ(32 + sr, kc)) = sr_[i].ks1; } while (0)
#define SWAIT() asm volatile("s_waitcnt vmcnt(4)" ::: "memory")
#define RESC(a) do { if (__any((a) < 1.f)) { if (hi == 0) al_l[r32] = (a); asm volatile("s_waitcnt lgkmcnt(0)" ::: "memory"); \
    _Pragma("unroll") for (int d = 0; d < 4; ++d) _Pragma("unroll") for (int r = 0; r < 16; ++r) o[d][r] *= al_l[crow(r, hi)]; } } while (0)
  f32x16 pA0, pA1, pB0, pB1; float mnA, mnB, alA, alB; bf16x8 pa0, pa1, pa2, pa3; const int NT = seq / KVBLK;
  constexpr int SE = 0, SO = 1;
  SLOAD(SE, 0); asm volatile("s_waitcnt vmcnt(0)" ::: "memory"); SWRITE(0, SE); __syncthreads();
  qkt(pA0, pA1, K_lds, qr, r32, hi); partialSM(pA0, pA1, m_reg, mnA, alA);
  SLOAD(SO, KVBLK); if (2 < NT) SLOAD(SE, 2 * KVBLK);
  SWAIT(); SWRITE(1, SO); __syncthreads();
  for (int j = 1; j + 1 < NT; j += 2) {
    SBAR(); qkt(pB0, pB1, (bf16_t*)((char*)K_lds + SHM_K), qr, r32, hi);
    finishSM(pA0, pA1, alA, l_reg, pa0, pa1, pa2, pa3); SBAR();
    SLOAD(SO, (j + 2) * KVBLK); SBAR();
    pv_d0(o, vb0, pa0, pa1, pa2, pa3); partialSM(pB0, pB1, m_reg, mnB, alB);
    __syncthreads(); SWAIT(); SWRITE(0, SE);
    RESC(alB); __syncthreads();
    SBAR(); qkt(pA0, pA1, K_lds, qr, r32, hi);
    finishSM(pB0, pB1, alB, l_reg, pa0, pa1, pa2, pa3); SBAR();
    if (j + 3 < NT) SLOAD(SE, (j + 3) * KVBLK); SBAR();
    pv_d0(o, vb0 + (int)SHM_V, pa0, pa1, pa2, pa3); partialSM(pA0, pA1, m_reg, mnA, alA);
    __syncthreads(); SWAIT(); SWRITE(1, SO);
    RESC(alA); __syncthreads();
  }
  SBAR(); qkt(pB0, pB1, (bf16_t*)((char*)K_lds + SHM_K), qr, r32, hi);
  finishSM(pA0, pA1, alA, l_reg, pa0, pa1, pa2, pa3); SBAR();
  pv_d0(o, vb0, pa0, pa1, pa2, pa3); partialSM(pB0, pB1, m_reg, mnB, alB);
  __syncthreads(); RESC(alB);
  finishSM(pB0, pB1, alB, l_reg, pa0, pa1, pa2, pa3); SBAR();
  pv_d0(o, vb0 + (int)SHM_V, pa0, pa1, pa2, pa3);
  u32x4 zq[8];
#pragma unroll
  for (int i = 0; i < 8; ++i) { const int id = tid + 512 * i; zq[i] = *(const u32x4*)(SZb + (long)(id >> 4) * LDQ + (id & 15) * 8); }
  if (hi == 0) li_l[r32] = l_reg; asm volatile("s_waitcnt lgkmcnt(0)" ::: "memory");
  __syncthreads();
  {
    float rli[16];
#pragma unroll
    for (int r = 0; r < 16; ++r) rli[r] = __builtin_amdgcn_rcpf(li_l[crow(r, hi)]);
    char* ost = lds;
#pragma unroll
    for (int r = 0; r < 16; ++r) { char* rowp = ost + (wid * QBLK + crow(r, hi)) * 256 + r32 * 2;
#pragma unroll
      for (int d0 = 0; d0 < 4; ++d0) *(unsigned short*)(rowp + d0 * 64) = (unsigned short)(pk2(o[d0][r] * rli[r], 0.f) & 0xffffu); }
  }
  __syncthreads();
#pragma unroll
  for (int i = 0; i < 8; ++i) { const int id = tid + 512 * i; const int row = id >> 4, ch = id & 15;
    const u32x4 ov = *(const u32x4*)(lds + row * 256 + ch * 16);
    f32x4 a0 = {bf_lo(ov.x), bf_hi(ov.x), bf_lo(ov.y), bf_hi(ov.y)}, a1 = {bf_lo(ov.z), bf_hi(ov.z), bf_lo(ov.w), bf_hi(ov.w)};
    const f32x4 z0 = {bf_lo(zq[i].x), bf_hi(zq[i].x), bf_lo(zq[i].y), bf_hi(zq[i].y)}, z1 = {bf_lo(zq[i].z), bf_hi(zq[i].z), bf_lo(zq[i].w), bf_hi(zq[i].w)};
    st_bf16x8(Ub + (long)row * LDQ + ch * 8, a0 * z0, a1 * z1); }
  __syncthreads();
#undef SLOAD
#undef SWRITE
#undef SWAIT
#undef RESC
}
#undef KSWZ
#undef SBAR
}

DI void qknorm_phase(const Args& A, LAS unsigned char* lds, int wv) {
    const int tid = otid(wv), lane = tid & 63, wave = tid >> 6, G = gridDim.x;
    bf16_t* Q = (bf16_t*)(A.ws + WS_SCR + A_Q); bf16_t* Kb = (bf16_t*)(A.ws + WS_SCR + A_K);
    const float* qn = A.in[14]; const float* kn = A.in[15];
    const int sub = lane >> 4, l16 = lane & 15, e0 = l16 * 8;
    LAS f32x2* rope = (LAS f32x2*)lds;
    for (int e = tid; e < 2048; e += NTHREADS) { const float ang = (float)(e >> 5) * exp2f(-(float)(e & 31) * 0.41524101186092029f); rope[e] = (f32x2){cosf(ang), sinf(ang)}; }
    __syncthreads();
    const long NIT = (long)NTOK * 20;
    for (long it0 = ((long)blockIdx.x * NWAVES + wave) * 16 + sub; it0 < NIT; it0 += (long)G * NWAVES * 16) {
        bf16_t* pq[4]; u32x4 raw[4];
#pragma unroll
        for (int k = 0; k < 4; ++k) { const long it = it0 + 4 * k; const int row = (int)(it / 20), hj = (int)(it % 20);
            pq[k] = (hj < 16) ? Q + (size_t)row * 2048 + hj * 128 + e0 : Kb + (size_t)row * 512 + (hj - 16) * 128 + e0;
            raw[k] = *(const u32x4*)pq[k]; }
#pragma unroll
        for (int k = 0; k < 4; ++k) {
            const long it = it0 + 4 * k; const int row = (int)(it / 20), hj = (int)(it % 20);
            const float* wn = (hj < 16 ? qn : kn) + e0;
            f32x4 a = {bf_lo(raw[k].x), bf_hi(raw[k].x), bf_lo(raw[k].y), bf_hi(raw[k].y)}, b = {bf_lo(raw[k].z), bf_hi(raw[k].z), bf_lo(raw[k].w), bf_hi(raw[k].w)};
            float ss = 0.f;
#pragma unroll
            for (int q = 0; q < 4; ++q) ss += a[q] * a[q] + b[q] * b[q];
            ss += __shfl_xor(ss, 1); ss += __shfl_xor(ss, 2); ss += __shfl_xor(ss, 4); ss += __shfl_xor(ss, 8);
            const float rs = 1.0f / sqrtf(ss * (1.f / 128.f) + EPS);
            const f32x4 w0 = *(const f32x4*)wn, w1 = *(const f32x4*)(wn + 4);
            a = a * rs * w0; b = b * rs * w1;
            const int t = row % TB;
            if (t < TL) {
                const int pos = (l16 < 8) ? (t >> 6) : (t & 63);
                float y[8] = {a[0], a[1], a[2], a[3], b[0], b[1], b[2], b[3]};
                const LAS f32x4* rp = (const LAS f32x4*)(rope + pos * 32 + ((4 * l16) & 31));
                const f32x4 c01 = rp[0], c23 = rp[1];
                const float cs[4] = {c01[0], c01[2], c23[0], c23[2]}, sn[4] = {c01[1], c01[3], c23[1], c23[3]};
#pragma unroll
                for (int pp = 0; pp < 4; ++pp) {
                    const float x0 = y[2 * pp], x1 = y[2 * pp + 1];
                    y[2 * pp] = x0 * cs[pp] - x1 * sn[pp]; y[2 * pp + 1] = x0 * sn[pp] + x1 * cs[pp];
                }
                a = (f32x4){y[0], y[1], y[2], y[3]}; b = (f32x4){y[4], y[5], y[6], y[7]};
            }
            st_bf16x8(pq[k], a, b);
        }
    }
}

DI void attn_layer(const Args& A, LAS unsigned char* lds, char* lds_gen, const XcdBarrier& gbar, int layer, int wv) {
    unsigned char* ws = A.ws;
    const bf16_t* H = (const bf16_t*)(ws + WS_H); bf16_t* U = (bf16_t*)(ws + WS_H);
    bf16_t* Q = (bf16_t*)(ws + WS_SCR + A_Q); bf16_t* Kb = (bf16_t*)(ws + WS_SCR + A_K); bf16_t* Vb = (bf16_t*)(ws + WS_SCR + A_V); bf16_t* SZ = (bf16_t*)(ws + WS_SCR + A_SZ);
    norm_phase(A, layer, false, wv);
    xcd_barrier(gbar, wv);
    {
        DescPlain D; D.init(H, (const bf16_t*)(ws + WS_WAI), 20, false);
        auto E = [=](const pg8::Unit& u, int row_l, int col_l, f32x4 v0, f32x4 v1) {
            const size_t row = (size_t)u.i0 * 256 + row_l; const int pn = u.i1;
            if (pn < 8) st_bf16x8(Q + row * 2048 + pn * 256 + col_l, v0, v1);
            else if (pn < 10) st_bf16x8(Kb + row * 512 + (pn - 8) * 256 + col_l, v0, v1);
            else if (pn < 12) st_bf16x8(Vb + row * 512 + (pn - 10) * 256 + col_l, v0, v1);
            else { f32x4 a, b;
#pragma unroll
                for (int q = 0; q < 4; ++q) { a[q] = siluf(v0[q]); b[q] = siluf(v1[q]); }
                st_bf16x8(SZ + row * 2048 + (pn - 12) * 256 + col_l, a, b); }
        };
        pg8::gemm_phase(lds, D, E, wv);
    }
    xcd_barrier(gbar, wv);
    qknorm_phase(A, lds, wv);
    xcd_barrier(gbar, wv);
    {
        const int G = gridDim.x, c = blockIdx.x;
        for (long L = c; L < 2048; L += G) {
            const int u = pg8::xcd_remap((int)L, 2048);
            const int b = u / 128, rem = u % 128, kvh = rem / 32, g = (rem / 8) % 4, qb = rem % 8, h = kvh * 4 + g;
            const size_t qoff = ((size_t)b * TB + qb * 256) * 2048 + h * 128, koff = ((size_t)b * TB) * 512 + kvh * 128;
            att::attn_dense_body(Q + qoff, Kb + koff, Vb + koff, SZ + qoff, U + qoff, TB, lds_gen, wv);
        }
        for (int u = c; u < 256; u += G) {
            const int b = u / 16, h = u % 16, kvh = h / 4;
            const size_t qoff = ((size_t)b * TB + TL) * 2048 + h * 128, koff = ((size_t)b * TB + TL) * 512 + kvh * 128;
            att::attn_dense_body(Q + qoff, Kb + koff, Vb + koff, SZ + qoff, U + qoff, TC, lds_gen, wv);
        }
    }
    xcd_barrier(gbar, wv);
    {
        DescPlain D; D.init(U, (const bf16_t*)(ws + WS_WAO), 8, false);
        const float* modl = (const float*)(ws + WS_MOD) + (size_t)layer * 17 * MOD_LD;
        auto E = [=](const pg8::Unit& u, int row_l, int col_l, f32x4 v0, f32x4 v1) { resid_store(A, layer, u.i0, row_l, u.i1 * 256 + col_l, modl, v0, v1); };
        pg8::gemm_phase(lds, D, E, wv);
    }
    xcd_barrier(gbar, wv);
}


struct DescM1 {
    const bf16_t* H; const bf16_t* WA; const bf16_t* WB; int lda, ldb, K, total;
    DI void init(const bf16_t* H_, const bf16_t* WA_, const bf16_t* WB_) { H = H_; WA = WA_; WB = WB_; lda = DM; ldb = DM; K = DM; total = 144 * 9 + 12 * 144; }
    DI pg8::Unit unit(int idx) const {
        pg8::Unit u;
        if (idx < 1296) { const int nig = 72, gid = idx / nig, pm = gid * 8 + (idx % nig) % 8, pn = (idx % nig) / 8;
            u.a = (const char*)(H + (size_t)pm * 256 * DM); u.b = (const char*)(WA + (size_t)pn * 256 * DM); u.i0 = pm; u.i1 = pn; u.i2 = 0; }
        else { const int j = idx - 1296, mt = j % 12, nt = j / 12;
            u.a = (const char*)(WB + (size_t)mt * 256 * DM); u.b = (const char*)(H + (size_t)nt * 256 * DM); u.i0 = mt; u.i1 = nt; u.i2 = 1; }
        return u;
    }
};
namespace ml {
#define MFMA32(a, b, c) __builtin_amdgcn_mfma_f32_32x32x16_bf16((a), (b), (c), 0, 0, 0)
#define LFENCE() asm volatile("s_waitcnt lgkmcnt(0)" ::: "memory")
DI int crow(int reg, int h) { return (reg & 3) + 8 * (reg >> 2) + 4 * h; }
DI bf16x8 ldperm(const bf16_t* p) { const s16x4 lo = *(const s16x4*)p, hi = *(const s16x4*)(p + 8); return __builtin_shufflevector(lo, hi, 0, 1, 2, 3, 4, 5, 6, 7); }
DI bf16x8 pack_step(const f32x16& x, int s) { u32x4 p = {pk2(x[8 * s], x[8 * s + 1]), pk2(x[8 * s + 2], x[8 * s + 3]), pk2(x[8 * s + 4], x[8 * s + 5]), pk2(x[8 * s + 6], x[8 * s + 7])}; return __builtin_bit_cast(bf16x8, p); }
DI float bfs(short h) { return __uint_as_float(((unsigned)(unsigned short)h) << 16); }

constexpr int SC_Q = 0, SC_K = 16384, SC_KT = 32768, SC_BUF = 49152, SC_WAVE = 2 * SC_BUF, SC_WAVE_BYTES = 6144;
DI bf16x8 ldsfrag(const LAS unsigned char* buf, unsigned o) { const s16x4 lo = *(const LAS s16x4*)(buf + o), hi = *(const LAS s16x4*)(buf + (o ^ 16u)); return __builtin_shufflevector(lo, hi, 0, 1, 2, 3, 4, 5, 6, 7); }
DI void scan_phase(const Args& A, LAS unsigned char* lds, int wv) {
    const int wave = wv;
    LAS float* wl = (LAS float*)(lds + SC_WAVE + wave * SC_WAVE_BYTES);
    LAS unsigned char* hst = lds + SC_WAVE + wave * SC_WAVE_BYTES + 2048;
    unsigned char* ws = A.ws;
    const bf16_t* Qg = (const bf16_t*)(ws + WS_SCR + M_Q); const bf16_t* Kg = (const bf16_t*)(ws + WS_SCR + M_K); const bf16_t* KVT = (const bf16_t*)(ws + WS_SCR + M_KVT);
    const float* G32 = (const float*)(ws + WS_SCR + M_G32); const float* bg = A.in[10];
#define SC_POS0(j) (dir == 0 ? ((j) < 4 ? TL + 64 * (j) : 64 * ((j) - 4)) : ((j) < 4 ? TL + 64 * (3 - (j)) : 64 * (35 - (j))))
#define SC_DMA(bufi, p0) do { const int tj_ = otid(wv); _Pragma("unroll") for (int i_ = 0; i_ < 2; ++i_) { const int sl_ = i_ * 512 + tj_; \
        { const int row_ = sl_ >> 4, c_ = (sl_ & 15) ^ (row_ & 15); const size_t go_ = (size_t)((p0) + row_) * 1024 + c_ * 8; \
          __builtin_amdgcn_global_load_lds((const unsigned*)(Qu + go_), (LAS unsigned*)(lds + (bufi) * SC_BUF + SC_Q + i_ * 8192 + wave * 1024), 16, 0, 0); \
          __builtin_amdgcn_global_load_lds((const unsigned*)(Ku + go_), (LAS unsigned*)(lds + (bufi) * SC_BUF + SC_K + i_ * 8192 + wave * 1024), 16, 0, 0); } \
        { const int d_ = sl_ >> 3, c_ = (sl_ & 7) ^ ((d_ >> 1) & 7); \
          __builtin_amdgcn_global_load_lds((const unsigned*)(KTu + (size_t)d_ * TB + (p0) + c_ * 8), (LAS unsigned*)(lds + (bufi) * SC_BUF + SC_KT + i_ * 8192 + wave * 1024), 16, 0, 0); } } } while (0)
    for (int item = blockIdx.x; item < 256; item += gridDim.x) {
        const int dir = item & 1, h = (item >> 1) & 7, b = item >> 4, e0 = wave * 32;
        const bf16_t* Qu = Qg + (size_t)b * TB * 1024 + h * 128;
        const bf16_t* Ku = Kg + (size_t)b * TB * 1024 + h * 128;
        const bf16_t* KTu = KVT + ((size_t)b * 3072 + h * 128) * TB;
        const bf16_t* VTu = KVT + ((size_t)b * 3072 + 1024 + h * 256 + e0) * TB;
        bf16_t* Hout = (bf16_t*)(ws + WS_SCR + (dir ? M_HB : M_HF)) + (size_t)b * TB * DM + h * 256 + e0;
        const float big = bg[(dir * 2) * 8 + h], bfg = bg[(dir * 2 + 1) * 8 + h];
        f32x16 cacc[4];
#pragma unroll
        for (int d = 0; d < 4; ++d)
#pragma unroll
            for (int i = 0; i < 16; ++i) cacc[d][i] = 0.f;
        float m = 0.f;
        { const int l0 = otid(wv) & 63; wl[384 + l0] = 0.f; wl[448 + l0] = 0.f; }
        LFENCE();
        SC_DMA(0, SC_POS0(0));
        float ig_n, fg_n;
        { const int l0 = otid(wv) & 63; const float* gp = G32 + (size_t)(b * TB + SC_POS0(0) + (dir ? 63 - l0 : l0)) * 32 + (dir * 2) * 8 + h; ig_n = gp[0]; fg_n = gp[8]; }
        for (int j = 0; j < 36; ++j) {
            const int pos0 = SC_POS0(j);
            const LAS unsigned char* Qb = lds + (j & 1) * SC_BUF + SC_Q; const LAS unsigned char* Kb = lds + (j & 1) * SC_BUF + SC_K; const LAS unsigned char* KTb = lds + (j & 1) * SC_BUF + SC_KT;
            asm volatile("s_waitcnt vmcnt(0)" ::: "memory"); __builtin_amdgcn_s_barrier(); asm volatile("" ::: "memory");
            if (j + 1 < 36) SC_DMA((j + 1) & 1, SC_POS0(j + 1));
            const int lj = otid(wv) & 63, rj = lj & 31, h4 = (lj >> 5) * 4;
            LAS float* wh = wl + h4; LAS float* wr = wl + rj; LAS unsigned char* hb = hst + h4 * 64 + rj * 2;
            const unsigned xr = rj & 15, xd = (rj >> 1) & 7;
            const unsigned qro = (unsigned)rj * 256u + 2u * h4;
            const unsigned kro = (unsigned)rj * 128u + 2u * h4;
            const bf16_t* VTp = VTu + (size_t)rj * TB + pos0 + h4;
            bf16x8 vf[4];
#pragma unroll
            for (int kk = 0; kk < 4; ++kk) vf[kk] = ldperm(VTp + 16 * kk);
            float decay, m_new;
            {
                const int s = dir ? 63 - lj : lj;
                const float ig = ig_n + big, fg = fg_n + bfg;
                if (j + 1 < 36) { const float* gp = G32 + (size_t)(b * TB + SC_POS0(j + 1) + s) * 32 + (dir * 2) * 8 + h; ig_n = gp[0]; fg_n = gp[8]; }
                const float lf = fminf(fg, 0.f) - log1pf(__expf(-fabsf(fg)));
                float bs = lf;
#pragma unroll
                for (int o = 1; o < 64; o <<= 1) { const float t = __shfl_up(bs, o); if (lj >= o) bs += t; }
                const float uu = ig - bs;
                float pmx = uu;
#pragma unroll
                for (int o = 1; o < 64; o <<= 1) { const float t = __shfl_up(pmx, o); if (lj >= o) pmx = fmaxf(pmx, t); }
                pmx = fmaxf(pmx, m);
                const float b_end = __shfl(bs, 63), pm_last = __shfl(pmx, 63);
                LAS float* ws_ = wl + s;
                ws_[0] = uu * 1.4426950408889634f; ws_[64] = pmx * 1.4426950408889634f; ws_[128] = __expf(m - pmx); ws_[192] = __expf(-(bs + pmx)); ws_[256] = __expf(uu - pm_last);
                decay = __expf(m - pm_last); m_new = b_end + pm_last;
            }
            LFENCE();
            const int sbase = dir ? 63 - h4 : h4, sgn = dir ? -1 : 1;
#pragma unroll
            for (int tb = 0; tb < 2; ++tb) {
                __builtin_amdgcn_sched_barrier(0);
                const unsigned qo = qro + tb * 8192u;
                f32x16 ha;
#pragma unroll
                for (int i = 0; i < 16; ++i) ha[i] = 0.f;
                float qnv = 0.f;
#pragma unroll
                for (int kk = 0; kk < 8; ++kk) {
                    const bf16x8 qa = ldsfrag(Qb, qo + (((2u * kk) ^ xr) << 4));
                    ha = MFMA32(qa, pack_step(cacc[kk >> 1], kk & 1), ha);
                    const f32x4 n0 = *(const LAS f32x4*)(wh + 384 + 16 * kk), n1 = *(const LAS f32x4*)(wh + 384 + 16 * kk + 8);
#pragma unroll
                    for (int jj = 0; jj < 4; ++jj) qnv += bfs(qa[jj]) * n0[jj] + bfs(qa[4 + jj]) * n1[jj];
                }
                qnv += __shfl_xor(qnv, 32);
#pragma unroll
                for (int g = 0; g < 4; ++g) { const f32x4 av = *(const LAS f32x4*)(wh + 128 + 32 * tb + 8 * g);
#pragma unroll
                    for (int q = 0; q < 4; ++q) ha[4 * g + q] *= av[q]; }
                const float pmt = wr[64 + 32 * tb];
                const int tp = dir ? (63 - 32 * tb) - rj : 32 * tb + rj;
                float ds = 0.f;
#pragma unroll
                for (int sb = 0; sb < 2; ++sb) {
                    __builtin_amdgcn_sched_barrier(0);
                    if (sb != tb && (dir ? sb < tb : sb > tb)) continue;
                    const unsigned ko = qro + sb * 8192u;
                    f32x16 st;
#pragma unroll
                    for (int i = 0; i < 16; ++i) st[i] = 0.f;
#pragma unroll
                    for (int kk = 0; kk < 8; ++kk) { const unsigned c = ((2u * kk) ^ xr) << 4; st = MFMA32(ldsfrag(Kb, ko + c), ldsfrag(Qb, qo + c), st); }
#pragma unroll
                    for (int g = 0; g < 4; ++g) { const f32x4 uv = *(const LAS f32x4*)(wh + 32 * sb + 8 * g);
#pragma unroll
                        for (int q = 0; q < 4; ++q) {
                            const int sc = 32 * sb + q + 8 * g;
                            const int sp = sbase + sgn * sc;
                            st[4 * g + q] *= __builtin_amdgcn_exp2f((sp <= tp) ? uv[q] - pmt : -1e30f);
                            ds += st[4 * g + q];
                        } }
                    ha = MFMA32(pack_step(st, 0), vf[2 * sb], ha);
                    ha = MFMA32(pack_step(st, 1), vf[2 * sb + 1], ha);
                }
                ds += __shfl_xor(ds, 32);
                {
                    const float den = wr[128 + 32 * tb] * qnv + ds;
                    const float rd = 1.0f / fmaxf(fabsf(den), wr[192 + 32 * tb]);
                    if (h4 == 0) wr[320 + 32 * tb] = rd;
                }
                LFENCE();
#pragma unroll
                for (int g = 0; g < 4; ++g) { const f32x4 rv = *(const LAS f32x4*)(wh + 320 + 32 * tb + 8 * g);
#pragma unroll
                    for (int q = 0; q < 4; ++q) { const int tc = 32 * tb + q + 8 * g;
                        *(LAS unsigned short*)(hb + tc * 64) = (unsigned short)(pk2(ha[4 * g + q] * rv[q], 0.f) & 0xffffu); } }
            }
            LFENCE();
            {
                bf16_t* hp = Hout + (size_t)(pos0 + lj) * DM;
                const LAS unsigned char* hrow = hst + lj * 64;
#pragma unroll
                for (int q = 0; q < 4; ++q) *(u32x4*)(hp + 8 * q) = *(const LAS u32x4*)(hrow + 16 * q);
            }
            __builtin_amdgcn_sched_barrier(0);
#pragma unroll
            for (int db = 0; db < 4; ++db) {
                if (db == 2) __builtin_amdgcn_sched_barrier(0);
#pragma unroll
                for (int i = 0; i < 16; ++i) cacc[db][i] *= decay;
                const unsigned to = kro + db * 4096u;
                float nadd = 0.f;
#pragma unroll
                for (int kk = 0; kk < 4; ++kk) {
                    const bf16x8 kv = ldsfrag(KTb, to + (((2u * kk) ^ xd) << 4));
                    const f32x4 w0 = *(const LAS f32x4*)(wh + 256 + 16 * kk), w1 = *(const LAS f32x4*)(wh + 256 + 16 * kk + 8);
                    float f[8];
#pragma unroll
                    for (int jj = 0; jj < 4; ++jj) { f[jj] = bfs(kv[jj]) * w0[jj]; f[4 + jj] = bfs(kv[4 + jj]) * w1[jj]; }
#pragma unroll
                    for (int jj = 0; jj < 8; ++jj) nadd += f[jj];
                    u32x4 p = {pk2(f[0], f[1]), pk2(f[2], f[3]), pk2(f[4], f[5]), pk2(f[6], f[7])};
                    cacc[db] = MFMA32(__builtin_bit_cast(bf16x8, p), vf[kk], cacc[db]);
                }
                nadd += __shfl_xor(nadd, 32);
                if (h4 == 0) wr[384 + 32 * db] = decay * wr[384 + 32 * db] + nadd;
            }
            LFENCE();
            m = m_new;
        }
        asm volatile("s_waitcnt vmcnt(0)" ::: "memory"); __builtin_amdgcn_s_barrier();
    }
#undef SC_DMA
#undef SC_POS0
}
#undef MFMA32
#undef LFENCE
}

DI void mlstm_finish_phase(const Args& A, int wv) {
    const int tid = otid(wv), lane = tid & 63, wave = tid >> 6, G = gridDim.x;
    unsigned char* ws = A.ws;
    const bf16_t* HF = (const bf16_t*)(ws + WS_SCR + M_HF); const bf16_t* HB = (const bf16_t*)(ws + WS_SCR + M_HB);
    const bf16_t* SO = (const bf16_t*)(ws + WS_SCR + M_SO); const bf16_t* SZ = (const bf16_t*)(ws + WS_SCR + M_SZ);
    bf16_t* U = (bf16_t*)(ws + WS_H); const float* hn = A.in[11];
    const int sub = lane >> 5, e0 = (lane & 31) * 8;
    const long NIT = (long)NTOK * 8;
    for (long it0 = ((long)blockIdx.x * NWAVES + wave) * 4 + sub; it0 < NIT; it0 += (long)G * NWAVES * 4) {
        f32x4 f0[2], f1[2], b0[2], b1[2], o0[2], o1[2], z0[2], z1[2];
#pragma unroll
        for (int k = 0; k < 2; ++k) { const long it = it0 + 2 * k; const size_t off = (size_t)(it >> 3) * DM + (int)(it & 7) * 256 + e0;
            ld_bf16x8(HF + off, f0[k], f1[k]); ld_bf16x8(HB + off, b0[k], b1[k]); ld_bf16x8(SO + off, o0[k], o1[k]); ld_bf16x8(SZ + off, z0[k], z1[k]); }
#pragma unroll
        for (int k = 0; k < 2; ++k) { const long it = it0 + 2 * k; const size_t off = (size_t)(it >> 3) * DM + (int)(it & 7) * 256 + e0;
            f32x4 y0 = o0[k] * (f0[k] + b0[k]), y1 = o1[k] * (f1[k] + b1[k]);
            float ss = 0.f;
#pragma unroll
            for (int q = 0; q < 4; ++q) ss += y0[q] * y0[q] + y1[q] * y1[q];
            ss += __shfl_xor(ss, 1); ss += __shfl_xor(ss, 2); ss += __shfl_xor(ss, 4); ss += __shfl_xor(ss, 8); ss += __shfl_xor(ss, 16);
            const float rs = 1.0f / sqrtf(ss * (1.f / 256.f) + EPS);
            const float* hp = hn + (int)(it & 7) * 256 + e0;
            const f32x4 h0 = *(const f32x4*)hp, h1 = *(const f32x4*)(hp + 4);
            st_bf16x8(U + off, y0 * rs * h0 * z0[k], y1 * rs * h1 * z1[k]); }
    }
}

DI void mlstm_layer(const Args& A, LAS unsigned char* lds, const XcdBarrier& gbar, int layer, int wv) {
    unsigned char* ws = A.ws;
    const bf16_t* H = (const bf16_t*)(ws + WS_H); bf16_t* U = (bf16_t*)(ws + WS_H);
    bf16_t* Q = (bf16_t*)(ws + WS_SCR + M_Q); bf16_t* Kb = (bf16_t*)(ws + WS_SCR + M_K); bf16_t* KVT = (bf16_t*)(ws + WS_SCR + M_KVT);
    float* G32 = (float*)(ws + WS_SCR + M_G32); bf16_t* SO = (bf16_t*)(ws + WS_SCR + M_SO); bf16_t* SZ = (bf16_t*)(ws + WS_SCR + M_SZ);
    norm_phase(A, layer, false, wv);
    xcd_barrier(gbar, wv);
    {
        DescM1 D; D.init(H, (const bf16_t*)(ws + WS_WMA), (const bf16_t*)(ws + WS_WMB));
        auto E = [=](const pg8::Unit& u, int row_l, int col_l, f32x4 v0, f32x4 v1) {
            if (u.i2 == 0) {
                const size_t row = (size_t)u.i0 * 256 + row_l; const int pn = u.i1;
                if (pn < 4) st_bf16x8(Q + row * 1024 + pn * 256 + col_l, v0 * 0.088388347648318440f, v1 * 0.088388347648318440f);
                else if (pn < 8) st_bf16x8(Kb + row * 1024 + (pn - 4) * 256 + col_l, v0, v1);
                else if (col_l < 32) { *(f32x4*)(G32 + row * 32 + col_l) = v0; *(f32x4*)(G32 + row * 32 + col_l + 4) = v1; }
            } else {
                const int bb = u.i1 / 9, s0 = (u.i1 % 9) * 256;
                st_bf16x8(KVT + ((size_t)bb * 3072 + u.i0 * 256 + row_l) * TB + s0 + col_l, v0, v1);
            }
        };
        pg8::gemm_phase(lds, D, E, wv);
    }
    xcd_barrier(gbar, wv);
    ml::scan_phase(A, lds, wv);
    xcd_barrier(gbar, wv);
    {
        DescPlain D; D.init(H, (const bf16_t*)(ws + WS_WMA) + (size_t)2304 * DM, 16, false);
        auto E = [=](const pg8::Unit& u, int row_l, int col_l, f32x4 v0, f32x4 v1) {
            const size_t row = (size_t)u.i0 * 256 + row_l; const int pn = u.i1; f32x4 a, b;
            if (pn < 8) {
#pragma unroll
                for (int q = 0; q < 4; ++q) { a[q] = sigmf(v0[q]); b[q] = sigmf(v1[q]); }
                st_bf16x8(SO + row * DM + pn * 256 + col_l, a, b);
            } else {
#pragma unroll
                for (int q = 0; q < 4; ++q) { a[q] = siluf(v0[q]); b[q] = siluf(v1[q]); }
                st_bf16x8(SZ + row * DM + (pn - 8) * 256 + col_l, a, b);
            }
        };
        pg8::gemm_phase(lds, D, E, wv);
    }
    xcd_barrier(gbar, wv);
    mlstm_finish_phase(A, wv);
    xcd_barrier(gbar, wv);
    {
        DescPlain D; D.init(U, (const bf16_t*)(ws + WS_WMO), 8, false);
        const float* modl = (const float*)(ws + WS_MOD) + (size_t)layer * 17 * MOD_LD;
        auto E = [=](const pg8::Unit& u, int row_l, int col_l, f32x4 v0, f32x4 v1) { resid_store(A, layer, u.i0, row_l, u.i1 * 256 + col_l, modl, v0, v1); };
        pg8::gemm_phase(lds, D, E, wv);
    }
    xcd_barrier(gbar, wv);
}

__global__ void __launch_bounds__(NTHREADS, 2) fwd_megakernel(Args A) {
    extern __shared__ __attribute__((aligned(16))) unsigned char lds_raw[];
    LAS unsigned char* lds = (LAS unsigned char*)lds_raw;
    cg::grid_group grid = cg::this_grid();
    const int wv = __builtin_amdgcn_readfirstlane(threadIdx.x >> 6);
    volatile LAS unsigned* bst = (volatile LAS unsigned*)(lds + 147456);
    if (otid(wv) < 2) bst[otid(wv)] = 0u;
    __syncthreads();
    const XcdBarrier gbar = xcd_barrier_post((unsigned*)(A.ws + WS_BAR), bst, wv);
    prep_phase(A, lds, wv);
    grid.sync();
    {
        const long long* mi = (const long long*)(A.ws + WS_MODI); float* mf = (float*)(A.ws + WS_MOD);
        for (int i = blockIdx.x * NTHREADS + otid(wv); i < 4 * 17 * MOD_LD; i += gridDim.x * NTHREADS) mf[i] = (float)mi[i] * MODI_INV;
    }
    xcd_barrier(gbar, wv);
    fnet_layer(A, lds, gbar, 0, 0, false, wv);
    mlstm_layer(A, lds, gbar, 1, wv);
    attn_layer(A, lds, (char*)lds_raw, gbar, 2, wv);
    fnet_layer(A, lds, gbar, 3, 1, true, wv);
    final_norm_phase(A, (const float*)(A.ws + WS_SCR + F_PQX), wv);
}

extern "C" void kernel_launch(void* const* d_in, const int* in_sizes, int n_in, void* d_out, int out_size, void* d_ws, size_t ws_size, hipStream_t stream) {
    static int grid = 0;
    if (grid == 0) {
        if (n_in != 18 || ws_size < WS_END) { fprintf(stderr, "kernel_launch: unexpected n_in %d / ws_size %zu (need %zu)\n", n_in, ws_size, (size_t)WS_END); grid = -1; return; }
        int dev = 0, cus = 0, per_cu = 0;
        hipGetDevice(&dev);
        hipDeviceGetAttribute(&cus, hipDeviceAttributeMultiprocessorCount, dev);
        if (hipFuncSetAttribute((const void*)fwd_megakernel, hipFuncAttributeMaxDynamicSharedMemorySize, LDS_BYTES) != hipSuccess) { fprintf(stderr, "kernel_launch: hipFuncSetAttribute failed\n"); grid = -1; return; }
        if (hipOccupancyMaxActiveBlocksPerMultiprocessor(&per_cu, (const void*)fwd_megakernel, NTHREADS, LDS_BYTES) != hipSuccess || per_cu < 1) { fprintf(stderr, "kernel_launch: occupancy query failed (%d)\n", per_cu); per_cu = 1; }
        (void)hipGetLastError();
        grid = cus * per_cu;
        fprintf(stderr, "kernel_launch: grid %d (cus %d x %d)\n", grid, cus, per_cu);
    }
    if (grid < 0) return;
    (void)hipMemsetAsync((char*)d_ws + WS_MOD, 0, ZERO_BYTES, stream);
    (void)hipMemsetAsync((char*)d_ws + WS_MODI, 0, MODI_BYTES, stream);
    Args a{};
    for (int i = 0; i < 18; ++i) a.in[i] = (const float*)d_in[i];
    a.out = (float*)d_out; a.ws = (unsigned char*)d_ws; a.ph_lo = 0; a.ph_hi = 100;
    void* args[] = {&a};
    hipError_t e = hipLaunchCooperativeKernel((const void*)fwd_megakernel, dim3(grid), dim3(NTHREADS), args, LDS_BYTES, stream);
    if (e != hipSuccess) fprintf(stderr, "kernel_launch: cooperative launch failed: %s (grid %d)\n", hipGetErrorString(e), grid);
}
```

```cpp
#include <hip/hip_runtime.h>
#include <hip/hip_cooperative_groups.h>
#include <cstdio>
#include <cstdint>
namespace cg = cooperative_groups;

#define LAS __attribute__((address_space(3)))
#define DI __device__ __forceinline__
typedef unsigned short bf16_t;
typedef short bf16x8 __attribute__((ext_vector_type(8)));
typedef short s16x4 __attribute__((ext_vector_type(4)));
typedef float f32x2 __attribute__((ext_vector_type(2)));
typedef float f32x4 __attribute__((ext_vector_type(4)));
typedef float f32x16 __attribute__((ext_vector_type(16)));
typedef unsigned u32x2 __attribute__((ext_vector_type(2)));
typedef unsigned u32x4 __attribute__((ext_vector_type(4)));
typedef __bf16 bf16v2 __attribute__((ext_vector_type(2)));

constexpr int DM = 2048, NB = 16, TL = 2048, TC = 256, TB = TL + TC, NTOK = NB * TB;
constexpr int NWAVES = 8, NTHREADS = 512;
constexpr float EPS = 1e-6f;
constexpr int MOD_LD = 3 * DM;
constexpr int M_WA_ROWS = 6400, M_WB_ROWS = 3072;
constexpr size_t MiB = 1u << 20;
constexpr size_t WS_SCR_ = 301 * MiB;
constexpr size_t WS_MOD = 0;
constexpr size_t MOD_BYTES = (size_t)4 * 17 * MOD_LD * 4;
constexpr size_t WS_BAR = 1792 * 1024, ZERO_BYTES = 2 * MiB;
constexpr size_t WS_MODI = WS_SCR_ + 700 * MiB, MODI_BYTES = (size_t)4 * 17 * MOD_LD * 8;
constexpr float MODI_SCALE = 1073741824.f, MODI_INV = 9.313225746154785e-10f;
constexpr size_t WS_WFG = 2 * MiB, WS_WFO = 18 * MiB, WS_WMA = 34 * MiB, WS_WMB = 59 * MiB, WS_WMO = 71 * MiB, WS_WAI = 79 * MiB, WS_WAO = 99 * MiB;
constexpr size_t WS_DC = 107 * MiB, WS_DT = 108 * MiB, WS_DT2 = 124 * MiB, WS_CTXS = 125 * MiB, WS_H = 157 * MiB, WS_SCR = 301 * MiB;
constexpr size_t WS_END = 1024 * MiB;
constexpr size_t F_G = 0, F_PQX = 144 * MiB, F_PQC = 400 * MiB, F_A1 = 432 * MiB, F_NYQ = 496 * MiB;
constexpr size_t M_Q = 0, M_K = 72 * MiB, M_KVT = 144 * MiB, M_G32 = 360 * MiB, M_HF = 365 * MiB, M_HB = 509 * MiB, M_SO = 0, M_SZ = 144 * MiB;
constexpr size_t A_Q = 0, A_K = 144 * MiB, A_V = 180 * MiB, A_SZ = 216 * MiB;
static_assert(WS_SCR + M_HB + 144 * MiB <= WS_END, "ws map");
constexpr int LDS_BYTES = 152576 + 1024;

DI unsigned pk2(float a, float b) { f32x2 v = {a, b}; return __builtin_bit_cast(unsigned, __builtin_convertvector(v, bf16v2)); }
DI float bf_lo(unsigned w) { return __uint_as_float(w << 16); }
DI float bf_hi(unsigned w) { return __uint_as_float(w & 0xffff0000u); }
DI float wave_sum(float v) {
#pragma unroll
    for (int o = 1; o < 64; o <<= 1) v += __shfl_xor(v, o);
    return v;
}
DI int otid(int wv) { int t; asm volatile("v_mbcnt_lo_u32_b32 %0, -1, 0\n\tv_mbcnt_hi_u32_b32 %0, -1, %0" : "=v"(t)); return wv * 64 + t; }
DI float siluf(float x) { return x / (1.f + __expf(-x)); }
DI float sigmf(float x) { return 1.f / (1.f + __expf(-x)); }
DI void st_bf16x8(bf16_t* p, f32x4 a, f32x4 b) { u32x4 w = {pk2(a[0], a[1]), pk2(a[2], a[3]), pk2(b[0], b[1]), pk2(b[2], b[3])}; *(u32x4*)p = w; }
DI void ld_bf16x8(const bf16_t* p, f32x4& a, f32x4& b) { const u32x4 w = *(const u32x4*)p; a = (f32x4){bf_lo(w.x), bf_hi(w.x), bf_lo(w.y), bf_hi(w.y)}; b = (f32x4){bf_lo(w.z), bf_hi(w.z), bf_lo(w.w), bf_hi(w.w)}; }

DI f32x4 ldmod4(const long long* p) { return (f32x4){(float)p[0] * MODI_INV, (float)p[1] * MODI_INV, (float)p[2] * MODI_INV, (float)p[3] * MODI_INV}; }

struct Args { const float* in[18]; float* out; unsigned char* ws; int ph_lo, ph_hi; };

#define XB_TMO      128
#define XB_XCNT(j)  (256  + 64 * (j))
#define XB_XSUB(j)  (1280 + 64 * (j))
#define XB_XGEN(j)  (2304 + 64 * (j))
#define XB_TOP      3328
#define XB_TOPGEN   3392
#define XCD_BAR_WORDS 3456
#define XB_SPIN_CAP (1u << 18)

__device__ __forceinline__ unsigned xb_ld(unsigned* p)              { return __hip_atomic_load(p, __ATOMIC_RELAXED, __HIP_MEMORY_SCOPE_AGENT); }
__device__ __forceinline__ unsigned xb_add(unsigned* p, unsigned v) { return __hip_atomic_fetch_add(p, v, __ATOMIC_RELAXED, __HIP_MEMORY_SCOPE_AGENT); }
__device__ __forceinline__ unsigned xb_xcc_id() { return (unsigned)__builtin_amdgcn_s_getreg((3 << 11) | 20) & 0xFu; }
#define XB_SPIN(cond, bar) do { unsigned _sp = 0; while (cond) { __builtin_amdgcn_s_sleep(1); \
    if ((++_sp & 255u) == 0u) { if (xb_ld(&(bar)[XB_TMO])) break; if (_sp > XB_SPIN_CAP) { atomicAdd(&(bar)[XB_TMO], 1u); break; } } } } while (0)

struct XcdBarrier {
    unsigned* bar; unsigned x;
    volatile LAS unsigned* st;
};

__device__ __forceinline__ XcdBarrier xcd_barrier_post(unsigned* bar, volatile LAS unsigned* st, int wv) {
    XcdBarrier b; b.bar = bar; b.x = xb_xcc_id(); b.st = st;
    if (otid(wv) == 0) (void)xb_add(&bar[XB_XCNT(b.x)], 1u);
    return b;
}
__device__ __forceinline__ void xcd_barrier_complete(unsigned* bar, unsigned x, unsigned& nloc, unsigned& nx) {
    const unsigned G = gridDim.x * gridDim.y * gridDim.z;
    unsigned sum, cnt, mine, sp = 0u;
    for (;;) {
        sum = 0u; cnt = 0u; mine = 0u;
#pragma unroll
        for (unsigned j = 0; j < 16; ++j) { const unsigned c = xb_ld(&bar[XB_XCNT(j)]); sum += c; cnt += (c > 0u) ? 1u : 0u; mine = (j == x) ? c : mine; }
        if (sum == G) break;
        __builtin_amdgcn_s_sleep(1);
        if ((++sp & 255u) == 0u) { if (xb_ld(&bar[XB_TMO])) break; if (sp > XB_SPIN_CAP) { atomicAdd(&bar[XB_TMO], 1u); break; } }
    }
    nloc = mine > 0u ? mine : 1u; nx = cnt > 0u ? cnt : 1u;
}

__device__ __forceinline__ void xcd_barrier(const XcdBarrier& b, int wv) {
    asm volatile("s_waitcnt vmcnt(0)" ::: "memory");
    __syncthreads();
    if (otid(wv) == 0) {
        unsigned* bar = b.bar;
        __builtin_amdgcn_s_waitcnt(0);
        unsigned nloc = b.st[0], nx = b.st[1];
        if (nloc == 0u) { xcd_barrier_complete(bar, b.x, nloc, nx); b.st[0] = nloc; b.st[1] = nx; }
        const unsigned old = xb_add(&bar[XB_XSUB(b.x)], 1u);
        const unsigned gen = old / nloc;
        if (old + 1u == (gen + 1u) * nloc) {
            __builtin_amdgcn_fence(__ATOMIC_RELEASE, "agent");
            asm volatile("s_waitcnt vmcnt(0)" ::: "memory");
            const unsigned og = xb_add(&bar[XB_TOP], 1u);
            const unsigned tg = og / nx;
            if (og + 1u == (tg + 1u) * nx) xb_add(&bar[XB_TOPGEN], 1u);
            else XB_SPIN(xb_ld(&bar[XB_TOPGEN]) == tg, bar);
            __builtin_amdgcn_fence(__ATOMIC_ACQUIRE, "agent");
            xb_add(&bar[XB_XGEN(b.x)], 1u);
            asm volatile("s_waitcnt vmcnt(0)" ::: "memory");
        } else {
            XB_SPIN(xb_ld(&bar[XB_XGEN(b.x)]) == gen, bar);
            __builtin_amdgcn_fence(__ATOMIC_ACQUIRE, "agent");
            asm volatile("s_waitcnt vmcnt(0)" ::: "memory");
        }
    }
    __syncthreads();
}


namespace pg8 {
constexpr int BM = 256, BK = 64, HALF = 128, HTB = HALF * BK * 2, NXCD = 8;
DI int lds_byte(int r, int c) { const int st = (r >> 4) * 2 + (c >> 5), rr = r & 15, cc = c & 31, ob = rr * 64 + cc * 2; return st * 1024 + (ob ^ (((ob >> 9) & 1) << 5)); }
DI void stage_rc(int b, int& R, int& C) { const int st = b / 1024, sb = b % 1024, swz = sb ^ (((sb >> 9) & 1) << 5); R = (st >> 1) * 16 + swz / 64; C = (st & 1) * 32 + (swz % 64) / 2; }
DI int perm32(int rho) { const int n = rho >> 4, i = rho & 15; return 8 * (i >> 2) + 4 * n + (i & 3); }
struct Unit { const char* a; const char* b; int i0, i1, i2; };
DI int xcd_remap(int L, int total) { const int q = total / NXCD, r = total % NXCD, xcd = L % NXCD, off = L / NXCD; return (xcd < r ? xcd * (q + 1) : r * (q + 1) + (xcd - r) * q) + off; }

template <class Desc, class Epi>
DI void gemm_phase(LAS unsigned char* lds, const Desc& D, const Epi& E, int wv) {
    const int tid = otid(wv), wid = __builtin_amdgcn_readfirstlane(tid >> 6), lane = tid & 63, wr = wid >> 2, wc = wid & 3, fr = lane & 15, fq = lane >> 4;
    const int G = gridDim.x, c = blockIdx.x, total = D.total;
    const int K = D.K, nt = K / BK;
    unsigned voffA[2], voffB[2];
#pragma unroll
    for (int i = 0; i < 2; ++i) { int R, C; stage_rc(tid * 16 + i * 8192, R, C); const int Rb = (R & ~31) + perm32(R & 31);
        voffA[i] = (unsigned)(R * D.lda + C) * 2u; voffB[i] = (unsigned)(Rb * D.ldb + C) * 2u; }
    const size_t kstep = (size_t)(BK * 2);
    const size_t hstepA = (size_t)HALF * D.lda * 2, hstepB = (size_t)HALF * D.ldb * 2;
    const unsigned ldsw = (unsigned)wid * 1024u;
    const int aoff = lds_byte(wr * 64 + fr, fq * 8), boff = lds_byte(wc * 32 + fr, fq * 8);
#define PG8_SA(b, h) (((b) * 2 + (h)) * HTB)
#define PG8_SB(b, h) ((4 + (b) * 2 + (h)) * HTB)
#define PG8_STAGE(bufoff, gbase, voff) do { _Pragma("unroll") for (int _i = 0; _i < 2; ++_i) \
        __builtin_amdgcn_global_load_lds((const unsigned*)((const char*)(gbase) + (voff)[_i]), (LAS unsigned*)(lds + (bufoff) + ldsw + _i * 8192), 16, 0, 0); } while (0)
#define PG8_LDA(dst, b, h) do { _Pragma("unroll") for (int m = 0; m < 4; ++m) _Pragma("unroll") for (int k = 0; k < 2; ++k) dst[m][k] = *(const LAS bf16x8*)(lds + PG8_SA(b, h) + aoff + m * 2048 + k * 1024); } while (0)
#define PG8_LDB(dst, b, h) do { _Pragma("unroll") for (int n = 0; n < 2; ++n) _Pragma("unroll") for (int k = 0; k < 2; ++k) dst[n][k] = *(const LAS bf16x8*)(lds + PG8_SB(b, h) + boff + n * 2048 + k * 1024); } while (0)
#define PG8_MMA(ai, bj, At, Bt) do { __builtin_amdgcn_s_setprio(1); _Pragma("unroll") for (int m = 0; m < 4; ++m) _Pragma("unroll") for (int n = 0; n < 2; ++n) _Pragma("unroll") for (int k = 0; k < 2; ++k) \
        acc[ai][bj][m][n] = __builtin_amdgcn_mfma_f32_16x16x32_bf16(Bt[n][k], At[m][k], acc[ai][bj][m][n], 0, 0, 0); __builtin_amdgcn_s_setprio(0); } while (0)
#define PG8_WAIT_V(n) asm volatile("s_waitcnt vmcnt(" #n ")" ::: "memory")
#define PG8_WAIT_L(n) asm volatile("s_waitcnt lgkmcnt(" #n ")" ::: "memory")
#define PG8_BAR __builtin_amdgcn_s_barrier()
#define PG8_SCHED __builtin_amdgcn_sched_barrier(0)
    if (c >= total) return;
    Unit cur = D.unit(xcd_remap(c, total)), nxt = cur; int ui = 0;
    f32x4 acc[2][2][4][2];
#pragma unroll
    for (int a = 0; a < 2; ++a)
#pragma unroll
        for (int b = 0; b < 2; ++b)
#pragma unroll
            for (int m = 0; m < 4; ++m)
#pragma unroll
                for (int n = 0; n < 2; ++n) acc[a][b][m][n] = (f32x4){0.f, 0.f, 0.f, 0.f};
    bf16x8 At[4][2], B0[2][2], B1[2][2];
    const char* cA = cur.a; const char* cB = cur.b;
    PG8_STAGE(PG8_SB(0, 0), cB, voffB); PG8_STAGE(PG8_SB(0, 1), cB + hstepB, voffB); PG8_STAGE(PG8_SA(0, 0), cA, voffA); PG8_STAGE(PG8_SA(0, 1), cA + hstepA, voffA);
    if (wr == 1) PG8_BAR;
    PG8_WAIT_V(2); PG8_BAR;
    PG8_STAGE(PG8_SB(1, 0), cB + kstep, voffB); PG8_STAGE(PG8_SA(1, 0), cA + kstep, voffA); PG8_STAGE(PG8_SB(1, 1), cB + hstepB + kstep, voffB);
    PG8_WAIT_V(6); PG8_BAR;
    for (;;) {
        const long Ln = (long)(ui + 1) * G + c;
        const bool has_next = Ln < total;
        if (has_next) nxt = D.unit(xcd_remap((int)Ln, total));
        const char* nA = has_next ? nxt.a : cA; const char* nB = has_next ? nxt.b : cB;
        for (int t = 0; t < nt; t += 2) {
            const bool last = (t == nt - 2);
            const char* a1 = cA + (size_t)(t + 1) * kstep;
            const char* a2 = last ? nA : cA + (size_t)(t + 2) * kstep; const char* b2 = last ? nB : cB + (size_t)(t + 2) * kstep;
            const char* a3 = a2 + kstep; const char* b3 = b2 + kstep;
            PG8_LDB(B0, 0, 0); PG8_LDB(B1, 0, 1); PG8_SCHED; PG8_LDA(At, 0, 0); PG8_STAGE(PG8_SA(1, 1), a1 + hstepA, voffA);
            PG8_WAIT_V(8); PG8_WAIT_L(0); PG8_BAR; PG8_MMA(0, 0, At, B0); PG8_MMA(0, 1, At, B1); PG8_BAR; PG8_SCHED;
            PG8_LDA(At, 0, 1); PG8_STAGE(PG8_SB(0, 0), b2, voffB); PG8_STAGE(PG8_SB(0, 1), b2 + hstepB, voffB); PG8_STAGE(PG8_SA(0, 0), a2, voffA);
            PG8_WAIT_V(8); PG8_WAIT_L(0); PG8_BAR; PG8_MMA(1, 0, At, B0); PG8_MMA(1, 1, At, B1); PG8_BAR; PG8_SCHED;
            PG8_LDB(B0, 1, 0); PG8_LDB(B1, 1, 1); PG8_SCHED; PG8_LDA(At, 1, 0); PG8_STAGE(PG8_SA(0, 1), a2 + hstepA, voffA);
            PG8_WAIT_V(8); PG8_WAIT_L(0); PG8_BAR; PG8_MMA(0, 0, At, B0); PG8_MMA(0, 1, At, B1); PG8_BAR; PG8_SCHED;
            PG8_LDA(At, 1, 1); PG8_STAGE(PG8_SB(1, 0), b3, voffB); PG8_STAGE(PG8_SB(1, 1), b3 + hstepB, voffB); PG8_STAGE(PG8_SA(1, 0), a3, voffA);
            PG8_WAIT_V(8); PG8_WAIT_L(0); PG8_BAR; PG8_MMA(1, 0, At, B0); PG8_MMA(1, 1, At, B1); PG8_BAR; PG8_SCHED;
        }
        if (wr == 0) PG8_BAR;
        {
            const int le = otid(wv) & 63, fre = le & 15, fqe = le >> 4;
#pragma unroll
            for (int ai = 0; ai < 2; ++ai)
#pragma unroll
                for (int m = 0; m < 4; ++m)
#pragma unroll
                    for (int bj = 0; bj < 2; ++bj)
                        E(cur, ai * HALF + wr * 64 + m * 16 + fre, bj * HALF + wc * 32 + 8 * fqe, acc[ai][bj][m][0], acc[ai][bj][m][1]);
        }
        if (!has_next) break;
#pragma unroll
        for (int a = 0; a < 2; ++a)
#pragma unroll
            for (int b = 0; b < 2; ++b)
#pragma unroll
                for (int m = 0; m < 4; ++m)
#pragma unroll
                    for (int n = 0; n < 2; ++n) acc[a][b][m][n] = (f32x4){0.f, 0.f, 0.f, 0.f};
        cur = nxt; cA = nA; cB = nB; ++ui;
        if (wr == 1) PG8_BAR;
    }
    PG8_WAIT_V(0);
    PG8_BAR;
#undef PG8_SA
#undef PG8_SB
#undef PG8_STAGE
#undef PG8_LDA
#undef PG8_LDB
#undef PG8_MMA
#undef PG8_WAIT_V
#undef PG8_WAIT_L
#undef PG8_BAR
#undef PG8_SCHED
}
}

DI void transpose_item(const float* W, int N, int kb, int nb, bf16_t* d0, bf16_t* d1, int K, LAS float* scr, int lane) {
    const int k0 = 64 * kb, n0 = 32 * nb;
#pragma unroll 8
    for (int i = 0; i < 32; ++i) { const int kk = 2 * i + (lane >> 5); scr[kk * 33 + (lane & 31)] = W[(size_t)(k0 + kk) * N + n0 + (lane & 31)]; }
    asm volatile("s_waitcnt lgkmcnt(0)" ::: "memory");
    const int c = lane & 7;
#pragma unroll
    for (int j = 0; j < 4; ++j) { const int n = (lane >> 3) + 8 * j; const LAS float* s = scr + (8 * c) * 33 + n;
        u32x4 o; o.x = pk2(s[0 * 33], s[1 * 33]); o.y = pk2(s[2 * 33], s[3 * 33]); o.z = pk2(s[4 * 33], s[5 * 33]); o.w = pk2(s[6 * 33], s[7 * 33]);
        *(u32x4*)(d0 + (size_t)n * K + k0 + 8 * c) = o;
        if (d1) *(u32x4*)(d1 + (size_t)n * K + k0 + 8 * c) = o; }
    asm volatile("s_waitcnt lgkmcnt(0)" ::: "memory");
}

DI void prep_phase(const Args& A, LAS unsigned char* lds, int wv) {
    const int tid = otid(wv), lane = tid & 63, wave = tid >> 6, G = gridDim.x;
    unsigned char* ws = A.ws;
    {
        LAS float* s_lds = (LAS float*)lds;
        const float* cc = A.in[1]; const float* cctx = A.in[3]; const float* aw = A.in[4]; const float* ab = A.in[5];
        long long* modi = (long long*)(ws + WS_MODI);
        for (int item = blockIdx.x; item < 768; item += G) {
            const int kc = item % 16, cb = (item / 16) % 12, l = item / 192;
            const int k0 = kc * 128, j = cb * 512 + tid;
            __syncthreads();
            for (int e = tid; e < 17 * 128; e += NTHREADS) { const int r = e / 128, k = e % 128; const float v = r < 16 ? cc[r * DM + k0 + k] : cctx[k0 + k]; s_lds[k * 20 + r] = siluf(v); }
            __syncthreads();
            float acc[17];
#pragma unroll
            for (int r = 0; r < 17; ++r) acc[r] = 0.f;
            const float* wp = aw + ((size_t)l * DM + k0) * MOD_LD + j;
#pragma unroll 4
            for (int k = 0; k < 128; ++k) {
                const float w = wp[(size_t)k * MOD_LD];
                const LAS f32x4* sp = (const LAS f32x4*)(s_lds + k * 20);
                const f32x4 s0 = sp[0], s1 = sp[1], s2 = sp[2], s3 = sp[3]; const float s4 = s_lds[k * 20 + 16];
#pragma unroll
                for (int q = 0; q < 4; ++q) { acc[q] += s0[q] * w; acc[4 + q] += s1[q] * w; acc[8 + q] += s2[q] * w; acc[12 + q] += s3[q] * w; }
                acc[16] += s4 * w;
            }
            const float bias = (kc == 0) ? ab[l * MOD_LD + j] : 0.f;
#pragma unroll
            for (int r = 0; r < 17; ++r) atomicAdd((unsigned long long*)&modi[(size_t)(l * 17 + r) * MOD_LD + j], (unsigned long long)__float2ll_rn((acc[r] + bias) * MODI_SCALE));
        }
        __syncthreads();
    }
    {
        LAS float* scr = (LAS float*)(lds + wave * 16384);
        const int gw = blockIdx.x * NWAVES + wave, NGW = G * NWAVES;
        constexpr int I_SQ = 32 * 64, I_AI = 32 * 160, I_MI = 32 * 257;
        constexpr int NIT = 6 * I_SQ + I_AI + I_MI;
        for (int it = gw; it < NIT; it += NGW) {
            int r = it;
            if (r < 6 * I_SQ) {
                const int w = r / I_SQ; r -= w * I_SQ;
                const float* src; bf16_t* dst;
                if (w < 2)      { src = A.in[7] + (size_t)w * DM * DM;       dst = (bf16_t*)(ws + WS_WFG) + (size_t)w * DM * DM; }
                else if (w < 4) { src = A.in[8] + (size_t)(w - 2) * DM * DM; dst = (bf16_t*)(ws + WS_WFO) + (size_t)(w - 2) * DM * DM; }
                else if (w == 4) { src = A.in[12]; dst = (bf16_t*)(ws + WS_WMO); }
                else             { src = A.in[16]; dst = (bf16_t*)(ws + WS_WAO); }
                const int kb = r / 64, nb = r % 64;
                transpose_item(src, DM, kb, nb, dst + (size_t)(32 * nb) * DM, nullptr, DM, scr, lane);
                continue;
            }
            r -= 6 * I_SQ;
            if (r < I_AI) { const int kb = r / 160, nb = r % 160; transpose_item(A.in[13], 5120, kb, nb, (bf16_t*)(ws + WS_WAI) + (size_t)(32 * nb) * DM, nullptr, DM, scr, lane); continue; }
            r -= I_AI;
            {
                const int kb = r / 257, nb = r % 257, n0 = 32 * nb;
                bf16_t* WA = (bf16_t*)(ws + WS_WMA); bf16_t* WB = (bf16_t*)(ws + WS_WMB);
                bf16_t* d0; bf16_t* d1 = nullptr;
                if (n0 < 1024) d0 = WA + (size_t)n0 * DM;
                else if (n0 < 2048) { d0 = WA + (size_t)n0 * DM; d1 = WB + (size_t)(n0 - 1024) * DM; }
                else if (n0 < 4096) d0 = WB + (size_t)(1024 + n0 - 2048) * DM;
                else if (n0 < 6144) d0 = WA + (size_t)(2304 + n0 - 4096) * DM;
                else if (n0 < 6176) d0 = WA + (size_t)(2048 + n0 - 6144) * DM;
                else d0 = WA + (size_t)(4352 + n0 - 6176) * DM;
                transpose_item(A.in[9], 8224, kb, nb, d0, d1, DM, scr, lane);
            }
        }
    }
    {
        const long gt = (long)blockIdx.x * NTHREADS + tid, NGT = (long)G * NTHREADS;
        constexpr long N_DC = 1024L * 512 / 8, N_DT = 2048L * 4096 / 8, N_DT2 = 256L * 512 / 8;
        for (long it = gt; it < N_DC + N_DT + N_DT2; it += NGT) {
            float v[8]; bf16_t* dst;
            if (it < N_DC) {
                const int m = (int)(it / 64), k0 = (int)(it % 64) * 8; const float sc = 0.044194173824159216f;
#pragma unroll
                for (int j = 0; j < 8; ++j) { const int rr = ((m & 511) * (k0 + j)) & 511; const float ang = (float)rr * (1.f / 256.f); v[j] = (m < 512 ? cospif(ang) : sinpif(ang)) * sc; }
                dst = (bf16_t*)(ws + WS_DC) + (size_t)m * 512 + k0;
            } else if (it < N_DC + N_DT) {
                const long i2 = it - N_DC; const int kk = (int)(i2 / 512), s0 = (int)(i2 % 512) * 8; const float sc = 0.022097086912079608f;
#pragma unroll
                for (int j = 0; j < 8; ++j) { const int s = s0 + j; const int rr = (kk * (s & 2047)) & 2047; const float ang = (float)rr * (1.f / 1024.f); v[j] = (s < 2048 ? cospif(ang) : -sinpif(ang)) * sc; }
                dst = (bf16_t*)(ws + WS_DT) + (size_t)kk * 4096 + s0;
            } else {
                const long i2 = it - N_DC - N_DT; const int kk = (int)(i2 / 64), s0 = (int)(i2 % 64) * 8; const float sc = 0.0625f;
#pragma unroll
                for (int j = 0; j < 8; ++j) { const int s = s0 + j; const int rr = (kk * (s & 255)) & 255; const float ang = (float)rr * (1.f / 128.f); v[j] = (s < 256 ? cospif(ang) : -sinpif(ang)) * sc; }
                dst = (bf16_t*)(ws + WS_DT2) + (size_t)kk * 512 + s0;
            }
            u32x4 o = {pk2(v[0], v[1]), pk2(v[2], v[3]), pk2(v[4], v[5]), pk2(v[6], v[7])};
            *(u32x4*)dst = o;
        }
    }
}

DI const float* xrow_in(const Args& A, int r) {
    const int b = r / TB, t = r % TB;
    if (t < TL) return A.in[0] + ((size_t)b * TL + t) * DM;
    return A.in[2] + ((size_t)b * TC + (t - TL)) * DM;
}
DI void norm_phase(const Args& A, int layer, bool latonly, int wv) {
    const int tid = otid(wv), lane = tid & 63, wave = tid >> 6, G = gridDim.x;
    const float* ng = A.in[6] + (size_t)layer * DM;
    const float* mod = (const float*)(A.ws + WS_MOD) + (size_t)layer * 17 * MOD_LD;
    bf16_t* H = (bf16_t*)(A.ws + WS_H);
    const bf16_t* XB = (const bf16_t*)A.out;
    for (int r0 = (blockIdx.x * NWAVES + wave) * 2; r0 < NTOK; r0 += G * NWAVES * 2) {
        const int b = r0 / TB, t = r0 % TB;
        if (latonly && t >= TL) continue;
        const float* mr = mod + (size_t)(t < TL ? b : 16) * MOD_LD;
        f32x4 v[2][4][2];
#pragma unroll
        for (int k = 0; k < 2; ++k) {
            const int r = r0 + k;
            if (layer == 0) {
                const float* xr = xrow_in(A, r);
#pragma unroll
                for (int j = 0; j < 4; ++j) { const f32x4* p = (const f32x4*)(xr + 512 * j + 8 * lane); v[k][j][0] = p[0]; v[k][j][1] = p[1]; }
            } else {
#pragma unroll
                for (int j = 0; j < 4; ++j) ld_bf16x8(XB + (size_t)r * DM + 512 * j + 8 * lane, v[k][j][0], v[k][j][1]);
            }
        }
#pragma unroll
        for (int k = 0; k < 2; ++k) {
            const int r = r0 + k; float ss = 0.f;
#pragma unroll
            for (int j = 0; j < 4; ++j)
#pragma unroll
                for (int q = 0; q < 4; ++q) ss += v[k][j][0][q] * v[k][j][0][q] + v[k][j][1][q] * v[k][j][1][q];
            const float rs = 1.0f / sqrtf(wave_sum(ss) * (1.f / DM) + EPS);
#pragma unroll
            for (int j = 0; j < 4; ++j) { const int c0 = 512 * j + 8 * lane; f32x4 o[2];
#pragma unroll
                for (int h = 0; h < 2; ++h) { const f32x4 g4 = *(const f32x4*)(ng + c0 + 4 * h), sh = *(const f32x4*)(mr + c0 + 4 * h), sc = *(const f32x4*)(mr + DM + c0 + 4 * h);
                    o[h] = (v[k][j][h] * rs) * g4 * (sc + 1.0f) + sh; }
                st_bf16x8(H + (size_t)r * DM + c0, o[0], o[1]); }
        }
    }
}
DI void final_norm_phase(const Args& A, const float* src_override, int wv) {
    const int tid = otid(wv), lane = tid & 63, wave = tid >> 6, G = gridDim.x;
    const float* fg = A.in[17];
    for (int r0 = (blockIdx.x * NWAVES + wave) * 2; r0 < NB * TL; r0 += G * NWAVES * 2) {
        f32x4 v[2][4][2];
#pragma unroll
        for (int k = 0; k < 2; ++k) { const float* xr = (src_override ? src_override : (const float*)A.out) + (size_t)(r0 + k) * DM;
#pragma unroll
            for (int j = 0; j < 4; ++j) { const f32x4* p = (const f32x4*)(xr + 512 * j + 8 * lane); v[k][j][0] = p[0]; v[k][j][1] = p[1]; } }
#pragma unroll
        for (int k = 0; k < 2; ++k) { float* orow = A.out + (size_t)(r0 + k) * DM; float ss = 0.f;
#pragma unroll
            for (int j = 0; j < 4; ++j)
#pragma unroll
                for (int q = 0; q < 4; ++q) ss += v[k][j][0][q] * v[k][j][0][q] + v[k][j][1][q] * v[k][j][1][q];
            const float rs = 1.0f / sqrtf(wave_sum(ss) * (1.f / DM) + EPS);
#pragma unroll
            for (int j = 0; j < 4; ++j) { const int c0 = 512 * j + 8 * lane;
#pragma unroll
                for (int h = 0; h < 2; ++h) { const f32x4 g4 = *(const f32x4*)(fg + c0 + 4 * h); *(f32x4*)(orow + c0 + 4 * h) = (v[k][j][h] * rs) * g4; } }
        }
    }
}

struct DescPlain {
    const bf16_t* A; const bf16_t* B; int nN; bool latonly; int lda, ldb, K, total;
    DI void init(const bf16_t* A_, const bf16_t* B_, int nN_, bool lat) { A = A_; B = B_; nN = nN_; latonly = lat; lda = DM; ldb = DM; K = DM; total = (lat ? 128 : 144) * nN_; }
    DI pg8::Unit unit(int idx) const {
        const int nMt = latonly ? 128 : 144, nig = 8 * nN, gid = idx / nig, fm = gid * 8, gsz = (nMt - fm) < 8 ? (nMt - fm) : 8;
        const int pmi = fm + (idx % nig) % gsz, pn = (idx % nig) / gsz, pm = latonly ? (pmi / 8) * 9 + (pmi % 8) : pmi;
        pg8::Unit u; u.a = (const char*)(A + (size_t)pm * 256 * DM); u.b = (const char*)(B + (size_t)pn * 256 * DM); u.i0 = pm; u.i1 = pn; u.i2 = 0; return u;
    }
};
struct DescChan {
    const bf16_t* DC; const bf16_t* H; int lda, ldb, K, total;
    DI void init(const bf16_t* DC_, const bf16_t* H_, bool lat) { DC = DC_; H = H_; lda = 512; ldb = DM; K = 512; total = lat ? 2048 : 2304; }
    DI pg8::Unit unit(int idx) const {
        pg8::Unit u; int b, g, mt, nt, toff;
        if (idx < 2048) { mt = idx % 4; nt = (idx / 4) % 8; g = (idx / 32) % 4; b = idx / 128; toff = nt * 256; u.i2 = nt; }
        else { const int j = idx - 2048; mt = j % 4; g = (j / 4) % 4; b = j / 16; toff = TL; u.i2 = 8; }
        u.a = (const char*)(DC + (size_t)mt * 256 * 512); u.b = (const char*)(H + ((size_t)b * TB + toff) * DM + g * 512); u.i0 = b * 4 + g; u.i1 = mt; return u;
    }
};
struct DescT {
    const bf16_t* DT; const bf16_t* PQ; int nMt; int lda, ldb, K, total;
    DI void init(const bf16_t* DT_, const bf16_t* PQ_, int ld, int Kd, int coff, int nMt_) { DT = DT_ + coff; PQ = PQ_ + coff; nMt = nMt_; lda = ld; ldb = ld; K = Kd; total = NB * nMt_ * 8; }
    DI pg8::Unit unit(int idx) const {
        const int mt = idx % nMt, nt = (idx / nMt) % 8, b = idx / (nMt * 8);
        pg8::Unit u; u.a = (const char*)(DT + (size_t)mt * 256 * lda); u.b = (const char*)(PQ + ((size_t)b * DM + nt * 256) * ldb); u.i0 = b; u.i1 = mt; u.i2 = nt; return u;
    }
};

DI void resid_store(const Args& A, int layer, int pm, int row_l, int col, const float* modl, f32x4 v0, f32x4 v1) {
    const int b = pm / 9, tt = pm % 9;
    const float* gp = modl + (size_t)(tt < 8 ? b : 16) * MOD_LD + 2 * DM + col;
    const f32x4 g0 = *(const f32x4*)gp, g1 = *(const f32x4*)(gp + 4);
    bf16_t* XB = (bf16_t*)A.out;
    const size_t roff = ((size_t)pm * 256 + row_l) * DM + col;
    f32x4 x0, x1;
    if (layer == 0) {
        const float* src = (tt < 8) ? A.in[0] + ((size_t)b * TL + tt * 256 + row_l) * DM + col : A.in[2] + ((size_t)b * TC + row_l) * DM + col;
        x0 = *(const f32x4*)src; x1 = *(const f32x4*)(src + 4);
    } else ld_bf16x8(XB + roff, x0, x1);
    x0 = x0 + g0 * v0; x1 = x1 + g1 * v1;
    if (layer == 3) { float* dst = (float*)(A.ws + WS_SCR + F_PQX) + ((size_t)b * TL + tt * 256 + row_l) * DM + col; *(f32x4*)dst = x0; *(f32x4*)(dst + 4) = x1; }
    else st_bf16x8(XB + roff, x0, x1);
}

DI void fnet_layer(const Args& A, LAS unsigned char* lds, const XcdBarrier& gbar, int layer, int j, bool latonly, int wv) {
    unsigned char* ws = A.ws;
    const bf16_t* H = (const bf16_t*)(ws + WS_H); bf16_t* U = (bf16_t*)(ws + WS_H);
    bf16_t* Gt = (bf16_t*)(ws + WS_SCR + F_G); bf16_t* PQX = (bf16_t*)(ws + WS_SCR + F_PQX); bf16_t* PQC = (bf16_t*)(ws + WS_SCR + F_PQC);
    norm_phase(A, layer, latonly, wv);
    xcd_barrier(gbar, wv);
    {
        DescPlain D; D.init(H, (const bf16_t*)(ws + WS_WFG) + (size_t)j * DM * DM, 8, latonly);
        auto E = [=](const pg8::Unit& u, int row_l, int col_l, f32x4 v0, f32x4 v1) {
            f32x4 a, b;
#pragma unroll
            for (int q = 0; q < 4; ++q) { a[q] = siluf(v0[q]); b[q] = siluf(v1[q]); }
            st_bf16x8(Gt + ((size_t)u.i0 * 256 + row_l) * DM + u.i1 * 256 + col_l, a, b);
        };
        pg8::gemm_phase(lds, D, E, wv);
    }
    {
        DescChan D; D.init((const bf16_t*)(ws + WS_DC), H, latonly);
        auto E = [=](const pg8::Unit& u, int row_l, int col_l, f32x4 v0, f32x4 v1) {
            const int b = u.i0 >> 2, g = u.i0 & 3, mt = u.i1, half = mt >> 1, ch = g * 512 + (mt & 1) * 256 + row_l;
            bf16_t* dst = (u.i2 < 8) ? PQX + ((size_t)b * DM + ch) * 4096 + half * 2048 + u.i2 * 256 + col_l
                                     : PQC + ((size_t)b * DM + ch) * 512 + half * 256 + col_l;
            st_bf16x8(dst, v0, v1);
        };
        pg8::gemm_phase(lds, D, E, wv);
    }
    xcd_barrier(gbar, wv);
    bf16_t* A1 = (bf16_t*)(ws + WS_SCR + F_A1); float* NYQ = (float*)(ws + WS_SCR + F_NYQ);
    {
        const int tid = otid(wv), lane = tid & 63;
        for (int rr0 = (blockIdx.x * NWAVES + wv) * 4; rr0 < NB * DM; rr0 += gridDim.x * NWAVES * 4) {
            u32x4 raw[4][4];
#pragma unroll
            for (int k = 0; k < 4; ++k)
#pragma unroll
                for (int q = 0; q < 4; ++q) raw[k][q] = *(const u32x4*)(PQX + (size_t)(rr0 + k) * 4096 + (q * 64 + lane) * 8);
#pragma unroll
            for (int k = 0; k < 4; ++k) { float acc = 0.f;
#pragma unroll
                for (int q = 0; q < 4; ++q) { const u32x4 w = raw[k][q]; acc += (bf_lo(w.x) - bf_hi(w.x)) + (bf_lo(w.y) - bf_hi(w.y)) + (bf_lo(w.z) - bf_hi(w.z)) + (bf_lo(w.w) - bf_hi(w.w)); }
                acc = wave_sum(acc);
                if (lane == 0) NYQ[rr0 + k] = acc * 0.022097086912079608f; }
        }
    }
    {
        DescT D; D.init((const bf16_t*)(ws + WS_DT), PQX, 4096, 2048, 0, 4);
        auto E = [=](const pg8::Unit& u, int row_l, int col_l, f32x4 v0, f32x4 v1) {
            st_bf16x8(A1 + ((size_t)u.i0 * 1024 + u.i1 * 256 + row_l) * DM + u.i2 * 256 + col_l, v0, v1);
        };
        pg8::gemm_phase(lds, D, E, wv);
    }
    xcd_barrier(gbar, wv);
    {
        DescT D; D.init((const bf16_t*)(ws + WS_DT), PQX, 4096, 2048, 2048, 4);
        auto E = [=](const pg8::Unit& u, int row_l, int col_l, f32x4 v0, f32x4 v1) {
            const int k = u.i1 * 256 + row_l, col = u.i2 * 256 + col_l;
            f32x4 a0, a1; ld_bf16x8(A1 + ((size_t)u.i0 * 1024 + k) * DM + col, a0, a1);
            const size_t off = ((size_t)u.i0 * TB + k) * DM + col;
            f32x4 g0, g1; ld_bf16x8(Gt + off, g0, g1);
            st_bf16x8(U + off, (a0 + v0) * g0, (a1 + v1) * g1);
            const size_t off2 = ((size_t)u.i0 * TB + (k == 0 ? 1024 : TL - k)) * DM + col;
            ld_bf16x8(Gt + off2, g0, g1);
            if (k == 0) { const float* nq = NYQ + (size_t)u.i0 * DM + col; a0 = *(const f32x4*)nq; a1 = *(const f32x4*)(nq + 4); v0 = (f32x4){0.f, 0.f, 0.f, 0.f}; v1 = v0; }
            st_bf16x8(U + off2, (a0 - v0) * g0, (a1 - v1) * g1);
        };
        pg8::gemm_phase(lds, D, E, wv);
    }
    if (!latonly) {
        DescT D; D.init((const bf16_t*)(ws + WS_DT2), PQC, 512, 512, 0, 1);
        auto E = [=](const pg8::Unit& u, int row_l, int col_l, f32x4 v0, f32x4 v1) {
            const size_t off = ((size_t)u.i0 * TB + TL + row_l) * DM + u.i2 * 256 + col_l;
            f32x4 g0, g1; ld_bf16x8(Gt + off, g0, g1);
            st_bf16x8(U + off, v0 * g0, v1 * g1);
        };
        pg8::gemm_phase(lds, D, E, wv);
    }
    xcd_barrier(gbar, wv);
    {
        DescPlain D; D.init(U, (const bf16_t*)(ws + WS_WFO) + (size_t)j * DM * DM, 8, latonly);
        const float* modl = (const float*)(ws + WS_MOD) + (size_t)layer * 17 * MOD_LD;
        auto E = [=](const pg8::Unit& u, int row_l, int col_l, f32x4 v0, f32x4 v1) { resid_store(A, layer, u.i0, row_l, u.i1 * 256 + col_l, modl, v0, v1); };
        pg8::gemm_phase(lds, D, E, wv);
    }
    xcd_barrier(gbar, wv);
}


namespace att {
constexpr int D = 128, NW = 8, QBLK = 32, KVBLK = 64;
constexpr float SCALE = 0.088388347648318440f;
constexpr float THR = 8.f;
constexpr int LDQ = 2048, LDK = 512;
constexpr size_t SHM_V = KVBLK * D * 2, SHM_K = KVBLK * D * 2;
typedef float f32x8 __attribute__((ext_vector_type(8)));
#define KSWZ(row, colB) ((row) * 256 + ((colB) ^ (((row) & 7) << 4)))
#define SBAR() __builtin_amdgcn_sched_barrier(0)
DI int crow(int r, int hi) { return (r & 3) + 8 * (r >> 2) + 4 * hi; }
DI unsigned cvtpk(float lo, float hi) { unsigned r; asm volatile("v_cvt_pk_bf16_f32 %0, %1, %2" : "=v"(r) : "v"(lo), "v"(hi)); return r; }
DI void partialSM(f32x16& p0, f32x16& p1, float& m_reg, float& mn, float& alpha) {
  constexpr float C = SCALE * 1.4426950408889634f;
  float pmax = p0[0];
#pragma unroll
  for (int r = 1; r < 16; ++r) pmax = fmaxf(pmax, p0[r]);
#pragma unroll
  for (int r = 0; r < 16; ++r) pmax = fmaxf(pmax, p1[r]);
  { auto rr = __builtin_amdgcn_permlane32_swap(__float_as_uint(pmax), __float_as_uint(pmax), false, false);
    pmax = fmaxf(__uint_as_float(rr[0]), __uint_as_float(rr[1])); }
  if (__builtin_expect(__all(pmax - m_reg <= THR / SCALE), 1)) { mn = m_reg; alpha = 1.f; }
  else { mn = fmaxf(m_reg, pmax); alpha = __builtin_amdgcn_exp2f((m_reg - mn) * C); m_reg = mn; }
  float mnC = -mn * C;
#pragma unroll
  for (int r = 0; r < 16; ++r) p0[r] = fmaf(p0[r], C, mnC);
#pragma unroll
  for (int r = 0; r < 16; ++r) p1[r] = fmaf(p1[r], C, mnC);
#pragma unroll
  for (int r = 0; r < 16; ++r) p0[r] = __builtin_amdgcn_exp2f(p0[r]);
}
DI void finishSM(f32x16& p0, f32x16& p1, float alpha, float& l_reg, bf16x8& pa0, bf16x8& pa1, bf16x8& pa2, bf16x8& pa3) {
#pragma unroll
  for (int r = 0; r < 16; ++r) p1[r] = __builtin_amdgcn_exp2f(p1[r]);
  float ps = 0;
#pragma unroll
  for (int r = 0; r < 16; ++r) ps += p0[r];
#pragma unroll
  for (int r = 0; r < 16; ++r) ps += p1[r];
  { auto rr = __builtin_amdgcn_permlane32_swap(__float_as_uint(ps), __float_as_uint(ps), false, false);
    ps = __uint_as_float(rr[0]) + __uint_as_float(rr[1]); }
  l_reg = l_reg * alpha + ps;
#define PK4(P, BASE, OUT) do { unsigned a0 = cvtpk(P[BASE + 0], P[BASE + 1]), a1 = cvtpk(P[BASE + 2], P[BASE + 3]);   \
    unsigned b0 = cvtpk(P[BASE + 4], P[BASE + 5]), b1 = cvtpk(P[BASE + 6], P[BASE + 7]);                              \
    auto r0 = __builtin_amdgcn_permlane32_swap(a0, b0, false, false); auto r1 = __builtin_amdgcn_permlane32_swap(a1, b1, false, false); \
    u32x4 w = {r0[0], r1[0], r0[1], r1[1]}; OUT = *reinterpret_cast<bf16x8*>(&w); } while (0)
  PK4(p0, 0, pa0); PK4(p0, 8, pa1); PK4(p1, 0, pa2); PK4(p1, 8, pa3);
#undef PK4
}
DI void qkt(f32x16& p0, f32x16& p1, const bf16_t* Ks, const bf16x8* qr, int r32, int hi) {
  p0 = f32x16{}; p1 = f32x16{};
#pragma unroll
  for (int d0 = 0; d0 < 8; ++d0) { int cb = (d0 * 16 + hi * 8) * 2;
    bf16x8 b0 = *reinterpret_cast<const bf16x8*>((const char*)Ks + KSWZ(r32, cb));
    bf16x8 b1 = *reinterpret_cast<const bf16x8*>((const char*)Ks + KSWZ(32 + r32, cb));
    p0 = __builtin_amdgcn_mfma_f32_32x32x16_bf16(b0, qr[d0], p0, 0, 0, 0);
    p1 = __builtin_amdgcn_mfma_f32_32x32x16_bf16(b1, qr[d0], p1, 0, 0, 0); }
}
DI int v_st(int k, int c) { const int kk = (k & ~0xC) | ((k & 4) << 1) | ((k & 8) >> 1); return ((kk >> 3) * 4 + (c >> 5)) * 512 + ((kk & 7) * 32 + (c & 31)) * 2; }
DI int v_rd_base(int lane) { return ((lane & 3) << 3) | (((lane >> 2) & 3) << 6) | (((lane >> 4) & 1) << 5) | (((lane >> 5) & 1) << 8); }
constexpr int v_rd_off(int d0, int ks, int half) { return d0 * 512 + ks * 4096 + half * 2048; }
template <int OFF> DI s16x4 tr_read(int vb) {
  s16x4 r; asm volatile("ds_read_b64_tr_b16 %0, %1 offset:%2" : "=&v"(r) : "v"(vb), "i"(OFF) : "memory"); return r;
}
template <int D0> DI void pv_one(f32x16& od, int vb, bf16x8 pa0, bf16x8 pa1, bf16x8 pa2, bf16x8 pa3) {
  const s16x4 l0 = tr_read<v_rd_off(D0, 0, 0)>(vb), h0 = tr_read<v_rd_off(D0, 0, 1)>(vb), l1 = tr_read<v_rd_off(D0, 1, 0)>(vb), h1 = tr_read<v_rd_off(D0, 1, 1)>(vb);
  const s16x4 l2 = tr_read<v_rd_off(D0, 2, 0)>(vb), h2 = tr_read<v_rd_off(D0, 2, 1)>(vb), l3 = tr_read<v_rd_off(D0, 3, 0)>(vb), h3 = tr_read<v_rd_off(D0, 3, 1)>(vb);
  asm volatile("s_waitcnt lgkmcnt(0)" ::: "memory"); SBAR();
#define PK(L, H) (bf16x8){L[0], L[1], L[2], L[3], H[0], H[1], H[2], H[3]}
  od = __builtin_amdgcn_mfma_f32_32x32x16_bf16(pa0, PK(l0, h0), od, 0, 0, 0);
  od = __builtin_amdgcn_mfma_f32_32x32x16_bf16(pa1, PK(l1, h1), od, 0, 0, 0);
  od = __builtin_amdgcn_mfma_f32_32x32x16_bf16(pa2, PK(l2, h2), od, 0, 0, 0);
  od = __builtin_amdgcn_mfma_f32_32x32x16_bf16(pa3, PK(l3, h3), od, 0, 0, 0);
#undef PK
}
DI void pv_d0(f32x16* o, int vb, bf16x8 pa0, bf16x8 pa1, bf16x8 pa2, bf16x8 pa3) {
  pv_one<0>(o[0], vb, pa0, pa1, pa2, pa3); pv_one<1>(o[1], vb, pa0, pa1, pa2, pa3); pv_one<2>(o[2], vb, pa0, pa1, pa2, pa3); pv_one<3>(o[3], vb, pa0, pa1, pa2, pa3);
}
DI void attn_dense_body(const bf16_t* __restrict__ Qb, const bf16_t* __restrict__ Kh, const bf16_t* __restrict__ Vh, const bf16_t* SZb, bf16_t* Ub, int seq, char* lds, int wv) {
  const int tid = otid(wv), wid = tid >> 6, lane = tid & 63, r32 = lane & 31, hi = lane >> 5;
  bf16_t* V_lds = (bf16_t*)lds; bf16_t* K_lds = (bf16_t*)(lds + 2 * SHM_V);
  float* wsf = (float*)(lds + 2 * SHM_V + 2 * SHM_K) + wid * 64; float* li_l = wsf; float* al_l = wsf + 32;
  float m_reg = -1e30f, l_reg = 0; f32x16 o[4] = {}; bf16x8 qr[8];
  const bf16_t* Qw = Qb + (long)(wid * QBLK + r32) * LDQ + hi * 8;
#pragma unroll
  for (int d0 = 0; d0 < 8; ++d0) qr[d0] = *reinterpret_cast<const bf16x8*>(Qw + d0 * 16);
  const int sr = tid >> 4, sc = (tid & 15) * 8, vst0 = v_st(sr, sc), vst1 = v_st(32 + sr, sc);
  const int vb0 = (int)(uintptr_t)V_lds + v_rd_base(lane);
  struct { bf16x8 vs0, vs1, ks0, ks1; } sr_[2];
#define SLOAD(i, k0) do { sr_[i].vs0 = *reinterpret_cast<const bf16x8*>(&Vh[(long)((k0) + sr) * LDK + sc]); sr_[i].vs1 = *reinterpret_cast<const bf16x8*>(&Vh[(long)((k0) + 32 + sr) * LDK + sc]); \
    sr_[i].ks0 = *reinterpret_cast<const bf16x8*>(&Kh[(long)((k0) + sr) * LDK + sc]); sr_[i].ks1 = *reinterpret_cast<const bf16x8*>(&Kh[(long)((k0) + 32 + sr) * LDK + sc]); } while (0)
#define SWRITE(b, i) do { *(bf16x8*)((char*)V_lds + (b) * SHM_V + vst0) = sr_[i].vs0;          \
    *(bf16x8*)((char*)V_lds + (b) * SHM_V + vst1) = sr_[i].vs1; int kc = sc * 2;               \
    *(bf16x8*)((char*)K_lds + (b) * SHM_K + KSWZ(sr, kc)) = sr_[i].ks0;                       \
    *(bf16x8*)((char*)K_lds + (b) * SHM_K + KSWZ(32 + sr, kc)) = sr_[i].ks1; } while (0)
#define SWAIT() asm volatile("s_waitcnt vmcnt(4)" ::: "memory")
#define RESC(a) do { if (__any((a) < 1.f)) { if (hi == 0) al_l[r32] = (a); asm volatile("s_waitcnt lgkmcnt(0)" ::: "memory"); \
    _Pragma("unroll") for (int d = 0; d < 4; ++d) _Pragma("unroll") for (int r = 0; r < 16; ++r) o[d][r] *= al_l[crow(r, hi)]; } } while (0)
  f32x16 pA0, pA1, pB0, pB1; float mnA, mnB, alA, alB; bf16x8 pa0, pa1, pa2, pa3; const int NT = seq / KVBLK;
  constexpr int SE = 0, SO = 1;
  SLOAD(SE, 0); asm volatile("s_waitcnt vmcnt(0)" ::: "memory"); SWRITE(0, SE); __syncthreads();
  qkt(pA0, pA1, K_lds, qr, r32, hi); partialSM(pA0, pA1, m_reg, mnA, alA);
  SLOAD(SO, KVBLK); if (2 < NT) SLOAD(SE, 2 * KVBLK);
  SWAIT(); SWRITE(1, SO); __syncthreads();
  for (int j = 1; j + 1 < NT; j += 2) {
    SBAR(); qkt(pB0, pB1, (bf16_t*)((char*)K_lds + SHM_K), qr, r32, hi);
    finishSM(pA0, pA1, alA, l_reg, pa0, pa1, pa2, pa3); SBAR();
    SLOAD(SO, (j + 2) * KVBLK); SBAR();
    pv_d0(o, vb0, pa0, pa1, pa2, pa3); partialSM(pB0, pB1, m_reg, mnB, alB);
    __syncthreads(); SWAIT(); SWRITE(0, SE);
    RESC(alB); __syncthreads();
    SBAR(); qkt(pA0, pA1, K_lds, qr, r32, hi);
    finishSM(pB0, pB1, alB, l_reg, pa0, pa1, pa2, pa3); SBAR();
    if (j + 3 < NT) SLOAD(SE, (j + 3) * KVBLK); SBAR();
    pv_d0(o, vb0 + (int)SHM_V, pa0, pa1, pa2, pa3); partialSM(pA0, pA1, m_reg, mnA, alA);
    __syncthreads(); SWAIT(); SWRITE(1, SO);
    RESC(alA); __syncthreads();
  }
  SBAR(); qkt(pB0, pB1, (bf16_t*)((char*)K_lds + SHM_K), qr, r32, hi);
  finishSM(pA0, pA1, alA, l_reg, pa0, pa1, pa2, pa3); SBAR();
  pv_d0(o, vb0, pa0, pa1, pa2, pa3); partialSM(pB0, pB1, m_reg, mnB, alB);
  __syncthreads(); RESC(alB);
  finishSM(pB0, pB1, alB, l_reg, pa0, pa1, pa2, pa3); SBAR();
  pv_d0(o, vb0 + (int)SHM_V, pa0, pa1, pa2, pa3);
  u32x4 zq[8];
#pragma unroll
  for (int i = 0; i < 8; ++i) { const int id = tid + 512 * i; zq[i] = *(const u32x4*)(SZb + (long)(id >> 4) * LDQ + (id & 15) * 8); }
  if (hi == 0) li_l[r32] = l_reg; asm volatile("s_waitcnt lgkmcnt(0)" ::: "memory");
  __syncthreads();
  {
    float rli[16];
#pragma unroll
    for (int r = 0; r < 16; ++r) rli[r] = __builtin_amdgcn_rcpf(li_l[crow(r, hi)]);
    char* ost = lds;
#pragma unroll
    for (int r = 0; r < 16; ++r) { char* rowp = ost + (wid * QBLK + crow(r, hi)) * 256 + r32 * 2;
#pragma unroll
      for (int d0 = 0; d0 < 4; ++d0) *(unsigned short*)(rowp + d0 * 64) = (unsigned short)(pk2(o[d0][r] * rli[r], 0.f) & 0xffffu); }
  }
  __syncthreads();
#pragma unroll
  for (int i = 0; i < 8; ++i) { const int id = tid + 512 * i; const int row = id >> 4, ch = id & 15;
    const u32x4 ov = *(const u32x4*)(lds + row * 256 + ch * 16);
    f32x4 a0 = {bf_lo(ov.x), bf_hi(ov.x), bf_lo(ov.y), bf_hi(ov.y)}, a1 = {bf_lo(ov.z), bf_hi(ov.z), bf_lo(ov.w), bf_hi(ov.w)};
    const f32x4 z0 = {bf_lo(zq[i].x), bf_hi(zq[i].x), bf_lo(zq[i].y), bf_hi(zq[i].y)}, z1 = {bf_lo(zq[i].z), bf_hi(zq[i].z), bf_lo(zq[i].w), bf_hi(zq[i].w)};
    st_bf16x8(Ub + (long)row * LDQ + ch * 8, a0 * z0, a1 * z1); }
  __syncthreads();
#undef SLOAD
#undef SWRITE
#undef SWAIT
#undef RESC
}
#undef KSWZ
#undef SBAR
}

DI void qknorm_phase(const Args& A, LAS unsigned char* lds, int wv) {
    const int tid = otid(wv), lane = tid & 63, wave = tid >> 6, G = gridDim.x;
    bf16_t* Q = (bf16_t*)(A.ws + WS_SCR + A_Q); bf16_t* Kb = (bf16_t*)(A.ws + WS_SCR + A_K);
    const float* qn = A.in[14]; const float* kn = A.in[15];
    const int sub = lane >> 4, l16 = lane & 15, e0 = l16 * 8;
    LAS f32x2* rope = (LAS f32x2*)lds;
    for (int e = tid; e < 2048; e += NTHREADS) { const float ang = (float)(e >> 5) * exp2f(-(float)(e & 31) * 0.41524101186092029f); rope[e] = (f32x2){cosf(ang), sinf(ang)}; }
    __syncthreads();
    const long NIT = (long)NTOK * 20;
    for (long it0 = ((long)blockIdx.x * NWAVES + wave) * 16 + sub; it0 < NIT; it0 += (long)G * NWAVES * 16) {
        bf16_t* pq[4]; u32x4 raw[4];
#pragma unroll
        for (int k = 0; k < 4; ++k) { const long it = it0 + 4 * k; const int row = (int)(it / 20), hj = (int)(it % 20);
            pq[k] = (hj < 16) ? Q + (size_t)row * 2048 + hj * 128 + e0 : Kb + (size_t)row * 512 + (hj - 16) * 128 + e0;
            raw[k] = *(const u32x4*)pq[k]; }
#pragma unroll
        for (int k = 0; k < 4; ++k) {
            const long it = it0 + 4 * k; const int row = (int)(it / 20), hj = (int)(it % 20);
            const float* wn = (hj < 16 ? qn : kn) + e0;
            f32x4 a = {bf_lo(raw[k].x), bf_hi(raw[k].x), bf_lo(raw[k].y), bf_hi(raw[k].y)}, b = {bf_lo(raw[k].z), bf_hi(raw[k].z), bf_lo(raw[k].w), bf_hi(raw[k].w)};
            float ss = 0.f;
#pragma unroll
            for (int q = 0; q < 4; ++q) ss += a[q] * a[q] + b[q] * b[q];
            ss += __shfl_xor(ss, 1); ss += __shfl_xor(ss, 2); ss += __shfl_xor(ss, 4); ss += __shfl_xor(ss, 8);
            const float rs = 1.0f / sqrtf(ss * (1.f / 128.f) + EPS);
            const f32x4 w0 = *(const f32x4*)wn, w1 = *(const f32x4*)(wn + 4);
            a = a * rs * w0; b = b * rs * w1;
            const int t = row % TB;
            if (t < TL) {
                const int pos = (l16 < 8) ? (t >> 6) : (t & 63);
                float y[8] = {a[0], a[1], a[2], a[3], b[0], b[1], b[2], b[3]};
                const LAS f32x4* rp = (const LAS f32x4*)(rope + pos * 32 + ((4 * l16) & 31));
                const f32x4 c01 = rp[0], c23 = rp[1];
                const float cs[4] = {c01[0], c01[2], c23[0], c23[2]}, sn[4] = {c01[1], c01[3], c23[1], c23[3]};
#pragma unroll
                for (int pp = 0; pp < 4; ++pp) {
                    const float x0 = y[2 * pp], x1 = y[2 * pp + 1];
                    y[2 * pp] = x0 * cs[pp] - x1 * sn[pp]; y[2 * pp + 1] = x0 * sn[pp] + x1 * cs[pp];
                }
                a = (f32x4){y[0], y[1], y[2], y[3]}; b = (f32x4){y[4], y[5], y[6], y[7]};
            }
            st_bf16x8(pq[k], a, b);
        }
    }
}

DI void attn_layer(const Args& A, LAS unsigned char* lds, char* lds_gen, const XcdBarrier& gbar, int layer, int wv) {
    unsigned char* ws = A.ws;
    const bf16_t* H = (const bf16_t*)(ws + WS_H); bf16_t* U = (bf16_t*)(ws + WS_H);
    bf16_t* Q = (bf16_t*)(ws + WS_SCR + A_Q); bf16_t* Kb = (bf16_t*)(ws + WS_SCR + A_K); bf16_t* Vb = (bf16_t*)(ws + WS_SCR + A_V); bf16_t* SZ = (bf16_t*)(ws + WS_SCR + A_SZ);
    norm_phase(A, layer, false, wv);
    xcd_barrier(gbar, wv);
    {
        DescPlain D; D.init(H, (const bf16_t*)(ws + WS_WAI), 20, false);
        auto E = [=](const pg8::Unit& u, int row_l, int col_l, f32x4 v0, f32x4 v1) {
            const size_t row = (size_t)u.i0 * 256 + row_l; const int pn = u.i1;
            if (pn < 8) st_bf16x8(Q + row * 2048 + pn * 256 + col_l, v0, v1);
            else if (pn < 10) st_bf16x8(Kb + row * 512 + (pn - 8) * 256 + col_l, v0, v1);
            else if (pn < 12) st_bf16x8(Vb + row * 512 + (pn - 10) * 256 + col_l, v0, v1);
            else { f32x4 a, b;
#pragma unroll
                for (int q = 0; q < 4; ++q) { a[q] = siluf(v0[q]); b[q] = siluf(v1[q]); }
                st_bf16x8(SZ + row * 2048 + (pn - 12) * 256 + col_l, a, b); }
        };
        pg8::gemm_phase(lds, D, E, wv);
    }
    xcd_barrier(gbar, wv);
    qknorm_phase(A, lds, wv);
    xcd_barrier(gbar, wv);
    {
        const int G = gridDim.x, c = blockIdx.x;
        for (long L = c; L < 2048; L += G) {
            const int u = pg8::xcd_remap((int)L, 2048);
            const int b = u / 128, rem = u % 128, kvh = rem / 32, g = (rem / 8) % 4, qb = rem % 8, h = kvh * 4 + g;
            const size_t qoff = ((size_t)b * TB + qb * 256) * 2048 + h * 128, koff = ((size_t)b * TB) * 512 + kvh * 128;
            att::attn_dense_body(Q + qoff, Kb + koff, Vb + koff, SZ + qoff, U + qoff, TB, lds_gen, wv);
        }
        for (int u = c; u < 256; u += G) {
            const int b = u / 16, h = u % 16, kvh = h / 4;
            const size_t qoff = ((size_t)b * TB + TL) * 2048 + h * 128, koff = ((size_t)b * TB + TL) * 512 + kvh * 128;
            att::attn_dense_body(Q + qoff, Kb + koff, Vb + koff, SZ + qoff, U + qoff, TC, lds_gen, wv);
        }
    }
    xcd_barrier(gbar, wv);
    {
        DescPlain D; D.init(U, (const bf16_t*)(ws + WS_WAO), 8, false);
        const float* modl = (const float*)(ws + WS_MOD) + (size_t)layer * 17 * MOD_LD;
        auto E = [=](const pg8::Unit& u, int row_l, int col_l, f32x4 v0, f32x4 v1) { resid_store(A, layer, u.i0, row_l, u.i1 * 256 + col_l, modl, v0, v1); };
        pg8::gemm_phase(lds, D, E, wv);
    }
    xcd_barrier(gbar, wv);
}


struct DescM1 {
    const bf16_t* H; const bf16_t* WA; const bf16_t* WB; int lda, ldb, K, total;
    DI void init(const bf16_t* H_, const bf16_t* WA_, const bf16_t* WB_) { H = H_; WA = WA_; WB = WB_; lda = DM; ldb = DM; K = DM; total = 144 * 9 + 12 * 144; }
    DI pg8::Unit unit(int idx) const {
        pg8::Unit u;
        if (idx < 1296) { const int nig = 72, gid = idx / nig, pm = gid * 8 + (idx % nig) % 8, pn = (idx % nig) / 8;
            u.a = (const char*)(H + (size_t)pm * 256 * DM); u.b = (const char*)(WA + (size_t)pn * 256 * DM); u.i0 = pm; u.i1 = pn; u.i2 = 0; }
        else { const int j = idx - 1296, mt = j % 12, nt = j / 12;
            u.a = (const char*)(WB + (size_t)mt * 256 * DM); u.b = (const char*)(H + (size_t)nt * 256 * DM); u.i0 = mt; u.i1 = nt; u.i2 = 1; }
        return u;
    }
};
namespace ml {
#define MFMA32(a, b, c) __builtin_amdgcn_mfma_f32_32x32x16_bf16((a), (b), (c), 0, 0, 0)
#define LFENCE() asm volatile("s_waitcnt lgkmcnt(0)" ::: "memory")
DI float dot2_bf16(unsigned a, unsigned b, float c) { asm("v_dot2c_f32_bf16 %0, %1, %2" : "+v"(c) : "v"(a), "v"(b)); return c; }
#define DOT2(a, b, c) dot2_bf16((a), (b), (c))
DI int crow(int reg, int h) { return (reg & 3) + 8 * (reg >> 2) + 4 * h; }
DI bf16x8 ldperm(const bf16_t* p) { const s16x4 lo = *(const s16x4*)p, hi = *(const s16x4*)(p + 8); return __builtin_shufflevector(lo, hi, 0, 1, 2, 3, 4, 5, 6, 7); }
DI bf16x8 pack_step(const f32x16& x, int s) { u32x4 p = {pk2(x[8 * s], x[8 * s + 1]), pk2(x[8 * s + 2], x[8 * s + 3]), pk2(x[8 * s + 4], x[8 * s + 5]), pk2(x[8 * s + 6], x[8 * s + 7])}; return __builtin_bit_cast(bf16x8, p); }
DI float bfs(short h) { return __uint_as_float(((unsigned)(unsigned short)h) << 16); }

constexpr int SC_Q = 0, SC_K = 16384, SC_KT = 32768, SC_BUF = 49152, SC_WAVE = 2 * SC_BUF, SC_WAVE_BYTES = 6656;
DI bf16x8 ldsfrag(const LAS unsigned char* buf, unsigned o) { const s16x4 lo = *(const LAS s16x4*)(buf + o), hi = *(const LAS s16x4*)(buf + (o ^ 16u)); return __builtin_shufflevector(lo, hi, 0, 1, 2, 3, 4, 5, 6, 7); }
DI void scan_phase(const Args& A, LAS unsigned char* lds, int wv) {
    const int wave = wv;
    LAS float* wl = (LAS float*)(lds + SC_WAVE + wave * SC_WAVE_BYTES);
    LAS unsigned* nbp = (LAS unsigned*)(lds + SC_WAVE + wave * SC_WAVE_BYTES + 2048);
    LAS unsigned* wbp = nbp + 64;
    LAS unsigned char* hst = lds + SC_WAVE + wave * SC_WAVE_BYTES + 2560;
    unsigned char* ws = A.ws;
    const bf16_t* Qg = (const bf16_t*)(ws + WS_SCR + M_Q); const bf16_t* Kg = (const bf16_t*)(ws + WS_SCR + M_K); const bf16_t* KVT = (const bf16_t*)(ws + WS_SCR + M_KVT);
    const float* G32 = (const float*)(ws + WS_SCR + M_G32); const float* bg = A.in[10];
#define SC_POS0(j) (dir == 0 ? ((j) < 4 ? TL + 64 * (j) : 64 * ((j) - 4)) : ((j) < 4 ? TL + 64 * (3 - (j)) : 64 * (35 - (j))))
#define SC_DMA(bufi, p0) do { const int tj_ = otid(wv); _Pragma("unroll") for (int i_ = 0; i_ < 2; ++i_) { const int sl_ = i_ * 512 + tj_; \
        { const int row_ = sl_ >> 4, c_ = (sl_ & 15) ^ (row_ & 15); const size_t go_ = (size_t)((p0) + row_) * 1024 + c_ * 8; \
          __builtin_amdgcn_global_load_lds((const unsigned*)(Qu + go_), (LAS unsigned*)(lds + (bufi) * SC_BUF + SC_Q + i_ * 8192 + wave * 1024), 16, 0, 0); \
          __builtin_amdgcn_global_load_lds((const unsigned*)(Ku + go_), (LAS unsigned*)(lds + (bufi) * SC_BUF + SC_K + i_ * 8192 + wave * 1024), 16, 0, 0); } \
        { const int d_ = sl_ >> 3, c_ = (sl_ & 7) ^ ((d_ >> 1) & 7); \
          __builtin_amdgcn_global_load_lds((const unsigned*)(KTu + (size_t)d_ * TB + (p0) + c_ * 8), (LAS unsigned*)(lds + (bufi) * SC_BUF + SC_KT + i_ * 8192 + wave * 1024), 16, 0, 0); } } } while (0)
    for (int item = blockIdx.x; item < 256; item += gridDim.x) {
        const int dir = item & 1, h = (item >> 1) & 7, b = item >> 4, e0 = wave * 32;
        const bf16_t* Qu = Qg + (size_t)b * TB * 1024 + h * 128;
        const bf16_t* Ku = Kg + (size_t)b * TB * 1024 + h * 128;
        const bf16_t* KTu = KVT + ((size_t)b * 3072 + h * 128) * TB;
        const bf16_t* VTu = KVT + ((size_t)b * 3072 + 1024 + h * 256 + e0) * TB;
        bf16_t* Hout = (bf16_t*)(ws + WS_SCR + (dir ? M_HB : M_HF)) + (size_t)b * TB * DM + h * 256 + e0;
        const float big = bg[(dir * 2) * 8 + h], bfg = bg[(dir * 2 + 1) * 8 + h];
        f32x16 cacc[4];
#pragma unroll
        for (int d = 0; d < 4; ++d)
#pragma unroll
            for (int i = 0; i < 16; ++i) cacc[d][i] = 0.f;
        float m = 0.f;
        { const int l0 = otid(wv) & 63; wl[384 + l0] = 0.f; wl[448 + l0] = 0.f; nbp[l0] = 0u; }
        LFENCE();
        SC_DMA(0, SC_POS0(0));
        float ig_n, fg_n;
        { const int l0 = otid(wv) & 63; const float* gp = G32 + (size_t)(b * TB + SC_POS0(0) + (dir ? 63 - l0 : l0)) * 32 + (dir * 2) * 8 + h; ig_n = gp[0]; fg_n = gp[8]; }
        for (int j = 0; j < 36; ++j) {
            const int pos0 = SC_POS0(j);
            const LAS unsigned char* Qb = lds + (j & 1) * SC_BUF + SC_Q; const LAS unsigned char* Kb = lds + (j & 1) * SC_BUF + SC_K; const LAS unsigned char* KTb = lds + (j & 1) * SC_BUF + SC_KT;
            asm volatile("s_waitcnt vmcnt(0)" ::: "memory"); __builtin_amdgcn_s_barrier(); asm volatile("" ::: "memory");
            if (j + 1 < 36) SC_DMA((j + 1) & 1, SC_POS0(j + 1));
            const int lj = otid(wv) & 63, rj = lj & 31, h4 = (lj >> 5) * 4;
            LAS float* wh = wl + h4; LAS float* wr = wl + rj; LAS unsigned char* hb = hst + h4 * 64 + rj * 2;
            const LAS unsigned* nbh = nbp + (h4 >> 1); const LAS unsigned* wbh = wbp + (h4 >> 1);
            const unsigned xr = rj & 15, xd = (rj >> 1) & 7;
            const unsigned qro = (unsigned)rj * 256u + 2u * h4;
            const unsigned kro = (unsigned)rj * 128u + 2u * h4;
            const bf16_t* VTp = VTu + (size_t)rj * TB + pos0 + h4;
            bf16x8 vf[4];
#pragma unroll
            for (int kk = 0; kk < 4; ++kk) vf[kk] = ldperm(VTp + 16 * kk);
            float decay, m_new;
            {
                const int s = dir ? 63 - lj : lj;
                const float ig = ig_n + big, fg = fg_n + bfg;
                if (j + 1 < 36) { const float* gp = G32 + (size_t)(b * TB + SC_POS0(j + 1) + s) * 32 + (dir * 2) * 8 + h; ig_n = gp[0]; fg_n = gp[8]; }
                const float lf = fminf(fg, 0.f) - log1pf(__expf(-fabsf(fg)));
                float bs = lf;
#pragma unroll
                for (int o = 1; o < 64; o <<= 1) { const float t = __shfl_up(bs, o); if (lj >= o) bs += t; }
                const float uu = ig - bs;
                float pmx = uu;
#pragma unroll
                for (int o = 1; o < 64; o <<= 1) { const float t = __shfl_up(pmx, o); if (lj >= o) pmx = fmaxf(pmx, t); }
                pmx = fmaxf(pmx, m);
                const float b_end = __shfl(bs, 63), pm_last = __shfl(pmx, 63);
                LAS float* ws_ = wl + s;
                ws_[0] = uu * 1.4426950408889634f; ws_[64] = pmx * 1.4426950408889634f; ws_[128] = __expf(m - pmx); ws_[192] = __expf(-(bs + pmx)); ws_[256] = __expf(uu - pm_last);
                { const float wv_ = __expf(uu - pm_last), wp_ = __shfl_xor(wv_, 1); if ((s & 1) == 0) wbp[s >> 1] = pk2(wv_, wp_); }
                decay = __expf(m - pm_last); m_new = b_end + pm_last;
            }
            LFENCE();
            const int sbase = dir ? 63 - h4 : h4, sgn = dir ? -1 : 1;
#pragma unroll
            for (int tb = 0; tb < 2; ++tb) {
                __builtin_amdgcn_sched_barrier(0);
                const unsigned qo = qro + tb * 8192u;
                f32x16 ha;
#pragma unroll
                for (int i = 0; i < 16; ++i) ha[i] = 0.f;
                float qnv = 0.f;
#pragma unroll
                for (int kk = 0; kk < 8; ++kk) {
                    const bf16x8 qa = ldsfrag(Qb, qo + (((2u * kk) ^ xr) << 4));
                    ha = MFMA32(qa, pack_step(cacc[kk >> 1], kk & 1), ha);
                    { const u32x2 nb0 = *(const LAS u32x2*)(nbh + 8 * kk), nb1 = *(const LAS u32x2*)(nbh + 8 * kk + 4); const u32x4 qw = __builtin_bit_cast(u32x4, qa);
                      qnv = DOT2(qw.x, nb0.x, qnv); qnv = DOT2(qw.y, nb0.y, qnv); qnv = DOT2(qw.z, nb1.x, qnv); qnv = DOT2(qw.w, nb1.y, qnv); }
                }
                qnv += __shfl_xor(qnv, 32);
#pragma unroll
                for (int g = 0; g < 4; ++g) { const f32x4 av = *(const LAS f32x4*)(wh + 128 + 32 * tb + 8 * g);
#pragma unroll
                    for (int q = 0; q < 4; ++q) ha[4 * g + q] *= av[q]; }
                const float pmt = wr[64 + 32 * tb];
                const int tp = dir ? (63 - 32 * tb) - rj : 32 * tb + rj;
                float ds = 0.f;
#pragma unroll
                for (int sb = 0; sb < 2; ++sb) {
                    __builtin_amdgcn_sched_barrier(0);
                    if (sb != tb && (dir ? sb < tb : sb > tb)) continue;
                    const unsigned ko = qro + sb * 8192u;
                    f32x16 st;
#pragma unroll
                    for (int i = 0; i < 16; ++i) st[i] = 0.f;
#pragma unroll
                    for (int kk = 0; kk < 8; ++kk) { const unsigned c = ((2u * kk) ^ xr) << 4; st = MFMA32(ldsfrag(Kb, ko + c), ldsfrag(Qb, qo + c), st); }
#pragma unroll
                    for (int g = 0; g < 4; ++g) { const f32x4 uv = *(const LAS f32x4*)(wh + 32 * sb + 8 * g);
#pragma unroll
                        for (int q = 0; q < 4; ++q) {
                            const int sc = 32 * sb + q + 8 * g;
                            const int sp = sbase + sgn * sc;
                            st[4 * g + q] *= __builtin_amdgcn_exp2f((sp <= tp) ? uv[q] - pmt : -1e30f);
                            ds += st[4 * g + q];
                        } }
                    ha = MFMA32(pack_step(st, 0), vf[2 * sb], ha);
                    ha = MFMA32(pack_step(st, 1), vf[2 * sb + 1], ha);
                }
                ds += __shfl_xor(ds, 32);
                {
                    const float den = wr[128 + 32 * tb] * qnv + ds;
                    const float rd = 1.0f / fmaxf(fabsf(den), wr[192 + 32 * tb]);
                    if (h4 == 0) wr[320 + 32 * tb] = rd;
                }
                LFENCE();
#pragma unroll
                for (int g = 0; g < 4; ++g) { const f32x4 rv = *(const LAS f32x4*)(wh + 320 + 32 * tb + 8 * g);
#pragma unroll
                    for (int q = 0; q < 4; ++q) { const int tc = 32 * tb + q + 8 * g;
                        *(LAS unsigned short*)(hb + tc * 64) = (unsigned short)(pk2(ha[4 * g + q] * rv[q], 0.f) & 0xffffu); } }
            }
            LFENCE();
            {
                bf16_t* hp = Hout + (size_t)(pos0 + lj) * DM;
                const LAS unsigned char* hrow = hst + lj * 64;
#pragma unroll
                for (int q = 0; q < 4; ++q) *(u32x4*)(hp + 8 * q) = *(const LAS u32x4*)(hrow + 16 * q);
            }
            __builtin_amdgcn_sched_barrier(0);
            bf16x8 vfw[4];
#pragma unroll
            for (int kk = 0; kk < 4; ++kk) {
                const f32x4 w0 = *(const LAS f32x4*)(wh + 256 + 16 * kk), w1 = *(const LAS f32x4*)(wh + 256 + 16 * kk + 8);
                u32x4 p = {pk2(bfs(vf[kk][0]) * w0[0], bfs(vf[kk][1]) * w0[1]), pk2(bfs(vf[kk][2]) * w0[2], bfs(vf[kk][3]) * w0[3]),
                           pk2(bfs(vf[kk][4]) * w1[0], bfs(vf[kk][5]) * w1[1]), pk2(bfs(vf[kk][6]) * w1[2], bfs(vf[kk][7]) * w1[3])};
                vfw[kk] = __builtin_bit_cast(bf16x8, p);
            }
#pragma unroll
            for (int db = 0; db < 4; ++db) {
                if (db == 2) __builtin_amdgcn_sched_barrier(0);
#pragma unroll
                for (int i = 0; i < 16; ++i) cacc[db][i] *= decay;
                const unsigned to = kro + db * 4096u;
                float nadd = 0.f;
#pragma unroll
                for (int kk = 0; kk < 4; ++kk) {
                    const bf16x8 kv = ldsfrag(KTb, to + (((2u * kk) ^ xd) << 4));
                    const u32x2 wq0 = *(const LAS u32x2*)(wbh + 8 * kk), wq1 = *(const LAS u32x2*)(wbh + 8 * kk + 4); const u32x4 kw = __builtin_bit_cast(u32x4, kv);
                    nadd = DOT2(kw.x, wq0.x, nadd); nadd = DOT2(kw.y, wq0.y, nadd); nadd = DOT2(kw.z, wq1.x, nadd); nadd = DOT2(kw.w, wq1.y, nadd);
                    cacc[db] = MFMA32(kv, vfw[kk], cacc[db]);
                }
                nadd += __shfl_xor(nadd, 32);
                const float nnew = decay * wr[384 + 32 * db] + nadd, npart = __shfl_xor(nnew, 1);
                if (h4 == 0) { wr[384 + 32 * db] = nnew; if ((rj & 1) == 0) nbp[(32 * db + rj) >> 1] = pk2(nnew, npart); }
            }
            LFENCE();
            m = m_new;
        }
        asm volatile("s_waitcnt vmcnt(0)" ::: "memory"); __builtin_amdgcn_s_barrier();
    }
#undef SC_DMA
#undef SC_POS0
}
#undef MFMA32
#undef LFENCE
#undef DOT2
}

DI void mlstm_finish_phase(const Args& A, int wv) {
    const int tid = otid(wv), lane = tid & 63, wave = tid >> 6, G = gridDim.x;
    unsigned char* ws = A.ws;
    const bf16_t* HF = (const bf16_t*)(ws + WS_SCR + M_HF); const bf16_t* HB = (const bf16_t*)(ws + WS_SCR + M_HB);
    const bf16_t* SO = (const bf16_t*)(ws + WS_SCR + M_SO); const bf16_t* SZ = (const bf16_t*)(ws + WS_SCR + M_SZ);
    bf16_t* U = (bf16_t*)(ws + WS_H); const float* hn = A.in[11];
    const int sub = lane >> 5, e0 = (lane & 31) * 8;
    const long NIT = (long)NTOK * 8;
    for (long it0 = ((long)blockIdx.x * NWAVES + wave) * 4 + sub; it0 < NIT; it0 += (long)G * NWAVES * 4) {
        f32x4 f0[2], f1[2], b0[2], b1[2], o0[2], o1[2], z0[2], z1[2];
#pragma unroll
        for (int k = 0; k < 2; ++k) { const long it = it0 + 2 * k; const size_t off = (size_t)(it >> 3) * DM + (int)(it & 7) * 256 + e0;
            ld_bf16x8(HF + off, f0[k], f1[k]); ld_bf16x8(HB + off, b0[k], b1[k]); ld_bf16x8(SO + off, o0[k], o1[k]); ld_bf16x8(SZ + off, z0[k], z1[k]); }
#pragma unroll
        for (int k = 0; k < 2; ++k) { const long it = it0 + 2 * k; const size_t off = (size_t)(it >> 3) * DM + (int)(it & 7) * 256 + e0;
            f32x4 y0 = o0[k] * (f0[k] + b0[k]), y1 = o1[k] * (f1[k] + b1[k]);
            float ss = 0.f;
#pragma unroll
            for (int q = 0; q < 4; ++q) ss += y0[q] * y0[q] + y1[q] * y1[q];
            ss += __shfl_xor(ss, 1); ss += __shfl_xor(ss, 2); ss += __shfl_xor(ss, 4); ss += __shfl_xor(ss, 8); ss += __shfl_xor(ss, 16);
            const float rs = 1.0f / sqrtf(ss * (1.f / 256.f) + EPS);
            const float* hp = hn + (int)(it & 7) * 256 + e0;
            const f32x4 h0 = *(const f32x4*)hp, h1 = *(const f32x4*)(hp + 4);
            st_bf16x8(U + off, y0 * rs * h0 * z0[k], y1 * rs * h1 * z1[k]); }
    }
}

DI void mlstm_layer(const Args& A, LAS unsigned char* lds, const XcdBarrier& gbar, int layer, int wv) {
    unsigned char* ws = A.ws;
    const bf16_t* H = (const bf16_t*)(ws + WS_H); bf16_t* U = (bf16_t*)(ws + WS_H);
    bf16_t* Q = (bf16_t*)(ws + WS_SCR + M_Q); bf16_t* Kb = (bf16_t*)(ws + WS_SCR + M_K); bf16_t* KVT = (bf16_t*)(ws + WS_SCR + M_KVT);
    float* G32 = (float*)(ws + WS_SCR + M_G32); bf16_t* SO = (bf16_t*)(ws + WS_SCR + M_SO); bf16_t* SZ = (bf16_t*)(ws + WS_SCR + M_SZ);
    norm_phase(A, layer, false, wv);
    xcd_barrier(gbar, wv);
    {
        DescM1 D; D.init(H, (const bf16_t*)(ws + WS_WMA), (const bf16_t*)(ws + WS_WMB));
        auto E = [=](const pg8::Unit& u, int row_l, int col_l, f32x4 v0, f32x4 v1) {
            if (u.i2 == 0) {
                const size_t row = (size_t)u.i0 * 256 + row_l; const int pn = u.i1;
                if (pn < 4) st_bf16x8(Q + row * 1024 + pn * 256 + col_l, v0 * 0.088388347648318440f, v1 * 0.088388347648318440f);
                else if (pn < 8) st_bf16x8(Kb + row * 1024 + (pn - 4) * 256 + col_l, v0, v1);
                else if (col_l < 32) { *(f32x4*)(G32 + row * 32 + col_l) = v0; *(f32x4*)(G32 + row * 32 + col_l + 4) = v1; }
            } else {
                const int bb = u.i1 / 9, s0 = (u.i1 % 9) * 256;
                st_bf16x8(KVT + ((size_t)bb * 3072 + u.i0 * 256 + row_l) * TB + s0 + col_l, v0, v1);
            }
        };
        pg8::gemm_phase(lds, D, E, wv);
    }
    xcd_barrier(gbar, wv);
    ml::scan_phase(A, lds, wv);
    xcd_barrier(gbar, wv);
    {
        DescPlain D; D.init(H, (const bf16_t*)(ws + WS_WMA) + (size_t)2304 * DM, 16, false);
        auto E = [=](const pg8::Unit& u, int row_l, int col_l, f32x4 v0, f32x4 v1) {
            const size_t row = (size_t)u.i0 * 256 + row_l; const int pn = u.i1; f32x4 a, b;
            if (pn < 8) {
#pragma unroll
                for (int q = 0; q < 4; ++q) { a[q] = sigmf(v0[q]); b[q] = sigmf(v1[q]); }
                st_bf16x8(SO + row * DM + pn * 256 + col_l, a, b);
            } else {
#pragma unroll
                for (int q = 0; q < 4; ++q) { a[q] = siluf(v0[q]); b[q] = siluf(v1[q]); }
                st_bf16x8(SZ + row * DM + (pn - 8) * 256 + col_l, a, b);
            }
        };
        pg8::gemm_phase(lds, D, E, wv);
    }
    xcd_barrier(gbar, wv);
    mlstm_finish_phase(A, wv);
    xcd_barrier(gbar, wv);
    {
        DescPlain D; D.init(U, (const bf16_t*)(ws + WS_WMO), 8, false);
        const float* modl = (const float*)(ws + WS_MOD) + (size_t)layer * 17 * MOD_LD;
        auto E = [=](const pg8::Unit& u, int row_l, int col_l, f32x4 v0, f32x4 v1) { resid_store(A, layer, u.i0, row_l, u.i1 * 256 + col_l, modl, v0, v1); };
        pg8::gemm_phase(lds, D, E, wv);
    }
    xcd_barrier(gbar, wv);
}

__global__ void __launch_bounds__(NTHREADS, 2) fwd_megakernel(Args A) {
    extern __shared__ __attribute__((aligned(16))) unsigned char lds_raw[];
    LAS unsigned char* lds = (LAS unsigned char*)lds_raw;
    cg::grid_group grid = cg::this_grid();
    const int wv = __builtin_amdgcn_readfirstlane(threadIdx.x >> 6);
    volatile LAS unsigned* bst = (volatile LAS unsigned*)(lds + 152576);
    if (otid(wv) < 2) bst[otid(wv)] = 0u;
    __syncthreads();
    const XcdBarrier gbar = xcd_barrier_post((unsigned*)(A.ws + WS_BAR), bst, wv);
    prep_phase(A, lds, wv);
    grid.sync();
    {
        const long long* mi = (const long long*)(A.ws + WS_MODI); float* mf = (float*)(A.ws + WS_MOD);
        for (int i = blockIdx.x * NTHREADS + otid(wv); i < 4 * 17 * MOD_LD; i += gridDim.x * NTHREADS) mf[i] = (float)mi[i] * MODI_INV;
    }
    xcd_barrier(gbar, wv);
    fnet_layer(A, lds, gbar, 0, 0, false, wv);
    mlstm_layer(A, lds, gbar, 1, wv);
    attn_layer(A, lds, (char*)lds_raw, gbar, 2, wv);
    fnet_layer(A, lds, gbar, 3, 1, true, wv);
    final_norm_phase(A, (const float*)(A.ws + WS_SCR + F_PQX), wv);
}

extern "C" void kernel_launch(void* const* d_in, const int* in_sizes, int n_in, void* d_out, int out_size, void* d_ws, size_t ws_size, hipStream_t stream) {
    static int grid = 0;
    if (grid == 0) {
        if (n_in != 18 || ws_size < WS_END) { fprintf(stderr, "kernel_launch: unexpected n_in %d / ws_size %zu (need %zu)\n", n_in, ws_size, (size_t)WS_END); grid = -1; return; }
        int dev = 0, cus = 0, per_cu = 0;
        hipGetDevice(&dev);
        hipDeviceGetAttribute(&cus, hipDeviceAttributeMultiprocessorCount, dev);
        if (hipFuncSetAttribute((const void*)fwd_megakernel, hipFuncAttributeMaxDynamicSharedMemorySize, LDS_BYTES) != hipSuccess) { fprintf(stderr, "kernel_launch: hipFuncSetAttribute failed\n"); grid = -1; return; }
        if (hipOccupancyMaxActiveBlocksPerMultiprocessor(&per_cu, (const void*)fwd_megakernel, NTHREADS, LDS_BYTES) != hipSuccess || per_cu < 1) { fprintf(stderr, "kernel_launch: occupancy query failed (%d)\n", per_cu); per_cu = 1; }
        (void)hipGetLastError();
        grid = cus * per_cu;
        fprintf(stderr, "kernel_launch: grid %d (cus %d x %d)\n", grid, cus, per_cu);
    }
    if (grid < 0) return;
    (void)hipMemsetAsync((char*)d_ws + WS_MOD, 0, ZERO_BYTES, stream);
    (void)hipMemsetAsync((char*)d_ws + WS_MODI, 0, MODI_BYTES, stream);
    Args a{};
    for (int i = 0; i < 18; ++i) a.in[i] = (const float*)d_in[i];
    a.out = (float*)d_out; a.ws = (unsigned char*)d_ws; a.ph_lo = 0; a.ph_hi = 100;
    void* args[] = {&a};
    hipError_t e = hipLaunchCooperativeKernel((const void*)fwd_megakernel, dim3(grid), dim3(NTHREADS), args, LDS_BYTES, stream);
    if (e != hipSuccess) fprintf(stderr, "kernel_launch: cooperative launch failed: %s (grid %d)\n", hipGetErrorString(e), grid);
}
```

```cpp
#include <hip/hip_runtime.h>
#include <hip/hip_cooperative_groups.h>
#include <cstdio>
#include <cstdint>
namespace cg = cooperative_groups;

#define LAS __attribute__((address_space(3)))
#define DI __device__ __forceinline__
typedef unsigned short bf16_t;
typedef short bf16x8 __attribute__((ext_vector_type(8)));
typedef short s16x4 __attribute__((ext_vector_type(4)));
typedef float f32x2 __attribute__((ext_vector_type(2)));
typedef float f32x4 __attribute__((ext_vector_type(4)));
typedef float f32x16 __attribute__((ext_vector_type(16)));
typedef unsigned u32x2 __attribute__((ext_vector_type(2)));
typedef unsigned u32x4 __attribute__((ext_vector_type(4)));
typedef __bf16 bf16v2 __attribute__((ext_vector_type(2)));

constexpr int DM = 2048, NB = 16, TL = 2048, TC = 256, TB = TL + TC, NTOK = NB * TB;
constexpr int NWAVES = 8, NTHREADS = 512;
constexpr float EPS = 1e-6f;
constexpr int MOD_LD = 3 * DM;
constexpr int M_WA_ROWS = 6400, M_WB_ROWS = 3072;
constexpr size_t MiB = 1u << 20;
constexpr size_t WS_SCR_ = 301 * MiB;
constexpr size_t WS_MOD = 0;
constexpr size_t MOD_BYTES = (size_t)4 * 17 * MOD_LD * 4;
constexpr size_t WS_BAR = 1792 * 1024, ZERO_BYTES = 2 * MiB;
constexpr size_t WS_MODI = WS_SCR_ + 700 * MiB, MODI_BYTES = (size_t)4 * 17 * MOD_LD * 8;
constexpr float MODI_SCALE = 1073741824.f, MODI_INV = 9.313225746154785e-10f;
constexpr size_t WS_WFG = 2 * MiB, WS_WFO = 18 * MiB, WS_WMA = 34 * MiB, WS_WMB = 59 * MiB, WS_WMO = 71 * MiB, WS_WAI = 79 * MiB, WS_WAO = 99 * MiB;
constexpr size_t WS_DC = 107 * MiB, WS_DT = 108 * MiB, WS_DT2 = 124 * MiB, WS_CTXS = 125 * MiB, WS_H = 157 * MiB, WS_SCR = 301 * MiB;
constexpr size_t WS_END = 1024 * MiB;
constexpr size_t F_G = 0, F_PQX = 144 * MiB, F_PQC = 400 * MiB, F_A1 = 432 * MiB;
constexpr size_t M_Q = 0, M_K = 72 * MiB, M_KVT = 144 * MiB, M_G32 = 360 * MiB, M_HF = 365 * MiB, M_HB = 509 * MiB, M_SO = 0, M_SZ = 144 * MiB;
constexpr size_t A_Q = 0, A_K = 144 * MiB, A_V = 180 * MiB, A_SZ = 216 * MiB;
static_assert(WS_SCR + M_HB + 144 * MiB <= WS_END, "ws map");
constexpr int LDS_BYTES = 152576 + 1024;

DI unsigned pk2(float a, float b) { f32x2 v = {a, b}; return __builtin_bit_cast(unsigned, __builtin_convertvector(v, bf16v2)); }
DI float bf_lo(unsigned w) { return __uint_as_float(w << 16); }
DI float bf_hi(unsigned w) { return __uint_as_float(w & 0xffff0000u); }
DI float wave_sum(float v) {
#pragma unroll
    for (int o = 1; o < 64; o <<= 1) v += __shfl_xor(v, o);
    return v;
}
DI int otid(int wv) { int t; asm volatile("v_mbcnt_lo_u32_b32 %0, -1, 0\n\tv_mbcnt_hi_u32_b32 %0, -1, %0" : "=v"(t)); return wv * 64 + t; }
DI float siluf(float x) { return x / (1.f + __expf(-x)); }
DI float sigmf(float x) { return 1.f / (1.f + __expf(-x)); }
DI void st_bf16x8(bf16_t* p, f32x4 a, f32x4 b) { u32x4 w = {pk2(a[0], a[1]), pk2(a[2], a[3]), pk2(b[0], b[1]), pk2(b[2], b[3])}; *(u32x4*)p = w; }
DI void ld_bf16x8(const bf16_t* p, f32x4& a, f32x4& b) { const u32x4 w = *(const u32x4*)p; a = (f32x4){bf_lo(w.x), bf_hi(w.x), bf_lo(w.y), bf_hi(w.y)}; b = (f32x4){bf_lo(w.z), bf_hi(w.z), bf_lo(w.w), bf_hi(w.w)}; }

DI f32x4 ldmod4(const long long* p) { return (f32x4){(float)p[0] * MODI_INV, (float)p[1] * MODI_INV, (float)p[2] * MODI_INV, (float)p[3] * MODI_INV}; }

struct Args { const float* in[18]; float* out; unsigned char* ws; int ph_lo, ph_hi; };

#define XB_TMO      128
#define XB_XCNT(j)  (256  + 64 * (j))
#define XB_XSUB(j)  (1280 + 64 * (j))
#define XB_XGEN(j)  (2304 + 64 * (j))
#define XB_TOP      3328
#define XB_TOPGEN   3392
#define XCD_BAR_WORDS 3456
#define XB_SPIN_CAP (1u << 18)

__device__ __forceinline__ unsigned xb_ld(unsigned* p)              { return __hip_atomic_load(p, __ATOMIC_RELAXED, __HIP_MEMORY_SCOPE_AGENT); }
__device__ __forceinline__ unsigned xb_add(unsigned* p, unsigned v) { return __hip_atomic_fetch_add(p, v, __ATOMIC_RELAXED, __HIP_MEMORY_SCOPE_AGENT); }
__device__ __forceinline__ unsigned xb_xcc_id() { return (unsigned)__builtin_amdgcn_s_getreg((3 << 11) | 20) & 0xFu; }
#define XB_SPIN(cond, bar) do { unsigned _sp = 0; while (cond) { __builtin_amdgcn_s_sleep(1); \
    if ((++_sp & 255u) == 0u) { if (xb_ld(&(bar)[XB_TMO])) break; if (_sp > XB_SPIN_CAP) { atomicAdd(&(bar)[XB_TMO], 1u); break; } } } } while (0)

struct XcdBarrier {
    unsigned* bar; unsigned x;
    volatile LAS unsigned* st;
};

__device__ __forceinline__ XcdBarrier xcd_barrier_post(unsigned* bar, volatile LAS unsigned* st, int wv) {
    XcdBarrier b; b.bar = bar; b.x = xb_xcc_id(); b.st = st;
    if (otid(wv) == 0) (void)xb_add(&bar[XB_XCNT(b.x)], 1u);
    return b;
}
__device__ __forceinline__ void xcd_barrier_complete(unsigned* bar, unsigned x, unsigned& nloc, unsigned& nx) {
    const unsigned G = gridDim.x * gridDim.y * gridDim.z;
    unsigned sum, cnt, mine, sp = 0u;
    for (;;) {
        sum = 0u; cnt = 0u; mine = 0u;
#pragma unroll
        for (unsigned j = 0; j < 16; ++j) { const unsigned c = xb_ld(&bar[XB_XCNT(j)]); sum += c; cnt += (c > 0u) ? 1u : 0u; mine = (j == x) ? c : mine; }
        if (sum == G) break;
        __builtin_amdgcn_s_sleep(1);
        if ((++sp & 255u) == 0u) { if (xb_ld(&bar[XB_TMO])) break; if (sp > XB_SPIN_CAP) { atomicAdd(&bar[XB_TMO], 1u); break; } }
    }
    nloc = mine > 0u ? mine : 1u; nx = cnt > 0u ? cnt : 1u;
}

__device__ __forceinline__ void xcd_barrier(const XcdBarrier& b, int wv) {
    asm volatile("s_waitcnt vmcnt(0)" ::: "memory");
    __syncthreads();
    if (otid(wv) == 0) {
        unsigned* bar = b.bar;
        __builtin_amdgcn_s_waitcnt(0);
        unsigned nloc = b.st[0], nx = b.st[1];
        if (nloc == 0u) { xcd_barrier_complete(bar, b.x, nloc, nx); b.st[0] = nloc; b.st[1] = nx; }
        const unsigned old = xb_add(&bar[XB_XSUB(b.x)], 1u);
        const unsigned gen = old / nloc;
        if (old + 1u == (gen + 1u) * nloc) {
            __builtin_amdgcn_fence(__ATOMIC_RELEASE, "agent");
            asm volatile("s_waitcnt vmcnt(0)" ::: "memory");
            const unsigned og = xb_add(&bar[XB_TOP], 1u);
            const unsigned tg = og / nx;
            if (og + 1u == (tg + 1u) * nx) xb_add(&bar[XB_TOPGEN], 1u);
            else XB_SPIN(xb_ld(&bar[XB_TOPGEN]) == tg, bar);
            __builtin_amdgcn_fence(__ATOMIC_ACQUIRE, "agent");
            xb_add(&bar[XB_XGEN(b.x)], 1u);
            asm volatile("s_waitcnt vmcnt(0)" ::: "memory");
        } else {
            XB_SPIN(xb_ld(&bar[XB_XGEN(b.x)]) == gen, bar);
            __builtin_amdgcn_fence(__ATOMIC_ACQUIRE, "agent");
            asm volatile("s_waitcnt vmcnt(0)" ::: "memory");
        }
    }
    __syncthreads();
}


namespace pg8 {
constexpr int BM = 256, BK = 64, HALF = 128, HTB = HALF * BK * 2, NXCD = 8;
DI int lds_byte(int r, int c) { const int st = (r >> 4) * 2 + (c >> 5), rr = r & 15, cc = c & 31, ob = rr * 64 + cc * 2; return st * 1024 + (ob ^ (((ob >> 9) & 1) << 5)); }
DI void stage_rc(int b, int& R, int& C) { const int st = b / 1024, sb = b % 1024, swz = sb ^ (((sb >> 9) & 1) << 5); R = (st >> 1) * 16 + swz / 64; C = (st & 1) * 32 + (swz % 64) / 2; }
DI int perm32(int rho) { const int n = rho >> 4, i = rho & 15; return 8 * (i >> 2) + 4 * n + (i & 3); }
struct Unit { const char* a; const char* b; int i0, i1, i2; };
DI int xcd_remap(int L, int total) { const int q = total / NXCD, r = total % NXCD, xcd = L % NXCD, off = L / NXCD; return (xcd < r ? xcd * (q + 1) : r * (q + 1) + (xcd - r) * q) + off; }

template <class Desc, class Epi>
DI void gemm_phase(LAS unsigned char* lds, const Desc& D, const Epi& E, int wv) {
    const int tid = otid(wv), wid = __builtin_amdgcn_readfirstlane(tid >> 6), lane = tid & 63, wr = wid >> 2, wc = wid & 3, fr = lane & 15, fq = lane >> 4;
    const int G = gridDim.x, c = blockIdx.x, total = D.total;
    const int K = D.K, nt = K / BK;
    unsigned voffA[2], voffB[2];
#pragma unroll
    for (int i = 0; i < 2; ++i) { int R, C; stage_rc(tid * 16 + i * 8192, R, C); const int Rb = (R & ~31) + perm32(R & 31);
        voffA[i] = (unsigned)(R * D.lda + C) * 2u; voffB[i] = (unsigned)(Rb * D.ldb + C) * 2u; }
    const size_t kstep = (size_t)(BK * 2);
    const size_t hstepA = (size_t)HALF * D.lda * 2, hstepB = (size_t)HALF * D.ldb * 2;
    const unsigned ldsw = (unsigned)wid * 1024u;
    const int aoff = lds_byte(wr * 64 + fr, fq * 8), boff = lds_byte(wc * 32 + fr, fq * 8);
#define PG8_SA(b, h) (((b) * 2 + (h)) * HTB)
#define PG8_SB(b, h) ((4 + (b) * 2 + (h)) * HTB)
#define PG8_STAGE(bufoff, gbase, voff) do { _Pragma("unroll") for (int _i = 0; _i < 2; ++_i) \
        __builtin_amdgcn_global_load_lds((const unsigned*)((const char*)(gbase) + (voff)[_i]), (LAS unsigned*)(lds + (bufoff) + ldsw + _i * 8192), 16, 0, 0); } while (0)
#define PG8_LDA(dst, b, h) do { _Pragma("unroll") for (int m = 0; m < 4; ++m) _Pragma("unroll") for (int k = 0; k < 2; ++k) dst[m][k] = *(const LAS bf16x8*)(lds + PG8_SA(b, h) + aoff + m * 2048 + k * 1024); } while (0)
#define PG8_LDB(dst, b, h) do { _Pragma("unroll") for (int n = 0; n < 2; ++n) _Pragma("unroll") for (int k = 0; k < 2; ++k) dst[n][k] = *(const LAS bf16x8*)(lds + PG8_SB(b, h) + boff + n * 2048 + k * 1024); } while (0)
#define PG8_MMA(ai, bj, At, Bt) do { __builtin_amdgcn_s_setprio(1); _Pragma("unroll") for (int m = 0; m < 4; ++m) _Pragma("unroll") for (int n = 0; n < 2; ++n) _Pragma("unroll") for (int k = 0; k < 2; ++k) \
        acc[ai][bj][m][n] = __builtin_amdgcn_mfma_f32_16x16x32_bf16(Bt[n][k], At[m][k], acc[ai][bj][m][n], 0, 0, 0); __builtin_amdgcn_s_setprio(0); } while (0)
#define PG8_WAIT_V(n) asm volatile("s_waitcnt vmcnt(" #n ")" ::: "memory")
#define PG8_WAIT_L(n) asm volatile("s_waitcnt lgkmcnt(" #n ")" ::: "memory")
#define PG8_BAR __builtin_amdgcn_s_barrier()
#define PG8_SCHED __builtin_amdgcn_sched_barrier(0)
    if constexpr (Desc::RAW) { if (!D.valid(c, G)) return; } else { if (c >= total) return; }
    Unit cur, nxt; int ui = 0;
    if constexpr (Desc::RAW) cur = D.unit(c, G); else cur = D.unit(xcd_remap(c, total));
    nxt = cur;
    f32x4 acc[2][2][4][2];
#pragma unroll
    for (int a = 0; a < 2; ++a)
#pragma unroll
        for (int b = 0; b < 2; ++b)
#pragma unroll
            for (int m = 0; m < 4; ++m)
#pragma unroll
                for (int n = 0; n < 2; ++n) acc[a][b][m][n] = (f32x4){0.f, 0.f, 0.f, 0.f};
    bf16x8 At[4][2], B0[2][2], B1[2][2];
    const char* cA = cur.a; const char* cB = cur.b;
    PG8_STAGE(PG8_SB(0, 0), cB, voffB); PG8_STAGE(PG8_SB(0, 1), cB + hstepB, voffB); PG8_STAGE(PG8_SA(0, 0), cA, voffA); PG8_STAGE(PG8_SA(0, 1), cA + hstepA, voffA);
    if (wr == 1) PG8_BAR;
    PG8_WAIT_V(2); PG8_BAR;
    PG8_STAGE(PG8_SB(1, 0), cB + kstep, voffB); PG8_STAGE(PG8_SA(1, 0), cA + kstep, voffA); PG8_STAGE(PG8_SB(1, 1), cB + hstepB + kstep, voffB);
    PG8_WAIT_V(6); PG8_BAR;
    for (;;) {
        const long Ln = (long)(ui + 1) * G + c;
        bool has_next;
        if constexpr (Desc::RAW) { has_next = D.valid((int)Ln, G); if (has_next) nxt = D.unit((int)Ln, G); }
        else { has_next = Ln < total; if (has_next) nxt = D.unit(xcd_remap((int)Ln, total)); }
        const char* nA = has_next ? nxt.a : cA; const char* nB = has_next ? nxt.b : cB;
        for (int t = 0; t < nt; t += 2) {
            const bool last = (t == nt - 2);
            const char* a1 = cA + (size_t)(t + 1) * kstep;
            const char* a2 = last ? nA : cA + (size_t)(t + 2) * kstep; const char* b2 = last ? nB : cB + (size_t)(t + 2) * kstep;
            const char* a3 = a2 + kstep; const char* b3 = b2 + kstep;
            PG8_LDB(B0, 0, 0); PG8_LDB(B1, 0, 1); PG8_SCHED; PG8_LDA(At, 0, 0); PG8_STAGE(PG8_SA(1, 1), a1 + hstepA, voffA);
            PG8_WAIT_V(8); PG8_WAIT_L(0); PG8_BAR; PG8_MMA(0, 0, At, B0); PG8_MMA(0, 1, At, B1); PG8_BAR; PG8_SCHED;
            PG8_LDA(At, 0, 1); PG8_STAGE(PG8_SB(0, 0), b2, voffB); PG8_STAGE(PG8_SB(0, 1), b2 + hstepB, voffB); PG8_STAGE(PG8_SA(0, 0), a2, voffA);
            PG8_WAIT_V(8); PG8_WAIT_L(0); PG8_BAR; PG8_MMA(1, 0, At, B0); PG8_MMA(1, 1, At, B1); PG8_BAR; PG8_SCHED;
            PG8_LDB(B0, 1, 0); PG8_LDB(B1, 1, 1); PG8_SCHED; PG8_LDA(At, 1, 0); PG8_STAGE(PG8_SA(0, 1), a2 + hstepA, voffA);
            PG8_WAIT_V(8); PG8_WAIT_L(0); PG8_BAR; PG8_MMA(0, 0, At, B0); PG8_MMA(0, 1, At, B1); PG8_BAR; PG8_SCHED;
            PG8_LDA(At, 1, 1); PG8_STAGE(PG8_SB(1, 0), b3, voffB); PG8_STAGE(PG8_SB(1, 1), b3 + hstepB, voffB); PG8_STAGE(PG8_SA(1, 0), a3, voffA);
            PG8_WAIT_V(8); PG8_WAIT_L(0); PG8_BAR; PG8_MMA(1, 0, At, B0); PG8_MMA(1, 1, At, B1); PG8_BAR; PG8_SCHED;
        }
        if (wr == 0) PG8_BAR;
        {
            const int le = otid(wv) & 63, fre = le & 15, fqe = le >> 4;
#pragma unroll
            for (int ai = 0; ai < 2; ++ai)
#pragma unroll
                for (int m = 0; m < 4; ++m)
#pragma unroll
                    for (int bj = 0; bj < 2; ++bj)
                        E(cur, ai * HALF + wr * 64 + m * 16 + fre, bj * HALF + wc * 32 + 8 * fqe, acc[ai][bj][m][0], acc[ai][bj][m][1]);
        }
        if (!has_next) break;
#pragma unroll
        for (int a = 0; a < 2; ++a)
#pragma unroll
            for (int b = 0; b < 2; ++b)
#pragma unroll
                for (int m = 0; m < 4; ++m)
#pragma unroll
                    for (int n = 0; n < 2; ++n) acc[a][b][m][n] = (f32x4){0.f, 0.f, 0.f, 0.f};
        cur = nxt; cA = nA; cB = nB; ++ui;
        if (wr == 1) PG8_BAR;
    }
    PG8_WAIT_V(0);
    PG8_BAR;
#undef PG8_SA
#undef PG8_SB
#undef PG8_STAGE
#undef PG8_LDA
#undef PG8_LDB
#undef PG8_MMA
#undef PG8_WAIT_V
#undef PG8_WAIT_L
#undef PG8_BAR
#undef PG8_SCHED
}
}

DI void transpose_item(const float* W, int N, int kb, int nb, bf16_t* d0, bf16_t* d1, int K, LAS float* scr, int lane) {
    const int k0 = 64 * kb, n0 = 32 * nb;
#pragma unroll 8
    for (int i = 0; i < 32; ++i) { const int kk = 2 * i + (lane >> 5); scr[kk * 33 + (lane & 31)] = W[(size_t)(k0 + kk) * N + n0 + (lane & 31)]; }
    asm volatile("s_waitcnt lgkmcnt(0)" ::: "memory");
    const int c = lane & 7;
#pragma unroll
    for (int j = 0; j < 4; ++j) { const int n = (lane >> 3) + 8 * j; const LAS float* s = scr + (8 * c) * 33 + n;
        u32x4 o; o.x = pk2(s[0 * 33], s[1 * 33]); o.y = pk2(s[2 * 33], s[3 * 33]); o.z = pk2(s[4 * 33], s[5 * 33]); o.w = pk2(s[6 * 33], s[7 * 33]);
        *(u32x4*)(d0 + (size_t)n * K + k0 + 8 * c) = o;
        if (d1) *(u32x4*)(d1 + (size_t)n * K + k0 + 8 * c) = o; }
    asm volatile("s_waitcnt lgkmcnt(0)" ::: "memory");
}

DI void prep_phase(const Args& A, LAS unsigned char* lds, int wv) {
    const int tid = otid(wv), lane = tid & 63, wave = tid >> 6, G = gridDim.x;
    unsigned char* ws = A.ws;
    {
        LAS float* s_lds = (LAS float*)lds;
        const float* cc = A.in[1]; const float* cctx = A.in[3]; const float* aw = A.in[4]; const float* ab = A.in[5];
        long long* modi = (long long*)(ws + WS_MODI);
        for (int item = blockIdx.x; item < 768; item += G) {
            const int kc = item % 16, cb = (item / 16) % 12, l = item / 192;
            const int k0 = kc * 128, j = cb * 512 + tid;
            __syncthreads();
            for (int e = tid; e < 17 * 128; e += NTHREADS) { const int r = e / 128, k = e % 128; const float v = r < 16 ? cc[r * DM + k0 + k] : cctx[k0 + k]; s_lds[k * 20 + r] = siluf(v); }
            __syncthreads();
            float acc[17];
#pragma unroll
            for (int r = 0; r < 17; ++r) acc[r] = 0.f;
            const float* wp = aw + ((size_t)l * DM + k0) * MOD_LD + j;
#pragma unroll 4
            for (int k = 0; k < 128; ++k) {
                const float w = wp[(size_t)k * MOD_LD];
                const LAS f32x4* sp = (const LAS f32x4*)(s_lds + k * 20);
                const f32x4 s0 = sp[0], s1 = sp[1], s2 = sp[2], s3 = sp[3]; const float s4 = s_lds[k * 20 + 16];
#pragma unroll
                for (int q = 0; q < 4; ++q) { acc[q] += s0[q] * w; acc[4 + q] += s1[q] * w; acc[8 + q] += s2[q] * w; acc[12 + q] += s3[q] * w; }
                acc[16] += s4 * w;
            }
            const float bias = (kc == 0) ? ab[l * MOD_LD + j] : 0.f;
#pragma unroll
            for (int r = 0; r < 17; ++r) atomicAdd((unsigned long long*)&modi[(size_t)(l * 17 + r) * MOD_LD + j], (unsigned long long)__float2ll_rn((acc[r] + bias) * MODI_SCALE));
        }
        __syncthreads();
    }
    {
        LAS float* scr = (LAS float*)(lds + wave * 16384);
        const int gw = blockIdx.x * NWAVES + wave, NGW = G * NWAVES;
        constexpr int I_SQ = 32 * 64, I_AI = 32 * 160, I_MI = 32 * 257;
        constexpr int NIT = 6 * I_SQ + I_AI + I_MI;
        for (int it = gw; it < NIT; it += NGW) {
            int r = it;
            if (r < 6 * I_SQ) {
                const int w = r / I_SQ; r -= w * I_SQ;
                const float* src; bf16_t* dst;
                if (w < 2)      { src = A.in[7] + (size_t)w * DM * DM;       dst = (bf16_t*)(ws + WS_WFG) + (size_t)w * DM * DM; }
                else if (w < 4) { src = A.in[8] + (size_t)(w - 2) * DM * DM; dst = (bf16_t*)(ws + WS_WFO) + (size_t)(w - 2) * DM * DM; }
                else if (w == 4) { src = A.in[12]; dst = (bf16_t*)(ws + WS_WMO); }
                else             { src = A.in[16]; dst = (bf16_t*)(ws + WS_WAO); }
                const int kb = r / 64, nb = r % 64;
                transpose_item(src, DM, kb, nb, dst + (size_t)(32 * nb) * DM, nullptr, DM, scr, lane);
                continue;
            }
            r -= 6 * I_SQ;
            if (r < I_AI) { const int kb = r / 160, nb = r % 160; transpose_item(A.in[13], 5120, kb, nb, (bf16_t*)(ws + WS_WAI) + (size_t)(32 * nb) * DM, nullptr, DM, scr, lane); continue; }
            r -= I_AI;
            {
                const int kb = r / 257, nb = r % 257, n0 = 32 * nb;
                bf16_t* WA = (bf16_t*)(ws + WS_WMA); bf16_t* WB = (bf16_t*)(ws + WS_WMB);
                bf16_t* d0; bf16_t* d1 = nullptr;
                if (n0 < 1024) d0 = WA + (size_t)n0 * DM;
                else if (n0 < 2048) { d0 = WA + (size_t)n0 * DM; d1 = WB + (size_t)(n0 - 1024) * DM; }
                else if (n0 < 4096) d0 = WB + (size_t)(1024 + n0 - 2048) * DM;
                else if (n0 < 6144) d0 = WA + (size_t)(2304 + n0 - 4096) * DM;
                else if (n0 < 6176) d0 = WA + (size_t)(2048 + n0 - 6144) * DM;
                else d0 = WA + (size_t)(4352 + n0 - 6176) * DM;
                transpose_item(A.in[9], 8224, kb, nb, d0, d1, DM, scr, lane);
            }
        }
    }
    {
        const long gt = (long)blockIdx.x * NTHREADS + tid, NGT = (long)G * NTHREADS;
        constexpr long N_DC = 1024L * 512 / 8, N_DT = 2048L * 4096 / 8, N_DT2 = 256L * 512 / 8;
        for (long it = gt; it < N_DC + N_DT + N_DT2; it += NGT) {
            float v[8]; bf16_t* dst;
            if (it < N_DC) {
                const int m = (int)(it / 64), k0 = (int)(it % 64) * 8; const float sc = 0.044194173824159216f;
#pragma unroll
                for (int j = 0; j < 8; ++j) { const int rr = ((m & 511) * (k0 + j)) & 511; const float ang = (float)rr * (1.f / 256.f); v[j] = (m < 512 ? cospif(ang) : sinpif(ang)) * sc; }
                dst = (bf16_t*)(ws + WS_DC) + (size_t)m * 512 + k0;
            } else if (it < N_DC + N_DT) {
                const long i2 = it - N_DC; const int kk = (int)(i2 / 512), s0 = (int)(i2 % 512) * 8; const float sc = 0.022097086912079608f;
#pragma unroll
                for (int j = 0; j < 8; ++j) { const int s = s0 + j; const int rr = (kk * (s & 2047)) & 2047; const float ang = (float)rr * (1.f / 1024.f); v[j] = (s < 2048 ? cospif(ang) : -sinpif(ang)) * sc; }
                dst = (bf16_t*)(ws + WS_DT) + (size_t)kk * 4096 + s0;
            } else {
                const long i2 = it - N_DC - N_DT; const int kk = (int)(i2 / 64), s0 = (int)(i2 % 64) * 8; const float sc = 0.0625f;
#pragma unroll
                for (int j = 0; j < 8; ++j) { const int s = s0 + j; const int rr = (kk * (s & 255)) & 255; const float ang = (float)rr * (1.f / 128.f); v[j] = (s < 256 ? cospif(ang) : -sinpif(ang)) * sc; }
                dst = (bf16_t*)(ws + WS_DT2) + (size_t)kk * 512 + s0;
            }
            u32x4 o = {pk2(v[0], v[1]), pk2(v[2], v[3]), pk2(v[4], v[5]), pk2(v[6], v[7])};
            *(u32x4*)dst = o;
        }
    }
}

DI const float* xrow_in(const Args& A, int r) {
    const int b = r / TB, t = r % TB;
    if (t < TL) return A.in[0] + ((size_t)b * TL + t) * DM;
    return A.in[2] + ((size_t)b * TC + (t - TL)) * DM;
}
DI void norm_phase(const Args& A, int layer, bool latonly, int wv) {
    const int tid = otid(wv), lane = tid & 63, wave = tid >> 6, G = gridDim.x;
    const float* ng = A.in[6] + (size_t)layer * DM;
    const float* mod = (const float*)(A.ws + WS_MOD) + (size_t)layer * 17 * MOD_LD;
    bf16_t* H = (bf16_t*)(A.ws + WS_H);
    const bf16_t* XB = (const bf16_t*)A.out;
    for (int r0 = (blockIdx.x * NWAVES + wave) * 2; r0 < NTOK; r0 += G * NWAVES * 2) {
        const int b = r0 / TB, t = r0 % TB;
        if (latonly && t >= TL) continue;
        const float* mr = mod + (size_t)(t < TL ? b : 16) * MOD_LD;
        f32x4 v[2][4][2];
#pragma unroll
        for (int k = 0; k < 2; ++k) {
            const int r = r0 + k;
            if (layer == 0) {
                const float* xr = xrow_in(A, r);
#pragma unroll
                for (int j = 0; j < 4; ++j) { const f32x4* p = (const f32x4*)(xr + 512 * j + 8 * lane); v[k][j][0] = p[0]; v[k][j][1] = p[1]; }
            } else {
#pragma unroll
                for (int j = 0; j < 4; ++j) ld_bf16x8(XB + (size_t)r * DM + 512 * j + 8 * lane, v[k][j][0], v[k][j][1]);
            }
        }
#pragma unroll
        for (int k = 0; k < 2; ++k) {
            const int r = r0 + k; float ss = 0.f;
#pragma unroll
            for (int j = 0; j < 4; ++j)
#pragma unroll
                for (int q = 0; q < 4; ++q) ss += v[k][j][0][q] * v[k][j][0][q] + v[k][j][1][q] * v[k][j][1][q];
            const float rs = 1.0f / sqrtf(wave_sum(ss) * (1.f / DM) + EPS);
#pragma unroll
            for (int j = 0; j < 4; ++j) { const int c0 = 512 * j + 8 * lane; f32x4 o[2];
#pragma unroll
                for (int h = 0; h < 2; ++h) { const f32x4 g4 = *(const f32x4*)(ng + c0 + 4 * h), sh = *(const f32x4*)(mr + c0 + 4 * h), sc = *(const f32x4*)(mr + DM + c0 + 4 * h);
                    o[h] = (v[k][j][h] * rs) * g4 * (sc + 1.0f) + sh; }
                st_bf16x8(H + (size_t)r * DM + c0, o[0], o[1]); }
        }
    }
}
DI void final_norm_phase(const Args& A, const bf16_t* src, int wv) {
    const int tid = otid(wv), lane = tid & 63, wave = tid >> 6, G = gridDim.x;
    const float* fg = A.in[17];
    for (int r0 = (blockIdx.x * NWAVES + wave) * 2; r0 < NB * TL; r0 += G * NWAVES * 2) {
        f32x4 v[2][4][2];
#pragma unroll
        for (int k = 0; k < 2; ++k)
#pragma unroll
            for (int j = 0; j < 4; ++j) ld_bf16x8(src + (size_t)(r0 + k) * DM + 512 * j + 8 * lane, v[k][j][0], v[k][j][1]);
#pragma unroll
        for (int k = 0; k < 2; ++k) { float* orow = A.out + (size_t)(r0 + k) * DM; float ss = 0.f;
#pragma unroll
            for (int j = 0; j < 4; ++j)
#pragma unroll
                for (int q = 0; q < 4; ++q) ss += v[k][j][0][q] * v[k][j][0][q] + v[k][j][1][q] * v[k][j][1][q];
            const float rs = 1.0f / sqrtf(wave_sum(ss) * (1.f / DM) + EPS);
#pragma unroll
            for (int j = 0; j < 4; ++j) { const int c0 = 512 * j + 8 * lane;
#pragma unroll
                for (int h = 0; h < 2; ++h) { const f32x4 g4 = *(const f32x4*)(fg + c0 + 4 * h); *(f32x4*)(orow + c0 + 4 * h) = (v[k][j][h] * rs) * g4; } }
        }
    }
}

struct DescPlain {
    static constexpr bool RAW = false;
    const bf16_t* A; const bf16_t* B; int nN; bool latonly; int lda, ldb, K, total;
    DI void init(const bf16_t* A_, const bf16_t* B_, int nN_, bool lat) { A = A_; B = B_; nN = nN_; latonly = lat; lda = DM; ldb = DM; K = DM; total = (lat ? 128 : 144) * nN_; }
    DI pg8::Unit unit(int idx) const {
        const int nMt = latonly ? 128 : 144, nig = 8 * nN, gid = idx / nig, fm = gid * 8, gsz = (nMt - fm) < 8 ? (nMt - fm) : 8;
        const int pmi = fm + (idx % nig) % gsz, pn = (idx % nig) / gsz, pm = latonly ? (pmi / 8) * 9 + (pmi % 8) : pmi;
        pg8::Unit u; u.a = (const char*)(A + (size_t)pm * 256 * DM); u.b = (const char*)(B + (size_t)pn * 256 * DM); u.i0 = pm; u.i1 = pn; u.i2 = 0; return u;
    }
};
struct DescChan {
    static constexpr bool RAW = false;
    const bf16_t* DC; const bf16_t* H; int lda, ldb, K, total;
    DI void init(const bf16_t* DC_, const bf16_t* H_, bool lat) { DC = DC_; H = H_; lda = 512; ldb = DM; K = 512; total = lat ? 2048 : 2304; }
    DI pg8::Unit unit(int idx) const {
        pg8::Unit u; int b, g, mt, nt, toff;
        if (idx < 2048) { mt = idx % 4; nt = (idx / 4) % 8; g = (idx / 32) % 4; b = idx / 128; toff = nt * 256; u.i2 = nt; }
        else { const int j = idx - 2048; mt = j % 4; g = (j / 4) % 4; b = j / 16; toff = TL; u.i2 = 8; }
        u.a = (const char*)(DC + (size_t)mt * 256 * 512); u.b = (const char*)(H + ((size_t)b * TB + toff) * DM + g * 512); u.i0 = b * 4 + g; u.i1 = mt; return u;
    }
};
struct DescT {
    static constexpr bool RAW = false;
    const bf16_t* DT; const bf16_t* PQ; int nMt; int lda, ldb, K, total;
    DI void init(const bf16_t* DT_, const bf16_t* PQ_, int ld, int Kd, int coff, int nMt_) { DT = DT_ + coff; PQ = PQ_ + coff; nMt = nMt_; lda = ld; ldb = ld; K = Kd; total = NB * nMt_ * 8; }
    DI pg8::Unit unit(int idx) const {
        const int mt = idx % nMt, nt = (idx / nMt) % 8, b = idx / (nMt * 8);
        pg8::Unit u; u.a = (const char*)(DT + (size_t)mt * 256 * lda); u.b = (const char*)(PQ + ((size_t)b * DM + nt * 256) * ldb); u.i0 = b; u.i1 = mt; u.i2 = nt; return u;
    }
};

struct DescT2 {
    static constexpr bool RAW = true;
    const bf16_t* DT; const bf16_t* PQ; int lda, ldb, K, total;
    DI void init(const bf16_t* DT_, const bf16_t* PQ_) { DT = DT_; PQ = PQ_; lda = 4096; ldb = 4096; K = 2048; total = 2 * NB * 4 * 8; }
    DI bool valid(int L, int G) const { return ((L / G) >> 1) * G + (L % G) < NB * 4 * 8; }
    DI pg8::Unit unit(int L, int G) const {
        const int i = L / G, pair = (i >> 1) * G + (L % G), part = i & 1;
        const int mt = pair % 4, nt = (pair / 4) % 8, b = pair / 32, coff = part * 2048;
        pg8::Unit u; u.a = (const char*)(DT + (size_t)mt * 256 * 4096 + coff); u.b = (const char*)(PQ + ((size_t)b * DM + nt * 256) * 4096 + coff); u.i0 = b; u.i1 = mt; u.i2 = part * 8 + nt; return u;
    }
};

DI void resid_store(const Args& A, int layer, int pm, int row_l, int col, const float* modl, f32x4 v0, f32x4 v1) {
    const int b = pm / 9, tt = pm % 9;
    const float* gp = modl + (size_t)(tt < 8 ? b : 16) * MOD_LD + 2 * DM + col;
    const f32x4 g0 = *(const f32x4*)gp, g1 = *(const f32x4*)(gp + 4);
    bf16_t* XB = (bf16_t*)A.out;
    const size_t roff = ((size_t)pm * 256 + row_l) * DM + col;
    f32x4 x0, x1;
    if (layer == 0) {
        const float* src = (tt < 8) ? A.in[0] + ((size_t)b * TL + tt * 256 + row_l) * DM + col : A.in[2] + ((size_t)b * TC + row_l) * DM + col;
        x0 = *(const f32x4*)src; x1 = *(const f32x4*)(src + 4);
    } else ld_bf16x8(XB + roff, x0, x1);
    x0 = x0 + g0 * v0; x1 = x1 + g1 * v1;
    if (layer == 3) st_bf16x8((bf16_t*)(A.ws + WS_SCR + F_PQX) + ((size_t)b * TL + tt * 256 + row_l) * DM + col, x0, x1);
    else st_bf16x8(XB + roff, x0, x1);
}

DI void fnet_layer(const Args& A, LAS unsigned char* lds, const XcdBarrier& gbar, int layer, int j, bool latonly, int wv) {
    unsigned char* ws = A.ws;
    const bf16_t* H = (const bf16_t*)(ws + WS_H); bf16_t* U = (bf16_t*)(ws + WS_H);
    bf16_t* Gt = (bf16_t*)(ws + WS_SCR + F_G); bf16_t* PQX = (bf16_t*)(ws + WS_SCR + F_PQX); bf16_t* PQC = (bf16_t*)(ws + WS_SCR + F_PQC);
    norm_phase(A, layer, latonly, wv);
    xcd_barrier(gbar, wv);
    {
        DescPlain D; D.init(H, (const bf16_t*)(ws + WS_WFG) + (size_t)j * DM * DM, 8, latonly);
        auto E = [=](const pg8::Unit& u, int row_l, int col_l, f32x4 v0, f32x4 v1) {
            f32x4 a, b;
#pragma unroll
            for (int q = 0; q < 4; ++q) { a[q] = siluf(v0[q]); b[q] = siluf(v1[q]); }
            st_bf16x8(Gt + ((size_t)u.i0 * 256 + row_l) * DM + u.i1 * 256 + col_l, a, b);
        };
        pg8::gemm_phase(lds, D, E, wv);
    }
    {
        DescChan D; D.init((const bf16_t*)(ws + WS_DC), H, latonly);
        auto E = [=](const pg8::Unit& u, int row_l, int col_l, f32x4 v0, f32x4 v1) {
            const int b = u.i0 >> 2, g = u.i0 & 3, mt = u.i1, half = mt >> 1, ch = g * 512 + (mt & 1) * 256 + row_l;
            bf16_t* dst = (u.i2 < 8) ? PQX + ((size_t)b * DM + ch) * 4096 + half * 2048 + u.i2 * 256 + col_l
                                     : PQC + ((size_t)b * DM + ch) * 512 + half * 256 + col_l;
            st_bf16x8(dst, v0, v1);
        };
        pg8::gemm_phase(lds, D, E, wv);
    }
    xcd_barrier(gbar, wv);
    bf16_t* A1 = (bf16_t*)(ws + WS_SCR + F_A1);
    {
        const int tid = otid(wv), lane = tid & 63;
        for (int rr0 = (blockIdx.x * NWAVES + wv) * 4; rr0 < NB * DM; rr0 += gridDim.x * NWAVES * 4) {
            u32x4 raw[4][4];
#pragma unroll
            for (int k = 0; k < 4; ++k)
#pragma unroll
                for (int q = 0; q < 4; ++q) raw[k][q] = *(const u32x4*)(PQX + (size_t)(rr0 + k) * 4096 + (q * 64 + lane) * 8);
#pragma unroll
            for (int k = 0; k < 4; ++k) { float acc = 0.f;
#pragma unroll
                for (int q = 0; q < 4; ++q) { const u32x4 w = raw[k][q]; acc += (bf_lo(w.x) - bf_hi(w.x)) + (bf_lo(w.y) - bf_hi(w.y)) + (bf_lo(w.z) - bf_hi(w.z)) + (bf_lo(w.w) - bf_hi(w.w)); }
                acc = wave_sum(acc);
                if (lane == 0) { const int rr = rr0 + k; const size_t off = ((size_t)(rr >> 11) * TB + 1024) * DM + (rr & 2047);
                    U[off] = (bf16_t)(pk2(acc * 0.022097086912079608f * __uint_as_float((unsigned)Gt[off] << 16), 0.f) & 0xffffu); } }
        }
    }
    {
        DescT2 D; D.init((const bf16_t*)(ws + WS_DT), PQX);
        auto E = [=](const pg8::Unit& u, int row_l, int col_l, f32x4 v0, f32x4 v1) {
            const int k = u.i1 * 256 + row_l, col = (u.i2 & 7) * 256 + col_l;
            bf16_t* ap = A1 + ((size_t)u.i0 * 1024 + k) * DM + col;
            if (u.i2 < 8) { st_bf16x8(ap, v0, v1); return; }
            f32x4 a0, a1; ld_bf16x8(ap, a0, a1);
            const size_t off = ((size_t)u.i0 * TB + k) * DM + col;
            f32x4 g0, g1; ld_bf16x8(Gt + off, g0, g1);
            st_bf16x8(U + off, (a0 + v0) * g0, (a1 + v1) * g1);
            if (k != 0) { const size_t off2 = ((size_t)u.i0 * TB + (TL - k)) * DM + col; ld_bf16x8(Gt + off2, g0, g1); st_bf16x8(U + off2, (a0 - v0) * g0, (a1 - v1) * g1); }
        };
        pg8::gemm_phase(lds, D, E, wv);
    }
    if (!latonly) {
        DescT D; D.init((const bf16_t*)(ws + WS_DT2), PQC, 512, 512, 0, 1);
        auto E = [=](const pg8::Unit& u, int row_l, int col_l, f32x4 v0, f32x4 v1) {
            const size_t off = ((size_t)u.i0 * TB + TL + row_l) * DM + u.i2 * 256 + col_l;
            f32x4 g0, g1; ld_bf16x8(Gt + off, g0, g1);
            st_bf16x8(U + off, v0 * g0, v1 * g1);
        };
        pg8::gemm_phase(lds, D, E, wv);
    }
    xcd_barrier(gbar, wv);
    {
        DescPlain D; D.init(U, (const bf16_t*)(ws + WS_WFO) + (size_t)j * DM * DM, 8, latonly);
        const float* modl = (const float*)(ws + WS_MOD) + (size_t)layer * 17 * MOD_LD;
        auto E = [=](const pg8::Unit& u, int row_l, int col_l, f32x4 v0, f32x4 v1) { resid_store(A, layer, u.i0, row_l, u.i1 * 256 + col_l, modl, v0, v1); };
        pg8::gemm_phase(lds, D, E, wv);
    }
    xcd_barrier(gbar, wv);
}


namespace att {
constexpr int D = 128, NW = 8, QBLK = 32, KVBLK = 64;
constexpr float SCALE = 0.088388347648318440f;
constexpr float THR = 8.f;
constexpr int LDQ = 2048, LDK = 512;
constexpr size_t SHM_V = KVBLK * D * 2, SHM_K = KVBLK * D * 2;
typedef float f32x8 __attribute__((ext_vector_type(8)));
#define KSWZ(row, colB) ((row) * 256 + ((colB) ^ (((row) & 7) << 4)))
#define SBAR() __builtin_amdgcn_sched_barrier(0)
DI int crow(int r, int hi) { return (r & 3) + 8 * (r >> 2) + 4 * hi; }
DI unsigned cvtpk(float lo, float hi) { unsigned r; asm volatile("v_cvt_pk_bf16_f32 %0, %1, %2" : "=v"(r) : "v"(lo), "v"(hi)); return r; }
DI void partialSM(f32x16& p0, f32x16& p1, float& m_reg, float& mn, float& alpha) {
  constexpr float C = SCALE * 1.4426950408889634f;
  float pmax = p0[0];
#pragma unroll
  for (int r = 1; r < 16; ++r) pmax = fmaxf(pmax, p0[r]);
#pragma unroll
  for (int r = 0; r < 16; ++r) pmax = fmaxf(pmax, p1[r]);
  { auto rr = __builtin_amdgcn_permlane32_swap(__float_as_uint(pmax), __float_as_uint(pmax), false, false);
    pmax = fmaxf(__uint_as_float(rr[0]), __uint_as_float(rr[1])); }
  if (__builtin_expect(__all(pmax - m_reg <= THR / SCALE), 1)) { mn = m_reg; alpha = 1.f; }
  else { mn = fmaxf(m_reg, pmax); alpha = __builtin_amdgcn_exp2f((m_reg - mn) * C); m_reg = mn; }
  float mnC = -mn * C;
#pragma unroll
  for (int r = 0; r < 16; ++r) p0[r] = fmaf(p0[r], C, mnC);
#pragma unroll
  for (int r = 0; r < 16; ++r) p1[r] = fmaf(p1[r], C, mnC);
#pragma unroll
  for (int r = 0; r < 16; ++r) p0[r] = __builtin_amdgcn_exp2f(p0[r]);
}
DI void finishSM(f32x16& p0, f32x16& p1, float alpha, float& l_reg, bf16x8& pa0, bf16x8& pa1, bf16x8& pa2, bf16x8& pa3) {
#pragma unroll
  for (int r = 0; r < 16; ++r) p1[r] = __builtin_amdgcn_exp2f(p1[r]);
  float ps = 0;
#pragma unroll
  for (int r = 0; r < 16; ++r) ps += p0[r];
#pragma unroll
  for (int r = 0; r < 16; ++r) ps += p1[r];
  { auto rr = __builtin_amdgcn_permlane32_swap(__float_as_uint(ps), __float_as_uint(ps), false, false);
    ps = __uint_as_float(rr[0]) + __uint_as_float(rr[1]); }
  l_reg = l_reg * alpha + ps;
#define PK4(P, BASE, OUT) do { unsigned a0 = cvtpk(P[BASE + 0], P[BASE + 1]), a1 = cvtpk(P[BASE + 2], P[BASE + 3]);   \
    unsigned b0 = cvtpk(P[BASE + 4], P[BASE + 5]), b1 = cvtpk(P[BASE + 6], P[BASE + 7]);                              \
    auto r0 = __builtin_amdgcn_permlane32_swap(a0, b0, false, false); auto r1 = __builtin_amdgcn_permlane32_swap(a1, b1, false, false); \
    u32x4 w = {r0[0], r1[0], r0[1], r1[1]}; OUT = *reinterpret_cast<bf16x8*>(&w); } while (0)
  PK4(p0, 0, pa0); PK4(p0, 8, pa1); PK4(p1, 0, pa2); PK4(p1, 8, pa3);
#undef PK4
}
DI void qkt(f32x16& p0, f32x16& p1, const bf16_t* Ks, const bf16x8* qr, int r32, int hi) {
  p0 = f32x16{}; p1 = f32x16{};
#pragma unroll
  for (int d0 = 0; d0 < 8; ++d0) { int cb = (d0 * 16 + hi * 8) * 2;
    bf16x8 b0 = *reinterpret_cast<const bf16x8*>((const char*)Ks + KSWZ(r32, cb));
    bf16x8 b1 = *reinterpret_cast<const bf16x8*>((const char*)Ks + KSWZ(32 + r32, cb));
    p0 = __builtin_amdgcn_mfma_f32_32x32x16_bf16(b0, qr[d0], p0, 0, 0, 0);
    p1 = __builtin_amdgcn_mfma_f32_32x32x16_bf16(b1, qr[d0], p1, 0, 0, 0); }
}
DI int v_st(int k, int c) { const int kk = (k & ~0xC) | ((k & 4) << 1) | ((k & 8) >> 1); return ((kk >> 3) * 4 + (c >> 5)) * 512 + ((kk & 7) * 32 + (c & 31)) * 2; }
DI int v_rd_base(int lane) { return ((lane & 3) << 3) | (((lane >> 2) & 3) << 6) | (((lane >> 4) & 1) << 5) | (((lane >> 5) & 1) << 8); }
constexpr int v_rd_off(int d0, int ks, int half) { return d0 * 512 + ks * 4096 + half * 2048; }
template <int OFF> DI s16x4 tr_read(int vb) {
  s16x4 r; asm volatile("ds_read_b64_tr_b16 %0, %1 offset:%2" : "=&v"(r) : "v"(vb), "i"(OFF) : "memory"); return r;
}
template <int D0> DI void pv_one(f32x16& od, int vb, bf16x8 pa0, bf16x8 pa1, bf16x8 pa2, bf16x8 pa3) {
  const s16x4 l0 = tr_read<v_rd_off(D0, 0, 0)>(vb), h0 = tr_read<v_rd_off(D0, 0, 1)>(vb), l1 = tr_read<v_rd_off(D0, 1, 0)>(vb), h1 = tr_read<v_rd_off(D0, 1, 1)>(vb);
  const s16x4 l2 = tr_read<v_rd_off(D0, 2, 0)>(vb), h2 = tr_read<v_rd_off(D0, 2, 1)>(vb), l3 = tr_read<v_rd_off(D0, 3, 0)>(vb), h3 = tr_read<v_rd_off(D0, 3, 1)>(vb);
  asm volatile("s_waitcnt lgkmcnt(0)" ::: "memory"); SBAR();
#define PK(L, H) (bf16x8){L[0], L[1], L[2], L[3], H[0], H[1], H[2], H[3]}
  od = __builtin_amdgcn_mfma_f32_32x32x16_bf16(pa0, PK(l0, h0), od, 0, 0, 0);
  od = __builtin_amdgcn_mfma_f32_32x32x16_bf16(pa1, PK(l1, h1), od, 0, 0, 0);
  od = __builtin_amdgcn_mfma_f32_32x32x16_bf16(pa2, PK(l2, h2), od, 0, 0, 0);
  od = __builtin_amdgcn_mfma_f32_32x32x16_bf16(pa3, PK(l3, h3), od, 0, 0, 0);
#undef PK
}
DI void pv_d0(f32x16* o, int vb, bf16x8 pa0, bf16x8 pa1, bf16x8 pa2, bf16x8 pa3) {
  pv_one<0>(o[0], vb, pa0, pa1, pa2, pa3); pv_one<1>(o[1], vb, pa0, pa1, pa2, pa3); pv_one<2>(o[2], vb, pa0, pa1, pa2, pa3); pv_one<3>(o[3], vb, pa0, pa1, pa2, pa3);
}
DI void attn_dense_body(const bf16_t* __restrict__ Qb, const bf16_t* __restrict__ Kh, const bf16_t* __restrict__ Vh, const bf16_t* SZb, bf16_t* Ub, int seq, char* lds, int wv) {
  const int tid = otid(wv), wid = tid >> 6, lane = tid & 63, r32 = lane & 31, hi = lane >> 5;
  bf16_t* V_lds = (bf16_t*)lds; bf16_t* K_lds = (bf16_t*)(lds + 2 * SHM_V);
  float* wsf = (float*)(lds + 2 * SHM_V + 2 * SHM_K) + wid * 64; float* li_l = wsf; float* al_l = wsf + 32;
  float m_reg = -1e30f, l_reg = 0; f32x16 o[4] = {}; bf16x8 qr[8];
  const bf16_t* Qw = Qb + (long)(wid * QBLK + r32) * LDQ + hi * 8;
#pragma unroll
  for (int d0 = 0; d0 < 8; ++d0) qr[d0] = *reinterpret_cast<const bf16x8*>(Qw + d0 * 16);
  const int sr = tid >> 4, sc = (tid & 15) * 8, vst0 = v_st(sr, sc), vst1 = v_st(32 + sr, sc);
  const int vb0 = (int)(uintptr_t)V_lds + v_rd_base(lane);
  struct { bf16x8 vs0, vs1, ks0, ks1; } sr_[2];
#define SLOAD(i, k0) do { sr_[i].vs0 = *reinterpret_cast<const bf16x8*>(&Vh[(long)((k0) + sr) * LDK + sc]); sr_[i].vs1 = *reinterpret_cast<const bf16x8*>(&Vh[(long)((k0) + 32 + sr) * LDK + sc]); \
    sr_[i].ks0 = *reinterpret_cast<const bf16x8*>(&Kh[(long)((k0) + sr) * LDK + sc]); sr_[i].ks1 = *reinterpret_cast<const bf16x8*>(&Kh[(long)((k0) + 32 + sr) * LDK + sc]); } while (0)
#define SWRITE(b, i) do { *(bf16x8*)((char*)V_lds + (b) * SHM_V + vst0) = sr_[i].vs0;          \
    *(bf16x8*)((char*)V_lds + (b) * SHM_V + vst1) = sr_[i].vs1; int kc = sc * 2;               \
    *(bf16x8*)((char*)K_lds + (b) * SHM_K + KSWZ(sr, kc)) = sr_[i].ks0;                       \
    *(bf16x8*)((char*)K_lds + (b) * SHM_K + KSWZ(32 + sr, kc)) = sr_[i].ks1; } while (0)
#define SWAIT() asm volatile("s_waitcnt vmcnt(4)" ::: "memory")
#define RESC(a) do { if (__any((a) < 1.f)) { if (hi == 0) al_l[r32] = (a); asm volatile("s_waitcnt lgkmcnt(0)" ::: "memory"); \
    _Pragma("unroll") for (int d = 0; d < 4; ++d) _Pragma("unroll") for (int r = 0; r < 16; ++r) o[d][r] *= al_l[crow(r, hi)]; } } while (0)
  f32x16 pA0, pA1, pB0, pB1; float mnA, mnB, alA, alB; bf16x8 pa0, pa1, pa2, pa3; const int NT = seq / KVBLK;
  constexpr int SE = 0, SO = 1;
  SLOAD(SE, 0); asm volatile("s_waitcnt vmcnt(0)" ::: "memory"); SWRITE(0, SE); __syncthreads();
  qkt(pA0, pA1, K_lds, qr, r32, hi); partialSM(pA0, pA1, m_reg, mnA, alA);
  SLOAD(SO, KVBLK); if (2 < NT) SLOAD(SE, 2 * KVBLK);
  SWAIT(); SWRITE(1, SO); __syncthreads();
  for (int j = 1; j + 1 < NT; j += 2) {
    SBAR(); qkt(pB0, pB1, (bf16_t*)((char*)K_lds + SHM_K), qr, r32, hi);
    finishSM(pA0, pA1, alA, l_reg, pa0, pa1, pa2, pa3); SBAR();
    SLOAD(SO, (j + 2) * KVBLK); SBAR();
    pv_d0(o, vb0, pa0, pa1, pa2, pa3); partialSM(pB0, pB1, m_reg, mnB, alB);
    __syncthreads(); SWAIT(); SWRITE(0, SE);
    RESC(alB); __syncthreads();
    SBAR(); qkt(pA0, pA1, K_lds, qr, r32, hi);
    finishSM(pB0, pB1, alB, l_reg, pa0, pa1, pa2, pa3); SBAR();
    if (j + 3 < NT) SLOAD(SE, (j + 3) * KVBLK); SBAR();
    pv_d0(o, vb0 + (int)SHM_V, pa0, pa1, pa2, pa3); partialSM(pA0, pA1, m_reg, mnA, alA);
    __syncthreads(); SWAIT(); SWRITE(1, SO);
    RESC(alA); __syncthreads();
  }
  SBAR(); qkt(pB0, pB1, (bf16_t*)((char*)K_lds + SHM_K), qr, r32, hi);
  finishSM(pA0, pA1, alA, l_reg, pa0, pa1, pa2, pa3); SBAR();
  pv_d0(o, vb0, pa0, pa1, pa2, pa3); partialSM(pB0, pB1, m_reg, mnB, alB);
  __syncthreads(); RESC(alB);
  finishSM(pB0, pB1, alB, l_reg, pa0, pa1, pa2, pa3); SBAR();
  pv_d0(o, vb0 + (int)SHM_V, pa0, pa1, pa2, pa3);
  u32x4 zq[8];
#pragma unroll
  for (int i = 0; i < 8; ++i) { const int id = tid + 512 * i; zq[i] = *(const u32x4*)(SZb + (long)(id >> 4) * LDQ + (id & 15) * 8); }
  if (hi == 0) li_l[r32] = l_reg; asm volatile("s_waitcnt lgkmcnt(0)" ::: "memory");
  __syncthreads();
  {
    float rli[16];
#pragma unroll
    for (int r = 0; r < 16; ++r) rli[r] = __builtin_amdgcn_rcpf(li_l[crow(r, hi)]);
    char* ost = lds;
#pragma unroll
    for (int r = 0; r < 16; ++r) { char* rowp = ost + (wid * QBLK + crow(r, hi)) * 256 + r32 * 2;
#pragma unroll
      for (int d0 = 0; d0 < 4; ++d0) *(unsigned short*)(rowp + d0 * 64) = (unsigned short)(pk2(o[d0][r] * rli[r], 0.f) & 0xffffu); }
  }
  __syncthreads();
#pragma unroll
  for (int i = 0; i < 8; ++i) { const int id = tid + 512 * i; const int row = id >> 4, ch = id & 15;
    const u32x4 ov = *(const u32x4*)(lds + row * 256 + ch * 16);
    f32x4 a0 = {bf_lo(ov.x), bf_hi(ov.x), bf_lo(ov.y), bf_hi(ov.y)}, a1 = {bf_lo(ov.z), bf_hi(ov.z), bf_lo(ov.w), bf_hi(ov.w)};
    const f32x4 z0 = {bf_lo(zq[i].x), bf_hi(zq[i].x), bf_lo(zq[i].y), bf_hi(zq[i].y)}, z1 = {bf_lo(zq[i].z), bf_hi(zq[i].z), bf_lo(zq[i].w), bf_hi(zq[i].w)};
    st_bf16x8(Ub + (long)row * LDQ + ch * 8, a0 * z0, a1 * z1); }
  __syncthreads();
#undef SLOAD
#undef SWRITE
#undef SWAIT
#undef RESC
}
#undef KSWZ
#undef SBAR
}

DI void qknorm_phase(const Args& A, LAS unsigned char* lds, int wv) {
    const int tid = otid(wv), lane = tid & 63, wave = tid >> 6, G = gridDim.x;
    bf16_t* Q = (bf16_t*)(A.ws + WS_SCR + A_Q); bf16_t* Kb = (bf16_t*)(A.ws + WS_SCR + A_K);
    const float* qn = A.in[14]; const float* kn = A.in[15];
    const int sub = lane >> 4, l16 = lane & 15, e0 = l16 * 8;
    LAS f32x2* rope = (LAS f32x2*)lds;
    for (int e = tid; e < 2048; e += NTHREADS) { const float ang = (float)(e >> 5) * exp2f(-(float)(e & 31) * 0.41524101186092029f); rope[e] = (f32x2){cosf(ang), sinf(ang)}; }
    __syncthreads();
    const long NIT = (long)NTOK * 20;
    for (long it0 = ((long)blockIdx.x * NWAVES + wave) * 16 + sub; it0 < NIT; it0 += (long)G * NWAVES * 16) {
        bf16_t* pq[4]; u32x4 raw[4];
#pragma unroll
        for (int k = 0; k < 4; ++k) { const long it = it0 + 4 * k; const int row = (int)(it / 20), hj = (int)(it % 20);
            pq[k] = (hj < 16) ? Q + (size_t)row * 2048 + hj * 128 + e0 : Kb + (size_t)row * 512 + (hj - 16) * 128 + e0;
            raw[k] = *(const u32x4*)pq[k]; }
#pragma unroll
        for (int k = 0; k < 4; ++k) {
            const long it = it0 + 4 * k; const int row = (int)(it / 20), hj = (int)(it % 20);
            const float* wn = (hj < 16 ? qn : kn) + e0;
            f32x4 a = {bf_lo(raw[k].x), bf_hi(raw[k].x), bf_lo(raw[k].y), bf_hi(raw[k].y)}, b = {bf_lo(raw[k].z), bf_hi(raw[k].z), bf_lo(raw[k].w), bf_hi(raw[k].w)};
            float ss = 0.f;
#pragma unroll
            for (int q = 0; q < 4; ++q) ss += a[q] * a[q] + b[q] * b[q];
            ss += __shfl_xor(ss, 1); ss += __shfl_xor(ss, 2); ss += __shfl_xor(ss, 4); ss += __shfl_xor(ss, 8);
            const float rs = 1.0f / sqrtf(ss * (1.f / 128.f) + EPS);
            const f32x4 w0 = *(const f32x4*)wn, w1 = *(const f32x4*)(wn + 4);
            a = a * rs * w0; b = b * rs * w1;
            const int t = row % TB;
            if (t < TL) {
                const int pos = (l16 < 8) ? (t >> 6) : (t & 63);
                float y[8] = {a[0], a[1], a[2], a[3], b[0], b[1], b[2], b[3]};
                const LAS f32x4* rp = (const LAS f32x4*)(rope + pos * 32 + ((4 * l16) & 31));
                const f32x4 c01 = rp[0], c23 = rp[1];
                const float cs[4] = {c01[0], c01[2], c23[0], c23[2]}, sn[4] = {c01[1], c01[3], c23[1], c23[3]};
#pragma unroll
                for (int pp = 0; pp < 4; ++pp) {
                    const float x0 = y[2 * pp], x1 = y[2 * pp + 1];
                    y[2 * pp] = x0 * cs[pp] - x1 * sn[pp]; y[2 * pp + 1] = x0 * sn[pp] + x1 * cs[pp];
                }
                a = (f32x4){y[0], y[1], y[2], y[3]}; b = (f32x4){y[4], y[5], y[6], y[7]};
            }
            st_bf16x8(pq[k], a, b);
        }
    }
}

DI void attn_layer(const Args& A, LAS unsigned char* lds, char* lds_gen, const XcdBarrier& gbar, int layer, int wv) {
    unsigned char* ws = A.ws;
    const bf16_t* H = (const bf16_t*)(ws + WS_H); bf16_t* U = (bf16_t*)(ws + WS_H);
    bf16_t* Q = (bf16_t*)(ws + WS_SCR + A_Q); bf16_t* Kb = (bf16_t*)(ws + WS_SCR + A_K); bf16_t* Vb = (bf16_t*)(ws + WS_SCR + A_V); bf16_t* SZ = (bf16_t*)(ws + WS_SCR + A_SZ);
    norm_phase(A, layer, false, wv);
    xcd_barrier(gbar, wv);
    {
        DescPlain D; D.init(H, (const bf16_t*)(ws + WS_WAI), 20, false);
        auto E = [=](const pg8::Unit& u, int row_l, int col_l, f32x4 v0, f32x4 v1) {
            const size_t row = (size_t)u.i0 * 256 + row_l; const int pn = u.i1;
            if (pn < 8) st_bf16x8(Q + row * 2048 + pn * 256 + col_l, v0, v1);
            else if (pn < 10) st_bf16x8(Kb + row * 512 + (pn - 8) * 256 + col_l, v0, v1);
            else if (pn < 12) st_bf16x8(Vb + row * 512 + (pn - 10) * 256 + col_l, v0, v1);
            else { f32x4 a, b;
#pragma unroll
                for (int q = 0; q < 4; ++q) { a[q] = siluf(v0[q]); b[q] = siluf(v1[q]); }
                st_bf16x8(SZ + row * 2048 + (pn - 12) * 256 + col_l, a, b); }
        };
        pg8::gemm_phase(lds, D, E, wv);
    }
    xcd_barrier(gbar, wv);
    qknorm_phase(A, lds, wv);
    xcd_barrier(gbar, wv);
    {
        const int G = gridDim.x, c = blockIdx.x;
        for (long L = c; L < 2048; L += G) {
            const int u = pg8::xcd_remap((int)L, 2048);
            const int b = u / 128, rem = u % 128, kvh = rem / 32, g = (rem / 8) % 4, qb = rem % 8, h = kvh * 4 + g;
            const size_t qoff = ((size_t)b * TB + qb * 256) * 2048 + h * 128, koff = ((size_t)b * TB) * 512 + kvh * 128;
            att::attn_dense_body(Q + qoff, Kb + koff, Vb + koff, SZ + qoff, U + qoff, TB, lds_gen, wv);
        }
        for (int u = c; u < 256; u += G) {
            const int b = u / 16, h = u % 16, kvh = h / 4;
            const size_t qoff = ((size_t)b * TB + TL) * 2048 + h * 128, koff = ((size_t)b * TB + TL) * 512 + kvh * 128;
            att::attn_dense_body(Q + qoff, Kb + koff, Vb + koff, SZ + qoff, U + qoff, TC, lds_gen, wv);
        }
    }
    xcd_barrier(gbar, wv);
    {
        DescPlain D; D.init(U, (const bf16_t*)(ws + WS_WAO), 8, false);
        const float* modl = (const float*)(ws + WS_MOD) + (size_t)layer * 17 * MOD_LD;
        auto E = [=](const pg8::Unit& u, int row_l, int col_l, f32x4 v0, f32x4 v1) { resid_store(A, layer, u.i0, row_l, u.i1 * 256 + col_l, modl, v0, v1); };
        pg8::gemm_phase(lds, D, E, wv);
    }
    xcd_barrier(gbar, wv);
}


struct DescM1 {
    static constexpr bool RAW = false;
    const bf16_t* H; const bf16_t* WA; const bf16_t* WB; int lda, ldb, K, total;
    DI void init(const bf16_t* H_, const bf16_t* WA_, const bf16_t* WB_) { H = H_; WA = WA_; WB = WB_; lda = DM; ldb = DM; K = DM; total = 144 * 9 + 12 * 144; }
    DI pg8::Unit unit(int idx) const {
        pg8::Unit u;
        if (idx < 1296) { const int nig = 72, gid = idx / nig, pm = gid * 8 + (idx % nig) % 8, pn = (idx % nig) / 8;
            u.a = (const char*)(H + (size_t)pm * 256 * DM); u.b = (const char*)(WA + (size_t)pn * 256 * DM); u.i0 = pm; u.i1 = pn; u.i2 = 0; }
        else { const int j = idx - 1296, mt = j % 12, nt = j / 12;
            u.a = (const char*)(WB + (size_t)mt * 256 * DM); u.b = (const char*)(H + (size_t)nt * 256 * DM); u.i0 = mt; u.i1 = nt; u.i2 = 1; }
        return u;
    }
};
namespace ml {
#define MFMA32(a, b, c) __builtin_amdgcn_mfma_f32_32x32x16_bf16((a), (b), (c), 0, 0, 0)
#define LFENCE() asm volatile("s_waitcnt lgkmcnt(0)" ::: "memory")
DI float dot2_bf16(unsigned a, unsigned b, float c) { asm("v_dot2c_f32_bf16 %0, %1, %2" : "+v"(c) : "v"(a), "v"(b)); return c; }
#define DOT2(a, b, c) dot2_bf16((a), (b), (c))
DI int crow(int reg, int h) { return (reg & 3) + 8 * (reg >> 2) + 4 * h; }
DI bf16x8 ldperm(const bf16_t* p) { const s16x4 lo = *(const s16x4*)p, hi = *(const s16x4*)(p + 8); return __builtin_shufflevector(lo, hi, 0, 1, 2, 3, 4, 5, 6, 7); }
DI bf16x8 pack_step(const f32x16& x, int s) { u32x4 p = {pk2(x[8 * s], x[8 * s + 1]), pk2(x[8 * s + 2], x[8 * s + 3]), pk2(x[8 * s + 4], x[8 * s + 5]), pk2(x[8 * s + 6], x[8 * s + 7])}; return __builtin_bit_cast(bf16x8, p); }
DI float bfs(short h) { return __uint_as_float(((unsigned)(unsigned short)h) << 16); }

constexpr int SC_Q = 0, SC_K = 16384, SC_KT = 32768, SC_BUF = 49152, SC_WAVE = 2 * SC_BUF, SC_WAVE_BYTES = 6656;
DI bf16x8 ldsfrag(const LAS unsigned char* buf, unsigned o) { const s16x4 lo = *(const LAS s16x4*)(buf + o), hi = *(const LAS s16x4*)(buf + (o ^ 16u)); return __builtin_shufflevector(lo, hi, 0, 1, 2, 3, 4, 5, 6, 7); }
DI void scan_phase(const Args& A, LAS unsigned char* lds, int wv) {
    const int wave = wv;
    LAS float* wl = (LAS float*)(lds + SC_WAVE + wave * SC_WAVE_BYTES);
    LAS unsigned* nbp = (LAS unsigned*)(lds + SC_WAVE + wave * SC_WAVE_BYTES + 2048);
    LAS unsigned* wbp = nbp + 64;
    LAS unsigned char* hst = lds + SC_WAVE + wave * SC_WAVE_BYTES + 2560;
    unsigned char* ws = A.ws;
    const bf16_t* Qg = (const bf16_t*)(ws + WS_SCR + M_Q); const bf16_t* Kg = (const bf16_t*)(ws + WS_SCR + M_K); const bf16_t* KVT = (const bf16_t*)(ws + WS_SCR + M_KVT);
    const float* G32 = (const float*)(ws + WS_SCR + M_G32); const float* bg = A.in[10];
#define SC_POS0(j) (dir == 0 ? ((j) < 4 ? TL + 64 * (j) : 64 * ((j) - 4)) : ((j) < 4 ? TL + 64 * (3 - (j)) : 64 * (35 - (j))))
#define SC_DMA(bufi, p0) do { const int tj_ = otid(wv); _Pragma("unroll") for (int i_ = 0; i_ < 2; ++i_) { const int sl_ = i_ * 512 + tj_; \
        { const int row_ = sl_ >> 4, c_ = (sl_ & 15) ^ (row_ & 15); const size_t go_ = (size_t)((p0) + row_) * 1024 + c_ * 8; \
          __builtin_amdgcn_global_load_lds((const unsigned*)(Qu + go_), (LAS unsigned*)(lds + (bufi) * SC_BUF + SC_Q + i_ * 8192 + wave * 1024), 16, 0, 0); \
          __builtin_amdgcn_global_load_lds((const unsigned*)(Ku + go_), (LAS unsigned*)(lds + (bufi) * SC_BUF + SC_K + i_ * 8192 + wave * 1024), 16, 0, 0); } \
        { const int d_ = sl_ >> 3, c_ = (sl_ & 7) ^ ((d_ >> 1) & 7); \
          __builtin_amdgcn_global_load_lds((const unsigned*)(KTu + (size_t)d_ * TB + (p0) + c_ * 8), (LAS unsigned*)(lds + (bufi) * SC_BUF + SC_KT + i_ * 8192 + wave * 1024), 16, 0, 0); } } } while (0)
    for (int item = blockIdx.x; item < 256; item += gridDim.x) {
        const int dir = item & 1, h = (item >> 1) & 7, b = item >> 4, e0 = wave * 32;
        const bf16_t* Qu = Qg + (size_t)b * TB * 1024 + h * 128;
        const bf16_t* Ku = Kg + (size_t)b * TB * 1024 + h * 128;
        const bf16_t* KTu = KVT + ((size_t)b * 3072 + h * 128) * TB;
        const bf16_t* VTu = KVT + ((size_t)b * 3072 + 1024 + h * 256 + e0) * TB;
        bf16_t* Hout = (bf16_t*)(ws + WS_SCR + (dir ? M_HB : M_HF)) + (size_t)b * TB * DM + h * 256 + e0;
        const float big = bg[(dir * 2) * 8 + h], bfg = bg[(dir * 2 + 1) * 8 + h];
        f32x16 cacc[4];
#pragma unroll
        for (int d = 0; d < 4; ++d)
#pragma unroll
            for (int i = 0; i < 16; ++i) cacc[d][i] = 0.f;
        float m = 0.f;
        { const int l0 = otid(wv) & 63; wl[384 + l0] = 0.f; wl[448 + l0] = 0.f; nbp[l0] = 0u; }
        LFENCE();
        SC_DMA(0, SC_POS0(0));
        float ig_n, fg_n;
        { const int l0 = otid(wv) & 63; const float* gp = G32 + (size_t)(b * TB + SC_POS0(0) + (dir ? 63 - l0 : l0)) * 32 + (dir * 2) * 8 + h; ig_n = gp[0]; fg_n = gp[8]; }
        for (int j = 0; j < 36; ++j) {
            const int pos0 = SC_POS0(j);
            const LAS unsigned char* Qb = lds + (j & 1) * SC_BUF + SC_Q; const LAS unsigned char* Kb = lds + (j & 1) * SC_BUF + SC_K; const LAS unsigned char* KTb = lds + (j & 1) * SC_BUF + SC_KT;
            asm volatile("s_waitcnt vmcnt(0)" ::: "memory"); __builtin_amdgcn_s_barrier(); asm volatile("" ::: "memory");
            if (j + 1 < 36) SC_DMA((j + 1) & 1, SC_POS0(j + 1));
            const int lj = otid(wv) & 63, rj = lj & 31, h4 = (lj >> 5) * 4;
            LAS float* wh = wl + h4; LAS float* wr = wl + rj; LAS unsigned char* hb = hst + h4 * 64 + rj * 2;
            const LAS unsigned* nbh = nbp + (h4 >> 1); const LAS unsigned* wbh = wbp + (h4 >> 1);
            const unsigned xr = rj & 15, xd = (rj >> 1) & 7;
            const unsigned qro = (unsigned)rj * 256u + 2u * h4;
            const unsigned kro = (unsigned)rj * 128u + 2u * h4;
            const bf16_t* VTp = VTu + (size_t)rj * TB + pos0 + h4;
            bf16x8 vf[4];
#pragma unroll
            for (int kk = 0; kk < 4; ++kk) vf[kk] = ldperm(VTp + 16 * kk);
            float decay, m_new;
            {
                const int s = dir ? 63 - lj : lj;
                const float ig = ig_n + big, fg = fg_n + bfg;
                if (j + 1 < 36) { const float* gp = G32 + (size_t)(b * TB + SC_POS0(j + 1) + s) * 32 + (dir * 2) * 8 + h; ig_n = gp[0]; fg_n = gp[8]; }
                const float lf = fminf(fg, 0.f) - log1pf(__expf(-fabsf(fg)));
                float bs = lf;
#pragma unroll
                for (int o = 1; o < 64; o <<= 1) { const float t = __shfl_up(bs, o); if (lj >= o) bs += t; }
                const float uu = ig - bs;
                float pmx = uu;
#pragma unroll
                for (int o = 1; o < 64; o <<= 1) { const float t = __shfl_up(pmx, o); if (lj >= o) pmx = fmaxf(pmx, t); }
                pmx = fmaxf(pmx, m);
                const float b_end = __shfl(bs, 63), pm_last = __shfl(pmx, 63);
                LAS float* ws_ = wl + s;
                ws_[0] = uu * 1.4426950408889634f; ws_[64] = pmx * 1.4426950408889634f; ws_[128] = __expf(m - pmx); ws_[192] = __expf(-(bs + pmx)); ws_[256] = __expf(uu - pm_last);
                { const float wv_ = __expf(uu - pm_last), wp_ = __shfl_xor(wv_, 1); if ((s & 1) == 0) wbp[s >> 1] = pk2(wv_, wp_); }
                decay = __expf(m - pm_last); m_new = b_end + pm_last;
            }
            LFENCE();
            const int sbase = dir ? 63 - h4 : h4, sgn = dir ? -1 : 1;
#pragma unroll
            for (int tb = 0; tb < 2; ++tb) {
                __builtin_amdgcn_sched_barrier(0);
                const unsigned qo = qro + tb * 8192u;
                f32x16 ha;
#pragma unroll
                for (int i = 0; i < 16; ++i) ha[i] = 0.f;
                float qnv = 0.f;
#pragma unroll
                for (int kk = 0; kk < 8; ++kk) {
                    const bf16x8 qa = ldsfrag(Qb, qo + (((2u * kk) ^ xr) << 4));
                    ha = MFMA32(qa, pack_step(cacc[kk >> 1], kk & 1), ha);
                    { const u32x2 nb0 = *(const LAS u32x2*)(nbh + 8 * kk), nb1 = *(const LAS u32x2*)(nbh + 8 * kk + 4); const u32x4 qw = __builtin_bit_cast(u32x4, qa);
                      qnv = DOT2(qw.x, nb0.x, qnv); qnv = DOT2(qw.y, nb0.y, qnv); qnv = DOT2(qw.z, nb1.x, qnv); qnv = DOT2(qw.w, nb1.y, qnv); }
                }
                qnv += __shfl_xor(qnv, 32);
#pragma unroll
                for (int g = 0; g < 4; ++g) { const f32x4 av = *(const LAS f32x4*)(wh + 128 + 32 * tb + 8 * g);
#pragma unroll
                    for (int q = 0; q < 4; ++q) ha[4 * g + q] *= av[q]; }
                const float pmt = wr[64 + 32 * tb];
                const int tp = dir ? (63 - 32 * tb) - rj : 32 * tb + rj;
                float ds = 0.f;
#pragma unroll
                for (int sb = 0; sb < 2; ++sb) {
                    __builtin_amdgcn_sched_barrier(0);
                    if (sb != tb && (dir ? sb < tb : sb > tb)) continue;
                    const unsigned ko = qro + sb * 8192u;
                    f32x16 st;
#pragma unroll
                    for (int i = 0; i < 16; ++i) st[i] = 0.f;
#pragma unroll
                    for (int kk = 0; kk < 8; ++kk) { const unsigned c = ((2u * kk) ^ xr) << 4; st = MFMA32(ldsfrag(Kb, ko + c), ldsfrag(Qb, qo + c), st); }
#pragma unroll
                    for (int g = 0; g < 4; ++g) { const f32x4 uv = *(const LAS f32x4*)(wh + 32 * sb + 8 * g);
#pragma unroll
                        for (int q = 0; q < 4; ++q) {
                            const int sc = 32 * sb + q + 8 * g;
                            const int sp = sbase + sgn * sc;
                            st[4 * g + q] *= __builtin_amdgcn_exp2f((sp <= tp) ? uv[q] - pmt : -1e30f);
                            ds += st[4 * g + q];
                        } }
                    ha = MFMA32(pack_step(st, 0), vf[2 * sb], ha);
                    ha = MFMA32(pack_step(st, 1), vf[2 * sb + 1], ha);
                }
                ds += __shfl_xor(ds, 32);
                {
                    const float den = wr[128 + 32 * tb] * qnv + ds;
                    const float rd = 1.0f / fmaxf(fabsf(den), wr[192 + 32 * tb]);
                    if (h4 == 0) wr[320 + 32 * tb] = rd;
                }
                LFENCE();
#pragma unroll
                for (int g = 0; g < 4; ++g) { const f32x4 rv = *(const LAS f32x4*)(wh + 320 + 32 * tb + 8 * g);
#pragma unroll
                    for (int q = 0; q < 4; ++q) { const int tc = 32 * tb + q + 8 * g;
                        *(LAS unsigned short*)(hb + tc * 64) = (unsigned short)(pk2(ha[4 * g + q] * rv[q], 0.f) & 0xffffu); } }
            }
            LFENCE();
            {
                bf16_t* hp = Hout + (size_t)(pos0 + lj) * DM;
                const LAS unsigned char* hrow = hst + lj * 64;
#pragma unroll
                for (int q = 0; q < 4; ++q) *(u32x4*)(hp + 8 * q) = *(const LAS u32x4*)(hrow + 16 * q);
            }
            __builtin_amdgcn_sched_barrier(0);
            bf16x8 vfw[4];
#pragma unroll
            for (int kk = 0; kk < 4; ++kk) {
                const f32x4 w0 = *(const LAS f32x4*)(wh + 256 + 16 * kk), w1 = *(const LAS f32x4*)(wh + 256 + 16 * kk + 8);
                u32x4 p = {pk2(bfs(vf[kk][0]) * w0[0], bfs(vf[kk][1]) * w0[1]), pk2(bfs(vf[kk][2]) * w0[2], bfs(vf[kk][3]) * w0[3]),
                           pk2(bfs(vf[kk][4]) * w1[0], bfs(vf[kk][5]) * w1[1]), pk2(bfs(vf[kk][6]) * w1[2], bfs(vf[kk][7]) * w1[3])};
                vfw[kk] = __builtin_bit_cast(bf16x8, p);
            }
#pragma unroll
            for (int db = 0; db < 4; ++db) {
                if (db == 2) __builtin_amdgcn_sched_barrier(0);
#pragma unroll
                for (int i = 0; i < 16; ++i) cacc[db][i] *= decay;
                const unsigned to = kro + db * 4096u;
                float nadd = 0.f;
#pragma unroll
                for (int kk = 0; kk < 4; ++kk) {
                    const bf16x8 kv = ldsfrag(KTb, to + (((2u * kk) ^ xd) << 4));
                    const u32x2 wq0 = *(const LAS u32x2*)(wbh + 8 * kk), wq1 = *(const LAS u32x2*)(wbh + 8 * kk + 4); const u32x4 kw = __builtin_bit_cast(u32x4, kv);
                    nadd = DOT2(kw.x, wq0.x, nadd); nadd = DOT2(kw.y, wq0.y, nadd); nadd = DOT2(kw.z, wq1.x, nadd); nadd = DOT2(kw.w, wq1.y, nadd);
                    cacc[db] = MFMA32(kv, vfw[kk], cacc[db]);
                }
                nadd += __shfl_xor(nadd, 32);
                const float nnew = decay * wr[384 + 32 * db] + nadd, npart = __shfl_xor(nnew, 1);
                if (h4 == 0) { wr[384 + 32 * db] = nnew; if ((rj & 1) == 0) nbp[(32 * db + rj) >> 1] = pk2(nnew, npart); }
            }
            LFENCE();
            m = m_new;
        }
        asm volatile("s_waitcnt vmcnt(0)" ::: "memory"); __builtin_amdgcn_s_barrier();
    }
#undef SC_DMA
#undef SC_POS0
}
#undef MFMA32
#undef LFENCE
#undef DOT2
}

DI void mlstm_finish_phase(const Args& A, int wv) {
    const int tid = otid(wv), lane = tid & 63, wave = tid >> 6, G = gridDim.x;
    unsigned char* ws = A.ws;
    const bf16_t* HF = (const bf16_t*)(ws + WS_SCR + M_HF); const bf16_t* HB = (const bf16_t*)(ws + WS_SCR + M_HB);
    const bf16_t* SO = (const bf16_t*)(ws + WS_SCR + M_SO); const bf16_t* SZ = (const bf16_t*)(ws + WS_SCR + M_SZ);
    bf16_t* U = (bf16_t*)(ws + WS_H); const float* hn = A.in[11];
    const int sub = lane >> 5, e0 = (lane & 31) * 8;
    const long NIT = (long)NTOK * 8;
    for (long it0 = ((long)blockIdx.x * NWAVES + wave) * 4 + sub; it0 < NIT; it0 += (long)G * NWAVES * 4) {
        f32x4 f0[2], f1[2], b0[2], b1[2], o0[2], o1[2], z0[2], z1[2];
#pragma unroll
        for (int k = 0; k < 2; ++k) { const long it = it0 + 2 * k; const size_t off = (size_t)(it >> 3) * DM + (int)(it & 7) * 256 + e0;
            ld_bf16x8(HF + off, f0[k], f1[k]); ld_bf16x8(HB + off, b0[k], b1[k]); ld_bf16x8(SO + off, o0[k], o1[k]); ld_bf16x8(SZ + off, z0[k], z1[k]); }
#pragma unroll
        for (int k = 0; k < 2; ++k) { const long it = it0 + 2 * k; const size_t off = (size_t)(it >> 3) * DM + (int)(it & 7) * 256 + e0;
            f32x4 y0 = o0[k] * (f0[k] + b0[k]), y1 = o1[k] * (f1[k] + b1[k]);
            float ss = 0.f;
#pragma unroll
            for (int q = 0; q < 4; ++q) ss += y0[q] * y0[q] + y1[q] * y1[q];
            ss += __shfl_xor(ss, 1); ss += __shfl_xor(ss, 2); ss += __shfl_xor(ss, 4); ss += __shfl_xor(ss, 8); ss += __shfl_xor(ss, 16);
            const float rs = 1.0f / sqrtf(ss * (1.f / 256.f) + EPS);
            const float* hp = hn + (int)(it & 7) * 256 + e0;
            const f32x4 h0 = *(const f32x4*)hp, h1 = *(const f32x4*)(hp + 4);
            st_bf16x8(U + off, y0 * rs * h0 * z0[k], y1 * rs * h1 * z1[k]); }
    }
}

DI void mlstm_layer(const Args& A, LAS unsigned char* lds, const XcdBarrier& gbar, int layer, int wv) {
    unsigned char* ws = A.ws;
    const bf16_t* H = (const bf16_t*)(ws + WS_H); bf16_t* U = (bf16_t*)(ws + WS_H);
    bf16_t* Q = (bf16_t*)(ws + WS_SCR + M_Q); bf16_t* Kb = (bf16_t*)(ws + WS_SCR + M_K); bf16_t* KVT = (bf16_t*)(ws + WS_SCR + M_KVT);
    float* G32 = (float*)(ws + WS_SCR + M_G32); bf16_t* SO = (bf16_t*)(ws + WS_SCR + M_SO); bf16_t* SZ = (bf16_t*)(ws + WS_SCR + M_SZ);
    norm_phase(A, layer, false, wv);
    xcd_barrier(gbar, wv);
    {
        DescM1 D; D.init(H, (const bf16_t*)(ws + WS_WMA), (const bf16_t*)(ws + WS_WMB));
        auto E = [=](const pg8::Unit& u, int row_l, int col_l, f32x4 v0, f32x4 v1) {
            if (u.i2 == 0) {
                const size_t row = (size_t)u.i0 * 256 + row_l; const int pn = u.i1;
                if (pn < 4) st_bf16x8(Q + row * 1024 + pn * 256 + col_l, v0 * 0.088388347648318440f, v1 * 0.088388347648318440f);
                else if (pn < 8) st_bf16x8(Kb + row * 1024 + (pn - 4) * 256 + col_l, v0, v1);
                else if (col_l < 32) { *(f32x4*)(G32 + row * 32 + col_l) = v0; *(f32x4*)(G32 + row * 32 + col_l + 4) = v1; }
            } else {
                const int bb = u.i1 / 9, s0 = (u.i1 % 9) * 256;
                st_bf16x8(KVT + ((size_t)bb * 3072 + u.i0 * 256 + row_l) * TB + s0 + col_l, v0, v1);
            }
        };
        pg8::gemm_phase(lds, D, E, wv);
    }
    xcd_barrier(gbar, wv);
    ml::scan_phase(A, lds, wv);
    xcd_barrier(gbar, wv);
    {
        DescPlain D; D.init(H, (const bf16_t*)(ws + WS_WMA) + (size_t)2304 * DM, 16, false);
        auto E = [=](const pg8::Unit& u, int row_l, int col_l, f32x4 v0, f32x4 v1) {
            const size_t row = (size_t)u.i0 * 256 + row_l; const int pn = u.i1; f32x4 a, b;
            if (pn < 8) {
#pragma unroll
                for (int q = 0; q < 4; ++q) { a[q] = sigmf(v0[q]); b[q] = sigmf(v1[q]); }
                st_bf16x8(SO + row * DM + pn * 256 + col_l, a, b);
            } else {
#pragma unroll
                for (int q = 0; q < 4; ++q) { a[q] = siluf(v0[q]); b[q] = siluf(v1[q]); }
                st_bf16x8(SZ + row * DM + (pn - 8) * 256 + col_l, a, b);
            }
        };
        pg8::gemm_phase(lds, D, E, wv);
    }
    xcd_barrier(gbar, wv);
    mlstm_finish_phase(A, wv);
    xcd_barrier(gbar, wv);
    {
        DescPlain D; D.init(U, (const bf16_t*)(ws + WS_WMO), 8, false);
        const float* modl = (const float*)(ws + WS_MOD) + (size_t)layer * 17 * MOD_LD;
        auto E = [=](const pg8::Unit& u, int row_l, int col_l, f32x4 v0, f32x4 v1) { resid_store(A, layer, u.i0, row_l, u.i1 * 256 + col_l, modl, v0, v1); };
        pg8::gemm_phase(lds, D, E, wv);
    }
    xcd_barrier(gbar, wv);
}

__global__ void __launch_bounds__(NTHREADS, 2) fwd_megakernel(Args A) {
    extern __shared__ __attribute__((aligned(16))) unsigned char lds_raw[];
    LAS unsigned char* lds = (LAS unsigned char*)lds_raw;
    cg::grid_group grid = cg::this_grid();
    const int wv = __builtin_amdgcn_readfirstlane(threadIdx.x >> 6);
    volatile LAS unsigned* bst = (volatile LAS unsigned*)(lds + 152576);
    if (otid(wv) < 2) bst[otid(wv)] = 0u;
    __syncthreads();
    const XcdBarrier gbar = xcd_barrier_post((unsigned*)(A.ws + WS_BAR), bst, wv);
    prep_phase(A, lds, wv);
    grid.sync();
    {
        const long long* mi = (const long long*)(A.ws + WS_MODI); float* mf = (float*)(A.ws + WS_MOD);
        for (int i = blockIdx.x * NTHREADS + otid(wv); i < 4 * 17 * MOD_LD; i += gridDim.x * NTHREADS) mf[i] = (float)mi[i] * MODI_INV;
    }
    xcd_barrier(gbar, wv);
    fnet_layer(A, lds, gbar, 0, 0, false, wv);
    mlstm_layer(A, lds, gbar, 1, wv);
    attn_layer(A, lds, (char*)lds_raw, gbar, 2, wv);
    fnet_layer(A, lds, gbar, 3, 1, true, wv);
    final_norm_phase(A, (const bf16_t*)(A.ws + WS_SCR + F_PQX), wv);
}

extern "C" void kernel_launch(void* const* d_in, const int* in_sizes, int n_in, void* d_out, int out_size, void* d_ws, size_t ws_size, hipStream_t stream) {
    static int grid = 0;
    if (grid == 0) {
        if (n_in != 18 || ws_size < WS_END) { fprintf(stderr, "kernel_launch: unexpected n_in %d / ws_size %zu (need %zu)\n", n_in, ws_size, (size_t)WS_END); grid = -1; return; }
        int dev = 0, cus = 0, per_cu = 0;
        hipGetDevice(&dev);
        hipDeviceGetAttribute(&cus, hipDeviceAttributeMultiprocessorCount, dev);
        if (hipFuncSetAttribute((const void*)fwd_megakernel, hipFuncAttributeMaxDynamicSharedMemorySize, LDS_BYTES) != hipSuccess) { fprintf(stderr, "kernel_launch: hipFuncSetAttribute failed\n"); grid = -1; return; }
        if (hipOccupancyMaxActiveBlocksPerMultiprocessor(&per_cu, (const void*)fwd_megakernel, NTHREADS, LDS_BYTES) != hipSuccess || per_cu < 1) { fprintf(stderr, "kernel_launch: occupancy query failed (%d)\n", per_cu); per_cu = 1; }
        (void)hipGetLastError();
        grid = cus * per_cu;
        fprintf(stderr, "kernel_launch: grid %d (cus %d x %d)\n", grid, cus, per_cu);
    }
    if (grid < 0) return;
    (void)hipMemsetAsync((char*)d_ws + WS_MOD, 0, ZERO_BYTES, stream);
    (void)hipMemsetAsync((char*)d_ws + WS_MODI, 0, MODI_BYTES, stream);
    Args a{};
    for (int i = 0; i < 18; ++i) a.in[i] = (const float*)d_in[i];
    a.out = (float*)d_out; a.ws = (unsigned char*)d_ws; a.ph_lo = 0; a.ph_hi = 100;
    void* args[] = {&a};
    hipError_t e = hipLaunchCooperativeKernel((const void*)fwd_megakernel, dim3(grid), dim3(NTHREADS), args, LDS_BYTES, stream);
    if (e != hipSuccess) fprintf(stderr, "kernel_launch: cooperative launch failed: %s (grid %d)\n", hipGetErrorString(e), grid);
}
```

```cpp
#include <hip/hip_runtime.h>
#include <hip/hip_cooperative_groups.h>
#include <cstdio>
#include <cstdint>
namespace cg = cooperative_groups;

#define LAS __attribute__((address_space(3)))
#define DI __device__ __forceinline__
typedef unsigned short bf16_t;
typedef short bf16x8 __attribute__((ext_vector_type(8)));
typedef short s16x4 __attribute__((ext_vector_type(4)));
typedef float f32x2 __attribute__((ext_vector_type(2)));
typedef float f32x4 __attribute__((ext_vector_type(4)));
typedef float f32x16 __attribute__((ext_vector_type(16)));
typedef unsigned u32x2 __attribute__((ext_vector_type(2)));
typedef unsigned u32x4 __attribute__((ext_vector_type(4)));
typedef __bf16 bf16v2 __attribute__((ext_vector_type(2)));

constexpr int DM = 2048, NB = 16, TL = 2048, TC = 256, TB = TL + TC, NTOK = NB * TB;
constexpr int NWAVES = 8, NTHREADS = 512;
constexpr float EPS = 1e-6f;
constexpr int MOD_LD = 3 * DM;
constexpr int M_WA_ROWS = 6400, M_WB_ROWS = 3072;
constexpr size_t MiB = 1u << 20;
constexpr size_t WS_SCR_ = 301 * MiB;
constexpr size_t WS_MOD = 0;
constexpr size_t MOD_BYTES = (size_t)4 * 17 * MOD_LD * 4;
constexpr size_t WS_BAR = 1792 * 1024, ZERO_BYTES = 2 * MiB;
constexpr size_t WS_MODI = WS_SCR_ + 700 * MiB, MODI_BYTES = (size_t)4 * 17 * MOD_LD * 8;
constexpr float MODI_SCALE = 1073741824.f, MODI_INV = 9.313225746154785e-10f;
constexpr size_t WS_WFG = 2 * MiB, WS_WFO = 18 * MiB, WS_WMA = 34 * MiB, WS_WMB = 59 * MiB, WS_WMO = 71 * MiB, WS_WAI = 79 * MiB, WS_WAO = 99 * MiB;
constexpr size_t WS_DC = 107 * MiB, WS_DT = 108 * MiB, WS_DT2 = 124 * MiB, WS_CTXS = 125 * MiB, WS_H = 157 * MiB, WS_SCR = 301 * MiB;
constexpr size_t WS_END = 1024 * MiB;
constexpr size_t F_G = 0, F_PQX = 144 * MiB, F_PQC = 400 * MiB, F_A1 = 432 * MiB;
constexpr size_t M_Q = 0, M_K = 72 * MiB, M_KVT = 144 * MiB, M_G32 = 360 * MiB, M_HF = 365 * MiB, M_HB = 509 * MiB, M_SO = 0, M_SZ = 144 * MiB;
constexpr size_t A_Q = 0, A_K = 144 * MiB, A_V = 180 * MiB, A_SZ = 216 * MiB;
static_assert(WS_SCR + M_HB + 144 * MiB <= WS_END, "ws map");
constexpr int LDS_BYTES = 152576 + 1024;

DI unsigned pk2(float a, float b) { f32x2 v = {a, b}; return __builtin_bit_cast(unsigned, __builtin_convertvector(v, bf16v2)); }
DI float bf_lo(unsigned w) { return __uint_as_float(w << 16); }
DI float bf_hi(unsigned w) { return __uint_as_float(w & 0xffff0000u); }
DI float wave_sum(float v) {
#pragma unroll
    for (int o = 1; o < 64; o <<= 1) v += __shfl_xor(v, o);
    return v;
}
DI int otid(int wv) { int t; asm volatile("v_mbcnt_lo_u32_b32 %0, -1, 0\n\tv_mbcnt_hi_u32_b32 %0, -1, %0" : "=v"(t)); return wv * 64 + t; }
DI float siluf(float x) { return x / (1.f + __expf(-x)); }
DI float sigmf(float x) { return 1.f / (1.f + __expf(-x)); }
DI void st_bf16x8(bf16_t* p, f32x4 a, f32x4 b) { u32x4 w = {pk2(a[0], a[1]), pk2(a[2], a[3]), pk2(b[0], b[1]), pk2(b[2], b[3])}; *(u32x4*)p = w; }
DI void ld_bf16x8(const bf16_t* p, f32x4& a, f32x4& b) { const u32x4 w = *(const u32x4*)p; a = (f32x4){bf_lo(w.x), bf_hi(w.x), bf_lo(w.y), bf_hi(w.y)}; b = (f32x4){bf_lo(w.z), bf_hi(w.z), bf_lo(w.w), bf_hi(w.w)}; }

DI f32x4 ldmod4(const long long* p) { return (f32x4){(float)p[0] * MODI_INV, (float)p[1] * MODI_INV, (float)p[2] * MODI_INV, (float)p[3] * MODI_INV}; }

struct Args { const float* in[18]; float* out; unsigned char* ws; int ph_lo, ph_hi; };

#define XB_TMO      128
#define XB_XCNT(j)  (256  + 64 * (j))
#define XB_XSUB(j)  (1280 + 64 * (j))
#define XB_XGEN(j)  (2304 + 64 * (j))
#define XB_TOP      3328
#define XB_TOPGEN   3392
#define XCD_BAR_WORDS 3456
#define XB_SPIN_CAP (1u << 18)

__device__ __forceinline__ unsigned xb_ld(unsigned* p)              { return __hip_atomic_load(p, __ATOMIC_RELAXED, __HIP_MEMORY_SCOPE_AGENT); }
__device__ __forceinline__ unsigned xb_add(unsigned* p, unsigned v) { return __hip_atomic_fetch_add(p, v, __ATOMIC_RELAXED, __HIP_MEMORY_SCOPE_AGENT); }
__device__ __forceinline__ unsigned xb_xcc_id() { return (unsigned)__builtin_amdgcn_s_getreg((3 << 11) | 20) & 0xFu; }
#define XB_SPIN(cond, bar) do { unsigned _sp = 0; while (cond) { __builtin_amdgcn_s_sleep(1); \
    if ((++_sp & 255u) == 0u) { if (xb_ld(&(bar)[XB_TMO])) break; if (_sp > XB_SPIN_CAP) { atomicAdd(&(bar)[XB_TMO], 1u); break; } } } } while (0)

struct XcdBarrier {
    unsigned* bar; unsigned x;
    volatile LAS unsigned* st;
};

__device__ __forceinline__ XcdBarrier xcd_barrier_post(unsigned* bar, volatile LAS unsigned* st, int wv) {
    XcdBarrier b; b.bar = bar; b.x = xb_xcc_id(); b.st = st;
    if (otid(wv) == 0) (void)xb_add(&bar[XB_XCNT(b.x)], 1u);
    return b;
}
__device__ __forceinline__ void xcd_barrier_complete(unsigned* bar, unsigned x, unsigned& nloc, unsigned& nx) {
    const unsigned G = gridDim.x * gridDim.y * gridDim.z;
    unsigned sum, cnt, mine, sp = 0u;
    for (;;) {
        sum = 0u; cnt = 0u; mine = 0u;
#pragma unroll
        for (unsigned j = 0; j < 16; ++j) { const unsigned c = xb_ld(&bar[XB_XCNT(j)]); sum += c; cnt += (c > 0u) ? 1u : 0u; mine = (j == x) ? c : mine; }
        if (sum == G) break;
        __builtin_amdgcn_s_sleep(1);
        if ((++sp & 255u) == 0u) { if (xb_ld(&bar[XB_TMO])) break; if (sp > XB_SPIN_CAP) { atomicAdd(&bar[XB_TMO], 1u); break; } }
    }
    nloc = mine > 0u ? mine : 1u; nx = cnt > 0u ? cnt : 1u;
}

__device__ __forceinline__ void xcd_barrier(const XcdBarrier& b, int wv) {
    asm volatile("s_waitcnt vmcnt(0)" ::: "memory");
    __syncthreads();
    if (otid(wv) == 0) {
        unsigned* bar = b.bar;
        __builtin_amdgcn_s_waitcnt(0);
        unsigned nloc = b.st[0], nx = b.st[1];
        if (nloc == 0u) { xcd_barrier_complete(bar, b.x, nloc, nx); b.st[0] = nloc; b.st[1] = nx; }
        const unsigned old = xb_add(&bar[XB_XSUB(b.x)], 1u);
        const unsigned gen = old / nloc;
        if (old + 1u == (gen + 1u) * nloc) {
            __builtin_amdgcn_fence(__ATOMIC_RELEASE, "agent");
            asm volatile("s_waitcnt vmcnt(0)" ::: "memory");
            const unsigned og = xb_add(&bar[XB_TOP], 1u);
            const unsigned tg = og / nx;
            if (og + 1u == (tg + 1u) * nx) xb_add(&bar[XB_TOPGEN], 1u);
            else XB_SPIN(xb_ld(&bar[XB_TOPGEN]) == tg, bar);
            __builtin_amdgcn_fence(__ATOMIC_ACQUIRE, "agent");
            xb_add(&bar[XB_XGEN(b.x)], 1u);
            asm volatile("s_waitcnt vmcnt(0)" ::: "memory");
        } else {
            XB_SPIN(xb_ld(&bar[XB_XGEN(b.x)]) == gen, bar);
            __builtin_amdgcn_fence(__ATOMIC_ACQUIRE, "agent");
            asm volatile("s_waitcnt vmcnt(0)" ::: "memory");
        }
    }
    __syncthreads();
}


namespace pg8 {
constexpr int BM = 256, BK = 64, HALF = 128, HTB = HALF * BK * 2, NXCD = 8;
DI int lds_byte(int r, int c) { const int st = (r >> 4) * 2 + (c >> 5), rr = r & 15, cc = c & 31, ob = rr * 64 + cc * 2; return st * 1024 + (ob ^ (((ob >> 9) & 1) << 5)); }
DI void stage_rc(int b, int& R, int& C) { const int st = b / 1024, sb = b % 1024, swz = sb ^ (((sb >> 9) & 1) << 5); R = (st >> 1) * 16 + swz / 64; C = (st & 1) * 32 + (swz % 64) / 2; }
DI int perm32(int rho) { const int n = rho >> 4, i = rho & 15; return 8 * (i >> 2) + 4 * n + (i & 3); }
struct Unit { const char* a; const char* b; int i0, i1, i2; };
DI int xcd_remap(int L, int total) { const int q = total / NXCD, r = total % NXCD, xcd = L % NXCD, off = L / NXCD; return (xcd < r ? xcd * (q + 1) : r * (q + 1) + (xcd - r) * q) + off; }

template <class Desc, class Epi>
DI void gemm_phase(LAS unsigned char* lds, const Desc& D, const Epi& E, int wv) {
    const int tid = otid(wv), wid = __builtin_amdgcn_readfirstlane(tid >> 6), lane = tid & 63, wr = wid >> 2, wc = wid & 3, fr = lane & 15, fq = lane >> 4;
    const int G = gridDim.x, c = blockIdx.x, total = D.total;
    const int K = D.K, nt = K / BK;
    unsigned voffA[2], voffB[2];
#pragma unroll
    for (int i = 0; i < 2; ++i) { int R, C; stage_rc(tid * 16 + i * 8192, R, C); const int Rb = (R & ~31) + perm32(R & 31);
        voffA[i] = (unsigned)(R * D.lda + C) * 2u; voffB[i] = (unsigned)(Rb * D.ldb + C) * 2u; }
    const size_t kstep = (size_t)(BK * 2);
    const size_t hstepA = (size_t)HALF * D.lda * 2, hstepB = (size_t)HALF * D.ldb * 2;
    const unsigned ldsw = (unsigned)wid * 1024u;
    const int aoff = lds_byte(wr * 64 + fr, fq * 8), boff = lds_byte(wc * 32 + fr, fq * 8);
#define PG8_SA(b, h) (((b) * 2 + (h)) * HTB)
#define PG8_SB(b, h) ((4 + (b) * 2 + (h)) * HTB)
#define PG8_STAGE(bufoff, gbase, voff) do { _Pragma("unroll") for (int _i = 0; _i < 2; ++_i) \
        __builtin_amdgcn_global_load_lds((const unsigned*)((const char*)(gbase) + (voff)[_i]), (LAS unsigned*)(lds + (bufoff) + ldsw + _i * 8192), 16, 0, 0); } while (0)
#define PG8_LDA(dst, b, h) do { _Pragma("unroll") for (int m = 0; m < 4; ++m) _Pragma("unroll") for (int k = 0; k < 2; ++k) dst[m][k] = *(const LAS bf16x8*)(lds + PG8_SA(b, h) + aoff + m * 2048 + k * 1024); } while (0)
#define PG8_LDB(dst, b, h) do { _Pragma("unroll") for (int n = 0; n < 2; ++n) _Pragma("unroll") for (int k = 0; k < 2; ++k) dst[n][k] = *(const LAS bf16x8*)(lds + PG8_SB(b, h) + boff + n * 2048 + k * 1024); } while (0)
#define PG8_MMA(ai, bj, At, Bt) do { __builtin_amdgcn_s_setprio(1); _Pragma("unroll") for (int m = 0; m < 4; ++m) _Pragma("unroll") for (int n = 0; n < 2; ++n) _Pragma("unroll") for (int k = 0; k < 2; ++k) \
        acc[ai][bj][m][n] = __builtin_amdgcn_mfma_f32_16x16x32_bf16(Bt[n][k], At[m][k], acc[ai][bj][m][n], 0, 0, 0); __builtin_amdgcn_s_setprio(0); } while (0)
#define PG8_WAIT_V(n) asm volatile("s_waitcnt vmcnt(" #n ")" ::: "memory")
#define PG8_WAIT_L(n) asm volatile("s_waitcnt lgkmcnt(" #n ")" ::: "memory")
#define PG8_BAR __builtin_amdgcn_s_barrier()
#define PG8_SCHED __builtin_amdgcn_sched_barrier(0)
    if constexpr (Desc::RAW) { if (!D.valid(c, G)) return; } else { if (c >= total) return; }
    Unit cur, nxt; int ui = 0;
    if constexpr (Desc::RAW) cur = D.unit(c, G); else cur = D.unit(xcd_remap(c, total));
    nxt = cur;
    f32x4 acc[2][2][4][2];
#pragma unroll
    for (int a = 0; a < 2; ++a)
#pragma unroll
        for (int b = 0; b < 2; ++b)
#pragma unroll
            for (int m = 0; m < 4; ++m)
#pragma unroll
                for (int n = 0; n < 2; ++n) acc[a][b][m][n] = (f32x4){0.f, 0.f, 0.f, 0.f};
    bf16x8 At[4][2], B0[2][2], B1[2][2];
    const char* cA = cur.a; const char* cB = cur.b;
    PG8_STAGE(PG8_SB(0, 0), cB, voffB); PG8_STAGE(PG8_SB(0, 1), cB + hstepB, voffB); PG8_STAGE(PG8_SA(0, 0), cA, voffA); PG8_STAGE(PG8_SA(0, 1), cA + hstepA, voffA);
    if (wr == 1) PG8_BAR;
    PG8_WAIT_V(2); PG8_BAR;
    PG8_STAGE(PG8_SB(1, 0), cB + kstep, voffB); PG8_STAGE(PG8_SA(1, 0), cA + kstep, voffA); PG8_STAGE(PG8_SB(1, 1), cB + hstepB + kstep, voffB);
    PG8_WAIT_V(6); PG8_BAR;
    for (;;) {
        const long Ln = (long)(ui + 1) * G + c;
        bool has_next;
        if constexpr (Desc::RAW) { has_next = D.valid((int)Ln, G); if (has_next) nxt = D.unit((int)Ln, G); }
        else { has_next = Ln < total; if (has_next) nxt = D.unit(xcd_remap((int)Ln, total)); }
        const char* nA = has_next ? nxt.a : cA; const char* nB = has_next ? nxt.b : cB;
        for (int t = 0; t < nt; t += 2) {
            const bool last = (t == nt - 2);
            const char* a1 = cA + (size_t)(t + 1) * kstep;
            const char* a2 = last ? nA : cA + (size_t)(t + 2) * kstep; const char* b2 = last ? nB : cB + (size_t)(t + 2) * kstep;
            const char* a3 = a2 + kstep; const char* b3 = b2 + kstep;
            PG8_LDB(B0, 0, 0); PG8_LDB(B1, 0, 1); PG8_SCHED; PG8_LDA(At, 0, 0); PG8_STAGE(PG8_SA(1, 1), a1 + hstepA, voffA);
            PG8_WAIT_V(8); PG8_WAIT_L(0); PG8_BAR; PG8_MMA(0, 0, At, B0); PG8_MMA(0, 1, At, B1); PG8_BAR; PG8_SCHED;
            PG8_LDA(At, 0, 1); PG8_STAGE(PG8_SB(0, 0), b2, voffB); PG8_STAGE(PG8_SB(0, 1), b2 + hstepB, voffB); PG8_STAGE(PG8_SA(0, 0), a2, voffA);
            PG8_WAIT_V(8); PG8_WAIT_L(0); PG8_BAR; PG8_MMA(1, 0, At, B0); PG8_MMA(1, 1, At, B1); PG8_BAR; PG8_SCHED;
            PG8_LDB(B0, 1, 0); PG8_LDB(B1, 1, 1); PG8_SCHED; PG8_LDA(At, 1, 0); PG8_STAGE(PG8_SA(0, 1), a2 + hstepA, voffA);
            PG8_WAIT_V(8); PG8_WAIT_L(0); PG8_BAR; PG8_MMA(0, 0, At, B0); PG8_MMA(0, 1, At, B1); PG8_BAR; PG8_SCHED;
            PG8_LDA(At, 1, 1); PG8_STAGE(PG8_SB(1, 0), b3, voffB); PG8_STAGE(PG8_SB(1, 1), b3 + hstepB, voffB); PG8_STAGE(PG8_SA(1, 0), a3, voffA);
            PG8_WAIT_V(8); PG8_WAIT_L(0); PG8_BAR; PG8_MMA(1, 0, At, B0); PG8_MMA(1, 1, At, B1); PG8_BAR; PG8_SCHED;
        }
        if (wr == 0) PG8_BAR;
        {
            const int le = otid(wv) & 63, fre = le & 15, fqe = le >> 4;
#pragma unroll
            for (int ai = 0; ai < 2; ++ai)
#pragma unroll
                for (int m = 0; m < 4; ++m)
#pragma unroll
                    for (int bj = 0; bj < 2; ++bj)
                        E(cur, ai * HALF + wr * 64 + m * 16 + fre, bj * HALF + wc * 32 + 8 * fqe, acc[ai][bj][m][0], acc[ai][bj][m][1]);
        }
        if (!has_next) break;
#pragma unroll
        for (int a = 0; a < 2; ++a)
#pragma unroll
            for (int b = 0; b < 2; ++b)
#pragma unroll
                for (int m = 0; m < 4; ++m)
#pragma unroll
                    for (int n = 0; n < 2; ++n) acc[a][b][m][n] = (f32x4){0.f, 0.f, 0.f, 0.f};
        cur = nxt; cA = nA; cB = nB; ++ui;
        if (wr == 1) PG8_BAR;
    }
    PG8_WAIT_V(0);
    PG8_BAR;
#undef PG8_SA
#undef PG8_SB
#undef PG8_STAGE
#undef PG8_LDA
#undef PG8_LDB
#undef PG8_MMA
#undef PG8_WAIT_V
#undef PG8_WAIT_L
#undef PG8_BAR
#undef PG8_SCHED
}
}

DI void transpose_item(const float* W, int N, int kb, int nb, bf16_t* d0, bf16_t* d1, int K, LAS float* scr, int lane) {
    const int k0 = 64 * kb, n0 = 32 * nb;
#pragma unroll 8
    for (int i = 0; i < 32; ++i) { const int kk = 2 * i + (lane >> 5); scr[kk * 33 + (lane & 31)] = W[(size_t)(k0 + kk) * N + n0 + (lane & 31)]; }
    asm volatile("s_waitcnt lgkmcnt(0)" ::: "memory");
    const int c = lane & 7;
#pragma unroll
    for (int j = 0; j < 4; ++j) { const int n = (lane >> 3) + 8 * j; const LAS float* s = scr + (8 * c) * 33 + n;
        u32x4 o; o.x = pk2(s[0 * 33], s[1 * 33]); o.y = pk2(s[2 * 33], s[3 * 33]); o.z = pk2(s[4 * 33], s[5 * 33]); o.w = pk2(s[6 * 33], s[7 * 33]);
        *(u32x4*)(d0 + (size_t)n * K + k0 + 8 * c) = o;
        if (d1) *(u32x4*)(d1 + (size_t)n * K + k0 + 8 * c) = o; }
    asm volatile("s_waitcnt lgkmcnt(0)" ::: "memory");
}

DI void prep_phase(const Args& A, LAS unsigned char* lds, int wv) {
    const int tid = otid(wv), lane = tid & 63, wave = tid >> 6, G = gridDim.x;
    unsigned char* ws = A.ws;
    {
        LAS float* s_lds = (LAS float*)lds;
        const float* cc = A.in[1]; const float* cctx = A.in[3]; const float* aw = A.in[4]; const float* ab = A.in[5];
        long long* modi = (long long*)(ws + WS_MODI);
        for (int item = blockIdx.x; item < 768; item += G) {
            const int kc = item % 16, cb = (item / 16) % 12, l = item / 192;
            const int k0 = kc * 128, j = cb * 512 + tid;
            __syncthreads();
            for (int e = tid; e < 17 * 128; e += NTHREADS) { const int r = e / 128, k = e % 128; const float v = r < 16 ? cc[r * DM + k0 + k] : cctx[k0 + k]; s_lds[k * 20 + r] = siluf(v); }
            __syncthreads();
            float acc[17];
#pragma unroll
            for (int r = 0; r < 17; ++r) acc[r] = 0.f;
            const float* wp = aw + ((size_t)l * DM + k0) * MOD_LD + j;
#pragma unroll 4
            for (int k = 0; k < 128; ++k) {
                const float w = wp[(size_t)k * MOD_LD];
                const LAS f32x4* sp = (const LAS f32x4*)(s_lds + k * 20);
                const f32x4 s0 = sp[0], s1 = sp[1], s2 = sp[2], s3 = sp[3]; const float s4 = s_lds[k * 20 + 16];
#pragma unroll
                for (int q = 0; q < 4; ++q) { acc[q] += s0[q] * w; acc[4 + q] += s1[q] * w; acc[8 + q] += s2[q] * w; acc[12 + q] += s3[q] * w; }
                acc[16] += s4 * w;
            }
            const float bias = (kc == 0) ? ab[l * MOD_LD + j] : 0.f;
#pragma unroll
            for (int r = 0; r < 17; ++r) atomicAdd((unsigned long long*)&modi[(size_t)(l * 17 + r) * MOD_LD + j], (unsigned long long)__float2ll_rn((acc[r] + bias) * MODI_SCALE));
        }
        __syncthreads();
    }
    {
        LAS float* scr = (LAS float*)(lds + wave * 16384);
        const int gw = blockIdx.x * NWAVES + wave, NGW = G * NWAVES;
        constexpr int I_SQ = 32 * 64, I_AI = 32 * 160, I_MI = 32 * 257;
        constexpr int NIT = 6 * I_SQ + I_AI + I_MI;
        for (int it = gw; it < NIT; it += NGW) {
            int r = it;
            if (r < 6 * I_SQ) {
                const int w = r / I_SQ; r -= w * I_SQ;
                const float* src; bf16_t* dst;
                if (w < 2)      { src = A.in[7] + (size_t)w * DM * DM;       dst = (bf16_t*)(ws + WS_WFG) + (size_t)w * DM * DM; }
                else if (w < 4) { src = A.in[8] + (size_t)(w - 2) * DM * DM; dst = (bf16_t*)(ws + WS_WFO) + (size_t)(w - 2) * DM * DM; }
                else if (w == 4) { src = A.in[12]; dst = (bf16_t*)(ws + WS_WMO); }
                else             { src = A.in[16]; dst = (bf16_t*)(ws + WS_WAO); }
                const int kb = r / 64, nb = r % 64;
                transpose_item(src, DM, kb, nb, dst + (size_t)(32 * nb) * DM, nullptr, DM, scr, lane);
                continue;
            }
            r -= 6 * I_SQ;
            if (r < I_AI) { const int kb = r / 160, nb = r % 160; transpose_item(A.in[13], 5120, kb, nb, (bf16_t*)(ws + WS_WAI) + (size_t)(32 * nb) * DM, nullptr, DM, scr, lane); continue; }
            r -= I_AI;
            {
                const int kb = r / 257, nb = r % 257, n0 = 32 * nb;
                bf16_t* WA = (bf16_t*)(ws + WS_WMA); bf16_t* WB = (bf16_t*)(ws + WS_WMB);
                bf16_t* d0; bf16_t* d1 = nullptr;
                if (n0 < 1024) d0 = WA + (size_t)n0 * DM;
                else if (n0 < 2048) d0 = WA + (size_t)n0 * DM;
                else if (n0 < 4096) d0 = WB + (size_t)(n0 - 2048) * DM;
                else if (n0 < 6144) d0 = WA + (size_t)(2304 + n0 - 4096) * DM;
                else if (n0 < 6176) d0 = WA + (size_t)(2048 + n0 - 6144) * DM;
                else d0 = WA + (size_t)(4352 + n0 - 6176) * DM;
                transpose_item(A.in[9], 8224, kb, nb, d0, d1, DM, scr, lane);
            }
        }
    }
    {
        const long gt = (long)blockIdx.x * NTHREADS + tid, NGT = (long)G * NTHREADS;
        constexpr long N_DC = 1024L * 512 / 8, N_DT = 2048L * 4096 / 8, N_DT2 = 256L * 512 / 8;
        for (long it = gt; it < N_DC + N_DT + N_DT2; it += NGT) {
            float v[8]; bf16_t* dst;
            if (it < N_DC) {
                const int m = (int)(it / 64), k0 = (int)(it % 64) * 8; const float sc = 0.044194173824159216f;
#pragma unroll
                for (int j = 0; j < 8; ++j) { const int rr = ((m & 511) * (k0 + j)) & 511; const float ang = (float)rr * (1.f / 256.f); v[j] = (m < 512 ? cospif(ang) : sinpif(ang)) * sc; }
                dst = (bf16_t*)(ws + WS_DC) + (size_t)m * 512 + k0;
            } else if (it < N_DC + N_DT) {
                const long i2 = it - N_DC; const int kk = (int)(i2 / 512), s0 = (int)(i2 % 512) * 8; const float sc = 0.022097086912079608f;
#pragma unroll
                for (int j = 0; j < 8; ++j) { const int s = s0 + j; const int rr = (kk * (s & 2047)) & 2047; const float ang = (float)rr * (1.f / 1024.f); v[j] = (s < 2048 ? cospif(ang) : -sinpif(ang)) * sc; }
                dst = (bf16_t*)(ws + WS_DT) + (size_t)kk * 4096 + s0;
            } else {
                const long i2 = it - N_DC - N_DT; const int kk = (int)(i2 / 64), s0 = (int)(i2 % 64) * 8; const float sc = 0.0625f;
#pragma unroll
                for (int j = 0; j < 8; ++j) { const int s = s0 + j; const int rr = (kk * (s & 255)) & 255; const float ang = (float)rr * (1.f / 128.f); v[j] = (s < 256 ? cospif(ang) : -sinpif(ang)) * sc; }
                dst = (bf16_t*)(ws + WS_DT2) + (size_t)kk * 512 + s0;
            }
            u32x4 o = {pk2(v[0], v[1]), pk2(v[2], v[3]), pk2(v[4], v[5]), pk2(v[6], v[7])};
            *(u32x4*)dst = o;
        }
    }
}

DI const float* xrow_in(const Args& A, int r) {
    const int b = r / TB, t = r % TB;
    if (t < TL) return A.in[0] + ((size_t)b * TL + t) * DM;
    return A.in[2] + ((size_t)b * TC + (t - TL)) * DM;
}
DI void norm_phase(const Args& A, int layer, bool latonly, int wv) {
    const int tid = otid(wv), lane = tid & 63, wave = tid >> 6, G = gridDim.x;
    const float* ng = A.in[6] + (size_t)layer * DM;
    const float* mod = (const float*)(A.ws + WS_MOD) + (size_t)layer * 17 * MOD_LD;
    bf16_t* H = (bf16_t*)(A.ws + WS_H);
    const bf16_t* XB = (const bf16_t*)A.out;
    for (int r0 = (blockIdx.x * NWAVES + wave) * 2; r0 < NTOK; r0 += G * NWAVES * 2) {
        const int b = r0 / TB, t = r0 % TB;
        if (latonly && t >= TL) continue;
        const float* mr = mod + (size_t)(t < TL ? b : 16) * MOD_LD;
        f32x4 v[2][4][2];
#pragma unroll
        for (int k = 0; k < 2; ++k) {
            const int r = r0 + k;
            if (layer == 0) {
                const float* xr = xrow_in(A, r);
#pragma unroll
                for (int j = 0; j < 4; ++j) { const f32x4* p = (const f32x4*)(xr + 512 * j + 8 * lane); v[k][j][0] = p[0]; v[k][j][1] = p[1]; }
            } else {
#pragma unroll
                for (int j = 0; j < 4; ++j) ld_bf16x8(XB + (size_t)r * DM + 512 * j + 8 * lane, v[k][j][0], v[k][j][1]);
            }
        }
#pragma unroll
        for (int k = 0; k < 2; ++k) {
            const int r = r0 + k; float ss = 0.f;
#pragma unroll
            for (int j = 0; j < 4; ++j)
#pragma unroll
                for (int q = 0; q < 4; ++q) ss += v[k][j][0][q] * v[k][j][0][q] + v[k][j][1][q] * v[k][j][1][q];
            const float rs = 1.0f / sqrtf(wave_sum(ss) * (1.f / DM) + EPS);
#pragma unroll
            for (int j = 0; j < 4; ++j) { const int c0 = 512 * j + 8 * lane; f32x4 o[2];
#pragma unroll
                for (int h = 0; h < 2; ++h) { const f32x4 g4 = *(const f32x4*)(ng + c0 + 4 * h), sh = *(const f32x4*)(mr + c0 + 4 * h), sc = *(const f32x4*)(mr + DM + c0 + 4 * h);
                    o[h] = (v[k][j][h] * rs) * g4 * (sc + 1.0f) + sh; }
                st_bf16x8(H + (size_t)r * DM + c0, o[0], o[1]); }
        }
    }
}
DI void final_norm_phase(const Args& A, const bf16_t* src, int wv) {
    const int tid = otid(wv), lane = tid & 63, wave = tid >> 6, G = gridDim.x;
    const float* fg = A.in[17];
    for (int r0 = (blockIdx.x * NWAVES + wave) * 2; r0 < NB * TL; r0 += G * NWAVES * 2) {
        f32x4 v[2][4][2];
#pragma unroll
        for (int k = 0; k < 2; ++k)
#pragma unroll
            for (int j = 0; j < 4; ++j) ld_bf16x8(src + (size_t)(r0 + k) * DM + 512 * j + 8 * lane, v[k][j][0], v[k][j][1]);
#pragma unroll
        for (int k = 0; k < 2; ++k) { float* orow = A.out + (size_t)(r0 + k) * DM; float ss = 0.f;
#pragma unroll
            for (int j = 0; j < 4; ++j)
#pragma unroll
                for (int q = 0; q < 4; ++q) ss += v[k][j][0][q] * v[k][j][0][q] + v[k][j][1][q] * v[k][j][1][q];
            const float rs = 1.0f / sqrtf(wave_sum(ss) * (1.f / DM) + EPS);
#pragma unroll
            for (int j = 0; j < 4; ++j) { const int c0 = 512 * j + 8 * lane;
#pragma unroll
                for (int h = 0; h < 2; ++h) { const f32x4 g4 = *(const f32x4*)(fg + c0 + 4 * h); *(f32x4*)(orow + c0 + 4 * h) = (v[k][j][h] * rs) * g4; } }
        }
    }
}

struct DescPlain {
    static constexpr bool RAW = false;
    const bf16_t* A; const bf16_t* B; int nN; bool latonly; int lda, ldb, K, total;
    DI void init(const bf16_t* A_, const bf16_t* B_, int nN_, bool lat) { A = A_; B = B_; nN = nN_; latonly = lat; lda = DM; ldb = DM; K = DM; total = (lat ? 128 : 144) * nN_; }
    DI pg8::Unit unit(int idx) const {
        const int nMt = latonly ? 128 : 144, nig = 8 * nN, gid = idx / nig, fm = gid * 8, gsz = (nMt - fm) < 8 ? (nMt - fm) : 8;
        const int pmi = fm + (idx % nig) % gsz, pn = (idx % nig) / gsz, pm = latonly ? (pmi / 8) * 9 + (pmi % 8) : pmi;
        pg8::Unit u; u.a = (const char*)(A + (size_t)pm * 256 * DM); u.b = (const char*)(B + (size_t)pn * 256 * DM); u.i0 = pm; u.i1 = pn; u.i2 = 0; return u;
    }
};
struct DescChan {
    static constexpr bool RAW = false;
    const bf16_t* DC; const bf16_t* H; int lda, ldb, K, total;
    DI void init(const bf16_t* DC_, const bf16_t* H_, bool lat) { DC = DC_; H = H_; lda = 512; ldb = DM; K = 512; total = lat ? 2048 : 2304; }
    DI pg8::Unit unit(int idx) const {
        pg8::Unit u; int b, g, mt, nt, toff;
        if (idx < 2048) { mt = idx % 4; nt = (idx / 4) % 8; g = (idx / 32) % 4; b = idx / 128; toff = nt * 256; u.i2 = nt; }
        else { const int j = idx - 2048; mt = j % 4; g = (j / 4) % 4; b = j / 16; toff = TL; u.i2 = 8; }
        u.a = (const char*)(DC + (size_t)mt * 256 * 512); u.b = (const char*)(H + ((size_t)b * TB + toff) * DM + g * 512); u.i0 = b * 4 + g; u.i1 = mt; return u;
    }
};
struct DescT {
    static constexpr bool RAW = false;
    const bf16_t* DT; const bf16_t* PQ; int nMt; int lda, ldb, K, total;
    DI void init(const bf16_t* DT_, const bf16_t* PQ_, int ld, int Kd, int coff, int nMt_) { DT = DT_ + coff; PQ = PQ_ + coff; nMt = nMt_; lda = ld; ldb = ld; K = Kd; total = NB * nMt_ * 8; }
    DI pg8::Unit unit(int idx) const {
        const int mt = idx % nMt, nt = (idx / nMt) % 8, b = idx / (nMt * 8);
        pg8::Unit u; u.a = (const char*)(DT + (size_t)mt * 256 * lda); u.b = (const char*)(PQ + ((size_t)b * DM + nt * 256) * ldb); u.i0 = b; u.i1 = mt; u.i2 = nt; return u;
    }
};

struct DescT2 {
    static constexpr bool RAW = true;
    const bf16_t* DT; const bf16_t* PQ; int lda, ldb, K, total;
    DI void init(const bf16_t* DT_, const bf16_t* PQ_) { DT = DT_; PQ = PQ_; lda = 4096; ldb = 4096; K = 2048; total = 2 * NB * 4 * 8; }
    DI bool valid(int L, int G) const { return ((L / G) >> 1) * G + (L % G) < NB * 4 * 8; }
    DI pg8::Unit unit(int L, int G) const {
        const int i = L / G, pair = (i >> 1) * G + (L % G), part = i & 1;
        const int mt = pair % 4, nt = (pair / 4) % 8, b = pair / 32, coff = part * 2048;
        pg8::Unit u; u.a = (const char*)(DT + (size_t)mt * 256 * 4096 + coff); u.b = (const char*)(PQ + ((size_t)b * DM + nt * 256) * 4096 + coff); u.i0 = b; u.i1 = mt; u.i2 = part * 8 + nt; return u;
    }
};

DI void resid_store(const Args& A, int layer, int pm, int row_l, int col, const float* modl, f32x4 v0, f32x4 v1) {
    const int b = pm / 9, tt = pm % 9;
    const float* gp = modl + (size_t)(tt < 8 ? b : 16) * MOD_LD + 2 * DM + col;
    const f32x4 g0 = *(const f32x4*)gp, g1 = *(const f32x4*)(gp + 4);
    bf16_t* XB = (bf16_t*)A.out;
    const size_t roff = ((size_t)pm * 256 + row_l) * DM + col;
    f32x4 x0, x1;
    if (layer == 0) {
        const float* src = (tt < 8) ? A.in[0] + ((size_t)b * TL + tt * 256 + row_l) * DM + col : A.in[2] + ((size_t)b * TC + row_l) * DM + col;
        x0 = *(const f32x4*)src; x1 = *(const f32x4*)(src + 4);
    } else ld_bf16x8(XB + roff, x0, x1);
    x0 = x0 + g0 * v0; x1 = x1 + g1 * v1;
    if (layer == 3) st_bf16x8((bf16_t*)(A.ws + WS_SCR + F_PQX) + ((size_t)b * TL + tt * 256 + row_l) * DM + col, x0, x1);
    else st_bf16x8(XB + roff, x0, x1);
}

DI void fnet_layer(const Args& A, LAS unsigned char* lds, const XcdBarrier& gbar, int layer, int j, bool latonly, int wv) {
    unsigned char* ws = A.ws;
    const bf16_t* H = (const bf16_t*)(ws + WS_H); bf16_t* U = (bf16_t*)(ws + WS_H);
    bf16_t* Gt = (bf16_t*)(ws + WS_SCR + F_G); bf16_t* PQX = (bf16_t*)(ws + WS_SCR + F_PQX); bf16_t* PQC = (bf16_t*)(ws + WS_SCR + F_PQC);
    norm_phase(A, layer, latonly, wv);
    xcd_barrier(gbar, wv);
    {
        DescPlain D; D.init(H, (const bf16_t*)(ws + WS_WFG) + (size_t)j * DM * DM, 8, latonly);
        auto E = [=](const pg8::Unit& u, int row_l, int col_l, f32x4 v0, f32x4 v1) {
            f32x4 a, b;
#pragma unroll
            for (int q = 0; q < 4; ++q) { a[q] = siluf(v0[q]); b[q] = siluf(v1[q]); }
            st_bf16x8(Gt + ((size_t)u.i0 * 256 + row_l) * DM + u.i1 * 256 + col_l, a, b);
        };
        pg8::gemm_phase(lds, D, E, wv);
    }
    {
        DescChan D; D.init((const bf16_t*)(ws + WS_DC), H, latonly);
        auto E = [=](const pg8::Unit& u, int row_l, int col_l, f32x4 v0, f32x4 v1) {
            const int b = u.i0 >> 2, g = u.i0 & 3, mt = u.i1, half = mt >> 1, ch = g * 512 + (mt & 1) * 256 + row_l;
            bf16_t* dst = (u.i2 < 8) ? PQX + ((size_t)b * DM + ch) * 4096 + half * 2048 + u.i2 * 256 + col_l
                                     : PQC + ((size_t)b * DM + ch) * 512 + half * 256 + col_l;
            st_bf16x8(dst, v0, v1);
        };
        pg8::gemm_phase(lds, D, E, wv);
    }
    xcd_barrier(gbar, wv);
    bf16_t* A1 = (bf16_t*)(ws + WS_SCR + F_A1);
    {
        const int tid = otid(wv), lane = tid & 63;
        for (int rr0 = (blockIdx.x * NWAVES + wv) * 4; rr0 < NB * DM; rr0 += gridDim.x * NWAVES * 4) {
            u32x4 raw[4][4];
#pragma unroll
            for (int k = 0; k < 4; ++k)
#pragma unroll
                for (int q = 0; q < 4; ++q) raw[k][q] = *(const u32x4*)(PQX + (size_t)(rr0 + k) * 4096 + (q * 64 + lane) * 8);
#pragma unroll
            for (int k = 0; k < 4; ++k) { float acc = 0.f;
#pragma unroll
                for (int q = 0; q < 4; ++q) { const u32x4 w = raw[k][q]; acc += (bf_lo(w.x) - bf_hi(w.x)) + (bf_lo(w.y) - bf_hi(w.y)) + (bf_lo(w.z) - bf_hi(w.z)) + (bf_lo(w.w) - bf_hi(w.w)); }
                acc = wave_sum(acc);
                if (lane == 0) { const int rr = rr0 + k; const size_t off = ((size_t)(rr >> 11) * TB + 1024) * DM + (rr & 2047);
                    U[off] = (bf16_t)(pk2(acc * 0.022097086912079608f * __uint_as_float((unsigned)Gt[off] << 16), 0.f) & 0xffffu); } }
        }
    }
    {
        DescT2 D; D.init((const bf16_t*)(ws + WS_DT), PQX);
        auto E = [=](const pg8::Unit& u, int row_l, int col_l, f32x4 v0, f32x4 v1) {
            const int k = u.i1 * 256 + row_l, col = (u.i2 & 7) * 256 + col_l;
            bf16_t* ap = A1 + ((size_t)u.i0 * 1024 + k) * DM + col;
            if (u.i2 < 8) { st_bf16x8(ap, v0, v1); return; }
            f32x4 a0, a1; ld_bf16x8(ap, a0, a1);
            const size_t off = ((size_t)u.i0 * TB + k) * DM + col;
            f32x4 g0, g1; ld_bf16x8(Gt + off, g0, g1);
            st_bf16x8(U + off, (a0 + v0) * g0, (a1 + v1) * g1);
            if (k != 0) { const size_t off2 = ((size_t)u.i0 * TB + (TL - k)) * DM + col; ld_bf16x8(Gt + off2, g0, g1); st_bf16x8(U + off2, (a0 - v0) * g0, (a1 - v1) * g1); }
        };
        pg8::gemm_phase(lds, D, E, wv);
    }
    if (!latonly) {
        DescT D; D.init((const bf16_t*)(ws + WS_DT2), PQC, 512, 512, 0, 1);
        auto E = [=](const pg8::Unit& u, int row_l, int col_l, f32x4 v0, f32x4 v1) {
            const size_t off = ((size_t)u.i0 * TB + TL + row_l) * DM + u.i2 * 256 + col_l;
            f32x4 g0, g1; ld_bf16x8(Gt + off, g0, g1);
            st_bf16x8(U + off, v0 * g0, v1 * g1);
        };
        pg8::gemm_phase(lds, D, E, wv);
    }
    xcd_barrier(gbar, wv);
    {
        DescPlain D; D.init(U, (const bf16_t*)(ws + WS_WFO) + (size_t)j * DM * DM, 8, latonly);
        const float* modl = (const float*)(ws + WS_MOD) + (size_t)layer * 17 * MOD_LD;
        auto E = [=](const pg8::Unit& u, int row_l, int col_l, f32x4 v0, f32x4 v1) { resid_store(A, layer, u.i0, row_l, u.i1 * 256 + col_l, modl, v0, v1); };
        pg8::gemm_phase(lds, D, E, wv);
    }
    xcd_barrier(gbar, wv);
}


namespace att {
constexpr int D = 128, NW = 8, QBLK = 32, KVBLK = 64;
constexpr float SCALE = 0.088388347648318440f;
constexpr float THR = 8.f;
constexpr int LDQ = 2048, LDK = 512;
constexpr size_t SHM_V = KVBLK * D * 2, SHM_K = KVBLK * D * 2;
typedef float f32x8 __attribute__((ext_vector_type(8)));
#define KSWZ(row, colB) ((row) * 256 + ((colB) ^ (((row) & 7) << 4)))
#define SBAR() __builtin_amdgcn_sched_barrier(0)
DI int crow(int r, int hi) { return (r & 3) + 8 * (r >> 2) + 4 * hi; }
DI unsigned cvtpk(float lo, float hi) { unsigned r; asm volatile("v_cvt_pk_bf16_f32 %0, %1, %2" : "=v"(r) : "v"(lo), "v"(hi)); return r; }
DI void partialSM(f32x16& p0, f32x16& p1, float& m_reg, float& mn, float& alpha) {
  constexpr float C = SCALE * 1.4426950408889634f;
  float pmax = p0[0];
#pragma unroll
  for (int r = 1; r < 16; ++r) pmax = fmaxf(pmax, p0[r]);
#pragma unroll
  for (int r = 0; r < 16; ++r) pmax = fmaxf(pmax, p1[r]);
  { auto rr = __builtin_amdgcn_permlane32_swap(__float_as_uint(pmax), __float_as_uint(pmax), false, false);
    pmax = fmaxf(__uint_as_float(rr[0]), __uint_as_float(rr[1])); }
  if (__builtin_expect(__all(pmax - m_reg <= THR / SCALE), 1)) { mn = m_reg; alpha = 1.f; }
  else { mn = fmaxf(m_reg, pmax); alpha = __builtin_amdgcn_exp2f((m_reg - mn) * C); m_reg = mn; }
  float mnC = -mn * C;
#pragma unroll
  for (int r = 0; r < 16; ++r) p0[r] = fmaf(p0[r], C, mnC);
#pragma unroll
  for (int r = 0; r < 16; ++r) p1[r] = fmaf(p1[r], C, mnC);
#pragma unroll
  for (int r = 0; r < 16; ++r) p0[r] = __builtin_amdgcn_exp2f(p0[r]);
}
DI void finishSM(f32x16& p0, f32x16& p1, float alpha, float& l_reg, bf16x8& pa0, bf16x8& pa1, bf16x8& pa2, bf16x8& pa3) {
#pragma unroll
  for (int r = 0; r < 16; ++r) p1[r] = __builtin_amdgcn_exp2f(p1[r]);
  float ps = 0;
#pragma unroll
  for (int r = 0; r < 16; ++r) ps += p0[r];
#pragma unroll
  for (int r = 0; r < 16; ++r) ps += p1[r];
  { auto rr = __builtin_amdgcn_permlane32_swap(__float_as_uint(ps), __float_as_uint(ps), false, false);
    ps = __uint_as_float(rr[0]) + __uint_as_float(rr[1]); }
  l_reg = l_reg * alpha + ps;
#define PK4(P, BASE, OUT) do { unsigned a0 = cvtpk(P[BASE + 0], P[BASE + 1]), a1 = cvtpk(P[BASE + 2], P[BASE + 3]);   \
    unsigned b0 = cvtpk(P[BASE + 4], P[BASE + 5]), b1 = cvtpk(P[BASE + 6], P[BASE + 7]);                              \
    auto r0 = __builtin_amdgcn_permlane32_swap(a0, b0, false, false); auto r1 = __builtin_amdgcn_permlane32_swap(a1, b1, false, false); \
    u32x4 w = {r0[0], r1[0], r0[1], r1[1]}; OUT = *reinterpret_cast<bf16x8*>(&w); } while (0)
  PK4(p0, 0, pa0); PK4(p0, 8, pa1); PK4(p1, 0, pa2); PK4(p1, 8, pa3);
#undef PK4
}
DI void qkt(f32x16& p0, f32x16& p1, const bf16_t* Ks, const bf16x8* qr, int r32, int hi) {
  p0 = f32x16{}; p1 = f32x16{};
#pragma unroll
  for (int d0 = 0; d0 < 8; ++d0) { int cb = (d0 * 16 + hi * 8) * 2;
    bf16x8 b0 = *reinterpret_cast<const bf16x8*>((const char*)Ks + KSWZ(r32, cb));
    bf16x8 b1 = *reinterpret_cast<const bf16x8*>((const char*)Ks + KSWZ(32 + r32, cb));
    p0 = __builtin_amdgcn_mfma_f32_32x32x16_bf16(b0, qr[d0], p0, 0, 0, 0);
    p1 = __builtin_amdgcn_mfma_f32_32x32x16_bf16(b1, qr[d0], p1, 0, 0, 0); }
}
DI int v_st(int k, int c) { const int kk = (k & ~0xC) | ((k & 4) << 1) | ((k & 8) >> 1); return ((kk >> 3) * 4 + (c >> 5)) * 512 + ((kk & 7) * 32 + (c & 31)) * 2; }
DI int v_rd_base(int lane) { return ((lane & 3) << 3) | (((lane >> 2) & 3) << 6) | (((lane >> 4) & 1) << 5) | (((lane >> 5) & 1) << 8); }
constexpr int v_rd_off(int d0, int ks, int half) { return d0 * 512 + ks * 4096 + half * 2048; }
template <int OFF> DI s16x4 tr_read(int vb) {
  s16x4 r; asm volatile("ds_read_b64_tr_b16 %0, %1 offset:%2" : "=&v"(r) : "v"(vb), "i"(OFF) : "memory"); return r;
}
template <int D0> DI void pv_one(f32x16& od, int vb, bf16x8 pa0, bf16x8 pa1, bf16x8 pa2, bf16x8 pa3) {
  const s16x4 l0 = tr_read<v_rd_off(D0, 0, 0)>(vb), h0 = tr_read<v_rd_off(D0, 0, 1)>(vb), l1 = tr_read<v_rd_off(D0, 1, 0)>(vb), h1 = tr_read<v_rd_off(D0, 1, 1)>(vb);
  const s16x4 l2 = tr_read<v_rd_off(D0, 2, 0)>(vb), h2 = tr_read<v_rd_off(D0, 2, 1)>(vb), l3 = tr_read<v_rd_off(D0, 3, 0)>(vb), h3 = tr_read<v_rd_off(D0, 3, 1)>(vb);
  asm volatile("s_waitcnt lgkmcnt(0)" ::: "memory"); SBAR();
#define PK(L, H) (bf16x8){L[0], L[1], L[2], L[3], H[0], H[1], H[2], H[3]}
  od = __builtin_amdgcn_mfma_f32_32x32x16_bf16(pa0, PK(l0, h0), od, 0, 0, 0);
  od = __builtin_amdgcn_mfma_f32_32x32x16_bf16(pa1, PK(l1, h1), od, 0, 0, 0);
  od = __builtin_amdgcn_mfma_f32_32x32x16_bf16(pa2, PK(l2, h2), od, 0, 0, 0);
  od = __builtin_amdgcn_mfma_f32_32x32x16_bf16(pa3, PK(l3, h3), od, 0, 0, 0);
#undef PK
}
DI void pv_d0(f32x16* o, int vb, bf16x8 pa0, bf16x8 pa1, bf16x8 pa2, bf16x8 pa3) {
  pv_one<0>(o[0], vb, pa0, pa1, pa2, pa3); pv_one<1>(o[1], vb, pa0, pa1, pa2, pa3); pv_one<2>(o[2], vb, pa0, pa1, pa2, pa3); pv_one<3>(o[3], vb, pa0, pa1, pa2, pa3);
}
DI void attn_dense_body(const bf16_t* __restrict__ Qb, const bf16_t* __restrict__ Kh, const bf16_t* __restrict__ Vh, const bf16_t* SZb, bf16_t* Ub, int seq, char* lds, int wv) {
  const int tid = otid(wv), wid = tid >> 6, lane = tid & 63, r32 = lane & 31, hi = lane >> 5;
  bf16_t* V_lds = (bf16_t*)lds; bf16_t* K_lds = (bf16_t*)(lds + 2 * SHM_V);
  float* wsf = (float*)(lds + 2 * SHM_V + 2 * SHM_K) + wid * 64; float* li_l = wsf; float* al_l = wsf + 32;
  float m_reg = -1e30f, l_reg = 0; f32x16 o[4] = {}; bf16x8 qr[8];
  const bf16_t* Qw = Qb + (long)(wid * QBLK + r32) * LDQ + hi * 8;
#pragma unroll
  for (int d0 = 0; d0 < 8; ++d0) qr[d0] = *reinterpret_cast<const bf16x8*>(Qw + d0 * 16);
  const int sr = tid >> 4, sc = (tid & 15) * 8, vst0 = v_st(sr, sc), vst1 = v_st(32 + sr, sc);
  const int vb0 = (int)(uintptr_t)V_lds + v_rd_base(lane);
  struct { bf16x8 vs0, vs1, ks0, ks1; } sr_[2];
#define SLOAD(i, k0) do { sr_[i].vs0 = *reinterpret_cast<const bf16x8*>(&Vh[(long)((k0) + sr) * LDK + sc]); sr_[i].vs1 = *reinterpret_cast<const bf16x8*>(&Vh[(long)((k0) + 32 + sr) * LDK + sc]); \
    sr_[i].ks0 = *reinterpret_cast<const bf16x8*>(&Kh[(long)((k0) + sr) * LDK + sc]); sr_[i].ks1 = *reinterpret_cast<const bf16x8*>(&Kh[(long)((k0) + 32 + sr) * LDK + sc]); } while (0)
#define SWRITE(b, i) do { *(bf16x8*)((char*)V_lds + (b) * SHM_V + vst0) = sr_[i].vs0;          \
    *(bf16x8*)((char*)V_lds + (b) * SHM_V + vst1) = sr_[i].vs1; int kc = sc * 2;               \
    *(bf16x8*)((char*)K_lds + (b) * SHM_K + KSWZ(sr, kc)) = sr_[i].ks0;                       \
    *(bf16x8*)((char*)K_lds + (b) * SHM_K + KSWZ(32 + sr, kc)) = sr_[i].ks1; } while (0)
#define SWAIT() asm volatile("s_waitcnt vmcnt(4)" ::: "memory")
#define RESC(a) do { if (__any((a) < 1.f)) { if (hi == 0) al_l[r32] = (a); asm volatile("s_waitcnt lgkmcnt(0)" ::: "memory"); \
    _Pragma("unroll") for (int d = 0; d < 4; ++d) _Pragma("unroll") for (int r = 0; r < 16; ++r) o[d][r] *= al_l[crow(r, hi)]; } } while (0)
  f32x16 pA0, pA1, pB0, pB1; float mnA, mnB, alA, alB; bf16x8 pa0, pa1, pa2, pa3; const int NT = seq / KVBLK;
  constexpr int SE = 0, SO = 1;
  SLOAD(SE, 0); asm volatile("s_waitcnt vmcnt(0)" ::: "memory"); SWRITE(0, SE); __syncthreads();
  qkt(pA0, pA1, K_lds, qr, r32, hi); partialSM(pA0, pA1, m_reg, mnA, alA);
  SLOAD(SO, KVBLK); if (2 < NT) SLOAD(SE, 2 * KVBLK);
  SWAIT(); SWRITE(1, SO); __syncthreads();
  for (int j = 1; j + 1 < NT; j += 2) {
    SBAR(); qkt(pB0, pB1, (bf16_t*)((char*)K_lds + SHM_K), qr, r32, hi);
    finishSM(pA0, pA1, alA, l_reg, pa0, pa1, pa2, pa3); SBAR();
    SLOAD(SO, (j + 2) * KVBLK); SBAR();
    pv_d0(o, vb0, pa0, pa1, pa2, pa3); partialSM(pB0, pB1, m_reg, mnB, alB);
    __syncthreads(); SWAIT(); SWRITE(0, SE);
    RESC(alB); __syncthreads();
    SBAR(); qkt(pA0, pA1, K_lds, qr, r32, hi);
    finishSM(pB0, pB1, alB, l_reg, pa0, pa1, pa2, pa3); SBAR();
    if (j + 3 < NT) SLOAD(SE, (j + 3) * KVBLK); SBAR();
    pv_d0(o, vb0 + (int)SHM_V, pa0, pa1, pa2, pa3); partialSM(pA0, pA1, m_reg, mnA, alA);
    __syncthreads(); SWAIT(); SWRITE(1, SO);
    RESC(alA); __syncthreads();
  }
  SBAR(); qkt(pB0, pB1, (bf16_t*)((char*)K_lds + SHM_K), qr, r32, hi);
  finishSM(pA0, pA1, alA, l_reg, pa0, pa1, pa2, pa3); SBAR();
  pv_d0(o, vb0, pa0, pa1, pa2, pa3); partialSM(pB0, pB1, m_reg, mnB, alB);
  __syncthreads(); RESC(alB);
  finishSM(pB0, pB1, alB, l_reg, pa0, pa1, pa2, pa3); SBAR();
  pv_d0(o, vb0 + (int)SHM_V, pa0, pa1, pa2, pa3);
  u32x4 zq[8];
#pragma unroll
  for (int i = 0; i < 8; ++i) { const int id = tid + 512 * i; zq[i] = *(const u32x4*)(SZb + (long)(id >> 4) * LDQ + (id & 15) * 8); }
  if (hi == 0) li_l[r32] = l_reg; asm volatile("s_waitcnt lgkmcnt(0)" ::: "memory");
  __syncthreads();
  {
    float rli[16];
#pragma unroll
    for (int r = 0; r < 16; ++r) rli[r] = __builtin_amdgcn_rcpf(li_l[crow(r, hi)]);
    char* ost = lds;
#pragma unroll
    for (int r = 0; r < 16; ++r) { char* rowp = ost + (wid * QBLK + crow(r, hi)) * 256 + r32 * 2;
#pragma unroll
      for (int d0 = 0; d0 < 4; ++d0) *(unsigned short*)(rowp + d0 * 64) = (unsigned short)(pk2(o[d0][r] * rli[r], 0.f) & 0xffffu); }
  }
  __syncthreads();
#pragma unroll
  for (int i = 0; i < 8; ++i) { const int id = tid + 512 * i; const int row = id >> 4, ch = id & 15;
    const u32x4 ov = *(const u32x4*)(lds + row * 256 + ch * 16);
    f32x4 a0 = {bf_lo(ov.x), bf_hi(ov.x), bf_lo(ov.y), bf_hi(ov.y)}, a1 = {bf_lo(ov.z), bf_hi(ov.z), bf_lo(ov.w), bf_hi(ov.w)};
    const f32x4 z0 = {bf_lo(zq[i].x), bf_hi(zq[i].x), bf_lo(zq[i].y), bf_hi(zq[i].y)}, z1 = {bf_lo(zq[i].z), bf_hi(zq[i].z), bf_lo(zq[i].w), bf_hi(zq[i].w)};
    st_bf16x8(Ub + (long)row * LDQ + ch * 8, a0 * z0, a1 * z1); }
  __syncthreads();
#undef SLOAD
#undef SWRITE
#undef SWAIT
#undef RESC
}
#undef KSWZ
#undef SBAR
}

DI void qknorm_phase(const Args& A, LAS unsigned char* lds, int wv) {
    const int tid = otid(wv), lane = tid & 63, wave = tid >> 6, G = gridDim.x;
    bf16_t* Q = (bf16_t*)(A.ws + WS_SCR + A_Q); bf16_t* Kb = (bf16_t*)(A.ws + WS_SCR + A_K);
    const float* qn = A.in[14]; const float* kn = A.in[15];
    const int sub = lane >> 4, l16 = lane & 15, e0 = l16 * 8;
    LAS f32x2* rope = (LAS f32x2*)lds;
    for (int e = tid; e < 2048; e += NTHREADS) { const float ang = (float)(e >> 5) * exp2f(-(float)(e & 31) * 0.41524101186092029f); rope[e] = (f32x2){cosf(ang), sinf(ang)}; }
    __syncthreads();
    const long NIT = (long)NTOK * 20;
    for (long it0 = ((long)blockIdx.x * NWAVES + wave) * 16 + sub; it0 < NIT; it0 += (long)G * NWAVES * 16) {
        bf16_t* pq[4]; u32x4 raw[4];
#pragma unroll
        for (int k = 0; k < 4; ++k) { const long it = it0 + 4 * k; const int row = (int)(it / 20), hj = (int)(it % 20);
            pq[k] = (hj < 16) ? Q + (size_t)row * 2048 + hj * 128 + e0 : Kb + (size_t)row * 512 + (hj - 16) * 128 + e0;
            raw[k] = *(const u32x4*)pq[k]; }
#pragma unroll
        for (int k = 0; k < 4; ++k) {
            const long it = it0 + 4 * k; const int row = (int)(it / 20), hj = (int)(it % 20);
            const float* wn = (hj < 16 ? qn : kn) + e0;
            f32x4 a = {bf_lo(raw[k].x), bf_hi(raw[k].x), bf_lo(raw[k].y), bf_hi(raw[k].y)}, b = {bf_lo(raw[k].z), bf_hi(raw[k].z), bf_lo(raw[k].w), bf_hi(raw[k].w)};
            float ss = 0.f;
#pragma unroll
            for (int q = 0; q < 4; ++q) ss += a[q] * a[q] + b[q] * b[q];
            ss += __shfl_xor(ss, 1); ss += __shfl_xor(ss, 2); ss += __shfl_xor(ss, 4); ss += __shfl_xor(ss, 8);
            const float rs = 1.0f / sqrtf(ss * (1.f / 128.f) + EPS);
            const f32x4 w0 = *(const f32x4*)wn, w1 = *(const f32x4*)(wn + 4);
            a = a * rs * w0; b = b * rs * w1;
            const int t = row % TB;
            if (t < TL) {
                const int pos = (l16 < 8) ? (t >> 6) : (t & 63);
                float y[8] = {a[0], a[1], a[2], a[3], b[0], b[1], b[2], b[3]};
                const LAS f32x4* rp = (const LAS f32x4*)(rope + pos * 32 + ((4 * l16) & 31));
                const f32x4 c01 = rp[0], c23 = rp[1];
                const float cs[4] = {c01[0], c01[2], c23[0], c23[2]}, sn[4] = {c01[1], c01[3], c23[1], c23[3]};
#pragma unroll
                for (int pp = 0; pp < 4; ++pp) {
                    const float x0 = y[2 * pp], x1 = y[2 * pp + 1];
                    y[2 * pp] = x0 * cs[pp] - x1 * sn[pp]; y[2 * pp + 1] = x0 * sn[pp] + x1 * cs[pp];
                }
                a = (f32x4){y[0], y[1], y[2], y[3]}; b = (f32x4){y[4], y[5], y[6], y[7]};
            }
            st_bf16x8(pq[k], a, b);
        }
    }
}

DI void attn_layer(const Args& A, LAS unsigned char* lds, char* lds_gen, const XcdBarrier& gbar, int layer, int wv) {
    unsigned char* ws = A.ws;
    const bf16_t* H = (const bf16_t*)(ws + WS_H); bf16_t* U = (bf16_t*)(ws + WS_H);
    bf16_t* Q = (bf16_t*)(ws + WS_SCR + A_Q); bf16_t* Kb = (bf16_t*)(ws + WS_SCR + A_K); bf16_t* Vb = (bf16_t*)(ws + WS_SCR + A_V); bf16_t* SZ = (bf16_t*)(ws + WS_SCR + A_SZ);
    norm_phase(A, layer, false, wv);
    xcd_barrier(gbar, wv);
    {
        DescPlain D; D.init(H, (const bf16_t*)(ws + WS_WAI), 20, false);
        auto E = [=](const pg8::Unit& u, int row_l, int col_l, f32x4 v0, f32x4 v1) {
            const size_t row = (size_t)u.i0 * 256 + row_l; const int pn = u.i1;
            if (pn < 8) st_bf16x8(Q + row * 2048 + pn * 256 + col_l, v0, v1);
            else if (pn < 10) st_bf16x8(Kb + row * 512 + (pn - 8) * 256 + col_l, v0, v1);
            else if (pn < 12) st_bf16x8(Vb + row * 512 + (pn - 10) * 256 + col_l, v0, v1);
            else { f32x4 a, b;
#pragma unroll
                for (int q = 0; q < 4; ++q) { a[q] = siluf(v0[q]); b[q] = siluf(v1[q]); }
                st_bf16x8(SZ + row * 2048 + (pn - 12) * 256 + col_l, a, b); }
        };
        pg8::gemm_phase(lds, D, E, wv);
    }
    xcd_barrier(gbar, wv);
    qknorm_phase(A, lds, wv);
    xcd_barrier(gbar, wv);
    {
        const int G = gridDim.x, c = blockIdx.x;
        for (long L = c; L < 2048; L += G) {
            const int u = pg8::xcd_remap((int)L, 2048);
            const int b = u / 128, rem = u % 128, kvh = rem / 32, g = (rem / 8) % 4, qb = rem % 8, h = kvh * 4 + g;
            const size_t qoff = ((size_t)b * TB + qb * 256) * 2048 + h * 128, koff = ((size_t)b * TB) * 512 + kvh * 128;
            att::attn_dense_body(Q + qoff, Kb + koff, Vb + koff, SZ + qoff, U + qoff, TB, lds_gen, wv);
        }
        for (int u = c; u < 256; u += G) {
            const int b = u / 16, h = u % 16, kvh = h / 4;
            const size_t qoff = ((size_t)b * TB + TL) * 2048 + h * 128, koff = ((size_t)b * TB + TL) * 512 + kvh * 128;
            att::attn_dense_body(Q + qoff, Kb + koff, Vb + koff, SZ + qoff, U + qoff, TC, lds_gen, wv);
        }
    }
    xcd_barrier(gbar, wv);
    {
        DescPlain D; D.init(U, (const bf16_t*)(ws + WS_WAO), 8, false);
        const float* modl = (const float*)(ws + WS_MOD) + (size_t)layer * 17 * MOD_LD;
        auto E = [=](const pg8::Unit& u, int row_l, int col_l, f32x4 v0, f32x4 v1) { resid_store(A, layer, u.i0, row_l, u.i1 * 256 + col_l, modl, v0, v1); };
        pg8::gemm_phase(lds, D, E, wv);
    }
    xcd_barrier(gbar, wv);
}


struct DescM1 {
    static constexpr bool RAW = false;
    const bf16_t* H; const bf16_t* WA; const bf16_t* WB; int lda, ldb, K, total;
    DI void init(const bf16_t* H_, const bf16_t* WA_, const bf16_t* WB_) { H = H_; WA = WA_; WB = WB_; lda = DM; ldb = DM; K = DM; total = 144 * 9 + 8 * 144; }
    DI pg8::Unit unit(int idx) const {
        pg8::Unit u;
        if (idx < 1296) { const int nig = 72, gid = idx / nig, pm = gid * 8 + (idx % nig) % 8, pn = (idx % nig) / 8;
            u.a = (const char*)(H + (size_t)pm * 256 * DM); u.b = (const char*)(WA + (size_t)pn * 256 * DM); u.i0 = pm; u.i1 = pn; u.i2 = 0; }
        else { const int j = idx - 1296, mt = j % 8, nt = j / 8;
            u.a = (const char*)(WB + (size_t)mt * 256 * DM); u.b = (const char*)(H + (size_t)nt * 256 * DM); u.i0 = mt; u.i1 = nt; u.i2 = 1; }
        return u;
    }
};
namespace ml {
#define MFMA32(a, b, c) __builtin_amdgcn_mfma_f32_32x32x16_bf16((a), (b), (c), 0, 0, 0)
#define LFENCE() asm volatile("s_waitcnt lgkmcnt(0)" ::: "memory")
DI float dot2_bf16(unsigned a, unsigned b, float c) { asm("v_dot2c_f32_bf16 %0, %1, %2" : "+v"(c) : "v"(a), "v"(b)); return c; }
#define DOT2(a, b, c) dot2_bf16((a), (b), (c))
DI int crow(int reg, int h) { return (reg & 3) + 8 * (reg >> 2) + 4 * h; }
DI bf16x8 ldperm(const bf16_t* p) { const s16x4 lo = *(const s16x4*)p, hi = *(const s16x4*)(p + 8); return __builtin_shufflevector(lo, hi, 0, 1, 2, 3, 4, 5, 6, 7); }
DI bf16x8 pack_step(const f32x16& x, int s) { u32x4 p = {pk2(x[8 * s], x[8 * s + 1]), pk2(x[8 * s + 2], x[8 * s + 3]), pk2(x[8 * s + 4], x[8 * s + 5]), pk2(x[8 * s + 6], x[8 * s + 7])}; return __builtin_bit_cast(bf16x8, p); }
DI float bfs(short h) { return __uint_as_float(((unsigned)(unsigned short)h) << 16); }

constexpr int SC_Q = 0, SC_K = 16384, SC_KT = 32768, SC_BUF = 49152, SC_WAVE = 2 * SC_BUF, SC_WAVE_BYTES = 6656;
DI bf16x8 ldsfrag(const LAS unsigned char* buf, unsigned o) { const s16x4 lo = *(const LAS s16x4*)(buf + o), hi = *(const LAS s16x4*)(buf + (o ^ 16u)); return __builtin_shufflevector(lo, hi, 0, 1, 2, 3, 4, 5, 6, 7); }
DI void scan_phase(const Args& A, LAS unsigned char* lds, int wv) {
    const int wave = wv;
    LAS float* wl = (LAS float*)(lds + SC_WAVE + wave * SC_WAVE_BYTES);
    LAS unsigned* nbp = (LAS unsigned*)(lds + SC_WAVE + wave * SC_WAVE_BYTES + 2048);
    LAS unsigned* wbp = nbp + 64;
    LAS unsigned char* hst = lds + SC_WAVE + wave * SC_WAVE_BYTES + 2560;
    unsigned char* ws = A.ws;
    const bf16_t* Qg = (const bf16_t*)(ws + WS_SCR + M_Q); const bf16_t* Kg = (const bf16_t*)(ws + WS_SCR + M_K); const bf16_t* KVT = (const bf16_t*)(ws + WS_SCR + M_KVT);
    const float* G32 = (const float*)(ws + WS_SCR + M_G32); const float* bg = A.in[10];
#define SC_POS0(j) (dir == 0 ? ((j) < 4 ? TL + 64 * (j) : 64 * ((j) - 4)) : ((j) < 4 ? TL + 64 * (3 - (j)) : 64 * (35 - (j))))
#define SC_DMA(bufi, p0) do { const int tj_ = otid(wv); _Pragma("unroll") for (int i_ = 0; i_ < 2; ++i_) { const int sl_ = i_ * 512 + tj_; \
        { const int row_ = sl_ >> 4, c_ = (sl_ & 15) ^ (row_ & 15); const size_t go_ = (size_t)((p0) + row_) * 1024 + c_ * 8; \
          __builtin_amdgcn_global_load_lds((const unsigned*)(Qu + go_), (LAS unsigned*)(lds + (bufi) * SC_BUF + SC_Q + i_ * 8192 + wave * 1024), 16, 0, 0); \
          __builtin_amdgcn_global_load_lds((const unsigned*)(Ku + go_), (LAS unsigned*)(lds + (bufi) * SC_BUF + SC_K + i_ * 8192 + wave * 1024), 16, 0, 0); } \
        { const int d_ = sl_ >> 3, c_ = (sl_ & 7) ^ ((d_ >> 1) & 7); \
          __builtin_amdgcn_global_load_lds((const unsigned*)(KTu + (size_t)d_ * TB + (p0) + c_ * 8), (LAS unsigned*)(lds + (bufi) * SC_BUF + SC_KT + i_ * 8192 + wave * 1024), 16, 0, 0); } } } while (0)
    for (int item = blockIdx.x; item < 256; item += gridDim.x) {
        const int dir = item & 1, h = (item >> 1) & 7, b = item >> 4, e0 = wave * 32;
        const bf16_t* Qu = Qg + (size_t)b * TB * 1024 + h * 128;
        const bf16_t* Ku = Kg + (size_t)b * TB * 1024 + h * 128;
        const bf16_t* KTu = KVT + ((size_t)b * 3072 + h * 128) * TB;
        const bf16_t* VTu = KVT + ((size_t)b * 3072 + 1024 + h * 256 + e0) * TB;
        bf16_t* Hout = (bf16_t*)(ws + WS_SCR + (dir ? M_HB : M_HF)) + (size_t)b * TB * DM + h * 256 + e0;
        const float big = bg[(dir * 2) * 8 + h], bfg = bg[(dir * 2 + 1) * 8 + h];
        f32x16 cacc[4];
#pragma unroll
        for (int d = 0; d < 4; ++d)
#pragma unroll
            for (int i = 0; i < 16; ++i) cacc[d][i] = 0.f;
        float m = 0.f;
        { const int l0 = otid(wv) & 63; wl[384 + l0] = 0.f; wl[448 + l0] = 0.f; nbp[l0] = 0u; }
        LFENCE();
        SC_DMA(0, SC_POS0(0));
        float ig_n, fg_n;
        { const int l0 = otid(wv) & 63; const float* gp = G32 + (size_t)(b * TB + SC_POS0(0) + (dir ? 63 - l0 : l0)) * 32 + (dir * 2) * 8 + h; ig_n = gp[0]; fg_n = gp[8]; }
        for (int j = 0; j < 36; ++j) {
            const int pos0 = SC_POS0(j);
            const LAS unsigned char* Qb = lds + (j & 1) * SC_BUF + SC_Q; const LAS unsigned char* Kb = lds + (j & 1) * SC_BUF + SC_K; const LAS unsigned char* KTb = lds + (j & 1) * SC_BUF + SC_KT;
            asm volatile("s_waitcnt vmcnt(0)" ::: "memory"); __builtin_amdgcn_s_barrier(); asm volatile("" ::: "memory");
            if (j + 1 < 36) SC_DMA((j + 1) & 1, SC_POS0(j + 1));
            const int lj = otid(wv) & 63, rj = lj & 31, h4 = (lj >> 5) * 4;
            LAS float* wh = wl + h4; LAS float* wr = wl + rj; LAS unsigned char* hb = hst + h4 * 64 + rj * 2;
            const LAS unsigned* nbh = nbp + (h4 >> 1); const LAS unsigned* wbh = wbp + (h4 >> 1);
            const unsigned xr = rj & 15, xd = (rj >> 1) & 7;
            const unsigned qro = (unsigned)rj * 256u + 2u * h4;
            const unsigned kro = (unsigned)rj * 128u + 2u * h4;
            const bf16_t* VTp = VTu + (size_t)rj * TB + pos0 + h4;
            bf16x8 vf[4];
#pragma unroll
            for (int kk = 0; kk < 4; ++kk) vf[kk] = ldperm(VTp + 16 * kk);
            float decay, m_new;
            {
                const int s = dir ? 63 - lj : lj;
                const float ig = ig_n + big, fg = fg_n + bfg;
                if (j + 1 < 36) { const float* gp = G32 + (size_t)(b * TB + SC_POS0(j + 1) + s) * 32 + (dir * 2) * 8 + h; ig_n = gp[0]; fg_n = gp[8]; }
                const float lf = fminf(fg, 0.f) - log1pf(__expf(-fabsf(fg)));
                float bs = lf;
#pragma unroll
                for (int o = 1; o < 64; o <<= 1) { const float t = __shfl_up(bs, o); if (lj >= o) bs += t; }
                const float uu = ig - bs;
                float pmx = uu;
#pragma unroll
                for (int o = 1; o < 64; o <<= 1) { const float t = __shfl_up(pmx, o); if (lj >= o) pmx = fmaxf(pmx, t); }
                pmx = fmaxf(pmx, m);
                const float b_end = __shfl(bs, 63), pm_last = __shfl(pmx, 63);
                LAS float* ws_ = wl + s;
                ws_[0] = uu * 1.4426950408889634f; ws_[64] = pmx * 1.4426950408889634f; ws_[128] = __expf(m - pmx); ws_[192] = __expf(-(bs + pmx)); ws_[256] = __expf(uu - pm_last);
                { const float wv_ = __expf(uu - pm_last), wp_ = __shfl_xor(wv_, 1); if ((s & 1) == 0) wbp[s >> 1] = pk2(wv_, wp_); }
                decay = __expf(m - pm_last); m_new = b_end + pm_last;
            }
            LFENCE();
            const int sbase = dir ? 63 - h4 : h4, sgn = dir ? -1 : 1;
#pragma unroll
            for (int tb = 0; tb < 2; ++tb) {
                __builtin_amdgcn_sched_barrier(0);
                const unsigned qo = qro + tb * 8192u;
                f32x16 ha;
#pragma unroll
                for (int i = 0; i < 16; ++i) ha[i] = 0.f;
                float qnv = 0.f;
#pragma unroll
                for (int kk = 0; kk < 8; ++kk) {
                    const bf16x8 qa = ldsfrag(Qb, qo + (((2u * kk) ^ xr) << 4));
                    ha = MFMA32(qa, pack_step(cacc[kk >> 1], kk & 1), ha);
                    { const u32x2 nb0 = *(const LAS u32x2*)(nbh + 8 * kk), nb1 = *(const LAS u32x2*)(nbh + 8 * kk + 4); const u32x4 qw = __builtin_bit_cast(u32x4, qa);
                      qnv = DOT2(qw.x, nb0.x, qnv); qnv = DOT2(qw.y, nb0.y, qnv); qnv = DOT2(qw.z, nb1.x, qnv); qnv = DOT2(qw.w, nb1.y, qnv); }
                }
                qnv += __shfl_xor(qnv, 32);
#pragma unroll
                for (int g = 0; g < 4; ++g) { const f32x4 av = *(const LAS f32x4*)(wh + 128 + 32 * tb + 8 * g);
#pragma unroll
                    for (int q = 0; q < 4; ++q) ha[4 * g + q] *= av[q]; }
                const float pmt = wr[64 + 32 * tb];
                const int tp = dir ? (63 - 32 * tb) - rj : 32 * tb + rj;
                float ds = 0.f;
#pragma unroll
                for (int sb = 0; sb < 2; ++sb) {
                    __builtin_amdgcn_sched_barrier(0);
                    if (sb != tb && (dir ? sb < tb : sb > tb)) continue;
                    const unsigned ko = qro + sb * 8192u;
                    f32x16 st;
#pragma unroll
                    for (int i = 0; i < 16; ++i) st[i] = 0.f;
#pragma unroll
                    for (int kk = 0; kk < 8; ++kk) { const unsigned c = ((2u * kk) ^ xr) << 4; st = MFMA32(ldsfrag(Kb, ko + c), ldsfrag(Qb, qo + c), st); }
#pragma unroll
                    for (int g = 0; g < 4; ++g) { const f32x4 uv = *(const LAS f32x4*)(wh + 32 * sb + 8 * g);
#pragma unroll
                        for (int q = 0; q < 4; ++q) {
                            const int sc = 32 * sb + q + 8 * g;
                            const int sp = sbase + sgn * sc;
                            st[4 * g + q] *= __builtin_amdgcn_exp2f((sp <= tp) ? uv[q] - pmt : -1e30f);
                            ds += st[4 * g + q];
                        } }
                    ha = MFMA32(pack_step(st, 0), vf[2 * sb], ha);
                    ha = MFMA32(pack_step(st, 1), vf[2 * sb + 1], ha);
                }
                ds += __shfl_xor(ds, 32);
                {
                    const float den = wr[128 + 32 * tb] * qnv + ds;
                    const float rd = 1.0f / fmaxf(fabsf(den), wr[192 + 32 * tb]);
                    if (h4 == 0) wr[320 + 32 * tb] = rd;
                }
                LFENCE();
#pragma unroll
                for (int g = 0; g < 4; ++g) { const f32x4 rv = *(const LAS f32x4*)(wh + 320 + 32 * tb + 8 * g);
#pragma unroll
                    for (int q = 0; q < 4; ++q) { const int tc = 32 * tb + q + 8 * g;
                        *(LAS unsigned short*)(hb + tc * 64) = (unsigned short)(pk2(ha[4 * g + q] * rv[q], 0.f) & 0xffffu); } }
            }
            LFENCE();
            {
                bf16_t* hp = Hout + (size_t)(pos0 + lj) * DM;
                const LAS unsigned char* hrow = hst + lj * 64;
#pragma unroll
                for (int q = 0; q < 4; ++q) *(u32x4*)(hp + 8 * q) = *(const LAS u32x4*)(hrow + 16 * q);
            }
            __builtin_amdgcn_sched_barrier(0);
            bf16x8 vfw[4];
#pragma unroll
            for (int kk = 0; kk < 4; ++kk) {
                const f32x4 w0 = *(const LAS f32x4*)(wh + 256 + 16 * kk), w1 = *(const LAS f32x4*)(wh + 256 + 16 * kk + 8);
                u32x4 p = {pk2(bfs(vf[kk][0]) * w0[0], bfs(vf[kk][1]) * w0[1]), pk2(bfs(vf[kk][2]) * w0[2], bfs(vf[kk][3]) * w0[3]),
                           pk2(bfs(vf[kk][4]) * w1[0], bfs(vf[kk][5]) * w1[1]), pk2(bfs(vf[kk][6]) * w1[2], bfs(vf[kk][7]) * w1[3])};
                vfw[kk] = __builtin_bit_cast(bf16x8, p);
            }
#pragma unroll
            for (int db = 0; db < 4; ++db) {
                if (db == 2) __builtin_amdgcn_sched_barrier(0);
#pragma unroll
                for (int i = 0; i < 16; ++i) cacc[db][i] *= decay;
                const unsigned to = kro + db * 4096u;
                float nadd = 0.f;
#pragma unroll
                for (int kk = 0; kk < 4; ++kk) {
                    const bf16x8 kv = ldsfrag(KTb, to + (((2u * kk) ^ xd) << 4));
                    const u32x2 wq0 = *(const LAS u32x2*)(wbh + 8 * kk), wq1 = *(const LAS u32x2*)(wbh + 8 * kk + 4); const u32x4 kw = __builtin_bit_cast(u32x4, kv);
                    nadd = DOT2(kw.x, wq0.x, nadd); nadd = DOT2(kw.y, wq0.y, nadd); nadd = DOT2(kw.z, wq1.x, nadd); nadd = DOT2(kw.w, wq1.y, nadd);
                    cacc[db] = MFMA32(kv, vfw[kk], cacc[db]);
                }
                nadd += __shfl_xor(nadd, 32);
                const float nnew = decay * wr[384 + 32 * db] + nadd, npart = __shfl_xor(nnew, 1);
                if (h4 == 0) { wr[384 + 32 * db] = nnew; if ((rj & 1) == 0) nbp[(32 * db + rj) >> 1] = pk2(nnew, npart); }
            }
            LFENCE();
            m = m_new;
        }
        asm volatile("s_waitcnt vmcnt(0)" ::: "memory"); __builtin_amdgcn_s_barrier();
    }
#undef SC_DMA
#undef SC_POS0
}
#undef MFMA32
#undef LFENCE
#undef DOT2
}

DI void mlstm_finish_phase(const Args& A, int wv) {
    const int tid = otid(wv), lane = tid & 63, wave = tid >> 6, G = gridDim.x;
    unsigned char* ws = A.ws;
    const bf16_t* HF = (const bf16_t*)(ws + WS_SCR + M_HF); const bf16_t* HB = (const bf16_t*)(ws + WS_SCR + M_HB);
    const bf16_t* SO = (const bf16_t*)(ws + WS_SCR + M_SO); const bf16_t* SZ = (const bf16_t*)(ws + WS_SCR + M_SZ);
    bf16_t* U = (bf16_t*)(ws + WS_H); const float* hn = A.in[11];
    const int sub = lane >> 5, e0 = (lane & 31) * 8;
    const long NIT = (long)NTOK * 8;
    for (long it0 = ((long)blockIdx.x * NWAVES + wave) * 4 + sub; it0 < NIT; it0 += (long)G * NWAVES * 4) {
        f32x4 f0[2], f1[2], b0[2], b1[2], o0[2], o1[2], z0[2], z1[2];
#pragma unroll
        for (int k = 0; k < 2; ++k) { const long it = it0 + 2 * k; const size_t off = (size_t)(it >> 3) * DM + (int)(it & 7) * 256 + e0;
            ld_bf16x8(HF + off, f0[k], f1[k]); ld_bf16x8(HB + off, b0[k], b1[k]); ld_bf16x8(SO + off, o0[k], o1[k]); ld_bf16x8(SZ + off, z0[k], z1[k]); }
#pragma unroll
        for (int k = 0; k < 2; ++k) { const long it = it0 + 2 * k; const size_t off = (size_t)(it >> 3) * DM + (int)(it & 7) * 256 + e0;
            f32x4 y0 = o0[k] * (f0[k] + b0[k]), y1 = o1[k] * (f1[k] + b1[k]);
            float ss = 0.f;
#pragma unroll
            for (int q = 0; q < 4; ++q) ss += y0[q] * y0[q] + y1[q] * y1[q];
            ss += __shfl_xor(ss, 1); ss += __shfl_xor(ss, 2); ss += __shfl_xor(ss, 4); ss += __shfl_xor(ss, 8); ss += __shfl_xor(ss, 16);
            const float rs = 1.0f / sqrtf(ss * (1.f / 256.f) + EPS);
            const float* hp = hn + (int)(it & 7) * 256 + e0;
            const f32x4 h0 = *(const f32x4*)hp, h1 = *(const f32x4*)(hp + 4);
            st_bf16x8(U + off, y0 * rs * h0 * z0[k], y1 * rs * h1 * z1[k]); }
    }
}

DI void mlstm_layer(const Args& A, LAS unsigned char* lds, const XcdBarrier& gbar, int layer, int wv) {
    unsigned char* ws = A.ws;
    const bf16_t* H = (const bf16_t*)(ws + WS_H); bf16_t* U = (bf16_t*)(ws + WS_H);
    bf16_t* Q = (bf16_t*)(ws + WS_SCR + M_Q); bf16_t* Kb = (bf16_t*)(ws + WS_SCR + M_K); bf16_t* KVT = (bf16_t*)(ws + WS_SCR + M_KVT);
    float* G32 = (float*)(ws + WS_SCR + M_G32); bf16_t* SO = (bf16_t*)(ws + WS_SCR + M_SO); bf16_t* SZ = (bf16_t*)(ws + WS_SCR + M_SZ);
    norm_phase(A, layer, false, wv);
    xcd_barrier(gbar, wv);
    {
        DescM1 D; D.init(H, (const bf16_t*)(ws + WS_WMA), (const bf16_t*)(ws + WS_WMB));
        auto E = [=](const pg8::Unit& u, int row_l, int col_l, f32x4 v0, f32x4 v1) {
            if (u.i2 == 0) {
                const size_t row = (size_t)u.i0 * 256 + row_l; const int pn = u.i1;
                if (pn < 4) st_bf16x8(Q + row * 1024 + pn * 256 + col_l, v0 * 0.088388347648318440f, v1 * 0.088388347648318440f);
                else if (pn < 8) { st_bf16x8(Kb + row * 1024 + (pn - 4) * 256 + col_l, v0, v1);
                    const int bb = u.i0 / 9, sp = (u.i0 % 9) * 256 + row_l;
                    bf16_t* kt = KVT + ((size_t)bb * 3072 + (pn - 4) * 256 + col_l) * TB + sp;
                    const unsigned w0 = pk2(v0[0], v0[1]), w1 = pk2(v0[2], v0[3]), w2 = pk2(v1[0], v1[1]), w3 = pk2(v1[2], v1[3]);
                    kt[0] = (bf16_t)(w0 & 0xffffu); kt[TB] = (bf16_t)(w0 >> 16); kt[2 * TB] = (bf16_t)(w1 & 0xffffu); kt[3 * TB] = (bf16_t)(w1 >> 16);
                    kt[4 * TB] = (bf16_t)(w2 & 0xffffu); kt[5 * TB] = (bf16_t)(w2 >> 16); kt[6 * TB] = (bf16_t)(w3 & 0xffffu); kt[7 * TB] = (bf16_t)(w3 >> 16); }
                else if (col_l < 32) { *(f32x4*)(G32 + row * 32 + col_l) = v0; *(f32x4*)(G32 + row * 32 + col_l + 4) = v1; }
            } else {
                const int bb = u.i1 / 9, s0 = (u.i1 % 9) * 256;
                st_bf16x8(KVT + ((size_t)bb * 3072 + 1024 + u.i0 * 256 + row_l) * TB + s0 + col_l, v0, v1);
            }
        };
        pg8::gemm_phase(lds, D, E, wv);
    }
    xcd_barrier(gbar, wv);
    ml::scan_phase(A, lds, wv);
    xcd_barrier(gbar, wv);
    {
        DescPlain D; D.init(H, (const bf16_t*)(ws + WS_WMA) + (size_t)2304 * DM, 16, false);
        auto E = [=](const pg8::Unit& u, int row_l, int col_l, f32x4 v0, f32x4 v1) {
            const size_t row = (size_t)u.i0 * 256 + row_l; const int pn = u.i1; f32x4 a, b;
            if (pn < 8) {
#pragma unroll
                for (int q = 0; q < 4; ++q) { a[q] = sigmf(v0[q]); b[q] = sigmf(v1[q]); }
                st_bf16x8(SO + row * DM + pn * 256 + col_l, a, b);
            } else {
#pragma unroll
                for (int q = 0; q < 4; ++q) { a[q] = siluf(v0[q]); b[q] = siluf(v1[q]); }
                st_bf16x8(SZ + row * DM + (pn - 8) * 256 + col_l, a, b);
            }
        };
        pg8::gemm_phase(lds, D, E, wv);
    }
    xcd_barrier(gbar, wv);
    mlstm_finish_phase(A, wv);
    xcd_barrier(gbar, wv);
    {
        DescPlain D; D.init(U, (const bf16_t*)(ws + WS_WMO), 8, false);
        const float* modl = (const float*)(ws + WS_MOD) + (size_t)layer * 17 * MOD_LD;
        auto E = [=](const pg8::Unit& u, int row_l, int col_l, f32x4 v0, f32x4 v1) { resid_store(A, layer, u.i0, row_l, u.i1 * 256 + col_l, modl, v0, v1); };
        pg8::gemm_phase(lds, D, E, wv);
    }
    xcd_barrier(gbar, wv);
}

__global__ void __launch_bounds__(NTHREADS, 2) fwd_megakernel(Args A) {
    extern __shared__ __attribute__((aligned(16))) unsigned char lds_raw[];
    LAS unsigned char* lds = (LAS unsigned char*)lds_raw;
    cg::grid_group grid = cg::this_grid();
    const int wv = __builtin_amdgcn_readfirstlane(threadIdx.x >> 6);
    volatile LAS unsigned* bst = (volatile LAS unsigned*)(lds + 152576);
    if (otid(wv) < 2) bst[otid(wv)] = 0u;
    __syncthreads();
    const XcdBarrier gbar = xcd_barrier_post((unsigned*)(A.ws + WS_BAR), bst, wv);
    prep_phase(A, lds, wv);
    grid.sync();
    {
        const long long* mi = (const long long*)(A.ws + WS_MODI); float* mf = (float*)(A.ws + WS_MOD);
        for (int i = blockIdx.x * NTHREADS + otid(wv); i < 4 * 17 * MOD_LD; i += gridDim.x * NTHREADS) mf[i] = (float)mi[i] * MODI_INV;
    }
    xcd_barrier(gbar, wv);
    fnet_layer(A, lds, gbar, 0, 0, false, wv);
    mlstm_layer(A, lds, gbar, 1, wv);
    attn_layer(A, lds, (char*)lds_raw, gbar, 2, wv);
    fnet_layer(A, lds, gbar, 3, 1, true, wv);
    final_norm_phase(A, (const bf16_t*)(A.ws + WS_SCR + F_PQX), wv);
}

extern "C" void kernel_launch(void* const* d_in, const int* in_sizes, int n_in, void* d_out, int out_size, void* d_ws, size_t ws_size, hipStream_t stream) {
    static int grid = 0;
    if (grid == 0) {
        if (n_in != 18 || ws_size < WS_END) { fprintf(stderr, "kernel_launch: unexpected n_in %d / ws_size %zu (need %zu)\n", n_in, ws_size, (size_t)WS_END); grid = -1; return; }
        int dev = 0, cus = 0, per_cu = 0;
        hipGetDevice(&dev);
        hipDeviceGetAttribute(&cus, hipDeviceAttributeMultiprocessorCount, dev);
        if (hipFuncSetAttribute((const void*)fwd_megakernel, hipFuncAttributeMaxDynamicSharedMemorySize, LDS_BYTES) != hipSuccess) { fprintf(stderr, "kernel_launch: hipFuncSetAttribute failed\n"); grid = -1; return; }
        if (hipOccupancyMaxActiveBlocksPerMultiprocessor(&per_cu, (const void*)fwd_megakernel, NTHREADS, LDS_BYTES) != hipSuccess || per_cu < 1) { fprintf(stderr, "kernel_launch: occupancy query failed (%d)\n", per_cu); per_cu = 1; }
        (void)hipGetLastError();
        grid = cus * per_cu;
        fprintf(stderr, "kernel_launch: grid %d (cus %d x %d)\n", grid, cus, per_cu);
    }
    if (grid < 0) return;
    (void)hipMemsetAsync((char*)d_ws + WS_MOD, 0, ZERO_BYTES, stream);
    (void)hipMemsetAsync((char*)d_ws + WS_MODI, 0, MODI_BYTES, stream);
    Args a{};
    for (int i = 0; i < 18; ++i) a.in[i] = (const float*)d_in[i];
    a.out = (float*)d_out; a.ws = (unsigned char*)d_ws; a.ph_lo = 0; a.ph_hi = 100;
    void* args[] = {&a};
    hipError_t e = hipLaunchCooperativeKernel((const void*)fwd_megakernel, dim3(grid), dim3(NTHREADS), args, LDS_BYTES, stream);
    if (e != hipSuccess) fprintf(stderr, "kernel_launch: cooperative launch failed: %s (grid %d)\n", hipGetErrorString(e), grid);
}
```

```cpp
#include <hip/hip_runtime.h>
#include <hip/hip_cooperative_groups.h>
#include <cstdio>
#include <cstdint>
namespace cg = cooperative_groups;

#define LAS __attribute__((address_space(3)))
#define DI __device__ __forceinline__
typedef unsigned short bf16_t;
typedef short bf16x8 __attribute__((ext_vector_type(8)));
typedef short s16x4 __attribute__((ext_vector_type(4)));
typedef float f32x2 __attribute__((ext_vector_type(2)));
typedef float f32x4 __attribute__((ext_vector_type(4)));
typedef float f32x16 __attribute__((ext_vector_type(16)));
typedef unsigned u32x2 __attribute__((ext_vector_type(2)));
typedef unsigned u32x4 __attribute__((ext_vector_type(4)));
typedef __bf16 bf16v2 __attribute__((ext_vector_type(2)));

constexpr int DM = 2048, NB = 16, TL = 2048, TC = 256, TB = TL + TC, NTOK = NB * TB;
constexpr int NWAVES = 8, NTHREADS = 512;
constexpr float EPS = 1e-6f;
constexpr int MOD_LD = 3 * DM;
constexpr int M_WA_ROWS = 6400, M_WB_ROWS = 3072;
constexpr size_t MiB = 1u << 20;
constexpr size_t WS_SCR_ = 301 * MiB;
constexpr size_t WS_MOD = 0;
constexpr size_t MOD_BYTES = (size_t)4 * 17 * MOD_LD * 4;
constexpr size_t WS_BAR = 1792 * 1024, ZERO_BYTES = 2 * MiB;
constexpr size_t WS_MODI = WS_SCR_ + 700 * MiB, MODI_BYTES = (size_t)4 * 17 * MOD_LD * 8;
constexpr float MODI_SCALE = 1073741824.f, MODI_INV = 9.313225746154785e-10f;
constexpr size_t WS_WFG = 2 * MiB, WS_WFO = 18 * MiB, WS_WMA = 34 * MiB, WS_WMB = 59 * MiB, WS_WMO = 71 * MiB, WS_WAI = 79 * MiB, WS_WAO = 99 * MiB;
constexpr size_t WS_DC = 107 * MiB, WS_DT = 108 * MiB, WS_DT2 = 124 * MiB, WS_CTXS = 125 * MiB, WS_H = 157 * MiB, WS_SCR = 301 * MiB;
constexpr size_t WS_END = 1024 * MiB;
constexpr size_t F_G = 0, F_PQX = 144 * MiB, F_PQC = 400 * MiB, F_A1 = 432 * MiB;
constexpr size_t M_Q = 0, M_K = 72 * MiB, M_KVT = 144 * MiB, M_G32 = 360 * MiB, M_HF = 365 * MiB, M_HB = 509 * MiB, M_SO = 0, M_SZ = 144 * MiB;
constexpr size_t A_Q = 0, A_K = 144 * MiB, A_V = 180 * MiB, A_SZ = 216 * MiB;
static_assert(WS_SCR + M_HB + 144 * MiB <= WS_END, "ws map");
constexpr int LDS_BYTES = 152576 + 1024;

DI unsigned pk2(float a, float b) { f32x2 v = {a, b}; return __builtin_bit_cast(unsigned, __builtin_convertvector(v, bf16v2)); }
DI float bf_lo(unsigned w) { return __uint_as_float(w << 16); }
DI float bf_hi(unsigned w) { return __uint_as_float(w & 0xffff0000u); }
DI float wave_sum(float v) {
#pragma unroll
    for (int o = 1; o < 64; o <<= 1) v += __shfl_xor(v, o);
    return v;
}
DI int otid(int wv) { int t; asm volatile("v_mbcnt_lo_u32_b32 %0, -1, 0\n\tv_mbcnt_hi_u32_b32 %0, -1, %0" : "=v"(t)); return wv * 64 + t; }
DI float siluf(float x) { return x / (1.f + __expf(-x)); }
DI float sigmf(float x) { return 1.f / (1.f + __expf(-x)); }
DI void st_bf16x8(bf16_t* p, f32x4 a, f32x4 b) { u32x4 w = {pk2(a[0], a[1]), pk2(a[2], a[3]), pk2(b[0], b[1]), pk2(b[2], b[3])}; *(u32x4*)p = w; }
DI void ld_bf16x8(const bf16_t* p, f32x4& a, f32x4& b) { const u32x4 w = *(const u32x4*)p; a = (f32x4){bf_lo(w.x), bf_hi(w.x), bf_lo(w.y), bf_hi(w.y)}; b = (f32x4){bf_lo(w.z), bf_hi(w.z), bf_lo(w.w), bf_hi(w.w)}; }

DI f32x4 ldmod4(const long long* p) { return (f32x4){(float)p[0] * MODI_INV, (float)p[1] * MODI_INV, (float)p[2] * MODI_INV, (float)p[3] * MODI_INV}; }

struct Args { const float* in[18]; float* out; unsigned char* ws; int ph_lo, ph_hi; };

#define XB_TMO      128
#define XB_XCNT(j)  (256  + 64 * (j))
#define XB_XSUB(j)  (1280 + 64 * (j))
#define XB_XGEN(j)  (2304 + 64 * (j))
#define XB_TOP      3328
#define XB_TOPGEN   3392
#define XCD_BAR_WORDS 3456
#define XB_SPIN_CAP (1u << 18)

__device__ __forceinline__ unsigned xb_ld(unsigned* p)              { return __hip_atomic_load(p, __ATOMIC_RELAXED, __HIP_MEMORY_SCOPE_AGENT); }
__device__ __forceinline__ unsigned xb_add(unsigned* p, unsigned v) { return __hip_atomic_fetch_add(p, v, __ATOMIC_RELAXED, __HIP_MEMORY_SCOPE_AGENT); }
__device__ __forceinline__ unsigned xb_xcc_id() { return (unsigned)__builtin_amdgcn_s_getreg((3 << 11) | 20) & 0xFu; }
#define XB_SPIN(cond, bar) do { unsigned _sp = 0; while (cond) { __builtin_amdgcn_s_sleep(1); \
    if ((++_sp & 255u) == 0u) { if (xb_ld(&(bar)[XB_TMO])) break; if (_sp > XB_SPIN_CAP) { atomicAdd(&(bar)[XB_TMO], 1u); break; } } } } while (0)

struct XcdBarrier {
    unsigned* bar; unsigned x;
    volatile LAS unsigned* st;
};

__device__ __forceinline__ XcdBarrier xcd_barrier_post(unsigned* bar, volatile LAS unsigned* st, int wv) {
    XcdBarrier b; b.bar = bar; b.x = xb_xcc_id(); b.st = st;
    if (otid(wv) == 0) (void)xb_add(&bar[XB_XCNT(b.x)], 1u);
    return b;
}
__device__ __forceinline__ void xcd_barrier_complete(unsigned* bar, unsigned x, unsigned& nloc, unsigned& nx) {
    const unsigned G = gridDim.x * gridDim.y * gridDim.z;
    unsigned sum, cnt, mine, sp = 0u;
    for (;;) {
        sum = 0u; cnt = 0u; mine = 0u;
#pragma unroll
        for (unsigned j = 0; j < 16; ++j) { const unsigned c = xb_ld(&bar[XB_XCNT(j)]); sum += c; cnt += (c > 0u) ? 1u : 0u; mine = (j == x) ? c : mine; }
        if (sum == G) break;
        __builtin_amdgcn_s_sleep(1);
        if ((++sp & 255u) == 0u) { if (xb_ld(&bar[XB_TMO])) break; if (sp > XB_SPIN_CAP) { atomicAdd(&bar[XB_TMO], 1u); break; } }
    }
    nloc = mine > 0u ? mine : 1u; nx = cnt > 0u ? cnt : 1u;
}

__device__ __forceinline__ void xcd_barrier(const XcdBarrier& b, int wv) {
    asm volatile("s_waitcnt vmcnt(0)" ::: "memory");
    __syncthreads();
    if (otid(wv) == 0) {
        unsigned* bar = b.bar;
        __builtin_amdgcn_s_waitcnt(0);
        unsigned nloc = b.st[0], nx = b.st[1];
        if (nloc == 0u) { xcd_barrier_complete(bar, b.x, nloc, nx); b.st[0] = nloc; b.st[1] = nx; }
        const unsigned old = xb_add(&bar[XB_XSUB(b.x)], 1u);
        const unsigned gen = old / nloc;
        if (old + 1u == (gen + 1u) * nloc) {
            __builtin_amdgcn_fence(__ATOMIC_RELEASE, "agent");
            asm volatile("s_waitcnt vmcnt(0)" ::: "memory");
            const unsigned og = xb_add(&bar[XB_TOP], 1u);
            const unsigned tg = og / nx;
            if (og + 1u == (tg + 1u) * nx) xb_add(&bar[XB_TOPGEN], 1u);
            else XB_SPIN(xb_ld(&bar[XB_TOPGEN]) == tg, bar);
            __builtin_amdgcn_fence(__ATOMIC_ACQUIRE, "agent");
            xb_add(&bar[XB_XGEN(b.x)], 1u);
            asm volatile("s_waitcnt vmcnt(0)" ::: "memory");
        } else {
            XB_SPIN(xb_ld(&bar[XB_XGEN(b.x)]) == gen, bar);
            __builtin_amdgcn_fence(__ATOMIC_ACQUIRE, "agent");
            asm volatile("s_waitcnt vmcnt(0)" ::: "memory");
        }
    }
    __syncthreads();
}


namespace pg8 {
constexpr int BM = 256, BK = 64, HALF = 128, HTB = HALF * BK * 2, NXCD = 8;
DI int lds_byte(int r, int c) { const int st = (r >> 4) * 2 + (c >> 5), rr = r & 15, cc = c & 31, ob = rr * 64 + cc * 2; return st * 1024 + (ob ^ (((ob >> 9) & 1) << 5)); }
DI void stage_rc(int b, int& R, int& C) { const int st = b / 1024, sb = b % 1024, swz = sb ^ (((sb >> 9) & 1) << 5); R = (st >> 1) * 16 + swz / 64; C = (st & 1) * 32 + (swz % 64) / 2; }
DI int perm32(int rho) { const int n = rho >> 4, i = rho & 15; return 8 * (i >> 2) + 4 * n + (i & 3); }
struct Unit { const char* a; const char* b; int i0, i1, i2; };
DI int xcd_remap(int L, int total) { const int q = total / NXCD, r = total % NXCD, xcd = L % NXCD, off = L / NXCD; return (xcd < r ? xcd * (q + 1) : r * (q + 1) + (xcd - r) * q) + off; }

template <class Desc, class Epi>
DI void gemm_phase(LAS unsigned char* lds, const Desc& D, const Epi& E, int wv) {
    const int tid = otid(wv), wid = __builtin_amdgcn_readfirstlane(tid >> 6), lane = tid & 63, wr = wid >> 2, wc = wid & 3, fr = lane & 15, fq = lane >> 4;
    const int G = gridDim.x, c = blockIdx.x, total = D.total;
    const int K = D.K, nt = K / BK;
    unsigned voffA[2], voffB[2];
#pragma unroll
    for (int i = 0; i < 2; ++i) { int R, C; stage_rc(tid * 16 + i * 8192, R, C); const int Rb = (R & ~31) + perm32(R & 31);
        voffA[i] = (unsigned)(R * D.lda + C) * 2u; voffB[i] = (unsigned)(Rb * D.ldb + C) * 2u; }
    const size_t kstep = (size_t)(BK * 2);
    const size_t hstepA = (size_t)HALF * D.lda * 2, hstepB = (size_t)HALF * D.ldb * 2;
    const unsigned ldsw = (unsigned)wid * 1024u;
    const int aoff = lds_byte(wr * 64 + fr, fq * 8), boff = lds_byte(wc * 32 + fr, fq * 8);
#define PG8_SA(b, h) (((b) * 2 + (h)) * HTB)
#define PG8_SB(b, h) ((4 + (b) * 2 + (h)) * HTB)
#define PG8_STAGE(bufoff, gbase, voff) do { _Pragma("unroll") for (int _i = 0; _i < 2; ++_i) \
        __builtin_amdgcn_global_load_lds((const unsigned*)((const char*)(gbase) + (voff)[_i]), (LAS unsigned*)(lds + (bufoff) + ldsw + _i * 8192), 16, 0, 0); } while (0)
#define PG8_LDA(dst, b, h) do { _Pragma("unroll") for (int m = 0; m < 4; ++m) _Pragma("unroll") for (int k = 0; k < 2; ++k) dst[m][k] = *(const LAS bf16x8*)(lds + PG8_SA(b, h) + aoff + m * 2048 + k * 1024); } while (0)
#define PG8_LDB(dst, b, h) do { _Pragma("unroll") for (int n = 0; n < 2; ++n) _Pragma("unroll") for (int k = 0; k < 2; ++k) dst[n][k] = *(const LAS bf16x8*)(lds + PG8_SB(b, h) + boff + n * 2048 + k * 1024); } while (0)
#define PG8_MMA(ai, bj, At, Bt) do { __builtin_amdgcn_s_setprio(1); _Pragma("unroll") for (int m = 0; m < 4; ++m) _Pragma("unroll") for (int n = 0; n < 2; ++n) _Pragma("unroll") for (int k = 0; k < 2; ++k) \
        acc[ai][bj][m][n] = __builtin_amdgcn_mfma_f32_16x16x32_bf16(Bt[n][k], At[m][k], acc[ai][bj][m][n], 0, 0, 0); __builtin_amdgcn_s_setprio(0); } while (0)
#define PG8_WAIT_V(n) asm volatile("s_waitcnt vmcnt(" #n ")" ::: "memory")
#define PG8_WAIT_L(n) asm volatile("s_waitcnt lgkmcnt(" #n ")" ::: "memory")
#define PG8_BAR __builtin_amdgcn_s_barrier()
#define PG8_SCHED __builtin_amdgcn_sched_barrier(0)
    if constexpr (Desc::RAW) { if (!D.valid(c, G)) return; } else { if (c >= total) return; }
    Unit cur, nxt; int ui = 0;
    if constexpr (Desc::RAW) cur = D.unit(c, G); else cur = D.unit(xcd_remap(c, total));
    nxt = cur;
    f32x4 acc[2][2][4][2];
#pragma unroll
    for (int a = 0; a < 2; ++a)
#pragma unroll
        for (int b = 0; b < 2; ++b)
#pragma unroll
            for (int m = 0; m < 4; ++m)
#pragma unroll
                for (int n = 0; n < 2; ++n) acc[a][b][m][n] = (f32x4){0.f, 0.f, 0.f, 0.f};
    bf16x8 At[4][2], B0[2][2], B1[2][2];
    const char* cA = cur.a; const char* cB = cur.b;
    PG8_STAGE(PG8_SB(0, 0), cB, voffB); PG8_STAGE(PG8_SB(0, 1), cB + hstepB, voffB); PG8_STAGE(PG8_SA(0, 0), cA, voffA); PG8_STAGE(PG8_SA(0, 1), cA + hstepA, voffA);
    if (wr == 1) PG8_BAR;
    PG8_WAIT_V(2); PG8_BAR;
    PG8_STAGE(PG8_SB(1, 0), cB + kstep, voffB); PG8_STAGE(PG8_SA(1, 0), cA + kstep, voffA); PG8_STAGE(PG8_SB(1, 1), cB + hstepB + kstep, voffB);
    PG8_WAIT_V(6); PG8_BAR;
    for (;;) {
        const long Ln = (long)(ui + 1) * G + c;
        bool has_next;
        if constexpr (Desc::RAW) { has_next = D.valid((int)Ln, G); if (has_next) nxt = D.unit((int)Ln, G); }
        else { has_next = Ln < total; if (has_next) nxt = D.unit(xcd_remap((int)Ln, total)); }
        const char* nA = has_next ? nxt.a : cA; const char* nB = has_next ? nxt.b : cB;
        for (int t = 0; t < nt; t += 2) {
            const bool last = (t == nt - 2);
            const char* a1 = cA + (size_t)(t + 1) * kstep;
            const char* a2 = last ? nA : cA + (size_t)(t + 2) * kstep; const char* b2 = last ? nB : cB + (size_t)(t + 2) * kstep;
            const char* a3 = a2 + kstep; const char* b3 = b2 + kstep;
            PG8_LDB(B0, 0, 0); PG8_LDB(B1, 0, 1); PG8_SCHED; PG8_LDA(At, 0, 0); PG8_STAGE(PG8_SA(1, 1), a1 + hstepA, voffA);
            PG8_WAIT_V(8); PG8_WAIT_L(0); PG8_BAR; PG8_MMA(0, 0, At, B0); PG8_MMA(0, 1, At, B1); PG8_BAR; PG8_SCHED;
            PG8_LDA(At, 0, 1); PG8_STAGE(PG8_SB(0, 0), b2, voffB); PG8_STAGE(PG8_SB(0, 1), b2 + hstepB, voffB); PG8_STAGE(PG8_SA(0, 0), a2, voffA);
            PG8_WAIT_V(8); PG8_WAIT_L(0); PG8_BAR; PG8_MMA(1, 0, At, B0); PG8_MMA(1, 1, At, B1); PG8_BAR; PG8_SCHED;
            PG8_LDB(B0, 1, 0); PG8_LDB(B1, 1, 1); PG8_SCHED; PG8_LDA(At, 1, 0); PG8_STAGE(PG8_SA(0, 1), a2 + hstepA, voffA);
            PG8_WAIT_V(8); PG8_WAIT_L(0); PG8_BAR; PG8_MMA(0, 0, At, B0); PG8_MMA(0, 1, At, B1); PG8_BAR; PG8_SCHED;
            PG8_LDA(At, 1, 1); PG8_STAGE(PG8_SB(1, 0), b3, voffB); PG8_STAGE(PG8_SB(1, 1), b3 + hstepB, voffB); PG8_STAGE(PG8_SA(1, 0), a3, voffA);
            PG8_WAIT_V(8); PG8_WAIT_L(0); PG8_BAR; PG8_MMA(1, 0, At, B0); PG8_MMA(1, 1, At, B1); PG8_BAR; PG8_SCHED;
        }
        if (wr == 0) PG8_BAR;
        {
            const int le = otid(wv) & 63, fre = le & 15, fqe = le >> 4;
#pragma unroll
            for (int ai = 0; ai < 2; ++ai)
#pragma unroll
                for (int m = 0; m < 4; ++m)
#pragma unroll
                    for (int bj = 0; bj < 2; ++bj)
                        E(cur, ai * HALF + wr * 64 + m * 16 + fre, bj * HALF + wc * 32 + 8 * fqe, acc[ai][bj][m][0], acc[ai][bj][m][1]);
        }
        if (!has_next) break;
#pragma unroll
        for (int a = 0; a < 2; ++a)
#pragma unroll
            for (int b = 0; b < 2; ++b)
#pragma unroll
                for (int m = 0; m < 4; ++m)
#pragma unroll
                    for (int n = 0; n < 2; ++n) acc[a][b][m][n] = (f32x4){0.f, 0.f, 0.f, 0.f};
        cur = nxt; cA = nA; cB = nB; ++ui;
        if (wr == 1) PG8_BAR;
    }
    PG8_WAIT_V(0);
    PG8_BAR;
#undef PG8_SA
#undef PG8_SB
#undef PG8_STAGE
#undef PG8_LDA
#undef PG8_LDB
#undef PG8_MMA
#undef PG8_WAIT_V
#undef PG8_WAIT_L
#undef PG8_BAR
#undef PG8_SCHED
}
}

DI void transpose_item(const float* W, int N, int kb, int nb, bf16_t* d0, bf16_t* d1, int K, LAS float* scr, int lane) {
    const int k0 = 64 * kb, n0 = 32 * nb;
#pragma unroll 8
    for (int i = 0; i < 32; ++i) { const int kk = 2 * i + (lane >> 5); scr[kk * 33 + (lane & 31)] = W[(size_t)(k0 + kk) * N + n0 + (lane & 31)]; }
    asm volatile("s_waitcnt lgkmcnt(0)" ::: "memory");
    const int c = lane & 7;
#pragma unroll
    for (int j = 0; j < 4; ++j) { const int n = (lane >> 3) + 8 * j; const LAS float* s = scr + (8 * c) * 33 + n;
        u32x4 o; o.x = pk2(s[0 * 33], s[1 * 33]); o.y = pk2(s[2 * 33], s[3 * 33]); o.z = pk2(s[4 * 33], s[5 * 33]); o.w = pk2(s[6 * 33], s[7 * 33]);
        *(u32x4*)(d0 + (size_t)n * K + k0 + 8 * c) = o;
        if (d1) *(u32x4*)(d1 + (size_t)n * K + k0 + 8 * c) = o; }
    asm volatile("s_waitcnt lgkmcnt(0)" ::: "memory");
}

DI void prep_phase(const Args& A, LAS unsigned char* lds, int wv) {
    const int tid = otid(wv), lane = tid & 63, wave = tid >> 6, G = gridDim.x;
    unsigned char* ws = A.ws;
    {
        LAS float* s_lds = (LAS float*)lds;
        const float* cc = A.in[1]; const float* cctx = A.in[3]; const float* aw = A.in[4]; const float* ab = A.in[5];
        long long* modi = (long long*)(ws + WS_MODI);
        for (int item = blockIdx.x; item < 768; item += G) {
            const int kc = item % 16, cb = (item / 16) % 12, l = item / 192;
            const int k0 = kc * 128, j = cb * 512 + tid;
            __syncthreads();
            for (int e = tid; e < 17 * 128; e += NTHREADS) { const int r = e / 128, k = e % 128; const float v = r < 16 ? cc[r * DM + k0 + k] : cctx[k0 + k]; s_lds[k * 20 + r] = siluf(v); }
            __syncthreads();
            float acc[17];
#pragma unroll
            for (int r = 0; r < 17; ++r) acc[r] = 0.f;
            const float* wp = aw + ((size_t)l * DM + k0) * MOD_LD + j;
#pragma unroll 4
            for (int k = 0; k < 128; ++k) {
                const float w = wp[(size_t)k * MOD_LD];
                const LAS f32x4* sp = (const LAS f32x4*)(s_lds + k * 20);
                const f32x4 s0 = sp[0], s1 = sp[1], s2 = sp[2], s3 = sp[3]; const float s4 = s_lds[k * 20 + 16];
#pragma unroll
                for (int q = 0; q < 4; ++q) { acc[q] += s0[q] * w; acc[4 + q] += s1[q] * w; acc[8 + q] += s2[q] * w; acc[12 + q] += s3[q] * w; }
                acc[16] += s4 * w;
            }
            const float bias = (kc == 0) ? ab[l * MOD_LD + j] : 0.f;
#pragma unroll
            for (int r = 0; r < 17; ++r) atomicAdd((unsigned long long*)&modi[(size_t)(l * 17 + r) * MOD_LD + j], (unsigned long long)__float2ll_rn((acc[r] + bias) * MODI_SCALE));
        }
        __syncthreads();
    }
    {
        LAS float* scr = (LAS float*)(lds + wave * 16384);
        const int gw = blockIdx.x * NWAVES + wave, NGW = G * NWAVES;
        constexpr int I_SQ = 32 * 64, I_AI = 32 * 160, I_MI = 32 * 257;
        constexpr int NIT = 6 * I_SQ + I_AI + I_MI;
        for (int it = gw; it < NIT; it += NGW) {
            int r = it;
            if (r < 6 * I_SQ) {
                const int w = r / I_SQ; r -= w * I_SQ;
                const float* src; bf16_t* dst;
                if (w < 2)      { src = A.in[7] + (size_t)w * DM * DM;       dst = (bf16_t*)(ws + WS_WFG) + (size_t)w * DM * DM; }
                else if (w < 4) { src = A.in[8] + (size_t)(w - 2) * DM * DM; dst = (bf16_t*)(ws + WS_WFO) + (size_t)(w - 2) * DM * DM; }
                else if (w == 4) { src = A.in[12]; dst = (bf16_t*)(ws + WS_WMO); }
                else             { src = A.in[16]; dst = (bf16_t*)(ws + WS_WAO); }
                const int kb = r / 64, nb = r % 64;
                transpose_item(src, DM, kb, nb, dst + (size_t)(32 * nb) * DM, nullptr, DM, scr, lane);
                continue;
            }
            r -= 6 * I_SQ;
            if (r < I_AI) { const int kb = r / 160, nb = r % 160; transpose_item(A.in[13], 5120, kb, nb, (bf16_t*)(ws + WS_WAI) + (size_t)(32 * nb) * DM, nullptr, DM, scr, lane); continue; }
            r -= I_AI;
            {
                const int kb = r / 257, nb = r % 257, n0 = 32 * nb;
                bf16_t* WA = (bf16_t*)(ws + WS_WMA); bf16_t* WB = (bf16_t*)(ws + WS_WMB);
                bf16_t* d0; bf16_t* d1 = nullptr;
                if (n0 < 1024) d0 = WA + (size_t)n0 * DM;
                else if (n0 < 2048) d0 = WA + (size_t)n0 * DM;
                else if (n0 < 4096) d0 = WB + (size_t)(n0 - 2048) * DM;
                else if (n0 < 6144) d0 = WA + (size_t)(2304 + n0 - 4096) * DM;
                else if (n0 < 6176) d0 = WA + (size_t)(2048 + n0 - 6144) * DM;
                else d0 = WA + (size_t)(4352 + n0 - 6176) * DM;
                transpose_item(A.in[9], 8224, kb, nb, d0, d1, DM, scr, lane);
            }
        }
    }
    {
        const long gt = (long)blockIdx.x * NTHREADS + tid, NGT = (long)G * NTHREADS;
        constexpr long N_DC = 1024L * 512 / 8, N_DT = 2048L * 4096 / 8, N_DT2 = 256L * 512 / 8;
        for (long it = gt; it < N_DC + N_DT + N_DT2; it += NGT) {
            float v[8]; bf16_t* dst;
            if (it < N_DC) {
                const int m = (int)(it / 64), k0 = (int)(it % 64) * 8; const float sc = 0.044194173824159216f;
#pragma unroll
                for (int j = 0; j < 8; ++j) { const int rr = ((m & 511) * (k0 + j)) & 511; const float ang = (float)rr * (1.f / 256.f); v[j] = (m < 512 ? cospif(ang) : sinpif(ang)) * sc; }
                dst = (bf16_t*)(ws + WS_DC) + (size_t)m * 512 + k0;
            } else if (it < N_DC + N_DT) {
                const long i2 = it - N_DC; const int kk = (int)(i2 / 512), s0 = (int)(i2 % 512) * 8; const float sc = 0.022097086912079608f;
#pragma unroll
                for (int j = 0; j < 8; ++j) { const int s = s0 + j; const int rr = (kk * (s & 2047)) & 2047; const float ang = (float)rr * (1.f / 1024.f); v[j] = (s < 2048 ? cospif(ang) : -sinpif(ang)) * sc; }
                dst = (bf16_t*)(ws + WS_DT) + (size_t)kk * 4096 + s0;
            } else {
                const long i2 = it - N_DC - N_DT; const int kk = (int)(i2 / 64), s0 = (int)(i2 % 64) * 8; const float sc = 0.0625f;
#pragma unroll
                for (int j = 0; j < 8; ++j) { const int s = s0 + j; const int rr = (kk * (s & 255)) & 255; const float ang = (float)rr * (1.f / 128.f); v[j] = (s < 256 ? cospif(ang) : -sinpif(ang)) * sc; }
                dst = (bf16_t*)(ws + WS_DT2) + (size_t)kk * 512 + s0;
            }
            u32x4 o = {pk2(v[0], v[1]), pk2(v[2], v[3]), pk2(v[4], v[5]), pk2(v[6], v[7])};
            *(u32x4*)dst = o;
        }
    }
}

DI const float* xrow_in(const Args& A, int r) {
    const int b = r / TB, t = r % TB;
    if (t < TL) return A.in[0] + ((size_t)b * TL + t) * DM;
    return A.in[2] + ((size_t)b * TC + (t - TL)) * DM;
}
DI void norm_phase(const Args& A, int layer, bool latonly, int wv) {
    const int tid = otid(wv), lane = tid & 63, wave = tid >> 6, G = gridDim.x;
    const float* ng = A.in[6] + (size_t)layer * DM;
    const float* mod = (const float*)(A.ws + WS_MOD) + (size_t)layer * 17 * MOD_LD;
    bf16_t* H = (bf16_t*)(A.ws + WS_H);
    const bf16_t* XB = (const bf16_t*)A.out;
    for (int r0 = (blockIdx.x * NWAVES + wave) * 2; r0 < NTOK; r0 += G * NWAVES * 2) {
        const int b = r0 / TB, t = r0 % TB;
        if (latonly && t >= TL) continue;
        const float* mr = mod + (size_t)(t < TL ? b : 16) * MOD_LD;
        f32x4 v[2][4][2];
#pragma unroll
        for (int k = 0; k < 2; ++k) {
            const int r = r0 + k;
            if (layer == 0) {
                const float* xr = xrow_in(A, r);
#pragma unroll
                for (int j = 0; j < 4; ++j) { const f32x4* p = (const f32x4*)(xr + 512 * j + 8 * lane); v[k][j][0] = p[0]; v[k][j][1] = p[1]; }
            } else {
#pragma unroll
                for (int j = 0; j < 4; ++j) ld_bf16x8(XB + (size_t)r * DM + 512 * j + 8 * lane, v[k][j][0], v[k][j][1]);
            }
        }
#pragma unroll
        for (int k = 0; k < 2; ++k) {
            const int r = r0 + k; float ss = 0.f;
#pragma unroll
            for (int j = 0; j < 4; ++j)
#pragma unroll
                for (int q = 0; q < 4; ++q) ss += v[k][j][0][q] * v[k][j][0][q] + v[k][j][1][q] * v[k][j][1][q];
            const float rs = 1.0f / sqrtf(wave_sum(ss) * (1.f / DM) + EPS);
#pragma unroll
            for (int j = 0; j < 4; ++j) { const int c0 = 512 * j + 8 * lane; f32x4 o[2];
#pragma unroll
                for (int h = 0; h < 2; ++h) { const f32x4 g4 = *(const f32x4*)(ng + c0 + 4 * h), sh = *(const f32x4*)(mr + c0 + 4 * h), sc = *(const f32x4*)(mr + DM + c0 + 4 * h);
                    o[h] = (v[k][j][h] * rs) * g4 * (sc + 1.0f) + sh; }
                st_bf16x8(H + (size_t)r * DM + c0, o[0], o[1]); }
        }
    }
}
DI void final_norm_phase(const Args& A, const bf16_t* src, int wv) {
    const int tid = otid(wv), lane = tid & 63, wave = tid >> 6, G = gridDim.x;
    const float* fg = A.in[17];
    for (int r0 = (blockIdx.x * NWAVES + wave) * 2; r0 < NB * TL; r0 += G * NWAVES * 2) {
        f32x4 v[2][4][2];
#pragma unroll
        for (int k = 0; k < 2; ++k)
#pragma unroll
            for (int j = 0; j < 4; ++j) ld_bf16x8(src + (size_t)(r0 + k) * DM + 512 * j + 8 * lane, v[k][j][0], v[k][j][1]);
#pragma unroll
        for (int k = 0; k < 2; ++k) { float* orow = A.out + (size_t)(r0 + k) * DM; float ss = 0.f;
#pragma unroll
            for (int j = 0; j < 4; ++j)
#pragma unroll
                for (int q = 0; q < 4; ++q) ss += v[k][j][0][q] * v[k][j][0][q] + v[k][j][1][q] * v[k][j][1][q];
            const float rs = 1.0f / sqrtf(wave_sum(ss) * (1.f / DM) + EPS);
#pragma unroll
            for (int j = 0; j < 4; ++j) { const int c0 = 512 * j + 8 * lane;
#pragma unroll
                for (int h = 0; h < 2; ++h) { const f32x4 g4 = *(const f32x4*)(fg + c0 + 4 * h); *(f32x4*)(orow + c0 + 4 * h) = (v[k][j][h] * rs) * g4; } }
        }
    }
}

struct DescPlain {
    static constexpr bool RAW = false;
    const bf16_t* A; const bf16_t* B; int nN; bool latonly; int lda, ldb, K, total;
    DI void init(const bf16_t* A_, const bf16_t* B_, int nN_, bool lat) { A = A_; B = B_; nN = nN_; latonly = lat; lda = DM; ldb = DM; K = DM; total = (lat ? 128 : 144) * nN_; }
    DI pg8::Unit unit(int idx) const {
        const int nMt = latonly ? 128 : 144, nig = 8 * nN, gid = idx / nig, fm = gid * 8, gsz = (nMt - fm) < 8 ? (nMt - fm) : 8;
        const int pmi = fm + (idx % nig) % gsz, pn = (idx % nig) / gsz, pm = latonly ? (pmi / 8) * 9 + (pmi % 8) : pmi;
        pg8::Unit u; u.a = (const char*)(A + (size_t)pm * 256 * DM); u.b = (const char*)(B + (size_t)pn * 256 * DM); u.i0 = pm; u.i1 = pn; u.i2 = 0; return u;
    }
};
struct DescChan {
    static constexpr bool RAW = false;
    const bf16_t* DC; const bf16_t* H; int lda, ldb, K, total;
    DI void init(const bf16_t* DC_, const bf16_t* H_, bool lat) { DC = DC_; H = H_; lda = 512; ldb = DM; K = 512; total = lat ? 2048 : 2304; }
    DI pg8::Unit unit(int idx) const {
        pg8::Unit u; int b, g, mt, nt, toff;
        if (idx < 2048) { mt = idx % 4; nt = (idx / 4) % 8; g = (idx / 32) % 4; b = idx / 128; toff = nt * 256; u.i2 = nt; }
        else { const int j = idx - 2048; mt = j % 4; g = (j / 4) % 4; b = j / 16; toff = TL; u.i2 = 8; }
        u.a = (const char*)(DC + (size_t)mt * 256 * 512); u.b = (const char*)(H + ((size_t)b * TB + toff) * DM + g * 512); u.i0 = b * 4 + g; u.i1 = mt; return u;
    }
};
struct DescT {
    static constexpr bool RAW = false;
    const bf16_t* DT; const bf16_t* PQ; int nMt; int lda, ldb, K, total;
    DI void init(const bf16_t* DT_, const bf16_t* PQ_, int ld, int Kd, int coff, int nMt_) { DT = DT_ + coff; PQ = PQ_ + coff; nMt = nMt_; lda = ld; ldb = ld; K = Kd; total = NB * nMt_ * 8; }
    DI pg8::Unit unit(int idx) const {
        const int mt = idx % nMt, nt = (idx / nMt) % 8, b = idx / (nMt * 8);
        pg8::Unit u; u.a = (const char*)(DT + (size_t)mt * 256 * lda); u.b = (const char*)(PQ + ((size_t)b * DM + nt * 256) * ldb); u.i0 = b; u.i1 = mt; u.i2 = nt; return u;
    }
};

struct DescT2 {
    static constexpr bool RAW = true;
    const bf16_t* DT; const bf16_t* PQ; int lda, ldb, K, total;
    DI void init(const bf16_t* DT_, const bf16_t* PQ_) { DT = DT_; PQ = PQ_; lda = 4096; ldb = 4096; K = 2048; total = 2 * NB * 4 * 8; }
    DI bool valid(int L, int G) const { return ((L / G) >> 1) * G + (L % G) < NB * 4 * 8; }
    DI pg8::Unit unit(int L, int G) const {
        const int i = L / G, pair = (i >> 1) * G + (L % G), part = i & 1;
        const int mt = pair % 4, nt = (pair / 4) % 8, b = pair / 32, coff = part * 2048;
        pg8::Unit u; u.a = (const char*)(DT + (size_t)mt * 256 * 4096 + coff); u.b = (const char*)(PQ + ((size_t)b * DM + nt * 256) * 4096 + coff); u.i0 = b; u.i1 = mt; u.i2 = part * 8 + nt; return u;
    }
};

DI void resid_store(const Args& A, int layer, int pm, int row_l, int col, const float* modl, f32x4 v0, f32x4 v1) {
    const int b = pm / 9, tt = pm % 9;
    const float* gp = modl + (size_t)(tt < 8 ? b : 16) * MOD_LD + 2 * DM + col;
    const f32x4 g0 = *(const f32x4*)gp, g1 = *(const f32x4*)(gp + 4);
    bf16_t* XB = (bf16_t*)A.out;
    const size_t roff = ((size_t)pm * 256 + row_l) * DM + col;
    f32x4 x0, x1;
    if (layer == 0) {
        const float* src = (tt < 8) ? A.in[0] + ((size_t)b * TL + tt * 256 + row_l) * DM + col : A.in[2] + ((size_t)b * TC + row_l) * DM + col;
        x0 = *(const f32x4*)src; x1 = *(const f32x4*)(src + 4);
    } else ld_bf16x8(XB + roff, x0, x1);
    x0 = x0 + g0 * v0; x1 = x1 + g1 * v1;
    if (layer == 3) st_bf16x8((bf16_t*)(A.ws + WS_SCR + F_PQX) + ((size_t)b * TL + tt * 256 + row_l) * DM + col, x0, x1);
    else st_bf16x8(XB + roff, x0, x1);
}

DI void fnet_layer(const Args& A, LAS unsigned char* lds, const XcdBarrier& gbar, int layer, int j, bool latonly, int wv) {
    unsigned char* ws = A.ws;
    const bf16_t* H = (const bf16_t*)(ws + WS_H); bf16_t* U = (bf16_t*)(ws + WS_H);
    bf16_t* Gt = (bf16_t*)(ws + WS_SCR + F_G); bf16_t* PQX = (bf16_t*)(ws + WS_SCR + F_PQX); bf16_t* PQC = (bf16_t*)(ws + WS_SCR + F_PQC);
    norm_phase(A, layer, latonly, wv);
    xcd_barrier(gbar, wv);
    {
        DescPlain D; D.init(H, (const bf16_t*)(ws + WS_WFG) + (size_t)j * DM * DM, 8, latonly);
        auto E = [=](const pg8::Unit& u, int row_l, int col_l, f32x4 v0, f32x4 v1) {
            f32x4 a, b;
#pragma unroll
            for (int q = 0; q < 4; ++q) { a[q] = siluf(v0[q]); b[q] = siluf(v1[q]); }
            st_bf16x8(Gt + ((size_t)u.i0 * 256 + row_l) * DM + u.i1 * 256 + col_l, a, b);
        };
        pg8::gemm_phase(lds, D, E, wv);
    }
    {
        DescChan D; D.init((const bf16_t*)(ws + WS_DC), H, latonly);
        auto E = [=](const pg8::Unit& u, int row_l, int col_l, f32x4 v0, f32x4 v1) {
            const int b = u.i0 >> 2, g = u.i0 & 3, mt = u.i1, half = mt >> 1, ch = g * 512 + (mt & 1) * 256 + row_l;
            bf16_t* dst = (u.i2 < 8) ? PQX + ((size_t)b * DM + ch) * 4096 + half * 2048 + u.i2 * 256 + col_l
                                     : PQC + ((size_t)b * DM + ch) * 512 + half * 256 + col_l;
            st_bf16x8(dst, v0, v1);
        };
        pg8::gemm_phase(lds, D, E, wv);
    }
    xcd_barrier(gbar, wv);
    bf16_t* A1 = (bf16_t*)(ws + WS_SCR + F_A1);
    {
        const int tid = otid(wv), lane = tid & 63;
        for (int rr0 = (blockIdx.x * NWAVES + wv) * 4; rr0 < NB * DM; rr0 += gridDim.x * NWAVES * 4) {
            u32x4 raw[4][4];
#pragma unroll
            for (int k = 0; k < 4; ++k)
#pragma unroll
                for (int q = 0; q < 4; ++q) raw[k][q] = *(const u32x4*)(PQX + (size_t)(rr0 + k) * 4096 + (q * 64 + lane) * 8);
#pragma unroll
            for (int k = 0; k < 4; ++k) { float acc = 0.f;
#pragma unroll
                for (int q = 0; q < 4; ++q) { const u32x4 w = raw[k][q]; acc += (bf_lo(w.x) - bf_hi(w.x)) + (bf_lo(w.y) - bf_hi(w.y)) + (bf_lo(w.z) - bf_hi(w.z)) + (bf_lo(w.w) - bf_hi(w.w)); }
                acc = wave_sum(acc);
                if (lane == 0) { const int rr = rr0 + k; const size_t off = ((size_t)(rr >> 11) * TB + 1024) * DM + (rr & 2047);
                    U[off] = (bf16_t)(pk2(acc * 0.022097086912079608f * __uint_as_float((unsigned)Gt[off] << 16), 0.f) & 0xffffu); } }
        }
    }
    {
        DescT2 D; D.init((const bf16_t*)(ws + WS_DT), PQX);
        auto E = [=](const pg8::Unit& u, int row_l, int col_l, f32x4 v0, f32x4 v1) {
            const int k = u.i1 * 256 + row_l, col = (u.i2 & 7) * 256 + col_l;
            bf16_t* ap = A1 + ((size_t)u.i0 * 1024 + k) * DM + col;
            if (u.i2 < 8) { st_bf16x8(ap, v0, v1); return; }
            f32x4 a0, a1; ld_bf16x8(ap, a0, a1);
            const size_t off = ((size_t)u.i0 * TB + k) * DM + col;
            f32x4 g0, g1; ld_bf16x8(Gt + off, g0, g1);
            st_bf16x8(U + off, (a0 + v0) * g0, (a1 + v1) * g1);
            if (k != 0) { const size_t off2 = ((size_t)u.i0 * TB + (TL - k)) * DM + col; ld_bf16x8(Gt + off2, g0, g1); st_bf16x8(U + off2, (a0 - v0) * g0, (a1 - v1) * g1); }
        };
        pg8::gemm_phase(lds, D, E, wv);
    }
    if (!latonly) {
        DescT D; D.init((const bf16_t*)(ws + WS_DT2), PQC, 512, 512, 0, 1);
        auto E = [=](const pg8::Unit& u, int row_l, int col_l, f32x4 v0, f32x4 v1) {
            const size_t off = ((size_t)u.i0 * TB + TL + row_l) * DM + u.i2 * 256 + col_l;
            f32x4 g0, g1; ld_bf16x8(Gt + off, g0, g1);
            st_bf16x8(U + off, v0 * g0, v1 * g1);
        };
        pg8::gemm_phase(lds, D, E, wv);
    }
    xcd_barrier(gbar, wv);
    {
        DescPlain D; D.init(U, (const bf16_t*)(ws + WS_WFO) + (size_t)j * DM * DM, 8, latonly);
        const float* modl = (const float*)(ws + WS_MOD) + (size_t)layer * 17 * MOD_LD;
        auto E = [=](const pg8::Unit& u, int row_l, int col_l, f32x4 v0, f32x4 v1) { resid_store(A, layer, u.i0, row_l, u.i1 * 256 + col_l, modl, v0, v1); };
        pg8::gemm_phase(lds, D, E, wv);
    }
    xcd_barrier(gbar, wv);
}


namespace att {
constexpr int D = 128, NW = 8, QBLK = 32, KVBLK = 64;
constexpr float SCALE = 0.088388347648318440f;
constexpr float THR = 8.f;
constexpr int LDQ = 2048, LDK = 512;
constexpr size_t SHM_V = KVBLK * D * 2, SHM_K = KVBLK * D * 2;
typedef float f32x8 __attribute__((ext_vector_type(8)));
#define KSWZ(row, colB) ((row) * 256 + ((colB) ^ (((row) & 7) << 4)))
#define SBAR() __builtin_amdgcn_sched_barrier(0)
DI int crow(int r, int hi) { return (r & 3) + 8 * (r >> 2) + 4 * hi; }
DI unsigned cvtpk(float lo, float hi) { unsigned r; asm volatile("v_cvt_pk_bf16_f32 %0, %1, %2" : "=v"(r) : "v"(lo), "v"(hi)); return r; }
DI void partialSM(f32x16& p0, f32x16& p1, float& m_reg, float& mn, float& alpha) {
  constexpr float C = SCALE * 1.4426950408889634f;
  float pmax = p0[0];
#pragma unroll
  for (int r = 1; r < 16; ++r) pmax = fmaxf(pmax, p0[r]);
#pragma unroll
  for (int r = 0; r < 16; ++r) pmax = fmaxf(pmax, p1[r]);
  { auto rr = __builtin_amdgcn_permlane32_swap(__float_as_uint(pmax), __float_as_uint(pmax), false, false);
    pmax = fmaxf(__uint_as_float(rr[0]), __uint_as_float(rr[1])); }
  if (__builtin_expect(__all(pmax - m_reg <= THR / SCALE), 1)) { mn = m_reg; alpha = 1.f; }
  else { mn = fmaxf(m_reg, pmax); alpha = __builtin_amdgcn_exp2f((m_reg - mn) * C); m_reg = mn; }
  float mnC = -mn * C;
#pragma unroll
  for (int r = 0; r < 16; ++r) p0[r] = fmaf(p0[r], C, mnC);
#pragma unroll
  for (int r = 0; r < 16; ++r) p1[r] = fmaf(p1[r], C, mnC);
#pragma unroll
  for (int r = 0; r < 16; ++r) p0[r] = __builtin_amdgcn_exp2f(p0[r]);
}
DI void finishSM(f32x16& p0, f32x16& p1, float alpha, float& l_reg, bf16x8& pa0, bf16x8& pa1, bf16x8& pa2, bf16x8& pa3) {
#pragma unroll
  for (int r = 0; r < 16; ++r) p1[r] = __builtin_amdgcn_exp2f(p1[r]);
  float ps = 0;
#pragma unroll
  for (int r = 0; r < 16; ++r) ps += p0[r];
#pragma unroll
  for (int r = 0; r < 16; ++r) ps += p1[r];
  { auto rr = __builtin_amdgcn_permlane32_swap(__float_as_uint(ps), __float_as_uint(ps), false, false);
    ps = __uint_as_float(rr[0]) + __uint_as_float(rr[1]); }
  l_reg = l_reg * alpha + ps;
#define PK4(P, BASE, OUT) do { unsigned a0 = cvtpk(P[BASE + 0], P[BASE + 1]), a1 = cvtpk(P[BASE + 2], P[BASE + 3]);   \
    unsigned b0 = cvtpk(P[BASE + 4], P[BASE + 5]), b1 = cvtpk(P[BASE + 6], P[BASE + 7]);                              \
    auto r0 = __builtin_amdgcn_permlane32_swap(a0, b0, false, false); auto r1 = __builtin_amdgcn_permlane32_swap(a1, b1, false, false); \
    u32x4 w = {r0[0], r1[0], r0[1], r1[1]}; OUT = *reinterpret_cast<bf16x8*>(&w); } while (0)
  PK4(p0, 0, pa0); PK4(p0, 8, pa1); PK4(p1, 0, pa2); PK4(p1, 8, pa3);
#undef PK4
}
DI void qkt(f32x16& p0, f32x16& p1, const bf16_t* Ks, const bf16x8* qr, int r32, int hi) {
  p0 = f32x16{}; p1 = f32x16{};
#pragma unroll
  for (int d0 = 0; d0 < 8; ++d0) { int cb = (d0 * 16 + hi * 8) * 2;
    bf16x8 b0 = *reinterpret_cast<const bf16x8*>((const char*)Ks + KSWZ(r32, cb));
    bf16x8 b1 = *reinterpret_cast<const bf16x8*>((const char*)Ks + KSWZ(32 + r32, cb));
    p0 = __builtin_amdgcn_mfma_f32_32x32x16_bf16(b0, qr[d0], p0, 0, 0, 0);
    p1 = __builtin_amdgcn_mfma_f32_32x32x16_bf16(b1, qr[d0], p1, 0, 0, 0); }
}
DI int v_st(int k, int c) { const int kk = (k & ~0xC) | ((k & 4) << 1) | ((k & 8) >> 1); return ((kk >> 3) * 4 + (c >> 5)) * 512 + ((kk & 7) * 32 + (c & 31)) * 2; }
DI int v_rd_base(int lane) { return ((lane & 3) << 3) | (((lane >> 2) & 3) << 6) | (((lane >> 4) & 1) << 5) | (((lane >> 5) & 1) << 8); }
constexpr int v_rd_off(int d0, int ks, int half) { return d0 * 512 + ks * 4096 + half * 2048; }
template <int OFF> DI s16x4 tr_read(int vb) {
  s16x4 r; asm volatile("ds_read_b64_tr_b16 %0, %1 offset:%2" : "=&v"(r) : "v"(vb), "i"(OFF) : "memory"); return r;
}
template <int D0> DI void pv_one(f32x16& od, int vb, bf16x8 pa0, bf16x8 pa1, bf16x8 pa2, bf16x8 pa3) {
  const s16x4 l0 = tr_read<v_rd_off(D0, 0, 0)>(vb), h0 = tr_read<v_rd_off(D0, 0, 1)>(vb), l1 = tr_read<v_rd_off(D0, 1, 0)>(vb), h1 = tr_read<v_rd_off(D0, 1, 1)>(vb);
  const s16x4 l2 = tr_read<v_rd_off(D0, 2, 0)>(vb), h2 = tr_read<v_rd_off(D0, 2, 1)>(vb), l3 = tr_read<v_rd_off(D0, 3, 0)>(vb), h3 = tr_read<v_rd_off(D0, 3, 1)>(vb);
  asm volatile("s_waitcnt lgkmcnt(0)" ::: "memory"); SBAR();
#define PK(L, H) (bf16x8){L[0], L[1], L[2], L[3], H[0], H[1], H[2], H[3]}
  od = __builtin_amdgcn_mfma_f32_32x32x16_bf16(pa0, PK(l0, h0), od, 0, 0, 0);
  od = __builtin_amdgcn_mfma_f32_32x32x16_bf16(pa1, PK(l1, h1), od, 0, 0, 0);
  od = __builtin_amdgcn_mfma_f32_32x32x16_bf16(pa2, PK(l2, h2), od, 0, 0, 0);
  od = __builtin_amdgcn_mfma_f32_32x32x16_bf16(pa3, PK(l3, h3), od, 0, 0, 0);
#undef PK
}
DI void pv_d0(f32x16* o, int vb, bf16x8 pa0, bf16x8 pa1, bf16x8 pa2, bf16x8 pa3) {
  pv_one<0>(o[0], vb, pa0, pa1, pa2, pa3); pv_one<1>(o[1], vb, pa0, pa1, pa2, pa3); pv_one<2>(o[2], vb, pa0, pa1, pa2, pa3); pv_one<3>(o[3], vb, pa0, pa1, pa2, pa3);
}
DI void attn_dense_body(const bf16_t* __restrict__ Qb, const bf16_t* __restrict__ Kh, const bf16_t* __restrict__ Vh, const bf16_t* SZb, bf16_t* Ub, int seq, char* lds, int wv, const float* qn, int tpos) {
  const int tid = otid(wv), wid = tid >> 6, lane = tid & 63, r32 = lane & 31, hi = lane >> 5;
  bf16_t* V_lds = (bf16_t*)lds; bf16_t* K_lds = (bf16_t*)(lds + 2 * SHM_V);
  float* wsf = (float*)(lds + 2 * SHM_V + 2 * SHM_K) + wid * 64; float* li_l = wsf; float* al_l = wsf + 32;
  float m_reg = -1e30f, l_reg = 0; f32x16 o[4] = {}; bf16x8 qr[8];
  const bf16_t* Qw = Qb + (long)(wid * QBLK + r32) * LDQ + hi * 8;
  {
    u32x4 raw[8];
#pragma unroll
    for (int d0 = 0; d0 < 8; ++d0) raw[d0] = *reinterpret_cast<const u32x4*>(Qw + d0 * 16);
    float ss = 0.f;
#pragma unroll
    for (int d0 = 0; d0 < 8; ++d0) { const u32x4 w = raw[d0];
      ss += bf_lo(w.x) * bf_lo(w.x) + bf_hi(w.x) * bf_hi(w.x) + bf_lo(w.y) * bf_lo(w.y) + bf_hi(w.y) * bf_hi(w.y) + bf_lo(w.z) * bf_lo(w.z) + bf_hi(w.z) * bf_hi(w.z) + bf_lo(w.w) * bf_lo(w.w) + bf_hi(w.w) * bf_hi(w.w); }
    ss += __shfl_xor(ss, 32);
    const float rs = 1.0f / sqrtf(ss * (1.f / 128.f) + EPS);
    const int t = tpos + wid * QBLK + r32;
    const f32x2* rope = (const f32x2*)(lds + 81920);
#pragma unroll
    for (int d0 = 0; d0 < 8; ++d0) { const u32x4 w = raw[d0]; const float* wn = qn + d0 * 16 + hi * 8;
      const f32x4 g0 = *(const f32x4*)wn, g1 = *(const f32x4*)(wn + 4);
      float y[8] = {bf_lo(w.x) * rs * g0[0], bf_hi(w.x) * rs * g0[1], bf_lo(w.y) * rs * g0[2], bf_hi(w.y) * rs * g0[3], bf_lo(w.z) * rs * g1[0], bf_hi(w.z) * rs * g1[1], bf_lo(w.w) * rs * g1[2], bf_hi(w.w) * rs * g1[3]};
      if (tpos >= 0) {
        const int pos = (d0 < 4) ? (t >> 6) : (t & 63);
        const f32x4* rp = (const f32x4*)(rope + pos * 32 + (8 * (d0 & 3) + 4 * hi));
        const f32x4 c01 = rp[0], c23 = rp[1];
        const float cs[4] = {c01[0], c01[2], c23[0], c23[2]}, sn[4] = {c01[1], c01[3], c23[1], c23[3]};
#pragma unroll
        for (int pp = 0; pp < 4; ++pp) { const float x0 = y[2 * pp], x1 = y[2 * pp + 1]; y[2 * pp] = x0 * cs[pp] - x1 * sn[pp]; y[2 * pp + 1] = x0 * sn[pp] + x1 * cs[pp]; }
      }
      u32x4 o4 = {pk2(y[0], y[1]), pk2(y[2], y[3]), pk2(y[4], y[5]), pk2(y[6], y[7])};
      qr[d0] = __builtin_bit_cast(bf16x8, o4); }
  }
  const int sr = tid >> 4, sc = (tid & 15) * 8, vst0 = v_st(sr, sc), vst1 = v_st(32 + sr, sc);
  const int vb0 = (int)(uintptr_t)V_lds + v_rd_base(lane);
  struct { bf16x8 vs0, vs1, ks0, ks1; } sr_[2];
#define SLOAD(i, k0) do { sr_[i].vs0 = *reinterpret_cast<const bf16x8*>(&Vh[(long)((k0) + sr) * LDK + sc]); sr_[i].vs1 = *reinterpret_cast<const bf16x8*>(&Vh[(long)((k0) + 32 + sr) * LDK + sc]); \
    sr_[i].ks0 = *reinterpret_cast<const bf16x8*>(&Kh[(long)((k0) + sr) * LDK + sc]); sr_[i].ks1 = *reinterpret_cast<const bf16x8*>(&Kh[(long)((k0) + 32 + sr) * LDK + sc]); } while (0)
#define SWRITE(b, i) do { *(bf16x8*)((char*)V_lds + (b) * SHM_V + vst0) = sr_[i].vs0;          \
    *(bf16x8*)((char*)V_lds + (b) * SHM_V + vst1) = sr_[i].vs1; int kc = sc * 2;               \
    *(bf16x8*)((char*)K_lds + (b) * SHM_K + KSWZ(sr, kc)) = sr_[i].ks0;                       \
    *(bf16x8*)((char*)K_lds + (b) * SHM_K + KSWZ(32 + sr, kc)) = sr_[i].ks1; } while (0)
#define SWAIT() asm volatile("s_waitcnt vmcnt(4)" ::: "memory")
#define RESC(a) do { if (__any((a) < 1.f)) { if (hi == 0) al_l[r32] = (a); asm volatile("s_waitcnt lgkmcnt(0)" ::: "memory"); \
    _Pragma("unroll") for (int d = 0; d < 4; ++d) _Pragma("unroll") for (int r = 0; r < 16; ++r) o[d][r] *= al_l[crow(r, hi)]; } } while (0)
  f32x16 pA0, pA1, pB0, pB1; float mnA, mnB, alA, alB; bf16x8 pa0, pa1, pa2, pa3; const int NT = seq / KVBLK;
  constexpr int SE = 0, SO = 1;
  SLOAD(SE, 0); asm volatile("s_waitcnt vmcnt(0)" ::: "memory"); SWRITE(0, SE); __syncthreads();
  qkt(pA0, pA1, K_lds, qr, r32, hi); partialSM(pA0, pA1, m_reg, mnA, alA);
  SLOAD(SO, KVBLK); if (2 < NT) SLOAD(SE, 2 * KVBLK);
  SWAIT(); SWRITE(1, SO); __syncthreads();
  for (int j = 1; j + 1 < NT; j += 2) {
    SBAR(); qkt(pB0, pB1, (bf16_t*)((char*)K_lds + SHM_K), qr, r32, hi);
    finishSM(pA0, pA1, alA, l_reg, pa0, pa1, pa2, pa3); SBAR();
    SLOAD(SO, (j + 2) * KVBLK); SBAR();
    pv_d0(o, vb0, pa0, pa1, pa2, pa3); partialSM(pB0, pB1, m_reg, mnB, alB);
    __syncthreads(); SWAIT(); SWRITE(0, SE);
    RESC(alB); __syncthreads();
    SBAR(); qkt(pA0, pA1, K_lds, qr, r32, hi);
    finishSM(pB0, pB1, alB, l_reg, pa0, pa1, pa2, pa3); SBAR();
    if (j + 3 < NT) SLOAD(SE, (j + 3) * KVBLK); SBAR();
    pv_d0(o, vb0 + (int)SHM_V, pa0, pa1, pa2, pa3); partialSM(pA0, pA1, m_reg, mnA, alA);
    __syncthreads(); SWAIT(); SWRITE(1, SO);
    RESC(alA); __syncthreads();
  }
  SBAR(); qkt(pB0, pB1, (bf16_t*)((char*)K_lds + SHM_K), qr, r32, hi);
  finishSM(pA0, pA1, alA, l_reg, pa0, pa1, pa2, pa3); SBAR();
  pv_d0(o, vb0, pa0, pa1, pa2, pa3); partialSM(pB0, pB1, m_reg, mnB, alB);
  __syncthreads(); RESC(alB);
  finishSM(pB0, pB1, alB, l_reg, pa0, pa1, pa2, pa3); SBAR();
  pv_d0(o, vb0 + (int)SHM_V, pa0, pa1, pa2, pa3);
  u32x4 zq[8];
#pragma unroll
  for (int i = 0; i < 8; ++i) { const int id = tid + 512 * i; zq[i] = *(const u32x4*)(SZb + (long)(id >> 4) * LDQ + (id & 15) * 8); }
  if (hi == 0) li_l[r32] = l_reg; asm volatile("s_waitcnt lgkmcnt(0)" ::: "memory");
  __syncthreads();
  {
    float rli[16];
#pragma unroll
    for (int r = 0; r < 16; ++r) rli[r] = __builtin_amdgcn_rcpf(li_l[crow(r, hi)]);
    char* ost = lds;
#pragma unroll
    for (int r = 0; r < 16; ++r) { char* rowp = ost + (wid * QBLK + crow(r, hi)) * 256 + r32 * 2;
#pragma unroll
      for (int d0 = 0; d0 < 4; ++d0) *(unsigned short*)(rowp + d0 * 64) = (unsigned short)(pk2(o[d0][r] * rli[r], 0.f) & 0xffffu); }
  }
  __syncthreads();
#pragma unroll
  for (int i = 0; i < 8; ++i) { const int id = tid + 512 * i; const int row = id >> 4, ch = id & 15;
    const u32x4 ov = *(const u32x4*)(lds + row * 256 + ch * 16);
    f32x4 a0 = {bf_lo(ov.x), bf_hi(ov.x), bf_lo(ov.y), bf_hi(ov.y)}, a1 = {bf_lo(ov.z), bf_hi(ov.z), bf_lo(ov.w), bf_hi(ov.w)};
    const f32x4 z0 = {bf_lo(zq[i].x), bf_hi(zq[i].x), bf_lo(zq[i].y), bf_hi(zq[i].y)}, z1 = {bf_lo(zq[i].z), bf_hi(zq[i].z), bf_lo(zq[i].w), bf_hi(zq[i].w)};
    st_bf16x8(Ub + (long)row * LDQ + ch * 8, a0 * z0, a1 * z1); }
  __syncthreads();
#undef SLOAD
#undef SWRITE
#undef SWAIT
#undef RESC
}
#undef KSWZ
#undef SBAR
}

DI void qknorm_phase(const Args& A, LAS unsigned char* lds, int wv) {
    const int tid = otid(wv), lane = tid & 63, wave = tid >> 6, G = gridDim.x;
    bf16_t* Q = (bf16_t*)(A.ws + WS_SCR + A_Q); bf16_t* Kb = (bf16_t*)(A.ws + WS_SCR + A_K);
    const float* qn = A.in[14]; const float* kn = A.in[15];
    const int sub = lane >> 4, l16 = lane & 15, e0 = l16 * 8;
    LAS f32x2* rope = (LAS f32x2*)lds;
    for (int e = tid; e < 2048; e += NTHREADS) { const float ang = (float)(e >> 5) * exp2f(-(float)(e & 31) * 0.41524101186092029f); rope[e] = (f32x2){cosf(ang), sinf(ang)}; }
    __syncthreads();
    const long NIT = (long)NTOK * 4;
    for (long it0 = ((long)blockIdx.x * NWAVES + wave) * 16 + sub; it0 < NIT; it0 += (long)G * NWAVES * 16) {
        bf16_t* pq[4]; u32x4 raw[4];
#pragma unroll
        for (int k = 0; k < 4; ++k) { const long it = it0 + 4 * k; const int row = (int)(it >> 2), hj = 16 + (int)(it & 3);
            pq[k] = (hj < 16) ? Q + (size_t)row * 2048 + hj * 128 + e0 : Kb + (size_t)row * 512 + (hj - 16) * 128 + e0;
            raw[k] = *(const u32x4*)pq[k]; }
#pragma unroll
        for (int k = 0; k < 4; ++k) {
            const long it = it0 + 4 * k; const int row = (int)(it >> 2), hj = 16 + (int)(it & 3);
            const float* wn = (hj < 16 ? qn : kn) + e0;
            f32x4 a = {bf_lo(raw[k].x), bf_hi(raw[k].x), bf_lo(raw[k].y), bf_hi(raw[k].y)}, b = {bf_lo(raw[k].z), bf_hi(raw[k].z), bf_lo(raw[k].w), bf_hi(raw[k].w)};
            float ss = 0.f;
#pragma unroll
            for (int q = 0; q < 4; ++q) ss += a[q] * a[q] + b[q] * b[q];
            ss += __shfl_xor(ss, 1); ss += __shfl_xor(ss, 2); ss += __shfl_xor(ss, 4); ss += __shfl_xor(ss, 8);
            const float rs = 1.0f / sqrtf(ss * (1.f / 128.f) + EPS);
            const f32x4 w0 = *(const f32x4*)wn, w1 = *(const f32x4*)(wn + 4);
            a = a * rs * w0; b = b * rs * w1;
            const int t = row % TB;
            if (t < TL) {
                const int pos = (l16 < 8) ? (t >> 6) : (t & 63);
                float y[8] = {a[0], a[1], a[2], a[3], b[0], b[1], b[2], b[3]};
                const LAS f32x4* rp = (const LAS f32x4*)(rope + pos * 32 + ((4 * l16) & 31));
                const f32x4 c01 = rp[0], c23 = rp[1];
                const float cs[4] = {c01[0], c01[2], c23[0], c23[2]}, sn[4] = {c01[1], c01[3], c23[1], c23[3]};
#pragma unroll
                for (int pp = 0; pp < 4; ++pp) {
                    const float x0 = y[2 * pp], x1 = y[2 * pp + 1];
                    y[2 * pp] = x0 * cs[pp] - x1 * sn[pp]; y[2 * pp + 1] = x0 * sn[pp] + x1 * cs[pp];
                }
                a = (f32x4){y[0], y[1], y[2], y[3]}; b = (f32x4){y[4], y[5], y[6], y[7]};
            }
            st_bf16x8(pq[k], a, b);
        }
    }
}

DI void attn_layer(const Args& A, LAS unsigned char* lds, char* lds_gen, const XcdBarrier& gbar, int layer, int wv) {
    unsigned char* ws = A.ws;
    const bf16_t* H = (const bf16_t*)(ws + WS_H); bf16_t* U = (bf16_t*)(ws + WS_H);
    bf16_t* Q = (bf16_t*)(ws + WS_SCR + A_Q); bf16_t* Kb = (bf16_t*)(ws + WS_SCR + A_K); bf16_t* Vb = (bf16_t*)(ws + WS_SCR + A_V); bf16_t* SZ = (bf16_t*)(ws + WS_SCR + A_SZ);
    norm_phase(A, layer, false, wv);
    xcd_barrier(gbar, wv);
    {
        DescPlain D; D.init(H, (const bf16_t*)(ws + WS_WAI), 20, false);
        auto E = [=](const pg8::Unit& u, int row_l, int col_l, f32x4 v0, f32x4 v1) {
            const size_t row = (size_t)u.i0 * 256 + row_l; const int pn = u.i1;
            if (pn < 8) st_bf16x8(Q + row * 2048 + pn * 256 + col_l, v0, v1);
            else if (pn < 10) st_bf16x8(Kb + row * 512 + (pn - 8) * 256 + col_l, v0, v1);
            else if (pn < 12) st_bf16x8(Vb + row * 512 + (pn - 10) * 256 + col_l, v0, v1);
            else { f32x4 a, b;
#pragma unroll
                for (int q = 0; q < 4; ++q) { a[q] = siluf(v0[q]); b[q] = siluf(v1[q]); }
                st_bf16x8(SZ + row * 2048 + (pn - 12) * 256 + col_l, a, b); }
        };
        pg8::gemm_phase(lds, D, E, wv);
    }
    xcd_barrier(gbar, wv);
    qknorm_phase(A, lds, wv);
    xcd_barrier(gbar, wv);
    {
        const int G = gridDim.x, c = blockIdx.x;
        { f32x2* rope = (f32x2*)(lds_gen + 81920); const int tid = otid(wv);
          for (int e = tid; e < 2048; e += NTHREADS) { const float ang = (float)(e >> 5) * exp2f(-(float)(e & 31) * 0.41524101186092029f); rope[e] = (f32x2){cosf(ang), sinf(ang)}; }
          __syncthreads(); }
        const float* qn = A.in[14];
        for (long L = c; L < 2048; L += G) {
            const int u = pg8::xcd_remap((int)L, 2048);
            const int b = u / 128, rem = u % 128, kvh = rem / 32, g = (rem / 8) % 4, qb = rem % 8, h = kvh * 4 + g;
            const size_t qoff = ((size_t)b * TB + qb * 256) * 2048 + h * 128, koff = ((size_t)b * TB) * 512 + kvh * 128;
            att::attn_dense_body(Q + qoff, Kb + koff, Vb + koff, SZ + qoff, U + qoff, TB, lds_gen, wv, qn, qb * 256);
        }
        for (int u = c; u < 256; u += G) {
            const int b = u / 16, h = u % 16, kvh = h / 4;
            const size_t qoff = ((size_t)b * TB + TL) * 2048 + h * 128, koff = ((size_t)b * TB + TL) * 512 + kvh * 128;
            att::attn_dense_body(Q + qoff, Kb + koff, Vb + koff, SZ + qoff, U + qoff, TC, lds_gen, wv, qn, -1);
        }
    }
    xcd_barrier(gbar, wv);
    {
        DescPlain D; D.init(U, (const bf16_t*)(ws + WS_WAO), 8, false);
        const float* modl = (const float*)(ws + WS_MOD) + (size_t)layer * 17 * MOD_LD;
        auto E = [=](const pg8::Unit& u, int row_l, int col_l, f32x4 v0, f32x4 v1) { resid_store(A, layer, u.i0, row_l, u.i1 * 256 + col_l, modl, v0, v1); };
        pg8::gemm_phase(lds, D, E, wv);
    }
    xcd_barrier(gbar, wv);
}


struct DescM1 {
    static constexpr bool RAW = false;
    const bf16_t* H; const bf16_t* WA; const bf16_t* WB; int lda, ldb, K, total;
    DI void init(const bf16_t* H_, const bf16_t* WA_, const bf16_t* WB_) { H = H_; WA = WA_; WB = WB_; lda = DM; ldb = DM; K = DM; total = 144 * 9 + 8 * 144; }
    DI pg8::Unit unit(int idx) const {
        pg8::Unit u;
        if (idx < 1296) { const int nig = 72, gid = idx / nig, pm = gid * 8 + (idx % nig) % 8, pn = (idx % nig) / 8;
            u.a = (const char*)(H + (size_t)pm * 256 * DM); u.b = (const char*)(WA + (size_t)pn * 256 * DM); u.i0 = pm; u.i1 = pn; u.i2 = 0; }
        else { const int j = idx - 1296, mt = j % 8, nt = j / 8;
            u.a = (const char*)(WB + (size_t)mt * 256 * DM); u.b = (const char*)(H + (size_t)nt * 256 * DM); u.i0 = mt; u.i1 = nt; u.i2 = 1; }
        return u;
    }
};
namespace ml {
#define MFMA32(a, b, c) __builtin_amdgcn_mfma_f32_32x32x16_bf16((a), (b), (c), 0, 0, 0)
#define LFENCE() asm volatile("s_waitcnt lgkmcnt(0)" ::: "memory")
DI float dot2_bf16(unsigned a, unsigned b, float c) { asm("v_dot2c_f32_bf16 %0, %1, %2" : "+v"(c) : "v"(a), "v"(b)); return c; }
#define DOT2(a, b, c) dot2_bf16((a), (b), (c))
DI int crow(int reg, int h) { return (reg & 3) + 8 * (reg >> 2) + 4 * h; }
DI bf16x8 ldperm(const bf16_t* p) { const s16x4 lo = *(const s16x4*)p, hi = *(const s16x4*)(p + 8); return __builtin_shufflevector(lo, hi, 0, 1, 2, 3, 4, 5, 6, 7); }
DI bf16x8 pack_step(const f32x16& x, int s) { u32x4 p = {pk2(x[8 * s], x[8 * s + 1]), pk2(x[8 * s + 2], x[8 * s + 3]), pk2(x[8 * s + 4], x[8 * s + 5]), pk2(x[8 * s + 6], x[8 * s + 7])}; return __builtin_bit_cast(bf16x8, p); }
DI float bfs(short h) { return __uint_as_float(((unsigned)(unsigned short)h) << 16); }

constexpr int SC_Q = 0, SC_K = 16384, SC_KT = 32768, SC_BUF = 49152, SC_WAVE = 2 * SC_BUF, SC_WAVE_BYTES = 6656;
DI bf16x8 ldsfrag(const LAS unsigned char* buf, unsigned o) { const s16x4 lo = *(const LAS s16x4*)(buf + o), hi = *(const LAS s16x4*)(buf + (o ^ 16u)); return __builtin_shufflevector(lo, hi, 0, 1, 2, 3, 4, 5, 6, 7); }
DI void scan_phase(const Args& A, LAS unsigned char* lds, int wv) {
    const int wave = wv;
    LAS float* wl = (LAS float*)(lds + SC_WAVE + wave * SC_WAVE_BYTES);
    LAS unsigned* nbp = (LAS unsigned*)(lds + SC_WAVE + wave * SC_WAVE_BYTES + 2048);
    LAS unsigned* wbp = nbp + 64;
    LAS unsigned char* hst = lds + SC_WAVE + wave * SC_WAVE_BYTES + 2560;
    unsigned char* ws = A.ws;
    const bf16_t* Qg = (const bf16_t*)(ws + WS_SCR + M_Q); const bf16_t* Kg = (const bf16_t*)(ws + WS_SCR + M_K); const bf16_t* KVT = (const bf16_t*)(ws + WS_SCR + M_KVT);
    const float* G32 = (const float*)(ws + WS_SCR + M_G32); const float* bg = A.in[10];
#define SC_POS0(j) (dir == 0 ? ((j) < 4 ? TL + 64 * (j) : 64 * ((j) - 4)) : ((j) < 4 ? TL + 64 * (3 - (j)) : 64 * (35 - (j))))
#define SC_DMA(bufi, p0) do { const int tj_ = otid(wv); _Pragma("unroll") for (int i_ = 0; i_ < 2; ++i_) { const int sl_ = i_ * 512 + tj_; \
        { const int row_ = sl_ >> 4, c_ = (sl_ & 15) ^ (row_ & 15); const size_t go_ = (size_t)((p0) + row_) * 1024 + c_ * 8; \
          __builtin_amdgcn_global_load_lds((const unsigned*)(Qu + go_), (LAS unsigned*)(lds + (bufi) * SC_BUF + SC_Q + i_ * 8192 + wave * 1024), 16, 0, 0); \
          __builtin_amdgcn_global_load_lds((const unsigned*)(Ku + go_), (LAS unsigned*)(lds + (bufi) * SC_BUF + SC_K + i_ * 8192 + wave * 1024), 16, 0, 0); } \
        { const int d_ = sl_ >> 3, c_ = (sl_ & 7) ^ ((d_ >> 1) & 7); \
          __builtin_amdgcn_global_load_lds((const unsigned*)(KTu + (size_t)d_ * TB + (p0) + c_ * 8), (LAS unsigned*)(lds + (bufi) * SC_BUF + SC_KT + i_ * 8192 + wave * 1024), 16, 0, 0); } } } while (0)
    for (int item = blockIdx.x; item < 256; item += gridDim.x) {
        const int dir = item & 1, h = (item >> 1) & 7, b = item >> 4, e0 = wave * 32;
        const bf16_t* Qu = Qg + (size_t)b * TB * 1024 + h * 128;
        const bf16_t* Ku = Kg + (size_t)b * TB * 1024 + h * 128;
        const bf16_t* KTu = KVT + ((size_t)b * 3072 + h * 128) * TB;
        const bf16_t* VTu = KVT + ((size_t)b * 3072 + 1024 + h * 256 + e0) * TB;
        bf16_t* Hout = (bf16_t*)(ws + WS_SCR + (dir ? M_HB : M_HF)) + (size_t)b * TB * DM + h * 256 + e0;
        const float big = bg[(dir * 2) * 8 + h], bfg = bg[(dir * 2 + 1) * 8 + h];
        f32x16 cacc[4];
#pragma unroll
        for (int d = 0; d < 4; ++d)
#pragma unroll
            for (int i = 0; i < 16; ++i) cacc[d][i] = 0.f;
        float m = 0.f;
        { const int l0 = otid(wv) & 63; wl[384 + l0] = 0.f; wl[448 + l0] = 0.f; nbp[l0] = 0u; }
        LFENCE();
        SC_DMA(0, SC_POS0(0));
        float ig_n, fg_n;
        { const int l0 = otid(wv) & 63; const float* gp = G32 + (size_t)(b * TB + SC_POS0(0) + (dir ? 63 - l0 : l0)) * 32 + (dir * 2) * 8 + h; ig_n = gp[0]; fg_n = gp[8]; }
        for (int j = 0; j < 36; ++j) {
            const int pos0 = SC_POS0(j);
            const LAS unsigned char* Qb = lds + (j & 1) * SC_BUF + SC_Q; const LAS unsigned char* Kb = lds + (j & 1) * SC_BUF + SC_K; const LAS unsigned char* KTb = lds + (j & 1) * SC_BUF + SC_KT;
            asm volatile("s_waitcnt vmcnt(0)" ::: "memory"); __builtin_amdgcn_s_barrier(); asm volatile("" ::: "memory");
            if (j + 1 < 36) SC_DMA((j + 1) & 1, SC_POS0(j + 1));
            const int lj = otid(wv) & 63, rj = lj & 31, h4 = (lj >> 5) * 4;
            LAS float* wh = wl + h4; LAS float* wr = wl + rj; LAS unsigned char* hb = hst + h4 * 64 + rj * 2;
            const LAS unsigned* nbh = nbp + (h4 >> 1); const LAS unsigned* wbh = wbp + (h4 >> 1);
            const unsigned xr = rj & 15, xd = (rj >> 1) & 7;
            const unsigned qro = (unsigned)rj * 256u + 2u * h4;
            const unsigned kro = (unsigned)rj * 128u + 2u * h4;
            const bf16_t* VTp = VTu + (size_t)rj * TB + pos0 + h4;
            bf16x8 vf[4];
#pragma unroll
            for (int kk = 0; kk < 4; ++kk) vf[kk] = ldperm(VTp + 16 * kk);
            float decay, m_new;
            {
                const int s = dir ? 63 - lj : lj;
                const float ig = ig_n + big, fg = fg_n + bfg;
                if (j + 1 < 36) { const float* gp = G32 + (size_t)(b * TB + SC_POS0(j + 1) + s) * 32 + (dir * 2) * 8 + h; ig_n = gp[0]; fg_n = gp[8]; }
                const float lf = fminf(fg, 0.f) - log1pf(__expf(-fabsf(fg)));
                float bs = lf;
#pragma unroll
                for (int o = 1; o < 64; o <<= 1) { const float t = __shfl_up(bs, o); if (lj >= o) bs += t; }
                const float uu = ig - bs;
                float pmx = uu;
#pragma unroll
                for (int o = 1; o < 64; o <<= 1) { const float t = __shfl_up(pmx, o); if (lj >= o) pmx = fmaxf(pmx, t); }
                pmx = fmaxf(pmx, m);
                const float b_end = __shfl(bs, 63), pm_last = __shfl(pmx, 63);
                LAS float* ws_ = wl + s;
                ws_[0] = uu * 1.4426950408889634f; ws_[64] = pmx * 1.4426950408889634f; ws_[128] = __expf(m - pmx); ws_[192] = __expf(-(bs + pmx)); ws_[256] = __expf(uu - pm_last);
                { const float wv_ = __expf(uu - pm_last), wp_ = __shfl_xor(wv_, 1); if ((s & 1) == 0) wbp[s >> 1] = pk2(wv_, wp_); }
                decay = __expf(m - pm_last); m_new = b_end + pm_last;
            }
            LFENCE();
            const int sbase = dir ? 63 - h4 : h4, sgn = dir ? -1 : 1;
#pragma unroll
            for (int tb = 0; tb < 2; ++tb) {
                __builtin_amdgcn_sched_barrier(0);
                const unsigned qo = qro + tb * 8192u;
                f32x16 ha;
#pragma unroll
                for (int i = 0; i < 16; ++i) ha[i] = 0.f;
                float qnv = 0.f;
#pragma unroll
                for (int kk = 0; kk < 8; ++kk) {
                    const bf16x8 qa = ldsfrag(Qb, qo + (((2u * kk) ^ xr) << 4));
                    ha = MFMA32(qa, pack_step(cacc[kk >> 1], kk & 1), ha);
                    { const u32x2 nb0 = *(const LAS u32x2*)(nbh + 8 * kk), nb1 = *(const LAS u32x2*)(nbh + 8 * kk + 4); const u32x4 qw = __builtin_bit_cast(u32x4, qa);
                      qnv = DOT2(qw.x, nb0.x, qnv); qnv = DOT2(qw.y, nb0.y, qnv); qnv = DOT2(qw.z, nb1.x, qnv); qnv = DOT2(qw.w, nb1.y, qnv); }
                }
                qnv += __shfl_xor(qnv, 32);
#pragma unroll
                for (int g = 0; g < 4; ++g) { const f32x4 av = *(const LAS f32x4*)(wh + 128 + 32 * tb + 8 * g);
#pragma unroll
                    for (int q = 0; q < 4; ++q) ha[4 * g + q] *= av[q]; }
                const float pmt = wr[64 + 32 * tb];
                const int tp = dir ? (63 - 32 * tb) - rj : 32 * tb + rj;
                float ds = 0.f;
#pragma unroll
                for (int sb = 0; sb < 2; ++sb) {
                    __builtin_amdgcn_sched_barrier(0);
                    if (sb != tb && (dir ? sb < tb : sb > tb)) continue;
                    const unsigned ko = qro + sb * 8192u;
                    f32x16 st;
#pragma unroll
                    for (int i = 0; i < 16; ++i) st[i] = 0.f;
#pragma unroll
                    for (int kk = 0; kk < 8; ++kk) { const unsigned c = ((2u * kk) ^ xr) << 4; st = MFMA32(ldsfrag(Kb, ko + c), ldsfrag(Qb, qo + c), st); }
#pragma unroll
                    for (int g = 0; g < 4; ++g) { const f32x4 uv = *(const LAS f32x4*)(wh + 32 * sb + 8 * g);
#pragma unroll
                        for (int q = 0; q < 4; ++q) {
                            const int sc = 32 * sb + q + 8 * g;
                            const int sp = sbase + sgn * sc;
                            st[4 * g + q] *= __builtin_amdgcn_exp2f((sp <= tp) ? uv[q] - pmt : -1e30f);
                            ds += st[4 * g + q];
                        } }
                    ha = MFMA32(pack_step(st, 0), vf[2 * sb], ha);
                    ha = MFMA32(pack_step(st, 1), vf[2 * sb + 1], ha);
                }
                ds += __shfl_xor(ds, 32);
                {
                    const float den = wr[128 + 32 * tb] * qnv + ds;
                    const float rd = 1.0f / fmaxf(fabsf(den), wr[192 + 32 * tb]);
                    if (h4 == 0) wr[320 + 32 * tb] = rd;
                }
                LFENCE();
#pragma unroll
                for (int g = 0; g < 4; ++g) { const f32x4 rv = *(const LAS f32x4*)(wh + 320 + 32 * tb + 8 * g);
#pragma unroll
                    for (int q = 0; q < 4; ++q) { const int tc = 32 * tb + q + 8 * g;
                        *(LAS unsigned short*)(hb + tc * 64) = (unsigned short)(pk2(ha[4 * g + q] * rv[q], 0.f) & 0xffffu); } }
            }
            LFENCE();
            {
                bf16_t* hp = Hout + (size_t)(pos0 + lj) * DM;
                const LAS unsigned char* hrow = hst + lj * 64;
#pragma unroll
                for (int q = 0; q < 4; ++q) *(u32x4*)(hp + 8 * q) = *(const LAS u32x4*)(hrow + 16 * q);
            }
            __builtin_amdgcn_sched_barrier(0);
            bf16x8 vfw[4];
#pragma unroll
            for (int kk = 0; kk < 4; ++kk) {
                const f32x4 w0 = *(const LAS f32x4*)(wh + 256 + 16 * kk), w1 = *(const LAS f32x4*)(wh + 256 + 16 * kk + 8);
                u32x4 p = {pk2(bfs(vf[kk][0]) * w0[0], bfs(vf[kk][1]) * w0[1]), pk2(bfs(vf[kk][2]) * w0[2], bfs(vf[kk][3]) * w0[3]),
                           pk2(bfs(vf[kk][4]) * w1[0], bfs(vf[kk][5]) * w1[1]), pk2(bfs(vf[kk][6]) * w1[2], bfs(vf[kk][7]) * w1[3])};
                vfw[kk] = __builtin_bit_cast(bf16x8, p);
            }
#pragma unroll
            for (int db = 0; db < 4; ++db) {
                if (db == 2) __builtin_amdgcn_sched_barrier(0);
#pragma unroll
                for (int i = 0; i < 16; ++i) cacc[db][i] *= decay;
                const unsigned to = kro + db * 4096u;
                float nadd = 0.f;
#pragma unroll
                for (int kk = 0; kk < 4; ++kk) {
                    const bf16x8 kv = ldsfrag(KTb, to + (((2u * kk) ^ xd) << 4));
                    const u32x2 wq0 = *(const LAS u32x2*)(wbh + 8 * kk), wq1 = *(const LAS u32x2*)(wbh + 8 * kk + 4); const u32x4 kw = __builtin_bit_cast(u32x4, kv);
                    nadd = DOT2(kw.x, wq0.x, nadd); nadd = DOT2(kw.y, wq0.y, nadd); nadd = DOT2(kw.z, wq1.x, nadd); nadd = DOT2(kw.w, wq1.y, nadd);
                    cacc[db] = MFMA32(kv, vfw[kk], cacc[db]);
                }
                nadd += __shfl_xor(nadd, 32);
                const float nnew = decay * wr[384 + 32 * db] + nadd, npart = __shfl_xor(nnew, 1);
                if (h4 == 0) { wr[384 + 32 * db] = nnew; if ((rj & 1) == 0) nbp[(32 * db + rj) >> 1] = pk2(nnew, npart); }
            }
            LFENCE();
            m = m_new;
        }
        asm volatile("s_waitcnt vmcnt(0)" ::: "memory"); __builtin_amdgcn_s_barrier();
    }
#undef SC_DMA
#undef SC_POS0
}
#undef MFMA32
#undef LFENCE
#undef DOT2
}

DI void mlstm_finish_phase(const Args& A, int wv) {
    const int tid = otid(wv), lane = tid & 63, wave = tid >> 6, G = gridDim.x;
    unsigned char* ws = A.ws;
    const bf16_t* HF = (const bf16_t*)(ws + WS_SCR + M_HF); const bf16_t* HB = (const bf16_t*)(ws + WS_SCR + M_HB);
    const bf16_t* SO = (const bf16_t*)(ws + WS_SCR + M_SO); const bf16_t* SZ = (const bf16_t*)(ws + WS_SCR + M_SZ);
    bf16_t* U = (bf16_t*)(ws + WS_H); const float* hn = A.in[11];
    const int sub = lane >> 5, e0 = (lane & 31) * 8;
    const long NIT = (long)NTOK * 8;
    for (long it0 = ((long)blockIdx.x * NWAVES + wave) * 4 + sub; it0 < NIT; it0 += (long)G * NWAVES * 4) {
        f32x4 f0[2], f1[2], b0[2], b1[2], o0[2], o1[2], z0[2], z1[2];
#pragma unroll
        for (int k = 0; k < 2; ++k) { const long it = it0 + 2 * k; const size_t off = (size_t)(it >> 3) * DM + (int)(it & 7) * 256 + e0;
            ld_bf16x8(HF + off, f0[k], f1[k]); ld_bf16x8(HB + off, b0[k], b1[k]); ld_bf16x8(SO + off, o0[k], o1[k]); ld_bf16x8(SZ + off, z0[k], z1[k]); }
#pragma unroll
        for (int k = 0; k < 2; ++k) { const long it = it0 + 2 * k; const size_t off = (size_t)(it >> 3) * DM + (int)(it & 7) * 256 + e0;
            f32x4 y0 = o0[k] * (f0[k] + b0[k]), y1 = o1[k] * (f1[k] + b1[k]);
            float ss = 0.f;
#pragma unroll
            for (int q = 0; q < 4; ++q) ss += y0[q] * y0[q] + y1[q] * y1[q];
            ss += __shfl_xor(ss, 1); ss += __shfl_xor(ss, 2); ss += __shfl_xor(ss, 4); ss += __shfl_xor(ss, 8); ss += __shfl_xor(ss, 16);
            const float rs = 1.0f / sqrtf(ss * (1.f / 256.f) + EPS);
            const float* hp = hn + (int)(it & 7) * 256 + e0;
            const f32x4 h0 = *(const f32x4*)hp, h1 = *(const f32x4*)(hp + 4);
            st_bf16x8(U + off, y0 * rs * h0 * z0[k], y1 * rs * h1 * z1[k]); }
    }
}

DI void mlstm_layer(const Args& A, LAS unsigned char* lds, const XcdBarrier& gbar, int layer, int wv) {
    unsigned char* ws = A.ws;
    const bf16_t* H = (const bf16_t*)(ws + WS_H); bf16_t* U = (bf16_t*)(ws + WS_H);
    bf16_t* Q = (bf16_t*)(ws + WS_SCR + M_Q); bf16_t* Kb = (bf16_t*)(ws + WS_SCR + M_K); bf16_t* KVT = (bf16_t*)(ws + WS_SCR + M_KVT);
    float* G32 = (float*)(ws + WS_SCR + M_G32); bf16_t* SO = (bf16_t*)(ws + WS_SCR + M_SO); bf16_t* SZ = (bf16_t*)(ws + WS_SCR + M_SZ);
    norm_phase(A, layer, false, wv);
    xcd_barrier(gbar, wv);
    {
        DescM1 D; D.init(H, (const bf16_t*)(ws + WS_WMA), (const bf16_t*)(ws + WS_WMB));
        auto E = [=](const pg8::Unit& u, int row_l, int col_l, f32x4 v0, f32x4 v1) {
            if (u.i2 == 0) {
                const size_t row = (size_t)u.i0 * 256 + row_l; const int pn = u.i1;
                if (pn < 4) st_bf16x8(Q + row * 1024 + pn * 256 + col_l, v0 * 0.088388347648318440f, v1 * 0.088388347648318440f);
                else if (pn < 8) { st_bf16x8(Kb + row * 1024 + (pn - 4) * 256 + col_l, v0, v1);
                    const int bb = u.i0 / 9, sp = (u.i0 % 9) * 256 + row_l;
                    bf16_t* kt = KVT + ((size_t)bb * 3072 + (pn - 4) * 256 + col_l) * TB + sp;
                    const unsigned w0 = pk2(v0[0], v0[1]), w1 = pk2(v0[2], v0[3]), w2 = pk2(v1[0], v1[1]), w3 = pk2(v1[2], v1[3]);
                    kt[0] = (bf16_t)(w0 & 0xffffu); kt[TB] = (bf16_t)(w0 >> 16); kt[2 * TB] = (bf16_t)(w1 & 0xffffu); kt[3 * TB] = (bf16_t)(w1 >> 16);
                    kt[4 * TB] = (bf16_t)(w2 & 0xffffu); kt[5 * TB] = (bf16_t)(w2 >> 16); kt[6 * TB] = (bf16_t)(w3 & 0xffffu); kt[7 * TB] = (bf16_t)(w3 >> 16); }
                else if (col_l < 32) { *(f32x4*)(G32 + row * 32 + col_l) = v0; *(f32x4*)(G32 + row * 32 + col_l + 4) = v1; }
            } else {
                const int bb = u.i1 / 9, s0 = (u.i1 % 9) * 256;
                st_bf16x8(KVT + ((size_t)bb * 3072 + 1024 + u.i0 * 256 + row_l) * TB + s0 + col_l, v0, v1);
            }
        };
        pg8::gemm_phase(lds, D, E, wv);
    }
    xcd_barrier(gbar, wv);
    ml::scan_phase(A, lds, wv);
    xcd_barrier(gbar, wv);
    {
        DescPlain D; D.init(H, (const bf16_t*)(ws + WS_WMA) + (size_t)2304 * DM, 16, false);
        auto E = [=](const pg8::Unit& u, int row_l, int col_l, f32x4 v0, f32x4 v1) {
            const size_t row = (size_t)u.i0 * 256 + row_l; const int pn = u.i1; f32x4 a, b;
            if (pn < 8) {
#pragma unroll
                for (int q = 0; q < 4; ++q) { a[q] = sigmf(v0[q]); b[q] = sigmf(v1[q]); }
                st_bf16x8(SO + row * DM + pn * 256 + col_l, a, b);
            } else {
#pragma unroll
                for (int q = 0; q < 4; ++q) { a[q] = siluf(v0[q]); b[q] = siluf(v1[q]); }
                st_bf16x8(SZ + row * DM + (pn - 8) * 256 + col_l, a, b);
            }
        };
        pg8::gemm_phase(lds, D, E, wv);
    }
    xcd_barrier(gbar, wv);
    mlstm_finish_phase(A, wv);
    xcd_barrier(gbar, wv);
    {
        DescPlain D; D.init(U, (const bf16_t*)(ws + WS_WMO), 8, false);
        const float* modl = (const float*)(ws + WS_MOD) + (size_t)layer * 17 * MOD_LD;
        auto E = [=](const pg8::Unit& u, int row_l, int col_l, f32x4 v0, f32x4 v1) { resid_store(A, layer, u.i0, row_l, u.i1 * 256 + col_l, modl, v0, v1); };
        pg8::gemm_phase(lds, D, E, wv);
    }
    xcd_barrier(gbar, wv);
}

__global__ void __launch_bounds__(NTHREADS, 2) fwd_megakernel(Args A) {
    extern __shared__ __attribute__((aligned(16))) unsigned char lds_raw[];
    LAS unsigned char* lds = (LAS unsigned char*)lds_raw;
    cg::grid_group grid = cg::this_grid();
    const int wv = __builtin_amdgcn_readfirstlane(threadIdx.x >> 6);
    volatile LAS unsigned* bst = (volatile LAS unsigned*)(lds + 152576);
    if (otid(wv) < 2) bst[otid(wv)] = 0u;
    __syncthreads();
    const XcdBarrier gbar = xcd_barrier_post((unsigned*)(A.ws + WS_BAR), bst, wv);
    prep_phase(A, lds, wv);
    grid.sync();
    {
        const long long* mi = (const long long*)(A.ws + WS_MODI); float* mf = (float*)(A.ws + WS_MOD);
        for (int i = blockIdx.x * NTHREADS + otid(wv); i < 4 * 17 * MOD_LD; i += gridDim.x * NTHREADS) mf[i] = (float)mi[i] * MODI_INV;
    }
    xcd_barrier(gbar, wv);
    fnet_layer(A, lds, gbar, 0, 0, false, wv);
    mlstm_layer(A, lds, gbar, 1, wv);
    attn_layer(A, lds, (char*)lds_raw, gbar, 2, wv);
    fnet_layer(A, lds, gbar, 3, 1, true, wv);
    final_norm_phase(A, (const bf16_t*)(A.ws + WS_SCR + F_PQX), wv);
}

extern "C" void kernel_launch(void* const* d_in, const int* in_sizes, int n_in, void* d_out, int out_size, void* d_ws, size_t ws_size, hipStream_t stream) {
    static int grid = 0;
    if (grid == 0) {
        if (n_in != 18 || ws_size < WS_END) { fprintf(stderr, "kernel_launch: unexpected n_in %d / ws_size %zu (need %zu)\n", n_in, ws_size, (size_t)WS_END); grid = -1; return; }
        int dev = 0, cus = 0, per_cu = 0;
        hipGetDevice(&dev);
        hipDeviceGetAttribute(&cus, hipDeviceAttributeMultiprocessorCount, dev);
        if (hipFuncSetAttribute((const void*)fwd_megakernel, hipFuncAttributeMaxDynamicSharedMemorySize, LDS_BYTES) != hipSuccess) { fprintf(stderr, "kernel_launch: hipFuncSetAttribute failed\n"); grid = -1; return; }
        if (hipOccupancyMaxActiveBlocksPerMultiprocessor(&per_cu, (const void*)fwd_megakernel, NTHREADS, LDS_BYTES) != hipSuccess || per_cu < 1) { fprintf(stderr, "kernel_launch: occupancy query failed (%d)\n", per_cu); per_cu = 1; }
        (void)hipGetLastError();
        grid = cus * per_cu;
        fprintf(stderr, "kernel_launch: grid %d (cus %d x %d)\n", grid, cus, per_cu);
    }
    if (grid < 0) return;
    (void)hipMemsetAsync((char*)d_ws + WS_MOD, 0, ZERO_BYTES, stream);
    (void)hipMemsetAsync((char*)d_ws + WS_MODI, 0, MODI_BYTES, stream);
    Args a{};
    for (int i = 0; i < 18; ++i) a.in[i] = (const float*)d_in[i];
    a.out = (float*)d_out; a.ws = (unsigned char*)d_ws; a.ph_lo = 0; a.ph_hi = 100;
    void* args[] = {&a};
    hipError_t e = hipLaunchCooperativeKernel((const void*)fwd_megakernel, dim3(grid), dim3(NTHREADS), args, LDS_BYTES, stream);
    if (e != hipSuccess) fprintf(stderr, "kernel_launch: cooperative launch failed: %s (grid %d)\n", hipGetErrorString(e), grid);
}
```

```cpp
#include <hip/hip_runtime.h>
#include <hip/hip_cooperative_groups.h>
#include <cstdio>
#include <cstdint>
namespace cg = cooperative_groups;

#define LAS __attribute__((address_space(3)))
#define DI __device__ __forceinline__
typedef unsigned short bf16_t;
typedef short bf16x8 __attribute__((ext_vector_type(8)));
typedef short s16x4 __attribute__((ext_vector_type(4)));
typedef float f32x2 __attribute__((ext_vector_type(2)));
typedef float f32x4 __attribute__((ext_vector_type(4)));
typedef float f32x16 __attribute__((ext_vector_type(16)));
typedef unsigned u32x2 __attribute__((ext_vector_type(2)));
typedef unsigned u32x4 __attribute__((ext_vector_type(4)));
typedef __bf16 bf16v2 __attribute__((ext_vector_type(2)));

constexpr int DM = 2048, NB = 16, TL = 2048, TC = 256, TB = TL + TC, NTOK = NB * TB;
constexpr int NWAVES = 8, NTHREADS = 512;
constexpr float EPS = 1e-6f;
constexpr int MOD_LD = 3 * DM;
constexpr int M_WA_ROWS = 6400, M_WB_ROWS = 3072;
constexpr size_t MiB = 1u << 20;
constexpr size_t WS_SCR_ = 301 * MiB;
constexpr size_t WS_MOD = 0;
constexpr size_t MOD_BYTES = (size_t)4 * 17 * MOD_LD * 4;
constexpr size_t WS_BAR = 1792 * 1024, ZERO_BYTES = 2 * MiB;
constexpr size_t WS_MODI = WS_SCR_ + 700 * MiB, MODI_BYTES = (size_t)4 * 17 * MOD_LD * 8;
constexpr float MODI_SCALE = 1073741824.f, MODI_INV = 9.313225746154785e-10f;
constexpr size_t WS_WFG = 2 * MiB, WS_WFO = 18 * MiB, WS_WMA = 34 * MiB, WS_WMB = 59 * MiB, WS_WMO = 71 * MiB, WS_WAI = 79 * MiB, WS_WAO = 99 * MiB;
constexpr size_t WS_DC = 107 * MiB, WS_DT = 108 * MiB, WS_DT2 = 124 * MiB, WS_CTXS = 125 * MiB, WS_H = 157 * MiB, WS_SCR = 301 * MiB;
constexpr size_t WS_END = 1024 * MiB;
constexpr size_t F_G = 0, F_PQX = 144 * MiB, F_PQC = 400 * MiB, F_A1 = 432 * MiB;
constexpr size_t M_Q = 0, M_K = 72 * MiB, M_KVT = 144 * MiB, M_G32 = 360 * MiB, M_HF = 365 * MiB, M_HB = 509 * MiB, M_SO = 0, M_SZ = 144 * MiB;
constexpr size_t A_Q = 0, A_K = 144 * MiB, A_V = 180 * MiB, A_SZ = 216 * MiB;
static_assert(WS_SCR + M_HB + 144 * MiB <= WS_END, "ws map");
constexpr int LDS_BYTES = 152576 + 1024;

DI unsigned pk2(float a, float b) { f32x2 v = {a, b}; return __builtin_bit_cast(unsigned, __builtin_convertvector(v, bf16v2)); }
DI float bf_lo(unsigned w) { return __uint_as_float(w << 16); }
DI float bf_hi(unsigned w) { return __uint_as_float(w & 0xffff0000u); }
DI float wave_sum(float v) {
#pragma unroll
    for (int o = 1; o < 64; o <<= 1) v += __shfl_xor(v, o);
    return v;
}
DI int otid(int wv) { int t; asm volatile("v_mbcnt_lo_u32_b32 %0, -1, 0\n\tv_mbcnt_hi_u32_b32 %0, -1, %0" : "=v"(t)); return wv * 64 + t; }
DI float siluf(float x) { return x / (1.f + __expf(-x)); }
DI float sigmf(float x) { return 1.f / (1.f + __expf(-x)); }
DI void st_bf16x8(bf16_t* p, f32x4 a, f32x4 b) { u32x4 w = {pk2(a[0], a[1]), pk2(a[2], a[3]), pk2(b[0], b[1]), pk2(b[2], b[3])}; *(u32x4*)p = w; }
DI void ld_bf16x8(const bf16_t* p, f32x4& a, f32x4& b) { const u32x4 w = *(const u32x4*)p; a = (f32x4){bf_lo(w.x), bf_hi(w.x), bf_lo(w.y), bf_hi(w.y)}; b = (f32x4){bf_lo(w.z), bf_hi(w.z), bf_lo(w.w), bf_hi(w.w)}; }

DI f32x4 ldmod4(const long long* p) { return (f32x4){(float)p[0] * MODI_INV, (float)p[1] * MODI_INV, (float)p[2] * MODI_INV, (float)p[3] * MODI_INV}; }

struct Args { const float* in[18]; float* out; unsigned char* ws; int ph_lo, ph_hi; };

#define XB_TMO      128
#define XB_XCNT(j)  (256  + 64 * (j))
#define XB_XSUB(j)  (1280 + 64 * (j))
#define XB_XGEN(j)  (2304 + 64 * (j))
#define XB_TOP      3328
#define XB_TOPGEN   3392
#define XCD_BAR_WORDS 3456
#define XB_SPIN_CAP (1u << 18)

__device__ __forceinline__ unsigned xb_ld(unsigned* p)              { return __hip_atomic_load(p, __ATOMIC_RELAXED, __HIP_MEMORY_SCOPE_AGENT); }
__device__ __forceinline__ unsigned xb_add(unsigned* p, unsigned v) { return __hip_atomic_fetch_add(p, v, __ATOMIC_RELAXED, __HIP_MEMORY_SCOPE_AGENT); }
__device__ __forceinline__ unsigned xb_xcc_id() { return (unsigned)__builtin_amdgcn_s_getreg((3 << 11) | 20) & 0xFu; }
#define XB_SPIN(cond, bar) do { unsigned _sp = 0; while (cond) { __builtin_amdgcn_s_sleep(1); \
    if ((++_sp & 255u) == 0u) { if (xb_ld(&(bar)[XB_TMO])) break; if (_sp > XB_SPIN_CAP) { atomicAdd(&(bar)[XB_TMO], 1u); break; } } } } while (0)

struct XcdBarrier {
    unsigned* bar; unsigned x;
    volatile LAS unsigned* st;
};

__device__ __forceinline__ XcdBarrier xcd_barrier_post(unsigned* bar, volatile LAS unsigned* st, int wv) {
    XcdBarrier b; b.bar = bar; b.x = xb_xcc_id(); b.st = st;
    if (otid(wv) == 0) (void)xb_add(&bar[XB_XCNT(b.x)], 1u);
    return b;
}
__device__ __forceinline__ void xcd_barrier_complete(unsigned* bar, unsigned x, unsigned& nloc, unsigned& nx) {
    const unsigned G = gridDim.x * gridDim.y * gridDim.z;
    unsigned sum, cnt, mine, sp = 0u;
    for (;;) {
        sum = 0u; cnt = 0u; mine = 0u;
#pragma unroll
        for (unsigned j = 0; j < 16; ++j) { const unsigned c = xb_ld(&bar[XB_XCNT(j)]); sum += c; cnt += (c > 0u) ? 1u : 0u; mine = (j == x) ? c : mine; }
        if (sum == G) break;
        __builtin_amdgcn_s_sleep(1);
        if ((++sp & 255u) == 0u) { if (xb_ld(&bar[XB_TMO])) break; if (sp > XB_SPIN_CAP) { atomicAdd(&bar[XB_TMO], 1u); break; } }
    }
    nloc = mine > 0u ? mine : 1u; nx = cnt > 0u ? cnt : 1u;
}

__device__ __forceinline__ void xcd_barrier(const XcdBarrier& b, int wv) {
    asm volatile("s_waitcnt vmcnt(0)" ::: "memory");
    __syncthreads();
    if (otid(wv) == 0) {
        unsigned* bar = b.bar;
        __builtin_amdgcn_s_waitcnt(0);
        unsigned nloc = b.st[0], nx = b.st[1];
        if (nloc == 0u) { xcd_barrier_complete(bar, b.x, nloc, nx); b.st[0] = nloc; b.st[1] = nx; }
        const unsigned old = xb_add(&bar[XB_XSUB(b.x)], 1u);
        const unsigned gen = old / nloc;
        if (old + 1u == (gen + 1u) * nloc) {
            __builtin_amdgcn_fence(__ATOMIC_RELEASE, "agent");
            asm volatile("s_waitcnt vmcnt(0)" ::: "memory");
            const unsigned og = xb_add(&bar[XB_TOP], 1u);
            const unsigned tg = og / nx;
            if (og + 1u == (tg + 1u) * nx) xb_add(&bar[XB_TOPGEN], 1u);
            else XB_SPIN(xb_ld(&bar[XB_TOPGEN]) == tg, bar);
            __builtin_amdgcn_fence(__ATOMIC_ACQUIRE, "agent");
            xb_add(&bar[XB_XGEN(b.x)], 1u);
            asm volatile("s_waitcnt vmcnt(0)" ::: "memory");
        } else {
            XB_SPIN(xb_ld(&bar[XB_XGEN(b.x)]) == gen, bar);
            __builtin_amdgcn_fence(__ATOMIC_ACQUIRE, "agent");
            asm volatile("s_waitcnt vmcnt(0)" ::: "memory");
        }
    }
    __syncthreads();
}


namespace pg8 {
constexpr int BM = 256, BK = 64, HALF = 128, HTB = HALF * BK * 2, NXCD = 8;
DI int lds_byte(int r, int c) { const int st = (r >> 4) * 2 + (c >> 5), rr = r & 15, cc = c & 31, ob = rr * 64 + cc * 2; return st * 1024 + (ob ^ (((ob >> 9) & 1) << 5)); }
DI void stage_rc(int b, int& R, int& C) { const int st = b / 1024, sb = b % 1024, swz = sb ^ (((sb >> 9) & 1) << 5); R = (st >> 1) * 16 + swz / 64; C = (st & 1) * 32 + (swz % 64) / 2; }
DI int perm32(int rho) { const int n = rho >> 4, i = rho & 15; return 8 * (i >> 2) + 4 * n + (i & 3); }
struct Unit { const char* a; const char* b; int i0, i1, i2; };
DI int xcd_remap(int L, int total) { const int q = total / NXCD, r = total % NXCD, xcd = L % NXCD, off = L / NXCD; return (xcd < r ? xcd * (q + 1) : r * (q + 1) + (xcd - r) * q) + off; }

template <class Desc, class Epi>
DI void gemm_phase(LAS unsigned char* lds, const Desc& D, const Epi& E, int wv) {
    const int tid = otid(wv), wid = __builtin_amdgcn_readfirstlane(tid >> 6), lane = tid & 63, wr = wid >> 2, wc = wid & 3, fr = lane & 15, fq = lane >> 4;
    const int G = gridDim.x, c = blockIdx.x, total = D.total;
    const int K = D.K, nt = K / BK;
    unsigned voffA[2], voffB[2];
#pragma unroll
    for (int i = 0; i < 2; ++i) { int R, C; stage_rc(tid * 16 + i * 8192, R, C); const int Rb = (R & ~31) + perm32(R & 31);
        voffA[i] = (unsigned)(R * D.lda + C) * 2u; voffB[i] = (unsigned)(Rb * D.ldb + C) * 2u; }
    const size_t kstep = (size_t)(BK * 2);
    const size_t hstepA = (size_t)HALF * D.lda * 2, hstepB = (size_t)HALF * D.ldb * 2;
    const unsigned ldsw = (unsigned)wid * 1024u;
    const int aoff = lds_byte(wr * 64 + fr, fq * 8), boff = lds_byte(wc * 32 + fr, fq * 8);
#define PG8_SA(b, h) (((b) * 2 + (h)) * HTB)
#define PG8_SB(b, h) ((4 + (b) * 2 + (h)) * HTB)
#define PG8_STAGE(bufoff, gbase, voff) do { _Pragma("unroll") for (int _i = 0; _i < 2; ++_i) \
        __builtin_amdgcn_global_load_lds((const unsigned*)((const char*)(gbase) + (voff)[_i]), (LAS unsigned*)(lds + (bufoff) + ldsw + _i * 8192), 16, 0, 0); } while (0)
#define PG8_LDA(dst, b, h) do { _Pragma("unroll") for (int m = 0; m < 4; ++m) _Pragma("unroll") for (int k = 0; k < 2; ++k) dst[m][k] = *(const LAS bf16x8*)(lds + PG8_SA(b, h) + aoff + m * 2048 + k * 1024); } while (0)
#define PG8_LDB(dst, b, h) do { _Pragma("unroll") for (int n = 0; n < 2; ++n) _Pragma("unroll") for (int k = 0; k < 2; ++k) dst[n][k] = *(const LAS bf16x8*)(lds + PG8_SB(b, h) + boff + n * 2048 + k * 1024); } while (0)
#define PG8_MMA(ai, bj, At, Bt) do { __builtin_amdgcn_s_setprio(1); _Pragma("unroll") for (int m = 0; m < 4; ++m) _Pragma("unroll") for (int n = 0; n < 2; ++n) _Pragma("unroll") for (int k = 0; k < 2; ++k) \
        acc[ai][bj][m][n] = __builtin_amdgcn_mfma_f32_16x16x32_bf16(Bt[n][k], At[m][k], acc[ai][bj][m][n], 0, 0, 0); __builtin_amdgcn_s_setprio(0); } while (0)
#define PG8_WAIT_V(n) asm volatile("s_waitcnt vmcnt(" #n ")" ::: "memory")
#define PG8_WAIT_L(n) asm volatile("s_waitcnt lgkmcnt(" #n ")" ::: "memory")
#define PG8_BAR __builtin_amdgcn_s_barrier()
#define PG8_SCHED __builtin_amdgcn_sched_barrier(0)
    if constexpr (Desc::RAW) { if (!D.valid(c, G)) return; } else { if (c >= total) return; }
    Unit cur, nxt; int ui = 0;
    if constexpr (Desc::RAW) cur = D.unit(c, G); else cur = D.unit(xcd_remap(c, total));
    nxt = cur;
    f32x4 acc[2][2][4][2];
#pragma unroll
    for (int a = 0; a < 2; ++a)
#pragma unroll
        for (int b = 0; b < 2; ++b)
#pragma unroll
            for (int m = 0; m < 4; ++m)
#pragma unroll
                for (int n = 0; n < 2; ++n) acc[a][b][m][n] = (f32x4){0.f, 0.f, 0.f, 0.f};
    bf16x8 At[4][2], B0[2][2], B1[2][2];
    const char* cA = cur.a; const char* cB = cur.b;
    PG8_STAGE(PG8_SB(0, 0), cB, voffB); PG8_STAGE(PG8_SB(0, 1), cB + hstepB, voffB); PG8_STAGE(PG8_SA(0, 0), cA, voffA); PG8_STAGE(PG8_SA(0, 1), cA + hstepA, voffA);
    if (wr == 1) PG8_BAR;
    PG8_WAIT_V(2); PG8_BAR;
    PG8_STAGE(PG8_SB(1, 0), cB + kstep, voffB); PG8_STAGE(PG8_SA(1, 0), cA + kstep, voffA); PG8_STAGE(PG8_SB(1, 1), cB + hstepB + kstep, voffB);
    PG8_WAIT_V(6); PG8_BAR;
    for (;;) {
        const long Ln = (long)(ui + 1) * G + c;
        bool has_next;
        if constexpr (Desc::RAW) { has_next = D.valid((int)Ln, G); if (has_next) nxt = D.unit((int)Ln, G); }
        else { has_next = Ln < total; if (has_next) nxt = D.unit(xcd_remap((int)Ln, total)); }
        const char* nA = has_next ? nxt.a : cA; const char* nB = has_next ? nxt.b : cB;
        for (int t = 0; t < nt; t += 2) {
            const bool last = (t == nt - 2);
            const char* a1 = cA + (size_t)(t + 1) * kstep;
            const char* a2 = last ? nA : cA + (size_t)(t + 2) * kstep; const char* b2 = last ? nB : cB + (size_t)(t + 2) * kstep;
            const char* a3 = a2 + kstep; const char* b3 = b2 + kstep;
            PG8_LDB(B0, 0, 0); PG8_LDB(B1, 0, 1); PG8_SCHED; PG8_LDA(At, 0, 0); PG8_STAGE(PG8_SA(1, 1), a1 + hstepA, voffA);
            PG8_WAIT_V(8); PG8_WAIT_L(0); PG8_BAR; PG8_MMA(0, 0, At, B0); PG8_MMA(0, 1, At, B1); PG8_BAR; PG8_SCHED;
            PG8_LDA(At, 0, 1); PG8_STAGE(PG8_SB(0, 0), b2, voffB); PG8_STAGE(PG8_SB(0, 1), b2 + hstepB, voffB); PG8_STAGE(PG8_SA(0, 0), a2, voffA);
            PG8_WAIT_V(8); PG8_WAIT_L(0); PG8_BAR; PG8_MMA(1, 0, At, B0); PG8_MMA(1, 1, At, B1); PG8_BAR; PG8_SCHED;
            PG8_LDB(B0, 1, 0); PG8_LDB(B1, 1, 1); PG8_SCHED; PG8_LDA(At, 1, 0); PG8_STAGE(PG8_SA(0, 1), a2 + hstepA, voffA);
            PG8_WAIT_V(8); PG8_WAIT_L(0); PG8_BAR; PG8_MMA(0, 0, At, B0); PG8_MMA(0, 1, At, B1); PG8_BAR; PG8_SCHED;
            PG8_LDA(At, 1, 1); PG8_STAGE(PG8_SB(1, 0), b3, voffB); PG8_STAGE(PG8_SB(1, 1), b3 + hstepB, voffB); PG8_STAGE(PG8_SA(1, 0), a3, voffA);
            PG8_WAIT_V(8); PG8_WAIT_L(0); PG8_BAR; PG8_MMA(1, 0, At, B0); PG8_MMA(1, 1, At, B1); PG8_BAR; PG8_SCHED;
        }
        if (wr == 0) PG8_BAR;
        {
            const int le = otid(wv) & 63, fre = le & 15, fqe = le >> 4;
#pragma unroll
            for (int ai = 0; ai < 2; ++ai)
#pragma unroll
                for (int m = 0; m < 4; ++m)
#pragma unroll
                    for (int bj = 0; bj < 2; ++bj)
                        E(cur, ai * HALF + wr * 64 + m * 16 + fre, bj * HALF + wc * 32 + 8 * fqe, acc[ai][bj][m][0], acc[ai][bj][m][1]);
        }
        if (!has_next) break;
#pragma unroll
        for (int a = 0; a < 2; ++a)
#pragma unroll
            for (int b = 0; b < 2; ++b)
#pragma unroll
                for (int m = 0; m < 4; ++m)
#pragma unroll
                    for (int n = 0; n < 2; ++n) acc[a][b][m][n] = (f32x4){0.f, 0.f, 0.f, 0.f};
        cur = nxt; cA = nA; cB = nB; ++ui;
        if (wr == 1) PG8_BAR;
    }
    PG8_WAIT_V(0);
    PG8_BAR;
#undef PG8_SA
#undef PG8_SB
#undef PG8_STAGE
#undef PG8_LDA
#undef PG8_LDB
#undef PG8_MMA
#undef PG8_WAIT_V
#undef PG8_WAIT_L
#undef PG8_BAR
#undef PG8_SCHED
}
}

DI void transpose_item(const float* W, int N, int kb, int nb, bf16_t* d0, bf16_t* d1, int K, LAS float* scr, int lane) {
    const int k0 = 64 * kb, n0 = 32 * nb;
#pragma unroll 8
    for (int i = 0; i < 32; ++i) { const int kk = 2 * i + (lane >> 5); scr[kk * 33 + (lane & 31)] = W[(size_t)(k0 + kk) * N + n0 + (lane & 31)]; }
    asm volatile("s_waitcnt lgkmcnt(0)" ::: "memory");
    const int c = lane & 7;
#pragma unroll
    for (int j = 0; j < 4; ++j) { const int n = (lane >> 3) + 8 * j; const LAS float* s = scr + (8 * c) * 33 + n;
        u32x4 o; o.x = pk2(s[0 * 33], s[1 * 33]); o.y = pk2(s[2 * 33], s[3 * 33]); o.z = pk2(s[4 * 33], s[5 * 33]); o.w = pk2(s[6 * 33], s[7 * 33]);
        *(u32x4*)(d0 + (size_t)n * K + k0 + 8 * c) = o;
        if (d1) *(u32x4*)(d1 + (size_t)n * K + k0 + 8 * c) = o; }
    asm volatile("s_waitcnt lgkmcnt(0)" ::: "memory");
}

DI void prep_phase(const Args& A, LAS unsigned char* lds, int wv) {
    const int tid = otid(wv), lane = tid & 63, wave = tid >> 6, G = gridDim.x;
    unsigned char* ws = A.ws;
    {
        LAS float* s_lds = (LAS float*)lds;
        const float* cc = A.in[1]; const float* cctx = A.in[3]; const float* aw = A.in[4]; const float* ab = A.in[5];
        long long* modi = (long long*)(ws + WS_MODI);
        for (int item = blockIdx.x; item < 768; item += G) {
            const int kc = item % 16, cb = (item / 16) % 12, l = item / 192;
            const int k0 = kc * 128, j = cb * 512 + tid;
            __syncthreads();
            for (int e = tid; e < 17 * 128; e += NTHREADS) { const int r = e / 128, k = e % 128; const float v = r < 16 ? cc[r * DM + k0 + k] : cctx[k0 + k]; s_lds[k * 20 + r] = siluf(v); }
            __syncthreads();
            float acc[17];
#pragma unroll
            for (int r = 0; r < 17; ++r) acc[r] = 0.f;
            const float* wp = aw + ((size_t)l * DM + k0) * MOD_LD + j;
#pragma unroll 4
            for (int k = 0; k < 128; ++k) {
                const float w = wp[(size_t)k * MOD_LD];
                const LAS f32x4* sp = (const LAS f32x4*)(s_lds + k * 20);
                const f32x4 s0 = sp[0], s1 = sp[1], s2 = sp[2], s3 = sp[3]; const float s4 = s_lds[k * 20 + 16];
#pragma unroll
                for (int q = 0; q < 4; ++q) { acc[q] += s0[q] * w; acc[4 + q] += s1[q] * w; acc[8 + q] += s2[q] * w; acc[12 + q] += s3[q] * w; }
                acc[16] += s4 * w;
            }
            const float bias = (kc == 0) ? ab[l * MOD_LD + j] : 0.f;
#pragma unroll
            for (int r = 0; r < 17; ++r) atomicAdd((unsigned long long*)&modi[(size_t)(l * 17 + r) * MOD_LD + j], (unsigned long long)__float2ll_rn((acc[r] + bias) * MODI_SCALE));
        }
        __syncthreads();
    }
    {
        LAS float* scr = (LAS float*)(lds + wave * 16384);
        const int gw = blockIdx.x * NWAVES + wave, NGW = G * NWAVES;
        constexpr int I_SQ = 32 * 64, I_AI = 32 * 160, I_MI = 32 * 257;
        constexpr int NIT = 6 * I_SQ + I_AI + I_MI;
        for (int it = gw; it < NIT; it += NGW) {
            int r = it;
            if (r < 6 * I_SQ) {
                const int w = r / I_SQ; r -= w * I_SQ;
                const float* src; bf16_t* dst;
                if (w < 2)      { src = A.in[7] + (size_t)w * DM * DM;       dst = (bf16_t*)(ws + WS_WFG) + (size_t)w * DM * DM; }
                else if (w < 4) { src = A.in[8] + (size_t)(w - 2) * DM * DM; dst = (bf16_t*)(ws + WS_WFO) + (size_t)(w - 2) * DM * DM; }
                else if (w == 4) { src = A.in[12]; dst = (bf16_t*)(ws + WS_WMO); }
                else             { src = A.in[16]; dst = (bf16_t*)(ws + WS_WAO); }
                const int kb = r / 64, nb = r % 64;
                transpose_item(src, DM, kb, nb, dst + (size_t)(32 * nb) * DM, nullptr, DM, scr, lane);
                continue;
            }
            r -= 6 * I_SQ;
            if (r < I_AI) { const int kb = r / 160, nb = r % 160; transpose_item(A.in[13], 5120, kb, nb, (bf16_t*)(ws + WS_WAI) + (size_t)(32 * nb) * DM, nullptr, DM, scr, lane); continue; }
            r -= I_AI;
            {
                const int kb = r / 257, nb = r % 257, n0 = 32 * nb;
                bf16_t* WA = (bf16_t*)(ws + WS_WMA); bf16_t* WB = (bf16_t*)(ws + WS_WMB);
                bf16_t* d0; bf16_t* d1 = nullptr;
                if (n0 < 1024) d0 = WA + (size_t)n0 * DM;
                else if (n0 < 2048) d0 = WA + (size_t)n0 * DM;
                else if (n0 < 4096) d0 = WB + (size_t)(n0 - 2048) * DM;
                else if (n0 < 6144) d0 = WA + (size_t)(2304 + n0 - 4096) * DM;
                else if (n0 < 6176) d0 = WA + (size_t)(2048 + n0 - 6144) * DM;
                else d0 = WA + (size_t)(4352 + n0 - 6176) * DM;
                transpose_item(A.in[9], 8224, kb, nb, d0, d1, DM, scr, lane);
            }
        }
    }
    {
        const long gt = (long)blockIdx.x * NTHREADS + tid, NGT = (long)G * NTHREADS;
        constexpr long N_DC = 1024L * 512 / 8, N_DT = 2048L * 4096 / 8, N_DT2 = 256L * 512 / 8;
        for (long it = gt; it < N_DC + N_DT + N_DT2; it += NGT) {
            float v[8]; bf16_t* dst;
            if (it < N_DC) {
                const int m = (int)(it / 64), k0 = (int)(it % 64) * 8; const float sc = 0.044194173824159216f;
#pragma unroll
                for (int j = 0; j < 8; ++j) { const int rr = ((m & 511) * (k0 + j)) & 511; const float ang = (float)rr * (1.f / 256.f); v[j] = (m < 512 ? cospif(ang) : sinpif(ang)) * sc; }
                dst = (bf16_t*)(ws + WS_DC) + (size_t)m * 512 + k0;
            } else if (it < N_DC + N_DT) {
                const long i2 = it - N_DC; const int kk = (int)(i2 / 512), s0 = (int)(i2 % 512) * 8; const float sc = 0.022097086912079608f;
#pragma unroll
                for (int j = 0; j < 8; ++j) { const int s = s0 + j; const int rr = (kk * (s & 2047)) & 2047; const float ang = (float)rr * (1.f / 1024.f); v[j] = (s < 2048 ? cospif(ang) : -sinpif(ang)) * sc; }
                dst = (bf16_t*)(ws + WS_DT) + (size_t)kk * 4096 + s0;
            } else {
                const long i2 = it - N_DC - N_DT; const int kk = (int)(i2 / 64), s0 = (int)(i2 % 64) * 8; const float sc = 0.0625f;
#pragma unroll
                for (int j = 0; j < 8; ++j) { const int s = s0 + j; const int rr = (kk * (s & 255)) & 255; const float ang = (float)rr * (1.f / 128.f); v[j] = (s < 256 ? cospif(ang) : -sinpif(ang)) * sc; }
                dst = (bf16_t*)(ws + WS_DT2) + (size_t)kk * 512 + s0;
            }
            u32x4 o = {pk2(v[0], v[1]), pk2(v[2], v[3]), pk2(v[4], v[5]), pk2(v[6], v[7])};
            *(u32x4*)dst = o;
        }
    }
}

DI const float* xrow_in(const Args& A, int r) {
    const int b = r / TB, t = r % TB;
    if (t < TL) return A.in[0] + ((size_t)b * TL + t) * DM;
    return A.in[2] + ((size_t)b * TC + (t - TL)) * DM;
}
DI void norm_phase(const Args& A, int layer, bool latonly, int wv) {
    const int tid = otid(wv), lane = tid & 63, wave = tid >> 6, G = gridDim.x;
    const float* ng = A.in[6] + (size_t)layer * DM;
    const float* mod = (const float*)(A.ws + WS_MOD) + (size_t)layer * 17 * MOD_LD;
    bf16_t* H = (bf16_t*)(A.ws + WS_H);
    const bf16_t* XB = (const bf16_t*)A.out;
    for (int r0 = (blockIdx.x * NWAVES + wave) * 2; r0 < NTOK; r0 += G * NWAVES * 2) {
        const int b = r0 / TB, t = r0 % TB;
        if (latonly && t >= TL) continue;
        const float* mr = mod + (size_t)(t < TL ? b : 16) * MOD_LD;
        f32x4 v[2][4][2];
#pragma unroll
        for (int k = 0; k < 2; ++k) {
            const int r = r0 + k;
            if (layer == 0) {
                const float* xr = xrow_in(A, r);
#pragma unroll
                for (int j = 0; j < 4; ++j) { const f32x4* p = (const f32x4*)(xr + 512 * j + 8 * lane); v[k][j][0] = p[0]; v[k][j][1] = p[1]; }
            } else {
#pragma unroll
                for (int j = 0; j < 4; ++j) ld_bf16x8(XB + (size_t)r * DM + 512 * j + 8 * lane, v[k][j][0], v[k][j][1]);
            }
        }
#pragma unroll
        for (int k = 0; k < 2; ++k) {
            const int r = r0 + k; float ss = 0.f;
#pragma unroll
            for (int j = 0; j < 4; ++j)
#pragma unroll
                for (int q = 0; q < 4; ++q) ss += v[k][j][0][q] * v[k][j][0][q] + v[k][j][1][q] * v[k][j][1][q];
            const float rs = 1.0f / sqrtf(wave_sum(ss) * (1.f / DM) + EPS);
#pragma unroll
            for (int j = 0; j < 4; ++j) { const int c0 = 512 * j + 8 * lane; f32x4 o[2];
#pragma unroll
                for (int h = 0; h < 2; ++h) { const f32x4 g4 = *(const f32x4*)(ng + c0 + 4 * h), sh = *(const f32x4*)(mr + c0 + 4 * h), sc = *(const f32x4*)(mr + DM + c0 + 4 * h);
                    o[h] = (v[k][j][h] * rs) * g4 * (sc + 1.0f) + sh; }
                st_bf16x8(H + (size_t)r * DM + c0, o[0], o[1]); }
        }
    }
}
DI void final_norm_phase(const Args& A, const bf16_t* src, int wv) {
    const int tid = otid(wv), lane = tid & 63, wave = tid >> 6, G = gridDim.x;
    const float* fg = A.in[17];
    for (int r0 = (blockIdx.x * NWAVES + wave) * 2; r0 < NB * TL; r0 += G * NWAVES * 2) {
        f32x4 v[2][4][2];
#pragma unroll
        for (int k = 0; k < 2; ++k)
#pragma unroll
            for (int j = 0; j < 4; ++j) ld_bf16x8(src + (size_t)(r0 + k) * DM + 512 * j + 8 * lane, v[k][j][0], v[k][j][1]);
#pragma unroll
        for (int k = 0; k < 2; ++k) { float* orow = A.out + (size_t)(r0 + k) * DM; float ss = 0.f;
#pragma unroll
            for (int j = 0; j < 4; ++j)
#pragma unroll
                for (int q = 0; q < 4; ++q) ss += v[k][j][0][q] * v[k][j][0][q] + v[k][j][1][q] * v[k][j][1][q];
            const float rs = 1.0f / sqrtf(wave_sum(ss) * (1.f / DM) + EPS);
#pragma unroll
            for (int j = 0; j < 4; ++j) { const int c0 = 512 * j + 8 * lane;
#pragma unroll
                for (int h = 0; h < 2; ++h) { const f32x4 g4 = *(const f32x4*)(fg + c0 + 4 * h); *(f32x4*)(orow + c0 + 4 * h) = (v[k][j][h] * rs) * g4; } }
        }
    }
}

struct DescPlain {
    static constexpr bool RAW = false;
    const bf16_t* A; const bf16_t* B; int nN; bool latonly; int lda, ldb, K, total;
    DI void init(const bf16_t* A_, const bf16_t* B_, int nN_, bool lat) { A = A_; B = B_; nN = nN_; latonly = lat; lda = DM; ldb = DM; K = DM; total = (lat ? 128 : 144) * nN_; }
    DI pg8::Unit unit(int idx) const {
        const int nMt = latonly ? 128 : 144, nig = 8 * nN, gid = idx / nig, fm = gid * 8, gsz = (nMt - fm) < 8 ? (nMt - fm) : 8;
        const int pmi = fm + (idx % nig) % gsz, pn = (idx % nig) / gsz, pm = latonly ? (pmi / 8) * 9 + (pmi % 8) : pmi;
        pg8::Unit u; u.a = (const char*)(A + (size_t)pm * 256 * DM); u.b = (const char*)(B + (size_t)pn * 256 * DM); u.i0 = pm; u.i1 = pn; u.i2 = 0; return u;
    }
};
struct DescChan {
    static constexpr bool RAW = false;
    const bf16_t* DC; const bf16_t* H; int lda, ldb, K, total;
    DI void init(const bf16_t* DC_, const bf16_t* H_, bool lat) { DC = DC_; H = H_; lda = 512; ldb = DM; K = 512; total = lat ? 2048 : 2304; }
    DI pg8::Unit unit(int idx) const {
        pg8::Unit u; int b, g, mt, nt, toff;
        if (idx < 2048) { mt = idx % 4; nt = (idx / 4) % 8; g = (idx / 32) % 4; b = idx / 128; toff = nt * 256; u.i2 = nt; }
        else { const int j = idx - 2048; mt = j % 4; g = (j / 4) % 4; b = j / 16; toff = TL; u.i2 = 8; }
        u.a = (const char*)(DC + (size_t)mt * 256 * 512); u.b = (const char*)(H + ((size_t)b * TB + toff) * DM + g * 512); u.i0 = b * 4 + g; u.i1 = mt; return u;
    }
};
struct DescT {
    static constexpr bool RAW = false;
    const bf16_t* DT; const bf16_t* PQ; int nMt; int lda, ldb, K, total;
    DI void init(const bf16_t* DT_, const bf16_t* PQ_, int ld, int Kd, int coff, int nMt_) { DT = DT_ + coff; PQ = PQ_ + coff; nMt = nMt_; lda = ld; ldb = ld; K = Kd; total = NB * nMt_ * 8; }
    DI pg8::Unit unit(int idx) const {
        const int mt = idx % nMt, nt = (idx / nMt) % 8, b = idx / (nMt * 8);
        pg8::Unit u; u.a = (const char*)(DT + (size_t)mt * 256 * lda); u.b = (const char*)(PQ + ((size_t)b * DM + nt * 256) * ldb); u.i0 = b; u.i1 = mt; u.i2 = nt; return u;
    }
};

struct DescT2 {
    static constexpr bool RAW = true;
    const bf16_t* DT; const bf16_t* PQ; int lda, ldb, K, total;
    DI void init(const bf16_t* DT_, const bf16_t* PQ_) { DT = DT_; PQ = PQ_; lda = 4096; ldb = 4096; K = 2048; total = 2 * NB * 4 * 8; }
    DI bool valid(int L, int G) const { return ((L / G) >> 1) * G + (L % G) < NB * 4 * 8; }
    DI pg8::Unit unit(int L, int G) const {
        const int i = L / G, pair = (i >> 1) * G + (L % G), part = i & 1;
        const int mt = pair % 4, nt = (pair / 4) % 8, b = pair / 32, coff = part * 2048;
        pg8::Unit u; u.a = (const char*)(DT + (size_t)mt * 256 * 4096 + coff); u.b = (const char*)(PQ + ((size_t)b * DM + nt * 256) * 4096 + coff); u.i0 = b; u.i1 = mt; u.i2 = part * 8 + nt; return u;
    }
};

DI void resid_store(const Args& A, int layer, int pm, int row_l, int col, const float* modl, f32x4 v0, f32x4 v1) {
    const int b = pm / 9, tt = pm % 9;
    const float* gp = modl + (size_t)(tt < 8 ? b : 16) * MOD_LD + 2 * DM + col;
    const f32x4 g0 = *(const f32x4*)gp, g1 = *(const f32x4*)(gp + 4);
    bf16_t* XB = (bf16_t*)A.out;
    const size_t roff = ((size_t)pm * 256 + row_l) * DM + col;
    f32x4 x0, x1;
    if (layer == 0) {
        const float* src = (tt < 8) ? A.in[0] + ((size_t)b * TL + tt * 256 + row_l) * DM + col : A.in[2] + ((size_t)b * TC + row_l) * DM + col;
        x0 = *(const f32x4*)src; x1 = *(const f32x4*)(src + 4);
    } else ld_bf16x8(XB + roff, x0, x1);
    x0 = x0 + g0 * v0; x1 = x1 + g1 * v1;
    if (layer == 3) st_bf16x8((bf16_t*)(A.ws + WS_SCR + F_PQX) + ((size_t)b * TL + tt * 256 + row_l) * DM + col, x0, x1);
    else st_bf16x8(XB + roff, x0, x1);
}

DI void fnet_layer(const Args& A, LAS unsigned char* lds, const XcdBarrier& gbar, int layer, int j, bool latonly, int wv) {
    unsigned char* ws = A.ws;
    const bf16_t* H = (const bf16_t*)(ws + WS_H); bf16_t* U = (bf16_t*)(ws + WS_H);
    bf16_t* Gt = (bf16_t*)(ws + WS_SCR + F_G); bf16_t* PQX = (bf16_t*)(ws + WS_SCR + F_PQX); bf16_t* PQC = (bf16_t*)(ws + WS_SCR + F_PQC);
    norm_phase(A, layer, latonly, wv);
    xcd_barrier(gbar, wv);
    {
        DescPlain D; D.init(H, (const bf16_t*)(ws + WS_WFG) + (size_t)j * DM * DM, 8, latonly);
        auto E = [=](const pg8::Unit& u, int row_l, int col_l, f32x4 v0, f32x4 v1) {
            f32x4 a, b;
#pragma unroll
            for (int q = 0; q < 4; ++q) { a[q] = siluf(v0[q]); b[q] = siluf(v1[q]); }
            st_bf16x8(Gt + ((size_t)u.i0 * 256 + row_l) * DM + u.i1 * 256 + col_l, a, b);
        };
        pg8::gemm_phase(lds, D, E, wv);
    }
    {
        DescChan D; D.init((const bf16_t*)(ws + WS_DC), H, latonly);
        auto E = [=](const pg8::Unit& u, int row_l, int col_l, f32x4 v0, f32x4 v1) {
            const int b = u.i0 >> 2, g = u.i0 & 3, mt = u.i1, half = mt >> 1, ch = g * 512 + (mt & 1) * 256 + row_l;
            bf16_t* dst = (u.i2 < 8) ? PQX + ((size_t)b * DM + ch) * 4096 + half * 2048 + u.i2 * 256 + col_l
                                     : PQC + ((size_t)b * DM + ch) * 512 + half * 256 + col_l;
            st_bf16x8(dst, v0, v1);
        };
        pg8::gemm_phase(lds, D, E, wv);
    }
    xcd_barrier(gbar, wv);
    bf16_t* A1 = (bf16_t*)(ws + WS_SCR + F_A1);
    {
        const int tid = otid(wv), lane = tid & 63;
        for (int rr0 = (blockIdx.x * NWAVES + wv) * 4; rr0 < NB * DM; rr0 += gridDim.x * NWAVES * 4) {
            u32x4 raw[4][4];
#pragma unroll
            for (int k = 0; k < 4; ++k)
#pragma unroll
                for (int q = 0; q < 4; ++q) raw[k][q] = *(const u32x4*)(PQX + (size_t)(rr0 + k) * 4096 + (q * 64 + lane) * 8);
#pragma unroll
            for (int k = 0; k < 4; ++k) { float acc = 0.f;
#pragma unroll
                for (int q = 0; q < 4; ++q) { const u32x4 w = raw[k][q]; acc += (bf_lo(w.x) - bf_hi(w.x)) + (bf_lo(w.y) - bf_hi(w.y)) + (bf_lo(w.z) - bf_hi(w.z)) + (bf_lo(w.w) - bf_hi(w.w)); }
                acc = wave_sum(acc);
                if (lane == 0) { const int rr = rr0 + k; const size_t off = ((size_t)(rr >> 11) * TB + 1024) * DM + (rr & 2047);
                    U[off] = (bf16_t)(pk2(acc * 0.022097086912079608f * __uint_as_float((unsigned)Gt[off] << 16), 0.f) & 0xffffu); } }
        }
    }
    {
        DescT2 D; D.init((const bf16_t*)(ws + WS_DT), PQX);
        auto E = [=](const pg8::Unit& u, int row_l, int col_l, f32x4 v0, f32x4 v1) {
            const int k = u.i1 * 256 + row_l, col = (u.i2 & 7) * 256 + col_l;
            bf16_t* ap = A1 + ((size_t)u.i0 * 1024 + k) * DM + col;
            if (u.i2 < 8) { st_bf16x8(ap, v0, v1); return; }
            f32x4 a0, a1; ld_bf16x8(ap, a0, a1);
            const size_t off = ((size_t)u.i0 * TB + k) * DM + col;
            f32x4 g0, g1; ld_bf16x8(Gt + off, g0, g1);
            st_bf16x8(U + off, (a0 + v0) * g0, (a1 + v1) * g1);
            if (k != 0) { const size_t off2 = ((size_t)u.i0 * TB + (TL - k)) * DM + col; ld_bf16x8(Gt + off2, g0, g1); st_bf16x8(U + off2, (a0 - v0) * g0, (a1 - v1) * g1); }
        };
        pg8::gemm_phase(lds, D, E, wv);
    }
    if (!latonly) {
        DescT D; D.init((const bf16_t*)(ws + WS_DT2), PQC, 512, 512, 0, 1);
        auto E = [=](const pg8::Unit& u, int row_l, int col_l, f32x4 v0, f32x4 v1) {
            const size_t off = ((size_t)u.i0 * TB + TL + row_l) * DM + u.i2 * 256 + col_l;
            f32x4 g0, g1; ld_bf16x8(Gt + off, g0, g1);
            st_bf16x8(U + off, v0 * g0, v1 * g1);
        };
        pg8::gemm_phase(lds, D, E, wv);
    }
    xcd_barrier(gbar, wv);
    {
        DescPlain D; D.init(U, (const bf16_t*)(ws + WS_WFO) + (size_t)j * DM * DM, 8, latonly);
        const float* modl = (const float*)(ws + WS_MOD) + (size_t)layer * 17 * MOD_LD;
        auto E = [=](const pg8::Unit& u, int row_l, int col_l, f32x4 v0, f32x4 v1) { resid_store(A, layer, u.i0, row_l, u.i1 * 256 + col_l, modl, v0, v1); };
        pg8::gemm_phase(lds, D, E, wv);
    }
    xcd_barrier(gbar, wv);
}


namespace att {
constexpr int D = 128, NW = 8, QBLK = 32, KVBLK = 64;
constexpr float SCALE = 0.088388347648318440f;
constexpr float THR = 8.f;
constexpr int LDQ = 2048, LDK = 512;
constexpr size_t SHM_V = KVBLK * D * 2, SHM_K = KVBLK * D * 2;
typedef float f32x8 __attribute__((ext_vector_type(8)));
#define KSWZ(row, colB) ((row) * 256 + ((colB) ^ (((row) & 7) << 4)))
#define SBAR() __builtin_amdgcn_sched_barrier(0)
DI int crow(int r, int hi) { return (r & 3) + 8 * (r >> 2) + 4 * hi; }
DI unsigned cvtpk(float lo, float hi) { unsigned r; asm volatile("v_cvt_pk_bf16_f32 %0, %1, %2" : "=v"(r) : "v"(lo), "v"(hi)); return r; }
DI void partialSM(f32x16& p0, f32x16& p1, float& m_reg, float& mn, float& alpha) {
  constexpr float C = SCALE * 1.4426950408889634f;
  float pmax = p0[0];
#pragma unroll
  for (int r = 1; r < 16; ++r) pmax = fmaxf(pmax, p0[r]);
#pragma unroll
  for (int r = 0; r < 16; ++r) pmax = fmaxf(pmax, p1[r]);
  { auto rr = __builtin_amdgcn_permlane32_swap(__float_as_uint(pmax), __float_as_uint(pmax), false, false);
    pmax = fmaxf(__uint_as_float(rr[0]), __uint_as_float(rr[1])); }
  if (__builtin_expect(__all(pmax - m_reg <= THR / SCALE), 1)) { mn = m_reg; alpha = 1.f; }
  else { mn = fmaxf(m_reg, pmax); alpha = __builtin_amdgcn_exp2f((m_reg - mn) * C); m_reg = mn; }
  float mnC = -mn * C;
#pragma unroll
  for (int r = 0; r < 16; ++r) p0[r] = fmaf(p0[r], C, mnC);
#pragma unroll
  for (int r = 0; r < 16; ++r) p1[r] = fmaf(p1[r], C, mnC);
#pragma unroll
  for (int r = 0; r < 16; ++r) p0[r] = __builtin_amdgcn_exp2f(p0[r]);
}
DI void finishSM(f32x16& p0, f32x16& p1, float alpha, float& l_reg, bf16x8& pa0, bf16x8& pa1, bf16x8& pa2, bf16x8& pa3) {
#pragma unroll
  for (int r = 0; r < 16; ++r) p1[r] = __builtin_amdgcn_exp2f(p1[r]);
  float ps = 0;
#pragma unroll
  for (int r = 0; r < 16; ++r) ps += p0[r];
#pragma unroll
  for (int r = 0; r < 16; ++r) ps += p1[r];
  { auto rr = __builtin_amdgcn_permlane32_swap(__float_as_uint(ps), __float_as_uint(ps), false, false);
    ps = __uint_as_float(rr[0]) + __uint_as_float(rr[1]); }
  l_reg = l_reg * alpha + ps;
#define PK4(P, BASE, OUT) do { unsigned a0 = cvtpk(P[BASE + 0], P[BASE + 1]), a1 = cvtpk(P[BASE + 2], P[BASE + 3]);   \
    unsigned b0 = cvtpk(P[BASE + 4], P[BASE + 5]), b1 = cvtpk(P[BASE + 6], P[BASE + 7]);                              \
    auto r0 = __builtin_amdgcn_permlane32_swap(a0, b0, false, false); auto r1 = __builtin_amdgcn_permlane32_swap(a1, b1, false, false); \
    u32x4 w = {r0[0], r1[0], r0[1], r1[1]}; OUT = *reinterpret_cast<bf16x8*>(&w); } while (0)
  PK4(p0, 0, pa0); PK4(p0, 8, pa1); PK4(p1, 0, pa2); PK4(p1, 8, pa3);
#undef PK4
}
DI void qkt(f32x16& p0, f32x16& p1, const bf16_t* Ks, const bf16x8* qr, int r32, int hi) {
  p0 = f32x16{}; p1 = f32x16{};
#pragma unroll
  for (int d0 = 0; d0 < 8; ++d0) { int cb = (d0 * 16 + hi * 8) * 2;
    bf16x8 b0 = *reinterpret_cast<const bf16x8*>((const char*)Ks + KSWZ(r32, cb));
    bf16x8 b1 = *reinterpret_cast<const bf16x8*>((const char*)Ks + KSWZ(32 + r32, cb));
    p0 = __builtin_amdgcn_mfma_f32_32x32x16_bf16(b0, qr[d0], p0, 0, 0, 0);
    p1 = __builtin_amdgcn_mfma_f32_32x32x16_bf16(b1, qr[d0], p1, 0, 0, 0); }
}
DI int v_st(int k, int c) { const int kk = (k & ~0xC) | ((k & 4) << 1) | ((k & 8) >> 1); return ((kk >> 3) * 4 + (c >> 5)) * 512 + ((kk & 7) * 32 + (c & 31)) * 2; }
DI int v_rd_base(int lane) { return ((lane & 3) << 3) | (((lane >> 2) & 3) << 6) | (((lane >> 4) & 1) << 5) | (((lane >> 5) & 1) << 8); }
constexpr int v_rd_off(int d0, int ks, int half) { return d0 * 512 + ks * 4096 + half * 2048; }
template <int OFF> DI s16x4 tr_read(int vb) {
  s16x4 r; asm volatile("ds_read_b64_tr_b16 %0, %1 offset:%2" : "=&v"(r) : "v"(vb), "i"(OFF) : "memory"); return r;
}
template <int D0> DI void pv_one(f32x16& od, int vb, bf16x8 pa0, bf16x8 pa1, bf16x8 pa2, bf16x8 pa3) {
  const s16x4 l0 = tr_read<v_rd_off(D0, 0, 0)>(vb), h0 = tr_read<v_rd_off(D0, 0, 1)>(vb), l1 = tr_read<v_rd_off(D0, 1, 0)>(vb), h1 = tr_read<v_rd_off(D0, 1, 1)>(vb);
  const s16x4 l2 = tr_read<v_rd_off(D0, 2, 0)>(vb), h2 = tr_read<v_rd_off(D0, 2, 1)>(vb), l3 = tr_read<v_rd_off(D0, 3, 0)>(vb), h3 = tr_read<v_rd_off(D0, 3, 1)>(vb);
  asm volatile("s_waitcnt lgkmcnt(0)" ::: "memory"); SBAR();
#define PK(L, H) (bf16x8){L[0], L[1], L[2], L[3], H[0], H[1], H[2], H[3]}
  od = __builtin_amdgcn_mfma_f32_32x32x16_bf16(pa0, PK(l0, h0), od, 0, 0, 0);
  od = __builtin_amdgcn_mfma_f32_32x32x16_bf16(pa1, PK(l1, h1), od, 0, 0, 0);
  od = __builtin_amdgcn_mfma_f32_32x32x16_bf16(pa2, PK(l2, h2), od, 0, 0, 0);
  od = __builtin_amdgcn_mfma_f32_32x32x16_bf16(pa3, PK(l3, h3), od, 0, 0, 0);
#undef PK
}
DI void pv_d0(f32x16* o, int vb, bf16x8 pa0, bf16x8 pa1, bf16x8 pa2, bf16x8 pa3) {
  pv_one<0>(o[0], vb, pa0, pa1, pa2, pa3); pv_one<1>(o[1], vb, pa0, pa1, pa2, pa3); pv_one<2>(o[2], vb, pa0, pa1, pa2, pa3); pv_one<3>(o[3], vb, pa0, pa1, pa2, pa3);
}
DI void attn_dense_body(const bf16_t* __restrict__ Qb, const bf16_t* __restrict__ Kh, const bf16_t* __restrict__ Vh, const bf16_t* SZb, bf16_t* Ub, int seq, char* lds, int wv, const float* qn, int tpos) {
  const int tid = otid(wv), wid = tid >> 6, lane = tid & 63, r32 = lane & 31, hi = lane >> 5;
  bf16_t* V_lds = (bf16_t*)lds; bf16_t* K_lds = (bf16_t*)(lds + 2 * SHM_V);
  float* wsf = (float*)(lds + 2 * SHM_V + 2 * SHM_K) + wid * 64; float* li_l = wsf; float* al_l = wsf + 32;
  float m_reg = -1e30f, l_reg = 0; f32x16 o[4] = {}; bf16x8 qr[8];
  const bf16_t* Qw = Qb + (long)(wid * QBLK + r32) * LDQ + hi * 8;
  {
    u32x4 raw[8];
#pragma unroll
    for (int d0 = 0; d0 < 8; ++d0) raw[d0] = *reinterpret_cast<const u32x4*>(Qw + d0 * 16);
    float ss = 0.f;
#pragma unroll
    for (int d0 = 0; d0 < 8; ++d0) { const u32x4 w = raw[d0];
      ss += bf_lo(w.x) * bf_lo(w.x) + bf_hi(w.x) * bf_hi(w.x) + bf_lo(w.y) * bf_lo(w.y) + bf_hi(w.y) * bf_hi(w.y) + bf_lo(w.z) * bf_lo(w.z) + bf_hi(w.z) * bf_hi(w.z) + bf_lo(w.w) * bf_lo(w.w) + bf_hi(w.w) * bf_hi(w.w); }
    ss += __shfl_xor(ss, 32);
    const float rs = 1.0f / sqrtf(ss * (1.f / 128.f) + EPS);
    const int t = tpos + wid * QBLK + r32;
    const f32x2* rope = (const f32x2*)(lds + 81920);
#pragma unroll
    for (int d0 = 0; d0 < 8; ++d0) { const u32x4 w = raw[d0]; const float* wn = qn + d0 * 16 + hi * 8;
      const f32x4 g0 = *(const f32x4*)wn, g1 = *(const f32x4*)(wn + 4);
      float y[8] = {bf_lo(w.x) * rs * g0[0], bf_hi(w.x) * rs * g0[1], bf_lo(w.y) * rs * g0[2], bf_hi(w.y) * rs * g0[3], bf_lo(w.z) * rs * g1[0], bf_hi(w.z) * rs * g1[1], bf_lo(w.w) * rs * g1[2], bf_hi(w.w) * rs * g1[3]};
      if (tpos >= 0) {
        const int pos = (d0 < 4) ? (t >> 6) : (t & 63);
        const f32x4* rp = (const f32x4*)(rope + pos * 32 + (8 * (d0 & 3) + 4 * hi));
        const f32x4 c01 = rp[0], c23 = rp[1];
        const float cs[4] = {c01[0], c01[2], c23[0], c23[2]}, sn[4] = {c01[1], c01[3], c23[1], c23[3]};
#pragma unroll
        for (int pp = 0; pp < 4; ++pp) { const float x0 = y[2 * pp], x1 = y[2 * pp + 1]; y[2 * pp] = x0 * cs[pp] - x1 * sn[pp]; y[2 * pp + 1] = x0 * sn[pp] + x1 * cs[pp]; }
      }
      u32x4 o4 = {pk2(y[0], y[1]), pk2(y[2], y[3]), pk2(y[4], y[5]), pk2(y[6], y[7])};
      qr[d0] = __builtin_bit_cast(bf16x8, o4); }
  }
  const int sr = tid >> 4, sc = (tid & 15) * 8, vst0 = v_st(sr, sc), vst1 = v_st(32 + sr, sc);
  const int vb0 = (int)(uintptr_t)V_lds + v_rd_base(lane);
  struct { bf16x8 vs0, vs1, ks0, ks1; } sr_[2];
#define SLOAD(i, k0) do { sr_[i].vs0 = *reinterpret_cast<const bf16x8*>(&Vh[(long)((k0) + sr) * LDK + sc]); sr_[i].vs1 = *reinterpret_cast<const bf16x8*>(&Vh[(long)((k0) + 32 + sr) * LDK + sc]); \
    sr_[i].ks0 = *reinterpret_cast<const bf16x8*>(&Kh[(long)((k0) + sr) * LDK + sc]); sr_[i].ks1 = *reinterpret_cast<const bf16x8*>(&Kh[(long)((k0) + 32 + sr) * LDK + sc]); } while (0)
#define SWRITE(b, i) do { *(bf16x8*)((char*)V_lds + (b) * SHM_V + vst0) = sr_[i].vs0;          \
    *(bf16x8*)((char*)V_lds + (b) * SHM_V + vst1) = sr_[i].vs1; int kc = sc * 2;               \
    *(bf16x8*)((char*)K_lds + (b) * SHM_K + KSWZ(sr, kc)) = sr_[i].ks0;                       \
    *(bf16x8*)((char*)K_lds + (b) * SHM_K + KSWZ(32 + sr, kc)) = sr_[i].ks1; } while (0)
#define SWAIT() asm volatile("s_waitcnt vmcnt(4)" ::: "memory")
#define RESC(a) do { if (__any((a) < 1.f)) { if (hi == 0) al_l[r32] = (a); asm volatile("s_waitcnt lgkmcnt(0)" ::: "memory"); \
    _Pragma("unroll") for (int d = 0; d < 4; ++d) _Pragma("unroll") for (int r = 0; r < 16; ++r) o[d][r] *= al_l[crow(r, hi)]; } } while (0)
  f32x16 pA0, pA1, pB0, pB1; float mnA, mnB, alA, alB; bf16x8 pa0, pa1, pa2, pa3; const int NT = seq / KVBLK;
  constexpr int SE = 0, SO = 1;
  SLOAD(SE, 0); asm volatile("s_waitcnt vmcnt(0)" ::: "memory"); SWRITE(0, SE); __syncthreads();
  qkt(pA0, pA1, K_lds, qr, r32, hi); partialSM(pA0, pA1, m_reg, mnA, alA);
  SLOAD(SO, KVBLK); if (2 < NT) SLOAD(SE, 2 * KVBLK);
  SWAIT(); SWRITE(1, SO); __syncthreads();
  for (int j = 1; j + 1 < NT; j += 2) {
    SBAR(); qkt(pB0, pB1, (bf16_t*)((char*)K_lds + SHM_K), qr, r32, hi);
    finishSM(pA0, pA1, alA, l_reg, pa0, pa1, pa2, pa3); SBAR();
    SLOAD(SO, (j + 2) * KVBLK); SBAR();
    pv_d0(o, vb0, pa0, pa1, pa2, pa3); partialSM(pB0, pB1, m_reg, mnB, alB);
    __syncthreads(); SWAIT(); SWRITE(0, SE);
    RESC(alB); __syncthreads();
    SBAR(); qkt(pA0, pA1, K_lds, qr, r32, hi);
    finishSM(pB0, pB1, alB, l_reg, pa0, pa1, pa2, pa3); SBAR();
    if (j + 3 < NT) SLOAD(SE, (j + 3) * KVBLK); SBAR();
    pv_d0(o, vb0 + (int)SHM_V, pa0, pa1, pa2, pa3); partialSM(pA0, pA1, m_reg, mnA, alA);
    __syncthreads(); SWAIT(); SWRITE(1, SO);
    RESC(alA); __syncthreads();
  }
  SBAR(); qkt(pB0, pB1, (bf16_t*)((char*)K_lds + SHM_K), qr, r32, hi);
  finishSM(pA0, pA1, alA, l_reg, pa0, pa1, pa2, pa3); SBAR();
  pv_d0(o, vb0, pa0, pa1, pa2, pa3); partialSM(pB0, pB1, m_reg, mnB, alB);
  __syncthreads(); RESC(alB);
  finishSM(pB0, pB1, alB, l_reg, pa0, pa1, pa2, pa3); SBAR();
  pv_d0(o, vb0 + (int)SHM_V, pa0, pa1, pa2, pa3);
  u32x4 zq[8];
#pragma unroll
  for (int i = 0; i < 8; ++i) { const int id = tid + 512 * i; zq[i] = *(const u32x4*)(SZb + (long)(id >> 4) * LDQ + (id & 15) * 8); }
  if (hi == 0) li_l[r32] = l_reg; asm volatile("s_waitcnt lgkmcnt(0)" ::: "memory");
  __syncthreads();
  {
    float rli[16];
#pragma unroll
    for (int r = 0; r < 16; ++r) rli[r] = __builtin_amdgcn_rcpf(li_l[crow(r, hi)]);
    char* ost = lds;
#pragma unroll
    for (int r = 0; r < 16; ++r) { char* rowp = ost + (wid * QBLK + crow(r, hi)) * 256 + r32 * 2;
#pragma unroll
      for (int d0 = 0; d0 < 4; ++d0) *(unsigned short*)(rowp + d0 * 64) = (unsigned short)(pk2(o[d0][r] * rli[r], 0.f) & 0xffffu); }
  }
  __syncthreads();
#pragma unroll
  for (int i = 0; i < 8; ++i) { const int id = tid + 512 * i; const int row = id >> 4, ch = id & 15;
    const u32x4 ov = *(const u32x4*)(lds + row * 256 + ch * 16);
    f32x4 a0 = {bf_lo(ov.x), bf_hi(ov.x), bf_lo(ov.y), bf_hi(ov.y)}, a1 = {bf_lo(ov.z), bf_hi(ov.z), bf_lo(ov.w), bf_hi(ov.w)};
    const f32x4 z0 = {bf_lo(zq[i].x), bf_hi(zq[i].x), bf_lo(zq[i].y), bf_hi(zq[i].y)}, z1 = {bf_lo(zq[i].z), bf_hi(zq[i].z), bf_lo(zq[i].w), bf_hi(zq[i].w)};
    st_bf16x8(Ub + (long)row * LDQ + ch * 8, a0 * z0, a1 * z1); }
  __syncthreads();
#undef SLOAD
#undef SWRITE
#undef SWAIT
#undef RESC
}
#undef KSWZ
#undef SBAR
}

DI void qknorm_phase(const Args& A, LAS unsigned char* lds, int wv) {
    const int tid = otid(wv), lane = tid & 63, wave = tid >> 6, G = gridDim.x;
    bf16_t* Q = (bf16_t*)(A.ws + WS_SCR + A_Q); bf16_t* Kb = (bf16_t*)(A.ws + WS_SCR + A_K);
    const float* qn = A.in[14]; const float* kn = A.in[15];
    const int sub = lane >> 4, l16 = lane & 15, e0 = l16 * 8;
    LAS f32x2* rope = (LAS f32x2*)lds;
    for (int e = tid; e < 2048; e += NTHREADS) { const float ang = (float)(e >> 5) * exp2f(-(float)(e & 31) * 0.41524101186092029f); rope[e] = (f32x2){cosf(ang), sinf(ang)}; }
    __syncthreads();
    const long NIT = (long)NTOK * 4;
    for (long it0 = ((long)blockIdx.x * NWAVES + wave) * 16 + sub; it0 < NIT; it0 += (long)G * NWAVES * 16) {
        bf16_t* pq[4]; u32x4 raw[4];
#pragma unroll
        for (int k = 0; k < 4; ++k) { const long it = it0 + 4 * k; const int row = (int)(it >> 2), hj = 16 + (int)(it & 3);
            pq[k] = (hj < 16) ? Q + (size_t)row * 2048 + hj * 128 + e0 : Kb + (size_t)row * 512 + (hj - 16) * 128 + e0;
            raw[k] = *(const u32x4*)pq[k]; }
#pragma unroll
        for (int k = 0; k < 4; ++k) {
            const long it = it0 + 4 * k; const int row = (int)(it >> 2), hj = 16 + (int)(it & 3);
            const float* wn = (hj < 16 ? qn : kn) + e0;
            f32x4 a = {bf_lo(raw[k].x), bf_hi(raw[k].x), bf_lo(raw[k].y), bf_hi(raw[k].y)}, b = {bf_lo(raw[k].z), bf_hi(raw[k].z), bf_lo(raw[k].w), bf_hi(raw[k].w)};
            float ss = 0.f;
#pragma unroll
            for (int q = 0; q < 4; ++q) ss += a[q] * a[q] + b[q] * b[q];
            ss += __shfl_xor(ss, 1); ss += __shfl_xor(ss, 2); ss += __shfl_xor(ss, 4); ss += __shfl_xor(ss, 8);
            const float rs = 1.0f / sqrtf(ss * (1.f / 128.f) + EPS);
            const f32x4 w0 = *(const f32x4*)wn, w1 = *(const f32x4*)(wn + 4);
            a = a * rs * w0; b = b * rs * w1;
            const int t = row % TB;
            if (t < TL) {
                const int pos = (l16 < 8) ? (t >> 6) : (t & 63);
                float y[8] = {a[0], a[1], a[2], a[3], b[0], b[1], b[2], b[3]};
                const LAS f32x4* rp = (const LAS f32x4*)(rope + pos * 32 + ((4 * l16) & 31));
                const f32x4 c01 = rp[0], c23 = rp[1];
                const float cs[4] = {c01[0], c01[2], c23[0], c23[2]}, sn[4] = {c01[1], c01[3], c23[1], c23[3]};
#pragma unroll
                for (int pp = 0; pp < 4; ++pp) {
                    const float x0 = y[2 * pp], x1 = y[2 * pp + 1];
                    y[2 * pp] = x0 * cs[pp] - x1 * sn[pp]; y[2 * pp + 1] = x0 * sn[pp] + x1 * cs[pp];
                }
                a = (f32x4){y[0], y[1], y[2], y[3]}; b = (f32x4){y[4], y[5], y[6], y[7]};
            }
            st_bf16x8(pq[k], a, b);
        }
    }
}

DI void attn_layer(const Args& A, LAS unsigned char* lds, char* lds_gen, const XcdBarrier& gbar, int layer, int wv) {
    unsigned char* ws = A.ws;
    const bf16_t* H = (const bf16_t*)(ws + WS_H); bf16_t* U = (bf16_t*)(ws + WS_H);
    bf16_t* Q = (bf16_t*)(ws + WS_SCR + A_Q); bf16_t* Kb = (bf16_t*)(ws + WS_SCR + A_K); bf16_t* Vb = (bf16_t*)(ws + WS_SCR + A_V); bf16_t* SZ = (bf16_t*)(ws + WS_SCR + A_SZ);
    norm_phase(A, layer, false, wv);
    xcd_barrier(gbar, wv);
    {
        DescPlain D; D.init(H, (const bf16_t*)(ws + WS_WAI), 20, false);
        auto E = [=](const pg8::Unit& u, int row_l, int col_l, f32x4 v0, f32x4 v1) {
            const size_t row = (size_t)u.i0 * 256 + row_l; const int pn = u.i1;
            if (pn < 8) st_bf16x8(Q + row * 2048 + pn * 256 + col_l, v0, v1);
            else if (pn < 10) st_bf16x8(Kb + row * 512 + (pn - 8) * 256 + col_l, v0, v1);
            else if (pn < 12) st_bf16x8(Vb + row * 512 + (pn - 10) * 256 + col_l, v0, v1);
            else { f32x4 a, b;
#pragma unroll
                for (int q = 0; q < 4; ++q) { a[q] = siluf(v0[q]); b[q] = siluf(v1[q]); }
                st_bf16x8(SZ + row * 2048 + (pn - 12) * 256 + col_l, a, b); }
        };
        pg8::gemm_phase(lds, D, E, wv);
    }
    xcd_barrier(gbar, wv);
    qknorm_phase(A, lds, wv);
    xcd_barrier(gbar, wv);
    {
        const int G = gridDim.x, c = blockIdx.x;
        { f32x2* rope = (f32x2*)(lds_gen + 81920); const int tid = otid(wv);
          for (int e = tid; e < 2048; e += NTHREADS) { const float ang = (float)(e >> 5) * exp2f(-(float)(e & 31) * 0.41524101186092029f); rope[e] = (f32x2){cosf(ang), sinf(ang)}; }
          __syncthreads(); }
        const float* qn = A.in[14];
        for (long L = c; L < 2048; L += G) {
            const int u = pg8::xcd_remap((int)L, 2048);
            const int b = u / 128, rem = u % 128, kvh = rem / 32, g = (rem / 8) % 4, qb = rem % 8, h = kvh * 4 + g;
            const size_t qoff = ((size_t)b * TB + qb * 256) * 2048 + h * 128, koff = ((size_t)b * TB) * 512 + kvh * 128;
            att::attn_dense_body(Q + qoff, Kb + koff, Vb + koff, SZ + qoff, U + qoff, TB, lds_gen, wv, qn, qb * 256);
        }
        for (int u = c; u < 256; u += G) {
            const int b = u / 16, h = u % 16, kvh = h / 4;
            const size_t qoff = ((size_t)b * TB + TL) * 2048 + h * 128, koff = ((size_t)b * TB + TL) * 512 + kvh * 128;
            att::attn_dense_body(Q + qoff, Kb + koff, Vb + koff, SZ + qoff, U + qoff, TC, lds_gen, wv, qn, -1);
        }
    }
    xcd_barrier(gbar, wv);
    {
        DescPlain D; D.init(U, (const bf16_t*)(ws + WS_WAO), 8, false);
        const float* modl = (const float*)(ws + WS_MOD) + (size_t)layer * 17 * MOD_LD;
        auto E = [=](const pg8::Unit& u, int row_l, int col_l, f32x4 v0, f32x4 v1) { resid_store(A, layer, u.i0, row_l, u.i1 * 256 + col_l, modl, v0, v1); };
        pg8::gemm_phase(lds, D, E, wv);
    }
    xcd_barrier(gbar, wv);
}


struct DescM1 {
    static constexpr bool RAW = false;
    const bf16_t* H; const bf16_t* WA; const bf16_t* WB; int lda, ldb, K, total;
    DI void init(const bf16_t* H_, const bf16_t* WA_, const bf16_t* WB_) { H = H_; WA = WA_; WB = WB_; lda = DM; ldb = DM; K = DM; total = 144 * 9 + 8 * 144; }
    DI pg8::Unit unit(int idx) const {
        pg8::Unit u;
        if (idx < 1296) { const int nig = 72, gid = idx / nig, pm = gid * 8 + (idx % nig) % 8, pn = (idx % nig) / 8;
            u.a = (const char*)(H + (size_t)pm * 256 * DM); u.b = (const char*)(WA + (size_t)pn * 256 * DM); u.i0 = pm; u.i1 = pn; u.i2 = 0; }
        else { const int j = idx - 1296, mt = j % 8, nt = j / 8;
            u.a = (const char*)(WB + (size_t)mt * 256 * DM); u.b = (const char*)(H + (size_t)nt * 256 * DM); u.i0 = mt; u.i1 = nt; u.i2 = 1; }
        return u;
    }
};
namespace ml {
#define MFMA32(a, b, c) __builtin_amdgcn_mfma_f32_32x32x16_bf16((a), (b), (c), 0, 0, 0)
#define LFENCE() asm volatile("s_waitcnt lgkmcnt(0)" ::: "memory")
DI float dot2_bf16(unsigned a, unsigned b, float c) { asm("v_dot2c_f32_bf16 %0, %1, %2" : "+v"(c) : "v"(a), "v"(b)); return c; }
#define DOT2(a, b, c) dot2_bf16((a), (b), (c))
DI int crow(int reg, int h) { return (reg & 3) + 8 * (reg >> 2) + 4 * h; }
DI bf16x8 ldperm(const bf16_t* p) { const s16x4 lo = *(const s16x4*)p, hi = *(const s16x4*)(p + 8); return __builtin_shufflevector(lo, hi, 0, 1, 2, 3, 4, 5, 6, 7); }
DI bf16x8 pack_step(const f32x16& x, int s) { u32x4 p = {pk2(x[8 * s], x[8 * s + 1]), pk2(x[8 * s + 2], x[8 * s + 3]), pk2(x[8 * s + 4], x[8 * s + 5]), pk2(x[8 * s + 6], x[8 * s + 7])}; return __builtin_bit_cast(bf16x8, p); }
DI float bfs(short h) { return __uint_as_float(((unsigned)(unsigned short)h) << 16); }

constexpr int SC_Q = 0, SC_K = 16384, SC_KT = 32768, SC_BUF = 49152, SC_WAVE = 2 * SC_BUF, SC_WAVE_BYTES = 6656;
DI bf16x8 ldsfrag(const LAS unsigned char* buf, unsigned o) { const s16x4 lo = *(const LAS s16x4*)(buf + o), hi = *(const LAS s16x4*)(buf + (o ^ 16u)); return __builtin_shufflevector(lo, hi, 0, 1, 2, 3, 4, 5, 6, 7); }
DI void scan_phase(const Args& A, LAS unsigned char* lds, int wv) {
    const int wave = wv;
    LAS float* wl = (LAS float*)(lds + SC_WAVE + wave * SC_WAVE_BYTES);
    LAS unsigned* nbp = (LAS unsigned*)(lds + SC_WAVE + wave * SC_WAVE_BYTES + 2048);
    LAS unsigned* wbp = nbp + 64;
    LAS unsigned char* hst = lds + SC_WAVE + wave * SC_WAVE_BYTES + 2560;
    unsigned char* ws = A.ws;
    const bf16_t* Qg = (const bf16_t*)(ws + WS_SCR + M_Q); const bf16_t* Kg = (const bf16_t*)(ws + WS_SCR + M_K); const bf16_t* KVT = (const bf16_t*)(ws + WS_SCR + M_KVT);
    const float* G32 = (const float*)(ws + WS_SCR + M_G32); const float* bg = A.in[10];
#define SC_POS0(j) (dir == 0 ? ((j) < 4 ? TL + 64 * (j) : 64 * ((j) - 4)) : ((j) < 4 ? TL + 64 * (3 - (j)) : 64 * (35 - (j))))
#define SC_DMA(bufi, p0) do { const int tj_ = otid(wv); _Pragma("unroll") for (int i_ = 0; i_ < 2; ++i_) { const int sl_ = i_ * 512 + tj_; \
        { const int row_ = sl_ >> 4, c_ = (sl_ & 15) ^ (row_ & 15); const size_t go_ = (size_t)((p0) + row_) * 1024 + c_ * 8; \
          __builtin_amdgcn_global_load_lds((const unsigned*)(Qu + go_), (LAS unsigned*)(lds + (bufi) * SC_BUF + SC_Q + i_ * 8192 + wave * 1024), 16, 0, 0); \
          __builtin_amdgcn_global_load_lds((const unsigned*)(Ku + go_), (LAS unsigned*)(lds + (bufi) * SC_BUF + SC_K + i_ * 8192 + wave * 1024), 16, 0, 0); } \
        { const int d_ = sl_ >> 3, c_ = (sl_ & 7) ^ ((d_ >> 1) & 7); \
          __builtin_amdgcn_global_load_lds((const unsigned*)(KTu + (size_t)d_ * TB + (p0) + c_ * 8), (LAS unsigned*)(lds + (bufi) * SC_BUF + SC_KT + i_ * 8192 + wave * 1024), 16, 0, 0); } } } while (0)
    for (int item = blockIdx.x; item < 256; item += gridDim.x) {
        const int dir = item & 1, h = (item >> 1) & 7, b = item >> 4, e0 = wave * 32;
        const bf16_t* Qu = Qg + (size_t)b * TB * 1024 + h * 128;
        const bf16_t* Ku = Kg + (size_t)b * TB * 1024 + h * 128;
        const bf16_t* KTu = KVT + ((size_t)b * 3072 + h * 128) * TB;
        const bf16_t* VTu = KVT + ((size_t)b * 3072 + 1024 + h * 256 + e0) * TB;
        bf16_t* Hout = (bf16_t*)(ws + WS_SCR + (dir ? M_HB : M_HF)) + (size_t)b * TB * DM + h * 256 + e0;
        const float big = bg[(dir * 2) * 8 + h], bfg = bg[(dir * 2 + 1) * 8 + h];
        f32x16 cacc[4];
#pragma unroll
        for (int d = 0; d < 4; ++d)
#pragma unroll
            for (int i = 0; i < 16; ++i) cacc[d][i] = 0.f;
        float m = 0.f;
        { const int l0 = otid(wv) & 63; wl[384 + l0] = 0.f; wl[448 + l0] = 0.f; nbp[l0] = 0u; }
        LFENCE();
        SC_DMA(0, SC_POS0(0));
        float ig_n, fg_n;
        { const int l0 = otid(wv) & 63; const float* gp = G32 + (size_t)(b * TB + SC_POS0(0) + (dir ? 63 - l0 : l0)) * 32 + (dir * 2) * 8 + h; ig_n = gp[0]; fg_n = gp[8]; }
        for (int j = 0; j < 36; ++j) {
            const int pos0 = SC_POS0(j);
            const LAS unsigned char* Qb = lds + (j & 1) * SC_BUF + SC_Q; const LAS unsigned char* Kb = lds + (j & 1) * SC_BUF + SC_K; const LAS unsigned char* KTb = lds + (j & 1) * SC_BUF + SC_KT;
            asm volatile("s_waitcnt vmcnt(0)" ::: "memory"); __builtin_amdgcn_s_barrier(); asm volatile("" ::: "memory");
            if (j + 1 < 36) SC_DMA((j + 1) & 1, SC_POS0(j + 1));
            const int lj = otid(wv) & 63, rj = lj & 31, h4 = (lj >> 5) * 4;
            LAS float* wh = wl + h4; LAS float* wr = wl + rj; LAS unsigned char* hb = hst + h4 * 64 + rj * 2;
            const LAS unsigned* nbh = nbp + (h4 >> 1); const LAS unsigned* wbh = wbp + (h4 >> 1);
            const unsigned xr = rj & 15, xd = (rj >> 1) & 7;
            const unsigned qro = (unsigned)rj * 256u + 2u * h4;
            const unsigned kro = (unsigned)rj * 128u + 2u * h4;
            const bf16_t* VTp = VTu + (size_t)rj * TB + pos0 + h4;
            bf16x8 vf[4];
#pragma unroll
            for (int kk = 0; kk < 4; ++kk) vf[kk] = ldperm(VTp + 16 * kk);
            float decay, m_new;
            {
                const int s = dir ? 63 - lj : lj;
                const float ig = ig_n + big, fg = fg_n + bfg;
                if (j + 1 < 36) { const float* gp = G32 + (size_t)(b * TB + SC_POS0(j + 1) + s) * 32 + (dir * 2) * 8 + h; ig_n = gp[0]; fg_n = gp[8]; }
                const float lf = fminf(fg, 0.f) - log1pf(__expf(-fabsf(fg)));
                float bs = lf;
#pragma unroll
                for (int o = 1; o < 64; o <<= 1) { const float t = __shfl_up(bs, o); if (lj >= o) bs += t; }
                const float uu = ig - bs;
                float pmx = uu;
#pragma unroll
                for (int o = 1; o < 64; o <<= 1) { const float t = __shfl_up(pmx, o); if (lj >= o) pmx = fmaxf(pmx, t); }
                pmx = fmaxf(pmx, m);
                const float b_end = __shfl(bs, 63), pm_last = __shfl(pmx, 63);
                LAS float* ws_ = wl + s;
                ws_[0] = uu * 1.4426950408889634f; ws_[64] = pmx * 1.4426950408889634f; ws_[128] = __expf(m - pmx); ws_[192] = __expf(-(bs + pmx)); ws_[256] = __expf(uu - pm_last);
                { const float wv_ = __expf(uu - pm_last), wp_ = __shfl_xor(wv_, 1); if ((s & 1) == 0) wbp[s >> 1] = pk2(wv_, wp_); }
                decay = __expf(m - pm_last); m_new = b_end + pm_last;
            }
            LFENCE();
            const int sbase = dir ? 63 - h4 : h4, sgn = dir ? -1 : 1;
#pragma unroll
            for (int tb = 0; tb < 2; ++tb) {
                __builtin_amdgcn_sched_barrier(0);
                const unsigned qo = qro + tb * 8192u;
                f32x16 ha;
#pragma unroll
                for (int i = 0; i < 16; ++i) ha[i] = 0.f;
                float qnv = 0.f;
#pragma unroll
                for (int kk = 0; kk < 8; ++kk) {
                    const bf16x8 qa = ldsfrag(Qb, qo + (((2u * kk) ^ xr) << 4));
                    ha = MFMA32(qa, pack_step(cacc[kk >> 1], kk & 1), ha);
                    { const u32x2 nb0 = *(const LAS u32x2*)(nbh + 8 * kk), nb1 = *(const LAS u32x2*)(nbh + 8 * kk + 4); const u32x4 qw = __builtin_bit_cast(u32x4, qa);
                      qnv = DOT2(qw.x, nb0.x, qnv); qnv = DOT2(qw.y, nb0.y, qnv); qnv = DOT2(qw.z, nb1.x, qnv); qnv = DOT2(qw.w, nb1.y, qnv); }
                }
                qnv += __shfl_xor(qnv, 32);
#pragma unroll
                for (int g = 0; g < 4; ++g) { const f32x4 av = *(const LAS f32x4*)(wh + 128 + 32 * tb + 8 * g);
#pragma unroll
                    for (int q = 0; q < 4; ++q) ha[4 * g + q] *= av[q]; }
                const float pmt = wr[64 + 32 * tb];
                const int tp = dir ? (63 - 32 * tb) - rj : 32 * tb + rj;
                float ds = 0.f;
#pragma unroll
                for (int sb = 0; sb < 2; ++sb) {
                    __builtin_amdgcn_sched_barrier(0);
                    if (sb != tb && (dir ? sb < tb : sb > tb)) continue;
                    const unsigned ko = qro + sb * 8192u;
                    f32x16 st;
#pragma unroll
                    for (int i = 0; i < 16; ++i) st[i] = 0.f;
#pragma unroll
                    for (int kk = 0; kk < 8; ++kk) { const unsigned c = ((2u * kk) ^ xr) << 4; st = MFMA32(ldsfrag(Kb, ko + c), ldsfrag(Qb, qo + c), st); }
#pragma unroll
                    for (int g = 0; g < 4; ++g) { const f32x4 uv = *(const LAS f32x4*)(wh + 32 * sb + 8 * g);
#pragma unroll
                        for (int q = 0; q < 4; ++q) {
                            const int sc = 32 * sb + q + 8 * g;
                            const int sp = sbase + sgn * sc;
                            st[4 * g + q] *= __builtin_amdgcn_exp2f((sp <= tp) ? uv[q] - pmt : -1e30f);
                            ds += st[4 * g + q];
                        } }
                    ha = MFMA32(pack_step(st, 0), vf[2 * sb], ha);
                    ha = MFMA32(pack_step(st, 1), vf[2 * sb + 1], ha);
                }
                ds += __shfl_xor(ds, 32);
                {
                    const float den = wr[128 + 32 * tb] * qnv + ds;
                    const float rd = 1.0f / fmaxf(fabsf(den), wr[192 + 32 * tb]);
                    if (h4 == 0) wr[320 + 32 * tb] = rd;
                }
                LFENCE();
#pragma unroll
                for (int g = 0; g < 4; ++g) { const f32x4 rv = *(const LAS f32x4*)(wh + 320 + 32 * tb + 8 * g);
#pragma unroll
                    for (int q = 0; q < 4; ++q) { const int tc = 32 * tb + q + 8 * g;
                        *(LAS unsigned short*)(hb + tc * 64) = (unsigned short)(pk2(ha[4 * g + q] * rv[q], 0.f) & 0xffffu); } }
            }
            LFENCE();
            {
                bf16_t* hp = Hout + (size_t)(pos0 + lj) * DM;
                const LAS unsigned char* hrow = hst + lj * 64;
#pragma unroll
                for (int q = 0; q < 4; ++q) *(u32x4*)(hp + 8 * q) = *(const LAS u32x4*)(hrow + 16 * q);
            }
            __builtin_amdgcn_sched_barrier(0);
            bf16x8 vfw[4];
#pragma unroll
            for (int kk = 0; kk < 4; ++kk) {
                const f32x4 w0 = *(const LAS f32x4*)(wh + 256 + 16 * kk), w1 = *(const LAS f32x4*)(wh + 256 + 16 * kk + 8);
                u32x4 p = {pk2(bfs(vf[kk][0]) * w0[0], bfs(vf[kk][1]) * w0[1]), pk2(bfs(vf[kk][2]) * w0[2], bfs(vf[kk][3]) * w0[3]),
                           pk2(bfs(vf[kk][4]) * w1[0], bfs(vf[kk][5]) * w1[1]), pk2(bfs(vf[kk][6]) * w1[2], bfs(vf[kk][7]) * w1[3])};
                vfw[kk] = __builtin_bit_cast(bf16x8, p);
            }
#pragma unroll
            for (int db = 0; db < 4; ++db) {
#pragma unroll
                for (int i = 0; i < 16; ++i) cacc[db][i] *= decay;
                const unsigned to = kro + db * 4096u;
                float nadd = 0.f;
#pragma unroll
                for (int kk = 0; kk < 4; ++kk) {
                    const bf16x8 kv = ldsfrag(KTb, to + (((2u * kk) ^ xd) << 4));
                    const u32x2 wq0 = *(const LAS u32x2*)(wbh + 8 * kk), wq1 = *(const LAS u32x2*)(wbh + 8 * kk + 4); const u32x4 kw = __builtin_bit_cast(u32x4, kv);
                    nadd = DOT2(kw.x, wq0.x, nadd); nadd = DOT2(kw.y, wq0.y, nadd); nadd = DOT2(kw.z, wq1.x, nadd); nadd = DOT2(kw.w, wq1.y, nadd);
                    cacc[db] = MFMA32(kv, vfw[kk], cacc[db]);
                }
                nadd += __shfl_xor(nadd, 32);
                const float nnew = decay * wr[384 + 32 * db] + nadd, npart = __shfl_xor(nnew, 1);
                if (h4 == 0) { wr[384 + 32 * db] = nnew; if ((rj & 1) == 0) nbp[(32 * db + rj) >> 1] = pk2(nnew, npart); }
            }
            LFENCE();
            m = m_new;
        }
        asm volatile("s_waitcnt vmcnt(0)" ::: "memory"); __builtin_amdgcn_s_barrier();
    }
#undef SC_DMA
#undef SC_POS0
}
#undef MFMA32
#undef LFENCE
#undef DOT2
}

DI void mlstm_finish_phase(const Args& A, int wv) {
    const int tid = otid(wv), lane = tid & 63, wave = tid >> 6, G = gridDim.x;
    unsigned char* ws = A.ws;
    const bf16_t* HF = (const bf16_t*)(ws + WS_SCR + M_HF); const bf16_t* HB = (const bf16_t*)(ws + WS_SCR + M_HB);
    const bf16_t* SO = (const bf16_t*)(ws + WS_SCR + M_SO); const bf16_t* SZ = (const bf16_t*)(ws + WS_SCR + M_SZ);
    bf16_t* U = (bf16_t*)(ws + WS_H); const float* hn = A.in[11];
    const int sub = lane >> 5, e0 = (lane & 31) * 8;
    const long NIT = (long)NTOK * 8;
    for (long it0 = ((long)blockIdx.x * NWAVES + wave) * 4 + sub; it0 < NIT; it0 += (long)G * NWAVES * 4) {
        f32x4 f0[2], f1[2], b0[2], b1[2], o0[2], o1[2], z0[2], z1[2];
#pragma unroll
        for (int k = 0; k < 2; ++k) { const long it = it0 + 2 * k; const size_t off = (size_t)(it >> 3) * DM + (int)(it & 7) * 256 + e0;
            ld_bf16x8(HF + off, f0[k], f1[k]); ld_bf16x8(HB + off, b0[k], b1[k]); ld_bf16x8(SO + off, o0[k], o1[k]); ld_bf16x8(SZ + off, z0[k], z1[k]); }
#pragma unroll
        for (int k = 0; k < 2; ++k) { const long it = it0 + 2 * k; const size_t off = (size_t)(it >> 3) * DM + (int)(it & 7) * 256 + e0;
            f32x4 y0 = o0[k] * (f0[k] + b0[k]), y1 = o1[k] * (f1[k] + b1[k]);
            float ss = 0.f;
#pragma unroll
            for (int q = 0; q < 4; ++q) ss += y0[q] * y0[q] + y1[q] * y1[q];
            ss += __shfl_xor(ss, 1); ss += __shfl_xor(ss, 2); ss += __shfl_xor(ss, 4); ss += __shfl_xor(ss, 8); ss += __shfl_xor(ss, 16);
            const float rs = 1.0f / sqrtf(ss * (1.f / 256.f) + EPS);
            const float* hp = hn + (int)(it & 7) * 256 + e0;
            const f32x4 h0 = *(const f32x4*)hp, h1 = *(const f32x4*)(hp + 4);
            st_bf16x8(U + off, y0 * rs * h0 * z0[k], y1 * rs * h1 * z1[k]); }
    }
}

DI void mlstm_layer(const Args& A, LAS unsigned char* lds, const XcdBarrier& gbar, int layer, int wv) {
    unsigned char* ws = A.ws;
    const bf16_t* H = (const bf16_t*)(ws + WS_H); bf16_t* U = (bf16_t*)(ws + WS_H);
    bf16_t* Q = (bf16_t*)(ws + WS_SCR + M_Q); bf16_t* Kb = (bf16_t*)(ws + WS_SCR + M_K); bf16_t* KVT = (bf16_t*)(ws + WS_SCR + M_KVT);
    float* G32 = (float*)(ws + WS_SCR + M_G32); bf16_t* SO = (bf16_t*)(ws + WS_SCR + M_SO); bf16_t* SZ = (bf16_t*)(ws + WS_SCR + M_SZ);
    norm_phase(A, layer, false, wv);
    xcd_barrier(gbar, wv);
    {
        DescM1 D; D.init(H, (const bf16_t*)(ws + WS_WMA), (const bf16_t*)(ws + WS_WMB));
        auto E = [=](const pg8::Unit& u, int row_l, int col_l, f32x4 v0, f32x4 v1) {
            if (u.i2 == 0) {
                const size_t row = (size_t)u.i0 * 256 + row_l; const int pn = u.i1;
                if (pn < 4) st_bf16x8(Q + row * 1024 + pn * 256 + col_l, v0 * 0.088388347648318440f, v1 * 0.088388347648318440f);
                else if (pn < 8) { st_bf16x8(Kb + row * 1024 + (pn - 4) * 256 + col_l, v0, v1);
                    const int bb = u.i0 / 9, sp = (u.i0 % 9) * 256 + row_l;
                    bf16_t* kt = KVT + ((size_t)bb * 3072 + (pn - 4) * 256 + col_l) * TB + sp;
                    const unsigned w0 = pk2(v0[0], v0[1]), w1 = pk2(v0[2], v0[3]), w2 = pk2(v1[0], v1[1]), w3 = pk2(v1[2], v1[3]);
                    kt[0] = (bf16_t)(w0 & 0xffffu); kt[TB] = (bf16_t)(w0 >> 16); kt[2 * TB] = (bf16_t)(w1 & 0xffffu); kt[3 * TB] = (bf16_t)(w1 >> 16);
                    kt[4 * TB] = (bf16_t)(w2 & 0xffffu); kt[5 * TB] = (bf16_t)(w2 >> 16); kt[6 * TB] = (bf16_t)(w3 & 0xffffu); kt[7 * TB] = (bf16_t)(w3 >> 16); }
                else if (col_l < 32) { *(f32x4*)(G32 + row * 32 + col_l) = v0; *(f32x4*)(G32 + row * 32 + col_l + 4) = v1; }
            } else {
                const int bb = u.i1 / 9, s0 = (u.i1 % 9) * 256;
                st_bf16x8(KVT + ((size_t)bb * 3072 + 1024 + u.i0 * 256 + row_l) * TB + s0 + col_l, v0, v1);
            }
        };
        pg8::gemm_phase(lds, D, E, wv);
    }
    xcd_barrier(gbar, wv);
    ml::scan_phase(A, lds, wv);
    xcd_barrier(gbar, wv);
    {
        DescPlain D; D.init(H, (const bf16_t*)(ws + WS_WMA) + (size_t)2304 * DM, 16, false);
        auto E = [=](const pg8::Unit& u, int row_l, int col_l, f32x4 v0, f32x4 v1) {
            const size_t row = (size_t)u.i0 * 256 + row_l; const int pn = u.i1; f32x4 a, b;
            if (pn < 8) {
#pragma unroll
                for (int q = 0; q < 4; ++q) { a[q] = sigmf(v0[q]); b[q] = sigmf(v1[q]); }
                st_bf16x8(SO + row * DM + pn * 256 + col_l, a, b);
            } else {
#pragma unroll
                for (int q = 0; q < 4; ++q) { a[q] = siluf(v0[q]); b[q] = siluf(v1[q]); }
                st_bf16x8(SZ + row * DM + (pn - 8) * 256 + col_l, a, b);
            }
        };
        pg8::gemm_phase(lds, D, E, wv);
    }
    xcd_barrier(gbar, wv);
    mlstm_finish_phase(A, wv);
    xcd_barrier(gbar, wv);
    {
        DescPlain D; D.init(U, (const bf16_t*)(ws + WS_WMO), 8, false);
        const float* modl = (const float*)(ws + WS_MOD) + (size_t)layer * 17 * MOD_LD;
        auto E = [=](const pg8::Unit& u, int row_l, int col_l, f32x4 v0, f32x4 v1) { resid_store(A, layer, u.i0, row_l, u.i1 * 256 + col_l, modl, v0, v1); };
        pg8::gemm_phase(lds, D, E, wv);
    }
    xcd_barrier(gbar, wv);
}

__global__ void __launch_bounds__(NTHREADS, 2) fwd_megakernel(Args A) {
    extern __shared__ __attribute__((aligned(16))) unsigned char lds_raw[];
    LAS unsigned char* lds = (LAS unsigned char*)lds_raw;
    cg::grid_group grid = cg::this_grid();
    const int wv = __builtin_amdgcn_readfirstlane(threadIdx.x >> 6);
    volatile LAS unsigned* bst = (volatile LAS unsigned*)(lds + 152576);
    if (otid(wv) < 2) bst[otid(wv)] = 0u;
    __syncthreads();
    const XcdBarrier gbar = xcd_barrier_post((unsigned*)(A.ws + WS_BAR), bst, wv);
    prep_phase(A, lds, wv);
    grid.sync();
    {
        const long long* mi = (const long long*)(A.ws + WS_MODI); float* mf = (float*)(A.ws + WS_MOD);
        for (int i = blockIdx.x * NTHREADS + otid(wv); i < 4 * 17 * MOD_LD; i += gridDim.x * NTHREADS) mf[i] = (float)mi[i] * MODI_INV;
    }
    xcd_barrier(gbar, wv);
    fnet_layer(A, lds, gbar, 0, 0, false, wv);
    mlstm_layer(A, lds, gbar, 1, wv);
    attn_layer(A, lds, (char*)lds_raw, gbar, 2, wv);
    fnet_layer(A, lds, gbar, 3, 1, true, wv);
    final_norm_phase(A, (const bf16_t*)(A.ws + WS_SCR + F_PQX), wv);
}

extern "C" void kernel_launch(void* const* d_in, const int* in_sizes, int n_in, void* d_out, int out_size, void* d_ws, size_t ws_size, hipStream_t stream) {
    static int grid = 0;
    if (grid == 0) {
        if (n_in != 18 || ws_size < WS_END) { fprintf(stderr, "kernel_launch: unexpected n_in %d / ws_size %zu (need %zu)\n", n_in, ws_size, (size_t)WS_END); grid = -1; return; }
        int dev = 0, cus = 0, per_cu = 0;
        hipGetDevice(&dev);
        hipDeviceGetAttribute(&cus, hipDeviceAttributeMultiprocessorCount, dev);
        if (hipFuncSetAttribute((const void*)fwd_megakernel, hipFuncAttributeMaxDynamicSharedMemorySize, LDS_BYTES) != hipSuccess) { fprintf(stderr, "kernel_launch: hipFuncSetAttribute failed\n"); grid = -1; return; }
        if (hipOccupancyMaxActiveBlocksPerMultiprocessor(&per_cu, (const void*)fwd_megakernel, NTHREADS, LDS_BYTES) != hipSuccess || per_cu < 1) { fprintf(stderr, "kernel_launch: occupancy query failed (%d)\n", per_cu); per_cu = 1; }
        (void)hipGetLastError();
        grid = cus * per_cu;
        fprintf(stderr, "kernel_launch: grid %d (cus %d x %d)\n", grid, cus, per_cu);
    }
    if (grid < 0) return;
    (void)hipMemsetAsync((char*)d_ws + WS_MOD, 0, ZERO_BYTES, stream);
    (void)hipMemsetAsync((char*)d_ws + WS_MODI, 0, MODI_BYTES, stream);
    Args a{};
    for (int i = 0; i < 18; ++i) a.in[i] = (const float*)d_in[i];
    a.out = (float*)d_out; a.ws = (unsigned char*)d_ws; a.ph_lo = 0; a.ph_hi = 100;
    void* args[] = {&a};
    hipError_t e = hipLaunchCooperativeKernel((const void*)fwd_megakernel, dim3(grid), dim3(NTHREADS), args, LDS_BYTES, stream);
    if (e != hipSuccess) fprintf(stderr, "kernel_launch: cooperative launch failed: %s (grid %d)\n", hipGetErrorString(e), grid);
}
```

```cpp
#include <hip/hip_runtime.h>
#include <hip/hip_cooperative_groups.h>
#include <cstdio>
#include <cstdint>
namespace cg = cooperative_groups;

#define LAS __attribute__((address_space(3)))
#define DI __device__ __forceinline__
typedef unsigned short bf16_t;
typedef short bf16x8 __attribute__((ext_vector_type(8)));
typedef short s16x4 __attribute__((ext_vector_type(4)));
typedef float f32x2 __attribute__((ext_vector_type(2)));
typedef float f32x4 __attribute__((ext_vector_type(4)));
typedef float f32x16 __attribute__((ext_vector_type(16)));
typedef unsigned u32x2 __attribute__((ext_vector_type(2)));
typedef unsigned u32x4 __attribute__((ext_vector_type(4)));
typedef __bf16 bf16v2 __attribute__((ext_vector_type(2)));

constexpr int DM = 2048, NB = 16, TL = 2048, TC = 256, TB = TL + TC, NTOK = NB * TB;
constexpr int NWAVES = 8, NTHREADS = 512;
constexpr float EPS = 1e-6f;
constexpr int MOD_LD = 3 * DM;
constexpr int M_WA_ROWS = 6400, M_WB_ROWS = 3072;
constexpr size_t MiB = 1u << 20;
constexpr size_t WS_SCR_ = 301 * MiB;
constexpr size_t WS_MOD = 0;
constexpr size_t MOD_BYTES = (size_t)4 * 17 * MOD_LD * 4;
constexpr size_t WS_BAR = 1792 * 1024, ZERO_BYTES = 2 * MiB;
constexpr size_t WS_MODI = WS_SCR_ + 700 * MiB, MODI_BYTES = (size_t)4 * 17 * MOD_LD * 8;
constexpr float MODI_SCALE = 1073741824.f, MODI_INV = 9.313225746154785e-10f;
constexpr size_t WS_WFG = 2 * MiB, WS_WFO = 18 * MiB, WS_WMA = 34 * MiB, WS_WMB = 59 * MiB, WS_WMO = 71 * MiB, WS_WAI = 79 * MiB, WS_WAO = 99 * MiB;
constexpr size_t WS_DC = 107 * MiB, WS_DT = 108 * MiB, WS_DT2 = 124 * MiB, WS_CTXS = 125 * MiB, WS_H = 157 * MiB, WS_SCR = 301 * MiB;
constexpr size_t WS_END = 1024 * MiB;
constexpr size_t F_G = 0, F_PQX = 144 * MiB, F_PQC = 400 * MiB, F_A1 = 432 * MiB;
constexpr size_t M_Q = 0, M_K = 72 * MiB, M_KVT = 144 * MiB, M_G32 = 360 * MiB, M_HF = 365 * MiB, M_HB = 509 * MiB, M_SO = 0, M_SZ = 144 * MiB;
constexpr size_t A_Q = 0, A_K = 144 * MiB, A_V = 180 * MiB, A_SZ = 216 * MiB;
static_assert(WS_SCR + M_HB + 144 * MiB <= WS_END, "ws map");
constexpr int LDS_BYTES = 152576 + 1024;

DI unsigned pk2(float a, float b) { f32x2 v = {a, b}; return __builtin_bit_cast(unsigned, __builtin_convertvector(v, bf16v2)); }
DI float bf_lo(unsigned w) { return __uint_as_float(w << 16); }
DI float bf_hi(unsigned w) { return __uint_as_float(w & 0xffff0000u); }
DI float wave_sum(float v) {
#pragma unroll
    for (int o = 1; o < 64; o <<= 1) v += __shfl_xor(v, o);
    return v;
}
DI int otid(int wv) { int t; asm volatile("v_mbcnt_lo_u32_b32 %0, -1, 0\n\tv_mbcnt_hi_u32_b32 %0, -1, %0" : "=v"(t)); return wv * 64 + t; }
DI float siluf(float x) { return x * __builtin_amdgcn_rcpf(1.f + __expf(-x)); }
DI float sigmf(float x) { return __builtin_amdgcn_rcpf(1.f + __expf(-x)); }
DI void st_bf16x8(bf16_t* p, f32x4 a, f32x4 b) { u32x4 w = {pk2(a[0], a[1]), pk2(a[2], a[3]), pk2(b[0], b[1]), pk2(b[2], b[3])}; *(u32x4*)p = w; }
DI void ld_bf16x8(const bf16_t* p, f32x4& a, f32x4& b) { const u32x4 w = *(const u32x4*)p; a = (f32x4){bf_lo(w.x), bf_hi(w.x), bf_lo(w.y), bf_hi(w.y)}; b = (f32x4){bf_lo(w.z), bf_hi(w.z), bf_lo(w.w), bf_hi(w.w)}; }

DI f32x4 ldmod4(const long long* p) { return (f32x4){(float)p[0] * MODI_INV, (float)p[1] * MODI_INV, (float)p[2] * MODI_INV, (float)p[3] * MODI_INV}; }

struct Args { const float* in[18]; float* out; unsigned char* ws; int ph_lo, ph_hi; };

#define XB_TMO      128
#define XB_XCNT(j)  (256  + 64 * (j))
#define XB_XSUB(j)  (1280 + 64 * (j))
#define XB_XGEN(j)  (2304 + 64 * (j))
#define XB_TOP      3328
#define XB_TOPGEN   3392
#define XCD_BAR_WORDS 3456
#define XB_SPIN_CAP (1u << 18)

__device__ __forceinline__ unsigned xb_ld(unsigned* p)              { return __hip_atomic_load(p, __ATOMIC_RELAXED, __HIP_MEMORY_SCOPE_AGENT); }
__device__ __forceinline__ unsigned xb_add(unsigned* p, unsigned v) { return __hip_atomic_fetch_add(p, v, __ATOMIC_RELAXED, __HIP_MEMORY_SCOPE_AGENT); }
__device__ __forceinline__ unsigned xb_xcc_id() { return (unsigned)__builtin_amdgcn_s_getreg((3 << 11) | 20) & 0xFu; }
#define XB_SPIN(cond, bar) do { unsigned _sp = 0; while (cond) { __builtin_amdgcn_s_sleep(1); \
    if ((++_sp & 255u) == 0u) { if (xb_ld(&(bar)[XB_TMO])) break; if (_sp > XB_SPIN_CAP) { atomicAdd(&(bar)[XB_TMO], 1u); break; } } } } while (0)

struct XcdBarrier {
    unsigned* bar; unsigned x;
    volatile LAS unsigned* st;
};

__device__ __forceinline__ XcdBarrier xcd_barrier_post(unsigned* bar, volatile LAS unsigned* st, int wv) {
    XcdBarrier b; b.bar = bar; b.x = xb_xcc_id(); b.st = st;
    if (otid(wv) == 0) (void)xb_add(&bar[XB_XCNT(b.x)], 1u);
    return b;
}
__device__ __forceinline__ void xcd_barrier_complete(unsigned* bar, unsigned x, unsigned& nloc, unsigned& nx) {
    const unsigned G = gridDim.x * gridDim.y * gridDim.z;
    unsigned sum, cnt, mine, sp = 0u;
    for (;;) {
        sum = 0u; cnt = 0u; mine = 0u;
#pragma unroll
        for (unsigned j = 0; j < 16; ++j) { const unsigned c = xb_ld(&bar[XB_XCNT(j)]); sum += c; cnt += (c > 0u) ? 1u : 0u; mine = (j == x) ? c : mine; }
        if (sum == G) break;
        __builtin_amdgcn_s_sleep(1);
        if ((++sp & 255u) == 0u) { if (xb_ld(&bar[XB_TMO])) break; if (sp > XB_SPIN_CAP) { atomicAdd(&bar[XB_TMO], 1u); break; } }
    }
    nloc = mine > 0u ? mine : 1u; nx = cnt > 0u ? cnt : 1u;
}

__device__ __forceinline__ void xcd_barrier(const XcdBarrier& b, int wv) {
    asm volatile("s_waitcnt vmcnt(0)" ::: "memory");
    __syncthreads();
    if (otid(wv) == 0) {
        unsigned* bar = b.bar;
        __builtin_amdgcn_s_waitcnt(0);
        unsigned nloc = b.st[0], nx = b.st[1];
        if (nloc == 0u) { xcd_barrier_complete(bar, b.x, nloc, nx); b.st[0] = nloc; b.st[1] = nx; }
        const unsigned old = xb_add(&bar[XB_XSUB(b.x)], 1u);
        const unsigned gen = old / nloc;
        if (old + 1u == (gen + 1u) * nloc) {
            __builtin_amdgcn_fence(__ATOMIC_RELEASE, "agent");
            asm volatile("s_waitcnt vmcnt(0)" ::: "memory");
            const unsigned og = xb_add(&bar[XB_TOP], 1u);
            const unsigned tg = og / nx;
            if (og + 1u == (tg + 1u) * nx) xb_add(&bar[XB_TOPGEN], 1u);
            else XB_SPIN(xb_ld(&bar[XB_TOPGEN]) == tg, bar);
            __builtin_amdgcn_fence(__ATOMIC_ACQUIRE, "agent");
            xb_add(&bar[XB_XGEN(b.x)], 1u);
            asm volatile("s_waitcnt vmcnt(0)" ::: "memory");
        } else {
            XB_SPIN(xb_ld(&bar[XB_XGEN(b.x)]) == gen, bar);
            __builtin_amdgcn_fence(__ATOMIC_ACQUIRE, "agent");
            asm volatile("s_waitcnt vmcnt(0)" ::: "memory");
        }
    }
    __syncthreads();
}


namespace pg8 {
constexpr int BM = 256, BK = 64, HALF = 128, HTB = HALF * BK * 2, NXCD = 8;
DI int lds_byte(int r, int c) { const int st = (r >> 4) * 2 + (c >> 5), rr = r & 15, cc = c & 31, ob = rr * 64 + cc * 2; return st * 1024 + (ob ^ (((ob >> 9) & 1) << 5)); }
DI void stage_rc(int b, int& R, int& C) { const int st = b / 1024, sb = b % 1024, swz = sb ^ (((sb >> 9) & 1) << 5); R = (st >> 1) * 16 + swz / 64; C = (st & 1) * 32 + (swz % 64) / 2; }
DI int perm32(int rho) { const int n = rho >> 4, i = rho & 15; return 8 * (i >> 2) + 4 * n + (i & 3); }
struct Unit { const char* a; const char* b; int i0, i1, i2; };
DI int xcd_remap(int L, int total) { const int q = total / NXCD, r = total % NXCD, xcd = L % NXCD, off = L / NXCD; return (xcd < r ? xcd * (q + 1) : r * (q + 1) + (xcd - r) * q) + off; }

template <class Desc, class Epi>
DI void gemm_phase(LAS unsigned char* lds, const Desc& D, const Epi& E, int wv) {
    const int tid = otid(wv), wid = __builtin_amdgcn_readfirstlane(tid >> 6), lane = tid & 63, wr = wid >> 2, wc = wid & 3, fr = lane & 15, fq = lane >> 4;
    const int G = gridDim.x, c = blockIdx.x, total = D.total;
    const int K = D.K, nt = K / BK;
    unsigned voffA[2], voffB[2];
#pragma unroll
    for (int i = 0; i < 2; ++i) { int R, C; stage_rc(tid * 16 + i * 8192, R, C); const int Rb = (R & ~31) + perm32(R & 31);
        voffA[i] = (unsigned)(R * D.lda + C) * 2u; voffB[i] = (unsigned)(Rb * D.ldb + C) * 2u; }
    const size_t kstep = (size_t)(BK * 2);
    const size_t hstepA = (size_t)HALF * D.lda * 2, hstepB = (size_t)HALF * D.ldb * 2;
    const unsigned ldsw = (unsigned)wid * 1024u;
    const int aoff = lds_byte(wr * 64 + fr, fq * 8), boff = lds_byte(wc * 32 + fr, fq * 8);
#define PG8_SA(b, h) (((b) * 2 + (h)) * HTB)
#define PG8_SB(b, h) ((4 + (b) * 2 + (h)) * HTB)
#define PG8_STAGE(bufoff, gbase, voff) do { _Pragma("unroll") for (int _i = 0; _i < 2; ++_i) \
        __builtin_amdgcn_global_load_lds((const unsigned*)((const char*)(gbase) + (voff)[_i]), (LAS unsigned*)(lds + (bufoff) + ldsw + _i * 8192), 16, 0, 0); } while (0)
#define PG8_LDA(dst, b, h) do { _Pragma("unroll") for (int m = 0; m < 4; ++m) _Pragma("unroll") for (int k = 0; k < 2; ++k) dst[m][k] = *(const LAS bf16x8*)(lds + PG8_SA(b, h) + aoff + m * 2048 + k * 1024); } while (0)
#define PG8_LDB(dst, b, h) do { _Pragma("unroll") for (int n = 0; n < 2; ++n) _Pragma("unroll") for (int k = 0; k < 2; ++k) dst[n][k] = *(const LAS bf16x8*)(lds + PG8_SB(b, h) + boff + n * 2048 + k * 1024); } while (0)
#define PG8_MMA(ai, bj, At, Bt) do { __builtin_amdgcn_s_setprio(1); _Pragma("unroll") for (int m = 0; m < 4; ++m) _Pragma("unroll") for (int n = 0; n < 2; ++n) _Pragma("unroll") for (int k = 0; k < 2; ++k) \
        acc[ai][bj][m][n] = __builtin_amdgcn_mfma_f32_16x16x32_bf16(Bt[n][k], At[m][k], acc[ai][bj][m][n], 0, 0, 0); __builtin_amdgcn_s_setprio(0); } while (0)
#define PG8_WAIT_V(n) asm volatile("s_waitcnt vmcnt(" #n ")" ::: "memory")
#define PG8_WAIT_L(n) asm volatile("s_waitcnt lgkmcnt(" #n ")" ::: "memory")
#define PG8_BAR __builtin_amdgcn_s_barrier()
#define PG8_SCHED __builtin_amdgcn_sched_barrier(0)
    if constexpr (Desc::RAW) { if (!D.valid(c, G)) return; } else { if (c >= total) return; }
    Unit cur, nxt; int ui = 0;
    if constexpr (Desc::RAW) cur = D.unit(c, G); else cur = D.unit(xcd_remap(c, total));
    nxt = cur;
    f32x4 acc[2][2][4][2];
#pragma unroll
    for (int a = 0; a < 2; ++a)
#pragma unroll
        for (int b = 0; b < 2; ++b)
#pragma unroll
            for (int m = 0; m < 4; ++m)
#pragma unroll
                for (int n = 0; n < 2; ++n) acc[a][b][m][n] = (f32x4){0.f, 0.f, 0.f, 0.f};
    bf16x8 At[4][2], B0[2][2], B1[2][2];
    const char* cA = cur.a; const char* cB = cur.b;
    PG8_STAGE(PG8_SB(0, 0), cB, voffB); PG8_STAGE(PG8_SB(0, 1), cB + hstepB, voffB); PG8_STAGE(PG8_SA(0, 0), cA, voffA); PG8_STAGE(PG8_SA(0, 1), cA + hstepA, voffA);
    if (wr == 1) PG8_BAR;
    PG8_WAIT_V(2); PG8_BAR;
    PG8_STAGE(PG8_SB(1, 0), cB + kstep, voffB); PG8_STAGE(PG8_SA(1, 0), cA + kstep, voffA); PG8_STAGE(PG8_SB(1, 1), cB + hstepB + kstep, voffB);
    PG8_WAIT_V(6); PG8_BAR;
    for (;;) {
        const long Ln = (long)(ui + 1) * G + c;
        bool has_next;
        if constexpr (Desc::RAW) { has_next = D.valid((int)Ln, G); if (has_next) nxt = D.unit((int)Ln, G); }
        else { has_next = Ln < total; if (has_next) nxt = D.unit(xcd_remap((int)Ln, total)); }
        const char* nA = has_next ? nxt.a : cA; const char* nB = has_next ? nxt.b : cB;
        for (int t = 0; t < nt; t += 2) {
            const bool last = (t == nt - 2);
            const char* a1 = cA + (size_t)(t + 1) * kstep;
            const char* a2 = last ? nA : cA + (size_t)(t + 2) * kstep; const char* b2 = last ? nB : cB + (size_t)(t + 2) * kstep;
            const char* a3 = a2 + kstep; const char* b3 = b2 + kstep;
            PG8_LDB(B0, 0, 0); PG8_LDB(B1, 0, 1); PG8_SCHED; PG8_LDA(At, 0, 0); PG8_STAGE(PG8_SA(1, 1), a1 + hstepA, voffA);
            PG8_WAIT_V(8); PG8_WAIT_L(0); PG8_BAR; PG8_MMA(0, 0, At, B0); PG8_MMA(0, 1, At, B1); PG8_BAR; PG8_SCHED;
            PG8_LDA(At, 0, 1); PG8_STAGE(PG8_SB(0, 0), b2, voffB); PG8_STAGE(PG8_SB(0, 1), b2 + hstepB, voffB); PG8_STAGE(PG8_SA(0, 0), a2, voffA);
            PG8_WAIT_V(8); PG8_WAIT_L(0); PG8_BAR; PG8_MMA(1, 0, At, B0); PG8_MMA(1, 1, At, B1); PG8_BAR; PG8_SCHED;
            PG8_LDB(B0, 1, 0); PG8_LDB(B1, 1, 1); PG8_SCHED; PG8_LDA(At, 1, 0); PG8_STAGE(PG8_SA(0, 1), a2 + hstepA, voffA);
            PG8_WAIT_V(8); PG8_WAIT_L(0); PG8_BAR; PG8_MMA(0, 0, At, B0); PG8_MMA(0, 1, At, B1); PG8_BAR; PG8_SCHED;
            PG8_LDA(At, 1, 1); PG8_STAGE(PG8_SB(1, 0), b3, voffB); PG8_STAGE(PG8_SB(1, 1), b3 + hstepB, voffB); PG8_STAGE(PG8_SA(1, 0), a3, voffA);
            PG8_WAIT_V(8); PG8_WAIT_L(0); PG8_BAR; PG8_MMA(1, 0, At, B0); PG8_MMA(1, 1, At, B1); PG8_BAR; PG8_SCHED;
        }
        if (wr == 0) PG8_BAR;
        {
            const int le = otid(wv) & 63, fre = le & 15, fqe = le >> 4;
#pragma unroll
            for (int ai = 0; ai < 2; ++ai)
#pragma unroll
                for (int m = 0; m < 4; ++m)
#pragma unroll
                    for (int bj = 0; bj < 2; ++bj)
                        E(cur, ai * HALF + wr * 64 + m * 16 + fre, bj * HALF + wc * 32 + 8 * fqe, acc[ai][bj][m][0], acc[ai][bj][m][1]);
        }
        if (!has_next) break;
#pragma unroll
        for (int a = 0; a < 2; ++a)
#pragma unroll
            for (int b = 0; b < 2; ++b)
#pragma unroll
                for (int m = 0; m < 4; ++m)
#pragma unroll
                    for (int n = 0; n < 2; ++n) acc[a][b][m][n] = (f32x4){0.f, 0.f, 0.f, 0.f};
        cur = nxt; cA = nA; cB = nB; ++ui;
        if (wr == 1) PG8_BAR;
    }
    PG8_WAIT_V(0);
    PG8_BAR;
#undef PG8_SA
#undef PG8_SB
#undef PG8_STAGE
#undef PG8_LDA
#undef PG8_LDB
#undef PG8_MMA
#undef PG8_WAIT_V
#undef PG8_WAIT_L
#undef PG8_BAR
#undef PG8_SCHED
}
}

DI void transpose_item(const float* W, int N, int kb, int nb, bf16_t* d0, bf16_t* d1, int K, LAS float* scr, int lane) {
    const int k0 = 64 * kb, n0 = 32 * nb;
#pragma unroll 8
    for (int i = 0; i < 32; ++i) { const int kk = 2 * i + (lane >> 5); scr[kk * 33 + (lane & 31)] = W[(size_t)(k0 + kk) * N + n0 + (lane & 31)]; }
    asm volatile("s_waitcnt lgkmcnt(0)" ::: "memory");
    const int c = lane & 7;
#pragma unroll
    for (int j = 0; j < 4; ++j) { const int n = (lane >> 3) + 8 * j; const LAS float* s = scr + (8 * c) * 33 + n;
        u32x4 o; o.x = pk2(s[0 * 33], s[1 * 33]); o.y = pk2(s[2 * 33], s[3 * 33]); o.z = pk2(s[4 * 33], s[5 * 33]); o.w = pk2(s[6 * 33], s[7 * 33]);
        *(u32x4*)(d0 + (size_t)n * K + k0 + 8 * c) = o;
        if (d1) *(u32x4*)(d1 + (size_t)n * K + k0 + 8 * c) = o; }
    asm volatile("s_waitcnt lgkmcnt(0)" ::: "memory");
}

DI void prep_phase(const Args& A, LAS unsigned char* lds, int wv) {
    const int tid = otid(wv), lane = tid & 63, wave = tid >> 6, G = gridDim.x;
    unsigned char* ws = A.ws;
    {
        LAS float* s_lds = (LAS float*)lds;
        const float* cc = A.in[1]; const float* cctx = A.in[3]; const float* aw = A.in[4]; const float* ab = A.in[5];
        long long* modi = (long long*)(ws + WS_MODI);
        for (int item = blockIdx.x; item < 768; item += G) {
            const int kc = item % 16, cb = (item / 16) % 12, l = item / 192;
            const int k0 = kc * 128, j = cb * 512 + tid;
            __syncthreads();
            for (int e = tid; e < 17 * 128; e += NTHREADS) { const int r = e / 128, k = e % 128; const float v = r < 16 ? cc[r * DM + k0 + k] : cctx[k0 + k]; s_lds[k * 20 + r] = siluf(v); }
            __syncthreads();
            float acc[17];
#pragma unroll
            for (int r = 0; r < 17; ++r) acc[r] = 0.f;
            const float* wp = aw + ((size_t)l * DM + k0) * MOD_LD + j;
#pragma unroll 4
            for (int k = 0; k < 128; ++k) {
                const float w = wp[(size_t)k * MOD_LD];
                const LAS f32x4* sp = (const LAS f32x4*)(s_lds + k * 20);
                const f32x4 s0 = sp[0], s1 = sp[1], s2 = sp[2], s3 = sp[3]; const float s4 = s_lds[k * 20 + 16];
#pragma unroll
                for (int q = 0; q < 4; ++q) { acc[q] += s0[q] * w; acc[4 + q] += s1[q] * w; acc[8 + q] += s2[q] * w; acc[12 + q] += s3[q] * w; }
                acc[16] += s4 * w;
            }
            const float bias = (kc == 0) ? ab[l * MOD_LD + j] : 0.f;
#pragma unroll
            for (int r = 0; r < 17; ++r) atomicAdd((unsigned long long*)&modi[(size_t)(l * 17 + r) * MOD_LD + j], (unsigned long long)__float2ll_rn((acc[r] + bias) * MODI_SCALE));
        }
        __syncthreads();
    }
    {
        LAS float* scr = (LAS float*)(lds + wave * 16384);
        const int gw = blockIdx.x * NWAVES + wave, NGW = G * NWAVES;
        constexpr int I_SQ = 32 * 64, I_AI = 32 * 160, I_MI = 32 * 257;
        constexpr int NIT = 6 * I_SQ + I_AI + I_MI;
        for (int it = gw; it < NIT; it += NGW) {
            int r = it;
            if (r < 6 * I_SQ) {
                const int w = r / I_SQ; r -= w * I_SQ;
                const float* src; bf16_t* dst;
                if (w < 2)      { src = A.in[7] + (size_t)w * DM * DM;       dst = (bf16_t*)(ws + WS_WFG) + (size_t)w * DM * DM; }
                else if (w < 4) { src = A.in[8] + (size_t)(w - 2) * DM * DM; dst = (bf16_t*)(ws + WS_WFO) + (size_t)(w - 2) * DM * DM; }
                else if (w == 4) { src = A.in[12]; dst = (bf16_t*)(ws + WS_WMO); }
                else             { src = A.in[16]; dst = (bf16_t*)(ws + WS_WAO); }
                const int kb = r / 64, nb = r % 64;
                transpose_item(src, DM, kb, nb, dst + (size_t)(32 * nb) * DM, nullptr, DM, scr, lane);
                continue;
            }
            r -= 6 * I_SQ;
            if (r < I_AI) { const int kb = r / 160, nb = r % 160; transpose_item(A.in[13], 5120, kb, nb, (bf16_t*)(ws + WS_WAI) + (size_t)(32 * nb) * DM, nullptr, DM, scr, lane); continue; }
            r -= I_AI;
            {
                const int kb = r / 257, nb = r % 257, n0 = 32 * nb;
                bf16_t* WA = (bf16_t*)(ws + WS_WMA); bf16_t* WB = (bf16_t*)(ws + WS_WMB);
                bf16_t* d0; bf16_t* d1 = nullptr;
                if (n0 < 1024) d0 = WA + (size_t)n0 * DM;
                else if (n0 < 2048) d0 = WA + (size_t)n0 * DM;
                else if (n0 < 4096) d0 = WB + (size_t)(n0 - 2048) * DM;
                else if (n0 < 6144) d0 = WA + (size_t)(2304 + n0 - 4096) * DM;
                else if (n0 < 6176) d0 = WA + (size_t)(2048 + n0 - 6144) * DM;
                else d0 = WA + (size_t)(4352 + n0 - 6176) * DM;
                transpose_item(A.in[9], 8224, kb, nb, d0, d1, DM, scr, lane);
            }
        }
    }
    {
        const long gt = (long)blockIdx.x * NTHREADS + tid, NGT = (long)G * NTHREADS;
        constexpr long N_DC = 1024L * 512 / 8, N_DT = 2048L * 4096 / 8, N_DT2 = 256L * 512 / 8;
        for (long it = gt; it < N_DC + N_DT + N_DT2; it += NGT) {
            float v[8]; bf16_t* dst;
            if (it < N_DC) {
                const int m = (int)(it / 64), k0 = (int)(it % 64) * 8; const float sc = 0.044194173824159216f;
#pragma unroll
                for (int j = 0; j < 8; ++j) { const int rr = ((m & 511) * (k0 + j)) & 511; const float ang = (float)rr * (1.f / 256.f); v[j] = (m < 512 ? cospif(ang) : sinpif(ang)) * sc; }
                dst = (bf16_t*)(ws + WS_DC) + (size_t)m * 512 + k0;
            } else if (it < N_DC + N_DT) {
                const long i2 = it - N_DC; const int kk = (int)(i2 / 512), s0 = (int)(i2 % 512) * 8; const float sc = 0.022097086912079608f;
#pragma unroll
                for (int j = 0; j < 8; ++j) { const int s = s0 + j; const int rr = (kk * (s & 2047)) & 2047; const float ang = (float)rr * (1.f / 1024.f); v[j] = (s < 2048 ? cospif(ang) : -sinpif(ang)) * sc; }
                dst = (bf16_t*)(ws + WS_DT) + (size_t)kk * 4096 + s0;
            } else {
                const long i2 = it - N_DC - N_DT; const int kk = (int)(i2 / 64), s0 = (int)(i2 % 64) * 8; const float sc = 0.0625f;
#pragma unroll
                for (int j = 0; j < 8; ++j) { const int s = s0 + j; const int rr = (kk * (s & 255)) & 255; const float ang = (float)rr * (1.f / 128.f); v[j] = (s < 256 ? cospif(ang) : -sinpif(ang)) * sc; }
                dst = (bf16_t*)(ws + WS_DT2) + (size_t)kk * 512 + s0;
            }
            u32x4 o = {pk2(v[0], v[1]), pk2(v[2], v[3]), pk2(v[4], v[5]), pk2(v[6], v[7])};
            *(u32x4*)dst = o;
        }
    }
}

DI const float* xrow_in(const Args& A, int r) {
    const int b = r / TB, t = r % TB;
    if (t < TL) return A.in[0] + ((size_t)b * TL + t) * DM;
    return A.in[2] + ((size_t)b * TC + (t - TL)) * DM;
}
DI void norm_phase(const Args& A, int layer, bool latonly, int wv) {
    const int tid = otid(wv), lane = tid & 63, wave = tid >> 6, G = gridDim.x;
    const float* ng = A.in[6] + (size_t)layer * DM;
    const float* mod = (const float*)(A.ws + WS_MOD) + (size_t)layer * 17 * MOD_LD;
    bf16_t* H = (bf16_t*)(A.ws + WS_H);
    const bf16_t* XB = (const bf16_t*)A.out;
    for (int r0 = (blockIdx.x * NWAVES + wave) * 2; r0 < NTOK; r0 += G * NWAVES * 2) {
        const int b = r0 / TB, t = r0 % TB;
        if (latonly && t >= TL) continue;
        const float* mr = mod + (size_t)(t < TL ? b : 16) * MOD_LD;
        f32x4 v[2][4][2];
#pragma unroll
        for (int k = 0; k < 2; ++k) {
            const int r = r0 + k;
            if (layer == 0) {
                const float* xr = xrow_in(A, r);
#pragma unroll
                for (int j = 0; j < 4; ++j) { const f32x4* p = (const f32x4*)(xr + 512 * j + 8 * lane); v[k][j][0] = p[0]; v[k][j][1] = p[1]; }
            } else {
#pragma unroll
                for (int j = 0; j < 4; ++j) ld_bf16x8(XB + (size_t)r * DM + 512 * j + 8 * lane, v[k][j][0], v[k][j][1]);
            }
        }
#pragma unroll
        for (int k = 0; k < 2; ++k) {
            const int r = r0 + k; float ss = 0.f;
#pragma unroll
            for (int j = 0; j < 4; ++j)
#pragma unroll
                for (int q = 0; q < 4; ++q) ss += v[k][j][0][q] * v[k][j][0][q] + v[k][j][1][q] * v[k][j][1][q];
            const float rs = 1.0f / sqrtf(wave_sum(ss) * (1.f / DM) + EPS);
#pragma unroll
            for (int j = 0; j < 4; ++j) { const int c0 = 512 * j + 8 * lane; f32x4 o[2];
#pragma unroll
                for (int h = 0; h < 2; ++h) { const f32x4 g4 = *(const f32x4*)(ng + c0 + 4 * h), sh = *(const f32x4*)(mr + c0 + 4 * h), sc = *(const f32x4*)(mr + DM + c0 + 4 * h);
                    o[h] = (v[k][j][h] * rs) * g4 * (sc + 1.0f) + sh; }
                st_bf16x8(H + (size_t)r * DM + c0, o[0], o[1]); }
        }
    }
}
DI void final_norm_phase(const Args& A, const bf16_t* src, int wv) {
    const int tid = otid(wv), lane = tid & 63, wave = tid >> 6, G = gridDim.x;
    const float* fg = A.in[17];
    for (int r0 = (blockIdx.x * NWAVES + wave) * 2; r0 < NB * TL; r0 += G * NWAVES * 2) {
        f32x4 v[2][4][2];
#pragma unroll
        for (int k = 0; k < 2; ++k)
#pragma unroll
            for (int j = 0; j < 4; ++j) ld_bf16x8(src + (size_t)(r0 + k) * DM + 512 * j + 8 * lane, v[k][j][0], v[k][j][1]);
#pragma unroll
        for (int k = 0; k < 2; ++k) { float* orow = A.out + (size_t)(r0 + k) * DM; float ss = 0.f;
#pragma unroll
            for (int j = 0; j < 4; ++j)
#pragma unroll
                for (int q = 0; q < 4; ++q) ss += v[k][j][0][q] * v[k][j][0][q] + v[k][j][1][q] * v[k][j][1][q];
            const float rs = 1.0f / sqrtf(wave_sum(ss) * (1.f / DM) + EPS);
#pragma unroll
            for (int j = 0; j < 4; ++j) { const int c0 = 512 * j + 8 * lane;
#pragma unroll
                for (int h = 0; h < 2; ++h) { const f32x4 g4 = *(const f32x4*)(fg + c0 + 4 * h); *(f32x4*)(orow + c0 + 4 * h) = (v[k][j][h] * rs) * g4; } }
        }
    }
}

struct DescPlain {
    static constexpr bool RAW = false;
    const bf16_t* A; const bf16_t* B; int nN; bool latonly; int lda, ldb, K, total;
    DI void init(const bf16_t* A_, const bf16_t* B_, int nN_, bool lat) { A = A_; B = B_; nN = nN_; latonly = lat; lda = DM; ldb = DM; K = DM; total = (lat ? 128 : 144) * nN_; }
    DI pg8::Unit unit(int idx) const {
        const int nMt = latonly ? 128 : 144, nig = 8 * nN, gid = idx / nig, fm = gid * 8, gsz = (nMt - fm) < 8 ? (nMt - fm) : 8;
        const int pmi = fm + (idx % nig) % gsz, pn = (idx % nig) / gsz, pm = latonly ? (pmi / 8) * 9 + (pmi % 8) : pmi;
        pg8::Unit u; u.a = (const char*)(A + (size_t)pm * 256 * DM); u.b = (const char*)(B + (size_t)pn * 256 * DM); u.i0 = pm; u.i1 = pn; u.i2 = 0; return u;
    }
};
struct DescChan {
    static constexpr bool RAW = false;
    const bf16_t* DC; const bf16_t* H; int lda, ldb, K, total;
    DI void init(const bf16_t* DC_, const bf16_t* H_, bool lat) { DC = DC_; H = H_; lda = 512; ldb = DM; K = 512; total = lat ? 2048 : 2304; }
    DI pg8::Unit unit(int idx) const {
        pg8::Unit u; int b, g, mt, nt, toff;
        if (idx < 2048) { mt = idx % 4; nt = (idx / 4) % 8; g = (idx / 32) % 4; b = idx / 128; toff = nt * 256; u.i2 = nt; }
        else { const int j = idx - 2048; mt = j % 4; g = (j / 4) % 4; b = j / 16; toff = TL; u.i2 = 8; }
        u.a = (const char*)(DC + (size_t)mt * 256 * 512); u.b = (const char*)(H + ((size_t)b * TB + toff) * DM + g * 512); u.i0 = b * 4 + g; u.i1 = mt; return u;
    }
};
struct DescT {
    static constexpr bool RAW = false;
    const bf16_t* DT; const bf16_t* PQ; int nMt; int lda, ldb, K, total;
    DI void init(const bf16_t* DT_, const bf16_t* PQ_, int ld, int Kd, int coff, int nMt_) { DT = DT_ + coff; PQ = PQ_ + coff; nMt = nMt_; lda = ld; ldb = ld; K = Kd; total = NB * nMt_ * 8; }
    DI pg8::Unit unit(int idx) const {
        const int mt = idx % nMt, nt = (idx / nMt) % 8, b = idx / (nMt * 8);
        pg8::Unit u; u.a = (const char*)(DT + (size_t)mt * 256 * lda); u.b = (const char*)(PQ + ((size_t)b * DM + nt * 256) * ldb); u.i0 = b; u.i1 = mt; u.i2 = nt; return u;
    }
};

struct DescT2 {
    static constexpr bool RAW = true;
    const bf16_t* DT; const bf16_t* PQ; int lda, ldb, K, total;
    DI void init(const bf16_t* DT_, const bf16_t* PQ_) { DT = DT_; PQ = PQ_; lda = 4096; ldb = 4096; K = 2048; total = 2 * NB * 4 * 8; }
    DI bool valid(int L, int G) const { return ((L / G) >> 1) * G + (L % G) < NB * 4 * 8; }
    DI pg8::Unit unit(int L, int G) const {
        const int i = L / G, pair = (i >> 1) * G + (L % G), part = i & 1;
        const int mt = pair % 4, nt = (pair / 4) % 8, b = pair / 32, coff = part * 2048;
        pg8::Unit u; u.a = (const char*)(DT + (size_t)mt * 256 * 4096 + coff); u.b = (const char*)(PQ + ((size_t)b * DM + nt * 256) * 4096 + coff); u.i0 = b; u.i1 = mt; u.i2 = part * 8 + nt; return u;
    }
};

DI void resid_store(const Args& A, int layer, int pm, int row_l, int col, const float* modl, f32x4 v0, f32x4 v1) {
    const int b = pm / 9, tt = pm % 9;
    const float* gp = modl + (size_t)(tt < 8 ? b : 16) * MOD_LD + 2 * DM + col;
    const f32x4 g0 = *(const f32x4*)gp, g1 = *(const f32x4*)(gp + 4);
    bf16_t* XB = (bf16_t*)A.out;
    const size_t roff = ((size_t)pm * 256 + row_l) * DM + col;
    f32x4 x0, x1;
    if (layer == 0) {
        const float* src = (tt < 8) ? A.in[0] + ((size_t)b * TL + tt * 256 + row_l) * DM + col : A.in[2] + ((size_t)b * TC + row_l) * DM + col;
        x0 = *(const f32x4*)src; x1 = *(const f32x4*)(src + 4);
    } else ld_bf16x8(XB + roff, x0, x1);
    x0 = x0 + g0 * v0; x1 = x1 + g1 * v1;
    if (layer == 3) st_bf16x8((bf16_t*)(A.ws + WS_SCR + F_PQX) + ((size_t)b * TL + tt * 256 + row_l) * DM + col, x0, x1);
    else st_bf16x8(XB + roff, x0, x1);
}

DI void fnet_layer(const Args& A, LAS unsigned char* lds, const XcdBarrier& gbar, int layer, int j, bool latonly, int wv) {
    unsigned char* ws = A.ws;
    const bf16_t* H = (const bf16_t*)(ws + WS_H); bf16_t* U = (bf16_t*)(ws + WS_H);
    bf16_t* Gt = (bf16_t*)(ws + WS_SCR + F_G); bf16_t* PQX = (bf16_t*)(ws + WS_SCR + F_PQX); bf16_t* PQC = (bf16_t*)(ws + WS_SCR + F_PQC);
    norm_phase(A, layer, latonly, wv);
    xcd_barrier(gbar, wv);
    {
        DescPlain D; D.init(H, (const bf16_t*)(ws + WS_WFG) + (size_t)j * DM * DM, 8, latonly);
        auto E = [=](const pg8::Unit& u, int row_l, int col_l, f32x4 v0, f32x4 v1) {
            f32x4 a, b;
#pragma unroll
            for (int q = 0; q < 4; ++q) { a[q] = siluf(v0[q]); b[q] = siluf(v1[q]); }
            st_bf16x8(Gt + ((size_t)u.i0 * 256 + row_l) * DM + u.i1 * 256 + col_l, a, b);
        };
        pg8::gemm_phase(lds, D, E, wv);
    }
    {
        DescChan D; D.init((const bf16_t*)(ws + WS_DC), H, latonly);
        auto E = [=](const pg8::Unit& u, int row_l, int col_l, f32x4 v0, f32x4 v1) {
            const int b = u.i0 >> 2, g = u.i0 & 3, mt = u.i1, half = mt >> 1, ch = g * 512 + (mt & 1) * 256 + row_l;
            bf16_t* dst = (u.i2 < 8) ? PQX + ((size_t)b * DM + ch) * 4096 + half * 2048 + u.i2 * 256 + col_l
                                     : PQC + ((size_t)b * DM + ch) * 512 + half * 256 + col_l;
            st_bf16x8(dst, v0, v1);
        };
        pg8::gemm_phase(lds, D, E, wv);
    }
    xcd_barrier(gbar, wv);
    bf16_t* A1 = (bf16_t*)(ws + WS_SCR + F_A1);
    {
        const int tid = otid(wv), lane = tid & 63;
        for (int rr0 = (blockIdx.x * NWAVES + wv) * 4; rr0 < NB * DM; rr0 += gridDim.x * NWAVES * 4) {
            u32x4 raw[4][4];
#pragma unroll
            for (int k = 0; k < 4; ++k)
#pragma unroll
                for (int q = 0; q < 4; ++q) raw[k][q] = *(const u32x4*)(PQX + (size_t)(rr0 + k) * 4096 + (q * 64 + lane) * 8);
#pragma unroll
            for (int k = 0; k < 4; ++k) { float acc = 0.f;
#pragma unroll
                for (int q = 0; q < 4; ++q) { const u32x4 w = raw[k][q]; acc += (bf_lo(w.x) - bf_hi(w.x)) + (bf_lo(w.y) - bf_hi(w.y)) + (bf_lo(w.z) - bf_hi(w.z)) + (bf_lo(w.w) - bf_hi(w.w)); }
                acc = wave_sum(acc);
                if (lane == 0) { const int rr = rr0 + k; const size_t off = ((size_t)(rr >> 11) * TB + 1024) * DM + (rr & 2047);
                    U[off] = (bf16_t)(pk2(acc * 0.022097086912079608f * __uint_as_float((unsigned)Gt[off] << 16), 0.f) & 0xffffu); } }
        }
    }
    {
        DescT2 D; D.init((const bf16_t*)(ws + WS_DT), PQX);
        auto E = [=](const pg8::Unit& u, int row_l, int col_l, f32x4 v0, f32x4 v1) {
            const int k = u.i1 * 256 + row_l, col = (u.i2 & 7) * 256 + col_l;
            bf16_t* ap = A1 + ((size_t)u.i0 * 1024 + k) * DM + col;
            if (u.i2 < 8) { st_bf16x8(ap, v0, v1); return; }
            f32x4 a0, a1; ld_bf16x8(ap, a0, a1);
            const size_t off = ((size_t)u.i0 * TB + k) * DM + col;
            f32x4 g0, g1; ld_bf16x8(Gt + off, g0, g1);
            st_bf16x8(U + off, (a0 + v0) * g0, (a1 + v1) * g1);
            if (k != 0) { const size_t off2 = ((size_t)u.i0 * TB + (TL - k)) * DM + col; ld_bf16x8(Gt + off2, g0, g1); st_bf16x8(U + off2, (a0 - v0) * g0, (a1 - v1) * g1); }
        };
        pg8::gemm_phase(lds, D, E, wv);
    }
    if (!latonly) {
        DescT D; D.init((const bf16_t*)(ws + WS_DT2), PQC, 512, 512, 0, 1);
        auto E = [=](const pg8::Unit& u, int row_l, int col_l, f32x4 v0, f32x4 v1) {
            const size_t off = ((size_t)u.i0 * TB + TL + row_l) * DM + u.i2 * 256 + col_l;
            f32x4 g0, g1; ld_bf16x8(Gt + off, g0, g1);
            st_bf16x8(U + off, v0 * g0, v1 * g1);
        };
        pg8::gemm_phase(lds, D, E, wv);
    }
    xcd_barrier(gbar, wv);
    {
        DescPlain D; D.init(U, (const bf16_t*)(ws + WS_WFO) + (size_t)j * DM * DM, 8, latonly);
        const float* modl = (const float*)(ws + WS_MOD) + (size_t)layer * 17 * MOD_LD;
        auto E = [=](const pg8::Unit& u, int row_l, int col_l, f32x4 v0, f32x4 v1) { resid_store(A, layer, u.i0, row_l, u.i1 * 256 + col_l, modl, v0, v1); };
        pg8::gemm_phase(lds, D, E, wv);
    }
    xcd_barrier(gbar, wv);
}


namespace att {
constexpr int D = 128, NW = 8, QBLK = 32, KVBLK = 64;
constexpr float SCALE = 0.088388347648318440f;
constexpr float THR = 8.f;
constexpr int LDQ = 2048, LDK = 512;
constexpr size_t SHM_V = KVBLK * D * 2, SHM_K = KVBLK * D * 2;
typedef float f32x8 __attribute__((ext_vector_type(8)));
#define KSWZ(row, colB) ((row) * 256 + ((colB) ^ (((row) & 7) << 4)))
#define SBAR() __builtin_amdgcn_sched_barrier(0)
DI int crow(int r, int hi) { return (r & 3) + 8 * (r >> 2) + 4 * hi; }
DI unsigned cvtpk(float lo, float hi) { unsigned r; asm volatile("v_cvt_pk_bf16_f32 %0, %1, %2" : "=v"(r) : "v"(lo), "v"(hi)); return r; }
DI void partialSM(f32x16& p0, f32x16& p1, float& m_reg, float& mn, float& alpha) {
  constexpr float C = SCALE * 1.4426950408889634f;
  float pmax = p0[0];
#pragma unroll
  for (int r = 1; r < 16; ++r) pmax = fmaxf(pmax, p0[r]);
#pragma unroll
  for (int r = 0; r < 16; ++r) pmax = fmaxf(pmax, p1[r]);
  { auto rr = __builtin_amdgcn_permlane32_swap(__float_as_uint(pmax), __float_as_uint(pmax), false, false);
    pmax = fmaxf(__uint_as_float(rr[0]), __uint_as_float(rr[1])); }
  if (__builtin_expect(__all(pmax - m_reg <= THR / SCALE), 1)) { mn = m_reg; alpha = 1.f; }
  else { mn = fmaxf(m_reg, pmax); alpha = __builtin_amdgcn_exp2f((m_reg - mn) * C); m_reg = mn; }
  float mnC = -mn * C;
#pragma unroll
  for (int r = 0; r < 16; ++r) p0[r] = fmaf(p0[r], C, mnC);
#pragma unroll
  for (int r = 0; r < 16; ++r) p1[r] = fmaf(p1[r], C, mnC);
#pragma unroll
  for (int r = 0; r < 16; ++r) p0[r] = __builtin_amdgcn_exp2f(p0[r]);
}
DI void finishSM(f32x16& p0, f32x16& p1, float alpha, float& l_reg, bf16x8& pa0, bf16x8& pa1, bf16x8& pa2, bf16x8& pa3) {
#pragma unroll
  for (int r = 0; r < 16; ++r) p1[r] = __builtin_amdgcn_exp2f(p1[r]);
  float ps = 0;
#pragma unroll
  for (int r = 0; r < 16; ++r) ps += p0[r];
#pragma unroll
  for (int r = 0; r < 16; ++r) ps += p1[r];
  { auto rr = __builtin_amdgcn_permlane32_swap(__float_as_uint(ps), __float_as_uint(ps), false, false);
    ps = __uint_as_float(rr[0]) + __uint_as_float(rr[1]); }
  l_reg = l_reg * alpha + ps;
#define PK4(P, BASE, OUT) do { unsigned a0 = cvtpk(P[BASE + 0], P[BASE + 1]), a1 = cvtpk(P[BASE + 2], P[BASE + 3]);   \
    unsigned b0 = cvtpk(P[BASE + 4], P[BASE + 5]), b1 = cvtpk(P[BASE + 6], P[BASE + 7]);                              \
    auto r0 = __builtin_amdgcn_permlane32_swap(a0, b0, false, false); auto r1 = __builtin_amdgcn_permlane32_swap(a1, b1, false, false); \
    u32x4 w = {r0[0], r1[0], r0[1], r1[1]}; OUT = *reinterpret_cast<bf16x8*>(&w); } while (0)
  PK4(p0, 0, pa0); PK4(p0, 8, pa1); PK4(p1, 0, pa2); PK4(p1, 8, pa3);
#undef PK4
}
DI void qkt(f32x16& p0, f32x16& p1, const bf16_t* Ks, const bf16x8* qr, int r32, int hi) {
  p0 = f32x16{}; p1 = f32x16{};
#pragma unroll
  for (int d0 = 0; d0 < 8; ++d0) { int cb = (d0 * 16 + hi * 8) * 2;
    bf16x8 b0 = *reinterpret_cast<const bf16x8*>((const char*)Ks + KSWZ(r32, cb));
    bf16x8 b1 = *reinterpret_cast<const bf16x8*>((const char*)Ks + KSWZ(32 + r32, cb));
    p0 = __builtin_amdgcn_mfma_f32_32x32x16_bf16(b0, qr[d0], p0, 0, 0, 0);
    p1 = __builtin_amdgcn_mfma_f32_32x32x16_bf16(b1, qr[d0], p1, 0, 0, 0); }
}
DI int v_st(int k, int c) { const int kk = (k & ~0xC) | ((k & 4) << 1) | ((k & 8) >> 1); return ((kk >> 3) * 4 + (c >> 5)) * 512 + ((kk & 7) * 32 + (c & 31)) * 2; }
DI int v_rd_base(int lane) { return ((lane & 3) << 3) | (((lane >> 2) & 3) << 6) | (((lane >> 4) & 1) << 5) | (((lane >> 5) & 1) << 8); }
constexpr int v_rd_off(int d0, int ks, int half) { return d0 * 512 + ks * 4096 + half * 2048; }
template <int OFF> DI s16x4 tr_read(int vb) {
  s16x4 r; asm volatile("ds_read_b64_tr_b16 %0, %1 offset:%2" : "=&v"(r) : "v"(vb), "i"(OFF) : "memory"); return r;
}
template <int D0> DI void pv_one(f32x16& od, int vb, bf16x8 pa0, bf16x8 pa1, bf16x8 pa2, bf16x8 pa3) {
  const s16x4 l0 = tr_read<v_rd_off(D0, 0, 0)>(vb), h0 = tr_read<v_rd_off(D0, 0, 1)>(vb), l1 = tr_read<v_rd_off(D0, 1, 0)>(vb), h1 = tr_read<v_rd_off(D0, 1, 1)>(vb);
  const s16x4 l2 = tr_read<v_rd_off(D0, 2, 0)>(vb), h2 = tr_read<v_rd_off(D0, 2, 1)>(vb), l3 = tr_read<v_rd_off(D0, 3, 0)>(vb), h3 = tr_read<v_rd_off(D0, 3, 1)>(vb);
  asm volatile("s_waitcnt lgkmcnt(0)" ::: "memory"); SBAR();
#define PK(L, H) (bf16x8){L[0], L[1], L[2], L[3], H[0], H[1], H[2], H[3]}
  od = __builtin_amdgcn_mfma_f32_32x32x16_bf16(pa0, PK(l0, h0), od, 0, 0, 0);
  od = __builtin_amdgcn_mfma_f32_32x32x16_bf16(pa1, PK(l1, h1), od, 0, 0, 0);
  od = __builtin_amdgcn_mfma_f32_32x32x16_bf16(pa2, PK(l2, h2), od, 0, 0, 0);
  od = __builtin_amdgcn_mfma_f32_32x32x16_bf16(pa3, PK(l3, h3), od, 0, 0, 0);
#undef PK
}
DI void pv_d0(f32x16* o, int vb, bf16x8 pa0, bf16x8 pa1, bf16x8 pa2, bf16x8 pa3) {
  pv_one<0>(o[0], vb, pa0, pa1, pa2, pa3); pv_one<1>(o[1], vb, pa0, pa1, pa2, pa3); pv_one<2>(o[2], vb, pa0, pa1, pa2, pa3); pv_one<3>(o[3], vb, pa0, pa1, pa2, pa3);
}
DI void attn_dense_body(const bf16_t* __restrict__ Qb, const bf16_t* __restrict__ Kh, const bf16_t* __restrict__ Vh, const bf16_t* SZb, bf16_t* Ub, int seq, char* lds, int wv, const float* qn, int tpos) {
  const int tid = otid(wv), wid = tid >> 6, lane = tid & 63, r32 = lane & 31, hi = lane >> 5;
  bf16_t* V_lds = (bf16_t*)lds; bf16_t* K_lds = (bf16_t*)(lds + 2 * SHM_V);
  float* wsf = (float*)(lds + 2 * SHM_V + 2 * SHM_K) + wid * 64; float* li_l = wsf; float* al_l = wsf + 32;
  float m_reg = -1e30f, l_reg = 0; f32x16 o[4] = {}; bf16x8 qr[8];
  const bf16_t* Qw = Qb + (long)(wid * QBLK + r32) * LDQ + hi * 8;
  {
    u32x4 raw[8];
#pragma unroll
    for (int d0 = 0; d0 < 8; ++d0) raw[d0] = *reinterpret_cast<const u32x4*>(Qw + d0 * 16);
    float ss = 0.f;
#pragma unroll
    for (int d0 = 0; d0 < 8; ++d0) { const u32x4 w = raw[d0];
      ss += bf_lo(w.x) * bf_lo(w.x) + bf_hi(w.x) * bf_hi(w.x) + bf_lo(w.y) * bf_lo(w.y) + bf_hi(w.y) * bf_hi(w.y) + bf_lo(w.z) * bf_lo(w.z) + bf_hi(w.z) * bf_hi(w.z) + bf_lo(w.w) * bf_lo(w.w) + bf_hi(w.w) * bf_hi(w.w); }
    ss += __shfl_xor(ss, 32);
    const float rs = 1.0f / sqrtf(ss * (1.f / 128.f) + EPS);
    const int t = tpos + wid * QBLK + r32;
    const f32x2* rope = (const f32x2*)(lds + 81920);
#pragma unroll
    for (int d0 = 0; d0 < 8; ++d0) { const u32x4 w = raw[d0]; const float* wn = qn + d0 * 16 + hi * 8;
      const f32x4 g0 = *(const f32x4*)wn, g1 = *(const f32x4*)(wn + 4);
      float y[8] = {bf_lo(w.x) * rs * g0[0], bf_hi(w.x) * rs * g0[1], bf_lo(w.y) * rs * g0[2], bf_hi(w.y) * rs * g0[3], bf_lo(w.z) * rs * g1[0], bf_hi(w.z) * rs * g1[1], bf_lo(w.w) * rs * g1[2], bf_hi(w.w) * rs * g1[3]};
      if (tpos >= 0) {
        const int pos = (d0 < 4) ? (t >> 6) : (t & 63);
        const f32x4* rp = (const f32x4*)(rope + pos * 32 + (8 * (d0 & 3) + 4 * hi));
        const f32x4 c01 = rp[0], c23 = rp[1];
        const float cs[4] = {c01[0], c01[2], c23[0], c23[2]}, sn[4] = {c01[1], c01[3], c23[1], c23[3]};
#pragma unroll
        for (int pp = 0; pp < 4; ++pp) { const float x0 = y[2 * pp], x1 = y[2 * pp + 1]; y[2 * pp] = x0 * cs[pp] - x1 * sn[pp]; y[2 * pp + 1] = x0 * sn[pp] + x1 * cs[pp]; }
      }
      u32x4 o4 = {pk2(y[0], y[1]), pk2(y[2], y[3]), pk2(y[4], y[5]), pk2(y[6], y[7])};
      qr[d0] = __builtin_bit_cast(bf16x8, o4); }
  }
  const int sr = tid >> 4, sc = (tid & 15) * 8, vst0 = v_st(sr, sc), vst1 = v_st(32 + sr, sc);
  const int vb0 = (int)(uintptr_t)V_lds + v_rd_base(lane);
  struct { bf16x8 vs0, vs1, ks0, ks1; } sr_[2];
#define SLOAD(i, k0) do { sr_[i].vs0 = *reinterpret_cast<const bf16x8*>(&Vh[(long)((k0) + sr) * LDK + sc]); sr_[i].vs1 = *reinterpret_cast<const bf16x8*>(&Vh[(long)((k0) + 32 + sr) * LDK + sc]); \
    sr_[i].ks0 = *reinterpret_cast<const bf16x8*>(&Kh[(long)((k0) + sr) * LDK + sc]); sr_[i].ks1 = *reinterpret_cast<const bf16x8*>(&Kh[(long)((k0) + 32 + sr) * LDK + sc]); } while (0)
#define SWRITE(b, i) do { *(bf16x8*)((char*)V_lds + (b) * SHM_V + vst0) = sr_[i].vs0;          \
    *(bf16x8*)((char*)V_lds + (b) * SHM_V + vst1) = sr_[i].vs1; int kc = sc * 2;               \
    *(bf16x8*)((char*)K_lds + (b) * SHM_K + KSWZ(sr, kc)) = sr_[i].ks0;                       \
    *(bf16x8*)((char*)K_lds + (b) * SHM_K + KSWZ(32 + sr, kc)) = sr_[i].ks1; } while (0)
#define SWAIT() asm volatile("s_waitcnt vmcnt(4)" ::: "memory")
#define RESC(a) do { if (__any((a) < 1.f)) { if (hi == 0) al_l[r32] = (a); asm volatile("s_waitcnt lgkmcnt(0)" ::: "memory"); \
    _Pragma("unroll") for (int d = 0; d < 4; ++d) _Pragma("unroll") for (int r = 0; r < 16; ++r) o[d][r] *= al_l[crow(r, hi)]; } } while (0)
  f32x16 pA0, pA1, pB0, pB1; float mnA, mnB, alA, alB; bf16x8 pa0, pa1, pa2, pa3; const int NT = seq / KVBLK;
  constexpr int SE = 0, SO = 1;
  SLOAD(SE, 0); asm volatile("s_waitcnt vmcnt(0)" ::: "memory"); SWRITE(0, SE); __syncthreads();
  qkt(pA0, pA1, K_lds, qr, r32, hi); partialSM(pA0, pA1, m_reg, mnA, alA);
  SLOAD(SO, KVBLK); if (2 < NT) SLOAD(SE, 2 * KVBLK);
  SWAIT(); SWRITE(1, SO); __syncthreads();
  for (int j = 1; j + 1 < NT; j += 2) {
    SBAR(); qkt(pB0, pB1, (bf16_t*)((char*)K_lds + SHM_K), qr, r32, hi);
    finishSM(pA0, pA1, alA, l_reg, pa0, pa1, pa2, pa3); SBAR();
    SLOAD(SO, (j + 2) * KVBLK); SBAR();
    pv_d0(o, vb0, pa0, pa1, pa2, pa3); partialSM(pB0, pB1, m_reg, mnB, alB);
    __syncthreads(); SWAIT(); SWRITE(0, SE);
    RESC(alB); __syncthreads();
    SBAR(); qkt(pA0, pA1, K_lds, qr, r32, hi);
    finishSM(pB0, pB1, alB, l_reg, pa0, pa1, pa2, pa3); SBAR();
    if (j + 3 < NT) SLOAD(SE, (j + 3) * KVBLK); SBAR();
    pv_d0(o, vb0 + (int)SHM_V, pa0, pa1, pa2, pa3); partialSM(pA0, pA1, m_reg, mnA, alA);
    __syncthreads(); SWAIT(); SWRITE(1, SO);
    RESC(alA); __syncthreads();
  }
  SBAR(); qkt(pB0, pB1, (bf16_t*)((char*)K_lds + SHM_K), qr, r32, hi);
  finishSM(pA0, pA1, alA, l_reg, pa0, pa1, pa2, pa3); SBAR();
  pv_d0(o, vb0, pa0, pa1, pa2, pa3); partialSM(pB0, pB1, m_reg, mnB, alB);
  __syncthreads(); RESC(alB);
  finishSM(pB0, pB1, alB, l_reg, pa0, pa1, pa2, pa3); SBAR();
  pv_d0(o, vb0 + (int)SHM_V, pa0, pa1, pa2, pa3);
  u32x4 zq[8];
#pragma unroll
  for (int i = 0; i < 8; ++i) { const int id = tid + 512 * i; zq[i] = *(const u32x4*)(SZb + (long)(id >> 4) * LDQ + (id & 15) * 8); }
  if (hi == 0) li_l[r32] = l_reg; asm volatile("s_waitcnt lgkmcnt(0)" ::: "memory");
  __syncthreads();
  {
    float rli[16];
#pragma unroll
    for (int r = 0; r < 16; ++r) rli[r] = __builtin_amdgcn_rcpf(li_l[crow(r, hi)]);
    char* ost = lds;
#pragma unroll
    for (int r = 0; r < 16; ++r) { char* rowp = ost + (wid * QBLK + crow(r, hi)) * 256 + r32 * 2;
#pragma unroll
      for (int d0 = 0; d0 < 4; ++d0) *(unsigned short*)(rowp + d0 * 64) = (unsigned short)(pk2(o[d0][r] * rli[r], 0.f) & 0xffffu); }
  }
  __syncthreads();
#pragma unroll
  for (int i = 0; i < 8; ++i) { const int id = tid + 512 * i; const int row = id >> 4, ch = id & 15;
    const u32x4 ov = *(const u32x4*)(lds + row * 256 + ch * 16);
    f32x4 a0 = {bf_lo(ov.x), bf_hi(ov.x), bf_lo(ov.y), bf_hi(ov.y)}, a1 = {bf_lo(ov.z), bf_hi(ov.z), bf_lo(ov.w), bf_hi(ov.w)};
    const f32x4 z0 = {bf_lo(zq[i].x), bf_hi(zq[i].x), bf_lo(zq[i].y), bf_hi(zq[i].y)}, z1 = {bf_lo(zq[i].z), bf_hi(zq[i].z), bf_lo(zq[i].w), bf_hi(zq[i].w)};
    st_bf16x8(Ub + (long)row * LDQ + ch * 8, a0 * z0, a1 * z1); }
  __syncthreads();
#undef SLOAD
#undef SWRITE
#undef SWAIT
#undef RESC
}
#undef KSWZ
#undef SBAR
}

DI void qknorm_phase(const Args& A, LAS unsigned char* lds, int wv) {
    const int tid = otid(wv), lane = tid & 63, wave = tid >> 6, G = gridDim.x;
    bf16_t* Q = (bf16_t*)(A.ws + WS_SCR + A_Q); bf16_t* Kb = (bf16_t*)(A.ws + WS_SCR + A_K);
    const float* qn = A.in[14]; const float* kn = A.in[15];
    const int sub = lane >> 4, l16 = lane & 15, e0 = l16 * 8;
    LAS f32x2* rope = (LAS f32x2*)lds;
    for (int e = tid; e < 2048; e += NTHREADS) { const float ang = (float)(e >> 5) * exp2f(-(float)(e & 31) * 0.41524101186092029f); rope[e] = (f32x2){cosf(ang), sinf(ang)}; }
    __syncthreads();
    const long NIT = (long)NTOK * 4;
    for (long it0 = ((long)blockIdx.x * NWAVES + wave) * 16 + sub; it0 < NIT; it0 += (long)G * NWAVES * 16) {
        bf16_t* pq[4]; u32x4 raw[4];
#pragma unroll
        for (int k = 0; k < 4; ++k) { const long it = it0 + 4 * k; const int row = (int)(it >> 2), hj = 16 + (int)(it & 3);
            pq[k] = (hj < 16) ? Q + (size_t)row * 2048 + hj * 128 + e0 : Kb + (size_t)row * 512 + (hj - 16) * 128 + e0;
            raw[k] = *(const u32x4*)pq[k]; }
#pragma unroll
        for (int k = 0; k < 4; ++k) {
            const long it = it0 + 4 * k; const int row = (int)(it >> 2), hj = 16 + (int)(it & 3);
            const float* wn = (hj < 16 ? qn : kn) + e0;
            f32x4 a = {bf_lo(raw[k].x), bf_hi(raw[k].x), bf_lo(raw[k].y), bf_hi(raw[k].y)}, b = {bf_lo(raw[k].z), bf_hi(raw[k].z), bf_lo(raw[k].w), bf_hi(raw[k].w)};
            float ss = 0.f;
#pragma unroll
            for (int q = 0; q < 4; ++q) ss += a[q] * a[q] + b[q] * b[q];
            ss += __shfl_xor(ss, 1); ss += __shfl_xor(ss, 2); ss += __shfl_xor(ss, 4); ss += __shfl_xor(ss, 8);
            const float rs = 1.0f / sqrtf(ss * (1.f / 128.f) + EPS);
            const f32x4 w0 = *(const f32x4*)wn, w1 = *(const f32x4*)(wn + 4);
            a = a * rs * w0; b = b * rs * w1;
            const int t = row % TB;
            if (t < TL) {
                const int pos = (l16 < 8) ? (t >> 6) : (t & 63);
                float y[8] = {a[0], a[1], a[2], a[3], b[0], b[1], b[2], b[3]};
                const LAS f32x4* rp = (const LAS f32x4*)(rope + pos * 32 + ((4 * l16) & 31));
                const f32x4 c01 = rp[0], c23 = rp[1];
                const float cs[4] = {c01[0], c01[2], c23[0], c23[2]}, sn[4] = {c01[1], c01[3], c23[1], c23[3]};
#pragma unroll
                for (int pp = 0; pp < 4; ++pp) {
                    const float x0 = y[2 * pp], x1 = y[2 * pp + 1];
                    y[2 * pp] = x0 * cs[pp] - x1 * sn[pp]; y[2 * pp + 1] = x0 * sn[pp] + x1 * cs[pp];
                }
                a = (f32x4){y[0], y[1], y[2], y[3]}; b = (f32x4){y[4], y[5], y[6], y[7]};
            }
            st_bf16x8(pq[k], a, b);
        }
    }
}

DI void attn_layer(const Args& A, LAS unsigned char* lds, char* lds_gen, const XcdBarrier& gbar, int layer, int wv) {
    unsigned char* ws = A.ws;
    const bf16_t* H = (const bf16_t*)(ws + WS_H); bf16_t* U = (bf16_t*)(ws + WS_H);
    bf16_t* Q = (bf16_t*)(ws + WS_SCR + A_Q); bf16_t* Kb = (bf16_t*)(ws + WS_SCR + A_K); bf16_t* Vb = (bf16_t*)(ws + WS_SCR + A_V); bf16_t* SZ = (bf16_t*)(ws + WS_SCR + A_SZ);
    norm_phase(A, layer, false, wv);
    xcd_barrier(gbar, wv);
    {
        DescPlain D; D.init(H, (const bf16_t*)(ws + WS_WAI), 20, false);
        auto E = [=](const pg8::Unit& u, int row_l, int col_l, f32x4 v0, f32x4 v1) {
            const size_t row = (size_t)u.i0 * 256 + row_l; const int pn = u.i1;
            if (pn < 8) st_bf16x8(Q + row * 2048 + pn * 256 + col_l, v0, v1);
            else if (pn < 10) st_bf16x8(Kb + row * 512 + (pn - 8) * 256 + col_l, v0, v1);
            else if (pn < 12) st_bf16x8(Vb + row * 512 + (pn - 10) * 256 + col_l, v0, v1);
            else { f32x4 a, b;
#pragma unroll
                for (int q = 0; q < 4; ++q) { a[q] = siluf(v0[q]); b[q] = siluf(v1[q]); }
                st_bf16x8(SZ + row * 2048 + (pn - 12) * 256 + col_l, a, b); }
        };
        pg8::gemm_phase(lds, D, E, wv);
    }
    xcd_barrier(gbar, wv);
    qknorm_phase(A, lds, wv);
    xcd_barrier(gbar, wv);
    {
        const int G = gridDim.x, c = blockIdx.x;
        { f32x2* rope = (f32x2*)(lds_gen + 81920); const int tid = otid(wv);
          for (int e = tid; e < 2048; e += NTHREADS) { const float ang = (float)(e >> 5) * exp2f(-(float)(e & 31) * 0.41524101186092029f); rope[e] = (f32x2){cosf(ang), sinf(ang)}; }
          __syncthreads(); }
        const float* qn = A.in[14];
        for (long L = c; L < 2048; L += G) {
            const int u = pg8::xcd_remap((int)L, 2048);
            const int b = u / 128, rem = u % 128, kvh = rem / 32, g = (rem / 8) % 4, qb = rem % 8, h = kvh * 4 + g;
            const size_t qoff = ((size_t)b * TB + qb * 256) * 2048 + h * 128, koff = ((size_t)b * TB) * 512 + kvh * 128;
            att::attn_dense_body(Q + qoff, Kb + koff, Vb + koff, SZ + qoff, U + qoff, TB, lds_gen, wv, qn, qb * 256);
        }
        for (int u = c; u < 256; u += G) {
            const int b = u / 16, h = u % 16, kvh = h / 4;
            const size_t qoff = ((size_t)b * TB + TL) * 2048 + h * 128, koff = ((size_t)b * TB + TL) * 512 + kvh * 128;
            att::attn_dense_body(Q + qoff, Kb + koff, Vb + koff, SZ + qoff, U + qoff, TC, lds_gen, wv, qn, -1);
        }
    }
    xcd_barrier(gbar, wv);
    {
        DescPlain D; D.init(U, (const bf16_t*)(ws + WS_WAO), 8, false);
        const float* modl = (const float*)(ws + WS_MOD) + (size_t)layer * 17 * MOD_LD;
        auto E = [=](const pg8::Unit& u, int row_l, int col_l, f32x4 v0, f32x4 v1) { resid_store(A, layer, u.i0, row_l, u.i1 * 256 + col_l, modl, v0, v1); };
        pg8::gemm_phase(lds, D, E, wv);
    }
    xcd_barrier(gbar, wv);
}


struct DescM1 {
    static constexpr bool RAW = false;
    const bf16_t* H; const bf16_t* WA; const bf16_t* WB; int lda, ldb, K, total;
    DI void init(const bf16_t* H_, const bf16_t* WA_, const bf16_t* WB_) { H = H_; WA = WA_; WB = WB_; lda = DM; ldb = DM; K = DM; total = 144 * 9 + 8 * 144; }
    DI pg8::Unit unit(int idx) const {
        pg8::Unit u;
        if (idx < 1296) { const int nig = 72, gid = idx / nig, pm = gid * 8 + (idx % nig) % 8, pn = (idx % nig) / 8;
            u.a = (const char*)(H + (size_t)pm * 256 * DM); u.b = (const char*)(WA + (size_t)pn * 256 * DM); u.i0 = pm; u.i1 = pn; u.i2 = 0; }
        else { const int j = idx - 1296, mt = j % 8, nt = j / 8;
            u.a = (const char*)(WB + (size_t)mt * 256 * DM); u.b = (const char*)(H + (size_t)nt * 256 * DM); u.i0 = mt; u.i1 = nt; u.i2 = 1; }
        return u;
    }
};
namespace ml {
#define MFMA32(a, b, c) __builtin_amdgcn_mfma_f32_32x32x16_bf16((a), (b), (c), 0, 0, 0)
#define LFENCE() asm volatile("s_waitcnt lgkmcnt(0)" ::: "memory")
DI float dot2_bf16(unsigned a, unsigned b, float c) { asm("v_dot2c_f32_bf16 %0, %1, %2" : "+v"(c) : "v"(a), "v"(b)); return c; }
#define DOT2(a, b, c) dot2_bf16((a), (b), (c))
DI int crow(int reg, int h) { return (reg & 3) + 8 * (reg >> 2) + 4 * h; }
DI bf16x8 ldperm(const bf16_t* p) { const s16x4 lo = *(const s16x4*)p, hi = *(const s16x4*)(p + 8); return __builtin_shufflevector(lo, hi, 0, 1, 2, 3, 4, 5, 6, 7); }
DI bf16x8 pack_step(const f32x16& x, int s) { u32x4 p = {pk2(x[8 * s], x[8 * s + 1]), pk2(x[8 * s + 2], x[8 * s + 3]), pk2(x[8 * s + 4], x[8 * s + 5]), pk2(x[8 * s + 6], x[8 * s + 7])}; return __builtin_bit_cast(bf16x8, p); }
DI float bfs(short h) { return __uint_as_float(((unsigned)(unsigned short)h) << 16); }

constexpr int SC_Q = 0, SC_K = 16384, SC_KT = 32768, SC_BUF = 49152, SC_WAVE = 2 * SC_BUF, SC_WAVE_BYTES = 6656;
DI bf16x8 ldsfrag(const LAS unsigned char* buf, unsigned o) { const s16x4 lo = *(const LAS s16x4*)(buf + o), hi = *(const LAS s16x4*)(buf + (o ^ 16u)); return __builtin_shufflevector(lo, hi, 0, 1, 2, 3, 4, 5, 6, 7); }
DI void scan_phase(const Args& A, LAS unsigned char* lds, int wv) {
    const int wave = wv;
    LAS float* wl = (LAS float*)(lds + SC_WAVE + wave * SC_WAVE_BYTES);
    LAS unsigned* nbp = (LAS unsigned*)(lds + SC_WAVE + wave * SC_WAVE_BYTES + 2048);
    LAS unsigned* wbp = nbp + 64;
    LAS unsigned char* hst = lds + SC_WAVE + wave * SC_WAVE_BYTES + 2560;
    unsigned char* ws = A.ws;
    const bf16_t* Qg = (const bf16_t*)(ws + WS_SCR + M_Q); const bf16_t* Kg = (const bf16_t*)(ws + WS_SCR + M_K); const bf16_t* KVT = (const bf16_t*)(ws + WS_SCR + M_KVT);
    const float* G32 = (const float*)(ws + WS_SCR + M_G32); const float* bg = A.in[10];
#define SC_POS0(j) (dir == 0 ? ((j) < 4 ? TL + 64 * (j) : 64 * ((j) - 4)) : ((j) < 4 ? TL + 64 * (3 - (j)) : 64 * (35 - (j))))
#define SC_DMA(bufi, p0) do { const int tj_ = otid(wv); _Pragma("unroll") for (int i_ = 0; i_ < 2; ++i_) { const int sl_ = i_ * 512 + tj_; \
        { const int row_ = sl_ >> 4, c_ = (sl_ & 15) ^ (row_ & 15); const size_t go_ = (size_t)((p0) + row_) * 1024 + c_ * 8; \
          __builtin_amdgcn_global_load_lds((const unsigned*)(Qu + go_), (LAS unsigned*)(lds + (bufi) * SC_BUF + SC_Q + i_ * 8192 + wave * 1024), 16, 0, 0); \
          __builtin_amdgcn_global_load_lds((const unsigned*)(Ku + go_), (LAS unsigned*)(lds + (bufi) * SC_BUF + SC_K + i_ * 8192 + wave * 1024), 16, 0, 0); } \
        { const int d_ = sl_ >> 3, c_ = (sl_ & 7) ^ ((d_ >> 1) & 7); \
          __builtin_amdgcn_global_load_lds((const unsigned*)(KTu + (size_t)d_ * TB + (p0) + c_ * 8), (LAS unsigned*)(lds + (bufi) * SC_BUF + SC_KT + i_ * 8192 + wave * 1024), 16, 0, 0); } } } while (0)
    for (int item = blockIdx.x; item < 256; item += gridDim.x) {
        const int dir = item & 1, h = (item >> 1) & 7, b = item >> 4, e0 = wave * 32;
        const bf16_t* Qu = Qg + (size_t)b * TB * 1024 + h * 128;
        const bf16_t* Ku = Kg + (size_t)b * TB * 1024 + h * 128;
        const bf16_t* KTu = KVT + ((size_t)b * 3072 + h * 128) * TB;
        const bf16_t* VTu = KVT + ((size_t)b * 3072 + 1024 + h * 256 + e0) * TB;
        bf16_t* Hout = (bf16_t*)(ws + WS_SCR + (dir ? M_HB : M_HF)) + (size_t)b * TB * DM + h * 256 + e0;
        const float big = bg[(dir * 2) * 8 + h], bfg = bg[(dir * 2 + 1) * 8 + h];
        f32x16 cacc[4];
#pragma unroll
        for (int d = 0; d < 4; ++d)
#pragma unroll
            for (int i = 0; i < 16; ++i) cacc[d][i] = 0.f;
        float m = 0.f;
        { const int l0 = otid(wv) & 63; wl[384 + l0] = 0.f; wl[448 + l0] = 0.f; nbp[l0] = 0u; }
        LFENCE();
        SC_DMA(0, SC_POS0(0));
        float ig_n, fg_n;
        { const int l0 = otid(wv) & 63; const float* gp = G32 + (size_t)(b * TB + SC_POS0(0) + (dir ? 63 - l0 : l0)) * 32 + (dir * 2) * 8 + h; ig_n = gp[0]; fg_n = gp[8]; }
        for (int j = 0; j < 36; ++j) {
            const int pos0 = SC_POS0(j);
            const LAS unsigned char* Qb = lds + (j & 1) * SC_BUF + SC_Q; const LAS unsigned char* Kb = lds + (j & 1) * SC_BUF + SC_K; const LAS unsigned char* KTb = lds + (j & 1) * SC_BUF + SC_KT;
            asm volatile("s_waitcnt vmcnt(0)" ::: "memory"); __builtin_amdgcn_s_barrier(); asm volatile("" ::: "memory");
            if (j + 1 < 36) SC_DMA((j + 1) & 1, SC_POS0(j + 1));
            const int lj = otid(wv) & 63, rj = lj & 31, h4 = (lj >> 5) * 4;
            LAS float* wh = wl + h4; LAS float* wr = wl + rj; LAS unsigned char* hb = hst + h4 * 64 + rj * 2;
            const LAS unsigned* nbh = nbp + (h4 >> 1); const LAS unsigned* wbh = wbp + (h4 >> 1);
            const unsigned xr = rj & 15, xd = (rj >> 1) & 7;
            const unsigned qro = (unsigned)rj * 256u + 2u * h4;
            const unsigned kro = (unsigned)rj * 128u + 2u * h4;
            const bf16_t* VTp = VTu + (size_t)rj * TB + pos0 + h4;
            bf16x8 vf[4];
#pragma unroll
            for (int kk = 0; kk < 4; ++kk) vf[kk] = ldperm(VTp + 16 * kk);
            float decay, m_new;
            {
                const int s = dir ? 63 - lj : lj;
                const float ig = ig_n + big, fg = fg_n + bfg;
                if (j + 1 < 36) { const float* gp = G32 + (size_t)(b * TB + SC_POS0(j + 1) + s) * 32 + (dir * 2) * 8 + h; ig_n = gp[0]; fg_n = gp[8]; }
                const float lf = fminf(fg, 0.f) - log1pf(__expf(-fabsf(fg)));
                float bs = lf;
#pragma unroll
                for (int o = 1; o < 64; o <<= 1) { const float t = __shfl_up(bs, o); if (lj >= o) bs += t; }
                const float uu = ig - bs;
                float pmx = uu;
#pragma unroll
                for (int o = 1; o < 64; o <<= 1) { const float t = __shfl_up(pmx, o); if (lj >= o) pmx = fmaxf(pmx, t); }
                pmx = fmaxf(pmx, m);
                const float b_end = __shfl(bs, 63), pm_last = __shfl(pmx, 63);
                LAS float* ws_ = wl + s;
                ws_[0] = uu * 1.4426950408889634f; ws_[64] = pmx * 1.4426950408889634f; ws_[128] = __expf(m - pmx); ws_[192] = __expf(-(bs + pmx)); ws_[256] = __expf(uu - pm_last);
                { const float wv_ = __expf(uu - pm_last), wp_ = __shfl_xor(wv_, 1); if ((s & 1) == 0) wbp[s >> 1] = pk2(wv_, wp_); }
                decay = __expf(m - pm_last); m_new = b_end + pm_last;
            }
            LFENCE();
            const int sbase = dir ? 63 - h4 : h4, sgn = dir ? -1 : 1;
#pragma unroll
            for (int tb = 0; tb < 2; ++tb) {
                __builtin_amdgcn_sched_barrier(0);
                const unsigned qo = qro + tb * 8192u;
                f32x16 ha;
#pragma unroll
                for (int i = 0; i < 16; ++i) ha[i] = 0.f;
                float qnv = 0.f;
#pragma unroll
                for (int kk = 0; kk < 8; ++kk) {
                    const bf16x8 qa = ldsfrag(Qb, qo + (((2u * kk) ^ xr) << 4));
                    ha = MFMA32(qa, pack_step(cacc[kk >> 1], kk & 1), ha);
                    { const u32x2 nb0 = *(const LAS u32x2*)(nbh + 8 * kk), nb1 = *(const LAS u32x2*)(nbh + 8 * kk + 4); const u32x4 qw = __builtin_bit_cast(u32x4, qa);
                      qnv = DOT2(qw.x, nb0.x, qnv); qnv = DOT2(qw.y, nb0.y, qnv); qnv = DOT2(qw.z, nb1.x, qnv); qnv = DOT2(qw.w, nb1.y, qnv); }
                }
                qnv += __shfl_xor(qnv, 32);
#pragma unroll
                for (int g = 0; g < 4; ++g) { const f32x4 av = *(const LAS f32x4*)(wh + 128 + 32 * tb + 8 * g);
#pragma unroll
                    for (int q = 0; q < 4; ++q) ha[4 * g + q] *= av[q]; }
                const float pmt = wr[64 + 32 * tb];
                const int tp = dir ? (63 - 32 * tb) - rj : 32 * tb + rj;
                float ds = 0.f;
#pragma unroll
                for (int sb = 0; sb < 2; ++sb) {
                    __builtin_amdgcn_sched_barrier(0);
                    if (sb != tb && (dir ? sb < tb : sb > tb)) continue;
                    const unsigned ko = qro + sb * 8192u;
                    f32x16 st;
#pragma unroll
                    for (int i = 0; i < 16; ++i) st[i] = 0.f;
#pragma unroll
                    for (int kk = 0; kk < 8; ++kk) { const unsigned c = ((2u * kk) ^ xr) << 4; st = MFMA32(ldsfrag(Kb, ko + c), ldsfrag(Qb, qo + c), st); }
#pragma unroll
                    for (int g = 0; g < 4; ++g) { const f32x4 uv = *(const LAS f32x4*)(wh + 32 * sb + 8 * g);
#pragma unroll
                        for (int q = 0; q < 4; ++q) {
                            const int sc = 32 * sb + q + 8 * g;
                            const int sp = sbase + sgn * sc;
                            st[4 * g + q] *= __builtin_amdgcn_exp2f((sp <= tp) ? uv[q] - pmt : -1e30f);
                            ds += st[4 * g + q];
                        } }
                    ha = MFMA32(pack_step(st, 0), vf[2 * sb], ha);
                    ha = MFMA32(pack_step(st, 1), vf[2 * sb + 1], ha);
                }
                ds += __shfl_xor(ds, 32);
                {
                    const float den = wr[128 + 32 * tb] * qnv + ds;
                    const float rd = 1.0f / fmaxf(fabsf(den), wr[192 + 32 * tb]);
                    if (h4 == 0) wr[320 + 32 * tb] = rd;
                }
                LFENCE();
#pragma unroll
                for (int g = 0; g < 4; ++g) { const f32x4 rv = *(const LAS f32x4*)(wh + 320 + 32 * tb + 8 * g);
#pragma unroll
                    for (int q = 0; q < 4; ++q) { const int tc = 32 * tb + q + 8 * g;
                        *(LAS unsigned short*)(hb + tc * 64) = (unsigned short)(pk2(ha[4 * g + q] * rv[q], 0.f) & 0xffffu); } }
            }
            LFENCE();
            {
                bf16_t* hp = Hout + (size_t)(pos0 + lj) * DM;
                const LAS unsigned char* hrow = hst + lj * 64;
#pragma unroll
                for (int q = 0; q < 4; ++q) *(u32x4*)(hp + 8 * q) = *(const LAS u32x4*)(hrow + 16 * q);
            }
            __builtin_amdgcn_sched_barrier(0);
            bf16x8 vfw[4];
#pragma unroll
            for (int kk = 0; kk < 4; ++kk) {
                const f32x4 w0 = *(const LAS f32x4*)(wh + 256 + 16 * kk), w1 = *(const LAS f32x4*)(wh + 256 + 16 * kk + 8);
                u32x4 p = {pk2(bfs(vf[kk][0]) * w0[0], bfs(vf[kk][1]) * w0[1]), pk2(bfs(vf[kk][2]) * w0[2], bfs(vf[kk][3]) * w0[3]),
                           pk2(bfs(vf[kk][4]) * w1[0], bfs(vf[kk][5]) * w1[1]), pk2(bfs(vf[kk][6]) * w1[2], bfs(vf[kk][7]) * w1[3])};
                vfw[kk] = __builtin_bit_cast(bf16x8, p);
            }
#pragma unroll
            for (int db = 0; db < 4; ++db) {
#pragma unroll
                for (int i = 0; i < 16; ++i) cacc[db][i] *= decay;
                const unsigned to = kro + db * 4096u;
                float nadd = 0.f;
#pragma unroll
                for (int kk = 0; kk < 4; ++kk) {
                    const bf16x8 kv = ldsfrag(KTb, to + (((2u * kk) ^ xd) << 4));
                    const u32x2 wq0 = *(const LAS u32x2*)(wbh + 8 * kk), wq1 = *(const LAS u32x2*)(wbh + 8 * kk + 4); const u32x4 kw = __builtin_bit_cast(u32x4, kv);
                    nadd = DOT2(kw.x, wq0.x, nadd); nadd = DOT2(kw.y, wq0.y, nadd); nadd = DOT2(kw.z, wq1.x, nadd); nadd = DOT2(kw.w, wq1.y, nadd);
                    cacc[db] = MFMA32(kv, vfw[kk], cacc[db]);
                }
                nadd += __shfl_xor(nadd, 32);
                const float nnew = decay * wr[384 + 32 * db] + nadd, npart = __shfl_xor(nnew, 1);
                if (h4 == 0) { wr[384 + 32 * db] = nnew; if ((rj & 1) == 0) nbp[(32 * db + rj) >> 1] = pk2(nnew, npart); }
            }
            LFENCE();
            m = m_new;
        }
        asm volatile("s_waitcnt vmcnt(0)" ::: "memory"); __builtin_amdgcn_s_barrier();
    }
#undef SC_DMA
#undef SC_POS0
}
#undef MFMA32
#undef LFENCE
#undef DOT2
}

DI void mlstm_finish_phase(const Args& A, int wv) {
    const int tid = otid(wv), lane = tid & 63, wave = tid >> 6, G = gridDim.x;
    unsigned char* ws = A.ws;
    const bf16_t* HF = (const bf16_t*)(ws + WS_SCR + M_HF); const bf16_t* HB = (const bf16_t*)(ws + WS_SCR + M_HB);
    const bf16_t* SO = (const bf16_t*)(ws + WS_SCR + M_SO); const bf16_t* SZ = (const bf16_t*)(ws + WS_SCR + M_SZ);
    bf16_t* U = (bf16_t*)(ws + WS_H); const float* hn = A.in[11];
    const int sub = lane >> 5, e0 = (lane & 31) * 8;
    const long NIT = (long)NTOK * 8;
    for (long it0 = ((long)blockIdx.x * NWAVES + wave) * 4 + sub; it0 < NIT; it0 += (long)G * NWAVES * 4) {
        f32x4 f0[2], f1[2], b0[2], b1[2], o0[2], o1[2], z0[2], z1[2];
#pragma unroll
        for (int k = 0; k < 2; ++k) { const long it = it0 + 2 * k; const size_t off = (size_t)(it >> 3) * DM + (int)(it & 7) * 256 + e0;
            ld_bf16x8(HF + off, f0[k], f1[k]); ld_bf16x8(HB + off, b0[k], b1[k]); ld_bf16x8(SO + off, o0[k], o1[k]); ld_bf16x8(SZ + off, z0[k], z1[k]); }
#pragma unroll
        for (int k = 0; k < 2; ++k) { const long it = it0 + 2 * k; const size_t off = (size_t)(it >> 3) * DM + (int)(it & 7) * 256 + e0;
            f32x4 y0 = o0[k] * (f0[k] + b0[k]), y1 = o1[k] * (f1[k] + b1[k]);
            float ss = 0.f;
#pragma unroll
            for (int q = 0; q < 4; ++q) ss += y0[q] * y0[q] + y1[q] * y1[q];
            ss += __shfl_xor(ss, 1); ss += __shfl_xor(ss, 2); ss += __shfl_xor(ss, 4); ss += __shfl_xor(ss, 8); ss += __shfl_xor(ss, 16);
            const float rs = 1.0f / sqrtf(ss * (1.f / 256.f) + EPS);
            const float* hp = hn + (int)(it & 7) * 256 + e0;
            const f32x4 h0 = *(const f32x4*)hp, h1 = *(const f32x4*)(hp + 4);
            st_bf16x8(U + off, y0 * rs * h0 * z0[k], y1 * rs * h1 * z1[k]); }
    }
}

DI void mlstm_layer(const Args& A, LAS unsigned char* lds, const XcdBarrier& gbar, int layer, int wv) {
    unsigned char* ws = A.ws;
    const bf16_t* H = (const bf16_t*)(ws + WS_H); bf16_t* U = (bf16_t*)(ws + WS_H);
    bf16_t* Q = (bf16_t*)(ws + WS_SCR + M_Q); bf16_t* Kb = (bf16_t*)(ws + WS_SCR + M_K); bf16_t* KVT = (bf16_t*)(ws + WS_SCR + M_KVT);
    float* G32 = (float*)(ws + WS_SCR + M_G32); bf16_t* SO = (bf16_t*)(ws + WS_SCR + M_SO); bf16_t* SZ = (bf16_t*)(ws + WS_SCR + M_SZ);
    norm_phase(A, layer, false, wv);
    xcd_barrier(gbar, wv);
    {
        DescM1 D; D.init(H, (const bf16_t*)(ws + WS_WMA), (const bf16_t*)(ws + WS_WMB));
        auto E = [=](const pg8::Unit& u, int row_l, int col_l, f32x4 v0, f32x4 v1) {
            if (u.i2 == 0) {
                const size_t row = (size_t)u.i0 * 256 + row_l; const int pn = u.i1;
                if (pn < 4) st_bf16x8(Q + row * 1024 + pn * 256 + col_l, v0 * 0.088388347648318440f, v1 * 0.088388347648318440f);
                else if (pn < 8) { st_bf16x8(Kb + row * 1024 + (pn - 4) * 256 + col_l, v0, v1);
                    const int bb = u.i0 / 9, sp = (u.i0 % 9) * 256 + row_l;
                    bf16_t* kt = KVT + ((size_t)bb * 3072 + (pn - 4) * 256 + col_l) * TB + sp;
                    const unsigned w0 = pk2(v0[0], v0[1]), w1 = pk2(v0[2], v0[3]), w2 = pk2(v1[0], v1[1]), w3 = pk2(v1[2], v1[3]);
                    kt[0] = (bf16_t)(w0 & 0xffffu); kt[TB] = (bf16_t)(w0 >> 16); kt[2 * TB] = (bf16_t)(w1 & 0xffffu); kt[3 * TB] = (bf16_t)(w1 >> 16);
                    kt[4 * TB] = (bf16_t)(w2 & 0xffffu); kt[5 * TB] = (bf16_t)(w2 >> 16); kt[6 * TB] = (bf16_t)(w3 & 0xffffu); kt[7 * TB] = (bf16_t)(w3 >> 16); }
                else if (col_l < 32) { *(f32x4*)(G32 + row * 32 + col_l) = v0; *(f32x4*)(G32 + row * 32 + col_l + 4) = v1; }
            } else {
                const int bb = u.i1 / 9, s0 = (u.i1 % 9) * 256;
                st_bf16x8(KVT + ((size_t)bb * 3072 + 1024 + u.i0 * 256 + row_l) * TB + s0 + col_l, v0, v1);
            }
        };
        pg8::gemm_phase(lds, D, E, wv);
    }
    xcd_barrier(gbar, wv);
    ml::scan_phase(A, lds, wv);
    xcd_barrier(gbar, wv);
    {
        DescPlain D; D.init(H, (const bf16_t*)(ws + WS_WMA) + (size_t)2304 * DM, 16, false);
        auto E = [=](const pg8::Unit& u, int row_l, int col_l, f32x4 v0, f32x4 v1) {
            const size_t row = (size_t)u.i0 * 256 + row_l; const int pn = u.i1; f32x4 a, b;
            if (pn < 8) {
#pragma unroll
                for (int q = 0; q < 4; ++q) { a[q] = sigmf(v0[q]); b[q] = sigmf(v1[q]); }
                st_bf16x8(SO + row * DM + pn * 256 + col_l, a, b);
            } else {
#pragma unroll
                for (int q = 0; q < 4; ++q) { a[q] = siluf(v0[q]); b[q] = siluf(v1[q]); }
                st_bf16x8(SZ + row * DM + (pn - 8) * 256 + col_l, a, b);
            }
        };
        pg8::gemm_phase(lds, D, E, wv);
    }
    xcd_barrier(gbar, wv);
    mlstm_finish_phase(A, wv);
    xcd_barrier(gbar, wv);
    {
        DescPlain D; D.init(U, (const bf16_t*)(ws + WS_WMO), 8, false);
        const float* modl = (const float*)(ws + WS_MOD) + (size_t)layer * 17 * MOD_LD;
        auto E = [=](const pg8::Unit& u, int row_l, int col_l, f32x4 v0, f32x4 v1) { resid_store(A, layer, u.i0, row_l, u.i1 * 256 + col_l, modl, v0, v1); };
        pg8::gemm_phase(lds, D, E, wv);
    }
    xcd_barrier(gbar, wv);
}

__global__ void __launch_bounds__(NTHREADS, 2) fwd_megakernel(Args A) {
    extern __shared__ __attribute__((aligned(16))) unsigned char lds_raw[];
    LAS unsigned char* lds = (LAS unsigned char*)lds_raw;
    cg::grid_group grid = cg::this_grid();
    const int wv = __builtin_amdgcn_readfirstlane(threadIdx.x >> 6);
    volatile LAS unsigned* bst = (volatile LAS unsigned*)(lds + 152576);
    if (otid(wv) < 2) bst[otid(wv)] = 0u;
    __syncthreads();
    const XcdBarrier gbar = xcd_barrier_post((unsigned*)(A.ws + WS_BAR), bst, wv);
    prep_phase(A, lds, wv);
    grid.sync();
    {
        const long long* mi = (const long long*)(A.ws + WS_MODI); float* mf = (float*)(A.ws + WS_MOD);
        for (int i = blockIdx.x * NTHREADS + otid(wv); i < 4 * 17 * MOD_LD; i += gridDim.x * NTHREADS) mf[i] = (float)mi[i] * MODI_INV;
    }
    xcd_barrier(gbar, wv);
    fnet_layer(A, lds, gbar, 0, 0, false, wv);
    mlstm_layer(A, lds, gbar, 1, wv);
    attn_layer(A, lds, (char*)lds_raw, gbar, 2, wv);
    fnet_layer(A, lds, gbar, 3, 1, true, wv);
    final_norm_phase(A, (const bf16_t*)(A.ws + WS_SCR + F_PQX), wv);
}

extern "C" void kernel_launch(void* const* d_in, const int* in_sizes, int n_in, void* d_out, int out_size, void* d_ws, size_t ws_size, hipStream_t stream) {
    static int grid = 0;
    if (grid == 0) {
        if (n_in != 18 || ws_size < WS_END) { fprintf(stderr, "kernel_launch: unexpected n_in %d / ws_size %zu (need %zu)\n", n_in, ws_size, (size_t)WS_END); grid = -1; return; }
        int dev = 0, cus = 0, per_cu = 0;
        hipGetDevice(&dev);
        hipDeviceGetAttribute(&cus, hipDeviceAttributeMultiprocessorCount, dev);
        if (hipFuncSetAttribute((const void*)fwd_megakernel, hipFuncAttributeMaxDynamicSharedMemorySize, LDS_BYTES) != hipSuccess) { fprintf(stderr, "kernel_launch: hipFuncSetAttribute failed\n"); grid = -1; return; }
        if (hipOccupancyMaxActiveBlocksPerMultiprocessor(&per_cu, (const void*)fwd_megakernel, NTHREADS, LDS_BYTES) != hipSuccess || per_cu < 1) { fprintf(stderr, "kernel_launch: occupancy query failed (%d)\n", per_cu); per_cu = 1; }
        (void)hipGetLastError();
        grid = cus * per_cu;
        fprintf(stderr, "kernel_launch: grid %d (cus %d x %d)\n", grid, cus, per_cu);
    }
    if (grid < 0) return;
    (void)hipMemsetAsync((char*)d_ws + WS_MOD, 0, ZERO_BYTES, stream);
    (void)hipMemsetAsync((char*)d_ws + WS_MODI, 0, MODI_BYTES, stream);
    Args a{};
    for (int i = 0; i < 18; ++i) a.in[i] = (const float*)d_in[i];
    a.out = (float*)d_out; a.ws = (unsigned char*)d_ws; a.ph_lo = 0; a.ph_hi = 100;
    void* args[] = {&a};
    hipError_t e = hipLaunchCooperativeKernel((const void*)fwd_megakernel, dim3(grid), dim3(NTHREADS), args, LDS_BYTES, stream);
    if (e != hipSuccess) fprintf(stderr, "kernel_launch: cooperative launch failed: %s (grid %d)\n", hipGetErrorString(e), grid);
}
```

```cpp
#include <hip/hip_runtime.h>
#include <hip/hip_cooperative_groups.h>
#include <cstdio>
#include <cstdint>
#include <type_traits>
namespace cg = cooperative_groups;

#define LAS __attribute__((address_space(3)))
#define DI __device__ __forceinline__
typedef unsigned short bf16_t;
typedef short bf16x8 __attribute__((ext_vector_type(8)));
typedef short s16x4 __attribute__((ext_vector_type(4)));
typedef float f32x2 __attribute__((ext_vector_type(2)));
typedef float f32x4 __attribute__((ext_vector_type(4)));
typedef float f32x16 __attribute__((ext_vector_type(16)));
typedef unsigned u32x2 __attribute__((ext_vector_type(2)));
typedef unsigned u32x4 __attribute__((ext_vector_type(4)));
typedef __bf16 bf16v2 __attribute__((ext_vector_type(2)));

constexpr int DM = 2048, NB = 16, TL = 2048, TC = 256, TB = TL + TC, NTOK = NB * TB;
constexpr int NWAVES = 8, NTHREADS = 512;
constexpr float EPS = 1e-6f;
constexpr int MOD_LD = 3 * DM;
constexpr int M_WA_ROWS = 6400, M_WB_ROWS = 3072;
constexpr size_t MiB = 1u << 20;
constexpr size_t WS_SCR_ = 301 * MiB;
constexpr size_t WS_MOD = 0;
constexpr size_t MOD_BYTES = (size_t)4 * 17 * MOD_LD * 4;
constexpr size_t WS_BAR = 1792 * 1024, ZERO_BYTES = 2 * MiB;
constexpr size_t WS_MODI = WS_SCR_ + 700 * MiB, MODI_BYTES = (size_t)4 * 17 * MOD_LD * 8;
constexpr float MODI_SCALE = 1073741824.f, MODI_INV = 9.313225746154785e-10f;
constexpr size_t WS_WFG = 2 * MiB, WS_WFO = 18 * MiB, WS_WMA = 34 * MiB, WS_WMB = 59 * MiB, WS_WMO = 71 * MiB, WS_WAI = 79 * MiB, WS_WAO = 99 * MiB;
constexpr size_t WS_DC = 107 * MiB, WS_DT = 108 * MiB, WS_DT2 = 124 * MiB, WS_CTXS = 125 * MiB, WS_H = 157 * MiB, WS_SCR = 301 * MiB;
constexpr size_t WS_END = 1024 * MiB;
constexpr size_t F_G = 0, F_PQX = 144 * MiB, F_PQC = 400 * MiB, F_A1 = 432 * MiB;
constexpr size_t M_Q = 0, M_K = 72 * MiB, M_KVT = 144 * MiB, M_G32 = 360 * MiB, M_HF = 365 * MiB, M_HB = 509 * MiB, M_SO = 0, M_SZ = 144 * MiB;
constexpr size_t A_Q = 0, A_K = 144 * MiB, A_V = 180 * MiB, A_SZ = 216 * MiB;
static_assert(WS_SCR + M_HB + 144 * MiB <= WS_END, "ws map");
constexpr int LDS_BYTES = 152576 + 1024;

DI unsigned pk2(float a, float b) { f32x2 v = {a, b}; return __builtin_bit_cast(unsigned, __builtin_convertvector(v, bf16v2)); }
DI float bf_lo(unsigned w) { return __uint_as_float(w << 16); }
DI float bf_hi(unsigned w) { return __uint_as_float(w & 0xffff0000u); }
DI float wave_sum(float v) {
#pragma unroll
    for (int o = 1; o < 64; o <<= 1) v += __shfl_xor(v, o);
    return v;
}
DI int otid(int wv) { int t; asm volatile("v_mbcnt_lo_u32_b32 %0, -1, 0\n\tv_mbcnt_hi_u32_b32 %0, -1, %0" : "=v"(t)); return wv * 64 + t; }
DI float siluf(float x) { return x * __builtin_amdgcn_rcpf(1.f + __expf(-x)); }
DI float sigmf(float x) { return __builtin_amdgcn_rcpf(1.f + __expf(-x)); }
DI void st_bf16x8(bf16_t* p, f32x4 a, f32x4 b) { u32x4 w = {pk2(a[0], a[1]), pk2(a[2], a[3]), pk2(b[0], b[1]), pk2(b[2], b[3])}; *(u32x4*)p = w; }
DI void ld_bf16x8(const bf16_t* p, f32x4& a, f32x4& b) { const u32x4 w = *(const u32x4*)p; a = (f32x4){bf_lo(w.x), bf_hi(w.x), bf_lo(w.y), bf_hi(w.y)}; b = (f32x4){bf_lo(w.z), bf_hi(w.z), bf_lo(w.w), bf_hi(w.w)}; }

DI f32x4 ldmod4(const long long* p) { return (f32x4){(float)p[0] * MODI_INV, (float)p[1] * MODI_INV, (float)p[2] * MODI_INV, (float)p[3] * MODI_INV}; }

struct Args { const float* in[18]; float* out; unsigned char* ws; int ph_lo, ph_hi; };

#define XB_TMO      128
#define XB_XCNT(j)  (256  + 64 * (j))
#define XB_XSUB(j)  (1280 + 64 * (j))
#define XB_XGEN(j)  (2304 + 64 * (j))
#define XB_TOP      3328
#define XB_TOPGEN   3392
#define XCD_BAR_WORDS 3456
#define XB_SPIN_CAP (1u << 18)

__device__ __forceinline__ unsigned xb_ld(unsigned* p)              { return __hip_atomic_load(p, __ATOMIC_RELAXED, __HIP_MEMORY_SCOPE_AGENT); }
__device__ __forceinline__ unsigned xb_add(unsigned* p, unsigned v) { return __hip_atomic_fetch_add(p, v, __ATOMIC_RELAXED, __HIP_MEMORY_SCOPE_AGENT); }
__device__ __forceinline__ unsigned xb_xcc_id() { return (unsigned)__builtin_amdgcn_s_getreg((3 << 11) | 20) & 0xFu; }
#define XB_SPIN(cond, bar) do { unsigned _sp = 0; while (cond) { __builtin_amdgcn_s_sleep(1); \
    if ((++_sp & 255u) == 0u) { if (xb_ld(&(bar)[XB_TMO])) break; if (_sp > XB_SPIN_CAP) { atomicAdd(&(bar)[XB_TMO], 1u); break; } } } } while (0)

struct XcdBarrier {
    unsigned* bar; unsigned x;
    volatile LAS unsigned* st;
};

__device__ __forceinline__ XcdBarrier xcd_barrier_post(unsigned* bar, volatile LAS unsigned* st, int wv) {
    XcdBarrier b; b.bar = bar; b.x = xb_xcc_id(); b.st = st;
    if (otid(wv) == 0) (void)xb_add(&bar[XB_XCNT(b.x)], 1u);
    return b;
}
__device__ __forceinline__ void xcd_barrier_complete(unsigned* bar, unsigned x, unsigned& nloc, unsigned& nx) {
    const unsigned G = gridDim.x * gridDim.y * gridDim.z;
    unsigned sum, cnt, mine, sp = 0u;
    for (;;) {
        sum = 0u; cnt = 0u; mine = 0u;
#pragma unroll
        for (unsigned j = 0; j < 16; ++j) { const unsigned c = xb_ld(&bar[XB_XCNT(j)]); sum += c; cnt += (c > 0u) ? 1u : 0u; mine = (j == x) ? c : mine; }
        if (sum == G) break;
        __builtin_amdgcn_s_sleep(1);
        if ((++sp & 255u) == 0u) { if (xb_ld(&bar[XB_TMO])) break; if (sp > XB_SPIN_CAP) { atomicAdd(&bar[XB_TMO], 1u); break; } }
    }
    nloc = mine > 0u ? mine : 1u; nx = cnt > 0u ? cnt : 1u;
}

__device__ __forceinline__ void xcd_barrier(const XcdBarrier& b, int wv) {
    asm volatile("s_waitcnt vmcnt(0)" ::: "memory");
    __syncthreads();
    if (otid(wv) == 0) {
        unsigned* bar = b.bar;
        __builtin_amdgcn_s_waitcnt(0);
        unsigned nloc = b.st[0], nx = b.st[1];
        if (nloc == 0u) { xcd_barrier_complete(bar, b.x, nloc, nx); b.st[0] = nloc; b.st[1] = nx; }
        const unsigned old = xb_add(&bar[XB_XSUB(b.x)], 1u);
        const unsigned gen = old / nloc;
        if (old + 1u == (gen + 1u) * nloc) {
            __builtin_amdgcn_fence(__ATOMIC_RELEASE, "agent");
            asm volatile("s_waitcnt vmcnt(0)" ::: "memory");
            const unsigned og = xb_add(&bar[XB_TOP], 1u);
            const unsigned tg = og / nx;
            if (og + 1u == (tg + 1u) * nx) xb_add(&bar[XB_TOPGEN], 1u);
            else XB_SPIN(xb_ld(&bar[XB_TOPGEN]) == tg, bar);
            __builtin_amdgcn_fence(__ATOMIC_ACQUIRE, "agent");
            xb_add(&bar[XB_XGEN(b.x)], 1u);
            asm volatile("s_waitcnt vmcnt(0)" ::: "memory");
        } else {
            XB_SPIN(xb_ld(&bar[XB_XGEN(b.x)]) == gen, bar);
            __builtin_amdgcn_fence(__ATOMIC_ACQUIRE, "agent");
            asm volatile("s_waitcnt vmcnt(0)" ::: "memory");
        }
    }
    __syncthreads();
}


namespace pg8 {
constexpr int BM = 256, BK = 64, HALF = 128, HTB = HALF * BK * 2, NXCD = 8;
DI int lds_byte(int r, int c) { const int st = (r >> 4) * 2 + (c >> 5), rr = r & 15, cc = c & 31, ob = rr * 64 + cc * 2; return st * 1024 + (ob ^ (((ob >> 9) & 1) << 5)); }
DI void stage_rc(int b, int& R, int& C) { const int st = b / 1024, sb = b % 1024, swz = sb ^ (((sb >> 9) & 1) << 5); R = (st >> 1) * 16 + swz / 64; C = (st & 1) * 32 + (swz % 64) / 2; }
DI int perm32(int rho) { const int n = rho >> 4, i = rho & 15; return 8 * (i >> 2) + 4 * n + (i & 3); }
struct Unit { const char* a; const char* b; int i0, i1, i2; };
template <class T, class = void> struct is_whole_tile : std::false_type {};
template <class T> struct is_whole_tile<T, std::void_t<decltype(T::WHOLE_TILE)>> : std::true_type {};
DI int xcd_remap(int L, int total) { const int q = total / NXCD, r = total % NXCD, xcd = L % NXCD, off = L / NXCD; return (xcd < r ? xcd * (q + 1) : r * (q + 1) + (xcd - r) * q) + off; }

template <class Desc, class Epi>
DI void gemm_phase(LAS unsigned char* lds, const Desc& D, const Epi& E, int wv) {
    const int tid = otid(wv), wid = __builtin_amdgcn_readfirstlane(tid >> 6), lane = tid & 63, wr = wid >> 2, wc = wid & 3, fr = lane & 15, fq = lane >> 4;
    const int G = gridDim.x, c = blockIdx.x, total = D.total;
    const int K = D.K, nt = K / BK;
    unsigned voffA[2], voffB[2];
#pragma unroll
    for (int i = 0; i < 2; ++i) { int R, C; stage_rc(tid * 16 + i * 8192, R, C); const int Rb = (R & ~31) + perm32(R & 31);
        voffA[i] = (unsigned)(R * D.lda + C) * 2u; voffB[i] = (unsigned)(Rb * D.ldb + C) * 2u; }
    const size_t kstep = (size_t)(BK * 2);
    const size_t hstepA = (size_t)HALF * D.lda * 2, hstepB = (size_t)HALF * D.ldb * 2;
    const unsigned ldsw = (unsigned)wid * 1024u;
    const int aoff = lds_byte(wr * 64 + fr, fq * 8), boff = lds_byte(wc * 32 + fr, fq * 8);
#define PG8_SA(b, h) (((b) * 2 + (h)) * HTB)
#define PG8_SB(b, h) ((4 + (b) * 2 + (h)) * HTB)
#define PG8_STAGE(bufoff, gbase, voff) do { _Pragma("unroll") for (int _i = 0; _i < 2; ++_i) \
        __builtin_amdgcn_global_load_lds((const unsigned*)((const char*)(gbase) + (voff)[_i]), (LAS unsigned*)(lds + (bufoff) + ldsw + _i * 8192), 16, 0, 0); } while (0)
#define PG8_LDA(dst, b, h) do { _Pragma("unroll") for (int m = 0; m < 4; ++m) _Pragma("unroll") for (int k = 0; k < 2; ++k) dst[m][k] = *(const LAS bf16x8*)(lds + PG8_SA(b, h) + aoff + m * 2048 + k * 1024); } while (0)
#define PG8_LDB(dst, b, h) do { _Pragma("unroll") for (int n = 0; n < 2; ++n) _Pragma("unroll") for (int k = 0; k < 2; ++k) dst[n][k] = *(const LAS bf16x8*)(lds + PG8_SB(b, h) + boff + n * 2048 + k * 1024); } while (0)
#define PG8_MMA(ai, bj, At, Bt) do { __builtin_amdgcn_s_setprio(1); _Pragma("unroll") for (int m = 0; m < 4; ++m) _Pragma("unroll") for (int n = 0; n < 2; ++n) _Pragma("unroll") for (int k = 0; k < 2; ++k) \
        acc[ai][bj][m][n] = __builtin_amdgcn_mfma_f32_16x16x32_bf16(Bt[n][k], At[m][k], acc[ai][bj][m][n], 0, 0, 0); __builtin_amdgcn_s_setprio(0); } while (0)
#define PG8_WAIT_V(n) asm volatile("s_waitcnt vmcnt(" #n ")" ::: "memory")
#define PG8_WAIT_L(n) asm volatile("s_waitcnt lgkmcnt(" #n ")" ::: "memory")
#define PG8_BAR __builtin_amdgcn_s_barrier()
#define PG8_SCHED __builtin_amdgcn_sched_barrier(0)
    if constexpr (Desc::RAW) { if (!D.valid(c, G)) return; } else { if (c >= total) return; }
    Unit cur, nxt; int ui = 0;
    if constexpr (Desc::RAW) cur = D.unit(c, G); else cur = D.unit(xcd_remap(c, total));
    nxt = cur;
    f32x4 acc[2][2][4][2];
#pragma unroll
    for (int a = 0; a < 2; ++a)
#pragma unroll
        for (int b = 0; b < 2; ++b)
#pragma unroll
            for (int m = 0; m < 4; ++m)
#pragma unroll
                for (int n = 0; n < 2; ++n) acc[a][b][m][n] = (f32x4){0.f, 0.f, 0.f, 0.f};
    bf16x8 At[4][2], B0[2][2], B1[2][2];
    const char* cA = cur.a; const char* cB = cur.b;
    PG8_STAGE(PG8_SB(0, 0), cB, voffB); PG8_STAGE(PG8_SB(0, 1), cB + hstepB, voffB); PG8_STAGE(PG8_SA(0, 0), cA, voffA); PG8_STAGE(PG8_SA(0, 1), cA + hstepA, voffA);
    if (wr == 1) PG8_BAR;
    PG8_WAIT_V(2); PG8_BAR;
    PG8_STAGE(PG8_SB(1, 0), cB + kstep, voffB); PG8_STAGE(PG8_SA(1, 0), cA + kstep, voffA); PG8_STAGE(PG8_SB(1, 1), cB + hstepB + kstep, voffB);
    PG8_WAIT_V(6); PG8_BAR;
    for (;;) {
        const long Ln = (long)(ui + 1) * G + c;
        bool has_next;
        if constexpr (Desc::RAW) { has_next = D.valid((int)Ln, G); if (has_next) nxt = D.unit((int)Ln, G); }
        else { has_next = Ln < total; if (has_next) nxt = D.unit(xcd_remap((int)Ln, total)); }
        const char* nA = has_next ? nxt.a : cA; const char* nB = has_next ? nxt.b : cB;
        for (int t = 0; t < nt; t += 2) {
            const bool last = (t == nt - 2);
            const char* a1 = cA + (size_t)(t + 1) * kstep;
            const char* a2 = last ? nA : cA + (size_t)(t + 2) * kstep; const char* b2 = last ? nB : cB + (size_t)(t + 2) * kstep;
            const char* a3 = a2 + kstep; const char* b3 = b2 + kstep;
            PG8_LDB(B0, 0, 0); PG8_LDB(B1, 0, 1); PG8_SCHED; PG8_LDA(At, 0, 0); PG8_STAGE(PG8_SA(1, 1), a1 + hstepA, voffA);
            PG8_WAIT_V(8); PG8_WAIT_L(0); PG8_BAR; PG8_MMA(0, 0, At, B0); PG8_MMA(0, 1, At, B1); PG8_BAR; PG8_SCHED;
            PG8_LDA(At, 0, 1); PG8_STAGE(PG8_SB(0, 0), b2, voffB); PG8_STAGE(PG8_SB(0, 1), b2 + hstepB, voffB); PG8_STAGE(PG8_SA(0, 0), a2, voffA);
            PG8_WAIT_V(8); PG8_WAIT_L(0); PG8_BAR; PG8_MMA(1, 0, At, B0); PG8_MMA(1, 1, At, B1); PG8_BAR; PG8_SCHED;
            PG8_LDB(B0, 1, 0); PG8_LDB(B1, 1, 1); PG8_SCHED; PG8_LDA(At, 1, 0); PG8_STAGE(PG8_SA(0, 1), a2 + hstepA, voffA);
            PG8_WAIT_V(8); PG8_WAIT_L(0); PG8_BAR; PG8_MMA(0, 0, At, B0); PG8_MMA(0, 1, At, B1); PG8_BAR; PG8_SCHED;
            PG8_LDA(At, 1, 1); PG8_STAGE(PG8_SB(1, 0), b3, voffB); PG8_STAGE(PG8_SB(1, 1), b3 + hstepB, voffB); PG8_STAGE(PG8_SA(1, 0), a3, voffA);
            PG8_WAIT_V(8); PG8_WAIT_L(0); PG8_BAR; PG8_MMA(1, 0, At, B0); PG8_MMA(1, 1, At, B1); PG8_BAR; PG8_SCHED;
        }
        if (wr == 0) PG8_BAR;
        {
            const int le = otid(wv) & 63, fre = le & 15, fqe = le >> 4;
            if constexpr (is_whole_tile<Epi>::value) E.run(cur, acc, wr, wc, fre, fqe); else
#pragma unroll
            for (int ai = 0; ai < 2; ++ai)
#pragma unroll
                for (int m = 0; m < 4; ++m)
#pragma unroll
                    for (int bj = 0; bj < 2; ++bj)
                        E(cur, ai * HALF + wr * 64 + m * 16 + fre, bj * HALF + wc * 32 + 8 * fqe, acc[ai][bj][m][0], acc[ai][bj][m][1]);
        }
        if (!has_next) break;
#pragma unroll
        for (int a = 0; a < 2; ++a)
#pragma unroll
            for (int b = 0; b < 2; ++b)
#pragma unroll
                for (int m = 0; m < 4; ++m)
#pragma unroll
                    for (int n = 0; n < 2; ++n) acc[a][b][m][n] = (f32x4){0.f, 0.f, 0.f, 0.f};
        cur = nxt; cA = nA; cB = nB; ++ui;
        if (wr == 1) PG8_BAR;
    }
    PG8_WAIT_V(0);
    PG8_BAR;
#undef PG8_SA
#undef PG8_SB
#undef PG8_STAGE
#undef PG8_LDA
#undef PG8_LDB
#undef PG8_MMA
#undef PG8_WAIT_V
#undef PG8_WAIT_L
#undef PG8_BAR
#undef PG8_SCHED
}
}

DI void transpose_item(const float* W, int N, int kb, int nb, bf16_t* d0, bf16_t* d1, int K, LAS float* scr, int lane) {
    const int k0 = 64 * kb, n0 = 32 * nb;
#pragma unroll 8
    for (int i = 0; i < 32; ++i) { const int kk = 2 * i + (lane >> 5); scr[kk * 33 + (lane & 31)] = W[(size_t)(k0 + kk) * N + n0 + (lane & 31)]; }
    asm volatile("s_waitcnt lgkmcnt(0)" ::: "memory");
    const int c = lane & 7;
#pragma unroll
    for (int j = 0; j < 4; ++j) { const int n = (lane >> 3) + 8 * j; const LAS float* s = scr + (8 * c) * 33 + n;
        u32x4 o; o.x = pk2(s[0 * 33], s[1 * 33]); o.y = pk2(s[2 * 33], s[3 * 33]); o.z = pk2(s[4 * 33], s[5 * 33]); o.w = pk2(s[6 * 33], s[7 * 33]);
        *(u32x4*)(d0 + (size_t)n * K + k0 + 8 * c) = o;
        if (d1) *(u32x4*)(d1 + (size_t)n * K + k0 + 8 * c) = o; }
    asm volatile("s_waitcnt lgkmcnt(0)" ::: "memory");
}

DI void prep_phase(const Args& A, LAS unsigned char* lds, int wv) {
    const int tid = otid(wv), lane = tid & 63, wave = tid >> 6, G = gridDim.x;
    unsigned char* ws = A.ws;
    {
        LAS float* s_lds = (LAS float*)lds;
        const float* cc = A.in[1]; const float* cctx = A.in[3]; const float* aw = A.in[4]; const float* ab = A.in[5];
        long long* modi = (long long*)(ws + WS_MODI);
        for (int item = blockIdx.x; item < 768; item += G) {
            const int kc = item % 16, cb = (item / 16) % 12, l = item / 192;
            const int k0 = kc * 128, j = cb * 512 + tid;
            __syncthreads();
            for (int e = tid; e < 17 * 128; e += NTHREADS) { const int r = e / 128, k = e % 128; const float v = r < 16 ? cc[r * DM + k0 + k] : cctx[k0 + k]; s_lds[k * 20 + r] = siluf(v); }
            __syncthreads();
            float acc[17];
#pragma unroll
            for (int r = 0; r < 17; ++r) acc[r] = 0.f;
            const float* wp = aw + ((size_t)l * DM + k0) * MOD_LD + j;
#pragma unroll 4
            for (int k = 0; k < 128; ++k) {
                const float w = wp[(size_t)k * MOD_LD];
                const LAS f32x4* sp = (const LAS f32x4*)(s_lds + k * 20);
                const f32x4 s0 = sp[0], s1 = sp[1], s2 = sp[2], s3 = sp[3]; const float s4 = s_lds[k * 20 + 16];
#pragma unroll
                for (int q = 0; q < 4; ++q) { acc[q] += s0[q] * w; acc[4 + q] += s1[q] * w; acc[8 + q] += s2[q] * w; acc[12 + q] += s3[q] * w; }
                acc[16] += s4 * w;
            }
            const float bias = (kc == 0) ? ab[l * MOD_LD + j] : 0.f;
#pragma unroll
            for (int r = 0; r < 17; ++r) atomicAdd((unsigned long long*)&modi[(size_t)(l * 17 + r) * MOD_LD + j], (unsigned long long)__float2ll_rn((acc[r] + bias) * MODI_SCALE));
        }
        __syncthreads();
    }
    {
        LAS float* scr = (LAS float*)(lds + wave * 16384);
        const int gw = blockIdx.x * NWAVES + wave, NGW = G * NWAVES;
        constexpr int I_SQ = 32 * 64, I_AI = 32 * 160, I_MI = 32 * 257;
        constexpr int NIT = 6 * I_SQ + I_AI + I_MI;
        for (int it = gw; it < NIT; it += NGW) {
            int r = it;
            if (r < 6 * I_SQ) {
                const int w = r / I_SQ; r -= w * I_SQ;
                const float* src; bf16_t* dst;
                if (w < 2)      { src = A.in[7] + (size_t)w * DM * DM;       dst = (bf16_t*)(ws + WS_WFG) + (size_t)w * DM * DM; }
                else if (w < 4) { src = A.in[8] + (size_t)(w - 2) * DM * DM; dst = (bf16_t*)(ws + WS_WFO) + (size_t)(w - 2) * DM * DM; }
                else if (w == 4) { src = A.in[12]; dst = (bf16_t*)(ws + WS_WMO); }
                else             { src = A.in[16]; dst = (bf16_t*)(ws + WS_WAO); }
                const int kb = r / 64, nb = r % 64;
                transpose_item(src, DM, kb, nb, dst + (size_t)(32 * nb) * DM, nullptr, DM, scr, lane);
                continue;
            }
            r -= 6 * I_SQ;
            if (r < I_AI) { const int kb = r / 160, nb = r % 160; transpose_item(A.in[13], 5120, kb, nb, (bf16_t*)(ws + WS_WAI) + (size_t)(32 * nb) * DM, nullptr, DM, scr, lane); continue; }
            r -= I_AI;
            {
                const int kb = r / 257, nb = r % 257, n0 = 32 * nb;
                bf16_t* WA = (bf16_t*)(ws + WS_WMA); bf16_t* WB = (bf16_t*)(ws + WS_WMB);
                bf16_t* d0; bf16_t* d1 = nullptr;
                if (n0 < 1024) d0 = WA + (size_t)n0 * DM;
                else if (n0 < 2048) d0 = WA + (size_t)n0 * DM;
                else if (n0 < 4096) d0 = WB + (size_t)(n0 - 2048) * DM;
                else if (n0 < 6144) d0 = WA + (size_t)(2304 + n0 - 4096) * DM;
                else if (n0 < 6176) d0 = WA + (size_t)(2048 + n0 - 6144) * DM;
                else d0 = WA + (size_t)(4352 + n0 - 6176) * DM;
                transpose_item(A.in[9], 8224, kb, nb, d0, d1, DM, scr, lane);
            }
        }
    }
    {
        const long gt = (long)blockIdx.x * NTHREADS + tid, NGT = (long)G * NTHREADS;
        constexpr long N_DC = 1024L * 512 / 8, N_DT = 2048L * 4096 / 8, N_DT2 = 256L * 512 / 8;
        for (long it = gt; it < N_DC + N_DT + N_DT2; it += NGT) {
            float v[8]; bf16_t* dst;
            if (it < N_DC) {
                const int m = (int)(it / 64), k0 = (int)(it % 64) * 8; const float sc = 0.044194173824159216f;
#pragma unroll
                for (int j = 0; j < 8; ++j) { const int rr = ((m & 511) * (k0 + j)) & 511; const float ang = (float)rr * (1.f / 256.f); v[j] = (m < 512 ? cospif(ang) : sinpif(ang)) * sc; }
                dst = (bf16_t*)(ws + WS_DC) + (size_t)m * 512 + k0;
            } else if (it < N_DC + N_DT) {
                const long i2 = it - N_DC; const int kk = (int)(i2 / 512), s0 = (int)(i2 % 512) * 8; const float sc = 0.022097086912079608f;
#pragma unroll
                for (int j = 0; j < 8; ++j) { const int s = s0 + j; const int rr = (kk * (s & 2047)) & 2047; const float ang = (float)rr * (1.f / 1024.f); v[j] = (s < 2048 ? cospif(ang) : -sinpif(ang)) * sc; }
                dst = (bf16_t*)(ws + WS_DT) + (size_t)kk * 4096 + s0;
            } else {
                const long i2 = it - N_DC - N_DT; const int kk = (int)(i2 / 64), s0 = (int)(i2 % 64) * 8; const float sc = 0.0625f;
#pragma unroll
                for (int j = 0; j < 8; ++j) { const int s = s0 + j; const int rr = (kk * (s & 255)) & 255; const float ang = (float)rr * (1.f / 128.f); v[j] = (s < 256 ? cospif(ang) : -sinpif(ang)) * sc; }
                dst = (bf16_t*)(ws + WS_DT2) + (size_t)kk * 512 + s0;
            }
            u32x4 o = {pk2(v[0], v[1]), pk2(v[2], v[3]), pk2(v[4], v[5]), pk2(v[6], v[7])};
            *(u32x4*)dst = o;
        }
    }
}

DI const float* xrow_in(const Args& A, int r) {
    const int b = r / TB, t = r % TB;
    if (t < TL) return A.in[0] + ((size_t)b * TL + t) * DM;
    return A.in[2] + ((size_t)b * TC + (t - TL)) * DM;
}
DI void norm_phase(const Args& A, int layer, bool latonly, int wv) {
    const int tid = otid(wv), lane = tid & 63, wave = tid >> 6, G = gridDim.x;
    const float* ng = A.in[6] + (size_t)layer * DM;
    const float* mod = (const float*)(A.ws + WS_MOD) + (size_t)layer * 17 * MOD_LD;
    bf16_t* H = (bf16_t*)(A.ws + WS_H);
    const bf16_t* XB = (const bf16_t*)A.out;
    for (int r0 = (blockIdx.x * NWAVES + wave) * 2; r0 < NTOK; r0 += G * NWAVES * 2) {
        const int b = r0 / TB, t = r0 % TB;
        if (latonly && t >= TL) continue;
        const float* mr = mod + (size_t)(t < TL ? b : 16) * MOD_LD;
        f32x4 v[2][4][2];
#pragma unroll
        for (int k = 0; k < 2; ++k) {
            const int r = r0 + k;
            if (layer == 0) {
                const float* xr = xrow_in(A, r);
#pragma unroll
                for (int j = 0; j < 4; ++j) { const f32x4* p = (const f32x4*)(xr + 512 * j + 8 * lane); v[k][j][0] = p[0]; v[k][j][1] = p[1]; }
            } else {
#pragma unroll
                for (int j = 0; j < 4; ++j) ld_bf16x8(XB + (size_t)r * DM + 512 * j + 8 * lane, v[k][j][0], v[k][j][1]);
            }
        }
#pragma unroll
        for (int k = 0; k < 2; ++k) {
            const int r = r0 + k; float ss = 0.f;
#pragma unroll
            for (int j = 0; j < 4; ++j)
#pragma unroll
                for (int q = 0; q < 4; ++q) ss += v[k][j][0][q] * v[k][j][0][q] + v[k][j][1][q] * v[k][j][1][q];
            const float rs = 1.0f / sqrtf(wave_sum(ss) * (1.f / DM) + EPS);
#pragma unroll
            for (int j = 0; j < 4; ++j) { const int c0 = 512 * j + 8 * lane; f32x4 o[2];
#pragma unroll
                for (int h = 0; h < 2; ++h) { const f32x4 g4 = *(const f32x4*)(ng + c0 + 4 * h), sh = *(const f32x4*)(mr + c0 + 4 * h), sc = *(const f32x4*)(mr + DM + c0 + 4 * h);
                    o[h] = (v[k][j][h] * rs) * g4 * (sc + 1.0f) + sh; }
                st_bf16x8(H + (size_t)r * DM + c0, o[0], o[1]); }
        }
    }
}
DI void final_norm_phase(const Args& A, const bf16_t* src, int wv) {
    const int tid = otid(wv), lane = tid & 63, wave = tid >> 6, G = gridDim.x;
    const float* fg = A.in[17];
    for (int r0 = (blockIdx.x * NWAVES + wave) * 2; r0 < NB * TL; r0 += G * NWAVES * 2) {
        f32x4 v[2][4][2];
#pragma unroll
        for (int k = 0; k < 2; ++k)
#pragma unroll
            for (int j = 0; j < 4; ++j) ld_bf16x8(src + (size_t)(r0 + k) * DM + 512 * j + 8 * lane, v[k][j][0], v[k][j][1]);
#pragma unroll
        for (int k = 0; k < 2; ++k) { float* orow = A.out + (size_t)(r0 + k) * DM; float ss = 0.f;
#pragma unroll
            for (int j = 0; j < 4; ++j)
#pragma unroll
                for (int q = 0; q < 4; ++q) ss += v[k][j][0][q] * v[k][j][0][q] + v[k][j][1][q] * v[k][j][1][q];
            const float rs = 1.0f / sqrtf(wave_sum(ss) * (1.f / DM) + EPS);
#pragma unroll
            for (int j = 0; j < 4; ++j) { const int c0 = 512 * j + 8 * lane;
#pragma unroll
                for (int h = 0; h < 2; ++h) { const f32x4 g4 = *(const f32x4*)(fg + c0 + 4 * h); *(f32x4*)(orow + c0 + 4 * h) = (v[k][j][h] * rs) * g4; } }
        }
    }
}

struct DescPlain {
    static constexpr bool RAW = false;
    const bf16_t* A; const bf16_t* B; int nN; bool latonly; int lda, ldb, K, total;
    DI void init(const bf16_t* A_, const bf16_t* B_, int nN_, bool lat) { A = A_; B = B_; nN = nN_; latonly = lat; lda = DM; ldb = DM; K = DM; total = (lat ? 128 : 144) * nN_; }
    DI pg8::Unit unit(int idx) const {
        const int nMt = latonly ? 128 : 144, nig = 8 * nN, gid = idx / nig, fm = gid * 8, gsz = (nMt - fm) < 8 ? (nMt - fm) : 8;
        const int pmi = fm + (idx % nig) % gsz, pn = (idx % nig) / gsz, pm = latonly ? (pmi / 8) * 9 + (pmi % 8) : pmi;
        pg8::Unit u; u.a = (const char*)(A + (size_t)pm * 256 * DM); u.b = (const char*)(B + (size_t)pn * 256 * DM); u.i0 = pm; u.i1 = pn; u.i2 = 0; return u;
    }
};
struct DescChan {
    static constexpr bool RAW = false;
    const bf16_t* DC; const bf16_t* H; int lda, ldb, K, total;
    DI void init(const bf16_t* DC_, const bf16_t* H_, bool lat) { DC = DC_; H = H_; lda = 512; ldb = DM; K = 512; total = lat ? 2048 : 2304; }
    DI pg8::Unit unit(int idx) const {
        pg8::Unit u; int b, g, mt, nt, toff;
        if (idx < 2048) { mt = idx % 4; nt = (idx / 4) % 8; g = (idx / 32) % 4; b = idx / 128; toff = nt * 256; u.i2 = nt; }
        else { const int j = idx - 2048; mt = j % 4; g = (j / 4) % 4; b = j / 16; toff = TL; u.i2 = 8; }
        u.a = (const char*)(DC + (size_t)mt * 256 * 512); u.b = (const char*)(H + ((size_t)b * TB + toff) * DM + g * 512); u.i0 = b * 4 + g; u.i1 = mt; return u;
    }
};
struct DescT {
    static constexpr bool RAW = false;
    const bf16_t* DT; const bf16_t* PQ; int nMt; int lda, ldb, K, total;
    DI void init(const bf16_t* DT_, const bf16_t* PQ_, int ld, int Kd, int coff, int nMt_) { DT = DT_ + coff; PQ = PQ_ + coff; nMt = nMt_; lda = ld; ldb = ld; K = Kd; total = NB * nMt_ * 8; }
    DI pg8::Unit unit(int idx) const {
        const int mt = idx % nMt, nt = (idx / nMt) % 8, b = idx / (nMt * 8);
        pg8::Unit u; u.a = (const char*)(DT + (size_t)mt * 256 * lda); u.b = (const char*)(PQ + ((size_t)b * DM + nt * 256) * ldb); u.i0 = b; u.i1 = mt; u.i2 = nt; return u;
    }
};

struct DescT2 {
    static constexpr bool RAW = true;
    const bf16_t* DT; const bf16_t* PQ; int lda, ldb, K, total;
    DI void init(const bf16_t* DT_, const bf16_t* PQ_) { DT = DT_; PQ = PQ_; lda = 4096; ldb = 4096; K = 2048; total = 2 * NB * 4 * 8; }
    DI bool valid(int L, int G) const { return ((L / G) >> 1) * G + (L % G) < NB * 4 * 8; }
    DI pg8::Unit unit(int L, int G) const {
        const int i = L / G, pair = (i >> 1) * G + (L % G), part = i & 1;
        const int mt = pair % 4, nt = (pair / 4) % 8, b = pair / 32, coff = part * 2048;
        pg8::Unit u; u.a = (const char*)(DT + (size_t)mt * 256 * 4096 + coff); u.b = (const char*)(PQ + ((size_t)b * DM + nt * 256) * 4096 + coff); u.i0 = b; u.i1 = mt; u.i2 = part * 8 + nt; return u;
    }
};

DI void resid_store(const Args& A, int layer, int pm, int row_l, int col, const float* modl, f32x4 v0, f32x4 v1) {
    const int b = pm / 9, tt = pm % 9;
    const float* gp = modl + (size_t)(tt < 8 ? b : 16) * MOD_LD + 2 * DM + col;
    const f32x4 g0 = *(const f32x4*)gp, g1 = *(const f32x4*)(gp + 4);
    bf16_t* XB = (bf16_t*)A.out;
    const size_t roff = ((size_t)pm * 256 + row_l) * DM + col;
    f32x4 x0, x1;
    if (layer == 0) {
        const float* src = (tt < 8) ? A.in[0] + ((size_t)b * TL + tt * 256 + row_l) * DM + col : A.in[2] + ((size_t)b * TC + row_l) * DM + col;
        x0 = *(const f32x4*)src; x1 = *(const f32x4*)(src + 4);
    } else ld_bf16x8(XB + roff, x0, x1);
    x0 = x0 + g0 * v0; x1 = x1 + g1 * v1;
    if (layer == 3) st_bf16x8((bf16_t*)(A.ws + WS_SCR + F_PQX) + ((size_t)b * TL + tt * 256 + row_l) * DM + col, x0, x1);
    else st_bf16x8(XB + roff, x0, x1);
}

struct EpiResid {
    static constexpr bool WHOLE_TILE = true;
    const float* x_in; const float* c_in; bf16_t* XB; bf16_t* X2; const float* modl; int layer;
    DI void init(const Args& A, int layer_) { x_in = A.in[0]; c_in = A.in[2]; XB = (bf16_t*)A.out; X2 = (bf16_t*)(A.ws + WS_SCR + F_PQX); modl = (const float*)(A.ws + WS_MOD) + (size_t)layer_ * 17 * MOD_LD; layer = layer_; }
    DI void run(const pg8::Unit& u, const f32x4 (&acc)[2][2][4][2], int wr, int wc, int fr, int fq) const {
        const int pm = u.i0, b = pm / 9, tt = pm % 9, col0 = u.i1 * 256 + wc * 32 + 8 * fq;
        f32x4 g[2][2];
#pragma unroll
        for (int bj = 0; bj < 2; ++bj) { const float* gp = modl + (size_t)(tt < 8 ? b : 16) * MOD_LD + 2 * DM + col0 + bj * 128; g[bj][0] = *(const f32x4*)gp; g[bj][1] = *(const f32x4*)(gp + 4); }
        if (layer != 0) {
            u32x4 xq[2][4][2];
#pragma unroll
            for (int ai = 0; ai < 2; ++ai)
#pragma unroll
                for (int m = 0; m < 4; ++m)
#pragma unroll
                    for (int bj = 0; bj < 2; ++bj) xq[ai][m][bj] = *(const u32x4*)(XB + ((size_t)pm * 256 + ai * 128 + wr * 64 + m * 16 + fr) * DM + col0 + bj * 128);
#pragma unroll
            for (int ai = 0; ai < 2; ++ai)
#pragma unroll
                for (int m = 0; m < 4; ++m)
#pragma unroll
                    for (int bj = 0; bj < 2; ++bj) {
                        const int row_l = ai * 128 + wr * 64 + m * 16 + fr; const u32x4 w = xq[ai][m][bj];
                        const f32x4 x0 = (f32x4){bf_lo(w.x), bf_hi(w.x), bf_lo(w.y), bf_hi(w.y)} + g[bj][0] * acc[ai][bj][m][0];
                        const f32x4 x1 = (f32x4){bf_lo(w.z), bf_hi(w.z), bf_lo(w.w), bf_hi(w.w)} + g[bj][1] * acc[ai][bj][m][1];
                        if (layer == 3) st_bf16x8(X2 + ((size_t)b * TL + tt * 256 + row_l) * DM + col0 + bj * 128, x0, x1);
                        else st_bf16x8(XB + ((size_t)pm * 256 + row_l) * DM + col0 + bj * 128, x0, x1);
                    }
        } else {
#pragma unroll
            for (int ai = 0; ai < 2; ++ai) {
                f32x4 xf[4][2][2];
#pragma unroll
                for (int m = 0; m < 4; ++m)
#pragma unroll
                    for (int bj = 0; bj < 2; ++bj) { const int row_l = ai * 128 + wr * 64 + m * 16 + fr;
                        const float* src = (tt < 8) ? x_in + ((size_t)b * TL + tt * 256 + row_l) * DM + col0 + bj * 128 : c_in + ((size_t)b * TC + row_l) * DM + col0 + bj * 128;
                        xf[m][bj][0] = *(const f32x4*)src; xf[m][bj][1] = *(const f32x4*)(src + 4); }
#pragma unroll
                for (int m = 0; m < 4; ++m)
#pragma unroll
                    for (int bj = 0; bj < 2; ++bj) { const int row_l = ai * 128 + wr * 64 + m * 16 + fr;
                        st_bf16x8(XB + ((size_t)pm * 256 + row_l) * DM + col0 + bj * 128, xf[m][bj][0] + g[bj][0] * acc[ai][bj][m][0], xf[m][bj][1] + g[bj][1] * acc[ai][bj][m][1]); }
            }
        }
    }
};

DI void fnet_layer(const Args& A, LAS unsigned char* lds, const XcdBarrier& gbar, int layer, int j, bool latonly, int wv) {
    unsigned char* ws = A.ws;
    const bf16_t* H = (const bf16_t*)(ws + WS_H); bf16_t* U = (bf16_t*)(ws + WS_H);
    bf16_t* Gt = (bf16_t*)(ws + WS_SCR + F_G); bf16_t* PQX = (bf16_t*)(ws + WS_SCR + F_PQX); bf16_t* PQC = (bf16_t*)(ws + WS_SCR + F_PQC);
    norm_phase(A, layer, latonly, wv);
    xcd_barrier(gbar, wv);
    {
        DescPlain D; D.init(H, (const bf16_t*)(ws + WS_WFG) + (size_t)j * DM * DM, 8, latonly);
        auto E = [=](const pg8::Unit& u, int row_l, int col_l, f32x4 v0, f32x4 v1) {
            f32x4 a, b;
#pragma unroll
            for (int q = 0; q < 4; ++q) { a[q] = siluf(v0[q]); b[q] = siluf(v1[q]); }
            st_bf16x8(Gt + ((size_t)u.i0 * 256 + row_l) * DM + u.i1 * 256 + col_l, a, b);
        };
        pg8::gemm_phase(lds, D, E, wv);
    }
    {
        DescChan D; D.init((const bf16_t*)(ws + WS_DC), H, latonly);
        auto E = [=](const pg8::Unit& u, int row_l, int col_l, f32x4 v0, f32x4 v1) {
            const int b = u.i0 >> 2, g = u.i0 & 3, mt = u.i1, half = mt >> 1, ch = g * 512 + (mt & 1) * 256 + row_l;
            bf16_t* dst = (u.i2 < 8) ? PQX + ((size_t)b * DM + ch) * 4096 + half * 2048 + u.i2 * 256 + col_l
                                     : PQC + ((size_t)b * DM + ch) * 512 + half * 256 + col_l;
            st_bf16x8(dst, v0, v1);
        };
        pg8::gemm_phase(lds, D, E, wv);
    }
    xcd_barrier(gbar, wv);
    bf16_t* A1 = (bf16_t*)(ws + WS_SCR + F_A1);
    {
        const int tid = otid(wv), lane = tid & 63;
        for (int rr0 = (blockIdx.x * NWAVES + wv) * 4; rr0 < NB * DM; rr0 += gridDim.x * NWAVES * 4) {
            u32x4 raw[4][4];
#pragma unroll
            for (int k = 0; k < 4; ++k)
#pragma unroll
                for (int q = 0; q < 4; ++q) raw[k][q] = *(const u32x4*)(PQX + (size_t)(rr0 + k) * 4096 + (q * 64 + lane) * 8);
#pragma unroll
            for (int k = 0; k < 4; ++k) { float acc = 0.f;
#pragma unroll
                for (int q = 0; q < 4; ++q) { const u32x4 w = raw[k][q]; acc += (bf_lo(w.x) - bf_hi(w.x)) + (bf_lo(w.y) - bf_hi(w.y)) + (bf_lo(w.z) - bf_hi(w.z)) + (bf_lo(w.w) - bf_hi(w.w)); }
                acc = wave_sum(acc);
                if (lane == 0) { const int rr = rr0 + k; const size_t off = ((size_t)(rr >> 11) * TB + 1024) * DM + (rr & 2047);
                    U[off] = (bf16_t)(pk2(acc * 0.022097086912079608f * __uint_as_float((unsigned)Gt[off] << 16), 0.f) & 0xffffu); } }
        }
    }
    {
        DescT2 D; D.init((const bf16_t*)(ws + WS_DT), PQX);
        auto E = [=](const pg8::Unit& u, int row_l, int col_l, f32x4 v0, f32x4 v1) {
            const int k = u.i1 * 256 + row_l, col = (u.i2 & 7) * 256 + col_l;
            bf16_t* ap = A1 + ((size_t)u.i0 * 1024 + k) * DM + col;
            if (u.i2 < 8) { st_bf16x8(ap, v0, v1); return; }
            f32x4 a0, a1; ld_bf16x8(ap, a0, a1);
            const size_t off = ((size_t)u.i0 * TB + k) * DM + col;
            f32x4 g0, g1; ld_bf16x8(Gt + off, g0, g1);
            st_bf16x8(U + off, (a0 + v0) * g0, (a1 + v1) * g1);
            if (k != 0) { const size_t off2 = ((size_t)u.i0 * TB + (TL - k)) * DM + col; ld_bf16x8(Gt + off2, g0, g1); st_bf16x8(U + off2, (a0 - v0) * g0, (a1 - v1) * g1); }
        };
        pg8::gemm_phase(lds, D, E, wv);
    }
    if (!latonly) {
        DescT D; D.init((const bf16_t*)(ws + WS_DT2), PQC, 512, 512, 0, 1);
        auto E = [=](const pg8::Unit& u, int row_l, int col_l, f32x4 v0, f32x4 v1) {
            const size_t off = ((size_t)u.i0 * TB + TL + row_l) * DM + u.i2 * 256 + col_l;
            f32x4 g0, g1; ld_bf16x8(Gt + off, g0, g1);
            st_bf16x8(U + off, v0 * g0, v1 * g1);
        };
        pg8::gemm_phase(lds, D, E, wv);
    }
    xcd_barrier(gbar, wv);
    {
        DescPlain D; D.init(U, (const bf16_t*)(ws + WS_WFO) + (size_t)j * DM * DM, 8, latonly);
        EpiResid E; E.init(A, layer);
        pg8::gemm_phase(lds, D, E, wv);
    }
    xcd_barrier(gbar, wv);
}


namespace att {
constexpr int D = 128, NW = 8, QBLK = 32, KVBLK = 64;
constexpr float SCALE = 0.088388347648318440f;
constexpr float THR = 8.f;
constexpr int LDQ = 2048, LDK = 512;
constexpr size_t SHM_V = KVBLK * D * 2, SHM_K = KVBLK * D * 2;
typedef float f32x8 __attribute__((ext_vector_type(8)));
#define KSWZ(row, colB) ((row) * 256 + ((colB) ^ (((row) & 7) << 4)))
#define SBAR() __builtin_amdgcn_sched_barrier(0)
DI int crow(int r, int hi) { return (r & 3) + 8 * (r >> 2) + 4 * hi; }
DI unsigned cvtpk(float lo, float hi) { unsigned r; asm volatile("v_cvt_pk_bf16_f32 %0, %1, %2" : "=v"(r) : "v"(lo), "v"(hi)); return r; }
DI void partialSM(f32x16& p0, f32x16& p1, float& m_reg, float& mn, float& alpha) {
  constexpr float C = SCALE * 1.4426950408889634f;
  float pmax = p0[0];
#pragma unroll
  for (int r = 1; r < 16; ++r) pmax = fmaxf(pmax, p0[r]);
#pragma unroll
  for (int r = 0; r < 16; ++r) pmax = fmaxf(pmax, p1[r]);
  { auto rr = __builtin_amdgcn_permlane32_swap(__float_as_uint(pmax), __float_as_uint(pmax), false, false);
    pmax = fmaxf(__uint_as_float(rr[0]), __uint_as_float(rr[1])); }
  if (__builtin_expect(__all(pmax - m_reg <= THR / SCALE), 1)) { mn = m_reg; alpha = 1.f; }
  else { mn = fmaxf(m_reg, pmax); alpha = __builtin_amdgcn_exp2f((m_reg - mn) * C); m_reg = mn; }
  float mnC = -mn * C;
#pragma unroll
  for (int r = 0; r < 16; ++r) p0[r] = fmaf(p0[r], C, mnC);
#pragma unroll
  for (int r = 0; r < 16; ++r) p1[r] = fmaf(p1[r], C, mnC);
#pragma unroll
  for (int r = 0; r < 16; ++r) p0[r] = __builtin_amdgcn_exp2f(p0[r]);
}
DI void finishSM(f32x16& p0, f32x16& p1, float alpha, float& l_reg, bf16x8& pa0, bf16x8& pa1, bf16x8& pa2, bf16x8& pa3) {
#pragma unroll
  for (int r = 0; r < 16; ++r) p1[r] = __builtin_amdgcn_exp2f(p1[r]);
  float ps = 0;
#pragma unroll
  for (int r = 0; r < 16; ++r) ps += p0[r];
#pragma unroll
  for (int r = 0; r < 16; ++r) ps += p1[r];
  { auto rr = __builtin_amdgcn_permlane32_swap(__float_as_uint(ps), __float_as_uint(ps), false, false);
    ps = __uint_as_float(rr[0]) + __uint_as_float(rr[1]); }
  l_reg = l_reg * alpha + ps;
#define PK4(P, BASE, OUT) do { unsigned a0 = cvtpk(P[BASE + 0], P[BASE + 1]), a1 = cvtpk(P[BASE + 2], P[BASE + 3]);   \
    unsigned b0 = cvtpk(P[BASE + 4], P[BASE + 5]), b1 = cvtpk(P[BASE + 6], P[BASE + 7]);                              \
    auto r0 = __builtin_amdgcn_permlane32_swap(a0, b0, false, false); auto r1 = __builtin_amdgcn_permlane32_swap(a1, b1, false, false); \
    u32x4 w = {r0[0], r1[0], r0[1], r1[1]}; OUT = *reinterpret_cast<bf16x8*>(&w); } while (0)
  PK4(p0, 0, pa0); PK4(p0, 8, pa1); PK4(p1, 0, pa2); PK4(p1, 8, pa3);
#undef PK4
}
DI void qkt(f32x16& p0, f32x16& p1, const bf16_t* Ks, const bf16x8* qr, int r32, int hi) {
  p0 = f32x16{}; p1 = f32x16{};
#pragma unroll
  for (int d0 = 0; d0 < 8; ++d0) { int cb = (d0 * 16 + hi * 8) * 2;
    bf16x8 b0 = *reinterpret_cast<const bf16x8*>((const char*)Ks + KSWZ(r32, cb));
    bf16x8 b1 = *reinterpret_cast<const bf16x8*>((const char*)Ks + KSWZ(32 + r32, cb));
    p0 = __builtin_amdgcn_mfma_f32_32x32x16_bf16(b0, qr[d0], p0, 0, 0, 0);
    p1 = __builtin_amdgcn_mfma_f32_32x32x16_bf16(b1, qr[d0], p1, 0, 0, 0); }
}
DI int v_st(int k, int c) { const int kk = (k & ~0xC) | ((k & 4) << 1) | ((k & 8) >> 1); return ((kk >> 3) * 4 + (c >> 5)) * 512 + ((kk & 7) * 32 + (c & 31)) * 2; }
DI int v_rd_base(int lane) { return ((lane & 3) << 3) | (((lane >> 2) & 3) << 6) | (((lane >> 4) & 1) << 5) | (((lane >> 5) & 1) << 8); }
constexpr int v_rd_off(int d0, int ks, int half) { return d0 * 512 + ks * 4096 + half * 2048; }
template <int OFF> DI s16x4 tr_read(int vb) {
  s16x4 r; asm volatile("ds_read_b64_tr_b16 %0, %1 offset:%2" : "=&v"(r) : "v"(vb), "i"(OFF) : "memory"); return r;
}
template <int D0> DI void pv_one(f32x16& od, int vb, bf16x8 pa0, bf16x8 pa1, bf16x8 pa2, bf16x8 pa3) {
  const s16x4 l0 = tr_read<v_rd_off(D0, 0, 0)>(vb), h0 = tr_read<v_rd_off(D0, 0, 1)>(vb), l1 = tr_read<v_rd_off(D0, 1, 0)>(vb), h1 = tr_read<v_rd_off(D0, 1, 1)>(vb);
  const s16x4 l2 = tr_read<v_rd_off(D0, 2, 0)>(vb), h2 = tr_read<v_rd_off(D0, 2, 1)>(vb), l3 = tr_read<v_rd_off(D0, 3, 0)>(vb), h3 = tr_read<v_rd_off(D0, 3, 1)>(vb);
  asm volatile("s_waitcnt lgkmcnt(0)" ::: "memory"); SBAR();
#define PK(L, H) (bf16x8){L[0], L[1], L[2], L[3], H[0], H[1], H[2], H[3]}
  od = __builtin_amdgcn_mfma_f32_32x32x16_bf16(pa0, PK(l0, h0), od, 0, 0, 0);
  od = __builtin_amdgcn_mfma_f32_32x32x16_bf16(pa1, PK(l1, h1), od, 0, 0, 0);
  od = __builtin_amdgcn_mfma_f32_32x32x16_bf16(pa2, PK(l2, h2), od, 0, 0, 0);
  od = __builtin_amdgcn_mfma_f32_32x32x16_bf16(pa3, PK(l3, h3), od, 0, 0, 0);
#undef PK
}
DI void pv_d0(f32x16* o, int vb, bf16x8 pa0, bf16x8 pa1, bf16x8 pa2, bf16x8 pa3) {
  pv_one<0>(o[0], vb, pa0, pa1, pa2, pa3); pv_one<1>(o[1], vb, pa0, pa1, pa2, pa3); pv_one<2>(o[2], vb, pa0, pa1, pa2, pa3); pv_one<3>(o[3], vb, pa0, pa1, pa2, pa3);
}
DI void attn_dense_body(const bf16_t* __restrict__ Qb, const bf16_t* __restrict__ Kh, const bf16_t* __restrict__ Vh, const bf16_t* SZb, bf16_t* Ub, int seq, char* lds, int wv, const float* qn, int tpos) {
  const int tid = otid(wv), wid = tid >> 6, lane = tid & 63, r32 = lane & 31, hi = lane >> 5;
  bf16_t* V_lds = (bf16_t*)lds; bf16_t* K_lds = (bf16_t*)(lds + 2 * SHM_V);
  float* wsf = (float*)(lds + 2 * SHM_V + 2 * SHM_K) + wid * 64; float* li_l = wsf; float* al_l = wsf + 32;
  float m_reg = -1e30f, l_reg = 0; f32x16 o[4] = {}; bf16x8 qr[8];
  const bf16_t* Qw = Qb + (long)(wid * QBLK + r32) * LDQ + hi * 8;
  {
    u32x4 raw[8];
#pragma unroll
    for (int d0 = 0; d0 < 8; ++d0) raw[d0] = *reinterpret_cast<const u32x4*>(Qw + d0 * 16);
    float ss = 0.f;
#pragma unroll
    for (int d0 = 0; d0 < 8; ++d0) { const u32x4 w = raw[d0];
      ss += bf_lo(w.x) * bf_lo(w.x) + bf_hi(w.x) * bf_hi(w.x) + bf_lo(w.y) * bf_lo(w.y) + bf_hi(w.y) * bf_hi(w.y) + bf_lo(w.z) * bf_lo(w.z) + bf_hi(w.z) * bf_hi(w.z) + bf_lo(w.w) * bf_lo(w.w) + bf_hi(w.w) * bf_hi(w.w); }
    ss += __shfl_xor(ss, 32);
    const float rs = 1.0f / sqrtf(ss * (1.f / 128.f) + EPS);
    const int t = tpos + wid * QBLK + r32;
    const f32x2* rope = (const f32x2*)(lds + 81920);
#pragma unroll
    for (int d0 = 0; d0 < 8; ++d0) { const u32x4 w = raw[d0]; const float* wn = qn + d0 * 16 + hi * 8;
      const f32x4 g0 = *(const f32x4*)wn, g1 = *(const f32x4*)(wn + 4);
      float y[8] = {bf_lo(w.x) * rs * g0[0], bf_hi(w.x) * rs * g0[1], bf_lo(w.y) * rs * g0[2], bf_hi(w.y) * rs * g0[3], bf_lo(w.z) * rs * g1[0], bf_hi(w.z) * rs * g1[1], bf_lo(w.w) * rs * g1[2], bf_hi(w.w) * rs * g1[3]};
      if (tpos >= 0) {
        const int pos = (d0 < 4) ? (t >> 6) : (t & 63);
        const f32x4* rp = (const f32x4*)(rope + pos * 32 + (8 * (d0 & 3) + 4 * hi));
        const f32x4 c01 = rp[0], c23 = rp[1];
        const float cs[4] = {c01[0], c01[2], c23[0], c23[2]}, sn[4] = {c01[1], c01[3], c23[1], c23[3]};
#pragma unroll
        for (int pp = 0; pp < 4; ++pp) { const float x0 = y[2 * pp], x1 = y[2 * pp + 1]; y[2 * pp] = x0 * cs[pp] - x1 * sn[pp]; y[2 * pp + 1] = x0 * sn[pp] + x1 * cs[pp]; }
      }
      u32x4 o4 = {pk2(y[0], y[1]), pk2(y[2], y[3]), pk2(y[4], y[5]), pk2(y[6], y[7])};
      qr[d0] = __builtin_bit_cast(bf16x8, o4); }
  }
  const int sr = tid >> 4, sc = (tid & 15) * 8, vst0 = v_st(sr, sc), vst1 = v_st(32 + sr, sc);
  const int vb0 = (int)(uintptr_t)V_lds + v_rd_base(lane);
  struct { bf16x8 vs0, vs1, ks0, ks1; } sr_[2];
#define SLOAD(i, k0) do { sr_[i].vs0 = *reinterpret_cast<const bf16x8*>(&Vh[(long)((k0) + sr) * LDK + sc]); sr_[i].vs1 = *reinterpret_cast<const bf16x8*>(&Vh[(long)((k0) + 32 + sr) * LDK + sc]); \
    sr_[i].ks0 = *reinterpret_cast<const bf16x8*>(&Kh[(long)((k0) + sr) * LDK + sc]); sr_[i].ks1 = *reinterpret_cast<const bf16x8*>(&Kh[(long)((k0) + 32 + sr) * LDK + sc]); } while (0)
#define SWRITE(b, i) do { *(bf16x8*)((char*)V_lds + (b) * SHM_V + vst0) = sr_[i].vs0;          \
    *(bf16x8*)((char*)V_lds + (b) * SHM_V + vst1) = sr_[i].vs1; int kc = sc * 2;               \
    *(bf16x8*)((char*)K_lds + (b) * SHM_K + KSWZ(sr, kc)) = sr_[i].ks0;                       \
    *(bf16x8*)((char*)K_lds + (b) * SHM_K + KSWZ(32 + sr, kc)) = sr_[i].ks1; } while (0)
#define SWAIT() asm volatile("s_waitcnt vmcnt(4)" ::: "memory")
#define RESC(a) do { if (__any((a) < 1.f)) { if (hi == 0) al_l[r32] = (a); asm volatile("s_waitcnt lgkmcnt(0)" ::: "memory"); \
    _Pragma("unroll") for (int d = 0; d < 4; ++d) _Pragma("unroll") for (int r = 0; r < 16; ++r) o[d][r] *= al_l[crow(r, hi)]; } } while (0)
  f32x16 pA0, pA1, pB0, pB1; float mnA, mnB, alA, alB; bf16x8 pa0, pa1, pa2, pa3; const int NT = seq / KVBLK;
  constexpr int SE = 0, SO = 1;
  SLOAD(SE, 0); asm volatile("s_waitcnt vmcnt(0)" ::: "memory"); SWRITE(0, SE); __syncthreads();
  qkt(pA0, pA1, K_lds, qr, r32, hi); partialSM(pA0, pA1, m_reg, mnA, alA);
  SLOAD(SO, KVBLK); if (2 < NT) SLOAD(SE, 2 * KVBLK);
  SWAIT(); SWRITE(1, SO); __syncthreads();
  for (int j = 1; j + 1 < NT; j += 2) {
    SBAR(); qkt(pB0, pB1, (bf16_t*)((char*)K_lds + SHM_K), qr, r32, hi);
    finishSM(pA0, pA1, alA, l_reg, pa0, pa1, pa2, pa3); SBAR();
    SLOAD(SO, (j + 2) * KVBLK); SBAR();
    pv_d0(o, vb0, pa0, pa1, pa2, pa3); partialSM(pB0, pB1, m_reg, mnB, alB);
    __syncthreads(); SWAIT(); SWRITE(0, SE);
    RESC(alB); __syncthreads();
    SBAR(); qkt(pA0, pA1, K_lds, qr, r32, hi);
    finishSM(pB0, pB1, alB, l_reg, pa0, pa1, pa2, pa3); SBAR();
    if (j + 3 < NT) SLOAD(SE, (j + 3) * KVBLK); SBAR();
    pv_d0(o, vb0 + (int)SHM_V, pa0, pa1, pa2, pa3); partialSM(pA0, pA1, m_reg, mnA, alA);
    __syncthreads(); SWAIT(); SWRITE(1, SO);
    RESC(alA); __syncthreads();
  }
  SBAR(); qkt(pB0, pB1, (bf16_t*)((char*)K_lds + SHM_K), qr, r32, hi);
  finishSM(pA0, pA1, alA, l_reg, pa0, pa1, pa2, pa3); SBAR();
  pv_d0(o, vb0, pa0, pa1, pa2, pa3); partialSM(pB0, pB1, m_reg, mnB, alB);
  __syncthreads(); RESC(alB);
  finishSM(pB0, pB1, alB, l_reg, pa0, pa1, pa2, pa3); SBAR();
  pv_d0(o, vb0 + (int)SHM_V, pa0, pa1, pa2, pa3);
  u32x4 zq[8];
#pragma unroll
  for (int i = 0; i < 8; ++i) { const int id = tid + 512 * i; zq[i] = *(const u32x4*)(SZb + (long)(id >> 4) * LDQ + (id & 15) * 8); }
  if (hi == 0) li_l[r32] = l_reg; asm volatile("s_waitcnt lgkmcnt(0)" ::: "memory");
  __syncthreads();
  {
    float rli[16];
#pragma unroll
    for (int r = 0; r < 16; ++r) rli[r] = __builtin_amdgcn_rcpf(li_l[crow(r, hi)]);
    char* ost = lds;
#pragma unroll
    for (int r = 0; r < 16; ++r) { char* rowp = ost + (wid * QBLK + crow(r, hi)) * 256 + r32 * 2;
#pragma unroll
      for (int d0 = 0; d0 < 4; ++d0) *(unsigned short*)(rowp + d0 * 64) = (unsigned short)(pk2(o[d0][r] * rli[r], 0.f) & 0xffffu); }
  }
  __syncthreads();
#pragma unroll
  for (int i = 0; i < 8; ++i) { const int id = tid + 512 * i; const int row = id >> 4, ch = id & 15;
    const u32x4 ov = *(const u32x4*)(lds + row * 256 + ch * 16);
    f32x4 a0 = {bf_lo(ov.x), bf_hi(ov.x), bf_lo(ov.y), bf_hi(ov.y)}, a1 = {bf_lo(ov.z), bf_hi(ov.z), bf_lo(ov.w), bf_hi(ov.w)};
    const f32x4 z0 = {bf_lo(zq[i].x), bf_hi(zq[i].x), bf_lo(zq[i].y), bf_hi(zq[i].y)}, z1 = {bf_lo(zq[i].z), bf_hi(zq[i].z), bf_lo(zq[i].w), bf_hi(zq[i].w)};
    st_bf16x8(Ub + (long)row * LDQ + ch * 8, a0 * z0, a1 * z1); }
  __syncthreads();
#undef SLOAD
#undef SWRITE
#undef SWAIT
#undef RESC
}
#undef KSWZ
#undef SBAR
}

DI void qknorm_phase(const Args& A, LAS unsigned char* lds, int wv) {
    const int tid = otid(wv), lane = tid & 63, wave = tid >> 6, G = gridDim.x;
    bf16_t* Q = (bf16_t*)(A.ws + WS_SCR + A_Q); bf16_t* Kb = (bf16_t*)(A.ws + WS_SCR + A_K);
    const float* qn = A.in[14]; const float* kn = A.in[15];
    const int sub = lane >> 4, l16 = lane & 15, e0 = l16 * 8;
    LAS f32x2* rope = (LAS f32x2*)lds;
    for (int e = tid; e < 2048; e += NTHREADS) { const float ang = (float)(e >> 5) * exp2f(-(float)(e & 31) * 0.41524101186092029f); rope[e] = (f32x2){cosf(ang), sinf(ang)}; }
    __syncthreads();
    const long NIT = (long)NTOK * 4;
    for (long it0 = ((long)blockIdx.x * NWAVES + wave) * 16 + sub; it0 < NIT; it0 += (long)G * NWAVES * 16) {
        bf16_t* pq[4]; u32x4 raw[4];
#pragma unroll
        for (int k = 0; k < 4; ++k) { const long it = it0 + 4 * k; const int row = (int)(it >> 2), hj = 16 + (int)(it & 3);
            pq[k] = (hj < 16) ? Q + (size_t)row * 2048 + hj * 128 + e0 : Kb + (size_t)row * 512 + (hj - 16) * 128 + e0;
            raw[k] = *(const u32x4*)pq[k]; }
#pragma unroll
        for (int k = 0; k < 4; ++k) {
            const long it = it0 + 4 * k; const int row = (int)(it >> 2), hj = 16 + (int)(it & 3);
            const float* wn = (hj < 16 ? qn : kn) + e0;
            f32x4 a = {bf_lo(raw[k].x), bf_hi(raw[k].x), bf_lo(raw[k].y), bf_hi(raw[k].y)}, b = {bf_lo(raw[k].z), bf_hi(raw[k].z), bf_lo(raw[k].w), bf_hi(raw[k].w)};
            float ss = 0.f;
#pragma unroll
            for (int q = 0; q < 4; ++q) ss += a[q] * a[q] + b[q] * b[q];
            ss += __shfl_xor(ss, 1); ss += __shfl_xor(ss, 2); ss += __shfl_xor(ss, 4); ss += __shfl_xor(ss, 8);
            const float rs = 1.0f / sqrtf(ss * (1.f / 128.f) + EPS);
            const f32x4 w0 = *(const f32x4*)wn, w1 = *(const f32x4*)(wn + 4);
            a = a * rs * w0; b = b * rs * w1;
            const int t = row % TB;
            if (t < TL) {
                const int pos = (l16 < 8) ? (t >> 6) : (t & 63);
                float y[8] = {a[0], a[1], a[2], a[3], b[0], b[1], b[2], b[3]};
                const LAS f32x4* rp = (const LAS f32x4*)(rope + pos * 32 + ((4 * l16) & 31));
                const f32x4 c01 = rp[0], c23 = rp[1];
                const float cs[4] = {c01[0], c01[2], c23[0], c23[2]}, sn[4] = {c01[1], c01[3], c23[1], c23[3]};
#pragma unroll
                for (int pp = 0; pp < 4; ++pp) {
                    const float x0 = y[2 * pp], x1 = y[2 * pp + 1];
                    y[2 * pp] = x0 * cs[pp] - x1 * sn[pp]; y[2 * pp + 1] = x0 * sn[pp] + x1 * cs[pp];
                }
                a = (f32x4){y[0], y[1], y[2], y[3]}; b = (f32x4){y[4], y[5], y[6], y[7]};
            }
            st_bf16x8(pq[k], a, b);
        }
    }
}

DI void attn_layer(const Args& A, LAS unsigned char* lds, char* lds_gen, const XcdBarrier& gbar, int layer, int wv) {
    unsigned char* ws = A.ws;
    const bf16_t* H = (const bf16_t*)(ws + WS_H); bf16_t* U = (bf16_t*)(ws + WS_H);
    bf16_t* Q = (bf16_t*)(ws + WS_SCR + A_Q); bf16_t* Kb = (bf16_t*)(ws + WS_SCR + A_K); bf16_t* Vb = (bf16_t*)(ws + WS_SCR + A_V); bf16_t* SZ = (bf16_t*)(ws + WS_SCR + A_SZ);
    norm_phase(A, layer, false, wv);
    xcd_barrier(gbar, wv);
    {
        DescPlain D; D.init(H, (const bf16_t*)(ws + WS_WAI), 20, false);
        auto E = [=](const pg8::Unit& u, int row_l, int col_l, f32x4 v0, f32x4 v1) {
            const size_t row = (size_t)u.i0 * 256 + row_l; const int pn = u.i1;
            if (pn < 8) st_bf16x8(Q + row * 2048 + pn * 256 + col_l, v0, v1);
            else if (pn < 10) st_bf16x8(Kb + row * 512 + (pn - 8) * 256 + col_l, v0, v1);
            else if (pn < 12) st_bf16x8(Vb + row * 512 + (pn - 10) * 256 + col_l, v0, v1);
            else { f32x4 a, b;
#pragma unroll
                for (int q = 0; q < 4; ++q) { a[q] = siluf(v0[q]); b[q] = siluf(v1[q]); }
                st_bf16x8(SZ + row * 2048 + (pn - 12) * 256 + col_l, a, b); }
        };
        pg8::gemm_phase(lds, D, E, wv);
    }
    xcd_barrier(gbar, wv);
    qknorm_phase(A, lds, wv);
    xcd_barrier(gbar, wv);
    {
        const int G = gridDim.x, c = blockIdx.x;
        { f32x2* rope = (f32x2*)(lds_gen + 81920); const int tid = otid(wv);
          for (int e = tid; e < 2048; e += NTHREADS) { const float ang = (float)(e >> 5) * exp2f(-(float)(e & 31) * 0.41524101186092029f); rope[e] = (f32x2){cosf(ang), sinf(ang)}; }
          __syncthreads(); }
        const float* qn = A.in[14];
        for (long L = c; L < 2048; L += G) {
            const int u = pg8::xcd_remap((int)L, 2048);
            const int b = u / 128, rem = u % 128, kvh = rem / 32, g = (rem / 8) % 4, qb = rem % 8, h = kvh * 4 + g;
            const size_t qoff = ((size_t)b * TB + qb * 256) * 2048 + h * 128, koff = ((size_t)b * TB) * 512 + kvh * 128;
            att::attn_dense_body(Q + qoff, Kb + koff, Vb + koff, SZ + qoff, U + qoff, TB, lds_gen, wv, qn, qb * 256);
        }
        for (int u = c; u < 256; u += G) {
            const int b = u / 16, h = u % 16, kvh = h / 4;
            const size_t qoff = ((size_t)b * TB + TL) * 2048 + h * 128, koff = ((size_t)b * TB + TL) * 512 + kvh * 128;
            att::attn_dense_body(Q + qoff, Kb + koff, Vb + koff, SZ + qoff, U + qoff, TC, lds_gen, wv, qn, -1);
        }
    }
    xcd_barrier(gbar, wv);
    {
        DescPlain D; D.init(U, (const bf16_t*)(ws + WS_WAO), 8, false);
        EpiResid E; E.init(A, layer);
        pg8::gemm_phase(lds, D, E, wv);
    }
    xcd_barrier(gbar, wv);
}


struct DescM1 {
    static constexpr bool RAW = false;
    const bf16_t* H; const bf16_t* WA; const bf16_t* WB; int lda, ldb, K, total;
    DI void init(const bf16_t* H_, const bf16_t* WA_, const bf16_t* WB_) { H = H_; WA = WA_; WB = WB_; lda = DM; ldb = DM; K = DM; total = 144 * 9 + 8 * 144; }
    DI pg8::Unit unit(int idx) const {
        pg8::Unit u;
        if (idx < 1296) { const int nig = 72, gid = idx / nig, pm = gid * 8 + (idx % nig) % 8, pn = (idx % nig) / 8;
            u.a = (const char*)(H + (size_t)pm * 256 * DM); u.b = (const char*)(WA + (size_t)pn * 256 * DM); u.i0 = pm; u.i1 = pn; u.i2 = 0; }
        else { const int j = idx - 1296, mt = j % 8, nt = j / 8;
            u.a = (const char*)(WB + (size_t)mt * 256 * DM); u.b = (const char*)(H + (size_t)nt * 256 * DM); u.i0 = mt; u.i1 = nt; u.i2 = 1; }
        return u;
    }
};
namespace ml {
#define MFMA32(a, b, c) __builtin_amdgcn_mfma_f32_32x32x16_bf16((a), (b), (c), 0, 0, 0)
#define LFENCE() asm volatile("s_waitcnt lgkmcnt(0)" ::: "memory")
DI float dot2_bf16(unsigned a, unsigned b, float c) { asm("v_dot2c_f32_bf16 %0, %1, %2" : "+v"(c) : "v"(a), "v"(b)); return c; }
#define DOT2(a, b, c) dot2_bf16((a), (b), (c))
DI int crow(int reg, int h) { return (reg & 3) + 8 * (reg >> 2) + 4 * h; }
DI bf16x8 ldperm(const bf16_t* p) { const s16x4 lo = *(const s16x4*)p, hi = *(const s16x4*)(p + 8); return __builtin_shufflevector(lo, hi, 0, 1, 2, 3, 4, 5, 6, 7); }
DI bf16x8 pack_step(const f32x16& x, int s) { u32x4 p = {pk2(x[8 * s], x[8 * s + 1]), pk2(x[8 * s + 2], x[8 * s + 3]), pk2(x[8 * s + 4], x[8 * s + 5]), pk2(x[8 * s + 6], x[8 * s + 7])}; return __builtin_bit_cast(bf16x8, p); }
DI float bfs(short h) { return __uint_as_float(((unsigned)(unsigned short)h) << 16); }

constexpr int SC_Q = 0, SC_K = 16384, SC_KT = 32768, SC_BUF = 49152, SC_WAVE = 2 * SC_BUF, SC_WAVE_BYTES = 6656;
DI bf16x8 ldsfrag(const LAS unsigned char* buf, unsigned o) { const s16x4 lo = *(const LAS s16x4*)(buf + o), hi = *(const LAS s16x4*)(buf + (o ^ 16u)); return __builtin_shufflevector(lo, hi, 0, 1, 2, 3, 4, 5, 6, 7); }
DI void scan_phase(const Args& A, LAS unsigned char* lds, int wv) {
    const int wave = wv;
    LAS float* wl = (LAS float*)(lds + SC_WAVE + wave * SC_WAVE_BYTES);
    LAS unsigned* nbp = (LAS unsigned*)(lds + SC_WAVE + wave * SC_WAVE_BYTES + 2048);
    LAS unsigned* wbp = nbp + 64;
    LAS unsigned char* hst = lds + SC_WAVE + wave * SC_WAVE_BYTES + 2560;
    unsigned char* ws = A.ws;
    const bf16_t* Qg = (const bf16_t*)(ws + WS_SCR + M_Q); const bf16_t* Kg = (const bf16_t*)(ws + WS_SCR + M_K); const bf16_t* KVT = (const bf16_t*)(ws + WS_SCR + M_KVT);
    const float* G32 = (const float*)(ws + WS_SCR + M_G32); const float* bg = A.in[10];
#define SC_POS0(j) (dir == 0 ? ((j) < 4 ? TL + 64 * (j) : 64 * ((j) - 4)) : ((j) < 4 ? TL + 64 * (3 - (j)) : 64 * (35 - (j))))
#define SC_DMA(bufi, p0) do { const int tj_ = otid(wv); _Pragma("unroll") for (int i_ = 0; i_ < 2; ++i_) { const int sl_ = i_ * 512 + tj_; \
        { const int row_ = sl_ >> 4, c_ = (sl_ & 15) ^ (row_ & 15); const size_t go_ = (size_t)((p0) + row_) * 1024 + c_ * 8; \
          __builtin_amdgcn_global_load_lds((const unsigned*)(Qu + go_), (LAS unsigned*)(lds + (bufi) * SC_BUF + SC_Q + i_ * 8192 + wave * 1024), 16, 0, 0); \
          __builtin_amdgcn_global_load_lds((const unsigned*)(Ku + go_), (LAS unsigned*)(lds + (bufi) * SC_BUF + SC_K + i_ * 8192 + wave * 1024), 16, 0, 0); } \
        { const int d_ = sl_ >> 3, c_ = (sl_ & 7) ^ ((d_ >> 1) & 7); \
          __builtin_amdgcn_global_load_lds((const unsigned*)(KTu + (size_t)d_ * TB + (p0) + c_ * 8), (LAS unsigned*)(lds + (bufi) * SC_BUF + SC_KT + i_ * 8192 + wave * 1024), 16, 0, 0); } } } while (0)
    for (int item = blockIdx.x; item < 256; item += gridDim.x) {
        const int dir = item & 1, h = (item >> 1) & 7, b = item >> 4, e0 = wave * 32;
        const bf16_t* Qu = Qg + (size_t)b * TB * 1024 + h * 128;
        const bf16_t* Ku = Kg + (size_t)b * TB * 1024 + h * 128;
        const bf16_t* KTu = KVT + ((size_t)b * 3072 + h * 128) * TB;
        const bf16_t* VTu = KVT + ((size_t)b * 3072 + 1024 + h * 256 + e0) * TB;
        bf16_t* Hout = (bf16_t*)(ws + WS_SCR + (dir ? M_HB : M_HF)) + (size_t)b * TB * DM + h * 256 + e0;
        const float big = bg[(dir * 2) * 8 + h], bfg = bg[(dir * 2 + 1) * 8 + h];
        f32x16 cacc[4];
#pragma unroll
        for (int d = 0; d < 4; ++d)
#pragma unroll
            for (int i = 0; i < 16; ++i) cacc[d][i] = 0.f;
        float m = 0.f;
        { const int l0 = otid(wv) & 63; wl[384 + l0] = 0.f; wl[448 + l0] = 0.f; nbp[l0] = 0u; }
        LFENCE();
        SC_DMA(0, SC_POS0(0));
        float ig_n, fg_n;
        { const int l0 = otid(wv) & 63; const float* gp = G32 + (size_t)(b * TB + SC_POS0(0) + (dir ? 63 - l0 : l0)) * 32 + (dir * 2) * 8 + h; ig_n = gp[0]; fg_n = gp[8]; }
        for (int j = 0; j < 36; ++j) {
            const int pos0 = SC_POS0(j);
            const LAS unsigned char* Qb = lds + (j & 1) * SC_BUF + SC_Q; const LAS unsigned char* Kb = lds + (j & 1) * SC_BUF + SC_K; const LAS unsigned char* KTb = lds + (j & 1) * SC_BUF + SC_KT;
            asm volatile("s_waitcnt vmcnt(0)" ::: "memory"); __builtin_amdgcn_s_barrier(); asm volatile("" ::: "memory");
            if (j + 1 < 36) SC_DMA((j + 1) & 1, SC_POS0(j + 1));
            const int lj = otid(wv) & 63, rj = lj & 31, h4 = (lj >> 5) * 4;
            LAS float* wh = wl + h4; LAS float* wr = wl + rj; LAS unsigned char* hb = hst + h4 * 64 + rj * 2;
            const LAS unsigned* nbh = nbp + (h4 >> 1); const LAS unsigned* wbh = wbp + (h4 >> 1);
            const unsigned xr = rj & 15, xd = (rj >> 1) & 7;
            const unsigned qro = (unsigned)rj * 256u + 2u * h4;
            const unsigned kro = (unsigned)rj * 128u + 2u * h4;
            const bf16_t* VTp = VTu + (size_t)rj * TB + pos0 + h4;
            bf16x8 vf[4];
#pragma unroll
            for (int kk = 0; kk < 4; ++kk) vf[kk] = ldperm(VTp + 16 * kk);
            float decay, m_new;
            {
                const int s = dir ? 63 - lj : lj;
                const float ig = ig_n + big, fg = fg_n + bfg;
                if (j + 1 < 36) { const float* gp = G32 + (size_t)(b * TB + SC_POS0(j + 1) + s) * 32 + (dir * 2) * 8 + h; ig_n = gp[0]; fg_n = gp[8]; }
                const float lf = fminf(fg, 0.f) - log1pf(__expf(-fabsf(fg)));
                float bs = lf;
#pragma unroll
                for (int o = 1; o < 64; o <<= 1) { const float t = __shfl_up(bs, o); if (lj >= o) bs += t; }
                const float uu = ig - bs;
                float pmx = uu;
#pragma unroll
                for (int o = 1; o < 64; o <<= 1) { const float t = __shfl_up(pmx, o); if (lj >= o) pmx = fmaxf(pmx, t); }
                pmx = fmaxf(pmx, m);
                const float b_end = __shfl(bs, 63), pm_last = __shfl(pmx, 63);
                LAS float* ws_ = wl + s;
                ws_[0] = uu * 1.4426950408889634f; ws_[64] = pmx * 1.4426950408889634f; ws_[128] = __expf(m - pmx); ws_[192] = __expf(-(bs + pmx)); ws_[256] = __expf(uu - pm_last);
                { const float wv_ = __expf(uu - pm_last), wp_ = __shfl_xor(wv_, 1); if ((s & 1) == 0) wbp[s >> 1] = pk2(wv_, wp_); }
                decay = __expf(m - pm_last); m_new = b_end + pm_last;
            }
            LFENCE();
            const int sbase = dir ? 63 - h4 : h4, sgn = dir ? -1 : 1;
#pragma unroll
            for (int tb = 0; tb < 2; ++tb) {
                __builtin_amdgcn_sched_barrier(0);
                const unsigned qo = qro + tb * 8192u;
                f32x16 ha;
#pragma unroll
                for (int i = 0; i < 16; ++i) ha[i] = 0.f;
                float qnv = 0.f;
#pragma unroll
                for (int kk = 0; kk < 8; ++kk) {
                    const bf16x8 qa = ldsfrag(Qb, qo + (((2u * kk) ^ xr) << 4));
                    ha = MFMA32(qa, pack_step(cacc[kk >> 1], kk & 1), ha);
                    { const u32x2 nb0 = *(const LAS u32x2*)(nbh + 8 * kk), nb1 = *(const LAS u32x2*)(nbh + 8 * kk + 4); const u32x4 qw = __builtin_bit_cast(u32x4, qa);
                      qnv = DOT2(qw.x, nb0.x, qnv); qnv = DOT2(qw.y, nb0.y, qnv); qnv = DOT2(qw.z, nb1.x, qnv); qnv = DOT2(qw.w, nb1.y, qnv); }
                }
                qnv += __shfl_xor(qnv, 32);
#pragma unroll
                for (int g = 0; g < 4; ++g) { const f32x4 av = *(const LAS f32x4*)(wh + 128 + 32 * tb + 8 * g);
#pragma unroll
                    for (int q = 0; q < 4; ++q) ha[4 * g + q] *= av[q]; }
                const float pmt = wr[64 + 32 * tb];
                const int tp = dir ? (63 - 32 * tb) - rj : 32 * tb + rj;
                float ds = 0.f;
#pragma unroll
                for (int sb = 0; sb < 2; ++sb) {
                    __builtin_amdgcn_sched_barrier(0);
                    if (sb != tb && (dir ? sb < tb : sb > tb)) continue;
                    const unsigned ko = qro + sb * 8192u;
                    f32x16 st;
#pragma unroll
                    for (int i = 0; i < 16; ++i) st[i] = 0.f;
#pragma unroll
                    for (int kk = 0; kk < 8; ++kk) { const unsigned c = ((2u * kk) ^ xr) << 4; st = MFMA32(ldsfrag(Kb, ko + c), ldsfrag(Qb, qo + c), st); }
#pragma unroll
                    for (int g = 0; g < 4; ++g) { const f32x4 uv = *(const LAS f32x4*)(wh + 32 * sb + 8 * g);
#pragma unroll
                        for (int q = 0; q < 4; ++q) {
                            const int sc = 32 * sb + q + 8 * g;
                            const int sp = sbase + sgn * sc;
                            st[4 * g + q] *= __builtin_amdgcn_exp2f((sp <= tp) ? uv[q] - pmt : -1e30f);
                            ds += st[4 * g + q];
                        } }
                    ha = MFMA32(pack_step(st, 0), vf[2 * sb], ha);
                    ha = MFMA32(pack_step(st, 1), vf[2 * sb + 1], ha);
                }
                ds += __shfl_xor(ds, 32);
                {
                    const float den = wr[128 + 32 * tb] * qnv + ds;
                    const float rd = 1.0f / fmaxf(fabsf(den), wr[192 + 32 * tb]);
                    if (h4 == 0) wr[320 + 32 * tb] = rd;
                }
                LFENCE();
#pragma unroll
                for (int g = 0; g < 4; ++g) { const f32x4 rv = *(const LAS f32x4*)(wh + 320 + 32 * tb + 8 * g);
#pragma unroll
                    for (int q = 0; q < 4; ++q) { const int tc = 32 * tb + q + 8 * g;
                        *(LAS unsigned short*)(hb + tc * 64) = (unsigned short)(pk2(ha[4 * g + q] * rv[q], 0.f) & 0xffffu); } }
            }
            LFENCE();
            {
                bf16_t* hp = Hout + (size_t)(pos0 + lj) * DM;
                const LAS unsigned char* hrow = hst + lj * 64;
#pragma unroll
                for (int q = 0; q < 4; ++q) *(u32x4*)(hp + 8 * q) = *(const LAS u32x4*)(hrow + 16 * q);
            }
            __builtin_amdgcn_sched_barrier(0);
            bf16x8 vfw[4];
#pragma unroll
            for (int kk = 0; kk < 4; ++kk) {
                const f32x4 w0 = *(const LAS f32x4*)(wh + 256 + 16 * kk), w1 = *(const LAS f32x4*)(wh + 256 + 16 * kk + 8);
                u32x4 p = {pk2(bfs(vf[kk][0]) * w0[0], bfs(vf[kk][1]) * w0[1]), pk2(bfs(vf[kk][2]) * w0[2], bfs(vf[kk][3]) * w0[3]),
                           pk2(bfs(vf[kk][4]) * w1[0], bfs(vf[kk][5]) * w1[1]), pk2(bfs(vf[kk][6]) * w1[2], bfs(vf[kk][7]) * w1[3])};
                vfw[kk] = __builtin_bit_cast(bf16x8, p);
            }
#pragma unroll
            for (int db = 0; db < 4; ++db) {
#pragma unroll
                for (int i = 0; i < 16; ++i) cacc[db][i] *= decay;
                const unsigned to = kro + db * 4096u;
                float nadd = 0.f;
#pragma unroll
                for (int kk = 0; kk < 4; ++kk) {
                    const bf16x8 kv = ldsfrag(KTb, to + (((2u * kk) ^ xd) << 4));
                    const u32x2 wq0 = *(const LAS u32x2*)(wbh + 8 * kk), wq1 = *(const LAS u32x2*)(wbh + 8 * kk + 4); const u32x4 kw = __builtin_bit_cast(u32x4, kv);
                    nadd = DOT2(kw.x, wq0.x, nadd); nadd = DOT2(kw.y, wq0.y, nadd); nadd = DOT2(kw.z, wq1.x, nadd); nadd = DOT2(kw.w, wq1.y, nadd);
                    cacc[db] = MFMA32(kv, vfw[kk], cacc[db]);
                }
                nadd += __shfl_xor(nadd, 32);
                const float nnew = decay * wr[384 + 32 * db] + nadd, npart = __shfl_xor(nnew, 1);
                if (h4 == 0) { wr[384 + 32 * db] = nnew; if ((rj & 1) == 0) nbp[(32 * db + rj) >> 1] = pk2(nnew, npart); }
            }
            LFENCE();
            m = m_new;
        }
        asm volatile("s_waitcnt vmcnt(0)" ::: "memory"); __builtin_amdgcn_s_barrier();
    }
#undef SC_DMA
#undef SC_POS0
}
#undef MFMA32
#undef LFENCE
#undef DOT2
}

DI void mlstm_finish_phase(const Args& A, int wv) {
    const int tid = otid(wv), lane = tid & 63, wave = tid >> 6, G = gridDim.x;
    unsigned char* ws = A.ws;
    const bf16_t* HF = (const bf16_t*)(ws + WS_SCR + M_HF); const bf16_t* HB = (const bf16_t*)(ws + WS_SCR + M_HB);
    const bf16_t* SO = (const bf16_t*)(ws + WS_SCR + M_SO); const bf16_t* SZ = (const bf16_t*)(ws + WS_SCR + M_SZ);
    bf16_t* U = (bf16_t*)(ws + WS_H); const float* hn = A.in[11];
    const int sub = lane >> 5, e0 = (lane & 31) * 8;
    const long NIT = (long)NTOK * 8;
    for (long it0 = ((long)blockIdx.x * NWAVES + wave) * 4 + sub; it0 < NIT; it0 += (long)G * NWAVES * 4) {
        f32x4 f0[2], f1[2], b0[2], b1[2], o0[2], o1[2], z0[2], z1[2];
#pragma unroll
        for (int k = 0; k < 2; ++k) { const long it = it0 + 2 * k; const size_t off = (size_t)(it >> 3) * DM + (int)(it & 7) * 256 + e0;
            ld_bf16x8(HF + off, f0[k], f1[k]); ld_bf16x8(HB + off, b0[k], b1[k]); ld_bf16x8(SO + off, o0[k], o1[k]); ld_bf16x8(SZ + off, z0[k], z1[k]); }
#pragma unroll
        for (int k = 0; k < 2; ++k) { const long it = it0 + 2 * k; const size_t off = (size_t)(it >> 3) * DM + (int)(it & 7) * 256 + e0;
            f32x4 y0 = o0[k] * (f0[k] + b0[k]), y1 = o1[k] * (f1[k] + b1[k]);
            float ss = 0.f;
#pragma unroll
            for (int q = 0; q < 4; ++q) ss += y0[q] * y0[q] + y1[q] * y1[q];
            ss += __shfl_xor(ss, 1); ss += __shfl_xor(ss, 2); ss += __shfl_xor(ss, 4); ss += __shfl_xor(ss, 8); ss += __shfl_xor(ss, 16);
            const float rs = 1.0f / sqrtf(ss * (1.f / 256.f) + EPS);
            const float* hp = hn + (int)(it & 7) * 256 + e0;
            const f32x4 h0 = *(const f32x4*)hp, h1 = *(const f32x4*)(hp + 4);
            st_bf16x8(U + off, y0 * rs * h0 * z0[k], y1 * rs * h1 * z1[k]); }
    }
}

DI void mlstm_layer(const Args& A, LAS unsigned char* lds, const XcdBarrier& gbar, int layer, int wv) {
    unsigned char* ws = A.ws;
    const bf16_t* H = (const bf16_t*)(ws + WS_H); bf16_t* U = (bf16_t*)(ws + WS_H);
    bf16_t* Q = (bf16_t*)(ws + WS_SCR + M_Q); bf16_t* Kb = (bf16_t*)(ws + WS_SCR + M_K); bf16_t* KVT = (bf16_t*)(ws + WS_SCR + M_KVT);
    float* G32 = (float*)(ws + WS_SCR + M_G32); bf16_t* SO = (bf16_t*)(ws + WS_SCR + M_SO); bf16_t* SZ = (bf16_t*)(ws + WS_SCR + M_SZ);
    norm_phase(A, layer, false, wv);
    xcd_barrier(gbar, wv);
    {
        DescM1 D; D.init(H, (const bf16_t*)(ws + WS_WMA), (const bf16_t*)(ws + WS_WMB));
        auto E = [=](const pg8::Unit& u, int row_l, int col_l, f32x4 v0, f32x4 v1) {
            if (u.i2 == 0) {
                const size_t row = (size_t)u.i0 * 256 + row_l; const int pn = u.i1;
                if (pn < 4) st_bf16x8(Q + row * 1024 + pn * 256 + col_l, v0 * 0.088388347648318440f, v1 * 0.088388347648318440f);
                else if (pn < 8) { st_bf16x8(Kb + row * 1024 + (pn - 4) * 256 + col_l, v0, v1);
                    const int bb = u.i0 / 9, sp = (u.i0 % 9) * 256 + row_l;
                    bf16_t* kt = KVT + ((size_t)bb * 3072 + (pn - 4) * 256 + col_l) * TB + sp;
                    const unsigned w0 = pk2(v0[0], v0[1]), w1 = pk2(v0[2], v0[3]), w2 = pk2(v1[0], v1[1]), w3 = pk2(v1[2], v1[3]);
                    kt[0] = (bf16_t)(w0 & 0xffffu); kt[TB] = (bf16_t)(w0 >> 16); kt[2 * TB] = (bf16_t)(w1 & 0xffffu); kt[3 * TB] = (bf16_t)(w1 >> 16);
                    kt[4 * TB] = (bf16_t)(w2 & 0xffffu); kt[5 * TB] = (bf16_t)(w2 >> 16); kt[6 * TB] = (bf16_t)(w3 & 0xffffu); kt[7 * TB] = (bf16_t)(w3 >> 16); }
                else if (col_l < 32) { *(f32x4*)(G32 + row * 32 + col_l) = v0; *(f32x4*)(G32 + row * 32 + col_l + 4) = v1; }
            } else {
                const int bb = u.i1 / 9, s0 = (u.i1 % 9) * 256;
                st_bf16x8(KVT + ((size_t)bb * 3072 + 1024 + u.i0 * 256 + row_l) * TB + s0 + col_l, v0, v1);
            }
        };
        pg8::gemm_phase(lds, D, E, wv);
    }
    xcd_barrier(gbar, wv);
    ml::scan_phase(A, lds, wv);
    xcd_barrier(gbar, wv);
    {
        DescPlain D; D.init(H, (const bf16_t*)(ws + WS_WMA) + (size_t)2304 * DM, 16, false);
        auto E = [=](const pg8::Unit& u, int row_l, int col_l, f32x4 v0, f32x4 v1) {
            const size_t row = (size_t)u.i0 * 256 + row_l; const int pn = u.i1; f32x4 a, b;
            if (pn < 8) {
#pragma unroll
                for (int q = 0; q < 4; ++q) { a[q] = sigmf(v0[q]); b[q] = sigmf(v1[q]); }
                st_bf16x8(SO + row * DM + pn * 256 + col_l, a, b);
            } else {
#pragma unroll
                for (int q = 0; q < 4; ++q) { a[q] = siluf(v0[q]); b[q] = siluf(v1[q]); }
                st_bf16x8(SZ + row * DM + (pn - 8) * 256 + col_l, a, b);
            }
        };
        pg8::gemm_phase(lds, D, E, wv);
    }
    xcd_barrier(gbar, wv);
    mlstm_finish_phase(A, wv);
    xcd_barrier(gbar, wv);
    {
        DescPlain D; D.init(U, (const bf16_t*)(ws + WS_WMO), 8, false);
        EpiResid E; E.init(A, layer);
        pg8::gemm_phase(lds, D, E, wv);
    }
    xcd_barrier(gbar, wv);
}

__global__ void __launch_bounds__(NTHREADS, 2) fwd_megakernel(Args A) {
    extern __shared__ __attribute__((aligned(16))) unsigned char lds_raw[];
    LAS unsigned char* lds = (LAS unsigned char*)lds_raw;
    cg::grid_group grid = cg::this_grid();
    const int wv = __builtin_amdgcn_readfirstlane(threadIdx.x >> 6);
    volatile LAS unsigned* bst = (volatile LAS unsigned*)(lds + 152576);
    if (otid(wv) < 2) bst[otid(wv)] = 0u;
    __syncthreads();
    const XcdBarrier gbar = xcd_barrier_post((unsigned*)(A.ws + WS_BAR), bst, wv);
    prep_phase(A, lds, wv);
    grid.sync();
    {
        const long long* mi = (const long long*)(A.ws + WS_MODI); float* mf = (float*)(A.ws + WS_MOD);
        for (int i = blockIdx.x * NTHREADS + otid(wv); i < 4 * 17 * MOD_LD; i += gridDim.x * NTHREADS) mf[i] = (float)mi[i] * MODI_INV;
    }
    xcd_barrier(gbar, wv);
    fnet_layer(A, lds, gbar, 0, 0, false, wv);
    mlstm_layer(A, lds, gbar, 1, wv);
    attn_layer(A, lds, (char*)lds_raw, gbar, 2, wv);
    fnet_layer(A, lds, gbar, 3, 1, true, wv);
    final_norm_phase(A, (const bf16_t*)(A.ws + WS_SCR + F_PQX), wv);
}

extern "C" void kernel_launch(void* const* d_in, const int* in_sizes, int n_in, void* d_out, int out_size, void* d_ws, size_t ws_size, hipStream_t stream) {
    static int grid = 0;
    if (grid == 0) {
        if (n_in != 18 || ws_size < WS_END) { fprintf(stderr, "kernel_launch: unexpected n_in %d / ws_size %zu (need %zu)\n", n_in, ws_size, (size_t)WS_END); grid = -1; return; }
        int dev = 0, cus = 0, per_cu = 0;
        hipGetDevice(&dev);
        hipDeviceGetAttribute(&cus, hipDeviceAttributeMultiprocessorCount, dev);
        if (hipFuncSetAttribute((const void*)fwd_megakernel, hipFuncAttributeMaxDynamicSharedMemorySize, LDS_BYTES) != hipSuccess) { fprintf(stderr, "kernel_launch: hipFuncSetAttribute failed\n"); grid = -1; return; }
        if (hipOccupancyMaxActiveBlocksPerMultiprocessor(&per_cu, (const void*)fwd_megakernel, NTHREADS, LDS_BYTES) != hipSuccess || per_cu < 1) { fprintf(stderr, "kernel_launch: occupancy query failed (%d)\n", per_cu); per_cu = 1; }
        (void)hipGetLastError();
        grid = cus * per_cu;
        fprintf(stderr, "kernel_launch: grid %d (cus %d x %d)\n", grid, cus, per_cu);
    }
    if (grid < 0) return;
    (void)hipMemsetAsync((char*)d_ws + WS_MOD, 0, ZERO_BYTES, stream);
    (void)hipMemsetAsync((char*)d_ws + WS_MODI, 0, MODI_BYTES, stream);
    Args a{};
    for (int i = 0; i < 18; ++i) a.in[i] = (const float*)d_in[i];
    a.out = (float*)d_out; a.ws = (unsigned char*)d_ws; a.ph_lo = 0; a.ph_hi = 100;
    void* args[] = {&a};
    hipError_t e = hipLaunchCooperativeKernel((const void*)fwd_megakernel, dim3(grid), dim3(NTHREADS), args, LDS_BYTES, stream);
    if (e != hipSuccess) fprintf(stderr, "kernel_launch: cooperative launch failed: %s (grid %d)\n", hipGetErrorString(e), grid);
}
```

```cpp
#include <hip/hip_runtime.h>
#include <hip/hip_cooperative_groups.h>
#include <cstdio>
#include <cstdint>
#include <type_traits>
namespace cg = cooperative_groups;

#define LAS __attribute__((address_space(3)))
#define DI __device__ __forceinline__
typedef unsigned short bf16_t;
typedef short bf16x8 __attribute__((ext_vector_type(8)));
typedef short s16x4 __attribute__((ext_vector_type(4)));
typedef float f32x2 __attribute__((ext_vector_type(2)));
typedef float f32x4 __attribute__((ext_vector_type(4)));
typedef float f32x16 __attribute__((ext_vector_type(16)));
typedef unsigned u32x2 __attribute__((ext_vector_type(2)));
typedef unsigned u32x4 __attribute__((ext_vector_type(4)));
typedef __bf16 bf16v2 __attribute__((ext_vector_type(2)));

constexpr int DM = 2048, NB = 16, TL = 2048, TC = 256, TB = TL + TC, NTOK = NB * TB;
constexpr int NWAVES = 8, NTHREADS = 512;
constexpr float EPS = 1e-6f;
constexpr int MOD_LD = 3 * DM;
constexpr int M_WA_ROWS = 6400, M_WB_ROWS = 3072;
constexpr size_t MiB = 1u << 20;
constexpr size_t WS_SCR_ = 301 * MiB;
constexpr size_t WS_MOD = 0;
constexpr size_t MOD_BYTES = (size_t)4 * 17 * MOD_LD * 4;
constexpr size_t WS_BAR = 1792 * 1024, ZERO_BYTES = 2 * MiB;
constexpr size_t WS_MODI = WS_SCR_ + 700 * MiB, MODI_BYTES = (size_t)4 * 17 * MOD_LD * 8;
constexpr float MODI_SCALE = 1073741824.f, MODI_INV = 9.313225746154785e-10f;
constexpr size_t WS_WFG = 2 * MiB, WS_WFO = 18 * MiB, WS_WMA = 34 * MiB, WS_WMB = 59 * MiB, WS_WMO = 71 * MiB, WS_WAI = 79 * MiB, WS_WAO = 99 * MiB;
constexpr size_t WS_DC = 107 * MiB, WS_DT = 108 * MiB, WS_DT2 = 124 * MiB, WS_CTXS = 125 * MiB, WS_H = 157 * MiB, WS_SCR = 301 * MiB;
constexpr size_t WS_END = 1024 * MiB;
constexpr size_t F_G = 0, F_PQX = 144 * MiB, F_PQC = 400 * MiB, F_A1 = 432 * MiB;
constexpr size_t M_Q = 0, M_K = 72 * MiB, M_KVT = 144 * MiB, M_G32 = 360 * MiB, M_HF = 365 * MiB, M_HB = 509 * MiB, M_SO = 0, M_SZ = 144 * MiB;
constexpr size_t A_Q = 0, A_K = 144 * MiB, A_V = 180 * MiB, A_SZ = 216 * MiB;
static_assert(WS_SCR + M_HB + 144 * MiB <= WS_END, "ws map");
constexpr int LDS_BYTES = 152576 + 1024;

DI unsigned pk2(float a, float b) { f32x2 v = {a, b}; return __builtin_bit_cast(unsigned, __builtin_convertvector(v, bf16v2)); }
DI float bf_lo(unsigned w) { return __uint_as_float(w << 16); }
DI float bf_hi(unsigned w) { return __uint_as_float(w & 0xffff0000u); }
DI float wave_sum(float v) {
#pragma unroll
    for (int o = 1; o < 64; o <<= 1) v += __shfl_xor(v, o);
    return v;
}
DI int otid(int wv) { int t; asm volatile("v_mbcnt_lo_u32_b32 %0, -1, 0\n\tv_mbcnt_hi_u32_b32 %0, -1, %0" : "=v"(t)); return wv * 64 + t; }
DI float siluf(float x) { return x * __builtin_amdgcn_rcpf(1.f + __expf(-x)); }
DI float sigmf(float x) { return __builtin_amdgcn_rcpf(1.f + __expf(-x)); }
DI void st_bf16x8(bf16_t* p, f32x4 a, f32x4 b) { u32x4 w = {pk2(a[0], a[1]), pk2(a[2], a[3]), pk2(b[0], b[1]), pk2(b[2], b[3])}; *(u32x4*)p = w; }
DI void ld_bf16x8(const bf16_t* p, f32x4& a, f32x4& b) { const u32x4 w = *(const u32x4*)p; a = (f32x4){bf_lo(w.x), bf_hi(w.x), bf_lo(w.y), bf_hi(w.y)}; b = (f32x4){bf_lo(w.z), bf_hi(w.z), bf_lo(w.w), bf_hi(w.w)}; }

DI f32x4 ldmod4(const long long* p) { return (f32x4){(float)p[0] * MODI_INV, (float)p[1] * MODI_INV, (float)p[2] * MODI_INV, (float)p[3] * MODI_INV}; }

struct Args { const float* in[18]; float* out; unsigned char* ws; int ph_lo, ph_hi; };

#define XB_TMO      128
#define XB_XCNT(j)  (256  + 64 * (j))
#define XB_XSUB(j)  (1280 + 64 * (j))
#define XB_XGEN(j)  (2304 + 64 * (j))
#define XB_TOP      3328
#define XB_TOPGEN   3392
#define XCD_BAR_WORDS 3456
#define XB_SPIN_CAP (1u << 18)

__device__ __forceinline__ unsigned xb_ld(unsigned* p)              { return __hip_atomic_load(p, __ATOMIC_RELAXED, __HIP_MEMORY_SCOPE_AGENT); }
__device__ __forceinline__ unsigned xb_add(unsigned* p, unsigned v) { return __hip_atomic_fetch_add(p, v, __ATOMIC_RELAXED, __HIP_MEMORY_SCOPE_AGENT); }
__device__ __forceinline__ unsigned xb_xcc_id() { return (unsigned)__builtin_amdgcn_s_getreg((3 << 11) | 20) & 0xFu; }
#define XB_SPIN(cond, bar) do { unsigned _sp = 0; while (cond) { __builtin_amdgcn_s_sleep(1); \
    if ((++_sp & 255u) == 0u) { if (xb_ld(&(bar)[XB_TMO])) break; if (_sp > XB_SPIN_CAP) { atomicAdd(&(bar)[XB_TMO], 1u); break; } } } } while (0)

struct XcdBarrier {
    unsigned* bar; unsigned x;
    volatile LAS unsigned* st;
};

__device__ __forceinline__ XcdBarrier xcd_barrier_post(unsigned* bar, volatile LAS unsigned* st, int wv) {
    XcdBarrier b; b.bar = bar; b.x = xb_xcc_id(); b.st = st;
    if (otid(wv) == 0) (void)xb_add(&bar[XB_XCNT(b.x)], 1u);
    return b;
}
__device__ __forceinline__ void xcd_barrier_complete(unsigned* bar, unsigned x, unsigned& nloc, unsigned& nx) {
    const unsigned G = gridDim.x * gridDim.y * gridDim.z;
    unsigned sum, cnt, mine, sp = 0u;
    for (;;) {
        sum = 0u; cnt = 0u; mine = 0u;
#pragma unroll
        for (unsigned j = 0; j < 16; ++j) { const unsigned c = xb_ld(&bar[XB_XCNT(j)]); sum += c; cnt += (c > 0u) ? 1u : 0u; mine = (j == x) ? c : mine; }
        if (sum == G) break;
        __builtin_amdgcn_s_sleep(1);
        if ((++sp & 255u) == 0u) { if (xb_ld(&bar[XB_TMO])) break; if (sp > XB_SPIN_CAP) { atomicAdd(&bar[XB_TMO], 1u); break; } }
    }
    nloc = mine > 0u ? mine : 1u; nx = cnt > 0u ? cnt : 1u;
}

__device__ __forceinline__ void xcd_barrier(const XcdBarrier& b, int wv) {
    asm volatile("s_waitcnt vmcnt(0)" ::: "memory");
    __syncthreads();
    if (otid(wv) == 0) {
        unsigned* bar = b.bar;
        __builtin_amdgcn_s_waitcnt(0);
        unsigned nloc = b.st[0], nx = b.st[1];
        if (nloc == 0u) { xcd_barrier_complete(bar, b.x, nloc, nx); b.st[0] = nloc; b.st[1] = nx; }
        const unsigned old = xb_add(&bar[XB_XSUB(b.x)], 1u);
        const unsigned gen = old / nloc;
        if (old + 1u == (gen + 1u) * nloc) {
            __builtin_amdgcn_fence(__ATOMIC_RELEASE, "agent");
            asm volatile("s_waitcnt vmcnt(0)" ::: "memory");
            const unsigned og = xb_add(&bar[XB_TOP], 1u);
            const unsigned tg = og / nx;
            if (og + 1u == (tg + 1u) * nx) xb_add(&bar[XB_TOPGEN], 1u);
            else XB_SPIN(xb_ld(&bar[XB_TOPGEN]) == tg, bar);
            __builtin_amdgcn_fence(__ATOMIC_ACQUIRE, "agent");
            xb_add(&bar[XB_XGEN(b.x)], 1u);
            asm volatile("s_waitcnt vmcnt(0)" ::: "memory");
        } else {
            XB_SPIN(xb_ld(&bar[XB_XGEN(b.x)]) == gen, bar);
            __builtin_amdgcn_fence(__ATOMIC_ACQUIRE, "agent");
            asm volatile("s_waitcnt vmcnt(0)" ::: "memory");
        }
    }
    __syncthreads();
}


namespace pg8 {
constexpr int BM = 256, BK = 64, HALF = 128, HTB = HALF * BK * 2, NXCD = 8;
DI int lds_byte(int r, int c) { const int st = (r >> 4) * 2 + (c >> 5), rr = r & 15, cc = c & 31, ob = rr * 64 + cc * 2; return st * 1024 + (ob ^ (((ob >> 9) & 1) << 5)); }
DI void stage_rc(int b, int& R, int& C) { const int st = b / 1024, sb = b % 1024, swz = sb ^ (((sb >> 9) & 1) << 5); R = (st >> 1) * 16 + swz / 64; C = (st & 1) * 32 + (swz % 64) / 2; }
DI int perm32(int rho) { const int n = rho >> 4, i = rho & 15; return 8 * (i >> 2) + 4 * n + (i & 3); }
struct Unit { const char* a; const char* b; int i0, i1, i2; };
template <class T, class = void> struct is_whole_tile : std::false_type {};
template <class T> struct is_whole_tile<T, std::void_t<decltype(T::WHOLE_TILE)>> : std::true_type {};
DI int xcd_remap(int L, int total) { const int q = total / NXCD, r = total % NXCD, xcd = L % NXCD, off = L / NXCD; return (xcd < r ? xcd * (q + 1) : r * (q + 1) + (xcd - r) * q) + off; }

template <class Desc, class Epi>
DI void gemm_phase(LAS unsigned char* lds, const Desc& D, const Epi& E, int wv) {
    const int tid = otid(wv), wid = __builtin_amdgcn_readfirstlane(tid >> 6), lane = tid & 63, wr = wid >> 2, wc = wid & 3, fr = lane & 15, fq = lane >> 4;
    const int G = gridDim.x, c = blockIdx.x, total = D.total;
    const int K = D.K, nt = K / BK;
    unsigned voffA[2], voffB[2];
#pragma unroll
    for (int i = 0; i < 2; ++i) { int R, C; stage_rc(tid * 16 + i * 8192, R, C); const int Rb = (R & ~31) + perm32(R & 31);
        voffA[i] = (unsigned)(R * D.lda + C) * 2u; voffB[i] = (unsigned)(Rb * D.ldb + C) * 2u; }
    const size_t kstep = (size_t)(BK * 2);
    const size_t hstepA = (size_t)HALF * D.lda * 2, hstepB = (size_t)HALF * D.ldb * 2;
    const unsigned ldsw = (unsigned)wid * 1024u;
    const int aoff = lds_byte(wr * 64 + fr, fq * 8), boff = lds_byte(wc * 32 + fr, fq * 8);
#define PG8_SA(b, h) (((b) * 2 + (h)) * HTB)
#define PG8_SB(b, h) ((4 + (b) * 2 + (h)) * HTB)
#define PG8_STAGE(bufoff, gbase, voff) do { _Pragma("unroll") for (int _i = 0; _i < 2; ++_i) \
        __builtin_amdgcn_global_load_lds((const unsigned*)((const char*)(gbase) + (voff)[_i]), (LAS unsigned*)(lds + (bufoff) + ldsw + _i * 8192), 16, 0, 0); } while (0)
#define PG8_LDA(dst, b, h) do { _Pragma("unroll") for (int m = 0; m < 4; ++m) _Pragma("unroll") for (int k = 0; k < 2; ++k) dst[m][k] = *(const LAS bf16x8*)(lds + PG8_SA(b, h) + aoff + m * 2048 + k * 1024); } while (0)
#define PG8_LDB(dst, b, h) do { _Pragma("unroll") for (int n = 0; n < 2; ++n) _Pragma("unroll") for (int k = 0; k < 2; ++k) dst[n][k] = *(const LAS bf16x8*)(lds + PG8_SB(b, h) + boff + n * 2048 + k * 1024); } while (0)
#define PG8_MMA(ai, bj, At, Bt) do { __builtin_amdgcn_s_setprio(1); _Pragma("unroll") for (int m = 0; m < 4; ++m) _Pragma("unroll") for (int n = 0; n < 2; ++n) _Pragma("unroll") for (int k = 0; k < 2; ++k) \
        acc[ai][bj][m][n] = __builtin_amdgcn_mfma_f32_16x16x32_bf16(Bt[n][k], At[m][k], acc[ai][bj][m][n], 0, 0, 0); __builtin_amdgcn_s_setprio(0); } while (0)
#define PG8_WAIT_V(n) asm volatile("s_waitcnt vmcnt(" #n ")" ::: "memory")
#define PG8_WAIT_L(n) asm volatile("s_waitcnt lgkmcnt(" #n ")" ::: "memory")
#define PG8_BAR __builtin_amdgcn_s_barrier()
#define PG8_SCHED __builtin_amdgcn_sched_barrier(0)
    if constexpr (Desc::RAW) { if (!D.valid(c, G)) return; } else { if (c >= total) return; }
    Unit cur, nxt; int ui = 0;
    if constexpr (Desc::RAW) cur = D.unit(c, G); else cur = D.unit(xcd_remap(c, total));
    nxt = cur;
    f32x4 acc[2][2][4][2];
#pragma unroll
    for (int a = 0; a < 2; ++a)
#pragma unroll
        for (int b = 0; b < 2; ++b)
#pragma unroll
            for (int m = 0; m < 4; ++m)
#pragma unroll
                for (int n = 0; n < 2; ++n) acc[a][b][m][n] = (f32x4){0.f, 0.f, 0.f, 0.f};
    bf16x8 At[4][2], B0[2][2], B1[2][2];
    const char* cA = cur.a; const char* cB = cur.b;
    PG8_STAGE(PG8_SB(0, 0), cB, voffB); PG8_STAGE(PG8_SB(0, 1), cB + hstepB, voffB); PG8_STAGE(PG8_SA(0, 0), cA, voffA); PG8_STAGE(PG8_SA(0, 1), cA + hstepA, voffA);
    if (wr == 1) PG8_BAR;
    PG8_WAIT_V(2); PG8_BAR;
    PG8_STAGE(PG8_SB(1, 0), cB + kstep, voffB); PG8_STAGE(PG8_SA(1, 0), cA + kstep, voffA); PG8_STAGE(PG8_SB(1, 1), cB + hstepB + kstep, voffB);
    PG8_WAIT_V(6); PG8_BAR;
    for (;;) {
        const long Ln = (long)(ui + 1) * G + c;
        bool has_next;
        if constexpr (Desc::RAW) { has_next = D.valid((int)Ln, G); if (has_next) nxt = D.unit((int)Ln, G); }
        else { has_next = Ln < total; if (has_next) nxt = D.unit(xcd_remap((int)Ln, total)); }
        const char* nA = has_next ? nxt.a : cA; const char* nB = has_next ? nxt.b : cB;
        for (int t = 0; t < nt; t += 2) {
            const bool last = (t == nt - 2);
            const char* a1 = cA + (size_t)(t + 1) * kstep;
            const char* a2 = last ? nA : cA + (size_t)(t + 2) * kstep; const char* b2 = last ? nB : cB + (size_t)(t + 2) * kstep;
            const char* a3 = a2 + kstep; const char* b3 = b2 + kstep;
            PG8_LDB(B0, 0, 0); PG8_LDB(B1, 0, 1); PG8_SCHED; PG8_LDA(At, 0, 0); PG8_STAGE(PG8_SA(1, 1), a1 + hstepA, voffA);
            PG8_WAIT_V(8); PG8_WAIT_L(0); PG8_BAR; PG8_MMA(0, 0, At, B0); PG8_MMA(0, 1, At, B1); PG8_BAR; PG8_SCHED;
            PG8_LDA(At, 0, 1); PG8_STAGE(PG8_SB(0, 0), b2, voffB); PG8_STAGE(PG8_SB(0, 1), b2 + hstepB, voffB); PG8_STAGE(PG8_SA(0, 0), a2, voffA);
            PG8_WAIT_V(8); PG8_WAIT_L(0); PG8_BAR; PG8_MMA(1, 0, At, B0); PG8_MMA(1, 1, At, B1); PG8_BAR; PG8_SCHED;
            PG8_LDB(B0, 1, 0); PG8_LDB(B1, 1, 1); PG8_SCHED; PG8_LDA(At, 1, 0); PG8_STAGE(PG8_SA(0, 1), a2 + hstepA, voffA);
            PG8_WAIT_V(8); PG8_WAIT_L(0); PG8_BAR; PG8_MMA(0, 0, At, B0); PG8_MMA(0, 1, At, B1); PG8_BAR; PG8_SCHED;
            PG8_LDA(At, 1, 1); PG8_STAGE(PG8_SB(1, 0), b3, voffB); PG8_STAGE(PG8_SB(1, 1), b3 + hstepB, voffB); PG8_STAGE(PG8_SA(1, 0), a3, voffA);
            PG8_WAIT_V(8); PG8_WAIT_L(0); PG8_BAR; PG8_MMA(1, 0, At, B0); PG8_MMA(1, 1, At, B1); PG8_BAR; PG8_SCHED;
        }
        if (wr == 0) PG8_BAR;
        {
            const int le = otid(wv) & 63, fre = le & 15, fqe = le >> 4;
            if constexpr (is_whole_tile<Epi>::value) E.run(cur, acc, wr, wc, fre, fqe); else
#pragma unroll
            for (int ai = 0; ai < 2; ++ai)
#pragma unroll
                for (int m = 0; m < 4; ++m)
#pragma unroll
                    for (int bj = 0; bj < 2; ++bj)
                        E(cur, ai * HALF + wr * 64 + m * 16 + fre, bj * HALF + wc * 32 + 8 * fqe, acc[ai][bj][m][0], acc[ai][bj][m][1]);
        }
        if (!has_next) break;
#pragma unroll
        for (int a = 0; a < 2; ++a)
#pragma unroll
            for (int b = 0; b < 2; ++b)
#pragma unroll
                for (int m = 0; m < 4; ++m)
#pragma unroll
                    for (int n = 0; n < 2; ++n) acc[a][b][m][n] = (f32x4){0.f, 0.f, 0.f, 0.f};
        cur = nxt; cA = nA; cB = nB; ++ui;
        if (wr == 1) PG8_BAR;
    }
    PG8_WAIT_V(0);
    PG8_BAR;
#undef PG8_SA
#undef PG8_SB
#undef PG8_STAGE
#undef PG8_LDA
#undef PG8_LDB
#undef PG8_MMA
#undef PG8_WAIT_V
#undef PG8_WAIT_L
#undef PG8_BAR
#undef PG8_SCHED
}
}

DI void transpose_item(const float* W, int N, int kb, int nb, bf16_t* d0, bf16_t* d1, int K, LAS float* scr, int lane) {
    const int k0 = 64 * kb, n0 = 32 * nb;
#pragma unroll 8
    for (int i = 0; i < 32; ++i) { const int kk = 2 * i + (lane >> 5); scr[kk * 33 + (lane & 31)] = W[(size_t)(k0 + kk) * N + n0 + (lane & 31)]; }
    asm volatile("s_waitcnt lgkmcnt(0)" ::: "memory");
    const int c = lane & 7;
#pragma unroll
    for (int j = 0; j < 4; ++j) { const int n = (lane >> 3) + 8 * j; const LAS float* s = scr + (8 * c) * 33 + n;
        u32x4 o; o.x = pk2(s[0 * 33], s[1 * 33]); o.y = pk2(s[2 * 33], s[3 * 33]); o.z = pk2(s[4 * 33], s[5 * 33]); o.w = pk2(s[6 * 33], s[7 * 33]);
        *(u32x4*)(d0 + (size_t)n * K + k0 + 8 * c) = o;
        if (d1) *(u32x4*)(d1 + (size_t)n * K + k0 + 8 * c) = o; }
    asm volatile("s_waitcnt lgkmcnt(0)" ::: "memory");
}

DI void prep_phase(const Args& A, LAS unsigned char* lds, int wv) {
    const int tid = otid(wv), lane = tid & 63, wave = tid >> 6, G = gridDim.x;
    unsigned char* ws = A.ws;
    {
        LAS float* s_lds = (LAS float*)lds;
        const float* cc = A.in[1]; const float* cctx = A.in[3]; const float* aw = A.in[4]; const float* ab = A.in[5];
        long long* modi = (long long*)(ws + WS_MODI);
        for (int item = blockIdx.x; item < 768; item += G) {
            const int kc = item % 16, cb = (item / 16) % 12, l = item / 192;
            const int k0 = kc * 128, j = cb * 512 + tid;
            __syncthreads();
            for (int e = tid; e < 17 * 128; e += NTHREADS) { const int r = e / 128, k = e % 128; const float v = r < 16 ? cc[r * DM + k0 + k] : cctx[k0 + k]; s_lds[k * 20 + r] = siluf(v); }
            __syncthreads();
            float acc[17];
#pragma unroll
            for (int r = 0; r < 17; ++r) acc[r] = 0.f;
            const float* wp = aw + ((size_t)l * DM + k0) * MOD_LD + j;
#pragma unroll 4
            for (int k = 0; k < 128; ++k) {
                const float w = wp[(size_t)k * MOD_LD];
                const LAS f32x4* sp = (const LAS f32x4*)(s_lds + k * 20);
                const f32x4 s0 = sp[0], s1 = sp[1], s2 = sp[2], s3 = sp[3]; const float s4 = s_lds[k * 20 + 16];
#pragma unroll
                for (int q = 0; q < 4; ++q) { acc[q] += s0[q] * w; acc[4 + q] += s1[q] * w; acc[8 + q] += s2[q] * w; acc[12 + q] += s3[q] * w; }
                acc[16] += s4 * w;
            }
            const float bias = (kc == 0) ? ab[l * MOD_LD + j] : 0.f;
#pragma unroll
            for (int r = 0; r < 17; ++r) atomicAdd((unsigned long long*)&modi[(size_t)(l * 17 + r) * MOD_LD + j], (unsigned long long)__float2ll_rn((acc[r] + bias) * MODI_SCALE));
        }
        __syncthreads();
    }
    {
        LAS float* scr = (LAS float*)(lds + wave * 16384);
        const int gw = blockIdx.x * NWAVES + wave, NGW = G * NWAVES;
        constexpr int I_SQ = 32 * 64, I_AI = 32 * 160, I_MI = 32 * 257;
        constexpr int NIT = 6 * I_SQ + I_AI + I_MI;
        for (int it = gw; it < NIT; it += NGW) {
            int r = it;
            if (r < 6 * I_SQ) {
                const int w = r / I_SQ; r -= w * I_SQ;
                const float* src; bf16_t* dst;
                if (w < 2)      { src = A.in[7] + (size_t)w * DM * DM;       dst = (bf16_t*)(ws + WS_WFG) + (size_t)w * DM * DM; }
                else if (w < 4) { src = A.in[8] + (size_t)(w - 2) * DM * DM; dst = (bf16_t*)(ws + WS_WFO) + (size_t)(w - 2) * DM * DM; }
                else if (w == 4) { src = A.in[12]; dst = (bf16_t*)(ws + WS_WMO); }
                else             { src = A.in[16]; dst = (bf16_t*)(ws + WS_WAO); }
                const int kb = r / 64, nb = r % 64;
                transpose_item(src, DM, kb, nb, dst + (size_t)(32 * nb) * DM, nullptr, DM, scr, lane);
                continue;
            }
            r -= 6 * I_SQ;
            if (r < I_AI) { const int kb = r / 160, nb = r % 160; transpose_item(A.in[13], 5120, kb, nb, (bf16_t*)(ws + WS_WAI) + (size_t)(32 * nb) * DM, nullptr, DM, scr, lane); continue; }
            r -= I_AI;
            {
                const int kb = r / 257, nb = r % 257, n0 = 32 * nb;
                bf16_t* WA = (bf16_t*)(ws + WS_WMA); bf16_t* WB = (bf16_t*)(ws + WS_WMB);
                bf16_t* d0; bf16_t* d1 = nullptr;
                if (n0 < 1024) d0 = WA + (size_t)n0 * DM;
                else if (n0 < 2048) d0 = WA + (size_t)n0 * DM;
                else if (n0 < 4096) d0 = WB + (size_t)(n0 - 2048) * DM;
                else if (n0 < 6144) d0 = WA + (size_t)(2304 + n0 - 4096) * DM;
                else if (n0 < 6176) d0 = WA + (size_t)(2048 + n0 - 6144) * DM;
                else d0 = WA + (size_t)(4352 + n0 - 6176) * DM;
                transpose_item(A.in[9], 8224, kb, nb, d0, d1, DM, scr, lane);
            }
        }
    }
    {
        const long gt = (long)blockIdx.x * NTHREADS + tid, NGT = (long)G * NTHREADS;
        constexpr long N_DC = 512L * 512 / 8, N_DT = 2048L * 4096 / 8, N_DT2 = 256L * 512 / 8;
        for (long it = gt; it < N_DC + N_DT + N_DT2; it += NGT) {
            float v[8]; bf16_t* dst;
            if (it < N_DC) {
                const int m = (int)(it / 64), k0 = (int)(it % 64) * 8; const float sc = 0.044194173824159216f;
#pragma unroll
                for (int j = 0; j < 8; ++j) { const int mm = (m <= 256) ? m : m - 256; const int rr = (mm * (k0 + j)) & 511; const float ang = (float)rr * (1.f / 256.f); v[j] = (m <= 256 ? cospif(ang) : sinpif(ang)) * sc; }
                dst = (bf16_t*)(ws + WS_DC) + (size_t)m * 512 + k0;
            } else if (it < N_DC + N_DT) {
                const long i2 = it - N_DC; const int kk = (int)(i2 / 512), s0 = (int)(i2 % 512) * 8; const float sc = 0.022097086912079608f;
#pragma unroll
                for (int j = 0; j < 8; ++j) { const int s = s0 + j; const int rr = (kk * (s & 2047)) & 2047; const float ang = (float)rr * (1.f / 1024.f); v[j] = (s < 2048 ? cospif(ang) : -sinpif(ang)) * sc; }
                dst = (bf16_t*)(ws + WS_DT) + (size_t)kk * 4096 + s0;
            } else {
                const long i2 = it - N_DC - N_DT; const int kk = (int)(i2 / 64), s0 = (int)(i2 % 64) * 8; const float sc = 0.0625f;
#pragma unroll
                for (int j = 0; j < 8; ++j) { const int s = s0 + j; const int rr = (kk * (s & 255)) & 255; const float ang = (float)rr * (1.f / 128.f); v[j] = (s < 256 ? cospif(ang) : -sinpif(ang)) * sc; }
                dst = (bf16_t*)(ws + WS_DT2) + (size_t)kk * 512 + s0;
            }
            u32x4 o = {pk2(v[0], v[1]), pk2(v[2], v[3]), pk2(v[4], v[5]), pk2(v[6], v[7])};
            *(u32x4*)dst = o;
        }
    }
}

DI const float* xrow_in(const Args& A, int r) {
    const int b = r / TB, t = r % TB;
    if (t < TL) return A.in[0] + ((size_t)b * TL + t) * DM;
    return A.in[2] + ((size_t)b * TC + (t - TL)) * DM;
}
DI void norm_phase(const Args& A, int layer, bool latonly, int wv) {
    const int tid = otid(wv), lane = tid & 63, wave = tid >> 6, G = gridDim.x;
    const float* ng = A.in[6] + (size_t)layer * DM;
    const float* mod = (const float*)(A.ws + WS_MOD) + (size_t)layer * 17 * MOD_LD;
    bf16_t* H = (bf16_t*)(A.ws + WS_H);
    const bf16_t* XB = (const bf16_t*)A.out;
    for (int r0 = (blockIdx.x * NWAVES + wave) * 2; r0 < NTOK; r0 += G * NWAVES * 2) {
        const int b = r0 / TB, t = r0 % TB;
        if (latonly && t >= TL) continue;
        const float* mr = mod + (size_t)(t < TL ? b : 16) * MOD_LD;
        f32x4 v[2][4][2];
#pragma unroll
        for (int k = 0; k < 2; ++k) {
            const int r = r0 + k;
            if (layer == 0) {
                const float* xr = xrow_in(A, r);
#pragma unroll
                for (int j = 0; j < 4; ++j) { const f32x4* p = (const f32x4*)(xr + 512 * j + 8 * lane); v[k][j][0] = p[0]; v[k][j][1] = p[1]; }
            } else {
#pragma unroll
                for (int j = 0; j < 4; ++j) ld_bf16x8(XB + (size_t)r * DM + 512 * j + 8 * lane, v[k][j][0], v[k][j][1]);
            }
        }
#pragma unroll
        for (int k = 0; k < 2; ++k) {
            const int r = r0 + k; float ss = 0.f;
#pragma unroll
            for (int j = 0; j < 4; ++j)
#pragma unroll
                for (int q = 0; q < 4; ++q) ss += v[k][j][0][q] * v[k][j][0][q] + v[k][j][1][q] * v[k][j][1][q];
            const float rs = 1.0f / sqrtf(wave_sum(ss) * (1.f / DM) + EPS);
#pragma unroll
            for (int j = 0; j < 4; ++j) { const int c0 = 512 * j + 8 * lane; f32x4 o[2];
#pragma unroll
                for (int h = 0; h < 2; ++h) { const f32x4 g4 = *(const f32x4*)(ng + c0 + 4 * h), sh = *(const f32x4*)(mr + c0 + 4 * h), sc = *(const f32x4*)(mr + DM + c0 + 4 * h);
                    o[h] = (v[k][j][h] * rs) * g4 * (sc + 1.0f) + sh; }
                st_bf16x8(H + (size_t)r * DM + c0, o[0], o[1]); }
        }
    }
}
DI void final_norm_phase(const Args& A, const bf16_t* src, int wv) {
    const int tid = otid(wv), lane = tid & 63, wave = tid >> 6, G = gridDim.x;
    const float* fg = A.in[17];
    for (int r0 = (blockIdx.x * NWAVES + wave) * 2; r0 < NB * TL; r0 += G * NWAVES * 2) {
        f32x4 v[2][4][2];
#pragma unroll
        for (int k = 0; k < 2; ++k)
#pragma unroll
            for (int j = 0; j < 4; ++j) ld_bf16x8(src + (size_t)(r0 + k) * DM + 512 * j + 8 * lane, v[k][j][0], v[k][j][1]);
#pragma unroll
        for (int k = 0; k < 2; ++k) { float* orow = A.out + (size_t)(r0 + k) * DM; float ss = 0.f;
#pragma unroll
            for (int j = 0; j < 4; ++j)
#pragma unroll
                for (int q = 0; q < 4; ++q) ss += v[k][j][0][q] * v[k][j][0][q] + v[k][j][1][q] * v[k][j][1][q];
            const float rs = 1.0f / sqrtf(wave_sum(ss) * (1.f / DM) + EPS);
#pragma unroll
            for (int j = 0; j < 4; ++j) { const int c0 = 512 * j + 8 * lane;
#pragma unroll
                for (int h = 0; h < 2; ++h) { const f32x4 g4 = *(const f32x4*)(fg + c0 + 4 * h); *(f32x4*)(orow + c0 + 4 * h) = (v[k][j][h] * rs) * g4; } }
        }
    }
}

struct DescPlain {
    static constexpr bool RAW = false;
    const bf16_t* A; const bf16_t* B; int nN; bool latonly; int lda, ldb, K, total;
    DI void init(const bf16_t* A_, const bf16_t* B_, int nN_, bool lat) { A = A_; B = B_; nN = nN_; latonly = lat; lda = DM; ldb = DM; K = DM; total = (lat ? 128 : 144) * nN_; }
    DI pg8::Unit unit(int idx) const {
        const int nMt = latonly ? 128 : 144, nig = 8 * nN, gid = idx / nig, fm = gid * 8, gsz = (nMt - fm) < 8 ? (nMt - fm) : 8;
        const int pmi = fm + (idx % nig) % gsz, pn = (idx % nig) / gsz, pm = latonly ? (pmi / 8) * 9 + (pmi % 8) : pmi;
        pg8::Unit u; u.a = (const char*)(A + (size_t)pm * 256 * DM); u.b = (const char*)(B + (size_t)pn * 256 * DM); u.i0 = pm; u.i1 = pn; u.i2 = 0; return u;
    }
};
struct DescChan {
    static constexpr bool RAW = false;
    const bf16_t* DC; const bf16_t* H; int lda, ldb, K, total;
    DI void init(const bf16_t* DC_, const bf16_t* H_, bool lat) { DC = DC_; H = H_; lda = 512; ldb = DM; K = 512; total = lat ? 1024 : 1152; }
    DI pg8::Unit unit(int idx) const {
        pg8::Unit u; int b, g, mt, nt, toff;
        if (idx < 1024) { mt = idx % 2; nt = (idx / 2) % 8; g = (idx / 16) % 4; b = idx / 64; toff = nt * 256; u.i2 = nt; }
        else { const int j = idx - 1024; mt = j % 2; g = (j / 2) % 4; b = j / 8; toff = TL; u.i2 = 8; }
        u.a = (const char*)(DC + (size_t)mt * 256 * 512); u.b = (const char*)(H + ((size_t)b * TB + toff) * DM + g * 512); u.i0 = b * 4 + g; u.i1 = mt; return u;
    }
};
struct DescT {
    static constexpr bool RAW = false;
    const bf16_t* DT; const bf16_t* PQ; int nMt; int lda, ldb, K, total;
    DI void init(const bf16_t* DT_, const bf16_t* PQ_, int ld, int Kd, int coff, int nMt_) { DT = DT_ + coff; PQ = PQ_ + coff; nMt = nMt_; lda = ld; ldb = ld; K = Kd; total = NB * nMt_ * 8; }
    DI pg8::Unit unit(int idx) const {
        const int mt = idx % nMt, nt = (idx / nMt) % 8, b = idx / (nMt * 8);
        pg8::Unit u; u.a = (const char*)(DT + (size_t)mt * 256 * lda); u.b = (const char*)(PQ + ((size_t)b * DM + nt * 256) * ldb); u.i0 = b; u.i1 = mt; u.i2 = nt; return u;
    }
};

struct DescT2 {
    static constexpr bool RAW = true;
    const bf16_t* DT; const bf16_t* PQ; int lda, ldb, K, total;
    DI void init(const bf16_t* DT_, const bf16_t* PQ_) { DT = DT_; PQ = PQ_; lda = 4096; ldb = 4096; K = 2048; total = 2 * NB * 4 * 8; }
    DI bool valid(int L, int G) const { return ((L / G) >> 1) * G + (L % G) < NB * 4 * 8; }
    DI pg8::Unit unit(int L, int G) const {
        const int i = L / G, pair = (i >> 1) * G + (L % G), part = i & 1;
        const int mt = pair % 4, nt = (pair / 4) % 8, b = pair / 32, coff = part * 2048;
        pg8::Unit u; u.a = (const char*)(DT + (size_t)mt * 256 * 4096 + coff); u.b = (const char*)(PQ + ((size_t)b * DM + nt * 256) * 4096 + coff); u.i0 = b; u.i1 = mt; u.i2 = part * 8 + nt; return u;
    }
};

DI void resid_store(const Args& A, int layer, int pm, int row_l, int col, const float* modl, f32x4 v0, f32x4 v1) {
    const int b = pm / 9, tt = pm % 9;
    const float* gp = modl + (size_t)(tt < 8 ? b : 16) * MOD_LD + 2 * DM + col;
    const f32x4 g0 = *(const f32x4*)gp, g1 = *(const f32x4*)(gp + 4);
    bf16_t* XB = (bf16_t*)A.out;
    const size_t roff = ((size_t)pm * 256 + row_l) * DM + col;
    f32x4 x0, x1;
    if (layer == 0) {
        const float* src = (tt < 8) ? A.in[0] + ((size_t)b * TL + tt * 256 + row_l) * DM + col : A.in[2] + ((size_t)b * TC + row_l) * DM + col;
        x0 = *(const f32x4*)src; x1 = *(const f32x4*)(src + 4);
    } else ld_bf16x8(XB + roff, x0, x1);
    x0 = x0 + g0 * v0; x1 = x1 + g1 * v1;
    if (layer == 3) st_bf16x8((bf16_t*)(A.ws + WS_SCR + F_PQX) + ((size_t)b * TL + tt * 256 + row_l) * DM + col, x0, x1);
    else st_bf16x8(XB + roff, x0, x1);
}

struct EpiResid {
    static constexpr bool WHOLE_TILE = true;
    const float* x_in; const float* c_in; bf16_t* XB; bf16_t* X2; const float* modl; int layer;
    DI void init(const Args& A, int layer_) { x_in = A.in[0]; c_in = A.in[2]; XB = (bf16_t*)A.out; X2 = (bf16_t*)(A.ws + WS_SCR + F_PQX); modl = (const float*)(A.ws + WS_MOD) + (size_t)layer_ * 17 * MOD_LD; layer = layer_; }
    DI void run(const pg8::Unit& u, const f32x4 (&acc)[2][2][4][2], int wr, int wc, int fr, int fq) const {
        const int pm = u.i0, b = pm / 9, tt = pm % 9, col0 = u.i1 * 256 + wc * 32 + 8 * fq;
        f32x4 g[2][2];
#pragma unroll
        for (int bj = 0; bj < 2; ++bj) { const float* gp = modl + (size_t)(tt < 8 ? b : 16) * MOD_LD + 2 * DM + col0 + bj * 128; g[bj][0] = *(const f32x4*)gp; g[bj][1] = *(const f32x4*)(gp + 4); }
        if (layer != 0) {
            u32x4 xq[2][4][2];
#pragma unroll
            for (int ai = 0; ai < 2; ++ai)
#pragma unroll
                for (int m = 0; m < 4; ++m)
#pragma unroll
                    for (int bj = 0; bj < 2; ++bj) xq[ai][m][bj] = *(const u32x4*)(XB + ((size_t)pm * 256 + ai * 128 + wr * 64 + m * 16 + fr) * DM + col0 + bj * 128);
#pragma unroll
            for (int ai = 0; ai < 2; ++ai)
#pragma unroll
                for (int m = 0; m < 4; ++m)
#pragma unroll
                    for (int bj = 0; bj < 2; ++bj) {
                        const int row_l = ai * 128 + wr * 64 + m * 16 + fr; const u32x4 w = xq[ai][m][bj];
                        const f32x4 x0 = (f32x4){bf_lo(w.x), bf_hi(w.x), bf_lo(w.y), bf_hi(w.y)} + g[bj][0] * acc[ai][bj][m][0];
                        const f32x4 x1 = (f32x4){bf_lo(w.z), bf_hi(w.z), bf_lo(w.w), bf_hi(w.w)} + g[bj][1] * acc[ai][bj][m][1];
                        if (layer == 3) st_bf16x8(X2 + ((size_t)b * TL + tt * 256 + row_l) * DM + col0 + bj * 128, x0, x1);
                        else st_bf16x8(XB + ((size_t)pm * 256 + row_l) * DM + col0 + bj * 128, x0, x1);
                    }
        } else {
#pragma unroll
            for (int ai = 0; ai < 2; ++ai) {
                f32x4 xf[4][2][2];
#pragma unroll
                for (int m = 0; m < 4; ++m)
#pragma unroll
                    for (int bj = 0; bj < 2; ++bj) { const int row_l = ai * 128 + wr * 64 + m * 16 + fr;
                        const float* src = (tt < 8) ? x_in + ((size_t)b * TL + tt * 256 + row_l) * DM + col0 + bj * 128 : c_in + ((size_t)b * TC + row_l) * DM + col0 + bj * 128;
                        xf[m][bj][0] = *(const f32x4*)src; xf[m][bj][1] = *(const f32x4*)(src + 4); }
#pragma unroll
                for (int m = 0; m < 4; ++m)
#pragma unroll
                    for (int bj = 0; bj < 2; ++bj) { const int row_l = ai * 128 + wr * 64 + m * 16 + fr;
                        st_bf16x8(XB + ((size_t)pm * 256 + row_l) * DM + col0 + bj * 128, xf[m][bj][0] + g[bj][0] * acc[ai][bj][m][0], xf[m][bj][1] + g[bj][1] * acc[ai][bj][m][1]); }
            }
        }
    }
};

DI void fnet_layer(const Args& A, LAS unsigned char* lds, const XcdBarrier& gbar, int layer, int j, bool latonly, int wv) {
    unsigned char* ws = A.ws;
    const bf16_t* H = (const bf16_t*)(ws + WS_H); bf16_t* U = (bf16_t*)(ws + WS_H);
    bf16_t* Gt = (bf16_t*)(ws + WS_SCR + F_G); bf16_t* PQX = (bf16_t*)(ws + WS_SCR + F_PQX); bf16_t* PQC = (bf16_t*)(ws + WS_SCR + F_PQC);
    norm_phase(A, layer, latonly, wv);
    xcd_barrier(gbar, wv);
    {
        DescPlain D; D.init(H, (const bf16_t*)(ws + WS_WFG) + (size_t)j * DM * DM, 8, latonly);
        auto E = [=](const pg8::Unit& u, int row_l, int col_l, f32x4 v0, f32x4 v1) {
            f32x4 a, b;
#pragma unroll
            for (int q = 0; q < 4; ++q) { a[q] = siluf(v0[q]); b[q] = siluf(v1[q]); }
            st_bf16x8(Gt + ((size_t)u.i0 * 256 + row_l) * DM + u.i1 * 256 + col_l, a, b);
        };
        pg8::gemm_phase(lds, D, E, wv);
    }
    {
        DescChan D; D.init((const bf16_t*)(ws + WS_DC), H, latonly);
        auto E = [=](const pg8::Unit& u, int row_l, int col_l, f32x4 v0, f32x4 v1) {
            const int b = u.i0 >> 2, g = u.i0 & 3, m = row_l;
            bf16_t* base; size_t cs; int hs;
            if (u.i2 < 8) { base = PQX + ((size_t)b * DM + g * 512) * 4096 + u.i2 * 256 + col_l; cs = 4096; hs = 2048; }
            else          { base = PQC + ((size_t)b * DM + g * 512) * 512 + col_l; cs = 512; hs = 256; }
            const f32x4 z = {0.f, 0.f, 0.f, 0.f};
            if (u.i1 == 0) { st_bf16x8(base + (size_t)m * cs, v0, v1); if (m != 0) st_bf16x8(base + (size_t)(512 - m) * cs, v0, v1); }
            else if (m == 0) { st_bf16x8(base + (size_t)256 * cs, v0, v1); st_bf16x8(base + (size_t)256 * cs + hs, z, z); st_bf16x8(base + hs, z, z); }
            else { st_bf16x8(base + (size_t)m * cs + hs, v0, v1); st_bf16x8(base + (size_t)(512 - m) * cs + hs, z - v0, z - v1); }
        };
        pg8::gemm_phase(lds, D, E, wv);
    }
    xcd_barrier(gbar, wv);
    bf16_t* A1 = (bf16_t*)(ws + WS_SCR + F_A1);
    {
        const int tid = otid(wv), lane = tid & 63;
        for (int rr0 = (blockIdx.x * NWAVES + wv) * 4; rr0 < NB * DM; rr0 += gridDim.x * NWAVES * 4) {
            u32x4 raw[4][4];
#pragma unroll
            for (int k = 0; k < 4; ++k)
#pragma unroll
                for (int q = 0; q < 4; ++q) raw[k][q] = *(const u32x4*)(PQX + (size_t)(rr0 + k) * 4096 + (q * 64 + lane) * 8);
#pragma unroll
            for (int k = 0; k < 4; ++k) { float acc = 0.f;
#pragma unroll
                for (int q = 0; q < 4; ++q) { const u32x4 w = raw[k][q]; acc += (bf_lo(w.x) - bf_hi(w.x)) + (bf_lo(w.y) - bf_hi(w.y)) + (bf_lo(w.z) - bf_hi(w.z)) + (bf_lo(w.w) - bf_hi(w.w)); }
                acc = wave_sum(acc);
                if (lane == 0) { const int rr = rr0 + k; const size_t off = ((size_t)(rr >> 11) * TB + 1024) * DM + (rr & 2047);
                    U[off] = (bf16_t)(pk2(acc * 0.022097086912079608f * __uint_as_float((unsigned)Gt[off] << 16), 0.f) & 0xffffu); } }
        }
    }
    {
        DescT2 D; D.init((const bf16_t*)(ws + WS_DT), PQX);
        auto E = [=](const pg8::Unit& u, int row_l, int col_l, f32x4 v0, f32x4 v1) {
            const int k = u.i1 * 256 + row_l, col = (u.i2 & 7) * 256 + col_l;
            bf16_t* ap = A1 + ((size_t)u.i0 * 1024 + k) * DM + col;
            if (u.i2 < 8) { st_bf16x8(ap, v0, v1); return; }
            f32x4 a0, a1; ld_bf16x8(ap, a0, a1);
            const size_t off = ((size_t)u.i0 * TB + k) * DM + col;
            f32x4 g0, g1; ld_bf16x8(Gt + off, g0, g1);
            st_bf16x8(U + off, (a0 + v0) * g0, (a1 + v1) * g1);
            if (k != 0) { const size_t off2 = ((size_t)u.i0 * TB + (TL - k)) * DM + col; ld_bf16x8(Gt + off2, g0, g1); st_bf16x8(U + off2, (a0 - v0) * g0, (a1 - v1) * g1); }
        };
        pg8::gemm_phase(lds, D, E, wv);
    }
    if (!latonly) {
        DescT D; D.init((const bf16_t*)(ws + WS_DT2), PQC, 512, 512, 0, 1);
        auto E = [=](const pg8::Unit& u, int row_l, int col_l, f32x4 v0, f32x4 v1) {
            const size_t off = ((size_t)u.i0 * TB + TL + row_l) * DM + u.i2 * 256 + col_l;
            f32x4 g0, g1; ld_bf16x8(Gt + off, g0, g1);
            st_bf16x8(U + off, v0 * g0, v1 * g1);
        };
        pg8::gemm_phase(lds, D, E, wv);
    }
    xcd_barrier(gbar, wv);
    {
        DescPlain D; D.init(U, (const bf16_t*)(ws + WS_WFO) + (size_t)j * DM * DM, 8, latonly);
        EpiResid E; E.init(A, layer);
        pg8::gemm_phase(lds, D, E, wv);
    }
    xcd_barrier(gbar, wv);
}


namespace att {
constexpr int D = 128, NW = 8, QBLK = 32, KVBLK = 64;
constexpr float SCALE = 0.088388347648318440f;
constexpr float THR = 8.f;
constexpr int LDQ = 2048, LDK = 512;
constexpr size_t SHM_V = KVBLK * D * 2, SHM_K = KVBLK * D * 2;
typedef float f32x8 __attribute__((ext_vector_type(8)));
#define KSWZ(row, colB) ((row) * 256 + ((colB) ^ (((row) & 7) << 4)))
#define SBAR() __builtin_amdgcn_sched_barrier(0)
DI int crow(int r, int hi) { return (r & 3) + 8 * (r >> 2) + 4 * hi; }
DI unsigned cvtpk(float lo, float hi) { unsigned r; asm volatile("v_cvt_pk_bf16_f32 %0, %1, %2" : "=v"(r) : "v"(lo), "v"(hi)); return r; }
DI void partialSM(f32x16& p0, f32x16& p1, float& m_reg, float& mn, float& alpha) {
  constexpr float C = SCALE * 1.4426950408889634f;
  float pmax = p0[0];
#pragma unroll
  for (int r = 1; r < 16; ++r) pmax = fmaxf(pmax, p0[r]);
#pragma unroll
  for (int r = 0; r < 16; ++r) pmax = fmaxf(pmax, p1[r]);
  { auto rr = __builtin_amdgcn_permlane32_swap(__float_as_uint(pmax), __float_as_uint(pmax), false, false);
    pmax = fmaxf(__uint_as_float(rr[0]), __uint_as_float(rr[1])); }
  if (__builtin_expect(__all(pmax - m_reg <= THR / SCALE), 1)) { mn = m_reg; alpha = 1.f; }
  else { mn = fmaxf(m_reg, pmax); alpha = __builtin_amdgcn_exp2f((m_reg - mn) * C); m_reg = mn; }
  float mnC = -mn * C;
#pragma unroll
  for (int r = 0; r < 16; ++r) p0[r] = fmaf(p0[r], C, mnC);
#pragma unroll
  for (int r = 0; r < 16; ++r) p1[r] = fmaf(p1[r], C, mnC);
#pragma unroll
  for (int r = 0; r < 16; ++r) p0[r] = __builtin_amdgcn_exp2f(p0[r]);
}
DI void finishSM(f32x16& p0, f32x16& p1, float alpha, float& l_reg, bf16x8& pa0, bf16x8& pa1, bf16x8& pa2, bf16x8& pa3) {
#pragma unroll
  for (int r = 0; r < 16; ++r) p1[r] = __builtin_amdgcn_exp2f(p1[r]);
  float ps = 0;
#pragma unroll
  for (int r = 0; r < 16; ++r) ps += p0[r];
#pragma unroll
  for (int r = 0; r < 16; ++r) ps += p1[r];
  { auto rr = __builtin_amdgcn_permlane32_swap(__float_as_uint(ps), __float_as_uint(ps), false, false);
    ps = __uint_as_float(rr[0]) + __uint_as_float(rr[1]); }
  l_reg = l_reg * alpha + ps;
#define PK4(P, BASE, OUT) do { unsigned a0 = cvtpk(P[BASE + 0], P[BASE + 1]), a1 = cvtpk(P[BASE + 2], P[BASE + 3]);   \
    unsigned b0 = cvtpk(P[BASE + 4], P[BASE + 5]), b1 = cvtpk(P[BASE + 6], P[BASE + 7]);                              \
    auto r0 = __builtin_amdgcn_permlane32_swap(a0, b0, false, false); auto r1 = __builtin_amdgcn_permlane32_swap(a1, b1, false, false); \
    u32x4 w = {r0[0], r1[0], r0[1], r1[1]}; OUT = *reinterpret_cast<bf16x8*>(&w); } while (0)
  PK4(p0, 0, pa0); PK4(p0, 8, pa1); PK4(p1, 0, pa2); PK4(p1, 8, pa3);
#undef PK4
}
DI void qkt(f32x16& p0, f32x16& p1, const bf16_t* Ks, const bf16x8* qr, int r32, int hi) {
  p0 = f32x16{}; p1 = f32x16{};
#pragma unroll
  for (int d0 = 0; d0 < 8; ++d0) { int cb = (d0 * 16 + hi * 8) * 2;
    bf16x8 b0 = *reinterpret_cast<const bf16x8*>((const char*)Ks + KSWZ(r32, cb));
    bf16x8 b1 = *reinterpret_cast<const bf16x8*>((const char*)Ks + KSWZ(32 + r32, cb));
    p0 = __builtin_amdgcn_mfma_f32_32x32x16_bf16(b0, qr[d0], p0, 0, 0, 0);
    p1 = __builtin_amdgcn_mfma_f32_32x32x16_bf16(b1, qr[d0], p1, 0, 0, 0); }
}
DI int v_st(int k, int c) { const int kk = (k & ~0xC) | ((k & 4) << 1) | ((k & 8) >> 1); return ((kk >> 3) * 4 + (c >> 5)) * 512 + ((kk & 7) * 32 + (c & 31)) * 2; }
DI int v_rd_base(int lane) { return ((lane & 3) << 3) | (((lane >> 2) & 3) << 6) | (((lane >> 4) & 1) << 5) | (((lane >> 5) & 1) << 8); }
constexpr int v_rd_off(int d0, int ks, int half) { return d0 * 512 + ks * 4096 + half * 2048; }
template <int OFF> DI s16x4 tr_read(int vb) {
  s16x4 r; asm volatile("ds_read_b64_tr_b16 %0, %1 offset:%2" : "=&v"(r) : "v"(vb), "i"(OFF) : "memory"); return r;
}
template <int D0> DI void pv_one(f32x16& od, int vb, bf16x8 pa0, bf16x8 pa1, bf16x8 pa2, bf16x8 pa3) {
  const s16x4 l0 = tr_read<v_rd_off(D0, 0, 0)>(vb), h0 = tr_read<v_rd_off(D0, 0, 1)>(vb), l1 = tr_read<v_rd_off(D0, 1, 0)>(vb), h1 = tr_read<v_rd_off(D0, 1, 1)>(vb);
  const s16x4 l2 = tr_read<v_rd_off(D0, 2, 0)>(vb), h2 = tr_read<v_rd_off(D0, 2, 1)>(vb), l3 = tr_read<v_rd_off(D0, 3, 0)>(vb), h3 = tr_read<v_rd_off(D0, 3, 1)>(vb);
  asm volatile("s_waitcnt lgkmcnt(0)" ::: "memory"); SBAR();
#define PK(L, H) (bf16x8){L[0], L[1], L[2], L[3], H[0], H[1], H[2], H[3]}
  od = __builtin_amdgcn_mfma_f32_32x32x16_bf16(pa0, PK(l0, h0), od, 0, 0, 0);
  od = __builtin_amdgcn_mfma_f32_32x32x16_bf16(pa1, PK(l1, h1), od, 0, 0, 0);
  od = __builtin_amdgcn_mfma_f32_32x32x16_bf16(pa2, PK(l2, h2), od, 0, 0, 0);
  od = __builtin_amdgcn_mfma_f32_32x32x16_bf16(pa3, PK(l3, h3), od, 0, 0, 0);
#undef PK
}
DI void pv_d0(f32x16* o, int vb, bf16x8 pa0, bf16x8 pa1, bf16x8 pa2, bf16x8 pa3) {
  pv_one<0>(o[0], vb, pa0, pa1, pa2, pa3); pv_one<1>(o[1], vb, pa0, pa1, pa2, pa3); pv_one<2>(o[2], vb, pa0, pa1, pa2, pa3); pv_one<3>(o[3], vb, pa0, pa1, pa2, pa3);
}
DI void attn_dense_body(const bf16_t* __restrict__ Qb, const bf16_t* __restrict__ Kh, const bf16_t* __restrict__ Vh, const bf16_t* SZb, bf16_t* Ub, int seq, char* lds, int wv, const float* qn, int tpos) {
  const int tid = otid(wv), wid = tid >> 6, lane = tid & 63, r32 = lane & 31, hi = lane >> 5;
  bf16_t* V_lds = (bf16_t*)lds; bf16_t* K_lds = (bf16_t*)(lds + 2 * SHM_V);
  float* wsf = (float*)(lds + 2 * SHM_V + 2 * SHM_K) + wid * 64; float* li_l = wsf; float* al_l = wsf + 32;
  float m_reg = -1e30f, l_reg = 0; f32x16 o[4] = {}; bf16x8 qr[8];
  const bf16_t* Qw = Qb + (long)(wid * QBLK + r32) * LDQ + hi * 8;
  {
    u32x4 raw[8];
#pragma unroll
    for (int d0 = 0; d0 < 8; ++d0) raw[d0] = *reinterpret_cast<const u32x4*>(Qw + d0 * 16);
    float ss = 0.f;
#pragma unroll
    for (int d0 = 0; d0 < 8; ++d0) { const u32x4 w = raw[d0];
      ss += bf_lo(w.x) * bf_lo(w.x) + bf_hi(w.x) * bf_hi(w.x) + bf_lo(w.y) * bf_lo(w.y) + bf_hi(w.y) * bf_hi(w.y) + bf_lo(w.z) * bf_lo(w.z) + bf_hi(w.z) * bf_hi(w.z) + bf_lo(w.w) * bf_lo(w.w) + bf_hi(w.w) * bf_hi(w.w); }
    ss += __shfl_xor(ss, 32);
    const float rs = 1.0f / sqrtf(ss * (1.f / 128.f) + EPS);
    const int t = tpos + wid * QBLK + r32;
    const f32x2* rope = (const f32x2*)(lds + 81920);
#pragma unroll
    for (int d0 = 0; d0 < 8; ++d0) { const u32x4 w = raw[d0]; const float* wn = qn + d0 * 16 + hi * 8;
      const f32x4 g0 = *(const f32x4*)wn, g1 = *(const f32x4*)(wn + 4);
      float y[8] = {bf_lo(w.x) * rs * g0[0], bf_hi(w.x) * rs * g0[1], bf_lo(w.y) * rs * g0[2], bf_hi(w.y) * rs * g0[3], bf_lo(w.z) * rs * g1[0], bf_hi(w.z) * rs * g1[1], bf_lo(w.w) * rs * g1[2], bf_hi(w.w) * rs * g1[3]};
      if (tpos >= 0) {
        const int pos = (d0 < 4) ? (t >> 6) : (t & 63);
        const f32x4* rp = (const f32x4*)(rope + pos * 32 + (8 * (d0 & 3) + 4 * hi));
        const f32x4 c01 = rp[0], c23 = rp[1];
        const float cs[4] = {c01[0], c01[2], c23[0], c23[2]}, sn[4] = {c01[1], c01[3], c23[1], c23[3]};
#pragma unroll
        for (int pp = 0; pp < 4; ++pp) { const float x0 = y[2 * pp], x1 = y[2 * pp + 1]; y[2 * pp] = x0 * cs[pp] - x1 * sn[pp]; y[2 * pp + 1] = x0 * sn[pp] + x1 * cs[pp]; }
      }
      u32x4 o4 = {pk2(y[0], y[1]), pk2(y[2], y[3]), pk2(y[4], y[5]), pk2(y[6], y[7])};
      qr[d0] = __builtin_bit_cast(bf16x8, o4); }
  }
  const int sr = tid >> 4, sc = (tid & 15) * 8, vst0 = v_st(sr, sc), vst1 = v_st(32 + sr, sc);
  const int vb0 = (int)(uintptr_t)V_lds + v_rd_base(lane);
  struct { bf16x8 vs0, vs1, ks0, ks1; } sr_[2];
#define SLOAD(i, k0) do { sr_[i].vs0 = *reinterpret_cast<const bf16x8*>(&Vh[(long)((k0) + sr) * LDK + sc]); sr_[i].vs1 = *reinterpret_cast<const bf16x8*>(&Vh[(long)((k0) + 32 + sr) * LDK + sc]); \
    sr_[i].ks0 = *reinterpret_cast<const bf16x8*>(&Kh[(long)((k0) + sr) * LDK + sc]); sr_[i].ks1 = *reinterpret_cast<const bf16x8*>(&Kh[(long)((k0) + 32 + sr) * LDK + sc]); } while (0)
#define SWRITE(b, i) do { *(bf16x8*)((char*)V_lds + (b) * SHM_V + vst0) = sr_[i].vs0;          \
    *(bf16x8*)((char*)V_lds + (b) * SHM_V + vst1) = sr_[i].vs1; int kc = sc * 2;               \
    *(bf16x8*)((char*)K_lds + (b) * SHM_K + KSWZ(sr, kc)) = sr_[i].ks0;                       \
    *(bf16x8*)((char*)K_lds + (b) * SHM_K + KSWZ(32 + sr, kc)) = sr_[i].ks1; } while (0)
#define SWAIT() asm volatile("s_waitcnt vmcnt(4)" ::: "memory")
#define RESC(a) do { if (__any((a) < 1.f)) { if (hi == 0) al_l[r32] = (a); asm volatile("s_waitcnt lgkmcnt(0)" ::: "memory"); \
    _Pragma("unroll") for (int d = 0; d < 4; ++d) _Pragma("unroll") for (int r = 0; r < 16; ++r) o[d][r] *= al_l[crow(r, hi)]; } } while (0)
  f32x16 pA0, pA1, pB0, pB1; float mnA, mnB, alA, alB; bf16x8 pa0, pa1, pa2, pa3; const int NT = seq / KVBLK;
  constexpr int SE = 0, SO = 1;
  SLOAD(SE, 0); asm volatile("s_waitcnt vmcnt(0)" ::: "memory"); SWRITE(0, SE); __syncthreads();
  qkt(pA0, pA1, K_lds, qr, r32, hi); partialSM(pA0, pA1, m_reg, mnA, alA);
  SLOAD(SO, KVBLK); if (2 < NT) SLOAD(SE, 2 * KVBLK);
  SWAIT(); SWRITE(1, SO); __syncthreads();
  for (int j = 1; j + 1 < NT; j += 2) {
    SBAR(); qkt(pB0, pB1, (bf16_t*)((char*)K_lds + SHM_K), qr, r32, hi);
    finishSM(pA0, pA1, alA, l_reg, pa0, pa1, pa2, pa3); SBAR();
    SLOAD(SO, (j + 2) * KVBLK); SBAR();
    pv_d0(o, vb0, pa0, pa1, pa2, pa3); partialSM(pB0, pB1, m_reg, mnB, alB);
    __syncthreads(); SWAIT(); SWRITE(0, SE);
    RESC(alB); __syncthreads();
    SBAR(); qkt(pA0, pA1, K_lds, qr, r32, hi);
    finishSM(pB0, pB1, alB, l_reg, pa0, pa1, pa2, pa3); SBAR();
    if (j + 3 < NT) SLOAD(SE, (j + 3) * KVBLK); SBAR();
    pv_d0(o, vb0 + (int)SHM_V, pa0, pa1, pa2, pa3); partialSM(pA0, pA1, m_reg, mnA, alA);
    __syncthreads(); SWAIT(); SWRITE(1, SO);
    RESC(alA); __syncthreads();
  }
  SBAR(); qkt(pB0, pB1, (bf16_t*)((char*)K_lds + SHM_K), qr, r32, hi);
  finishSM(pA0, pA1, alA, l_reg, pa0, pa1, pa2, pa3); SBAR();
  pv_d0(o, vb0, pa0, pa1, pa2, pa3); partialSM(pB0, pB1, m_reg, mnB, alB);
  __syncthreads(); RESC(alB);
  finishSM(pB0, pB1, alB, l_reg, pa0, pa1, pa2, pa3); SBAR();
  pv_d0(o, vb0 + (int)SHM_V, pa0, pa1, pa2, pa3);
  u32x4 zq[8];
#pragma unroll
  for (int i = 0; i < 8; ++i) { const int id = tid + 512 * i; zq[i] = *(const u32x4*)(SZb + (long)(id >> 4) * LDQ + (id & 15) * 8); }
  if (hi == 0) li_l[r32] = l_reg; asm volatile("s_waitcnt lgkmcnt(0)" ::: "memory");
  __syncthreads();
  {
    float rli[16];
#pragma unroll
    for (int r = 0; r < 16; ++r) rli[r] = __builtin_amdgcn_rcpf(li_l[crow(r, hi)]);
    char* ost = lds;
#pragma unroll
    for (int r = 0; r < 16; ++r) { char* rowp = ost + (wid * QBLK + crow(r, hi)) * 256 + r32 * 2;
#pragma unroll
      for (int d0 = 0; d0 < 4; ++d0) *(unsigned short*)(rowp + d0 * 64) = (unsigned short)(pk2(o[d0][r] * rli[r], 0.f) & 0xffffu); }
  }
  __syncthreads();
#pragma unroll
  for (int i = 0; i < 8; ++i) { const int id = tid + 512 * i; const int row = id >> 4, ch = id & 15;
    const u32x4 ov = *(const u32x4*)(lds + row * 256 + ch * 16);
    f32x4 a0 = {bf_lo(ov.x), bf_hi(ov.x), bf_lo(ov.y), bf_hi(ov.y)}, a1 = {bf_lo(ov.z), bf_hi(ov.z), bf_lo(ov.w), bf_hi(ov.w)};
    const f32x4 z0 = {bf_lo(zq[i].x), bf_hi(zq[i].x), bf_lo(zq[i].y), bf_hi(zq[i].y)}, z1 = {bf_lo(zq[i].z), bf_hi(zq[i].z), bf_lo(zq[i].w), bf_hi(zq[i].w)};
    st_bf16x8(Ub + (long)row * LDQ + ch * 8, a0 * z0, a1 * z1); }
  __syncthreads();
#undef SLOAD
#undef SWRITE
#undef SWAIT
#undef RESC
}
#undef KSWZ
#undef SBAR
}

DI void qknorm_phase(const Args& A, LAS unsigned char* lds, int wv) {
    const int tid = otid(wv), lane = tid & 63, wave = tid >> 6, G = gridDim.x;
    bf16_t* Q = (bf16_t*)(A.ws + WS_SCR + A_Q); bf16_t* Kb = (bf16_t*)(A.ws + WS_SCR + A_K);
    const float* qn = A.in[14]; const float* kn = A.in[15];
    const int sub = lane >> 4, l16 = lane & 15, e0 = l16 * 8;
    LAS f32x2* rope = (LAS f32x2*)lds;
    for (int e = tid; e < 2048; e += NTHREADS) { const float ang = (float)(e >> 5) * exp2f(-(float)(e & 31) * 0.41524101186092029f); rope[e] = (f32x2){cosf(ang), sinf(ang)}; }
    __syncthreads();
    const long NIT = (long)NTOK * 4;
    for (long it0 = ((long)blockIdx.x * NWAVES + wave) * 16 + sub; it0 < NIT; it0 += (long)G * NWAVES * 16) {
        bf16_t* pq[4]; u32x4 raw[4];
#pragma unroll
        for (int k = 0; k < 4; ++k) { const long it = it0 + 4 * k; const int row = (int)(it >> 2), hj = 16 + (int)(it & 3);
            pq[k] = (hj < 16) ? Q + (size_t)row * 2048 + hj * 128 + e0 : Kb + (size_t)row * 512 + (hj - 16) * 128 + e0;
            raw[k] = *(const u32x4*)pq[k]; }
#pragma unroll
        for (int k = 0; k < 4; ++k) {
            const long it = it0 + 4 * k; const int row = (int)(it >> 2), hj = 16 + (int)(it & 3);
            const float* wn = (hj < 16 ? qn : kn) + e0;
            f32x4 a = {bf_lo(raw[k].x), bf_hi(raw[k].x), bf_lo(raw[k].y), bf_hi(raw[k].y)}, b = {bf_lo(raw[k].z), bf_hi(raw[k].z), bf_lo(raw[k].w), bf_hi(raw[k].w)};
            float ss = 0.f;
#pragma unroll
            for (int q = 0; q < 4; ++q) ss += a[q] * a[q] + b[q] * b[q];
            ss += __shfl_xor(ss, 1); ss += __shfl_xor(ss, 2); ss += __shfl_xor(ss, 4); ss += __shfl_xor(ss, 8);
            const float rs = 1.0f / sqrtf(ss * (1.f / 128.f) + EPS);
            const f32x4 w0 = *(const f32x4*)wn, w1 = *(const f32x4*)(wn + 4);
            a = a * rs * w0; b = b * rs * w1;
            const int t = row % TB;
            if (t < TL) {
                const int pos = (l16 < 8) ? (t >> 6) : (t & 63);
                float y[8] = {a[0], a[1], a[2], a[3], b[0], b[1], b[2], b[3]};
                const LAS f32x4* rp = (const LAS f32x4*)(rope + pos * 32 + ((4 * l16) & 31));
                const f32x4 c01 = rp[0], c23 = rp[1];
                const float cs[4] = {c01[0], c01[2], c23[0], c23[2]}, sn[4] = {c01[1], c01[3], c23[1], c23[3]};
#pragma unroll
                for (int pp = 0; pp < 4; ++pp) {
                    const float x0 = y[2 * pp], x1 = y[2 * pp + 1];
                    y[2 * pp] = x0 * cs[pp] - x1 * sn[pp]; y[2 * pp + 1] = x0 * sn[pp] + x1 * cs[pp];
                }
                a = (f32x4){y[0], y[1], y[2], y[3]}; b = (f32x4){y[4], y[5], y[6], y[7]};
            }
            st_bf16x8(pq[k], a, b);
        }
    }
}

DI void attn_layer(const Args& A, LAS unsigned char* lds, char* lds_gen, const XcdBarrier& gbar, int layer, int wv) {
    unsigned char* ws = A.ws;
    const bf16_t* H = (const bf16_t*)(ws + WS_H); bf16_t* U = (bf16_t*)(ws + WS_H);
    bf16_t* Q = (bf16_t*)(ws + WS_SCR + A_Q); bf16_t* Kb = (bf16_t*)(ws + WS_SCR + A_K); bf16_t* Vb = (bf16_t*)(ws + WS_SCR + A_V); bf16_t* SZ = (bf16_t*)(ws + WS_SCR + A_SZ);
    norm_phase(A, layer, false, wv);
    xcd_barrier(gbar, wv);
    {
        DescPlain D; D.init(H, (const bf16_t*)(ws + WS_WAI), 20, false);
        auto E = [=](const pg8::Unit& u, int row_l, int col_l, f32x4 v0, f32x4 v1) {
            const size_t row = (size_t)u.i0 * 256 + row_l; const int pn = u.i1;
            if (pn < 8) st_bf16x8(Q + row * 2048 + pn * 256 + col_l, v0, v1);
            else if (pn < 10) st_bf16x8(Kb + row * 512 + (pn - 8) * 256 + col_l, v0, v1);
            else if (pn < 12) st_bf16x8(Vb + row * 512 + (pn - 10) * 256 + col_l, v0, v1);
            else { f32x4 a, b;
#pragma unroll
                for (int q = 0; q < 4; ++q) { a[q] = siluf(v0[q]); b[q] = siluf(v1[q]); }
                st_bf16x8(SZ + row * 2048 + (pn - 12) * 256 + col_l, a, b); }
        };
        pg8::gemm_phase(lds, D, E, wv);
    }
    xcd_barrier(gbar, wv);
    qknorm_phase(A, lds, wv);
    xcd_barrier(gbar, wv);
    {
        const int G = gridDim.x, c = blockIdx.x;
        { f32x2* rope = (f32x2*)(lds_gen + 81920); const int tid = otid(wv);
          for (int e = tid; e < 2048; e += NTHREADS) { const float ang = (float)(e >> 5) * exp2f(-(float)(e & 31) * 0.41524101186092029f); rope[e] = (f32x2){cosf(ang), sinf(ang)}; }
          __syncthreads(); }
        const float* qn = A.in[14];
        for (long L = c; L < 2048; L += G) {
            const int u = pg8::xcd_remap((int)L, 2048);
            const int b = u / 128, rem = u % 128, kvh = rem / 32, g = (rem / 8) % 4, qb = rem % 8, h = kvh * 4 + g;
            const size_t qoff = ((size_t)b * TB + qb * 256) * 2048 + h * 128, koff = ((size_t)b * TB) * 512 + kvh * 128;
            att::attn_dense_body(Q + qoff, Kb + koff, Vb + koff, SZ + qoff, U + qoff, TB, lds_gen, wv, qn, qb * 256);
        }
        for (int u = c; u < 256; u += G) {
            const int b = u / 16, h = u % 16, kvh = h / 4;
            const size_t qoff = ((size_t)b * TB + TL) * 2048 + h * 128, koff = ((size_t)b * TB + TL) * 512 + kvh * 128;
            att::attn_dense_body(Q + qoff, Kb + koff, Vb + koff, SZ + qoff, U + qoff, TC, lds_gen, wv, qn, -1);
        }
    }
    xcd_barrier(gbar, wv);
    {
        DescPlain D; D.init(U, (const bf16_t*)(ws + WS_WAO), 8, false);
        EpiResid E; E.init(A, layer);
        pg8::gemm_phase(lds, D, E, wv);
    }
    xcd_barrier(gbar, wv);
}


struct DescM1 {
    static constexpr bool RAW = false;
    const bf16_t* H; const bf16_t* WA; const bf16_t* WB; int lda, ldb, K, total;
    DI void init(const bf16_t* H_, const bf16_t* WA_, const bf16_t* WB_) { H = H_; WA = WA_; WB = WB_; lda = DM; ldb = DM; K = DM; total = 144 * 9 + 8 * 144; }
    DI pg8::Unit unit(int idx) const {
        pg8::Unit u;
        if (idx < 1296) { const int nig = 72, gid = idx / nig, pm = gid * 8 + (idx % nig) % 8, pn = (idx % nig) / 8;
            u.a = (const char*)(H + (size_t)pm * 256 * DM); u.b = (const char*)(WA + (size_t)pn * 256 * DM); u.i0 = pm; u.i1 = pn; u.i2 = 0; }
        else { const int j = idx - 1296, mt = j % 8, nt = j / 8;
            u.a = (const char*)(WB + (size_t)mt * 256 * DM); u.b = (const char*)(H + (size_t)nt * 256 * DM); u.i0 = mt; u.i1 = nt; u.i2 = 1; }
        return u;
    }
};
namespace ml {
#define MFMA32(a, b, c) __builtin_amdgcn_mfma_f32_32x32x16_bf16((a), (b), (c), 0, 0, 0)
#define LFENCE() asm volatile("s_waitcnt lgkmcnt(0)" ::: "memory")
DI float dot2_bf16(unsigned a, unsigned b, float c) { asm("v_dot2c_f32_bf16 %0, %1, %2" : "+v"(c) : "v"(a), "v"(b)); return c; }
#define DOT2(a, b, c) dot2_bf16((a), (b), (c))
DI int crow(int reg, int h) { return (reg & 3) + 8 * (reg >> 2) + 4 * h; }
DI bf16x8 ldperm(const bf16_t* p) { const s16x4 lo = *(const s16x4*)p, hi = *(const s16x4*)(p + 8); return __builtin_shufflevector(lo, hi, 0, 1, 2, 3, 4, 5, 6, 7); }
DI bf16x8 pack_step(const f32x16& x, int s) { u32x4 p = {pk2(x[8 * s], x[8 * s + 1]), pk2(x[8 * s + 2], x[8 * s + 3]), pk2(x[8 * s + 4], x[8 * s + 5]), pk2(x[8 * s + 6], x[8 * s + 7])}; return __builtin_bit_cast(bf16x8, p); }
DI float bfs(short h) { return __uint_as_float(((unsigned)(unsigned short)h) << 16); }

constexpr int SC_Q = 0, SC_K = 16384, SC_KT = 32768, SC_BUF = 49152, SC_WAVE = 2 * SC_BUF, SC_WAVE_BYTES = 6656;
DI bf16x8 ldsfrag(const LAS unsigned char* buf, unsigned o) { const s16x4 lo = *(const LAS s16x4*)(buf + o), hi = *(const LAS s16x4*)(buf + (o ^ 16u)); return __builtin_shufflevector(lo, hi, 0, 1, 2, 3, 4, 5, 6, 7); }
DI void scan_phase(const Args& A, LAS unsigned char* lds, int wv) {
    const int wave = wv;
    LAS float* wl = (LAS float*)(lds + SC_WAVE + wave * SC_WAVE_BYTES);
    LAS unsigned* nbp = (LAS unsigned*)(lds + SC_WAVE + wave * SC_WAVE_BYTES + 2048);
    LAS unsigned* wbp = nbp + 64;
    LAS unsigned char* hst = lds + SC_WAVE + wave * SC_WAVE_BYTES + 2560;
    unsigned char* ws = A.ws;
    const bf16_t* Qg = (const bf16_t*)(ws + WS_SCR + M_Q); const bf16_t* Kg = (const bf16_t*)(ws + WS_SCR + M_K); const bf16_t* KVT = (const bf16_t*)(ws + WS_SCR + M_KVT);
    const float* G32 = (const float*)(ws + WS_SCR + M_G32); const float* bg = A.in[10];
#define SC_POS0(j) (dir == 0 ? ((j) < 4 ? TL + 64 * (j) : 64 * ((j) - 4)) : ((j) < 4 ? TL + 64 * (3 - (j)) : 64 * (35 - (j))))
#define SC_DMA(bufi, p0) do { const int tj_ = otid(wv); _Pragma("unroll") for (int i_ = 0; i_ < 2; ++i_) { const int sl_ = i_ * 512 + tj_; \
        { const int row_ = sl_ >> 4, c_ = (sl_ & 15) ^ (row_ & 15); const size_t go_ = (size_t)((p0) + row_) * 1024 + c_ * 8; \
          __builtin_amdgcn_global_load_lds((const unsigned*)(Qu + go_), (LAS unsigned*)(lds + (bufi) * SC_BUF + SC_Q + i_ * 8192 + wave * 1024), 16, 0, 0); \
          __builtin_amdgcn_global_load_lds((const unsigned*)(Ku + go_), (LAS unsigned*)(lds + (bufi) * SC_BUF + SC_K + i_ * 8192 + wave * 1024), 16, 0, 0); } \
        { const int d_ = sl_ >> 3, c_ = (sl_ & 7) ^ ((d_ >> 1) & 7); \
          __builtin_amdgcn_global_load_lds((const unsigned*)(KTu + (size_t)d_ * TB + (p0) + c_ * 8), (LAS unsigned*)(lds + (bufi) * SC_BUF + SC_KT + i_ * 8192 + wave * 1024), 16, 0, 0); } } } while (0)
    for (int item = blockIdx.x; item < 256; item += gridDim.x) {
        const int dir = item & 1, h = (item >> 1) & 7, b = item >> 4, e0 = wave * 32;
        const bf16_t* Qu = Qg + (size_t)b * TB * 1024 + h * 128;
        const bf16_t* Ku = Kg + (size_t)b * TB * 1024 + h * 128;
        const bf16_t* KTu = KVT + ((size_t)b * 3072 + h * 128) * TB;
        const bf16_t* VTu = KVT + ((size_t)b * 3072 + 1024 + h * 256 + e0) * TB;
        bf16_t* Hout = (bf16_t*)(ws + WS_SCR + (dir ? M_HB : M_HF)) + (size_t)b * TB * DM + h * 256 + e0;
        const float big = bg[(dir * 2) * 8 + h], bfg = bg[(dir * 2 + 1) * 8 + h];
        f32x16 cacc[4];
#pragma unroll
        for (int d = 0; d < 4; ++d)
#pragma unroll
            for (int i = 0; i < 16; ++i) cacc[d][i] = 0.f;
        float m = 0.f;
        { const int l0 = otid(wv) & 63; wl[384 + l0] = 0.f; wl[448 + l0] = 0.f; nbp[l0] = 0u; }
        LFENCE();
        SC_DMA(0, SC_POS0(0));
        float ig_n, fg_n;
        { const int l0 = otid(wv) & 63; const float* gp = G32 + (size_t)(b * TB + SC_POS0(0) + (dir ? 63 - l0 : l0)) * 32 + (dir * 2) * 8 + h; ig_n = gp[0]; fg_n = gp[8]; }
        for (int j = 0; j < 36; ++j) {
            const int pos0 = SC_POS0(j);
            const LAS unsigned char* Qb = lds + (j & 1) * SC_BUF + SC_Q; const LAS unsigned char* Kb = lds + (j & 1) * SC_BUF + SC_K; const LAS unsigned char* KTb = lds + (j & 1) * SC_BUF + SC_KT;
            asm volatile("s_waitcnt vmcnt(0)" ::: "memory"); __builtin_amdgcn_s_barrier(); asm volatile("" ::: "memory");
            if (j + 1 < 36) SC_DMA((j + 1) & 1, SC_POS0(j + 1));
            const int lj = otid(wv) & 63, rj = lj & 31, h4 = (lj >> 5) * 4;
            LAS float* wh = wl + h4; LAS float* wr = wl + rj; LAS unsigned char* hb = hst + h4 * 64 + rj * 2;
            const LAS unsigned* nbh = nbp + (h4 >> 1); const LAS unsigned* wbh = wbp + (h4 >> 1);
            const unsigned xr = rj & 15, xd = (rj >> 1) & 7;
            const unsigned qro = (unsigned)rj * 256u + 2u * h4;
            const unsigned kro = (unsigned)rj * 128u + 2u * h4;
            const bf16_t* VTp = VTu + (size_t)rj * TB + pos0 + h4;
            bf16x8 vf[4];
#pragma unroll
            for (int kk = 0; kk < 4; ++kk) vf[kk] = ldperm(VTp + 16 * kk);
            float decay, m_new;
            {
                const int s = dir ? 63 - lj : lj;
                const float ig = ig_n + big, fg = fg_n + bfg;
                if (j + 1 < 36) { const float* gp = G32 + (size_t)(b * TB + SC_POS0(j + 1) + s) * 32 + (dir * 2) * 8 + h; ig_n = gp[0]; fg_n = gp[8]; }
                const float lf = fminf(fg, 0.f) - log1pf(__expf(-fabsf(fg)));
                float bs = lf;
#pragma unroll
                for (int o = 1; o < 64; o <<= 1) { const float t = __shfl_up(bs, o); if (lj >= o) bs += t; }
                const float uu = ig - bs;
                float pmx = uu;
#pragma unroll
                for (int o = 1; o < 64; o <<= 1) { const float t = __shfl_up(pmx, o); if (lj >= o) pmx = fmaxf(pmx, t); }
                pmx = fmaxf(pmx, m);
                const float b_end = __shfl(bs, 63), pm_last = __shfl(pmx, 63);
                LAS float* ws_ = wl + s;
                ws_[0] = uu * 1.4426950408889634f; ws_[64] = pmx * 1.4426950408889634f; ws_[128] = __expf(m - pmx); ws_[192] = __expf(-(bs + pmx)); ws_[256] = __expf(uu - pm_last);
                { const float wv_ = __expf(uu - pm_last), wp_ = __shfl_xor(wv_, 1); if ((s & 1) == 0) wbp[s >> 1] = pk2(wv_, wp_); }
                decay = __expf(m - pm_last); m_new = b_end + pm_last;
            }
            LFENCE();
            const int sbase = dir ? 63 - h4 : h4, sgn = dir ? -1 : 1;
#pragma unroll
            for (int tb = 0; tb < 2; ++tb) {
                __builtin_amdgcn_sched_barrier(0);
                const unsigned qo = qro + tb * 8192u;
                f32x16 ha;
#pragma unroll
                for (int i = 0; i < 16; ++i) ha[i] = 0.f;
                float qnv = 0.f;
#pragma unroll
                for (int kk = 0; kk < 8; ++kk) {
                    const bf16x8 qa = ldsfrag(Qb, qo + (((2u * kk) ^ xr) << 4));
                    ha = MFMA32(qa, pack_step(cacc[kk >> 1], kk & 1), ha);
                    { const u32x2 nb0 = *(const LAS u32x2*)(nbh + 8 * kk), nb1 = *(const LAS u32x2*)(nbh + 8 * kk + 4); const u32x4 qw = __builtin_bit_cast(u32x4, qa);
                      qnv = DOT2(qw.x, nb0.x, qnv); qnv = DOT2(qw.y, nb0.y, qnv); qnv = DOT2(qw.z, nb1.x, qnv); qnv = DOT2(qw.w, nb1.y, qnv); }
                }
                qnv += __shfl_xor(qnv, 32);
#pragma unroll
                for (int g = 0; g < 4; ++g) { const f32x4 av = *(const LAS f32x4*)(wh + 128 + 32 * tb + 8 * g);
#pragma unroll
                    for (int q = 0; q < 4; ++q) ha[4 * g + q] *= av[q]; }
                const float pmt = wr[64 + 32 * tb];
                const int tp = dir ? (63 - 32 * tb) - rj : 32 * tb + rj;
                float ds = 0.f;
#pragma unroll
                for (int sb = 0; sb < 2; ++sb) {
                    __builtin_amdgcn_sched_barrier(0);
                    if (sb != tb && (dir ? sb < tb : sb > tb)) continue;
                    const unsigned ko = qro + sb * 8192u;
                    f32x16 st;
#pragma unroll
                    for (int i = 0; i < 16; ++i) st[i] = 0.f;
#pragma unroll
                    for (int kk = 0; kk < 8; ++kk) { const unsigned c = ((2u * kk) ^ xr) << 4; st = MFMA32(ldsfrag(Kb, ko + c), ldsfrag(Qb, qo + c), st); }
#pragma unroll
                    for (int g = 0; g < 4; ++g) { const f32x4 uv = *(const LAS f32x4*)(wh + 32 * sb + 8 * g);
#pragma unroll
                        for (int q = 0; q < 4; ++q) {
                            const int sc = 32 * sb + q + 8 * g;
                            const int sp = sbase + sgn * sc;
                            st[4 * g + q] *= __builtin_amdgcn_exp2f((sp <= tp) ? uv[q] - pmt : -1e30f);
                            ds += st[4 * g + q];
                        } }
                    ha = MFMA32(pack_step(st, 0), vf[2 * sb], ha);
                    ha = MFMA32(pack_step(st, 1), vf[2 * sb + 1], ha);
                }
                ds += __shfl_xor(ds, 32);
                {
                    const float den = wr[128 + 32 * tb] * qnv + ds;
                    const float rd = 1.0f / fmaxf(fabsf(den), wr[192 + 32 * tb]);
                    if (h4 == 0) wr[320 + 32 * tb] = rd;
                }
                LFENCE();
#pragma unroll
                for (int g = 0; g < 4; ++g) { const f32x4 rv = *(const LAS f32x4*)(wh + 320 + 32 * tb + 8 * g);
#pragma unroll
                    for (int q = 0; q < 4; ++q) { const int tc = 32 * tb + q + 8 * g;
                        *(LAS unsigned short*)(hb + tc * 64) = (unsigned short)(pk2(ha[4 * g + q] * rv[q], 0.f) & 0xffffu); } }
            }
            LFENCE();
            {
                bf16_t* hp = Hout + (size_t)(pos0 + lj) * DM;
                const LAS unsigned char* hrow = hst + lj * 64;
#pragma unroll
                for (int q = 0; q < 4; ++q) *(u32x4*)(hp + 8 * q) = *(const LAS u32x4*)(hrow + 16 * q);
            }
            __builtin_amdgcn_sched_barrier(0);
            bf16x8 vfw[4];
#pragma unroll
            for (int kk = 0; kk < 4; ++kk) {
                const f32x4 w0 = *(const LAS f32x4*)(wh + 256 + 16 * kk), w1 = *(const LAS f32x4*)(wh + 256 + 16 * kk + 8);
                u32x4 p = {pk2(bfs(vf[kk][0]) * w0[0], bfs(vf[kk][1]) * w0[1]), pk2(bfs(vf[kk][2]) * w0[2], bfs(vf[kk][3]) * w0[3]),
                           pk2(bfs(vf[kk][4]) * w1[0], bfs(vf[kk][5]) * w1[1]), pk2(bfs(vf[kk][6]) * w1[2], bfs(vf[kk][7]) * w1[3])};
                vfw[kk] = __builtin_bit_cast(bf16x8, p);
            }
#pragma unroll
            for (int db = 0; db < 4; ++db) {
#pragma unroll
                for (int i = 0; i < 16; ++i) cacc[db][i] *= decay;
                const unsigned to = kro + db * 4096u;
                float nadd = 0.f;
#pragma unroll
                for (int kk = 0; kk < 4; ++kk) {
                    const bf16x8 kv = ldsfrag(KTb, to + (((2u * kk) ^ xd) << 4));
                    const u32x2 wq0 = *(const LAS u32x2*)(wbh + 8 * kk), wq1 = *(const LAS u32x2*)(wbh + 8 * kk + 4); const u32x4 kw = __builtin_bit_cast(u32x4, kv);
                    nadd = DOT2(kw.x, wq0.x, nadd); nadd = DOT2(kw.y, wq0.y, nadd); nadd = DOT2(kw.z, wq1.x, nadd); nadd = DOT2(kw.w, wq1.y, nadd);
                    cacc[db] = MFMA32(kv, vfw[kk], cacc[db]);
                }
                nadd += __shfl_xor(nadd, 32);
                const float nnew = decay * wr[384 + 32 * db] + nadd, npart = __shfl_xor(nnew, 1);
                if (h4 == 0) { wr[384 + 32 * db] = nnew; if ((rj & 1) == 0) nbp[(32 * db + rj) >> 1] = pk2(nnew, npart); }
            }
            LFENCE();
            m = m_new;
        }
        asm volatile("s_waitcnt vmcnt(0)" ::: "memory"); __builtin_amdgcn_s_barrier();
    }
#undef SC_DMA
#undef SC_POS0
}
#undef MFMA32
#undef LFENCE
#undef DOT2
}

DI void mlstm_finish_phase(const Args& A, int wv) {
    const int tid = otid(wv), lane = tid & 63, wave = tid >> 6, G = gridDim.x;
    unsigned char* ws = A.ws;
    const bf16_t* HF = (const bf16_t*)(ws + WS_SCR + M_HF); const bf16_t* HB = (const bf16_t*)(ws + WS_SCR + M_HB);
    const bf16_t* SO = (const bf16_t*)(ws + WS_SCR + M_SO); const bf16_t* SZ = (const bf16_t*)(ws + WS_SCR + M_SZ);
    bf16_t* U = (bf16_t*)(ws + WS_H); const float* hn = A.in[11];
    const int sub = lane >> 5, e0 = (lane & 31) * 8;
    const long NIT = (long)NTOK * 8;
    for (long it0 = ((long)blockIdx.x * NWAVES + wave) * 4 + sub; it0 < NIT; it0 += (long)G * NWAVES * 4) {
        f32x4 f0[2], f1[2], b0[2], b1[2], o0[2], o1[2], z0[2], z1[2];
#pragma unroll
        for (int k = 0; k < 2; ++k) { const long it = it0 + 2 * k; const size_t off = (size_t)(it >> 3) * DM + (int)(it & 7) * 256 + e0;
            ld_bf16x8(HF + off, f0[k], f1[k]); ld_bf16x8(HB + off, b0[k], b1[k]); ld_bf16x8(SO + off, o0[k], o1[k]); ld_bf16x8(SZ + off, z0[k], z1[k]); }
#pragma unroll
        for (int k = 0; k < 2; ++k) { const long it = it0 + 2 * k; const size_t off = (size_t)(it >> 3) * DM + (int)(it & 7) * 256 + e0;
            f32x4 y0 = o0[k] * (f0[k] + b0[k]), y1 = o1[k] * (f1[k] + b1[k]);
            float ss = 0.f;
#pragma unroll
            for (int q = 0; q < 4; ++q) ss += y0[q] * y0[q] + y1[q] * y1[q];
            ss += __shfl_xor(ss, 1); ss += __shfl_xor(ss, 2); ss += __shfl_xor(ss, 4); ss += __shfl_xor(ss, 8); ss += __shfl_xor(ss, 16);
            const float rs = 1.0f / sqrtf(ss * (1.f / 256.f) + EPS);
            const float* hp = hn + (int)(it & 7) * 256 + e0;
            const f32x4 h0 = *(const f32x4*)hp, h1 = *(const f32x4*)(hp + 4);
            st_bf16x8(U + off, y0 * rs * h0 * z0[k], y1 * rs * h1 * z1[k]); }
    }
}

DI void mlstm_layer(const Args& A, LAS unsigned char* lds, const XcdBarrier& gbar, int layer, int wv) {
    unsigned char* ws = A.ws;
    const bf16_t* H = (const bf16_t*)(ws + WS_H); bf16_t* U = (bf16_t*)(ws + WS_H);
    bf16_t* Q = (bf16_t*)(ws + WS_SCR + M_Q); bf16_t* Kb = (bf16_t*)(ws + WS_SCR + M_K); bf16_t* KVT = (bf16_t*)(ws + WS_SCR + M_KVT);
    float* G32 = (float*)(ws + WS_SCR + M_G32); bf16_t* SO = (bf16_t*)(ws + WS_SCR + M_SO); bf16_t* SZ = (bf16_t*)(ws + WS_SCR + M_SZ);
    norm_phase(A, layer, false, wv);
    xcd_barrier(gbar, wv);
    {
        DescM1 D; D.init(H, (const bf16_t*)(ws + WS_WMA), (const bf16_t*)(ws + WS_WMB));
        auto E = [=](const pg8::Unit& u, int row_l, int col_l, f32x4 v0, f32x4 v1) {
            if (u.i2 == 0) {
                const size_t row = (size_t)u.i0 * 256 + row_l; const int pn = u.i1;
                if (pn < 4) st_bf16x8(Q + row * 1024 + pn * 256 + col_l, v0 * 0.088388347648318440f, v1 * 0.088388347648318440f);
                else if (pn < 8) { st_bf16x8(Kb + row * 1024 + (pn - 4) * 256 + col_l, v0, v1);
                    const int bb = u.i0 / 9, sp = (u.i0 % 9) * 256 + row_l;
                    bf16_t* kt = KVT + ((size_t)bb * 3072 + (pn - 4) * 256 + col_l) * TB + sp;
                    const unsigned w0 = pk2(v0[0], v0[1]), w1 = pk2(v0[2], v0[3]), w2 = pk2(v1[0], v1[1]), w3 = pk2(v1[2], v1[3]);
                    kt[0] = (bf16_t)(w0 & 0xffffu); kt[TB] = (bf16_t)(w0 >> 16); kt[2 * TB] = (bf16_t)(w1 & 0xffffu); kt[3 * TB] = (bf16_t)(w1 >> 16);
                    kt[4 * TB] = (bf16_t)(w2 & 0xffffu); kt[5 * TB] = (bf16_t)(w2 >> 16); kt[6 * TB] = (bf16_t)(w3 & 0xffffu); kt[7 * TB] = (bf16_t)(w3 >> 16); }
                else if (col_l < 32) { *(f32x4*)(G32 + row * 32 + col_l) = v0; *(f32x4*)(G32 + row * 32 + col_l + 4) = v1; }
            } else {
                const int bb = u.i1 / 9, s0 = (u.i1 % 9) * 256;
                st_bf16x8(KVT + ((size_t)bb * 3072 + 1024 + u.i0 * 256 + row_l) * TB + s0 + col_l, v0, v1);
            }
        };
        pg8::gemm_phase(lds, D, E, wv);
    }
    xcd_barrier(gbar, wv);
    ml::scan_phase(A, lds, wv);
    xcd_barrier(gbar, wv);
    {
        DescPlain D; D.init(H, (const bf16_t*)(ws + WS_WMA) + (size_t)2304 * DM, 16, false);
        auto E = [=](const pg8::Unit& u, int row_l, int col_l, f32x4 v0, f32x4 v1) {
            const size_t row = (size_t)u.i0 * 256 + row_l; const int pn = u.i1; f32x4 a, b;
            if (pn < 8) {
#pragma unroll
                for (int q = 0; q < 4; ++q) { a[q] = sigmf(v0[q]); b[q] = sigmf(v1[q]); }
                st_bf16x8(SO + row * DM + pn * 256 + col_l, a, b);
            } else {
#pragma unroll
                for (int q = 0; q < 4; ++q) { a[q] = siluf(v0[q]); b[q] = siluf(v1[q]); }
                st_bf16x8(SZ + row * DM + (pn - 8) * 256 + col_l, a, b);
            }
        };
        pg8::gemm_phase(lds, D, E, wv);
    }
    xcd_barrier(gbar, wv);
    mlstm_finish_phase(A, wv);
    xcd_barrier(gbar, wv);
    {
        DescPlain D; D.init(U, (const bf16_t*)(ws + WS_WMO), 8, false);
        EpiResid E; E.init(A, layer);
        pg8::gemm_phase(lds, D, E, wv);
    }
    xcd_barrier(gbar, wv);
}

__global__ void __launch_bounds__(NTHREADS, 2) fwd_megakernel(Args A) {
    extern __shared__ __attribute__((aligned(16))) unsigned char lds_raw[];
    LAS unsigned char* lds = (LAS unsigned char*)lds_raw;
    cg::grid_group grid = cg::this_grid();
    const int wv = __builtin_amdgcn_readfirstlane(threadIdx.x >> 6);
    volatile LAS unsigned* bst = (volatile LAS unsigned*)(lds + 152576);
    if (otid(wv) < 2) bst[otid(wv)] = 0u;
    __syncthreads();
    const XcdBarrier gbar = xcd_barrier_post((unsigned*)(A.ws + WS_BAR), bst, wv);
    prep_phase(A, lds, wv);
    grid.sync();
    {
        const long long* mi = (const long long*)(A.ws + WS_MODI); float* mf = (float*)(A.ws + WS_MOD);
        for (int i = blockIdx.x * NTHREADS + otid(wv); i < 4 * 17 * MOD_LD; i += gridDim.x * NTHREADS) mf[i] = (float)mi[i] * MODI_INV;
    }
    xcd_barrier(gbar, wv);
    fnet_layer(A, lds, gbar, 0, 0, false, wv);
    mlstm_layer(A, lds, gbar, 1, wv);
    attn_layer(A, lds, (char*)lds_raw, gbar, 2, wv);
    fnet_layer(A, lds, gbar, 3, 1, true, wv);
    final_norm_phase(A, (const bf16_t*)(A.ws + WS_SCR + F_PQX), wv);
}

extern "C" void kernel_launch(void* const* d_in, const int* in_sizes, int n_in, void* d_out, int out_size, void* d_ws, size_t ws_size, hipStream_t stream) {
    static int grid = 0;
    if (grid == 0) {
        if (n_in != 18 || ws_size < WS_END) { fprintf(stderr, "kernel_launch: unexpected n_in %d / ws_size %zu (need %zu)\n", n_in, ws_size, (size_t)WS_END); grid = -1; return; }
        int dev = 0, cus = 0, per_cu = 0;
        hipGetDevice(&dev);
        hipDeviceGetAttribute(&cus, hipDeviceAttributeMultiprocessorCount, dev);
        if (hipFuncSetAttribute((const void*)fwd_megakernel, hipFuncAttributeMaxDynamicSharedMemorySize, LDS_BYTES) != hipSuccess) { fprintf(stderr, "kernel_launch: hipFuncSetAttribute failed\n"); grid = -1; return; }
        if (hipOccupancyMaxActiveBlocksPerMultiprocessor(&per_cu, (const void*)fwd_megakernel, NTHREADS, LDS_BYTES) != hipSuccess || per_cu < 1) { fprintf(stderr, "kernel_launch: occupancy query failed (%d)\n", per_cu); per_cu = 1; }
        (void)hipGetLastError();
        grid = cus * per_cu;
        fprintf(stderr, "kernel_launch: grid %d (cus %d x %d)\n", grid, cus, per_cu);
    }
    if (grid < 0) return;
    (void)hipMemsetAsync((char*)d_ws + WS_MOD, 0, ZERO_BYTES, stream);
    (void)hipMemsetAsync((char*)d_ws + WS_MODI, 0, MODI_BYTES, stream);
    Args a{};
    for (int i = 0; i < 18; ++i) a.in[i] = (const float*)d_in[i];
    a.out = (float*)d_out; a.ws = (unsigned char*)d_ws; a.ph_lo = 0; a.ph_hi = 100;
    void* args[] = {&a};
    hipError_t e = hipLaunchCooperativeKernel((const void*)fwd_megakernel, dim3(grid), dim3(NTHREADS), args, LDS_BYTES, stream);
    if (e != hipSuccess) fprintf(stderr, "kernel_launch: cooperative launch failed: %s (grid %d)\n", hipGetErrorString(e), grid);
}
```

```cpp
#include <hip/hip_runtime.h>
#include <hip/hip_cooperative_groups.h>
#include <cstdio>
#include <cstdint>
#include <type_traits>
namespace cg = cooperative_groups;

#define LAS __attribute__((address_space(3)))
#define DI __device__ __forceinline__
typedef unsigned short bf16_t;
typedef short bf16x8 __attribute__((ext_vector_type(8)));
typedef short s16x4 __attribute__((ext_vector_type(4)));
typedef float f32x2 __attribute__((ext_vector_type(2)));
typedef float f32x4 __attribute__((ext_vector_type(4)));
typedef float f32x16 __attribute__((ext_vector_type(16)));
typedef unsigned u32x2 __attribute__((ext_vector_type(2)));
typedef unsigned u32x4 __attribute__((ext_vector_type(4)));
typedef __bf16 bf16v2 __attribute__((ext_vector_type(2)));

constexpr int DM = 2048, NB = 16, TL = 2048, TC = 256, TB = TL + TC, NTOK = NB * TB;
constexpr int NWAVES = 8, NTHREADS = 512;
constexpr float EPS = 1e-6f;
constexpr int MOD_LD = 3 * DM;
constexpr int M_WA_ROWS = 6400, M_WB_ROWS = 3072;
constexpr size_t MiB = 1u << 20;
constexpr size_t WS_SCR_ = 301 * MiB;
constexpr size_t WS_MOD = 0;
constexpr size_t MOD_BYTES = (size_t)4 * 17 * MOD_LD * 4;
constexpr size_t WS_BAR = 1792 * 1024, ZERO_BYTES = 2 * MiB;
constexpr size_t WS_MODI = WS_SCR_ + 700 * MiB, MODI_BYTES = (size_t)4 * 17 * MOD_LD * 8;
constexpr float MODI_SCALE = 1073741824.f, MODI_INV = 9.313225746154785e-10f;
constexpr size_t WS_WFG = 2 * MiB, WS_WFO = 18 * MiB, WS_WMA = 34 * MiB, WS_WMB = 59 * MiB, WS_WMO = 71 * MiB, WS_WAI = 79 * MiB, WS_WAO = 99 * MiB;
constexpr size_t WS_DC = 107 * MiB, WS_DT = 108 * MiB, WS_DT2 = 124 * MiB, WS_CTXS = 125 * MiB, WS_H = 157 * MiB, WS_SCR = 301 * MiB;
constexpr size_t WS_END = 1024 * MiB;
constexpr size_t F_G = 0, F_PQX = 144 * MiB, F_PQC = 400 * MiB, F_A1 = 432 * MiB;
constexpr size_t M_Q = 0, M_K = 72 * MiB, M_KVT = 144 * MiB, M_G32 = 360 * MiB, M_HF = 365 * MiB, M_HB = 509 * MiB, M_SO = 0, M_SZ = 144 * MiB;
constexpr size_t A_Q = 0, A_K = 144 * MiB, A_V = 180 * MiB, A_SZ = 216 * MiB;
static_assert(WS_SCR + M_HB + 144 * MiB <= WS_END, "ws map");
constexpr int LDS_BYTES = 152576 + 1024;

DI unsigned pk2(float a, float b) { f32x2 v = {a, b}; return __builtin_bit_cast(unsigned, __builtin_convertvector(v, bf16v2)); }
DI float bf_lo(unsigned w) { return __uint_as_float(w << 16); }
DI float bf_hi(unsigned w) { return __uint_as_float(w & 0xffff0000u); }
DI float wave_sum(float v) {
#pragma unroll
    for (int o = 1; o < 64; o <<= 1) v += __shfl_xor(v, o);
    return v;
}
DI int otid(int wv) { int t; asm volatile("v_mbcnt_lo_u32_b32 %0, -1, 0\n\tv_mbcnt_hi_u32_b32 %0, -1, %0" : "=v"(t)); return wv * 64 + t; }
DI float dot2g(unsigned a, unsigned b, float c) { asm("v_dot2c_f32_bf16 %0, %1, %2" : "+v"(c) : "v"(a), "v"(b)); return c; }
DI float siluf(float x) { return x * __builtin_amdgcn_rcpf(1.f + __expf(-x)); }
DI float sigmf(float x) { return __builtin_amdgcn_rcpf(1.f + __expf(-x)); }
DI void st_bf16x8(bf16_t* p, f32x4 a, f32x4 b) { u32x4 w = {pk2(a[0], a[1]), pk2(a[2], a[3]), pk2(b[0], b[1]), pk2(b[2], b[3])}; *(u32x4*)p = w; }
DI void ld_bf16x8(const bf16_t* p, f32x4& a, f32x4& b) { const u32x4 w = *(const u32x4*)p; a = (f32x4){bf_lo(w.x), bf_hi(w.x), bf_lo(w.y), bf_hi(w.y)}; b = (f32x4){bf_lo(w.z), bf_hi(w.z), bf_lo(w.w), bf_hi(w.w)}; }

DI f32x4 ldmod4(const long long* p) { return (f32x4){(float)p[0] * MODI_INV, (float)p[1] * MODI_INV, (float)p[2] * MODI_INV, (float)p[3] * MODI_INV}; }

struct Args { const float* in[18]; float* out; unsigned char* ws; int ph_lo, ph_hi; };

#define XB_TMO      128
#define XB_XCNT(j)  (256  + 64 * (j))
#define XB_XSUB(j)  (1280 + 64 * (j))
#define XB_XGEN(j)  (2304 + 64 * (j))
#define XB_TOP      3328
#define XB_TOPGEN   3392
#define XCD_BAR_WORDS 3456
#define XB_SPIN_CAP (1u << 18)

__device__ __forceinline__ unsigned xb_ld(unsigned* p)              { return __hip_atomic_load(p, __ATOMIC_RELAXED, __HIP_MEMORY_SCOPE_AGENT); }
__device__ __forceinline__ unsigned xb_add(unsigned* p, unsigned v) { return __hip_atomic_fetch_add(p, v, __ATOMIC_RELAXED, __HIP_MEMORY_SCOPE_AGENT); }
__device__ __forceinline__ unsigned xb_xcc_id() { return (unsigned)__builtin_amdgcn_s_getreg((3 << 11) | 20) & 0xFu; }
#define XB_SPIN(cond, bar) do { unsigned _sp = 0; while (cond) { __builtin_amdgcn_s_sleep(1); \
    if ((++_sp & 255u) == 0u) { if (xb_ld(&(bar)[XB_TMO])) break; if (_sp > XB_SPIN_CAP) { atomicAdd(&(bar)[XB_TMO], 1u); break; } } } } while (0)

struct XcdBarrier {
    unsigned* bar; unsigned x;
    volatile LAS unsigned* st;
};

__device__ __forceinline__ XcdBarrier xcd_barrier_post(unsigned* bar, volatile LAS unsigned* st, int wv) {
    XcdBarrier b; b.bar = bar; b.x = xb_xcc_id(); b.st = st;
    if (otid(wv) == 0) (void)xb_add(&bar[XB_XCNT(b.x)], 1u);
    return b;
}
__device__ __forceinline__ void xcd_barrier_complete(unsigned* bar, unsigned x, unsigned& nloc, unsigned& nx) {
    const unsigned G = gridDim.x * gridDim.y * gridDim.z;
    unsigned sum, cnt, mine, sp = 0u;
    for (;;) {
        sum = 0u; cnt = 0u; mine = 0u;
#pragma unroll
        for (unsigned j = 0; j < 16; ++j) { const unsigned c = xb_ld(&bar[XB_XCNT(j)]); sum += c; cnt += (c > 0u) ? 1u : 0u; mine = (j == x) ? c : mine; }
        if (sum == G) break;
        __builtin_amdgcn_s_sleep(1);
        if ((++sp & 255u) == 0u) { if (xb_ld(&bar[XB_TMO])) break; if (sp > XB_SPIN_CAP) { atomicAdd(&bar[XB_TMO], 1u); break; } }
    }
    nloc = mine > 0u ? mine : 1u; nx = cnt > 0u ? cnt : 1u;
}

__device__ __forceinline__ void xcd_barrier(const XcdBarrier& b, int wv) {
    asm volatile("s_waitcnt vmcnt(0)" ::: "memory");
    __syncthreads();
    if (otid(wv) == 0) {
        unsigned* bar = b.bar;
        __builtin_amdgcn_s_waitcnt(0);
        unsigned nloc = b.st[0], nx = b.st[1];
        if (nloc == 0u) { xcd_barrier_complete(bar, b.x, nloc, nx); b.st[0] = nloc; b.st[1] = nx; }
        const unsigned old = xb_add(&bar[XB_XSUB(b.x)], 1u);
        const unsigned gen = old / nloc;
        if (old + 1u == (gen + 1u) * nloc) {
            __builtin_amdgcn_fence(__ATOMIC_RELEASE, "agent");
            asm volatile("s_waitcnt vmcnt(0)" ::: "memory");
            const unsigned og = xb_add(&bar[XB_TOP], 1u);
            const unsigned tg = og / nx;
            if (og + 1u == (tg + 1u) * nx) xb_add(&bar[XB_TOPGEN], 1u);
            else XB_SPIN(xb_ld(&bar[XB_TOPGEN]) == tg, bar);
            __builtin_amdgcn_fence(__ATOMIC_ACQUIRE, "agent");
            xb_add(&bar[XB_XGEN(b.x)], 1u);
            asm volatile("s_waitcnt vmcnt(0)" ::: "memory");
        } else {
            XB_SPIN(xb_ld(&bar[XB_XGEN(b.x)]) == gen, bar);
            __builtin_amdgcn_fence(__ATOMIC_ACQUIRE, "agent");
            asm volatile("s_waitcnt vmcnt(0)" ::: "memory");
        }
    }
    __syncthreads();
}


namespace pg8 {
constexpr int BM = 256, BK = 64, HALF = 128, HTB = HALF * BK * 2, NXCD = 8;
DI int lds_byte(int r, int c) { const int st = (r >> 4) * 2 + (c >> 5), rr = r & 15, cc = c & 31, ob = rr * 64 + cc * 2; return st * 1024 + (ob ^ (((ob >> 9) & 1) << 5)); }
DI void stage_rc(int b, int& R, int& C) { const int st = b / 1024, sb = b % 1024, swz = sb ^ (((sb >> 9) & 1) << 5); R = (st >> 1) * 16 + swz / 64; C = (st & 1) * 32 + (swz % 64) / 2; }
DI int perm32(int rho) { const int n = rho >> 4, i = rho & 15; return 8 * (i >> 2) + 4 * n + (i & 3); }
struct Unit { const char* a; const char* b; int i0, i1, i2; };
template <class T, class = void> struct is_whole_tile : std::false_type {};
template <class T> struct is_whole_tile<T, std::void_t<decltype(T::WHOLE_TILE)>> : std::true_type {};
DI int xcd_remap(int L, int total) { const int q = total / NXCD, r = total % NXCD, xcd = L % NXCD, off = L / NXCD; return (xcd < r ? xcd * (q + 1) : r * (q + 1) + (xcd - r) * q) + off; }

template <class Desc, class Epi>
DI void gemm_phase(LAS unsigned char* lds, const Desc& D, const Epi& E, int wv) {
    const int tid = otid(wv), wid = __builtin_amdgcn_readfirstlane(tid >> 6), lane = tid & 63, wr = wid >> 2, wc = wid & 3, fr = lane & 15, fq = lane >> 4;
    const int G = gridDim.x, c = blockIdx.x, total = D.total;
    const int K = D.K, nt = K / BK;
    unsigned voffA[2], voffB[2];
#pragma unroll
    for (int i = 0; i < 2; ++i) { int R, C; stage_rc(tid * 16 + i * 8192, R, C); const int Rb = (R & ~31) + perm32(R & 31);
        voffA[i] = (unsigned)(R * D.lda + C) * 2u; voffB[i] = (unsigned)(Rb * D.ldb + C) * 2u; }
    const size_t kstep = (size_t)(BK * 2);
    const size_t hstepA = (size_t)HALF * D.lda * 2, hstepB = (size_t)HALF * D.ldb * 2;
    const unsigned ldsw = (unsigned)wid * 1024u;
    const int aoff = lds_byte(wr * 64 + fr, fq * 8), boff = lds_byte(wc * 32 + fr, fq * 8);
#define PG8_SA(b, h) (((b) * 2 + (h)) * HTB)
#define PG8_SB(b, h) ((4 + (b) * 2 + (h)) * HTB)
#define PG8_STAGE(bufoff, gbase, voff) do { _Pragma("unroll") for (int _i = 0; _i < 2; ++_i) \
        __builtin_amdgcn_global_load_lds((const unsigned*)((const char*)(gbase) + (voff)[_i]), (LAS unsigned*)(lds + (bufoff) + ldsw + _i * 8192), 16, 0, 0); } while (0)
#define PG8_LDA(dst, b, h) do { _Pragma("unroll") for (int m = 0; m < 4; ++m) _Pragma("unroll") for (int k = 0; k < 2; ++k) dst[m][k] = *(const LAS bf16x8*)(lds + PG8_SA(b, h) + aoff + m * 2048 + k * 1024); } while (0)
#define PG8_LDB(dst, b, h) do { _Pragma("unroll") for (int n = 0; n < 2; ++n) _Pragma("unroll") for (int k = 0; k < 2; ++k) dst[n][k] = *(const LAS bf16x8*)(lds + PG8_SB(b, h) + boff + n * 2048 + k * 1024); } while (0)
#define PG8_MMA(ai, bj, At, Bt) do { __builtin_amdgcn_s_setprio(1); _Pragma("unroll") for (int m = 0; m < 4; ++m) _Pragma("unroll") for (int n = 0; n < 2; ++n) _Pragma("unroll") for (int k = 0; k < 2; ++k) \
        acc[ai][bj][m][n] = __builtin_amdgcn_mfma_f32_16x16x32_bf16(Bt[n][k], At[m][k], acc[ai][bj][m][n], 0, 0, 0); __builtin_amdgcn_s_setprio(0); } while (0)
#define PG8_WAIT_V(n) asm volatile("s_waitcnt vmcnt(" #n ")" ::: "memory")
#define PG8_WAIT_L(n) asm volatile("s_waitcnt lgkmcnt(" #n ")" ::: "memory")
#define PG8_BAR __builtin_amdgcn_s_barrier()
#define PG8_SCHED __builtin_amdgcn_sched_barrier(0)
    if constexpr (Desc::RAW) { if (!D.valid(c, G)) return; } else { if (c >= total) return; }
    Unit cur, nxt; int ui = 0;
    if constexpr (Desc::RAW) cur = D.unit(c, G); else cur = D.unit(xcd_remap(c, total));
    nxt = cur;
    f32x4 acc[2][2][4][2];
#pragma unroll
    for (int a = 0; a < 2; ++a)
#pragma unroll
        for (int b = 0; b < 2; ++b)
#pragma unroll
            for (int m = 0; m < 4; ++m)
#pragma unroll
                for (int n = 0; n < 2; ++n) acc[a][b][m][n] = (f32x4){0.f, 0.f, 0.f, 0.f};
    bf16x8 At[4][2], B0[2][2], B1[2][2];
    const char* cA = cur.a; const char* cB = cur.b;
    PG8_STAGE(PG8_SB(0, 0), cB, voffB); PG8_STAGE(PG8_SB(0, 1), cB + hstepB, voffB); PG8_STAGE(PG8_SA(0, 0), cA, voffA); PG8_STAGE(PG8_SA(0, 1), cA + hstepA, voffA);
    if (wr == 1) PG8_BAR;
    PG8_WAIT_V(2); PG8_BAR;
    PG8_STAGE(PG8_SB(1, 0), cB + kstep, voffB); PG8_STAGE(PG8_SA(1, 0), cA + kstep, voffA); PG8_STAGE(PG8_SB(1, 1), cB + hstepB + kstep, voffB);
    PG8_WAIT_V(6); PG8_BAR;
    for (;;) {
        const long Ln = (long)(ui + 1) * G + c;
        bool has_next;
        if constexpr (Desc::RAW) { has_next = D.valid((int)Ln, G); if (has_next) nxt = D.unit((int)Ln, G); }
        else { has_next = Ln < total; if (has_next) nxt = D.unit(xcd_remap((int)Ln, total)); }
        const char* nA = has_next ? nxt.a : cA; const char* nB = has_next ? nxt.b : cB;
        for (int t = 0; t < nt; t += 2) {
            const bool last = (t == nt - 2);
            const char* a1 = cA + (size_t)(t + 1) * kstep;
            const char* a2 = last ? nA : cA + (size_t)(t + 2) * kstep; const char* b2 = last ? nB : cB + (size_t)(t + 2) * kstep;
            const char* a3 = a2 + kstep; const char* b3 = b2 + kstep;
            PG8_LDB(B0, 0, 0); PG8_LDB(B1, 0, 1); PG8_SCHED; PG8_LDA(At, 0, 0); PG8_STAGE(PG8_SA(1, 1), a1 + hstepA, voffA);
            PG8_WAIT_V(8); PG8_WAIT_L(0); PG8_BAR; PG8_MMA(0, 0, At, B0); PG8_MMA(0, 1, At, B1); PG8_BAR; PG8_SCHED;
            PG8_LDA(At, 0, 1); PG8_STAGE(PG8_SB(0, 0), b2, voffB); PG8_STAGE(PG8_SB(0, 1), b2 + hstepB, voffB); PG8_STAGE(PG8_SA(0, 0), a2, voffA);
            PG8_WAIT_V(8); PG8_WAIT_L(0); PG8_BAR; PG8_MMA(1, 0, At, B0); PG8_MMA(1, 1, At, B1); PG8_BAR; PG8_SCHED;
            PG8_LDB(B0, 1, 0); PG8_LDB(B1, 1, 1); PG8_SCHED; PG8_LDA(At, 1, 0); PG8_STAGE(PG8_SA(0, 1), a2 + hstepA, voffA);
            PG8_WAIT_V(8); PG8_WAIT_L(0); PG8_BAR; PG8_MMA(0, 0, At, B0); PG8_MMA(0, 1, At, B1); PG8_BAR; PG8_SCHED;
            PG8_LDA(At, 1, 1); PG8_STAGE(PG8_SB(1, 0), b3, voffB); PG8_STAGE(PG8_SB(1, 1), b3 + hstepB, voffB); PG8_STAGE(PG8_SA(1, 0), a3, voffA);
            PG8_WAIT_V(8); PG8_WAIT_L(0); PG8_BAR; PG8_MMA(1, 0, At, B0); PG8_MMA(1, 1, At, B1); PG8_BAR; PG8_SCHED;
        }
        if (wr == 0) PG8_BAR;
        {
            const int le = otid(wv) & 63, fre = le & 15, fqe = le >> 4;
            if constexpr (is_whole_tile<Epi>::value) E.run(cur, acc, wr, wc, fre, fqe); else
#pragma unroll
            for (int ai = 0; ai < 2; ++ai)
#pragma unroll
                for (int m = 0; m < 4; ++m)
#pragma unroll
                    for (int bj = 0; bj < 2; ++bj)
                        E(cur, ai * HALF + wr * 64 + m * 16 + fre, bj * HALF + wc * 32 + 8 * fqe, acc[ai][bj][m][0], acc[ai][bj][m][1]);
        }
        if (!has_next) break;
#pragma unroll
        for (int a = 0; a < 2; ++a)
#pragma unroll
            for (int b = 0; b < 2; ++b)
#pragma unroll
                for (int m = 0; m < 4; ++m)
#pragma unroll
                    for (int n = 0; n < 2; ++n) acc[a][b][m][n] = (f32x4){0.f, 0.f, 0.f, 0.f};
        cur = nxt; cA = nA; cB = nB; ++ui;
        if (wr == 1) PG8_BAR;
    }
    PG8_WAIT_V(0);
    PG8_BAR;
#undef PG8_SA
#undef PG8_SB
#undef PG8_STAGE
#undef PG8_LDA
#undef PG8_LDB
#undef PG8_MMA
#undef PG8_WAIT_V
#undef PG8_WAIT_L
#undef PG8_BAR
#undef PG8_SCHED
}
}

DI void transpose_item(const float* W, int N, int kb, int nb, bf16_t* d0, bf16_t* d1, int K, LAS float* scr, int lane) {
    const int k0 = 64 * kb, n0 = 32 * nb;
#pragma unroll 8
    for (int i = 0; i < 32; ++i) { const int kk = 2 * i + (lane >> 5); scr[kk * 33 + (lane & 31)] = W[(size_t)(k0 + kk) * N + n0 + (lane & 31)]; }
    asm volatile("s_waitcnt lgkmcnt(0)" ::: "memory");
    const int c = lane & 7;
#pragma unroll
    for (int j = 0; j < 4; ++j) { const int n = (lane >> 3) + 8 * j; const LAS float* s = scr + (8 * c) * 33 + n;
        u32x4 o; o.x = pk2(s[0 * 33], s[1 * 33]); o.y = pk2(s[2 * 33], s[3 * 33]); o.z = pk2(s[4 * 33], s[5 * 33]); o.w = pk2(s[6 * 33], s[7 * 33]);
        *(u32x4*)(d0 + (size_t)n * K + k0 + 8 * c) = o;
        if (d1) *(u32x4*)(d1 + (size_t)n * K + k0 + 8 * c) = o; }
    asm volatile("s_waitcnt lgkmcnt(0)" ::: "memory");
}

DI void prep_phase(const Args& A, LAS unsigned char* lds, int wv) {
    const int tid = otid(wv), lane = tid & 63, wave = tid >> 6, G = gridDim.x;
    unsigned char* ws = A.ws;
    {
        LAS float* s_lds = (LAS float*)lds;
        const float* cc = A.in[1]; const float* cctx = A.in[3]; const float* aw = A.in[4]; const float* ab = A.in[5];
        long long* modi = (long long*)(ws + WS_MODI);
        for (int item = blockIdx.x; item < 768; item += G) {
            const int kc = item % 16, cb = (item / 16) % 12, l = item / 192;
            const int k0 = kc * 128, j = cb * 512 + tid;
            __syncthreads();
            for (int e = tid; e < 17 * 128; e += NTHREADS) { const int r = e / 128, k = e % 128; const float v = r < 16 ? cc[r * DM + k0 + k] : cctx[k0 + k]; s_lds[k * 20 + r] = siluf(v); }
            __syncthreads();
            float acc[17];
#pragma unroll
            for (int r = 0; r < 17; ++r) acc[r] = 0.f;
            const float* wp = aw + ((size_t)l * DM + k0) * MOD_LD + j;
#pragma unroll 4
            for (int k = 0; k < 128; ++k) {
                const float w = wp[(size_t)k * MOD_LD];
                const LAS f32x4* sp = (const LAS f32x4*)(s_lds + k * 20);
                const f32x4 s0 = sp[0], s1 = sp[1], s2 = sp[2], s3 = sp[3]; const float s4 = s_lds[k * 20 + 16];
#pragma unroll
                for (int q = 0; q < 4; ++q) { acc[q] += s0[q] * w; acc[4 + q] += s1[q] * w; acc[8 + q] += s2[q] * w; acc[12 + q] += s3[q] * w; }
                acc[16] += s4 * w;
            }
            const float bias = (kc == 0) ? ab[l * MOD_LD + j] : 0.f;
#pragma unroll
            for (int r = 0; r < 17; ++r) atomicAdd((unsigned long long*)&modi[(size_t)(l * 17 + r) * MOD_LD + j], (unsigned long long)__float2ll_rn((acc[r] + bias) * MODI_SCALE));
        }
        __syncthreads();
    }
    {
        LAS float* scr = (LAS float*)(lds + wave * 16384);
        const int gw = blockIdx.x * NWAVES + wave, NGW = G * NWAVES;
        constexpr int I_SQ = 32 * 64, I_AI = 32 * 160, I_MI = 32 * 257;
        constexpr int NIT = 6 * I_SQ + I_AI + I_MI;
        for (int it = gw; it < NIT; it += NGW) {
            int r = it;
            if (r < 6 * I_SQ) {
                const int w = r / I_SQ; r -= w * I_SQ;
                const float* src; bf16_t* dst;
                if (w < 2)      { src = A.in[7] + (size_t)w * DM * DM;       dst = (bf16_t*)(ws + WS_WFG) + (size_t)w * DM * DM; }
                else if (w < 4) { src = A.in[8] + (size_t)(w - 2) * DM * DM; dst = (bf16_t*)(ws + WS_WFO) + (size_t)(w - 2) * DM * DM; }
                else if (w == 4) { src = A.in[12]; dst = (bf16_t*)(ws + WS_WMO); }
                else             { src = A.in[16]; dst = (bf16_t*)(ws + WS_WAO); }
                const int kb = r / 64, nb = r % 64;
                transpose_item(src, DM, kb, nb, dst + (size_t)(32 * nb) * DM, nullptr, DM, scr, lane);
                continue;
            }
            r -= 6 * I_SQ;
            if (r < I_AI) { const int kb = r / 160, nb = r % 160; transpose_item(A.in[13], 5120, kb, nb, (bf16_t*)(ws + WS_WAI) + (size_t)(32 * nb) * DM, nullptr, DM, scr, lane); continue; }
            r -= I_AI;
            {
                const int kb = r / 257, nb = r % 257, n0 = 32 * nb;
                bf16_t* WA = (bf16_t*)(ws + WS_WMA); bf16_t* WB = (bf16_t*)(ws + WS_WMB);
                bf16_t* d0; bf16_t* d1 = nullptr;
                if (n0 < 1024) d0 = WA + (size_t)n0 * DM;
                else if (n0 < 2048) d0 = WA + (size_t)n0 * DM;
                else if (n0 < 4096) d0 = WB + (size_t)(n0 - 2048) * DM;
                else if (n0 < 6144) d0 = WA + (size_t)(2304 + n0 - 4096) * DM;
                else if (n0 < 6176) d0 = WA + (size_t)(2048 + n0 - 6144) * DM;
                else d0 = WA + (size_t)(4352 + n0 - 6176) * DM;
                transpose_item(A.in[9], 8224, kb, nb, d0, d1, DM, scr, lane);
            }
        }
    }
    {
        const long gt = (long)blockIdx.x * NTHREADS + tid, NGT = (long)G * NTHREADS;
        constexpr long N_DC = 512L * 512 / 8, N_DT = 2048L * 4096 / 8, N_DT2 = 256L * 512 / 8;
        for (long it = gt; it < N_DC + N_DT + N_DT2; it += NGT) {
            float v[8]; bf16_t* dst;
            if (it < N_DC) {
                const int m = (int)(it / 64), k0 = (int)(it % 64) * 8; const float sc = 0.044194173824159216f;
#pragma unroll
                for (int j = 0; j < 8; ++j) { const int mm = (m <= 256) ? m : m - 256; const int rr = (mm * (k0 + j)) & 511; const float ang = (float)rr * (1.f / 256.f); v[j] = (m <= 256 ? cospif(ang) : sinpif(ang)) * sc; }
                dst = (bf16_t*)(ws + WS_DC) + (size_t)m * 512 + k0;
            } else if (it < N_DC + N_DT) {
                const long i2 = it - N_DC; const int kk = (int)(i2 / 512), s0 = (int)(i2 % 512) * 8; const float sc = 0.022097086912079608f;
#pragma unroll
                for (int j = 0; j < 8; ++j) { const int s = s0 + j; const int rr = (kk * (s & 2047)) & 2047; const float ang = (float)rr * (1.f / 1024.f); v[j] = (s < 2048 ? cospif(ang) : -sinpif(ang)) * sc; }
                dst = (bf16_t*)(ws + WS_DT) + (size_t)kk * 4096 + s0;
            } else {
                const long i2 = it - N_DC - N_DT; const int kk = (int)(i2 / 64), s0 = (int)(i2 % 64) * 8; const float sc = 0.0625f;
#pragma unroll
                for (int j = 0; j < 8; ++j) { const int s = s0 + j; const int rr = (kk * (s & 255)) & 255; const float ang = (float)rr * (1.f / 128.f); v[j] = (s < 256 ? cospif(ang) : -sinpif(ang)) * sc; }
                dst = (bf16_t*)(ws + WS_DT2) + (size_t)kk * 512 + s0;
            }
            u32x4 o = {pk2(v[0], v[1]), pk2(v[2], v[3]), pk2(v[4], v[5]), pk2(v[6], v[7])};
            *(u32x4*)dst = o;
        }
    }
}

DI const float* xrow_in(const Args& A, int r) {
    const int b = r / TB, t = r % TB;
    if (t < TL) return A.in[0] + ((size_t)b * TL + t) * DM;
    return A.in[2] + ((size_t)b * TC + (t - TL)) * DM;
}
DI void norm_phase(const Args& A, int layer, bool latonly, int wv) {
    const int tid = otid(wv), lane = tid & 63, wave = tid >> 6, G = gridDim.x;
    const float* ng = A.in[6] + (size_t)layer * DM;
    const float* mod = (const float*)(A.ws + WS_MOD) + (size_t)layer * 17 * MOD_LD;
    bf16_t* H = (bf16_t*)(A.ws + WS_H);
    const bf16_t* XB = (const bf16_t*)A.out;
    for (int r0 = (blockIdx.x * NWAVES + wave) * 2; r0 < NTOK; r0 += G * NWAVES * 2) {
        const int b = r0 / TB, t = r0 % TB;
        if (latonly && t >= TL) continue;
        const float* mr = mod + (size_t)(t < TL ? b : 16) * MOD_LD;
        f32x4 v[2][4][2];
#pragma unroll
        for (int k = 0; k < 2; ++k) {
            const int r = r0 + k;
            if (layer == 0) {
                const float* xr = xrow_in(A, r);
#pragma unroll
                for (int j = 0; j < 4; ++j) { const f32x4* p = (const f32x4*)(xr + 512 * j + 8 * lane); v[k][j][0] = p[0]; v[k][j][1] = p[1]; }
            } else {
#pragma unroll
                for (int j = 0; j < 4; ++j) ld_bf16x8(XB + (size_t)r * DM + 512 * j + 8 * lane, v[k][j][0], v[k][j][1]);
            }
        }
#pragma unroll
        for (int k = 0; k < 2; ++k) {
            const int r = r0 + k; float ss = 0.f;
#pragma unroll
            for (int j = 0; j < 4; ++j)
#pragma unroll
                for (int q = 0; q < 4; ++q) ss += v[k][j][0][q] * v[k][j][0][q] + v[k][j][1][q] * v[k][j][1][q];
            const float rs = 1.0f / sqrtf(wave_sum(ss) * (1.f / DM) + EPS);
#pragma unroll
            for (int j = 0; j < 4; ++j) { const int c0 = 512 * j + 8 * lane; f32x4 o[2];
#pragma unroll
                for (int h = 0; h < 2; ++h) { const f32x4 g4 = *(const f32x4*)(ng + c0 + 4 * h), sh = *(const f32x4*)(mr + c0 + 4 * h), sc = *(const f32x4*)(mr + DM + c0 + 4 * h);
                    o[h] = (v[k][j][h] * rs) * g4 * (sc + 1.0f) + sh; }
                st_bf16x8(H + (size_t)r * DM + c0, o[0], o[1]); }
        }
    }
}
DI void final_norm_phase(const Args& A, const bf16_t* src, int wv) {
    const int tid = otid(wv), lane = tid & 63, wave = tid >> 6, G = gridDim.x;
    const float* fg = A.in[17];
    for (int r0 = (blockIdx.x * NWAVES + wave) * 2; r0 < NB * TL; r0 += G * NWAVES * 2) {
        f32x4 v[2][4][2];
#pragma unroll
        for (int k = 0; k < 2; ++k)
#pragma unroll
            for (int j = 0; j < 4; ++j) ld_bf16x8(src + (size_t)(r0 + k) * DM + 512 * j + 8 * lane, v[k][j][0], v[k][j][1]);
#pragma unroll
        for (int k = 0; k < 2; ++k) { float* orow = A.out + (size_t)(r0 + k) * DM; float ss = 0.f;
#pragma unroll
            for (int j = 0; j < 4; ++j)
#pragma unroll
                for (int q = 0; q < 4; ++q) ss += v[k][j][0][q] * v[k][j][0][q] + v[k][j][1][q] * v[k][j][1][q];
            const float rs = 1.0f / sqrtf(wave_sum(ss) * (1.f / DM) + EPS);
#pragma unroll
            for (int j = 0; j < 4; ++j) { const int c0 = 512 * j + 8 * lane;
#pragma unroll
                for (int h = 0; h < 2; ++h) { const f32x4 g4 = *(const f32x4*)(fg + c0 + 4 * h); *(f32x4*)(orow + c0 + 4 * h) = (v[k][j][h] * rs) * g4; } }
        }
    }
}

struct DescPlain {
    static constexpr bool RAW = false;
    const bf16_t* A; const bf16_t* B; int nN; bool latonly; int lda, ldb, K, total;
    DI void init(const bf16_t* A_, const bf16_t* B_, int nN_, bool lat) { A = A_; B = B_; nN = nN_; latonly = lat; lda = DM; ldb = DM; K = DM; total = (lat ? 128 : 144) * nN_; }
    DI pg8::Unit unit(int idx) const {
        const int nMt = latonly ? 128 : 144, nig = 8 * nN, gid = idx / nig, fm = gid * 8, gsz = (nMt - fm) < 8 ? (nMt - fm) : 8;
        const int pmi = fm + (idx % nig) % gsz, pn = (idx % nig) / gsz, pm = latonly ? (pmi / 8) * 9 + (pmi % 8) : pmi;
        pg8::Unit u; u.a = (const char*)(A + (size_t)pm * 256 * DM); u.b = (const char*)(B + (size_t)pn * 256 * DM); u.i0 = pm; u.i1 = pn; u.i2 = 0; return u;
    }
};
struct DescChan {
    static constexpr bool RAW = false;
    const bf16_t* DC; const bf16_t* H; int lda, ldb, K, total;
    DI void init(const bf16_t* DC_, const bf16_t* H_, bool lat) { DC = DC_; H = H_; lda = 512; ldb = DM; K = 512; total = lat ? 1024 : 1152; }
    DI pg8::Unit unit(int idx) const {
        pg8::Unit u; int b, g, mt, nt, toff;
        if (idx < 1024) { mt = idx % 2; nt = (idx / 2) % 8; g = (idx / 16) % 4; b = idx / 64; toff = nt * 256; u.i2 = nt; }
        else { const int j = idx - 1024; mt = j % 2; g = (j / 2) % 4; b = j / 8; toff = TL; u.i2 = 8; }
        u.a = (const char*)(DC + (size_t)mt * 256 * 512); u.b = (const char*)(H + ((size_t)b * TB + toff) * DM + g * 512); u.i0 = b * 4 + g; u.i1 = mt; return u;
    }
};
struct DescT {
    static constexpr bool RAW = false;
    const bf16_t* DT; const bf16_t* PQ; int nMt; int lda, ldb, K, total;
    DI void init(const bf16_t* DT_, const bf16_t* PQ_, int ld, int Kd, int coff, int nMt_) { DT = DT_ + coff; PQ = PQ_ + coff; nMt = nMt_; lda = ld; ldb = ld; K = Kd; total = NB * nMt_ * 8; }
    DI pg8::Unit unit(int idx) const {
        const int mt = idx % nMt, nt = (idx / nMt) % 8, b = idx / (nMt * 8);
        pg8::Unit u; u.a = (const char*)(DT + (size_t)mt * 256 * lda); u.b = (const char*)(PQ + ((size_t)b * DM + nt * 256) * ldb); u.i0 = b; u.i1 = mt; u.i2 = nt; return u;
    }
};

struct DescT2 {
    static constexpr bool RAW = true;
    const bf16_t* DT; const bf16_t* PQ; int lda, ldb, K, total;
    DI void init(const bf16_t* DT_, const bf16_t* PQ_) { DT = DT_; PQ = PQ_; lda = 4096; ldb = 4096; K = 2048; total = 2 * NB * 4 * 4; }
    DI bool valid(int L, int G) const { return ((L / G) >> 1) * G + (L % G) < NB * 4 * 4; }
    DI pg8::Unit unit(int L, int G) const {
        const int i = L / G, pair = (i >> 1) * G + (L % G), part = i & 1;
        const int mt = pair % 4, nt = 2 * ((pair / 4) % 4), b = pair / 16, coff = part * 2048;
        pg8::Unit u; u.a = (const char*)(DT + (size_t)mt * 256 * 4096 + coff); u.b = (const char*)(PQ + ((size_t)b * DM + nt * 256) * 4096 + coff); u.i0 = b; u.i1 = mt; u.i2 = part * 8 + nt; return u;
    }
};

struct EpiResid {
    static constexpr bool WHOLE_TILE = true;
    const float* x_in; const float* c_in; bf16_t* XB; bf16_t* X2; const float* modl; int layer;
    DI void init(const Args& A, int layer_) { x_in = A.in[0]; c_in = A.in[2]; XB = (bf16_t*)A.out; X2 = (bf16_t*)(A.ws + WS_SCR + F_PQX); modl = (const float*)(A.ws + WS_MOD) + (size_t)layer_ * 17 * MOD_LD; layer = layer_; }
    DI void run(const pg8::Unit& u, const f32x4 (&acc)[2][2][4][2], int wr, int wc, int fr, int fq) const {
        const int pm = u.i0, b = pm / 9, tt = pm % 9, col0 = u.i1 * 256 + wc * 32 + 8 * fq;
        f32x4 g[2][2];
#pragma unroll
        for (int bj = 0; bj < 2; ++bj) { const float* gp = modl + (size_t)(tt < 8 ? b : 16) * MOD_LD + 2 * DM + col0 + bj * 128; g[bj][0] = *(const f32x4*)gp; g[bj][1] = *(const f32x4*)(gp + 4); }
        if (layer != 0) {
            u32x4 xq[2][4][2];
#pragma unroll
            for (int ai = 0; ai < 2; ++ai)
#pragma unroll
                for (int m = 0; m < 4; ++m)
#pragma unroll
                    for (int bj = 0; bj < 2; ++bj) xq[ai][m][bj] = *(const u32x4*)(XB + ((size_t)pm * 256 + ai * 128 + wr * 64 + m * 16 + fr) * DM + col0 + bj * 128);
#pragma unroll
            for (int ai = 0; ai < 2; ++ai)
#pragma unroll
                for (int m = 0; m < 4; ++m)
#pragma unroll
                    for (int bj = 0; bj < 2; ++bj) {
                        const int row_l = ai * 128 + wr * 64 + m * 16 + fr; const u32x4 w = xq[ai][m][bj];
                        const f32x4 x0 = (f32x4){bf_lo(w.x), bf_hi(w.x), bf_lo(w.y), bf_hi(w.y)} + g[bj][0] * acc[ai][bj][m][0];
                        const f32x4 x1 = (f32x4){bf_lo(w.z), bf_hi(w.z), bf_lo(w.w), bf_hi(w.w)} + g[bj][1] * acc[ai][bj][m][1];
                        if (layer == 3) st_bf16x8(X2 + ((size_t)b * TL + tt * 256 + row_l) * DM + col0 + bj * 128, x0, x1);
                        else st_bf16x8(XB + ((size_t)pm * 256 + row_l) * DM + col0 + bj * 128, x0, x1);
                    }
        } else {
#pragma unroll
            for (int ai = 0; ai < 2; ++ai) {
                f32x4 xf[4][2][2];
#pragma unroll
                for (int m = 0; m < 4; ++m)
#pragma unroll
                    for (int bj = 0; bj < 2; ++bj) { const int row_l = ai * 128 + wr * 64 + m * 16 + fr;
                        const float* src = (tt < 8) ? x_in + ((size_t)b * TL + tt * 256 + row_l) * DM + col0 + bj * 128 : c_in + ((size_t)b * TC + row_l) * DM + col0 + bj * 128;
                        xf[m][bj][0] = *(const f32x4*)src; xf[m][bj][1] = *(const f32x4*)(src + 4); }
#pragma unroll
                for (int m = 0; m < 4; ++m)
#pragma unroll
                    for (int bj = 0; bj < 2; ++bj) { const int row_l = ai * 128 + wr * 64 + m * 16 + fr;
                        st_bf16x8(XB + ((size_t)pm * 256 + row_l) * DM + col0 + bj * 128, xf[m][bj][0] + g[bj][0] * acc[ai][bj][m][0], xf[m][bj][1] + g[bj][1] * acc[ai][bj][m][1]); }
            }
        }
    }
};

DI void fnet_layer(const Args& A, LAS unsigned char* lds, const XcdBarrier& gbar, int layer, int j, bool latonly, int wv) {
    unsigned char* ws = A.ws;
    const bf16_t* H = (const bf16_t*)(ws + WS_H); bf16_t* U = (bf16_t*)(ws + WS_H);
    bf16_t* Gt = (bf16_t*)(ws + WS_SCR + F_G); bf16_t* PQX = (bf16_t*)(ws + WS_SCR + F_PQX); bf16_t* PQC = (bf16_t*)(ws + WS_SCR + F_PQC);
    norm_phase(A, layer, latonly, wv);
    xcd_barrier(gbar, wv);
    {
        DescPlain D; D.init(H, (const bf16_t*)(ws + WS_WFG) + (size_t)j * DM * DM, 8, latonly);
        auto E = [=](const pg8::Unit& u, int row_l, int col_l, f32x4 v0, f32x4 v1) {
            f32x4 a, b;
#pragma unroll
            for (int q = 0; q < 4; ++q) { a[q] = siluf(v0[q]); b[q] = siluf(v1[q]); }
            st_bf16x8(Gt + ((size_t)u.i0 * 256 + row_l) * DM + u.i1 * 256 + col_l, a, b);
        };
        pg8::gemm_phase(lds, D, E, wv);
    }
    {
        DescChan D; D.init((const bf16_t*)(ws + WS_DC), H, latonly);
        auto E = [=](const pg8::Unit& u, int row_l, int col_l, f32x4 v0, f32x4 v1) {
            const int b = u.i0 >> 2, g = u.i0 & 3, m = row_l;
            bf16_t* base; size_t cs; int hs;
            if (u.i2 < 8) { base = PQX + ((size_t)b * DM + g * 512) * 4096 + u.i2 * 256 + col_l; cs = 4096; hs = 2048; }
            else          { base = PQC + ((size_t)b * DM + g * 512) * 512 + col_l; cs = 512; hs = 256; }
            const f32x4 z = {0.f, 0.f, 0.f, 0.f};
            if (u.i1 == 0) { st_bf16x8(base + (size_t)m * cs, v0, v1); if (m != 0) st_bf16x8(base + (size_t)(512 - m) * cs, v0, v1); }
            else if (m == 0) { st_bf16x8(base + (size_t)256 * cs, v0, v1); st_bf16x8(base + (size_t)256 * cs + hs, z, z); st_bf16x8(base + hs, z, z); }
            else { st_bf16x8(base + (size_t)m * cs + hs, v0, v1); st_bf16x8(base + (size_t)(512 - m) * cs + hs, z - v0, z - v1); }
        };
        pg8::gemm_phase(lds, D, E, wv);
    }
    xcd_barrier(gbar, wv);
    bf16_t* A1 = (bf16_t*)(ws + WS_SCR + F_A1);
    {
        const int tid = otid(wv), lane = tid & 63;
        for (int rr0 = (blockIdx.x * NWAVES + wv) * 4; rr0 < NB * DM; rr0 += gridDim.x * NWAVES * 4) {
            u32x4 raw[4][4];
#pragma unroll
            for (int k = 0; k < 4; ++k)
#pragma unroll
                for (int q = 0; q < 4; ++q) raw[k][q] = *(const u32x4*)(PQX + (size_t)(rr0 + k) * 4096 + (q * 64 + lane) * 8);
#pragma unroll
            for (int k = 0; k < 4; ++k) { float acc = 0.f;
#pragma unroll
                for (int q = 0; q < 4; ++q) { const u32x4 w = raw[k][q]; acc += (bf_lo(w.x) - bf_hi(w.x)) + (bf_lo(w.y) - bf_hi(w.y)) + (bf_lo(w.z) - bf_hi(w.z)) + (bf_lo(w.w) - bf_hi(w.w)); }
                acc = wave_sum(acc);
                if (lane == 0) { const int rr = rr0 + k; const size_t off = ((size_t)(rr >> 11) * TB + 1024) * DM + (rr & 2047);
                    U[off] = (bf16_t)(pk2(acc * 0.022097086912079608f * __uint_as_float((unsigned)Gt[off] << 16), 0.f) & 0xffffu); } }
        }
    }
    {
        const int tid = otid(wv), lane = tid & 63; const bf16_t* DTm = (const bf16_t*)(ws + WS_DT);
        for (int it = blockIdx.x * NWAVES + wv; it < 64 * 256; it += gridDim.x * NWAVES) {
            const int bg = it >> 8, kq = it & 255, b = bg >> 2, ch = (bg & 3) * 512 + 256;
            const bf16_t* pr = PQX + ((size_t)b * DM + ch) * 4096;
            u32x4 pv[4], dv[4][4];
#pragma unroll
            for (int q = 0; q < 4; ++q) pv[q] = *(const u32x4*)(pr + (q * 64 + lane) * 8);
#pragma unroll
            for (int kk = 0; kk < 4; ++kk)
#pragma unroll
                for (int q = 0; q < 4; ++q) dv[kk][q] = *(const u32x4*)(DTm + (size_t)(kq * 4 + kk) * 4096 + (q * 64 + lane) * 8);
            float accs[4];
#pragma unroll
            for (int kk = 0; kk < 4; ++kk) { float acc = 0.f;
#pragma unroll
                for (int q = 0; q < 4; ++q) { acc = dot2g(dv[kk][q].x, pv[q].x, acc); acc = dot2g(dv[kk][q].y, pv[q].y, acc); acc = dot2g(dv[kk][q].z, pv[q].z, acc); acc = dot2g(dv[kk][q].w, pv[q].w, acc); }
                accs[kk] = wave_sum(acc); }
            if (lane == 0) {
                unsigned short g1[4], g2[4];
#pragma unroll
                for (int kk = 0; kk < 4; ++kk) { const int k = kq * 4 + kk; g1[kk] = Gt[((size_t)b * TB + k) * DM + ch]; g2[kk] = Gt[((size_t)b * TB + ((TL - k) & (TL - 1))) * DM + ch]; }
#pragma unroll
                for (int kk = 0; kk < 4; ++kk) { const int k = kq * 4 + kk;
                    U[((size_t)b * TB + k) * DM + ch] = (bf16_t)(pk2(accs[kk] * __uint_as_float((unsigned)g1[kk] << 16), 0.f) & 0xffffu);
                    if (k != 0) U[((size_t)b * TB + (TL - k)) * DM + ch] = (bf16_t)(pk2(accs[kk] * __uint_as_float((unsigned)g2[kk] << 16), 0.f) & 0xffffu); }
            }
        }
    }
    {
        DescT2 D; D.init((const bf16_t*)(ws + WS_DT), PQX);
        auto E = [=](const pg8::Unit& u, int row_l, int col_l, f32x4 v0, f32x4 v1) {
            const int k = u.i1 * 256 + row_l, col = (u.i2 & 7) * 256 + col_l;
            bf16_t* ap = A1 + ((size_t)u.i0 * 1024 + k) * DM + col;
            if (u.i2 < 8) { st_bf16x8(ap, v0, v1); return; }
            f32x4 a0, a1; ld_bf16x8(ap, a0, a1);
            const size_t off = ((size_t)u.i0 * TB + k) * DM + col;
            f32x4 g0, g1; ld_bf16x8(Gt + off, g0, g1);
            st_bf16x8(U + off, (a0 + v0) * g0, (a1 + v1) * g1);
            if (k != 0) { const size_t off2 = ((size_t)u.i0 * TB + (TL - k)) * DM + col; ld_bf16x8(Gt + off2, g0, g1); st_bf16x8(U + off2, (a0 - v0) * g0, (a1 - v1) * g1); }
            const f32x4 s0 = a0 + v0, s1 = a1 + v1, d0 = a0 - v0, d1 = a1 - v1;
            const float sm[8] = {s0[0], s0[1], s0[2], s0[3], s1[0], s1[1], s1[2], s1[3]}, df[8] = {d0[0], d0[1], d0[2], d0[3], d1[0], d1[1], d1[2], d1[3]};
            const size_t rowk = ((size_t)u.i0 * TB + k) * DM, rowT = ((size_t)u.i0 * TB + (TL - k)) * DM; const int cm = (col & ~255) + 512 - col_l;
            {
                const bf16_t* gk_ = Gt + rowk + cm - 8; const bf16_t* gT_ = Gt + rowT + cm - 8; bf16_t* uk_ = U + rowk + cm - 8; bf16_t* uT_ = U + rowT + cm - 8;
                const unsigned short ka1 = gk_[1]; const unsigned ka2 = *(const unsigned*)(gk_ + 2); const u32x2 ka4 = *(const u32x2*)(gk_ + 4); const unsigned short ka0 = col_l ? gk_[8] : (unsigned short)0;
                unsigned short ta1 = 0, ta0 = 0; unsigned ta2 = 0; u32x2 ta4 = {0u, 0u};
                if (k != 0) { ta1 = gT_[1]; ta2 = *(const unsigned*)(gT_ + 2); ta4 = *(const u32x2*)(gT_ + 4); ta0 = col_l ? gT_[8] : (unsigned short)0; }
                uk_[1] = (bf16_t)(pk2(df[7] * __uint_as_float((unsigned)ka1 << 16), 0.f) & 0xffffu);
                *(unsigned*)(uk_ + 2) = pk2(df[6] * bf_lo(ka2), df[5] * bf_hi(ka2));
                *(u32x2*)(uk_ + 4) = (u32x2){pk2(df[4] * bf_lo(ka4.x), df[3] * bf_hi(ka4.x)), pk2(df[2] * bf_lo(ka4.y), df[1] * bf_hi(ka4.y))};
                if (col_l) uk_[8] = (bf16_t)(pk2(df[0] * __uint_as_float((unsigned)ka0 << 16), 0.f) & 0xffffu);
                if (k != 0) {
                    uT_[1] = (bf16_t)(pk2(sm[7] * __uint_as_float((unsigned)ta1 << 16), 0.f) & 0xffffu);
                    *(unsigned*)(uT_ + 2) = pk2(sm[6] * bf_lo(ta2), sm[5] * bf_hi(ta2));
                    *(u32x2*)(uT_ + 4) = (u32x2){pk2(sm[4] * bf_lo(ta4.x), sm[3] * bf_hi(ta4.x)), pk2(sm[2] * bf_lo(ta4.y), sm[1] * bf_hi(ta4.y))};
                    if (col_l) uT_[8] = (bf16_t)(pk2(sm[0] * __uint_as_float((unsigned)ta0 << 16), 0.f) & 0xffffu);
                }
            }
        };
        pg8::gemm_phase(lds, D, E, wv);
    }
    if (!latonly) {
        DescT D; D.init((const bf16_t*)(ws + WS_DT2), PQC, 512, 512, 0, 1);
        auto E = [=](const pg8::Unit& u, int row_l, int col_l, f32x4 v0, f32x4 v1) {
            const size_t off = ((size_t)u.i0 * TB + TL + row_l) * DM + u.i2 * 256 + col_l;
            f32x4 g0, g1; ld_bf16x8(Gt + off, g0, g1);
            st_bf16x8(U + off, v0 * g0, v1 * g1);
        };
        pg8::gemm_phase(lds, D, E, wv);
    }
    xcd_barrier(gbar, wv);
    {
        DescPlain D; D.init(U, (const bf16_t*)(ws + WS_WFO) + (size_t)j * DM * DM, 8, latonly);
        EpiResid E; E.init(A, layer);
        pg8::gemm_phase(lds, D, E, wv);
    }
    xcd_barrier(gbar, wv);
}


namespace att {
constexpr int D = 128, NW = 8, QBLK = 32, KVBLK = 64;
constexpr float SCALE = 0.088388347648318440f;
constexpr float THR = 8.f;
constexpr int LDQ = 2048, LDK = 512;
constexpr size_t SHM_V = KVBLK * D * 2, SHM_K = KVBLK * D * 2;
typedef float f32x8 __attribute__((ext_vector_type(8)));
#define KSWZ(row, colB) ((row) * 256 + ((colB) ^ (((row) & 7) << 4)))
#define SBAR() __builtin_amdgcn_sched_barrier(0)
DI int crow(int r, int hi) { return (r & 3) + 8 * (r >> 2) + 4 * hi; }
DI unsigned cvtpk(float lo, float hi) { unsigned r; asm volatile("v_cvt_pk_bf16_f32 %0, %1, %2" : "=v"(r) : "v"(lo), "v"(hi)); return r; }
DI void partialSM(f32x16& p0, f32x16& p1, float& m_reg, float& mn, float& alpha) {
  constexpr float C = SCALE * 1.4426950408889634f;
  float pmax = p0[0];
#pragma unroll
  for (int r = 1; r < 16; ++r) pmax = fmaxf(pmax, p0[r]);
#pragma unroll
  for (int r = 0; r < 16; ++r) pmax = fmaxf(pmax, p1[r]);
  { auto rr = __builtin_amdgcn_permlane32_swap(__float_as_uint(pmax), __float_as_uint(pmax), false, false);
    pmax = fmaxf(__uint_as_float(rr[0]), __uint_as_float(rr[1])); }
  if (__builtin_expect(__all(pmax - m_reg <= THR / SCALE), 1)) { mn = m_reg; alpha = 1.f; }
  else { mn = fmaxf(m_reg, pmax); alpha = __builtin_amdgcn_exp2f((m_reg - mn) * C); m_reg = mn; }
  float mnC = -mn * C;
#pragma unroll
  for (int r = 0; r < 16; ++r) p0[r] = fmaf(p0[r], C, mnC);
#pragma unroll
  for (int r = 0; r < 16; ++r) p1[r] = fmaf(p1[r], C, mnC);
#pragma unroll
  for (int r = 0; r < 16; ++r) p0[r] = __builtin_amdgcn_exp2f(p0[r]);
}
DI void finishSM(f32x16& p0, f32x16& p1, float alpha, float& l_reg, bf16x8& pa0, bf16x8& pa1, bf16x8& pa2, bf16x8& pa3) {
#pragma unroll
  for (int r = 0; r < 16; ++r) p1[r] = __builtin_amdgcn_exp2f(p1[r]);
  float ps = 0;
#pragma unroll
  for (int r = 0; r < 16; ++r) ps += p0[r];
#pragma unroll
  for (int r = 0; r < 16; ++r) ps += p1[r];
  { auto rr = __builtin_amdgcn_permlane32_swap(__float_as_uint(ps), __float_as_uint(ps), false, false);
    ps = __uint_as_float(rr[0]) + __uint_as_float(rr[1]); }
  l_reg = l_reg * alpha + ps;
#define PK4(P, BASE, OUT) do { unsigned a0 = cvtpk(P[BASE + 0], P[BASE + 1]), a1 = cvtpk(P[BASE + 2], P[BASE + 3]);   \
    unsigned b0 = cvtpk(P[BASE + 4], P[BASE + 5]), b1 = cvtpk(P[BASE + 6], P[BASE + 7]);                              \
    auto r0 = __builtin_amdgcn_permlane32_swap(a0, b0, false, false); auto r1 = __builtin_amdgcn_permlane32_swap(a1, b1, false, false); \
    u32x4 w = {r0[0], r1[0], r0[1], r1[1]}; OUT = *reinterpret_cast<bf16x8*>(&w); } while (0)
  PK4(p0, 0, pa0); PK4(p0, 8, pa1); PK4(p1, 0, pa2); PK4(p1, 8, pa3);
#undef PK4
}
DI void qkt(f32x16& p0, f32x16& p1, const bf16_t* Ks, const bf16x8* qr, int r32, int hi) {
  p0 = f32x16{}; p1 = f32x16{};
#pragma unroll
  for (int d0 = 0; d0 < 8; ++d0) { int cb = (d0 * 16 + hi * 8) * 2;
    bf16x8 b0 = *reinterpret_cast<const bf16x8*>((const char*)Ks + KSWZ(r32, cb));
    bf16x8 b1 = *reinterpret_cast<const bf16x8*>((const char*)Ks + KSWZ(32 + r32, cb));
    p0 = __builtin_amdgcn_mfma_f32_32x32x16_bf16(b0, qr[d0], p0, 0, 0, 0);
    p1 = __builtin_amdgcn_mfma_f32_32x32x16_bf16(b1, qr[d0], p1, 0, 0, 0); }
}
DI int v_st(int k, int c) { const int kk = (k & ~0xC) | ((k & 4) << 1) | ((k & 8) >> 1); return ((kk >> 3) * 4 + (c >> 5)) * 512 + ((kk & 7) * 32 + (c & 31)) * 2; }
DI int v_rd_base(int lane) { return ((lane & 3) << 3) | (((lane >> 2) & 3) << 6) | (((lane >> 4) & 1) << 5) | (((lane >> 5) & 1) << 8); }
constexpr int v_rd_off(int d0, int ks, int half) { return d0 * 512 + ks * 4096 + half * 2048; }
template <int OFF> DI s16x4 tr_read(int vb) {
  s16x4 r; asm volatile("ds_read_b64_tr_b16 %0, %1 offset:%2" : "=&v"(r) : "v"(vb), "i"(OFF) : "memory"); return r;
}
template <int D0> DI void pv_one(f32x16& od, int vb, bf16x8 pa0, bf16x8 pa1, bf16x8 pa2, bf16x8 pa3) {
  const s16x4 l0 = tr_read<v_rd_off(D0, 0, 0)>(vb), h0 = tr_read<v_rd_off(D0, 0, 1)>(vb), l1 = tr_read<v_rd_off(D0, 1, 0)>(vb), h1 = tr_read<v_rd_off(D0, 1, 1)>(vb);
  const s16x4 l2 = tr_read<v_rd_off(D0, 2, 0)>(vb), h2 = tr_read<v_rd_off(D0, 2, 1)>(vb), l3 = tr_read<v_rd_off(D0, 3, 0)>(vb), h3 = tr_read<v_rd_off(D0, 3, 1)>(vb);
  asm volatile("s_waitcnt lgkmcnt(0)" ::: "memory"); SBAR();
#define PK(L, H) (bf16x8){L[0], L[1], L[2], L[3], H[0], H[1], H[2], H[3]}
  od = __builtin_amdgcn_mfma_f32_32x32x16_bf16(pa0, PK(l0, h0), od, 0, 0, 0);
  od = __builtin_amdgcn_mfma_f32_32x32x16_bf16(pa1, PK(l1, h1), od, 0, 0, 0);
  od = __builtin_amdgcn_mfma_f32_32x32x16_bf16(pa2, PK(l2, h2), od, 0, 0, 0);
  od = __builtin_amdgcn_mfma_f32_32x32x16_bf16(pa3, PK(l3, h3), od, 0, 0, 0);
#undef PK
}
DI void pv_d0(f32x16* o, int vb, bf16x8 pa0, bf16x8 pa1, bf16x8 pa2, bf16x8 pa3) {
  pv_one<0>(o[0], vb, pa0, pa1, pa2, pa3); pv_one<1>(o[1], vb, pa0, pa1, pa2, pa3); pv_one<2>(o[2], vb, pa0, pa1, pa2, pa3); pv_one<3>(o[3], vb, pa0, pa1, pa2, pa3);
}
DI void attn_dense_body(const bf16_t* __restrict__ Qb, const bf16_t* __restrict__ Kh, const bf16_t* __restrict__ Vh, const bf16_t* SZb, bf16_t* Ub, int seq, char* lds, int wv, const float* qn, int tpos) {
  const int tid = otid(wv), wid = tid >> 6, lane = tid & 63, r32 = lane & 31, hi = lane >> 5;
  bf16_t* V_lds = (bf16_t*)lds; bf16_t* K_lds = (bf16_t*)(lds + 2 * SHM_V);
  float* wsf = (float*)(lds + 2 * SHM_V + 2 * SHM_K) + wid * 64; float* li_l = wsf; float* al_l = wsf + 32;
  float m_reg = -1e30f, l_reg = 0; f32x16 o[4] = {}; bf16x8 qr[8];
  const bf16_t* Qw = Qb + (long)(wid * QBLK + r32) * LDQ + hi * 8;
  {
    u32x4 raw[8];
#pragma unroll
    for (int d0 = 0; d0 < 8; ++d0) raw[d0] = *reinterpret_cast<const u32x4*>(Qw + d0 * 16);
    float ss = 0.f;
#pragma unroll
    for (int d0 = 0; d0 < 8; ++d0) { const u32x4 w = raw[d0];
      ss += bf_lo(w.x) * bf_lo(w.x) + bf_hi(w.x) * bf_hi(w.x) + bf_lo(w.y) * bf_lo(w.y) + bf_hi(w.y) * bf_hi(w.y) + bf_lo(w.z) * bf_lo(w.z) + bf_hi(w.z) * bf_hi(w.z) + bf_lo(w.w) * bf_lo(w.w) + bf_hi(w.w) * bf_hi(w.w); }
    ss += __shfl_xor(ss, 32);
    const float rs = 1.0f / sqrtf(ss * (1.f / 128.f) + EPS);
    const int t = tpos + wid * QBLK + r32;
    const f32x2* rope = (const f32x2*)(lds + 81920);
#pragma unroll
    for (int d0 = 0; d0 < 8; ++d0) { const u32x4 w = raw[d0]; const float* wn = qn + d0 * 16 + hi * 8;
      const f32x4 g0 = *(const f32x4*)wn, g1 = *(const f32x4*)(wn + 4);
      float y[8] = {bf_lo(w.x) * rs * g0[0], bf_hi(w.x) * rs * g0[1], bf_lo(w.y) * rs * g0[2], bf_hi(w.y) * rs * g0[3], bf_lo(w.z) * rs * g1[0], bf_hi(w.z) * rs * g1[1], bf_lo(w.w) * rs * g1[2], bf_hi(w.w) * rs * g1[3]};
      if (tpos >= 0) {
        const int pos = (d0 < 4) ? (t >> 6) : (t & 63);
        const f32x4* rp = (const f32x4*)(rope + pos * 32 + (8 * (d0 & 3) + 4 * hi));
        const f32x4 c01 = rp[0], c23 = rp[1];
        const float cs[4] = {c01[0], c01[2], c23[0], c23[2]}, sn[4] = {c01[1], c01[3], c23[1], c23[3]};
#pragma unroll
        for (int pp = 0; pp < 4; ++pp) { const float x0 = y[2 * pp], x1 = y[2 * pp + 1]; y[2 * pp] = x0 * cs[pp] - x1 * sn[pp]; y[2 * pp + 1] = x0 * sn[pp] + x1 * cs[pp]; }
      }
      u32x4 o4 = {pk2(y[0], y[1]), pk2(y[2], y[3]), pk2(y[4], y[5]), pk2(y[6], y[7])};
      qr[d0] = __builtin_bit_cast(bf16x8, o4); }
  }
  const int sr = tid >> 4, sc = (tid & 15) * 8, vst0 = v_st(sr, sc), vst1 = v_st(32 + sr, sc);
  const int vb0 = (int)(uintptr_t)V_lds + v_rd_base(lane);
  struct { bf16x8 vs0, vs1, ks0, ks1; } sr_[2];
#define SLOAD(i, k0) do { sr_[i].vs0 = *reinterpret_cast<const bf16x8*>(&Vh[(long)((k0) + sr) * LDK + sc]); sr_[i].vs1 = *reinterpret_cast<const bf16x8*>(&Vh[(long)((k0) + 32 + sr) * LDK + sc]); \
    sr_[i].ks0 = *reinterpret_cast<const bf16x8*>(&Kh[(long)((k0) + sr) * LDK + sc]); sr_[i].ks1 = *reinterpret_cast<const bf16x8*>(&Kh[(long)((k0) + 32 + sr) * LDK + sc]); } while (0)
#define SWRITE(b, i) do { *(bf16x8*)((char*)V_lds + (b) * SHM_V + vst0) = sr_[i].vs0;          \
    *(bf16x8*)((char*)V_lds + (b) * SHM_V + vst1) = sr_[i].vs1; int kc = sc * 2;               \
    *(bf16x8*)((char*)K_lds + (b) * SHM_K + KSWZ(sr, kc)) = sr_[i].ks0;                       \
    *(bf16x8*)((char*)K_lds + (b) * SHM_K + KSWZ(32 + sr, kc)) = sr_[i].ks1; } while (0)
#define SWAIT() asm volatile("s_waitcnt vmcnt(4)" ::: "memory")
#define RESC(a) do { if (__any((a) < 1.f)) { if (hi == 0) al_l[r32] = (a); asm volatile("s_waitcnt lgkmcnt(0)" ::: "memory"); \
    _Pragma("unroll") for (int d = 0; d < 4; ++d) _Pragma("unroll") for (int r = 0; r < 16; ++r) o[d][r] *= al_l[crow(r, hi)]; } } while (0)
  f32x16 pA0, pA1, pB0, pB1; float mnA, mnB, alA, alB; bf16x8 pa0, pa1, pa2, pa3; const int NT = seq / KVBLK;
  constexpr int SE = 0, SO = 1;
  SLOAD(SE, 0); asm volatile("s_waitcnt vmcnt(0)" ::: "memory"); SWRITE(0, SE); __syncthreads();
  qkt(pA0, pA1, K_lds, qr, r32, hi); partialSM(pA0, pA1, m_reg, mnA, alA);
  SLOAD(SO, KVBLK); if (2 < NT) SLOAD(SE, 2 * KVBLK);
  SWAIT(); SWRITE(1, SO); __syncthreads();
  for (int j = 1; j + 1 < NT; j += 2) {
    SBAR(); qkt(pB0, pB1, (bf16_t*)((char*)K_lds + SHM_K), qr, r32, hi);
    finishSM(pA0, pA1, alA, l_reg, pa0, pa1, pa2, pa3); SBAR();
    SLOAD(SO, (j + 2) * KVBLK); SBAR();
    pv_d0(o, vb0, pa0, pa1, pa2, pa3); partialSM(pB0, pB1, m_reg, mnB, alB);
    __syncthreads(); SWAIT(); SWRITE(0, SE);
    RESC(alB); __syncthreads();
    SBAR(); qkt(pA0, pA1, K_lds, qr, r32, hi);
    finishSM(pB0, pB1, alB, l_reg, pa0, pa1, pa2, pa3); SBAR();
    if (j + 3 < NT) SLOAD(SE, (j + 3) * KVBLK); SBAR();
    pv_d0(o, vb0 + (int)SHM_V, pa0, pa1, pa2, pa3); partialSM(pA0, pA1, m_reg, mnA, alA);
    __syncthreads(); SWAIT(); SWRITE(1, SO);
    RESC(alA); __syncthreads();
  }
  SBAR(); qkt(pB0, pB1, (bf16_t*)((char*)K_lds + SHM_K), qr, r32, hi);
  finishSM(pA0, pA1, alA, l_reg, pa0, pa1, pa2, pa3); SBAR();
  pv_d0(o, vb0, pa0, pa1, pa2, pa3); partialSM(pB0, pB1, m_reg, mnB, alB);
  __syncthreads(); RESC(alB);
  finishSM(pB0, pB1, alB, l_reg, pa0, pa1, pa2, pa3); SBAR();
  pv_d0(o, vb0 + (int)SHM_V, pa0, pa1, pa2, pa3);
  u32x4 zq[8];
#pragma unroll
  for (int i = 0; i < 8; ++i) { const int id = tid + 512 * i; zq[i] = *(const u32x4*)(SZb + (long)(id >> 4) * LDQ + (id & 15) * 8); }
  if (hi == 0) li_l[r32] = l_reg; asm volatile("s_waitcnt lgkmcnt(0)" ::: "memory");
  __syncthreads();
  {
    float rli[16];
#pragma unroll
    for (int r = 0; r < 16; ++r) rli[r] = __builtin_amdgcn_rcpf(li_l[crow(r, hi)]);
    char* ost = lds;
#pragma unroll
    for (int r = 0; r < 16; ++r) { char* rowp = ost + (wid * QBLK + crow(r, hi)) * 256 + r32 * 2;
#pragma unroll
      for (int d0 = 0; d0 < 4; ++d0) *(unsigned short*)(rowp + d0 * 64) = (unsigned short)(pk2(o[d0][r] * rli[r], 0.f) & 0xffffu); }
  }
  __syncthreads();
#pragma unroll
  for (int i = 0; i < 8; ++i) { const int id = tid + 512 * i; const int row = id >> 4, ch = id & 15;
    const u32x4 ov = *(const u32x4*)(lds + row * 256 + ch * 16);
    f32x4 a0 = {bf_lo(ov.x), bf_hi(ov.x), bf_lo(ov.y), bf_hi(ov.y)}, a1 = {bf_lo(ov.z), bf_hi(ov.z), bf_lo(ov.w), bf_hi(ov.w)};
    const f32x4 z0 = {bf_lo(zq[i].x), bf_hi(zq[i].x), bf_lo(zq[i].y), bf_hi(zq[i].y)}, z1 = {bf_lo(zq[i].z), bf_hi(zq[i].z), bf_lo(zq[i].w), bf_hi(zq[i].w)};
    st_bf16x8(Ub + (long)row * LDQ + ch * 8, a0 * z0, a1 * z1); }
  __syncthreads();
#undef SLOAD
#undef SWRITE
#undef SWAIT
#undef RESC
}
#undef KSWZ
#undef SBAR
}

DI void qknorm_phase(const Args& A, LAS unsigned char* lds, int wv) {
    const int tid = otid(wv), lane = tid & 63, wave = tid >> 6, G = gridDim.x;
    bf16_t* Q = (bf16_t*)(A.ws + WS_SCR + A_Q); bf16_t* Kb = (bf16_t*)(A.ws + WS_SCR + A_K);
    const float* qn = A.in[14]; const float* kn = A.in[15];
    const int sub = lane >> 4, l16 = lane & 15, e0 = l16 * 8;
    LAS f32x2* rope = (LAS f32x2*)lds;
    for (int e = tid; e < 2048; e += NTHREADS) { const float ang = (float)(e >> 5) * exp2f(-(float)(e & 31) * 0.41524101186092029f); rope[e] = (f32x2){cosf(ang), sinf(ang)}; }
    __syncthreads();
    const long NIT = (long)NTOK * 4;
    for (long it0 = ((long)blockIdx.x * NWAVES + wave) * 16 + sub; it0 < NIT; it0 += (long)G * NWAVES * 16) {
        bf16_t* pq[4]; u32x4 raw[4];
#pragma unroll
        for (int k = 0; k < 4; ++k) { const long it = it0 + 4 * k; const int row = (int)(it >> 2), hj = 16 + (int)(it & 3);
            pq[k] = (hj < 16) ? Q + (size_t)row * 2048 + hj * 128 + e0 : Kb + (size_t)row * 512 + (hj - 16) * 128 + e0;
            raw[k] = *(const u32x4*)pq[k]; }
#pragma unroll
        for (int k = 0; k < 4; ++k) {
            const long it = it0 + 4 * k; const int row = (int)(it >> 2), hj = 16 + (int)(it & 3);
            const float* wn = (hj < 16 ? qn : kn) + e0;
            f32x4 a = {bf_lo(raw[k].x), bf_hi(raw[k].x), bf_lo(raw[k].y), bf_hi(raw[k].y)}, b = {bf_lo(raw[k].z), bf_hi(raw[k].z), bf_lo(raw[k].w), bf_hi(raw[k].w)};
            float ss = 0.f;
#pragma unroll
            for (int q = 0; q < 4; ++q) ss += a[q] * a[q] + b[q] * b[q];
            ss += __shfl_xor(ss, 1); ss += __shfl_xor(ss, 2); ss += __shfl_xor(ss, 4); ss += __shfl_xor(ss, 8);
            const float rs = 1.0f / sqrtf(ss * (1.f / 128.f) + EPS);
            const f32x4 w0 = *(const f32x4*)wn, w1 = *(const f32x4*)(wn + 4);
            a = a * rs * w0; b = b * rs * w1;
            const int t = row % TB;
            if (t < TL) {
                const int pos = (l16 < 8) ? (t >> 6) : (t & 63);
                float y[8] = {a[0], a[1], a[2], a[3], b[0], b[1], b[2], b[3]};
                const LAS f32x4* rp = (const LAS f32x4*)(rope + pos * 32 + ((4 * l16) & 31));
                const f32x4 c01 = rp[0], c23 = rp[1];
                const float cs[4] = {c01[0], c01[2], c23[0], c23[2]}, sn[4] = {c01[1], c01[3], c23[1], c23[3]};
#pragma unroll
                for (int pp = 0; pp < 4; ++pp) {
                    const float x0 = y[2 * pp], x1 = y[2 * pp + 1];
                    y[2 * pp] = x0 * cs[pp] - x1 * sn[pp]; y[2 * pp + 1] = x0 * sn[pp] + x1 * cs[pp];
                }
                a = (f32x4){y[0], y[1], y[2], y[3]}; b = (f32x4){y[4], y[5], y[6], y[7]};
            }
            st_bf16x8(pq[k], a, b);
        }
    }
}

DI void attn_layer(const Args& A, LAS unsigned char* lds, char* lds_gen, const XcdBarrier& gbar, int layer, int wv) {
    unsigned char* ws = A.ws;
    const bf16_t* H = (const bf16_t*)(ws + WS_H); bf16_t* U = (bf16_t*)(ws + WS_H);
    bf16_t* Q = (bf16_t*)(ws + WS_SCR + A_Q); bf16_t* Kb = (bf16_t*)(ws + WS_SCR + A_K); bf16_t* Vb = (bf16_t*)(ws + WS_SCR + A_V); bf16_t* SZ = (bf16_t*)(ws + WS_SCR + A_SZ);
    norm_phase(A, layer, false, wv);
    xcd_barrier(gbar, wv);
    {
        DescPlain D; D.init(H, (const bf16_t*)(ws + WS_WAI), 20, false);
        auto E = [=](const pg8::Unit& u, int row_l, int col_l, f32x4 v0, f32x4 v1) {
            const size_t row = (size_t)u.i0 * 256 + row_l; const int pn = u.i1;
            if (pn < 8) st_bf16x8(Q + row * 2048 + pn * 256 + col_l, v0, v1);
            else if (pn < 10) st_bf16x8(Kb + row * 512 + (pn - 8) * 256 + col_l, v0, v1);
            else if (pn < 12) st_bf16x8(Vb + row * 512 + (pn - 10) * 256 + col_l, v0, v1);
            else { f32x4 a, b;
#pragma unroll
                for (int q = 0; q < 4; ++q) { a[q] = siluf(v0[q]); b[q] = siluf(v1[q]); }
                st_bf16x8(SZ + row * 2048 + (pn - 12) * 256 + col_l, a, b); }
        };
        pg8::gemm_phase(lds, D, E, wv);
    }
    xcd_barrier(gbar, wv);
    qknorm_phase(A, lds, wv);
    xcd_barrier(gbar, wv);
    {
        const int G = gridDim.x, c = blockIdx.x;
        { f32x2* rope = (f32x2*)(lds_gen + 81920); const int tid = otid(wv);
          for (int e = tid; e < 2048; e += NTHREADS) { const float ang = (float)(e >> 5) * exp2f(-(float)(e & 31) * 0.41524101186092029f); rope[e] = (f32x2){cosf(ang), sinf(ang)}; }
          __syncthreads(); }
        const float* qn = A.in[14];
        for (long L = c; L < 2048; L += G) {
            const int u = pg8::xcd_remap((int)L, 2048);
            const int b = u / 128, rem = u % 128, kvh = rem / 32, g = (rem / 8) % 4, qb = rem % 8, h = kvh * 4 + g;
            const size_t qoff = ((size_t)b * TB + qb * 256) * 2048 + h * 128, koff = ((size_t)b * TB) * 512 + kvh * 128;
            att::attn_dense_body(Q + qoff, Kb + koff, Vb + koff, SZ + qoff, U + qoff, TB, lds_gen, wv, qn, qb * 256);
        }
        for (int u = c; u < 256; u += G) {
            const int b = u / 16, h = u % 16, kvh = h / 4;
            const size_t qoff = ((size_t)b * TB + TL) * 2048 + h * 128, koff = ((size_t)b * TB + TL) * 512 + kvh * 128;
            att::attn_dense_body(Q + qoff, Kb + koff, Vb + koff, SZ + qoff, U + qoff, TC, lds_gen, wv, qn, -1);
        }
    }
    xcd_barrier(gbar, wv);
    {
        DescPlain D; D.init(U, (const bf16_t*)(ws + WS_WAO), 8, false);
        EpiResid E; E.init(A, layer);
        pg8::gemm_phase(lds, D, E, wv);
    }
    xcd_barrier(gbar, wv);
}


struct DescM1 {
    static constexpr bool RAW = false;
    const bf16_t* H; const bf16_t* WA; const bf16_t* WB; int lda, ldb, K, total;
    DI void init(const bf16_t* H_, const bf16_t* WA_, const bf16_t* WB_) { H = H_; WA = WA_; WB = WB_; lda = DM; ldb = DM; K = DM; total = 144 * 9 + 8 * 144; }
    DI pg8::Unit unit(int idx) const {
        pg8::Unit u;
        if (idx < 1296) { const int nig = 72, gid = idx / nig, pm = gid * 8 + (idx % nig) % 8, pn = (idx % nig) / 8;
            u.a = (const char*)(H + (size_t)pm * 256 * DM); u.b = (const char*)(WA + (size_t)pn * 256 * DM); u.i0 = pm; u.i1 = pn; u.i2 = 0; }
        else { const int j = idx - 1296, mt = j % 8, nt = j / 8;
            u.a = (const char*)(WB + (size_t)mt * 256 * DM); u.b = (const char*)(H + (size_t)nt * 256 * DM); u.i0 = mt; u.i1 = nt; u.i2 = 1; }
        return u;
    }
};
namespace ml {
#define MFMA32(a, b, c) __builtin_amdgcn_mfma_f32_32x32x16_bf16((a), (b), (c), 0, 0, 0)
#define LFENCE() asm volatile("s_waitcnt lgkmcnt(0)" ::: "memory")
DI float dot2_bf16(unsigned a, unsigned b, float c) { asm("v_dot2c_f32_bf16 %0, %1, %2" : "+v"(c) : "v"(a), "v"(b)); return c; }
#define DOT2(a, b, c) dot2_bf16((a), (b), (c))
DI int crow(int reg, int h) { return (reg & 3) + 8 * (reg >> 2) + 4 * h; }
DI bf16x8 ldperm(const bf16_t* p) { const s16x4 lo = *(const s16x4*)p, hi = *(const s16x4*)(p + 8); return __builtin_shufflevector(lo, hi, 0, 1, 2, 3, 4, 5, 6, 7); }
DI bf16x8 pack_step(const f32x16& x, int s) { u32x4 p = {pk2(x[8 * s], x[8 * s + 1]), pk2(x[8 * s + 2], x[8 * s + 3]), pk2(x[8 * s + 4], x[8 * s + 5]), pk2(x[8 * s + 6], x[8 * s + 7])}; return __builtin_bit_cast(bf16x8, p); }
DI float bfs(short h) { return __uint_as_float(((unsigned)(unsigned short)h) << 16); }

constexpr int SC_Q = 0, SC_K = 16384, SC_KT = 32768, SC_BUF = 49152, SC_WAVE = 2 * SC_BUF, SC_WAVE_BYTES = 6656;
DI bf16x8 ldsfrag(const LAS unsigned char* buf, unsigned o) { const s16x4 lo = *(const LAS s16x4*)(buf + o), hi = *(const LAS s16x4*)(buf + (o ^ 16u)); return __builtin_shufflevector(lo, hi, 0, 1, 2, 3, 4, 5, 6, 7); }
DI void scan_phase(const Args& A, LAS unsigned char* lds, int wv) {
    const int wave = wv;
    LAS float* wl = (LAS float*)(lds + SC_WAVE + wave * SC_WAVE_BYTES);
    LAS unsigned* nbp = (LAS unsigned*)(lds + SC_WAVE + wave * SC_WAVE_BYTES + 2048);
    LAS unsigned* wbp = nbp + 64;
    LAS unsigned char* hst = lds + SC_WAVE + wave * SC_WAVE_BYTES + 2560;
    unsigned char* ws = A.ws;
    const bf16_t* Qg = (const bf16_t*)(ws + WS_SCR + M_Q); const bf16_t* Kg = (const bf16_t*)(ws + WS_SCR + M_K); const bf16_t* KVT = (const bf16_t*)(ws + WS_SCR + M_KVT);
    const float* G32 = (const float*)(ws + WS_SCR + M_G32); const float* bg = A.in[10];
#define SC_POS0(j) (dir == 0 ? ((j) < 4 ? TL + 64 * (j) : 64 * ((j) - 4)) : ((j) < 4 ? TL + 64 * (3 - (j)) : 64 * (35 - (j))))
#define SC_DMA(bufi, p0) do { const int tj_ = otid(wv); _Pragma("unroll") for (int i_ = 0; i_ < 2; ++i_) { const int sl_ = i_ * 512 + tj_; \
        { const int row_ = sl_ >> 4, c_ = (sl_ & 15) ^ (row_ & 15); const size_t go_ = (size_t)((p0) + row_) * 1024 + c_ * 8; \
          __builtin_amdgcn_global_load_lds((const unsigned*)(Qu + go_), (LAS unsigned*)(lds + (bufi) * SC_BUF + SC_Q + i_ * 8192 + wave * 1024), 16, 0, 0); \
          __builtin_amdgcn_global_load_lds((const unsigned*)(Ku + go_), (LAS unsigned*)(lds + (bufi) * SC_BUF + SC_K + i_ * 8192 + wave * 1024), 16, 0, 0); } \
        { const int d_ = sl_ >> 3, c_ = (sl_ & 7) ^ ((d_ >> 1) & 7); \
          __builtin_amdgcn_global_load_lds((const unsigned*)(KTu + (size_t)d_ * TB + (p0) + c_ * 8), (LAS unsigned*)(lds + (bufi) * SC_BUF + SC_KT + i_ * 8192 + wave * 1024), 16, 0, 0); } } } while (0)
    for (int item = blockIdx.x; item < 256; item += gridDim.x) {
        const int dir = item & 1, h = (item >> 1) & 7, b = item >> 4, e0 = wave * 32;
        const bf16_t* Qu = Qg + (size_t)b * TB * 1024 + h * 128;
        const bf16_t* Ku = Kg + (size_t)b * TB * 1024 + h * 128;
        const bf16_t* KTu = KVT + ((size_t)b * 3072 + h * 128) * TB;
        const bf16_t* VTu = KVT + ((size_t)b * 3072 + 1024 + h * 256 + e0) * TB;
        bf16_t* Hout = (bf16_t*)(ws + WS_SCR + (dir ? M_HB : M_HF)) + (size_t)b * TB * DM + h * 256 + e0;
        const float big = bg[(dir * 2) * 8 + h], bfg = bg[(dir * 2 + 1) * 8 + h];
        f32x16 cacc[4];
#pragma unroll
        for (int d = 0; d < 4; ++d)
#pragma unroll
            for (int i = 0; i < 16; ++i) cacc[d][i] = 0.f;
        float m = 0.f;
        { const int l0 = otid(wv) & 63; wl[384 + l0] = 0.f; wl[448 + l0] = 0.f; nbp[l0] = 0u; }
        LFENCE();
        SC_DMA(0, SC_POS0(0));
        float ig_n, fg_n;
        { const int l0 = otid(wv) & 63; const float* gp = G32 + (size_t)(b * TB + SC_POS0(0) + (dir ? 63 - l0 : l0)) * 32 + (dir * 2) * 8 + h; ig_n = gp[0]; fg_n = gp[8]; }
        for (int j = 0; j < 36; ++j) {
            const int pos0 = SC_POS0(j);
            const LAS unsigned char* Qb = lds + (j & 1) * SC_BUF + SC_Q; const LAS unsigned char* Kb = lds + (j & 1) * SC_BUF + SC_K; const LAS unsigned char* KTb = lds + (j & 1) * SC_BUF + SC_KT;
            asm volatile("s_waitcnt vmcnt(0)" ::: "memory"); __builtin_amdgcn_s_barrier(); asm volatile("" ::: "memory");
            if (j + 1 < 36) SC_DMA((j + 1) & 1, SC_POS0(j + 1));
            const int lj = otid(wv) & 63, rj = lj & 31, h4 = (lj >> 5) * 4;
            LAS float* wh = wl + h4; LAS float* wr = wl + rj; LAS unsigned char* hb = hst + h4 * 64 + rj * 2;
            const LAS unsigned* nbh = nbp + (h4 >> 1); const LAS unsigned* wbh = wbp + (h4 >> 1);
            const unsigned xr = rj & 15, xd = (rj >> 1) & 7;
            const unsigned qro = (unsigned)rj * 256u + 2u * h4;
            const unsigned kro = (unsigned)rj * 128u + 2u * h4;
            const bf16_t* VTp = VTu + (size_t)rj * TB + pos0 + h4;
            bf16x8 vf[4];
#pragma unroll
            for (int kk = 0; kk < 4; ++kk) vf[kk] = ldperm(VTp + 16 * kk);
            float decay, m_new;
            {
                const int s = dir ? 63 - lj : lj;
                const float ig = ig_n + big, fg = fg_n + bfg;
                if (j + 1 < 36) { const float* gp = G32 + (size_t)(b * TB + SC_POS0(j + 1) + s) * 32 + (dir * 2) * 8 + h; ig_n = gp[0]; fg_n = gp[8]; }
                const float lf = fminf(fg, 0.f) - log1pf(__expf(-fabsf(fg)));
                float bs = lf;
#pragma unroll
                for (int o = 1; o < 64; o <<= 1) { const float t = __shfl_up(bs, o); if (lj >= o) bs += t; }
                const float uu = ig - bs;
                float pmx = uu;
#pragma unroll
                for (int o = 1; o < 64; o <<= 1) { const float t = __shfl_up(pmx, o); if (lj >= o) pmx = fmaxf(pmx, t); }
                pmx = fmaxf(pmx, m);
                const float b_end = __shfl(bs, 63), pm_last = __shfl(pmx, 63);
                LAS float* ws_ = wl + s;
                ws_[0] = uu * 1.4426950408889634f; ws_[64] = pmx * 1.4426950408889634f; ws_[128] = __expf(m - pmx); ws_[192] = __expf(-(bs + pmx)); ws_[256] = __expf(uu - pm_last);
                { const float wv_ = __expf(uu - pm_last), wp_ = __shfl_xor(wv_, 1); if ((s & 1) == 0) wbp[s >> 1] = pk2(wv_, wp_); }
                decay = __expf(m - pm_last); m_new = b_end + pm_last;
            }
            LFENCE();
            const int sbase = dir ? 63 - h4 : h4, sgn = dir ? -1 : 1;
#pragma unroll
            for (int tb = 0; tb < 2; ++tb) {
                __builtin_amdgcn_sched_barrier(0);
                const unsigned qo = qro + tb * 8192u;
                f32x16 ha;
#pragma unroll
                for (int i = 0; i < 16; ++i) ha[i] = 0.f;
                float qnv = 0.f;
#pragma unroll
                for (int kk = 0; kk < 8; ++kk) {
                    const bf16x8 qa = ldsfrag(Qb, qo + (((2u * kk) ^ xr) << 4));
                    ha = MFMA32(qa, pack_step(cacc[kk >> 1], kk & 1), ha);
                    { const u32x2 nb0 = *(const LAS u32x2*)(nbh + 8 * kk), nb1 = *(const LAS u32x2*)(nbh + 8 * kk + 4); const u32x4 qw = __builtin_bit_cast(u32x4, qa);
                      qnv = DOT2(qw.x, nb0.x, qnv); qnv = DOT2(qw.y, nb0.y, qnv); qnv = DOT2(qw.z, nb1.x, qnv); qnv = DOT2(qw.w, nb1.y, qnv); }
                }
                qnv += __shfl_xor(qnv, 32);
#pragma unroll
                for (int g = 0; g < 4; ++g) { const f32x4 av = *(const LAS f32x4*)(wh + 128 + 32 * tb + 8 * g);
#pragma unroll
                    for (int q = 0; q < 4; ++q) ha[4 * g + q] *= av[q]; }
                const float pmt = wr[64 + 32 * tb];
                const int tp = dir ? (63 - 32 * tb) - rj : 32 * tb + rj;
                float ds = 0.f;
#pragma unroll
                for (int sb = 0; sb < 2; ++sb) {
                    __builtin_amdgcn_sched_barrier(0);
                    if (sb != tb && (dir ? sb < tb : sb > tb)) continue;
                    const unsigned ko = qro + sb * 8192u;
                    f32x16 st;
#pragma unroll
                    for (int i = 0; i < 16; ++i) st[i] = 0.f;
#pragma unroll
                    for (int kk = 0; kk < 8; ++kk) { const unsigned c = ((2u * kk) ^ xr) << 4; st = MFMA32(ldsfrag(Kb, ko + c), ldsfrag(Qb, qo + c), st); }
#pragma unroll
                    for (int g = 0; g < 4; ++g) { const f32x4 uv = *(const LAS f32x4*)(wh + 32 * sb + 8 * g);
#pragma unroll
                        for (int q = 0; q < 4; ++q) {
                            const int sc = 32 * sb + q + 8 * g;
                            const int sp = sbase + sgn * sc;
                            st[4 * g + q] *= __builtin_amdgcn_exp2f((sp <= tp) ? uv[q] - pmt : -1e30f);
                            ds += st[4 * g + q];
                        } }
                    ha = MFMA32(pack_step(st, 0), vf[2 * sb], ha);
                    ha = MFMA32(pack_step(st, 1), vf[2 * sb + 1], ha);
                }
                ds += __shfl_xor(ds, 32);
                {
                    const float den = wr[128 + 32 * tb] * qnv + ds;
                    const float rd = 1.0f / fmaxf(fabsf(den), wr[192 + 32 * tb]);
                    if (h4 == 0) wr[320 + 32 * tb] = rd;
                }
                LFENCE();
#pragma unroll
                for (int g = 0; g < 4; ++g) { const f32x4 rv = *(const LAS f32x4*)(wh + 320 + 32 * tb + 8 * g);
#pragma unroll
                    for (int q = 0; q < 4; ++q) { const int tc = 32 * tb + q + 8 * g;
                        *(LAS unsigned short*)(hb + tc * 64) = (unsigned short)(pk2(ha[4 * g + q] * rv[q], 0.f) & 0xffffu); } }
            }
            LFENCE();
            {
                bf16_t* hp = Hout + (size_t)(pos0 + lj) * DM;
                const LAS unsigned char* hrow = hst + lj * 64;
#pragma unroll
                for (int q = 0; q < 4; ++q) *(u32x4*)(hp + 8 * q) = *(const LAS u32x4*)(hrow + 16 * q);
            }
            __builtin_amdgcn_sched_barrier(0);
            bf16x8 vfw[4];
#pragma unroll
            for (int kk = 0; kk < 4; ++kk) {
                const f32x4 w0 = *(const LAS f32x4*)(wh + 256 + 16 * kk), w1 = *(const LAS f32x4*)(wh + 256 + 16 * kk + 8);
                u32x4 p = {pk2(bfs(vf[kk][0]) * w0[0], bfs(vf[kk][1]) * w0[1]), pk2(bfs(vf[kk][2]) * w0[2], bfs(vf[kk][3]) * w0[3]),
                           pk2(bfs(vf[kk][4]) * w1[0], bfs(vf[kk][5]) * w1[1]), pk2(bfs(vf[kk][6]) * w1[2], bfs(vf[kk][7]) * w1[3])};
                vfw[kk] = __builtin_bit_cast(bf16x8, p);
            }
#pragma unroll
            for (int db = 0; db < 4; ++db) {
#pragma unroll
                for (int i = 0; i < 16; ++i) cacc[db][i] *= decay;
                const unsigned to = kro + db * 4096u;
                float nadd = 0.f;
#pragma unroll
                for (int kk = 0; kk < 4; ++kk) {
                    const bf16x8 kv = ldsfrag(KTb, to + (((2u * kk) ^ xd) << 4));
                    const u32x2 wq0 = *(const LAS u32x2*)(wbh + 8 * kk), wq1 = *(const LAS u32x2*)(wbh + 8 * kk + 4); const u32x4 kw = __builtin_bit_cast(u32x4, kv);
                    nadd = DOT2(kw.x, wq0.x, nadd); nadd = DOT2(kw.y, wq0.y, nadd); nadd = DOT2(kw.z, wq1.x, nadd); nadd = DOT2(kw.w, wq1.y, nadd);
                    cacc[db] = MFMA32(kv, vfw[kk], cacc[db]);
                }
                nadd += __shfl_xor(nadd, 32);
                const float nnew = decay * wr[384 + 32 * db] + nadd, npart = __shfl_xor(nnew, 1);
                if (h4 == 0) { wr[384 + 32 * db] = nnew; if ((rj & 1) == 0) nbp[(32 * db + rj) >> 1] = pk2(nnew, npart); }
            }
            LFENCE();
            m = m_new;
        }
        asm volatile("s_waitcnt vmcnt(0)" ::: "memory"); __builtin_amdgcn_s_barrier();
    }
#undef SC_DMA
#undef SC_POS0
}
#undef MFMA32
#undef LFENCE
#undef DOT2
}

DI void mlstm_finish_phase(const Args& A, int wv) {
    const int tid = otid(wv), lane = tid & 63, wave = tid >> 6, G = gridDim.x;
    unsigned char* ws = A.ws;
    const bf16_t* HF = (const bf16_t*)(ws + WS_SCR + M_HF); const bf16_t* HB = (const bf16_t*)(ws + WS_SCR + M_HB);
    const bf16_t* SO = (const bf16_t*)(ws + WS_SCR + M_SO); const bf16_t* SZ = (const bf16_t*)(ws + WS_SCR + M_SZ);
    bf16_t* U = (bf16_t*)(ws + WS_H); const float* hn = A.in[11];
    const int sub = lane >> 5, e0 = (lane & 31) * 8;
    const long NIT = (long)NTOK * 8;
    for (long it0 = ((long)blockIdx.x * NWAVES + wave) * 4 + sub; it0 < NIT; it0 += (long)G * NWAVES * 4) {
        f32x4 f0[2], f1[2], b0[2], b1[2], o0[2], o1[2], z0[2], z1[2];
#pragma unroll
        for (int k = 0; k < 2; ++k) { const long it = it0 + 2 * k; const size_t off = (size_t)(it >> 3) * DM + (int)(it & 7) * 256 + e0;
            ld_bf16x8(HF + off, f0[k], f1[k]); ld_bf16x8(HB + off, b0[k], b1[k]); ld_bf16x8(SO + off, o0[k], o1[k]); ld_bf16x8(SZ + off, z0[k], z1[k]); }
#pragma unroll
        for (int k = 0; k < 2; ++k) { const long it = it0 + 2 * k; const size_t off = (size_t)(it >> 3) * DM + (int)(it & 7) * 256 + e0;
            f32x4 y0 = o0[k] * (f0[k] + b0[k]), y1 = o1[k] * (f1[k] + b1[k]);
            float ss = 0.f;
#pragma unroll
            for (int q = 0; q < 4; ++q) ss += y0[q] * y0[q] + y1[q] * y1[q];
            ss += __shfl_xor(ss, 1); ss += __shfl_xor(ss, 2); ss += __shfl_xor(ss, 4); ss += __shfl_xor(ss, 8); ss += __shfl_xor(ss, 16);
            const float rs = 1.0f / sqrtf(ss * (1.f / 256.f) + EPS);
            const float* hp = hn + (int)(it & 7) * 256 + e0;
            const f32x4 h0 = *(const f32x4*)hp, h1 = *(const f32x4*)(hp + 4);
            st_bf16x8(U + off, y0 * rs * h0 * z0[k], y1 * rs * h1 * z1[k]); }
    }
}

DI void mlstm_layer(const Args& A, LAS unsigned char* lds, const XcdBarrier& gbar, int layer, int wv) {
    unsigned char* ws = A.ws;
    const bf16_t* H = (const bf16_t*)(ws + WS_H); bf16_t* U = (bf16_t*)(ws + WS_H);
    bf16_t* Q = (bf16_t*)(ws + WS_SCR + M_Q); bf16_t* Kb = (bf16_t*)(ws + WS_SCR + M_K); bf16_t* KVT = (bf16_t*)(ws + WS_SCR + M_KVT);
    float* G32 = (float*)(ws + WS_SCR + M_G32); bf16_t* SO = (bf16_t*)(ws + WS_SCR + M_SO); bf16_t* SZ = (bf16_t*)(ws + WS_SCR + M_SZ);
    norm_phase(A, layer, false, wv);
    xcd_barrier(gbar, wv);
    {
        DescM1 D; D.init(H, (const bf16_t*)(ws + WS_WMA), (const bf16_t*)(ws + WS_WMB));
        auto E = [=](const pg8::Unit& u, int row_l, int col_l, f32x4 v0, f32x4 v1) {
            if (u.i2 == 0) {
                const size_t row = (size_t)u.i0 * 256 + row_l; const int pn = u.i1;
                if (pn < 4) st_bf16x8(Q + row * 1024 + pn * 256 + col_l, v0 * 0.088388347648318440f, v1 * 0.088388347648318440f);
                else if (pn < 8) { st_bf16x8(Kb + row * 1024 + (pn - 4) * 256 + col_l, v0, v1);
                    const int bb = u.i0 / 9, sp = (u.i0 % 9) * 256 + row_l;
                    bf16_t* kt = KVT + ((size_t)bb * 3072 + (pn - 4) * 256 + col_l) * TB + sp;
                    const unsigned w0 = pk2(v0[0], v0[1]), w1 = pk2(v0[2], v0[3]), w2 = pk2(v1[0], v1[1]), w3 = pk2(v1[2], v1[3]);
                    kt[0] = (bf16_t)(w0 & 0xffffu); kt[TB] = (bf16_t)(w0 >> 16); kt[2 * TB] = (bf16_t)(w1 & 0xffffu); kt[3 * TB] = (bf16_t)(w1 >> 16);
                    kt[4 * TB] = (bf16_t)(w2 & 0xffffu); kt[5 * TB] = (bf16_t)(w2 >> 16); kt[6 * TB] = (bf16_t)(w3 & 0xffffu); kt[7 * TB] = (bf16_t)(w3 >> 16); }
                else if (col_l < 32) { *(f32x4*)(G32 + row * 32 + col_l) = v0; *(f32x4*)(G32 + row * 32 + col_l + 4) = v1; }
            } else {
                const int bb = u.i1 / 9, s0 = (u.i1 % 9) * 256;
                st_bf16x8(KVT + ((size_t)bb * 3072 + 1024 + u.i0 * 256 + row_l) * TB + s0 + col_l, v0, v1);
            }
        };
        pg8::gemm_phase(lds, D, E, wv);
    }
    xcd_barrier(gbar, wv);
    ml::scan_phase(A, lds, wv);
    xcd_barrier(gbar, wv);
    {
        DescPlain D; D.init(H, (const bf16_t*)(ws + WS_WMA) + (size_t)2304 * DM, 16, false);
        auto E = [=](const pg8::Unit& u, int row_l, int col_l, f32x4 v0, f32x4 v1) {
            const size_t row = (size_t)u.i0 * 256 + row_l; const int pn = u.i1; f32x4 a, b;
            if (pn < 8) {
#pragma unroll
                for (int q = 0; q < 4; ++q) { a[q] = sigmf(v0[q]); b[q] = sigmf(v1[q]); }
                st_bf16x8(SO + row * DM + pn * 256 + col_l, a, b);
            } else {
#pragma unroll
                for (int q = 0; q < 4; ++q) { a[q] = siluf(v0[q]); b[q] = siluf(v1[q]); }
                st_bf16x8(SZ + row * DM + (pn - 8) * 256 + col_l, a, b);
            }
        };
        pg8::gemm_phase(lds, D, E, wv);
    }
    xcd_barrier(gbar, wv);
    mlstm_finish_phase(A, wv);
    xcd_barrier(gbar, wv);
    {
        DescPlain D; D.init(U, (const bf16_t*)(ws + WS_WMO), 8, false);
        EpiResid E; E.init(A, layer);
        pg8::gemm_phase(lds, D, E, wv);
    }
    xcd_barrier(gbar, wv);
}

__global__ void __launch_bounds__(NTHREADS, 2) fwd_megakernel(Args A) {
    extern __shared__ __attribute__((aligned(16))) unsigned char lds_raw[];
    LAS unsigned char* lds = (LAS unsigned char*)lds_raw;
    cg::grid_group grid = cg::this_grid();
    const int wv = __builtin_amdgcn_readfirstlane(threadIdx.x >> 6);
    volatile LAS unsigned* bst = (volatile LAS unsigned*)(lds + 152576);
    if (otid(wv) < 2) bst[otid(wv)] = 0u;
    __syncthreads();
    const XcdBarrier gbar = xcd_barrier_post((unsigned*)(A.ws + WS_BAR), bst, wv);
    prep_phase(A, lds, wv);
    grid.sync();
    {
        const long long* mi = (const long long*)(A.ws + WS_MODI); float* mf = (float*)(A.ws + WS_MOD);
        for (int i = blockIdx.x * NTHREADS + otid(wv); i < 4 * 17 * MOD_LD; i += gridDim.x * NTHREADS) mf[i] = (float)mi[i] * MODI_INV;
    }
    xcd_barrier(gbar, wv);
    fnet_layer(A, lds, gbar, 0, 0, false, wv);
    mlstm_layer(A, lds, gbar, 1, wv);
    attn_layer(A, lds, (char*)lds_raw, gbar, 2, wv);
    fnet_layer(A, lds, gbar, 3, 1, true, wv);
    final_norm_phase(A, (const bf16_t*)(A.ws + WS_SCR + F_PQX), wv);
}

extern "C" void kernel_launch(void* const* d_in, const int* in_sizes, int n_in, void* d_out, int out_size, void* d_ws, size_t ws_size, hipStream_t stream) {
    static int grid = 0;
    if (grid == 0) {
        if (n_in != 18 || ws_size < WS_END) { fprintf(stderr, "kernel_launch: unexpected n_in %d / ws_size %zu (need %zu)\n", n_in, ws_size, (size_t)WS_END); grid = -1; return; }
        int dev = 0, cus = 0, per_cu = 0;
        hipGetDevice(&dev);
        hipDeviceGetAttribute(&cus, hipDeviceAttributeMultiprocessorCount, dev);
        if (hipFuncSetAttribute((const void*)fwd_megakernel, hipFuncAttributeMaxDynamicSharedMemorySize, LDS_BYTES) != hipSuccess) { fprintf(stderr, "kernel_launch: hipFuncSetAttribute failed\n"); grid = -1; return; }
        if (hipOccupancyMaxActiveBlocksPerMultiprocessor(&per_cu, (const void*)fwd_megakernel, NTHREADS, LDS_BYTES) != hipSuccess || per_cu < 1) { fprintf(stderr, "kernel_launch: occupancy query failed (%d)\n", per_cu); per_cu = 1; }
        (void)hipGetLastError();
        grid = cus * per_cu;
        fprintf(stderr, "kernel_launch: grid %d (cus %d x %d)\n", grid, cus, per_cu);
    }
    if (grid < 0) return;
    (void)hipMemsetAsync((char*)d_ws + WS_MOD, 0, ZERO_BYTES, stream);
    (void)hipMemsetAsync((char*)d_ws + WS_MODI, 0, MODI_BYTES, stream);
    Args a{};
    for (int i = 0; i < 18; ++i) a.in[i] = (const float*)d_in[i];
    a.out = (float*)d_out; a.ws = (unsigned char*)d_ws; a.ph_lo = 0; a.ph_hi = 100;
    void* args[] = {&a};
    hipError_t e = hipLaunchCooperativeKernel((const void*)fwd_megakernel, dim3(grid), dim3(NTHREADS), args, LDS_BYTES, stream);
    if (e != hipSuccess) fprintf(stderr, "kernel_launch: cooperative launch failed: %s (grid %d)\n", hipGetErrorString(e), grid);
}
```

```cpp
#include <hip/hip_runtime.h>
#include <hip/hip_cooperative_groups.h>
#include <cstdio>
#include <cstdint>
#include <type_traits>
namespace cg = cooperative_groups;

#define LAS __attribute__((address_space(3)))
#define DI __device__ __forceinline__
typedef unsigned short bf16_t;
typedef short bf16x8 __attribute__((ext_vector_type(8)));
typedef short s16x4 __attribute__((ext_vector_type(4)));
typedef float f32x2 __attribute__((ext_vector_type(2)));
typedef float f32x4 __attribute__((ext_vector_type(4)));
typedef float f32x16 __attribute__((ext_vector_type(16)));
typedef unsigned u32x2 __attribute__((ext_vector_type(2)));
typedef unsigned u32x4 __attribute__((ext_vector_type(4)));
typedef __bf16 bf16v2 __attribute__((ext_vector_type(2)));

constexpr int DM = 2048, NB = 16, TL = 2048, TC = 256, TB = TL + TC, NTOK = NB * TB;
constexpr int NWAVES = 8, NTHREADS = 512;
constexpr float EPS = 1e-6f;
constexpr int MOD_LD = 3 * DM;
constexpr int M_WA_ROWS = 6400, M_WB_ROWS = 3072;
constexpr size_t MiB = 1u << 20;
constexpr size_t WS_SCR_ = 301 * MiB;
constexpr size_t WS_MOD = 0;
constexpr size_t MOD_BYTES = (size_t)4 * 17 * MOD_LD * 4;
constexpr size_t WS_BAR = 1792 * 1024, ZERO_BYTES = 2 * MiB;
constexpr size_t WS_MODI = WS_SCR_ + 700 * MiB, MODI_BYTES = (size_t)4 * 17 * MOD_LD * 8;
constexpr float MODI_SCALE = 1073741824.f, MODI_INV = 9.313225746154785e-10f;
constexpr size_t WS_WFG = 2 * MiB, WS_WFO = 18 * MiB, WS_WMA = 34 * MiB, WS_WMB = 59 * MiB, WS_WMO = 71 * MiB, WS_WAI = 79 * MiB, WS_WAO = 99 * MiB;
constexpr size_t WS_DC = 107 * MiB, WS_DT = 108 * MiB, WS_DT2 = 124 * MiB, WS_CTXS = 125 * MiB, WS_H = 157 * MiB, WS_SCR = 301 * MiB;
constexpr size_t WS_END = 1024 * MiB;
constexpr size_t F_G = 0, F_PQX = 144 * MiB, F_PQC = 400 * MiB, F_A1 = 432 * MiB;
constexpr size_t M_Q = 0, M_K = 72 * MiB, M_KVT = 144 * MiB, M_G32 = 360 * MiB, M_HF = 365 * MiB, M_HB = 509 * MiB, M_SO = 0, M_SZ = 144 * MiB;
constexpr size_t A_Q = 0, A_K = 144 * MiB, A_V = 180 * MiB, A_SZ = 216 * MiB;
static_assert(WS_SCR + M_HB + 144 * MiB <= WS_END, "ws map");
constexpr int LDS_BYTES = 152576 + 1024;

DI unsigned pk2(float a, float b) { f32x2 v = {a, b}; return __builtin_bit_cast(unsigned, __builtin_convertvector(v, bf16v2)); }
DI float bf_lo(unsigned w) { return __uint_as_float(w << 16); }
DI float bf_hi(unsigned w) { return __uint_as_float(w & 0xffff0000u); }
DI float wave_sum(float v) {
#pragma unroll
    for (int o = 1; o < 64; o <<= 1) v += __shfl_xor(v, o);
    return v;
}
DI int otid(int wv) { int t; asm volatile("v_mbcnt_lo_u32_b32 %0, -1, 0\n\tv_mbcnt_hi_u32_b32 %0, -1, %0" : "=v"(t)); return wv * 64 + t; }
DI float dot2g(unsigned a, unsigned b, float c) { asm("v_dot2c_f32_bf16 %0, %1, %2" : "+v"(c) : "v"(a), "v"(b)); return c; }
DI float siluf(float x) { return x * __builtin_amdgcn_rcpf(1.f + __expf(-x)); }
DI float sigmf(float x) { return __builtin_amdgcn_rcpf(1.f + __expf(-x)); }
DI void st_bf16x8(bf16_t* p, f32x4 a, f32x4 b) { u32x4 w = {pk2(a[0], a[1]), pk2(a[2], a[3]), pk2(b[0], b[1]), pk2(b[2], b[3])}; *(u32x4*)p = w; }
DI void ld_bf16x8(const bf16_t* p, f32x4& a, f32x4& b) { const u32x4 w = *(const u32x4*)p; a = (f32x4){bf_lo(w.x), bf_hi(w.x), bf_lo(w.y), bf_hi(w.y)}; b = (f32x4){bf_lo(w.z), bf_hi(w.z), bf_lo(w.w), bf_hi(w.w)}; }

DI f32x4 ldmod4(const long long* p) { return (f32x4){(float)p[0] * MODI_INV, (float)p[1] * MODI_INV, (float)p[2] * MODI_INV, (float)p[3] * MODI_INV}; }

struct Args { const float* in[18]; float* out; unsigned char* ws; int ph_lo, ph_hi; };

#define XB_TMO      128
#define XB_XCNT(j)  (256  + 64 * (j))
#define XB_XSUB(j)  (1280 + 64 * (j))
#define XB_XGEN(j)  (2304 + 64 * (j))
#define XB_TOP      3328
#define XB_TOPGEN   3392
#define XCD_BAR_WORDS 3456
#define XB_SPIN_CAP (1u << 18)

__device__ __forceinline__ unsigned xb_ld(unsigned* p)              { return __hip_atomic_load(p, __ATOMIC_RELAXED, __HIP_MEMORY_SCOPE_AGENT); }
__device__ __forceinline__ unsigned xb_add(unsigned* p, unsigned v) { return __hip_atomic_fetch_add(p, v, __ATOMIC_RELAXED, __HIP_MEMORY_SCOPE_AGENT); }
__device__ __forceinline__ unsigned xb_xcc_id() { return (unsigned)__builtin_amdgcn_s_getreg((3 << 11) | 20) & 0xFu; }
#define XB_SPIN(cond, bar) do { unsigned _sp = 0; while (cond) { __builtin_amdgcn_s_sleep(1); \
    if ((++_sp & 255u) == 0u) { if (xb_ld(&(bar)[XB_TMO])) break; if (_sp > XB_SPIN_CAP) { atomicAdd(&(bar)[XB_TMO], 1u); break; } } } } while (0)

struct XcdBarrier {
    unsigned* bar; unsigned x;
    volatile LAS unsigned* st;
};

__device__ __forceinline__ XcdBarrier xcd_barrier_post(unsigned* bar, volatile LAS unsigned* st, int wv) {
    XcdBarrier b; b.bar = bar; b.x = xb_xcc_id(); b.st = st;
    if (otid(wv) == 0) (void)xb_add(&bar[XB_XCNT(b.x)], 1u);
    return b;
}
__device__ __forceinline__ void xcd_barrier_complete(unsigned* bar, unsigned x, unsigned& nloc, unsigned& nx) {
    const unsigned G = gridDim.x * gridDim.y * gridDim.z;
    unsigned sum, cnt, mine, sp = 0u;
    for (;;) {
        sum = 0u; cnt = 0u; mine = 0u;
#pragma unroll
        for (unsigned j = 0; j < 16; ++j) { const unsigned c = xb_ld(&bar[XB_XCNT(j)]); sum += c; cnt += (c > 0u) ? 1u : 0u; mine = (j == x) ? c : mine; }
        if (sum == G) break;
        __builtin_amdgcn_s_sleep(1);
        if ((++sp & 255u) == 0u) { if (xb_ld(&bar[XB_TMO])) break; if (sp > XB_SPIN_CAP) { atomicAdd(&bar[XB_TMO], 1u); break; } }
    }
    nloc = mine > 0u ? mine : 1u; nx = cnt > 0u ? cnt : 1u;
}

__device__ __forceinline__ void xcd_barrier(const XcdBarrier& b, int wv) {
    asm volatile("s_waitcnt vmcnt(0)" ::: "memory");
    __syncthreads();
    if (otid(wv) == 0) {
        unsigned* bar = b.bar;
        __builtin_amdgcn_s_waitcnt(0);
        unsigned nloc = b.st[0], nx = b.st[1];
        if (nloc == 0u) { xcd_barrier_complete(bar, b.x, nloc, nx); b.st[0] = nloc; b.st[1] = nx; }
        const unsigned old = xb_add(&bar[XB_XSUB(b.x)], 1u);
        const unsigned gen = old / nloc;
        if (old + 1u == (gen + 1u) * nloc) {
            __builtin_amdgcn_fence(__ATOMIC_RELEASE, "agent");
            asm volatile("s_waitcnt vmcnt(0)" ::: "memory");
            const unsigned og = xb_add(&bar[XB_TOP], 1u);
            const unsigned tg = og / nx;
            if (og + 1u == (tg + 1u) * nx) xb_add(&bar[XB_TOPGEN], 1u);
            else XB_SPIN(xb_ld(&bar[XB_TOPGEN]) == tg, bar);
            __builtin_amdgcn_fence(__ATOMIC_ACQUIRE, "agent");
            xb_add(&bar[XB_XGEN(b.x)], 1u);
            asm volatile("s_waitcnt vmcnt(0)" ::: "memory");
        } else {
            XB_SPIN(xb_ld(&bar[XB_XGEN(b.x)]) == gen, bar);
            __builtin_amdgcn_fence(__ATOMIC_ACQUIRE, "agent");
            asm volatile("s_waitcnt vmcnt(0)" ::: "memory");
        }
    }
    __syncthreads();
}


namespace pg8 {
constexpr int BM = 256, BK = 64, HALF = 128, HTB = HALF * BK * 2, NXCD = 8;
DI int lds_byte(int r, int c) { const int st = (r >> 4) * 2 + (c >> 5), rr = r & 15, cc = c & 31, ob = rr * 64 + cc * 2; return st * 1024 + (ob ^ (((ob >> 9) & 1) << 5)); }
DI void stage_rc(int b, int& R, int& C) { const int st = b / 1024, sb = b % 1024, swz = sb ^ (((sb >> 9) & 1) << 5); R = (st >> 1) * 16 + swz / 64; C = (st & 1) * 32 + (swz % 64) / 2; }
DI int perm32(int rho) { const int n = rho >> 4, i = rho & 15; return 8 * (i >> 2) + 4 * n + (i & 3); }
struct Unit { const char* a; const char* b; int i0, i1, i2; };
template <class T, class = void> struct is_whole_tile : std::false_type {};
template <class T> struct is_whole_tile<T, std::void_t<decltype(T::WHOLE_TILE)>> : std::true_type {};
DI int xcd_remap(int L, int total) { const int q = total / NXCD, r = total % NXCD, xcd = L % NXCD, off = L / NXCD; return (xcd < r ? xcd * (q + 1) : r * (q + 1) + (xcd - r) * q) + off; }

template <class Desc, class Epi>
DI void gemm_phase(LAS unsigned char* lds, const Desc& D, const Epi& E, int wv) {
    const int tid = otid(wv), wid = __builtin_amdgcn_readfirstlane(tid >> 6), lane = tid & 63, wr = wid >> 2, wc = wid & 3, fr = lane & 15, fq = lane >> 4;
    const int G = gridDim.x, c = blockIdx.x, total = D.total;
    const int K = D.K, nt = K / BK;
    unsigned voffA[2], voffB[2];
#pragma unroll
    for (int i = 0; i < 2; ++i) { int R, C; stage_rc(tid * 16 + i * 8192, R, C); const int Rb = (R & ~31) + perm32(R & 31);
        voffA[i] = (unsigned)(R * D.lda + C) * 2u; voffB[i] = (unsigned)(Rb * D.ldb + C) * 2u; }
    const size_t kstep = (size_t)(BK * 2);
    const size_t hstepA = (size_t)HALF * D.lda * 2, hstepB = (size_t)HALF * D.ldb * 2;
    const unsigned ldsw = (unsigned)wid * 1024u;
    const int aoff = lds_byte(wr * 64 + fr, fq * 8), boff = lds_byte(wc * 32 + fr, fq * 8);
#define PG8_SA(b, h) (((b) * 2 + (h)) * HTB)
#define PG8_SB(b, h) ((4 + (b) * 2 + (h)) * HTB)
#define PG8_STAGE(bufoff, gbase, voff) do { _Pragma("unroll") for (int _i = 0; _i < 2; ++_i) \
        __builtin_amdgcn_global_load_lds((const unsigned*)((const char*)(gbase) + (voff)[_i]), (LAS unsigned*)(lds + (bufoff) + ldsw + _i * 8192), 16, 0, 0); } while (0)
#define PG8_LDA(dst, b, h) do { _Pragma("unroll") for (int m = 0; m < 4; ++m) _Pragma("unroll") for (int k = 0; k < 2; ++k) dst[m][k] = *(const LAS bf16x8*)(lds + PG8_SA(b, h) + aoff + m * 2048 + k * 1024); } while (0)
#define PG8_LDB(dst, b, h) do { _Pragma("unroll") for (int n = 0; n < 2; ++n) _Pragma("unroll") for (int k = 0; k < 2; ++k) dst[n][k] = *(const LAS bf16x8*)(lds + PG8_SB(b, h) + boff + n * 2048 + k * 1024); } while (0)
#define PG8_MMA(ai, bj, At, Bt) do { __builtin_amdgcn_s_setprio(1); _Pragma("unroll") for (int m = 0; m < 4; ++m) _Pragma("unroll") for (int n = 0; n < 2; ++n) _Pragma("unroll") for (int k = 0; k < 2; ++k) \
        acc[ai][bj][m][n] = __builtin_amdgcn_mfma_f32_16x16x32_bf16(Bt[n][k], At[m][k], acc[ai][bj][m][n], 0, 0, 0); __builtin_amdgcn_s_setprio(0); } while (0)
#define PG8_WAIT_V(n) asm volatile("s_waitcnt vmcnt(" #n ")" ::: "memory")
#define PG8_WAIT_L(n) asm volatile("s_waitcnt lgkmcnt(" #n ")" ::: "memory")
#define PG8_BAR __builtin_amdgcn_s_barrier()
#define PG8_SCHED __builtin_amdgcn_sched_barrier(0)
    if constexpr (Desc::RAW) { if (!D.valid(c, G)) return; } else { if (c >= total) return; }
    Unit cur, nxt; int ui = 0;
    if constexpr (Desc::RAW) cur = D.unit(c, G); else cur = D.unit(xcd_remap(c, total));
    nxt = cur;
    f32x4 acc[2][2][4][2];
#pragma unroll
    for (int a = 0; a < 2; ++a)
#pragma unroll
        for (int b = 0; b < 2; ++b)
#pragma unroll
            for (int m = 0; m < 4; ++m)
#pragma unroll
                for (int n = 0; n < 2; ++n) acc[a][b][m][n] = (f32x4){0.f, 0.f, 0.f, 0.f};
    bf16x8 At[4][2], B0[2][2], B1[2][2];
    const char* cA = cur.a; const char* cB = cur.b;
    PG8_STAGE(PG8_SB(0, 0), cB, voffB); PG8_STAGE(PG8_SB(0, 1), cB + hstepB, voffB); PG8_STAGE(PG8_SA(0, 0), cA, voffA); PG8_STAGE(PG8_SA(0, 1), cA + hstepA, voffA);
    if (wr == 1) PG8_BAR;
    PG8_WAIT_V(2); PG8_BAR;
    PG8_STAGE(PG8_SB(1, 0), cB + kstep, voffB); PG8_STAGE(PG8_SA(1, 0), cA + kstep, voffA); PG8_STAGE(PG8_SB(1, 1), cB + hstepB + kstep, voffB);
    PG8_WAIT_V(6); PG8_BAR;
    for (;;) {
        const long Ln = (long)(ui + 1) * G + c;
        bool has_next;
        if constexpr (Desc::RAW) { has_next = D.valid((int)Ln, G); if (has_next) nxt = D.unit((int)Ln, G); }
        else { has_next = Ln < total; if (has_next) nxt = D.unit(xcd_remap((int)Ln, total)); }
        const char* nA = has_next ? nxt.a : cA; const char* nB = has_next ? nxt.b : cB;
        for (int t = 0; t < nt; t += 2) {
            const bool last = (t == nt - 2);
            const char* a1 = cA + (size_t)(t + 1) * kstep;
            const char* a2 = last ? nA : cA + (size_t)(t + 2) * kstep; const char* b2 = last ? nB : cB + (size_t)(t + 2) * kstep;
            const char* a3 = a2 + kstep; const char* b3 = b2 + kstep;
            PG8_LDB(B0, 0, 0); PG8_LDB(B1, 0, 1); PG8_SCHED; PG8_LDA(At, 0, 0); PG8_STAGE(PG8_SA(1, 1), a1 + hstepA, voffA);
            PG8_WAIT_V(8); PG8_WAIT_L(0); PG8_BAR; PG8_MMA(0, 0, At, B0); PG8_MMA(0, 1, At, B1); PG8_BAR; PG8_SCHED;
            PG8_LDA(At, 0, 1); PG8_STAGE(PG8_SB(0, 0), b2, voffB); PG8_STAGE(PG8_SB(0, 1), b2 + hstepB, voffB); PG8_STAGE(PG8_SA(0, 0), a2, voffA);
            PG8_WAIT_V(8); PG8_WAIT_L(0); PG8_BAR; PG8_MMA(1, 0, At, B0); PG8_MMA(1, 1, At, B1); PG8_BAR; PG8_SCHED;
            PG8_LDB(B0, 1, 0); PG8_LDB(B1, 1, 1); PG8_SCHED; PG8_LDA(At, 1, 0); PG8_STAGE(PG8_SA(0, 1), a2 + hstepA, voffA);
            PG8_WAIT_V(8); PG8_WAIT_L(0); PG8_BAR; PG8_MMA(0, 0, At, B0); PG8_MMA(0, 1, At, B1); PG8_BAR; PG8_SCHED;
            PG8_LDA(At, 1, 1); PG8_STAGE(PG8_SB(1, 0), b3, voffB); PG8_STAGE(PG8_SB(1, 1), b3 + hstepB, voffB); PG8_STAGE(PG8_SA(1, 0), a3, voffA);
            PG8_WAIT_V(8); PG8_WAIT_L(0); PG8_BAR; PG8_MMA(1, 0, At, B0); PG8_MMA(1, 1, At, B1); PG8_BAR; PG8_SCHED;
        }
        if (wr == 0) PG8_BAR;
        {
            const int le = otid(wv) & 63, fre = le & 15, fqe = le >> 4;
            if constexpr (is_whole_tile<Epi>::value) E.run(cur, acc, wr, wc, fre, fqe); else
#pragma unroll
            for (int ai = 0; ai < 2; ++ai)
#pragma unroll
                for (int m = 0; m < 4; ++m)
#pragma unroll
                    for (int bj = 0; bj < 2; ++bj)
                        E(cur, ai * HALF + wr * 64 + m * 16 + fre, bj * HALF + wc * 32 + 8 * fqe, acc[ai][bj][m][0], acc[ai][bj][m][1]);
        }
        if (!has_next) break;
#pragma unroll
        for (int a = 0; a < 2; ++a)
#pragma unroll
            for (int b = 0; b < 2; ++b)
#pragma unroll
                for (int m = 0; m < 4; ++m)
#pragma unroll
                    for (int n = 0; n < 2; ++n) acc[a][b][m][n] = (f32x4){0.f, 0.f, 0.f, 0.f};
        cur = nxt; cA = nA; cB = nB; ++ui;
        if (wr == 1) PG8_BAR;
    }
    PG8_WAIT_V(0);
    PG8_BAR;
#undef PG8_SA
#undef PG8_SB
#undef PG8_STAGE
#undef PG8_LDA
#undef PG8_LDB
#undef PG8_MMA
#undef PG8_WAIT_V
#undef PG8_WAIT_L
#undef PG8_BAR
#undef PG8_SCHED
}
}

DI void transpose_item(const float* W, int N, int kb, int nb, bf16_t* d0, bf16_t* d1, int K, LAS float* scr, int lane) {
    const int k0 = 64 * kb, n0 = 32 * nb;
#pragma unroll 8
    for (int i = 0; i < 32; ++i) { const int kk = 2 * i + (lane >> 5); scr[kk * 33 + (lane & 31)] = W[(size_t)(k0 + kk) * N + n0 + (lane & 31)]; }
    asm volatile("s_waitcnt lgkmcnt(0)" ::: "memory");
    const int c = lane & 7;
#pragma unroll
    for (int j = 0; j < 4; ++j) { const int n = (lane >> 3) + 8 * j; const LAS float* s = scr + (8 * c) * 33 + n;
        u32x4 o; o.x = pk2(s[0 * 33], s[1 * 33]); o.y = pk2(s[2 * 33], s[3 * 33]); o.z = pk2(s[4 * 33], s[5 * 33]); o.w = pk2(s[6 * 33], s[7 * 33]);
        *(u32x4*)(d0 + (size_t)n * K + k0 + 8 * c) = o;
        if (d1) *(u32x4*)(d1 + (size_t)n * K + k0 + 8 * c) = o; }
    asm volatile("s_waitcnt lgkmcnt(0)" ::: "memory");
}

DI void prep_phase(const Args& A, LAS unsigned char* lds, int wv) {
    const int tid = otid(wv), lane = tid & 63, wave = tid >> 6, G = gridDim.x;
    unsigned char* ws = A.ws;
    {
        LAS float* s_lds = (LAS float*)lds;
        const float* cc = A.in[1]; const float* cctx = A.in[3]; const float* aw = A.in[4]; const float* ab = A.in[5];
        long long* modi = (long long*)(ws + WS_MODI);
        for (int item = blockIdx.x; item < 768; item += G) {
            const int kc = item % 16, cb = (item / 16) % 12, l = item / 192;
            const int k0 = kc * 128, j = cb * 512 + tid;
            __syncthreads();
            for (int e = tid; e < 17 * 128; e += NTHREADS) { const int r = e / 128, k = e % 128; const float v = r < 16 ? cc[r * DM + k0 + k] : cctx[k0 + k]; s_lds[k * 20 + r] = siluf(v); }
            __syncthreads();
            float acc[17];
#pragma unroll
            for (int r = 0; r < 17; ++r) acc[r] = 0.f;
            const float* wp = aw + ((size_t)l * DM + k0) * MOD_LD + j;
#pragma unroll 4
            for (int k = 0; k < 128; ++k) {
                const float w = wp[(size_t)k * MOD_LD];
                const LAS f32x4* sp = (const LAS f32x4*)(s_lds + k * 20);
                const f32x4 s0 = sp[0], s1 = sp[1], s2 = sp[2], s3 = sp[3]; const float s4 = s_lds[k * 20 + 16];
#pragma unroll
                for (int q = 0; q < 4; ++q) { acc[q] += s0[q] * w; acc[4 + q] += s1[q] * w; acc[8 + q] += s2[q] * w; acc[12 + q] += s3[q] * w; }
                acc[16] += s4 * w;
            }
            const float bias = (kc == 0) ? ab[l * MOD_LD + j] : 0.f;
#pragma unroll
            for (int r = 0; r < 17; ++r) atomicAdd((unsigned long long*)&modi[(size_t)(l * 17 + r) * MOD_LD + j], (unsigned long long)__float2ll_rn((acc[r] + bias) * MODI_SCALE));
        }
        __syncthreads();
    }
    {
        LAS float* scr = (LAS float*)(lds + wave * 16384);
        const int gw = blockIdx.x * NWAVES + wave, NGW = G * NWAVES;
        constexpr int I_SQ = 32 * 64, I_AI = 32 * 160, I_MI = 32 * 257;
        constexpr int NIT = 6 * I_SQ + I_AI + I_MI;
        for (int it = gw; it < NIT; it += NGW) {
            int r = it;
            if (r < 6 * I_SQ) {
                const int w = r / I_SQ; r -= w * I_SQ;
                const float* src; bf16_t* dst;
                if (w < 2)      { src = A.in[7] + (size_t)w * DM * DM;       dst = (bf16_t*)(ws + WS_WFG) + (size_t)w * DM * DM; }
                else if (w < 4) { src = A.in[8] + (size_t)(w - 2) * DM * DM; dst = (bf16_t*)(ws + WS_WFO) + (size_t)(w - 2) * DM * DM; }
                else if (w == 4) { src = A.in[12]; dst = (bf16_t*)(ws + WS_WMO); }
                else             { src = A.in[16]; dst = (bf16_t*)(ws + WS_WAO); }
                const int kb = r / 64, nb = r % 64;
                transpose_item(src, DM, kb, nb, dst + (size_t)(32 * nb) * DM, nullptr, DM, scr, lane);
                continue;
            }
            r -= 6 * I_SQ;
            if (r < I_AI) { const int kb = r / 160, nb = r % 160; transpose_item(A.in[13], 5120, kb, nb, (bf16_t*)(ws + WS_WAI) + (size_t)(32 * nb) * DM, nullptr, DM, scr, lane); continue; }
            r -= I_AI;
            {
                const int kb = r / 257, nb = r % 257, n0 = 32 * nb;
                bf16_t* WA = (bf16_t*)(ws + WS_WMA); bf16_t* WB = (bf16_t*)(ws + WS_WMB);
                bf16_t* d0; bf16_t* d1 = nullptr;
                if (n0 < 1024) d0 = WA + (size_t)n0 * DM;
                else if (n0 < 2048) d0 = WA + (size_t)n0 * DM;
                else if (n0 < 4096) d0 = WB + (size_t)(n0 - 2048) * DM;
                else if (n0 < 6144) d0 = WA + (size_t)(2304 + n0 - 4096) * DM;
                else if (n0 < 6176) d0 = WA + (size_t)(2048 + n0 - 6144) * DM;
                else d0 = WA + (size_t)(4352 + n0 - 6176) * DM;
                transpose_item(A.in[9], 8224, kb, nb, d0, d1, DM, scr, lane);
            }
        }
    }
    {
        const long gt = (long)blockIdx.x * NTHREADS + tid, NGT = (long)G * NTHREADS;
        constexpr long N_DC = 512L * 512 / 8, N_DT = 2048L * 4096 / 8, N_DT2 = 256L * 512 / 8;
        for (long it = gt; it < N_DC + N_DT + N_DT2; it += NGT) {
            float v[8]; bf16_t* dst;
            if (it < N_DC) {
                const int m = (int)(it / 64), k0 = (int)(it % 64) * 8; const float sc = 0.044194173824159216f;
#pragma unroll
                for (int j = 0; j < 8; ++j) { const int mm = (m <= 256) ? m : m - 256; const int rr = (mm * (k0 + j)) & 511; const float ang = (float)rr * (1.f / 256.f); v[j] = (m <= 256 ? cospif(ang) : sinpif(ang)) * sc; }
                dst = (bf16_t*)(ws + WS_DC) + (size_t)m * 512 + k0;
            } else if (it < N_DC + N_DT) {
                const long i2 = it - N_DC; const int kk = (int)(i2 / 512), s0 = (int)(i2 % 512) * 8; const float sc = 0.022097086912079608f;
#pragma unroll
                for (int j = 0; j < 8; ++j) { const int s = s0 + j; const int rr = (kk * (s & 2047)) & 2047; const float ang = (float)rr * (1.f / 1024.f); v[j] = (s < 2048 ? cospif(ang) : -sinpif(ang)) * sc; }
                dst = (bf16_t*)(ws + WS_DT) + (size_t)kk * 4096 + s0;
            } else {
                const long i2 = it - N_DC - N_DT; const int kk = (int)(i2 / 64), s0 = (int)(i2 % 64) * 8; const float sc = 0.0625f;
#pragma unroll
                for (int j = 0; j < 8; ++j) { const int s = s0 + j; const int rr = (kk * (s & 255)) & 255; const float ang = (float)rr * (1.f / 128.f); v[j] = (s < 256 ? cospif(ang) : -sinpif(ang)) * sc; }
                dst = (bf16_t*)(ws + WS_DT2) + (size_t)kk * 512 + s0;
            }
            u32x4 o = {pk2(v[0], v[1]), pk2(v[2], v[3]), pk2(v[4], v[5]), pk2(v[6], v[7])};
            *(u32x4*)dst = o;
        }
    }
}

DI const float* xrow_in(const Args& A, int r) {
    const int b = r / TB, t = r % TB;
    if (t < TL) return A.in[0] + ((size_t)b * TL + t) * DM;
    return A.in[2] + ((size_t)b * TC + (t - TL)) * DM;
}
DI void norm_phase(const Args& A, int layer, bool latonly, int wv) {
    const int tid = otid(wv), lane = tid & 63, wave = tid >> 6, G = gridDim.x;
    const float* ng = A.in[6] + (size_t)layer * DM;
    const float* mod = (const float*)(A.ws + WS_MOD) + (size_t)layer * 17 * MOD_LD;
    bf16_t* H = (bf16_t*)(A.ws + WS_H);
    const bf16_t* XB = (const bf16_t*)A.out;
    for (int r0 = (blockIdx.x * NWAVES + wave) * 2; r0 < NTOK; r0 += G * NWAVES * 2) {
        const int b = r0 / TB, t = r0 % TB;
        if (latonly && t >= TL) continue;
        const float* mr = mod + (size_t)(t < TL ? b : 16) * MOD_LD;
        f32x4 v[2][4][2];
#pragma unroll
        for (int k = 0; k < 2; ++k) {
            const int r = r0 + k;
            if (layer == 0) {
                const float* xr = xrow_in(A, r);
#pragma unroll
                for (int j = 0; j < 4; ++j) { const f32x4* p = (const f32x4*)(xr + 512 * j + 8 * lane); v[k][j][0] = p[0]; v[k][j][1] = p[1]; }
            } else {
#pragma unroll
                for (int j = 0; j < 4; ++j) ld_bf16x8(XB + (size_t)r * DM + 512 * j + 8 * lane, v[k][j][0], v[k][j][1]);
            }
        }
#pragma unroll
        for (int k = 0; k < 2; ++k) {
            const int r = r0 + k; float ss = 0.f;
#pragma unroll
            for (int j = 0; j < 4; ++j)
#pragma unroll
                for (int q = 0; q < 4; ++q) ss += v[k][j][0][q] * v[k][j][0][q] + v[k][j][1][q] * v[k][j][1][q];
            const float rs = 1.0f / sqrtf(wave_sum(ss) * (1.f / DM) + EPS);
#pragma unroll
            for (int j = 0; j < 4; ++j) { const int c0 = 512 * j + 8 * lane; f32x4 o[2];
#pragma unroll
                for (int h = 0; h < 2; ++h) { const f32x4 g4 = *(const f32x4*)(ng + c0 + 4 * h), sh = *(const f32x4*)(mr + c0 + 4 * h), sc = *(const f32x4*)(mr + DM + c0 + 4 * h);
                    o[h] = (v[k][j][h] * rs) * g4 * (sc + 1.0f) + sh; }
                st_bf16x8(H + (size_t)r * DM + c0, o[0], o[1]); }
        }
    }
}
DI void final_norm_phase(const Args& A, const bf16_t* src, int wv) {
    const int tid = otid(wv), lane = tid & 63, wave = tid >> 6, G = gridDim.x;
    const float* fg = A.in[17];
    for (int r0 = (blockIdx.x * NWAVES + wave) * 2; r0 < NB * TL; r0 += G * NWAVES * 2) {
        f32x4 v[2][4][2];
#pragma unroll
        for (int k = 0; k < 2; ++k)
#pragma unroll
            for (int j = 0; j < 4; ++j) ld_bf16x8(src + (size_t)(r0 + k) * DM + 512 * j + 8 * lane, v[k][j][0], v[k][j][1]);
#pragma unroll
        for (int k = 0; k < 2; ++k) { float* orow = A.out + (size_t)(r0 + k) * DM; float ss = 0.f;
#pragma unroll
            for (int j = 0; j < 4; ++j)
#pragma unroll
                for (int q = 0; q < 4; ++q) ss += v[k][j][0][q] * v[k][j][0][q] + v[k][j][1][q] * v[k][j][1][q];
            const float rs = 1.0f / sqrtf(wave_sum(ss) * (1.f / DM) + EPS);
#pragma unroll
            for (int j = 0; j < 4; ++j) { const int c0 = 512 * j + 8 * lane;
#pragma unroll
                for (int h = 0; h < 2; ++h) { const f32x4 g4 = *(const f32x4*)(fg + c0 + 4 * h); *(f32x4*)(orow + c0 + 4 * h) = (v[k][j][h] * rs) * g4; } }
        }
    }
}

struct DescPlain {
    static constexpr bool RAW = false;
    const bf16_t* A; const bf16_t* B; int nN; bool latonly; int lda, ldb, K, total;
    DI void init(const bf16_t* A_, const bf16_t* B_, int nN_, bool lat) { A = A_; B = B_; nN = nN_; latonly = lat; lda = DM; ldb = DM; K = DM; total = (lat ? 128 : 144) * nN_; }
    DI pg8::Unit unit(int idx) const {
        const int nMt = latonly ? 128 : 144, nig = 8 * nN, gid = idx / nig, fm = gid * 8, gsz = (nMt - fm) < 8 ? (nMt - fm) : 8;
        const int pmi = fm + (idx % nig) % gsz, pn = (idx % nig) / gsz, pm = latonly ? (pmi / 8) * 9 + (pmi % 8) : pmi;
        pg8::Unit u; u.a = (const char*)(A + (size_t)pm * 256 * DM); u.b = (const char*)(B + (size_t)pn * 256 * DM); u.i0 = pm; u.i1 = pn; u.i2 = 0; return u;
    }
};
struct DescChan {
    static constexpr bool RAW = false;
    const bf16_t* DC; const bf16_t* H; int lda, ldb, K, total;
    DI void init(const bf16_t* DC_, const bf16_t* H_, bool lat) { DC = DC_; H = H_; lda = 512; ldb = DM; K = 512; total = lat ? 1024 : 1152; }
    DI pg8::Unit unit(int idx) const {
        pg8::Unit u; int b, g, mt, nt, toff;
        if (idx < 1024) { mt = idx % 2; nt = (idx / 2) % 8; g = (idx / 16) % 4; b = idx / 64; toff = nt * 256; u.i2 = nt; }
        else { const int j = idx - 1024; mt = j % 2; g = (j / 2) % 4; b = j / 8; toff = TL; u.i2 = 8; }
        u.a = (const char*)(DC + (size_t)mt * 256 * 512); u.b = (const char*)(H + ((size_t)b * TB + toff) * DM + g * 512); u.i0 = b * 4 + g; u.i1 = mt; return u;
    }
};
struct DescT {
    static constexpr bool RAW = false;
    const bf16_t* DT; const bf16_t* PQ; int nMt; int lda, ldb, K, total;
    DI void init(const bf16_t* DT_, const bf16_t* PQ_, int ld, int Kd, int coff, int nMt_) { DT = DT_ + coff; PQ = PQ_ + coff; nMt = nMt_; lda = ld; ldb = ld; K = Kd; total = NB * nMt_ * 8; }
    DI pg8::Unit unit(int idx) const {
        const int mt = idx % nMt, nt = (idx / nMt) % 8, b = idx / (nMt * 8);
        pg8::Unit u; u.a = (const char*)(DT + (size_t)mt * 256 * lda); u.b = (const char*)(PQ + ((size_t)b * DM + nt * 256) * ldb); u.i0 = b; u.i1 = mt; u.i2 = nt; return u;
    }
};

struct DescT2 {
    static constexpr bool RAW = true;
    const bf16_t* DT; const bf16_t* PQ; int lda, ldb, K, total;
    DI void init(const bf16_t* DT_, const bf16_t* PQ_) { DT = DT_; PQ = PQ_; lda = 4096; ldb = 4096; K = 2048; total = 2 * NB * 4 * 4; }
    DI bool valid(int L, int G) const { return ((L / G) >> 1) * G + (L % G) < NB * 4 * 4; }
    DI pg8::Unit unit(int L, int G) const {
        const int i = L / G, pair = (i >> 1) * G + (L % G), part = i & 1;
        const int mt = pair % 4, nt = 2 * ((pair / 4) % 4), b = pair / 16, coff = part * 2048;
        pg8::Unit u; u.a = (const char*)(DT + (size_t)mt * 256 * 4096 + coff); u.b = (const char*)(PQ + ((size_t)b * DM + nt * 256) * 4096 + coff); u.i0 = b; u.i1 = mt; u.i2 = part * 8 + nt; return u;
    }
};

struct EpiResid {
    static constexpr bool WHOLE_TILE = true;
    const float* x_in; const float* c_in; bf16_t* XB; bf16_t* X2; const float* modl; int layer;
    DI void init(const Args& A, int layer_) { x_in = A.in[0]; c_in = A.in[2]; XB = (bf16_t*)A.out; X2 = (bf16_t*)(A.ws + WS_SCR + F_PQX); modl = (const float*)(A.ws + WS_MOD) + (size_t)layer_ * 17 * MOD_LD; layer = layer_; }
    DI void run(const pg8::Unit& u, const f32x4 (&acc)[2][2][4][2], int wr, int wc, int fr, int fq) const {
        const int pm = u.i0, b = pm / 9, tt = pm % 9, col0 = u.i1 * 256 + wc * 32 + 8 * fq;
        f32x4 g[2][2];
#pragma unroll
        for (int bj = 0; bj < 2; ++bj) { const float* gp = modl + (size_t)(tt < 8 ? b : 16) * MOD_LD + 2 * DM + col0 + bj * 128; g[bj][0] = *(const f32x4*)gp; g[bj][1] = *(const f32x4*)(gp + 4); }
        if (layer != 0) {
            u32x4 xq[2][4][2];
#pragma unroll
            for (int ai = 0; ai < 2; ++ai)
#pragma unroll
                for (int m = 0; m < 4; ++m)
#pragma unroll
                    for (int bj = 0; bj < 2; ++bj) xq[ai][m][bj] = *(const u32x4*)(XB + ((size_t)pm * 256 + ai * 128 + wr * 64 + m * 16 + fr) * DM + col0 + bj * 128);
#pragma unroll
            for (int ai = 0; ai < 2; ++ai)
#pragma unroll
                for (int m = 0; m < 4; ++m)
#pragma unroll
                    for (int bj = 0; bj < 2; ++bj) {
                        const int row_l = ai * 128 + wr * 64 + m * 16 + fr; const u32x4 w = xq[ai][m][bj];
                        const f32x4 x0 = (f32x4){bf_lo(w.x), bf_hi(w.x), bf_lo(w.y), bf_hi(w.y)} + g[bj][0] * acc[ai][bj][m][0];
                        const f32x4 x1 = (f32x4){bf_lo(w.z), bf_hi(w.z), bf_lo(w.w), bf_hi(w.w)} + g[bj][1] * acc[ai][bj][m][1];
                        if (layer == 3) st_bf16x8(X2 + ((size_t)b * TL + tt * 256 + row_l) * DM + col0 + bj * 128, x0, x1);
                        else st_bf16x8(XB + ((size_t)pm * 256 + row_l) * DM + col0 + bj * 128, x0, x1);
                    }
        } else {
#pragma unroll
            for (int ai = 0; ai < 2; ++ai) {
                f32x4 xf[4][2][2];
#pragma unroll
                for (int m = 0; m < 4; ++m)
#pragma unroll
                    for (int bj = 0; bj < 2; ++bj) { const int row_l = ai * 128 + wr * 64 + m * 16 + fr;
                        const float* src = (tt < 8) ? x_in + ((size_t)b * TL + tt * 256 + row_l) * DM + col0 + bj * 128 : c_in + ((size_t)b * TC + row_l) * DM + col0 + bj * 128;
                        xf[m][bj][0] = *(const f32x4*)src; xf[m][bj][1] = *(const f32x4*)(src + 4); }
#pragma unroll
                for (int m = 0; m < 4; ++m)
#pragma unroll
                    for (int bj = 0; bj < 2; ++bj) { const int row_l = ai * 128 + wr * 64 + m * 16 + fr;
                        st_bf16x8(XB + ((size_t)pm * 256 + row_l) * DM + col0 + bj * 128, xf[m][bj][0] + g[bj][0] * acc[ai][bj][m][0], xf[m][bj][1] + g[bj][1] * acc[ai][bj][m][1]); }
            }
        }
    }
};

DI void fnet_layer(const Args& A, LAS unsigned char* lds, const XcdBarrier& gbar, int layer, int j, bool latonly, int wv) {
    unsigned char* ws = A.ws;
    const bf16_t* H = (const bf16_t*)(ws + WS_H); bf16_t* U = (bf16_t*)(ws + WS_H);
    bf16_t* Gt = (bf16_t*)(ws + WS_SCR + F_G); bf16_t* PQX = (bf16_t*)(ws + WS_SCR + F_PQX); bf16_t* PQC = (bf16_t*)(ws + WS_SCR + F_PQC);
    norm_phase(A, layer, latonly, wv);
    xcd_barrier(gbar, wv);
    {
        DescPlain D; D.init(H, (const bf16_t*)(ws + WS_WFG) + (size_t)j * DM * DM, 8, latonly);
        auto E = [=](const pg8::Unit& u, int row_l, int col_l, f32x4 v0, f32x4 v1) {
            f32x4 a, b;
#pragma unroll
            for (int q = 0; q < 4; ++q) { a[q] = siluf(v0[q]); b[q] = siluf(v1[q]); }
            st_bf16x8(Gt + ((size_t)u.i0 * 256 + row_l) * DM + u.i1 * 256 + col_l, a, b);
        };
        pg8::gemm_phase(lds, D, E, wv);
    }
    {
        DescChan D; D.init((const bf16_t*)(ws + WS_DC), H, latonly);
        auto E = [=](const pg8::Unit& u, int row_l, int col_l, f32x4 v0, f32x4 v1) {
            const int b = u.i0 >> 2, g = u.i0 & 3, m = row_l;
            bf16_t* base; size_t cs; int hs;
            if (u.i2 < 8) { base = PQX + ((size_t)b * DM + g * 512) * 4096 + u.i2 * 256 + col_l; cs = 4096; hs = 2048; }
            else          { base = PQC + ((size_t)b * DM + g * 512) * 512 + col_l; cs = 512; hs = 256; }
            const f32x4 z = {0.f, 0.f, 0.f, 0.f};
            const bool mir = (u.i2 == 8);
            if (u.i1 == 0) { st_bf16x8(base + (size_t)m * cs, v0, v1); if (mir && m != 0) st_bf16x8(base + (size_t)(512 - m) * cs, v0, v1); }
            else if (m == 0) { st_bf16x8(base + (size_t)256 * cs, v0, v1); st_bf16x8(base + hs, z, z); if (mir) st_bf16x8(base + (size_t)256 * cs + hs, z, z); }
            else { st_bf16x8(base + (size_t)m * cs + hs, v0, v1); if (mir) st_bf16x8(base + (size_t)(512 - m) * cs + hs, z - v0, z - v1); }
        };
        pg8::gemm_phase(lds, D, E, wv);
    }
    xcd_barrier(gbar, wv);
    bf16_t* A1 = (bf16_t*)(ws + WS_SCR + F_A1);
    {
        const int tid = otid(wv), lane = tid & 63;
        for (int rr0 = (blockIdx.x * NWAVES + wv) * 4; rr0 < NB * DM; rr0 += gridDim.x * NWAVES * 4) {
            if ((rr0 & 511) > 256) continue;
            u32x4 raw[4][4];
#pragma unroll
            for (int k = 0; k < 4; ++k)
#pragma unroll
                for (int q = 0; q < 4; ++q) raw[k][q] = *(const u32x4*)(PQX + (size_t)(rr0 + ((rr0 & 511) == 256 ? 0 : k)) * 4096 + (q * 64 + lane) * 8);
            float accs[4];
#pragma unroll
            for (int k = 0; k < 4; ++k) { float acc = 0.f;
#pragma unroll
                for (int q = 0; q < 4; ++q) { const u32x4 w = raw[k][q]; acc += (bf_lo(w.x) - bf_hi(w.x)) + (bf_lo(w.y) - bf_hi(w.y)) + (bf_lo(w.z) - bf_hi(w.z)) + (bf_lo(w.w) - bf_hi(w.w)); }
                accs[k] = wave_sum(acc) * 0.022097086912079608f; }
            if (lane == 0) {
                unsigned short g1[4], g2[4]; size_t o1[4], o2[4]; bool v1[4], v2[4];
#pragma unroll
                for (int k = 0; k < 4; ++k) { const int rr = rr0 + k, m = rr & 511; v1[k] = (m <= 256); v2[k] = (m >= 1 && m <= 255);
                    o1[k] = ((size_t)(rr >> 11) * TB + 1024) * DM + (rr & 2047); o2[k] = o1[k] - m + (512 - m);
                    g1[k] = v1[k] ? Gt[o1[k]] : (unsigned short)0; g2[k] = v2[k] ? Gt[o2[k]] : (unsigned short)0; }
#pragma unroll
                for (int k = 0; k < 4; ++k) {
                    if (v1[k]) U[o1[k]] = (bf16_t)(pk2(accs[k] * __uint_as_float((unsigned)g1[k] << 16), 0.f) & 0xffffu);
                    if (v2[k]) U[o2[k]] = (bf16_t)(pk2(accs[k] * __uint_as_float((unsigned)g2[k] << 16), 0.f) & 0xffffu); }
            }
        }
    }
    {
        const int tid = otid(wv), lane = tid & 63; const bf16_t* DTm = (const bf16_t*)(ws + WS_DT);
        for (int it = blockIdx.x * NWAVES + wv; it < 64 * 256; it += gridDim.x * NWAVES) {
            const int bg = it >> 8, kq = it & 255, b = bg >> 2, ch = (bg & 3) * 512 + 256;
            const bf16_t* pr = PQX + ((size_t)b * DM + ch) * 4096;
            u32x4 pv[4], dv[4][4];
#pragma unroll
            for (int q = 0; q < 4; ++q) pv[q] = *(const u32x4*)(pr + (q * 64 + lane) * 8);
#pragma unroll
            for (int kk = 0; kk < 4; ++kk)
#pragma unroll
                for (int q = 0; q < 4; ++q) dv[kk][q] = *(const u32x4*)(DTm + (size_t)(kq * 4 + kk) * 4096 + (q * 64 + lane) * 8);
            float accs[4];
#pragma unroll
            for (int kk = 0; kk < 4; ++kk) { float acc = 0.f;
#pragma unroll
                for (int q = 0; q < 4; ++q) { acc = dot2g(dv[kk][q].x, pv[q].x, acc); acc = dot2g(dv[kk][q].y, pv[q].y, acc); acc = dot2g(dv[kk][q].z, pv[q].z, acc); acc = dot2g(dv[kk][q].w, pv[q].w, acc); }
                accs[kk] = wave_sum(acc); }
            if (lane == 0) {
                unsigned short g1[4], g2[4];
#pragma unroll
                for (int kk = 0; kk < 4; ++kk) { const int k = kq * 4 + kk; g1[kk] = Gt[((size_t)b * TB + k) * DM + ch]; g2[kk] = Gt[((size_t)b * TB + ((TL - k) & (TL - 1))) * DM + ch]; }
#pragma unroll
                for (int kk = 0; kk < 4; ++kk) { const int k = kq * 4 + kk;
                    U[((size_t)b * TB + k) * DM + ch] = (bf16_t)(pk2(accs[kk] * __uint_as_float((unsigned)g1[kk] << 16), 0.f) & 0xffffu);
                    if (k != 0) U[((size_t)b * TB + (TL - k)) * DM + ch] = (bf16_t)(pk2(accs[kk] * __uint_as_float((unsigned)g2[kk] << 16), 0.f) & 0xffffu); }
            }
        }
    }
    {
        DescT2 D; D.init((const bf16_t*)(ws + WS_DT), PQX);
        auto E = [=](const pg8::Unit& u, int row_l, int col_l, f32x4 v0, f32x4 v1) {
            const int k = u.i1 * 256 + row_l, col = (u.i2 & 7) * 256 + col_l;
            bf16_t* ap = A1 + ((size_t)u.i0 * 1024 + k) * DM + col;
            if (u.i2 < 8) { st_bf16x8(ap, v0, v1); return; }
            f32x4 a0, a1; ld_bf16x8(ap, a0, a1);
            const size_t off = ((size_t)u.i0 * TB + k) * DM + col;
            f32x4 g0, g1; ld_bf16x8(Gt + off, g0, g1);
            st_bf16x8(U + off, (a0 + v0) * g0, (a1 + v1) * g1);
            if (k != 0) { const size_t off2 = ((size_t)u.i0 * TB + (TL - k)) * DM + col; ld_bf16x8(Gt + off2, g0, g1); st_bf16x8(U + off2, (a0 - v0) * g0, (a1 - v1) * g1); }
            const f32x4 s0 = a0 + v0, s1 = a1 + v1, d0 = a0 - v0, d1 = a1 - v1;
            const float sm[8] = {s0[0], s0[1], s0[2], s0[3], s1[0], s1[1], s1[2], s1[3]}, df[8] = {d0[0], d0[1], d0[2], d0[3], d1[0], d1[1], d1[2], d1[3]};
            const size_t rowk = ((size_t)u.i0 * TB + k) * DM, rowT = ((size_t)u.i0 * TB + (TL - k)) * DM; const int cm = (col & ~255) + 512 - col_l;
            {
                const bf16_t* gk_ = Gt + rowk + cm - 8; const bf16_t* gT_ = Gt + rowT + cm - 8; bf16_t* uk_ = U + rowk + cm - 8; bf16_t* uT_ = U + rowT + cm - 8;
                const unsigned short ka1 = gk_[1]; const unsigned ka2 = *(const unsigned*)(gk_ + 2); const u32x2 ka4 = *(const u32x2*)(gk_ + 4); const unsigned short ka0 = col_l ? gk_[8] : (unsigned short)0;
                unsigned short ta1 = 0, ta0 = 0; unsigned ta2 = 0; u32x2 ta4 = {0u, 0u};
                if (k != 0) { ta1 = gT_[1]; ta2 = *(const unsigned*)(gT_ + 2); ta4 = *(const u32x2*)(gT_ + 4); ta0 = col_l ? gT_[8] : (unsigned short)0; }
                uk_[1] = (bf16_t)(pk2(df[7] * __uint_as_float((unsigned)ka1 << 16), 0.f) & 0xffffu);
                *(unsigned*)(uk_ + 2) = pk2(df[6] * bf_lo(ka2), df[5] * bf_hi(ka2));
                *(u32x2*)(uk_ + 4) = (u32x2){pk2(df[4] * bf_lo(ka4.x), df[3] * bf_hi(ka4.x)), pk2(df[2] * bf_lo(ka4.y), df[1] * bf_hi(ka4.y))};
                if (col_l) uk_[8] = (bf16_t)(pk2(df[0] * __uint_as_float((unsigned)ka0 << 16), 0.f) & 0xffffu);
                if (k != 0) {
                    uT_[1] = (bf16_t)(pk2(sm[7] * __uint_as_float((unsigned)ta1 << 16), 0.f) & 0xffffu);
                    *(unsigned*)(uT_ + 2) = pk2(sm[6] * bf_lo(ta2), sm[5] * bf_hi(ta2));
                    *(u32x2*)(uT_ + 4) = (u32x2){pk2(sm[4] * bf_lo(ta4.x), sm[3] * bf_hi(ta4.x)), pk2(sm[2] * bf_lo(ta4.y), sm[1] * bf_hi(ta4.y))};
                    if (col_l) uT_[8] = (bf16_t)(pk2(sm[0] * __uint_as_float((unsigned)ta0 << 16), 0.f) & 0xffffu);
                }
            }
        };
        pg8::gemm_phase(lds, D, E, wv);
    }
    if (!latonly) {
        DescT D; D.init((const bf16_t*)(ws + WS_DT2), PQC, 512, 512, 0, 1);
        auto E = [=](const pg8::Unit& u, int row_l, int col_l, f32x4 v0, f32x4 v1) {
            const size_t off = ((size_t)u.i0 * TB + TL + row_l) * DM + u.i2 * 256 + col_l;
            f32x4 g0, g1; ld_bf16x8(Gt + off, g0, g1);
            st_bf16x8(U + off, v0 * g0, v1 * g1);
        };
        pg8::gemm_phase(lds, D, E, wv);
    }
    xcd_barrier(gbar, wv);
    {
        DescPlain D; D.init(U, (const bf16_t*)(ws + WS_WFO) + (size_t)j * DM * DM, 8, latonly);
        EpiResid E; E.init(A, layer);
        pg8::gemm_phase(lds, D, E, wv);
    }
    xcd_barrier(gbar, wv);
}


namespace att {
constexpr int D = 128, NW = 8, QBLK = 32, KVBLK = 64;
constexpr float SCALE = 0.088388347648318440f;
constexpr float THR = 8.f;
constexpr int LDQ = 2048, LDK = 512;
constexpr size_t SHM_V = KVBLK * D * 2, SHM_K = KVBLK * D * 2;
typedef float f32x8 __attribute__((ext_vector_type(8)));
#define KSWZ(row, colB) ((row) * 256 + ((colB) ^ (((row) & 7) << 4)))
#define SBAR() __builtin_amdgcn_sched_barrier(0)
DI int crow(int r, int hi) { return (r & 3) + 8 * (r >> 2) + 4 * hi; }
DI unsigned cvtpk(float lo, float hi) { unsigned r; asm volatile("v_cvt_pk_bf16_f32 %0, %1, %2" : "=v"(r) : "v"(lo), "v"(hi)); return r; }
DI void partialSM(f32x16& p0, f32x16& p1, float& m_reg, float& mn, float& alpha) {
  constexpr float C = SCALE * 1.4426950408889634f;
  float pmax = p0[0];
#pragma unroll
  for (int r = 1; r < 16; ++r) pmax = fmaxf(pmax, p0[r]);
#pragma unroll
  for (int r = 0; r < 16; ++r) pmax = fmaxf(pmax, p1[r]);
  { auto rr = __builtin_amdgcn_permlane32_swap(__float_as_uint(pmax), __float_as_uint(pmax), false, false);
    pmax = fmaxf(__uint_as_float(rr[0]), __uint_as_float(rr[1])); }
  if (__builtin_expect(__all(pmax - m_reg <= THR / SCALE), 1)) { mn = m_reg; alpha = 1.f; }
  else { mn = fmaxf(m_reg, pmax); alpha = __builtin_amdgcn_exp2f((m_reg - mn) * C); m_reg = mn; }
  float mnC = -mn * C;
#pragma unroll
  for (int r = 0; r < 16; ++r) p0[r] = fmaf(p0[r], C, mnC);
#pragma unroll
  for (int r = 0; r < 16; ++r) p1[r] = fmaf(p1[r], C, mnC);
#pragma unroll
  for (int r = 0; r < 16; ++r) p0[r] = __builtin_amdgcn_exp2f(p0[r]);
}
DI void finishSM(f32x16& p0, f32x16& p1, float alpha, float& l_reg, bf16x8& pa0, bf16x8& pa1, bf16x8& pa2, bf16x8& pa3) {
#pragma unroll
  for (int r = 0; r < 16; ++r) p1[r] = __builtin_amdgcn_exp2f(p1[r]);
  float ps = 0;
#pragma unroll
  for (int r = 0; r < 16; ++r) ps += p0[r];
#pragma unroll
  for (int r = 0; r < 16; ++r) ps += p1[r];
  { auto rr = __builtin_amdgcn_permlane32_swap(__float_as_uint(ps), __float_as_uint(ps), false, false);
    ps = __uint_as_float(rr[0]) + __uint_as_float(rr[1]); }
  l_reg = l_reg * alpha + ps;
#define PK4(P, BASE, OUT) do { unsigned a0 = cvtpk(P[BASE + 0], P[BASE + 1]), a1 = cvtpk(P[BASE + 2], P[BASE + 3]);   \
    unsigned b0 = cvtpk(P[BASE + 4], P[BASE + 5]), b1 = cvtpk(P[BASE + 6], P[BASE + 7]);                              \
    auto r0 = __builtin_amdgcn_permlane32_swap(a0, b0, false, false); auto r1 = __builtin_amdgcn_permlane32_swap(a1, b1, false, false); \
    u32x4 w = {r0[0], r1[0], r0[1], r1[1]}; OUT = *reinterpret_cast<bf16x8*>(&w); } while (0)
  PK4(p0, 0, pa0); PK4(p0, 8, pa1); PK4(p1, 0, pa2); PK4(p1, 8, pa3);
#undef PK4
}
DI void qkt(f32x16& p0, f32x16& p1, const bf16_t* Ks, const bf16x8* qr, int r32, int hi) {
  p0 = f32x16{}; p1 = f32x16{};
#pragma unroll
  for (int d0 = 0; d0 < 8; ++d0) { int cb = (d0 * 16 + hi * 8) * 2;
    bf16x8 b0 = *reinterpret_cast<const bf16x8*>((const char*)Ks + KSWZ(r32, cb));
    bf16x8 b1 = *reinterpret_cast<const bf16x8*>((const char*)Ks + KSWZ(32 + r32, cb));
    p0 = __builtin_amdgcn_mfma_f32_32x32x16_bf16(b0, qr[d0], p0, 0, 0, 0);
    p1 = __builtin_amdgcn_mfma_f32_32x32x16_bf16(b1, qr[d0], p1, 0, 0, 0); }
}
DI int v_st(int k, int c) { const int kk = (k & ~0xC) | ((k & 4) << 1) | ((k & 8) >> 1); return ((kk >> 3) * 4 + (c >> 5)) * 512 + ((kk & 7) * 32 + (c & 31)) * 2; }
DI int v_rd_base(int lane) { return ((lane & 3) << 3) | (((lane >> 2) & 3) << 6) | (((lane >> 4) & 1) << 5) | (((lane >> 5) & 1) << 8); }
constexpr int v_rd_off(int d0, int ks, int half) { return d0 * 512 + ks * 4096 + half * 2048; }
template <int OFF> DI s16x4 tr_read(int vb) {
  s16x4 r; asm volatile("ds_read_b64_tr_b16 %0, %1 offset:%2" : "=&v"(r) : "v"(vb), "i"(OFF) : "memory"); return r;
}
template <int D0> DI void pv_one(f32x16& od, int vb, bf16x8 pa0, bf16x8 pa1, bf16x8 pa2, bf16x8 pa3) {
  const s16x4 l0 = tr_read<v_rd_off(D0, 0, 0)>(vb), h0 = tr_read<v_rd_off(D0, 0, 1)>(vb), l1 = tr_read<v_rd_off(D0, 1, 0)>(vb), h1 = tr_read<v_rd_off(D0, 1, 1)>(vb);
  const s16x4 l2 = tr_read<v_rd_off(D0, 2, 0)>(vb), h2 = tr_read<v_rd_off(D0, 2, 1)>(vb), l3 = tr_read<v_rd_off(D0, 3, 0)>(vb), h3 = tr_read<v_rd_off(D0, 3, 1)>(vb);
  asm volatile("s_waitcnt lgkmcnt(0)" ::: "memory"); SBAR();
#define PK(L, H) (bf16x8){L[0], L[1], L[2], L[3], H[0], H[1], H[2], H[3]}
  od = __builtin_amdgcn_mfma_f32_32x32x16_bf16(pa0, PK(l0, h0), od, 0, 0, 0);
  od = __builtin_amdgcn_mfma_f32_32x32x16_bf16(pa1, PK(l1, h1), od, 0, 0, 0);
  od = __builtin_amdgcn_mfma_f32_32x32x16_bf16(pa2, PK(l2, h2), od, 0, 0, 0);
  od = __builtin_amdgcn_mfma_f32_32x32x16_bf16(pa3, PK(l3, h3), od, 0, 0, 0);
#undef PK
}
DI void pv_d0(f32x16* o, int vb, bf16x8 pa0, bf16x8 pa1, bf16x8 pa2, bf16x8 pa3) {
  pv_one<0>(o[0], vb, pa0, pa1, pa2, pa3); pv_one<1>(o[1], vb, pa0, pa1, pa2, pa3); pv_one<2>(o[2], vb, pa0, pa1, pa2, pa3); pv_one<3>(o[3], vb, pa0, pa1, pa2, pa3);
}
DI void attn_dense_body(const bf16_t* __restrict__ Qb, const bf16_t* __restrict__ Kh, const bf16_t* __restrict__ Vh, const bf16_t* SZb, bf16_t* Ub, int seq, char* lds, int wv, const float* qn, int tpos) {
  const int tid = otid(wv), wid = tid >> 6, lane = tid & 63, r32 = lane & 31, hi = lane >> 5;
  bf16_t* V_lds = (bf16_t*)lds; bf16_t* K_lds = (bf16_t*)(lds + 2 * SHM_V);
  float* wsf = (float*)(lds + 2 * SHM_V + 2 * SHM_K) + wid * 64; float* li_l = wsf; float* al_l = wsf + 32;
  float m_reg = -1e30f, l_reg = 0; f32x16 o[4] = {}; bf16x8 qr[8];
  const bf16_t* Qw = Qb + (long)(wid * QBLK + r32) * LDQ + hi * 8;
  {
    u32x4 raw[8];
#pragma unroll
    for (int d0 = 0; d0 < 8; ++d0) raw[d0] = *reinterpret_cast<const u32x4*>(Qw + d0 * 16);
    float ss = 0.f;
#pragma unroll
    for (int d0 = 0; d0 < 8; ++d0) { const u32x4 w = raw[d0];
      ss += bf_lo(w.x) * bf_lo(w.x) + bf_hi(w.x) * bf_hi(w.x) + bf_lo(w.y) * bf_lo(w.y) + bf_hi(w.y) * bf_hi(w.y) + bf_lo(w.z) * bf_lo(w.z) + bf_hi(w.z) * bf_hi(w.z) + bf_lo(w.w) * bf_lo(w.w) + bf_hi(w.w) * bf_hi(w.w); }
    ss += __shfl_xor(ss, 32);
    const float rs = 1.0f / sqrtf(ss * (1.f / 128.f) + EPS);
    const int t = tpos + wid * QBLK + r32;
    const f32x2* rope = (const f32x2*)(lds + 81920);
#pragma unroll
    for (int d0 = 0; d0 < 8; ++d0) { const u32x4 w = raw[d0]; const float* wn = qn + d0 * 16 + hi * 8;
      const f32x4 g0 = *(const f32x4*)wn, g1 = *(const f32x4*)(wn + 4);
      float y[8] = {bf_lo(w.x) * rs * g0[0], bf_hi(w.x) * rs * g0[1], bf_lo(w.y) * rs * g0[2], bf_hi(w.y) * rs * g0[3], bf_lo(w.z) * rs * g1[0], bf_hi(w.z) * rs * g1[1], bf_lo(w.w) * rs * g1[2], bf_hi(w.w) * rs * g1[3]};
      if (tpos >= 0) {
        const int pos = (d0 < 4) ? (t >> 6) : (t & 63);
        const f32x4* rp = (const f32x4*)(rope + pos * 32 + (8 * (d0 & 3) + 4 * hi));
        const f32x4 c01 = rp[0], c23 = rp[1];
        const float cs[4] = {c01[0], c01[2], c23[0], c23[2]}, sn[4] = {c01[1], c01[3], c23[1], c23[3]};
#pragma unroll
        for (int pp = 0; pp < 4; ++pp) { const float x0 = y[2 * pp], x1 = y[2 * pp + 1]; y[2 * pp] = x0 * cs[pp] - x1 * sn[pp]; y[2 * pp + 1] = x0 * sn[pp] + x1 * cs[pp]; }
      }
      u32x4 o4 = {pk2(y[0], y[1]), pk2(y[2], y[3]), pk2(y[4], y[5]), pk2(y[6], y[7])};
      qr[d0] = __builtin_bit_cast(bf16x8, o4); }
  }
  const int sr = tid >> 4, sc = (tid & 15) * 8, vst0 = v_st(sr, sc), vst1 = v_st(32 + sr, sc);
  const int vb0 = (int)(uintptr_t)V_lds + v_rd_base(lane);
  struct { bf16x8 vs0, vs1, ks0, ks1; } sr_[2];
#define SLOAD(i, k0) do { sr_[i].vs0 = *reinterpret_cast<const bf16x8*>(&Vh[(long)((k0) + sr) * LDK + sc]); sr_[i].vs1 = *reinterpret_cast<const bf16x8*>(&Vh[(long)((k0) + 32 + sr) * LDK + sc]); \
    sr_[i].ks0 = *reinterpret_cast<const bf16x8*>(&Kh[(long)((k0) + sr) * LDK + sc]); sr_[i].ks1 = *reinterpret_cast<const bf16x8*>(&Kh[(long)((k0) + 32 + sr) * LDK + sc]); } while (0)
#define SWRITE(b, i) do { *(bf16x8*)((char*)V_lds + (b) * SHM_V + vst0) = sr_[i].vs0;          \
    *(bf16x8*)((char*)V_lds + (b) * SHM_V + vst1) = sr_[i].vs1; int kc = sc * 2;               \
    *(bf16x8*)((char*)K_lds + (b) * SHM_K + KSWZ(sr, kc)) = sr_[i].ks0;                       \
    *(bf16x8*)((char*)K_lds + (b) * SHM_K + KSWZ(32 + sr, kc)) = sr_[i].ks1; } while (0)
#define SWAIT() asm volatile("s_waitcnt vmcnt(4)" ::: "memory")
#define RESC(a) do { if (__any((a) < 1.f)) { if (hi == 0) al_l[r32] = (a); asm volatile("s_waitcnt lgkmcnt(0)" ::: "memory"); \
    _Pragma("unroll") for (int d = 0; d < 4; ++d) _Pragma("unroll") for (int r = 0; r < 16; ++r) o[d][r] *= al_l[crow(r, hi)]; } } while (0)
  f32x16 pA0, pA1, pB0, pB1; float mnA, mnB, alA, alB; bf16x8 pa0, pa1, pa2, pa3; const int NT = seq / KVBLK;
  constexpr int SE = 0, SO = 1;
  SLOAD(SE, 0); asm volatile("s_waitcnt vmcnt(0)" ::: "memory"); SWRITE(0, SE); __syncthreads();
  qkt(pA0, pA1, K_lds, qr, r32, hi); partialSM(pA0, pA1, m_reg, mnA, alA);
  SLOAD(SO, KVBLK); if (2 < NT) SLOAD(SE, 2 * KVBLK);
  SWAIT(); SWRITE(1, SO); __syncthreads();
  for (int j = 1; j + 1 < NT; j += 2) {
    SBAR(); qkt(pB0, pB1, (bf16_t*)((char*)K_lds + SHM_K), qr, r32, hi);
    finishSM(pA0, pA1, alA, l_reg, pa0, pa1, pa2, pa3); SBAR();
    SLOAD(SO, (j + 2) * KVBLK); SBAR();
    pv_d0(o, vb0, pa0, pa1, pa2, pa3); partialSM(pB0, pB1, m_reg, mnB, alB);
    __syncthreads(); SWAIT(); SWRITE(0, SE);
    RESC(alB); __syncthreads();
    SBAR(); qkt(pA0, pA1, K_lds, qr, r32, hi);
    finishSM(pB0, pB1, alB, l_reg, pa0, pa1, pa2, pa3); SBAR();
    if (j + 3 < NT) SLOAD(SE, (j + 3) * KVBLK); SBAR();
    pv_d0(o, vb0 + (int)SHM_V, pa0, pa1, pa2, pa3); partialSM(pA0, pA1, m_reg, mnA, alA);
    __syncthreads(); SWAIT(); SWRITE(1, SO);
    RESC(alA); __syncthreads();
  }
  SBAR(); qkt(pB0, pB1, (bf16_t*)((char*)K_lds + SHM_K), qr, r32, hi);
  finishSM(pA0, pA1, alA, l_reg, pa0, pa1, pa2, pa3); SBAR();
  pv_d0(o, vb0, pa0, pa1, pa2, pa3); partialSM(pB0, pB1, m_reg, mnB, alB);
  __syncthreads(); RESC(alB);
  finishSM(pB0, pB1, alB, l_reg, pa0, pa1, pa2, pa3); SBAR();
  pv_d0(o, vb0 + (int)SHM_V, pa0, pa1, pa2, pa3);
  u32x4 zq[8];
#pragma unroll
  for (int i = 0; i < 8; ++i) { const int id = tid + 512 * i; zq[i] = *(const u32x4*)(SZb + (long)(id >> 4) * LDQ + (id & 15) * 8); }
  if (hi == 0) li_l[r32] = l_reg; asm volatile("s_waitcnt lgkmcnt(0)" ::: "memory");
  __syncthreads();
  {
    float rli[16];
#pragma unroll
    for (int r = 0; r < 16; ++r) rli[r] = __builtin_amdgcn_rcpf(li_l[crow(r, hi)]);
    char* ost = lds;
#pragma unroll
    for (int r = 0; r < 16; ++r) { char* rowp = ost + (wid * QBLK + crow(r, hi)) * 256 + r32 * 2;
#pragma unroll
      for (int d0 = 0; d0 < 4; ++d0) *(unsigned short*)(rowp + d0 * 64) = (unsigned short)(pk2(o[d0][r] * rli[r], 0.f) & 0xffffu); }
  }
  __syncthreads();
#pragma unroll
  for (int i = 0; i < 8; ++i) { const int id = tid + 512 * i; const int row = id >> 4, ch = id & 15;
    const u32x4 ov = *(const u32x4*)(lds + row * 256 + ch * 16);
    f32x4 a0 = {bf_lo(ov.x), bf_hi(ov.x), bf_lo(ov.y), bf_hi(ov.y)}, a1 = {bf_lo(ov.z), bf_hi(ov.z), bf_lo(ov.w), bf_hi(ov.w)};
    const f32x4 z0 = {bf_lo(zq[i].x), bf_hi(zq[i].x), bf_lo(zq[i].y), bf_hi(zq[i].y)}, z1 = {bf_lo(zq[i].z), bf_hi(zq[i].z), bf_lo(zq[i].w), bf_hi(zq[i].w)};
    st_bf16x8(Ub + (long)row * LDQ + ch * 8, a0 * z0, a1 * z1); }
  __syncthreads();
#undef SLOAD
#undef SWRITE
#undef SWAIT
#undef RESC
}
#undef KSWZ
#undef SBAR
}

DI void qknorm_phase(const Args& A, LAS unsigned char* lds, int wv) {
    const int tid = otid(wv), lane = tid & 63, wave = tid >> 6, G = gridDim.x;
    bf16_t* Q = (bf16_t*)(A.ws + WS_SCR + A_Q); bf16_t* Kb = (bf16_t*)(A.ws + WS_SCR + A_K);
    const float* qn = A.in[14]; const float* kn = A.in[15];
    const int sub = lane >> 4, l16 = lane & 15, e0 = l16 * 8;
    LAS f32x2* rope = (LAS f32x2*)lds;
    for (int e = tid; e < 2048; e += NTHREADS) { const float ang = (float)(e >> 5) * exp2f(-(float)(e & 31) * 0.41524101186092029f); rope[e] = (f32x2){cosf(ang), sinf(ang)}; }
    __syncthreads();
    const long NIT = (long)NTOK * 4;
    for (long it0 = ((long)blockIdx.x * NWAVES + wave) * 16 + sub; it0 < NIT; it0 += (long)G * NWAVES * 16) {
        bf16_t* pq[4]; u32x4 raw[4];
#pragma unroll
        for (int k = 0; k < 4; ++k) { const long it = it0 + 4 * k; const int row = (int)(it >> 2), hj = 16 + (int)(it & 3);
            pq[k] = (hj < 16) ? Q + (size_t)row * 2048 + hj * 128 + e0 : Kb + (size_t)row * 512 + (hj - 16) * 128 + e0;
            raw[k] = *(const u32x4*)pq[k]; }
#pragma unroll
        for (int k = 0; k < 4; ++k) {
            const long it = it0 + 4 * k; const int row = (int)(it >> 2), hj = 16 + (int)(it & 3);
            const float* wn = (hj < 16 ? qn : kn) + e0;
            f32x4 a = {bf_lo(raw[k].x), bf_hi(raw[k].x), bf_lo(raw[k].y), bf_hi(raw[k].y)}, b = {bf_lo(raw[k].z), bf_hi(raw[k].z), bf_lo(raw[k].w), bf_hi(raw[k].w)};
            float ss = 0.f;
#pragma unroll
            for (int q = 0; q < 4; ++q) ss += a[q] * a[q] + b[q] * b[q];
            ss += __shfl_xor(ss, 1); ss += __shfl_xor(ss, 2); ss += __shfl_xor(ss, 4); ss += __shfl_xor(ss, 8);
            const float rs = 1.0f / sqrtf(ss * (1.f / 128.f) + EPS);
            const f32x4 w0 = *(const f32x4*)wn, w1 = *(const f32x4*)(wn + 4);
            a = a * rs * w0; b = b * rs * w1;
            const int t = row % TB;
            if (t < TL) {
                const int pos = (l16 < 8) ? (t >> 6) : (t & 63);
                float y[8] = {a[0], a[1], a[2], a[3], b[0], b[1], b[2], b[3]};
                const LAS f32x4* rp = (const LAS f32x4*)(rope + pos * 32 + ((4 * l16) & 31));
                const f32x4 c01 = rp[0], c23 = rp[1];
                const float cs[4] = {c01[0], c01[2], c23[0], c23[2]}, sn[4] = {c01[1], c01[3], c23[1], c23[3]};
#pragma unroll
                for (int pp = 0; pp < 4; ++pp) {
                    const float x0 = y[2 * pp], x1 = y[2 * pp + 1];
                    y[2 * pp] = x0 * cs[pp] - x1 * sn[pp]; y[2 * pp + 1] = x0 * sn[pp] + x1 * cs[pp];
                }
                a = (f32x4){y[0], y[1], y[2], y[3]}; b = (f32x4){y[4], y[5], y[6], y[7]};
            }
            st_bf16x8(pq[k], a, b);
        }
    }
}

DI void attn_layer(const Args& A, LAS unsigned char* lds, char* lds_gen, const XcdBarrier& gbar, int layer, int wv) {
    unsigned char* ws = A.ws;
    const bf16_t* H = (const bf16_t*)(ws + WS_H); bf16_t* U = (bf16_t*)(ws + WS_H);
    bf16_t* Q = (bf16_t*)(ws + WS_SCR + A_Q); bf16_t* Kb = (bf16_t*)(ws + WS_SCR + A_K); bf16_t* Vb = (bf16_t*)(ws + WS_SCR + A_V); bf16_t* SZ = (bf16_t*)(ws + WS_SCR + A_SZ);
    norm_phase(A, layer, false, wv);
    xcd_barrier(gbar, wv);
    {
        DescPlain D; D.init(H, (const bf16_t*)(ws + WS_WAI), 20, false);
        auto E = [=](const pg8::Unit& u, int row_l, int col_l, f32x4 v0, f32x4 v1) {
            const size_t row = (size_t)u.i0 * 256 + row_l; const int pn = u.i1;
            if (pn < 8) st_bf16x8(Q + row * 2048 + pn * 256 + col_l, v0, v1);
            else if (pn < 10) st_bf16x8(Kb + row * 512 + (pn - 8) * 256 + col_l, v0, v1);
            else if (pn < 12) st_bf16x8(Vb + row * 512 + (pn - 10) * 256 + col_l, v0, v1);
            else { f32x4 a, b;
#pragma unroll
                for (int q = 0; q < 4; ++q) { a[q] = siluf(v0[q]); b[q] = siluf(v1[q]); }
                st_bf16x8(SZ + row * 2048 + (pn - 12) * 256 + col_l, a, b); }
        };
        pg8::gemm_phase(lds, D, E, wv);
    }
    xcd_barrier(gbar, wv);
    qknorm_phase(A, lds, wv);
    xcd_barrier(gbar, wv);
    {
        const int G = gridDim.x, c = blockIdx.x;
        { f32x2* rope = (f32x2*)(lds_gen + 81920); const int tid = otid(wv);
          for (int e = tid; e < 2048; e += NTHREADS) { const float ang = (float)(e >> 5) * exp2f(-(float)(e & 31) * 0.41524101186092029f); rope[e] = (f32x2){cosf(ang), sinf(ang)}; }
          __syncthreads(); }
        const float* qn = A.in[14];
        for (long L = c; L < 2048; L += G) {
            const int u = pg8::xcd_remap((int)L, 2048);
            const int b = u / 128, rem = u % 128, kvh = rem / 32, g = (rem / 8) % 4, qb = rem % 8, h = kvh * 4 + g;
            const size_t qoff = ((size_t)b * TB + qb * 256) * 2048 + h * 128, koff = ((size_t)b * TB) * 512 + kvh * 128;
            att::attn_dense_body(Q + qoff, Kb + koff, Vb + koff, SZ + qoff, U + qoff, TB, lds_gen, wv, qn, qb * 256);
        }
        for (int u = c; u < 256; u += G) {
            const int b = u / 16, h = u % 16, kvh = h / 4;
            const size_t qoff = ((size_t)b * TB + TL) * 2048 + h * 128, koff = ((size_t)b * TB + TL) * 512 + kvh * 128;
            att::attn_dense_body(Q + qoff, Kb + koff, Vb + koff, SZ + qoff, U + qoff, TC, lds_gen, wv, qn, -1);
        }
    }
    xcd_barrier(gbar, wv);
    {
        DescPlain D; D.init(U, (const bf16_t*)(ws + WS_WAO), 8, false);
        EpiResid E; E.init(A, layer);
        pg8::gemm_phase(lds, D, E, wv);
    }
    xcd_barrier(gbar, wv);
}


struct DescM1 {
    static constexpr bool RAW = false;
    const bf16_t* H; const bf16_t* WA; const bf16_t* WB; int lda, ldb, K, total;
    DI void init(const bf16_t* H_, const bf16_t* WA_, const bf16_t* WB_) { H = H_; WA = WA_; WB = WB_; lda = DM; ldb = DM; K = DM; total = 144 * 9 + 8 * 144; }
    DI pg8::Unit unit(int idx) const {
        pg8::Unit u;
        if (idx < 1296) { const int nig = 72, gid = idx / nig, pm = gid * 8 + (idx % nig) % 8, pn = (idx % nig) / 8;
            u.a = (const char*)(H + (size_t)pm * 256 * DM); u.b = (const char*)(WA + (size_t)pn * 256 * DM); u.i0 = pm; u.i1 = pn; u.i2 = 0; }
        else { const int j = idx - 1296, mt = j % 8, nt = j / 8;
            u.a = (const char*)(WB + (size_t)mt * 256 * DM); u.b = (const char*)(H + (size_t)nt * 256 * DM); u.i0 = mt; u.i1 = nt; u.i2 = 1; }
        return u;
    }
};
namespace ml {
#define MFMA32(a, b, c) __builtin_amdgcn_mfma_f32_32x32x16_bf16((a), (b), (c), 0, 0, 0)
#define LFENCE() asm volatile("s_waitcnt lgkmcnt(0)" ::: "memory")
DI float dot2_bf16(unsigned a, unsigned b, float c) { asm("v_dot2c_f32_bf16 %0, %1, %2" : "+v"(c) : "v"(a), "v"(b)); return c; }
#define DOT2(a, b, c) dot2_bf16((a), (b), (c))
DI int crow(int reg, int h) { return (reg & 3) + 8 * (reg >> 2) + 4 * h; }
DI bf16x8 ldperm(const bf16_t* p) { const s16x4 lo = *(const s16x4*)p, hi = *(const s16x4*)(p + 8); return __builtin_shufflevector(lo, hi, 0, 1, 2, 3, 4, 5, 6, 7); }
DI bf16x8 pack_step(const f32x16& x, int s) { u32x4 p = {pk2(x[8 * s], x[8 * s + 1]), pk2(x[8 * s + 2], x[8 * s + 3]), pk2(x[8 * s + 4], x[8 * s + 5]), pk2(x[8 * s + 6], x[8 * s + 7])}; return __builtin_bit_cast(bf16x8, p); }
DI float bfs(short h) { return __uint_as_float(((unsigned)(unsigned short)h) << 16); }

constexpr int SC_Q = 0, SC_K = 16384, SC_KT = 32768, SC_BUF = 49152, SC_WAVE = 2 * SC_BUF, SC_WAVE_BYTES = 6656;
DI bf16x8 ldsfrag(const LAS unsigned char* buf, unsigned o) { const s16x4 lo = *(const LAS s16x4*)(buf + o), hi = *(const LAS s16x4*)(buf + (o ^ 16u)); return __builtin_shufflevector(lo, hi, 0, 1, 2, 3, 4, 5, 6, 7); }
DI void scan_phase(const Args& A, LAS unsigned char* lds, int wv) {
    const int wave = wv;
    LAS float* wl = (LAS float*)(lds + SC_WAVE + wave * SC_WAVE_BYTES);
    LAS unsigned* nbp = (LAS unsigned*)(lds + SC_WAVE + wave * SC_WAVE_BYTES + 2048);
    LAS unsigned* wbp = nbp + 64;
    LAS unsigned char* hst = lds + SC_WAVE + wave * SC_WAVE_BYTES + 2560;
    unsigned char* ws = A.ws;
    const bf16_t* Qg = (const bf16_t*)(ws + WS_SCR + M_Q); const bf16_t* Kg = (const bf16_t*)(ws + WS_SCR + M_K); const bf16_t* KVT = (const bf16_t*)(ws + WS_SCR + M_KVT);
    const float* G32 = (const float*)(ws + WS_SCR + M_G32); const float* bg = A.in[10];
#define SC_POS0(j) (dir == 0 ? ((j) < 4 ? TL + 64 * (j) : 64 * ((j) - 4)) : ((j) < 4 ? TL + 64 * (3 - (j)) : 64 * (35 - (j))))
#define SC_DMA(bufi, p0) do { const int tj_ = otid(wv); _Pragma("unroll") for (int i_ = 0; i_ < 2; ++i_) { const int sl_ = i_ * 512 + tj_; \
        { const int row_ = sl_ >> 4, c_ = (sl_ & 15) ^ (row_ & 15); const size_t go_ = (size_t)((p0) + row_) * 1024 + c_ * 8; \
          __builtin_amdgcn_global_load_lds((const unsigned*)(Qu + go_), (LAS unsigned*)(lds + (bufi) * SC_BUF + SC_Q + i_ * 8192 + wave * 1024), 16, 0, 0); \
          __builtin_amdgcn_global_load_lds((const unsigned*)(Ku + go_), (LAS unsigned*)(lds + (bufi) * SC_BUF + SC_K + i_ * 8192 + wave * 1024), 16, 0, 0); } \
        { const int d_ = sl_ >> 3, c_ = (sl_ & 7) ^ ((d_ >> 1) & 7); \
          __builtin_amdgcn_global_load_lds((const unsigned*)(KTu + (size_t)d_ * TB + (p0) + c_ * 8), (LAS unsigned*)(lds + (bufi) * SC_BUF + SC_KT + i_ * 8192 + wave * 1024), 16, 0, 0); } } } while (0)
    for (int item = blockIdx.x; item < 256; item += gridDim.x) {
        const int dir = item & 1, h = (item >> 1) & 7, b = item >> 4, e0 = wave * 32;
        const bf16_t* Qu = Qg + (size_t)b * TB * 1024 + h * 128;
        const bf16_t* Ku = Kg + (size_t)b * TB * 1024 + h * 128;
        const bf16_t* KTu = KVT + ((size_t)b * 3072 + h * 128) * TB;
        const bf16_t* VTu = KVT + ((size_t)b * 3072 + 1024 + h * 256 + e0) * TB;
        bf16_t* Hout = (bf16_t*)(ws + WS_SCR + (dir ? M_HB : M_HF)) + (size_t)b * TB * DM + h * 256 + e0;
        const float big = bg[(dir * 2) * 8 + h], bfg = bg[(dir * 2 + 1) * 8 + h];
        f32x16 cacc[4];
#pragma unroll
        for (int d = 0; d < 4; ++d)
#pragma unroll
            for (int i = 0; i < 16; ++i) cacc[d][i] = 0.f;
        float m = 0.f;
        { const int l0 = otid(wv) & 63; wl[384 + l0] = 0.f; wl[448 + l0] = 0.f; nbp[l0] = 0u; }
        LFENCE();
        SC_DMA(0, SC_POS0(0));
        float ig_n, fg_n;
        { const int l0 = otid(wv) & 63; const float* gp = G32 + (size_t)(b * TB + SC_POS0(0) + (dir ? 63 - l0 : l0)) * 32 + (dir * 2) * 8 + h; ig_n = gp[0]; fg_n = gp[8]; }
        for (int j = 0; j < 36; ++j) {
            const int pos0 = SC_POS0(j);
            const LAS unsigned char* Qb = lds + (j & 1) * SC_BUF + SC_Q; const LAS unsigned char* Kb = lds + (j & 1) * SC_BUF + SC_K; const LAS unsigned char* KTb = lds + (j & 1) * SC_BUF + SC_KT;
            asm volatile("s_waitcnt vmcnt(0)" ::: "memory"); __builtin_amdgcn_s_barrier(); asm volatile("" ::: "memory");
            if (j + 1 < 36) SC_DMA((j + 1) & 1, SC_POS0(j + 1));
            const int lj = otid(wv) & 63, rj = lj & 31, h4 = (lj >> 5) * 4;
            LAS float* wh = wl + h4; LAS float* wr = wl + rj; LAS unsigned char* hb = hst + h4 * 64 + rj * 2;
            const LAS unsigned* nbh = nbp + (h4 >> 1); const LAS unsigned* wbh = wbp + (h4 >> 1);
            const unsigned xr = rj & 15, xd = (rj >> 1) & 7;
            const unsigned qro = (unsigned)rj * 256u + 2u * h4;
            const unsigned kro = (unsigned)rj * 128u + 2u * h4;
            const bf16_t* VTp = VTu + (size_t)rj * TB + pos0 + h4;
            bf16x8 vf[4];
#pragma unroll
            for (int kk = 0; kk < 4; ++kk) vf[kk] = ldperm(VTp + 16 * kk);
            float decay, m_new;
            {
                const int s = dir ? 63 - lj : lj;
                const float ig = ig_n + big, fg = fg_n + bfg;
                if (j + 1 < 36) { const float* gp = G32 + (size_t)(b * TB + SC_POS0(j + 1) + s) * 32 + (dir * 2) * 8 + h; ig_n = gp[0]; fg_n = gp[8]; }
                const float lf = fminf(fg, 0.f) - log1pf(__expf(-fabsf(fg)));
                float bs = lf;
#pragma unroll
                for (int o = 1; o < 64; o <<= 1) { const float t = __shfl_up(bs, o); if (lj >= o) bs += t; }
                const float uu = ig - bs;
                float pmx = uu;
#pragma unroll
                for (int o = 1; o < 64; o <<= 1) { const float t = __shfl_up(pmx, o); if (lj >= o) pmx = fmaxf(pmx, t); }
                pmx = fmaxf(pmx, m);
                const float b_end = __shfl(bs, 63), pm_last = __shfl(pmx, 63);
                LAS float* ws_ = wl + s;
                ws_[0] = uu * 1.4426950408889634f; ws_[64] = pmx * 1.4426950408889634f; ws_[128] = __expf(m - pmx); ws_[192] = __expf(-(bs + pmx)); ws_[256] = __expf(uu - pm_last);
                { const float wv_ = __expf(uu - pm_last), wp_ = __shfl_xor(wv_, 1); if ((s & 1) == 0) wbp[s >> 1] = pk2(wv_, wp_); }
                decay = __expf(m - pm_last); m_new = b_end + pm_last;
            }
            LFENCE();
            const int sbase = dir ? 63 - h4 : h4, sgn = dir ? -1 : 1;
#pragma unroll
            for (int tb = 0; tb < 2; ++tb) {
                __builtin_amdgcn_sched_barrier(0);
                const unsigned qo = qro + tb * 8192u;
                f32x16 ha;
#pragma unroll
                for (int i = 0; i < 16; ++i) ha[i] = 0.f;
                float qnv = 0.f;
#pragma unroll
                for (int kk = 0; kk < 8; ++kk) {
                    const bf16x8 qa = ldsfrag(Qb, qo + (((2u * kk) ^ xr) << 4));
                    ha = MFMA32(qa, pack_step(cacc[kk >> 1], kk & 1), ha);
                    { const u32x2 nb0 = *(const LAS u32x2*)(nbh + 8 * kk), nb1 = *(const LAS u32x2*)(nbh + 8 * kk + 4); const u32x4 qw = __builtin_bit_cast(u32x4, qa);
                      qnv = DOT2(qw.x, nb0.x, qnv); qnv = DOT2(qw.y, nb0.y, qnv); qnv = DOT2(qw.z, nb1.x, qnv); qnv = DOT2(qw.w, nb1.y, qnv); }
                }
                qnv += __shfl_xor(qnv, 32);
#pragma unroll
                for (int g = 0; g < 4; ++g) { const f32x4 av = *(const LAS f32x4*)(wh + 128 + 32 * tb + 8 * g);
#pragma unroll
                    for (int q = 0; q < 4; ++q) ha[4 * g + q] *= av[q]; }
                const float pmt = wr[64 + 32 * tb];
                const int tp = dir ? (63 - 32 * tb) - rj : 32 * tb + rj;
                float ds = 0.f;
#pragma unroll
                for (int sb = 0; sb < 2; ++sb) {
                    __builtin_amdgcn_sched_barrier(0);
                    if (sb != tb && (dir ? sb < tb : sb > tb)) continue;
                    const unsigned ko = qro + sb * 8192u;
                    f32x16 st;
#pragma unroll
                    for (int i = 0; i < 16; ++i) st[i] = 0.f;
#pragma unroll
                    for (int kk = 0; kk < 8; ++kk) { const unsigned c = ((2u * kk) ^ xr) << 4; st = MFMA32(ldsfrag(Kb, ko + c), ldsfrag(Qb, qo + c), st); }
#pragma unroll
                    for (int g = 0; g < 4; ++g) { const f32x4 uv = *(const LAS f32x4*)(wh + 32 * sb + 8 * g);
#pragma unroll
                        for (int q = 0; q < 4; ++q) {
                            const int sc = 32 * sb + q + 8 * g;
                            const int sp = sbase + sgn * sc;
                            st[4 * g + q] *= __builtin_amdgcn_exp2f((sp <= tp) ? uv[q] - pmt : -1e30f);
                            ds += st[4 * g + q];
                        } }
                    ha = MFMA32(pack_step(st, 0), vf[2 * sb], ha);
                    ha = MFMA32(pack_step(st, 1), vf[2 * sb + 1], ha);
                }
                ds += __shfl_xor(ds, 32);
                {
                    const float den = wr[128 + 32 * tb] * qnv + ds;
                    const float rd = 1.0f / fmaxf(fabsf(den), wr[192 + 32 * tb]);
                    if (h4 == 0) wr[320 + 32 * tb] = rd;
                }
                LFENCE();
#pragma unroll
                for (int g = 0; g < 4; ++g) { const f32x4 rv = *(const LAS f32x4*)(wh + 320 + 32 * tb + 8 * g);
#pragma unroll
                    for (int q = 0; q < 4; ++q) { const int tc = 32 * tb + q + 8 * g;
                        *(LAS unsigned short*)(hb + tc * 64) = (unsigned short)(pk2(ha[4 * g + q] * rv[q], 0.f) & 0xffffu); } }
            }
            LFENCE();
            {
                bf16_t* hp = Hout + (size_t)(pos0 + lj) * DM;
                const LAS unsigned char* hrow = hst + lj * 64;
#pragma unroll
                for (int q = 0; q < 4; ++q) *(u32x4*)(hp + 8 * q) = *(const LAS u32x4*)(hrow + 16 * q);
            }
            __builtin_amdgcn_sched_barrier(0);
            bf16x8 vfw[4];
#pragma unroll
            for (int kk = 0; kk < 4; ++kk) {
                const f32x4 w0 = *(const LAS f32x4*)(wh + 256 + 16 * kk), w1 = *(const LAS f32x4*)(wh + 256 + 16 * kk + 8);
                u32x4 p = {pk2(bfs(vf[kk][0]) * w0[0], bfs(vf[kk][1]) * w0[1]), pk2(bfs(vf[kk][2]) * w0[2], bfs(vf[kk][3]) * w0[3]),
                           pk2(bfs(vf[kk][4]) * w1[0], bfs(vf[kk][5]) * w1[1]), pk2(bfs(vf[kk][6]) * w1[2], bfs(vf[kk][7]) * w1[3])};
                vfw[kk] = __builtin_bit_cast(bf16x8, p);
            }
#pragma unroll
            for (int db = 0; db < 4; ++db) {
#pragma unroll
                for (int i = 0; i < 16; ++i) cacc[db][i] *= decay;
                const unsigned to = kro + db * 4096u;
                float nadd = 0.f;
#pragma unroll
                for (int kk = 0; kk < 4; ++kk) {
                    const bf16x8 kv = ldsfrag(KTb, to + (((2u * kk) ^ xd) << 4));
                    const u32x2 wq0 = *(const LAS u32x2*)(wbh + 8 * kk), wq1 = *(const LAS u32x2*)(wbh + 8 * kk + 4); const u32x4 kw = __builtin_bit_cast(u32x4, kv);
                    nadd = DOT2(kw.x, wq0.x, nadd); nadd = DOT2(kw.y, wq0.y, nadd); nadd = DOT2(kw.z, wq1.x, nadd); nadd = DOT2(kw.w, wq1.y, nadd);
                    cacc[db] = MFMA32(kv, vfw[kk], cacc[db]);
                }
                nadd += __shfl_xor(nadd, 32);
                const float nnew = decay * wr[384 + 32 * db] + nadd, npart = __shfl_xor(nnew, 1);
                if (h4 == 0) { wr[384 + 32 * db] = nnew; if ((rj & 1) == 0) nbp[(32 * db + rj) >> 1] = pk2(nnew, npart); }
            }
            LFENCE();
            m = m_new;
        }
        asm volatile("s_waitcnt vmcnt(0)" ::: "memory"); __builtin_amdgcn_s_barrier();
    }
#undef SC_DMA
#undef SC_POS0
}
#undef MFMA32
#undef LFENCE
#undef DOT2
}

DI void mlstm_finish_phase(const Args& A, int wv) {
    const int tid = otid(wv), lane = tid & 63, wave = tid >> 6, G = gridDim.x;
    unsigned char* ws = A.ws;
    const bf16_t* HF = (const bf16_t*)(ws + WS_SCR + M_HF); const bf16_t* HB = (const bf16_t*)(ws + WS_SCR + M_HB);
    const bf16_t* SO = (const bf16_t*)(ws + WS_SCR + M_SO); const bf16_t* SZ = (const bf16_t*)(ws + WS_SCR + M_SZ);
    bf16_t* U = (bf16_t*)(ws + WS_H); const float* hn = A.in[11];
    const int sub = lane >> 5, e0 = (lane & 31) * 8;
    const long NIT = (long)NTOK * 8;
    for (long it0 = ((long)blockIdx.x * NWAVES + wave) * 4 + sub; it0 < NIT; it0 += (long)G * NWAVES * 4) {
        f32x4 f0[2], f1[2], b0[2], b1[2], o0[2], o1[2], z0[2], z1[2];
#pragma unroll
        for (int k = 0; k < 2; ++k) { const long it = it0 + 2 * k; const size_t off = (size_t)(it >> 3) * DM + (int)(it & 7) * 256 + e0;
            ld_bf16x8(HF + off, f0[k], f1[k]); ld_bf16x8(HB + off, b0[k], b1[k]); ld_bf16x8(SO + off, o0[k], o1[k]); ld_bf16x8(SZ + off, z0[k], z1[k]); }
#pragma unroll
        for (int k = 0; k < 2; ++k) { const long it = it0 + 2 * k; const size_t off = (size_t)(it >> 3) * DM + (int)(it & 7) * 256 + e0;
            f32x4 y0 = o0[k] * (f0[k] + b0[k]), y1 = o1[k] * (f1[k] + b1[k]);
            float ss = 0.f;
#pragma unroll
            for (int q = 0; q < 4; ++q) ss += y0[q] * y0[q] + y1[q] * y1[q];
            ss += __shfl_xor(ss, 1); ss += __shfl_xor(ss, 2); ss += __shfl_xor(ss, 4); ss += __shfl_xor(ss, 8); ss += __shfl_xor(ss, 16);
            const float rs = 1.0f / sqrtf(ss * (1.f / 256.f) + EPS);
            const float* hp = hn + (int)(it & 7) * 256 + e0;
            const f32x4 h0 = *(const f32x4*)hp, h1 = *(const f32x4*)(hp + 4);
            st_bf16x8(U + off, y0 * rs * h0 * z0[k], y1 * rs * h1 * z1[k]); }
    }
}

DI void mlstm_layer(const Args& A, LAS unsigned char* lds, const XcdBarrier& gbar, int layer, int wv) {
    unsigned char* ws = A.ws;
    const bf16_t* H = (const bf16_t*)(ws + WS_H); bf16_t* U = (bf16_t*)(ws + WS_H);
    bf16_t* Q = (bf16_t*)(ws + WS_SCR + M_Q); bf16_t* Kb = (bf16_t*)(ws + WS_SCR + M_K); bf16_t* KVT = (bf16_t*)(ws + WS_SCR + M_KVT);
    float* G32 = (float*)(ws + WS_SCR + M_G32); bf16_t* SO = (bf16_t*)(ws + WS_SCR + M_SO); bf16_t* SZ = (bf16_t*)(ws + WS_SCR + M_SZ);
    norm_phase(A, layer, false, wv);
    xcd_barrier(gbar, wv);
    {
        DescM1 D; D.init(H, (const bf16_t*)(ws + WS_WMA), (const bf16_t*)(ws + WS_WMB));
        auto E = [=](const pg8::Unit& u, int row_l, int col_l, f32x4 v0, f32x4 v1) {
            if (u.i2 == 0) {
                const size_t row = (size_t)u.i0 * 256 + row_l; const int pn = u.i1;
                if (pn < 4) st_bf16x8(Q + row * 1024 + pn * 256 + col_l, v0 * 0.088388347648318440f, v1 * 0.088388347648318440f);
                else if (pn < 8) { st_bf16x8(Kb + row * 1024 + (pn - 4) * 256 + col_l, v0, v1);
                    const int bb = u.i0 / 9, sp = (u.i0 % 9) * 256 + row_l;
                    bf16_t* kt = KVT + ((size_t)bb * 3072 + (pn - 4) * 256 + col_l) * TB + sp;
                    const unsigned w0 = pk2(v0[0], v0[1]), w1 = pk2(v0[2], v0[3]), w2 = pk2(v1[0], v1[1]), w3 = pk2(v1[2], v1[3]);
                    kt[0] = (bf16_t)(w0 & 0xffffu); kt[TB] = (bf16_t)(w0 >> 16); kt[2 * TB] = (bf16_t)(w1 & 0xffffu); kt[3 * TB] = (bf16_t)(w1 >> 16);
                    kt[4 * TB] = (bf16_t)(w2 & 0xffffu); kt[5 * TB] = (bf16_t)(w2 >> 16); kt[6 * TB] = (bf16_t)(w3 & 0xffffu); kt[7 * TB] = (bf16_t)(w3 >> 16); }
                else if (col_l < 32) { *(f32x4*)(G32 + row * 32 + col_l) = v0; *(f32x4*)(G32 + row * 32 + col_l + 4) = v1; }
            } else {
                const int bb = u.i1 / 9, s0 = (u.i1 % 9) * 256;
                st_bf16x8(KVT + ((size_t)bb * 3072 + 1024 + u.i0 * 256 + row_l) * TB + s0 + col_l, v0, v1);
            }
        };
        pg8::gemm_phase(lds, D, E, wv);
    }
    xcd_barrier(gbar, wv);
    ml::scan_phase(A, lds, wv);
    xcd_barrier(gbar, wv);
    {
        DescPlain D; D.init(H, (const bf16_t*)(ws + WS_WMA) + (size_t)2304 * DM, 16, false);
        auto E = [=](const pg8::Unit& u, int row_l, int col_l, f32x4 v0, f32x4 v1) {
            const size_t row = (size_t)u.i0 * 256 + row_l; const int pn = u.i1; f32x4 a, b;
            if (pn < 8) {
#pragma unroll
                for (int q = 0; q < 4; ++q) { a[q] = sigmf(v0[q]); b[q] = sigmf(v1[q]); }
                st_bf16x8(SO + row * DM + pn * 256 + col_l, a, b);
            } else {
#pragma unroll
                for (int q = 0; q < 4; ++q) { a[q] = siluf(v0[q]); b[q] = siluf(v1[q]); }
                st_bf16x8(SZ + row * DM + (pn - 8) * 256 + col_l, a, b);
            }
        };
        pg8::gemm_phase(lds, D, E, wv);
    }
    xcd_barrier(gbar, wv);
    mlstm_finish_phase(A, wv);
    xcd_barrier(gbar, wv);
    {
        DescPlain D; D.init(U, (const bf16_t*)(ws + WS_WMO), 8, false);
        EpiResid E; E.init(A, layer);
        pg8::gemm_phase(lds, D, E, wv);
    }
    xcd_barrier(gbar, wv);
}

__global__ void __launch_bounds__(NTHREADS, 2) fwd_megakernel(Args A) {
    extern __shared__ __attribute__((aligned(16))) unsigned char lds_raw[];
    LAS unsigned char* lds = (LAS unsigned char*)lds_raw;
    cg::grid_group grid = cg::this_grid();
    const int wv = __builtin_amdgcn_readfirstlane(threadIdx.x >> 6);
    volatile LAS unsigned* bst = (volatile LAS unsigned*)(lds + 152576);
    if (otid(wv) < 2) bst[otid(wv)] = 0u;
    __syncthreads();
    const XcdBarrier gbar = xcd_barrier_post((unsigned*)(A.ws + WS_BAR), bst, wv);
    prep_phase(A, lds, wv);
    grid.sync();
    {
        const long long* mi = (const long long*)(A.ws + WS_MODI); float* mf = (float*)(A.ws + WS_MOD);
        for (int i = blockIdx.x * NTHREADS + otid(wv); i < 4 * 17 * MOD_LD; i += gridDim.x * NTHREADS) mf[i] = (float)mi[i] * MODI_INV;
    }
    xcd_barrier(gbar, wv);
    fnet_layer(A, lds, gbar, 0, 0, false, wv);
    mlstm_layer(A, lds, gbar, 1, wv);
    attn_layer(A, lds, (char*)lds_raw, gbar, 2, wv);
    fnet_layer(A, lds, gbar, 3, 1, true, wv);
    final_norm_phase(A, (const bf16_t*)(A.ws + WS_SCR + F_PQX), wv);
}

extern "C" void kernel_launch(void* const* d_in, const int* in_sizes, int n_in, void* d_out, int out_size, void* d_ws, size_t ws_size, hipStream_t stream) {
    static int grid = 0;
    if (grid == 0) {
        if (n_in != 18 || ws_size < WS_END) { fprintf(stderr, "kernel_launch: unexpected n_in %d / ws_size %zu (need %zu)\n", n_in, ws_size, (size_t)WS_END); grid = -1; return; }
        int dev = 0, cus = 0, per_cu = 0;
        hipGetDevice(&dev);
        hipDeviceGetAttribute(&cus, hipDeviceAttributeMultiprocessorCount, dev);
        if (hipFuncSetAttribute((const void*)fwd_megakernel, hipFuncAttributeMaxDynamicSharedMemorySize, LDS_BYTES) != hipSuccess) { fprintf(stderr, "kernel_launch: hipFuncSetAttribute failed\n"); grid = -1; return; }
        if (hipOccupancyMaxActiveBlocksPerMultiprocessor(&per_cu, (const void*)fwd_megakernel, NTHREADS, LDS_BYTES) != hipSuccess || per_cu < 1) { fprintf(stderr, "kernel_launch: occupancy query failed (%d)\n", per_cu); per_cu = 1; }
        (void)hipGetLastError();
        grid = cus * per_cu;
        fprintf(stderr, "kernel_launch: grid %d (cus %d x %d)\n", grid, cus, per_cu);
    }
    if (grid < 0) return;
    (void)hipMemsetAsync((char*)d_ws + WS_MOD, 0, ZERO_BYTES, stream);
    (void)hipMemsetAsync((char*)d_ws + WS_MODI, 0, MODI_BYTES, stream);
    Args a{};
    for (int i = 0; i < 18; ++i) a.in[i] = (const float*)d_in[i];
    a.out = (float*)d_out; a.ws = (unsigned char*)d_ws; a.ph_lo = 0; a.ph_hi = 100;
    void* args[] = {&a};
    hipError_t e = hipLaunchCooperativeKernel((const void*)fwd_megakernel, dim3(grid), dim3(NTHREADS), args, LDS_BYTES, stream);
    if (e != hipSuccess) fprintf(stderr, "kernel_launch: cooperative launch failed: %s (grid %d)\n", hipGetErrorString(e), grid);
}
```

```cpp
#include <hip/hip_runtime.h>
#include <hip/hip_cooperative_groups.h>
#include <cstdio>
#include <cstdint>
#include <type_traits>
namespace cg = cooperative_groups;

#define LAS __attribute__((address_space(3)))
#define DI __device__ __forceinline__
typedef unsigned short bf16_t;
typedef short bf16x8 __attribute__((ext_vector_type(8)));
typedef short s16x4 __attribute__((ext_vector_type(4)));
typedef float f32x2 __attribute__((ext_vector_type(2)));
typedef float f32x4 __attribute__((ext_vector_type(4)));
typedef float f32x16 __attribute__((ext_vector_type(16)));
typedef unsigned u32x2 __attribute__((ext_vector_type(2)));
typedef unsigned u32x4 __attribute__((ext_vector_type(4)));
typedef __bf16 bf16v2 __attribute__((ext_vector_type(2)));

constexpr int DM = 2048, NB = 16, TL = 2048, TC = 256, TB = TL + TC, NTOK = NB * TB;
constexpr int NWAVES = 8, NTHREADS = 512;
constexpr float EPS = 1e-6f;
constexpr int MOD_LD = 3 * DM;
constexpr int M_WA_ROWS = 6400, M_WB_ROWS = 3072;
constexpr size_t MiB = 1u << 20;
constexpr size_t WS_SCR_ = 301 * MiB;
constexpr size_t WS_MOD = 0;
constexpr size_t MOD_BYTES = (size_t)4 * 17 * MOD_LD * 4;
constexpr size_t WS_BAR = 1792 * 1024, ZERO_BYTES = 2 * MiB;
constexpr size_t WS_MODI = WS_SCR_ + 700 * MiB, MODI_BYTES = (size_t)4 * 17 * MOD_LD * 8;
constexpr float MODI_SCALE = 1073741824.f, MODI_INV = 9.313225746154785e-10f;
constexpr size_t WS_WFG = 2 * MiB, WS_WFO = 18 * MiB, WS_WMA = 34 * MiB, WS_WMB = 59 * MiB, WS_WMO = 71 * MiB, WS_WAI = 79 * MiB, WS_WAO = 99 * MiB;
constexpr size_t WS_DC = 107 * MiB, WS_DT = 108 * MiB, WS_DT2 = 124 * MiB, WS_CTXS = 125 * MiB, WS_H = 157 * MiB, WS_SCR = 301 * MiB;
constexpr size_t WS_END = 1024 * MiB;
constexpr size_t F_G = 0, F_PQX = 144 * MiB, F_PQC = 400 * MiB, F_A1 = 432 * MiB;
constexpr size_t M_Q = 0, M_K = 72 * MiB, M_KVT = 144 * MiB, M_G32 = 360 * MiB, M_HF = 365 * MiB, M_HB = 509 * MiB, M_SO = 0, M_SZ = 144 * MiB;
constexpr size_t A_Q = 0, A_K = 144 * MiB, A_V = 180 * MiB, A_SZ = 216 * MiB;
static_assert(WS_SCR + M_HB + 144 * MiB <= WS_END, "ws map");
constexpr int LDS_BYTES = 152576 + 1024;

DI unsigned pk2(float a, float b) { f32x2 v = {a, b}; return __builtin_bit_cast(unsigned, __builtin_convertvector(v, bf16v2)); }
DI float bf_lo(unsigned w) { return __uint_as_float(w << 16); }
DI float bf_hi(unsigned w) { return __uint_as_float(w & 0xffff0000u); }
DI float wave_sum(float v) {
#pragma unroll
    for (int o = 1; o < 64; o <<= 1) v += __shfl_xor(v, o);
    return v;
}
DI int otid(int wv) { int t; asm volatile("v_mbcnt_lo_u32_b32 %0, -1, 0\n\tv_mbcnt_hi_u32_b32 %0, -1, %0" : "=v"(t)); return wv * 64 + t; }
DI float dot2g(unsigned a, unsigned b, float c) { asm("v_dot2c_f32_bf16 %0, %1, %2" : "+v"(c) : "v"(a), "v"(b)); return c; }
DI float siluf(float x) { return x * __builtin_amdgcn_rcpf(1.f + __expf(-x)); }
DI float sigmf(float x) { return __builtin_amdgcn_rcpf(1.f + __expf(-x)); }
DI void st_bf16x8(bf16_t* p, f32x4 a, f32x4 b) { u32x4 w = {pk2(a[0], a[1]), pk2(a[2], a[3]), pk2(b[0], b[1]), pk2(b[2], b[3])}; *(u32x4*)p = w; }
DI void ld_bf16x8(const bf16_t* p, f32x4& a, f32x4& b) { const u32x4 w = *(const u32x4*)p; a = (f32x4){bf_lo(w.x), bf_hi(w.x), bf_lo(w.y), bf_hi(w.y)}; b = (f32x4){bf_lo(w.z), bf_hi(w.z), bf_lo(w.w), bf_hi(w.w)}; }

DI f32x4 ldmod4(const long long* p) { return (f32x4){(float)p[0] * MODI_INV, (float)p[1] * MODI_INV, (float)p[2] * MODI_INV, (float)p[3] * MODI_INV}; }

struct Args { const float* in[18]; float* out; unsigned char* ws; int ph_lo, ph_hi; };

#define XB_TMO      128
#define XB_XCNT(j)  (256  + 64 * (j))
#define XB_XSUB(j)  (1280 + 64 * (j))
#define XB_XGEN(j)  (2304 + 64 * (j))
#define XB_TOP      3328
#define XB_TOPGEN   3392
#define XCD_BAR_WORDS 3456
#define XB_SPIN_CAP (1u << 18)

__device__ __forceinline__ unsigned xb_ld(unsigned* p)              { return __hip_atomic_load(p, __ATOMIC_RELAXED, __HIP_MEMORY_SCOPE_AGENT); }
__device__ __forceinline__ unsigned xb_add(unsigned* p, unsigned v) { return __hip_atomic_fetch_add(p, v, __ATOMIC_RELAXED, __HIP_MEMORY_SCOPE_AGENT); }
__device__ __forceinline__ unsigned xb_xcc_id() { return (unsigned)__builtin_amdgcn_s_getreg((3 << 11) | 20) & 0xFu; }
#define XB_SPIN(cond, bar) do { unsigned _sp = 0; while (cond) { __builtin_amdgcn_s_sleep(1); \
    if ((++_sp & 255u) == 0u) { if (xb_ld(&(bar)[XB_TMO])) break; if (_sp > XB_SPIN_CAP) { atomicAdd(&(bar)[XB_TMO], 1u); break; } } } } while (0)

struct XcdBarrier {
    unsigned* bar; unsigned x;
    volatile LAS unsigned* st;
};

__device__ __forceinline__ XcdBarrier xcd_barrier_post(unsigned* bar, volatile LAS unsigned* st, int wv) {
    XcdBarrier b; b.bar = bar; b.x = xb_xcc_id(); b.st = st;
    if (otid(wv) == 0) (void)xb_add(&bar[XB_XCNT(b.x)], 1u);
    return b;
}
__device__ __forceinline__ void xcd_barrier_complete(unsigned* bar, unsigned x, unsigned& nloc, unsigned& nx) {
    const unsigned G = gridDim.x * gridDim.y * gridDim.z;
    unsigned sum, cnt, mine, sp = 0u;
    for (;;) {
        sum = 0u; cnt = 0u; mine = 0u;
#pragma unroll
        for (unsigned j = 0; j < 16; ++j) { const unsigned c = xb_ld(&bar[XB_XCNT(j)]); sum += c; cnt += (c > 0u) ? 1u : 0u; mine = (j == x) ? c : mine; }
        if (sum == G) break;
        __builtin_amdgcn_s_sleep(1);
        if ((++sp & 255u) == 0u) { if (xb_ld(&bar[XB_TMO])) break; if (sp > XB_SPIN_CAP) { atomicAdd(&bar[XB_TMO], 1u); break; } }
    }
    nloc = mine > 0u ? mine : 1u; nx = cnt > 0u ? cnt : 1u;
}

__device__ __forceinline__ void xcd_barrier(const XcdBarrier& b, int wv) {
    asm volatile("s_waitcnt vmcnt(0)" ::: "memory");
    __syncthreads();
    if (otid(wv) == 0) {
        unsigned* bar = b.bar;
        __builtin_amdgcn_s_waitcnt(0);
        unsigned nloc = b.st[0], nx = b.st[1];
        if (nloc == 0u) { xcd_barrier_complete(bar, b.x, nloc, nx); b.st[0] = nloc; b.st[1] = nx; }
        const unsigned old = xb_add(&bar[XB_XSUB(b.x)], 1u);
        const unsigned gen = old / nloc;
        if (old + 1u == (gen + 1u) * nloc) {
            __builtin_amdgcn_fence(__ATOMIC_RELEASE, "agent");
            asm volatile("s_waitcnt vmcnt(0)" ::: "memory");
            const unsigned og = xb_add(&bar[XB_TOP], 1u);
            const unsigned tg = og / nx;
            if (og + 1u == (tg + 1u) * nx) xb_add(&bar[XB_TOPGEN], 1u);
            else XB_SPIN(xb_ld(&bar[XB_TOPGEN]) == tg, bar);
            __builtin_amdgcn_fence(__ATOMIC_ACQUIRE, "agent");
            xb_add(&bar[XB_XGEN(b.x)], 1u);
            asm volatile("s_waitcnt vmcnt(0)" ::: "memory");
        } else {
            XB_SPIN(xb_ld(&bar[XB_XGEN(b.x)]) == gen, bar);
            __builtin_amdgcn_fence(__ATOMIC_ACQUIRE, "agent");
            asm volatile("s_waitcnt vmcnt(0)" ::: "memory");
        }
    }
    __syncthreads();
}


namespace pg8 {
constexpr int BM = 256, BK = 64, HALF = 128, HTB = HALF * BK * 2, NXCD = 8;
DI int lds_byte(int r, int c) { const int st = (r >> 4) * 2 + (c >> 5), rr = r & 15, cc = c & 31, ob = rr * 64 + cc * 2; return st * 1024 + (ob ^ (((ob >> 9) & 1) << 5)); }
DI void stage_rc(int b, int& R, int& C) { const int st = b / 1024, sb = b % 1024, swz = sb ^ (((sb >> 9) & 1) << 5); R = (st >> 1) * 16 + swz / 64; C = (st & 1) * 32 + (swz % 64) / 2; }
DI int perm32(int rho) { const int n = rho >> 4, i = rho & 15; return 8 * (i >> 2) + 4 * n + (i & 3); }
struct Unit { const char* a; const char* b; int i0, i1, i2; };
template <class T, class = void> struct is_whole_tile : std::false_type {};
template <class T> struct is_whole_tile<T, std::void_t<decltype(T::WHOLE_TILE)>> : std::true_type {};
DI int xcd_remap(int L, int total) { const int q = total / NXCD, r = total % NXCD, xcd = L % NXCD, off = L / NXCD; return (xcd < r ? xcd * (q + 1) : r * (q + 1) + (xcd - r) * q) + off; }

template <class Desc, class Epi>
DI void gemm_phase(LAS unsigned char* lds, const Desc& D, const Epi& E, int wv) {
    const int tid = otid(wv), wid = __builtin_amdgcn_readfirstlane(tid >> 6), lane = tid & 63, wr = wid >> 2, wc = wid & 3, fr = lane & 15, fq = lane >> 4;
    const int G = gridDim.x, c = blockIdx.x, total = D.total;
    const int K = D.K, nt = K / BK;
    unsigned voffA[2], voffB[2];
#pragma unroll
    for (int i = 0; i < 2; ++i) { int R, C; stage_rc(tid * 16 + i * 8192, R, C); const int Rb = (R & ~31) + perm32(R & 31);
        voffA[i] = (unsigned)(R * D.lda + C) * 2u; voffB[i] = (unsigned)(Rb * D.ldb + C) * 2u; }
    const size_t kstep = (size_t)(BK * 2);
    const size_t hstepA = (size_t)HALF * D.lda * 2, hstepB = (size_t)HALF * D.ldb * 2;
    const unsigned ldsw = (unsigned)wid * 1024u;
    const int aoff = lds_byte(wr * 64 + fr, fq * 8), boff = lds_byte(wc * 32 + fr, fq * 8);
#define PG8_SA(b, h) (((b) * 2 + (h)) * HTB)
#define PG8_SB(b, h) ((4 + (b) * 2 + (h)) * HTB)
#define PG8_STAGE(bufoff, gbase, voff) do { _Pragma("unroll") for (int _i = 0; _i < 2; ++_i) \
        __builtin_amdgcn_global_load_lds((const unsigned*)((const char*)(gbase) + (voff)[_i]), (LAS unsigned*)(lds + (bufoff) + ldsw + _i * 8192), 16, 0, 0); } while (0)
#define PG8_LDA(dst, b, h) do { _Pragma("unroll") for (int m = 0; m < 4; ++m) _Pragma("unroll") for (int k = 0; k < 2; ++k) dst[m][k] = *(const LAS bf16x8*)(lds + PG8_SA(b, h) + aoff + m * 2048 + k * 1024); } while (0)
#define PG8_LDB(dst, b, h) do { _Pragma("unroll") for (int n = 0; n < 2; ++n) _Pragma("unroll") for (int k = 0; k < 2; ++k) dst[n][k] = *(const LAS bf16x8*)(lds + PG8_SB(b, h) + boff + n * 2048 + k * 1024); } while (0)
#define PG8_MMA(ai, bj, At, Bt) do { __builtin_amdgcn_s_setprio(1); _Pragma("unroll") for (int m = 0; m < 4; ++m) _Pragma("unroll") for (int n = 0; n < 2; ++n) _Pragma("unroll") for (int k = 0; k < 2; ++k) \
        acc[ai][bj][m][n] = __builtin_amdgcn_mfma_f32_16x16x32_bf16(Bt[n][k], At[m][k], acc[ai][bj][m][n], 0, 0, 0); __builtin_amdgcn_s_setprio(0); } while (0)
#define PG8_WAIT_V(n) asm volatile("s_waitcnt vmcnt(" #n ")" ::: "memory")
#define PG8_WAIT_L(n) asm volatile("s_waitcnt lgkmcnt(" #n ")" ::: "memory")
#define PG8_BAR __builtin_amdgcn_s_barrier()
#define PG8_SCHED __builtin_amdgcn_sched_barrier(0)
    if constexpr (Desc::RAW) { if (!D.valid(c, G)) return; } else { if (c >= total) return; }
    Unit cur, nxt; int ui = 0;
    if constexpr (Desc::RAW) cur = D.unit(c, G); else cur = D.unit(xcd_remap(c, total));
    nxt = cur;
    f32x4 acc[2][2][4][2];
#pragma unroll
    for (int a = 0; a < 2; ++a)
#pragma unroll
        for (int b = 0; b < 2; ++b)
#pragma unroll
            for (int m = 0; m < 4; ++m)
#pragma unroll
                for (int n = 0; n < 2; ++n) acc[a][b][m][n] = (f32x4){0.f, 0.f, 0.f, 0.f};
    bf16x8 At[4][2], B0[2][2], B1[2][2];
    const char* cA = cur.a; const char* cB = cur.b;
    PG8_STAGE(PG8_SB(0, 0), cB, voffB); PG8_STAGE(PG8_SB(0, 1), cB + hstepB, voffB); PG8_STAGE(PG8_SA(0, 0), cA, voffA); PG8_STAGE(PG8_SA(0, 1), cA + hstepA, voffA);
    if (wr == 1) PG8_BAR;
    PG8_WAIT_V(2); PG8_BAR;
    PG8_STAGE(PG8_SB(1, 0), cB + kstep, voffB); PG8_STAGE(PG8_SA(1, 0), cA + kstep, voffA); PG8_STAGE(PG8_SB(1, 1), cB + hstepB + kstep, voffB);
    PG8_WAIT_V(6); PG8_BAR;
    for (;;) {
        const long Ln = (long)(ui + 1) * G + c;
        bool has_next;
        if constexpr (Desc::RAW) { has_next = D.valid((int)Ln, G); if (has_next) nxt = D.unit((int)Ln, G); }
        else { has_next = Ln < total; if (has_next) nxt = D.unit(xcd_remap((int)Ln, total)); }
        const char* nA = has_next ? nxt.a : cA; const char* nB = has_next ? nxt.b : cB;
        for (int t = 0; t < nt; t += 2) {
            const bool last = (t == nt - 2);
            const char* a1 = cA + (size_t)(t + 1) * kstep;
            const char* a2 = last ? nA : cA + (size_t)(t + 2) * kstep; const char* b2 = last ? nB : cB + (size_t)(t + 2) * kstep;
            const char* a3 = a2 + kstep; const char* b3 = b2 + kstep;
            PG8_LDB(B0, 0, 0); PG8_LDB(B1, 0, 1); PG8_SCHED; PG8_LDA(At, 0, 0); PG8_STAGE(PG8_SA(1, 1), a1 + hstepA, voffA);
            PG8_WAIT_V(8); PG8_WAIT_L(0); PG8_BAR; PG8_MMA(0, 0, At, B0); PG8_MMA(0, 1, At, B1); PG8_BAR; PG8_SCHED;
            PG8_LDA(At, 0, 1); PG8_STAGE(PG8_SB(0, 0), b2, voffB); PG8_STAGE(PG8_SB(0, 1), b2 + hstepB, voffB); PG8_STAGE(PG8_SA(0, 0), a2, voffA);
            PG8_WAIT_V(8); PG8_WAIT_L(0); PG8_BAR; PG8_MMA(1, 0, At, B0); PG8_MMA(1, 1, At, B1); PG8_BAR; PG8_SCHED;
            PG8_LDB(B0, 1, 0); PG8_LDB(B1, 1, 1); PG8_SCHED; PG8_LDA(At, 1, 0); PG8_STAGE(PG8_SA(0, 1), a2 + hstepA, voffA);
            PG8_WAIT_V(8); PG8_WAIT_L(0); PG8_BAR; PG8_MMA(0, 0, At, B0); PG8_MMA(0, 1, At, B1); PG8_BAR; PG8_SCHED;
            PG8_LDA(At, 1, 1); PG8_STAGE(PG8_SB(1, 0), b3, voffB); PG8_STAGE(PG8_SB(1, 1), b3 + hstepB, voffB); PG8_STAGE(PG8_SA(1, 0), a3, voffA);
            PG8_WAIT_V(8); PG8_WAIT_L(0); PG8_BAR; PG8_MMA(1, 0, At, B0); PG8_MMA(1, 1, At, B1); PG8_BAR; PG8_SCHED;
        }
        if (wr == 0) PG8_BAR;
        {
            const int le = otid(wv) & 63, fre = le & 15, fqe = le >> 4;
            if constexpr (is_whole_tile<Epi>::value) E.run(cur, acc, wr, wc, fre, fqe); else
#pragma unroll
            for (int ai = 0; ai < 2; ++ai)
#pragma unroll
                for (int m = 0; m < 4; ++m)
#pragma unroll
                    for (int bj = 0; bj < 2; ++bj)
                        E(cur, ai * HALF + wr * 64 + m * 16 + fre, bj * HALF + wc * 32 + 8 * fqe, acc[ai][bj][m][0], acc[ai][bj][m][1]);
        }
        if (!has_next) break;
#pragma unroll
        for (int a = 0; a < 2; ++a)
#pragma unroll
            for (int b = 0; b < 2; ++b)
#pragma unroll
                for (int m = 0; m < 4; ++m)
#pragma unroll
                    for (int n = 0; n < 2; ++n) acc[a][b][m][n] = (f32x4){0.f, 0.f, 0.f, 0.f};
        cur = nxt; cA = nA; cB = nB; ++ui;
        if (wr == 1) PG8_BAR;
    }
    PG8_WAIT_V(0);
    PG8_BAR;
#undef PG8_SA
#undef PG8_SB
#undef PG8_STAGE
#undef PG8_LDA
#undef PG8_LDB
#undef PG8_MMA
#undef PG8_WAIT_V
#undef PG8_WAIT_L
#undef PG8_BAR
#undef PG8_SCHED
}
}

DI void transpose_item(const float* W, int N, int kb, int nb, bf16_t* d0, bf16_t* d1, int K, LAS float* scr, int lane) {
    const int k0 = 64 * kb, n0 = 32 * nb;
#pragma unroll 8
    for (int i = 0; i < 32; ++i) { const int kk = 2 * i + (lane >> 5); scr[kk * 33 + (lane & 31)] = W[(size_t)(k0 + kk) * N + n0 + (lane & 31)]; }
    asm volatile("s_waitcnt lgkmcnt(0)" ::: "memory");
    const int c = lane & 7;
#pragma unroll
    for (int j = 0; j < 4; ++j) { const int n = (lane >> 3) + 8 * j; const LAS float* s = scr + (8 * c) * 33 + n;
        u32x4 o; o.x = pk2(s[0 * 33], s[1 * 33]); o.y = pk2(s[2 * 33], s[3 * 33]); o.z = pk2(s[4 * 33], s[5 * 33]); o.w = pk2(s[6 * 33], s[7 * 33]);
        *(u32x4*)(d0 + (size_t)n * K + k0 + 8 * c) = o;
        if (d1) *(u32x4*)(d1 + (size_t)n * K + k0 + 8 * c) = o; }
    asm volatile("s_waitcnt lgkmcnt(0)" ::: "memory");
}

DI void prep_phase(const Args& A, LAS unsigned char* lds, int wv) {
    const int tid = otid(wv), lane = tid & 63, wave = tid >> 6, G = gridDim.x;
    unsigned char* ws = A.ws;
    {
        LAS float* s_lds = (LAS float*)lds;
        const float* cc = A.in[1]; const float* cctx = A.in[3]; const float* aw = A.in[4]; const float* ab = A.in[5];
        long long* modi = (long long*)(ws + WS_MODI);
        for (int item = blockIdx.x; item < 768; item += G) {
            const int kc = item % 16, cb = (item / 16) % 12, l = item / 192;
            const int k0 = kc * 128, j = cb * 512 + tid;
            __syncthreads();
            for (int e = tid; e < 17 * 128; e += NTHREADS) { const int r = e / 128, k = e % 128; const float v = r < 16 ? cc[r * DM + k0 + k] : cctx[k0 + k]; s_lds[k * 20 + r] = siluf(v); }
            __syncthreads();
            float acc[17];
#pragma unroll
            for (int r = 0; r < 17; ++r) acc[r] = 0.f;
            const float* wp = aw + ((size_t)l * DM + k0) * MOD_LD + j;
#pragma unroll 4
            for (int k = 0; k < 128; ++k) {
                const float w = wp[(size_t)k * MOD_LD];
                const LAS f32x4* sp = (const LAS f32x4*)(s_lds + k * 20);
                const f32x4 s0 = sp[0], s1 = sp[1], s2 = sp[2], s3 = sp[3]; const float s4 = s_lds[k * 20 + 16];
#pragma unroll
                for (int q = 0; q < 4; ++q) { acc[q] += s0[q] * w; acc[4 + q] += s1[q] * w; acc[8 + q] += s2[q] * w; acc[12 + q] += s3[q] * w; }
                acc[16] += s4 * w;
            }
            const float bias = (kc == 0) ? ab[l * MOD_LD + j] : 0.f;
#pragma unroll
            for (int r = 0; r < 17; ++r) atomicAdd((unsigned long long*)&modi[(size_t)(l * 17 + r) * MOD_LD + j], (unsigned long long)__float2ll_rn((acc[r] + bias) * MODI_SCALE));
        }
        __syncthreads();
    }
    {
        LAS float* scr = (LAS float*)(lds + wave * 16384);
        const int gw = blockIdx.x * NWAVES + wave, NGW = G * NWAVES;
        constexpr int I_SQ = 32 * 64, I_AI = 32 * 160, I_MI = 32 * 257;
        constexpr int NIT = 6 * I_SQ + I_AI + I_MI;
        for (int it = gw; it < NIT; it += NGW) {
            int r = it;
            if (r < 6 * I_SQ) {
                const int w = r / I_SQ; r -= w * I_SQ;
                const float* src; bf16_t* dst;
                if (w < 2)      { src = A.in[7] + (size_t)w * DM * DM;       dst = (bf16_t*)(ws + WS_WFG) + (size_t)w * DM * DM; }
                else if (w < 4) { src = A.in[8] + (size_t)(w - 2) * DM * DM; dst = (bf16_t*)(ws + WS_WFO) + (size_t)(w - 2) * DM * DM; }
                else if (w == 4) { src = A.in[12]; dst = (bf16_t*)(ws + WS_WMO); }
                else             { src = A.in[16]; dst = (bf16_t*)(ws + WS_WAO); }
                const int kb = r / 64, nb = r % 64;
                transpose_item(src, DM, kb, nb, dst + (size_t)(32 * nb) * DM, nullptr, DM, scr, lane);
                continue;
            }
            r -= 6 * I_SQ;
            if (r < I_AI) { const int kb = r / 160, nb = r % 160; transpose_item(A.in[13], 5120, kb, nb, (bf16_t*)(ws + WS_WAI) + (size_t)(32 * nb) * DM, nullptr, DM, scr, lane); continue; }
            r -= I_AI;
            {
                const int kb = r / 257, nb = r % 257, n0 = 32 * nb;
                bf16_t* WA = (bf16_t*)(ws + WS_WMA); bf16_t* WB = (bf16_t*)(ws + WS_WMB);
                bf16_t* d0; bf16_t* d1 = nullptr;
                if (n0 < 1024) d0 = WA + (size_t)n0 * DM;
                else if (n0 < 2048) d0 = WA + (size_t)n0 * DM;
                else if (n0 < 4096) d0 = WB + (size_t)(n0 - 2048) * DM;
                else if (n0 < 6144) d0 = WA + (size_t)(2304 + n0 - 4096) * DM;
                else if (n0 < 6176) d0 = WA + (size_t)(2048 + n0 - 6144) * DM;
                else d0 = WA + (size_t)(4352 + n0 - 6176) * DM;
                transpose_item(A.in[9], 8224, kb, nb, d0, d1, DM, scr, lane);
            }
        }
    }
    {
        const long gt = (long)blockIdx.x * NTHREADS + tid, NGT = (long)G * NTHREADS;
        constexpr long N_DC = 512L * 512 / 8, N_DT = 2048L * 4096 / 8, N_DT2 = 256L * 512 / 8;
        for (long it = gt; it < N_DC + N_DT + N_DT2; it += NGT) {
            float v[8]; bf16_t* dst;
            if (it < N_DC) {
                const int m = (int)(it / 64), k0 = (int)(it % 64) * 8; const float sc = 0.044194173824159216f;
#pragma unroll
                for (int j = 0; j < 8; ++j) { const int mm = (m <= 256) ? m : m - 256; const int rr = (mm * (k0 + j)) & 511; const float ang = (float)rr * (1.f / 256.f); v[j] = (m <= 256 ? cospif(ang) : sinpif(ang)) * sc; }
                dst = (bf16_t*)(ws + WS_DC) + (size_t)m * 512 + k0;
            } else if (it < N_DC + N_DT) {
                const long i2 = it - N_DC; const int kk = (int)(i2 / 512), s0 = (int)(i2 % 512) * 8; const float sc = 0.022097086912079608f;
#pragma unroll
                for (int j = 0; j < 8; ++j) { const int s = s0 + j; const int rr = (kk * (s & 2047)) & 2047; const float ang = (float)rr * (1.f / 1024.f); v[j] = (s < 2048 ? cospif(ang) : -sinpif(ang)) * sc; }
                dst = (bf16_t*)(ws + WS_DT) + (size_t)kk * 4096 + s0;
            } else {
                const long i2 = it - N_DC - N_DT; const int kk = (int)(i2 / 64), s0 = (int)(i2 % 64) * 8; const float sc = 0.0625f;
#pragma unroll
                for (int j = 0; j < 8; ++j) { const int s = s0 + j; const int rr = (kk * (s & 255)) & 255; const float ang = (float)rr * (1.f / 128.f); v[j] = (s < 256 ? cospif(ang) : -sinpif(ang)) * sc; }
                dst = (bf16_t*)(ws + WS_DT2) + (size_t)kk * 512 + s0;
            }
            u32x4 o = {pk2(v[0], v[1]), pk2(v[2], v[3]), pk2(v[4], v[5]), pk2(v[6], v[7])};
            *(u32x4*)dst = o;
        }
    }
}

DI const float* xrow_in(const Args& A, int r) {
    const int b = r / TB, t = r % TB;
    if (t < TL) return A.in[0] + ((size_t)b * TL + t) * DM;
    return A.in[2] + ((size_t)b * TC + (t - TL)) * DM;
}
DI void norm_phase(const Args& A, int layer, bool latonly, int wv) {
    const int tid = otid(wv), lane = tid & 63, wave = tid >> 6, G = gridDim.x;
    const float* ng = A.in[6] + (size_t)layer * DM;
    const float* mod = (const float*)(A.ws + WS_MOD) + (size_t)layer * 17 * MOD_LD;
    bf16_t* H = (bf16_t*)(A.ws + WS_H);
    const bf16_t* XB = (const bf16_t*)A.out;
    for (int r0 = (blockIdx.x * NWAVES + wave) * 2; r0 < NTOK; r0 += G * NWAVES * 2) {
        const int b = r0 / TB, t = r0 % TB;
        if (latonly && t >= TL) continue;
        const float* mr = mod + (size_t)(t < TL ? b : 16) * MOD_LD;
        f32x4 v[2][4][2];
#pragma unroll
        for (int k = 0; k < 2; ++k) {
            const int r = r0 + k;
            if (layer == 0) {
                const float* xr = xrow_in(A, r);
#pragma unroll
                for (int j = 0; j < 4; ++j) { const f32x4* p = (const f32x4*)(xr + 512 * j + 8 * lane); v[k][j][0] = p[0]; v[k][j][1] = p[1]; }
            } else {
#pragma unroll
                for (int j = 0; j < 4; ++j) ld_bf16x8(XB + (size_t)r * DM + 512 * j + 8 * lane, v[k][j][0], v[k][j][1]);
            }
        }
#pragma unroll
        for (int k = 0; k < 2; ++k) {
            const int r = r0 + k; float ss = 0.f;
#pragma unroll
            for (int j = 0; j < 4; ++j)
#pragma unroll
                for (int q = 0; q < 4; ++q) ss += v[k][j][0][q] * v[k][j][0][q] + v[k][j][1][q] * v[k][j][1][q];
            const float rs = 1.0f / sqrtf(wave_sum(ss) * (1.f / DM) + EPS);
#pragma unroll
            for (int j = 0; j < 4; ++j) { const int c0 = 512 * j + 8 * lane; f32x4 o[2];
#pragma unroll
                for (int h = 0; h < 2; ++h) { const f32x4 g4 = *(const f32x4*)(ng + c0 + 4 * h), sh = *(const f32x4*)(mr + c0 + 4 * h), sc = *(const f32x4*)(mr + DM + c0 + 4 * h);
                    o[h] = (v[k][j][h] * rs) * g4 * (sc + 1.0f) + sh; }
                st_bf16x8(H + (size_t)r * DM + c0, o[0], o[1]); }
        }
    }
}
DI void final_norm_phase(const Args& A, const bf16_t* src, int wv) {
    const int tid = otid(wv), lane = tid & 63, wave = tid >> 6, G = gridDim.x;
    const float* fg = A.in[17];
    for (int r0 = (blockIdx.x * NWAVES + wave) * 2; r0 < NB * TL; r0 += G * NWAVES * 2) {
        f32x4 v[2][4][2];
#pragma unroll
        for (int k = 0; k < 2; ++k)
#pragma unroll
            for (int j = 0; j < 4; ++j) ld_bf16x8(src + (size_t)(r0 + k) * DM + 512 * j + 8 * lane, v[k][j][0], v[k][j][1]);
#pragma unroll
        for (int k = 0; k < 2; ++k) { float* orow = A.out + (size_t)(r0 + k) * DM; float ss = 0.f;
#pragma unroll
            for (int j = 0; j < 4; ++j)
#pragma unroll
                for (int q = 0; q < 4; ++q) ss += v[k][j][0][q] * v[k][j][0][q] + v[k][j][1][q] * v[k][j][1][q];
            const float rs = 1.0f / sqrtf(wave_sum(ss) * (1.f / DM) + EPS);
#pragma unroll
            for (int j = 0; j < 4; ++j) { const int c0 = 512 * j + 8 * lane;
#pragma unroll
                for (int h = 0; h < 2; ++h) { const f32x4 g4 = *(const f32x4*)(fg + c0 + 4 * h); *(f32x4*)(orow + c0 + 4 * h) = (v[k][j][h] * rs) * g4; } }
        }
    }
}

struct DescPlain {
    static constexpr bool RAW = false;
    const bf16_t* A; const bf16_t* B; int nN; bool latonly; int lda, ldb, K, total;
    DI void init(const bf16_t* A_, const bf16_t* B_, int nN_, bool lat) { A = A_; B = B_; nN = nN_; latonly = lat; lda = DM; ldb = DM; K = DM; total = (lat ? 128 : 144) * nN_; }
    DI pg8::Unit unit(int idx) const {
        const int nMt = latonly ? 128 : 144, nig = 8 * nN, gid = idx / nig, fm = gid * 8, gsz = (nMt - fm) < 8 ? (nMt - fm) : 8;
        const int pmi = fm + (idx % nig) % gsz, pn = (idx % nig) / gsz, pm = latonly ? (pmi / 8) * 9 + (pmi % 8) : pmi;
        pg8::Unit u; u.a = (const char*)(A + (size_t)pm * 256 * DM); u.b = (const char*)(B + (size_t)pn * 256 * DM); u.i0 = pm; u.i1 = pn; u.i2 = 0; return u;
    }
};
struct DescA1 {
    static constexpr bool RAW = false;
    const bf16_t* A; const bf16_t* B; int lda, ldb, K, total;
    DI void init(const bf16_t* A_, const bf16_t* B_) { A = A_; B = B_; lda = DM; ldb = DM; K = DM; total = 128 * 20 + 16 * 4; }
    DI pg8::Unit unit(int idx) const {
        int pm, pn;
        if (idx < 2560) { const int nig = 160, gid = idx / nig, pmi = gid * 8 + (idx % nig) % 8; pn = (idx % nig) / 8; pm = (pmi / 8) * 9 + (pmi % 8); }
        else { const int j = idx - 2560; pm = (j / 4) * 9 + 8; pn = 8 + (j % 4); }
        pg8::Unit u; u.a = (const char*)(A + (size_t)pm * 256 * DM); u.b = (const char*)(B + (size_t)pn * 256 * DM); u.i0 = pm; u.i1 = pn; u.i2 = 0; return u;
    }
};
struct DescChan {
    static constexpr bool RAW = false;
    const bf16_t* DC; const bf16_t* H; int lda, ldb, K, total;
    DI void init(const bf16_t* DC_, const bf16_t* H_, bool lat) { DC = DC_; H = H_; lda = 512; ldb = DM; K = 512; total = lat ? 1024 : 1152; }
    DI pg8::Unit unit(int idx) const {
        pg8::Unit u; int b, g, mt, nt, toff;
        if (idx < 1024) { mt = idx % 2; nt = (idx / 2) % 8; g = (idx / 16) % 4; b = idx / 64; toff = nt * 256; u.i2 = nt; }
        else { const int j = idx - 1024; mt = j % 2; g = (j / 2) % 4; b = j / 8; toff = TL; u.i2 = 8; }
        u.a = (const char*)(DC + (size_t)mt * 256 * 512); u.b = (const char*)(H + ((size_t)b * TB + toff) * DM + g * 512); u.i0 = b * 4 + g; u.i1 = mt; return u;
    }
};
struct DescT {
    static constexpr bool RAW = false;
    const bf16_t* DT; const bf16_t* PQ; int nMt; int lda, ldb, K, total;
    DI void init(const bf16_t* DT_, const bf16_t* PQ_, int ld, int Kd, int coff, int nMt_) { DT = DT_ + coff; PQ = PQ_ + coff; nMt = nMt_; lda = ld; ldb = ld; K = Kd; total = NB * nMt_ * 8; }
    DI pg8::Unit unit(int idx) const {
        const int mt = idx % nMt, nt = (idx / nMt) % 8, b = idx / (nMt * 8);
        pg8::Unit u; u.a = (const char*)(DT + (size_t)mt * 256 * lda); u.b = (const char*)(PQ + ((size_t)b * DM + nt * 256) * ldb); u.i0 = b; u.i1 = mt; u.i2 = nt; return u;
    }
};

struct DescT2 {
    static constexpr bool RAW = true;
    const bf16_t* DT; const bf16_t* PQ; int lda, ldb, K, total;
    DI void init(const bf16_t* DT_, const bf16_t* PQ_) { DT = DT_; PQ = PQ_; lda = 4096; ldb = 4096; K = 2048; total = 2 * NB * 4 * 4; }
    DI bool valid(int L, int G) const { return ((L / G) >> 1) * G + (L % G) < NB * 4 * 4; }
    DI pg8::Unit unit(int L, int G) const {
        const int i = L / G, pair = (i >> 1) * G + (L % G), part = i & 1;
        const int mt = pair % 4, nt = 2 * ((pair / 4) % 4), b = pair / 16, coff = part * 2048;
        pg8::Unit u; u.a = (const char*)(DT + (size_t)mt * 256 * 4096 + coff); u.b = (const char*)(PQ + ((size_t)b * DM + nt * 256) * 4096 + coff); u.i0 = b; u.i1 = mt; u.i2 = part * 8 + nt; return u;
    }
};

struct EpiResid {
    static constexpr bool WHOLE_TILE = true;
    const float* x_in; const float* c_in; bf16_t* XB; bf16_t* X2; const float* modl; int layer;
    DI void init(const Args& A, int layer_) { x_in = A.in[0]; c_in = A.in[2]; XB = (bf16_t*)A.out; X2 = (bf16_t*)(A.ws + WS_SCR + F_PQX); modl = (const float*)(A.ws + WS_MOD) + (size_t)layer_ * 17 * MOD_LD; layer = layer_; }
    DI void run(const pg8::Unit& u, const f32x4 (&acc)[2][2][4][2], int wr, int wc, int fr, int fq) const {
        const int pm = u.i0, b = pm / 9, tt = pm % 9, col0 = u.i1 * 256 + wc * 32 + 8 * fq;
        f32x4 g[2][2];
#pragma unroll
        for (int bj = 0; bj < 2; ++bj) { const float* gp = modl + (size_t)(tt < 8 ? b : 16) * MOD_LD + 2 * DM + col0 + bj * 128; g[bj][0] = *(const f32x4*)gp; g[bj][1] = *(const f32x4*)(gp + 4); }
        if (layer != 0) {
            u32x4 xq[2][4][2];
#pragma unroll
            for (int ai = 0; ai < 2; ++ai)
#pragma unroll
                for (int m = 0; m < 4; ++m)
#pragma unroll
                    for (int bj = 0; bj < 2; ++bj) xq[ai][m][bj] = *(const u32x4*)(XB + ((size_t)pm * 256 + ai * 128 + wr * 64 + m * 16 + fr) * DM + col0 + bj * 128);
#pragma unroll
            for (int ai = 0; ai < 2; ++ai)
#pragma unroll
                for (int m = 0; m < 4; ++m)
#pragma unroll
                    for (int bj = 0; bj < 2; ++bj) {
                        const int row_l = ai * 128 + wr * 64 + m * 16 + fr; const u32x4 w = xq[ai][m][bj];
                        const f32x4 x0 = (f32x4){bf_lo(w.x), bf_hi(w.x), bf_lo(w.y), bf_hi(w.y)} + g[bj][0] * acc[ai][bj][m][0];
                        const f32x4 x1 = (f32x4){bf_lo(w.z), bf_hi(w.z), bf_lo(w.w), bf_hi(w.w)} + g[bj][1] * acc[ai][bj][m][1];
                        if (layer == 3) st_bf16x8(X2 + ((size_t)b * TL + tt * 256 + row_l) * DM + col0 + bj * 128, x0, x1);
                        else st_bf16x8(XB + ((size_t)pm * 256 + row_l) * DM + col0 + bj * 128, x0, x1);
                    }
        } else {
#pragma unroll
            for (int ai = 0; ai < 2; ++ai) {
                f32x4 xf[4][2][2];
#pragma unroll
                for (int m = 0; m < 4; ++m)
#pragma unroll
                    for (int bj = 0; bj < 2; ++bj) { const int row_l = ai * 128 + wr * 64 + m * 16 + fr;
                        const float* src = (tt < 8) ? x_in + ((size_t)b * TL + tt * 256 + row_l) * DM + col0 + bj * 128 : c_in + ((size_t)b * TC + row_l) * DM + col0 + bj * 128;
                        xf[m][bj][0] = *(const f32x4*)src; xf[m][bj][1] = *(const f32x4*)(src + 4); }
#pragma unroll
                for (int m = 0; m < 4; ++m)
#pragma unroll
                    for (int bj = 0; bj < 2; ++bj) { const int row_l = ai * 128 + wr * 64 + m * 16 + fr;
                        st_bf16x8(XB + ((size_t)pm * 256 + row_l) * DM + col0 + bj * 128, xf[m][bj][0] + g[bj][0] * acc[ai][bj][m][0], xf[m][bj][1] + g[bj][1] * acc[ai][bj][m][1]); }
            }
        }
    }
};

DI void fnet_layer(const Args& A, LAS unsigned char* lds, const XcdBarrier& gbar, int layer, int j, bool latonly, int wv) {
    unsigned char* ws = A.ws;
    const bf16_t* H = (const bf16_t*)(ws + WS_H); bf16_t* U = (bf16_t*)(ws + WS_H);
    bf16_t* Gt = (bf16_t*)(ws + WS_SCR + F_G); bf16_t* PQX = (bf16_t*)(ws + WS_SCR + F_PQX); bf16_t* PQC = (bf16_t*)(ws + WS_SCR + F_PQC);
    norm_phase(A, layer, latonly, wv);
    xcd_barrier(gbar, wv);
    {
        DescPlain D; D.init(H, (const bf16_t*)(ws + WS_WFG) + (size_t)j * DM * DM, 8, latonly);
        auto E = [=](const pg8::Unit& u, int row_l, int col_l, f32x4 v0, f32x4 v1) {
            f32x4 a, b;
#pragma unroll
            for (int q = 0; q < 4; ++q) { a[q] = siluf(v0[q]); b[q] = siluf(v1[q]); }
            st_bf16x8(Gt + ((size_t)u.i0 * 256 + row_l) * DM + u.i1 * 256 + col_l, a, b);
        };
        pg8::gemm_phase(lds, D, E, wv);
    }
    {
        DescChan D; D.init((const bf16_t*)(ws + WS_DC), H, latonly);
        auto E = [=](const pg8::Unit& u, int row_l, int col_l, f32x4 v0, f32x4 v1) {
            const int b = u.i0 >> 2, g = u.i0 & 3, m = row_l;
            bf16_t* base; size_t cs; int hs;
            if (u.i2 < 8) { base = PQX + ((size_t)b * DM + g * 512) * 4096 + u.i2 * 256 + col_l; cs = 4096; hs = 2048; }
            else          { base = PQC + ((size_t)b * DM + g * 512) * 512 + col_l; cs = 512; hs = 256; }
            const f32x4 z = {0.f, 0.f, 0.f, 0.f};
            const bool mir = (u.i2 == 8);
            if (u.i1 == 0) { st_bf16x8(base + (size_t)m * cs, v0, v1); if (mir && m != 0) st_bf16x8(base + (size_t)(512 - m) * cs, v0, v1); }
            else if (m == 0) { st_bf16x8(base + (size_t)256 * cs, v0, v1); st_bf16x8(base + hs, z, z); if (mir) st_bf16x8(base + (size_t)256 * cs + hs, z, z); }
            else { st_bf16x8(base + (size_t)m * cs + hs, v0, v1); if (mir) st_bf16x8(base + (size_t)(512 - m) * cs + hs, z - v0, z - v1); }
        };
        pg8::gemm_phase(lds, D, E, wv);
    }
    xcd_barrier(gbar, wv);
    bf16_t* A1 = (bf16_t*)(ws + WS_SCR + F_A1);
    {
        const int tid = otid(wv), lane = tid & 63;
        for (int rr0 = (blockIdx.x * NWAVES + wv) * 4; rr0 < NB * DM; rr0 += gridDim.x * NWAVES * 4) {
            if ((rr0 & 511) > 256) continue;
            u32x4 raw[4][4];
#pragma unroll
            for (int k = 0; k < 4; ++k)
#pragma unroll
                for (int q = 0; q < 4; ++q) raw[k][q] = *(const u32x4*)(PQX + (size_t)(rr0 + ((rr0 & 511) == 256 ? 0 : k)) * 4096 + (q * 64 + lane) * 8);
            float accs[4];
#pragma unroll
            for (int k = 0; k < 4; ++k) { float acc = 0.f;
#pragma unroll
                for (int q = 0; q < 4; ++q) { const u32x4 w = raw[k][q]; acc += (bf_lo(w.x) - bf_hi(w.x)) + (bf_lo(w.y) - bf_hi(w.y)) + (bf_lo(w.z) - bf_hi(w.z)) + (bf_lo(w.w) - bf_hi(w.w)); }
                accs[k] = wave_sum(acc) * 0.022097086912079608f; }
            if (lane == 0) {
                unsigned short g1[4], g2[4]; size_t o1[4], o2[4]; bool v1[4], v2[4];
#pragma unroll
                for (int k = 0; k < 4; ++k) { const int rr = rr0 + k, m = rr & 511; v1[k] = (m <= 256); v2[k] = (m >= 1 && m <= 255);
                    o1[k] = ((size_t)(rr >> 11) * TB + 1024) * DM + (rr & 2047); o2[k] = o1[k] - m + (512 - m);
                    g1[k] = v1[k] ? Gt[o1[k]] : (unsigned short)0; g2[k] = v2[k] ? Gt[o2[k]] : (unsigned short)0; }
#pragma unroll
                for (int k = 0; k < 4; ++k) {
                    if (v1[k]) U[o1[k]] = (bf16_t)(pk2(accs[k] * __uint_as_float((unsigned)g1[k] << 16), 0.f) & 0xffffu);
                    if (v2[k]) U[o2[k]] = (bf16_t)(pk2(accs[k] * __uint_as_float((unsigned)g2[k] << 16), 0.f) & 0xffffu); }
            }
        }
    }
    {
        const int tid = otid(wv), lane = tid & 63; const bf16_t* DTm = (const bf16_t*)(ws + WS_DT);
        for (int it = blockIdx.x * NWAVES + wv; it < 64 * 256; it += gridDim.x * NWAVES) {
            const int bg = it >> 8, kq = it & 255, b = bg >> 2, ch = (bg & 3) * 512 + 256;
            const bf16_t* pr = PQX + ((size_t)b * DM + ch) * 4096;
            u32x4 pv[4], dv[4][4];
#pragma unroll
            for (int q = 0; q < 4; ++q) pv[q] = *(const u32x4*)(pr + (q * 64 + lane) * 8);
#pragma unroll
            for (int kk = 0; kk < 4; ++kk)
#pragma unroll
                for (int q = 0; q < 4; ++q) dv[kk][q] = *(const u32x4*)(DTm + (size_t)(kq * 4 + kk) * 4096 + (q * 64 + lane) * 8);
            float accs[4];
#pragma unroll
            for (int kk = 0; kk < 4; ++kk) { float acc = 0.f;
#pragma unroll
                for (int q = 0; q < 4; ++q) { acc = dot2g(dv[kk][q].x, pv[q].x, acc); acc = dot2g(dv[kk][q].y, pv[q].y, acc); acc = dot2g(dv[kk][q].z, pv[q].z, acc); acc = dot2g(dv[kk][q].w, pv[q].w, acc); }
                accs[kk] = wave_sum(acc); }
            if (lane == 0) {
                unsigned short g1[4], g2[4];
#pragma unroll
                for (int kk = 0; kk < 4; ++kk) { const int k = kq * 4 + kk; g1[kk] = Gt[((size_t)b * TB + k) * DM + ch]; g2[kk] = Gt[((size_t)b * TB + ((TL - k) & (TL - 1))) * DM + ch]; }
#pragma unroll
                for (int kk = 0; kk < 4; ++kk) { const int k = kq * 4 + kk;
                    U[((size_t)b * TB + k) * DM + ch] = (bf16_t)(pk2(accs[kk] * __uint_as_float((unsigned)g1[kk] << 16), 0.f) & 0xffffu);
                    if (k != 0) U[((size_t)b * TB + (TL - k)) * DM + ch] = (bf16_t)(pk2(accs[kk] * __uint_as_float((unsigned)g2[kk] << 16), 0.f) & 0xffffu); }
            }
        }
    }
    {
        DescT2 D; D.init((const bf16_t*)(ws + WS_DT), PQX);
        auto E = [=](const pg8::Unit& u, int row_l, int col_l, f32x4 v0, f32x4 v1) {
            const int k = u.i1 * 256 + row_l, col = (u.i2 & 7) * 256 + col_l;
            bf16_t* ap = A1 + ((size_t)u.i0 * 1024 + k) * DM + col;
            if (u.i2 < 8) { st_bf16x8(ap, v0, v1); return; }
            f32x4 a0, a1; ld_bf16x8(ap, a0, a1);
            const size_t off = ((size_t)u.i0 * TB + k) * DM + col;
            f32x4 g0, g1; ld_bf16x8(Gt + off, g0, g1);
            st_bf16x8(U + off, (a0 + v0) * g0, (a1 + v1) * g1);
            if (k != 0) { const size_t off2 = ((size_t)u.i0 * TB + (TL - k)) * DM + col; ld_bf16x8(Gt + off2, g0, g1); st_bf16x8(U + off2, (a0 - v0) * g0, (a1 - v1) * g1); }
            const f32x4 s0 = a0 + v0, s1 = a1 + v1, d0 = a0 - v0, d1 = a1 - v1;
            const float sm[8] = {s0[0], s0[1], s0[2], s0[3], s1[0], s1[1], s1[2], s1[3]}, df[8] = {d0[0], d0[1], d0[2], d0[3], d1[0], d1[1], d1[2], d1[3]};
            const size_t rowk = ((size_t)u.i0 * TB + k) * DM, rowT = ((size_t)u.i0 * TB + (TL - k)) * DM; const int cm = (col & ~255) + 512 - col_l;
            {
                const bf16_t* gk_ = Gt + rowk + cm - 8; const bf16_t* gT_ = Gt + rowT + cm - 8; bf16_t* uk_ = U + rowk + cm - 8; bf16_t* uT_ = U + rowT + cm - 8;
                const unsigned short ka1 = gk_[1]; const unsigned ka2 = *(const unsigned*)(gk_ + 2); const u32x2 ka4 = *(const u32x2*)(gk_ + 4); const unsigned short ka0 = col_l ? gk_[8] : (unsigned short)0;
                unsigned short ta1 = 0, ta0 = 0; unsigned ta2 = 0; u32x2 ta4 = {0u, 0u};
                if (k != 0) { ta1 = gT_[1]; ta2 = *(const unsigned*)(gT_ + 2); ta4 = *(const u32x2*)(gT_ + 4); ta0 = col_l ? gT_[8] : (unsigned short)0; }
                uk_[1] = (bf16_t)(pk2(df[7] * __uint_as_float((unsigned)ka1 << 16), 0.f) & 0xffffu);
                *(unsigned*)(uk_ + 2) = pk2(df[6] * bf_lo(ka2), df[5] * bf_hi(ka2));
                *(u32x2*)(uk_ + 4) = (u32x2){pk2(df[4] * bf_lo(ka4.x), df[3] * bf_hi(ka4.x)), pk2(df[2] * bf_lo(ka4.y), df[1] * bf_hi(ka4.y))};
                if (col_l) uk_[8] = (bf16_t)(pk2(df[0] * __uint_as_float((unsigned)ka0 << 16), 0.f) & 0xffffu);
                if (k != 0) {
                    uT_[1] = (bf16_t)(pk2(sm[7] * __uint_as_float((unsigned)ta1 << 16), 0.f) & 0xffffu);
                    *(unsigned*)(uT_ + 2) = pk2(sm[6] * bf_lo(ta2), sm[5] * bf_hi(ta2));
                    *(u32x2*)(uT_ + 4) = (u32x2){pk2(sm[4] * bf_lo(ta4.x), sm[3] * bf_hi(ta4.x)), pk2(sm[2] * bf_lo(ta4.y), sm[1] * bf_hi(ta4.y))};
                    if (col_l) uT_[8] = (bf16_t)(pk2(sm[0] * __uint_as_float((unsigned)ta0 << 16), 0.f) & 0xffffu);
                }
            }
        };
        pg8::gemm_phase(lds, D, E, wv);
    }
    if (!latonly) {
        DescT D; D.init((const bf16_t*)(ws + WS_DT2), PQC, 512, 512, 0, 1);
        auto E = [=](const pg8::Unit& u, int row_l, int col_l, f32x4 v0, f32x4 v1) {
            const size_t off = ((size_t)u.i0 * TB + TL + row_l) * DM + u.i2 * 256 + col_l;
            f32x4 g0, g1; ld_bf16x8(Gt + off, g0, g1);
            st_bf16x8(U + off, v0 * g0, v1 * g1);
        };
        pg8::gemm_phase(lds, D, E, wv);
    }
    xcd_barrier(gbar, wv);
    {
        DescPlain D; D.init(U, (const bf16_t*)(ws + WS_WFO) + (size_t)j * DM * DM, 8, latonly);
        EpiResid E; E.init(A, layer);
        pg8::gemm_phase(lds, D, E, wv);
    }
    xcd_barrier(gbar, wv);
}


namespace att {
constexpr int D = 128, NW = 8, QBLK = 32, KVBLK = 64;
constexpr float SCALE = 0.088388347648318440f;
constexpr float THR = 8.f;
constexpr int LDQ = 2048, LDK = 512;
constexpr size_t SHM_V = KVBLK * D * 2, SHM_K = KVBLK * D * 2;
typedef float f32x8 __attribute__((ext_vector_type(8)));
#define KSWZ(row, colB) ((row) * 256 + ((colB) ^ (((row) & 7) << 4)))
#define SBAR() __builtin_amdgcn_sched_barrier(0)
DI int crow(int r, int hi) { return (r & 3) + 8 * (r >> 2) + 4 * hi; }
DI unsigned cvtpk(float lo, float hi) { unsigned r; asm volatile("v_cvt_pk_bf16_f32 %0, %1, %2" : "=v"(r) : "v"(lo), "v"(hi)); return r; }
DI void partialSM(f32x16& p0, f32x16& p1, float& m_reg, float& mn, float& alpha) {
  constexpr float C = SCALE * 1.4426950408889634f;
  float pmax = p0[0];
#pragma unroll
  for (int r = 1; r < 16; ++r) pmax = fmaxf(pmax, p0[r]);
#pragma unroll
  for (int r = 0; r < 16; ++r) pmax = fmaxf(pmax, p1[r]);
  { auto rr = __builtin_amdgcn_permlane32_swap(__float_as_uint(pmax), __float_as_uint(pmax), false, false);
    pmax = fmaxf(__uint_as_float(rr[0]), __uint_as_float(rr[1])); }
  if (__builtin_expect(__all(pmax - m_reg <= THR / SCALE), 1)) { mn = m_reg; alpha = 1.f; }
  else { mn = fmaxf(m_reg, pmax); alpha = __builtin_amdgcn_exp2f((m_reg - mn) * C); m_reg = mn; }
  float mnC = -mn * C;
#pragma unroll
  for (int r = 0; r < 16; ++r) p0[r] = fmaf(p0[r], C, mnC);
#pragma unroll
  for (int r = 0; r < 16; ++r) p1[r] = fmaf(p1[r], C, mnC);
#pragma unroll
  for (int r = 0; r < 16; ++r) p0[r] = __builtin_amdgcn_exp2f(p0[r]);
}
DI void finishSM(f32x16& p0, f32x16& p1, float alpha, float& l_reg, bf16x8& pa0, bf16x8& pa1, bf16x8& pa2, bf16x8& pa3) {
#pragma unroll
  for (int r = 0; r < 16; ++r) p1[r] = __builtin_amdgcn_exp2f(p1[r]);
  float ps = 0;
#pragma unroll
  for (int r = 0; r < 16; ++r) ps += p0[r];
#pragma unroll
  for (int r = 0; r < 16; ++r) ps += p1[r];
  { auto rr = __builtin_amdgcn_permlane32_swap(__float_as_uint(ps), __float_as_uint(ps), false, false);
    ps = __uint_as_float(rr[0]) + __uint_as_float(rr[1]); }
  l_reg = l_reg * alpha + ps;
#define PK4(P, BASE, OUT) do { unsigned a0 = cvtpk(P[BASE + 0], P[BASE + 1]), a1 = cvtpk(P[BASE + 2], P[BASE + 3]);   \
    unsigned b0 = cvtpk(P[BASE + 4], P[BASE + 5]), b1 = cvtpk(P[BASE + 6], P[BASE + 7]);                              \
    auto r0 = __builtin_amdgcn_permlane32_swap(a0, b0, false, false); auto r1 = __builtin_amdgcn_permlane32_swap(a1, b1, false, false); \
    u32x4 w = {r0[0], r1[0], r0[1], r1[1]}; OUT = *reinterpret_cast<bf16x8*>(&w); } while (0)
  PK4(p0, 0, pa0); PK4(p0, 8, pa1); PK4(p1, 0, pa2); PK4(p1, 8, pa3);
#undef PK4
}
DI void qkt(f32x16& p0, f32x16& p1, const bf16_t* Ks, const bf16x8* qr, int r32, int hi) {
  p0 = f32x16{}; p1 = f32x16{};
#pragma unroll
  for (int d0 = 0; d0 < 8; ++d0) { int cb = (d0 * 16 + hi * 8) * 2;
    bf16x8 b0 = *reinterpret_cast<const bf16x8*>((const char*)Ks + KSWZ(r32, cb));
    bf16x8 b1 = *reinterpret_cast<const bf16x8*>((const char*)Ks + KSWZ(32 + r32, cb));
    p0 = __builtin_amdgcn_mfma_f32_32x32x16_bf16(b0, qr[d0], p0, 0, 0, 0);
    p1 = __builtin_amdgcn_mfma_f32_32x32x16_bf16(b1, qr[d0], p1, 0, 0, 0); }
}
DI int v_st(int k, int c) { const int kk = (k & ~0xC) | ((k & 4) << 1) | ((k & 8) >> 1); return ((kk >> 3) * 4 + (c >> 5)) * 512 + ((kk & 7) * 32 + (c & 31)) * 2; }
DI int v_rd_base(int lane) { return ((lane & 3) << 3) | (((lane >> 2) & 3) << 6) | (((lane >> 4) & 1) << 5) | (((lane >> 5) & 1) << 8); }
constexpr int v_rd_off(int d0, int ks, int half) { return d0 * 512 + ks * 4096 + half * 2048; }
template <int OFF> DI s16x4 tr_read(int vb) {
  s16x4 r; asm volatile("ds_read_b64_tr_b16 %0, %1 offset:%2" : "=&v"(r) : "v"(vb), "i"(OFF) : "memory"); return r;
}
template <int D0> DI void pv_one(f32x16& od, int vb, bf16x8 pa0, bf16x8 pa1, bf16x8 pa2, bf16x8 pa3) {
  const s16x4 l0 = tr_read<v_rd_off(D0, 0, 0)>(vb), h0 = tr_read<v_rd_off(D0, 0, 1)>(vb), l1 = tr_read<v_rd_off(D0, 1, 0)>(vb), h1 = tr_read<v_rd_off(D0, 1, 1)>(vb);
  const s16x4 l2 = tr_read<v_rd_off(D0, 2, 0)>(vb), h2 = tr_read<v_rd_off(D0, 2, 1)>(vb), l3 = tr_read<v_rd_off(D0, 3, 0)>(vb), h3 = tr_read<v_rd_off(D0, 3, 1)>(vb);
  asm volatile("s_waitcnt lgkmcnt(0)" ::: "memory"); SBAR();
#define PK(L, H) (bf16x8){L[0], L[1], L[2], L[3], H[0], H[1], H[2], H[3]}
  od = __builtin_amdgcn_mfma_f32_32x32x16_bf16(pa0, PK(l0, h0), od, 0, 0, 0);
  od = __builtin_amdgcn_mfma_f32_32x32x16_bf16(pa1, PK(l1, h1), od, 0, 0, 0);
  od = __builtin_amdgcn_mfma_f32_32x32x16_bf16(pa2, PK(l2, h2), od, 0, 0, 0);
  od = __builtin_amdgcn_mfma_f32_32x32x16_bf16(pa3, PK(l3, h3), od, 0, 0, 0);
#undef PK
}
DI void pv_d0(f32x16* o, int vb, bf16x8 pa0, bf16x8 pa1, bf16x8 pa2, bf16x8 pa3) {
  pv_one<0>(o[0], vb, pa0, pa1, pa2, pa3); pv_one<1>(o[1], vb, pa0, pa1, pa2, pa3); pv_one<2>(o[2], vb, pa0, pa1, pa2, pa3); pv_one<3>(o[3], vb, pa0, pa1, pa2, pa3);
}
DI void attn_dense_body(const bf16_t* __restrict__ Qb, const bf16_t* __restrict__ Kh, const bf16_t* __restrict__ Vh, const bf16_t* SZb, bf16_t* Ub, int seq, char* lds, int wv, const float* qn, int tpos) {
  const int tid = otid(wv), wid = tid >> 6, lane = tid & 63, r32 = lane & 31, hi = lane >> 5;
  bf16_t* V_lds = (bf16_t*)lds; bf16_t* K_lds = (bf16_t*)(lds + 2 * SHM_V);
  float* wsf = (float*)(lds + 2 * SHM_V + 2 * SHM_K) + wid * 64; float* li_l = wsf; float* al_l = wsf + 32;
  float m_reg = -1e30f, l_reg = 0; f32x16 o[4] = {}; bf16x8 qr[8];
  const bf16_t* Qw = Qb + (long)(wid * QBLK + r32) * LDQ + hi * 8;
  {
    u32x4 raw[8];
#pragma unroll
    for (int d0 = 0; d0 < 8; ++d0) raw[d0] = *reinterpret_cast<const u32x4*>(Qw + d0 * 16);
    float ss = 0.f;
#pragma unroll
    for (int d0 = 0; d0 < 8; ++d0) { const u32x4 w = raw[d0];
      ss += bf_lo(w.x) * bf_lo(w.x) + bf_hi(w.x) * bf_hi(w.x) + bf_lo(w.y) * bf_lo(w.y) + bf_hi(w.y) * bf_hi(w.y) + bf_lo(w.z) * bf_lo(w.z) + bf_hi(w.z) * bf_hi(w.z) + bf_lo(w.w) * bf_lo(w.w) + bf_hi(w.w) * bf_hi(w.w); }
    ss += __shfl_xor(ss, 32);
    const float rs = 1.0f / sqrtf(ss * (1.f / 128.f) + EPS);
    const int t = tpos + wid * QBLK + r32;
    const f32x2* rope = (const f32x2*)(lds + 81920);
#pragma unroll
    for (int d0 = 0; d0 < 8; ++d0) { const u32x4 w = raw[d0]; const float* wn = qn + d0 * 16 + hi * 8;
      const f32x4 g0 = *(const f32x4*)wn, g1 = *(const f32x4*)(wn + 4);
      float y[8] = {bf_lo(w.x) * rs * g0[0], bf_hi(w.x) * rs * g0[1], bf_lo(w.y) * rs * g0[2], bf_hi(w.y) * rs * g0[3], bf_lo(w.z) * rs * g1[0], bf_hi(w.z) * rs * g1[1], bf_lo(w.w) * rs * g1[2], bf_hi(w.w) * rs * g1[3]};
      if (tpos >= 0) {
        const int pos = (d0 < 4) ? (t >> 6) : (t & 63);
        const f32x4* rp = (const f32x4*)(rope + pos * 32 + (8 * (d0 & 3) + 4 * hi));
        const f32x4 c01 = rp[0], c23 = rp[1];
        const float cs[4] = {c01[0], c01[2], c23[0], c23[2]}, sn[4] = {c01[1], c01[3], c23[1], c23[3]};
#pragma unroll
        for (int pp = 0; pp < 4; ++pp) { const float x0 = y[2 * pp], x1 = y[2 * pp + 1]; y[2 * pp] = x0 * cs[pp] - x1 * sn[pp]; y[2 * pp + 1] = x0 * sn[pp] + x1 * cs[pp]; }
      }
      u32x4 o4 = {pk2(y[0], y[1]), pk2(y[2], y[3]), pk2(y[4], y[5]), pk2(y[6], y[7])};
      qr[d0] = __builtin_bit_cast(bf16x8, o4); }
  }
  const int sr = tid >> 4, sc = (tid & 15) * 8, vst0 = v_st(sr, sc), vst1 = v_st(32 + sr, sc);
  const int vb0 = (int)(uintptr_t)V_lds + v_rd_base(lane);
  struct { bf16x8 vs0, vs1, ks0, ks1; } sr_[2];
#define SLOAD(i, k0) do { sr_[i].vs0 = *reinterpret_cast<const bf16x8*>(&Vh[(long)((k0) + sr) * LDK + sc]); sr_[i].vs1 = *reinterpret_cast<const bf16x8*>(&Vh[(long)((k0) + 32 + sr) * LDK + sc]); \
    sr_[i].ks0 = *reinterpret_cast<const bf16x8*>(&Kh[(long)((k0) + sr) * LDK + sc]); sr_[i].ks1 = *reinterpret_cast<const bf16x8*>(&Kh[(long)((k0) + 32 + sr) * LDK + sc]); } while (0)
#define SWRITE(b, i) do { *(bf16x8*)((char*)V_lds + (b) * SHM_V + vst0) = sr_[i].vs0;          \
    *(bf16x8*)((char*)V_lds + (b) * SHM_V + vst1) = sr_[i].vs1; int kc = sc * 2;               \
    *(bf16x8*)((char*)K_lds + (b) * SHM_K + KSWZ(sr, kc)) = sr_[i].ks0;                       \
    *(bf16x8*)((char*)K_lds + (b) * SHM_K + KSWZ(32 + sr, kc)) = sr_[i].ks1; } while (0)
#define SWAIT() asm volatile("s_waitcnt vmcnt(4)" ::: "memory")
#define RESC(a) do { if (__any((a) < 1.f)) { if (hi == 0) al_l[r32] = (a); asm volatile("s_waitcnt lgkmcnt(0)" ::: "memory"); \
    _Pragma("unroll") for (int d = 0; d < 4; ++d) _Pragma("unroll") for (int r = 0; r < 16; ++r) o[d][r] *= al_l[crow(r, hi)]; } } while (0)
  f32x16 pA0, pA1, pB0, pB1; float mnA, mnB, alA, alB; bf16x8 pa0, pa1, pa2, pa3; const int NT = seq / KVBLK;
  constexpr int SE = 0, SO = 1;
  SLOAD(SE, 0); asm volatile("s_waitcnt vmcnt(0)" ::: "memory"); SWRITE(0, SE); __syncthreads();
  qkt(pA0, pA1, K_lds, qr, r32, hi); partialSM(pA0, pA1, m_reg, mnA, alA);
  SLOAD(SO, KVBLK); if (2 < NT) SLOAD(SE, 2 * KVBLK);
  SWAIT(); SWRITE(1, SO); __syncthreads();
  for (int j = 1; j + 1 < NT; j += 2) {
    SBAR(); qkt(pB0, pB1, (bf16_t*)((char*)K_lds + SHM_K), qr, r32, hi);
    finishSM(pA0, pA1, alA, l_reg, pa0, pa1, pa2, pa3); SBAR();
    SLOAD(SO, (j + 2) * KVBLK); SBAR();
    pv_d0(o, vb0, pa0, pa1, pa2, pa3); partialSM(pB0, pB1, m_reg, mnB, alB);
    __syncthreads(); SWAIT(); SWRITE(0, SE);
    RESC(alB); __syncthreads();
    SBAR(); qkt(pA0, pA1, K_lds, qr, r32, hi);
    finishSM(pB0, pB1, alB, l_reg, pa0, pa1, pa2, pa3); SBAR();
    if (j + 3 < NT) SLOAD(SE, (j + 3) * KVBLK); SBAR();
    pv_d0(o, vb0 + (int)SHM_V, pa0, pa1, pa2, pa3); partialSM(pA0, pA1, m_reg, mnA, alA);
    __syncthreads(); SWAIT(); SWRITE(1, SO);
    RESC(alA); __syncthreads();
  }
  SBAR(); qkt(pB0, pB1, (bf16_t*)((char*)K_lds + SHM_K), qr, r32, hi);
  finishSM(pA0, pA1, alA, l_reg, pa0, pa1, pa2, pa3); SBAR();
  pv_d0(o, vb0, pa0, pa1, pa2, pa3); partialSM(pB0, pB1, m_reg, mnB, alB);
  __syncthreads(); RESC(alB);
  finishSM(pB0, pB1, alB, l_reg, pa0, pa1, pa2, pa3); SBAR();
  pv_d0(o, vb0 + (int)SHM_V, pa0, pa1, pa2, pa3);
  u32x4 zq[8];
#pragma unroll
  for (int i = 0; i < 8; ++i) { const int id = tid + 512 * i; zq[i] = *(const u32x4*)(SZb + (long)(id >> 4) * LDQ + (id & 15) * 8); }
  if (hi == 0) li_l[r32] = l_reg; asm volatile("s_waitcnt lgkmcnt(0)" ::: "memory");
  __syncthreads();
  {
    float rli[16];
#pragma unroll
    for (int r = 0; r < 16; ++r) rli[r] = __builtin_amdgcn_rcpf(li_l[crow(r, hi)]);
    char* ost = lds;
#pragma unroll
    for (int r = 0; r < 16; ++r) { char* rowp = ost + (wid * QBLK + crow(r, hi)) * 256 + r32 * 2;
#pragma unroll
      for (int d0 = 0; d0 < 4; ++d0) *(unsigned short*)(rowp + d0 * 64) = (unsigned short)(pk2(o[d0][r] * rli[r], 0.f) & 0xffffu); }
  }
  __syncthreads();
#pragma unroll
  for (int i = 0; i < 8; ++i) { const int id = tid + 512 * i; const int row = id >> 4, ch = id & 15;
    const u32x4 ov = *(const u32x4*)(lds + row * 256 + ch * 16);
    f32x4 a0 = {bf_lo(ov.x), bf_hi(ov.x), bf_lo(ov.y), bf_hi(ov.y)}, a1 = {bf_lo(ov.z), bf_hi(ov.z), bf_lo(ov.w), bf_hi(ov.w)};
    const f32x4 z0 = {bf_lo(zq[i].x), bf_hi(zq[i].x), bf_lo(zq[i].y), bf_hi(zq[i].y)}, z1 = {bf_lo(zq[i].z), bf_hi(zq[i].z), bf_lo(zq[i].w), bf_hi(zq[i].w)};
    st_bf16x8(Ub + (long)row * LDQ + ch * 8, a0 * z0, a1 * z1); }
  __syncthreads();
#undef SLOAD
#undef SWRITE
#undef SWAIT
#undef RESC
}
#undef KSWZ
#undef SBAR
}

DI void qknorm_phase(const Args& A, LAS unsigned char* lds, int wv) {
    const int tid = otid(wv), lane = tid & 63, wave = tid >> 6, G = gridDim.x;
    bf16_t* Q = (bf16_t*)(A.ws + WS_SCR + A_Q); bf16_t* Kb = (bf16_t*)(A.ws + WS_SCR + A_K);
    const float* qn = A.in[14]; const float* kn = A.in[15];
    const int sub = lane >> 4, l16 = lane & 15, e0 = l16 * 8;
    LAS f32x2* rope = (LAS f32x2*)lds;
    for (int e = tid; e < 2048; e += NTHREADS) { const float ang = (float)(e >> 5) * exp2f(-(float)(e & 31) * 0.41524101186092029f); rope[e] = (f32x2){cosf(ang), sinf(ang)}; }
    __syncthreads();
    const long NIT = (long)NTOK * 4;
    for (long it0 = ((long)blockIdx.x * NWAVES + wave) * 16 + sub; it0 < NIT; it0 += (long)G * NWAVES * 16) {
        bf16_t* pq[4]; u32x4 raw[4];
#pragma unroll
        for (int k = 0; k < 4; ++k) { const long it = it0 + 4 * k; const int row = (int)(it >> 2), hj = 16 + (int)(it & 3);
            pq[k] = (hj < 16) ? Q + (size_t)row * 2048 + hj * 128 + e0 : Kb + (size_t)row * 512 + (hj - 16) * 128 + e0;
            raw[k] = *(const u32x4*)pq[k]; }
#pragma unroll
        for (int k = 0; k < 4; ++k) {
            const long it = it0 + 4 * k; const int row = (int)(it >> 2), hj = 16 + (int)(it & 3);
            const float* wn = (hj < 16 ? qn : kn) + e0;
            f32x4 a = {bf_lo(raw[k].x), bf_hi(raw[k].x), bf_lo(raw[k].y), bf_hi(raw[k].y)}, b = {bf_lo(raw[k].z), bf_hi(raw[k].z), bf_lo(raw[k].w), bf_hi(raw[k].w)};
            float ss = 0.f;
#pragma unroll
            for (int q = 0; q < 4; ++q) ss += a[q] * a[q] + b[q] * b[q];
            ss += __shfl_xor(ss, 1); ss += __shfl_xor(ss, 2); ss += __shfl_xor(ss, 4); ss += __shfl_xor(ss, 8);
            const float rs = 1.0f / sqrtf(ss * (1.f / 128.f) + EPS);
            const f32x4 w0 = *(const f32x4*)wn, w1 = *(const f32x4*)(wn + 4);
            a = a * rs * w0; b = b * rs * w1;
            const int t = row % TB;
            if (t < TL) {
                const int pos = (l16 < 8) ? (t >> 6) : (t & 63);
                float y[8] = {a[0], a[1], a[2], a[3], b[0], b[1], b[2], b[3]};
                const LAS f32x4* rp = (const LAS f32x4*)(rope + pos * 32 + ((4 * l16) & 31));
                const f32x4 c01 = rp[0], c23 = rp[1];
                const float cs[4] = {c01[0], c01[2], c23[0], c23[2]}, sn[4] = {c01[1], c01[3], c23[1], c23[3]};
#pragma unroll
                for (int pp = 0; pp < 4; ++pp) {
                    const float x0 = y[2 * pp], x1 = y[2 * pp + 1];
                    y[2 * pp] = x0 * cs[pp] - x1 * sn[pp]; y[2 * pp + 1] = x0 * sn[pp] + x1 * cs[pp];
                }
                a = (f32x4){y[0], y[1], y[2], y[3]}; b = (f32x4){y[4], y[5], y[6], y[7]};
            }
            st_bf16x8(pq[k], a, b);
        }
    }
}

DI void attn_layer(const Args& A, LAS unsigned char* lds, char* lds_gen, const XcdBarrier& gbar, int layer, int wv) {
    unsigned char* ws = A.ws;
    const bf16_t* H = (const bf16_t*)(ws + WS_H); bf16_t* U = (bf16_t*)(ws + WS_H);
    bf16_t* Q = (bf16_t*)(ws + WS_SCR + A_Q); bf16_t* Kb = (bf16_t*)(ws + WS_SCR + A_K); bf16_t* Vb = (bf16_t*)(ws + WS_SCR + A_V); bf16_t* SZ = (bf16_t*)(ws + WS_SCR + A_SZ);
    norm_phase(A, layer, false, wv);
    xcd_barrier(gbar, wv);
    {
        DescA1 D; D.init(H, (const bf16_t*)(ws + WS_WAI));
        auto E = [=](const pg8::Unit& u, int row_l, int col_l, f32x4 v0, f32x4 v1) {
            const size_t row = (size_t)u.i0 * 256 + row_l; const int pn = u.i1;
            if (pn < 8) st_bf16x8(Q + row * 2048 + pn * 256 + col_l, v0, v1);
            else if (pn < 10) st_bf16x8(Kb + row * 512 + (pn - 8) * 256 + col_l, v0, v1);
            else if (pn < 12) st_bf16x8(Vb + row * 512 + (pn - 10) * 256 + col_l, v0, v1);
            else { f32x4 a, b;
#pragma unroll
                for (int q = 0; q < 4; ++q) { a[q] = siluf(v0[q]); b[q] = siluf(v1[q]); }
                st_bf16x8(SZ + row * 2048 + (pn - 12) * 256 + col_l, a, b); }
        };
        pg8::gemm_phase(lds, D, E, wv);
    }
    xcd_barrier(gbar, wv);
    qknorm_phase(A, lds, wv);
    xcd_barrier(gbar, wv);
    {
        const int G = gridDim.x, c = blockIdx.x;
        { f32x2* rope = (f32x2*)(lds_gen + 81920); const int tid = otid(wv);
          for (int e = tid; e < 2048; e += NTHREADS) { const float ang = (float)(e >> 5) * exp2f(-(float)(e & 31) * 0.41524101186092029f); rope[e] = (f32x2){cosf(ang), sinf(ang)}; }
          __syncthreads(); }
        const float* qn = A.in[14];
        for (long L = c; L < 2048; L += G) {
            const int u = pg8::xcd_remap((int)L, 2048);
            const int b = u / 128, rem = u % 128, kvh = rem / 32, g = (rem / 8) % 4, qb = rem % 8, h = kvh * 4 + g;
            const size_t qoff = ((size_t)b * TB + qb * 256) * 2048 + h * 128, koff = ((size_t)b * TB) * 512 + kvh * 128;
            att::attn_dense_body(Q + qoff, Kb + koff, Vb + koff, SZ + qoff, U + qoff, TB, lds_gen, wv, qn, qb * 256);
        }
    }
    xcd_barrier(gbar, wv);
    {
        DescPlain D; D.init(U, (const bf16_t*)(ws + WS_WAO), 8, true);
        EpiResid E; E.init(A, layer);
        pg8::gemm_phase(lds, D, E, wv);
    }
    xcd_barrier(gbar, wv);
}


struct DescM1 {
    static constexpr bool RAW = false;
    const bf16_t* H; const bf16_t* WA; const bf16_t* WB; int lda, ldb, K, total;
    DI void init(const bf16_t* H_, const bf16_t* WA_, const bf16_t* WB_) { H = H_; WA = WA_; WB = WB_; lda = DM; ldb = DM; K = DM; total = 144 * 9 + 8 * 144; }
    DI pg8::Unit unit(int idx) const {
        pg8::Unit u;
        if (idx < 1296) { const int nig = 72, gid = idx / nig, pm = gid * 8 + (idx % nig) % 8, pn = (idx % nig) / 8;
            u.a = (const char*)(H + (size_t)pm * 256 * DM); u.b = (const char*)(WA + (size_t)pn * 256 * DM); u.i0 = pm; u.i1 = pn; u.i2 = 0; }
        else { const int j = idx - 1296, mt = j % 8, nt = j / 8;
            u.a = (const char*)(WB + (size_t)mt * 256 * DM); u.b = (const char*)(H + (size_t)nt * 256 * DM); u.i0 = mt; u.i1 = nt; u.i2 = 1; }
        return u;
    }
};
namespace ml {
#define MFMA32(a, b, c) __builtin_amdgcn_mfma_f32_32x32x16_bf16((a), (b), (c), 0, 0, 0)
#define LFENCE() asm volatile("s_waitcnt lgkmcnt(0)" ::: "memory")
DI float dot2_bf16(unsigned a, unsigned b, float c) { asm("v_dot2c_f32_bf16 %0, %1, %2" : "+v"(c) : "v"(a), "v"(b)); return c; }
#define DOT2(a, b, c) dot2_bf16((a), (b), (c))
DI int crow(int reg, int h) { return (reg & 3) + 8 * (reg >> 2) + 4 * h; }
DI bf16x8 ldperm(const bf16_t* p) { const s16x4 lo = *(const s16x4*)p, hi = *(const s16x4*)(p + 8); return __builtin_shufflevector(lo, hi, 0, 1, 2, 3, 4, 5, 6, 7); }
DI bf16x8 pack_step(const f32x16& x, int s) { u32x4 p = {pk2(x[8 * s], x[8 * s + 1]), pk2(x[8 * s + 2], x[8 * s + 3]), pk2(x[8 * s + 4], x[8 * s + 5]), pk2(x[8 * s + 6], x[8 * s + 7])}; return __builtin_bit_cast(bf16x8, p); }
DI float bfs(short h) { return __uint_as_float(((unsigned)(unsigned short)h) << 16); }

constexpr int SC_Q = 0, SC_K = 16384, SC_KT = 32768, SC_BUF = 49152, SC_WAVE = 2 * SC_BUF, SC_WAVE_BYTES = 6656;
DI bf16x8 ldsfrag(const LAS unsigned char* buf, unsigned o) { const s16x4 lo = *(const LAS s16x4*)(buf + o), hi = *(const LAS s16x4*)(buf + (o ^ 16u)); return __builtin_shufflevector(lo, hi, 0, 1, 2, 3, 4, 5, 6, 7); }
DI void scan_phase(const Args& A, LAS unsigned char* lds, int wv) {
    const int wave = wv;
    LAS float* wl = (LAS float*)(lds + SC_WAVE + wave * SC_WAVE_BYTES);
    LAS unsigned* nbp = (LAS unsigned*)(lds + SC_WAVE + wave * SC_WAVE_BYTES + 2048);
    LAS unsigned* wbp = nbp + 64;
    LAS unsigned char* hst = lds + SC_WAVE + wave * SC_WAVE_BYTES + 2560;
    unsigned char* ws = A.ws;
    const bf16_t* Qg = (const bf16_t*)(ws + WS_SCR + M_Q); const bf16_t* Kg = (const bf16_t*)(ws + WS_SCR + M_K); const bf16_t* KVT = (const bf16_t*)(ws + WS_SCR + M_KVT);
    const float* G32 = (const float*)(ws + WS_SCR + M_G32); const float* bg = A.in[10];
#define SC_POS0(j) (dir == 0 ? ((j) < 4 ? TL + 64 * (j) : 64 * ((j) - 4)) : ((j) < 4 ? TL + 64 * (3 - (j)) : 64 * (35 - (j))))
#define SC_DMA(bufi, p0) do { const int tj_ = otid(wv); _Pragma("unroll") for (int i_ = 0; i_ < 2; ++i_) { const int sl_ = i_ * 512 + tj_; \
        { const int row_ = sl_ >> 4, c_ = (sl_ & 15) ^ (row_ & 15); const size_t go_ = (size_t)((p0) + row_) * 1024 + c_ * 8; \
          __builtin_amdgcn_global_load_lds((const unsigned*)(Qu + go_), (LAS unsigned*)(lds + (bufi) * SC_BUF + SC_Q + i_ * 8192 + wave * 1024), 16, 0, 0); \
          __builtin_amdgcn_global_load_lds((const unsigned*)(Ku + go_), (LAS unsigned*)(lds + (bufi) * SC_BUF + SC_K + i_ * 8192 + wave * 1024), 16, 0, 0); } \
        { const int d_ = sl_ >> 3, c_ = (sl_ & 7) ^ ((d_ >> 1) & 7); \
          __builtin_amdgcn_global_load_lds((const unsigned*)(KTu + (size_t)d_ * TB + (p0) + c_ * 8), (LAS unsigned*)(lds + (bufi) * SC_BUF + SC_KT + i_ * 8192 + wave * 1024), 16, 0, 0); } } } while (0)
    for (int item = blockIdx.x; item < 256; item += gridDim.x) {
        const int dir = item & 1, h = (item >> 1) & 7, b = item >> 4, e0 = wave * 32;
        const bf16_t* Qu = Qg + (size_t)b * TB * 1024 + h * 128;
        const bf16_t* Ku = Kg + (size_t)b * TB * 1024 + h * 128;
        const bf16_t* KTu = KVT + ((size_t)b * 3072 + h * 128) * TB;
        const bf16_t* VTu = KVT + ((size_t)b * 3072 + 1024 + h * 256 + e0) * TB;
        bf16_t* Hout = (bf16_t*)(ws + WS_SCR + (dir ? M_HB : M_HF)) + (size_t)b * TB * DM + h * 256 + e0;
        const float big = bg[(dir * 2) * 8 + h], bfg = bg[(dir * 2 + 1) * 8 + h];
        f32x16 cacc[4];
#pragma unroll
        for (int d = 0; d < 4; ++d)
#pragma unroll
            for (int i = 0; i < 16; ++i) cacc[d][i] = 0.f;
        float m = 0.f;
        { const int l0 = otid(wv) & 63; wl[384 + l0] = 0.f; wl[448 + l0] = 0.f; nbp[l0] = 0u; }
        LFENCE();
        SC_DMA(0, SC_POS0(0));
        float ig_n, fg_n;
        { const int l0 = otid(wv) & 63; const float* gp = G32 + (size_t)(b * TB + SC_POS0(0) + (dir ? 63 - l0 : l0)) * 32 + (dir * 2) * 8 + h; ig_n = gp[0]; fg_n = gp[8]; }
        for (int j = 0; j < 36; ++j) {
            const int pos0 = SC_POS0(j);
            const LAS unsigned char* Qb = lds + (j & 1) * SC_BUF + SC_Q; const LAS unsigned char* Kb = lds + (j & 1) * SC_BUF + SC_K; const LAS unsigned char* KTb = lds + (j & 1) * SC_BUF + SC_KT;
            asm volatile("s_waitcnt vmcnt(0)" ::: "memory"); __builtin_amdgcn_s_barrier(); asm volatile("" ::: "memory");
            if (j + 1 < 36) SC_DMA((j + 1) & 1, SC_POS0(j + 1));
            const int lj = otid(wv) & 63, rj = lj & 31, h4 = (lj >> 5) * 4;
            LAS float* wh = wl + h4; LAS float* wr = wl + rj; LAS unsigned char* hb = hst + h4 * 64 + rj * 2;
            const LAS unsigned* nbh = nbp + (h4 >> 1); const LAS unsigned* wbh = wbp + (h4 >> 1);
            const unsigned xr = rj & 15, xd = (rj >> 1) & 7;
            const unsigned qro = (unsigned)rj * 256u + 2u * h4;
            const unsigned kro = (unsigned)rj * 128u + 2u * h4;
            const bf16_t* VTp = VTu + (size_t)rj * TB + pos0 + h4;
            bf16x8 vf[4];
#pragma unroll
            for (int kk = 0; kk < 4; ++kk) vf[kk] = ldperm(VTp + 16 * kk);
            float decay, m_new;
            {
                const int s = dir ? 63 - lj : lj;
                const float ig = ig_n + big, fg = fg_n + bfg;
                if (j + 1 < 36) { const float* gp = G32 + (size_t)(b * TB + SC_POS0(j + 1) + s) * 32 + (dir * 2) * 8 + h; ig_n = gp[0]; fg_n = gp[8]; }
                const float lf = fminf(fg, 0.f) - log1pf(__expf(-fabsf(fg)));
                float bs = lf;
#pragma unroll
                for (int o = 1; o < 64; o <<= 1) { const float t = __shfl_up(bs, o); if (lj >= o) bs += t; }
                const float uu = ig - bs;
                float pmx = uu;
#pragma unroll
                for (int o = 1; o < 64; o <<= 1) { const float t = __shfl_up(pmx, o); if (lj >= o) pmx = fmaxf(pmx, t); }
                pmx = fmaxf(pmx, m);
                const float b_end = __shfl(bs, 63), pm_last = __shfl(pmx, 63);
                LAS float* ws_ = wl + s;
                ws_[0] = uu * 1.4426950408889634f; ws_[64] = pmx * 1.4426950408889634f; ws_[128] = __expf(m - pmx); ws_[192] = __expf(-(bs + pmx)); ws_[256] = __expf(uu - pm_last);
                { const float wv_ = __expf(uu - pm_last), wp_ = __shfl_xor(wv_, 1); if ((s & 1) == 0) wbp[s >> 1] = pk2(wv_, wp_); }
                decay = __expf(m - pm_last); m_new = b_end + pm_last;
            }
            LFENCE();
            const int sbase = dir ? 63 - h4 : h4, sgn = dir ? -1 : 1;
#pragma unroll
            for (int tb = 0; tb < 2; ++tb) {
                __builtin_amdgcn_sched_barrier(0);
                const unsigned qo = qro + tb * 8192u;
                f32x16 ha;
#pragma unroll
                for (int i = 0; i < 16; ++i) ha[i] = 0.f;
                float qnv = 0.f;
#pragma unroll
                for (int kk = 0; kk < 8; ++kk) {
                    const bf16x8 qa = ldsfrag(Qb, qo + (((2u * kk) ^ xr) << 4));
                    ha = MFMA32(qa, pack_step(cacc[kk >> 1], kk & 1), ha);
                    { const u32x2 nb0 = *(const LAS u32x2*)(nbh + 8 * kk), nb1 = *(const LAS u32x2*)(nbh + 8 * kk + 4); const u32x4 qw = __builtin_bit_cast(u32x4, qa);
                      qnv = DOT2(qw.x, nb0.x, qnv); qnv = DOT2(qw.y, nb0.y, qnv); qnv = DOT2(qw.z, nb1.x, qnv); qnv = DOT2(qw.w, nb1.y, qnv); }
                }
                qnv += __shfl_xor(qnv, 32);
#pragma unroll
                for (int g = 0; g < 4; ++g) { const f32x4 av = *(const LAS f32x4*)(wh + 128 + 32 * tb + 8 * g);
#pragma unroll
                    for (int q = 0; q < 4; ++q) ha[4 * g + q] *= av[q]; }
                const float pmt = wr[64 + 32 * tb];
                const int tp = dir ? (63 - 32 * tb) - rj : 32 * tb + rj;
                float ds = 0.f;
#pragma unroll
                for (int sb = 0; sb < 2; ++sb) {
                    __builtin_amdgcn_sched_barrier(0);
                    if (sb != tb && (dir ? sb < tb : sb > tb)) continue;
                    const unsigned ko = qro + sb * 8192u;
                    f32x16 st;
#pragma unroll
                    for (int i = 0; i < 16; ++i) st[i] = 0.f;
#pragma unroll
                    for (int kk = 0; kk < 8; ++kk) { const unsigned c = ((2u * kk) ^ xr) << 4; st = MFMA32(ldsfrag(Kb, ko + c), ldsfrag(Qb, qo + c), st); }
#pragma unroll
                    for (int g = 0; g < 4; ++g) { const f32x4 uv = *(const LAS f32x4*)(wh + 32 * sb + 8 * g);
#pragma unroll
                        for (int q = 0; q < 4; ++q) {
                            const int sc = 32 * sb + q + 8 * g;
                            const int sp = sbase + sgn * sc;
                            st[4 * g + q] *= __builtin_amdgcn_exp2f((sp <= tp) ? uv[q] - pmt : -1e30f);
                            ds += st[4 * g + q];
                        } }
                    ha = MFMA32(pack_step(st, 0), vf[2 * sb], ha);
                    ha = MFMA32(pack_step(st, 1), vf[2 * sb + 1], ha);
                }
                ds += __shfl_xor(ds, 32);
                {
                    const float den = wr[128 + 32 * tb] * qnv + ds;
                    const float rd = 1.0f / fmaxf(fabsf(den), wr[192 + 32 * tb]);
                    if (h4 == 0) wr[320 + 32 * tb] = rd;
                }
                LFENCE();
#pragma unroll
                for (int g = 0; g < 4; ++g) { const f32x4 rv = *(const LAS f32x4*)(wh + 320 + 32 * tb + 8 * g);
#pragma unroll
                    for (int q = 0; q < 4; ++q) { const int tc = 32 * tb + q + 8 * g;
                        *(LAS unsigned short*)(hb + tc * 64) = (unsigned short)(pk2(ha[4 * g + q] * rv[q], 0.f) & 0xffffu); } }
            }
            LFENCE();
            {
                bf16_t* hp = Hout + (size_t)(pos0 + lj) * DM;
                const LAS unsigned char* hrow = hst + lj * 64;
#pragma unroll
                for (int q = 0; q < 4; ++q) *(u32x4*)(hp + 8 * q) = *(const LAS u32x4*)(hrow + 16 * q);
            }
            __builtin_amdgcn_sched_barrier(0);
            bf16x8 vfw[4];
#pragma unroll
            for (int kk = 0; kk < 4; ++kk) {
                const f32x4 w0 = *(const LAS f32x4*)(wh + 256 + 16 * kk), w1 = *(const LAS f32x4*)(wh + 256 + 16 * kk + 8);
                u32x4 p = {pk2(bfs(vf[kk][0]) * w0[0], bfs(vf[kk][1]) * w0[1]), pk2(bfs(vf[kk][2]) * w0[2], bfs(vf[kk][3]) * w0[3]),
                           pk2(bfs(vf[kk][4]) * w1[0], bfs(vf[kk][5]) * w1[1]), pk2(bfs(vf[kk][6]) * w1[2], bfs(vf[kk][7]) * w1[3])};
                vfw[kk] = __builtin_bit_cast(bf16x8, p);
            }
#pragma unroll
            for (int db = 0; db < 4; ++db) {
#pragma unroll
                for (int i = 0; i < 16; ++i) cacc[db][i] *= decay;
                const unsigned to = kro + db * 4096u;
                float nadd = 0.f;
#pragma unroll
                for (int kk = 0; kk < 4; ++kk) {
                    const bf16x8 kv = ldsfrag(KTb, to + (((2u * kk) ^ xd) << 4));
                    const u32x2 wq0 = *(const LAS u32x2*)(wbh + 8 * kk), wq1 = *(const LAS u32x2*)(wbh + 8 * kk + 4); const u32x4 kw = __builtin_bit_cast(u32x4, kv);
                    nadd = DOT2(kw.x, wq0.x, nadd); nadd = DOT2(kw.y, wq0.y, nadd); nadd = DOT2(kw.z, wq1.x, nadd); nadd = DOT2(kw.w, wq1.y, nadd);
                    cacc[db] = MFMA32(kv, vfw[kk], cacc[db]);
                }
                nadd += __shfl_xor(nadd, 32);
                const float nnew = decay * wr[384 + 32 * db] + nadd, npart = __shfl_xor(nnew, 1);
                if (h4 == 0) { wr[384 + 32 * db] = nnew; if ((rj & 1) == 0) nbp[(32 * db + rj) >> 1] = pk2(nnew, npart); }
            }
            LFENCE();
            m = m_new;
        }
        asm volatile("s_waitcnt vmcnt(0)" ::: "memory"); __builtin_amdgcn_s_barrier();
    }
#undef SC_DMA
#undef SC_POS0
}
#undef MFMA32
#undef LFENCE
#undef DOT2
}

DI void mlstm_finish_phase(const Args& A, int wv) {
    const int tid = otid(wv), lane = tid & 63, wave = tid >> 6, G = gridDim.x;
    unsigned char* ws = A.ws;
    const bf16_t* HF = (const bf16_t*)(ws + WS_SCR + M_HF); const bf16_t* HB = (const bf16_t*)(ws + WS_SCR + M_HB);
    const bf16_t* SO = (const bf16_t*)(ws + WS_SCR + M_SO); const bf16_t* SZ = (const bf16_t*)(ws + WS_SCR + M_SZ);
    bf16_t* U = (bf16_t*)(ws + WS_H); const float* hn = A.in[11];
    const int sub = lane >> 5, e0 = (lane & 31) * 8;
    const long NIT = (long)NTOK * 8;
    for (long it0 = ((long)blockIdx.x * NWAVES + wave) * 4 + sub; it0 < NIT; it0 += (long)G * NWAVES * 4) {
        f32x4 f0[2], f1[2], b0[2], b1[2], o0[2], o1[2], z0[2], z1[2];
#pragma unroll
        for (int k = 0; k < 2; ++k) { const long it = it0 + 2 * k; const size_t off = (size_t)(it >> 3) * DM + (int)(it & 7) * 256 + e0;
            ld_bf16x8(HF + off, f0[k], f1[k]); ld_bf16x8(HB + off, b0[k], b1[k]); ld_bf16x8(SO + off, o0[k], o1[k]); ld_bf16x8(SZ + off, z0[k], z1[k]); }
#pragma unroll
        for (int k = 0; k < 2; ++k) { const long it = it0 + 2 * k; const size_t off = (size_t)(it >> 3) * DM + (int)(it & 7) * 256 + e0;
            f32x4 y0 = o0[k] * (f0[k] + b0[k]), y1 = o1[k] * (f1[k] + b1[k]);
            float ss = 0.f;
#pragma unroll
            for (int q = 0; q < 4; ++q) ss += y0[q] * y0[q] + y1[q] * y1[q];
            ss += __shfl_xor(ss, 1); ss += __shfl_xor(ss, 2); ss += __shfl_xor(ss, 4); ss += __shfl_xor(ss, 8); ss += __shfl_xor(ss, 16);
            const float rs = 1.0f / sqrtf(ss * (1.f / 256.f) + EPS);
            const float* hp = hn + (int)(it & 7) * 256 + e0;
            const f32x4 h0 = *(const f32x4*)hp, h1 = *(const f32x4*)(hp + 4);
            st_bf16x8(U + off, y0 * rs * h0 * z0[k], y1 * rs * h1 * z1[k]); }
    }
}

DI void mlstm_layer(const Args& A, LAS unsigned char* lds, const XcdBarrier& gbar, int layer, int wv) {
    unsigned char* ws = A.ws;
    const bf16_t* H = (const bf16_t*)(ws + WS_H); bf16_t* U = (bf16_t*)(ws + WS_H);
    bf16_t* Q = (bf16_t*)(ws + WS_SCR + M_Q); bf16_t* Kb = (bf16_t*)(ws + WS_SCR + M_K); bf16_t* KVT = (bf16_t*)(ws + WS_SCR + M_KVT);
    float* G32 = (float*)(ws + WS_SCR + M_G32); bf16_t* SO = (bf16_t*)(ws + WS_SCR + M_SO); bf16_t* SZ = (bf16_t*)(ws + WS_SCR + M_SZ);
    norm_phase(A, layer, false, wv);
    xcd_barrier(gbar, wv);
    {
        DescM1 D; D.init(H, (const bf16_t*)(ws + WS_WMA), (const bf16_t*)(ws + WS_WMB));
        auto E = [=](const pg8::Unit& u, int row_l, int col_l, f32x4 v0, f32x4 v1) {
            if (u.i2 == 0) {
                const size_t row = (size_t)u.i0 * 256 + row_l; const int pn = u.i1;
                if (pn < 4) st_bf16x8(Q + row * 1024 + pn * 256 + col_l, v0 * 0.088388347648318440f, v1 * 0.088388347648318440f);
                else if (pn < 8) { st_bf16x8(Kb + row * 1024 + (pn - 4) * 256 + col_l, v0, v1);
                    const int bb = u.i0 / 9, sp = (u.i0 % 9) * 256 + row_l;
                    bf16_t* kt = KVT + ((size_t)bb * 3072 + (pn - 4) * 256 + col_l) * TB + sp;
                    const unsigned w0 = pk2(v0[0], v0[1]), w1 = pk2(v0[2], v0[3]), w2 = pk2(v1[0], v1[1]), w3 = pk2(v1[2], v1[3]);
                    kt[0] = (bf16_t)(w0 & 0xffffu); kt[TB] = (bf16_t)(w0 >> 16); kt[2 * TB] = (bf16_t)(w1 & 0xffffu); kt[3 * TB] = (bf16_t)(w1 >> 16);
                    kt[4 * TB] = (bf16_t)(w2 & 0xffffu); kt[5 * TB] = (bf16_t)(w2 >> 16); kt[6 * TB] = (bf16_t)(w3 & 0xffffu); kt[7 * TB] = (bf16_t)(w3 >> 16); }
                else if (col_l < 32) { *(f32x4*)(G32 + row * 32 + col_l) = v0; *(f32x4*)(G32 + row * 32 + col_l + 4) = v1; }
            } else {
                const int bb = u.i1 / 9, s0 = (u.i1 % 9) * 256;
                st_bf16x8(KVT + ((size_t)bb * 3072 + 1024 + u.i0 * 256 + row_l) * TB + s0 + col_l, v0, v1);
            }
        };
        pg8::gemm_phase(lds, D, E, wv);
    }
    xcd_barrier(gbar, wv);
    ml::scan_phase(A, lds, wv);
    xcd_barrier(gbar, wv);
    {
        DescPlain D; D.init(H, (const bf16_t*)(ws + WS_WMA) + (size_t)2304 * DM, 16, false);
        auto E = [=](const pg8::Unit& u, int row_l, int col_l, f32x4 v0, f32x4 v1) {
            const size_t row = (size_t)u.i0 * 256 + row_l; const int pn = u.i1; f32x4 a, b;
            if (pn < 8) {
#pragma unroll
                for (int q = 0; q < 4; ++q) { a[q] = sigmf(v0[q]); b[q] = sigmf(v1[q]); }
                st_bf16x8(SO + row * DM + pn * 256 + col_l, a, b);
            } else {
#pragma unroll
                for (int q = 0; q < 4; ++q) { a[q] = siluf(v0[q]); b[q] = siluf(v1[q]); }
                st_bf16x8(SZ + row * DM + (pn - 8) * 256 + col_l, a, b);
            }
        };
        pg8::gemm_phase(lds, D, E, wv);
    }
    xcd_barrier(gbar, wv);
    mlstm_finish_phase(A, wv);
    xcd_barrier(gbar, wv);
    {
        DescPlain D; D.init(U, (const bf16_t*)(ws + WS_WMO), 8, false);
        EpiResid E; E.init(A, layer);
        pg8::gemm_phase(lds, D, E, wv);
    }
    xcd_barrier(gbar, wv);
}

__global__ void __launch_bounds__(NTHREADS, 2) fwd_megakernel(Args A) {
    extern __shared__ __attribute__((aligned(16))) unsigned char lds_raw[];
    LAS unsigned char* lds = (LAS unsigned char*)lds_raw;
    cg::grid_group grid = cg::this_grid();
    const int wv = __builtin_amdgcn_readfirstlane(threadIdx.x >> 6);
    volatile LAS unsigned* bst = (volatile LAS unsigned*)(lds + 152576);
    if (otid(wv) < 2) bst[otid(wv)] = 0u;
    __syncthreads();
    const XcdBarrier gbar = xcd_barrier_post((unsigned*)(A.ws + WS_BAR), bst, wv);
    prep_phase(A, lds, wv);
    grid.sync();
    {
        const long long* mi = (const long long*)(A.ws + WS_MODI); float* mf = (float*)(A.ws + WS_MOD);
        for (int i = blockIdx.x * NTHREADS + otid(wv); i < 4 * 17 * MOD_LD; i += gridDim.x * NTHREADS) mf[i] = (float)mi[i] * MODI_INV;
    }
    xcd_barrier(gbar, wv);
    fnet_layer(A, lds, gbar, 0, 0, false, wv);
    mlstm_layer(A, lds, gbar, 1, wv);
    attn_layer(A, lds, (char*)lds_raw, gbar, 2, wv);
    fnet_layer(A, lds, gbar, 3, 1, true, wv);
    final_norm_phase(A, (const bf16_t*)(A.ws + WS_SCR + F_PQX), wv);
}

extern "C" void kernel_launch(void* const* d_in, const int* in_sizes, int n_in, void* d_out, int out_size, void* d_ws, size_t ws_size, hipStream_t stream) {
    static int grid = 0;
    if (grid == 0) {
        if (n_in != 18 || ws_size < WS_END) { fprintf(stderr, "kernel_launch: unexpected n_in %d / ws_size %zu (need %zu)\n", n_in, ws_size, (size_t)WS_END); grid = -1; return; }
        int dev = 0, cus = 0, per_cu = 0;
        hipGetDevice(&dev);
        hipDeviceGetAttribute(&cus, hipDeviceAttributeMultiprocessorCount, dev);
        if (hipFuncSetAttribute((const void*)fwd_megakernel, hipFuncAttributeMaxDynamicSharedMemorySize, LDS_BYTES) != hipSuccess) { fprintf(stderr, "kernel_launch: hipFuncSetAttribute failed\n"); grid = -1; return; }
        if (hipOccupancyMaxActiveBlocksPerMultiprocessor(&per_cu, (const void*)fwd_megakernel, NTHREADS, LDS_BYTES) != hipSuccess || per_cu < 1) { fprintf(stderr, "kernel_launch: occupancy query failed (%d)\n", per_cu); per_cu = 1; }
        (void)hipGetLastError();
        grid = cus * per_cu;
        fprintf(stderr, "kernel_launch: grid %d (cus %d x %d)\n", grid, cus, per_cu);
    }
    if (grid < 0) return;
    (void)hipMemsetAsync((char*)d_ws + WS_MOD, 0, ZERO_BYTES, stream);
    (void)hipMemsetAsync((char*)d_ws + WS_MODI, 0, MODI_BYTES, stream);
    Args a{};
    for (int i = 0; i < 18; ++i) a.in[i] = (const float*)d_in[i];
    a.out = (float*)d_out; a.ws = (unsigned char*)d_ws; a.ph_lo = 0; a.ph_hi = 100;
    void* args[] = {&a};
    hipError_t e = hipLaunchCooperativeKernel((const void*)fwd_megakernel, dim3(grid), dim3(NTHREADS), args, LDS_BYTES, stream);
    if (e != hipSuccess) fprintf(stderr, "kernel_launch: cooperative launch failed: %s (grid %d)\n", hipGetErrorString(e), grid);
}
```

```cpp
#include <hip/hip_runtime.h>
#include <hip/hip_cooperative_groups.h>
#include <cstdio>
#include <cstdint>
#include <type_traits>
namespace cg = cooperative_groups;

#define LAS __attribute__((address_space(3)))
#define DI __device__ __forceinline__
typedef unsigned short bf16_t;
typedef short bf16x8 __attribute__((ext_vector_type(8)));
typedef short s16x4 __attribute__((ext_vector_type(4)));
typedef float f32x2 __attribute__((ext_vector_type(2)));
typedef float f32x4 __attribute__((ext_vector_type(4)));
typedef float f32x16 __attribute__((ext_vector_type(16)));
typedef unsigned u32x2 __attribute__((ext_vector_type(2)));
typedef unsigned u32x4 __attribute__((ext_vector_type(4)));
typedef __bf16 bf16v2 __attribute__((ext_vector_type(2)));

constexpr int DM = 2048, NB = 16, TL = 2048, TC = 256, TB = TL + TC, NTOK = NB * TB;
constexpr int NWAVES = 8, NTHREADS = 512;
constexpr float EPS = 1e-6f;
constexpr int MOD_LD = 3 * DM;
constexpr int M_WA_ROWS = 6400, M_WB_ROWS = 3072;
constexpr size_t MiB = 1u << 20;
constexpr size_t WS_SCR_ = 301 * MiB;
constexpr size_t WS_MOD = 0;
constexpr size_t MOD_BYTES = (size_t)4 * 17 * MOD_LD * 4;
constexpr size_t WS_BAR = 1792 * 1024, ZERO_BYTES = 2 * MiB;
constexpr size_t WS_MODI = WS_SCR_ + 700 * MiB, MODI_BYTES = (size_t)4 * 17 * MOD_LD * 8;
constexpr float MODI_SCALE = 1073741824.f, MODI_INV = 9.313225746154785e-10f;
constexpr size_t WS_WFG = 2 * MiB, WS_WFO = 18 * MiB, WS_WMA = 34 * MiB, WS_WMB = 59 * MiB, WS_WMO = 71 * MiB, WS_WAI = 79 * MiB, WS_WAO = 99 * MiB;
constexpr size_t WS_DC = 107 * MiB, WS_DT = 108 * MiB, WS_DT2 = 124 * MiB, WS_CTXS = 125 * MiB, WS_H = 157 * MiB, WS_SCR = 301 * MiB;
constexpr size_t WS_END = 1024 * MiB;
constexpr size_t F_G = 0, F_PQX = 144 * MiB, F_PQC = 400 * MiB, F_A1 = 432 * MiB;
constexpr size_t M_Q = 0, M_K = 72 * MiB, M_KVT = 144 * MiB, M_G32 = 360 * MiB, M_HF = 365 * MiB, M_HB = 509 * MiB, M_SO = 0, M_SZ = 144 * MiB;
constexpr size_t A_Q = 0, A_K = 144 * MiB, A_V = 180 * MiB, A_SZ = 216 * MiB;
static_assert(WS_SCR + M_HB + 144 * MiB <= WS_END, "ws map");
constexpr int LDS_BYTES = 152576 + 1024;

DI unsigned pk2(float a, float b) { f32x2 v = {a, b}; return __builtin_bit_cast(unsigned, __builtin_convertvector(v, bf16v2)); }
DI float bf_lo(unsigned w) { return __uint_as_float(w << 16); }
DI float bf_hi(unsigned w) { return __uint_as_float(w & 0xffff0000u); }
DI float wave_sum(float v) {
#pragma unroll
    for (int o = 1; o < 64; o <<= 1) v += __shfl_xor(v, o);
    return v;
}
DI int otid(int wv) { int t; asm volatile("v_mbcnt_lo_u32_b32 %0, -1, 0\n\tv_mbcnt_hi_u32_b32 %0, -1, %0" : "=v"(t)); return wv * 64 + t; }
DI float dot2g(unsigned a, unsigned b, float c) { asm("v_dot2c_f32_bf16 %0, %1, %2" : "+v"(c) : "v"(a), "v"(b)); return c; }
DI float siluf(float x) { return x * __builtin_amdgcn_rcpf(1.f + __expf(-x)); }
DI float sigmf(float x) { return __builtin_amdgcn_rcpf(1.f + __expf(-x)); }
DI void st_bf16x8(bf16_t* p, f32x4 a, f32x4 b) { u32x4 w = {pk2(a[0], a[1]), pk2(a[2], a[3]), pk2(b[0], b[1]), pk2(b[2], b[3])}; *(u32x4*)p = w; }
DI void ld_bf16x8(const bf16_t* p, f32x4& a, f32x4& b) { const u32x4 w = *(const u32x4*)p; a = (f32x4){bf_lo(w.x), bf_hi(w.x), bf_lo(w.y), bf_hi(w.y)}; b = (f32x4){bf_lo(w.z), bf_hi(w.z), bf_lo(w.w), bf_hi(w.w)}; }

DI f32x4 ldmod4(const long long* p) { return (f32x4){(float)p[0] * MODI_INV, (float)p[1] * MODI_INV, (float)p[2] * MODI_INV, (float)p[3] * MODI_INV}; }

struct Args { const float* in[18]; float* out; unsigned char* ws; int ph_lo, ph_hi; };

#define XB_TMO      128
#define XB_XCNT(j)  (256  + 64 * (j))
#define XB_XSUB(j)  (1280 + 64 * (j))
#define XB_XGEN(j)  (2304 + 64 * (j))
#define XB_TOP      3328
#define XB_TOPGEN   3392
#define XCD_BAR_WORDS 3456
#define XB_SPIN_CAP (1u << 18)

__device__ __forceinline__ unsigned xb_ld(unsigned* p)              { return __hip_atomic_load(p, __ATOMIC_RELAXED, __HIP_MEMORY_SCOPE_AGENT); }
__device__ __forceinline__ unsigned xb_add(unsigned* p, unsigned v) { return __hip_atomic_fetch_add(p, v, __ATOMIC_RELAXED, __HIP_MEMORY_SCOPE_AGENT); }
__device__ __forceinline__ unsigned xb_xcc_id() { return (unsigned)__builtin_amdgcn_s_getreg((3 << 11) | 20) & 0xFu; }
#define XB_SPIN(cond, bar) do { unsigned _sp = 0; while (cond) { __builtin_amdgcn_s_sleep(1); \
    if ((++_sp & 255u) == 0u) { if (xb_ld(&(bar)[XB_TMO])) break; if (_sp > XB_SPIN_CAP) { atomicAdd(&(bar)[XB_TMO], 1u); break; } } } } while (0)

struct XcdBarrier {
    unsigned* bar; unsigned x;
    volatile LAS unsigned* st;
};

__device__ __forceinline__ XcdBarrier xcd_barrier_post(unsigned* bar, volatile LAS unsigned* st, int wv) {
    XcdBarrier b; b.bar = bar; b.x = xb_xcc_id(); b.st = st;
    if (otid(wv) == 0) (void)xb_add(&bar[XB_XCNT(b.x)], 1u);
    return b;
}
__device__ __forceinline__ void xcd_barrier_complete(unsigned* bar, unsigned x, unsigned& nloc, unsigned& nx) {
    const unsigned G = gridDim.x * gridDim.y * gridDim.z;
    unsigned sum, cnt, mine, sp = 0u;
    for (;;) {
        sum = 0u; cnt = 0u; mine = 0u;
#pragma unroll
        for (unsigned j = 0; j < 16; ++j) { const unsigned c = xb_ld(&bar[XB_XCNT(j)]); sum += c; cnt += (c > 0u) ? 1u : 0u; mine = (j == x) ? c : mine; }
        if (sum == G) break;
        __builtin_amdgcn_s_sleep(1);
        if ((++sp & 255u) == 0u) { if (xb_ld(&bar[XB_TMO])) break; if (sp > XB_SPIN_CAP) { atomicAdd(&bar[XB_TMO], 1u); break; } }
    }
    nloc = mine > 0u ? mine : 1u; nx = cnt > 0u ? cnt : 1u;
}

__device__ __forceinline__ void xcd_barrier(const XcdBarrier& b, int wv) {
    asm volatile("s_waitcnt vmcnt(0)" ::: "memory");
    __syncthreads();
    if (otid(wv) == 0) {
        unsigned* bar = b.bar;
        __builtin_amdgcn_s_waitcnt(0);
        unsigned nloc = b.st[0], nx = b.st[1];
        if (nloc == 0u) { xcd_barrier_complete(bar, b.x, nloc, nx); b.st[0] = nloc; b.st[1] = nx; }
        const unsigned old = xb_add(&bar[XB_XSUB(b.x)], 1u);
        const unsigned gen = old / nloc;
        if (old + 1u == (gen + 1u) * nloc) {
            __builtin_amdgcn_fence(__ATOMIC_RELEASE, "agent");
            asm volatile("s_waitcnt vmcnt(0)" ::: "memory");
            const unsigned og = xb_add(&bar[XB_TOP], 1u);
            const unsigned tg = og / nx;
            if (og + 1u == (tg + 1u) * nx) xb_add(&bar[XB_TOPGEN], 1u);
            else XB_SPIN(xb_ld(&bar[XB_TOPGEN]) == tg, bar);
            __builtin_amdgcn_fence(__ATOMIC_ACQUIRE, "agent");
            xb_add(&bar[XB_XGEN(b.x)], 1u);
            asm volatile("s_waitcnt vmcnt(0)" ::: "memory");
        } else {
            XB_SPIN(xb_ld(&bar[XB_XGEN(b.x)]) == gen, bar);
            __builtin_amdgcn_fence(__ATOMIC_ACQUIRE, "agent");
            asm volatile("s_waitcnt vmcnt(0)" ::: "memory");
        }
    }
    __syncthreads();
}


namespace pg8 {
constexpr int BM = 256, BK = 64, HALF = 128, HTB = HALF * BK * 2, NXCD = 8;
DI int lds_byte(int r, int c) { const int st = (r >> 4) * 2 + (c >> 5), rr = r & 15, cc = c & 31, ob = rr * 64 + cc * 2; return st * 1024 + (ob ^ (((ob >> 9) & 1) << 5)); }
DI void stage_rc(int b, int& R, int& C) { const int st = b / 1024, sb = b % 1024, swz = sb ^ (((sb >> 9) & 1) << 5); R = (st >> 1) * 16 + swz / 64; C = (st & 1) * 32 + (swz % 64) / 2; }
DI int perm32(int rho) { const int n = rho >> 4, i = rho & 15; return 8 * (i >> 2) + 4 * n + (i & 3); }
struct Unit { const char* a; const char* b; int i0, i1, i2; };
template <class T, class = void> struct is_whole_tile : std::false_type {};
template <class T> struct is_whole_tile<T, std::void_t<decltype(T::WHOLE_TILE)>> : std::true_type {};
DI int xcd_remap(int L, int total) { const int q = total / NXCD, r = total % NXCD, xcd = L % NXCD, off = L / NXCD; return (xcd < r ? xcd * (q + 1) : r * (q + 1) + (xcd - r) * q) + off; }

template <class Desc, class Epi>
DI void gemm_phase(LAS unsigned char* lds, const Desc& D, const Epi& E, int wv) {
    const int tid = otid(wv), wid = __builtin_amdgcn_readfirstlane(tid >> 6), lane = tid & 63, wr = wid >> 2, wc = wid & 3, fr = lane & 15, fq = lane >> 4;
    const int G = gridDim.x, c = blockIdx.x, total = D.total;
    const int K = D.K, nt = K / BK;
    unsigned voffA[2], voffB[2];
#pragma unroll
    for (int i = 0; i < 2; ++i) { int R, C; stage_rc(tid * 16 + i * 8192, R, C); const int Rb = (R & ~31) + perm32(R & 31);
        voffA[i] = (unsigned)(R * D.lda + C) * 2u; voffB[i] = (unsigned)(Rb * D.ldb + C) * 2u; }
    const size_t kstep = (size_t)(BK * 2);
    const size_t hstepA = (size_t)HALF * D.lda * 2, hstepB = (size_t)HALF * D.ldb * 2;
    const unsigned ldsw = (unsigned)wid * 1024u;
    const int aoff = lds_byte(wr * 64 + fr, fq * 8), boff = lds_byte(wc * 32 + fr, fq * 8);
#define PG8_SA(b, h) (((b) * 2 + (h)) * HTB)
#define PG8_SB(b, h) ((4 + (b) * 2 + (h)) * HTB)
#define PG8_STAGE(bufoff, gbase, voff) do { _Pragma("unroll") for (int _i = 0; _i < 2; ++_i) \
        __builtin_amdgcn_global_load_lds((const unsigned*)((const char*)(gbase) + (voff)[_i]), (LAS unsigned*)(lds + (bufoff) + ldsw + _i * 8192), 16, 0, 0); } while (0)
#define PG8_LDA(dst, b, h) do { _Pragma("unroll") for (int m = 0; m < 4; ++m) _Pragma("unroll") for (int k = 0; k < 2; ++k) dst[m][k] = *(const LAS bf16x8*)(lds + PG8_SA(b, h) + aoff + m * 2048 + k * 1024); } while (0)
#define PG8_LDB(dst, b, h) do { _Pragma("unroll") for (int n = 0; n < 2; ++n) _Pragma("unroll") for (int k = 0; k < 2; ++k) dst[n][k] = *(const LAS bf16x8*)(lds + PG8_SB(b, h) + boff + n * 2048 + k * 1024); } while (0)
#define PG8_MMA(ai, bj, At, Bt) do { __builtin_amdgcn_s_setprio(1); _Pragma("unroll") for (int m = 0; m < 4; ++m) _Pragma("unroll") for (int n = 0; n < 2; ++n) _Pragma("unroll") for (int k = 0; k < 2; ++k) \
        acc[ai][bj][m][n] = __builtin_amdgcn_mfma_f32_16x16x32_bf16(Bt[n][k], At[m][k], acc[ai][bj][m][n], 0, 0, 0); __builtin_amdgcn_s_setprio(0); } while (0)
#define PG8_WAIT_V(n) asm volatile("s_waitcnt vmcnt(" #n ")" ::: "memory")
#define PG8_WAIT_L(n) asm volatile("s_waitcnt lgkmcnt(" #n ")" ::: "memory")
#define PG8_BAR __builtin_amdgcn_s_barrier()
#define PG8_SCHED __builtin_amdgcn_sched_barrier(0)
    if constexpr (Desc::RAW) { if (!D.valid(c, G)) return; } else { if (c >= total) return; }
    Unit cur, nxt; int ui = 0;
    if constexpr (Desc::RAW) cur = D.unit(c, G); else cur = D.unit(xcd_remap(c, total));
    nxt = cur;
    f32x4 acc[2][2][4][2];
#pragma unroll
    for (int a = 0; a < 2; ++a)
#pragma unroll
        for (int b = 0; b < 2; ++b)
#pragma unroll
            for (int m = 0; m < 4; ++m)
#pragma unroll
                for (int n = 0; n < 2; ++n) acc[a][b][m][n] = (f32x4){0.f, 0.f, 0.f, 0.f};
    bf16x8 At[4][2], B0[2][2], B1[2][2];
    const char* cA = cur.a; const char* cB = cur.b;
    PG8_STAGE(PG8_SB(0, 0), cB, voffB); PG8_STAGE(PG8_SB(0, 1), cB + hstepB, voffB); PG8_STAGE(PG8_SA(0, 0), cA, voffA); PG8_STAGE(PG8_SA(0, 1), cA + hstepA, voffA);
    if (wr == 1) PG8_BAR;
    PG8_WAIT_V(2); PG8_BAR;
    PG8_STAGE(PG8_SB(1, 0), cB + kstep, voffB); PG8_STAGE(PG8_SA(1, 0), cA + kstep, voffA); PG8_STAGE(PG8_SB(1, 1), cB + hstepB + kstep, voffB);
    PG8_WAIT_V(6); PG8_BAR;
    for (;;) {
        const long Ln = (long)(ui + 1) * G + c;
        bool has_next;
        if constexpr (Desc::RAW) { has_next = D.valid((int)Ln, G); if (has_next) nxt = D.unit((int)Ln, G); }
        else { has_next = Ln < total; if (has_next) nxt = D.unit(xcd_remap((int)Ln, total)); }
        const char* nA = has_next ? nxt.a : cA; const char* nB = has_next ? nxt.b : cB;
        for (int t = 0; t < nt; t += 2) {
            const bool last = (t == nt - 2);
            const char* a1 = cA + (size_t)(t + 1) * kstep;
            const char* a2 = last ? nA : cA + (size_t)(t + 2) * kstep; const char* b2 = last ? nB : cB + (size_t)(t + 2) * kstep;
            const char* a3 = a2 + kstep; const char* b3 = b2 + kstep;
            PG8_LDB(B0, 0, 0); PG8_LDB(B1, 0, 1); PG8_SCHED; PG8_LDA(At, 0, 0); PG8_STAGE(PG8_SA(1, 1), a1 + hstepA, voffA);
            PG8_WAIT_V(8); PG8_WAIT_L(0); PG8_BAR; PG8_MMA(0, 0, At, B0); PG8_MMA(0, 1, At, B1); PG8_BAR; PG8_SCHED;
            PG8_LDA(At, 0, 1); PG8_STAGE(PG8_SB(0, 0), b2, voffB); PG8_STAGE(PG8_SB(0, 1), b2 + hstepB, voffB); PG8_STAGE(PG8_SA(0, 0), a2, voffA);
            PG8_WAIT_V(8); PG8_WAIT_L(0); PG8_BAR; PG8_MMA(1, 0, At, B0); PG8_MMA(1, 1, At, B1); PG8_BAR; PG8_SCHED;
            PG8_LDB(B0, 1, 0); PG8_LDB(B1, 1, 1); PG8_SCHED; PG8_LDA(At, 1, 0); PG8_STAGE(PG8_SA(0, 1), a2 + hstepA, voffA);
            PG8_WAIT_V(8); PG8_WAIT_L(0); PG8_BAR; PG8_MMA(0, 0, At, B0); PG8_MMA(0, 1, At, B1); PG8_BAR; PG8_SCHED;
            PG8_LDA(At, 1, 1); PG8_STAGE(PG8_SB(1, 0), b3, voffB); PG8_STAGE(PG8_SB(1, 1), b3 + hstepB, voffB); PG8_STAGE(PG8_SA(1, 0), a3, voffA);
            PG8_WAIT_V(8); PG8_WAIT_L(0); PG8_BAR; PG8_MMA(1, 0, At, B0); PG8_MMA(1, 1, At, B1); PG8_BAR; PG8_SCHED;
        }
        if (wr == 0) PG8_BAR;
        {
            const int le = otid(wv) & 63, fre = le & 15, fqe = le >> 4;
            if constexpr (is_whole_tile<Epi>::value) E.run(cur, acc, wr, wc, fre, fqe); else
#pragma unroll
            for (int ai = 0; ai < 2; ++ai)
#pragma unroll
                for (int m = 0; m < 4; ++m)
#pragma unroll
                    for (int bj = 0; bj < 2; ++bj)
                        E(cur, ai * HALF + wr * 64 + m * 16 + fre, bj * HALF + wc * 32 + 8 * fqe, acc[ai][bj][m][0], acc[ai][bj][m][1]);
        }
        if (!has_next) break;
#pragma unroll
        for (int a = 0; a < 2; ++a)
#pragma unroll
            for (int b = 0; b < 2; ++b)
#pragma unroll
                for (int m = 0; m < 4; ++m)
#pragma unroll
                    for (int n = 0; n < 2; ++n) acc[a][b][m][n] = (f32x4){0.f, 0.f, 0.f, 0.f};
        cur = nxt; cA = nA; cB = nB; ++ui;
        if (wr == 1) PG8_BAR;
    }
    PG8_WAIT_V(0);
    PG8_BAR;
#undef PG8_SA
#undef PG8_SB
#undef PG8_STAGE
#undef PG8_LDA
#undef PG8_LDB
#undef PG8_MMA
#undef PG8_WAIT_V
#undef PG8_WAIT_L
#undef PG8_BAR
#undef PG8_SCHED
}
}

DI void transpose_item(const float* W, int N, int kb, int nb, bf16_t* d0, bf16_t* d1, int K, LAS float* scr, int lane) {
    const int k0 = 64 * kb, n0 = 32 * nb;
#pragma unroll 8
    for (int i = 0; i < 32; ++i) { const int kk = 2 * i + (lane >> 5); scr[kk * 33 + (lane & 31)] = W[(size_t)(k0 + kk) * N + n0 + (lane & 31)]; }
    asm volatile("s_waitcnt lgkmcnt(0)" ::: "memory");
    const int c = lane & 7;
#pragma unroll
    for (int j = 0; j < 4; ++j) { const int n = (lane >> 3) + 8 * j; const LAS float* s = scr + (8 * c) * 33 + n;
        u32x4 o; o.x = pk2(s[0 * 33], s[1 * 33]); o.y = pk2(s[2 * 33], s[3 * 33]); o.z = pk2(s[4 * 33], s[5 * 33]); o.w = pk2(s[6 * 33], s[7 * 33]);
        *(u32x4*)(d0 + (size_t)n * K + k0 + 8 * c) = o;
        if (d1) *(u32x4*)(d1 + (size_t)n * K + k0 + 8 * c) = o; }
    asm volatile("s_waitcnt lgkmcnt(0)" ::: "memory");
}

DI void prep_phase(const Args& A, LAS unsigned char* lds, int wv) {
    const int tid = otid(wv), lane = tid & 63, wave = tid >> 6, G = gridDim.x;
    unsigned char* ws = A.ws;
    {
        LAS float* s_lds = (LAS float*)lds;
        const float* cc = A.in[1]; const float* cctx = A.in[3]; const float* aw = A.in[4]; const float* ab = A.in[5];
        long long* modi = (long long*)(ws + WS_MODI);
        for (int item = blockIdx.x; item < 768; item += G) {
            const int kc = item % 16, cb = (item / 16) % 12, l = item / 192;
            const int k0 = kc * 128, j = cb * 512 + tid;
            __syncthreads();
            for (int e = tid; e < 17 * 128; e += NTHREADS) { const int r = e / 128, k = e % 128; const float v = r < 16 ? cc[r * DM + k0 + k] : cctx[k0 + k]; s_lds[k * 20 + r] = siluf(v); }
            __syncthreads();
            float acc[17];
#pragma unroll
            for (int r = 0; r < 17; ++r) acc[r] = 0.f;
            const float* wp = aw + ((size_t)l * DM + k0) * MOD_LD + j;
#pragma unroll 4
            for (int k = 0; k < 128; ++k) {
                const float w = wp[(size_t)k * MOD_LD];
                const LAS f32x4* sp = (const LAS f32x4*)(s_lds + k * 20);
                const f32x4 s0 = sp[0], s1 = sp[1], s2 = sp[2], s3 = sp[3]; const float s4 = s_lds[k * 20 + 16];
#pragma unroll
                for (int q = 0; q < 4; ++q) { acc[q] += s0[q] * w; acc[4 + q] += s1[q] * w; acc[8 + q] += s2[q] * w; acc[12 + q] += s3[q] * w; }
                acc[16] += s4 * w;
            }
            const float bias = (kc == 0) ? ab[l * MOD_LD + j] : 0.f;
#pragma unroll
            for (int r = 0; r < 17; ++r) atomicAdd((unsigned long long*)&modi[(size_t)(l * 17 + r) * MOD_LD + j], (unsigned long long)__float2ll_rn((acc[r] + bias) * MODI_SCALE));
        }
        __syncthreads();
    }
    {
        LAS float* scr = (LAS float*)(lds + wave * 16384);
        const int gw = blockIdx.x * NWAVES + wave, NGW = G * NWAVES;
        constexpr int I_SQ = 32 * 64, I_AI = 32 * 160, I_MI = 32 * 257;
        constexpr int NIT = 6 * I_SQ + I_AI + I_MI;
        for (int it = gw; it < NIT; it += NGW) {
            int r = it;
            if (r < 6 * I_SQ) {
                const int w = r / I_SQ; r -= w * I_SQ;
                const float* src; bf16_t* dst;
                if (w < 2)      { src = A.in[7] + (size_t)w * DM * DM;       dst = (bf16_t*)(ws + WS_WFG) + (size_t)w * DM * DM; }
                else if (w < 4) { src = A.in[8] + (size_t)(w - 2) * DM * DM; dst = (bf16_t*)(ws + WS_WFO) + (size_t)(w - 2) * DM * DM; }
                else if (w == 4) { src = A.in[12]; dst = (bf16_t*)(ws + WS_WMO); }
                else             { src = A.in[16]; dst = (bf16_t*)(ws + WS_WAO); }
                const int kb = r / 64, nb = r % 64;
                transpose_item(src, DM, kb, nb, dst + (size_t)(32 * nb) * DM, nullptr, DM, scr, lane);
                continue;
            }
            r -= 6 * I_SQ;
            if (r < I_AI) { const int kb = r / 160, nb = r % 160; transpose_item(A.in[13], 5120, kb, nb, (bf16_t*)(ws + WS_WAI) + (size_t)(32 * nb) * DM, nullptr, DM, scr, lane); continue; }
            r -= I_AI;
            {
                const int kb = r / 257, nb = r % 257, n0 = 32 * nb;
                bf16_t* WA = (bf16_t*)(ws + WS_WMA); bf16_t* WB = (bf16_t*)(ws + WS_WMB);
                bf16_t* d0; bf16_t* d1 = nullptr;
                if (n0 < 1024) d0 = WA + (size_t)n0 * DM;
                else if (n0 < 2048) d0 = WA + (size_t)n0 * DM;
                else if (n0 < 4096) d0 = WB + (size_t)(n0 - 2048) * DM;
                else if (n0 < 6144) d0 = WA + (size_t)(2304 + n0 - 4096) * DM;
                else if (n0 < 6176) d0 = WA + (size_t)(2048 + n0 - 6144) * DM;
                else d0 = WA + (size_t)(4352 + n0 - 6176) * DM;
                transpose_item(A.in[9], 8224, kb, nb, d0, d1, DM, scr, lane);
            }
        }
    }
    {
        const long gt = (long)blockIdx.x * NTHREADS + tid, NGT = (long)G * NTHREADS;
        constexpr long N_DC = 512L * 512 / 8, N_DT = 2048L * 4096 / 8, N_DT2 = 256L * 512 / 8;
        for (long it = gt; it < N_DC + N_DT + N_DT2; it += NGT) {
            float v[8]; bf16_t* dst;
            if (it < N_DC) {
                const int m = (int)(it / 64), k0 = (int)(it % 64) * 8; const float sc = 0.044194173824159216f;
#pragma unroll
                for (int j = 0; j < 8; ++j) { const int mm = (m <= 256) ? m : m - 256; const int rr = (mm * (k0 + j)) & 511; const float ang = (float)rr * (1.f / 256.f); v[j] = (m <= 256 ? cospif(ang) : sinpif(ang)) * sc; }
                dst = (bf16_t*)(ws + WS_DC) + (size_t)m * 512 + k0;
            } else if (it < N_DC + N_DT) {
                const long i2 = it - N_DC; const int kk = (int)(i2 / 512), s0 = (int)(i2 % 512) * 8; const float sc = 0.022097086912079608f;
#pragma unroll
                for (int j = 0; j < 8; ++j) { const int s = s0 + j; const int rr = (kk * (s & 2047)) & 2047; const float ang = (float)rr * (1.f / 1024.f); v[j] = (s < 2048 ? cospif(ang) : -sinpif(ang)) * sc; }
                dst = (bf16_t*)(ws + WS_DT) + (size_t)kk * 4096 + s0;
            } else {
                const long i2 = it - N_DC - N_DT; const int kk = (int)(i2 / 64), s0 = (int)(i2 % 64) * 8; const float sc = 0.0625f;
#pragma unroll
                for (int j = 0; j < 8; ++j) { const int s = s0 + j; const int rr = (kk * (s & 255)) & 255; const float ang = (float)rr * (1.f / 128.f); v[j] = (s < 256 ? cospif(ang) : -sinpif(ang)) * sc; }
                dst = (bf16_t*)(ws + WS_DT2) + (size_t)kk * 512 + s0;
            }
            u32x4 o = {pk2(v[0], v[1]), pk2(v[2], v[3]), pk2(v[4], v[5]), pk2(v[6], v[7])};
            *(u32x4*)dst = o;
        }
    }
}

DI const float* xrow_in(const Args& A, int r) {
    const int b = r / TB, t = r % TB;
    if (t < TL) return A.in[0] + ((size_t)b * TL + t) * DM;
    return A.in[2] + ((size_t)b * TC + (t - TL)) * DM;
}
DI void norm_phase(const Args& A, int layer, bool latonly, int wv) {
    const int tid = otid(wv), lane = tid & 63, wave = tid >> 6, G = gridDim.x;
    const float* ng = A.in[6] + (size_t)layer * DM;
    const float* mod = (const float*)(A.ws + WS_MOD) + (size_t)layer * 17 * MOD_LD;
    bf16_t* H = (bf16_t*)(A.ws + WS_H);
    const bf16_t* XB = (const bf16_t*)A.out;
    for (int r0 = (blockIdx.x * NWAVES + wave) * 2; r0 < NTOK; r0 += G * NWAVES * 2) {
        const int b = r0 / TB, t = r0 % TB;
        if (latonly && t >= TL) continue;
        const float* mr = mod + (size_t)(t < TL ? b : 16) * MOD_LD;
        f32x4 v[2][4][2];
#pragma unroll
        for (int k = 0; k < 2; ++k) {
            const int r = r0 + k;
            if (layer == 0) {
                const float* xr = xrow_in(A, r);
#pragma unroll
                for (int j = 0; j < 4; ++j) { const f32x4* p = (const f32x4*)(xr + 512 * j + 8 * lane); v[k][j][0] = p[0]; v[k][j][1] = p[1]; }
            } else {
#pragma unroll
                for (int j = 0; j < 4; ++j) ld_bf16x8(XB + (size_t)r * DM + 512 * j + 8 * lane, v[k][j][0], v[k][j][1]);
            }
        }
#pragma unroll
        for (int k = 0; k < 2; ++k) {
            const int r = r0 + k; float ss = 0.f;
#pragma unroll
            for (int j = 0; j < 4; ++j)
#pragma unroll
                for (int q = 0; q < 4; ++q) ss += v[k][j][0][q] * v[k][j][0][q] + v[k][j][1][q] * v[k][j][1][q];
            const float rs = 1.0f / sqrtf(wave_sum(ss) * (1.f / DM) + EPS);
#pragma unroll
            for (int j = 0; j < 4; ++j) { const int c0 = 512 * j + 8 * lane; f32x4 o[2];
#pragma unroll
                for (int h = 0; h < 2; ++h) { const f32x4 g4 = *(const f32x4*)(ng + c0 + 4 * h), sh = *(const f32x4*)(mr + c0 + 4 * h), sc = *(const f32x4*)(mr + DM + c0 + 4 * h);
                    o[h] = (v[k][j][h] * rs) * g4 * (sc + 1.0f) + sh; }
                st_bf16x8(H + (size_t)r * DM + c0, o[0], o[1]); }
        }
    }
}
DI void final_norm_phase(const Args& A, const bf16_t* src, int wv) {
    const int tid = otid(wv), lane = tid & 63, wave = tid >> 6, G = gridDim.x;
    const float* fg = A.in[17];
    for (int r0 = (blockIdx.x * NWAVES + wave) * 2; r0 < NB * TL; r0 += G * NWAVES * 2) {
        f32x4 v[2][4][2];
#pragma unroll
        for (int k = 0; k < 2; ++k)
#pragma unroll
            for (int j = 0; j < 4; ++j) ld_bf16x8(src + (size_t)(r0 + k) * DM + 512 * j + 8 * lane, v[k][j][0], v[k][j][1]);
#pragma unroll
        for (int k = 0; k < 2; ++k) { float* orow = A.out + (size_t)(r0 + k) * DM; float ss = 0.f;
#pragma unroll
            for (int j = 0; j < 4; ++j)
#pragma unroll
                for (int q = 0; q < 4; ++q) ss += v[k][j][0][q] * v[k][j][0][q] + v[k][j][1][q] * v[k][j][1][q];
            const float rs = 1.0f / sqrtf(wave_sum(ss) * (1.f / DM) + EPS);
#pragma unroll
            for (int j = 0; j < 4; ++j) { const int c0 = 512 * j + 8 * lane;
#pragma unroll
                for (int h = 0; h < 2; ++h) { const f32x4 g4 = *(const f32x4*)(fg + c0 + 4 * h); *(f32x4*)(orow + c0 + 4 * h) = (v[k][j][h] * rs) * g4; } }
        }
    }
}

struct DescPlain {
    static constexpr bool RAW = false;
    const bf16_t* A; const bf16_t* B; int nN; bool latonly; int lda, ldb, K, total;
    DI void init(const bf16_t* A_, const bf16_t* B_, int nN_, bool lat) { A = A_; B = B_; nN = nN_; latonly = lat; lda = DM; ldb = DM; K = DM; total = (lat ? 128 : 144) * nN_; }
    DI pg8::Unit unit(int idx) const {
        const int nMt = latonly ? 128 : 144, nig = 8 * nN, gid = idx / nig, fm = gid * 8, gsz = (nMt - fm) < 8 ? (nMt - fm) : 8;
        const int pmi = fm + (idx % nig) % gsz, pn = (idx % nig) / gsz, pm = latonly ? (pmi / 8) * 9 + (pmi % 8) : pmi;
        pg8::Unit u; u.a = (const char*)(A + (size_t)pm * 256 * DM); u.b = (const char*)(B + (size_t)pn * 256 * DM); u.i0 = pm; u.i1 = pn; u.i2 = 0; return u;
    }
};
struct DescA1 {
    static constexpr bool RAW = false;
    const bf16_t* A; const bf16_t* B; int lda, ldb, K, total;
    DI void init(const bf16_t* A_, const bf16_t* B_) { A = A_; B = B_; lda = DM; ldb = DM; K = DM; total = 128 * 20 + 16 * 4; }
    DI pg8::Unit unit(int idx) const {
        int pm, pn;
        if (idx < 2560) { const int nig = 160, gid = idx / nig, pmi = gid * 8 + (idx % nig) % 8; pn = (idx % nig) / 8; pm = (pmi / 8) * 9 + (pmi % 8); }
        else { const int j = idx - 2560; pm = (j / 4) * 9 + 8; pn = 8 + (j % 4); }
        pg8::Unit u; u.a = (const char*)(A + (size_t)pm * 256 * DM); u.b = (const char*)(B + (size_t)pn * 256 * DM); u.i0 = pm; u.i1 = pn; u.i2 = 0; return u;
    }
};
struct DescChan {
    static constexpr bool RAW = false;
    const bf16_t* DC; const bf16_t* H; int lda, ldb, K, total;
    DI void init(const bf16_t* DC_, const bf16_t* H_, bool lat) { DC = DC_; H = H_; lda = 512; ldb = DM; K = 512; total = lat ? 1024 : 1152; }
    DI pg8::Unit unit(int idx) const {
        pg8::Unit u; int b, g, mt, nt, toff;
        if (idx < 1024) { mt = idx % 2; nt = (idx / 2) % 8; g = (idx / 16) % 4; b = idx / 64; toff = nt * 256; u.i2 = nt; }
        else { const int j = idx - 1024; mt = j % 2; g = (j / 2) % 4; b = j / 8; toff = TL; u.i2 = 8; }
        u.a = (const char*)(DC + (size_t)mt * 256 * 512); u.b = (const char*)(H + ((size_t)b * TB + toff) * DM + g * 512); u.i0 = b * 4 + g; u.i1 = mt; return u;
    }
};
struct DescT {
    static constexpr bool RAW = false;
    const bf16_t* DT; const bf16_t* PQ; int nMt; int lda, ldb, K, total;
    DI void init(const bf16_t* DT_, const bf16_t* PQ_, int ld, int Kd, int coff, int nMt_) { DT = DT_ + coff; PQ = PQ_ + coff; nMt = nMt_; lda = ld; ldb = ld; K = Kd; total = NB * nMt_ * 8; }
    DI pg8::Unit unit(int idx) const {
        const int mt = idx % nMt, nt = (idx / nMt) % 8, b = idx / (nMt * 8);
        pg8::Unit u; u.a = (const char*)(DT + (size_t)mt * 256 * lda); u.b = (const char*)(PQ + ((size_t)b * DM + nt * 256) * ldb); u.i0 = b; u.i1 = mt; u.i2 = nt; return u;
    }
};

struct DescT2 {
    static constexpr bool RAW = true;
    const bf16_t* DT; const bf16_t* PQ; int lda, ldb, K, total;
    DI void init(const bf16_t* DT_, const bf16_t* PQ_) { DT = DT_; PQ = PQ_; lda = 4096; ldb = 4096; K = 2048; total = 2 * NB * 4 * 4; }
    DI bool valid(int L, int G) const { return ((L / G) >> 1) * G + (L % G) < NB * 4 * 4; }
    DI pg8::Unit unit(int L, int G) const {
        const int i = L / G, pair = (i >> 1) * G + (L % G), part = i & 1;
        const int mt = pair % 4, nt = 2 * ((pair / 4) % 4), b = pair / 16, coff = part * 2048;
        pg8::Unit u; u.a = (const char*)(DT + (size_t)mt * 256 * 4096 + coff); u.b = (const char*)(PQ + ((size_t)b * DM + nt * 256) * 4096 + coff); u.i0 = b; u.i1 = mt; u.i2 = part * 8 + nt; return u;
    }
};

struct EpiResid {
    static constexpr bool WHOLE_TILE = true;
    const float* x_in; const float* c_in; bf16_t* XB; bf16_t* X2; const float* modl; int layer;
    DI void init(const Args& A, int layer_) { x_in = A.in[0]; c_in = A.in[2]; XB = (bf16_t*)A.out; X2 = (bf16_t*)(A.ws + WS_SCR + F_PQX); modl = (const float*)(A.ws + WS_MOD) + (size_t)layer_ * 17 * MOD_LD; layer = layer_; }
    DI void run(const pg8::Unit& u, const f32x4 (&acc)[2][2][4][2], int wr, int wc, int fr, int fq) const {
        const int pm = u.i0, b = pm / 9, tt = pm % 9, col0 = u.i1 * 256 + wc * 32 + 8 * fq;
        f32x4 g[2][2];
#pragma unroll
        for (int bj = 0; bj < 2; ++bj) { const float* gp = modl + (size_t)(tt < 8 ? b : 16) * MOD_LD + 2 * DM + col0 + bj * 128; g[bj][0] = *(const f32x4*)gp; g[bj][1] = *(const f32x4*)(gp + 4); }
        if (layer != 0) {
            u32x4 xq[2][4][2];
#pragma unroll
            for (int ai = 0; ai < 2; ++ai)
#pragma unroll
                for (int m = 0; m < 4; ++m)
#pragma unroll
                    for (int bj = 0; bj < 2; ++bj) xq[ai][m][bj] = *(const u32x4*)(XB + ((size_t)pm * 256 + ai * 128 + wr * 64 + m * 16 + fr) * DM + col0 + bj * 128);
#pragma unroll
            for (int ai = 0; ai < 2; ++ai)
#pragma unroll
                for (int m = 0; m < 4; ++m)
#pragma unroll
                    for (int bj = 0; bj < 2; ++bj) {
                        const int row_l = ai * 128 + wr * 64 + m * 16 + fr; const u32x4 w = xq[ai][m][bj];
                        const f32x4 x0 = (f32x4){bf_lo(w.x), bf_hi(w.x), bf_lo(w.y), bf_hi(w.y)} + g[bj][0] * acc[ai][bj][m][0];
                        const f32x4 x1 = (f32x4){bf_lo(w.z), bf_hi(w.z), bf_lo(w.w), bf_hi(w.w)} + g[bj][1] * acc[ai][bj][m][1];
                        if (layer == 3) st_bf16x8(X2 + ((size_t)b * TL + tt * 256 + row_l) * DM + col0 + bj * 128, x0, x1);
                        else st_bf16x8(XB + ((size_t)pm * 256 + row_l) * DM + col0 + bj * 128, x0, x1);
                    }
        } else {
#pragma unroll
            for (int ai = 0; ai < 2; ++ai) {
                f32x4 xf[4][2][2];
#pragma unroll
                for (int m = 0; m < 4; ++m)
#pragma unroll
                    for (int bj = 0; bj < 2; ++bj) { const int row_l = ai * 128 + wr * 64 + m * 16 + fr;
                        const float* src = (tt < 8) ? x_in + ((size_t)b * TL + tt * 256 + row_l) * DM + col0 + bj * 128 : c_in + ((size_t)b * TC + row_l) * DM + col0 + bj * 128;
                        xf[m][bj][0] = *(const f32x4*)src; xf[m][bj][1] = *(const f32x4*)(src + 4); }
#pragma unroll
                for (int m = 0; m < 4; ++m)
#pragma unroll
                    for (int bj = 0; bj < 2; ++bj) { const int row_l = ai * 128 + wr * 64 + m * 16 + fr;
                        st_bf16x8(XB + ((size_t)pm * 256 + row_l) * DM + col0 + bj * 128, xf[m][bj][0] + g[bj][0] * acc[ai][bj][m][0], xf[m][bj][1] + g[bj][1] * acc[ai][bj][m][1]); }
            }
        }
    }
};

DI void fnet_layer(const Args& A, LAS unsigned char* lds, const XcdBarrier& gbar, int layer, int j, bool latonly, int wv) {
    unsigned char* ws = A.ws;
    const bf16_t* H = (const bf16_t*)(ws + WS_H); bf16_t* U = (bf16_t*)(ws + WS_H);
    bf16_t* Gt = (bf16_t*)(ws + WS_SCR + F_G); bf16_t* PQX = (bf16_t*)(ws + WS_SCR + F_PQX); bf16_t* PQC = (bf16_t*)(ws + WS_SCR + F_PQC);
    norm_phase(A, layer, latonly, wv);
    xcd_barrier(gbar, wv);
    {
        DescPlain D; D.init(H, (const bf16_t*)(ws + WS_WFG) + (size_t)j * DM * DM, 8, latonly);
        auto E = [=](const pg8::Unit& u, int row_l, int col_l, f32x4 v0, f32x4 v1) {
            f32x4 a, b;
#pragma unroll
            for (int q = 0; q < 4; ++q) { a[q] = siluf(v0[q]); b[q] = siluf(v1[q]); }
            st_bf16x8(Gt + ((size_t)u.i0 * 256 + row_l) * DM + u.i1 * 256 + col_l, a, b);
        };
        pg8::gemm_phase(lds, D, E, wv);
    }
    {
        DescChan D; D.init((const bf16_t*)(ws + WS_DC), H, latonly);
        auto E = [=](const pg8::Unit& u, int row_l, int col_l, f32x4 v0, f32x4 v1) {
            const int b = u.i0 >> 2, g = u.i0 & 3, m = row_l;
            bf16_t* base; size_t cs; int hs;
            if (u.i2 < 8) { base = PQX + ((size_t)b * DM + g * 512) * 4096 + u.i2 * 256 + col_l; cs = 4096; hs = 2048; }
            else          { base = PQC + ((size_t)b * DM + g * 512) * 512 + col_l; cs = 512; hs = 256; }
            const f32x4 z = {0.f, 0.f, 0.f, 0.f};
            const bool mir = (u.i2 == 8);
            if (u.i1 == 0) { st_bf16x8(base + (size_t)m * cs, v0, v1); if (mir && m != 0) st_bf16x8(base + (size_t)(512 - m) * cs, v0, v1); }
            else if (m == 0) { st_bf16x8(base + (size_t)256 * cs, v0, v1); st_bf16x8(base + hs, z, z); if (mir) st_bf16x8(base + (size_t)256 * cs + hs, z, z); }
            else { st_bf16x8(base + (size_t)m * cs + hs, v0, v1); if (mir) st_bf16x8(base + (size_t)(512 - m) * cs + hs, z - v0, z - v1); }
        };
        pg8::gemm_phase(lds, D, E, wv);
    }
    xcd_barrier(gbar, wv);
    bf16_t* A1 = (bf16_t*)(ws + WS_SCR + F_A1);
    {
        const int tid = otid(wv), lane = tid & 63;
        for (int rr0 = (blockIdx.x * NWAVES + wv) * 4; rr0 < NB * DM; rr0 += gridDim.x * NWAVES * 4) {
            if ((rr0 & 511) > 256) continue;
            u32x4 raw[4][4];
#pragma unroll
            for (int k = 0; k < 4; ++k)
#pragma unroll
                for (int q = 0; q < 4; ++q) raw[k][q] = *(const u32x4*)(PQX + (size_t)(rr0 + ((rr0 & 511) == 256 ? 0 : k)) * 4096 + (q * 64 + lane) * 8);
            float accs[4];
#pragma unroll
            for (int k = 0; k < 4; ++k) { float acc = 0.f;
#pragma unroll
                for (int q = 0; q < 4; ++q) { const u32x4 w = raw[k][q]; acc += (bf_lo(w.x) - bf_hi(w.x)) + (bf_lo(w.y) - bf_hi(w.y)) + (bf_lo(w.z) - bf_hi(w.z)) + (bf_lo(w.w) - bf_hi(w.w)); }
                accs[k] = wave_sum(acc) * 0.022097086912079608f; }
            if (lane == 0) {
                unsigned short g1[4], g2[4]; size_t o1[4], o2[4]; bool v1[4], v2[4];
#pragma unroll
                for (int k = 0; k < 4; ++k) { const int rr = rr0 + k, m = rr & 511; v1[k] = (m <= 256); v2[k] = (m >= 1 && m <= 255);
                    o1[k] = ((size_t)(rr >> 11) * TB + 1024) * DM + (rr & 2047); o2[k] = o1[k] - m + (512 - m);
                    g1[k] = v1[k] ? Gt[o1[k]] : (unsigned short)0; g2[k] = v2[k] ? Gt[o2[k]] : (unsigned short)0; }
#pragma unroll
                for (int k = 0; k < 4; ++k) {
                    if (v1[k]) U[o1[k]] = (bf16_t)(pk2(accs[k] * __uint_as_float((unsigned)g1[k] << 16), 0.f) & 0xffffu);
                    if (v2[k]) U[o2[k]] = (bf16_t)(pk2(accs[k] * __uint_as_float((unsigned)g2[k] << 16), 0.f) & 0xffffu); }
            }
        }
    }
    {
        const int tid = otid(wv), lane = tid & 63; const bf16_t* DTm = (const bf16_t*)(ws + WS_DT);
        for (int it = blockIdx.x * NWAVES + wv; it < 64 * 128; it += gridDim.x * NWAVES) {
            const int bg = it >> 7, kq = it & 127, b = bg >> 2, ch = (bg & 3) * 512 + 256;
            const bf16_t* pr = PQX + ((size_t)b * DM + ch) * 4096;
            u32x4 pv[4], dv[8][4];
#pragma unroll
            for (int q = 0; q < 4; ++q) pv[q] = *(const u32x4*)(pr + (q * 64 + lane) * 8);
#pragma unroll
            for (int kk = 0; kk < 8; ++kk)
#pragma unroll
                for (int q = 0; q < 4; ++q) dv[kk][q] = *(const u32x4*)(DTm + (size_t)(kq * 8 + kk) * 4096 + (q * 64 + lane) * 8);
            float accs[8];
#pragma unroll
            for (int kk = 0; kk < 8; ++kk) { float acc = 0.f;
#pragma unroll
                for (int q = 0; q < 4; ++q) { acc = dot2g(dv[kk][q].x, pv[q].x, acc); acc = dot2g(dv[kk][q].y, pv[q].y, acc); acc = dot2g(dv[kk][q].z, pv[q].z, acc); acc = dot2g(dv[kk][q].w, pv[q].w, acc); }
                accs[kk] = wave_sum(acc); }
            if (lane == 0) {
                unsigned short g1[8], g2[8];
#pragma unroll
                for (int kk = 0; kk < 8; ++kk) { const int k = kq * 8 + kk; g1[kk] = Gt[((size_t)b * TB + k) * DM + ch]; g2[kk] = Gt[((size_t)b * TB + ((TL - k) & (TL - 1))) * DM + ch]; }
#pragma unroll
                for (int kk = 0; kk < 8; ++kk) { const int k = kq * 8 + kk;
                    U[((size_t)b * TB + k) * DM + ch] = (bf16_t)(pk2(accs[kk] * __uint_as_float((unsigned)g1[kk] << 16), 0.f) & 0xffffu);
                    if (k != 0) U[((size_t)b * TB + (TL - k)) * DM + ch] = (bf16_t)(pk2(accs[kk] * __uint_as_float((unsigned)g2[kk] << 16), 0.f) & 0xffffu); }
            }
        }
    }
    {
        DescT2 D; D.init((const bf16_t*)(ws + WS_DT), PQX);
        auto E = [=](const pg8::Unit& u, int row_l, int col_l, f32x4 v0, f32x4 v1) {
            const int k = u.i1 * 256 + row_l, col = (u.i2 & 7) * 256 + col_l;
            bf16_t* ap = A1 + ((size_t)u.i0 * 1024 + k) * DM + col;
            if (u.i2 < 8) { st_bf16x8(ap, v0, v1); return; }
            f32x4 a0, a1; ld_bf16x8(ap, a0, a1);
            const size_t off = ((size_t)u.i0 * TB + k) * DM + col;
            f32x4 g0, g1; ld_bf16x8(Gt + off, g0, g1);
            st_bf16x8(U + off, (a0 + v0) * g0, (a1 + v1) * g1);
            if (k != 0) { const size_t off2 = ((size_t)u.i0 * TB + (TL - k)) * DM + col; ld_bf16x8(Gt + off2, g0, g1); st_bf16x8(U + off2, (a0 - v0) * g0, (a1 - v1) * g1); }
            const f32x4 s0 = a0 + v0, s1 = a1 + v1, d0 = a0 - v0, d1 = a1 - v1;
            const float sm[8] = {s0[0], s0[1], s0[2], s0[3], s1[0], s1[1], s1[2], s1[3]}, df[8] = {d0[0], d0[1], d0[2], d0[3], d1[0], d1[1], d1[2], d1[3]};
            const size_t rowk = ((size_t)u.i0 * TB + k) * DM, rowT = ((size_t)u.i0 * TB + (TL - k)) * DM; const int cm = (col & ~255) + 512 - col_l;
            {
                const bf16_t* gk_ = Gt + rowk + cm - 8; const bf16_t* gT_ = Gt + rowT + cm - 8; bf16_t* uk_ = U + rowk + cm - 8; bf16_t* uT_ = U + rowT + cm - 8;
                const unsigned short ka1 = gk_[1]; const unsigned ka2 = *(const unsigned*)(gk_ + 2); const u32x2 ka4 = *(const u32x2*)(gk_ + 4); const unsigned short ka0 = col_l ? gk_[8] : (unsigned short)0;
                unsigned short ta1 = 0, ta0 = 0; unsigned ta2 = 0; u32x2 ta4 = {0u, 0u};
                if (k != 0) { ta1 = gT_[1]; ta2 = *(const unsigned*)(gT_ + 2); ta4 = *(const u32x2*)(gT_ + 4); ta0 = col_l ? gT_[8] : (unsigned short)0; }
                uk_[1] = (bf16_t)(pk2(df[7] * __uint_as_float((unsigned)ka1 << 16), 0.f) & 0xffffu);
                *(unsigned*)(uk_ + 2) = pk2(df[6] * bf_lo(ka2), df[5] * bf_hi(ka2));
                *(u32x2*)(uk_ + 4) = (u32x2){pk2(df[4] * bf_lo(ka4.x), df[3] * bf_hi(ka4.x)), pk2(df[2] * bf_lo(ka4.y), df[1] * bf_hi(ka4.y))};
                if (col_l) uk_[8] = (bf16_t)(pk2(df[0] * __uint_as_float((unsigned)ka0 << 16), 0.f) & 0xffffu);
                if (k != 0) {
                    uT_[1] = (bf16_t)(pk2(sm[7] * __uint_as_float((unsigned)ta1 << 16), 0.f) & 0xffffu);
                    *(unsigned*)(uT_ + 2) = pk2(sm[6] * bf_lo(ta2), sm[5] * bf_hi(ta2));
                    *(u32x2*)(uT_ + 4) = (u32x2){pk2(sm[4] * bf_lo(ta4.x), sm[3] * bf_hi(ta4.x)), pk2(sm[2] * bf_lo(ta4.y), sm[1] * bf_hi(ta4.y))};
                    if (col_l) uT_[8] = (bf16_t)(pk2(sm[0] * __uint_as_float((unsigned)ta0 << 16), 0.f) & 0xffffu);
                }
            }
        };
        pg8::gemm_phase(lds, D, E, wv);
    }
    if (!latonly) {
        DescT D; D.init((const bf16_t*)(ws + WS_DT2), PQC, 512, 512, 0, 1);
        auto E = [=](const pg8::Unit& u, int row_l, int col_l, f32x4 v0, f32x4 v1) {
            const size_t off = ((size_t)u.i0 * TB + TL + row_l) * DM + u.i2 * 256 + col_l;
            f32x4 g0, g1; ld_bf16x8(Gt + off, g0, g1);
            st_bf16x8(U + off, v0 * g0, v1 * g1);
        };
        pg8::gemm_phase(lds, D, E, wv);
    }
    xcd_barrier(gbar, wv);
    {
        DescPlain D; D.init(U, (const bf16_t*)(ws + WS_WFO) + (size_t)j * DM * DM, 8, latonly);
        EpiResid E; E.init(A, layer);
        pg8::gemm_phase(lds, D, E, wv);
    }
    xcd_barrier(gbar, wv);
}


namespace att {
constexpr int D = 128, NW = 8, QBLK = 32, KVBLK = 64;
constexpr float SCALE = 0.088388347648318440f;
constexpr float THR = 8.f;
constexpr int LDQ = 2048, LDK = 512;
constexpr size_t SHM_V = KVBLK * D * 2, SHM_K = KVBLK * D * 2;
typedef float f32x8 __attribute__((ext_vector_type(8)));
#define KSWZ(row, colB) ((row) * 256 + ((colB) ^ (((row) & 7) << 4)))
#define SBAR() __builtin_amdgcn_sched_barrier(0)
DI int crow(int r, int hi) { return (r & 3) + 8 * (r >> 2) + 4 * hi; }
DI unsigned cvtpk(float lo, float hi) { unsigned r; asm volatile("v_cvt_pk_bf16_f32 %0, %1, %2" : "=v"(r) : "v"(lo), "v"(hi)); return r; }
DI void partialSM(f32x16& p0, f32x16& p1, float& m_reg, float& mn, float& alpha) {
  constexpr float C = SCALE * 1.4426950408889634f;
  float pmax = p0[0];
#pragma unroll
  for (int r = 1; r < 16; ++r) pmax = fmaxf(pmax, p0[r]);
#pragma unroll
  for (int r = 0; r < 16; ++r) pmax = fmaxf(pmax, p1[r]);
  { auto rr = __builtin_amdgcn_permlane32_swap(__float_as_uint(pmax), __float_as_uint(pmax), false, false);
    pmax = fmaxf(__uint_as_float(rr[0]), __uint_as_float(rr[1])); }
  if (__builtin_expect(__all(pmax - m_reg <= THR / SCALE), 1)) { mn = m_reg; alpha = 1.f; }
  else { mn = fmaxf(m_reg, pmax); alpha = __builtin_amdgcn_exp2f((m_reg - mn) * C); m_reg = mn; }
  float mnC = -mn * C;
#pragma unroll
  for (int r = 0; r < 16; ++r) p0[r] = fmaf(p0[r], C, mnC);
#pragma unroll
  for (int r = 0; r < 16; ++r) p1[r] = fmaf(p1[r], C, mnC);
#pragma unroll
  for (int r = 0; r < 16; ++r) p0[r] = __builtin_amdgcn_exp2f(p0[r]);
}
DI void finishSM(f32x16& p0, f32x16& p1, float alpha, float& l_reg, bf16x8& pa0, bf16x8& pa1, bf16x8& pa2, bf16x8& pa3) {
#pragma unroll
  for (int r = 0; r < 16; ++r) p1[r] = __builtin_amdgcn_exp2f(p1[r]);
  float ps = 0;
#pragma unroll
  for (int r = 0; r < 16; ++r) ps += p0[r];
#pragma unroll
  for (int r = 0; r < 16; ++r) ps += p1[r];
  { auto rr = __builtin_amdgcn_permlane32_swap(__float_as_uint(ps), __float_as_uint(ps), false, false);
    ps = __uint_as_float(rr[0]) + __uint_as_float(rr[1]); }
  l_reg = l_reg * alpha + ps;
#define PK4(P, BASE, OUT) do { unsigned a0 = cvtpk(P[BASE + 0], P[BASE + 1]), a1 = cvtpk(P[BASE + 2], P[BASE + 3]);   \
    unsigned b0 = cvtpk(P[BASE + 4], P[BASE + 5]), b1 = cvtpk(P[BASE + 6], P[BASE + 7]);                              \
    auto r0 = __builtin_amdgcn_permlane32_swap(a0, b0, false, false); auto r1 = __builtin_amdgcn_permlane32_swap(a1, b1, false, false); \
    u32x4 w = {r0[0], r1[0], r0[1], r1[1]}; OUT = *reinterpret_cast<bf16x8*>(&w); } while (0)
  PK4(p0, 0, pa0); PK4(p0, 8, pa1); PK4(p1, 0, pa2); PK4(p1, 8, pa3);
#undef PK4
}
DI void qkt(f32x16& p0, f32x16& p1, const bf16_t* Ks, const bf16x8* qr, int r32, int hi) {
  p0 = f32x16{}; p1 = f32x16{};
#pragma unroll
  for (int d0 = 0; d0 < 8; ++d0) { int cb = (d0 * 16 + hi * 8) * 2;
    bf16x8 b0 = *reinterpret_cast<const bf16x8*>((const char*)Ks + KSWZ(r32, cb));
    bf16x8 b1 = *reinterpret_cast<const bf16x8*>((const char*)Ks + KSWZ(32 + r32, cb));
    p0 = __builtin_amdgcn_mfma_f32_32x32x16_bf16(b0, qr[d0], p0, 0, 0, 0);
    p1 = __builtin_amdgcn_mfma_f32_32x32x16_bf16(b1, qr[d0], p1, 0, 0, 0); }
}
DI int v_st(int k, int c) { const int kk = (k & ~0xC) | ((k & 4) << 1) | ((k & 8) >> 1); return ((kk >> 3) * 4 + (c >> 5)) * 512 + ((kk & 7) * 32 + (c & 31)) * 2; }
DI int v_rd_base(int lane) { return ((lane & 3) << 3) | (((lane >> 2) & 3) << 6) | (((lane >> 4) & 1) << 5) | (((lane >> 5) & 1) << 8); }
constexpr int v_rd_off(int d0, int ks, int half) { return d0 * 512 + ks * 4096 + half * 2048; }
template <int OFF> DI s16x4 tr_read(int vb) {
  s16x4 r; asm volatile("ds_read_b64_tr_b16 %0, %1 offset:%2" : "=&v"(r) : "v"(vb), "i"(OFF) : "memory"); return r;
}
template <int D0> DI void pv_one(f32x16& od, int vb, bf16x8 pa0, bf16x8 pa1, bf16x8 pa2, bf16x8 pa3) {
  const s16x4 l0 = tr_read<v_rd_off(D0, 0, 0)>(vb), h0 = tr_read<v_rd_off(D0, 0, 1)>(vb), l1 = tr_read<v_rd_off(D0, 1, 0)>(vb), h1 = tr_read<v_rd_off(D0, 1, 1)>(vb);
  const s16x4 l2 = tr_read<v_rd_off(D0, 2, 0)>(vb), h2 = tr_read<v_rd_off(D0, 2, 1)>(vb), l3 = tr_read<v_rd_off(D0, 3, 0)>(vb), h3 = tr_read<v_rd_off(D0, 3, 1)>(vb);
  asm volatile("s_waitcnt lgkmcnt(0)" ::: "memory"); SBAR();
#define PK(L, H) (bf16x8){L[0], L[1], L[2], L[3], H[0], H[1], H[2], H[3]}
  od = __builtin_amdgcn_mfma_f32_32x32x16_bf16(pa0, PK(l0, h0), od, 0, 0, 0);
  od = __builtin_amdgcn_mfma_f32_32x32x16_bf16(pa1, PK(l1, h1), od, 0, 0, 0);
  od = __builtin_amdgcn_mfma_f32_32x32x16_bf16(pa2, PK(l2, h2), od, 0, 0, 0);
  od = __builtin_amdgcn_mfma_f32_32x32x16_bf16(pa3, PK(l3, h3), od, 0, 0, 0);
#undef PK
}
DI void pv_d0(f32x16* o, int vb, bf16x8 pa0, bf16x8 pa1, bf16x8 pa2, bf16x8 pa3) {
  pv_one<0>(o[0], vb, pa0, pa1, pa2, pa3); pv_one<1>(o[1], vb, pa0, pa1, pa2, pa3); pv_one<2>(o[2], vb, pa0, pa1, pa2, pa3); pv_one<3>(o[3], vb, pa0, pa1, pa2, pa3);
}
DI void attn_dense_body(const bf16_t* __restrict__ Qb, const bf16_t* __restrict__ Kh, const bf16_t* __restrict__ Vh, const bf16_t* SZb, bf16_t* Ub, int seq, char* lds, int wv, const float* qn, int tpos) {
  const int tid = otid(wv), wid = tid >> 6, lane = tid & 63, r32 = lane & 31, hi = lane >> 5;
  bf16_t* V_lds = (bf16_t*)lds; bf16_t* K_lds = (bf16_t*)(lds + 2 * SHM_V);
  float* wsf = (float*)(lds + 2 * SHM_V + 2 * SHM_K) + wid * 64; float* li_l = wsf; float* al_l = wsf + 32;
  float m_reg = -1e30f, l_reg = 0; f32x16 o[4] = {}; bf16x8 qr[8];
  const bf16_t* Qw = Qb + (long)(wid * QBLK + r32) * LDQ + hi * 8;
  {
    u32x4 raw[8];
#pragma unroll
    for (int d0 = 0; d0 < 8; ++d0) raw[d0] = *reinterpret_cast<const u32x4*>(Qw + d0 * 16);
    float ss = 0.f;
#pragma unroll
    for (int d0 = 0; d0 < 8; ++d0) { const u32x4 w = raw[d0];
      ss += bf_lo(w.x) * bf_lo(w.x) + bf_hi(w.x) * bf_hi(w.x) + bf_lo(w.y) * bf_lo(w.y) + bf_hi(w.y) * bf_hi(w.y) + bf_lo(w.z) * bf_lo(w.z) + bf_hi(w.z) * bf_hi(w.z) + bf_lo(w.w) * bf_lo(w.w) + bf_hi(w.w) * bf_hi(w.w); }
    ss += __shfl_xor(ss, 32);
    const float rs = 1.0f / sqrtf(ss * (1.f / 128.f) + EPS);
    const int t = tpos + wid * QBLK + r32;
    const f32x2* rope = (const f32x2*)(lds + 81920);
#pragma unroll
    for (int d0 = 0; d0 < 8; ++d0) { const u32x4 w = raw[d0]; const float* wn = qn + d0 * 16 + hi * 8;
      const f32x4 g0 = *(const f32x4*)wn, g1 = *(const f32x4*)(wn + 4);
      float y[8] = {bf_lo(w.x) * rs * g0[0], bf_hi(w.x) * rs * g0[1], bf_lo(w.y) * rs * g0[2], bf_hi(w.y) * rs * g0[3], bf_lo(w.z) * rs * g1[0], bf_hi(w.z) * rs * g1[1], bf_lo(w.w) * rs * g1[2], bf_hi(w.w) * rs * g1[3]};
      if (tpos >= 0) {
        const int pos = (d0 < 4) ? (t >> 6) : (t & 63);
        const f32x4* rp = (const f32x4*)(rope + pos * 32 + (8 * (d0 & 3) + 4 * hi));
        const f32x4 c01 = rp[0], c23 = rp[1];
        const float cs[4] = {c01[0], c01[2], c23[0], c23[2]}, sn[4] = {c01[1], c01[3], c23[1], c23[3]};
#pragma unroll
        for (int pp = 0; pp < 4; ++pp) { const float x0 = y[2 * pp], x1 = y[2 * pp + 1]; y[2 * pp] = x0 * cs[pp] - x1 * sn[pp]; y[2 * pp + 1] = x0 * sn[pp] + x1 * cs[pp]; }
      }
      u32x4 o4 = {pk2(y[0], y[1]), pk2(y[2], y[3]), pk2(y[4], y[5]), pk2(y[6], y[7])};
      qr[d0] = __builtin_bit_cast(bf16x8, o4); }
  }
  const int sr = tid >> 4, sc = (tid & 15) * 8, vst0 = v_st(sr, sc), vst1 = v_st(32 + sr, sc);
  const int vb0 = (int)(uintptr_t)V_lds + v_rd_base(lane);
  struct { bf16x8 vs0, vs1, ks0, ks1; } sr_[2];
#define SLOAD(i, k0) do { sr_[i].vs0 = *reinterpret_cast<const bf16x8*>(&Vh[(long)((k0) + sr) * LDK + sc]); sr_[i].vs1 = *reinterpret_cast<const bf16x8*>(&Vh[(long)((k0) + 32 + sr) * LDK + sc]); \
    sr_[i].ks0 = *reinterpret_cast<const bf16x8*>(&Kh[(long)((k0) + sr) * LDK + sc]); sr_[i].ks1 = *reinterpret_cast<const bf16x8*>(&Kh[(long)((k0) + 32 + sr) * LDK + sc]); } while (0)
#define SWRITE(b, i) do { *(bf16x8*)((char*)V_lds + (b) * SHM_V + vst0) = sr_[i].vs0;          \
    *(bf16x8*)((char*)V_lds + (b) * SHM_V + vst1) = sr_[i].vs1; int kc = sc * 2;               \
    *(bf16x8*)((char*)K_lds + (b) * SHM_K + KSWZ(sr, kc)) = sr_[i].ks0;                       \
    *(bf16x8*)((char*)K_lds + (b) * SHM_K + KSWZ(32 + sr, kc)) = sr_[i].ks1; } while (0)
#define SWAIT() asm volatile("s_waitcnt vmcnt(4)" ::: "memory")
#define RESC(a) do { if (__any((a) < 1.f)) { if (hi == 0) al_l[r32] = (a); asm volatile("s_waitcnt lgkmcnt(0)" ::: "memory"); \
    _Pragma("unroll") for (int d = 0; d < 4; ++d) _Pragma("unroll") for (int r = 0; r < 16; ++r) o[d][r] *= al_l[crow(r, hi)]; } } while (0)
  f32x16 pA0, pA1, pB0, pB1; float mnA, mnB, alA, alB; bf16x8 pa0, pa1, pa2, pa3; const int NT = seq / KVBLK;
  constexpr int SE = 0, SO = 1;
  SLOAD(SE, 0); asm volatile("s_waitcnt vmcnt(0)" ::: "memory"); SWRITE(0, SE); __syncthreads();
  qkt(pA0, pA1, K_lds, qr, r32, hi); partialSM(pA0, pA1, m_reg, mnA, alA);
  SLOAD(SO, KVBLK); if (2 < NT) SLOAD(SE, 2 * KVBLK);
  SWAIT(); SWRITE(1, SO); __syncthreads();
  for (int j = 1; j + 1 < NT; j += 2) {
    SBAR(); qkt(pB0, pB1, (bf16_t*)((char*)K_lds + SHM_K), qr, r32, hi);
    finishSM(pA0, pA1, alA, l_reg, pa0, pa1, pa2, pa3); SBAR();
    SLOAD(SO, (j + 2) * KVBLK); SBAR();
    pv_d0(o, vb0, pa0, pa1, pa2, pa3); partialSM(pB0, pB1, m_reg, mnB, alB);
    __syncthreads(); SWAIT(); SWRITE(0, SE);
    RESC(alB); __syncthreads();
    SBAR(); qkt(pA0, pA1, K_lds, qr, r32, hi);
    finishSM(pB0, pB1, alB, l_reg, pa0, pa1, pa2, pa3); SBAR();
    if (j + 3 < NT) SLOAD(SE, (j + 3) * KVBLK); SBAR();
    pv_d0(o, vb0 + (int)SHM_V, pa0, pa1, pa2, pa3); partialSM(pA0, pA1, m_reg, mnA, alA);
    __syncthreads(); SWAIT(); SWRITE(1, SO);
    RESC(alA); __syncthreads();
  }
  SBAR(); qkt(pB0, pB1, (bf16_t*)((char*)K_lds + SHM_K), qr, r32, hi);
  finishSM(pA0, pA1, alA, l_reg, pa0, pa1, pa2, pa3); SBAR();
  pv_d0(o, vb0, pa0, pa1, pa2, pa3); partialSM(pB0, pB1, m_reg, mnB, alB);
  __syncthreads(); RESC(alB);
  finishSM(pB0, pB1, alB, l_reg, pa0, pa1, pa2, pa3); SBAR();
  pv_d0(o, vb0 + (int)SHM_V, pa0, pa1, pa2, pa3);
  u32x4 zq[8];
#pragma unroll
  for (int i = 0; i < 8; ++i) { const int id = tid + 512 * i; zq[i] = *(const u32x4*)(SZb + (long)(id >> 4) * LDQ + (id & 15) * 8); }
  if (hi == 0) li_l[r32] = l_reg; asm volatile("s_waitcnt lgkmcnt(0)" ::: "memory");
  __syncthreads();
  {
    float rli[16];
#pragma unroll
    for (int r = 0; r < 16; ++r) rli[r] = __builtin_amdgcn_rcpf(li_l[crow(r, hi)]);
    char* ost = lds;
#pragma unroll
    for (int r = 0; r < 16; ++r) { char* rowp = ost + (wid * QBLK + crow(r, hi)) * 256 + r32 * 2;
#pragma unroll
      for (int d0 = 0; d0 < 4; ++d0) *(unsigned short*)(rowp + d0 * 64) = (unsigned short)(pk2(o[d0][r] * rli[r], 0.f) & 0xffffu); }
  }
  __syncthreads();
#pragma unroll
  for (int i = 0; i < 8; ++i) { const int id = tid + 512 * i; const int row = id >> 4, ch = id & 15;
    const u32x4 ov = *(const u32x4*)(lds + row * 256 + ch * 16);
    f32x4 a0 = {bf_lo(ov.x), bf_hi(ov.x), bf_lo(ov.y), bf_hi(ov.y)}, a1 = {bf_lo(ov.z), bf_hi(ov.z), bf_lo(ov.w), bf_hi(ov.w)};
    const f32x4 z0 = {bf_lo(zq[i].x), bf_hi(zq[i].x), bf_lo(zq[i].y), bf_hi(zq[i].y)}, z1 = {bf_lo(zq[i].z), bf_hi(zq[i].z), bf_lo(zq[i].w), bf_hi(zq[i].w)};
    st_bf16x8(Ub + (long)row * LDQ + ch * 8, a0 * z0, a1 * z1); }
  __syncthreads();
#undef SLOAD
#undef SWRITE
#undef SWAIT
#undef RESC
}
#undef KSWZ
#undef SBAR
}

DI void qknorm_phase(const Args& A, LAS unsigned char* lds, int wv) {
    const int tid = otid(wv), lane = tid & 63, wave = tid >> 6, G = gridDim.x;
    bf16_t* Q = (bf16_t*)(A.ws + WS_SCR + A_Q); bf16_t* Kb = (bf16_t*)(A.ws + WS_SCR + A_K);
    const float* qn = A.in[14]; const float* kn = A.in[15];
    const int sub = lane >> 4, l16 = lane & 15, e0 = l16 * 8;
    LAS f32x2* rope = (LAS f32x2*)lds;
    for (int e = tid; e < 2048; e += NTHREADS) { const float ang = (float)(e >> 5) * exp2f(-(float)(e & 31) * 0.41524101186092029f); rope[e] = (f32x2){cosf(ang), sinf(ang)}; }
    __syncthreads();
    const long NIT = (long)NTOK * 4;
    for (long it0 = ((long)blockIdx.x * NWAVES + wave) * 16 + sub; it0 < NIT; it0 += (long)G * NWAVES * 16) {
        bf16_t* pq[4]; u32x4 raw[4];
#pragma unroll
        for (int k = 0; k < 4; ++k) { const long it = it0 + 4 * k; const int row = (int)(it >> 2), hj = 16 + (int)(it & 3);
            pq[k] = (hj < 16) ? Q + (size_t)row * 2048 + hj * 128 + e0 : Kb + (size_t)row * 512 + (hj - 16) * 128 + e0;
            raw[k] = *(const u32x4*)pq[k]; }
#pragma unroll
        for (int k = 0; k < 4; ++k) {
            const long it = it0 + 4 * k; const int row = (int)(it >> 2), hj = 16 + (int)(it & 3);
            const float* wn = (hj < 16 ? qn : kn) + e0;
            f32x4 a = {bf_lo(raw[k].x), bf_hi(raw[k].x), bf_lo(raw[k].y), bf_hi(raw[k].y)}, b = {bf_lo(raw[k].z), bf_hi(raw[k].z), bf_lo(raw[k].w), bf_hi(raw[k].w)};
            float ss = 0.f;
#pragma unroll
            for (int q = 0; q < 4; ++q) ss += a[q] * a[q] + b[q] * b[q];
            ss += __shfl_xor(ss, 1); ss += __shfl_xor(ss, 2); ss += __shfl_xor(ss, 4); ss += __shfl_xor(ss, 8);
            const float rs = 1.0f / sqrtf(ss * (1.f / 128.f) + EPS);
            const f32x4 w0 = *(const f32x4*)wn, w1 = *(const f32x4*)(wn + 4);
            a = a * rs * w0; b = b * rs * w1;
            const int t = row % TB;
            if (t < TL) {
                const int pos = (l16 < 8) ? (t >> 6) : (t & 63);
                float y[8] = {a[0], a[1], a[2], a[3], b[0], b[1], b[2], b[3]};
                const LAS f32x4* rp = (const LAS f32x4*)(rope + pos * 32 + ((4 * l16) & 31));
                const f32x4 c01 = rp[0], c23 = rp[1];
                const float cs[4] = {c01[0], c01[2], c23[0], c23[2]}, sn[4] = {c01[1], c01[3], c23[1], c23[3]};
#pragma unroll
                for (int pp = 0; pp < 4; ++pp) {
                    const float x0 = y[2 * pp], x1 = y[2 * pp + 1];
                    y[2 * pp] = x0 * cs[pp] - x1 * sn[pp]; y[2 * pp + 1] = x0 * sn[pp] + x1 * cs[pp];
                }
                a = (f32x4){y[0], y[1], y[2], y[3]}; b = (f32x4){y[4], y[5], y[6], y[7]};
            }
            st_bf16x8(pq[k], a, b);
        }
    }
}

DI void attn_layer(const Args& A, LAS unsigned char* lds, char* lds_gen, const XcdBarrier& gbar, int layer, int wv) {
    unsigned char* ws = A.ws;
    const bf16_t* H = (const bf16_t*)(ws + WS_H); bf16_t* U = (bf16_t*)(ws + WS_H);
    bf16_t* Q = (bf16_t*)(ws + WS_SCR + A_Q); bf16_t* Kb = (bf16_t*)(ws + WS_SCR + A_K); bf16_t* Vb = (bf16_t*)(ws + WS_SCR + A_V); bf16_t* SZ = (bf16_t*)(ws + WS_SCR + A_SZ);
    norm_phase(A, layer, false, wv);
    xcd_barrier(gbar, wv);
    {
        DescA1 D; D.init(H, (const bf16_t*)(ws + WS_WAI));
        auto E = [=](const pg8::Unit& u, int row_l, int col_l, f32x4 v0, f32x4 v1) {
            const size_t row = (size_t)u.i0 * 256 + row_l; const int pn = u.i1;
            if (pn < 8) st_bf16x8(Q + row * 2048 + pn * 256 + col_l, v0, v1);
            else if (pn < 10) st_bf16x8(Kb + row * 512 + (pn - 8) * 256 + col_l, v0, v1);
            else if (pn < 12) st_bf16x8(Vb + row * 512 + (pn - 10) * 256 + col_l, v0, v1);
            else { f32x4 a, b;
#pragma unroll
                for (int q = 0; q < 4; ++q) { a[q] = siluf(v0[q]); b[q] = siluf(v1[q]); }
                st_bf16x8(SZ + row * 2048 + (pn - 12) * 256 + col_l, a, b); }
        };
        pg8::gemm_phase(lds, D, E, wv);
    }
    xcd_barrier(gbar, wv);
    qknorm_phase(A, lds, wv);
    xcd_barrier(gbar, wv);
    {
        const int G = gridDim.x, c = blockIdx.x;
        { f32x2* rope = (f32x2*)(lds_gen + 81920); const int tid = otid(wv);
          for (int e = tid; e < 2048; e += NTHREADS) { const float ang = (float)(e >> 5) * exp2f(-(float)(e & 31) * 0.41524101186092029f); rope[e] = (f32x2){cosf(ang), sinf(ang)}; }
          __syncthreads(); }
        const float* qn = A.in[14];
        for (long L = c; L < 2048; L += G) {
            const int u = pg8::xcd_remap((int)L, 2048);
            const int b = u / 128, rem = u % 128, kvh = rem / 32, g = (rem / 8) % 4, qb = rem % 8, h = kvh * 4 + g;
            const size_t qoff = ((size_t)b * TB + qb * 256) * 2048 + h * 128, koff = ((size_t)b * TB) * 512 + kvh * 128;
            att::attn_dense_body(Q + qoff, Kb + koff, Vb + koff, SZ + qoff, U + qoff, TB, lds_gen, wv, qn, qb * 256);
        }
    }
    xcd_barrier(gbar, wv);
    {
        DescPlain D; D.init(U, (const bf16_t*)(ws + WS_WAO), 8, true);
        EpiResid E; E.init(A, layer);
        pg8::gemm_phase(lds, D, E, wv);
    }
    xcd_barrier(gbar, wv);
}


struct DescM1 {
    static constexpr bool RAW = false;
    const bf16_t* H; const bf16_t* WA; const bf16_t* WB; int lda, ldb, K, total;
    DI void init(const bf16_t* H_, const bf16_t* WA_, const bf16_t* WB_) { H = H_; WA = WA_; WB = WB_; lda = DM; ldb = DM; K = DM; total = 144 * 9 + 8 * 144; }
    DI pg8::Unit unit(int idx) const {
        pg8::Unit u;
        if (idx < 1296) { const int nig = 72, gid = idx / nig, pm = gid * 8 + (idx % nig) % 8, pn = (idx % nig) / 8;
            u.a = (const char*)(H + (size_t)pm * 256 * DM); u.b = (const char*)(WA + (size_t)pn * 256 * DM); u.i0 = pm; u.i1 = pn; u.i2 = 0; }
        else { const int j = idx - 1296, mt = j % 8, nt = j / 8;
            u.a = (const char*)(WB + (size_t)mt * 256 * DM); u.b = (const char*)(H + (size_t)nt * 256 * DM); u.i0 = mt; u.i1 = nt; u.i2 = 1; }
        return u;
    }
};
namespace ml {
#define MFMA32(a, b, c) __builtin_amdgcn_mfma_f32_32x32x16_bf16((a), (b), (c), 0, 0, 0)
#define LFENCE() asm volatile("s_waitcnt lgkmcnt(0)" ::: "memory")
DI float dot2_bf16(unsigned a, unsigned b, float c) { asm("v_dot2c_f32_bf16 %0, %1, %2" : "+v"(c) : "v"(a), "v"(b)); return c; }
#define DOT2(a, b, c) dot2_bf16((a), (b), (c))
DI int crow(int reg, int h) { return (reg & 3) + 8 * (reg >> 2) + 4 * h; }
DI bf16x8 ldperm(const bf16_t* p) { const s16x4 lo = *(const s16x4*)p, hi = *(const s16x4*)(p + 8); return __builtin_shufflevector(lo, hi, 0, 1, 2, 3, 4, 5, 6, 7); }
DI bf16x8 pack_step(const f32x16& x, int s) { u32x4 p = {pk2(x[8 * s], x[8 * s + 1]), pk2(x[8 * s + 2], x[8 * s + 3]), pk2(x[8 * s + 4], x[8 * s + 5]), pk2(x[8 * s + 6], x[8 * s + 7])}; return __builtin_bit_cast(bf16x8, p); }
DI float bfs(short h) { return __uint_as_float(((unsigned)(unsigned short)h) << 16); }

constexpr int SC_Q = 0, SC_K = 16384, SC_KT = 32768, SC_BUF = 49152, SC_WAVE = 2 * SC_BUF, SC_WAVE_BYTES = 6656;
DI bf16x8 ldsfrag(const LAS unsigned char* buf, unsigned o) { const s16x4 lo = *(const LAS s16x4*)(buf + o), hi = *(const LAS s16x4*)(buf + (o ^ 16u)); return __builtin_shufflevector(lo, hi, 0, 1, 2, 3, 4, 5, 6, 7); }
DI void scan_phase(const Args& A, LAS unsigned char* lds, int wv) {
    const int wave = wv;
    LAS float* wl = (LAS float*)(lds + SC_WAVE + wave * SC_WAVE_BYTES);
    LAS unsigned* nbp = (LAS unsigned*)(lds + SC_WAVE + wave * SC_WAVE_BYTES + 2048);
    LAS unsigned* wbp = nbp + 64;
    LAS unsigned char* hst = lds + SC_WAVE + wave * SC_WAVE_BYTES + 2560;
    unsigned char* ws = A.ws;
    const bf16_t* Qg = (const bf16_t*)(ws + WS_SCR + M_Q); const bf16_t* Kg = (const bf16_t*)(ws + WS_SCR + M_K); const bf16_t* KVT = (const bf16_t*)(ws + WS_SCR + M_KVT);
    const float* G32 = (const float*)(ws + WS_SCR + M_G32); const float* bg = A.in[10];
#define SC_POS0(j) (dir == 0 ? ((j) < 4 ? TL + 64 * (j) : 64 * ((j) - 4)) : ((j) < 4 ? TL + 64 * (3 - (j)) : 64 * (35 - (j))))
#define SC_DMA(bufi, p0) do { const int tj_ = otid(wv); _Pragma("unroll") for (int i_ = 0; i_ < 2; ++i_) { const int sl_ = i_ * 512 + tj_; \
        { const int row_ = sl_ >> 4, c_ = (sl_ & 15) ^ (row_ & 15); const size_t go_ = (size_t)((p0) + row_) * 1024 + c_ * 8; \
          __builtin_amdgcn_global_load_lds((const unsigned*)(Qu + go_), (LAS unsigned*)(lds + (bufi) * SC_BUF + SC_Q + i_ * 8192 + wave * 1024), 16, 0, 0); \
          __builtin_amdgcn_global_load_lds((const unsigned*)(Ku + go_), (LAS unsigned*)(lds + (bufi) * SC_BUF + SC_K + i_ * 8192 + wave * 1024), 16, 0, 0); } \
        { const int d_ = sl_ >> 3, c_ = (sl_ & 7) ^ ((d_ >> 1) & 7); \
          __builtin_amdgcn_global_load_lds((const unsigned*)(KTu + (size_t)d_ * TB + (p0) + c_ * 8), (LAS unsigned*)(lds + (bufi) * SC_BUF + SC_KT + i_ * 8192 + wave * 1024), 16, 0, 0); } } } while (0)
    for (int item = blockIdx.x; item < 256; item += gridDim.x) {
        const int dir = item & 1, h = (item >> 1) & 7, b = item >> 4, e0 = wave * 32;
        const bf16_t* Qu = Qg + (size_t)b * TB * 1024 + h * 128;
        const bf16_t* Ku = Kg + (size_t)b * TB * 1024 + h * 128;
        const bf16_t* KTu = KVT + ((size_t)b * 3072 + h * 128) * TB;
        const bf16_t* VTu = KVT + ((size_t)b * 3072 + 1024 + h * 256 + e0) * TB;
        bf16_t* Hout = (bf16_t*)(ws + WS_SCR + (dir ? M_HB : M_HF)) + (size_t)b * TB * DM + h * 256 + e0;
        const float big = bg[(dir * 2) * 8 + h], bfg = bg[(dir * 2 + 1) * 8 + h];
        f32x16 cacc[4];
#pragma unroll
        for (int d = 0; d < 4; ++d)
#pragma unroll
            for (int i = 0; i < 16; ++i) cacc[d][i] = 0.f;
        float m = 0.f;
        { const int l0 = otid(wv) & 63; wl[384 + l0] = 0.f; wl[448 + l0] = 0.f; nbp[l0] = 0u; }
        LFENCE();
        SC_DMA(0, SC_POS0(0));
        float ig_n, fg_n;
        { const int l0 = otid(wv) & 63; const float* gp = G32 + (size_t)(b * TB + SC_POS0(0) + (dir ? 63 - l0 : l0)) * 32 + (dir * 2) * 8 + h; ig_n = gp[0]; fg_n = gp[8]; }
        for (int j = 0; j < 36; ++j) {
            const int pos0 = SC_POS0(j);
            const LAS unsigned char* Qb = lds + (j & 1) * SC_BUF + SC_Q; const LAS unsigned char* Kb = lds + (j & 1) * SC_BUF + SC_K; const LAS unsigned char* KTb = lds + (j & 1) * SC_BUF + SC_KT;
            asm volatile("s_waitcnt vmcnt(0)" ::: "memory"); __builtin_amdgcn_s_barrier(); asm volatile("" ::: "memory");
            if (j + 1 < 36) SC_DMA((j + 1) & 1, SC_POS0(j + 1));
            const int lj = otid(wv) & 63, rj = lj & 31, h4 = (lj >> 5) * 4;
            LAS float* wh = wl + h4; LAS float* wr = wl + rj; LAS unsigned char* hb = hst + h4 * 64 + rj * 2;
            const LAS unsigned* nbh = nbp + (h4 >> 1); const LAS unsigned* wbh = wbp + (h4 >> 1);
            const unsigned xr = rj & 15, xd = (rj >> 1) & 7;
            const unsigned qro = (unsigned)rj * 256u + 2u * h4;
            const unsigned kro = (unsigned)rj * 128u + 2u * h4;
            const bf16_t* VTp = VTu + (size_t)rj * TB + pos0 + h4;
            bf16x8 vf[4];
#pragma unroll
            for (int kk = 0; kk < 4; ++kk) vf[kk] = ldperm(VTp + 16 * kk);
            float decay, m_new;
            {
                const int s = dir ? 63 - lj : lj;
                const float ig = ig_n + big, fg = fg_n + bfg;
                if (j + 1 < 36) { const float* gp = G32 + (size_t)(b * TB + SC_POS0(j + 1) + s) * 32 + (dir * 2) * 8 + h; ig_n = gp[0]; fg_n = gp[8]; }
                const float lf = fminf(fg, 0.f) - log1pf(__expf(-fabsf(fg)));
                float bs = lf;
#pragma unroll
                for (int o = 1; o < 64; o <<= 1) { const float t = __shfl_up(bs, o); if (lj >= o) bs += t; }
                const float uu = ig - bs;
                float pmx = uu;
#pragma unroll
                for (int o = 1; o < 64; o <<= 1) { const float t = __shfl_up(pmx, o); if (lj >= o) pmx = fmaxf(pmx, t); }
                pmx = fmaxf(pmx, m);
                const float b_end = __shfl(bs, 63), pm_last = __shfl(pmx, 63);
                LAS float* ws_ = wl + s;
                ws_[0] = uu * 1.4426950408889634f; ws_[64] = pmx * 1.4426950408889634f; ws_[128] = __expf(m - pmx); ws_[192] = __expf(-(bs + pmx)); ws_[256] = __expf(uu - pm_last);
                { const float wv_ = __expf(uu - pm_last), wp_ = __shfl_xor(wv_, 1); if ((s & 1) == 0) wbp[s >> 1] = pk2(wv_, wp_); }
                decay = __expf(m - pm_last); m_new = b_end + pm_last;
            }
            LFENCE();
            const int sbase = dir ? 63 - h4 : h4, sgn = dir ? -1 : 1;
#pragma unroll
            for (int tb = 0; tb < 2; ++tb) {
                __builtin_amdgcn_sched_barrier(0);
                const unsigned qo = qro + tb * 8192u;
                f32x16 ha;
#pragma unroll
                for (int i = 0; i < 16; ++i) ha[i] = 0.f;
                float qnv = 0.f;
#pragma unroll
                for (int kk = 0; kk < 8; ++kk) {
                    const bf16x8 qa = ldsfrag(Qb, qo + (((2u * kk) ^ xr) << 4));
                    ha = MFMA32(qa, pack_step(cacc[kk >> 1], kk & 1), ha);
                    { const u32x2 nb0 = *(const LAS u32x2*)(nbh + 8 * kk), nb1 = *(const LAS u32x2*)(nbh + 8 * kk + 4); const u32x4 qw = __builtin_bit_cast(u32x4, qa);
                      qnv = DOT2(qw.x, nb0.x, qnv); qnv = DOT2(qw.y, nb0.y, qnv); qnv = DOT2(qw.z, nb1.x, qnv); qnv = DOT2(qw.w, nb1.y, qnv); }
                }
                qnv += __shfl_xor(qnv, 32);
#pragma unroll
                for (int g = 0; g < 4; ++g) { const f32x4 av = *(const LAS f32x4*)(wh + 128 + 32 * tb + 8 * g);
#pragma unroll
                    for (int q = 0; q < 4; ++q) ha[4 * g + q] *= av[q]; }
                const float pmt = wr[64 + 32 * tb];
                const int tp = dir ? (63 - 32 * tb) - rj : 32 * tb + rj;
                float ds = 0.f;
#pragma unroll
                for (int sb = 0; sb < 2; ++sb) {
                    __builtin_amdgcn_sched_barrier(0);
                    if (sb != tb && (dir ? sb < tb : sb > tb)) continue;
                    const unsigned ko = qro + sb * 8192u;
                    f32x16 st;
#pragma unroll
                    for (int i = 0; i < 16; ++i) st[i] = 0.f;
#pragma unroll
                    for (int kk = 0; kk < 8; ++kk) { const unsigned c = ((2u * kk) ^ xr) << 4; st = MFMA32(ldsfrag(Kb, ko + c), ldsfrag(Qb, qo + c), st); }
#pragma unroll
                    for (int g = 0; g < 4; ++g) { const f32x4 uv = *(const LAS f32x4*)(wh + 32 * sb + 8 * g);
#pragma unroll
                        for (int q = 0; q < 4; ++q) {
                            const int sc = 32 * sb + q + 8 * g;
                            const int sp = sbase + sgn * sc;
                            st[4 * g + q] *= __builtin_amdgcn_exp2f((sp <= tp) ? uv[q] - pmt : -1e30f);
                            ds += st[4 * g + q];
                        } }
                    ha = MFMA32(pack_step(st, 0), vf[2 * sb], ha);
                    ha = MFMA32(pack_step(st, 1), vf[2 * sb + 1], ha);
                }
                ds += __shfl_xor(ds, 32);
                {
                    const float den = wr[128 + 32 * tb] * qnv + ds;
                    const float rd = 1.0f / fmaxf(fabsf(den), wr[192 + 32 * tb]);
                    if (h4 == 0) wr[320 + 32 * tb] = rd;
                }
                LFENCE();
#pragma unroll
                for (int g = 0; g < 4; ++g) { const f32x4 rv = *(const LAS f32x4*)(wh + 320 + 32 * tb + 8 * g);
#pragma unroll
                    for (int q = 0; q < 4; ++q) { const int tc = 32 * tb + q + 8 * g;
                        *(LAS unsigned short*)(hb + tc * 64) = (unsigned short)(pk2(ha[4 * g + q] * rv[q], 0.f) & 0xffffu); } }
            }
            LFENCE();
            {
                bf16_t* hp = Hout + (size_t)(pos0 + lj) * DM;
                const LAS unsigned char* hrow = hst + lj * 64;
#pragma unroll
                for (int q = 0; q < 4; ++q) *(u32x4*)(hp + 8 * q) = *(const LAS u32x4*)(hrow + 16 * q);
            }
            __builtin_amdgcn_sched_barrier(0);
            bf16x8 vfw[4];
#pragma unroll
            for (int kk = 0; kk < 4; ++kk) {
                const f32x4 w0 = *(const LAS f32x4*)(wh + 256 + 16 * kk), w1 = *(const LAS f32x4*)(wh + 256 + 16 * kk + 8);
                u32x4 p = {pk2(bfs(vf[kk][0]) * w0[0], bfs(vf[kk][1]) * w0[1]), pk2(bfs(vf[kk][2]) * w0[2], bfs(vf[kk][3]) * w0[3]),
                           pk2(bfs(vf[kk][4]) * w1[0], bfs(vf[kk][5]) * w1[1]), pk2(bfs(vf[kk][6]) * w1[2], bfs(vf[kk][7]) * w1[3])};
                vfw[kk] = __builtin_bit_cast(bf16x8, p);
            }
#pragma unroll
            for (int db = 0; db < 4; ++db) {
#pragma unroll
                for (int i = 0; i < 16; ++i) cacc[db][i] *= decay;
                const unsigned to = kro + db * 4096u;
                float nadd = 0.f;
#pragma unroll
                for (int kk = 0; kk < 4; ++kk) {
                    const bf16x8 kv = ldsfrag(KTb, to + (((2u * kk) ^ xd) << 4));
                    const u32x2 wq0 = *(const LAS u32x2*)(wbh + 8 * kk), wq1 = *(const LAS u32x2*)(wbh + 8 * kk + 4); const u32x4 kw = __builtin_bit_cast(u32x4, kv);
                    nadd = DOT2(kw.x, wq0.x, nadd); nadd = DOT2(kw.y, wq0.y, nadd); nadd = DOT2(kw.z, wq1.x, nadd); nadd = DOT2(kw.w, wq1.y, nadd);
                    cacc[db] = MFMA32(kv, vfw[kk], cacc[db]);
                }
                nadd += __shfl_xor(nadd, 32);
                const float nnew = decay * wr[384 + 32 * db] + nadd, npart = __shfl_xor(nnew, 1);
                if (h4 == 0) { wr[384 + 32 * db] = nnew; if ((rj & 1) == 0) nbp[(32 * db + rj) >> 1] = pk2(nnew, npart); }
            }
            LFENCE();
            m = m_new;
        }
        asm volatile("s_waitcnt vmcnt(0)" ::: "memory"); __builtin_amdgcn_s_barrier();
    }
#undef SC_DMA
#undef SC_POS0
}
#undef MFMA32
#undef LFENCE
#undef DOT2
}

DI void mlstm_finish_phase(const Args& A, int wv) {
    const int tid = otid(wv), lane = tid & 63, wave = tid >> 6, G = gridDim.x;
    unsigned char* ws = A.ws;
    const bf16_t* HF = (const bf16_t*)(ws + WS_SCR + M_HF); const bf16_t* HB = (const bf16_t*)(ws + WS_SCR + M_HB);
    const bf16_t* SO = (const bf16_t*)(ws + WS_SCR + M_SO); const bf16_t* SZ = (const bf16_t*)(ws + WS_SCR + M_SZ);
    bf16_t* U = (bf16_t*)(ws + WS_H); const float* hn = A.in[11];
    const int sub = lane >> 5, e0 = (lane & 31) * 8;
    const long NIT = (long)NTOK * 8;
    for (long it0 = ((long)blockIdx.x * NWAVES + wave) * 4 + sub; it0 < NIT; it0 += (long)G * NWAVES * 4) {
        f32x4 f0[2], f1[2], b0[2], b1[2], o0[2], o1[2], z0[2], z1[2];
#pragma unroll
        for (int k = 0; k < 2; ++k) { const long it = it0 + 2 * k; const size_t off = (size_t)(it >> 3) * DM + (int)(it & 7) * 256 + e0;
            ld_bf16x8(HF + off, f0[k], f1[k]); ld_bf16x8(HB + off, b0[k], b1[k]); ld_bf16x8(SO + off, o0[k], o1[k]); ld_bf16x8(SZ + off, z0[k], z1[k]); }
#pragma unroll
        for (int k = 0; k < 2; ++k) { const long it = it0 + 2 * k; const size_t off = (size_t)(it >> 3) * DM + (int)(it & 7) * 256 + e0;
            f32x4 y0 = o0[k] * (f0[k] + b0[k]), y1 = o1[k] * (f1[k] + b1[k]);
            float ss = 0.f;
#pragma unroll
            for (int q = 0; q < 4; ++q) ss += y0[q] * y0[q] + y1[q] * y1[q];
            ss += __shfl_xor(ss, 1); ss += __shfl_xor(ss, 2); ss += __shfl_xor(ss, 4); ss += __shfl_xor(ss, 8); ss += __shfl_xor(ss, 16);
            const float rs = 1.0f / sqrtf(ss * (1.f / 256.f) + EPS);
            const float* hp = hn + (int)(it & 7) * 256 + e0;
            const f32x4 h0 = *(const f32x4*)hp, h1 = *(const f32x4*)(hp + 4);
            st_bf16x8(U + off, y0 * rs * h0 * z0[k], y1 * rs * h1 * z1[k]); }
    }
}

DI void mlstm_layer(const Args& A, LAS unsigned char* lds, const XcdBarrier& gbar, int layer, int wv) {
    unsigned char* ws = A.ws;
    const bf16_t* H = (const bf16_t*)(ws + WS_H); bf16_t* U = (bf16_t*)(ws + WS_H);
    bf16_t* Q = (bf16_t*)(ws + WS_SCR + M_Q); bf16_t* Kb = (bf16_t*)(ws + WS_SCR + M_K); bf16_t* KVT = (bf16_t*)(ws + WS_SCR + M_KVT);
    float* G32 = (float*)(ws + WS_SCR + M_G32); bf16_t* SO = (bf16_t*)(ws + WS_SCR + M_SO); bf16_t* SZ = (bf16_t*)(ws + WS_SCR + M_SZ);
    norm_phase(A, layer, false, wv);
    xcd_barrier(gbar, wv);
    {
        DescM1 D; D.init(H, (const bf16_t*)(ws + WS_WMA), (const bf16_t*)(ws + WS_WMB));
        auto E = [=](const pg8::Unit& u, int row_l, int col_l, f32x4 v0, f32x4 v1) {
            if (u.i2 == 0) {
                const size_t row = (size_t)u.i0 * 256 + row_l; const int pn = u.i1;
                if (pn < 4) st_bf16x8(Q + row * 1024 + pn * 256 + col_l, v0 * 0.088388347648318440f, v1 * 0.088388347648318440f);
                else if (pn < 8) { st_bf16x8(Kb + row * 1024 + (pn - 4) * 256 + col_l, v0, v1);
                    const int bb = u.i0 / 9, sp = (u.i0 % 9) * 256 + row_l;
                    bf16_t* kt = KVT + ((size_t)bb * 3072 + (pn - 4) * 256 + col_l) * TB + sp;
                    const unsigned w0 = pk2(v0[0], v0[1]), w1 = pk2(v0[2], v0[3]), w2 = pk2(v1[0], v1[1]), w3 = pk2(v1[2], v1[3]);
                    kt[0] = (bf16_t)(w0 & 0xffffu); kt[TB] = (bf16_t)(w0 >> 16); kt[2 * TB] = (bf16_t)(w1 & 0xffffu); kt[3 * TB] = (bf16_t)(w1 >> 16);
                    kt[4 * TB] = (bf16_t)(w2 & 0xffffu); kt[5 * TB] = (bf16_t)(w2 >> 16); kt[6 * TB] = (bf16_t)(w3 & 0xffffu); kt[7 * TB] = (bf16_t)(w3 >> 16); }
                else if (col_l < 32) { *(f32x4*)(G32 + row * 32 + col_l) = v0; *(f32x4*)(G32 + row * 32 + col_l + 4) = v1; }
            } else {
                const int bb = u.i1 / 9, s0 = (u.i1 % 9) * 256;
                st_bf16x8(KVT + ((size_t)bb * 3072 + 1024 + u.i0 * 256 + row_l) * TB + s0 + col_l, v0, v1);
            }
        };
        pg8::gemm_phase(lds, D, E, wv);
    }
    xcd_barrier(gbar, wv);
    ml::scan_phase(A, lds, wv);
    xcd_barrier(gbar, wv);
    {
        DescPlain D; D.init(H, (const bf16_t*)(ws + WS_WMA) + (size_t)2304 * DM, 16, false);
        auto E = [=](const pg8::Unit& u, int row_l, int col_l, f32x4 v0, f32x4 v1) {
            const size_t row = (size_t)u.i0 * 256 + row_l; const int pn = u.i1; f32x4 a, b;
            if (pn < 8) {
#pragma unroll
                for (int q = 0; q < 4; ++q) { a[q] = sigmf(v0[q]); b[q] = sigmf(v1[q]); }
                st_bf16x8(SO + row * DM + pn * 256 + col_l, a, b);
            } else {
#pragma unroll
                for (int q = 0; q < 4; ++q) { a[q] = siluf(v0[q]); b[q] = siluf(v1[q]); }
                st_bf16x8(SZ + row * DM + (pn - 8) * 256 + col_l, a, b);
            }
        };
        pg8::gemm_phase(lds, D, E, wv);
    }
    xcd_barrier(gbar, wv);
    mlstm_finish_phase(A, wv);
    xcd_barrier(gbar, wv);
    {
        DescPlain D; D.init(U, (const bf16_t*)(ws + WS_WMO), 8, false);
        EpiResid E; E.init(A, layer);
        pg8::gemm_phase(lds, D, E, wv);
    }
    xcd_barrier(gbar, wv);
}

__global__ void __launch_bounds__(NTHREADS, 2) fwd_megakernel(Args A) {
    extern __shared__ __attribute__((aligned(16))) unsigned char lds_raw[];
    LAS unsigned char* lds = (LAS unsigned char*)lds_raw;
    cg::grid_group grid = cg::this_grid();
    const int wv = __builtin_amdgcn_readfirstlane(threadIdx.x >> 6);
    volatile LAS unsigned* bst = (volatile LAS unsigned*)(lds + 152576);
    if (otid(wv) < 2) bst[otid(wv)] = 0u;
    __syncthreads();
    const XcdBarrier gbar = xcd_barrier_post((unsigned*)(A.ws + WS_BAR), bst, wv);
    prep_phase(A, lds, wv);
    grid.sync();
    {
        const long long* mi = (const long long*)(A.ws + WS_MODI); float* mf = (float*)(A.ws + WS_MOD);
        for (int i = blockIdx.x * NTHREADS + otid(wv); i < 4 * 17 * MOD_LD; i += gridDim.x * NTHREADS) mf[i] = (float)mi[i] * MODI_INV;
    }
    xcd_barrier(gbar, wv);
    fnet_layer(A, lds, gbar, 0, 0, false, wv);
    mlstm_layer(A, lds, gbar, 1, wv);
    attn_layer(A, lds, (char*)lds_raw, gbar, 2, wv);
    fnet_layer(A, lds, gbar, 3, 1, true, wv);
    final_norm_phase(A, (const bf16_t*)(A.ws + WS_SCR + F_PQX), wv);
}

extern "C" void kernel_launch(void* const* d_in, const int* in_sizes, int n_in, void* d_out, int out_size, void* d_ws, size_t ws_size, hipStream_t stream) {
    static int grid = 0;
    if (grid == 0) {
        if (n_in != 18 || ws_size < WS_END) { fprintf(stderr, "kernel_launch: unexpected n_in %d / ws_size %zu (need %zu)\n", n_in, ws_size, (size_t)WS_END); grid = -1; return; }
        int dev = 0, cus = 0, per_cu = 0;
        hipGetDevice(&dev);
        hipDeviceGetAttribute(&cus, hipDeviceAttributeMultiprocessorCount, dev);
        if (hipFuncSetAttribute((const void*)fwd_megakernel, hipFuncAttributeMaxDynamicSharedMemorySize, LDS_BYTES) != hipSuccess) { fprintf(stderr, "kernel_launch: hipFuncSetAttribute failed\n"); grid = -1; return; }
        if (hipOccupancyMaxActiveBlocksPerMultiprocessor(&per_cu, (const void*)fwd_megakernel, NTHREADS, LDS_BYTES) != hipSuccess || per_cu < 1) { fprintf(stderr, "kernel_launch: occupancy query failed (%d)\n", per_cu); per_cu = 1; }
        (void)hipGetLastError();
        grid = cus * per_cu;
        fprintf(stderr, "kernel_launch: grid %d (cus %d x %d)\n", grid, cus, per_cu);
    }
    if (grid < 0) return;
    (void)hipMemsetAsync((char*)d_ws + WS_MOD, 0, ZERO_BYTES, stream);
    (void)hipMemsetAsync((char*)d_ws + WS_MODI, 0, MODI_BYTES, stream);
    Args a{};
    for (int i = 0; i < 18; ++i) a.in[i] = (const float*)d_in[i];
    a.out = (float*)d_out; a.ws = (unsigned char*)d_ws; a.ph_lo = 0; a.ph_hi = 100;
    void* args[] = {&a};
    hipError_t e = hipLaunchCooperativeKernel((const void*)fwd_megakernel, dim3(grid), dim3(NTHREADS), args, LDS_BYTES, stream);
    if (e != hipSuccess) fprintf(stderr, "kernel_launch: cooperative launch failed: %s (grid %d)\n", hipGetErrorString(e), grid);
}
```

```cpp
#include <hip/hip_runtime.h>
#include <hip/hip_cooperative_groups.h>
#include <cstdio>
#include <cstdint>
#include <type_traits>
namespace cg = cooperative_groups;

#define LAS __attribute__((address_space(3)))
#define DI __device__ __forceinline__
typedef unsigned short bf16_t;
typedef short bf16x8 __attribute__((ext_vector_type(8)));
typedef short s16x4 __attribute__((ext_vector_type(4)));
typedef float f32x2 __attribute__((ext_vector_type(2)));
typedef float f32x4 __attribute__((ext_vector_type(4)));
typedef float f32x16 __attribute__((ext_vector_type(16)));
typedef unsigned u32x2 __attribute__((ext_vector_type(2)));
typedef unsigned u32x4 __attribute__((ext_vector_type(4)));
typedef __bf16 bf16v2 __attribute__((ext_vector_type(2)));

constexpr int DM = 2048, NB = 16, TL = 2048, TC = 256, TB = TL + TC, NTOK = NB * TB;
constexpr int NWAVES = 8, NTHREADS = 512;
constexpr float EPS = 1e-6f;
constexpr int MOD_LD = 3 * DM;
constexpr int M_WA_ROWS = 6400, M_WB_ROWS = 3072;
constexpr size_t MiB = 1u << 20;
constexpr size_t WS_SCR_ = 301 * MiB;
constexpr size_t WS_MOD = 0;
constexpr size_t MOD_BYTES = (size_t)4 * 17 * MOD_LD * 4;
constexpr size_t WS_BAR = 1792 * 1024, ZERO_BYTES = 2 * MiB;
constexpr size_t WS_MODI = WS_SCR_ + 700 * MiB, MODI_BYTES = (size_t)4 * 17 * MOD_LD * 8;
constexpr float MODI_SCALE = 1073741824.f, MODI_INV = 9.313225746154785e-10f;
constexpr size_t WS_MODP = WS_SCR_ + 660 * MiB;
constexpr size_t WS_WFG = 2 * MiB, WS_WFO = 18 * MiB, WS_WMA = 34 * MiB, WS_WMB = 59 * MiB, WS_WMO = 71 * MiB, WS_WAI = 79 * MiB, WS_WAO = 99 * MiB;
constexpr size_t WS_DC = 107 * MiB, WS_DT = 108 * MiB, WS_DT2 = 124 * MiB, WS_CTXS = 125 * MiB, WS_H = 157 * MiB, WS_SCR = 301 * MiB;
constexpr size_t WS_END = 1024 * MiB;
constexpr size_t F_G = 0, F_PQX = 144 * MiB, F_PQC = 400 * MiB, F_A1 = 432 * MiB;
constexpr size_t M_Q = 0, M_K = 72 * MiB, M_KVT = 144 * MiB, M_G32 = 360 * MiB, M_HF = 365 * MiB, M_HB = 509 * MiB, M_SO = 0, M_SZ = 144 * MiB;
constexpr size_t A_Q = 0, A_K = 144 * MiB, A_V = 180 * MiB, A_SZ = 216 * MiB;
static_assert(WS_SCR + M_HB + 144 * MiB <= WS_END, "ws map");
constexpr int LDS_BYTES = 152576 + 1024;

DI unsigned pk2(float a, float b) { f32x2 v = {a, b}; return __builtin_bit_cast(unsigned, __builtin_convertvector(v, bf16v2)); }
DI float bf_lo(unsigned w) { return __uint_as_float(w << 16); }
DI float bf_hi(unsigned w) { return __uint_as_float(w & 0xffff0000u); }
DI float wave_sum(float v) {
#pragma unroll
    for (int o = 1; o < 64; o <<= 1) v += __shfl_xor(v, o);
    return v;
}
DI int otid(int wv) { int t; asm volatile("v_mbcnt_lo_u32_b32 %0, -1, 0\n\tv_mbcnt_hi_u32_b32 %0, -1, %0" : "=v"(t)); return wv * 64 + t; }
DI float dot2g(unsigned a, unsigned b, float c) { asm("v_dot2c_f32_bf16 %0, %1, %2" : "+v"(c) : "v"(a), "v"(b)); return c; }
DI float siluf(float x) { return x * __builtin_amdgcn_rcpf(1.f + __expf(-x)); }
DI float sigmf(float x) { return __builtin_amdgcn_rcpf(1.f + __expf(-x)); }
DI void st_bf16x8(bf16_t* p, f32x4 a, f32x4 b) { u32x4 w = {pk2(a[0], a[1]), pk2(a[2], a[3]), pk2(b[0], b[1]), pk2(b[2], b[3])}; *(u32x4*)p = w; }
DI void ld_bf16x8(const bf16_t* p, f32x4& a, f32x4& b) { const u32x4 w = *(const u32x4*)p; a = (f32x4){bf_lo(w.x), bf_hi(w.x), bf_lo(w.y), bf_hi(w.y)}; b = (f32x4){bf_lo(w.z), bf_hi(w.z), bf_lo(w.w), bf_hi(w.w)}; }

DI f32x4 ldmod4(const long long* p) { return (f32x4){(float)p[0] * MODI_INV, (float)p[1] * MODI_INV, (float)p[2] * MODI_INV, (float)p[3] * MODI_INV}; }

struct Args { const float* in[18]; float* out; unsigned char* ws; int ph_lo, ph_hi; };

#define XB_TMO      128
#define XB_XCNT(j)  (256  + 64 * (j))
#define XB_XSUB(j)  (1280 + 64 * (j))
#define XB_XGEN(j)  (2304 + 64 * (j))
#define XB_TOP      3328
#define XB_TOPGEN   3392
#define XCD_BAR_WORDS 3456
#define XB_SPIN_CAP (1u << 18)

__device__ __forceinline__ unsigned xb_ld(unsigned* p)              { return __hip_atomic_load(p, __ATOMIC_RELAXED, __HIP_MEMORY_SCOPE_AGENT); }
__device__ __forceinline__ unsigned xb_add(unsigned* p, unsigned v) { return __hip_atomic_fetch_add(p, v, __ATOMIC_RELAXED, __HIP_MEMORY_SCOPE_AGENT); }
__device__ __forceinline__ unsigned xb_xcc_id() { return (unsigned)__builtin_amdgcn_s_getreg((3 << 11) | 20) & 0xFu; }
#define XB_SPIN(cond, bar) do { unsigned _sp = 0; while (cond) { __builtin_amdgcn_s_sleep(1); \
    if ((++_sp & 255u) == 0u) { if (xb_ld(&(bar)[XB_TMO])) break; if (_sp > XB_SPIN_CAP) { atomicAdd(&(bar)[XB_TMO], 1u); break; } } } } while (0)

struct XcdBarrier {
    unsigned* bar; unsigned x;
    volatile LAS unsigned* st;
};

__device__ __forceinline__ XcdBarrier xcd_barrier_post(unsigned* bar, volatile LAS unsigned* st, int wv) {
    XcdBarrier b; b.bar = bar; b.x = xb_xcc_id(); b.st = st;
    if (otid(wv) == 0) (void)xb_add(&bar[XB_XCNT(b.x)], 1u);
    return b;
}
__device__ __forceinline__ void xcd_barrier_complete(unsigned* bar, unsigned x, unsigned& nloc, unsigned& nx) {
    const unsigned G = gridDim.x * gridDim.y * gridDim.z;
    unsigned sum, cnt, mine, sp = 0u;
    for (;;) {
        sum = 0u; cnt = 0u; mine = 0u;
#pragma unroll
        for (unsigned j = 0; j < 16; ++j) { const unsigned c = xb_ld(&bar[XB_XCNT(j)]); sum += c; cnt += (c > 0u) ? 1u : 0u; mine = (j == x) ? c : mine; }
        if (sum == G) break;
        __builtin_amdgcn_s_sleep(1);
        if ((++sp & 255u) == 0u) { if (xb_ld(&bar[XB_TMO])) break; if (sp > XB_SPIN_CAP) { atomicAdd(&bar[XB_TMO], 1u); break; } }
    }
    nloc = mine > 0u ? mine : 1u; nx = cnt > 0u ? cnt : 1u;
}

__device__ __forceinline__ void xcd_barrier(const XcdBarrier& b, int wv) {
    asm volatile("s_waitcnt vmcnt(0)" ::: "memory");
    __syncthreads();
    if (otid(wv) == 0) {
        unsigned* bar = b.bar;
        __builtin_amdgcn_s_waitcnt(0);
        unsigned nloc = b.st[0], nx = b.st[1];
        if (nloc == 0u) { xcd_barrier_complete(bar, b.x, nloc, nx); b.st[0] = nloc; b.st[1] = nx; }
        const unsigned old = xb_add(&bar[XB_XSUB(b.x)], 1u);
        const unsigned gen = old / nloc;
        if (old + 1u == (gen + 1u) * nloc) {
            __builtin_amdgcn_fence(__ATOMIC_RELEASE, "agent");
            asm volatile("s_waitcnt vmcnt(0)" ::: "memory");
            const unsigned og = xb_add(&bar[XB_TOP], 1u);
            const unsigned tg = og / nx;
            if (og + 1u == (tg + 1u) * nx) xb_add(&bar[XB_TOPGEN], 1u);
            else XB_SPIN(xb_ld(&bar[XB_TOPGEN]) == tg, bar);
            __builtin_amdgcn_fence(__ATOMIC_ACQUIRE, "agent");
            xb_add(&bar[XB_XGEN(b.x)], 1u);
            asm volatile("s_waitcnt vmcnt(0)" ::: "memory");
        } else {
            XB_SPIN(xb_ld(&bar[XB_XGEN(b.x)]) == gen, bar);
            __builtin_amdgcn_fence(__ATOMIC_ACQUIRE, "agent");
            asm volatile("s_waitcnt vmcnt(0)" ::: "memory");
        }
    }
    __syncthreads();
}


namespace pg8 {
constexpr int BM = 256, BK = 64, HALF = 128, HTB = HALF * BK * 2, NXCD = 8;
DI int lds_byte(int r, int c) { const int st = (r >> 4) * 2 + (c >> 5), rr = r & 15, cc = c & 31, ob = rr * 64 + cc * 2; return st * 1024 + (ob ^ (((ob >> 9) & 1) << 5)); }
DI void stage_rc(int b, int& R, int& C) { const int st = b / 1024, sb = b % 1024, swz = sb ^ (((sb >> 9) & 1) << 5); R = (st >> 1) * 16 + swz / 64; C = (st & 1) * 32 + (swz % 64) / 2; }
DI int perm32(int rho) { const int n = rho >> 4, i = rho & 15; return 8 * (i >> 2) + 4 * n + (i & 3); }
struct Unit { const char* a; const char* b; int i0, i1, i2; };
template <class T, class = void> struct is_whole_tile : std::false_type {};
template <class T> struct is_whole_tile<T, std::void_t<decltype(T::WHOLE_TILE)>> : std::true_type {};
DI int xcd_remap(int L, int total) { const int q = total / NXCD, r = total % NXCD, xcd = L % NXCD, off = L / NXCD; return (xcd < r ? xcd * (q + 1) : r * (q + 1) + (xcd - r) * q) + off; }

template <class Desc, class Epi>
DI void gemm_phase(LAS unsigned char* lds, const Desc& D, const Epi& E, int wv) {
    const int tid = otid(wv), wid = __builtin_amdgcn_readfirstlane(tid >> 6), lane = tid & 63, wr = wid >> 2, wc = wid & 3, fr = lane & 15, fq = lane >> 4;
    const int G = gridDim.x, c = blockIdx.x, total = D.total;
    const int K = D.K, nt = K / BK;
    unsigned voffA[2], voffB[2];
#pragma unroll
    for (int i = 0; i < 2; ++i) { int R, C; stage_rc(tid * 16 + i * 8192, R, C); const int Rb = (R & ~31) + perm32(R & 31);
        voffA[i] = (unsigned)(R * D.lda + C) * 2u; voffB[i] = (unsigned)(Rb * D.ldb + C) * 2u; }
    const size_t kstep = (size_t)(BK * 2);
    const size_t hstepA = (size_t)HALF * D.lda * 2, hstepB = (size_t)HALF * D.ldb * 2;
    const unsigned ldsw = (unsigned)wid * 1024u;
    const int aoff = lds_byte(wr * 64 + fr, fq * 8), boff = lds_byte(wc * 32 + fr, fq * 8);
#define PG8_SA(b, h) (((b) * 2 + (h)) * HTB)
#define PG8_SB(b, h) ((4 + (b) * 2 + (h)) * HTB)
#define PG8_STAGE(bufoff, gbase, voff) do { _Pragma("unroll") for (int _i = 0; _i < 2; ++_i) \
        __builtin_amdgcn_global_load_lds((const unsigned*)((const char*)(gbase) + (voff)[_i]), (LAS unsigned*)(lds + (bufoff) + ldsw + _i * 8192), 16, 0, 0); } while (0)
#define PG8_LDA(dst, b, h) do { _Pragma("unroll") for (int m = 0; m < 4; ++m) _Pragma("unroll") for (int k = 0; k < 2; ++k) dst[m][k] = *(const LAS bf16x8*)(lds + PG8_SA(b, h) + aoff + m * 2048 + k * 1024); } while (0)
#define PG8_LDB(dst, b, h) do { _Pragma("unroll") for (int n = 0; n < 2; ++n) _Pragma("unroll") for (int k = 0; k < 2; ++k) dst[n][k] = *(const LAS bf16x8*)(lds + PG8_SB(b, h) + boff + n * 2048 + k * 1024); } while (0)
#define PG8_MMA(ai, bj, At, Bt) do { __builtin_amdgcn_s_setprio(1); _Pragma("unroll") for (int m = 0; m < 4; ++m) _Pragma("unroll") for (int n = 0; n < 2; ++n) _Pragma("unroll") for (int k = 0; k < 2; ++k) \
        acc[ai][bj][m][n] = __builtin_amdgcn_mfma_f32_16x16x32_bf16(Bt[n][k], At[m][k], acc[ai][bj][m][n], 0, 0, 0); __builtin_amdgcn_s_setprio(0); } while (0)
#define PG8_WAIT_V(n) asm volatile("s_waitcnt vmcnt(" #n ")" ::: "memory")
#define PG8_WAIT_L(n) asm volatile("s_waitcnt lgkmcnt(" #n ")" ::: "memory")
#define PG8_BAR __builtin_amdgcn_s_barrier()
#define PG8_SCHED __builtin_amdgcn_sched_barrier(0)
    if constexpr (Desc::RAW) { if (!D.valid(c, G)) return; } else { if (c >= total) return; }
    Unit cur, nxt; int ui = 0;
    if constexpr (Desc::RAW) cur = D.unit(c, G); else cur = D.unit(xcd_remap(c, total));
    nxt = cur;
    f32x4 acc[2][2][4][2];
#pragma unroll
    for (int a = 0; a < 2; ++a)
#pragma unroll
        for (int b = 0; b < 2; ++b)
#pragma unroll
            for (int m = 0; m < 4; ++m)
#pragma unroll
                for (int n = 0; n < 2; ++n) acc[a][b][m][n] = (f32x4){0.f, 0.f, 0.f, 0.f};
    bf16x8 At[4][2], B0[2][2], B1[2][2];
    const char* cA = cur.a; const char* cB = cur.b;
    PG8_STAGE(PG8_SB(0, 0), cB, voffB); PG8_STAGE(PG8_SB(0, 1), cB + hstepB, voffB); PG8_STAGE(PG8_SA(0, 0), cA, voffA); PG8_STAGE(PG8_SA(0, 1), cA + hstepA, voffA);
    if (wr == 1) PG8_BAR;
    PG8_WAIT_V(2); PG8_BAR;
    PG8_STAGE(PG8_SB(1, 0), cB + kstep, voffB); PG8_STAGE(PG8_SA(1, 0), cA + kstep, voffA); PG8_STAGE(PG8_SB(1, 1), cB + hstepB + kstep, voffB);
    PG8_WAIT_V(6); PG8_BAR;
    for (;;) {
        const long Ln = (long)(ui + 1) * G + c;
        bool has_next;
        if constexpr (Desc::RAW) { has_next = D.valid((int)Ln, G); if (has_next) nxt = D.unit((int)Ln, G); }
        else { has_next = Ln < total; if (has_next) nxt = D.unit(xcd_remap((int)Ln, total)); }
        const char* nA = has_next ? nxt.a : cA; const char* nB = has_next ? nxt.b : cB;
        for (int t = 0; t < nt; t += 2) {
            const bool last = (t == nt - 2);
            const char* a1 = cA + (size_t)(t + 1) * kstep;
            const char* a2 = last ? nA : cA + (size_t)(t + 2) * kstep; const char* b2 = last ? nB : cB + (size_t)(t + 2) * kstep;
            const char* a3 = a2 + kstep; const char* b3 = b2 + kstep;
            PG8_LDB(B0, 0, 0); PG8_LDB(B1, 0, 1); PG8_SCHED; PG8_LDA(At, 0, 0); PG8_STAGE(PG8_SA(1, 1), a1 + hstepA, voffA);
            PG8_WAIT_V(8); PG8_WAIT_L(0); PG8_BAR; PG8_MMA(0, 0, At, B0); PG8_MMA(0, 1, At, B1); PG8_BAR; PG8_SCHED;
            PG8_LDA(At, 0, 1); PG8_STAGE(PG8_SB(0, 0), b2, voffB); PG8_STAGE(PG8_SB(0, 1), b2 + hstepB, voffB); PG8_STAGE(PG8_SA(0, 0), a2, voffA);
            PG8_WAIT_V(8); PG8_WAIT_L(0); PG8_BAR; PG8_MMA(1, 0, At, B0); PG8_MMA(1, 1, At, B1); PG8_BAR; PG8_SCHED;
            PG8_LDB(B0, 1, 0); PG8_LDB(B1, 1, 1); PG8_SCHED; PG8_LDA(At, 1, 0); PG8_STAGE(PG8_SA(0, 1), a2 + hstepA, voffA);
            PG8_WAIT_V(8); PG8_WAIT_L(0); PG8_BAR; PG8_MMA(0, 0, At, B0); PG8_MMA(0, 1, At, B1); PG8_BAR; PG8_SCHED;
            PG8_LDA(At, 1, 1); PG8_STAGE(PG8_SB(1, 0), b3, voffB); PG8_STAGE(PG8_SB(1, 1), b3 + hstepB, voffB); PG8_STAGE(PG8_SA(1, 0), a3, voffA);
            PG8_WAIT_V(8); PG8_WAIT_L(0); PG8_BAR; PG8_MMA(1, 0, At, B0); PG8_MMA(1, 1, At, B1); PG8_BAR; PG8_SCHED;
        }
        if (wr == 0) PG8_BAR;
        {
            const int le = otid(wv) & 63, fre = le & 15, fqe = le >> 4;
            if constexpr (is_whole_tile<Epi>::value) E.run(cur, acc, wr, wc, fre, fqe); else
#pragma unroll
            for (int ai = 0; ai < 2; ++ai)
#pragma unroll
                for (int m = 0; m < 4; ++m)
#pragma unroll
                    for (int bj = 0; bj < 2; ++bj)
                        E(cur, ai * HALF + wr * 64 + m * 16 + fre, bj * HALF + wc * 32 + 8 * fqe, acc[ai][bj][m][0], acc[ai][bj][m][1]);
        }
        if (!has_next) break;
#pragma unroll
        for (int a = 0; a < 2; ++a)
#pragma unroll
            for (int b = 0; b < 2; ++b)
#pragma unroll
                for (int m = 0; m < 4; ++m)
#pragma unroll
                    for (int n = 0; n < 2; ++n) acc[a][b][m][n] = (f32x4){0.f, 0.f, 0.f, 0.f};
        cur = nxt; cA = nA; cB = nB; ++ui;
        if (wr == 1) PG8_BAR;
    }
    PG8_WAIT_V(0);
    PG8_BAR;
#undef PG8_SA
#undef PG8_SB
#undef PG8_STAGE
#undef PG8_LDA
#undef PG8_LDB
#undef PG8_MMA
#undef PG8_WAIT_V
#undef PG8_WAIT_L
#undef PG8_BAR
#undef PG8_SCHED
}
}

DI void transpose_item(const float* W, int N, int kb, int nb, bf16_t* d0, bf16_t* d1, int K, LAS float* scr, int lane) {
    const int k0 = 64 * kb, n0 = 32 * nb;
#pragma unroll 8
    for (int i = 0; i < 32; ++i) { const int kk = 2 * i + (lane >> 5); scr[kk * 33 + (lane & 31)] = W[(size_t)(k0 + kk) * N + n0 + (lane & 31)]; }
    asm volatile("s_waitcnt lgkmcnt(0)" ::: "memory");
    const int c = lane & 7;
#pragma unroll
    for (int j = 0; j < 4; ++j) { const int n = (lane >> 3) + 8 * j; const LAS float* s = scr + (8 * c) * 33 + n;
        u32x4 o; o.x = pk2(s[0 * 33], s[1 * 33]); o.y = pk2(s[2 * 33], s[3 * 33]); o.z = pk2(s[4 * 33], s[5 * 33]); o.w = pk2(s[6 * 33], s[7 * 33]);
        *(u32x4*)(d0 + (size_t)n * K + k0 + 8 * c) = o;
        if (d1) *(u32x4*)(d1 + (size_t)n * K + k0 + 8 * c) = o; }
    asm volatile("s_waitcnt lgkmcnt(0)" ::: "memory");
}

DI void prep_phase(const Args& A, LAS unsigned char* lds, int wv) {
    const int tid = otid(wv), lane = tid & 63, wave = tid >> 6, G = gridDim.x;
    unsigned char* ws = A.ws;
    {
        LAS float* s_lds = (LAS float*)lds;
        const float* cc = A.in[1]; const float* cctx = A.in[3]; const float* aw = A.in[4]; const float* ab = A.in[5];
        float* modp = (float*)(ws + WS_MODP);
        for (int item = blockIdx.x; item < 768; item += G) {
            const int kc = item % 16, cb = (item / 16) % 12, l = item / 192;
            const int k0 = kc * 128, j = cb * 512 + tid;
            __syncthreads();
            for (int e = tid; e < 17 * 128; e += NTHREADS) { const int r = e / 128, k = e % 128; const float v = r < 16 ? cc[r * DM + k0 + k] : cctx[k0 + k]; s_lds[k * 20 + r] = siluf(v); }
            __syncthreads();
            float acc[17];
#pragma unroll
            for (int r = 0; r < 17; ++r) acc[r] = 0.f;
            const float* wp = aw + ((size_t)l * DM + k0) * MOD_LD + j;
#pragma unroll 4
            for (int k = 0; k < 128; ++k) {
                const float w = wp[(size_t)k * MOD_LD];
                const LAS f32x4* sp = (const LAS f32x4*)(s_lds + k * 20);
                const f32x4 s0 = sp[0], s1 = sp[1], s2 = sp[2], s3 = sp[3]; const float s4 = s_lds[k * 20 + 16];
#pragma unroll
                for (int q = 0; q < 4; ++q) { acc[q] += s0[q] * w; acc[4 + q] += s1[q] * w; acc[8 + q] += s2[q] * w; acc[12 + q] += s3[q] * w; }
                acc[16] += s4 * w;
            }
            const float bias = (kc == 0) ? ab[l * MOD_LD + j] : 0.f;
#pragma unroll
            for (int r = 0; r < 17; ++r) modp[((size_t)(kc * 4 + l) * 17 + r) * MOD_LD + j] = acc[r] + bias;
        }
        __syncthreads();
    }
    {
        LAS float* scr = (LAS float*)(lds + wave * 16384);
        const int gw = blockIdx.x * NWAVES + wave, NGW = G * NWAVES;
        constexpr int I_SQ = 32 * 64, I_AI = 32 * 160, I_MI = 32 * 257;
        constexpr int NIT = 6 * I_SQ + I_AI + I_MI;
        for (int it = gw; it < NIT; it += NGW) {
            int r = it;
            if (r < 6 * I_SQ) {
                const int w = r / I_SQ; r -= w * I_SQ;
                const float* src; bf16_t* dst;
                if (w < 2)      { src = A.in[7] + (size_t)w * DM * DM;       dst = (bf16_t*)(ws + WS_WFG) + (size_t)w * DM * DM; }
                else if (w < 4) { src = A.in[8] + (size_t)(w - 2) * DM * DM; dst = (bf16_t*)(ws + WS_WFO) + (size_t)(w - 2) * DM * DM; }
                else if (w == 4) { src = A.in[12]; dst = (bf16_t*)(ws + WS_WMO); }
                else             { src = A.in[16]; dst = (bf16_t*)(ws + WS_WAO); }
                const int kb = r / 64, nb = r % 64;
                transpose_item(src, DM, kb, nb, dst + (size_t)(32 * nb) * DM, nullptr, DM, scr, lane);
                continue;
            }
            r -= 6 * I_SQ;
            if (r < I_AI) { const int kb = r / 160, nb = r % 160; transpose_item(A.in[13], 5120, kb, nb, (bf16_t*)(ws + WS_WAI) + (size_t)(32 * nb) * DM, nullptr, DM, scr, lane); continue; }
            r -= I_AI;
            {
                const int kb = r / 257, nb = r % 257, n0 = 32 * nb;
                bf16_t* WA = (bf16_t*)(ws + WS_WMA); bf16_t* WB = (bf16_t*)(ws + WS_WMB);
                bf16_t* d0; bf16_t* d1 = nullptr;
                if (n0 < 1024) d0 = WA + (size_t)n0 * DM;
                else if (n0 < 2048) d0 = WA + (size_t)n0 * DM;
                else if (n0 < 4096) d0 = WB + (size_t)(n0 - 2048) * DM;
                else if (n0 < 6144) d0 = WA + (size_t)(2304 + n0 - 4096) * DM;
                else if (n0 < 6176) d0 = WA + (size_t)(2048 + n0 - 6144) * DM;
                else d0 = WA + (size_t)(4352 + n0 - 6176) * DM;
                transpose_item(A.in[9], 8224, kb, nb, d0, d1, DM, scr, lane);
            }
        }
    }
    {
        const long gt = (long)blockIdx.x * NTHREADS + tid, NGT = (long)G * NTHREADS;
        constexpr long N_DC = 512L * 512 / 8, N_DT = 2048L * 4096 / 8, N_DT2 = 256L * 512 / 8;
        for (long it = gt; it < N_DC + N_DT + N_DT2; it += NGT) {
            float v[8]; bf16_t* dst;
            if (it < N_DC) {
                const int m = (int)(it / 64), k0 = (int)(it % 64) * 8; const float sc = 0.044194173824159216f;
#pragma unroll
                for (int j = 0; j < 8; ++j) { const int mm = (m <= 256) ? m : m - 256; const int rr = (mm * (k0 + j)) & 511; const float ang = (float)rr * (1.f / 256.f); v[j] = (m <= 256 ? cospif(ang) : sinpif(ang)) * sc; }
                dst = (bf16_t*)(ws + WS_DC) + (size_t)m * 512 + k0;
            } else if (it < N_DC + N_DT) {
                const long i2 = it - N_DC; const int kk = (int)(i2 / 512), s0 = (int)(i2 % 512) * 8; const float sc = 0.022097086912079608f;
#pragma unroll
                for (int j = 0; j < 8; ++j) { const int s = s0 + j; const int rr = (kk * (s & 2047)) & 2047; const float ang = (float)rr * (1.f / 1024.f); v[j] = (s < 2048 ? cospif(ang) : -sinpif(ang)) * sc; }
                dst = (bf16_t*)(ws + WS_DT) + (size_t)kk * 4096 + s0;
            } else {
                const long i2 = it - N_DC - N_DT; const int kk = (int)(i2 / 64), s0 = (int)(i2 % 64) * 8; const float sc = 0.0625f;
#pragma unroll
                for (int j = 0; j < 8; ++j) { const int s = s0 + j; const int rr = (kk * (s & 255)) & 255; const float ang = (float)rr * (1.f / 128.f); v[j] = (s < 256 ? cospif(ang) : -sinpif(ang)) * sc; }
                dst = (bf16_t*)(ws + WS_DT2) + (size_t)kk * 512 + s0;
            }
            u32x4 o = {pk2(v[0], v[1]), pk2(v[2], v[3]), pk2(v[4], v[5]), pk2(v[6], v[7])};
            *(u32x4*)dst = o;
        }
    }
}

DI const float* xrow_in(const Args& A, int r) {
    const int b = r / TB, t = r % TB;
    if (t < TL) return A.in[0] + ((size_t)b * TL + t) * DM;
    return A.in[2] + ((size_t)b * TC + (t - TL)) * DM;
}
DI void norm_phase(const Args& A, int layer, bool latonly, int wv) {
    const int tid = otid(wv), lane = tid & 63, wave = tid >> 6, G = gridDim.x;
    const float* ng = A.in[6] + (size_t)layer * DM;
    const float* mod = (const float*)(A.ws + WS_MOD) + (size_t)layer * 17 * MOD_LD;
    bf16_t* H = (bf16_t*)(A.ws + WS_H);
    const bf16_t* XB = (const bf16_t*)A.out;
    for (int r0 = (blockIdx.x * NWAVES + wave) * 2; r0 < NTOK; r0 += G * NWAVES * 2) {
        const int b = r0 / TB, t = r0 % TB;
        if (latonly && t >= TL) continue;
        const float* mr = mod + (size_t)(t < TL ? b : 16) * MOD_LD;
        f32x4 v[2][4][2];
#pragma unroll
        for (int k = 0; k < 2; ++k) {
            const int r = r0 + k;
            if (layer == 0) {
                const float* xr = xrow_in(A, r);
#pragma unroll
                for (int j = 0; j < 4; ++j) { const f32x4* p = (const f32x4*)(xr + 512 * j + 8 * lane); v[k][j][0] = p[0]; v[k][j][1] = p[1]; }
            } else {
#pragma unroll
                for (int j = 0; j < 4; ++j) ld_bf16x8(XB + (size_t)r * DM + 512 * j + 8 * lane, v[k][j][0], v[k][j][1]);
            }
        }
#pragma unroll
        for (int k = 0; k < 2; ++k) {
            const int r = r0 + k; float ss = 0.f;
#pragma unroll
            for (int j = 0; j < 4; ++j)
#pragma unroll
                for (int q = 0; q < 4; ++q) ss += v[k][j][0][q] * v[k][j][0][q] + v[k][j][1][q] * v[k][j][1][q];
            const float rs = 1.0f / sqrtf(wave_sum(ss) * (1.f / DM) + EPS);
#pragma unroll
            for (int j = 0; j < 4; ++j) { const int c0 = 512 * j + 8 * lane; f32x4 o[2];
#pragma unroll
                for (int h = 0; h < 2; ++h) { const f32x4 g4 = *(const f32x4*)(ng + c0 + 4 * h), sh = *(const f32x4*)(mr + c0 + 4 * h), sc = *(const f32x4*)(mr + DM + c0 + 4 * h);
                    o[h] = (v[k][j][h] * rs) * g4 * (sc + 1.0f) + sh; }
                st_bf16x8(H + (size_t)r * DM + c0, o[0], o[1]); }
        }
    }
}
DI void final_norm_phase(const Args& A, const bf16_t* src, int wv) {
    const int tid = otid(wv), lane = tid & 63, wave = tid >> 6, G = gridDim.x;
    const float* fg = A.in[17];
    for (int r0 = (blockIdx.x * NWAVES + wave) * 2; r0 < NB * TL; r0 += G * NWAVES * 2) {
        f32x4 v[2][4][2];
#pragma unroll
        for (int k = 0; k < 2; ++k)
#pragma unroll
            for (int j = 0; j < 4; ++j) ld_bf16x8(src + (size_t)(r0 + k) * DM + 512 * j + 8 * lane, v[k][j][0], v[k][j][1]);
#pragma unroll
        for (int k = 0; k < 2; ++k) { float* orow = A.out + (size_t)(r0 + k) * DM; float ss = 0.f;
#pragma unroll
            for (int j = 0; j < 4; ++j)
#pragma unroll
                for (int q = 0; q < 4; ++q) ss += v[k][j][0][q] * v[k][j][0][q] + v[k][j][1][q] * v[k][j][1][q];
            const float rs = 1.0f / sqrtf(wave_sum(ss) * (1.f / DM) + EPS);
#pragma unroll
            for (int j = 0; j < 4; ++j) { const int c0 = 512 * j + 8 * lane;
#pragma unroll
                for (int h = 0; h < 2; ++h) { const f32x4 g4 = *(const f32x4*)(fg + c0 + 4 * h); *(f32x4*)(orow + c0 + 4 * h) = (v[k][j][h] * rs) * g4; } }
        }
    }
}

struct DescPlain {
    static constexpr bool RAW = false;
    const bf16_t* A; const bf16_t* B; int nN; bool latonly; int lda, ldb, K, total;
    DI void init(const bf16_t* A_, const bf16_t* B_, int nN_, bool lat) { A = A_; B = B_; nN = nN_; latonly = lat; lda = DM; ldb = DM; K = DM; total = (lat ? 128 : 144) * nN_; }
    DI pg8::Unit unit(int idx) const {
        const int nMt = latonly ? 128 : 144, nig = 8 * nN, gid = idx / nig, fm = gid * 8, gsz = (nMt - fm) < 8 ? (nMt - fm) : 8;
        const int pmi = fm + (idx % nig) % gsz, pn = (idx % nig) / gsz, pm = latonly ? (pmi / 8) * 9 + (pmi % 8) : pmi;
        pg8::Unit u; u.a = (const char*)(A + (size_t)pm * 256 * DM); u.b = (const char*)(B + (size_t)pn * 256 * DM); u.i0 = pm; u.i1 = pn; u.i2 = 0; return u;
    }
};
struct DescA1 {
    static constexpr bool RAW = false;
    const bf16_t* A; const bf16_t* B; int lda, ldb, K, total;
    DI void init(const bf16_t* A_, const bf16_t* B_) { A = A_; B = B_; lda = DM; ldb = DM; K = DM; total = 128 * 20 + 16 * 4; }
    DI pg8::Unit unit(int idx) const {
        int pm, pn;
        if (idx < 2560) { const int nig = 160, gid = idx / nig, pmi = gid * 8 + (idx % nig) % 8; pn = (idx % nig) / 8; pm = (pmi / 8) * 9 + (pmi % 8); }
        else { const int j = idx - 2560; pm = (j / 4) * 9 + 8; pn = 8 + (j % 4); }
        pg8::Unit u; u.a = (const char*)(A + (size_t)pm * 256 * DM); u.b = (const char*)(B + (size_t)pn * 256 * DM); u.i0 = pm; u.i1 = pn; u.i2 = 0; return u;
    }
};
struct DescChan {
    static constexpr bool RAW = false;
    const bf16_t* DC; const bf16_t* H; int lda, ldb, K, total;
    DI void init(const bf16_t* DC_, const bf16_t* H_, bool lat) { DC = DC_; H = H_; lda = 512; ldb = DM; K = 512; total = lat ? 1024 : 1152; }
    DI pg8::Unit unit(int idx) const {
        pg8::Unit u; int b, g, mt, nt, toff;
        if (idx < 1024) { mt = idx % 2; nt = (idx / 2) % 8; g = (idx / 16) % 4; b = idx / 64; toff = nt * 256; u.i2 = nt; }
        else { const int j = idx - 1024; mt = j % 2; g = (j / 2) % 4; b = j / 8; toff = TL; u.i2 = 8; }
        u.a = (const char*)(DC + (size_t)mt * 256 * 512); u.b = (const char*)(H + ((size_t)b * TB + toff) * DM + g * 512); u.i0 = b * 4 + g; u.i1 = mt; return u;
    }
};
struct DescT {
    static constexpr bool RAW = false;
    const bf16_t* DT; const bf16_t* PQ; int nMt; int lda, ldb, K, total;
    DI void init(const bf16_t* DT_, const bf16_t* PQ_, int ld, int Kd, int coff, int nMt_) { DT = DT_ + coff; PQ = PQ_ + coff; nMt = nMt_; lda = ld; ldb = ld; K = Kd; total = NB * nMt_ * 8; }
    DI pg8::Unit unit(int idx) const {
        const int mt = idx % nMt, nt = (idx / nMt) % 8, b = idx / (nMt * 8);
        pg8::Unit u; u.a = (const char*)(DT + (size_t)mt * 256 * lda); u.b = (const char*)(PQ + ((size_t)b * DM + nt * 256) * ldb); u.i0 = b; u.i1 = mt; u.i2 = nt; return u;
    }
};

struct DescT2 {
    static constexpr bool RAW = true;
    const bf16_t* DT; const bf16_t* PQ; int lda, ldb, K, total;
    DI void init(const bf16_t* DT_, const bf16_t* PQ_) { DT = DT_; PQ = PQ_; lda = 4096; ldb = 4096; K = 2048; total = 2 * NB * 4 * 4; }
    DI bool valid(int L, int G) const { return ((L / G) >> 1) * G + (L % G) < NB * 4 * 4; }
    DI pg8::Unit unit(int L, int G) const {
        const int i = L / G, pair = (i >> 1) * G + (L % G), part = i & 1;
        const int mt = pair % 4, nt = 2 * ((pair / 4) % 4), b = pair / 16, coff = part * 2048;
        pg8::Unit u; u.a = (const char*)(DT + (size_t)mt * 256 * 4096 + coff); u.b = (const char*)(PQ + ((size_t)b * DM + nt * 256) * 4096 + coff); u.i0 = b; u.i1 = mt; u.i2 = part * 8 + nt; return u;
    }
};

struct EpiResid {
    static constexpr bool WHOLE_TILE = true;
    const float* x_in; const float* c_in; bf16_t* XB; bf16_t* X2; const float* modl; int layer;
    DI void init(const Args& A, int layer_) { x_in = A.in[0]; c_in = A.in[2]; XB = (bf16_t*)A.out; X2 = (bf16_t*)(A.ws + WS_SCR + F_PQX); modl = (const float*)(A.ws + WS_MOD) + (size_t)layer_ * 17 * MOD_LD; layer = layer_; }
    DI void run(const pg8::Unit& u, const f32x4 (&acc)[2][2][4][2], int wr, int wc, int fr, int fq) const {
        const int pm = u.i0, b = pm / 9, tt = pm % 9, col0 = u.i1 * 256 + wc * 32 + 8 * fq;
        f32x4 g[2][2];
#pragma unroll
        for (int bj = 0; bj < 2; ++bj) { const float* gp = modl + (size_t)(tt < 8 ? b : 16) * MOD_LD + 2 * DM + col0 + bj * 128; g[bj][0] = *(const f32x4*)gp; g[bj][1] = *(const f32x4*)(gp + 4); }
        if (layer != 0) {
            u32x4 xq[2][4][2];
#pragma unroll
            for (int ai = 0; ai < 2; ++ai)
#pragma unroll
                for (int m = 0; m < 4; ++m)
#pragma unroll
                    for (int bj = 0; bj < 2; ++bj) xq[ai][m][bj] = *(const u32x4*)(XB + ((size_t)pm * 256 + ai * 128 + wr * 64 + m * 16 + fr) * DM + col0 + bj * 128);
#pragma unroll
            for (int ai = 0; ai < 2; ++ai)
#pragma unroll
                for (int m = 0; m < 4; ++m)
#pragma unroll
                    for (int bj = 0; bj < 2; ++bj) {
                        const int row_l = ai * 128 + wr * 64 + m * 16 + fr; const u32x4 w = xq[ai][m][bj];
                        const f32x4 x0 = (f32x4){bf_lo(w.x), bf_hi(w.x), bf_lo(w.y), bf_hi(w.y)} + g[bj][0] * acc[ai][bj][m][0];
                        const f32x4 x1 = (f32x4){bf_lo(w.z), bf_hi(w.z), bf_lo(w.w), bf_hi(w.w)} + g[bj][1] * acc[ai][bj][m][1];
                        if (layer == 3) st_bf16x8(X2 + ((size_t)b * TL + tt * 256 + row_l) * DM + col0 + bj * 128, x0, x1);
                        else st_bf16x8(XB + ((size_t)pm * 256 + row_l) * DM + col0 + bj * 128, x0, x1);
                    }
        } else {
#pragma unroll
            for (int ai = 0; ai < 2; ++ai) {
                f32x4 xf[4][2][2];
#pragma unroll
                for (int m = 0; m < 4; ++m)
#pragma unroll
                    for (int bj = 0; bj < 2; ++bj) { const int row_l = ai * 128 + wr * 64 + m * 16 + fr;
                        const float* src = (tt < 8) ? x_in + ((size_t)b * TL + tt * 256 + row_l) * DM + col0 + bj * 128 : c_in + ((size_t)b * TC + row_l) * DM + col0 + bj * 128;
                        xf[m][bj][0] = *(const f32x4*)src; xf[m][bj][1] = *(const f32x4*)(src + 4); }
#pragma unroll
                for (int m = 0; m < 4; ++m)
#pragma unroll
                    for (int bj = 0; bj < 2; ++bj) { const int row_l = ai * 128 + wr * 64 + m * 16 + fr;
                        st_bf16x8(XB + ((size_t)pm * 256 + row_l) * DM + col0 + bj * 128, xf[m][bj][0] + g[bj][0] * acc[ai][bj][m][0], xf[m][bj][1] + g[bj][1] * acc[ai][bj][m][1]); }
            }
        }
    }
};

DI void fnet_layer(const Args& A, LAS unsigned char* lds, const XcdBarrier& gbar, int layer, int j, bool latonly, int wv) {
    unsigned char* ws = A.ws;
    const bf16_t* H = (const bf16_t*)(ws + WS_H); bf16_t* U = (bf16_t*)(ws + WS_H);
    bf16_t* Gt = (bf16_t*)(ws + WS_SCR + F_G); bf16_t* PQX = (bf16_t*)(ws + WS_SCR + F_PQX); bf16_t* PQC = (bf16_t*)(ws + WS_SCR + F_PQC);
    norm_phase(A, layer, latonly, wv);
    xcd_barrier(gbar, wv);
    {
        DescPlain D; D.init(H, (const bf16_t*)(ws + WS_WFG) + (size_t)j * DM * DM, 8, latonly);
        auto E = [=](const pg8::Unit& u, int row_l, int col_l, f32x4 v0, f32x4 v1) {
            f32x4 a, b;
#pragma unroll
            for (int q = 0; q < 4; ++q) { a[q] = siluf(v0[q]); b[q] = siluf(v1[q]); }
            st_bf16x8(Gt + ((size_t)u.i0 * 256 + row_l) * DM + u.i1 * 256 + col_l, a, b);
        };
        pg8::gemm_phase(lds, D, E, wv);
    }
    {
        DescChan D; D.init((const bf16_t*)(ws + WS_DC), H, latonly);
        auto E = [=](const pg8::Unit& u, int row_l, int col_l, f32x4 v0, f32x4 v1) {
            const int b = u.i0 >> 2, g = u.i0 & 3, m = row_l;
            bf16_t* base; size_t cs; int hs;
            if (u.i2 < 8) { base = PQX + ((size_t)b * DM + g * 512) * 4096 + u.i2 * 256 + col_l; cs = 4096; hs = 2048; }
            else          { base = PQC + ((size_t)b * DM + g * 512) * 512 + col_l; cs = 512; hs = 256; }
            const f32x4 z = {0.f, 0.f, 0.f, 0.f};
            const bool mir = (u.i2 == 8);
            if (u.i1 == 0) { st_bf16x8(base + (size_t)m * cs, v0, v1); if (mir && m != 0) st_bf16x8(base + (size_t)(512 - m) * cs, v0, v1); }
            else if (m == 0) { st_bf16x8(base + (size_t)256 * cs, v0, v1); st_bf16x8(base + hs, z, z); if (mir) st_bf16x8(base + (size_t)256 * cs + hs, z, z); }
            else { st_bf16x8(base + (size_t)m * cs + hs, v0, v1); if (mir) st_bf16x8(base + (size_t)(512 - m) * cs + hs, z - v0, z - v1); }
        };
        pg8::gemm_phase(lds, D, E, wv);
    }
    xcd_barrier(gbar, wv);
    bf16_t* A1 = (bf16_t*)(ws + WS_SCR + F_A1);
    {
        const int tid = otid(wv), lane = tid & 63;
        for (int rr0 = (blockIdx.x * NWAVES + wv) * 4; rr0 < NB * DM; rr0 += gridDim.x * NWAVES * 4) {
            if ((rr0 & 511) > 256) continue;
            u32x4 raw[4][4];
#pragma unroll
            for (int k = 0; k < 4; ++k)
#pragma unroll
                for (int q = 0; q < 4; ++q) raw[k][q] = *(const u32x4*)(PQX + (size_t)(rr0 + ((rr0 & 511) == 256 ? 0 : k)) * 4096 + (q * 64 + lane) * 8);
            float accs[4];
#pragma unroll
            for (int k = 0; k < 4; ++k) { float acc = 0.f;
#pragma unroll
                for (int q = 0; q < 4; ++q) { const u32x4 w = raw[k][q]; acc += (bf_lo(w.x) - bf_hi(w.x)) + (bf_lo(w.y) - bf_hi(w.y)) + (bf_lo(w.z) - bf_hi(w.z)) + (bf_lo(w.w) - bf_hi(w.w)); }
                accs[k] = wave_sum(acc) * 0.022097086912079608f; }
            if (lane == 0) {
                unsigned short g1[4], g2[4]; size_t o1[4], o2[4]; bool v1[4], v2[4];
#pragma unroll
                for (int k = 0; k < 4; ++k) { const int rr = rr0 + k, m = rr & 511; v1[k] = (m <= 256); v2[k] = (m >= 1 && m <= 255);
                    o1[k] = ((size_t)(rr >> 11) * TB + 1024) * DM + (rr & 2047); o2[k] = o1[k] - m + (512 - m);
                    g1[k] = v1[k] ? Gt[o1[k]] : (unsigned short)0; g2[k] = v2[k] ? Gt[o2[k]] : (unsigned short)0; }
#pragma unroll
                for (int k = 0; k < 4; ++k) {
                    if (v1[k]) U[o1[k]] = (bf16_t)(pk2(accs[k] * __uint_as_float((unsigned)g1[k] << 16), 0.f) & 0xffffu);
                    if (v2[k]) U[o2[k]] = (bf16_t)(pk2(accs[k] * __uint_as_float((unsigned)g2[k] << 16), 0.f) & 0xffffu); }
            }
        }
    }
    {
        const int tid = otid(wv), lane = tid & 63; const bf16_t* DTm = (const bf16_t*)(ws + WS_DT);
        for (int it = blockIdx.x * NWAVES + wv; it < 64 * 128; it += gridDim.x * NWAVES) {
            const int bg = it >> 7, kq = it & 127, b = bg >> 2, ch = (bg & 3) * 512 + 256;
            const bf16_t* pr = PQX + ((size_t)b * DM + ch) * 4096;
            u32x4 pv[4], dv[8][4];
#pragma unroll
            for (int q = 0; q < 4; ++q) pv[q] = *(const u32x4*)(pr + (q * 64 + lane) * 8);
#pragma unroll
            for (int kk = 0; kk < 8; ++kk)
#pragma unroll
                for (int q = 0; q < 4; ++q) dv[kk][q] = *(const u32x4*)(DTm + (size_t)(kq * 8 + kk) * 4096 + (q * 64 + lane) * 8);
            float accs[8];
#pragma unroll
            for (int kk = 0; kk < 8; ++kk) { float acc = 0.f;
#pragma unroll
                for (int q = 0; q < 4; ++q) { acc = dot2g(dv[kk][q].x, pv[q].x, acc); acc = dot2g(dv[kk][q].y, pv[q].y, acc); acc = dot2g(dv[kk][q].z, pv[q].z, acc); acc = dot2g(dv[kk][q].w, pv[q].w, acc); }
                accs[kk] = wave_sum(acc); }
            if (lane == 0) {
                unsigned short g1[8], g2[8];
#pragma unroll
                for (int kk = 0; kk < 8; ++kk) { const int k = kq * 8 + kk; g1[kk] = Gt[((size_t)b * TB + k) * DM + ch]; g2[kk] = Gt[((size_t)b * TB + ((TL - k) & (TL - 1))) * DM + ch]; }
#pragma unroll
                for (int kk = 0; kk < 8; ++kk) { const int k = kq * 8 + kk;
                    U[((size_t)b * TB + k) * DM + ch] = (bf16_t)(pk2(accs[kk] * __uint_as_float((unsigned)g1[kk] << 16), 0.f) & 0xffffu);
                    if (k != 0) U[((size_t)b * TB + (TL - k)) * DM + ch] = (bf16_t)(pk2(accs[kk] * __uint_as_float((unsigned)g2[kk] << 16), 0.f) & 0xffffu); }
            }
        }
    }
    {
        DescT2 D; D.init((const bf16_t*)(ws + WS_DT), PQX);
        auto E = [=](const pg8::Unit& u, int row_l, int col_l, f32x4 v0, f32x4 v1) {
            const int k = u.i1 * 256 + row_l, col = (u.i2 & 7) * 256 + col_l;
            bf16_t* ap = A1 + ((size_t)u.i0 * 1024 + k) * DM + col;
            if (u.i2 < 8) { st_bf16x8(ap, v0, v1); return; }
            f32x4 a0, a1; ld_bf16x8(ap, a0, a1);
            const size_t off = ((size_t)u.i0 * TB + k) * DM + col;
            f32x4 g0, g1; ld_bf16x8(Gt + off, g0, g1);
            st_bf16x8(U + off, (a0 + v0) * g0, (a1 + v1) * g1);
            if (k != 0) { const size_t off2 = ((size_t)u.i0 * TB + (TL - k)) * DM + col; ld_bf16x8(Gt + off2, g0, g1); st_bf16x8(U + off2, (a0 - v0) * g0, (a1 - v1) * g1); }
            const f32x4 s0 = a0 + v0, s1 = a1 + v1, d0 = a0 - v0, d1 = a1 - v1;
            const float sm[8] = {s0[0], s0[1], s0[2], s0[3], s1[0], s1[1], s1[2], s1[3]}, df[8] = {d0[0], d0[1], d0[2], d0[3], d1[0], d1[1], d1[2], d1[3]};
            const size_t rowk = ((size_t)u.i0 * TB + k) * DM, rowT = ((size_t)u.i0 * TB + (TL - k)) * DM; const int cm = (col & ~255) + 512 - col_l;
            {
                const bf16_t* gk_ = Gt + rowk + cm - 8; const bf16_t* gT_ = Gt + rowT + cm - 8; bf16_t* uk_ = U + rowk + cm - 8; bf16_t* uT_ = U + rowT + cm - 8;
                const unsigned short ka1 = gk_[1]; const unsigned ka2 = *(const unsigned*)(gk_ + 2); const u32x2 ka4 = *(const u32x2*)(gk_ + 4); const unsigned short ka0 = col_l ? gk_[8] : (unsigned short)0;
                unsigned short ta1 = 0, ta0 = 0; unsigned ta2 = 0; u32x2 ta4 = {0u, 0u};
                if (k != 0) { ta1 = gT_[1]; ta2 = *(const unsigned*)(gT_ + 2); ta4 = *(const u32x2*)(gT_ + 4); ta0 = col_l ? gT_[8] : (unsigned short)0; }
                uk_[1] = (bf16_t)(pk2(df[7] * __uint_as_float((unsigned)ka1 << 16), 0.f) & 0xffffu);
                *(unsigned*)(uk_ + 2) = pk2(df[6] * bf_lo(ka2), df[5] * bf_hi(ka2));
                *(u32x2*)(uk_ + 4) = (u32x2){pk2(df[4] * bf_lo(ka4.x), df[3] * bf_hi(ka4.x)), pk2(df[2] * bf_lo(ka4.y), df[1] * bf_hi(ka4.y))};
                if (col_l) uk_[8] = (bf16_t)(pk2(df[0] * __uint_as_float((unsigned)ka0 << 16), 0.f) & 0xffffu);
                if (k != 0) {
                    uT_[1] = (bf16_t)(pk2(sm[7] * __uint_as_float((unsigned)ta1 << 16), 0.f) & 0xffffu);
                    *(unsigned*)(uT_ + 2) = pk2(sm[6] * bf_lo(ta2), sm[5] * bf_hi(ta2));
                    *(u32x2*)(uT_ + 4) = (u32x2){pk2(sm[4] * bf_lo(ta4.x), sm[3] * bf_hi(ta4.x)), pk2(sm[2] * bf_lo(ta4.y), sm[1] * bf_hi(ta4.y))};
                    if (col_l) uT_[8] = (bf16_t)(pk2(sm[0] * __uint_as_float((unsigned)ta0 << 16), 0.f) & 0xffffu);
                }
            }
        };
        pg8::gemm_phase(lds, D, E, wv);
    }
    if (!latonly) {
        DescT D; D.init((const bf16_t*)(ws + WS_DT2), PQC, 512, 512, 0, 1);
        auto E = [=](const pg8::Unit& u, int row_l, int col_l, f32x4 v0, f32x4 v1) {
            const size_t off = ((size_t)u.i0 * TB + TL + row_l) * DM + u.i2 * 256 + col_l;
            f32x4 g0, g1; ld_bf16x8(Gt + off, g0, g1);
            st_bf16x8(U + off, v0 * g0, v1 * g1);
        };
        pg8::gemm_phase(lds, D, E, wv);
    }
    xcd_barrier(gbar, wv);
    {
        DescPlain D; D.init(U, (const bf16_t*)(ws + WS_WFO) + (size_t)j * DM * DM, 8, latonly);
        EpiResid E; E.init(A, layer);
        pg8::gemm_phase(lds, D, E, wv);
    }
    xcd_barrier(gbar, wv);
}


namespace att {
constexpr int D = 128, NW = 8, QBLK = 32, KVBLK = 64;
constexpr float SCALE = 0.088388347648318440f;
constexpr float THR = 8.f;
constexpr int LDQ = 2048, LDK = 512;
constexpr size_t SHM_V = KVBLK * D * 2, SHM_K = KVBLK * D * 2;
typedef float f32x8 __attribute__((ext_vector_type(8)));
#define KSWZ(row, colB) ((row) * 256 + ((colB) ^ (((row) & 7) << 4)))
#define SBAR() __builtin_amdgcn_sched_barrier(0)
DI int crow(int r, int hi) { return (r & 3) + 8 * (r >> 2) + 4 * hi; }
DI unsigned cvtpk(float lo, float hi) { unsigned r; asm volatile("v_cvt_pk_bf16_f32 %0, %1, %2" : "=v"(r) : "v"(lo), "v"(hi)); return r; }
DI void partialSM(f32x16& p0, f32x16& p1, float& m_reg, float& mn, float& alpha) {
  constexpr float C = SCALE * 1.4426950408889634f;
  float pmax = p0[0];
#pragma unroll
  for (int r = 1; r < 16; ++r) pmax = fmaxf(pmax, p0[r]);
#pragma unroll
  for (int r = 0; r < 16; ++r) pmax = fmaxf(pmax, p1[r]);
  { auto rr = __builtin_amdgcn_permlane32_swap(__float_as_uint(pmax), __float_as_uint(pmax), false, false);
    pmax = fmaxf(__uint_as_float(rr[0]), __uint_as_float(rr[1])); }
  if (__builtin_expect(__all(pmax - m_reg <= THR / SCALE), 1)) { mn = m_reg; alpha = 1.f; }
  else { mn = fmaxf(m_reg, pmax); alpha = __builtin_amdgcn_exp2f((m_reg - mn) * C); m_reg = mn; }
  float mnC = -mn * C;
#pragma unroll
  for (int r = 0; r < 16; ++r) p0[r] = fmaf(p0[r], C, mnC);
#pragma unroll
  for (int r = 0; r < 16; ++r) p1[r] = fmaf(p1[r], C, mnC);
#pragma unroll
  for (int r = 0; r < 16; ++r) p0[r] = __builtin_amdgcn_exp2f(p0[r]);
}
DI void finishSM(f32x16& p0, f32x16& p1, float alpha, float& l_reg, bf16x8& pa0, bf16x8& pa1, bf16x8& pa2, bf16x8& pa3) {
#pragma unroll
  for (int r = 0; r < 16; ++r) p1[r] = __builtin_amdgcn_exp2f(p1[r]);
  float ps = 0;
#pragma unroll
  for (int r = 0; r < 16; ++r) ps += p0[r];
#pragma unroll
  for (int r = 0; r < 16; ++r) ps += p1[r];
  { auto rr = __builtin_amdgcn_permlane32_swap(__float_as_uint(ps), __float_as_uint(ps), false, false);
    ps = __uint_as_float(rr[0]) + __uint_as_float(rr[1]); }
  l_reg = l_reg * alpha + ps;
#define PK4(P, BASE, OUT) do { unsigned a0 = cvtpk(P[BASE + 0], P[BASE + 1]), a1 = cvtpk(P[BASE + 2], P[BASE + 3]);   \
    unsigned b0 = cvtpk(P[BASE + 4], P[BASE + 5]), b1 = cvtpk(P[BASE + 6], P[BASE + 7]);                              \
    auto r0 = __builtin_amdgcn_permlane32_swap(a0, b0, false, false); auto r1 = __builtin_amdgcn_permlane32_swap(a1, b1, false, false); \
    u32x4 w = {r0[0], r1[0], r0[1], r1[1]}; OUT = *reinterpret_cast<bf16x8*>(&w); } while (0)
  PK4(p0, 0, pa0); PK4(p0, 8, pa1); PK4(p1, 0, pa2); PK4(p1, 8, pa3);
#undef PK4
}
DI void qkt(f32x16& p0, f32x16& p1, const bf16_t* Ks, const bf16x8* qr, int r32, int hi) {
  p0 = f32x16{}; p1 = f32x16{};
#pragma unroll
  for (int d0 = 0; d0 < 8; ++d0) { int cb = (d0 * 16 + hi * 8) * 2;
    bf16x8 b0 = *reinterpret_cast<const bf16x8*>((const char*)Ks + KSWZ(r32, cb));
    bf16x8 b1 = *reinterpret_cast<const bf16x8*>((const char*)Ks + KSWZ(32 + r32, cb));
    p0 = __builtin_amdgcn_mfma_f32_32x32x16_bf16(b0, qr[d0], p0, 0, 0, 0);
    p1 = __builtin_amdgcn_mfma_f32_32x32x16_bf16(b1, qr[d0], p1, 0, 0, 0); }
}
DI int v_st(int k, int c) { const int kk = (k & ~0xC) | ((k & 4) << 1) | ((k & 8) >> 1); return ((kk >> 3) * 4 + (c >> 5)) * 512 + ((kk & 7) * 32 + (c & 31)) * 2; }
DI int v_rd_base(int lane) { return ((lane & 3) << 3) | (((lane >> 2) & 3) << 6) | (((lane >> 4) & 1) << 5) | (((lane >> 5) & 1) << 8); }
constexpr int v_rd_off(int d0, int ks, int half) { return d0 * 512 + ks * 4096 + half * 2048; }
template <int OFF> DI s16x4 tr_read(int vb) {
  s16x4 r; asm volatile("ds_read_b64_tr_b16 %0, %1 offset:%2" : "=&v"(r) : "v"(vb), "i"(OFF) : "memory"); return r;
}
template <int D0> DI void pv_one(f32x16& od, int vb, bf16x8 pa0, bf16x8 pa1, bf16x8 pa2, bf16x8 pa3) {
  const s16x4 l0 = tr_read<v_rd_off(D0, 0, 0)>(vb), h0 = tr_read<v_rd_off(D0, 0, 1)>(vb), l1 = tr_read<v_rd_off(D0, 1, 0)>(vb), h1 = tr_read<v_rd_off(D0, 1, 1)>(vb);
  const s16x4 l2 = tr_read<v_rd_off(D0, 2, 0)>(vb), h2 = tr_read<v_rd_off(D0, 2, 1)>(vb), l3 = tr_read<v_rd_off(D0, 3, 0)>(vb), h3 = tr_read<v_rd_off(D0, 3, 1)>(vb);
  asm volatile("s_waitcnt lgkmcnt(0)" ::: "memory"); SBAR();
#define PK(L, H) (bf16x8){L[0], L[1], L[2], L[3], H[0], H[1], H[2], H[3]}
  od = __builtin_amdgcn_mfma_f32_32x32x16_bf16(pa0, PK(l0, h0), od, 0, 0, 0);
  od = __builtin_amdgcn_mfma_f32_32x32x16_bf16(pa1, PK(l1, h1), od, 0, 0, 0);
  od = __builtin_amdgcn_mfma_f32_32x32x16_bf16(pa2, PK(l2, h2), od, 0, 0, 0);
  od = __builtin_amdgcn_mfma_f32_32x32x16_bf16(pa3, PK(l3, h3), od, 0, 0, 0);
#undef PK
}
DI void pv_d0(f32x16* o, int vb, bf16x8 pa0, bf16x8 pa1, bf16x8 pa2, bf16x8 pa3) {
  pv_one<0>(o[0], vb, pa0, pa1, pa2, pa3); pv_one<1>(o[1], vb, pa0, pa1, pa2, pa3); pv_one<2>(o[2], vb, pa0, pa1, pa2, pa3); pv_one<3>(o[3], vb, pa0, pa1, pa2, pa3);
}
DI void attn_dense_body(const bf16_t* __restrict__ Qb, const bf16_t* __restrict__ Kh, const bf16_t* __restrict__ Vh, const bf16_t* SZb, bf16_t* Ub, int seq, char* lds, int wv, const float* qn, int tpos) {
  const int tid = otid(wv), wid = tid >> 6, lane = tid & 63, r32 = lane & 31, hi = lane >> 5;
  bf16_t* V_lds = (bf16_t*)lds; bf16_t* K_lds = (bf16_t*)(lds + 2 * SHM_V);
  float* wsf = (float*)(lds + 2 * SHM_V + 2 * SHM_K) + wid * 64; float* li_l = wsf; float* al_l = wsf + 32;
  float m_reg = -1e30f, l_reg = 0; f32x16 o[4] = {}; bf16x8 qr[8];
  const bf16_t* Qw = Qb + (long)(wid * QBLK + r32) * LDQ + hi * 8;
  {
    u32x4 raw[8];
#pragma unroll
    for (int d0 = 0; d0 < 8; ++d0) raw[d0] = *reinterpret_cast<const u32x4*>(Qw + d0 * 16);
    float ss = 0.f;
#pragma unroll
    for (int d0 = 0; d0 < 8; ++d0) { const u32x4 w = raw[d0];
      ss += bf_lo(w.x) * bf_lo(w.x) + bf_hi(w.x) * bf_hi(w.x) + bf_lo(w.y) * bf_lo(w.y) + bf_hi(w.y) * bf_hi(w.y) + bf_lo(w.z) * bf_lo(w.z) + bf_hi(w.z) * bf_hi(w.z) + bf_lo(w.w) * bf_lo(w.w) + bf_hi(w.w) * bf_hi(w.w); }
    ss += __shfl_xor(ss, 32);
    const float rs = 1.0f / sqrtf(ss * (1.f / 128.f) + EPS);
    const int t = tpos + wid * QBLK + r32;
    const f32x2* rope = (const f32x2*)(lds + 81920);
#pragma unroll
    for (int d0 = 0; d0 < 8; ++d0) { const u32x4 w = raw[d0]; const float* wn = qn + d0 * 16 + hi * 8;
      const f32x4 g0 = *(const f32x4*)wn, g1 = *(const f32x4*)(wn + 4);
      float y[8] = {bf_lo(w.x) * rs * g0[0], bf_hi(w.x) * rs * g0[1], bf_lo(w.y) * rs * g0[2], bf_hi(w.y) * rs * g0[3], bf_lo(w.z) * rs * g1[0], bf_hi(w.z) * rs * g1[1], bf_lo(w.w) * rs * g1[2], bf_hi(w.w) * rs * g1[3]};
      if (tpos >= 0) {
        const int pos = (d0 < 4) ? (t >> 6) : (t & 63);
        const f32x4* rp = (const f32x4*)(rope + pos * 32 + (8 * (d0 & 3) + 4 * hi));
        const f32x4 c01 = rp[0], c23 = rp[1];
        const float cs[4] = {c01[0], c01[2], c23[0], c23[2]}, sn[4] = {c01[1], c01[3], c23[1], c23[3]};
#pragma unroll
        for (int pp = 0; pp < 4; ++pp) { const float x0 = y[2 * pp], x1 = y[2 * pp + 1]; y[2 * pp] = x0 * cs[pp] - x1 * sn[pp]; y[2 * pp + 1] = x0 * sn[pp] + x1 * cs[pp]; }
      }
      u32x4 o4 = {pk2(y[0], y[1]), pk2(y[2], y[3]), pk2(y[4], y[5]), pk2(y[6], y[7])};
      qr[d0] = __builtin_bit_cast(bf16x8, o4); }
  }
  const int sr = tid >> 4, sc = (tid & 15) * 8, vst0 = v_st(sr, sc), vst1 = v_st(32 + sr, sc);
  const int vb0 = (int)(uintptr_t)V_lds + v_rd_base(lane);
  struct { bf16x8 vs0, vs1, ks0, ks1; } sr_[2];
#define SLOAD(i, k0) do { sr_[i].vs0 = *reinterpret_cast<const bf16x8*>(&Vh[(long)((k0) + sr) * LDK + sc]); sr_[i].vs1 = *reinterpret_cast<const bf16x8*>(&Vh[(long)((k0) + 32 + sr) * LDK + sc]); \
    sr_[i].ks0 = *reinterpret_cast<const bf16x8*>(&Kh[(long)((k0) + sr) * LDK + sc]); sr_[i].ks1 = *reinterpret_cast<const bf16x8*>(&Kh[(long)((k0) + 32 + sr) * LDK + sc]); } while (0)
#define SWRITE(b, i) do { *(bf16x8*)((char*)V_lds + (b) * SHM_V + vst0) = sr_[i].vs0;          \
    *(bf16x8*)((char*)V_lds + (b) * SHM_V + vst1) = sr_[i].vs1; int kc = sc * 2;               \
    *(bf16x8*)((char*)K_lds + (b) * SHM_K + KSWZ(sr, kc)) = sr_[i].ks0;                       \
    *(bf16x8*)((char*)K_lds + (b) * SHM_K + KSWZ(32 + sr, kc)) = sr_[i].ks1; } while (0)
#define SWAIT() asm volatile("s_waitcnt vmcnt(4)" ::: "memory")
#define RESC(a) do { if (__any((a) < 1.f)) { if (hi == 0) al_l[r32] = (a); asm volatile("s_waitcnt lgkmcnt(0)" ::: "memory"); \
    _Pragma("unroll") for (int d = 0; d < 4; ++d) _Pragma("unroll") for (int r = 0; r < 16; ++r) o[d][r] *= al_l[crow(r, hi)]; } } while (0)
  f32x16 pA0, pA1, pB0, pB1; float mnA, mnB, alA, alB; bf16x8 pa0, pa1, pa2, pa3; const int NT = seq / KVBLK;
  constexpr int SE = 0, SO = 1;
  SLOAD(SE, 0); asm volatile("s_waitcnt vmcnt(0)" ::: "memory"); SWRITE(0, SE); __syncthreads();
  qkt(pA0, pA1, K_lds, qr, r32, hi); partialSM(pA0, pA1, m_reg, mnA, alA);
  SLOAD(SO, KVBLK); if (2 < NT) SLOAD(SE, 2 * KVBLK);
  SWAIT(); SWRITE(1, SO); __syncthreads();
  for (int j = 1; j + 1 < NT; j += 2) {
    SBAR(); qkt(pB0, pB1, (bf16_t*)((char*)K_lds + SHM_K), qr, r32, hi);
    finishSM(pA0, pA1, alA, l_reg, pa0, pa1, pa2, pa3); SBAR();
    SLOAD(SO, (j + 2) * KVBLK); SBAR();
    pv_d0(o, vb0, pa0, pa1, pa2, pa3); partialSM(pB0, pB1, m_reg, mnB, alB);
    __syncthreads(); SWAIT(); SWRITE(0, SE);
    RESC(alB); __syncthreads();
    SBAR(); qkt(pA0, pA1, K_lds, qr, r32, hi);
    finishSM(pB0, pB1, alB, l_reg, pa0, pa1, pa2, pa3); SBAR();
    if (j + 3 < NT) SLOAD(SE, (j + 3) * KVBLK); SBAR();
    pv_d0(o, vb0 + (int)SHM_V, pa0, pa1, pa2, pa3); partialSM(pA0, pA1, m_reg, mnA, alA);
    __syncthreads(); SWAIT(); SWRITE(1, SO);
    RESC(alA); __syncthreads();
  }
  SBAR(); qkt(pB0, pB1, (bf16_t*)((char*)K_lds + SHM_K), qr, r32, hi);
  finishSM(pA0, pA1, alA, l_reg, pa0, pa1, pa2, pa3); SBAR();
  pv_d0(o, vb0, pa0, pa1, pa2, pa3); partialSM(pB0, pB1, m_reg, mnB, alB);
  __syncthreads(); RESC(alB);
  finishSM(pB0, pB1, alB, l_reg, pa0, pa1, pa2, pa3); SBAR();
  pv_d0(o, vb0 + (int)SHM_V, pa0, pa1, pa2, pa3);
  u32x4 zq[8];
#pragma unroll
  for (int i = 0; i < 8; ++i) { const int id = tid + 512 * i; zq[i] = *(const u32x4*)(SZb + (long)(id >> 4) * LDQ + (id & 15) * 8); }
  if (hi == 0) li_l[r32] = l_reg; asm volatile("s_waitcnt lgkmcnt(0)" ::: "memory");
  __syncthreads();
  {
    float rli[16];
#pragma unroll
    for (int r = 0; r < 16; ++r) rli[r] = __builtin_amdgcn_rcpf(li_l[crow(r, hi)]);
    char* ost = lds;
#pragma unroll
    for (int r = 0; r < 16; ++r) { char* rowp = ost + (wid * QBLK + crow(r, hi)) * 256 + r32 * 2;
#pragma unroll
      for (int d0 = 0; d0 < 4; ++d0) *(unsigned short*)(rowp + d0 * 64) = (unsigned short)(pk2(o[d0][r] * rli[r], 0.f) & 0xffffu); }
  }
  __syncthreads();
#pragma unroll
  for (int i = 0; i < 8; ++i) { const int id = tid + 512 * i; const int row = id >> 4, ch = id & 15;
    const u32x4 ov = *(const u32x4*)(lds + row * 256 + ch * 16);
    f32x4 a0 = {bf_lo(ov.x), bf_hi(ov.x), bf_lo(ov.y), bf_hi(ov.y)}, a1 = {bf_lo(ov.z), bf_hi(ov.z), bf_lo(ov.w), bf_hi(ov.w)};
    const f32x4 z0 = {bf_lo(zq[i].x), bf_hi(zq[i].x), bf_lo(zq[i].y), bf_hi(zq[i].y)}, z1 = {bf_lo(zq[i].z), bf_hi(zq[i].z), bf_lo(zq[i].w), bf_hi(zq[i].w)};
    st_bf16x8(Ub + (long)row * LDQ + ch * 8, a0 * z0, a1 * z1); }
  __syncthreads();
#undef SLOAD
#undef SWRITE
#undef SWAIT
#undef RESC
}
#undef KSWZ
#undef SBAR
}

DI void qknorm_phase(const Args& A, LAS unsigned char* lds, int wv) {
    const int tid = otid(wv), lane = tid & 63, wave = tid >> 6, G = gridDim.x;
    bf16_t* Q = (bf16_t*)(A.ws + WS_SCR + A_Q); bf16_t* Kb = (bf16_t*)(A.ws + WS_SCR + A_K);
    const float* qn = A.in[14]; const float* kn = A.in[15];
    const int sub = lane >> 4, l16 = lane & 15, e0 = l16 * 8;
    LAS f32x2* rope = (LAS f32x2*)lds;
    for (int e = tid; e < 2048; e += NTHREADS) { const float ang = (float)(e >> 5) * exp2f(-(float)(e & 31) * 0.41524101186092029f); rope[e] = (f32x2){cosf(ang), sinf(ang)}; }
    __syncthreads();
    const long NIT = (long)NTOK * 4;
    for (long it0 = ((long)blockIdx.x * NWAVES + wave) * 16 + sub; it0 < NIT; it0 += (long)G * NWAVES * 16) {
        bf16_t* pq[4]; u32x4 raw[4];
#pragma unroll
        for (int k = 0; k < 4; ++k) { const long it = it0 + 4 * k; const int row = (int)(it >> 2), hj = 16 + (int)(it & 3);
            pq[k] = (hj < 16) ? Q + (size_t)row * 2048 + hj * 128 + e0 : Kb + (size_t)row * 512 + (hj - 16) * 128 + e0;
            raw[k] = *(const u32x4*)pq[k]; }
#pragma unroll
        for (int k = 0; k < 4; ++k) {
            const long it = it0 + 4 * k; const int row = (int)(it >> 2), hj = 16 + (int)(it & 3);
            const float* wn = (hj < 16 ? qn : kn) + e0;
            f32x4 a = {bf_lo(raw[k].x), bf_hi(raw[k].x), bf_lo(raw[k].y), bf_hi(raw[k].y)}, b = {bf_lo(raw[k].z), bf_hi(raw[k].z), bf_lo(raw[k].w), bf_hi(raw[k].w)};
            float ss = 0.f;
#pragma unroll
            for (int q = 0; q < 4; ++q) ss += a[q] * a[q] + b[q] * b[q];
            ss += __shfl_xor(ss, 1); ss += __shfl_xor(ss, 2); ss += __shfl_xor(ss, 4); ss += __shfl_xor(ss, 8);
            const float rs = 1.0f / sqrtf(ss * (1.f / 128.f) + EPS);
            const f32x4 w0 = *(const f32x4*)wn, w1 = *(const f32x4*)(wn + 4);
            a = a * rs * w0; b = b * rs * w1;
            const int t = row % TB;
            if (t < TL) {
                const int pos = (l16 < 8) ? (t >> 6) : (t & 63);
                float y[8] = {a[0], a[1], a[2], a[3], b[0], b[1], b[2], b[3]};
                const LAS f32x4* rp = (const LAS f32x4*)(rope + pos * 32 + ((4 * l16) & 31));
                const f32x4 c01 = rp[0], c23 = rp[1];
                const float cs[4] = {c01[0], c01[2], c23[0], c23[2]}, sn[4] = {c01[1], c01[3], c23[1], c23[3]};
#pragma unroll
                for (int pp = 0; pp < 4; ++pp) {
                    const float x0 = y[2 * pp], x1 = y[2 * pp + 1];
                    y[2 * pp] = x0 * cs[pp] - x1 * sn[pp]; y[2 * pp + 1] = x0 * sn[pp] + x1 * cs[pp];
                }
                a = (f32x4){y[0], y[1], y[2], y[3]}; b = (f32x4){y[4], y[5], y[6], y[7]};
            }
            st_bf16x8(pq[k], a, b);
        }
    }
}

DI void attn_layer(const Args& A, LAS unsigned char* lds, char* lds_gen, const XcdBarrier& gbar, int layer, int wv) {
    unsigned char* ws = A.ws;
    const bf16_t* H = (const bf16_t*)(ws + WS_H); bf16_t* U = (bf16_t*)(ws + WS_H);
    bf16_t* Q = (bf16_t*)(ws + WS_SCR + A_Q); bf16_t* Kb = (bf16_t*)(ws + WS_SCR + A_K); bf16_t* Vb = (bf16_t*)(ws + WS_SCR + A_V); bf16_t* SZ = (bf16_t*)(ws + WS_SCR + A_SZ);
    norm_phase(A, layer, false, wv);
    xcd_barrier(gbar, wv);
    {
        DescA1 D; D.init(H, (const bf16_t*)(ws + WS_WAI));
        auto E = [=](const pg8::Unit& u, int row_l, int col_l, f32x4 v0, f32x4 v1) {
            const size_t row = (size_t)u.i0 * 256 + row_l; const int pn = u.i1;
            if (pn < 8) st_bf16x8(Q + row * 2048 + pn * 256 + col_l, v0, v1);
            else if (pn < 10) st_bf16x8(Kb + row * 512 + (pn - 8) * 256 + col_l, v0, v1);
            else if (pn < 12) st_bf16x8(Vb + row * 512 + (pn - 10) * 256 + col_l, v0, v1);
            else { f32x4 a, b;
#pragma unroll
                for (int q = 0; q < 4; ++q) { a[q] = siluf(v0[q]); b[q] = siluf(v1[q]); }
                st_bf16x8(SZ + row * 2048 + (pn - 12) * 256 + col_l, a, b); }
        };
        pg8::gemm_phase(lds, D, E, wv);
    }
    xcd_barrier(gbar, wv);
    qknorm_phase(A, lds, wv);
    xcd_barrier(gbar, wv);
    {
        const int G = gridDim.x, c = blockIdx.x;
        { f32x2* rope = (f32x2*)(lds_gen + 81920); const int tid = otid(wv);
          for (int e = tid; e < 2048; e += NTHREADS) { const float ang = (float)(e >> 5) * exp2f(-(float)(e & 31) * 0.41524101186092029f); rope[e] = (f32x2){cosf(ang), sinf(ang)}; }
          __syncthreads(); }
        const float* qn = A.in[14];
        for (long L = c; L < 2048; L += G) {
            const int u = pg8::xcd_remap((int)L, 2048);
            const int b = u / 128, rem = u % 128, kvh = rem / 32, g = (rem / 8) % 4, qb = rem % 8, h = kvh * 4 + g;
            const size_t qoff = ((size_t)b * TB + qb * 256) * 2048 + h * 128, koff = ((size_t)b * TB) * 512 + kvh * 128;
            att::attn_dense_body(Q + qoff, Kb + koff, Vb + koff, SZ + qoff, U + qoff, TB, lds_gen, wv, qn, qb * 256);
        }
    }
    xcd_barrier(gbar, wv);
    {
        DescPlain D; D.init(U, (const bf16_t*)(ws + WS_WAO), 8, true);
        EpiResid E; E.init(A, layer);
        pg8::gemm_phase(lds, D, E, wv);
    }
    xcd_barrier(gbar, wv);
}


struct DescM1 {
    static constexpr bool RAW = false;
    const bf16_t* H; const bf16_t* WA; const bf16_t* WB; int lda, ldb, K, total;
    DI void init(const bf16_t* H_, const bf16_t* WA_, const bf16_t* WB_) { H = H_; WA = WA_; WB = WB_; lda = DM; ldb = DM; K = DM; total = 144 * 9 + 8 * 144; }
    DI pg8::Unit unit(int idx) const {
        pg8::Unit u;
        if (idx < 1296) { const int nig = 72, gid = idx / nig, pm = gid * 8 + (idx % nig) % 8, pn = (idx % nig) / 8;
            u.a = (const char*)(H + (size_t)pm * 256 * DM); u.b = (const char*)(WA + (size_t)pn * 256 * DM); u.i0 = pm; u.i1 = pn; u.i2 = 0; }
        else { const int j = idx - 1296, mt = j % 8, nt = j / 8;
            u.a = (const char*)(WB + (size_t)mt * 256 * DM); u.b = (const char*)(H + (size_t)nt * 256 * DM); u.i0 = mt; u.i1 = nt; u.i2 = 1; }
        return u;
    }
};
namespace ml {
#define MFMA32(a, b, c) __builtin_amdgcn_mfma_f32_32x32x16_bf16((a), (b), (c), 0, 0, 0)
#define LFENCE() asm volatile("s_waitcnt lgkmcnt(0)" ::: "memory")
DI float dot2_bf16(unsigned a, unsigned b, float c) { asm("v_dot2c_f32_bf16 %0, %1, %2" : "+v"(c) : "v"(a), "v"(b)); return c; }
#define DOT2(a, b, c) dot2_bf16((a), (b), (c))
DI int crow(int reg, int h) { return (reg & 3) + 8 * (reg >> 2) + 4 * h; }
DI bf16x8 ldperm(const bf16_t* p) { const s16x4 lo = *(const s16x4*)p, hi = *(const s16x4*)(p + 8); return __builtin_shufflevector(lo, hi, 0, 1, 2, 3, 4, 5, 6, 7); }
DI bf16x8 pack_step(const f32x16& x, int s) { u32x4 p = {pk2(x[8 * s], x[8 * s + 1]), pk2(x[8 * s + 2], x[8 * s + 3]), pk2(x[8 * s + 4], x[8 * s + 5]), pk2(x[8 * s + 6], x[8 * s + 7])}; return __builtin_bit_cast(bf16x8, p); }
DI float bfs(short h) { return __uint_as_float(((unsigned)(unsigned short)h) << 16); }

constexpr int SC_Q = 0, SC_K = 16384, SC_KT = 32768, SC_BUF = 49152, SC_WAVE = 2 * SC_BUF, SC_WAVE_BYTES = 6656;
DI bf16x8 ldsfrag(const LAS unsigned char* buf, unsigned o) { const s16x4 lo = *(const LAS s16x4*)(buf + o), hi = *(const LAS s16x4*)(buf + (o ^ 16u)); return __builtin_shufflevector(lo, hi, 0, 1, 2, 3, 4, 5, 6, 7); }
DI void scan_phase(const Args& A, LAS unsigned char* lds, int wv) {
    const int wave = wv;
    LAS float* wl = (LAS float*)(lds + SC_WAVE + wave * SC_WAVE_BYTES);
    LAS unsigned* nbp = (LAS unsigned*)(lds + SC_WAVE + wave * SC_WAVE_BYTES + 2048);
    LAS unsigned* wbp = nbp + 64;
    LAS unsigned char* hst = lds + SC_WAVE + wave * SC_WAVE_BYTES + 2560;
    unsigned char* ws = A.ws;
    const bf16_t* Qg = (const bf16_t*)(ws + WS_SCR + M_Q); const bf16_t* Kg = (const bf16_t*)(ws + WS_SCR + M_K); const bf16_t* KVT = (const bf16_t*)(ws + WS_SCR + M_KVT);
    const float* G32 = (const float*)(ws + WS_SCR + M_G32); const float* bg = A.in[10];
#define SC_POS0(j) (dir == 0 ? ((j) < 4 ? TL + 64 * (j) : 64 * ((j) - 4)) : ((j) < 4 ? TL + 64 * (3 - (j)) : 64 * (35 - (j))))
#define SC_DMA(bufi, p0) do { const int tj_ = otid(wv); _Pragma("unroll") for (int i_ = 0; i_ < 2; ++i_) { const int sl_ = i_ * 512 + tj_; \
        { const int row_ = sl_ >> 4, c_ = (sl_ & 15) ^ (row_ & 15); const size_t go_ = (size_t)((p0) + row_) * 1024 + c_ * 8; \
          __builtin_amdgcn_global_load_lds((const unsigned*)(Qu + go_), (LAS unsigned*)(lds + (bufi) * SC_BUF + SC_Q + i_ * 8192 + wave * 1024), 16, 0, 0); \
          __builtin_amdgcn_global_load_lds((const unsigned*)(Ku + go_), (LAS unsigned*)(lds + (bufi) * SC_BUF + SC_K + i_ * 8192 + wave * 1024), 16, 0, 0); } \
        { const int d_ = sl_ >> 3, c_ = (sl_ & 7) ^ ((d_ >> 1) & 7); \
          __builtin_amdgcn_global_load_lds((const unsigned*)(KTu + (size_t)d_ * TB + (p0) + c_ * 8), (LAS unsigned*)(lds + (bufi) * SC_BUF + SC_KT + i_ * 8192 + wave * 1024), 16, 0, 0); } } } while (0)
    for (int item = blockIdx.x; item < 256; item += gridDim.x) {
        const int dir = item & 1, h = (item >> 1) & 7, b = item >> 4, e0 = wave * 32;
        const bf16_t* Qu = Qg + (size_t)b * TB * 1024 + h * 128;
        const bf16_t* Ku = Kg + (size_t)b * TB * 1024 + h * 128;
        const bf16_t* KTu = KVT + ((size_t)b * 3072 + h * 128) * TB;
        const bf16_t* VTu = KVT + ((size_t)b * 3072 + 1024 + h * 256 + e0) * TB;
        bf16_t* Hout = (bf16_t*)(ws + WS_SCR + (dir ? M_HB : M_HF)) + (size_t)b * TB * DM + h * 256 + e0;
        const float big = bg[(dir * 2) * 8 + h], bfg = bg[(dir * 2 + 1) * 8 + h];
        f32x16 cacc[4];
#pragma unroll
        for (int d = 0; d < 4; ++d)
#pragma unroll
            for (int i = 0; i < 16; ++i) cacc[d][i] = 0.f;
        float m = 0.f;
        { const int l0 = otid(wv) & 63; wl[384 + l0] = 0.f; wl[448 + l0] = 0.f; nbp[l0] = 0u; }
        LFENCE();
        SC_DMA(0, SC_POS0(0));
        float ig_n, fg_n;
        { const int l0 = otid(wv) & 63; const float* gp = G32 + (size_t)(b * TB + SC_POS0(0) + (dir ? 63 - l0 : l0)) * 32 + (dir * 2) * 8 + h; ig_n = gp[0]; fg_n = gp[8]; }
        for (int j = 0; j < 36; ++j) {
            const int pos0 = SC_POS0(j);
            const LAS unsigned char* Qb = lds + (j & 1) * SC_BUF + SC_Q; const LAS unsigned char* Kb = lds + (j & 1) * SC_BUF + SC_K; const LAS unsigned char* KTb = lds + (j & 1) * SC_BUF + SC_KT;
            asm volatile("s_waitcnt vmcnt(0)" ::: "memory"); __builtin_amdgcn_s_barrier(); asm volatile("" ::: "memory");
            if (j + 1 < 36) SC_DMA((j + 1) & 1, SC_POS0(j + 1));
            const int lj = otid(wv) & 63, rj = lj & 31, h4 = (lj >> 5) * 4;
            LAS float* wh = wl + h4; LAS float* wr = wl + rj; LAS unsigned char* hb = hst + h4 * 64 + rj * 2;
            const LAS unsigned* nbh = nbp + (h4 >> 1); const LAS unsigned* wbh = wbp + (h4 >> 1);
            const unsigned xr = rj & 15, xd = (rj >> 1) & 7;
            const unsigned qro = (unsigned)rj * 256u + 2u * h4;
            const unsigned kro = (unsigned)rj * 128u + 2u * h4;
            const bf16_t* VTp = VTu + (size_t)rj * TB + pos0 + h4;
            bf16x8 vf[4];
#pragma unroll
            for (int kk = 0; kk < 4; ++kk) vf[kk] = ldperm(VTp + 16 * kk);
            float decay, m_new;
            {
                const int s = dir ? 63 - lj : lj;
                const float ig = ig_n + big, fg = fg_n + bfg;
                if (j + 1 < 36) { const float* gp = G32 + (size_t)(b * TB + SC_POS0(j + 1) + s) * 32 + (dir * 2) * 8 + h; ig_n = gp[0]; fg_n = gp[8]; }
                const float lf = fminf(fg, 0.f) - log1pf(__expf(-fabsf(fg)));
                float bs = lf;
#pragma unroll
                for (int o = 1; o < 64; o <<= 1) { const float t = __shfl_up(bs, o); if (lj >= o) bs += t; }
                const float uu = ig - bs;
                float pmx = uu;
#pragma unroll
                for (int o = 1; o < 64; o <<= 1) { const float t = __shfl_up(pmx, o); if (lj >= o) pmx = fmaxf(pmx, t); }
                pmx = fmaxf(pmx, m);
                const float b_end = __shfl(bs, 63), pm_last = __shfl(pmx, 63);
                LAS float* ws_ = wl + s;
                ws_[0] = uu * 1.4426950408889634f; ws_[64] = pmx * 1.4426950408889634f; ws_[128] = __expf(m - pmx); ws_[192] = __expf(-(bs + pmx)); ws_[256] = __expf(uu - pm_last);
                { const float wv_ = __expf(uu - pm_last), wp_ = __shfl_xor(wv_, 1); if ((s & 1) == 0) wbp[s >> 1] = pk2(wv_, wp_); }
                decay = __expf(m - pm_last); m_new = b_end + pm_last;
            }
            LFENCE();
            const int sbase = dir ? 63 - h4 : h4, sgn = dir ? -1 : 1;
#pragma unroll
            for (int tb = 0; tb < 2; ++tb) {
                __builtin_amdgcn_sched_barrier(0);
                const unsigned qo = qro + tb * 8192u;
                f32x16 ha;
#pragma unroll
                for (int i = 0; i < 16; ++i) ha[i] = 0.f;
                float qnv = 0.f;
#pragma unroll
                for (int kk = 0; kk < 8; ++kk) {
                    const bf16x8 qa = ldsfrag(Qb, qo + (((2u * kk) ^ xr) << 4));
                    ha = MFMA32(qa, pack_step(cacc[kk >> 1], kk & 1), ha);
                    { const u32x2 nb0 = *(const LAS u32x2*)(nbh + 8 * kk), nb1 = *(const LAS u32x2*)(nbh + 8 * kk + 4); const u32x4 qw = __builtin_bit_cast(u32x4, qa);
                      qnv = DOT2(qw.x, nb0.x, qnv); qnv = DOT2(qw.y, nb0.y, qnv); qnv = DOT2(qw.z, nb1.x, qnv); qnv = DOT2(qw.w, nb1.y, qnv); }
                }
                qnv += __shfl_xor(qnv, 32);
#pragma unroll
                for (int g = 0; g < 4; ++g) { const f32x4 av = *(const LAS f32x4*)(wh + 128 + 32 * tb + 8 * g);
#pragma unroll
                    for (int q = 0; q < 4; ++q) ha[4 * g + q] *= av[q]; }
                const float pmt = wr[64 + 32 * tb];
                const int tp = dir ? (63 - 32 * tb) - rj : 32 * tb + rj;
                float ds = 0.f;
#pragma unroll
                for (int sb = 0; sb < 2; ++sb) {
                    __builtin_amdgcn_sched_barrier(0);
                    if (sb != tb && (dir ? sb < tb : sb > tb)) continue;
                    const unsigned ko = qro + sb * 8192u;
                    f32x16 st;
#pragma unroll
                    for (int i = 0; i < 16; ++i) st[i] = 0.f;
#pragma unroll
                    for (int kk = 0; kk < 8; ++kk) { const unsigned c = ((2u * kk) ^ xr) << 4; st = MFMA32(ldsfrag(Kb, ko + c), ldsfrag(Qb, qo + c), st); }
#pragma unroll
                    for (int g = 0; g < 4; ++g) { const f32x4 uv = *(const LAS f32x4*)(wh + 32 * sb + 8 * g);
#pragma unroll
                        for (int q = 0; q < 4; ++q) {
                            const int sc = 32 * sb + q + 8 * g;
                            const int sp = sbase + sgn * sc;
                            st[4 * g + q] *= __builtin_amdgcn_exp2f((sp <= tp) ? uv[q] - pmt : -1e30f);
                            ds += st[4 * g + q];
                        } }
                    ha = MFMA32(pack_step(st, 0), vf[2 * sb], ha);
                    ha = MFMA32(pack_step(st, 1), vf[2 * sb + 1], ha);
                }
                ds += __shfl_xor(ds, 32);
                {
                    const float den = wr[128 + 32 * tb] * qnv + ds;
                    const float rd = 1.0f / fmaxf(fabsf(den), wr[192 + 32 * tb]);
                    if (h4 == 0) wr[320 + 32 * tb] = rd;
                }
                LFENCE();
#pragma unroll
                for (int g = 0; g < 4; ++g) { const f32x4 rv = *(const LAS f32x4*)(wh + 320 + 32 * tb + 8 * g);
#pragma unroll
                    for (int q = 0; q < 4; ++q) { const int tc = 32 * tb + q + 8 * g;
                        *(LAS unsigned short*)(hb + tc * 64) = (unsigned short)(pk2(ha[4 * g + q] * rv[q], 0.f) & 0xffffu); } }
            }
            LFENCE();
            {
                bf16_t* hp = Hout + (size_t)(pos0 + lj) * DM;
                const LAS unsigned char* hrow = hst + lj * 64;
#pragma unroll
                for (int q = 0; q < 4; ++q) *(u32x4*)(hp + 8 * q) = *(const LAS u32x4*)(hrow + 16 * q);
            }
            __builtin_amdgcn_sched_barrier(0);
            bf16x8 vfw[4];
#pragma unroll
            for (int kk = 0; kk < 4; ++kk) {
                const f32x4 w0 = *(const LAS f32x4*)(wh + 256 + 16 * kk), w1 = *(const LAS f32x4*)(wh + 256 + 16 * kk + 8);
                u32x4 p = {pk2(bfs(vf[kk][0]) * w0[0], bfs(vf[kk][1]) * w0[1]), pk2(bfs(vf[kk][2]) * w0[2], bfs(vf[kk][3]) * w0[3]),
                           pk2(bfs(vf[kk][4]) * w1[0], bfs(vf[kk][5]) * w1[1]), pk2(bfs(vf[kk][6]) * w1[2], bfs(vf[kk][7]) * w1[3])};
                vfw[kk] = __builtin_bit_cast(bf16x8, p);
            }
#pragma unroll
            for (int db = 0; db < 4; ++db) {
#pragma unroll
                for (int i = 0; i < 16; ++i) cacc[db][i] *= decay;
                const unsigned to = kro + db * 4096u;
                float nadd = 0.f;
#pragma unroll
                for (int kk = 0; kk < 4; ++kk) {
                    const bf16x8 kv = ldsfrag(KTb, to + (((2u * kk) ^ xd) << 4));
                    const u32x2 wq0 = *(const LAS u32x2*)(wbh + 8 * kk), wq1 = *(const LAS u32x2*)(wbh + 8 * kk + 4); const u32x4 kw = __builtin_bit_cast(u32x4, kv);
                    nadd = DOT2(kw.x, wq0.x, nadd); nadd = DOT2(kw.y, wq0.y, nadd); nadd = DOT2(kw.z, wq1.x, nadd); nadd = DOT2(kw.w, wq1.y, nadd);
                    cacc[db] = MFMA32(kv, vfw[kk], cacc[db]);
                }
                nadd += __shfl_xor(nadd, 32);
                const float nnew = decay * wr[384 + 32 * db] + nadd, npart = __shfl_xor(nnew, 1);
                if (h4 == 0) { wr[384 + 32 * db] = nnew; if ((rj & 1) == 0) nbp[(32 * db + rj) >> 1] = pk2(nnew, npart); }
            }
            LFENCE();
            m = m_new;
        }
        asm volatile("s_waitcnt vmcnt(0)" ::: "memory"); __builtin_amdgcn_s_barrier();
    }
#undef SC_DMA
#undef SC_POS0
}
#undef MFMA32
#undef LFENCE
#undef DOT2
}

DI void mlstm_finish_phase(const Args& A, int wv) {
    const int tid = otid(wv), lane = tid & 63, wave = tid >> 6, G = gridDim.x;
    unsigned char* ws = A.ws;
    const bf16_t* HF = (const bf16_t*)(ws + WS_SCR + M_HF); const bf16_t* HB = (const bf16_t*)(ws + WS_SCR + M_HB);
    const bf16_t* SO = (const bf16_t*)(ws + WS_SCR + M_SO); const bf16_t* SZ = (const bf16_t*)(ws + WS_SCR + M_SZ);
    bf16_t* U = (bf16_t*)(ws + WS_H); const float* hn = A.in[11];
    const int sub = lane >> 5, e0 = (lane & 31) * 8;
    const long NIT = (long)NTOK * 8;
    for (long it0 = ((long)blockIdx.x * NWAVES + wave) * 4 + sub; it0 < NIT; it0 += (long)G * NWAVES * 4) {
        f32x4 f0[2], f1[2], b0[2], b1[2], o0[2], o1[2], z0[2], z1[2];
#pragma unroll
        for (int k = 0; k < 2; ++k) { const long it = it0 + 2 * k; const size_t off = (size_t)(it >> 3) * DM + (int)(it & 7) * 256 + e0;
            ld_bf16x8(HF + off, f0[k], f1[k]); ld_bf16x8(HB + off, b0[k], b1[k]); ld_bf16x8(SO + off, o0[k], o1[k]); ld_bf16x8(SZ + off, z0[k], z1[k]); }
#pragma unroll
        for (int k = 0; k < 2; ++k) { const long it = it0 + 2 * k; const size_t off = (size_t)(it >> 3) * DM + (int)(it & 7) * 256 + e0;
            f32x4 y0 = o0[k] * (f0[k] + b0[k]), y1 = o1[k] * (f1[k] + b1[k]);
            float ss = 0.f;
#pragma unroll
            for (int q = 0; q < 4; ++q) ss += y0[q] * y0[q] + y1[q] * y1[q];
            ss += __shfl_xor(ss, 1); ss += __shfl_xor(ss, 2); ss += __shfl_xor(ss, 4); ss += __shfl_xor(ss, 8); ss += __shfl_xor(ss, 16);
            const float rs = 1.0f / sqrtf(ss * (1.f / 256.f) + EPS);
            const float* hp = hn + (int)(it & 7) * 256 + e0;
            const f32x4 h0 = *(const f32x4*)hp, h1 = *(const f32x4*)(hp + 4);
            st_bf16x8(U + off, y0 * rs * h0 * z0[k], y1 * rs * h1 * z1[k]); }
    }
}

DI void mlstm_layer(const Args& A, LAS unsigned char* lds, const XcdBarrier& gbar, int layer, int wv) {
    unsigned char* ws = A.ws;
    const bf16_t* H = (const bf16_t*)(ws + WS_H); bf16_t* U = (bf16_t*)(ws + WS_H);
    bf16_t* Q = (bf16_t*)(ws + WS_SCR + M_Q); bf16_t* Kb = (bf16_t*)(ws + WS_SCR + M_K); bf16_t* KVT = (bf16_t*)(ws + WS_SCR + M_KVT);
    float* G32 = (float*)(ws + WS_SCR + M_G32); bf16_t* SO = (bf16_t*)(ws + WS_SCR + M_SO); bf16_t* SZ = (bf16_t*)(ws + WS_SCR + M_SZ);
    norm_phase(A, layer, false, wv);
    xcd_barrier(gbar, wv);
    {
        DescM1 D; D.init(H, (const bf16_t*)(ws + WS_WMA), (const bf16_t*)(ws + WS_WMB));
        auto E = [=](const pg8::Unit& u, int row_l, int col_l, f32x4 v0, f32x4 v1) {
            if (u.i2 == 0) {
                const size_t row = (size_t)u.i0 * 256 + row_l; const int pn = u.i1;
                if (pn < 4) st_bf16x8(Q + row * 1024 + pn * 256 + col_l, v0 * 0.088388347648318440f, v1 * 0.088388347648318440f);
                else if (pn < 8) { st_bf16x8(Kb + row * 1024 + (pn - 4) * 256 + col_l, v0, v1);
                    const int bb = u.i0 / 9, sp = (u.i0 % 9) * 256 + row_l;
                    bf16_t* kt = KVT + ((size_t)bb * 3072 + (pn - 4) * 256 + col_l) * TB + sp;
                    const unsigned w0 = pk2(v0[0], v0[1]), w1 = pk2(v0[2], v0[3]), w2 = pk2(v1[0], v1[1]), w3 = pk2(v1[2], v1[3]);
                    kt[0] = (bf16_t)(w0 & 0xffffu); kt[TB] = (bf16_t)(w0 >> 16); kt[2 * TB] = (bf16_t)(w1 & 0xffffu); kt[3 * TB] = (bf16_t)(w1 >> 16);
                    kt[4 * TB] = (bf16_t)(w2 & 0xffffu); kt[5 * TB] = (bf16_t)(w2 >> 16); kt[6 * TB] = (bf16_t)(w3 & 0xffffu); kt[7 * TB] = (bf16_t)(w3 >> 16); }
                else if (col_l < 32) { *(f32x4*)(G32 + row * 32 + col_l) = v0; *(f32x4*)(G32 + row * 32 + col_l + 4) = v1; }
            } else {
                const int bb = u.i1 / 9, s0 = (u.i1 % 9) * 256;
                st_bf16x8(KVT + ((size_t)bb * 3072 + 1024 + u.i0 * 256 + row_l) * TB + s0 + col_l, v0, v1);
            }
        };
        pg8::gemm_phase(lds, D, E, wv);
    }
    xcd_barrier(gbar, wv);
    ml::scan_phase(A, lds, wv);
    xcd_barrier(gbar, wv);
    {
        DescPlain D; D.init(H, (const bf16_t*)(ws + WS_WMA) + (size_t)2304 * DM, 16, false);
        auto E = [=](const pg8::Unit& u, int row_l, int col_l, f32x4 v0, f32x4 v1) {
            const size_t row = (size_t)u.i0 * 256 + row_l; const int pn = u.i1; f32x4 a, b;
            if (pn < 8) {
#pragma unroll
                for (int q = 0; q < 4; ++q) { a[q] = sigmf(v0[q]); b[q] = sigmf(v1[q]); }
                st_bf16x8(SO + row * DM + pn * 256 + col_l, a, b);
            } else {
#pragma unroll
                for (int q = 0; q < 4; ++q) { a[q] = siluf(v0[q]); b[q] = siluf(v1[q]); }
                st_bf16x8(SZ + row * DM + (pn - 8) * 256 + col_l, a, b);
            }
        };
        pg8::gemm_phase(lds, D, E, wv);
    }
    xcd_barrier(gbar, wv);
    mlstm_finish_phase(A, wv);
    xcd_barrier(gbar, wv);
    {
        DescPlain D; D.init(U, (const bf16_t*)(ws + WS_WMO), 8, false);
        EpiResid E; E.init(A, layer);
        pg8::gemm_phase(lds, D, E, wv);
    }
    xcd_barrier(gbar, wv);
}

__global__ void __launch_bounds__(NTHREADS, 2) fwd_megakernel(Args A) {
    extern __shared__ __attribute__((aligned(16))) unsigned char lds_raw[];
    LAS unsigned char* lds = (LAS unsigned char*)lds_raw;
    cg::grid_group grid = cg::this_grid();
    const int wv = __builtin_amdgcn_readfirstlane(threadIdx.x >> 6);
    volatile LAS unsigned* bst = (volatile LAS unsigned*)(lds + 152576);
    if (otid(wv) < 2) bst[otid(wv)] = 0u;
    __syncthreads();
    const XcdBarrier gbar = xcd_barrier_post((unsigned*)(A.ws + WS_BAR), bst, wv);
    prep_phase(A, lds, wv);
    grid.sync();
    {
        const float* mp = (const float*)(A.ws + WS_MODP); float* mf = (float*)(A.ws + WS_MOD);
        for (int i = blockIdx.x * NTHREADS + otid(wv); i < 4 * 17 * MOD_LD; i += gridDim.x * NTHREADS) { float a = 0.f;
#pragma unroll
            for (int kc = 0; kc < 16; ++kc) a += mp[(size_t)kc * (4 * 17 * MOD_LD) + i];
            mf[i] = a; }
    }
    xcd_barrier(gbar, wv);
    fnet_layer(A, lds, gbar, 0, 0, false, wv);
    mlstm_layer(A, lds, gbar, 1, wv);
    attn_layer(A, lds, (char*)lds_raw, gbar, 2, wv);
    fnet_layer(A, lds, gbar, 3, 1, true, wv);
    final_norm_phase(A, (const bf16_t*)(A.ws + WS_SCR + F_PQX), wv);
}

extern "C" void kernel_launch(void* const* d_in, const int* in_sizes, int n_in, void* d_out, int out_size, void* d_ws, size_t ws_size, hipStream_t stream) {
    static int grid = 0;
    if (grid == 0) {
        if (n_in != 18 || ws_size < WS_END) { fprintf(stderr, "kernel_launch: unexpected n_in %d / ws_size %zu (need %zu)\n", n_in, ws_size, (size_t)WS_END); grid = -1; return; }
        int dev = 0, cus = 0, per_cu = 0;
        hipGetDevice(&dev);
        hipDeviceGetAttribute(&cus, hipDeviceAttributeMultiprocessorCount, dev);
        if (hipFuncSetAttribute((const void*)fwd_megakernel, hipFuncAttributeMaxDynamicSharedMemorySize, LDS_BYTES) != hipSuccess) { fprintf(stderr, "kernel_launch: hipFuncSetAttribute failed\n"); grid = -1; return; }
        if (hipOccupancyMaxActiveBlocksPerMultiprocessor(&per_cu, (const void*)fwd_megakernel, NTHREADS, LDS_BYTES) != hipSuccess || per_cu < 1) { fprintf(stderr, "kernel_launch: occupancy query failed (%d)\n", per_cu); per_cu = 1; }
        (void)hipGetLastError();
        grid = cus * per_cu;
        fprintf(stderr, "kernel_launch: grid %d (cus %d x %d)\n", grid, cus, per_cu);
    }
    if (grid < 0) return;
    (void)hipMemsetAsync((char*)d_ws + WS_MOD, 0, ZERO_BYTES, stream);
    Args a{};
    for (int i = 0; i < 18; ++i) a.in[i] = (const float*)d_in[i];
    a.out = (float*)d_out; a.ws = (unsigned char*)d_ws; a.ph_lo = 0; a.ph_hi = 100;
    void* args[] = {&a};
    hipError_t e = hipLaunchCooperativeKernel((const void*)fwd_megakernel, dim3(grid), dim3(NTHREADS), args, LDS_BYTES, stream);
    if (e != hipSuccess) fprintf(stderr, "kernel_launch: cooperative launch failed: %s (grid %d)\n", hipGetErrorString(e), grid);
}
```
